# Optimizing an MI355X kernel written in HIP

```python
import jax, jax.numpy as jnp
from jax import lax
import numpy as np

D_MODEL = 1024
BATCH = 32
SEQ = 2048
DEPTH = 4

HEAD_DIM = 64
MLA_HEADS = 8
MLA_Q_RANK = 256
MLA_KV_RANK = 128
MLA_NOPE = 64
MLA_ROPE = 32
MLA_V = 64
DSA_HEADS = 4
IDX_HEADS = 8
IDX_DIM = 32
DSA_TOPK_MAX = 256
DIL_CONFIGS = ((128, 1), (512, 4), (2048, 16))
DIL_HEADS = 4
MIX_WIDTH = (MLA_HEADS + DSA_HEADS + DIL_HEADS) * HEAD_DIM
ROPE_THETA = 500000.0
ROT_HEAD_DIMS = HEAD_DIM // 4
ROT_IDX_DIMS = IDX_DIM // 4
Q_BLOCK = 128
N_GROUPS = 4
EXPERTS_PER_GROUP = 8
TOP_K_IN_GROUP = 2
EXPERT_HIDDEN = 256
DEEPNORM_ALPHA = (2.0 * DEPTH) ** 0.25
DEEPNORM_BETA = (8.0 * DEPTH) ** -0.25
LN_EPS = 1e-5
RMS_EPS = 1e-6
NEG_INF = -1e30
IN_SPLITS = (MLA_Q_RANK, MLA_KV_RANK, MLA_ROPE,
             DSA_HEADS * HEAD_DIM, HEAD_DIM, HEAD_DIM,
             IDX_HEADS * IDX_DIM, IDX_DIM, IDX_HEADS,
             3 * len(DIL_CONFIGS) * DIL_HEADS * HEAD_DIM)
IN_COLS = sum(IN_SPLITS)

kernel_name = "hybrid_mla_dsa_dilated_hmoe_deepnorm"


def layer_norm(x, g, b):
    xf = x.astype(jnp.float32)
    mu = jnp.mean(xf, -1, keepdims=True)
    var = jnp.mean(jnp.square(xf - mu), -1, keepdims=True)
    return ((xf - mu) * lax.rsqrt(var + LN_EPS) * g.astype(jnp.float32) + b.astype(jnp.float32)).astype(x.dtype)


def rms_norm(x, g):
    xf = x.astype(jnp.float32)
    y = xf * lax.rsqrt(jnp.mean(jnp.square(xf), -1, keepdims=True) + RMS_EPS)
    return (y * g.astype(jnp.float32)).astype(x.dtype)


def rope_table(positions, rot_dims):
    inv = ROPE_THETA ** (-jnp.arange(0, rot_dims, 2, dtype=jnp.float32) / rot_dims)
    ang = positions.astype(jnp.float32)[..., None] * inv
    return jnp.cos(ang), jnp.sin(ang)


def apply_rope(x, cos, sin):
    half = cos.shape[-1]
    r = 2 * half
    c, s = cos[:, :, None, :], sin[:, :, None, :]
    xf = x[..., :r].astype(jnp.float32)
    x1, x2 = xf[..., :half], xf[..., half:]
    rot = jnp.concatenate([x1 * c - x2 * s, x2 * c + x1 * s], -1).astype(x.dtype)
    return jnp.concatenate([rot, x[..., r:]], -1)


def _to_blocks(a):
    B, S = a.shape[:2]
    return jnp.moveaxis(a.reshape(B, S // Q_BLOCK, Q_BLOCK, *a.shape[2:]), 1, 0)


def _from_blocks(a):
    nb, B, qb = a.shape[:3]
    return jnp.moveaxis(a, 0, 1).reshape(B, nb * qb, *a.shape[3:])


def _block_starts(S):
    return jnp.arange(S // Q_BLOCK, dtype=jnp.int32) * Q_BLOCK


def mla_mixer(cq, ckv, kpe, q_norm, kv_norm, w_uq, w_ukv, cos, sin):
    B, S = cq.shape[:2]
    q = jnp.einsum('bsr,rc->bsc', rms_norm(cq, q_norm), w_uq).reshape(B, S, MLA_HEADS, MLA_NOPE + MLA_ROPE)
    q = jnp.concatenate([q[..., :MLA_NOPE], apply_rope(q[..., MLA_NOPE:], cos, sin)], -1)
    kv = jnp.einsum('bsr,rc->bsc', rms_norm(ckv, kv_norm), w_ukv).reshape(B, S, MLA_HEADS, MLA_NOPE + MLA_V)
    k_pe = apply_rope(kpe[:, :, None, :], cos, sin)
    k = jnp.concatenate([kv[..., :MLA_NOPE], jnp.broadcast_to(k_pe, (B, S, MLA_HEADS, MLA_ROPE))], -1)
    v = kv[..., MLA_NOPE:]
    scale = (MLA_NOPE + MLA_ROPE) ** -0.5
    key_pos = jnp.arange(S, dtype=jnp.int32)

    def block(args):
        q0, qb = args
        qpos = q0 + jnp.arange(Q_BLOCK, dtype=jnp.int32)
        s = jnp.einsum('bqhd,bkhd->bhqk', qb, k, preferred_element_type=jnp.float32) * scale
        s = jnp.where(key_pos[None, :] <= qpos[:, None], s, NEG_INF)
        p = jax.nn.softmax(s, -1).astype(v.dtype)
        return jnp.einsum('bhqk,bkhd->bqhd', p, v)

    o = _from_blocks(lax.map(block, (_block_starts(S), _to_blocks(q))))
    return o.reshape(B, S, MLA_HEADS * MLA_V)


def dsa_mixer(q, k, v, qi, ki, wi, cos_h, sin_h, cos_i, sin_i):
    B, S = q.shape[:2]
    q = apply_rope(q.reshape(B, S, DSA_HEADS, HEAD_DIM), cos_h, sin_h)
    k = apply_rope(k[:, :, None, :], cos_h, sin_h)[:, :, 0]
    qi = apply_rope(qi.reshape(B, S, IDX_HEADS, IDX_DIM), cos_i, sin_i)
    ki = apply_rope(ki[:, :, None, :], cos_i, sin_i)[:, :, 0]
    top_k = min(DSA_TOPK_MAX, S // 4)
    key_pos = jnp.arange(S, dtype=jnp.int32)
    gather = jax.vmap(lambda arr, idx: arr[idx])
    idx_scale = IDX_DIM ** -0.5 * IDX_HEADS ** -0.5

    def block(args):
        q0, qb, qib, wb = args
        qpos = q0 + jnp.arange(Q_BLOCK, dtype=jnp.int32)
        rel = jax.nn.relu(jnp.einsum('bqhd,bsd->bqhs', qib, ki, preferred_element_type=jnp.float32))
        score = jnp.einsum('bqhs,bqh->bqs', rel, wb.astype(jnp.float32)) * idx_scale
        score = jnp.where(key_pos[None, None, :] <= qpos[None, :, None], score, NEG_INF)
        _, sel = lax.top_k(score, top_k)
        k_sel = gather(k, sel)
        v_sel = gather(v, sel)
        valid = sel <= qpos[None, :, None]
        s = jnp.einsum('bqhd,bqkd->bhqk', qb, k_sel, preferred_element_type=jnp.float32) * HEAD_DIM ** -0.5
        s = jnp.where(valid[:, None], s, NEG_INF)
        p = jax.nn.softmax(s, -1).astype(v.dtype)
        return jnp.einsum('bhqk,bqkd->bqhd', p, v_sel)

    o = _from_blocks(lax.map(block, (_block_starts(S), _to_blocks(q), _to_blocks(qi), _to_blocks(wi))))
    return o.reshape(B, S, DSA_HEADS * HEAD_DIM)


def dilated_window_attention(q, k, v, window, dilation):
    S = q.shape[1]
    n_keys = window // dilation + 1
    offs = dilation * jnp.arange(n_keys, dtype=jnp.int32)

    def block(args):
        q0, qb = args
        qpos = q0 + jnp.arange(Q_BLOCK, dtype=jnp.int32)
        idx = qpos[:, None] - offs[None, :]
        valid = idx >= 0
        idx = jnp.maximum(idx, 0)
        k_sel = k[:, idx]
        v_sel = v[:, idx]
        s = jnp.einsum('bqhd,bqkhd->bqhk', qb, k_sel, preferred_element_type=jnp.float32) * HEAD_DIM ** -0.5
        s = jnp.where(valid[None, :, None, :], s, NEG_INF)
        lse = jax.nn.logsumexp(s, -1)
        p = jnp.exp(s - lse[..., None]).astype(v.dtype)
        return jnp.einsum('bqhk,bqkhd->bqhd', p, v_sel), lse

    o, lse = lax.map(block, (_block_starts(S), _to_blocks(q)))
    return _from_blocks(o), _from_blocks(lse)


def dilated_mixer(qkv, cos, sin):
    B, S = qkv.shape[:2]
    n_cfg = len(DIL_CONFIGS)
    qkv = qkv.reshape(B, S, 3, n_cfg * DIL_HEADS, HEAD_DIM)
    q = apply_rope(qkv[:, :, 0], cos, sin)
    k = apply_rope(qkv[:, :, 1], cos, sin)
    v = qkv[:, :, 2]
    outs, lses = [], []
    for g, (window, dilation) in enumerate(DIL_CONFIGS):
        sl = slice(g * DIL_HEADS, (g + 1) * DIL_HEADS)
        o, lse = dilated_window_attention(q[:, :, sl], k[:, :, sl], v[:, :, sl], window, dilation)
        outs.append(o)
        lses.append(lse)
    wts = jax.nn.softmax(jnp.stack(lses, 0), axis=0)
    o = jnp.sum(wts[..., None] * jnp.stack(outs, 0).astype(jnp.float32), 0).astype(qkv.dtype)
    return o.reshape(B, S, DIL_HEADS * HEAD_DIM)


def hybrid_mixer(x, tabs, w_in, q_norm, kv_norm, w_uq, w_ukv, w_o):
    (cos_m, sin_m), (cos_h, sin_h), (cos_i, sin_i) = tabs
    u = jnp.einsum('bsd,dc->bsc', x, w_in)
    cuts = [int(c) for c in np.cumsum(IN_SPLITS)[:-1]]
    a_cq, a_ckv, a_kpe, b_q, b_k, b_v, b_qi, b_ki, b_wi, c_qkv = jnp.split(u, cuts, axis=-1)
    o_a = mla_mixer(a_cq, a_ckv, a_kpe, q_norm, kv_norm, w_uq, w_ukv, cos_m, sin_m)
    o_b = dsa_mixer(b_q, b_k, b_v, b_qi, b_ki, b_wi, cos_h, sin_h, cos_i, sin_i)
    o_c = dilated_mixer(c_qkv, cos_h, sin_h)
    o = jnp.concatenate([o_a, o_b, o_c], -1)
    return jnp.einsum('bsc,cd->bsd', o, w_o)


def hier_moe(x, rg_w, rg_b, re_w, re_b, w_gate, w_up, w_down):
    B, S, D = x.shape
    t = x.reshape(B * S, D)
    lg = jnp.einsum('td,dg->tg', t, rg_w, preferred_element_type=jnp.float32) + rg_b.astype(jnp.float32)
    g_star = jnp.argmax(lg, -1)
    g_hot = jax.nn.one_hot(g_star, N_GROUPS, dtype=jnp.float32)
    p_top = jnp.sum(jax.nn.softmax(lg, -1) * g_hot, -1, keepdims=True)
    le = jnp.einsum('td,gde->tge', t, re_w, preferred_element_type=jnp.float32) + re_b.astype(jnp.float32)
    le = jnp.einsum('tge,tg->te', le, g_hot)
    top_v, top_i = lax.top_k(le, TOP_K_IN_GROUP)
    w_sel = jax.nn.softmax(top_v, -1)
    gate_e = jnp.sum(jax.nn.one_hot(top_i, EXPERTS_PER_GROUP, dtype=jnp.float32) * w_sel[..., None], 1)
    gate = (g_hot[:, :, None] * (p_top * gate_e)[:, None, :]).astype(x.dtype)
    y = jnp.zeros_like(t)
    for g in range(N_GROUPS):
        h = jax.nn.silu(jnp.einsum('td,edf->tef', t, w_gate[g])) * jnp.einsum('td,edf->tef', t, w_up[g])
        y = y + jnp.einsum('tef,efd->td', h * gate[:, g, :, None], w_down[g])
    return y.reshape(B, S, D)


def setup_inputs(seed: int = 0) -> dict:
    key = jax.random.key(seed)
    ks = jax.random.split(key, 20)

    def nrm(k, shape, scale):
        return jax.random.normal(k, shape, jnp.float32) * scale

    x = nrm(ks[0], (BATCH, SEQ, D_MODEL), 1.0)
    positions = (jax.random.randint(ks[1], (BATCH, 1), 0, 4096, dtype=jnp.int32)
                 + jnp.arange(SEQ, dtype=jnp.int32)[None, :])
    G, E, F = N_GROUPS, EXPERTS_PER_GROUP, EXPERT_HIDDEN
    return {
        "x": x,
        "positions": positions,
        "w_in": nrm(ks[2], (DEPTH, D_MODEL, IN_COLS), D_MODEL ** -0.5),
        "mla_q_norm": 1.0 + nrm(ks[3], (DEPTH, MLA_Q_RANK), 0.02),
        "mla_kv_norm": 1.0 + nrm(ks[4], (DEPTH, MLA_KV_RANK), 0.02),
        "mla_w_uq": nrm(ks[5], (DEPTH, MLA_Q_RANK, MLA_HEADS * (MLA_NOPE + MLA_ROPE)), MLA_Q_RANK ** -0.5),
        "mla_w_ukv": nrm(ks[6], (DEPTH, MLA_KV_RANK, MLA_HEADS * (MLA_NOPE + MLA_V)), MLA_KV_RANK ** -0.5),
        "w_o": nrm(ks[7], (DEPTH, MIX_WIDTH, D_MODEL), MIX_WIDTH ** -0.5 * DEEPNORM_BETA),
        "ln1_g": 1.0 + nrm(ks[8], (DEPTH, D_MODEL), 0.02),
        "ln1_b": nrm(ks[9], (DEPTH, D_MODEL), 0.02),
        "router_group_w": nrm(ks[10], (DEPTH, D_MODEL, G), D_MODEL ** -0.5),
        "router_group_b": nrm(ks[11], (DEPTH, G), 0.01),
        "router_expert_w": nrm(ks[12], (DEPTH, G, D_MODEL, E), D_MODEL ** -0.5),
        "router_expert_b": nrm(ks[13], (DEPTH, G, E), 0.01),
        "expert_w_gate": nrm(ks[14], (DEPTH, G, E, D_MODEL, F), D_MODEL ** -0.5),
        "expert_w_up": nrm(ks[15], (DEPTH, G, E, D_MODEL, F), D_MODEL ** -0.5),
        "expert_w_down": nrm(ks[16], (DEPTH, G, E, F, D_MODEL), F ** -0.5 * DEEPNORM_BETA),
        "ln2_g": 1.0 + nrm(ks[17], (DEPTH, D_MODEL), 0.02),
        "ln2_b": nrm(ks[18], (DEPTH, D_MODEL), 0.02),
    }


def reference(x, positions, w_in, mla_q_norm, mla_kv_norm, mla_w_uq, mla_w_ukv, w_o, ln1_g, ln1_b,
              router_group_w, router_group_b, router_expert_w, router_expert_b,
              expert_w_gate, expert_w_up, expert_w_down, ln2_g, ln2_b):
    tabs = (rope_table(positions, MLA_ROPE),
            rope_table(positions, ROT_HEAD_DIMS),
            rope_table(positions, ROT_IDX_DIMS))
    for l in range(DEPTH):
        mix = hybrid_mixer(x, tabs, w_in[l], mla_q_norm[l], mla_kv_norm[l], mla_w_uq[l], mla_w_ukv[l], w_o[l])
        x = layer_norm(DEEPNORM_ALPHA * x + mix, ln1_g[l], ln1_b[l])
        moe = hier_moe(x, router_group_w[l], router_group_b[l], router_expert_w[l], router_expert_b[l],
                       expert_w_gate[l], expert_w_up[l], expert_w_down[l])
        x = layer_norm(DEEPNORM_ALPHA * x + moe, ln2_g[l], ln2_b[l])
    return x
```

```cpp
#include <hip/hip_runtime.h>
#include <cstdio>
#include <cstdint>

#define LAS __attribute__((address_space(3)))
#define GAS __attribute__((address_space(1)))
typedef unsigned short bf16;
typedef short bf16x8 __attribute__((ext_vector_type(8)));
typedef short s16x4 __attribute__((ext_vector_type(4)));
typedef float f32x2 __attribute__((ext_vector_type(2)));
typedef float f32x4 __attribute__((ext_vector_type(4)));
typedef float f32x16 __attribute__((ext_vector_type(16)));
typedef unsigned u32x2 __attribute__((ext_vector_type(2)));
typedef unsigned u32x4 __attribute__((ext_vector_type(4)));
typedef __bf16 bf16x2_t __attribute__((ext_vector_type(2)));

#ifndef MK_MULTI
#define MK_MULTI 0
#endif

constexpr int NB = 32, SEQ = 2048, NT = NB * SEQ, DM = 1024, DEPTH = 4;
constexpr int IN_COLS = 3400, NIN = 3584;
constexpr int NEXP = 32, FH = 256;
constexpr int NSLOT = 2 * NT + NEXP * 256;
constexpr int MAXTILES = NSLOT / 256;
constexpr float ALPHA = 1.681792830507429f;
constexpr float LOG2E = 1.4426950408889634f;
constexpr float QSC64 = 0.125f * LOG2E;
constexpr float QSC96 = 0.10206207261596577f * LOG2E;
constexpr float IDX_SCALE = 0.0625f;

constexpr size_t MiB = 1u << 20;
constexpr size_t WS_CTL = 0, CTL_BYTES = 1 * MiB;
constexpr size_t WS_WIN = 1 * MiB;
constexpr size_t WS_WUQ = 29 * MiB;
constexpr size_t WS_WUKV = WS_WUQ + 3 * MiB / 2;
constexpr size_t WS_WO = WS_WUKV + 2 * MiB;
constexpr size_t WS_RGT = WS_WO + 8 * MiB;
constexpr size_t WS_RET = WS_RGT + 64 * 1024;
constexpr size_t WS_ROPE = 42 * MiB;
constexpr size_t WS_WGU = 56 * MiB;
constexpr size_t WS_WD = 88 * MiB;
constexpr size_t WS_XB = 104 * MiB;
constexpr size_t WS_A = 232 * MiB;
constexpr size_t WS_CQ = WS_A;
constexpr size_t WS_T1 = WS_CQ + 32 * MiB;
constexpr size_t WS_BQ = WS_T1 + 32 * MiB;
constexpr size_t WS_BV = WS_BQ + 32 * MiB;
constexpr size_t WS_WI = WS_BV + 8 * MiB;
constexpr size_t WS_BQI = WS_WI + 2 * MiB;
constexpr size_t WS_SSQ = WS_BQI + 32 * MiB;
constexpr size_t WS_DQ = WS_SSQ + 4 * MiB;
constexpr size_t WS_DK = WS_DQ + 96 * MiB;
constexpr size_t WS_DV = WS_DK + 96 * MiB;
constexpr size_t WS_B = WS_DV + 96 * MiB;
constexpr size_t WS_QA = WS_B;
constexpr size_t WS_KVA = WS_QA + 96 * MiB;
constexpr size_t WS_BM = WS_KVA + 128 * MiB;
constexpr size_t WS_OD = WS_BM + 16 * MiB;
constexpr size_t WS_LSE = WS_OD + 96 * MiB;
constexpr size_t WS_MOE = WS_LSE + 4 * MiB;
constexpr size_t WS_ROUTE = WS_MOE;
constexpr size_t WS_HIST = WS_ROUTE + 1 * MiB;
constexpr size_t WS_STOK = WS_HIST + 64 * 1024;
constexpr size_t WS_SW = WS_STOK + 640 * 1024;
constexpr size_t WS_TSLOT = WS_SW + 640 * 1024;
constexpr size_t WS_TILEE = WS_TSLOT + 512 * 1024;
constexpr size_t WS_KPE = WS_MOE + 4 * MiB;
constexpr size_t WS_KI = WS_KPE + 4 * MiB;
constexpr size_t WS_END = WS_KI + 4 * MiB;
constexpr size_t WS_MIX = WS_A;
constexpr size_t WS_H = WS_A + 128 * MiB;
constexpr size_t WS_Y = WS_H + 68 * MiB;
static_assert(WS_RET + 512 * 1024 <= WS_ROPE && WS_ROPE + 14 * MiB <= WS_WGU && WS_WD + 16 * MiB <= WS_XB && WS_XB + 128 * MiB <= WS_A, "ws map 1");
static_assert(WS_Y + 272 * MiB <= WS_MOE && WS_TILEE + 8192 <= WS_END && WS_END <= 1024 * MiB, "ws map 2");
constexpr size_t ROPE_C16 = 0, ROPE_S16 = (size_t)NT * 16 * 4, ROPE_C8 = 2 * ROPE_S16, ROPE_S8 = ROPE_C8 + (size_t)NT * 8 * 4,
                 ROPE_C4 = ROPE_S8 + (size_t)NT * 8 * 4, ROPE_S4 = ROPE_C4 + (size_t)NT * 4 * 4;

constexpr int CW_BAR = 4096;
constexpr int RING_BYTES = 131072;
constexpr int LDS_X_OFF = 131072;
constexpr int LDSCTL_OFF = 147456;
constexpr int LDS_HIST_OFF = LDSCTL_OFF + 4096;
constexpr int LDS_BYTES = LDS_HIST_OFF + 4096;

#define RLX_AGENT __ATOMIC_RELAXED, __HIP_MEMORY_SCOPE_AGENT
__device__ __forceinline__ unsigned f2bf(float f) { unsigned u = __builtin_bit_cast(unsigned, f); return (u + 0x7fffu + ((u >> 16) & 1u)) >> 16; }
#ifndef NT_EPI
#define NT_EPI 1
#endif
#ifndef NT_LN
#define NT_LN 1
#endif
#ifndef NT_ATT
#define NT_ATT 1
#endif
template <bool NT> __device__ __forceinline__ void stgf4(void* p, f32x4 w) { if constexpr (NT) __builtin_nontemporal_store(w, (f32x4*)p); else *(f32x4*)p = w; }
template <bool NT> __device__ __forceinline__ void stg16(void* p, u32x4 w) { if constexpr (NT) __builtin_nontemporal_store(w, (u32x4*)p); else *(u32x4*)p = w; }
template <bool NT> __device__ __forceinline__ void stg8(void* p, u32x2 w) { if constexpr (NT) __builtin_nontemporal_store(w, (u32x2*)p); else *(u32x2*)p = w; }
__device__ __forceinline__ unsigned pk2(float lo, float hi) { f32x2 v = {lo, hi}; bf16x2_t b = __builtin_convertvector(v, bf16x2_t); return __builtin_bit_cast(unsigned, b); }
__device__ __forceinline__ float bf2f(unsigned short b) { return __builtin_bit_cast(float, ((unsigned)b) << 16); }
__device__ __forceinline__ float bflo(unsigned w) { return __builtin_bit_cast(float, w << 16); }
__device__ __forceinline__ float bfhi(unsigned w) { return __builtin_bit_cast(float, w & 0xffff0000u); }
template <int CTRL> __device__ __forceinline__ float dppf(float x) { return __builtin_bit_cast(float, __builtin_amdgcn_mov_dpp(__builtin_bit_cast(int, x), CTRL, 0xf, 0xf, true)); }
__device__ __forceinline__ float xhalf_sum(float v) { const auto t = __builtin_amdgcn_permlane32_swap(__float_as_uint(v), __float_as_uint(v), false, false); return __uint_as_float(t[0]) + __uint_as_float(t[1]); }
__device__ __forceinline__ float xhalf_max(float v) { const auto t = __builtin_amdgcn_permlane32_swap(__float_as_uint(v), __float_as_uint(v), false, false); return fmaxf(__uint_as_float(t[0]), __uint_as_float(t[1])); }
__device__ __forceinline__ float wave_sum(float v) {
    v += dppf<0xB1>(v); v += dppf<0x4E>(v); v += dppf<0x141>(v); v += dppf<0x140>(v);
    const auto s = __builtin_amdgcn_permlane16_swap(__float_as_uint(v), __float_as_uint(v), false, false);
    v = __uint_as_float(s[0]) + __uint_as_float(s[1]);
    return xhalf_sum(v);
}
__device__ __forceinline__ int crow(int r, int hi) { return (r & 3) + 8 * (r >> 2) + 4 * hi; }

#define XB_TMO      128
#define XB_XCNT(j)  (256  + 64 * (j))
#define XB_XSUB(j)  (1280 + 64 * (j))
#define XB_XGEN(j)  (2304 + 64 * (j))
#define XB_TOP      3328
#define XB_TOPGEN   3392
#define XCD_BAR_WORDS 3456
#define XB_SPIN_CAP (1u << 18)
__device__ __forceinline__ unsigned xb_ld(unsigned* p)              { return __hip_atomic_load(p, __ATOMIC_RELAXED, __HIP_MEMORY_SCOPE_AGENT); }
__device__ __forceinline__ unsigned xb_add(unsigned* p, unsigned v) { return __hip_atomic_fetch_add(p, v, __ATOMIC_RELAXED, __HIP_MEMORY_SCOPE_AGENT); }
__device__ __forceinline__ unsigned xb_xcc_id() { return (unsigned)__builtin_amdgcn_s_getreg((3 << 11) | 20) & 0xFu; }
#define XB_SPIN(cond, bar) do { unsigned _sp = 0; while (cond) { __builtin_amdgcn_s_sleep(1); \
    if ((++_sp & 255u) == 0u) { if (xb_ld(&(bar)[XB_TMO])) break; if (_sp > XB_SPIN_CAP) { atomicAdd(&(bar)[XB_TMO], 1u); break; } } } } while (0)
struct XcdBarrier { unsigned* bar; unsigned x; volatile LAS unsigned* st; };
__device__ __forceinline__ XcdBarrier xcd_barrier_post(unsigned* bar, volatile LAS unsigned* st) {
    XcdBarrier b; b.bar = bar; b.x = xb_xcc_id(); b.st = st;
    if (threadIdx.x == 0) (void)xb_add(&bar[XB_XCNT(b.x)], 1u);
    return b;
}
__device__ __forceinline__ void xcd_barrier_complete(unsigned* bar, unsigned x, unsigned& nloc, unsigned& nx) {
    const unsigned G = gridDim.x * gridDim.y * gridDim.z;
    unsigned sum, cnt, mine, sp = 0u;
    for (;;) {
        sum = 0u; cnt = 0u; mine = 0u;
#pragma unroll
        for (unsigned j = 0; j < 16; ++j) { const unsigned c = xb_ld(&bar[XB_XCNT(j)]); sum += c; cnt += (c > 0u) ? 1u : 0u; mine = (j == x) ? c : mine; }
        if (sum == G) break;
        __builtin_amdgcn_s_sleep(1);
        if ((++sp & 255u) == 0u) { if (xb_ld(&bar[XB_TMO])) break; if (sp > XB_SPIN_CAP) { atomicAdd(&bar[XB_TMO], 1u); break; } }
    }
    nloc = mine > 0u ? mine : 1u; nx = cnt > 0u ? cnt : 1u;
}
__device__ __forceinline__ void xcd_barrier(const XcdBarrier& b) {
    asm volatile("s_waitcnt vmcnt(0)" ::: "memory");
    __syncthreads();
    if (threadIdx.x == 0) {
        unsigned* bar = b.bar;
        __builtin_amdgcn_s_waitcnt(0);
        unsigned nloc = b.st[0], nx = b.st[1];
        if (nloc == 0u) { xcd_barrier_complete(bar, b.x, nloc, nx); b.st[0] = nloc; b.st[1] = nx; }
        const unsigned old = xb_add(&bar[XB_XSUB(b.x)], 1u);
        const unsigned gen = old / nloc;
        if (old + 1u == (gen + 1u) * nloc) {
            __builtin_amdgcn_fence(__ATOMIC_RELEASE, "agent");
            asm volatile("s_waitcnt vmcnt(0)" ::: "memory");
            const unsigned og = xb_add(&bar[XB_TOP], 1u);
            const unsigned tg = og / nx;
            if (og + 1u == (tg + 1u) * nx) xb_add(&bar[XB_TOPGEN], 1u);
            else XB_SPIN(xb_ld(&bar[XB_TOPGEN]) == tg, bar);
            __builtin_amdgcn_fence(__ATOMIC_ACQUIRE, "agent");
            xb_add(&bar[XB_XGEN(b.x)], 1u);
            asm volatile("s_waitcnt vmcnt(0)" ::: "memory");
        } else {
            XB_SPIN(xb_ld(&bar[XB_XGEN(b.x)]) == gen, bar);
            __builtin_amdgcn_fence(__ATOMIC_ACQUIRE, "agent");
            asm volatile("s_waitcnt vmcnt(0)" ::: "memory");
        }
    }
    __syncthreads();
}

namespace pg8 {
constexpr int BM = 256, BK = 64, HALF = 128, HTB = HALF * BK * 2, STAGE_BYTES = 8 * HTB, NXCD = 8, WGM = 8;
__host__ __device__ __forceinline__ int lds_byte(int r, int c) { const int st = (r >> 4) * 2 + (c >> 5), rr = r & 15, cc = c & 31, ob = rr * 64 + cc * 2; return st * 1024 + (ob ^ (((ob >> 9) & 1) << 5)); }
__host__ __device__ __forceinline__ void stage_rc(int b, int& R, int& C) { const int st = b / 1024, sb = b % 1024, swz = sb ^ (((sb >> 9) & 1) << 5); R = (st >> 1) * 16 + swz / 64; C = (st & 1) * 32 + (swz % 64) / 2; }
__host__ __device__ __forceinline__ int perm32(int rho) { const int n = rho >> 4, i = rho & 15; return 8 * (i >> 2) + 4 * n + (i & 3); }

struct Unit { int pm, pn, pb; };
struct Gemm { const bf16* A; const bf16* Bt; int K; const int* gidx; };

__device__ __forceinline__ int xcd_remap(int wgid, int nwg) { const int q = nwg / NXCD, r = nwg % NXCD, xcd = wgid % NXCD, off = wgid / NXCD; return (xcd < r ? xcd * (q + 1) : r * (q + 1) + (xcd - r) * q) + off; }
struct StaticOrder {
    int nM, nN, nwg, G, c, rep;
    __device__ void init(int M, int N, int G_, int c_, int rep_ = 1) { nM = M / BM; nN = N / BM; nwg = nM * nN; G = G_; c = c_; rep = rep_; }
    __device__ bool next(int i, Unit& u) const {
        long L = (long)i * G + c; if (L >= (long)nwg * rep) return false; L %= nwg;
        const int wgid = xcd_remap((int)L, nwg);
        const int nig = WGM * nN, gid = wgid / nig, fm = gid * WGM, gsz = (nM - fm) < WGM ? (nM - fm) : WGM;
        u.pm = fm + ((wgid % nig) % gsz); u.pn = (wgid % nig) / gsz; u.pb = u.pn; return true;
    }
};
struct GroupedOrder {
    const int* tile_e; int ntiles, npn, G, c;
    __device__ bool next(int i, Unit& u) const {
        const long L = (long)i * G + c; const int nwg = ntiles * npn; if (L >= nwg) return false;
        const int wgid = xcd_remap((int)L, nwg);
        u.pm = wgid / npn; u.pn = wgid % npn; u.pb = tile_e[u.pm] * npn + u.pn; return true;
    }
};

__device__ __forceinline__ unsigned cvt_pk_bf16(float lo, float hi) { unsigned r; asm volatile("v_cvt_pk_bf16_f32 %0, %1, %2" : "=v"(r) : "v"(lo), "v"(hi)); return r; }

struct EpiPlain {
    static constexpr bool PERM = true;
    bf16* O; int ldc; const float* ssq; int ssq_n; float ssq_inv; float eps;
    LAS unsigned char* xl;
    __device__ __forceinline__ void operator()(const f32x4 (&acc)[2][2][4][2], const Unit& u, int wr, int wc, int fr, int fq) const {
        const int lane = fq * 16 + fr; LAS unsigned char* t = xl + (wr * 4 + wc) * 2048;
        const int wsw = fr & 7, rrow = lane >> 3, rch = lane & 7;
#pragma unroll
        for (int ai = 0; ai < 2; ++ai)
#pragma unroll
            for (int m = 0; m < 4; ++m) { const int rowb = u.pm * BM + ai * HALF + wr * 64 + m * 16;
                float sc = 1.f;
                if (ssq) { const f32x4 p = *(const f32x4*)(ssq + (size_t)(rowb + fr) * ssq_n); sc = __builtin_amdgcn_rsqf((p[0] + p[1] + p[2] + p[3]) * ssq_inv + eps); }
#pragma unroll
                for (int bj = 0; bj < 2; ++bj) { const f32x4 v0 = acc[ai][bj][m][0] * sc, v1 = acc[ai][bj][m][1] * sc;
                    u32x4 w; w.x = cvt_pk_bf16(v0[0], v0[1]); w.y = cvt_pk_bf16(v0[2], v0[3]); w.z = cvt_pk_bf16(v1[0], v1[1]); w.w = cvt_pk_bf16(v1[2], v1[3]);
                    *(LAS u32x4*)(t + fr * 128 + 16 * ((4 * bj + fq) ^ wsw)) = w; }
#pragma unroll
                for (int i = 0; i < 2; ++i) { const int rr = 8 * i + rrow;
                    const u32x4 w = *(const LAS u32x4*)(t + rr * 128 + 16 * (rch ^ (rr & 7)));
                    stg16<NT_EPI>(O + (size_t)(rowb + rr) * ldc + u.pn * BM + wc * 64 + 8 * rch, w); }
            }
    }
};
struct EpiGateUp {
    static constexpr bool PERM = true;
    bf16* H; const float* sw;
    __device__ __forceinline__ void operator()(const f32x4 (&acc)[2][2][4][2], const Unit& u, int wr, int wc, int fr, int fq) const {
        const int row0 = u.pm * BM + wr * 64 + fr; const int col0 = u.pn * HALF + wc * 32 + 8 * fq;
#pragma unroll
        for (int ai = 0; ai < 2; ++ai)
#pragma unroll
            for (int m = 0; m < 4; ++m) { const int row = row0 + ai * HALF + m * 16; const float w = sw[row]; f32x4 hv[2];
#pragma unroll
                for (int n = 0; n < 2; ++n) { const f32x4 g = acc[ai][0][m][n], up = acc[ai][1][m][n];
#pragma unroll
                    for (int e = 0; e < 4; ++e) { const float sg = g[e] * __builtin_amdgcn_rcpf(1.0f + __builtin_amdgcn_exp2f(-g[e] * LOG2E)); hv[n][e] = sg * up[e] * w; } }
                u32x4 o; o.x = cvt_pk_bf16(hv[0][0], hv[0][1]); o.y = cvt_pk_bf16(hv[0][2], hv[0][3]); o.z = cvt_pk_bf16(hv[1][0], hv[1][1]); o.w = cvt_pk_bf16(hv[1][2], hv[1][3]);
                stg16<NT_EPI>(H + (size_t)row * FH + col0, o); }
    }
};

enum { GK_SKIP = 0, GK_PLAIN = 1, GK_ROPE32 = 2, GK_HEAD16 = 3, GK_IDX8 = 4, GK_WI = 5 };
struct GroupDesc { int kind; bf16* dst; int pitch; int col; float scale; int perm; float* ssq; int ssq_n; int ssq_i; };
struct RopeTabs { const int* pos; };
__device__ __forceinline__ int perm_row(int row, int perm) {
    if (perm == 0) return row; const int b = row >> 11, s = row & 2047;
    return perm == 4 ? (b << 11) + ((s & 3) << 9) + (s >> 2) : (b << 11) + ((s & 15) << 7) + (s >> 4);
}
__device__ __forceinline__ void st16(bf16* p, u32x2 a, u32x2 b) { u32x4 w; w.x = a.x; w.y = a.y; w.z = b.x; w.w = b.y; stg16<NT_EPI>(p, w); }
__device__ __forceinline__ u32x2 pk4(f32x4 v) { u32x2 w; w.x = cvt_pk_bf16(v[0], v[1]); w.y = cvt_pk_bf16(v[2], v[3]); return w; }
__device__ __forceinline__ void swap16(u32x2& X, u32x2& Y) {
    const auto a = __builtin_amdgcn_permlane16_swap(X.x, Y.x, false, false); const auto b = __builtin_amdgcn_permlane16_swap(X.y, Y.y, false, false);
    X.x = a[0]; Y.x = a[1]; X.y = b[0]; Y.y = b[1];
}
__device__ __forceinline__ float rope_k(int i, int rd) { return __builtin_amdgcn_exp2f(-18.931568569324174f * (float)(2 * i) / (float)rd) * 0.15915494309189535f; }
__device__ __forceinline__ void rope_cs(float posf, int i0, int rd, f32x4& c, f32x4& s) {
#pragma unroll
    for (int e = 0; e < 4; ++e) { const float f = __builtin_amdgcn_fractf(posf * rope_k(i0 + e, rd)); s[e] = __builtin_amdgcn_sinf(f); c[e] = __builtin_amdgcn_cosf(f); }
}
template <class DescFn> struct EpiGroups {
    static constexpr bool PERM = true;
    DescFn F; RopeTabs R; const float* rs_ssq; int rs_n; float rs_inv, rs_eps;
    __device__ __forceinline__ void operator()(const f32x4 (&acc)[2][2][4][2], const Unit& u, int wr, int wc, int fr, int fq) const {
        const int row0 = u.pm * BM + wr * 64 + fr;
#pragma unroll
        for (int bj = 0; bj < 2; ++bj) {
            const GroupDesc d = F(u.pn, bj, wc);
            if (d.kind == GK_SKIP) continue;
            const int ki0 = d.kind == GK_ROPE32 ? 4 * fq : (d.kind == GK_HEAD16 ? 4 * (fq & 1) : 0), krd = d.kind == GK_ROPE32 ? 32 : (d.kind == GK_HEAD16 ? 16 : 8);
#pragma unroll
            for (int ai = 0; ai < 2; ++ai)
#pragma unroll
                for (int m = 0; m < 4; ++m) {
                    const int row = row0 + ai * HALF + m * 16;
                    float sc = d.scale;
                    if (rs_ssq) { float s = 0.f; for (int i = 0; i < rs_n; ++i) s += rs_ssq[(size_t)row * rs_n + i]; sc *= __builtin_amdgcn_rsqf(s * rs_inv + rs_eps); }
                    f32x4 v0 = acc[ai][bj][m][0], v1 = acc[ai][bj][m][1];
                    if (d.ssq) {
                        float q = (v0[0] * v0[0] + v0[1] * v0[1]) + (v0[2] * v0[2] + v0[3] * v0[3]) + (v1[0] * v1[0] + v1[1] * v1[1]) + (v1[2] * v1[2] + v1[3] * v1[3]);
                        q += __shfl_xor(q, 16); q += __shfl_xor(q, 32);
                        if (fq == 0) d.ssq[(size_t)row * d.ssq_n + d.ssq_i] = q;
                    }
                    v0 = v0 * sc; v1 = v1 * sc;
                    if (d.kind == GK_WI) { if (fq == 0) { float* wp = (float*)d.dst + (size_t)row * 8; *(f32x4*)wp = v0; *(f32x4*)(wp + 4) = v1; } continue; }
                    bf16* rp = d.dst + (size_t)perm_row(row, d.perm) * d.pitch + d.col;
                    if (d.kind == GK_PLAIN) { st16(rp + 8 * fq, pk4(v0), pk4(v1)); }
                    else if (d.kind == GK_IDX8) {
                        f32x4 c, s; rope_cs((float)R.pos[row], ki0, krd, c, s);
                        const f32x4 o1 = fq == 0 ? v0 * c - v1 * s : v0, o2 = fq == 0 ? v1 * c + v0 * s : v1;
                        st16(rp + 8 * fq, pk4(o1), pk4(o2));
                    } else if (d.kind == GK_ROPE32) {
                        f32x4 c, s; rope_cs((float)R.pos[row], ki0, krd, c, s);
                        u32x2 X = pk4(v0 * c - v1 * s), Y = pk4(v1 * c + v0 * s);
                        swap16(X, Y);
                        st16(rp + ((fq & 1) ? 16 + 4 * (fq - 1) : 4 * fq), X, Y);
                    } else {
                        f32x4 c, s; rope_cs((float)R.pos[row], ki0, krd, c, s);
                        u32x2 X = pk4(fq < 2 ? v0 * c - v1 * s : v0), Y = pk4(fq < 2 ? v1 * c + v0 * s : v1);
                        swap16(X, Y);
                        st16(rp + 16 * (fq >> 1) + 8 * (fq & 1), X, Y);
                    }
                }
        }
    }
};

template <class Epi, class Sched, bool GATHER, int LDA = 0>
__device__ __forceinline__ void gemm_phase(LAS unsigned char* lds, const Gemm g, const Sched& S, const Epi& E, const int tid) {
    const int wid = __builtin_amdgcn_readfirstlane(tid >> 6), lane = tid & 63, wr = wid >> 2, wc = wid & 3, fr = lane & 15, fq = lane >> 4;
    const int K = g.K, nt = K / BK, lda = LDA ? LDA : K;
    unsigned voA[2][2], voB[2]; int RA[2], CA[2];
#pragma unroll
    for (int i = 0; i < 2; ++i) { int R, C; stage_rc(tid * 16 + i * 8192, R, C); const int Rb = Epi::PERM ? ((R & ~31) + perm32(R & 31)) : R;
        RA[i] = R; CA[i] = C; voA[0][i] = (unsigned)(R * lda + C) * 2u; voA[1][i] = (unsigned)((R + HALF) * lda + C) * 2u; voB[i] = (unsigned)(Rb * K + C) * 2u; }
    const size_t kstep = (size_t)(BK * 2);
    const size_t hstep = (size_t)HALF * K * 2;
    const size_t tstep = 2 * hstep;
    const size_t tstepA = (size_t)BM * lda * 2;
    const unsigned ldsw = (unsigned)wid * 1024u;
    const int aoff = lds_byte(wr * 64 + fr, fq * 8), boff = lds_byte(wc * 32 + fr, fq * 8);
#define PG8_SA(b, h) (((b) * 2 + (h)) * HTB)
#define PG8_SB(b, h) ((4 + (b) * 2 + (h)) * HTB)
#define PG8_STAGE(bufoff, gbase, voff) do { _Pragma("unroll") for (int _i = 0; _i < 2; ++_i) \
        __builtin_amdgcn_global_load_lds((const unsigned*)((const char*)(gbase) + (voff)[_i]), (LAS unsigned*)(lds + (bufoff) + ldsw + _i * 8192), 16, 0, 0); } while (0)
#define PG8_LDA(dst, b, h) do { _Pragma("unroll") for (int m = 0; m < 4; ++m) _Pragma("unroll") for (int k = 0; k < 2; ++k) dst[m][k] = *(const LAS bf16x8*)(lds + PG8_SA(b, h) + aoff + m * 2048 + k * 1024); } while (0)
#define PG8_LDB(dst, b, h) do { _Pragma("unroll") for (int n = 0; n < 2; ++n) _Pragma("unroll") for (int k = 0; k < 2; ++k) dst[n][k] = *(const LAS bf16x8*)(lds + PG8_SB(b, h) + boff + n * 2048 + k * 1024); } while (0)
#define PG8_MMA(ai, bj, At, Bt) do { __builtin_amdgcn_s_setprio(1); _Pragma("unroll") for (int m = 0; m < 4; ++m) _Pragma("unroll") for (int n = 0; n < 2; ++n) _Pragma("unroll") for (int k = 0; k < 2; ++k) \
        acc[ai][bj][m][n] = __builtin_amdgcn_mfma_f32_16x16x32_bf16(Bt[n][k], At[m][k], acc[ai][bj][m][n], 0, 0, 0); __builtin_amdgcn_s_setprio(0); } while (0)
#define PG8_WAIT_V(n) asm volatile("s_waitcnt vmcnt(" #n ")" ::: "memory")
#define PG8_WAIT_L(n) asm volatile("s_waitcnt lgkmcnt(" #n ")" ::: "memory")
#define PG8_BAR __builtin_amdgcn_s_barrier()
#define PG8_SCHED __builtin_amdgcn_sched_barrier(0)
    Unit cur, nxt; int ui = 0;
    if (!S.next(0, cur)) return;
    f32x4 acc[2][2][4][2];
#pragma unroll
    for (int a = 0; a < 2; ++a)
#pragma unroll
        for (int b = 0; b < 2; ++b)
#pragma unroll
            for (int m = 0; m < 4; ++m)
#pragma unroll
                for (int n = 0; n < 2; ++n) acc[a][b][m][n] = (f32x4){0.f, 0.f, 0.f, 0.f};
    bf16x8 At[4][2], B0[2][2], B1[2][2];
    unsigned nvA[2][2];
    const char* cA; const char* cB = (const char*)g.Bt + (size_t)cur.pb * tstep;
    if constexpr (GATHER) { cA = (const char*)g.A;
#pragma unroll
        for (int h = 0; h < 2; ++h)
#pragma unroll
            for (int i = 0; i < 2; ++i) voA[h][i] = (unsigned)g.gidx[cur.pm * BM + h * HALF + RA[i]] * (unsigned)(lda * 2) + (unsigned)CA[i] * 2u;
    } else cA = (const char*)g.A + (size_t)cur.pm * tstepA;
    PG8_STAGE(PG8_SB(0, 0), cB, voB); PG8_STAGE(PG8_SB(0, 1), cB + hstep, voB); PG8_STAGE(PG8_SA(0, 0), cA, voA[0]); PG8_STAGE(PG8_SA(0, 1), cA, voA[1]);
    if (wr == 1) PG8_BAR;
    PG8_WAIT_V(2); PG8_BAR;
    PG8_STAGE(PG8_SB(1, 0), cB + kstep, voB); PG8_STAGE(PG8_SA(1, 0), cA + kstep, voA[0]); PG8_STAGE(PG8_SB(1, 1), cB + hstep + kstep, voB);
    PG8_WAIT_V(6); PG8_BAR;
    for (;;) {
        const bool has_next = S.next(ui + 1, nxt);
        const char* nA; const char* nB = has_next ? (const char*)g.Bt + (size_t)nxt.pb * tstep : cB;
        if constexpr (GATHER) { nA = cA;
#pragma unroll
            for (int h = 0; h < 2; ++h)
#pragma unroll
                for (int i = 0; i < 2; ++i) nvA[h][i] = has_next ? (unsigned)g.gidx[nxt.pm * BM + h * HALF + RA[i]] * (unsigned)(lda * 2) + (unsigned)CA[i] * 2u : voA[h][i];
        } else nA = has_next ? (const char*)g.A + (size_t)nxt.pm * tstepA : cA;
#pragma nounroll
        for (int t = 0; t < nt; t += 2) {
            const bool last = (t == nt - 2);
            const char* a1 = cA + (size_t)(t + 1) * kstep;
            const char* a2 = last ? nA : cA + (size_t)(t + 2) * kstep; const char* b2 = last ? nB : cB + (size_t)(t + 2) * kstep;
            const char* a3 = a2 + kstep; const char* b3 = b2 + kstep;
            unsigned xA[2][2];
#pragma unroll
            for (int h = 0; h < 2; ++h)
#pragma unroll
                for (int i = 0; i < 2; ++i) xA[h][i] = (GATHER && last) ? nvA[h][i] : voA[h][i];
            PG8_LDB(B0, 0, 0); PG8_LDB(B1, 0, 1); PG8_SCHED; PG8_LDA(At, 0, 0); PG8_STAGE(PG8_SA(1, 1), a1, voA[1]);
            PG8_WAIT_V(8); PG8_WAIT_L(0); PG8_BAR; PG8_MMA(0, 0, At, B0); PG8_MMA(0, 1, At, B1); PG8_BAR; PG8_SCHED;
            PG8_LDA(At, 0, 1); PG8_STAGE(PG8_SB(0, 0), b2, voB); PG8_STAGE(PG8_SB(0, 1), b2 + hstep, voB); PG8_STAGE(PG8_SA(0, 0), a2, xA[0]);
            PG8_WAIT_V(8); PG8_WAIT_L(0); PG8_BAR; PG8_MMA(1, 0, At, B0); PG8_MMA(1, 1, At, B1); PG8_BAR; PG8_SCHED;
            PG8_LDB(B0, 1, 0); PG8_LDB(B1, 1, 1); PG8_SCHED; PG8_LDA(At, 1, 0); PG8_STAGE(PG8_SA(0, 1), a2, xA[1]);
            PG8_WAIT_V(8); PG8_WAIT_L(0); PG8_BAR; PG8_MMA(0, 0, At, B0); PG8_MMA(0, 1, At, B1); PG8_BAR; PG8_SCHED;
            PG8_LDA(At, 1, 1); PG8_STAGE(PG8_SB(1, 0), b3, voB); PG8_STAGE(PG8_SB(1, 1), b3 + hstep, voB); PG8_STAGE(PG8_SA(1, 0), a3, xA[0]);
            PG8_WAIT_V(8); PG8_WAIT_L(0); PG8_BAR; PG8_MMA(1, 0, At, B0); PG8_MMA(1, 1, At, B1); PG8_BAR; PG8_SCHED;
        }
        if (wr == 0) PG8_BAR;
        E(acc, cur, wr, wc, fr, fq);
        if (!has_next) break;
#pragma unroll
        for (int a = 0; a < 2; ++a)
#pragma unroll
            for (int b = 0; b < 2; ++b)
#pragma unroll
                for (int m = 0; m < 4; ++m)
#pragma unroll
                    for (int n = 0; n < 2; ++n) acc[a][b][m][n] = (f32x4){0.f, 0.f, 0.f, 0.f};
        cur = nxt; cA = nA; cB = nB; ++ui;
        if constexpr (GATHER) {
#pragma unroll
            for (int h = 0; h < 2; ++h)
#pragma unroll
                for (int i = 0; i < 2; ++i) voA[h][i] = nvA[h][i];
        }
        if (wr == 1) PG8_BAR;
    }
    PG8_WAIT_V(0);
    PG8_BAR;
#undef PG8_SA
#undef PG8_SB
#undef PG8_STAGE
#undef PG8_LDA
#undef PG8_LDB
#undef PG8_MMA
#undef PG8_WAIT_V
#undef PG8_WAIT_L
#undef PG8_BAR
#undef PG8_SCHED
}
}

#ifndef PROBE_LDS2
#define PROBE_LDS2 0
#endif
#ifndef PROBE_EXP2
#define PROBE_EXP2 0
#endif
#ifndef FA_FUSE
#define FA_FUSE 0
#endif
namespace fa {
constexpr int VBYTES_T = 64 * 128;
typedef short v4i16_t __attribute__((ext_vector_type(4)));
__device__ __forceinline__ u32x2 vtr(const LAS unsigned char* p) { return __builtin_bit_cast(u32x2, __builtin_amdgcn_ds_read_tr16_b64_v4i16((LAS v4i16_t*)p)); }
struct Params {
    const bf16* Q;  int q_pitch;
    const bf16* K1; int k1_pitch, k1_col;
    const bf16* K2; int k2_pitch, k2_col;
    const bf16* V;  int v_pitch, v_col;
    bf16* O; int o_pitch;
    float* LSE; int lse_pitch;
    const unsigned* BM;
    int CL, W;
};
template <int DQK, int MODE>
__device__ __forceinline__ void attn_unit(const Params& P, LAS unsigned char* lds, const int tid, int seq0, int qw, int q_col, int o_col, int lse_col, int kt_lo, int kt_hi, const bool active = true) {
    constexpr int NKS = DQK / 16, AHEAD = 4, NST = AHEAD + 1, K1B = 8192, K2B = (DQK == 96 ? 4096 : 0), BMOFF = K1B + K2B + 8192, STB = BMOFF + (MODE == 1 ? 8192 : 0);
    constexpr int NDMA = 2 + (DQK == 96 ? 1 : 0) + (MODE == 1 ? 1 : 0);
    const int lane = tid & 63, r = lane & 31, h = lane >> 5, wave = __builtin_amdgcn_readfirstlane(tid >> 6);
    const int q = qw + r;
    const int lo_q = MODE == 0 ? max(q & ~(P.CL - 1), q - P.W) : 0;
    const int lo_w0 = MODE == 0 ? max(qw & ~(P.CL - 1), qw - P.W) : 0;
    const int lo_w1 = MODE == 0 ? max((qw + 31) & ~(P.CL - 1), qw + 31 - P.W) : 0;
    const int tq_ = (lane & 15) >> 2, tp_ = lane & 3, tg_ = lane >> 4;
    const int vtoff = K1B + K2B + (4 * h + tq_) * 128, vxb = 2 * (16 * (tg_ & 1) + 4 * tp_), vsw = (tq_ >> 1) & 1;
    const int vx0 = vxb + ((0 ^ vsw) << 6), vx1 = vxb + ((1 ^ vsw) << 6);
    const int ka_ = (r >> 1) & 3, kb_ = h ^ ((r >> 1) >> 2 & 1);
    const int s1_ = (r >> 1) & 7, s2_ = (r >> 2) & 3;
    const int k1row = r * 128, k2row = K1B + r * 64;
    (void)ka_; (void)kb_;
    const int row1 = 8 * wave + (lane >> 3);
    const bf16* src_k1 = P.K1 + (size_t)(seq0 + row1) * P.k1_pitch + P.k1_col + 8 * ((lane & 7) ^ ((row1 >> 1) & 7));
    const bf16* src_v = P.V + (size_t)(seq0 + row1) * P.v_pitch + P.v_col + 8 * ((lane & 7) ^ (((row1 >> 1) & 1) << 2));
    const int row2 = 16 * (wave & 3) + (lane >> 2);
    const bf16* src_k2 = DQK == 96 ? P.K2 + (size_t)(seq0 + row2) * P.k2_pitch + P.k2_col + 8 * ((lane & 3) ^ ((row2 >> 2) & 3)) : nullptr;
    const size_t tk1 = (size_t)64 * P.k1_pitch, tk2 = (size_t)64 * P.k2_pitch, tv = (size_t)64 * P.v_pitch;
    const unsigned* bmp = MODE == 1 ? P.BM + (size_t)(seq0 + q) * 64 : nullptr;
    const int d_k1 = wave * 1024, d_k2 = K1B + (wave & 3) * 1024, d_v = K1B + K2B + wave * 1024;
#define FA_ISSUE(TILE, ST) do { const int kk_ = (TILE) < kt_hi ? (TILE) : kt_hi; LAS unsigned char* sb_ = lds + (ST) * STB; \
        __builtin_amdgcn_global_load_lds((const unsigned*)(src_k1 + kk_ * tk1), (LAS unsigned*)(sb_ + d_k1), 16, 0, 0); \
        __builtin_amdgcn_global_load_lds((const unsigned*)(src_v + kk_ * tv), (LAS unsigned*)(sb_ + d_v), 16, 0, 0); \
        if constexpr (DQK == 96) __builtin_amdgcn_global_load_lds((const unsigned*)(src_k2 + kk_ * tk2), (LAS unsigned*)(sb_ + d_k2), 16, 0, 0); \
        if constexpr (MODE == 1) __builtin_amdgcn_global_load_lds(bmp + (kk_ & ~1) * 2, (LAS unsigned*)(sb_ + BMOFF + wave * 1024), 16, 0, 0); } while (0)
#define FA_WAITBAR(N) do { asm volatile("s_waitcnt vmcnt(%0)" :: "n"(N) : "memory"); __builtin_amdgcn_s_barrier(); asm volatile("" ::: "memory"); } while (0)
    bf16x8 qf[NKS];
    { const bf16* qp = P.Q + (size_t)(seq0 + q) * P.q_pitch + q_col + 8 * h;
#pragma unroll
      for (int ks = 0; ks < NKS; ++ks) qf[ks] = *(const bf16x8*)(qp + 16 * ks); }
    u32x2 bmc = {0u, 0u};
    f32x16 o0, o1, c0, c1, n0, n1;
#pragma unroll
    for (int i = 0; i < 16; ++i) { o0[i] = 0.f; o1[i] = 0.f; c0[i] = 0.f; c1[i] = 0.f; n0[i] = 0.f; n1[i] = 0.f; }
    float m = -INFINITY, l = 0.f;
#define FA_PART(kt_) (active && (MODE == 0 ? ((kt_) * 64 <= qw + 31 && (kt_) * 64 + 63 >= lo_w0) : ((kt_) * 64 <= qw + 31)))
#define FA_KADDR(SB_, ROFF, ks) ((ks) < 4 ? (SB_) + (ROFF) * 128 + k1row + 16 * ((2 * (ks) + h) ^ s1_) : (SB_) + (ROFF) * 64 + k2row + 16 * ((2 * ((ks) - 4) + h) ^ s2_))
#define FA_QKH(S, SB_, ROFF) do { bf16x8 fa_[NKS]; \
        _Pragma("unroll") for (int ks = 0; ks < NKS; ++ks) fa_[ks] = *(const LAS bf16x8*)FA_KADDR(SB_, ROFF, ks); \
        if (PROBE_LDS2) { _Pragma("unroll") for (int ks = 0; ks < NKS; ++ks) { const bf16x8 fb_ = *(const volatile LAS bf16x8*)FA_KADDR(SB_, (ROFF) ^ 32, ks); asm volatile("" :: "v"(fb_)); } } \
        _Pragma("unroll") for (int i = 0; i < 16; ++i) S[i] = 0.f; \
        _Pragma("unroll") for (int ks = 0; ks < NKS; ++ks) S = __builtin_amdgcn_mfma_f32_32x32x16_bf16(fa_[ks], qf[ks], S, 0, 0, 0); \
        __builtin_amdgcn_sched_group_barrier(0x100, NKS, 0); __builtin_amdgcn_sched_group_barrier(0x008, NKS, 0); } while (0)
#define FA_QK(S0, S1, SB_) do { FA_QKH(S0, SB_, 0); FA_QKH(S1, SB_, 32); } while (0)
#define FA_QKX(S, SB_, ROFF) do { bf16x8 fa_[NKS]; \
        _Pragma("unroll") for (int ks = 0; ks < NKS; ++ks) fa_[ks] = *(const LAS bf16x8*)FA_KADDR(SB_, ROFF, ks); \
        _Pragma("unroll") for (int i = 0; i < 16; ++i) S[i] = 0.f; \
        _Pragma("unroll") for (int ks = 0; ks < NKS; ++ks) S = __builtin_amdgcn_mfma_f32_32x32x16_bf16(fa_[ks], qf[ks], S, 0, 0, 0); } while (0)
    int st_is = 0;
#pragma unroll
    for (int a = 0; a < AHEAD; ++a) { FA_ISSUE(kt_lo + a, st_is); st_is = st_is + 1; }
    int st_c = 0, st_n = 1;
    FA_WAITBAR((AHEAD - 2) * NDMA);
    if (FA_PART(kt_lo)) FA_QK(c0, c1, lds);
    for (int kt = kt_lo; kt <= kt_hi; ++kt) {
        FA_ISSUE(kt + AHEAD, st_is); st_is = (st_is + 1 == NST) ? 0 : st_is + 1;
        const bool more1 = kt < kt_hi;
        const int k0 = kt * 64;
        const bool part_c = FA_PART(kt), part_n = more1 && FA_PART(kt + 1);
        const LAS unsigned char* Sn = lds + st_n * STB; const LAS unsigned char* Vb = lds + st_c * STB;
        const bool fused = FA_FUSE && (DQK == 64) && part_c && part_n;
        if (part_n && !fused) FA_QK(n0, n1, Sn);
        if (part_c) {
            float alpha;
            if constexpr (MODE == 1) { const u32x4 bw = *(const LAS u32x4*)(Vb + BMOFF + wave * 1024 + lane * 16); bmc.x = (kt & 1) ? bw.z : bw.x; bmc.y = (kt & 1) ? bw.w : bw.y; }
#define FA_SOFTMAX(MASKED) do { \
            if (MASKED) { if constexpr (MODE == 0) { \
                    _Pragma("unroll") for (int i = 0; i < 16; ++i) { const int kk = k0 + crow(i, h); \
                        c0[i] = (kk > q || kk < lo_q) ? -INFINITY : c0[i]; c1[i] = (kk + 32 > q || kk + 32 < lo_q) ? -INFINITY : c1[i]; } \
                } else { const unsigned w0 = bmc.x >> (4 * h), w1 = bmc.y >> (4 * h); \
                    _Pragma("unroll") for (int i = 0; i < 16; ++i) { const int b = (i & 3) + 8 * (i >> 2); \
                        c0[i] = ((w0 >> b) & 1u) ? c0[i] : -INFINITY; c1[i] = ((w1 >> b) & 1u) ? c1[i] : -INFINITY; } } } \
            float mx = fmaxf(c0[0], c1[0]); \
            _Pragma("unroll") for (int i = 1; i < 16; ++i) mx = fmaxf(mx, fmaxf(c0[i], c1[i])); \
            mx = xhalf_max(mx); \
            const float mn = fmaxf(m, mx); \
            const float ms = (mn == -INFINITY) ? 0.f : mn; \
            alpha = __builtin_amdgcn_exp2f(m - ms); \
            m = mn; \
            float ls = 0.f; \
            if (PROBE_EXP2) { float dm_ = 0.f; _Pragma("unroll") for (int i = 0; i < 16; ++i) { dm_ += __builtin_amdgcn_exp2f(c0[i] - mx) + __builtin_amdgcn_exp2f(c1[i] - mx); } asm volatile("" :: "v"(dm_)); } \
            _Pragma("unroll") for (int i = 0; i < 16; ++i) { c0[i] = __builtin_amdgcn_exp2f(c0[i] - ms); c1[i] = __builtin_amdgcn_exp2f(c1[i] - ms); ls += c0[i] + c1[i]; } \
            l = l * alpha + ls; } while (0)
            const bool need_mask = MODE == 1 ? true : ((k0 + 63 > qw) || (k0 < lo_w1));
#define FA_FUSED(MASKED) do { FA_QKX(n0, Sn, 0); FA_QKX(n1, Sn, 32); FA_SOFTMAX(MASKED); \
            _Pragma("unroll") for (int hh_ = 0; hh_ < 2; ++hh_) { \
                __builtin_amdgcn_sched_group_barrier(0x100, NKS, 0); \
                _Pragma("unroll") for (int i = 0; i < NKS; ++i) { __builtin_amdgcn_sched_group_barrier(0x008, 1, 0); __builtin_amdgcn_sched_group_barrier(0x002, 120 / (2 * NKS), 0); } } } while (0)
            if (fused) { if (need_mask) FA_FUSED(true); else FA_FUSED(false); }
            else { if (need_mask) FA_SOFTMAX(true); else FA_SOFTMAX(false); }
#undef FA_FUSED
#undef FA_SOFTMAX
            if (!__all(alpha == 1.0f)) {
#pragma unroll
                for (int i = 0; i < 16; ++i) { o0[i] *= alpha; o1[i] *= alpha; } }
#pragma unroll
            for (int kb = 0; kb < 2; ++kb) {
                const f32x16& s = kb ? c1 : c0;
                u32x2 va[2][2], vb[2][2];
                const unsigned vaddr = (unsigned)(size_t)(Vb + (32 * kb) * 128 + vtoff);
#pragma unroll
                for (int sk = 0; sk < 2; ++sk) {
                    asm volatile("ds_read_b64_tr_b16 %0, %1" : "=&v"(va[sk][0]) : "v"(vaddr + (unsigned)(sk * 2048 + vx0)) : "memory");
                    asm volatile("ds_read_b64_tr_b16 %0, %1" : "=&v"(vb[sk][0]) : "v"(vaddr + (unsigned)(sk * 2048 + 1024 + vx0)) : "memory");
                    asm volatile("ds_read_b64_tr_b16 %0, %1" : "=&v"(va[sk][1]) : "v"(vaddr + (unsigned)(sk * 2048 + vx1)) : "memory");
                    asm volatile("ds_read_b64_tr_b16 %0, %1" : "=&v"(vb[sk][1]) : "v"(vaddr + (unsigned)(sk * 2048 + 1024 + vx1)) : "memory");
                }
                bf16x8 pf[2];
#pragma unroll
                for (int sk = 0; sk < 2; ++sk) { u32x4 pw; pw.x = pk2(s[8 * sk + 0], s[8 * sk + 1]); pw.y = pk2(s[8 * sk + 2], s[8 * sk + 3]); pw.z = pk2(s[8 * sk + 4], s[8 * sk + 5]); pw.w = pk2(s[8 * sk + 6], s[8 * sk + 7]); pf[sk] = __builtin_bit_cast(bf16x8, pw); }
                asm volatile("s_waitcnt lgkmcnt(0)" : "+v"(va[0][0]), "+v"(vb[0][0]), "+v"(va[0][1]), "+v"(vb[0][1]), "+v"(va[1][0]), "+v"(vb[1][0]), "+v"(va[1][1]), "+v"(vb[1][1]) :: "memory");
                __builtin_amdgcn_sched_barrier(0);
#pragma unroll
                for (int sk = 0; sk < 2; ++sk) {
                    const u32x4 v0w = {va[sk][0].x, va[sk][0].y, vb[sk][0].x, vb[sk][0].y}, v1w = {va[sk][1].x, va[sk][1].y, vb[sk][1].x, vb[sk][1].y};
                    o0 = __builtin_amdgcn_mfma_f32_32x32x16_bf16(__builtin_bit_cast(bf16x8, v0w), pf[sk], o0, 0, 0, 0);
                    o1 = __builtin_amdgcn_mfma_f32_32x32x16_bf16(__builtin_bit_cast(bf16x8, v1w), pf[sk], o1, 0, 0, 0);
                }
            }
        }
        FA_WAITBAR((AHEAD - 2) * NDMA);
        c0 = n0; c1 = n1;
        st_c = st_n; st_n = (st_n + 1 == NST) ? 0 : st_n + 1;
    }
#undef FA_PART
#undef FA_QK
#undef FA_QKH
#undef FA_QKX
#undef FA_KADDR
    const float lt = xhalf_sum(l);
    const float inv = 1.0f / lt;
    if (active) {
    bf16* op = P.O + (size_t)(seq0 + q) * P.o_pitch + o_col + 8 * h;
#pragma unroll
    for (int db = 0; db < 2; ++db) {
        const f32x16& o = db ? o1 : o0;
#pragma unroll
        for (int j = 0; j < 2; ++j) {
            u32x2 X, Y;
            X.x = pk2(o[8 * j] * inv, o[8 * j + 1] * inv); X.y = pk2(o[8 * j + 2] * inv, o[8 * j + 3] * inv);
            Y.x = pk2(o[8 * j + 4] * inv, o[8 * j + 5] * inv); Y.y = pk2(o[8 * j + 6] * inv, o[8 * j + 7] * inv);
            const auto a = __builtin_amdgcn_permlane32_swap(X.x, Y.x, false, false); const auto b = __builtin_amdgcn_permlane32_swap(X.y, Y.y, false, false);
            u32x4 w; w.x = a[0]; w.y = b[0]; w.z = a[1]; w.w = b[1];
            stg16<NT_ATT>(op + 32 * db + 16 * j, w);
        }
    }
    if (P.LSE && h == 0) P.LSE[(size_t)(seq0 + q) * P.lse_pitch + lse_col] = m + __builtin_amdgcn_logf(lt);
    }
    asm volatile("s_waitcnt vmcnt(0)" ::: "memory"); __builtin_amdgcn_s_barrier(); asm volatile("" ::: "memory");
#undef FA_ISSUE
#undef FA_WAITBAR
}
}

struct Args {
    const float* x; const int* pos; const float* w_in; const float* qn; const float* kvn; const float* w_uq; const float* w_ukv; const float* w_o;
    const float* ln1g; const float* ln1b; const float* rgw; const float* rgb; const float* rew; const float* reb;
    const float* wg; const float* wu; const float* wd; const float* ln2g; const float* ln2b;
    float* out; unsigned char* ws; int l_lo, l_hi, ph_lo, ph_hi, use_bar, pad;
};
typedef const __attribute__((address_space(4))) Args CArgs;
struct Ctx { LAS unsigned char* lds; int tid, lane, wave, G, c, vcu; unsigned char* ws; };

struct ColIdent { int off; __device__ __forceinline__ int operator()(int P) const { return off + P; } };
struct ColAdj { __device__ __forceinline__ int operator()(int P) const { const int p = P & 255; return (P & ~255) + 64 * ((p >> 5) & 3) + 32 * (p >> 7) + (p & 31); } };
__device__ __forceinline__ int map_rope32(int p) { return 16 * ((p >> 2) & 1) + 4 * (p >> 3) + (p & 3); }
__device__ __forceinline__ int map_head16(int p) { const int fq = p >> 3; return 16 * (fq >> 1) + 8 * ((p >> 2) & 1) + 4 * (fq & 1) + (p & 3); }
struct ColWin {
    __device__ __forceinline__ int operator()(int P) const {
        const int G = P >> 5, p = P & 31;
        if (G < 8) return 32 * G + p;
        if (G < 12) return 256 + 32 * (G - 8) + p;
        if (G == 12) return 384 + map_rope32(p);
        if (G == 13) return 1056 + p;
        if (G == 14) return 672 + map_head16(p);
        if (G == 15) return 704 + p;
        if (G < 24) { const int hh = (G - 16) >> 1; return 416 + 64 * hh + (((G - 16) & 1) ? 32 + p : map_head16(p)); }
        if (G < 26) return 736 + 32 * (G - 24) + p;
        if (G == 26) return p < 8 ? 1088 + p : -1;
        if (G < 32) return -1;
        if (G < 40) return 800 + 32 * (G - 32) + p;
        if (G < 64) { const int j = G - 40; return 1096 + 64 * (j >> 1) + ((j & 1) ? 32 + p : map_head16(p)); }
        if (G < 88) { const int j = G - 64; return 1096 + 768 + 64 * (j >> 1) + ((j & 1) ? 32 + p : map_head16(p)); }
        return 1096 + 1536 + 32 * (G - 88) + p;
    }
};
struct ColUq {
    __device__ __forceinline__ int operator()(int P) const { const int G = P >> 5, p = P & 31; return 32 * G + ((G % 3 == 2) ? map_rope32(p) : p); }
};
template <class ColFn>
__device__ __forceinline__ void transpose_item(const float* W, int ldw, int kvalid, bf16* WT, int ldt, int k0, int P0, const ColFn& cf, const float* rowscale, LAS float* scr, int lane) {
    const int c = lane & 31, col = cf(P0 + c);
#pragma unroll 8
    for (int i = 0; i < 32; ++i) { const int kk = 2 * i + (lane >> 5), k = k0 + kk; float v = 0.f;
        if (col >= 0 && k < kvalid) { v = W[(size_t)k * ldw + col]; if (rowscale) v *= rowscale[k]; }
        scr[kk * 33 + c] = v; }
    asm volatile("s_waitcnt lgkmcnt(0)" ::: "memory");
    const int cc = lane & 7;
#pragma unroll
    for (int j = 0; j < 4; ++j) { const int n = (lane >> 3) + 8 * j; const LAS float* s = scr + (8 * cc) * 33 + n;
        u32x4 o; o.x = pk2(s[0 * 33], s[1 * 33]); o.y = pk2(s[2 * 33], s[3 * 33]); o.z = pk2(s[4 * 33], s[5 * 33]); o.w = pk2(s[6 * 33], s[7 * 33]);
        *(u32x4*)(WT + (size_t)(P0 + n) * ldt + k0 + 8 * cc) = o; }
    asm volatile("s_waitcnt lgkmcnt(0)" ::: "memory");
}
__device__ __forceinline__ void prologue(const Ctx& X, const CArgs* ap) {
    struct { const float* x; const float *w_in, *qn, *kvn, *w_uq, *w_ukv, *w_o, *rgw, *rew; } a = {ap->x, ap->w_in, ap->qn, ap->kvn, ap->w_uq, ap->w_ukv, ap->w_o, ap->rgw, ap->rew};
    LAS float* scr = (LAS float*)(X.lds + X.wave * 16384);
    const int gw = X.vcu * 8 + X.wave, NGW = X.G * 8;
    constexpr int I_WIN = 16 * 112, I_UQ = 4 * 24, I_UKV = 4 * 32, I_WO = 16 * 32, I_L = I_WIN + I_UQ + I_UKV + I_WO;
    for (int it = gw; it < DEPTH * I_L; it += NGW) {
        const int l = it / I_L; int r = it % I_L;
        if (r < I_WIN) { transpose_item(a.w_in + (size_t)l * DM * IN_COLS, IN_COLS, DM, (bf16*)(X.ws + WS_WIN) + (size_t)l * NIN * DM, DM, 64 * (r / 112), 32 * (r % 112), ColWin{}, nullptr, scr, X.lane); continue; }
        r -= I_WIN;
        if (r < I_UQ) { transpose_item(a.w_uq + (size_t)l * 256 * 768, 768, 256, (bf16*)(X.ws + WS_WUQ) + (size_t)l * 768 * 256, 256, 64 * (r / 24), 32 * (r % 24), ColUq{}, a.qn + l * 256, scr, X.lane); continue; }
        r -= I_UQ;
        if (r < I_UKV) { transpose_item(a.w_ukv + (size_t)l * 128 * 1024, 1024, 128, (bf16*)(X.ws + WS_WUKV) + (size_t)l * 1024 * 256, 256, 64 * (r / 32), 32 * (r % 32), ColAdj{}, a.kvn + l * 128, scr, X.lane); continue; }
        r -= I_UKV;
        transpose_item(a.w_o + (size_t)l * DM * DM, DM, DM, (bf16*)(X.ws + WS_WO) + (size_t)l * DM * DM, DM, 64 * (r / 32), 32 * (r % 32), ColAdj{}, nullptr, scr, X.lane);
    }
    const size_t gt = (size_t)X.vcu * 512 + X.tid, NGT = (size_t)X.G * 512;
    { float* rgt = (float*)(X.ws + WS_RGT); float* ret = (float*)(X.ws + WS_RET);
      for (size_t i = gt; i < (size_t)DEPTH * 4 * DM; i += NGT) { const int l = (int)(i / (4 * DM)), g = (int)(i / DM) & 3, k = (int)(i % DM); rgt[i] = a.rgw[((size_t)l * DM + k) * 4 + g]; }
      for (size_t i = gt; i < (size_t)DEPTH * 32 * DM; i += NGT) { const int l = (int)(i / (32 * DM)), ge = (int)(i / DM) & 31, k = (int)(i % DM); ret[i] = a.rew[(((size_t)l * 4 + (ge >> 3)) * DM + k) * 8 + (ge & 7)]; } }
    { u32x4* z = (u32x4*)(X.ws + WS_T1); for (size_t i = gt; i < (size_t)NT * 256 * 2 / 16; i += NGT) z[i] = (u32x4){0u, 0u, 0u, 0u}; }
    { const f32x4* xs = (const f32x4*)a.x; u32x2* xb = (u32x2*)(X.ws + WS_XB);
      for (size_t i = gt; i < (size_t)NT * DM / 4; i += NGT) { const f32x4 v = xs[i]; u32x2 w; w.x = pk2(v[0], v[1]); w.y = pk2(v[2], v[3]); xb[i] = w; } }
}
__device__ __forceinline__ void convert_experts(const Ctx& X, const CArgs* ap, int l) {
    struct { const float *wg, *wu, *wd; } a = {ap->wg, ap->wu, ap->wd};
    LAS float* scr = (LAS float*)(X.lds + X.wave * 16384);
    const int gw = X.vcu * 8 + X.wave, NGW = X.G * 8;
    constexpr int I_GU = 32 * 16 * 16, I_D = 32 * 4 * 32;
    for (int it = gw; it < I_GU + I_D; it += NGW) {
        if (it < I_GU) { const int e = it >> 8, r = it & 255, G32 = r >> 4, kb = r & 15; const int pn = G32 >> 3, r0 = (G32 & 7) * 32; const bool up = r0 >= 128;
            const float* W = (up ? a.wu : a.wg) + ((size_t)l * NEXP + e) * DM * FH;
            transpose_item(W, FH, DM, (bf16*)(X.ws + WS_WGU) + (size_t)e * 512 * DM, DM, 64 * kb, 32 * G32, ColIdent{128 * pn + (r0 & 127) - 32 * G32}, nullptr, scr, X.lane);
        } else { const int r = it - I_GU, e = r >> 7, q = r & 127, kb = q >> 5, pg = q & 31;
            transpose_item(a.wd + ((size_t)l * NEXP + e) * FH * DM, DM, FH, (bf16*)(X.ws + WS_WD) + (size_t)e * DM * FH, FH, 64 * kb, 32 * pg, ColAdj{}, nullptr, scr, X.lane); }
    }
}

struct InProjDesc {
    unsigned char* ws;
    __device__ __forceinline__ pg8::GroupDesc operator()(int pn, int bj, int wc) const {
        using namespace pg8; const int G = 8 * pn + 4 * bj + wc; GroupDesc d; d.kind = GK_PLAIN; d.dst = nullptr; d.pitch = 256; d.col = 0; d.scale = 1.f; d.perm = 0; d.ssq = nullptr; d.ssq_n = 0; d.ssq_i = 0;
        if (G < 8) { d.dst = (bf16*)(ws + WS_CQ); d.col = 32 * G; d.ssq = (float*)(ws + WS_SSQ); d.ssq_n = 8; d.ssq_i = G; }
        else if (G < 12) { d.dst = (bf16*)(ws + WS_T1); d.col = 32 * (G - 8); d.ssq = (float*)(ws + WS_SSQ) + (size_t)NT * 8; d.ssq_n = 4; d.ssq_i = G - 8; }
        else if (G == 12) { d.kind = GK_ROPE32; d.dst = (bf16*)(ws + WS_KPE); d.pitch = 32; d.col = 0; }
        else if (G == 13) { d.kind = GK_IDX8; d.dst = (bf16*)(ws + WS_KI); d.pitch = 32; d.col = 0; }
        else if (G == 14) { d.kind = GK_HEAD16; d.dst = (bf16*)(ws + WS_T1); d.col = 192; }
        else if (G == 15) { d.dst = (bf16*)(ws + WS_T1); d.col = 224; }
        else if (G < 24) { d.kind = ((G - 16) & 1) ? GK_PLAIN : GK_HEAD16; d.dst = (bf16*)(ws + WS_BQ); d.col = 32 * (G - 16); d.scale = QSC64; }
        else if (G < 26) { d.dst = (bf16*)(ws + WS_BV); d.pitch = 64; d.col = 32 * (G - 24); }
        else if (G == 26) { d.kind = GK_WI; d.dst = (bf16*)(ws + WS_WI); }
        else if (G < 32) { d.kind = GK_SKIP; }
        else if (G < 40) { d.kind = GK_IDX8; d.dst = (bf16*)(ws + WS_BQI); d.col = 32 * (G - 32); }
        else if (G < 64) { const int j = G - 40, cfg = j >> 3; d.kind = (j & 1) ? GK_PLAIN : GK_HEAD16; d.dst = (bf16*)(ws + WS_DQ) + (size_t)cfg * NT * 256; d.col = 32 * (j & 7); d.scale = QSC64; d.perm = cfg == 0 ? 0 : (cfg == 1 ? 4 : 16); }
        else if (G < 88) { const int j = G - 64, cfg = j >> 3; d.kind = (j & 1) ? GK_PLAIN : GK_HEAD16; d.dst = (bf16*)(ws + WS_DK) + (size_t)cfg * NT * 256; d.col = 32 * (j & 7); d.perm = cfg == 0 ? 0 : (cfg == 1 ? 4 : 16); }
        else { const int j = G - 88, cfg = j >> 3; d.dst = (bf16*)(ws + WS_DV) + (size_t)cfg * NT * 256; d.col = 32 * (j & 7); d.perm = cfg == 0 ? 0 : (cfg == 1 ? 4 : 16); }
        return d;
    }
};
struct UqDesc {
    unsigned char* ws;
    __device__ __forceinline__ pg8::GroupDesc operator()(int pn, int bj, int wc) const {
        using namespace pg8; const int G = 8 * pn + 4 * bj + wc; GroupDesc d; d.kind = (G % 3 == 2) ? GK_ROPE32 : GK_PLAIN; d.dst = (bf16*)(ws + WS_QA); d.pitch = 768; d.col = 32 * G; d.scale = QSC96; d.perm = 0; d.ssq = nullptr; d.ssq_n = 0; d.ssq_i = 0;
        return d;
    }
};

__device__ __forceinline__ unsigned f16key(float v) { const _Float16 hf = (_Float16)v; const unsigned u = (unsigned)__builtin_bit_cast(unsigned short, hf); return (u & 0x8000u) ? (~u & 0xffffu) : (u | 0x8000u); }
__device__ __forceinline__ unsigned pk_cnt(unsigned acc, unsigned kp2, unsigned mid2, unsigned one2) {
    unsigned t;
    asm("v_pk_sub_u16 %0, %2, %3 clamp\n\tv_pk_min_u16 %0, %0, %4\n\tv_pk_add_u16 %1, %1, %0" : "=&v"(t), "+v"(acc) : "v"(kp2), "s"(mid2), "s"(one2));
    return acc;
}
__device__ __forceinline__ int count_gt(const unsigned (&kp)[16], unsigned mid) {
    const unsigned m2 = __builtin_amdgcn_readfirstlane(mid | (mid << 16)), one2 = __builtin_amdgcn_readfirstlane(0x00010001u);
    unsigned a0 = 0u, a1 = 0u;
#pragma unroll
    for (int i = 0; i < 16; i += 2) { a0 = pk_cnt(a0, kp[i], m2, one2); a1 = pk_cnt(a1, kp[i + 1], m2, one2); }
    unsigned aw; asm("v_pk_add_u16 %0, %1, %2" : "=v"(aw) : "v"(a0), "v"(a1));
    const unsigned c = (aw & 0xffffu) + (aw >> 16);
    int tot = 0;
#pragma unroll
    for (int b = 0; b < 6; ++b) tot += __builtin_popcountll(__ballot((c >> b) & 1u)) << b;
    return tot;
}
__device__ __forceinline__ void radix_pick(const LAS unsigned* hist, int lane, int target, int& B, int& above, int& inbin) {
    const u32x2 hw = *(const LAS u32x2*)(hist + 2 * lane);
    const int c0 = (int)(hw.x & 0xffffu), c1 = (int)(hw.x >> 16), c2 = (int)(hw.y & 0xffffu), c3 = (int)(hw.y >> 16);
    const int tl = (c0 + c1) + (c2 + c3);
    int suf = tl;
#pragma unroll
    for (int o = 1; o < 64; o <<= 1) { const int dn = __shfl_down(suf, o); if (lane + o < 64) suf += dn; }
    const unsigned long long reach = __ballot(suf >= target);
    const int ls = 63 - __builtin_clzll(reach | 1ull);
    int a = suf - tl, b = 4 * lane + 3, ib = c3;
    if (a + c3 < target) { a += c3; b = 4 * lane + 2; ib = c2; if (a + c2 < target) { a += c2; b = 4 * lane + 1; ib = c1; if (a + c1 < target) { a += c1; b = 4 * lane; ib = c0; } } }
    B = __builtin_amdgcn_readlane(b, ls); above = __builtin_amdgcn_readlane(a, ls); inbin = __builtin_amdgcn_readlane(ib, ls);
}
__device__ __forceinline__ void dsa_index_unit(const Ctx& X, int b, int q0) {
    const int lane = X.lane, r = lane & 31, h = lane >> 5; const size_t seq0 = (size_t)b * SEQ; const int t0 = q0 + 4 * X.wave;
    const bf16* BQI = (const bf16*)(X.ws + WS_BQI); const bf16* KI = (const bf16*)(X.ws + WS_KI); const float* WI = (const float*)(X.ws + WS_WI);
    LAS unsigned short* rows = (LAS unsigned short*)(X.lds + X.wave * 16384);
    LAS unsigned char* kbuf = X.lds + LDS_X_OFF;
    const bf16* ap = BQI + (seq0 + t0 + (r >> 3)) * 256 + 32 * (r & 7) + 16 * h;
    const bf16x8 a0 = *(const bf16x8*)ap, a1 = *(const bf16x8*)(ap + 8);
    float wq[4][4];
#pragma unroll
    for (int j = 0; j < 4; ++j) { const f32x4 w = *(const f32x4*)(WI + (seq0 + t0 + j) * 8 + 4 * h);
#pragma unroll
        for (int ii = 0; ii < 4; ++ii) wq[j][ii] = w[ii] * IDX_SCALE; }
    const int nch = ((q0 + 31) >> 7) + 1;
    const int skey = X.tid >> 2, spc = X.tid & 3;
    const bf16* sp = KI + (seq0 + skey) * 32 + 8 * spc;
    const int sdst = skey * 64 + ((spc ^ ((skey >> 2) & 3)) << 4);
    u32x4 stg0 = *(const u32x4*)sp, stg1 = stg0, stg2 = stg0, stg3 = stg0;
    if (1 < nch) stg1 = *(const u32x4*)(sp + (size_t)1 * 128 * 32);
    if (2 < nch) stg2 = *(const u32x4*)(sp + (size_t)2 * 128 * 32);
    if (3 < nch) stg3 = *(const u32x4*)(sp + (size_t)3 * 128 * 32);
    *(LAS u32x4*)(kbuf + sdst) = stg0;
    __syncthreads();
#define DSA_STEP(J, RCUR, RNEXT) { const int c = c0 + (J); \
        if (c + 4 < nch) RCUR = *(const u32x4*)(sp + (size_t)(c + 4) * 128 * 32); \
        const LAS unsigned char* kb = kbuf + (c & 1) * 8192; \
        _Pragma("unroll") for (int tq = 0; tq < 4; ++tq) { \
            const int key = 32 * tq + r, sw = (key >> 2) & 3; \
            const bf16x8 b0 = *(const LAS bf16x8*)(kb + key * 64 + (((2 * h) ^ sw) << 4)), b1 = *(const LAS bf16x8*)(kb + key * 64 + (((2 * h + 1) ^ sw) << 4)); \
            f32x16 acc; \
            _Pragma("unroll") for (int i = 0; i < 16; ++i) acc[i] = 0.f; \
            acc = __builtin_amdgcn_mfma_f32_32x32x16_bf16(a0, b0, acc, 0, 0, 0); \
            acc = __builtin_amdgcn_mfma_f32_32x32x16_bf16(a1, b1, acc, 0, 0, 0); \
            float p[4]; \
            _Pragma("unroll") for (int j = 0; j < 4; ++j) { float pp = 0.f; \
                _Pragma("unroll") for (int ii = 0; ii < 4; ++ii) pp += wq[j][ii] * fmaxf(acc[4 * j + ii], 0.f); \
                p[j] = pp; } \
            const auto s01 = __builtin_amdgcn_permlane32_swap(__float_as_uint(p[0]), __float_as_uint(p[1]), false, false); \
            const auto s23 = __builtin_amdgcn_permlane32_swap(__float_as_uint(p[2]), __float_as_uint(p[3]), false, false); \
            const float va = __uint_as_float(s01[0]) + __uint_as_float(s01[1]), vb = __uint_as_float(s23[0]) + __uint_as_float(s23[1]); \
            const int hw = 128 * c + 32 * tq + r;                                      \
            rows[h * 2048 + hw] = (unsigned short)f16key(va); \
            rows[(2 + h) * 2048 + hw] = (unsigned short)f16key(vb); \
        } \
        if (c + 1 < nch) *(LAS u32x4*)(kbuf + ((c + 1) & 1) * 8192 + sdst) = RNEXT; \
        __syncthreads(); }
#ifndef REP_SCORE
#define REP_SCORE 1
#endif
#ifndef REP_SEL
#define REP_SEL 1
#endif
    for (int rsc = 0; rsc < REP_SCORE; ++rsc) {
    if (rsc > 0) { stg0 = *(const u32x4*)sp; stg1 = stg0; stg2 = stg0; stg3 = stg0; if (1 < nch) stg1 = *(const u32x4*)(sp + (size_t)1 * 128 * 32); if (2 < nch) stg2 = *(const u32x4*)(sp + (size_t)2 * 128 * 32); if (3 < nch) stg3 = *(const u32x4*)(sp + (size_t)3 * 128 * 32); *(LAS u32x4*)(kbuf + sdst) = stg0; __syncthreads(); }
    for (int c0 = 0; c0 < nch; c0 += 4) {
        DSA_STEP(0, stg0, stg1)
        if (c0 + 1 >= nch) break;
        DSA_STEP(1, stg1, stg2)
        if (c0 + 2 >= nch) break;
        DSA_STEP(2, stg2, stg3)
        if (c0 + 3 >= nch) break;
        DSA_STEP(3, stg3, stg0)
    }
    }
#undef DSA_STEP
    unsigned* BMp = (unsigned*)(X.ws + WS_BM);
#ifndef REP_BIS
#define REP_BIS 1
#endif
#ifndef REP_EMIT
#define REP_EMIT 1
#endif
    for (int rsl = 0; rsl < REP_SEL; ++rsl)
    for (int j = 0; j < 4; ++j) {
        const int t = t0 + j;
        const LAS u32x4* rw = (const LAS u32x4*)(rows + j * 2048) + 4 * lane;
        unsigned kp[16];
#pragma unroll
        for (int v4 = 0; v4 < 4; ++v4) { const u32x4 d = rw[v4]; kp[4 * v4] = d.x; kp[4 * v4 + 1] = d.y; kp[4 * v4 + 2] = d.z; kp[4 * v4 + 3] = d.w; }
        const int nv = t + 1 - 32 * lane;
#pragma unroll
        for (int d = 0; d < 16; ++d) kp[d] &= ((2 * d < nv) ? 0xffffu : 0u) | ((2 * d + 1 < nv) ? 0xffff0000u : 0u);
        unsigned thr = 0u; int need = 0;
        for (int rb_ = 0; rb_ < REP_BIS; ++rb_)
        if (t + 1 > 256) {
            LAS unsigned* hist = (LAS unsigned*)(X.lds + LDS_HIST_OFF + X.wave * 512);
            *(LAS u32x2*)(hist + 2 * lane) = (u32x2){0u, 0u};
#pragma unroll
            for (int d = 0; d < 16; ++d) { const unsigned klo = kp[d] & 0xffffu, khi = kp[d] >> 16;
                if (klo) __hip_atomic_fetch_add(hist + (klo >> 9), (klo & 0x100u) ? 0x10000u : 1u, __ATOMIC_RELAXED, __HIP_MEMORY_SCOPE_WORKGROUP);
                if (khi) __hip_atomic_fetch_add(hist + (khi >> 9), (khi & 0x100u) ? 0x10000u : 1u, __ATOMIC_RELAXED, __HIP_MEMORY_SCOPE_WORKGROUP); }
            int B1, above1, in1; radix_pick(hist, lane, 256, B1, above1, in1);
            *(LAS u32x2*)(hist + 2 * lane) = (u32x2){0u, 0u};
#pragma unroll
            for (int d = 0; d < 16; ++d) { const unsigned klo = kp[d] & 0xffffu, khi = kp[d] >> 16;
                if ((int)(klo >> 8) == B1) __hip_atomic_fetch_add(hist + ((klo & 0xffu) >> 1), (klo & 1u) ? 0x10000u : 1u, __ATOMIC_RELAXED, __HIP_MEMORY_SCOPE_WORKGROUP);
                if ((int)(khi >> 8) == B1) __hip_atomic_fetch_add(hist + ((khi & 0xffu) >> 1), (khi & 1u) ? 0x10000u : 1u, __ATOMIC_RELAXED, __HIP_MEMORY_SCOPE_WORKGROUP); }
            int B2, above2, in2; radix_pick(hist, lane, 256 - above1, B2, above2, in2);
            const unsigned tk = ((unsigned)B1 << 8) | (unsigned)B2;
            const int rest = 256 - (above1 + above2);
            if (rest >= in2) { thr = tk - 1u; need = 0; } else { thr = tk; need = rest; }
        }
        unsigned word = 0u, eqw = 0u;
        const unsigned thr2 = __builtin_amdgcn_readfirstlane(thr | (thr << 16)), one2 = __builtin_amdgcn_readfirstlane(0x00010001u);
#pragma unroll
        for (int d = 0; d < 16; ++d) { unsigned g;
            asm("v_pk_sub_u16 %0, %1, %2 clamp\n\tv_pk_min_u16 %0, %0, %3" : "=&v"(g) : "v"(kp[d]), "s"(thr2), "s"(one2));
            word |= ((g | (g >> 15)) & 3u) << (2 * d); }
        if (need > 0) {
#pragma unroll
            for (int d = 0; d < 16; ++d) { unsigned g; const unsigned x = kp[d] ^ thr2;
                asm("v_pk_min_u16 %0, %1, %2" : "=v"(g) : "v"(x), "s"(one2));
                eqw |= ((~(g | (g >> 15))) & 3u) << (2 * d); }
            if (thr == 0u) eqw = 0u;
            const int ne = __builtin_popcount(eqw); int inc = ne;
#pragma unroll
            for (int o = 1; o < 64; o <<= 1) { const int up = __shfl_up(inc, o); if (lane >= o) inc += up; }
            int take = need - (inc - ne); take = take < 0 ? 0 : (take > ne ? ne : take);
            while (__any(take > 0)) { if (take > 0) { const unsigned lowbit = eqw & (0u - eqw); word |= lowbit; eqw ^= lowbit; --take; } }
        }
        BMp[(seq0 + t) * 64 + lane] = word;
    }
}

__device__ __forceinline__ void dil_combine(const Ctx& X) {
    const bf16* OD = (const bf16*)(X.ws + WS_OD); const float* LS = (const float*)(X.ws + WS_LSE); bf16* O = (bf16*)(X.ws + WS_XB);
    const int gw = X.vcu * 8 + X.wave, NGW = X.G * 8, lane = X.lane, hh = lane >> 4;
    for (int t = gw; t < NT; t += NGW) {
        const int b = t >> 11, s = t & 2047;
        const int r0 = t, r1 = (b << 11) + ((s & 3) << 9) + (s >> 2), r2 = (b << 11) + ((s & 15) << 7) + (s >> 4);
        const float L0 = LS[(size_t)r0 * 4 + hh], L1 = LS[((size_t)NT + r1) * 4 + hh], L2 = LS[((size_t)2 * NT + r2) * 4 + hh];
        const float mx = fmaxf(L0, fmaxf(L1, L2));
        float w0 = __builtin_amdgcn_exp2f(L0 - mx), w1 = __builtin_amdgcn_exp2f(L1 - mx), w2 = __builtin_amdgcn_exp2f(L2 - mx);
        const float inv = 1.0f / (w0 + w1 + w2); w0 *= inv; w1 *= inv; w2 *= inv;
        const u32x2 a = *(const u32x2*)(OD + (size_t)r0 * 256 + 4 * lane), bq = *(const u32x2*)(OD + ((size_t)NT + r1) * 256 + 4 * lane), cq = *(const u32x2*)(OD + ((size_t)2 * NT + r2) * 256 + 4 * lane);
        u32x2 o;
        o.x = pk2(w0 * bflo(a.x) + w1 * bflo(bq.x) + w2 * bflo(cq.x), w0 * bfhi(a.x) + w1 * bfhi(bq.x) + w2 * bfhi(cq.x));
        o.y = pk2(w0 * bflo(a.y) + w1 * bflo(bq.y) + w2 * bflo(cq.y), w0 * bfhi(a.y) + w1 * bfhi(bq.y) + w2 * bfhi(cq.y));
        stg8<NT_ATT>(O + (size_t)t * DM + 768 + 4 * lane, o);
    }
}

__device__ __forceinline__ void ln1_router(const Ctx& X, const CArgs* ap, int l, bool first, bool dummy = false) {
    struct { const float *ln1g, *ln1b, *rgb, *reb; float* out; } a = {ap->ln1g, ap->ln1b, ap->rgb, ap->reb, dummy ? (float*)(X.ws + WS_QA) : ap->out}; const float* xin = first ? ap->x : ap->out;
    const int lane = X.lane; const bf16* MIX = (const bf16*)(X.ws + WS_MIX); bf16* X1B = (bf16*)(X.ws + (dummy ? WS_Y : WS_XB));
    LAS float* reT = (LAS float*)X.lds;
    LAS float* rgT = (LAS float*)(X.lds + LDS_X_OFF);
    LAS int* hist = (LAS int*)(X.lds + LDSCTL_OFF + 256);
    { const u32x4* s1 = (const u32x4*)(X.ws + WS_RET + (size_t)l * 32 * DM * 4); for (int i = X.tid; i < 32 * DM / 4; i += 512) ((LAS u32x4*)reT)[i] = s1[i];
      const u32x4* s2 = (const u32x4*)(X.ws + WS_RGT + (size_t)l * 4 * DM * 4); for (int i = X.tid; i < 4 * DM / 4; i += 512) ((LAS u32x4*)rgT)[i] = s2[i]; }
    f32x4 g[4], bb[4];
#pragma unroll
    for (int j = 0; j < 4; ++j) { g[j] = *(const f32x4*)(a.ln1g + l * DM + 4 * lane + 256 * j); bb[j] = *(const f32x4*)(a.ln1b + l * DM + 4 * lane + 256 * j); }
    const float* rgb = a.rgb + l * 4; const float* reb = a.reb + l * 32;
    for (int rb = X.c; rb < NT / 256; rb += X.G) {
        if (X.tid < 32) hist[X.tid] = 0;
        __syncthreads();
        f32x4 xn[4]; u32x2 mn[4];
        { const int t = rb * 256 + X.wave * 32;
#pragma unroll
          for (int j = 0; j < 4; ++j) { xn[j] = *(const f32x4*)(xin + (size_t)t * DM + 4 * lane + 256 * j); mn[j] = *(const u32x2*)(MIX + (size_t)t * DM + 4 * lane + 256 * j); } }
        for (int i = 0; i < 32; ++i) {
            const int t = rb * 256 + X.wave * 32 + i;
            f32x4 v[4]; float s = 0.f;
#pragma unroll
            for (int j = 0; j < 4; ++j) { const f32x4 xv = xn[j]; const u32x2 mw = mn[j];
                v[j][0] = ALPHA * xv[0] + bflo(mw.x); v[j][1] = ALPHA * xv[1] + bfhi(mw.x); v[j][2] = ALPHA * xv[2] + bflo(mw.y); v[j][3] = ALPHA * xv[3] + bfhi(mw.y);
                s += (v[j][0] + v[j][1]) + (v[j][2] + v[j][3]); }
            if (i + 1 < 32) {
#pragma unroll
                for (int j = 0; j < 4; ++j) { xn[j] = *(const f32x4*)(xin + (size_t)(t + 1) * DM + 4 * lane + 256 * j); mn[j] = *(const u32x2*)(MIX + (size_t)(t + 1) * DM + 4 * lane + 256 * j); } }
            const float mean = wave_sum(s) * (1.f / DM); float s2 = 0.f;
#pragma unroll
            for (int j = 0; j < 4; ++j) { v[j] = v[j] - mean; s2 += (v[j][0] * v[j][0] + v[j][1] * v[j][1]) + (v[j][2] * v[j][2] + v[j][3] * v[j][3]); }
            const float rstd = 1.0f / sqrtf(wave_sum(s2) * (1.f / DM) + 1e-5f);
#pragma unroll
            for (int j = 0; j < 4; ++j) { v[j] = v[j] * rstd * g[j] + bb[j];
                u32x2 w; w.x = pk2(v[j][0], v[j][1]); w.y = pk2(v[j][2], v[j][3]); stg8<NT_LN>(X1B + (size_t)t * DM + 4 * lane + 256 * j, w); }
            float lg[4];
#pragma unroll
            for (int gi = 0; gi < 4; ++gi) { float p = 0.f;
#pragma unroll
                for (int j = 0; j < 4; ++j) { const f32x4 w = *(const LAS f32x4*)(rgT + gi * DM + 4 * lane + 256 * j); p += (v[j][0] * w[0] + v[j][1] * w[1]) + (v[j][2] * w[2] + v[j][3] * w[3]); }
                lg[gi] = wave_sum(p) + rgb[gi]; }
            int gs = 0; float gm = lg[0];
#pragma unroll
            for (int gi = 1; gi < 4; ++gi) if (lg[gi] > gm) { gm = lg[gi]; gs = gi; }
            float den = 0.f;
#pragma unroll
            for (int gi = 0; gi < 4; ++gi) den += __expf(lg[gi] - gm);
            const float ptop = 1.0f / den;
            gs = __builtin_amdgcn_readfirstlane(gs);
            float le[8];
#pragma unroll
            for (int e = 0; e < 8; ++e) { float p = 0.f;
#pragma unroll
                for (int j = 0; j < 4; ++j) { const f32x4 w = *(const LAS f32x4*)(reT + (gs * 8 + e) * DM + 4 * lane + 256 * j); p += (v[j][0] * w[0] + v[j][1] * w[1]) + (v[j][2] * w[2] + v[j][3] * w[3]); }
                le[e] = wave_sum(p) + reb[gs * 8 + e]; }
            int e1 = 0; float v1 = le[0];
#pragma unroll
            for (int e = 1; e < 8; ++e) if (le[e] > v1) { v1 = le[e]; e1 = e; }
            int e2 = -1; float v2 = -INFINITY;
#pragma unroll
            for (int e = 0; e < 8; ++e) if (e != e1 && le[e] > v2) { v2 = le[e]; e2 = e; }
            const float wa = 1.0f / (1.0f + __expf(v2 - v1)), wb = 1.0f - wa;
            if (lane == 0) { u32x4 ro; ro.x = (unsigned)(gs * 8 + e1); ro.y = (unsigned)(gs * 8 + e2); ro.z = __builtin_bit_cast(unsigned, ptop * wa); ro.w = __builtin_bit_cast(unsigned, ptop * wb);
                *(u32x4*)(X.ws + WS_ROUTE + (size_t)t * 16) = ro;
                __hip_atomic_fetch_add(hist + gs * 8 + e1, 1, __ATOMIC_RELAXED, __HIP_MEMORY_SCOPE_WORKGROUP); __hip_atomic_fetch_add(hist + gs * 8 + e2, 1, __ATOMIC_RELAXED, __HIP_MEMORY_SCOPE_WORKGROUP); }
        }
        __syncthreads();
        if (X.tid < 32) ((int*)(X.ws + WS_HIST))[rb * 32 + X.tid] = hist[X.tid];
        __syncthreads();
    }
}

__device__ __forceinline__ void moe_dispatch(const Ctx& X) {
    LAS int* cnt = (LAS int*)(X.lds);
    LAS int* pre = cnt + 32;
    LAS int* ebase = cnt + 64;
    LAS int* wcnt = cnt + 128;
    const int* HIST = (const int*)(X.ws + WS_HIST); int* STOK = (int*)(X.ws + WS_STOK); float* SW = (float*)(X.ws + WS_SW); int* TSLOT = (int*)(X.ws + WS_TSLOT); int* TILEE = (int*)(X.ws + WS_TILEE);
    for (int rb = X.c; rb < NT / 256; rb += X.G) {
        if (X.tid < 64) cnt[X.tid] = 0;
        __syncthreads();
        { const int e = X.tid & 31, part = X.tid >> 5; int sa = 0, sp = 0;
          for (int q = 0; q < 16; ++q) { const int b2 = part * 16 + q; const int hv = HIST[b2 * 32 + e]; sa += hv; if (b2 < rb) sp += hv; }
          __hip_atomic_fetch_add(cnt + e, sa, __ATOMIC_RELAXED, __HIP_MEMORY_SCOPE_WORKGROUP); __hip_atomic_fetch_add(pre + e, sp, __ATOMIC_RELAXED, __HIP_MEMORY_SCOPE_WORKGROUP); }
        __syncthreads();
        if (X.tid < 64) { const int n = X.tid < 32 ? cnt[X.tid] : 0; const int pad = (n + 255) & ~255; int inc = pad;
#pragma unroll
            for (int o = 1; o < 32; o <<= 1) { const int u = __shfl_up(inc, o); if ((X.tid & 63) >= o) inc += u; }
            if (X.tid < 32) { ebase[X.tid] = inc - pad; if (X.tid == 31) ebase[32] = inc; } }
        __syncthreads();
        const int tl = X.tid >> 1, kk = X.tid & 1, t = rb * 256 + tl;
        const u32x4 ro = *(const u32x4*)(X.ws + WS_ROUTE + (size_t)t * 16);
        const int e = (int)(kk ? ro.y : ro.x); const float w = __builtin_bit_cast(float, kk ? ro.w : ro.z);
        int rank = 0;
        for (int ee = 0; ee < 32; ++ee) { const unsigned long long mm = __ballot(e == ee);
            if (e == ee) rank = __builtin_popcountll(mm & ((1ull << X.lane) - 1ull));
            if (X.lane == 0) wcnt[X.wave * 32 + ee] = __builtin_popcountll(mm); }
        __syncthreads();
        int off = 0;
        for (int w2 = 0; w2 < X.wave; ++w2) off += wcnt[w2 * 32 + e];
        const int slot = ebase[e] + pre[e] + off + rank;
        STOK[slot] = t; SW[slot] = w; TSLOT[2 * t + kk] = slot;
        if (rb < 32) { const int e2 = rb; for (int s = ebase[e2] + cnt[e2] + X.tid; s < ebase[e2 + 1]; s += 512) { STOK[s] = 0; SW[s] = 0.f; } }
        if (rb == 0) { const int ntl = ebase[32] >> 8;
            for (int tile = X.tid; tile < ntl; tile += 512) { int ee = 0; while (ee < 31 && ebase[ee + 1] <= tile * 256) ++ee; TILEE[tile] = ee; }
            if (X.tid == 0) TILEE[1024] = ntl; }
        __syncthreads();
    }
}

__device__ __forceinline__ void ln2_phase(const Ctx& X, const CArgs* ap, int l, bool first, bool dummy = false) {
    struct { const float *ln1g, *ln1b, *ln2g, *ln2b; } a = {ap->ln1g, ap->ln1b, ap->ln2g, ap->ln2b}; float* outw = dummy ? (float*)(X.ws + WS_Y + 272 * MiB) : ap->out;
    const float* xin = first ? ap->x : ap->out;
    const int lane = X.lane; const bf16* Y = (const bf16*)(X.ws + WS_Y); const bf16* MIX = (const bf16*)(X.ws + WS_MIX); const int* TSLOT = (const int*)(X.ws + WS_TSLOT); bf16* XBp = (bf16*)(X.ws + (dummy ? WS_MIX : WS_XB));
    f32x4 g1[4], b1[4], g[4], bb[4];
#pragma unroll
    for (int j = 0; j < 4; ++j) { g1[j] = *(const f32x4*)(a.ln1g + l * DM + 4 * lane + 256 * j); b1[j] = *(const f32x4*)(a.ln1b + l * DM + 4 * lane + 256 * j);
        g[j] = *(const f32x4*)(a.ln2g + l * DM + 4 * lane + 256 * j); bb[j] = *(const f32x4*)(a.ln2b + l * DM + 4 * lane + 256 * j); }
    for (int rb = X.c; rb < NT / 256; rb += X.G) {
        const int tb = rb * 256 + X.wave * 32;
        const int myslots_a = TSLOT[2 * (tb + (lane & 31))], myslots_b = TSLOT[2 * (tb + (lane & 31)) + 1];
        f32x4 xn[4]; u32x2 mn[4], yan[4], ybn[4];
        { const int sa = __builtin_amdgcn_readlane(myslots_a, 0), sb = __builtin_amdgcn_readlane(myslots_b, 0);
#pragma unroll
          for (int j = 0; j < 4; ++j) { xn[j] = *(const f32x4*)(xin + (size_t)tb * DM + 4 * lane + 256 * j); mn[j] = *(const u32x2*)(MIX + (size_t)tb * DM + 4 * lane + 256 * j);
              yan[j] = *(const u32x2*)(Y + (size_t)sa * DM + 4 * lane + 256 * j); ybn[j] = *(const u32x2*)(Y + (size_t)sb * DM + 4 * lane + 256 * j); } }
        for (int i = 0; i < 32; ++i) {
            const int t = tb + i;
            f32x4 v[4]; float s = 0.f;
#pragma unroll
            for (int j = 0; j < 4; ++j) { const f32x4 xv = xn[j]; const u32x2 mw = mn[j];
                v[j][0] = ALPHA * xv[0] + bflo(mw.x); v[j][1] = ALPHA * xv[1] + bfhi(mw.x); v[j][2] = ALPHA * xv[2] + bflo(mw.y); v[j][3] = ALPHA * xv[3] + bfhi(mw.y);
                s += (v[j][0] + v[j][1]) + (v[j][2] + v[j][3]); }
            u32x2 ya[4], yb[4];
#pragma unroll
            for (int j = 0; j < 4; ++j) { ya[j] = yan[j]; yb[j] = ybn[j]; }
            if (i + 1 < 32) { const int sa = __shfl(myslots_a, i + 1), sb = __shfl(myslots_b, i + 1);
#pragma unroll
                for (int j = 0; j < 4; ++j) { xn[j] = *(const f32x4*)(xin + (size_t)(t + 1) * DM + 4 * lane + 256 * j); mn[j] = *(const u32x2*)(MIX + (size_t)(t + 1) * DM + 4 * lane + 256 * j);
                    yan[j] = *(const u32x2*)(Y + (size_t)sa * DM + 4 * lane + 256 * j); ybn[j] = *(const u32x2*)(Y + (size_t)sb * DM + 4 * lane + 256 * j); } }
            { const float mean = wave_sum(s) * (1.f / DM); float s2 = 0.f;
#pragma unroll
              for (int j = 0; j < 4; ++j) { v[j] = v[j] - mean; s2 += (v[j][0] * v[j][0] + v[j][1] * v[j][1]) + (v[j][2] * v[j][2] + v[j][3] * v[j][3]); }
              const float rstd = 1.0f / sqrtf(wave_sum(s2) * (1.f / DM) + 1e-5f);
#pragma unroll
              for (int j = 0; j < 4; ++j) v[j] = v[j] * rstd * g1[j] + b1[j]; }
            s = 0.f;
#pragma unroll
            for (int j = 0; j < 4; ++j) { const f32x4 xv = v[j];
                v[j][0] = ALPHA * xv[0] + (bflo(ya[j].x) + bflo(yb[j].x)); v[j][1] = ALPHA * xv[1] + (bfhi(ya[j].x) + bfhi(yb[j].x)); v[j][2] = ALPHA * xv[2] + (bflo(ya[j].y) + bflo(yb[j].y)); v[j][3] = ALPHA * xv[3] + (bfhi(ya[j].y) + bfhi(yb[j].y));
                s += (v[j][0] + v[j][1]) + (v[j][2] + v[j][3]); }
            const float mean = wave_sum(s) * (1.f / DM); float s2 = 0.f;
#pragma unroll
            for (int j = 0; j < 4; ++j) { v[j] = v[j] - mean; s2 += (v[j][0] * v[j][0] + v[j][1] * v[j][1]) + (v[j][2] * v[j][2] + v[j][3] * v[j][3]); }
            const float rstd = 1.0f / sqrtf(wave_sum(s2) * (1.f / DM) + 1e-5f);
#pragma unroll
            for (int j = 0; j < 4; ++j) { v[j] = v[j] * rstd * g[j] + bb[j];
                stgf4<NT_LN>(outw + (size_t)t * DM + 4 * lane + 256 * j, v[j]);
                if (l + 1 < DEPTH) { u32x2 w; w.x = pk2(v[j][0], v[j][1]); w.y = pk2(v[j][2], v[j][3]); stg8<NT_LN>(XBp + (size_t)t * DM + 4 * lane + 256 * j, w); } }
        }
    }
}

#ifndef REP_P0
#define REP_P0 1
#endif
#ifndef REP_P5
#define REP_P5 1
#endif
#ifndef REP_P9
#define REP_P9 1
#endif
#ifndef REP_BAR
#define REP_BAR 1
#endif
#ifndef REP_P1
#define REP_P1 1
#endif
#ifndef REP_P2A
#define REP_P2A 1
#endif
#ifndef REP_P2B
#define REP_P2B 1
#endif
#ifndef REP_P2C
#define REP_P2C 1
#endif
#ifndef REP_P2D
#define REP_P2D 1
#endif
#ifndef REP_P3A
#define REP_P3A 1
#endif
#ifndef REP_P3B
#define REP_P3B 1
#endif
#ifndef REP_P3C
#define REP_P3C 1
#endif
#ifndef REP_P4
#define REP_P4 1
#endif
#ifndef REP_P6
#define REP_P6 1
#endif
#ifndef REP_P7
#define REP_P7 1
#endif
#ifndef REP_P8
#define REP_P8 1
#endif
__global__ void __launch_bounds__(512, 2) mk_fwd(Args a) {
    extern __shared__ __attribute__((aligned(16))) unsigned char lds_raw[];
    LAS unsigned char* const lds0 = (LAS unsigned char*)lds_raw;
    for (int u = threadIdx.x; u < (LDS_BYTES - LDSCTL_OFF) / 4; u += 512) ((LAS unsigned*)(lds0 + LDSCTL_OFF))[u] = 0u;
    __syncthreads();
    unsigned* barw = (unsigned*)(a.ws + WS_CTL) + CW_BAR;
    XcdBarrier bar; bar.bar = barw; bar.x = 0; bar.st = nullptr;
    if (a.use_bar) bar = xcd_barrier_post(barw, (volatile LAS unsigned*)(lds0 + LDSCTL_OFF) + 8);
#define MKCTX() Ctx X; const CArgs* ap = (const CArgs*)__builtin_amdgcn_kernarg_segment_ptr(); asm volatile("" : "+s"(ap)); { int t_ = threadIdx.x; asm volatile("" : "+v"(t_)); X.lds = lds0; X.tid = t_; X.lane = t_ & 63; X.wave = __builtin_amdgcn_readfirstlane(t_ >> 6); \
        unsigned char* w_ = ap->ws; X.G = gridDim.x; X.c = blockIdx.x; X.vcu = (X.G % 8 == 0) ? (X.c % 8) * (X.G / 8) + X.c / 8 : X.c; X.ws = w_; }
#ifndef P2M
#define P2M 31
#endif
#ifndef PH_MASK0
#define PH_MASK0 1
#endif
#define GBAR() do { if (a.use_bar) for (int rb_ = 0; rb_ < REP_BAR; ++rb_) xcd_barrier(bar); } while (0)

    if ((PH_MASK0 & 1) && a.l_lo == 0 && a.ph_lo == 0) { MKCTX(); for (int rep = 0; rep < REP_P0; ++rep) { prologue(X, ap); __syncthreads(); } GBAR(); }

    for (int l = a.l_lo; l < a.l_hi; ++l) {
        const int lo = (l == a.l_lo) ? (a.ph_lo < 1 ? 1 : a.ph_lo) : 1, hi = (l == a.l_hi - 1) ? a.ph_hi : 10;
#ifndef PH_MASK
#define PH_MASK 0x3ff
#endif
#define IN(k) (((PH_MASK >> (k)) & 1) && lo <= (k) && (k) < hi)
        if (IN(1)) { MKCTX();
            pg8::Gemm g{(const bf16*)(X.ws + WS_XB), (const bf16*)(X.ws + WS_WIN) + (size_t)l * NIN * DM, DM, nullptr};
            pg8::StaticOrder S; S.init(NT, NIN, X.G, X.c, REP_P1);
            pg8::RopeTabs R{ap->pos};
            pg8::EpiGroups<InProjDesc> E{InProjDesc{X.ws}, R, nullptr, 0, 0.f, 0.f};
            pg8::gemm_phase<pg8::EpiGroups<InProjDesc>, pg8::StaticOrder, false>(X.lds, g, S, E, X.tid);
            GBAR();
        }
        if (IN(2)) { MKCTX();
            {
                pg8::Gemm g{(const bf16*)(X.ws + WS_CQ), (const bf16*)(X.ws + WS_WUQ) + (size_t)l * 768 * 256, 256, nullptr};
                pg8::StaticOrder S; S.init(NT, 768, X.G, X.c, REP_P2A);
                pg8::RopeTabs R{ap->pos};
                pg8::EpiGroups<UqDesc> E{UqDesc{X.ws}, R, (const float*)(X.ws + WS_SSQ), 8, 1.0f / 256.0f, 1e-6f};
                pg8::gemm_phase<pg8::EpiGroups<UqDesc>, pg8::StaticOrder, false>(X.lds, g, S, E, X.tid);
            }
            {
                pg8::Gemm g{(const bf16*)(X.ws + WS_T1), (const bf16*)(X.ws + WS_WUKV) + (size_t)l * 1024 * 256, 256, nullptr};
                pg8::StaticOrder S; S.init(NT, 1024, X.G, X.c, REP_P2A);
                pg8::EpiPlain E{(bf16*)(X.ws + WS_KVA), 1024, (const float*)(X.ws + WS_SSQ) + (size_t)NT * 8, 4, 1.0f / 128.0f, 1e-6f, X.lds + LDS_X_OFF};
                pg8::gemm_phase<pg8::EpiPlain, pg8::StaticOrder, false>(X.lds, g, S, E, X.tid);
            }
            __syncthreads();
            for (int rep = 0; rep < REP_P2B; ++rep) convert_experts(X, ap, l);
            __syncthreads();
            for (int rep = 0; rep < REP_P2C; ++rep) for (int U = X.vcu; U < NB * 32; U += X.G) { const int b = U >> 5, pr = U & 31;
                dsa_index_unit(X, b, 32 * pr); dsa_index_unit(X, b, 32 * (63 - pr)); }
            __syncthreads();
#pragma unroll 1
            for (int cfg = 0; cfg < 3 * REP_P2D; ++cfg) { const int cfgi = cfg % 3;
                fa::Params P; const size_t co = (size_t)cfgi * NT * 256;
                P.Q = (const bf16*)(X.ws + WS_DQ) + co; P.q_pitch = 256; P.K1 = (const bf16*)(X.ws + WS_DK) + co; P.k1_pitch = 256; P.K2 = nullptr; P.k2_pitch = 0; P.k2_col = 0;
                P.V = (const bf16*)(X.ws + WS_DV) + co; P.v_pitch = 256; P.O = (bf16*)(X.ws + WS_OD) + co; P.o_pitch = 256; P.LSE = (float*)(X.ws + WS_LSE) + (size_t)cfgi * NT * 4; P.lse_pitch = 4; P.BM = nullptr;
                P.CL = cfgi == 0 ? 2048 : (cfgi == 1 ? 512 : 128); P.W = 128;
                for (int U = X.vcu; U < NB * 4 * 8; U += X.G) { const int bh = U >> 3, qb = U & 7, b = bh >> 2, hh = bh & 3;
                    P.k1_col = 64 * hh; P.v_col = 64 * hh;
                    const int q0 = 256 * qb; int klo = q0 & ~(P.CL - 1); if (q0 - 128 > klo) klo = q0 - 128;
                    fa::attn_unit<64, 0>(P, X.lds, X.tid, b * SEQ, q0 + 32 * X.wave, 64 * hh, 64 * hh, hh, klo >> 6, (q0 + 255) >> 6); }
            }
            GBAR();
        }
        if (IN(3)) { MKCTX();
            {   fa::Params P; P.Q = (const bf16*)(X.ws + WS_QA); P.q_pitch = 768; P.K1 = (const bf16*)(X.ws + WS_KVA); P.k1_pitch = 1024; P.K2 = (const bf16*)(X.ws + WS_KPE); P.k2_pitch = 32; P.k2_col = 0;
                P.V = (const bf16*)(X.ws + WS_KVA); P.v_pitch = 1024; P.O = (bf16*)(X.ws + WS_XB); P.o_pitch = DM; P.LSE = nullptr; P.lse_pitch = 0; P.BM = nullptr; P.CL = 2048; P.W = 1 << 20;
#if defined(PROBE_HALF) && PROBE_HALF
                for (int U = X.vcu; U < NB * 8 * 8; U += X.G) { const int bh = U >> 3, pr = U & 7, b = bh >> 3, hd = bh & 7;
                    P.k1_col = 128 * hd; P.v_col = 128 * hd + 64;
#pragma unroll 1
                    for (int z = 0; z < 2; ++z) { const int qb = z ? 15 - pr : pr; const int q0 = 128 * qb;
                        fa::attn_unit<96, 0>(P, X.lds, X.tid, b * SEQ, q0 + 32 * (X.wave & 3), 96 * hd, 64 * hd, 0, 0, (q0 + 127) >> 6, X.wave < 4); } }
#else
                for (int rep = 0; rep < REP_P3A; ++rep) for (int U = X.vcu; U < NB * 8 * 4; U += X.G) { const int bh = U >> 2, pr = U & 3, b = bh >> 3, hd = bh & 7;
                    P.k1_col = 128 * hd; P.v_col = 128 * hd + 64;
#pragma unroll 1
                    for (int z = 0; z < 2; ++z) { const int qb = z ? 7 - pr : pr; const int q0 = 256 * qb;
                        fa::attn_unit<96, 0>(P, X.lds, X.tid, b * SEQ, q0 + 32 * X.wave, 96 * hd, 64 * hd, 0, 0, (q0 + 255) >> 6); } }
#endif
            }
            {   fa::Params P; P.Q = (const bf16*)(X.ws + WS_BQ); P.q_pitch = 256; P.K1 = (const bf16*)(X.ws + WS_T1); P.k1_pitch = 256; P.k1_col = 192; P.K2 = nullptr; P.k2_pitch = 0; P.k2_col = 0;
                P.V = (const bf16*)(X.ws + WS_BV); P.v_pitch = 64; P.v_col = 0; P.O = (bf16*)(X.ws + WS_XB); P.o_pitch = DM; P.LSE = nullptr; P.lse_pitch = 0; P.BM = (const unsigned*)(X.ws + WS_BM); P.CL = 2048; P.W = 1 << 20;
                const int hd = X.wave & 3, sub = X.wave >> 2;
                for (int rep = 0; rep < REP_P3B; ++rep) for (int U = X.vcu; U < NB * 16; U += X.G) { const int b = U >> 4, pr = U & 15;
#pragma unroll 1
                    for (int z = 0; z < 2; ++z) { const int qb = z ? 31 - pr : pr; const int q0 = 64 * qb;
                        fa::attn_unit<64, 1>(P, X.lds, X.tid, b * SEQ, q0 + 32 * sub, 64 * hd, 512 + 64 * hd, 0, 0, qb); } }
            }
            for (int rep = 0; rep < REP_P3C; ++rep) dil_combine(X);
            GBAR();
        }
        if (IN(4)) { MKCTX();
            pg8::Gemm g{(const bf16*)(X.ws + WS_XB), (const bf16*)(X.ws + WS_WO) + (size_t)l * DM * DM, DM, nullptr};
            pg8::StaticOrder S; S.init(NT, DM, X.G, X.c, REP_P4);
            pg8::EpiPlain E{(bf16*)(X.ws + WS_MIX), DM, nullptr, 0, 0.f, 0.f, X.lds + LDS_X_OFF};
            pg8::gemm_phase<pg8::EpiPlain, pg8::StaticOrder, false>(X.lds, g, S, E, X.tid);
            GBAR();
        }
        if (IN(5)) { MKCTX(); if (REP_P5 > 1) ln1_router(X, ap, l, l == 0, true); ln1_router(X, ap, l, l == 0); GBAR(); }
        if (IN(6)) { MKCTX(); for (int rep = 0; rep < REP_P6; ++rep) moe_dispatch(X); GBAR(); }
        if (IN(7)) { MKCTX();
            const int* TILEE = (const int*)(X.ws + WS_TILEE);
            pg8::Gemm g{(const bf16*)(X.ws + WS_XB), (const bf16*)(X.ws + WS_WGU), DM, (const int*)(X.ws + WS_STOK)};
            pg8::GroupedOrder S{TILEE, TILEE[1024], 2, X.G, X.c};
            pg8::EpiGateUp E{(bf16*)(X.ws + WS_H), (const float*)(X.ws + WS_SW)};
            for (int rep = 0; rep < REP_P7; ++rep) pg8::gemm_phase<pg8::EpiGateUp, pg8::GroupedOrder, true>(X.lds, g, S, E, X.tid);
            GBAR();
        }
        if (IN(8)) { MKCTX();
            const int* TILEE = (const int*)(X.ws + WS_TILEE);
            pg8::Gemm g{(const bf16*)(X.ws + WS_H), (const bf16*)(X.ws + WS_WD), FH, nullptr};
            pg8::GroupedOrder S{TILEE, TILEE[1024], 4, X.G, X.c};
            pg8::EpiPlain E{(bf16*)(X.ws + WS_Y), DM, nullptr, 0, 0.f, 0.f, X.lds + LDS_X_OFF};
            for (int rep = 0; rep < REP_P8; ++rep) pg8::gemm_phase<pg8::EpiPlain, pg8::GroupedOrder, false>(X.lds, g, S, E, X.tid);
            GBAR();
        }
        if (IN(9)) { MKCTX(); if (REP_P9 > 1) ln2_phase(X, ap, l, l == 0, true); ln2_phase(X, ap, l, l == 0); if (!(l == a.l_hi - 1)) GBAR(); }
#undef IN
    }
#undef GBAR
}

extern "C" void kernel_launch(void* const* d_in, const int* in_sizes, int n_in, void* d_out, int out_size, void* d_ws, size_t ws_size, hipStream_t stream) {
    static int grid = 0;
    if (grid == 0) {
        if (n_in != 19 || in_sizes[0] != NT * DM || out_size != NT * DM || ws_size < WS_END) { fprintf(stderr, "kernel_launch: unexpected shapes (n_in %d, in0 %d, out %d, ws %zu < %zu); nothing launched\n", n_in, n_in > 0 ? in_sizes[0] : -1, out_size, ws_size, (size_t)WS_END); grid = -1; return; }
        int dev = 0, cus = 0, per_cu = 0;
        if (hipGetDevice(&dev) != hipSuccess || hipDeviceGetAttribute(&cus, hipDeviceAttributeMultiprocessorCount, dev) != hipSuccess) { grid = -1; return; }
        if (hipFuncSetAttribute((const void*)mk_fwd, hipFuncAttributeMaxDynamicSharedMemorySize, LDS_BYTES) != hipSuccess) { fprintf(stderr, "kernel_launch: hipFuncSetAttribute failed\n"); grid = -1; return; }
        if (hipOccupancyMaxActiveBlocksPerMultiprocessor(&per_cu, (const void*)mk_fwd, 512, LDS_BYTES) != hipSuccess || per_cu < 1) fprintf(stderr, "kernel_launch: occupancy query reports %d\n", per_cu);
        (void)hipGetLastError();
        grid = cus;
    }
    if (grid < 0) return;
    (void)hipMemsetAsync((char*)d_ws + WS_CTL, 0, CTL_BYTES, stream);
    Args a{};
    a.x = (const float*)d_in[0]; a.pos = (const int*)d_in[1]; a.w_in = (const float*)d_in[2]; a.qn = (const float*)d_in[3]; a.kvn = (const float*)d_in[4];
    a.w_uq = (const float*)d_in[5]; a.w_ukv = (const float*)d_in[6]; a.w_o = (const float*)d_in[7]; a.ln1g = (const float*)d_in[8]; a.ln1b = (const float*)d_in[9];
    a.rgw = (const float*)d_in[10]; a.rgb = (const float*)d_in[11]; a.rew = (const float*)d_in[12]; a.reb = (const float*)d_in[13];
    a.wg = (const float*)d_in[14]; a.wu = (const float*)d_in[15]; a.wd = (const float*)d_in[16]; a.ln2g = (const float*)d_in[17]; a.ln2b = (const float*)d_in[18];
    a.out = (float*)d_out; a.ws = (unsigned char*)d_ws; a.pad = 0;
#if MK_MULTI
    a.use_bar = 0;
    a.l_lo = 0; a.l_hi = 0; a.ph_lo = 0; a.ph_hi = 0;
    hipLaunchKernelGGL(mk_fwd, dim3(grid), dim3(512), LDS_BYTES, stream, a);
    for (int l = 0; l < DEPTH; ++l)
        for (int ph = 1; ph < 10; ++ph) { a.l_lo = l; a.l_hi = l + 1; a.ph_lo = ph; a.ph_hi = ph + 1; hipLaunchKernelGGL(mk_fwd, dim3(grid), dim3(512), LDS_BYTES, stream, a); }
#else
    a.use_bar = 1; a.l_lo = 0; a.l_hi = DEPTH; a.ph_lo = 0; a.ph_hi = 10;
    hipLaunchKernelGGL(mk_fwd, dim3(grid), dim3(512), LDS_BYTES, stream, a);
#endif
    const hipError_t le = hipPeekAtLastError();
    if (le != hipSuccess) fprintf(stderr, "kernel_launch: launch failed: %s\n", hipGetErrorName(le));
}
```

```cpp
#include <hip/hip_runtime.h>
#include <cstdio>
#include <cstdint>

#define LAS __attribute__((address_space(3)))
#define GAS __attribute__((address_space(1)))
typedef unsigned short bf16;
typedef short bf16x8 __attribute__((ext_vector_type(8)));
typedef short s16x4 __attribute__((ext_vector_type(4)));
typedef float f32x2 __attribute__((ext_vector_type(2)));
typedef float f32x4 __attribute__((ext_vector_type(4)));
typedef float f32x16 __attribute__((ext_vector_type(16)));
typedef unsigned u32x2 __attribute__((ext_vector_type(2)));
typedef unsigned u32x4 __attribute__((ext_vector_type(4)));
typedef __bf16 bf16x2_t __attribute__((ext_vector_type(2)));

#ifndef MK_MULTI
#define MK_MULTI 0
#endif

constexpr int NB = 32, SEQ = 2048, NT = NB * SEQ, DM = 1024, DEPTH = 4;
constexpr int IN_COLS = 3400, NIN = 3584;
constexpr int NEXP = 32, FH = 256;
constexpr int NSLOT = 2 * NT + NEXP * 256;
constexpr int MAXTILES = NSLOT / 256;
constexpr float ALPHA = 1.681792830507429f;
constexpr float LOG2E = 1.4426950408889634f;
constexpr float QSC64 = 0.125f * LOG2E;
constexpr float QSC96 = 0.10206207261596577f * LOG2E;
constexpr float IDX_SCALE = 0.0625f;

constexpr size_t MiB = 1u << 20;
constexpr size_t WS_CTL = 0, CTL_BYTES = 1 * MiB;
constexpr size_t WS_WIN = 1 * MiB;
constexpr size_t WS_WUQ = 29 * MiB;
constexpr size_t WS_WUKV = WS_WUQ + 3 * MiB / 2;
constexpr size_t WS_WO = WS_WUKV + 2 * MiB;
constexpr size_t WS_RGT = WS_WO + 8 * MiB;
constexpr size_t WS_RET = WS_RGT + 64 * 1024;
constexpr size_t WS_ROPE = 42 * MiB;
constexpr size_t WS_WGU = 56 * MiB;
constexpr size_t WS_WD = 88 * MiB;
constexpr size_t WS_XB = 104 * MiB;
constexpr size_t WS_A = 232 * MiB;
constexpr size_t WS_CQ = WS_A;
constexpr size_t WS_T1 = WS_CQ + 32 * MiB;
constexpr size_t WS_BQ = WS_T1 + 32 * MiB;
constexpr size_t WS_BV = WS_BQ + 32 * MiB;
constexpr size_t WS_WI = WS_BV + 8 * MiB;
constexpr size_t WS_BQI = WS_WI + 2 * MiB;
constexpr size_t WS_SSQ = WS_BQI + 32 * MiB;
constexpr size_t WS_DQ = WS_SSQ + 4 * MiB;
constexpr size_t WS_DK = WS_DQ + 96 * MiB;
constexpr size_t WS_DV = WS_DK + 96 * MiB;
constexpr size_t WS_B = WS_DV + 96 * MiB;
constexpr size_t WS_QA = WS_B;
constexpr size_t WS_KVA = WS_QA + 96 * MiB;
constexpr size_t WS_BM = WS_KVA + 128 * MiB;
constexpr size_t WS_OD = WS_BM + 16 * MiB;
constexpr size_t WS_LSE = WS_OD + 96 * MiB;
constexpr size_t WS_MOE = WS_LSE + 4 * MiB;
constexpr size_t WS_ROUTE = WS_MOE;
constexpr size_t WS_HIST = WS_ROUTE + 1 * MiB;
constexpr size_t WS_STOK = WS_HIST + 64 * 1024;
constexpr size_t WS_SW = WS_STOK + 640 * 1024;
constexpr size_t WS_TSLOT = WS_SW + 640 * 1024;
constexpr size_t WS_TILEE = WS_TSLOT + 512 * 1024;
constexpr size_t WS_KPE = WS_MOE + 4 * MiB;
constexpr size_t WS_KI = WS_KPE + 4 * MiB;
constexpr size_t WS_END = WS_KI + 4 * MiB;
constexpr size_t WS_MIX = WS_A;
constexpr size_t WS_H = WS_A + 128 * MiB;
constexpr size_t WS_Y = WS_H + 68 * MiB;
static_assert(WS_RET + 512 * 1024 <= WS_ROPE && WS_ROPE + 14 * MiB <= WS_WGU && WS_WD + 16 * MiB <= WS_XB && WS_XB + 128 * MiB <= WS_A, "ws map 1");
static_assert(WS_Y + 272 * MiB <= WS_MOE && WS_TILEE + 8192 <= WS_END && WS_END <= 1024 * MiB, "ws map 2");
constexpr size_t ROPE_C16 = 0, ROPE_S16 = (size_t)NT * 16 * 4, ROPE_C8 = 2 * ROPE_S16, ROPE_S8 = ROPE_C8 + (size_t)NT * 8 * 4,
                 ROPE_C4 = ROPE_S8 + (size_t)NT * 8 * 4, ROPE_S4 = ROPE_C4 + (size_t)NT * 4 * 4;

constexpr int CW_BAR = 4096;
constexpr int RING_BYTES = 131072;
constexpr int LDS_X_OFF = 131072;
constexpr int LDSCTL_OFF = 147456;
constexpr int LDS_HIST_OFF = LDSCTL_OFF + 4096;
constexpr int LDS_BYTES = LDS_HIST_OFF + 4096;

#define RLX_AGENT __ATOMIC_RELAXED, __HIP_MEMORY_SCOPE_AGENT
__device__ __forceinline__ unsigned f2bf(float f) { unsigned u = __builtin_bit_cast(unsigned, f); return (u + 0x7fffu + ((u >> 16) & 1u)) >> 16; }
#ifndef NT_EPI
#define NT_EPI 1
#endif
#ifndef NT_LN
#define NT_LN 0
#endif
#ifndef NT_ATT
#define NT_ATT 1
#endif
template <bool NT> __device__ __forceinline__ void stgf4(void* p, f32x4 w) { if constexpr (NT) __builtin_nontemporal_store(w, (f32x4*)p); else *(f32x4*)p = w; }
template <bool NT> __device__ __forceinline__ void stg16(void* p, u32x4 w) { if constexpr (NT) __builtin_nontemporal_store(w, (u32x4*)p); else *(u32x4*)p = w; }
template <bool NT> __device__ __forceinline__ void stg8(void* p, u32x2 w) { if constexpr (NT) __builtin_nontemporal_store(w, (u32x2*)p); else *(u32x2*)p = w; }
__device__ __forceinline__ unsigned pk2(float lo, float hi) { f32x2 v = {lo, hi}; bf16x2_t b = __builtin_convertvector(v, bf16x2_t); return __builtin_bit_cast(unsigned, b); }
__device__ __forceinline__ float bf2f(unsigned short b) { return __builtin_bit_cast(float, ((unsigned)b) << 16); }
__device__ __forceinline__ float bflo(unsigned w) { return __builtin_bit_cast(float, w << 16); }
__device__ __forceinline__ float bfhi(unsigned w) { return __builtin_bit_cast(float, w & 0xffff0000u); }
template <int CTRL> __device__ __forceinline__ float dppf(float x) { return __builtin_bit_cast(float, __builtin_amdgcn_mov_dpp(__builtin_bit_cast(int, x), CTRL, 0xf, 0xf, true)); }
__device__ __forceinline__ float xhalf_sum(float v) { const auto t = __builtin_amdgcn_permlane32_swap(__float_as_uint(v), __float_as_uint(v), false, false); return __uint_as_float(t[0]) + __uint_as_float(t[1]); }
__device__ __forceinline__ float xhalf_max(float v) { const auto t = __builtin_amdgcn_permlane32_swap(__float_as_uint(v), __float_as_uint(v), false, false); return fmaxf(__uint_as_float(t[0]), __uint_as_float(t[1])); }
__device__ __forceinline__ float wave_sum(float v) {
    v += dppf<0xB1>(v); v += dppf<0x4E>(v); v += dppf<0x141>(v); v += dppf<0x140>(v);
    const auto s = __builtin_amdgcn_permlane16_swap(__float_as_uint(v), __float_as_uint(v), false, false);
    v = __uint_as_float(s[0]) + __uint_as_float(s[1]);
    return xhalf_sum(v);
}
__device__ __forceinline__ int crow(int r, int hi) { return (r & 3) + 8 * (r >> 2) + 4 * hi; }

#define XB_TMO      128
#define XB_XCNT(j)  (256  + 64 * (j))
#define XB_XSUB(j)  (1280 + 64 * (j))
#define XB_XGEN(j)  (2304 + 64 * (j))
#define XB_TOP      3328
#define XB_TOPGEN   3392
#define XCD_BAR_WORDS 3456
#define XB_SPIN_CAP (1u << 18)
__device__ __forceinline__ unsigned xb_ld(unsigned* p)              { return __hip_atomic_load(p, __ATOMIC_RELAXED, __HIP_MEMORY_SCOPE_AGENT); }
__device__ __forceinline__ unsigned xb_add(unsigned* p, unsigned v) { return __hip_atomic_fetch_add(p, v, __ATOMIC_RELAXED, __HIP_MEMORY_SCOPE_AGENT); }
__device__ __forceinline__ unsigned xb_xcc_id() { return (unsigned)__builtin_amdgcn_s_getreg((3 << 11) | 20) & 0xFu; }
#define XB_SPIN(cond, bar) do { unsigned _sp = 0; while (cond) { __builtin_amdgcn_s_sleep(1); \
    if ((++_sp & 255u) == 0u) { if (xb_ld(&(bar)[XB_TMO])) break; if (_sp > XB_SPIN_CAP) { atomicAdd(&(bar)[XB_TMO], 1u); break; } } } } while (0)
struct XcdBarrier { unsigned* bar; unsigned x; volatile LAS unsigned* st; };
__device__ __forceinline__ XcdBarrier xcd_barrier_post(unsigned* bar, volatile LAS unsigned* st) {
    XcdBarrier b; b.bar = bar; b.x = xb_xcc_id(); b.st = st;
    if (threadIdx.x == 0) (void)xb_add(&bar[XB_XCNT(b.x)], 1u);
    return b;
}
__device__ __forceinline__ void xcd_barrier_complete(unsigned* bar, unsigned x, unsigned& nloc, unsigned& nx) {
    const unsigned G = gridDim.x * gridDim.y * gridDim.z;
    unsigned sum, cnt, mine, sp = 0u;
    for (;;) {
        sum = 0u; cnt = 0u; mine = 0u;
#pragma unroll
        for (unsigned j = 0; j < 16; ++j) { const unsigned c = xb_ld(&bar[XB_XCNT(j)]); sum += c; cnt += (c > 0u) ? 1u : 0u; mine = (j == x) ? c : mine; }
        if (sum == G) break;
        __builtin_amdgcn_s_sleep(1);
        if ((++sp & 255u) == 0u) { if (xb_ld(&bar[XB_TMO])) break; if (sp > XB_SPIN_CAP) { atomicAdd(&bar[XB_TMO], 1u); break; } }
    }
    nloc = mine > 0u ? mine : 1u; nx = cnt > 0u ? cnt : 1u;
}
__device__ __forceinline__ void xcd_barrier(const XcdBarrier& b) {
    asm volatile("s_waitcnt vmcnt(0)" ::: "memory");
    __syncthreads();
    if (threadIdx.x == 0) {
        unsigned* bar = b.bar;
        __builtin_amdgcn_s_waitcnt(0);
        unsigned nloc = b.st[0], nx = b.st[1];
        if (nloc == 0u) { xcd_barrier_complete(bar, b.x, nloc, nx); b.st[0] = nloc; b.st[1] = nx; }
        const unsigned old = xb_add(&bar[XB_XSUB(b.x)], 1u);
        const unsigned gen = old / nloc;
        if (old + 1u == (gen + 1u) * nloc) {
            __builtin_amdgcn_fence(__ATOMIC_RELEASE, "agent");
            asm volatile("s_waitcnt vmcnt(0)" ::: "memory");
            const unsigned og = xb_add(&bar[XB_TOP], 1u);
            const unsigned tg = og / nx;
            if (og + 1u == (tg + 1u) * nx) xb_add(&bar[XB_TOPGEN], 1u);
            else XB_SPIN(xb_ld(&bar[XB_TOPGEN]) == tg, bar);
            __builtin_amdgcn_fence(__ATOMIC_ACQUIRE, "agent");
            xb_add(&bar[XB_XGEN(b.x)], 1u);
            asm volatile("s_waitcnt vmcnt(0)" ::: "memory");
        } else {
            XB_SPIN(xb_ld(&bar[XB_XGEN(b.x)]) == gen, bar);
            __builtin_amdgcn_fence(__ATOMIC_ACQUIRE, "agent");
            asm volatile("s_waitcnt vmcnt(0)" ::: "memory");
        }
    }
    __syncthreads();
}

namespace pg8 {
constexpr int BM = 256, BK = 64, HALF = 128, HTB = HALF * BK * 2, STAGE_BYTES = 8 * HTB, NXCD = 8, WGM = 8;
__host__ __device__ __forceinline__ int lds_byte(int r, int c) { const int st = (r >> 4) * 2 + (c >> 5), rr = r & 15, cc = c & 31, ob = rr * 64 + cc * 2; return st * 1024 + (ob ^ (((ob >> 9) & 1) << 5)); }
__host__ __device__ __forceinline__ void stage_rc(int b, int& R, int& C) { const int st = b / 1024, sb = b % 1024, swz = sb ^ (((sb >> 9) & 1) << 5); R = (st >> 1) * 16 + swz / 64; C = (st & 1) * 32 + (swz % 64) / 2; }
__host__ __device__ __forceinline__ int perm32(int rho) { const int n = rho >> 4, i = rho & 15; return 8 * (i >> 2) + 4 * n + (i & 3); }

struct Unit { int pm, pn, pb; };
struct Gemm { const bf16* A; const bf16* Bt; int K; const int* gidx; };

__device__ __forceinline__ int xcd_remap(int wgid, int nwg) { const int q = nwg / NXCD, r = nwg % NXCD, xcd = wgid % NXCD, off = wgid / NXCD; return (xcd < r ? xcd * (q + 1) : r * (q + 1) + (xcd - r) * q) + off; }
struct StaticOrder {
    int nM, nN, nwg, G, c, rep;
    __device__ void init(int M, int N, int G_, int c_, int rep_ = 1) { nM = M / BM; nN = N / BM; nwg = nM * nN; G = G_; c = c_; rep = rep_; }
    __device__ bool next(int i, Unit& u) const {
        long L = (long)i * G + c; if (L >= (long)nwg * rep) return false; L %= nwg;
        const int wgid = xcd_remap((int)L, nwg);
        const int nig = WGM * nN, gid = wgid / nig, fm = gid * WGM, gsz = (nM - fm) < WGM ? (nM - fm) : WGM;
        u.pm = fm + ((wgid % nig) % gsz); u.pn = (wgid % nig) / gsz; u.pb = u.pn; return true;
    }
};
struct GroupedOrder {
    const int* tile_e; int ntiles, npn, G, c;
    __device__ bool next(int i, Unit& u) const {
        const long L = (long)i * G + c; const int nwg = ntiles * npn; if (L >= nwg) return false;
        const int wgid = xcd_remap((int)L, nwg);
        u.pm = wgid / npn; u.pn = wgid % npn; u.pb = tile_e[u.pm] * npn + u.pn; return true;
    }
};

__device__ __forceinline__ unsigned cvt_pk_bf16(float lo, float hi) { unsigned r; asm volatile("v_cvt_pk_bf16_f32 %0, %1, %2" : "=v"(r) : "v"(lo), "v"(hi)); return r; }

struct EpiPlain {
    static constexpr bool PERM = true;
    bf16* O; int ldc; const float* ssq; int ssq_n; float ssq_inv; float eps;
    LAS unsigned char* xl;
    __device__ __forceinline__ void operator()(const f32x4 (&acc)[2][2][4][2], const Unit& u, int wr, int wc, int fr, int fq) const {
        const int lane = fq * 16 + fr; LAS unsigned char* t = xl + (wr * 4 + wc) * 2048;
        const int wsw = fr & 7, rrow = lane >> 3, rch = lane & 7;
#pragma unroll
        for (int ai = 0; ai < 2; ++ai)
#pragma unroll
            for (int m = 0; m < 4; ++m) { const int rowb = u.pm * BM + ai * HALF + wr * 64 + m * 16;
                float sc = 1.f;
                if (ssq) { const f32x4 p = *(const f32x4*)(ssq + (size_t)(rowb + fr) * ssq_n); sc = __builtin_amdgcn_rsqf((p[0] + p[1] + p[2] + p[3]) * ssq_inv + eps); }
#pragma unroll
                for (int bj = 0; bj < 2; ++bj) { const f32x4 v0 = acc[ai][bj][m][0] * sc, v1 = acc[ai][bj][m][1] * sc;
                    u32x4 w; w.x = cvt_pk_bf16(v0[0], v0[1]); w.y = cvt_pk_bf16(v0[2], v0[3]); w.z = cvt_pk_bf16(v1[0], v1[1]); w.w = cvt_pk_bf16(v1[2], v1[3]);
                    *(LAS u32x4*)(t + fr * 128 + 16 * ((4 * bj + fq) ^ wsw)) = w; }
#pragma unroll
                for (int i = 0; i < 2; ++i) { const int rr = 8 * i + rrow;
                    const u32x4 w = *(const LAS u32x4*)(t + rr * 128 + 16 * (rch ^ (rr & 7)));
                    stg16<NT_EPI>(O + (size_t)(rowb + rr) * ldc + u.pn * BM + wc * 64 + 8 * rch, w); }
            }
    }
};
struct EpiGateUp {
    static constexpr bool PERM = true;
    bf16* H; const float* sw;
    __device__ __forceinline__ void operator()(const f32x4 (&acc)[2][2][4][2], const Unit& u, int wr, int wc, int fr, int fq) const {
        const int row0 = u.pm * BM + wr * 64 + fr; const int col0 = u.pn * HALF + wc * 32 + 8 * fq;
#pragma unroll
        for (int ai = 0; ai < 2; ++ai)
#pragma unroll
            for (int m = 0; m < 4; ++m) { const int row = row0 + ai * HALF + m * 16; const float w = sw[row]; f32x4 hv[2];
#pragma unroll
                for (int n = 0; n < 2; ++n) { const f32x4 g = acc[ai][0][m][n], up = acc[ai][1][m][n];
#pragma unroll
                    for (int e = 0; e < 4; ++e) { const float sg = g[e] * __builtin_amdgcn_rcpf(1.0f + __builtin_amdgcn_exp2f(-g[e] * LOG2E)); hv[n][e] = sg * up[e] * w; } }
                u32x4 o; o.x = cvt_pk_bf16(hv[0][0], hv[0][1]); o.y = cvt_pk_bf16(hv[0][2], hv[0][3]); o.z = cvt_pk_bf16(hv[1][0], hv[1][1]); o.w = cvt_pk_bf16(hv[1][2], hv[1][3]);
                stg16<NT_EPI>(H + (size_t)row * FH + col0, o); }
    }
};

enum { GK_SKIP = 0, GK_PLAIN = 1, GK_ROPE32 = 2, GK_HEAD16 = 3, GK_IDX8 = 4, GK_WI = 5 };
struct GroupDesc { int kind; bf16* dst; int pitch; int col; float scale; int perm; float* ssq; int ssq_n; int ssq_i; };
struct RopeTabs { const int* pos; };
__device__ __forceinline__ int perm_row(int row, int perm) {
    if (perm == 0) return row; const int b = row >> 11, s = row & 2047;
    return perm == 4 ? (b << 11) + ((s & 3) << 9) + (s >> 2) : (b << 11) + ((s & 15) << 7) + (s >> 4);
}
__device__ __forceinline__ void st16(bf16* p, u32x2 a, u32x2 b) { u32x4 w; w.x = a.x; w.y = a.y; w.z = b.x; w.w = b.y; stg16<NT_EPI>(p, w); }
__device__ __forceinline__ u32x2 pk4(f32x4 v) { u32x2 w; w.x = cvt_pk_bf16(v[0], v[1]); w.y = cvt_pk_bf16(v[2], v[3]); return w; }
__device__ __forceinline__ void swap16(u32x2& X, u32x2& Y) {
    const auto a = __builtin_amdgcn_permlane16_swap(X.x, Y.x, false, false); const auto b = __builtin_amdgcn_permlane16_swap(X.y, Y.y, false, false);
    X.x = a[0]; Y.x = a[1]; X.y = b[0]; Y.y = b[1];
}
__device__ __forceinline__ float rope_k(int i, int rd) { return __builtin_amdgcn_exp2f(-18.931568569324174f * (float)(2 * i) / (float)rd) * 0.15915494309189535f; }
__device__ __forceinline__ void rope_cs(float posf, int i0, int rd, f32x4& c, f32x4& s) {
#pragma unroll
    for (int e = 0; e < 4; ++e) { const float f = __builtin_amdgcn_fractf(posf * rope_k(i0 + e, rd)); s[e] = __builtin_amdgcn_sinf(f); c[e] = __builtin_amdgcn_cosf(f); }
}
template <class DescFn> struct EpiGroups {
    static constexpr bool PERM = true;
    DescFn F; RopeTabs R; const float* rs_ssq; int rs_n; float rs_inv, rs_eps;
    __device__ __forceinline__ void operator()(const f32x4 (&acc)[2][2][4][2], const Unit& u, int wr, int wc, int fr, int fq) const {
        const int row0 = u.pm * BM + wr * 64 + fr;
#pragma unroll
        for (int bj = 0; bj < 2; ++bj) {
            const GroupDesc d = F(u.pn, bj, wc);
            if (d.kind == GK_SKIP) continue;
            const int ki0 = d.kind == GK_ROPE32 ? 4 * fq : (d.kind == GK_HEAD16 ? 4 * (fq & 1) : 0), krd = d.kind == GK_ROPE32 ? 32 : (d.kind == GK_HEAD16 ? 16 : 8);
#pragma unroll
            for (int ai = 0; ai < 2; ++ai)
#pragma unroll
                for (int m = 0; m < 4; ++m) {
                    const int row = row0 + ai * HALF + m * 16;
                    float sc = d.scale;
                    if (rs_ssq) { float s = 0.f; for (int i = 0; i < rs_n; ++i) s += rs_ssq[(size_t)row * rs_n + i]; sc *= __builtin_amdgcn_rsqf(s * rs_inv + rs_eps); }
                    f32x4 v0 = acc[ai][bj][m][0], v1 = acc[ai][bj][m][1];
                    if (d.ssq) {
                        float q = (v0[0] * v0[0] + v0[1] * v0[1]) + (v0[2] * v0[2] + v0[3] * v0[3]) + (v1[0] * v1[0] + v1[1] * v1[1]) + (v1[2] * v1[2] + v1[3] * v1[3]);
                        q += __shfl_xor(q, 16); q += __shfl_xor(q, 32);
                        if (fq == 0) d.ssq[(size_t)row * d.ssq_n + d.ssq_i] = q;
                    }
                    v0 = v0 * sc; v1 = v1 * sc;
                    if (d.kind == GK_WI) { if (fq == 0) { float* wp = (float*)d.dst + (size_t)row * 8; *(f32x4*)wp = v0; *(f32x4*)(wp + 4) = v1; } continue; }
                    bf16* rp = d.dst + (size_t)perm_row(row, d.perm) * d.pitch + d.col;
                    if (d.kind == GK_PLAIN) { st16(rp + 8 * fq, pk4(v0), pk4(v1)); }
                    else if (d.kind == GK_IDX8) {
                        f32x4 c, s; rope_cs((float)R.pos[row], ki0, krd, c, s);
                        const f32x4 o1 = fq == 0 ? v0 * c - v1 * s : v0, o2 = fq == 0 ? v1 * c + v0 * s : v1;
                        st16(rp + 8 * fq, pk4(o1), pk4(o2));
                    } else if (d.kind == GK_ROPE32) {
                        f32x4 c, s; rope_cs((float)R.pos[row], ki0, krd, c, s);
                        u32x2 X = pk4(v0 * c - v1 * s), Y = pk4(v1 * c + v0 * s);
                        swap16(X, Y);
                        st16(rp + ((fq & 1) ? 16 + 4 * (fq - 1) : 4 * fq), X, Y);
                    } else {
                        f32x4 c, s; rope_cs((float)R.pos[row], ki0, krd, c, s);
                        u32x2 X = pk4(fq < 2 ? v0 * c - v1 * s : v0), Y = pk4(fq < 2 ? v1 * c + v0 * s : v1);
                        swap16(X, Y);
                        st16(rp + 16 * (fq >> 1) + 8 * (fq & 1), X, Y);
                    }
                }
        }
    }
};

template <class Epi, class Sched, bool GATHER, int LDA = 0>
__device__ __forceinline__ void gemm_phase(LAS unsigned char* lds, const Gemm g, const Sched& S, const Epi& E, const int tid) {
    const int wid = __builtin_amdgcn_readfirstlane(tid >> 6), lane = tid & 63, wr = wid >> 2, wc = wid & 3, fr = lane & 15, fq = lane >> 4;
    const int K = g.K, nt = K / BK, lda = LDA ? LDA : K;
    unsigned voA[2][2], voB[2]; int RA[2], CA[2];
#pragma unroll
    for (int i = 0; i < 2; ++i) { int R, C; stage_rc(tid * 16 + i * 8192, R, C); const int Rb = Epi::PERM ? ((R & ~31) + perm32(R & 31)) : R;
        RA[i] = R; CA[i] = C; voA[0][i] = (unsigned)(R * lda + C) * 2u; voA[1][i] = (unsigned)((R + HALF) * lda + C) * 2u; voB[i] = (unsigned)(Rb * K + C) * 2u; }
    const size_t kstep = (size_t)(BK * 2);
    const size_t hstep = (size_t)HALF * K * 2;
    const size_t tstep = 2 * hstep;
    const size_t tstepA = (size_t)BM * lda * 2;
    const unsigned ldsw = (unsigned)wid * 1024u;
    const int aoff = lds_byte(wr * 64 + fr, fq * 8), boff = lds_byte(wc * 32 + fr, fq * 8);
#define PG8_SA(b, h) (((b) * 2 + (h)) * HTB)
#define PG8_SB(b, h) ((4 + (b) * 2 + (h)) * HTB)
#define PG8_STAGE(bufoff, gbase, voff) do { _Pragma("unroll") for (int _i = 0; _i < 2; ++_i) \
        __builtin_amdgcn_global_load_lds((const unsigned*)((const char*)(gbase) + (voff)[_i]), (LAS unsigned*)(lds + (bufoff) + ldsw + _i * 8192), 16, 0, 0); } while (0)
#define PG8_LDA(dst, b, h) do { _Pragma("unroll") for (int m = 0; m < 4; ++m) _Pragma("unroll") for (int k = 0; k < 2; ++k) dst[m][k] = *(const LAS bf16x8*)(lds + PG8_SA(b, h) + aoff + m * 2048 + k * 1024); } while (0)
#define PG8_LDB(dst, b, h) do { _Pragma("unroll") for (int n = 0; n < 2; ++n) _Pragma("unroll") for (int k = 0; k < 2; ++k) dst[n][k] = *(const LAS bf16x8*)(lds + PG8_SB(b, h) + boff + n * 2048 + k * 1024); } while (0)
#define PG8_MMA(ai, bj, At, Bt) do { __builtin_amdgcn_s_setprio(1); _Pragma("unroll") for (int m = 0; m < 4; ++m) _Pragma("unroll") for (int n = 0; n < 2; ++n) _Pragma("unroll") for (int k = 0; k < 2; ++k) \
        acc[ai][bj][m][n] = __builtin_amdgcn_mfma_f32_16x16x32_bf16(Bt[n][k], At[m][k], acc[ai][bj][m][n], 0, 0, 0); __builtin_amdgcn_s_setprio(0); } while (0)
#define PG8_WAIT_V(n) asm volatile("s_waitcnt vmcnt(" #n ")" ::: "memory")
#define PG8_WAIT_L(n) asm volatile("s_waitcnt lgkmcnt(" #n ")" ::: "memory")
#define PG8_BAR __builtin_amdgcn_s_barrier()
#define PG8_SCHED __builtin_amdgcn_sched_barrier(0)
    Unit cur, nxt; int ui = 0;
    if (!S.next(0, cur)) return;
    f32x4 acc[2][2][4][2];
#pragma unroll
    for (int a = 0; a < 2; ++a)
#pragma unroll
        for (int b = 0; b < 2; ++b)
#pragma unroll
            for (int m = 0; m < 4; ++m)
#pragma unroll
                for (int n = 0; n < 2; ++n) acc[a][b][m][n] = (f32x4){0.f, 0.f, 0.f, 0.f};
    bf16x8 At[4][2], B0[2][2], B1[2][2];
    unsigned nvA[2][2];
    const char* cA; const char* cB = (const char*)g.Bt + (size_t)cur.pb * tstep;
    if constexpr (GATHER) { cA = (const char*)g.A;
#pragma unroll
        for (int h = 0; h < 2; ++h)
#pragma unroll
            for (int i = 0; i < 2; ++i) voA[h][i] = (unsigned)g.gidx[cur.pm * BM + h * HALF + RA[i]] * (unsigned)(lda * 2) + (unsigned)CA[i] * 2u;
    } else cA = (const char*)g.A + (size_t)cur.pm * tstepA;
    PG8_STAGE(PG8_SB(0, 0), cB, voB); PG8_STAGE(PG8_SB(0, 1), cB + hstep, voB); PG8_STAGE(PG8_SA(0, 0), cA, voA[0]); PG8_STAGE(PG8_SA(0, 1), cA, voA[1]);
    if (wr == 1) PG8_BAR;
    PG8_WAIT_V(2); PG8_BAR;
    PG8_STAGE(PG8_SB(1, 0), cB + kstep, voB); PG8_STAGE(PG8_SA(1, 0), cA + kstep, voA[0]); PG8_STAGE(PG8_SB(1, 1), cB + hstep + kstep, voB);
    PG8_WAIT_V(6); PG8_BAR;
    for (;;) {
        const bool has_next = S.next(ui + 1, nxt);
        const char* nA; const char* nB = has_next ? (const char*)g.Bt + (size_t)nxt.pb * tstep : cB;
        if constexpr (GATHER) { nA = cA;
#pragma unroll
            for (int h = 0; h < 2; ++h)
#pragma unroll
                for (int i = 0; i < 2; ++i) nvA[h][i] = has_next ? (unsigned)g.gidx[nxt.pm * BM + h * HALF + RA[i]] * (unsigned)(lda * 2) + (unsigned)CA[i] * 2u : voA[h][i];
        } else nA = has_next ? (const char*)g.A + (size_t)nxt.pm * tstepA : cA;
#pragma nounroll
        for (int t = 0; t < nt; t += 2) {
            const bool last = (t == nt - 2);
            const char* a1 = cA + (size_t)(t + 1) * kstep;
            const char* a2 = last ? nA : cA + (size_t)(t + 2) * kstep; const char* b2 = last ? nB : cB + (size_t)(t + 2) * kstep;
            const char* a3 = a2 + kstep; const char* b3 = b2 + kstep;
            unsigned xA[2][2];
#pragma unroll
            for (int h = 0; h < 2; ++h)
#pragma unroll
                for (int i = 0; i < 2; ++i) xA[h][i] = (GATHER && last) ? nvA[h][i] : voA[h][i];
            PG8_LDB(B0, 0, 0); PG8_LDB(B1, 0, 1); PG8_SCHED; PG8_LDA(At, 0, 0); PG8_STAGE(PG8_SA(1, 1), a1, voA[1]);
            PG8_WAIT_V(8); PG8_WAIT_L(0); PG8_BAR; PG8_MMA(0, 0, At, B0); PG8_MMA(0, 1, At, B1); PG8_BAR; PG8_SCHED;
            PG8_LDA(At, 0, 1); PG8_STAGE(PG8_SB(0, 0), b2, voB); PG8_STAGE(PG8_SB(0, 1), b2 + hstep, voB); PG8_STAGE(PG8_SA(0, 0), a2, xA[0]);
            PG8_WAIT_V(8); PG8_WAIT_L(0); PG8_BAR; PG8_MMA(1, 0, At, B0); PG8_MMA(1, 1, At, B1); PG8_BAR; PG8_SCHED;
            PG8_LDB(B0, 1, 0); PG8_LDB(B1, 1, 1); PG8_SCHED; PG8_LDA(At, 1, 0); PG8_STAGE(PG8_SA(0, 1), a2, xA[1]);
            PG8_WAIT_V(8); PG8_WAIT_L(0); PG8_BAR; PG8_MMA(0, 0, At, B0); PG8_MMA(0, 1, At, B1); PG8_BAR; PG8_SCHED;
            PG8_LDA(At, 1, 1); PG8_STAGE(PG8_SB(1, 0), b3, voB); PG8_STAGE(PG8_SB(1, 1), b3 + hstep, voB); PG8_STAGE(PG8_SA(1, 0), a3, xA[0]);
            PG8_WAIT_V(8); PG8_WAIT_L(0); PG8_BAR; PG8_MMA(1, 0, At, B0); PG8_MMA(1, 1, At, B1); PG8_BAR; PG8_SCHED;
        }
        if (wr == 0) PG8_BAR;
        E(acc, cur, wr, wc, fr, fq);
        if (!has_next) break;
#pragma unroll
        for (int a = 0; a < 2; ++a)
#pragma unroll
            for (int b = 0; b < 2; ++b)
#pragma unroll
                for (int m = 0; m < 4; ++m)
#pragma unroll
                    for (int n = 0; n < 2; ++n) acc[a][b][m][n] = (f32x4){0.f, 0.f, 0.f, 0.f};
        cur = nxt; cA = nA; cB = nB; ++ui;
        if constexpr (GATHER) {
#pragma unroll
            for (int h = 0; h < 2; ++h)
#pragma unroll
                for (int i = 0; i < 2; ++i) voA[h][i] = nvA[h][i];
        }
        if (wr == 1) PG8_BAR;
    }
    PG8_WAIT_V(0);
    PG8_BAR;
#undef PG8_SA
#undef PG8_SB
#undef PG8_STAGE
#undef PG8_LDA
#undef PG8_LDB
#undef PG8_MMA
#undef PG8_WAIT_V
#undef PG8_WAIT_L
#undef PG8_BAR
#undef PG8_SCHED
}
}

#ifndef PROBE_LDS2
#define PROBE_LDS2 0
#endif
#ifndef PROBE_EXP2
#define PROBE_EXP2 0
#endif
#ifndef FA_FUSE
#define FA_FUSE 0
#endif
namespace fa {
constexpr int VBYTES_T = 64 * 128;
typedef short v4i16_t __attribute__((ext_vector_type(4)));
__device__ __forceinline__ u32x2 vtr(const LAS unsigned char* p) { return __builtin_bit_cast(u32x2, __builtin_amdgcn_ds_read_tr16_b64_v4i16((LAS v4i16_t*)p)); }
struct Params {
    const bf16* Q;  int q_pitch;
    const bf16* K1; int k1_pitch, k1_col;
    const bf16* K2; int k2_pitch, k2_col;
    const bf16* V;  int v_pitch, v_col;
    bf16* O; int o_pitch;
    float* LSE; int lse_pitch;
    const unsigned* BM;
    int CL, W;
};
template <int DQK, int MODE>
__device__ __forceinline__ void attn_unit(const Params& P, LAS unsigned char* lds, const int tid, int seq0, int qw, int q_col, int o_col, int lse_col, int kt_lo, int kt_hi, const bool active = true) {
    constexpr int NKS = DQK / 16, AHEAD = 4, NST = AHEAD + 1, K1B = 8192, K2B = (DQK == 96 ? 4096 : 0), BMOFF = K1B + K2B + 8192, STB = BMOFF + (MODE == 1 ? 8192 : 0);
    constexpr int NDMA = 2 + (DQK == 96 ? 1 : 0) + (MODE == 1 ? 1 : 0);
    const int lane = tid & 63, r = lane & 31, h = lane >> 5, wave = __builtin_amdgcn_readfirstlane(tid >> 6);
    const int q = qw + r;
    const int lo_q = MODE == 0 ? max(q & ~(P.CL - 1), q - P.W) : 0;
    const int lo_w0 = MODE == 0 ? max(qw & ~(P.CL - 1), qw - P.W) : 0;
    const int lo_w1 = MODE == 0 ? max((qw + 31) & ~(P.CL - 1), qw + 31 - P.W) : 0;
    const int tq_ = (lane & 15) >> 2, tp_ = lane & 3, tg_ = lane >> 4;
    const int vtoff = K1B + K2B + (4 * h + tq_) * 128, vxb = 2 * (16 * (tg_ & 1) + 4 * tp_), vsw = (tq_ >> 1) & 1;
    const int vx0 = vxb + ((0 ^ vsw) << 6), vx1 = vxb + ((1 ^ vsw) << 6);
    const int ka_ = (r >> 1) & 3, kb_ = h ^ ((r >> 1) >> 2 & 1);
    const int s1_ = (r >> 1) & 7, s2_ = (r >> 2) & 3;
    const int k1row = r * 128, k2row = K1B + r * 64;
    (void)ka_; (void)kb_;
    const int row1 = 8 * wave + (lane >> 3);
    const bf16* src_k1 = P.K1 + (size_t)(seq0 + row1) * P.k1_pitch + P.k1_col + 8 * ((lane & 7) ^ ((row1 >> 1) & 7));
    const bf16* src_v = P.V + (size_t)(seq0 + row1) * P.v_pitch + P.v_col + 8 * ((lane & 7) ^ (((row1 >> 1) & 1) << 2));
    const int row2 = 16 * (wave & 3) + (lane >> 2);
    const bf16* src_k2 = DQK == 96 ? P.K2 + (size_t)(seq0 + row2) * P.k2_pitch + P.k2_col + 8 * ((lane & 3) ^ ((row2 >> 2) & 3)) : nullptr;
    const size_t tk1 = (size_t)64 * P.k1_pitch, tk2 = (size_t)64 * P.k2_pitch, tv = (size_t)64 * P.v_pitch;
    const unsigned* bmp = MODE == 1 ? P.BM + (size_t)(seq0 + q) * 64 : nullptr;
    const int d_k1 = wave * 1024, d_k2 = K1B + (wave & 3) * 1024, d_v = K1B + K2B + wave * 1024;
#define FA_ISSUE(TILE, ST) do { const int kk_ = (TILE) < kt_hi ? (TILE) : kt_hi; LAS unsigned char* sb_ = lds + (ST) * STB; \
        __builtin_amdgcn_global_load_lds((const unsigned*)(src_k1 + kk_ * tk1), (LAS unsigned*)(sb_ + d_k1), 16, 0, 0); \
        __builtin_amdgcn_global_load_lds((const unsigned*)(src_v + kk_ * tv), (LAS unsigned*)(sb_ + d_v), 16, 0, 0); \
        if constexpr (DQK == 96) __builtin_amdgcn_global_load_lds((const unsigned*)(src_k2 + kk_ * tk2), (LAS unsigned*)(sb_ + d_k2), 16, 0, 0); \
        if constexpr (MODE == 1) __builtin_amdgcn_global_load_lds(bmp + (kk_ & ~1) * 2, (LAS unsigned*)(sb_ + BMOFF + wave * 1024), 16, 0, 0); } while (0)
#define FA_WAITBAR(N) do { asm volatile("s_waitcnt vmcnt(%0)" :: "n"(N) : "memory"); __builtin_amdgcn_s_barrier(); asm volatile("" ::: "memory"); } while (0)
    bf16x8 qf[NKS];
    { const bf16* qp = P.Q + (size_t)(seq0 + q) * P.q_pitch + q_col + 8 * h;
#pragma unroll
      for (int ks = 0; ks < NKS; ++ks) qf[ks] = *(const bf16x8*)(qp + 16 * ks); }
    u32x2 bmc = {0u, 0u};
    f32x16 o0, o1, c0, c1, n0, n1;
#pragma unroll
    for (int i = 0; i < 16; ++i) { o0[i] = 0.f; o1[i] = 0.f; c0[i] = 0.f; c1[i] = 0.f; n0[i] = 0.f; n1[i] = 0.f; }
    float m = -INFINITY, l = 0.f;
#define FA_PART(kt_) (active && (MODE == 0 ? ((kt_) * 64 <= qw + 31 && (kt_) * 64 + 63 >= lo_w0) : ((kt_) * 64 <= qw + 31)))
#define FA_KADDR(SB_, ROFF, ks) ((ks) < 4 ? (SB_) + (ROFF) * 128 + k1row + 16 * ((2 * (ks) + h) ^ s1_) : (SB_) + (ROFF) * 64 + k2row + 16 * ((2 * ((ks) - 4) + h) ^ s2_))
#define FA_QKH(S, SB_, ROFF) do { bf16x8 fa_[NKS]; \
        _Pragma("unroll") for (int ks = 0; ks < NKS; ++ks) fa_[ks] = *(const LAS bf16x8*)FA_KADDR(SB_, ROFF, ks); \
        if (PROBE_LDS2) { _Pragma("unroll") for (int ks = 0; ks < NKS; ++ks) { const bf16x8 fb_ = *(const volatile LAS bf16x8*)FA_KADDR(SB_, (ROFF) ^ 32, ks); asm volatile("" :: "v"(fb_)); } } \
        _Pragma("unroll") for (int i = 0; i < 16; ++i) S[i] = 0.f; \
        _Pragma("unroll") for (int ks = 0; ks < NKS; ++ks) S = __builtin_amdgcn_mfma_f32_32x32x16_bf16(fa_[ks], qf[ks], S, 0, 0, 0); \
        __builtin_amdgcn_sched_group_barrier(0x100, NKS, 0); __builtin_amdgcn_sched_group_barrier(0x008, NKS, 0); } while (0)
#define FA_QK(S0, S1, SB_) do { FA_QKH(S0, SB_, 0); FA_QKH(S1, SB_, 32); } while (0)
#define FA_QKX(S, SB_, ROFF) do { bf16x8 fa_[NKS]; \
        _Pragma("unroll") for (int ks = 0; ks < NKS; ++ks) fa_[ks] = *(const LAS bf16x8*)FA_KADDR(SB_, ROFF, ks); \
        _Pragma("unroll") for (int i = 0; i < 16; ++i) S[i] = 0.f; \
        _Pragma("unroll") for (int ks = 0; ks < NKS; ++ks) S = __builtin_amdgcn_mfma_f32_32x32x16_bf16(fa_[ks], qf[ks], S, 0, 0, 0); } while (0)
    int st_is = 0;
#pragma unroll
    for (int a = 0; a < AHEAD; ++a) { FA_ISSUE(kt_lo + a, st_is); st_is = st_is + 1; }
    int st_c = 0, st_n = 1;
    FA_WAITBAR((AHEAD - 2) * NDMA);
    if (FA_PART(kt_lo)) FA_QK(c0, c1, lds);
    for (int kt = kt_lo; kt <= kt_hi; ++kt) {
        FA_ISSUE(kt + AHEAD, st_is); st_is = (st_is + 1 == NST) ? 0 : st_is + 1;
        const bool more1 = kt < kt_hi;
        const int k0 = kt * 64;
        const bool part_c = FA_PART(kt), part_n = more1 && FA_PART(kt + 1);
        const LAS unsigned char* Sn = lds + st_n * STB; const LAS unsigned char* Vb = lds + st_c * STB;
        const bool fused = FA_FUSE && (DQK == 64) && part_c && part_n;
        if (part_n && !fused) FA_QK(n0, n1, Sn);
        if (part_c) {
            float alpha;
            if constexpr (MODE == 1) { const u32x4 bw = *(const LAS u32x4*)(Vb + BMOFF + wave * 1024 + lane * 16); bmc.x = (kt & 1) ? bw.z : bw.x; bmc.y = (kt & 1) ? bw.w : bw.y; }
#define FA_SOFTMAX(MASKED) do { \
            if (MASKED) { if constexpr (MODE == 0) { \
                    _Pragma("unroll") for (int i = 0; i < 16; ++i) { const int kk = k0 + crow(i, h); \
                        c0[i] = (kk > q || kk < lo_q) ? -INFINITY : c0[i]; c1[i] = (kk + 32 > q || kk + 32 < lo_q) ? -INFINITY : c1[i]; } \
                } else { const unsigned w0 = bmc.x >> (4 * h), w1 = bmc.y >> (4 * h); \
                    _Pragma("unroll") for (int i = 0; i < 16; ++i) { const int b = (i & 3) + 8 * (i >> 2); \
                        c0[i] = ((w0 >> b) & 1u) ? c0[i] : -INFINITY; c1[i] = ((w1 >> b) & 1u) ? c1[i] : -INFINITY; } } } \
            float mx = fmaxf(c0[0], c1[0]); \
            _Pragma("unroll") for (int i = 1; i < 16; ++i) mx = fmaxf(mx, fmaxf(c0[i], c1[i])); \
            mx = xhalf_max(mx); \
            const float mn = fmaxf(m, mx); \
            const float ms = (mn == -INFINITY) ? 0.f : mn; \
            alpha = __builtin_amdgcn_exp2f(m - ms); \
            m = mn; \
            float ls = 0.f; \
            if (PROBE_EXP2) { float dm_ = 0.f; _Pragma("unroll") for (int i = 0; i < 16; ++i) { dm_ += __builtin_amdgcn_exp2f(c0[i] - mx) + __builtin_amdgcn_exp2f(c1[i] - mx); } asm volatile("" :: "v"(dm_)); } \
            _Pragma("unroll") for (int i = 0; i < 16; ++i) { c0[i] = __builtin_amdgcn_exp2f(c0[i] - ms); c1[i] = __builtin_amdgcn_exp2f(c1[i] - ms); ls += c0[i] + c1[i]; } \
            l = l * alpha + ls; } while (0)
            const bool need_mask = MODE == 1 ? true : ((k0 + 63 > qw) || (k0 < lo_w1));
#define FA_FUSED(MASKED) do { FA_QKX(n0, Sn, 0); FA_QKX(n1, Sn, 32); FA_SOFTMAX(MASKED); \
            _Pragma("unroll") for (int hh_ = 0; hh_ < 2; ++hh_) { \
                __builtin_amdgcn_sched_group_barrier(0x100, NKS, 0); \
                _Pragma("unroll") for (int i = 0; i < NKS; ++i) { __builtin_amdgcn_sched_group_barrier(0x008, 1, 0); __builtin_amdgcn_sched_group_barrier(0x002, 120 / (2 * NKS), 0); } } } while (0)
            if (fused) { if (need_mask) FA_FUSED(true); else FA_FUSED(false); }
            else { if (need_mask) FA_SOFTMAX(true); else FA_SOFTMAX(false); }
#undef FA_FUSED
#undef FA_SOFTMAX
            if (!__all(alpha == 1.0f)) {
#pragma unroll
                for (int i = 0; i < 16; ++i) { o0[i] *= alpha; o1[i] *= alpha; } }
#pragma unroll
            for (int kb = 0; kb < 2; ++kb) {
                const f32x16& s = kb ? c1 : c0;
                u32x2 va[2][2], vb[2][2];
                const unsigned vaddr = (unsigned)(size_t)(Vb + (32 * kb) * 128 + vtoff);
#pragma unroll
                for (int sk = 0; sk < 2; ++sk) {
                    asm volatile("ds_read_b64_tr_b16 %0, %1" : "=&v"(va[sk][0]) : "v"(vaddr + (unsigned)(sk * 2048 + vx0)) : "memory");
                    asm volatile("ds_read_b64_tr_b16 %0, %1" : "=&v"(vb[sk][0]) : "v"(vaddr + (unsigned)(sk * 2048 + 1024 + vx0)) : "memory");
                    asm volatile("ds_read_b64_tr_b16 %0, %1" : "=&v"(va[sk][1]) : "v"(vaddr + (unsigned)(sk * 2048 + vx1)) : "memory");
                    asm volatile("ds_read_b64_tr_b16 %0, %1" : "=&v"(vb[sk][1]) : "v"(vaddr + (unsigned)(sk * 2048 + 1024 + vx1)) : "memory");
                }
                bf16x8 pf[2];
#pragma unroll
                for (int sk = 0; sk < 2; ++sk) { u32x4 pw; pw.x = pk2(s[8 * sk + 0], s[8 * sk + 1]); pw.y = pk2(s[8 * sk + 2], s[8 * sk + 3]); pw.z = pk2(s[8 * sk + 4], s[8 * sk + 5]); pw.w = pk2(s[8 * sk + 6], s[8 * sk + 7]); pf[sk] = __builtin_bit_cast(bf16x8, pw); }
                asm volatile("s_waitcnt lgkmcnt(0)" : "+v"(va[0][0]), "+v"(vb[0][0]), "+v"(va[0][1]), "+v"(vb[0][1]), "+v"(va[1][0]), "+v"(vb[1][0]), "+v"(va[1][1]), "+v"(vb[1][1]) :: "memory");
                __builtin_amdgcn_sched_barrier(0);
#pragma unroll
                for (int sk = 0; sk < 2; ++sk) {
                    const u32x4 v0w = {va[sk][0].x, va[sk][0].y, vb[sk][0].x, vb[sk][0].y}, v1w = {va[sk][1].x, va[sk][1].y, vb[sk][1].x, vb[sk][1].y};
                    o0 = __builtin_amdgcn_mfma_f32_32x32x16_bf16(__builtin_bit_cast(bf16x8, v0w), pf[sk], o0, 0, 0, 0);
                    o1 = __builtin_amdgcn_mfma_f32_32x32x16_bf16(__builtin_bit_cast(bf16x8, v1w), pf[sk], o1, 0, 0, 0);
                }
            }
        }
        FA_WAITBAR((AHEAD - 2) * NDMA);
        c0 = n0; c1 = n1;
        st_c = st_n; st_n = (st_n + 1 == NST) ? 0 : st_n + 1;
    }
#undef FA_PART
#undef FA_QK
#undef FA_QKH
#undef FA_QKX
#undef FA_KADDR
    const float lt = xhalf_sum(l);
    const float inv = 1.0f / lt;
    if (active) {
    bf16* op = P.O + (size_t)(seq0 + q) * P.o_pitch + o_col + 8 * h;
#pragma unroll
    for (int db = 0; db < 2; ++db) {
        const f32x16& o = db ? o1 : o0;
#pragma unroll
        for (int j = 0; j < 2; ++j) {
            u32x2 X, Y;
            X.x = pk2(o[8 * j] * inv, o[8 * j + 1] * inv); X.y = pk2(o[8 * j + 2] * inv, o[8 * j + 3] * inv);
            Y.x = pk2(o[8 * j + 4] * inv, o[8 * j + 5] * inv); Y.y = pk2(o[8 * j + 6] * inv, o[8 * j + 7] * inv);
            const auto a = __builtin_amdgcn_permlane32_swap(X.x, Y.x, false, false); const auto b = __builtin_amdgcn_permlane32_swap(X.y, Y.y, false, false);
            u32x4 w; w.x = a[0]; w.y = b[0]; w.z = a[1]; w.w = b[1];
            stg16<NT_ATT>(op + 32 * db + 16 * j, w);
        }
    }
    if (P.LSE && h == 0) P.LSE[(size_t)(seq0 + q) * P.lse_pitch + lse_col] = m + __builtin_amdgcn_logf(lt);
    }
    asm volatile("s_waitcnt vmcnt(0)" ::: "memory"); __builtin_amdgcn_s_barrier(); asm volatile("" ::: "memory");
#undef FA_ISSUE
#undef FA_WAITBAR
}
}

struct Args {
    const float* x; const int* pos; const float* w_in; const float* qn; const float* kvn; const float* w_uq; const float* w_ukv; const float* w_o;
    const float* ln1g; const float* ln1b; const float* rgw; const float* rgb; const float* rew; const float* reb;
    const float* wg; const float* wu; const float* wd; const float* ln2g; const float* ln2b;
    float* out; unsigned char* ws; int l_lo, l_hi, ph_lo, ph_hi, use_bar, pad;
};
typedef const __attribute__((address_space(4))) Args CArgs;
struct Ctx { LAS unsigned char* lds; int tid, lane, wave, G, c, vcu; unsigned char* ws; };

struct ColIdent { int off; __device__ __forceinline__ int operator()(int P) const { return off + P; } };
struct ColAdj { __device__ __forceinline__ int operator()(int P) const { const int p = P & 255; return (P & ~255) + 64 * ((p >> 5) & 3) + 32 * (p >> 7) + (p & 31); } };
__device__ __forceinline__ int map_rope32(int p) { return 16 * ((p >> 2) & 1) + 4 * (p >> 3) + (p & 3); }
__device__ __forceinline__ int map_head16(int p) { const int fq = p >> 3; return 16 * (fq >> 1) + 8 * ((p >> 2) & 1) + 4 * (fq & 1) + (p & 3); }
struct ColWin {
    __device__ __forceinline__ int operator()(int P) const {
        const int G = P >> 5, p = P & 31;
        if (G < 8) return 32 * G + p;
        if (G < 12) return 256 + 32 * (G - 8) + p;
        if (G == 12) return 384 + map_rope32(p);
        if (G == 13) return 1056 + p;
        if (G == 14) return 672 + map_head16(p);
        if (G == 15) return 704 + p;
        if (G < 24) { const int hh = (G - 16) >> 1; return 416 + 64 * hh + (((G - 16) & 1) ? 32 + p : map_head16(p)); }
        if (G < 26) return 736 + 32 * (G - 24) + p;
        if (G == 26) return p < 8 ? 1088 + p : -1;
        if (G < 32) return -1;
        if (G < 40) return 800 + 32 * (G - 32) + p;
        if (G < 64) { const int j = G - 40; return 1096 + 64 * (j >> 1) + ((j & 1) ? 32 + p : map_head16(p)); }
        if (G < 88) { const int j = G - 64; return 1096 + 768 + 64 * (j >> 1) + ((j & 1) ? 32 + p : map_head16(p)); }
        return 1096 + 1536 + 32 * (G - 88) + p;
    }
};
struct ColUq {
    __device__ __forceinline__ int operator()(int P) const { const int G = P >> 5, p = P & 31; return 32 * G + ((G % 3 == 2) ? map_rope32(p) : p); }
};
template <class ColFn>
__device__ __forceinline__ void transpose_item(const float* W, int ldw, int kvalid, bf16* WT, int ldt, int k0, int P0, const ColFn& cf, const float* rowscale, LAS float* scr, int lane) {
    const int c = lane & 31, col = cf(P0 + c);
#pragma unroll 8
    for (int i = 0; i < 32; ++i) { const int kk = 2 * i + (lane >> 5), k = k0 + kk; float v = 0.f;
        if (col >= 0 && k < kvalid) { v = W[(size_t)k * ldw + col]; if (rowscale) v *= rowscale[k]; }
        scr[kk * 33 + c] = v; }
    asm volatile("s_waitcnt lgkmcnt(0)" ::: "memory");
    const int cc = lane & 7;
#pragma unroll
    for (int j = 0; j < 4; ++j) { const int n = (lane >> 3) + 8 * j; const LAS float* s = scr + (8 * cc) * 33 + n;
        u32x4 o; o.x = pk2(s[0 * 33], s[1 * 33]); o.y = pk2(s[2 * 33], s[3 * 33]); o.z = pk2(s[4 * 33], s[5 * 33]); o.w = pk2(s[6 * 33], s[7 * 33]);
        *(u32x4*)(WT + (size_t)(P0 + n) * ldt + k0 + 8 * cc) = o; }
    asm volatile("s_waitcnt lgkmcnt(0)" ::: "memory");
}
__device__ __forceinline__ void prologue(const Ctx& X, const CArgs* ap) {
    struct { const float* x; const float *w_in, *qn, *kvn, *w_uq, *w_ukv, *w_o, *rgw, *rew; } a = {ap->x, ap->w_in, ap->qn, ap->kvn, ap->w_uq, ap->w_ukv, ap->w_o, ap->rgw, ap->rew};
    LAS float* scr = (LAS float*)(X.lds + X.wave * 16384);
    const int gw = X.vcu * 8 + X.wave, NGW = X.G * 8;
    constexpr int I_WIN = 16 * 112, I_UQ = 4 * 24, I_UKV = 4 * 32, I_WO = 16 * 32, I_L = I_WIN + I_UQ + I_UKV + I_WO;
    for (int it = gw; it < DEPTH * I_L; it += NGW) {
        const int l = it / I_L; int r = it % I_L;
        if (r < I_WIN) { transpose_item(a.w_in + (size_t)l * DM * IN_COLS, IN_COLS, DM, (bf16*)(X.ws + WS_WIN) + (size_t)l * NIN * DM, DM, 64 * (r / 112), 32 * (r % 112), ColWin{}, nullptr, scr, X.lane); continue; }
        r -= I_WIN;
        if (r < I_UQ) { transpose_item(a.w_uq + (size_t)l * 256 * 768, 768, 256, (bf16*)(X.ws + WS_WUQ) + (size_t)l * 768 * 256, 256, 64 * (r / 24), 32 * (r % 24), ColUq{}, a.qn + l * 256, scr, X.lane); continue; }
        r -= I_UQ;
        if (r < I_UKV) { transpose_item(a.w_ukv + (size_t)l * 128 * 1024, 1024, 128, (bf16*)(X.ws + WS_WUKV) + (size_t)l * 1024 * 256, 256, 64 * (r / 32), 32 * (r % 32), ColAdj{}, a.kvn + l * 128, scr, X.lane); continue; }
        r -= I_UKV;
        transpose_item(a.w_o + (size_t)l * DM * DM, DM, DM, (bf16*)(X.ws + WS_WO) + (size_t)l * DM * DM, DM, 64 * (r / 32), 32 * (r % 32), ColAdj{}, nullptr, scr, X.lane);
    }
    const size_t gt = (size_t)X.vcu * 512 + X.tid, NGT = (size_t)X.G * 512;
    { float* rgt = (float*)(X.ws + WS_RGT); float* ret = (float*)(X.ws + WS_RET);
      for (size_t i = gt; i < (size_t)DEPTH * 4 * DM; i += NGT) { const int l = (int)(i / (4 * DM)), g = (int)(i / DM) & 3, k = (int)(i % DM); rgt[i] = a.rgw[((size_t)l * DM + k) * 4 + g]; }
      for (size_t i = gt; i < (size_t)DEPTH * 32 * DM; i += NGT) { const int l = (int)(i / (32 * DM)), ge = (int)(i / DM) & 31, k = (int)(i % DM); ret[i] = a.rew[(((size_t)l * 4 + (ge >> 3)) * DM + k) * 8 + (ge & 7)]; } }
    { u32x4* z = (u32x4*)(X.ws + WS_T1); for (size_t i = gt; i < (size_t)NT * 256 * 2 / 16; i += NGT) z[i] = (u32x4){0u, 0u, 0u, 0u}; }
    { const f32x4* xs = (const f32x4*)a.x; u32x2* xb = (u32x2*)(X.ws + WS_XB);
      for (size_t i = gt; i < (size_t)NT * DM / 4; i += NGT) { const f32x4 v = xs[i]; u32x2 w; w.x = pk2(v[0], v[1]); w.y = pk2(v[2], v[3]); xb[i] = w; } }
}
__device__ __forceinline__ void convert_experts(const Ctx& X, const CArgs* ap, int l) {
    struct { const float *wg, *wu, *wd; } a = {ap->wg, ap->wu, ap->wd};
    LAS float* scr = (LAS float*)(X.lds + X.wave * 16384);
    const int gw = X.vcu * 8 + X.wave, NGW = X.G * 8;
    constexpr int I_GU = 32 * 16 * 16, I_D = 32 * 4 * 32;
    for (int it = gw; it < I_GU + I_D; it += NGW) {
        if (it < I_GU) { const int e = it >> 8, r = it & 255, G32 = r >> 4, kb = r & 15; const int pn = G32 >> 3, r0 = (G32 & 7) * 32; const bool up = r0 >= 128;
            const float* W = (up ? a.wu : a.wg) + ((size_t)l * NEXP + e) * DM * FH;
            transpose_item(W, FH, DM, (bf16*)(X.ws + WS_WGU) + (size_t)e * 512 * DM, DM, 64 * kb, 32 * G32, ColIdent{128 * pn + (r0 & 127) - 32 * G32}, nullptr, scr, X.lane);
        } else { const int r = it - I_GU, e = r >> 7, q = r & 127, kb = q >> 5, pg = q & 31;
            transpose_item(a.wd + ((size_t)l * NEXP + e) * FH * DM, DM, FH, (bf16*)(X.ws + WS_WD) + (size_t)e * DM * FH, FH, 64 * kb, 32 * pg, ColAdj{}, nullptr, scr, X.lane); }
    }
}

struct InProjDesc {
    unsigned char* ws;
    __device__ __forceinline__ pg8::GroupDesc operator()(int pn, int bj, int wc) const {
        using namespace pg8; const int G = 8 * pn + 4 * bj + wc; GroupDesc d; d.kind = GK_PLAIN; d.dst = nullptr; d.pitch = 256; d.col = 0; d.scale = 1.f; d.perm = 0; d.ssq = nullptr; d.ssq_n = 0; d.ssq_i = 0;
        if (G < 8) { d.dst = (bf16*)(ws + WS_CQ); d.col = 32 * G; d.ssq = (float*)(ws + WS_SSQ); d.ssq_n = 8; d.ssq_i = G; }
        else if (G < 12) { d.dst = (bf16*)(ws + WS_T1); d.col = 32 * (G - 8); d.ssq = (float*)(ws + WS_SSQ) + (size_t)NT * 8; d.ssq_n = 4; d.ssq_i = G - 8; }
        else if (G == 12) { d.kind = GK_ROPE32; d.dst = (bf16*)(ws + WS_KPE); d.pitch = 32; d.col = 0; }
        else if (G == 13) { d.kind = GK_IDX8; d.dst = (bf16*)(ws + WS_KI); d.pitch = 32; d.col = 0; }
        else if (G == 14) { d.kind = GK_HEAD16; d.dst = (bf16*)(ws + WS_T1); d.col = 192; }
        else if (G == 15) { d.dst = (bf16*)(ws + WS_T1); d.col = 224; }
        else if (G < 24) { d.kind = ((G - 16) & 1) ? GK_PLAIN : GK_HEAD16; d.dst = (bf16*)(ws + WS_BQ); d.col = 32 * (G - 16); d.scale = QSC64; }
        else if (G < 26) { d.dst = (bf16*)(ws + WS_BV); d.pitch = 64; d.col = 32 * (G - 24); }
        else if (G == 26) { d.kind = GK_WI; d.dst = (bf16*)(ws + WS_WI); }
        else if (G < 32) { d.kind = GK_SKIP; }
        else if (G < 40) { d.kind = GK_IDX8; d.dst = (bf16*)(ws + WS_BQI); d.col = 32 * (G - 32); }
        else if (G < 64) { const int j = G - 40, cfg = j >> 3; d.kind = (j & 1) ? GK_PLAIN : GK_HEAD16; d.dst = (bf16*)(ws + WS_DQ) + (size_t)cfg * NT * 256; d.col = 32 * (j & 7); d.scale = QSC64; d.perm = cfg == 0 ? 0 : (cfg == 1 ? 4 : 16); }
        else if (G < 88) { const int j = G - 64, cfg = j >> 3; d.kind = (j & 1) ? GK_PLAIN : GK_HEAD16; d.dst = (bf16*)(ws + WS_DK) + (size_t)cfg * NT * 256; d.col = 32 * (j & 7); d.perm = cfg == 0 ? 0 : (cfg == 1 ? 4 : 16); }
        else { const int j = G - 88, cfg = j >> 3; d.dst = (bf16*)(ws + WS_DV) + (size_t)cfg * NT * 256; d.col = 32 * (j & 7); d.perm = cfg == 0 ? 0 : (cfg == 1 ? 4 : 16); }
        return d;
    }
};
struct UqDesc {
    unsigned char* ws;
    __device__ __forceinline__ pg8::GroupDesc operator()(int pn, int bj, int wc) const {
        using namespace pg8; const int G = 8 * pn + 4 * bj + wc; GroupDesc d; d.kind = (G % 3 == 2) ? GK_ROPE32 : GK_PLAIN; d.dst = (bf16*)(ws + WS_QA); d.pitch = 768; d.col = 32 * G; d.scale = QSC96; d.perm = 0; d.ssq = nullptr; d.ssq_n = 0; d.ssq_i = 0;
        return d;
    }
};

__device__ __forceinline__ unsigned f16key(float v) { const _Float16 hf = (_Float16)v; const unsigned u = (unsigned)__builtin_bit_cast(unsigned short, hf); return (u & 0x8000u) ? (~u & 0xffffu) : (u | 0x8000u); }
__device__ __forceinline__ unsigned pk_cnt(unsigned acc, unsigned kp2, unsigned mid2, unsigned one2) {
    unsigned t;
    asm("v_pk_sub_u16 %0, %2, %3 clamp\n\tv_pk_min_u16 %0, %0, %4\n\tv_pk_add_u16 %1, %1, %0" : "=&v"(t), "+v"(acc) : "v"(kp2), "s"(mid2), "s"(one2));
    return acc;
}
__device__ __forceinline__ int count_gt(const unsigned (&kp)[16], unsigned mid) {
    const unsigned m2 = __builtin_amdgcn_readfirstlane(mid | (mid << 16)), one2 = __builtin_amdgcn_readfirstlane(0x00010001u);
    unsigned a0 = 0u, a1 = 0u;
#pragma unroll
    for (int i = 0; i < 16; i += 2) { a0 = pk_cnt(a0, kp[i], m2, one2); a1 = pk_cnt(a1, kp[i + 1], m2, one2); }
    unsigned aw; asm("v_pk_add_u16 %0, %1, %2" : "=v"(aw) : "v"(a0), "v"(a1));
    const unsigned c = (aw & 0xffffu) + (aw >> 16);
    int tot = 0;
#pragma unroll
    for (int b = 0; b < 6; ++b) tot += __builtin_popcountll(__ballot((c >> b) & 1u)) << b;
    return tot;
}
__device__ __forceinline__ void radix_pick(const LAS unsigned* hist, int lane, int target, int& B, int& above, int& inbin) {
    const u32x2 hw = *(const LAS u32x2*)(hist + 2 * lane);
    const int c0 = (int)(hw.x & 0xffffu), c1 = (int)(hw.x >> 16), c2 = (int)(hw.y & 0xffffu), c3 = (int)(hw.y >> 16);
    const int tl = (c0 + c1) + (c2 + c3);
    int suf = tl;
#pragma unroll
    for (int o = 1; o < 64; o <<= 1) { const int dn = __shfl_down(suf, o); if (lane + o < 64) suf += dn; }
    const unsigned long long reach = __ballot(suf >= target);
    const int ls = 63 - __builtin_clzll(reach | 1ull);
    int a = suf - tl, b = 4 * lane + 3, ib = c3;
    if (a + c3 < target) { a += c3; b = 4 * lane + 2; ib = c2; if (a + c2 < target) { a += c2; b = 4 * lane + 1; ib = c1; if (a + c1 < target) { a += c1; b = 4 * lane; ib = c0; } } }
    B = __builtin_amdgcn_readlane(b, ls); above = __builtin_amdgcn_readlane(a, ls); inbin = __builtin_amdgcn_readlane(ib, ls);
}
__device__ __forceinline__ void dsa_index_unit(const Ctx& X, int b, int q0) {
    const int lane = X.lane, r = lane & 31, h = lane >> 5; const size_t seq0 = (size_t)b * SEQ; const int t0 = q0 + 4 * X.wave;
    const bf16* BQI = (const bf16*)(X.ws + WS_BQI); const bf16* KI = (const bf16*)(X.ws + WS_KI); const float* WI = (const float*)(X.ws + WS_WI);
    LAS unsigned short* rows = (LAS unsigned short*)(X.lds + X.wave * 16384);
    LAS unsigned char* kbuf = X.lds + LDS_X_OFF;
    const bf16* ap = BQI + (seq0 + t0 + (r >> 3)) * 256 + 32 * (r & 7) + 16 * h;
    const bf16x8 a0 = *(const bf16x8*)ap, a1 = *(const bf16x8*)(ap + 8);
    float wq[4][4];
#pragma unroll
    for (int j = 0; j < 4; ++j) { const f32x4 w = *(const f32x4*)(WI + (seq0 + t0 + j) * 8 + 4 * h);
#pragma unroll
        for (int ii = 0; ii < 4; ++ii) wq[j][ii] = w[ii] * IDX_SCALE; }
    const int nch = ((q0 + 31) >> 7) + 1;
    const int skey = X.tid >> 2, spc = X.tid & 3;
    const bf16* sp = KI + (seq0 + skey) * 32 + 8 * spc;
    const int sdst = skey * 64 + ((spc ^ ((skey >> 2) & 3)) << 4);
    u32x4 stg0 = *(const u32x4*)sp, stg1 = stg0, stg2 = stg0, stg3 = stg0;
    if (1 < nch) stg1 = *(const u32x4*)(sp + (size_t)1 * 128 * 32);
    if (2 < nch) stg2 = *(const u32x4*)(sp + (size_t)2 * 128 * 32);
    if (3 < nch) stg3 = *(const u32x4*)(sp + (size_t)3 * 128 * 32);
    *(LAS u32x4*)(kbuf + sdst) = stg0;
    __syncthreads();
#define DSA_STEP(J, RCUR, RNEXT) { const int c = c0 + (J); \
        if (c + 4 < nch) RCUR = *(const u32x4*)(sp + (size_t)(c + 4) * 128 * 32); \
        const LAS unsigned char* kb = kbuf + (c & 1) * 8192; \
        _Pragma("unroll") for (int tq = 0; tq < 4; ++tq) { \
            const int key = 32 * tq + r, sw = (key >> 2) & 3; \
            const bf16x8 b0 = *(const LAS bf16x8*)(kb + key * 64 + (((2 * h) ^ sw) << 4)), b1 = *(const LAS bf16x8*)(kb + key * 64 + (((2 * h + 1) ^ sw) << 4)); \
            f32x16 acc; \
            _Pragma("unroll") for (int i = 0; i < 16; ++i) acc[i] = 0.f; \
            acc = __builtin_amdgcn_mfma_f32_32x32x16_bf16(a0, b0, acc, 0, 0, 0); \
            acc = __builtin_amdgcn_mfma_f32_32x32x16_bf16(a1, b1, acc, 0, 0, 0); \
            float p[4]; \
            _Pragma("unroll") for (int j = 0; j < 4; ++j) { float pp = 0.f; \
                _Pragma("unroll") for (int ii = 0; ii < 4; ++ii) pp += wq[j][ii] * fmaxf(acc[4 * j + ii], 0.f); \
                p[j] = pp; } \
            const auto s01 = __builtin_amdgcn_permlane32_swap(__float_as_uint(p[0]), __float_as_uint(p[1]), false, false); \
            const auto s23 = __builtin_amdgcn_permlane32_swap(__float_as_uint(p[2]), __float_as_uint(p[3]), false, false); \
            const float va = __uint_as_float(s01[0]) + __uint_as_float(s01[1]), vb = __uint_as_float(s23[0]) + __uint_as_float(s23[1]); \
            const int hw = 128 * c + 32 * tq + r;                                      \
            rows[h * 2048 + hw] = (unsigned short)f16key(va); \
            rows[(2 + h) * 2048 + hw] = (unsigned short)f16key(vb); \
        } \
        if (c + 1 < nch) *(LAS u32x4*)(kbuf + ((c + 1) & 1) * 8192 + sdst) = RNEXT; \
        __syncthreads(); }
#ifndef REP_SCORE
#define REP_SCORE 1
#endif
#ifndef REP_SEL
#define REP_SEL 1
#endif
    for (int rsc = 0; rsc < REP_SCORE; ++rsc) {
    if (rsc > 0) { stg0 = *(const u32x4*)sp; stg1 = stg0; stg2 = stg0; stg3 = stg0; if (1 < nch) stg1 = *(const u32x4*)(sp + (size_t)1 * 128 * 32); if (2 < nch) stg2 = *(const u32x4*)(sp + (size_t)2 * 128 * 32); if (3 < nch) stg3 = *(const u32x4*)(sp + (size_t)3 * 128 * 32); *(LAS u32x4*)(kbuf + sdst) = stg0; __syncthreads(); }
    for (int c0 = 0; c0 < nch; c0 += 4) {
        DSA_STEP(0, stg0, stg1)
        if (c0 + 1 >= nch) break;
        DSA_STEP(1, stg1, stg2)
        if (c0 + 2 >= nch) break;
        DSA_STEP(2, stg2, stg3)
        if (c0 + 3 >= nch) break;
        DSA_STEP(3, stg3, stg0)
    }
    }
#undef DSA_STEP
    unsigned* BMp = (unsigned*)(X.ws + WS_BM);
#ifndef REP_BIS
#define REP_BIS 1
#endif
#ifndef REP_EMIT
#define REP_EMIT 1
#endif
    for (int rsl = 0; rsl < REP_SEL; ++rsl)
    for (int j = 0; j < 4; ++j) {
        const int t = t0 + j;
        const LAS u32x4* rw = (const LAS u32x4*)(rows + j * 2048) + 4 * lane;
        unsigned kp[16];
#pragma unroll
        for (int v4 = 0; v4 < 4; ++v4) { const u32x4 d = rw[v4]; kp[4 * v4] = d.x; kp[4 * v4 + 1] = d.y; kp[4 * v4 + 2] = d.z; kp[4 * v4 + 3] = d.w; }
        const int nv = t + 1 - 32 * lane;
#pragma unroll
        for (int d = 0; d < 16; ++d) kp[d] &= ((2 * d < nv) ? 0xffffu : 0u) | ((2 * d + 1 < nv) ? 0xffff0000u : 0u);
        unsigned thr = 0u; int need = 0;
        for (int rb_ = 0; rb_ < REP_BIS; ++rb_)
        if (t + 1 > 256) {
            LAS unsigned* hist = (LAS unsigned*)(X.lds + LDS_HIST_OFF + X.wave * 512);
            *(LAS u32x2*)(hist + 2 * lane) = (u32x2){0u, 0u};
#pragma unroll
            for (int d = 0; d < 16; ++d) { const unsigned klo = kp[d] & 0xffffu, khi = kp[d] >> 16;
                if (klo) __hip_atomic_fetch_add(hist + (klo >> 9), (klo & 0x100u) ? 0x10000u : 1u, __ATOMIC_RELAXED, __HIP_MEMORY_SCOPE_WORKGROUP);
                if (khi) __hip_atomic_fetch_add(hist + (khi >> 9), (khi & 0x100u) ? 0x10000u : 1u, __ATOMIC_RELAXED, __HIP_MEMORY_SCOPE_WORKGROUP); }
            int B1, above1, in1; radix_pick(hist, lane, 256, B1, above1, in1);
            *(LAS u32x2*)(hist + 2 * lane) = (u32x2){0u, 0u};
#pragma unroll
            for (int d = 0; d < 16; ++d) { const unsigned klo = kp[d] & 0xffffu, khi = kp[d] >> 16;
                if ((int)(klo >> 8) == B1) __hip_atomic_fetch_add(hist + ((klo & 0xffu) >> 1), (klo & 1u) ? 0x10000u : 1u, __ATOMIC_RELAXED, __HIP_MEMORY_SCOPE_WORKGROUP);
                if ((int)(khi >> 8) == B1) __hip_atomic_fetch_add(hist + ((khi & 0xffu) >> 1), (khi & 1u) ? 0x10000u : 1u, __ATOMIC_RELAXED, __HIP_MEMORY_SCOPE_WORKGROUP); }
            int B2, above2, in2; radix_pick(hist, lane, 256 - above1, B2, above2, in2);
            const unsigned tk = ((unsigned)B1 << 8) | (unsigned)B2;
            const int rest = 256 - (above1 + above2);
            if (rest >= in2) { thr = tk - 1u; need = 0; } else { thr = tk; need = rest; }
        }
        unsigned word = 0u, eqw = 0u;
        const unsigned thr2 = __builtin_amdgcn_readfirstlane(thr | (thr << 16)), one2 = __builtin_amdgcn_readfirstlane(0x00010001u);
#pragma unroll
        for (int d = 0; d < 16; ++d) { unsigned g;
            asm("v_pk_sub_u16 %0, %1, %2 clamp\n\tv_pk_min_u16 %0, %0, %3" : "=&v"(g) : "v"(kp[d]), "s"(thr2), "s"(one2));
            word |= ((g | (g >> 15)) & 3u) << (2 * d); }
        if (need > 0) {
#pragma unroll
            for (int d = 0; d < 16; ++d) { unsigned g; const unsigned x = kp[d] ^ thr2;
                asm("v_pk_min_u16 %0, %1, %2" : "=v"(g) : "v"(x), "s"(one2));
                eqw |= ((~(g | (g >> 15))) & 3u) << (2 * d); }
            if (thr == 0u) eqw = 0u;
            const int ne = __builtin_popcount(eqw); int inc = ne;
#pragma unroll
            for (int o = 1; o < 64; o <<= 1) { const int up = __shfl_up(inc, o); if (lane >= o) inc += up; }
            int take = need - (inc - ne); take = take < 0 ? 0 : (take > ne ? ne : take);
            while (__any(take > 0)) { if (take > 0) { const unsigned lowbit = eqw & (0u - eqw); word |= lowbit; eqw ^= lowbit; --take; } }
        }
        BMp[(seq0 + t) * 64 + lane] = word;
    }
}

__device__ __forceinline__ void dil_combine(const Ctx& X) {
    const bf16* OD = (const bf16*)(X.ws + WS_OD); const float* LS = (const float*)(X.ws + WS_LSE); bf16* O = (bf16*)(X.ws + WS_XB);
    const int gw = X.vcu * 8 + X.wave, NGW = X.G * 8, lane = X.lane, hh = lane >> 4;
    for (int t = gw; t < NT; t += NGW) {
        const int b = t >> 11, s = t & 2047;
        const int r0 = t, r1 = (b << 11) + ((s & 3) << 9) + (s >> 2), r2 = (b << 11) + ((s & 15) << 7) + (s >> 4);
        const float L0 = LS[(size_t)r0 * 4 + hh], L1 = LS[((size_t)NT + r1) * 4 + hh], L2 = LS[((size_t)2 * NT + r2) * 4 + hh];
        const float mx = fmaxf(L0, fmaxf(L1, L2));
        float w0 = __builtin_amdgcn_exp2f(L0 - mx), w1 = __builtin_amdgcn_exp2f(L1 - mx), w2 = __builtin_amdgcn_exp2f(L2 - mx);
        const float inv = 1.0f / (w0 + w1 + w2); w0 *= inv; w1 *= inv; w2 *= inv;
        const u32x2 a = *(const u32x2*)(OD + (size_t)r0 * 256 + 4 * lane), bq = *(const u32x2*)(OD + ((size_t)NT + r1) * 256 + 4 * lane), cq = *(const u32x2*)(OD + ((size_t)2 * NT + r2) * 256 + 4 * lane);
        u32x2 o;
        o.x = pk2(w0 * bflo(a.x) + w1 * bflo(bq.x) + w2 * bflo(cq.x), w0 * bfhi(a.x) + w1 * bfhi(bq.x) + w2 * bfhi(cq.x));
        o.y = pk2(w0 * bflo(a.y) + w1 * bflo(bq.y) + w2 * bflo(cq.y), w0 * bfhi(a.y) + w1 * bfhi(bq.y) + w2 * bfhi(cq.y));
        stg8<NT_ATT>(O + (size_t)t * DM + 768 + 4 * lane, o);
    }
}

__device__ __forceinline__ void ln1_router(const Ctx& X, const CArgs* ap, int l, bool first, bool dummy = false) {
    struct { const float *ln1g, *ln1b, *rgb, *reb; float* out; } a = {ap->ln1g, ap->ln1b, ap->rgb, ap->reb, dummy ? (float*)(X.ws + WS_QA) : ap->out}; const float* xin = first ? ap->x : ap->out;
    const int lane = X.lane; const bf16* MIX = (const bf16*)(X.ws + WS_MIX); bf16* X1B = (bf16*)(X.ws + (dummy ? WS_Y : WS_XB));
    LAS float* reT = (LAS float*)X.lds;
    LAS float* rgT = (LAS float*)(X.lds + LDS_X_OFF);
    LAS int* hist = (LAS int*)(X.lds + LDSCTL_OFF + 256);
    { const u32x4* s1 = (const u32x4*)(X.ws + WS_RET + (size_t)l * 32 * DM * 4); for (int i = X.tid; i < 32 * DM / 4; i += 512) ((LAS u32x4*)reT)[i] = s1[i];
      const u32x4* s2 = (const u32x4*)(X.ws + WS_RGT + (size_t)l * 4 * DM * 4); for (int i = X.tid; i < 4 * DM / 4; i += 512) ((LAS u32x4*)rgT)[i] = s2[i]; }
    f32x4 g[4], bb[4];
#pragma unroll
    for (int j = 0; j < 4; ++j) { g[j] = *(const f32x4*)(a.ln1g + l * DM + 4 * lane + 256 * j); bb[j] = *(const f32x4*)(a.ln1b + l * DM + 4 * lane + 256 * j); }
    const float* rgb = a.rgb + l * 4; const float* reb = a.reb + l * 32;
    for (int rb = X.c; rb < NT / 256; rb += X.G) {
        if (X.tid < 32) hist[X.tid] = 0;
        __syncthreads();
        f32x4 xn[4]; u32x2 mn[4];
        { const int t = rb * 256 + X.wave * 32;
#pragma unroll
          for (int j = 0; j < 4; ++j) { xn[j] = *(const f32x4*)(xin + (size_t)t * DM + 4 * lane + 256 * j); mn[j] = *(const u32x2*)(MIX + (size_t)t * DM + 4 * lane + 256 * j); } }
        for (int i = 0; i < 32; ++i) {
            const int t = rb * 256 + X.wave * 32 + i;
            f32x4 v[4]; float s = 0.f;
#pragma unroll
            for (int j = 0; j < 4; ++j) { const f32x4 xv = xn[j]; const u32x2 mw = mn[j];
                v[j][0] = ALPHA * xv[0] + bflo(mw.x); v[j][1] = ALPHA * xv[1] + bfhi(mw.x); v[j][2] = ALPHA * xv[2] + bflo(mw.y); v[j][3] = ALPHA * xv[3] + bfhi(mw.y);
                s += (v[j][0] + v[j][1]) + (v[j][2] + v[j][3]); }
            if (i + 1 < 32) {
#pragma unroll
                for (int j = 0; j < 4; ++j) { xn[j] = *(const f32x4*)(xin + (size_t)(t + 1) * DM + 4 * lane + 256 * j); mn[j] = *(const u32x2*)(MIX + (size_t)(t + 1) * DM + 4 * lane + 256 * j); } }
            const float mean = wave_sum(s) * (1.f / DM); float s2 = 0.f;
#pragma unroll
            for (int j = 0; j < 4; ++j) { v[j] = v[j] - mean; s2 += (v[j][0] * v[j][0] + v[j][1] * v[j][1]) + (v[j][2] * v[j][2] + v[j][3] * v[j][3]); }
            const float rstd = 1.0f / sqrtf(wave_sum(s2) * (1.f / DM) + 1e-5f);
#pragma unroll
            for (int j = 0; j < 4; ++j) { v[j] = v[j] * rstd * g[j] + bb[j];
                u32x2 w; w.x = pk2(v[j][0], v[j][1]); w.y = pk2(v[j][2], v[j][3]); stg8<NT_LN>(X1B + (size_t)t * DM + 4 * lane + 256 * j, w); }
            float lg[4];
#pragma unroll
            for (int gi = 0; gi < 4; ++gi) { float p = 0.f;
#pragma unroll
                for (int j = 0; j < 4; ++j) { const f32x4 w = *(const LAS f32x4*)(rgT + gi * DM + 4 * lane + 256 * j); p += (v[j][0] * w[0] + v[j][1] * w[1]) + (v[j][2] * w[2] + v[j][3] * w[3]); }
                lg[gi] = wave_sum(p) + rgb[gi]; }
            int gs = 0; float gm = lg[0];
#pragma unroll
            for (int gi = 1; gi < 4; ++gi) if (lg[gi] > gm) { gm = lg[gi]; gs = gi; }
            float den = 0.f;
#pragma unroll
            for (int gi = 0; gi < 4; ++gi) den += __expf(lg[gi] - gm);
            const float ptop = 1.0f / den;
            gs = __builtin_amdgcn_readfirstlane(gs);
            float le[8];
#pragma unroll
            for (int e = 0; e < 8; ++e) { float p = 0.f;
#pragma unroll
                for (int j = 0; j < 4; ++j) { const f32x4 w = *(const LAS f32x4*)(reT + (gs * 8 + e) * DM + 4 * lane + 256 * j); p += (v[j][0] * w[0] + v[j][1] * w[1]) + (v[j][2] * w[2] + v[j][3] * w[3]); }
                le[e] = wave_sum(p) + reb[gs * 8 + e]; }
            int e1 = 0; float v1 = le[0];
#pragma unroll
            for (int e = 1; e < 8; ++e) if (le[e] > v1) { v1 = le[e]; e1 = e; }
            int e2 = -1; float v2 = -INFINITY;
#pragma unroll
            for (int e = 0; e < 8; ++e) if (e != e1 && le[e] > v2) { v2 = le[e]; e2 = e; }
            const float wa = 1.0f / (1.0f + __expf(v2 - v1)), wb = 1.0f - wa;
            if (lane == 0) { u32x4 ro; ro.x = (unsigned)(gs * 8 + e1); ro.y = (unsigned)(gs * 8 + e2); ro.z = __builtin_bit_cast(unsigned, ptop * wa); ro.w = __builtin_bit_cast(unsigned, ptop * wb);
                *(u32x4*)(X.ws + WS_ROUTE + (size_t)t * 16) = ro;
                __hip_atomic_fetch_add(hist + gs * 8 + e1, 1, __ATOMIC_RELAXED, __HIP_MEMORY_SCOPE_WORKGROUP); __hip_atomic_fetch_add(hist + gs * 8 + e2, 1, __ATOMIC_RELAXED, __HIP_MEMORY_SCOPE_WORKGROUP); }
        }
        __syncthreads();
        if (X.tid < 32) ((int*)(X.ws + WS_HIST))[rb * 32 + X.tid] = hist[X.tid];
        __syncthreads();
    }
}

__device__ __forceinline__ void moe_dispatch(const Ctx& X) {
    LAS int* cnt = (LAS int*)(X.lds);
    LAS int* pre = cnt + 32;
    LAS int* ebase = cnt + 64;
    LAS int* wcnt = cnt + 128;
    const int* HIST = (const int*)(X.ws + WS_HIST); int* STOK = (int*)(X.ws + WS_STOK); float* SW = (float*)(X.ws + WS_SW); int* TSLOT = (int*)(X.ws + WS_TSLOT); int* TILEE = (int*)(X.ws + WS_TILEE);
    for (int rb = X.c; rb < NT / 256; rb += X.G) {
        if (X.tid < 64) cnt[X.tid] = 0;
        __syncthreads();
        { const int e = X.tid & 31, part = X.tid >> 5; int sa = 0, sp = 0;
          for (int q = 0; q < 16; ++q) { const int b2 = part * 16 + q; const int hv = HIST[b2 * 32 + e]; sa += hv; if (b2 < rb) sp += hv; }
          __hip_atomic_fetch_add(cnt + e, sa, __ATOMIC_RELAXED, __HIP_MEMORY_SCOPE_WORKGROUP); __hip_atomic_fetch_add(pre + e, sp, __ATOMIC_RELAXED, __HIP_MEMORY_SCOPE_WORKGROUP); }
        __syncthreads();
        if (X.tid < 64) { const int n = X.tid < 32 ? cnt[X.tid] : 0; const int pad = (n + 255) & ~255; int inc = pad;
#pragma unroll
            for (int o = 1; o < 32; o <<= 1) { const int u = __shfl_up(inc, o); if ((X.tid & 63) >= o) inc += u; }
            if (X.tid < 32) { ebase[X.tid] = inc - pad; if (X.tid == 31) ebase[32] = inc; } }
        __syncthreads();
        const int tl = X.tid >> 1, kk = X.tid & 1, t = rb * 256 + tl;
        const u32x4 ro = *(const u32x4*)(X.ws + WS_ROUTE + (size_t)t * 16);
        const int e = (int)(kk ? ro.y : ro.x); const float w = __builtin_bit_cast(float, kk ? ro.w : ro.z);
        int rank = 0;
        for (int ee = 0; ee < 32; ++ee) { const unsigned long long mm = __ballot(e == ee);
            if (e == ee) rank = __builtin_popcountll(mm & ((1ull << X.lane) - 1ull));
            if (X.lane == 0) wcnt[X.wave * 32 + ee] = __builtin_popcountll(mm); }
        __syncthreads();
        int off = 0;
        for (int w2 = 0; w2 < X.wave; ++w2) off += wcnt[w2 * 32 + e];
        const int slot = ebase[e] + pre[e] + off + rank;
        STOK[slot] = t; SW[slot] = w; TSLOT[2 * t + kk] = slot;
        if (rb < 32) { const int e2 = rb; for (int s = ebase[e2] + cnt[e2] + X.tid; s < ebase[e2 + 1]; s += 512) { STOK[s] = 0; SW[s] = 0.f; } }
        if (rb == 0) { const int ntl = ebase[32] >> 8;
            for (int tile = X.tid; tile < ntl; tile += 512) { int ee = 0; while (ee < 31 && ebase[ee + 1] <= tile * 256) ++ee; TILEE[tile] = ee; }
            if (X.tid == 0) TILEE[1024] = ntl; }
        __syncthreads();
    }
}

__device__ __forceinline__ void ln2_phase(const Ctx& X, const CArgs* ap, int l, bool first, bool dummy = false) {
    struct { const float *ln1g, *ln1b, *ln2g, *ln2b; } a = {ap->ln1g, ap->ln1b, ap->ln2g, ap->ln2b}; float* outw = dummy ? (float*)(X.ws + WS_Y + 272 * MiB) : ap->out;
    const float* xin = first ? ap->x : ap->out;
    const int lane = X.lane; const bf16* Y = (const bf16*)(X.ws + WS_Y); const bf16* MIX = (const bf16*)(X.ws + WS_MIX); const int* TSLOT = (const int*)(X.ws + WS_TSLOT); bf16* XBp = (bf16*)(X.ws + (dummy ? WS_MIX : WS_XB));
    f32x4 g1[4], b1[4], g[4], bb[4];
#pragma unroll
    for (int j = 0; j < 4; ++j) { g1[j] = *(const f32x4*)(a.ln1g + l * DM + 4 * lane + 256 * j); b1[j] = *(const f32x4*)(a.ln1b + l * DM + 4 * lane + 256 * j);
        g[j] = *(const f32x4*)(a.ln2g + l * DM + 4 * lane + 256 * j); bb[j] = *(const f32x4*)(a.ln2b + l * DM + 4 * lane + 256 * j); }
    for (int rb = X.c; rb < NT / 256; rb += X.G) {
        const int tb = rb * 256 + X.wave * 32;
        const int myslots_a = TSLOT[2 * (tb + (lane & 31))], myslots_b = TSLOT[2 * (tb + (lane & 31)) + 1];
        f32x4 xn[4]; u32x2 mn[4], yan[4], ybn[4];
        { const int sa = __builtin_amdgcn_readlane(myslots_a, 0), sb = __builtin_amdgcn_readlane(myslots_b, 0);
#pragma unroll
          for (int j = 0; j < 4; ++j) { xn[j] = *(const f32x4*)(xin + (size_t)tb * DM + 4 * lane + 256 * j); mn[j] = *(const u32x2*)(MIX + (size_t)tb * DM + 4 * lane + 256 * j);
              yan[j] = *(const u32x2*)(Y + (size_t)sa * DM + 4 * lane + 256 * j); ybn[j] = *(const u32x2*)(Y + (size_t)sb * DM + 4 * lane + 256 * j); } }
        for (int i = 0; i < 32; ++i) {
            const int t = tb + i;
            f32x4 v[4]; float s = 0.f;
#pragma unroll
            for (int j = 0; j < 4; ++j) { const f32x4 xv = xn[j]; const u32x2 mw = mn[j];
                v[j][0] = ALPHA * xv[0] + bflo(mw.x); v[j][1] = ALPHA * xv[1] + bfhi(mw.x); v[j][2] = ALPHA * xv[2] + bflo(mw.y); v[j][3] = ALPHA * xv[3] + bfhi(mw.y);
                s += (v[j][0] + v[j][1]) + (v[j][2] + v[j][3]); }
            u32x2 ya[4], yb[4];
#pragma unroll
            for (int j = 0; j < 4; ++j) { ya[j] = yan[j]; yb[j] = ybn[j]; }
            if (i + 1 < 32) { const int sa = __shfl(myslots_a, i + 1), sb = __shfl(myslots_b, i + 1);
#pragma unroll
                for (int j = 0; j < 4; ++j) { xn[j] = *(const f32x4*)(xin + (size_t)(t + 1) * DM + 4 * lane + 256 * j); mn[j] = *(const u32x2*)(MIX + (size_t)(t + 1) * DM + 4 * lane + 256 * j);
                    yan[j] = *(const u32x2*)(Y + (size_t)sa * DM + 4 * lane + 256 * j); ybn[j] = *(const u32x2*)(Y + (size_t)sb * DM + 4 * lane + 256 * j); } }
            { const float mean = wave_sum(s) * (1.f / DM); float s2 = 0.f;
#pragma unroll
              for (int j = 0; j < 4; ++j) { v[j] = v[j] - mean; s2 += (v[j][0] * v[j][0] + v[j][1] * v[j][1]) + (v[j][2] * v[j][2] + v[j][3] * v[j][3]); }
              const float rstd = 1.0f / sqrtf(wave_sum(s2) * (1.f / DM) + 1e-5f);
#pragma unroll
              for (int j = 0; j < 4; ++j) v[j] = v[j] * rstd * g1[j] + b1[j]; }
            s = 0.f;
#pragma unroll
            for (int j = 0; j < 4; ++j) { const f32x4 xv = v[j];
                v[j][0] = ALPHA * xv[0] + (bflo(ya[j].x) + bflo(yb[j].x)); v[j][1] = ALPHA * xv[1] + (bfhi(ya[j].x) + bfhi(yb[j].x)); v[j][2] = ALPHA * xv[2] + (bflo(ya[j].y) + bflo(yb[j].y)); v[j][3] = ALPHA * xv[3] + (bfhi(ya[j].y) + bfhi(yb[j].y));
                s += (v[j][0] + v[j][1]) + (v[j][2] + v[j][3]); }
            const float mean = wave_sum(s) * (1.f / DM); float s2 = 0.f;
#pragma unroll
            for (int j = 0; j < 4; ++j) { v[j] = v[j] - mean; s2 += (v[j][0] * v[j][0] + v[j][1] * v[j][1]) + (v[j][2] * v[j][2] + v[j][3] * v[j][3]); }
            const float rstd = 1.0f / sqrtf(wave_sum(s2) * (1.f / DM) + 1e-5f);
#pragma unroll
            for (int j = 0; j < 4; ++j) { v[j] = v[j] * rstd * g[j] + bb[j];
                stgf4<NT_LN>(outw + (size_t)t * DM + 4 * lane + 256 * j, v[j]);
                if (l + 1 < DEPTH) { u32x2 w; w.x = pk2(v[j][0], v[j][1]); w.y = pk2(v[j][2], v[j][3]); stg8<NT_LN>(XBp + (size_t)t * DM + 4 * lane + 256 * j, w); } }
        }
    }
}

#ifndef REP_P0
#define REP_P0 1
#endif
#ifndef REP_P5
#define REP_P5 1
#endif
#ifndef REP_P9
#define REP_P9 1
#endif
#ifndef REP_BAR
#define REP_BAR 1
#endif
#ifndef REP_P1
#define REP_P1 1
#endif
#ifndef REP_P2A
#define REP_P2A 1
#endif
#ifndef REP_P2B
#define REP_P2B 1
#endif
#ifndef REP_P2C
#define REP_P2C 1
#endif
#ifndef REP_P2D
#define REP_P2D 1
#endif
#ifndef REP_P3A
#define REP_P3A 1
#endif
#ifndef REP_P3B
#define REP_P3B 1
#endif
#ifndef REP_P3C
#define REP_P3C 1
#endif
#ifndef REP_P4
#define REP_P4 1
#endif
#ifndef REP_P6
#define REP_P6 1
#endif
#ifndef REP_P7
#define REP_P7 1
#endif
#ifndef REP_P8
#define REP_P8 1
#endif
__global__ void __launch_bounds__(512, 2) mk_fwd(Args a) {
    extern __shared__ __attribute__((aligned(16))) unsigned char lds_raw[];
    LAS unsigned char* const lds0 = (LAS unsigned char*)lds_raw;
    for (int u = threadIdx.x; u < (LDS_BYTES - LDSCTL_OFF) / 4; u += 512) ((LAS unsigned*)(lds0 + LDSCTL_OFF))[u] = 0u;
    __syncthreads();
    unsigned* barw = (unsigned*)(a.ws + WS_CTL) + CW_BAR;
    XcdBarrier bar; bar.bar = barw; bar.x = 0; bar.st = nullptr;
    if (a.use_bar) bar = xcd_barrier_post(barw, (volatile LAS unsigned*)(lds0 + LDSCTL_OFF) + 8);
#define MKCTX() Ctx X; const CArgs* ap = (const CArgs*)__builtin_amdgcn_kernarg_segment_ptr(); asm volatile("" : "+s"(ap)); { int t_ = threadIdx.x; asm volatile("" : "+v"(t_)); X.lds = lds0; X.tid = t_; X.lane = t_ & 63; X.wave = __builtin_amdgcn_readfirstlane(t_ >> 6); \
        unsigned char* w_ = ap->ws; X.G = gridDim.x; X.c = blockIdx.x; X.vcu = (X.G % 8 == 0) ? (X.c % 8) * (X.G / 8) + X.c / 8 : X.c; X.ws = w_; }
#ifndef P2M
#define P2M 31
#endif
#ifndef PH_MASK0
#define PH_MASK0 1
#endif
#define GBAR() do { if (a.use_bar) for (int rb_ = 0; rb_ < REP_BAR; ++rb_) xcd_barrier(bar); } while (0)

    if ((PH_MASK0 & 1) && a.l_lo == 0 && a.ph_lo == 0) { MKCTX(); for (int rep = 0; rep < REP_P0; ++rep) { prologue(X, ap); __syncthreads(); } GBAR(); }

    for (int l = a.l_lo; l < a.l_hi; ++l) {
        const int lo = (l == a.l_lo) ? (a.ph_lo < 1 ? 1 : a.ph_lo) : 1, hi = (l == a.l_hi - 1) ? a.ph_hi : 10;
#ifndef PH_MASK
#define PH_MASK 0x3ff
#endif
#define IN(k) (((PH_MASK >> (k)) & 1) && lo <= (k) && (k) < hi)
        if (IN(1)) { MKCTX();
            pg8::Gemm g{(const bf16*)(X.ws + WS_XB), (const bf16*)(X.ws + WS_WIN) + (size_t)l * NIN * DM, DM, nullptr};
            pg8::StaticOrder S; S.init(NT, NIN, X.G, X.c, REP_P1);
            pg8::RopeTabs R{ap->pos};
            pg8::EpiGroups<InProjDesc> E{InProjDesc{X.ws}, R, nullptr, 0, 0.f, 0.f};
            pg8::gemm_phase<pg8::EpiGroups<InProjDesc>, pg8::StaticOrder, false>(X.lds, g, S, E, X.tid);
            GBAR();
        }
        if (IN(2)) { MKCTX();
            {
                pg8::Gemm g{(const bf16*)(X.ws + WS_CQ), (const bf16*)(X.ws + WS_WUQ) + (size_t)l * 768 * 256, 256, nullptr};
                pg8::StaticOrder S; S.init(NT, 768, X.G, X.c, REP_P2A);
                pg8::RopeTabs R{ap->pos};
                pg8::EpiGroups<UqDesc> E{UqDesc{X.ws}, R, (const float*)(X.ws + WS_SSQ), 8, 1.0f / 256.0f, 1e-6f};
                pg8::gemm_phase<pg8::EpiGroups<UqDesc>, pg8::StaticOrder, false>(X.lds, g, S, E, X.tid);
            }
            {
                pg8::Gemm g{(const bf16*)(X.ws + WS_T1), (const bf16*)(X.ws + WS_WUKV) + (size_t)l * 1024 * 256, 256, nullptr};
                pg8::StaticOrder S; S.init(NT, 1024, X.G, X.c, REP_P2A);
                pg8::EpiPlain E{(bf16*)(X.ws + WS_KVA), 1024, (const float*)(X.ws + WS_SSQ) + (size_t)NT * 8, 4, 1.0f / 128.0f, 1e-6f, X.lds + LDS_X_OFF};
                pg8::gemm_phase<pg8::EpiPlain, pg8::StaticOrder, false>(X.lds, g, S, E, X.tid);
            }
            __syncthreads();
            for (int rep = 0; rep < REP_P2B; ++rep) convert_experts(X, ap, l);
            __syncthreads();
            for (int rep = 0; rep < REP_P2C; ++rep) for (int U = X.vcu; U < NB * 32; U += X.G) { const int b = U >> 5, pr = U & 31;
                dsa_index_unit(X, b, 32 * pr); dsa_index_unit(X, b, 32 * (63 - pr)); }
            __syncthreads();
#pragma unroll 1
            for (int cfg = 0; cfg < 3 * REP_P2D; ++cfg) { const int cfgi = cfg % 3;
                fa::Params P; const size_t co = (size_t)cfgi * NT * 256;
                P.Q = (const bf16*)(X.ws + WS_DQ) + co; P.q_pitch = 256; P.K1 = (const bf16*)(X.ws + WS_DK) + co; P.k1_pitch = 256; P.K2 = nullptr; P.k2_pitch = 0; P.k2_col = 0;
                P.V = (const bf16*)(X.ws + WS_DV) + co; P.v_pitch = 256; P.O = (bf16*)(X.ws + WS_OD) + co; P.o_pitch = 256; P.LSE = (float*)(X.ws + WS_LSE) + (size_t)cfgi * NT * 4; P.lse_pitch = 4; P.BM = nullptr;
                P.CL = cfgi == 0 ? 2048 : (cfgi == 1 ? 512 : 128); P.W = 128;
                for (int U = X.vcu; U < NB * 4 * 8; U += X.G) { const int bh = U >> 3, qb = U & 7, b = bh >> 2, hh = bh & 3;
                    P.k1_col = 64 * hh; P.v_col = 64 * hh;
                    const int q0 = 256 * qb; int klo = q0 & ~(P.CL - 1); if (q0 - 128 > klo) klo = q0 - 128;
                    fa::attn_unit<64, 0>(P, X.lds, X.tid, b * SEQ, q0 + 32 * X.wave, 64 * hh, 64 * hh, hh, klo >> 6, (q0 + 255) >> 6); }
            }
            GBAR();
        }
        if (IN(3)) { MKCTX();
            {   fa::Params P; P.Q = (const bf16*)(X.ws + WS_QA); P.q_pitch = 768; P.K1 = (const bf16*)(X.ws + WS_KVA); P.k1_pitch = 1024; P.K2 = (const bf16*)(X.ws + WS_KPE); P.k2_pitch = 32; P.k2_col = 0;
                P.V = (const bf16*)(X.ws + WS_KVA); P.v_pitch = 1024; P.O = (bf16*)(X.ws + WS_XB); P.o_pitch = DM; P.LSE = nullptr; P.lse_pitch = 0; P.BM = nullptr; P.CL = 2048; P.W = 1 << 20;
#if defined(PROBE_HALF) && PROBE_HALF
                for (int U = X.vcu; U < NB * 8 * 8; U += X.G) { const int bh = U >> 3, pr = U & 7, b = bh >> 3, hd = bh & 7;
                    P.k1_col = 128 * hd; P.v_col = 128 * hd + 64;
#pragma unroll 1
                    for (int z = 0; z < 2; ++z) { const int qb = z ? 15 - pr : pr; const int q0 = 128 * qb;
                        fa::attn_unit<96, 0>(P, X.lds, X.tid, b * SEQ, q0 + 32 * (X.wave & 3), 96 * hd, 64 * hd, 0, 0, (q0 + 127) >> 6, X.wave < 4); } }
#else
                for (int rep = 0; rep < REP_P3A; ++rep) for (int U = X.vcu; U < NB * 8 * 4; U += X.G) { const int bh = U >> 2, pr = U & 3, b = bh >> 3, hd = bh & 7;
                    P.k1_col = 128 * hd; P.v_col = 128 * hd + 64;
#pragma unroll 1
                    for (int z = 0; z < 2; ++z) { const int qb = z ? 7 - pr : pr; const int q0 = 256 * qb;
                        fa::attn_unit<96, 0>(P, X.lds, X.tid, b * SEQ, q0 + 32 * X.wave, 96 * hd, 64 * hd, 0, 0, (q0 + 255) >> 6); } }
#endif
            }
            {   fa::Params P; P.Q = (const bf16*)(X.ws + WS_BQ); P.q_pitch = 256; P.K1 = (const bf16*)(X.ws + WS_T1); P.k1_pitch = 256; P.k1_col = 192; P.K2 = nullptr; P.k2_pitch = 0; P.k2_col = 0;
                P.V = (const bf16*)(X.ws + WS_BV); P.v_pitch = 64; P.v_col = 0; P.O = (bf16*)(X.ws + WS_XB); P.o_pitch = DM; P.LSE = nullptr; P.lse_pitch = 0; P.BM = (const unsigned*)(X.ws + WS_BM); P.CL = 2048; P.W = 1 << 20;
                const int hd = X.wave & 3, sub = X.wave >> 2;
                for (int rep = 0; rep < REP_P3B; ++rep) for (int U = X.vcu; U < NB * 16; U += X.G) { const int b = U >> 4, pr = U & 15;
#pragma unroll 1
                    for (int z = 0; z < 2; ++z) { const int qb = z ? 31 - pr : pr; const int q0 = 64 * qb;
                        fa::attn_unit<64, 1>(P, X.lds, X.tid, b * SEQ, q0 + 32 * sub, 64 * hd, 512 + 64 * hd, 0, 0, qb); } }
            }
            for (int rep = 0; rep < REP_P3C; ++rep) dil_combine(X);
            GBAR();
        }
        if (IN(4)) { MKCTX();
            pg8::Gemm g{(const bf16*)(X.ws + WS_XB), (const bf16*)(X.ws + WS_WO) + (size_t)l * DM * DM, DM, nullptr};
            pg8::StaticOrder S; S.init(NT, DM, X.G, X.c, REP_P4);
            pg8::EpiPlain E{(bf16*)(X.ws + WS_MIX), DM, nullptr, 0, 0.f, 0.f, X.lds + LDS_X_OFF};
            pg8::gemm_phase<pg8::EpiPlain, pg8::StaticOrder, false>(X.lds, g, S, E, X.tid);
            GBAR();
        }
        if (IN(5)) { MKCTX(); if (REP_P5 > 1) ln1_router(X, ap, l, l == 0, true); ln1_router(X, ap, l, l == 0); GBAR(); }
        if (IN(6)) { MKCTX(); for (int rep = 0; rep < REP_P6; ++rep) moe_dispatch(X); GBAR(); }
        if (IN(7)) { MKCTX();
            const int* TILEE = (const int*)(X.ws + WS_TILEE);
            pg8::Gemm g{(const bf16*)(X.ws + WS_XB), (const bf16*)(X.ws + WS_WGU), DM, (const int*)(X.ws + WS_STOK)};
            pg8::GroupedOrder S{TILEE, TILEE[1024], 2, X.G, X.c};
            pg8::EpiGateUp E{(bf16*)(X.ws + WS_H), (const float*)(X.ws + WS_SW)};
            for (int rep = 0; rep < REP_P7; ++rep) pg8::gemm_phase<pg8::EpiGateUp, pg8::GroupedOrder, true>(X.lds, g, S, E, X.tid);
            GBAR();
        }
        if (IN(8)) { MKCTX();
            const int* TILEE = (const int*)(X.ws + WS_TILEE);
            pg8::Gemm g{(const bf16*)(X.ws + WS_H), (const bf16*)(X.ws + WS_WD), FH, nullptr};
            pg8::GroupedOrder S{TILEE, TILEE[1024], 4, X.G, X.c};
            pg8::EpiPlain E{(bf16*)(X.ws + WS_Y), DM, nullptr, 0, 0.f, 0.f, X.lds + LDS_X_OFF};
            for (int rep = 0; rep < REP_P8; ++rep) pg8::gemm_phase<pg8::EpiPlain, pg8::GroupedOrder, false>(X.lds, g, S, E, X.tid);
            GBAR();
        }
        if (IN(9)) { MKCTX(); if (REP_P9 > 1) ln2_phase(X, ap, l, l == 0, true); ln2_phase(X, ap, l, l == 0); if (!(l == a.l_hi - 1)) GBAR(); }
#undef IN
    }
#undef GBAR
}

extern "C" void kernel_launch(void* const* d_in, const int* in_sizes, int n_in, void* d_out, int out_size, void* d_ws, size_t ws_size, hipStream_t stream) {
    static int grid = 0;
    if (grid == 0) {
        if (n_in != 19 || in_sizes[0] != NT * DM || out_size != NT * DM || ws_size < WS_END) { fprintf(stderr, "kernel_launch: unexpected shapes (n_in %d, in0 %d, out %d, ws %zu < %zu); nothing launched\n", n_in, n_in > 0 ? in_sizes[0] : -1, out_size, ws_size, (size_t)WS_END); grid = -1; return; }
        int dev = 0, cus = 0, per_cu = 0;
        if (hipGetDevice(&dev) != hipSuccess || hipDeviceGetAttribute(&cus, hipDeviceAttributeMultiprocessorCount, dev) != hipSuccess) { grid = -1; return; }
        if (hipFuncSetAttribute((const void*)mk_fwd, hipFuncAttributeMaxDynamicSharedMemorySize, LDS_BYTES) != hipSuccess) { fprintf(stderr, "kernel_launch: hipFuncSetAttribute failed\n"); grid = -1; return; }
        if (hipOccupancyMaxActiveBlocksPerMultiprocessor(&per_cu, (const void*)mk_fwd, 512, LDS_BYTES) != hipSuccess || per_cu < 1) fprintf(stderr, "kernel_launch: occupancy query reports %d\n", per_cu);
        (void)hipGetLastError();
        grid = cus;
    }
    if (grid < 0) return;
    (void)hipMemsetAsync((char*)d_ws + WS_CTL, 0, CTL_BYTES, stream);
    Args a{};
    a.x = (const float*)d_in[0]; a.pos = (const int*)d_in[1]; a.w_in = (const float*)d_in[2]; a.qn = (const float*)d_in[3]; a.kvn = (const float*)d_in[4];
    a.w_uq = (const float*)d_in[5]; a.w_ukv = (const float*)d_in[6]; a.w_o = (const float*)d_in[7]; a.ln1g = (const float*)d_in[8]; a.ln1b = (const float*)d_in[9];
    a.rgw = (const float*)d_in[10]; a.rgb = (const float*)d_in[11]; a.rew = (const float*)d_in[12]; a.reb = (const float*)d_in[13];
    a.wg = (const float*)d_in[14]; a.wu = (const float*)d_in[15]; a.wd = (const float*)d_in[16]; a.ln2g = (const float*)d_in[17]; a.ln2b = (const float*)d_in[18];
    a.out = (float*)d_out; a.ws = (unsigned char*)d_ws; a.pad = 0;
#if MK_MULTI
    a.use_bar = 0;
    a.l_lo = 0; a.l_hi = 0; a.ph_lo = 0; a.ph_hi = 0;
    hipLaunchKernelGGL(mk_fwd, dim3(grid), dim3(512), LDS_BYTES, stream, a);
    for (int l = 0; l < DEPTH; ++l)
        for (int ph = 1; ph < 10; ++ph) { a.l_lo = l; a.l_hi = l + 1; a.ph_lo = ph; a.ph_hi = ph + 1; hipLaunchKernelGGL(mk_fwd, dim3(grid), dim3(512), LDS_BYTES, stream, a); }
#else
    a.use_bar = 1; a.l_lo = 0; a.l_hi = DEPTH; a.ph_lo = 0; a.ph_hi = 10;
    hipLaunchKernelGGL(mk_fwd, dim3(grid), dim3(512), LDS_BYTES, stream, a);
#endif
    const hipError_t le = hipPeekAtLastError();
    if (le != hipSuccess) fprintf(stderr, "kernel_launch: launch failed: %s\n", hipGetErrorName(le));
}
```

```cpp
#include <hip/hip_runtime.h>
#include <cstdio>
#include <cstdint>

#define LAS __attribute__((address_space(3)))
#define GAS __attribute__((address_space(1)))
typedef unsigned short bf16;
typedef short bf16x8 __attribute__((ext_vector_type(8)));
typedef short s16x4 __attribute__((ext_vector_type(4)));
typedef float f32x2 __attribute__((ext_vector_type(2)));
typedef float f32x4 __attribute__((ext_vector_type(4)));
typedef float f32x16 __attribute__((ext_vector_type(16)));
typedef unsigned u32x2 __attribute__((ext_vector_type(2)));
typedef unsigned u32x4 __attribute__((ext_vector_type(4)));
typedef __bf16 bf16x2_t __attribute__((ext_vector_type(2)));

#ifndef MK_MULTI
#define MK_MULTI 0
#endif

constexpr int NB = 32, SEQ = 2048, NT = NB * SEQ, DM = 1024, DEPTH = 4;
constexpr int IN_COLS = 3400, NIN = 3584;
constexpr int NEXP = 32, FH = 256;
constexpr int NSLOT = 2 * NT + NEXP * 256;
constexpr int MAXTILES = NSLOT / 256;
constexpr float ALPHA = 1.681792830507429f;
constexpr float LOG2E = 1.4426950408889634f;
constexpr float QSC64 = 0.125f * LOG2E;
constexpr float QSC96 = 0.10206207261596577f * LOG2E;
constexpr float IDX_SCALE = 0.0625f;

constexpr size_t MiB = 1u << 20;
constexpr size_t WS_CTL = 0, CTL_BYTES = 1 * MiB;
constexpr size_t WS_WIN = 1 * MiB;
constexpr size_t WS_WUQ = 29 * MiB;
constexpr size_t WS_WUKV = WS_WUQ + 3 * MiB / 2;
constexpr size_t WS_WO = WS_WUKV + 2 * MiB;
constexpr size_t WS_RGT = WS_WO + 8 * MiB;
constexpr size_t WS_RET = WS_RGT + 64 * 1024;
constexpr size_t WS_ROPE = 42 * MiB;
constexpr size_t WS_WGU = 56 * MiB;
constexpr size_t WS_WD = 88 * MiB;
constexpr size_t WS_XB = 104 * MiB;
constexpr size_t WS_A = 232 * MiB;
constexpr size_t WS_CQ = WS_A;
constexpr size_t WS_T1 = WS_CQ + 32 * MiB;
constexpr size_t WS_BQ = WS_T1 + 32 * MiB;
constexpr size_t WS_BV = WS_BQ + 32 * MiB;
constexpr size_t WS_WI = WS_BV + 8 * MiB;
constexpr size_t WS_BQI = WS_WI + 2 * MiB;
constexpr size_t WS_SSQ = WS_BQI + 32 * MiB;
constexpr size_t WS_DQ = WS_SSQ + 4 * MiB;
constexpr size_t WS_DK = WS_DQ + 96 * MiB;
constexpr size_t WS_DV = WS_DK + 96 * MiB;
constexpr size_t WS_B = WS_DV + 96 * MiB;
constexpr size_t WS_QA = WS_B;
constexpr size_t WS_KVA = WS_QA + 96 * MiB;
constexpr size_t WS_BM = WS_KVA + 128 * MiB;
constexpr size_t WS_OD = WS_BM + 16 * MiB;
constexpr size_t WS_LSE = WS_OD + 96 * MiB;
constexpr size_t WS_MOE = WS_LSE + 4 * MiB;
constexpr size_t WS_ROUTE = WS_MOE;
constexpr size_t WS_HIST = WS_ROUTE + 1 * MiB;
constexpr size_t WS_STOK = WS_HIST + 64 * 1024;
constexpr size_t WS_SW = WS_STOK + 640 * 1024;
constexpr size_t WS_TSLOT = WS_SW + 640 * 1024;
constexpr size_t WS_TILEE = WS_TSLOT + 512 * 1024;
constexpr size_t WS_KPE = WS_MOE + 4 * MiB;
constexpr size_t WS_KI = WS_KPE + 4 * MiB;
constexpr size_t WS_END = WS_KI + 4 * MiB;
constexpr size_t WS_MIX = WS_A;
constexpr size_t WS_H = WS_A + 128 * MiB;
constexpr size_t WS_Y = WS_H + 68 * MiB;
static_assert(WS_RET + 512 * 1024 <= WS_ROPE && WS_ROPE + 14 * MiB <= WS_WGU && WS_WD + 16 * MiB <= WS_XB && WS_XB + 128 * MiB <= WS_A, "ws map 1");
static_assert(WS_Y + 272 * MiB <= WS_MOE && WS_TILEE + 8192 <= WS_END && WS_END <= 1024 * MiB, "ws map 2");
constexpr size_t ROPE_C16 = 0, ROPE_S16 = (size_t)NT * 16 * 4, ROPE_C8 = 2 * ROPE_S16, ROPE_S8 = ROPE_C8 + (size_t)NT * 8 * 4,
                 ROPE_C4 = ROPE_S8 + (size_t)NT * 8 * 4, ROPE_S4 = ROPE_C4 + (size_t)NT * 4 * 4;

constexpr int CW_BAR = 4096;
constexpr int RING_BYTES = 131072;
constexpr int LDS_X_OFF = 131072;
constexpr int LDSCTL_OFF = 147456;
constexpr int LDS_HIST_OFF = LDSCTL_OFF + 4096;
constexpr int LDS_BYTES = LDS_HIST_OFF + 4096;

#define RLX_AGENT __ATOMIC_RELAXED, __HIP_MEMORY_SCOPE_AGENT
__device__ __forceinline__ unsigned f2bf(float f) { unsigned u = __builtin_bit_cast(unsigned, f); return (u + 0x7fffu + ((u >> 16) & 1u)) >> 16; }
#ifndef NT_EPI
#define NT_EPI 1
#endif
#ifndef NT_KVA
#define NT_KVA 1
#endif
#ifndef NT_MIX
#define NT_MIX 0
#endif
#ifndef NT_H
#define NT_H 0
#endif
#ifndef NT_Y
#define NT_Y 1
#endif
#ifndef NT_LN
#define NT_LN 0
#endif
#ifndef NT_ATT
#define NT_ATT 1
#endif
#define STG_ASM(W, POL) asm volatile("global_store_dwordx" W " %0, %1, off " POL "\n\ts_nop 1" :: "v"(p), "v"(w))
template <int M, class T> __device__ __forceinline__ void stg_any16(void* p, T w) {
    if constexpr (M == 0) *(T*)p = w; else if constexpr (M == 1) __builtin_nontemporal_store(w, (T*)p);
    else if constexpr (M == 2) STG_ASM("4", "sc1"); else if constexpr (M == 3) STG_ASM("4", "sc0 sc1"); else if constexpr (M == 4) STG_ASM("4", "sc1 nt"); else STG_ASM("4", "sc0 sc1 nt"); }
template <int M> __device__ __forceinline__ void stgf4(void* p, f32x4 w) { stg_any16<M>(p, w); }
template <int M> __device__ __forceinline__ void stg16(void* p, u32x4 w) { stg_any16<M>(p, w); }
template <int M> __device__ __forceinline__ void stg8(void* p, u32x2 w) {
    if constexpr (M == 0) *(u32x2*)p = w; else if constexpr (M == 1) __builtin_nontemporal_store(w, (u32x2*)p);
    else if constexpr (M == 2) STG_ASM("2", "sc1"); else if constexpr (M == 3) STG_ASM("2", "sc0 sc1"); else if constexpr (M == 4) STG_ASM("2", "sc1 nt"); else STG_ASM("2", "sc0 sc1 nt"); }
#ifndef NT_LD
#define NT_LD 1
#endif
template <class T> __device__ __forceinline__ T ldg_s(const void* p) { if constexpr (NT_LD) return __builtin_nontemporal_load((const T*)p); else return *(const T*)p; }
__device__ __forceinline__ unsigned pk2(float lo, float hi) { f32x2 v = {lo, hi}; bf16x2_t b = __builtin_convertvector(v, bf16x2_t); return __builtin_bit_cast(unsigned, b); }
__device__ __forceinline__ float bf2f(unsigned short b) { return __builtin_bit_cast(float, ((unsigned)b) << 16); }
__device__ __forceinline__ float bflo(unsigned w) { return __builtin_bit_cast(float, w << 16); }
__device__ __forceinline__ float bfhi(unsigned w) { return __builtin_bit_cast(float, w & 0xffff0000u); }
template <int CTRL> __device__ __forceinline__ float dppf(float x) { return __builtin_bit_cast(float, __builtin_amdgcn_mov_dpp(__builtin_bit_cast(int, x), CTRL, 0xf, 0xf, true)); }
__device__ __forceinline__ float xhalf_sum(float v) { const auto t = __builtin_amdgcn_permlane32_swap(__float_as_uint(v), __float_as_uint(v), false, false); return __uint_as_float(t[0]) + __uint_as_float(t[1]); }
__device__ __forceinline__ float xhalf_max(float v) { const auto t = __builtin_amdgcn_permlane32_swap(__float_as_uint(v), __float_as_uint(v), false, false); return fmaxf(__uint_as_float(t[0]), __uint_as_float(t[1])); }
__device__ __forceinline__ float wave_sum(float v) {
    v += dppf<0xB1>(v); v += dppf<0x4E>(v); v += dppf<0x141>(v); v += dppf<0x140>(v);
    const auto s = __builtin_amdgcn_permlane16_swap(__float_as_uint(v), __float_as_uint(v), false, false);
    v = __uint_as_float(s[0]) + __uint_as_float(s[1]);
    return xhalf_sum(v);
}
__device__ __forceinline__ int crow(int r, int hi) { return (r & 3) + 8 * (r >> 2) + 4 * hi; }

#define XB_TMO      128
#define XB_XCNT(j)  (256  + 64 * (j))
#define XB_XSUB(j)  (1280 + 64 * (j))
#define XB_XGEN(j)  (2304 + 64 * (j))
#define XB_TOP      3328
#define XB_TOPGEN   3392
#define XCD_BAR_WORDS 3456
#define XB_SPIN_CAP (1u << 18)
__device__ __forceinline__ unsigned xb_ld(unsigned* p)              { return __hip_atomic_load(p, __ATOMIC_RELAXED, __HIP_MEMORY_SCOPE_AGENT); }
__device__ __forceinline__ unsigned xb_add(unsigned* p, unsigned v) { return __hip_atomic_fetch_add(p, v, __ATOMIC_RELAXED, __HIP_MEMORY_SCOPE_AGENT); }
__device__ __forceinline__ unsigned xb_xcc_id() { return (unsigned)__builtin_amdgcn_s_getreg((3 << 11) | 20) & 0xFu; }
#define XB_SPIN(cond, bar) do { unsigned _sp = 0; while (cond) { __builtin_amdgcn_s_sleep(1); \
    if ((++_sp & 255u) == 0u) { if (xb_ld(&(bar)[XB_TMO])) break; if (_sp > XB_SPIN_CAP) { atomicAdd(&(bar)[XB_TMO], 1u); break; } } } } while (0)
struct XcdBarrier { unsigned* bar; unsigned x; volatile LAS unsigned* st; };
__device__ __forceinline__ XcdBarrier xcd_barrier_post(unsigned* bar, volatile LAS unsigned* st) {
    XcdBarrier b; b.bar = bar; b.x = xb_xcc_id(); b.st = st;
    if (threadIdx.x == 0) (void)xb_add(&bar[XB_XCNT(b.x)], 1u);
    return b;
}
__device__ __forceinline__ void xcd_barrier_complete(unsigned* bar, unsigned x, unsigned& nloc, unsigned& nx) {
    const unsigned G = gridDim.x * gridDim.y * gridDim.z;
    unsigned sum, cnt, mine, sp = 0u;
    for (;;) {
        sum = 0u; cnt = 0u; mine = 0u;
#pragma unroll
        for (unsigned j = 0; j < 16; ++j) { const unsigned c = xb_ld(&bar[XB_XCNT(j)]); sum += c; cnt += (c > 0u) ? 1u : 0u; mine = (j == x) ? c : mine; }
        if (sum == G) break;
        __builtin_amdgcn_s_sleep(1);
        if ((++sp & 255u) == 0u) { if (xb_ld(&bar[XB_TMO])) break; if (sp > XB_SPIN_CAP) { atomicAdd(&bar[XB_TMO], 1u); break; } }
    }
    nloc = mine > 0u ? mine : 1u; nx = cnt > 0u ? cnt : 1u;
}
__device__ __forceinline__ void xcd_barrier(const XcdBarrier& b) {
    asm volatile("s_waitcnt vmcnt(0)" ::: "memory");
    __syncthreads();
    if (threadIdx.x == 0) {
        unsigned* bar = b.bar;
        __builtin_amdgcn_s_waitcnt(0);
        unsigned nloc = b.st[0], nx = b.st[1];
        if (nloc == 0u) { xcd_barrier_complete(bar, b.x, nloc, nx); b.st[0] = nloc; b.st[1] = nx; }
        const unsigned old = xb_add(&bar[XB_XSUB(b.x)], 1u);
        const unsigned gen = old / nloc;
        if (old + 1u == (gen + 1u) * nloc) {
            __builtin_amdgcn_fence(__ATOMIC_RELEASE, "agent");
            asm volatile("s_waitcnt vmcnt(0)" ::: "memory");
            const unsigned og = xb_add(&bar[XB_TOP], 1u);
            const unsigned tg = og / nx;
            if (og + 1u == (tg + 1u) * nx) xb_add(&bar[XB_TOPGEN], 1u);
            else XB_SPIN(xb_ld(&bar[XB_TOPGEN]) == tg, bar);
            __builtin_amdgcn_fence(__ATOMIC_ACQUIRE, "agent");
            xb_add(&bar[XB_XGEN(b.x)], 1u);
            asm volatile("s_waitcnt vmcnt(0)" ::: "memory");
        } else {
            XB_SPIN(xb_ld(&bar[XB_XGEN(b.x)]) == gen, bar);
            __builtin_amdgcn_fence(__ATOMIC_ACQUIRE, "agent");
            asm volatile("s_waitcnt vmcnt(0)" ::: "memory");
        }
    }
    __syncthreads();
}

namespace pg8 {
constexpr int BM = 256, BK = 64, HALF = 128, HTB = HALF * BK * 2, STAGE_BYTES = 8 * HTB, NXCD = 8, WGM = 8;
__host__ __device__ __forceinline__ int lds_byte(int r, int c) { const int st = (r >> 4) * 2 + (c >> 5), rr = r & 15, cc = c & 31, ob = rr * 64 + cc * 2; return st * 1024 + (ob ^ (((ob >> 9) & 1) << 5)); }
__host__ __device__ __forceinline__ void stage_rc(int b, int& R, int& C) { const int st = b / 1024, sb = b % 1024, swz = sb ^ (((sb >> 9) & 1) << 5); R = (st >> 1) * 16 + swz / 64; C = (st & 1) * 32 + (swz % 64) / 2; }
__host__ __device__ __forceinline__ int perm32(int rho) { const int n = rho >> 4, i = rho & 15; return 8 * (i >> 2) + 4 * n + (i & 3); }

#ifndef PROBE_P1
#define PROBE_P1 0
#endif
struct Unit { int pm, pn, pb;
#if PROBE_P1
    int fl;
#endif
};
struct Gemm { const bf16* A; const bf16* Bt; int K; const int* gidx; };

__device__ __forceinline__ int xcd_remap(int wgid, int nwg) { const int q = nwg / NXCD, r = nwg % NXCD, xcd = wgid % NXCD, off = wgid / NXCD; return (xcd < r ? xcd * (q + 1) : r * (q + 1) + (xcd - r) * q) + off; }
struct StaticOrder {
    int nM, nN, nwg, G, c, rep;
    __device__ void init(int M, int N, int G_, int c_, int rep_ = 1) { nM = M / BM; nN = N / BM; nwg = nM * nN; G = G_; c = c_; rep = rep_; }
    __device__ bool next(int i, Unit& u) const {
        long L = (long)i * G + c; if (L >= (long)nwg * rep) return false;
#if PROBE_P1
        u.fl = (rep > 1 && L < nwg) ? 1 : 0;
#endif
        L %= nwg;
        const int wgid = xcd_remap((int)L, nwg);
        const int nig = WGM * nN, gid = wgid / nig, fm = gid * WGM, gsz = (nM - fm) < WGM ? (nM - fm) : WGM;
        u.pm = fm + ((wgid % nig) % gsz); u.pn = (wgid % nig) / gsz; u.pb = u.pn; return true;
    }
};
struct GroupedOrder {
    const int* tile_e; int ntiles, npn, G, c;
    __device__ bool next(int i, Unit& u) const {
        const long L = (long)i * G + c; const int nwg = ntiles * npn; if (L >= nwg) return false;
        const int wgid = xcd_remap((int)L, nwg);
        u.pm = wgid / npn; u.pn = wgid % npn; u.pb = tile_e[u.pm] * npn + u.pn;
#if PROBE_P1
        u.fl = 0;
#endif
        return true;
    }
};

__device__ __forceinline__ unsigned cvt_pk_bf16(float lo, float hi) { unsigned r; asm volatile("v_cvt_pk_bf16_f32 %0, %1, %2" : "=v"(r) : "v"(lo), "v"(hi)); return r; }

template <int STM> struct EpiPlainT {
    static constexpr bool PERM = true;
    bf16* O; int ldc; const float* ssq; int ssq_n; float ssq_inv; float eps;
    LAS unsigned char* xl;
    __device__ __forceinline__ void operator()(const f32x4 (&acc)[2][2][4][2], const Unit& u, int wr, int wc, int fr, int fq) const {
        const int lane = fq * 16 + fr; LAS unsigned char* t = xl + (wr * 4 + wc) * 2048;
        const int wsw = fr & 7, rrow = lane >> 3, rch = lane & 7;
#pragma unroll
        for (int ai = 0; ai < 2; ++ai)
#pragma unroll
            for (int m = 0; m < 4; ++m) { const int rowb = u.pm * BM + ai * HALF + wr * 64 + m * 16;
                float sc = 1.f;
                if (ssq) { const f32x4 p = *(const f32x4*)(ssq + (size_t)(rowb + fr) * ssq_n); sc = __builtin_amdgcn_rsqf((p[0] + p[1] + p[2] + p[3]) * ssq_inv + eps); }
#pragma unroll
                for (int bj = 0; bj < 2; ++bj) { const f32x4 v0 = acc[ai][bj][m][0] * sc, v1 = acc[ai][bj][m][1] * sc;
                    u32x4 w; w.x = cvt_pk_bf16(v0[0], v0[1]); w.y = cvt_pk_bf16(v0[2], v0[3]); w.z = cvt_pk_bf16(v1[0], v1[1]); w.w = cvt_pk_bf16(v1[2], v1[3]);
                    *(LAS u32x4*)(t + fr * 128 + 16 * ((4 * bj + fq) ^ wsw)) = w; }
#pragma unroll
                for (int i = 0; i < 2; ++i) { const int rr = 8 * i + rrow;
                    const u32x4 w = *(const LAS u32x4*)(t + rr * 128 + 16 * (rch ^ (rr & 7)));
                    stg16<STM>(O + (size_t)(rowb + rr) * ldc + u.pn * BM + wc * 64 + 8 * rch, w); }
            }
    }
};
template <int STM> struct EpiGateUpT {
    static constexpr bool PERM = true;
    bf16* H; const float* sw;
    __device__ __forceinline__ void operator()(const f32x4 (&acc)[2][2][4][2], const Unit& u, int wr, int wc, int fr, int fq) const {
        const int row0 = u.pm * BM + wr * 64 + fr; const int col0 = u.pn * HALF + wc * 32 + 8 * fq;
#pragma unroll
        for (int ai = 0; ai < 2; ++ai)
#pragma unroll
            for (int m = 0; m < 4; ++m) { const int row = row0 + ai * HALF + m * 16; const float w = sw[row]; f32x4 hv[2];
#pragma unroll
                for (int n = 0; n < 2; ++n) { const f32x4 g = acc[ai][0][m][n], up = acc[ai][1][m][n];
#pragma unroll
                    for (int e = 0; e < 4; ++e) { const float sg = g[e] * __builtin_amdgcn_rcpf(1.0f + __builtin_amdgcn_exp2f(-g[e] * LOG2E)); hv[n][e] = sg * up[e] * w; } }
                u32x4 o; o.x = cvt_pk_bf16(hv[0][0], hv[0][1]); o.y = cvt_pk_bf16(hv[0][2], hv[0][3]); o.z = cvt_pk_bf16(hv[1][0], hv[1][1]); o.w = cvt_pk_bf16(hv[1][2], hv[1][3]);
                stg16<STM>(H + (size_t)row * FH + col0, o); }
    }
};

enum { GK_SKIP = 0, GK_PLAIN = 1, GK_ROPE32 = 2, GK_HEAD16 = 3, GK_IDX8 = 4, GK_WI = 5 };
struct GroupDesc { int kind; bf16* dst; int pitch; int col; float scale; int perm; float* ssq; int ssq_n; int ssq_i; };
struct RopeTabs { const int* pos; };
__device__ __forceinline__ int perm_row(int row, int perm) {
    if (perm == 0) return row; const int b = row >> 11, s = row & 2047;
    return perm == 4 ? (b << 11) + ((s & 3) << 9) + (s >> 2) : (b << 11) + ((s & 15) << 7) + (s >> 4);
}
__device__ __forceinline__ void st16(bf16* p, u32x2 a, u32x2 b) { u32x4 w; w.x = a.x; w.y = a.y; w.z = b.x; w.w = b.y; stg16<NT_EPI>(p, w); }
__device__ __forceinline__ u32x2 pk4(f32x4 v) { u32x2 w; w.x = cvt_pk_bf16(v[0], v[1]); w.y = cvt_pk_bf16(v[2], v[3]); return w; }
__device__ __forceinline__ void swap16(u32x2& X, u32x2& Y) {
    const auto a = __builtin_amdgcn_permlane16_swap(X.x, Y.x, false, false); const auto b = __builtin_amdgcn_permlane16_swap(X.y, Y.y, false, false);
    X.x = a[0]; Y.x = a[1]; X.y = b[0]; Y.y = b[1];
}
__device__ __forceinline__ float rope_k(int i, int rd) { return __builtin_amdgcn_exp2f(-18.931568569324174f * (float)(2 * i) / (float)rd) * 0.15915494309189535f; }
__device__ __forceinline__ void rope_cs(float posf, int i0, int rd, f32x4& c, f32x4& s) {
#pragma unroll
    for (int e = 0; e < 4; ++e) { const float f = __builtin_amdgcn_fractf(posf * rope_k(i0 + e, rd)); s[e] = __builtin_amdgcn_sinf(f); c[e] = __builtin_amdgcn_cosf(f); }
}
template <class DescFn> struct EpiGroups {
    static constexpr bool PERM = true;
    DescFn F; RopeTabs R; const float* rs_ssq; int rs_n; float rs_inv, rs_eps;
    __device__ __forceinline__ void operator()(const f32x4 (&acc)[2][2][4][2], const Unit& u, int wr, int wc, int fr, int fq) const {
        const int row0 = u.pm * BM + wr * 64 + fr;
#pragma unroll
        for (int bj = 0; bj < 2; ++bj) {
            const GroupDesc d = F(u.pn, bj, wc);
            if (d.kind == GK_SKIP) continue;
#if PROBE_P1 == 1
            if (u.fl) continue;
#endif
            const int ki0 = d.kind == GK_ROPE32 ? 4 * fq : (d.kind == GK_HEAD16 ? 4 * (fq & 1) : 0), krd = d.kind == GK_ROPE32 ? 32 : (d.kind == GK_HEAD16 ? 16 : 8);
#pragma unroll
            for (int ai = 0; ai < 2; ++ai)
#pragma unroll
                for (int m = 0; m < 4; ++m) {
                    const int row = row0 + ai * HALF + m * 16;
                    float sc = d.scale;
                    if (rs_ssq) { float s = 0.f; for (int i = 0; i < rs_n; ++i) s += rs_ssq[(size_t)row * rs_n + i]; sc *= __builtin_amdgcn_rsqf(s * rs_inv + rs_eps); }
                    f32x4 v0 = acc[ai][bj][m][0], v1 = acc[ai][bj][m][1];
                    if (d.ssq) {
                        float q = (v0[0] * v0[0] + v0[1] * v0[1]) + (v0[2] * v0[2] + v0[3] * v0[3]) + (v1[0] * v1[0] + v1[1] * v1[1]) + (v1[2] * v1[2] + v1[3] * v1[3]);
                        q += __shfl_xor(q, 16); q += __shfl_xor(q, 32);
                        if (fq == 0) d.ssq[(size_t)row * d.ssq_n + d.ssq_i] = q;
                    }
                    v0 = v0 * sc; v1 = v1 * sc;
                    if (d.kind == GK_WI) { if (fq == 0) { float* wp = (float*)d.dst + (size_t)row * 8; *(f32x4*)wp = v0; *(f32x4*)(wp + 4) = v1; } continue; }
                    bf16* rp = d.dst + (size_t)perm_row(row, d.perm) * d.pitch + d.col;
                    if (d.kind == GK_PLAIN) { st16(rp + 8 * fq, pk4(v0), pk4(v1)); }
                    else if (d.kind == GK_IDX8) {
                        f32x4 c, s; rope_cs((float)R.pos[row], ki0, krd, c, s);
                        const f32x4 o1 = fq == 0 ? v0 * c - v1 * s : v0, o2 = fq == 0 ? v1 * c + v0 * s : v1;
                        st16(rp + 8 * fq, pk4(o1), pk4(o2));
                    } else if (d.kind == GK_ROPE32) {
                        f32x4 c, s; rope_cs((float)R.pos[row], ki0, krd, c, s);
                        u32x2 X = pk4(v0 * c - v1 * s), Y = pk4(v1 * c + v0 * s);
                        swap16(X, Y);
                        st16(rp + ((fq & 1) ? 16 + 4 * (fq - 1) : 4 * fq), X, Y);
                    } else {
                        f32x4 c, s; rope_cs((float)R.pos[row], ki0, krd, c, s);
                        u32x2 X = pk4(fq < 2 ? v0 * c - v1 * s : v0), Y = pk4(fq < 2 ? v1 * c + v0 * s : v1);
                        swap16(X, Y);
                        st16(rp + 16 * (fq >> 1) + 8 * (fq & 1), X, Y);
                    }
                }
        }
    }
};

template <class Epi, class Sched, bool GATHER, int LDA = 0>
__device__ __forceinline__ void gemm_phase(LAS unsigned char* lds, const Gemm g, const Sched& S, const Epi& E, const int tid) {
    const int wid = __builtin_amdgcn_readfirstlane(tid >> 6), lane = tid & 63, wr = wid >> 2, wc = wid & 3, fr = lane & 15, fq = lane >> 4;
    const int K = g.K, nt = K / BK, lda = LDA ? LDA : K;
    unsigned voA[2][2], voB[2]; int RA[2], CA[2];
#pragma unroll
    for (int i = 0; i < 2; ++i) { int R, C; stage_rc(tid * 16 + i * 8192, R, C); const int Rb = Epi::PERM ? ((R & ~31) + perm32(R & 31)) : R;
        RA[i] = R; CA[i] = C; voA[0][i] = (unsigned)(R * lda + C) * 2u; voA[1][i] = (unsigned)((R + HALF) * lda + C) * 2u; voB[i] = (unsigned)(Rb * K + C) * 2u; }
    const size_t kstep = (size_t)(BK * 2);
    const size_t hstep = (size_t)HALF * K * 2;
    const size_t tstep = 2 * hstep;
    const size_t tstepA = (size_t)BM * lda * 2;
    const unsigned ldsw = (unsigned)wid * 1024u;
    const int aoff = lds_byte(wr * 64 + fr, fq * 8), boff = lds_byte(wc * 32 + fr, fq * 8);
#define PG8_SA(b, h) (((b) * 2 + (h)) * HTB)
#define PG8_SB(b, h) ((4 + (b) * 2 + (h)) * HTB)
#define PG8_STAGE(bufoff, gbase, voff) do { _Pragma("unroll") for (int _i = 0; _i < 2; ++_i) \
        __builtin_amdgcn_global_load_lds((const unsigned*)((const char*)(gbase) + (voff)[_i]), (LAS unsigned*)(lds + (bufoff) + ldsw + _i * 8192), 16, 0, 0); } while (0)
#define PG8_LDA(dst, b, h) do { _Pragma("unroll") for (int m = 0; m < 4; ++m) _Pragma("unroll") for (int k = 0; k < 2; ++k) dst[m][k] = *(const LAS bf16x8*)(lds + PG8_SA(b, h) + aoff + m * 2048 + k * 1024); } while (0)
#define PG8_LDB(dst, b, h) do { _Pragma("unroll") for (int n = 0; n < 2; ++n) _Pragma("unroll") for (int k = 0; k < 2; ++k) dst[n][k] = *(const LAS bf16x8*)(lds + PG8_SB(b, h) + boff + n * 2048 + k * 1024); } while (0)
#define PG8_MMA(ai, bj, At, Bt) do { __builtin_amdgcn_s_setprio(1); _Pragma("unroll") for (int m = 0; m < 4; ++m) _Pragma("unroll") for (int n = 0; n < 2; ++n) _Pragma("unroll") for (int k = 0; k < 2; ++k) \
        acc[ai][bj][m][n] = __builtin_amdgcn_mfma_f32_16x16x32_bf16(Bt[n][k], At[m][k], acc[ai][bj][m][n], 0, 0, 0); __builtin_amdgcn_s_setprio(0); } while (0)
#define PG8_WAIT_V(n) asm volatile("s_waitcnt vmcnt(" #n ")" ::: "memory")
#define PG8_WAIT_L(n) asm volatile("s_waitcnt lgkmcnt(" #n ")" ::: "memory")
#define PG8_BAR __builtin_amdgcn_s_barrier()
#define PG8_SCHED __builtin_amdgcn_sched_barrier(0)
    Unit cur, nxt; int ui = 0;
    if (!S.next(0, cur)) return;
    f32x4 acc[2][2][4][2];
#pragma unroll
    for (int a = 0; a < 2; ++a)
#pragma unroll
        for (int b = 0; b < 2; ++b)
#pragma unroll
            for (int m = 0; m < 4; ++m)
#pragma unroll
                for (int n = 0; n < 2; ++n) acc[a][b][m][n] = (f32x4){0.f, 0.f, 0.f, 0.f};
    bf16x8 At[4][2], B0[2][2], B1[2][2];
    unsigned nvA[2][2];
    const char* cA; const char* cB = (const char*)g.Bt + (size_t)cur.pb * tstep;
    if constexpr (GATHER) { cA = (const char*)g.A;
#pragma unroll
        for (int h = 0; h < 2; ++h)
#pragma unroll
            for (int i = 0; i < 2; ++i) voA[h][i] = (unsigned)g.gidx[cur.pm * BM + h * HALF + RA[i]] * (unsigned)(lda * 2) + (unsigned)CA[i] * 2u;
    } else cA = (const char*)g.A + (size_t)cur.pm * tstepA;
    PG8_STAGE(PG8_SB(0, 0), cB, voB); PG8_STAGE(PG8_SB(0, 1), cB + hstep, voB); PG8_STAGE(PG8_SA(0, 0), cA, voA[0]); PG8_STAGE(PG8_SA(0, 1), cA, voA[1]);
    if (wr == 1) PG8_BAR;
    PG8_WAIT_V(2); PG8_BAR;
    PG8_STAGE(PG8_SB(1, 0), cB + kstep, voB); PG8_STAGE(PG8_SA(1, 0), cA + kstep, voA[0]); PG8_STAGE(PG8_SB(1, 1), cB + hstep + kstep, voB);
    PG8_WAIT_V(6); PG8_BAR;
    for (;;) {
        const bool has_next = S.next(ui + 1, nxt);
        const char* nA; const char* nB = has_next ? (const char*)g.Bt + (size_t)nxt.pb * tstep : cB;
        if constexpr (GATHER) { nA = cA;
#pragma unroll
            for (int h = 0; h < 2; ++h)
#pragma unroll
                for (int i = 0; i < 2; ++i) nvA[h][i] = has_next ? (unsigned)g.gidx[nxt.pm * BM + h * HALF + RA[i]] * (unsigned)(lda * 2) + (unsigned)CA[i] * 2u : voA[h][i];
        } else nA = has_next ? (const char*)g.A + (size_t)nxt.pm * tstepA : cA;
#if PROBE_P1 == 2
        const int ntu = cur.fl ? 2 : nt;
#else
        const int ntu = nt;
#endif
#pragma nounroll
        for (int t = 0; t < ntu; t += 2) {
            const bool last = (t == ntu - 2);
            const char* a1 = cA + (size_t)(t + 1) * kstep;
            const char* a2 = last ? nA : cA + (size_t)(t + 2) * kstep; const char* b2 = last ? nB : cB + (size_t)(t + 2) * kstep;
            const char* a3 = a2 + kstep; const char* b3 = b2 + kstep;
            unsigned xA[2][2];
#pragma unroll
            for (int h = 0; h < 2; ++h)
#pragma unroll
                for (int i = 0; i < 2; ++i) xA[h][i] = (GATHER && last) ? nvA[h][i] : voA[h][i];
            PG8_LDB(B0, 0, 0); PG8_LDB(B1, 0, 1); PG8_SCHED; PG8_LDA(At, 0, 0); PG8_STAGE(PG8_SA(1, 1), a1, voA[1]);
            PG8_WAIT_V(8); PG8_WAIT_L(0); PG8_BAR; PG8_MMA(0, 0, At, B0); PG8_MMA(0, 1, At, B1); PG8_BAR; PG8_SCHED;
            PG8_LDA(At, 0, 1); PG8_STAGE(PG8_SB(0, 0), b2, voB); PG8_STAGE(PG8_SB(0, 1), b2 + hstep, voB); PG8_STAGE(PG8_SA(0, 0), a2, xA[0]);
            PG8_WAIT_V(8); PG8_WAIT_L(0); PG8_BAR; PG8_MMA(1, 0, At, B0); PG8_MMA(1, 1, At, B1); PG8_BAR; PG8_SCHED;
            PG8_LDB(B0, 1, 0); PG8_LDB(B1, 1, 1); PG8_SCHED; PG8_LDA(At, 1, 0); PG8_STAGE(PG8_SA(0, 1), a2, xA[1]);
            PG8_WAIT_V(8); PG8_WAIT_L(0); PG8_BAR; PG8_MMA(0, 0, At, B0); PG8_MMA(0, 1, At, B1); PG8_BAR; PG8_SCHED;
            PG8_LDA(At, 1, 1); PG8_STAGE(PG8_SB(1, 0), b3, voB); PG8_STAGE(PG8_SB(1, 1), b3 + hstep, voB); PG8_STAGE(PG8_SA(1, 0), a3, xA[0]);
            PG8_WAIT_V(8); PG8_WAIT_L(0); PG8_BAR; PG8_MMA(1, 0, At, B0); PG8_MMA(1, 1, At, B1); PG8_BAR; PG8_SCHED;
        }
        if (wr == 0) PG8_BAR;
        E(acc, cur, wr, wc, fr, fq);
        if (!has_next) break;
#pragma unroll
        for (int a = 0; a < 2; ++a)
#pragma unroll
            for (int b = 0; b < 2; ++b)
#pragma unroll
                for (int m = 0; m < 4; ++m)
#pragma unroll
                    for (int n = 0; n < 2; ++n) acc[a][b][m][n] = (f32x4){0.f, 0.f, 0.f, 0.f};
        cur = nxt; cA = nA; cB = nB; ++ui;
        if constexpr (GATHER) {
#pragma unroll
            for (int h = 0; h < 2; ++h)
#pragma unroll
                for (int i = 0; i < 2; ++i) voA[h][i] = nvA[h][i];
        }
        if (wr == 1) PG8_BAR;
    }
    PG8_WAIT_V(0);
    PG8_BAR;
#undef PG8_SA
#undef PG8_SB
#undef PG8_STAGE
#undef PG8_LDA
#undef PG8_LDB
#undef PG8_MMA
#undef PG8_WAIT_V
#undef PG8_WAIT_L
#undef PG8_BAR
#undef PG8_SCHED
}
}

#ifndef PROBE_LDS2
#define PROBE_LDS2 0
#endif
#ifndef PROBE_EXP2
#define PROBE_EXP2 0
#endif
#ifndef FA_FUSE
#define FA_FUSE 0
#endif
namespace fa {
constexpr int VBYTES_T = 64 * 128;
typedef short v4i16_t __attribute__((ext_vector_type(4)));
__device__ __forceinline__ u32x2 vtr(const LAS unsigned char* p) { return __builtin_bit_cast(u32x2, __builtin_amdgcn_ds_read_tr16_b64_v4i16((LAS v4i16_t*)p)); }
__device__ __forceinline__ float max16(const f32x16& c) { float r;
    asm("v_max3_f32 %0, %1, %2, %3\n\tv_max3_f32 %0, %0, %4, %5\n\tv_max3_f32 %0, %0, %6, %7\n\tv_max3_f32 %0, %0, %8, %9\n\tv_max3_f32 %0, %0, %10, %11\n\tv_max3_f32 %0, %0, %12, %13\n\tv_max3_f32 %0, %0, %14, %15\n\tv_max_f32 %0, %0, %16"
        : "=&v"(r) : "v"(c[0]), "v"(c[1]), "v"(c[2]), "v"(c[3]), "v"(c[4]), "v"(c[5]), "v"(c[6]), "v"(c[7]), "v"(c[8]), "v"(c[9]), "v"(c[10]), "v"(c[11]), "v"(c[12]), "v"(c[13]), "v"(c[14]), "v"(c[15]));
    return r; }
__device__ __forceinline__ void mask_init(f32x16& S, unsigned nw) { float t0, t1, t2, t3, t4, t5, t6, t7, t8, t9, t10, t11, t12, t13, t14, t15;
    asm("v_bfe_i32 %0, %16, 0, 1\n\tv_lshlrev_b32 %0, 23, %0\n\tv_bfe_i32 %1, %16, 1, 1\n\tv_lshlrev_b32 %1, 23, %1\n\tv_bfe_i32 %2, %16, 2, 1\n\tv_lshlrev_b32 %2, 23, %2\n\tv_bfe_i32 %3, %16, 3, 1\n\tv_lshlrev_b32 %3, 23, %3\n\tv_bfe_i32 %4, %16, 8, 1\n\tv_lshlrev_b32 %4, 23, %4\n\tv_bfe_i32 %5, %16, 9, 1\n\tv_lshlrev_b32 %5, 23, %5\n\tv_bfe_i32 %6, %16, 10, 1\n\tv_lshlrev_b32 %6, 23, %6\n\tv_bfe_i32 %7, %16, 11, 1\n\tv_lshlrev_b32 %7, 23, %7\n\tv_bfe_i32 %8, %16, 16, 1\n\tv_lshlrev_b32 %8, 23, %8\n\tv_bfe_i32 %9, %16, 17, 1\n\tv_lshlrev_b32 %9, 23, %9\n\tv_bfe_i32 %10, %16, 18, 1\n\tv_lshlrev_b32 %10, 23, %10\n\tv_bfe_i32 %11, %16, 19, 1\n\tv_lshlrev_b32 %11, 23, %11\n\tv_bfe_i32 %12, %16, 24, 1\n\tv_lshlrev_b32 %12, 23, %12\n\tv_bfe_i32 %13, %16, 25, 1\n\tv_lshlrev_b32 %13, 23, %13\n\tv_bfe_i32 %14, %16, 26, 1\n\tv_lshlrev_b32 %14, 23, %14\n\tv_bfe_i32 %15, %16, 27, 1\n\tv_lshlrev_b32 %15, 23, %15"
        : "=&v"(t0), "=&v"(t1), "=&v"(t2), "=&v"(t3), "=&v"(t4), "=&v"(t5), "=&v"(t6), "=&v"(t7), "=&v"(t8), "=&v"(t9), "=&v"(t10), "=&v"(t11), "=&v"(t12), "=&v"(t13), "=&v"(t14), "=&v"(t15) : "v"(nw));
    S[0] = t0; S[1] = t1; S[2] = t2; S[3] = t3; S[4] = t4; S[5] = t5; S[6] = t6; S[7] = t7; S[8] = t8; S[9] = t9; S[10] = t10; S[11] = t11; S[12] = t12; S[13] = t13; S[14] = t14; S[15] = t15; }
struct Params {
    const bf16* Q;  int q_pitch;
    const bf16* K1; int k1_pitch, k1_col;
    const bf16* K2; int k2_pitch, k2_col;
    const bf16* V;  int v_pitch, v_col;
    bf16* O; int o_pitch;
    float* LSE; int lse_pitch;
    const unsigned* BM;
    int CL, W;
};
struct UnitDesc { int seq0, qw, q_col, o_col, lse_col, k1_col, v_col, kt_lo, kt_hi; };
template <int DQK, int MODE, class DescFn>
__device__ __forceinline__ void attn_stream(const Params& P, LAS unsigned char* lds, const int tid, const int n_units, DescFn desc) {
    constexpr int NKS = DQK / 16, AHEAD = 4, NST = AHEAD + 1, K1B = 8192, K2B = (DQK == 96 ? 4096 : 0), BMOFF = K1B + K2B + 8192, STB = BMOFF + (MODE == 1 ? 8192 : 0);
    constexpr int NDMA = 2 + (DQK == 96 ? 1 : 0) + (MODE == 1 ? 1 : 0);
    constexpr bool active = true;
    if (n_units <= 0) return;
    const int lane = tid & 63, r = lane & 31, h = lane >> 5, wave = __builtin_amdgcn_readfirstlane(tid >> 6);
    const int tq_ = (lane & 15) >> 2, tp_ = lane & 3, tg_ = lane >> 4;
    const int vtoff = K1B + K2B + (4 * h + tq_) * 128, vxb = 2 * (16 * (tg_ & 1) + 4 * tp_), vsw = (tq_ >> 1) & 1;
    const int vx0 = vxb + ((0 ^ vsw) << 6), vx1 = vxb + ((1 ^ vsw) << 6);
    const int s1_ = (r >> 1) & 7, s2_ = (r >> 2) & 3;
    const int k1row = r * 128, k2row = K1B + r * 64;
    const int row1 = 8 * wave + (lane >> 3), row2 = 16 * (wave & 3) + (lane >> 2);
    const size_t tk1 = (size_t)64 * P.k1_pitch, tk2 = (size_t)64 * P.k2_pitch, tv = (size_t)64 * P.v_pitch;
    const int d_k1 = wave * 1024, d_k2 = K1B + (wave & 3) * 1024, d_v = K1B + K2B + wave * 1024;
    const bf16* src_k1; const bf16* src_v; const bf16* src_k2 = nullptr; const unsigned* bmp = nullptr;
    int ji = -1, kti = 1, kti_hi = 0;
    auto fa_issue = [&](const int st) __attribute__((always_inline)) {
        if (kti > kti_hi) {
            if (ji + 1 < n_units) { ++ji; const UnitDesc t = desc(ji); kti = t.kt_lo; kti_hi = t.kt_hi;
                src_k1 = P.K1 + (size_t)(t.seq0 + row1) * P.k1_pitch + t.k1_col + 8 * ((lane & 7) ^ ((row1 >> 1) & 7));
                src_v = P.V + (size_t)(t.seq0 + row1) * P.v_pitch + t.v_col + 8 * ((lane & 7) ^ (((row1 >> 1) & 1) << 2));
                if constexpr (DQK == 96) src_k2 = P.K2 + (size_t)(t.seq0 + row2) * P.k2_pitch + P.k2_col + 8 * ((lane & 3) ^ ((row2 >> 2) & 3));
                if constexpr (MODE == 1) bmp = P.BM + (size_t)(t.seq0 + t.qw + r) * 64;
            } else kti = kti_hi; }
        LAS unsigned char* sb_ = lds + st * STB;
        __builtin_amdgcn_global_load_lds((const unsigned*)(src_k1 + kti * tk1), (LAS unsigned*)(sb_ + d_k1), 16, 0, 0);
        __builtin_amdgcn_global_load_lds((const unsigned*)(src_v + kti * tv), (LAS unsigned*)(sb_ + d_v), 16, 0, 0);
        if constexpr (DQK == 96) __builtin_amdgcn_global_load_lds((const unsigned*)(src_k2 + kti * tk2), (LAS unsigned*)(sb_ + d_k2), 16, 0, 0);
        if constexpr (MODE == 1) __builtin_amdgcn_global_load_lds(bmp + (kti & ~1) * 2, (LAS unsigned*)(sb_ + BMOFF + wave * 1024), 16, 0, 0);
        ++kti; };
#define FA_ISSUE(TILE, ST) fa_issue(ST)
    int st_is = 0, st_c = 0, st_n = 1;
    bf16x8 qf[NKS];
#define FA_LOADQ(D) do { const bf16* qp_ = P.Q + (size_t)((D).seq0 + (D).qw + r) * P.q_pitch + (D).q_col + 8 * h; \
        _Pragma("unroll") for (int ks = 0; ks < NKS; ++ks) asm volatile("global_load_dwordx4 %0, %1, off offset:%2" : "=&v"(qf[ks]) : "v"(qp_), "n"(32 * ks) : "memory"); } while (0)
#define FA_WAITQ(N) do { if constexpr (NKS == 6) asm volatile("s_waitcnt vmcnt(%6)" : "+v"(qf[0]), "+v"(qf[1]), "+v"(qf[2]), "+v"(qf[3]), "+v"(qf[4]), "+v"(qf[5]) : "n"(N) : "memory"); \
        else asm volatile("s_waitcnt vmcnt(%4)" : "+v"(qf[0]), "+v"(qf[1]), "+v"(qf[2]), "+v"(qf[3]) : "n"(N) : "memory"); } while (0)
    { const UnitDesc d0 = desc(0); FA_LOADQ(d0); FA_WAITQ(0); }
#pragma unroll 1
    for (int ju = 0; ju < n_units; ++ju) {
    const UnitDesc du = desc(ju);
    const int seq0 = du.seq0, qw = du.qw, q_col = du.q_col, o_col = du.o_col, lse_col = du.lse_col, kt_lo = du.kt_lo, kt_hi = du.kt_hi;
    const int q = qw + r;
    const int lo_q = MODE == 0 ? max(q & ~(P.CL - 1), q - P.W) : 0;
    const int qh = q - 4 * h, lqh = lo_q - 4 * h;
    const int lo_w0 = MODE == 0 ? max(qw & ~(P.CL - 1), qw - P.W) : 0;
    const int lo_w1 = MODE == 0 ? max((qw + 31) & ~(P.CL - 1), qw + 31 - P.W) : 0;
#define FA_WAITBAR(N) do { asm volatile("s_waitcnt vmcnt(%0)" :: "n"(N) : "memory"); __builtin_amdgcn_s_barrier(); asm volatile("" ::: "memory"); } while (0)
    f32x16 o0, o1, c0, c1, n0, n1;
#pragma unroll
    for (int i = 0; i < 16; ++i) { o0[i] = 0.f; o1[i] = 0.f; c0[i] = 0.f; c1[i] = 0.f; n0[i] = 0.f; n1[i] = 0.f; }
    float m = -INFINITY, l = 0.f;
#define FA_PART(kt_) (active && (MODE == 0 ? ((kt_) * 64 <= qw + 31 && (kt_) * 64 + 63 >= lo_w0) : ((kt_) * 64 <= qw + 31)))
#define FA_KADDR(SB_, ROFF, ks) ((ks) < 4 ? (SB_) + (ROFF) * 128 + k1row + 16 * ((2 * (ks) + h) ^ s1_) : (SB_) + (ROFF) * 64 + k2row + 16 * ((2 * ((ks) - 4) + h) ^ s2_))
#define FA_QKH(S, SB_, ROFF, NW) do { bf16x8 fa_[NKS]; \
        _Pragma("unroll") for (int ks = 0; ks < NKS; ++ks) fa_[ks] = *(const LAS bf16x8*)FA_KADDR(SB_, ROFF, ks); \
        if (PROBE_LDS2) { _Pragma("unroll") for (int ks = 0; ks < NKS; ++ks) { const bf16x8 fb_ = *(const volatile LAS bf16x8*)FA_KADDR(SB_, (ROFF) ^ 32, ks); asm volatile("" :: "v"(fb_)); } } \
        if constexpr (MODE == 1) {        \
            mask_init(S, NW); \
        } else { _Pragma("unroll") for (int i = 0; i < 16; ++i) S[i] = 0.f; } \
        _Pragma("unroll") for (int ks = 0; ks < NKS; ++ks) S = __builtin_amdgcn_mfma_f32_32x32x16_bf16(fa_[ks], qf[ks], S, 0, 0, 0); \
        __builtin_amdgcn_sched_group_barrier(0x100, NKS, 0); __builtin_amdgcn_sched_group_barrier(0x008, NKS, 0); } while (0)
#define FA_QK(S0, S1, SB_, KT) do { unsigned nwa_ = 0u, nwb_ = 0u; \
        if constexpr (MODE == 1) { const u32x4 bw_ = *(const LAS u32x4*)((SB_) + BMOFF + wave * 1024 + lane * 16);        \
            nwa_ = ~((((KT) & 1) ? bw_.z : bw_.x) >> (4 * h)); nwb_ = ~((((KT) & 1) ? bw_.w : bw_.y) >> (4 * h)); } \
        FA_QKH(S0, SB_, 0, nwa_); FA_QKH(S1, SB_, 32, nwb_); } while (0)
#define FA_QKX(S, SB_, ROFF) do { bf16x8 fa_[NKS]; \
        _Pragma("unroll") for (int ks = 0; ks < NKS; ++ks) fa_[ks] = *(const LAS bf16x8*)FA_KADDR(SB_, ROFF, ks); \
        _Pragma("unroll") for (int i = 0; i < 16; ++i) S[i] = 0.f; \
        _Pragma("unroll") for (int ks = 0; ks < NKS; ++ks) S = __builtin_amdgcn_mfma_f32_32x32x16_bf16(fa_[ks], qf[ks], S, 0, 0, 0); } while (0)
    if (ju == 0) {
#pragma unroll 1
        for (int a = 0; a < AHEAD; ++a) { FA_ISSUE(kt_lo + a, st_is); st_is = st_is + 1; }
        FA_WAITBAR((AHEAD - 2) * NDMA);
    }
    if (FA_PART(kt_lo)) FA_QK(c0, c1, lds + st_c * STB, kt_lo);
    auto fa_step = [&](f32x16& c0, f32x16& c1, f32x16& n0, f32x16& n1, const int kt) __attribute__((always_inline)) {
        FA_ISSUE(kt + AHEAD, st_is); st_is = (st_is + 1 == NST) ? 0 : st_is + 1;
        const bool more1 = kt < kt_hi;
        const bool qnext = !more1 && (ju + 1 < n_units);
        if (qnext) { const UnitDesc dq = desc(ju + 1); FA_LOADQ(dq); }
        const int k0 = kt * 64;
        const bool part_c = FA_PART(kt), part_n = more1 && FA_PART(kt + 1);
        const LAS unsigned char* Sn = lds + st_n * STB; const LAS unsigned char* Vb = lds + st_c * STB;
        const bool fused = FA_FUSE && (DQK == 64) && part_c && part_n;
        if (part_n && !fused) FA_QK(n0, n1, Sn, kt + 1);
        if (part_c) {
            float alpha;
#define FA_SOFTMAX(MASKED) do { \
            if (MASKED) { if constexpr (MODE == 2) { const int qa = qh - k0, qa1 = qa - 32; \
                    _Pragma("unroll") for (int i = 0; i < 16; ++i) { const int ci = (i & 3) + 8 * (i >> 2); \
                        c0[i] = (ci > qa) ? -INFINITY : c0[i]; c1[i] = (ci > qa1) ? -INFINITY : c1[i]; } \
                } else if constexpr (MODE == 0) { const int lb = lqh - k0; const unsigned span = (unsigned)(q - lo_q), lb1 = (unsigned)(lb - 32);     \
                    _Pragma("unroll") for (int i = 0; i < 16; ++i) { const int ci = (i & 3) + 8 * (i >> 2); \
                        c0[i] = ((unsigned)(ci - lb) > span) ? -INFINITY : c0[i]; c1[i] = ((unsigned)ci - lb1 > span) ? -INFINITY : c1[i]; } \
                } } \
            float mx = xhalf_max(fmaxf(max16(c0), max16(c1))); \
            const float mn = fmaxf(m, mx); \
            const float ms = (mn == -INFINITY) ? 0.f : mn; \
            alpha = __builtin_amdgcn_exp2f(m - ms); \
            m = mn; \
            float ls = 0.f; \
            if (PROBE_EXP2) { float dm_ = 0.f; _Pragma("unroll") for (int i = 0; i < 16; ++i) { dm_ += __builtin_amdgcn_exp2f(c0[i] - mx) + __builtin_amdgcn_exp2f(c1[i] - mx); } asm volatile("" :: "v"(dm_)); } \
            { const f32x2 ms2 = {ms, ms}; f32x2 lsa = {0.f, 0.f}, lsb = {0.f, 0.f};            \
              _Pragma("unroll") for (int i = 0; i < 16; i += 2) { \
                  f32x2 ta = {c0[i], c0[i + 1]}, tb = {c1[i], c1[i + 1]}; ta = ta - ms2; tb = tb - ms2; \
                  ta.x = __builtin_amdgcn_exp2f(ta.x); ta.y = __builtin_amdgcn_exp2f(ta.y); tb.x = __builtin_amdgcn_exp2f(tb.x); tb.y = __builtin_amdgcn_exp2f(tb.y); \
                  c0[i] = ta.x; c0[i + 1] = ta.y; c1[i] = tb.x; c1[i + 1] = tb.y; lsa = lsa + ta; lsb = lsb + tb; } \
              lsa = lsa + lsb; ls = lsa.x + lsa.y; } \
            l = l * alpha + ls; } while (0)
            const bool need_mask = MODE == 1 ? false : (MODE == 2 ? (k0 + 63 > qw) : ((k0 + 63 > qw) || (k0 < lo_w1)));
#define FA_FUSED(MASKED) do { FA_QKX(n0, Sn, 0); FA_QKX(n1, Sn, 32); FA_SOFTMAX(MASKED); \
            _Pragma("unroll") for (int hh_ = 0; hh_ < 2; ++hh_) { \
                __builtin_amdgcn_sched_group_barrier(0x100, NKS, 0); \
                _Pragma("unroll") for (int i = 0; i < NKS; ++i) { __builtin_amdgcn_sched_group_barrier(0x008, 1, 0); __builtin_amdgcn_sched_group_barrier(0x002, 120 / (2 * NKS), 0); } } } while (0)
            if (fused) { if (need_mask) FA_FUSED(true); else FA_FUSED(false); }
            else { if (need_mask) FA_SOFTMAX(true); else FA_SOFTMAX(false); }
#undef FA_FUSED
#undef FA_SOFTMAX
            if (!__all(alpha == 1.0f)) {
#pragma unroll
                for (int i = 0; i < 16; ++i) { o0[i] *= alpha; o1[i] *= alpha; } }
#pragma unroll
            for (int kb = 0; kb < 2; ++kb) {
                const f32x16& s = kb ? c1 : c0;
                u32x2 va[2][2], vb[2][2];
                const unsigned vaddr = (unsigned)(size_t)(Vb + (32 * kb) * 128 + vtoff);
#pragma unroll
                for (int sk = 0; sk < 2; ++sk) {
                    asm volatile("ds_read_b64_tr_b16 %0, %1" : "=&v"(va[sk][0]) : "v"(vaddr + (unsigned)(sk * 2048 + vx0)) : "memory");
                    asm volatile("ds_read_b64_tr_b16 %0, %1" : "=&v"(vb[sk][0]) : "v"(vaddr + (unsigned)(sk * 2048 + 1024 + vx0)) : "memory");
                    asm volatile("ds_read_b64_tr_b16 %0, %1" : "=&v"(va[sk][1]) : "v"(vaddr + (unsigned)(sk * 2048 + vx1)) : "memory");
                    asm volatile("ds_read_b64_tr_b16 %0, %1" : "=&v"(vb[sk][1]) : "v"(vaddr + (unsigned)(sk * 2048 + 1024 + vx1)) : "memory");
                }
                bf16x8 pf[2];
#pragma unroll
                for (int sk = 0; sk < 2; ++sk) { u32x4 pw; pw.x = pk2(s[8 * sk + 0], s[8 * sk + 1]); pw.y = pk2(s[8 * sk + 2], s[8 * sk + 3]); pw.z = pk2(s[8 * sk + 4], s[8 * sk + 5]); pw.w = pk2(s[8 * sk + 6], s[8 * sk + 7]); pf[sk] = __builtin_bit_cast(bf16x8, pw); }
                asm volatile("s_waitcnt lgkmcnt(0)" : "+v"(va[0][0]), "+v"(vb[0][0]), "+v"(va[0][1]), "+v"(vb[0][1]), "+v"(va[1][0]), "+v"(vb[1][0]), "+v"(va[1][1]), "+v"(vb[1][1]) :: "memory");
                __builtin_amdgcn_sched_barrier(0);
#pragma unroll
                for (int sk = 0; sk < 2; ++sk) {
                    const u32x4 v0w = {va[sk][0].x, va[sk][0].y, vb[sk][0].x, vb[sk][0].y}, v1w = {va[sk][1].x, va[sk][1].y, vb[sk][1].x, vb[sk][1].y};
                    o0 = __builtin_amdgcn_mfma_f32_32x32x16_bf16(__builtin_bit_cast(bf16x8, v0w), pf[sk], o0, 0, 0, 0);
                    o1 = __builtin_amdgcn_mfma_f32_32x32x16_bf16(__builtin_bit_cast(bf16x8, v1w), pf[sk], o1, 0, 0, 0);
                }
            }
        }
        if (qnext) FA_WAITBAR((AHEAD - 2) * NDMA + NKS); else FA_WAITBAR((AHEAD - 2) * NDMA);
        st_c = st_n; st_n = (st_n + 1 == NST) ? 0 : st_n + 1;
    };
    for (int kt = kt_lo;;) { fa_step(c0, c1, n0, n1, kt); if (++kt > kt_hi) break; fa_step(n0, n1, c0, c1, kt); if (++kt > kt_hi) break; }
#undef FA_PART
#undef FA_QK
#undef FA_QKH
#undef FA_QKX
#undef FA_KADDR
    const float lt = xhalf_sum(l);
    const float inv = 1.0f / lt;
    if (active) {
    bf16* op = P.O + (size_t)(seq0 + q) * P.o_pitch + o_col + 8 * h;
#pragma unroll
    for (int db = 0; db < 2; ++db) {
        const f32x16& o = db ? o1 : o0;
#pragma unroll
        for (int j = 0; j < 2; ++j) {
            u32x2 X, Y;
            X.x = pk2(o[8 * j] * inv, o[8 * j + 1] * inv); X.y = pk2(o[8 * j + 2] * inv, o[8 * j + 3] * inv);
            Y.x = pk2(o[8 * j + 4] * inv, o[8 * j + 5] * inv); Y.y = pk2(o[8 * j + 6] * inv, o[8 * j + 7] * inv);
            const auto a = __builtin_amdgcn_permlane32_swap(X.x, Y.x, false, false); const auto b = __builtin_amdgcn_permlane32_swap(X.y, Y.y, false, false);
            u32x4 w; w.x = a[0]; w.y = b[0]; w.z = a[1]; w.w = b[1];
            stg16<NT_ATT>(op + 32 * db + 16 * j, w);
        }
    }
    if (P.LSE && h == 0) P.LSE[(size_t)(seq0 + q) * P.lse_pitch + lse_col] = m + __builtin_amdgcn_logf(lt);
    }
    __builtin_amdgcn_sched_barrier(0);
    FA_WAITQ(4);
    }
    asm volatile("s_waitcnt vmcnt(0)" ::: "memory"); __builtin_amdgcn_s_barrier(); asm volatile("" ::: "memory");
#undef FA_ISSUE
#undef FA_LOADQ
#undef FA_WAITQ
#undef FA_WAITBAR
}
}

struct Args {
    const float* x; const int* pos; const float* w_in; const float* qn; const float* kvn; const float* w_uq; const float* w_ukv; const float* w_o;
    const float* ln1g; const float* ln1b; const float* rgw; const float* rgb; const float* rew; const float* reb;
    const float* wg; const float* wu; const float* wd; const float* ln2g; const float* ln2b;
    float* out; unsigned char* ws; int l_lo, l_hi, ph_lo, ph_hi, use_bar, pad;
};
typedef const __attribute__((address_space(4))) Args CArgs;
struct Ctx { LAS unsigned char* lds; int tid, lane, wave, G, c, vcu; unsigned char* ws; };

struct ColIdent { int off; __device__ __forceinline__ int operator()(int P) const { return off + P; } };
struct ColAdj { __device__ __forceinline__ int operator()(int P) const { const int p = P & 255; return (P & ~255) + 64 * ((p >> 5) & 3) + 32 * (p >> 7) + (p & 31); } };
__device__ __forceinline__ int map_rope32(int p) { return 16 * ((p >> 2) & 1) + 4 * (p >> 3) + (p & 3); }
__device__ __forceinline__ int map_head16(int p) { const int fq = p >> 3; return 16 * (fq >> 1) + 8 * ((p >> 2) & 1) + 4 * (fq & 1) + (p & 3); }
struct ColWin {
    __device__ __forceinline__ int operator()(int P) const {
        const int G = P >> 5, p = P & 31;
        if (G < 8) return 32 * G + p;
        if (G < 12) return 256 + 32 * (G - 8) + p;
        if (G == 12) return 384 + map_rope32(p);
        if (G == 13) return 1056 + p;
        if (G == 14) return 672 + map_head16(p);
        if (G == 15) return 704 + p;
        if (G < 24) { const int hh = (G - 16) >> 1; return 416 + 64 * hh + (((G - 16) & 1) ? 32 + p : map_head16(p)); }
        if (G < 26) return 736 + 32 * (G - 24) + p;
        if (G == 26) return p < 8 ? 1088 + p : -1;
        if (G < 32) return -1;
        if (G < 40) return 800 + 32 * (G - 32) + p;
        if (G < 64) { const int j = G - 40; return 1096 + 64 * (j >> 1) + ((j & 1) ? 32 + p : map_head16(p)); }
        if (G < 88) { const int j = G - 64; return 1096 + 768 + 64 * (j >> 1) + ((j & 1) ? 32 + p : map_head16(p)); }
        return 1096 + 1536 + 32 * (G - 88) + p;
    }
};
struct ColUq {
    __device__ __forceinline__ int operator()(int P) const { const int G = P >> 5, p = P & 31; return 32 * G + ((G % 3 == 2) ? map_rope32(p) : p); }
};
template <class ColFn>
__device__ __forceinline__ void transpose_item(const float* W, int ldw, int kvalid, bf16* WT, int ldt, int k0, int P0, const ColFn& cf, const float* rowscale, LAS float* scr, int lane) {
    const int c = lane & 31, col = cf(P0 + c);
#pragma unroll 8
    for (int i = 0; i < 32; ++i) { const int kk = 2 * i + (lane >> 5), k = k0 + kk; float v = 0.f;
        if (col >= 0 && k < kvalid) { v = W[(size_t)k * ldw + col]; if (rowscale) v *= rowscale[k]; }
        scr[kk * 33 + c] = v; }
    asm volatile("s_waitcnt lgkmcnt(0)" ::: "memory");
    const int cc = lane & 7;
#pragma unroll
    for (int j = 0; j < 4; ++j) { const int n = (lane >> 3) + 8 * j; const LAS float* s = scr + (8 * cc) * 33 + n;
        u32x4 o; o.x = pk2(s[0 * 33], s[1 * 33]); o.y = pk2(s[2 * 33], s[3 * 33]); o.z = pk2(s[4 * 33], s[5 * 33]); o.w = pk2(s[6 * 33], s[7 * 33]);
        *(u32x4*)(WT + (size_t)(P0 + n) * ldt + k0 + 8 * cc) = o; }
    asm volatile("s_waitcnt lgkmcnt(0)" ::: "memory");
}
__device__ __forceinline__ void prologue(const Ctx& X, const CArgs* ap) {
    struct { const float* x; const float *w_in, *qn, *kvn, *w_uq, *w_ukv, *w_o, *rgw, *rew; } a = {ap->x, ap->w_in, ap->qn, ap->kvn, ap->w_uq, ap->w_ukv, ap->w_o, ap->rgw, ap->rew};
    LAS float* scr = (LAS float*)(X.lds + X.wave * 16384);
    const int gw = X.vcu * 8 + X.wave, NGW = X.G * 8;
    constexpr int I_WIN = 16 * 112, I_UQ = 4 * 24, I_UKV = 4 * 32, I_WO = 16 * 32, I_L = I_WIN + I_UQ + I_UKV + I_WO;
    for (int it = gw; it < DEPTH * I_L; it += NGW) {
        const int l = it / I_L; int r = it % I_L;
        if (r < I_WIN) { transpose_item(a.w_in + (size_t)l * DM * IN_COLS, IN_COLS, DM, (bf16*)(X.ws + WS_WIN) + (size_t)l * NIN * DM, DM, 64 * (r / 112), 32 * (r % 112), ColWin{}, nullptr, scr, X.lane); continue; }
        r -= I_WIN;
        if (r < I_UQ) { transpose_item(a.w_uq + (size_t)l * 256 * 768, 768, 256, (bf16*)(X.ws + WS_WUQ) + (size_t)l * 768 * 256, 256, 64 * (r / 24), 32 * (r % 24), ColUq{}, a.qn + l * 256, scr, X.lane); continue; }
        r -= I_UQ;
        if (r < I_UKV) { transpose_item(a.w_ukv + (size_t)l * 128 * 1024, 1024, 128, (bf16*)(X.ws + WS_WUKV) + (size_t)l * 1024 * 256, 256, 64 * (r / 32), 32 * (r % 32), ColAdj{}, a.kvn + l * 128, scr, X.lane); continue; }
        r -= I_UKV;
        transpose_item(a.w_o + (size_t)l * DM * DM, DM, DM, (bf16*)(X.ws + WS_WO) + (size_t)l * DM * DM, DM, 64 * (r / 32), 32 * (r % 32), ColAdj{}, nullptr, scr, X.lane);
    }
    const size_t gt = (size_t)X.vcu * 512 + X.tid, NGT = (size_t)X.G * 512;
    { float* rgt = (float*)(X.ws + WS_RGT); float* ret = (float*)(X.ws + WS_RET);
      for (size_t i = gt; i < (size_t)DEPTH * 4 * DM; i += NGT) { const int l = (int)(i / (4 * DM)), g = (int)(i / DM) & 3, k = (int)(i % DM); rgt[i] = a.rgw[((size_t)l * DM + k) * 4 + g]; }
      for (size_t i = gt; i < (size_t)DEPTH * 32 * DM; i += NGT) { const int l = (int)(i / (32 * DM)), ge = (int)(i / DM) & 31, k = (int)(i % DM); ret[i] = a.rew[(((size_t)l * 4 + (ge >> 3)) * DM + k) * 8 + (ge & 7)]; } }
    { u32x4* z = (u32x4*)(X.ws + WS_T1); for (size_t i = gt; i < (size_t)NT * 256 * 2 / 16; i += NGT) z[i] = (u32x4){0u, 0u, 0u, 0u}; }
    { const f32x4* xs = (const f32x4*)a.x; u32x2* xb = (u32x2*)(X.ws + WS_XB);
      for (size_t i = gt; i < (size_t)NT * DM / 4; i += NGT) { const f32x4 v = xs[i]; u32x2 w; w.x = pk2(v[0], v[1]); w.y = pk2(v[2], v[3]); xb[i] = w; } }
}
__device__ __forceinline__ void convert_experts(const Ctx& X, const CArgs* ap, int l) {
    struct { const float *wg, *wu, *wd; } a = {ap->wg, ap->wu, ap->wd};
    LAS float* scr = (LAS float*)(X.lds + X.wave * 16384);
    const int gw = X.vcu * 8 + X.wave, NGW = X.G * 8;
    constexpr int I_GU = 32 * 16 * 16, I_D = 32 * 4 * 32;
    for (int it = gw; it < I_GU + I_D; it += NGW) {
        if (it < I_GU) { const int e = it >> 8, r = it & 255, G32 = r >> 4, kb = r & 15; const int pn = G32 >> 3, r0 = (G32 & 7) * 32; const bool up = r0 >= 128;
            const float* W = (up ? a.wu : a.wg) + ((size_t)l * NEXP + e) * DM * FH;
            transpose_item(W, FH, DM, (bf16*)(X.ws + WS_WGU) + (size_t)e * 512 * DM, DM, 64 * kb, 32 * G32, ColIdent{128 * pn + (r0 & 127) - 32 * G32}, nullptr, scr, X.lane);
        } else { const int r = it - I_GU, e = r >> 7, q = r & 127, kb = q >> 5, pg = q & 31;
            transpose_item(a.wd + ((size_t)l * NEXP + e) * FH * DM, DM, FH, (bf16*)(X.ws + WS_WD) + (size_t)e * DM * FH, FH, 64 * kb, 32 * pg, ColAdj{}, nullptr, scr, X.lane); }
    }
}

struct InProjDesc {
    unsigned char* ws;
    __device__ __forceinline__ pg8::GroupDesc operator()(int pn, int bj, int wc) const {
        using namespace pg8; const int G = 8 * pn + 4 * bj + wc; GroupDesc d; d.kind = GK_PLAIN; d.dst = nullptr; d.pitch = 256; d.col = 0; d.scale = 1.f; d.perm = 0; d.ssq = nullptr; d.ssq_n = 0; d.ssq_i = 0;
        if (G < 8) { d.dst = (bf16*)(ws + WS_CQ); d.col = 32 * G; d.ssq = (float*)(ws + WS_SSQ); d.ssq_n = 8; d.ssq_i = G; }
        else if (G < 12) { d.dst = (bf16*)(ws + WS_T1); d.col = 32 * (G - 8); d.ssq = (float*)(ws + WS_SSQ) + (size_t)NT * 8; d.ssq_n = 4; d.ssq_i = G - 8; }
        else if (G == 12) { d.kind = GK_ROPE32; d.dst = (bf16*)(ws + WS_KPE); d.pitch = 32; d.col = 0; }
        else if (G == 13) { d.kind = GK_IDX8; d.dst = (bf16*)(ws + WS_KI); d.pitch = 32; d.col = 0; }
        else if (G == 14) { d.kind = GK_HEAD16; d.dst = (bf16*)(ws + WS_T1); d.col = 192; }
        else if (G == 15) { d.dst = (bf16*)(ws + WS_T1); d.col = 224; }
        else if (G < 24) { d.kind = ((G - 16) & 1) ? GK_PLAIN : GK_HEAD16; d.dst = (bf16*)(ws + WS_BQ); d.col = 32 * (G - 16); d.scale = QSC64; }
        else if (G < 26) { d.dst = (bf16*)(ws + WS_BV); d.pitch = 64; d.col = 32 * (G - 24); }
        else if (G == 26) { d.kind = GK_WI; d.dst = (bf16*)(ws + WS_WI); }
        else if (G < 32) { d.kind = GK_SKIP; }
        else if (G < 40) { d.kind = GK_IDX8; d.dst = (bf16*)(ws + WS_BQI); d.col = 32 * (G - 32); }
        else if (G < 64) { const int j = G - 40, cfg = j >> 3; d.kind = (j & 1) ? GK_PLAIN : GK_HEAD16; d.dst = (bf16*)(ws + WS_DQ) + (size_t)cfg * NT * 256; d.col = 32 * (j & 7); d.scale = QSC64; d.perm = cfg == 0 ? 0 : (cfg == 1 ? 4 : 16); }
        else if (G < 88) { const int j = G - 64, cfg = j >> 3; d.kind = (j & 1) ? GK_PLAIN : GK_HEAD16; d.dst = (bf16*)(ws + WS_DK) + (size_t)cfg * NT * 256; d.col = 32 * (j & 7); d.perm = cfg == 0 ? 0 : (cfg == 1 ? 4 : 16); }
        else { const int j = G - 88, cfg = j >> 3; d.dst = (bf16*)(ws + WS_DV) + (size_t)cfg * NT * 256; d.col = 32 * (j & 7); d.perm = cfg == 0 ? 0 : (cfg == 1 ? 4 : 16); }
        return d;
    }
};
struct UqDesc {
    unsigned char* ws;
    __device__ __forceinline__ pg8::GroupDesc operator()(int pn, int bj, int wc) const {
        using namespace pg8; const int G = 8 * pn + 4 * bj + wc; GroupDesc d; d.kind = (G % 3 == 2) ? GK_ROPE32 : GK_PLAIN; d.dst = (bf16*)(ws + WS_QA); d.pitch = 768; d.col = 32 * G; d.scale = QSC96; d.perm = 0; d.ssq = nullptr; d.ssq_n = 0; d.ssq_i = 0;
        return d;
    }
};

__device__ __forceinline__ unsigned f16key(float v) { const _Float16 hf = (_Float16)v; const unsigned u = (unsigned)__builtin_bit_cast(unsigned short, hf); return (u ^ ((unsigned)__builtin_amdgcn_sbfe((int)u, 15, 1) | 0x8000u)) & 0xffffu; }
__device__ __forceinline__ unsigned pk_cnt(unsigned acc, unsigned kp2, unsigned mid2, unsigned one2) {
    unsigned t;
    asm("v_pk_sub_u16 %0, %2, %3 clamp\n\tv_pk_min_u16 %0, %0, %4\n\tv_pk_add_u16 %1, %1, %0" : "=&v"(t), "+v"(acc) : "v"(kp2), "s"(mid2), "s"(one2));
    return acc;
}
__device__ __forceinline__ int count_gt(const unsigned (&kp)[16], unsigned mid) {
    const unsigned m2 = __builtin_amdgcn_readfirstlane(mid | (mid << 16)), one2 = __builtin_amdgcn_readfirstlane(0x00010001u);
    unsigned a0 = 0u, a1 = 0u;
#pragma unroll
    for (int i = 0; i < 16; i += 2) { a0 = pk_cnt(a0, kp[i], m2, one2); a1 = pk_cnt(a1, kp[i + 1], m2, one2); }
    unsigned aw; asm("v_pk_add_u16 %0, %1, %2" : "=v"(aw) : "v"(a0), "v"(a1));
    const unsigned c = (aw & 0xffffu) + (aw >> 16);
    int tot = 0;
#pragma unroll
    for (int b = 0; b < 6; ++b) tot += __builtin_popcountll(__ballot((c >> b) & 1u)) << b;
    return tot;
}
__device__ __forceinline__ int wave_scan_incl(int v) {
    v += __builtin_amdgcn_update_dpp(0, v, 0x111, 0xf, 0xf, false); v += __builtin_amdgcn_update_dpp(0, v, 0x112, 0xf, 0xf, false);
    v += __builtin_amdgcn_update_dpp(0, v, 0x114, 0xf, 0xf, false); v += __builtin_amdgcn_update_dpp(0, v, 0x118, 0xf, 0xf, false);
    v += __builtin_amdgcn_update_dpp(0, v, 0x142, 0xa, 0xf, false); v += __builtin_amdgcn_update_dpp(0, v, 0x143, 0xc, 0xf, false);
    return v;
}
__device__ __forceinline__ void radix_pick(const LAS unsigned* hist, int lane, int target, int& B, int& above, int& inbin) {
    const u32x2 hw = *(const LAS u32x2*)(hist + 2 * lane);
    const int c0 = (int)(hw.x & 0xffffu), c1 = (int)(hw.x >> 16), c2 = (int)(hw.y & 0xffffu), c3 = (int)(hw.y >> 16);
    const int tl = (c0 + c1) + (c2 + c3);
    const int pre = wave_scan_incl(tl);
    const int suf = __builtin_amdgcn_readlane(pre, 63) - pre + tl;
    const unsigned long long reach = __ballot(suf >= target);
    const int ls = 63 - __builtin_clzll(reach | 1ull);
    int a = suf - tl, b = 4 * lane + 3, ib = c3;
    if (a + c3 < target) { a += c3; b = 4 * lane + 2; ib = c2; if (a + c2 < target) { a += c2; b = 4 * lane + 1; ib = c1; if (a + c1 < target) { a += c1; b = 4 * lane; ib = c0; } } }
    B = __builtin_amdgcn_readlane(b, ls); above = __builtin_amdgcn_readlane(a, ls); inbin = __builtin_amdgcn_readlane(ib, ls);
}
__device__ __forceinline__ float relu_i(float x) { const int i = __builtin_bit_cast(int, x); return __builtin_bit_cast(float, i > 0 ? i : 0); }
__device__ __forceinline__ void dsa_index_unit(const Ctx& X, int b, int q0) {
    const int lane = X.lane, r = lane & 31, h = lane >> 5; const size_t seq0 = (size_t)b * SEQ; const int t0 = q0 + 4 * X.wave;
    const bf16* BQI = (const bf16*)(X.ws + WS_BQI); const bf16* KI = (const bf16*)(X.ws + WS_KI); const float* WI = (const float*)(X.ws + WS_WI);
    LAS unsigned short* rows = (LAS unsigned short*)(X.lds + X.wave * 16384);
    LAS unsigned char* kbuf = X.lds + LDS_X_OFF;
    const bf16* ap = BQI + (seq0 + t0 + (r >> 3)) * 256 + 32 * (r & 7) + 16 * h;
    const bf16x8 a0 = *(const bf16x8*)ap, a1 = *(const bf16x8*)(ap + 8);
    f32x2 wq[4][2];
#pragma unroll
    for (int j = 0; j < 4; ++j) { const f32x4 w = *(const f32x4*)(WI + (seq0 + t0 + j) * 8 + 4 * h);
        wq[j][0] = (f32x2){w[0] * IDX_SCALE, w[1] * IDX_SCALE}; wq[j][1] = (f32x2){w[2] * IDX_SCALE, w[3] * IDX_SCALE}; }
    const int nch = ((q0 + 31) >> 7) + 1;
    const int skey = X.tid >> 2, spc = X.tid & 3;
    const bf16* sp = KI + (seq0 + skey) * 32 + 8 * spc;
    const int sdst = skey * 64 + ((spc ^ ((skey >> 2) & 3)) << 4);
    u32x4 stg0 = *(const u32x4*)sp, stg1 = stg0, stg2 = stg0, stg3 = stg0;
    if (1 < nch) stg1 = *(const u32x4*)(sp + (size_t)1 * 128 * 32);
    if (2 < nch) stg2 = *(const u32x4*)(sp + (size_t)2 * 128 * 32);
    if (3 < nch) stg3 = *(const u32x4*)(sp + (size_t)3 * 128 * 32);
    *(LAS u32x4*)(kbuf + sdst) = stg0;
    __syncthreads();
#define DSA_STEP(J, RCUR, RNEXT) { const int c = c0 + (J); \
        if (c + 4 < nch) RCUR = *(const u32x4*)(sp + (size_t)(c + 4) * 128 * 32); \
        const LAS unsigned char* kb = kbuf + (c & 1) * 8192; \
        _Pragma("unroll") for (int tq = 0; tq < 4; ++tq) { \
            const int key = 32 * tq + r, sw = (key >> 2) & 3; \
            const bf16x8 b0 = *(const LAS bf16x8*)(kb + key * 64 + (((2 * h) ^ sw) << 4)), b1 = *(const LAS bf16x8*)(kb + key * 64 + (((2 * h + 1) ^ sw) << 4)); \
            f32x16 acc; \
            _Pragma("unroll") for (int i = 0; i < 16; ++i) acc[i] = 0.f; \
            acc = __builtin_amdgcn_mfma_f32_32x32x16_bf16(a0, b0, acc, 0, 0, 0); \
            acc = __builtin_amdgcn_mfma_f32_32x32x16_bf16(a1, b1, acc, 0, 0, 0); \
            float p[4]; \
            _Pragma("unroll") for (int j = 0; j < 4; ++j) {            \
                const f32x2 ra = {relu_i(acc[4 * j]), relu_i(acc[4 * j + 1])}, rb = {relu_i(acc[4 * j + 2]), relu_i(acc[4 * j + 3])}; \
                const f32x2 pp = __builtin_elementwise_fma(rb, wq[j][1], ra * wq[j][0]); \
                p[j] = pp.x + pp.y; } \
            const auto s01 = __builtin_amdgcn_permlane32_swap(__float_as_uint(p[0]), __float_as_uint(p[1]), false, false); \
            const auto s23 = __builtin_amdgcn_permlane32_swap(__float_as_uint(p[2]), __float_as_uint(p[3]), false, false); \
            const float va = __uint_as_float(s01[0]) + __uint_as_float(s01[1]), vb = __uint_as_float(s23[0]) + __uint_as_float(s23[1]); \
            const int hw = 128 * c + 32 * tq + r;                                      \
            rows[h * 2048 + hw] = (unsigned short)f16key(va); \
            rows[(2 + h) * 2048 + hw] = (unsigned short)f16key(vb); \
        } \
        if (c + 1 < nch) *(LAS u32x4*)(kbuf + ((c + 1) & 1) * 8192 + sdst) = RNEXT; \
        __syncthreads(); }
#ifndef REP_SCORE
#define REP_SCORE 1
#endif
#ifndef REP_SEL
#define REP_SEL 1
#endif
    for (int rsc = 0; rsc < REP_SCORE; ++rsc) {
    if (rsc > 0) { stg0 = *(const u32x4*)sp; stg1 = stg0; stg2 = stg0; stg3 = stg0; if (1 < nch) stg1 = *(const u32x4*)(sp + (size_t)1 * 128 * 32); if (2 < nch) stg2 = *(const u32x4*)(sp + (size_t)2 * 128 * 32); if (3 < nch) stg3 = *(const u32x4*)(sp + (size_t)3 * 128 * 32); *(LAS u32x4*)(kbuf + sdst) = stg0; __syncthreads(); }
    for (int c0 = 0; c0 < nch; c0 += 4) {
        DSA_STEP(0, stg0, stg1)
        if (c0 + 1 >= nch) break;
        DSA_STEP(1, stg1, stg2)
        if (c0 + 2 >= nch) break;
        DSA_STEP(2, stg2, stg3)
        if (c0 + 3 >= nch) break;
        DSA_STEP(3, stg3, stg0)
    }
    }
#undef DSA_STEP
    unsigned* BMp = (unsigned*)(X.ws + WS_BM);
#ifndef REP_BIS
#define REP_BIS 1
#endif
#ifndef REP_EMIT
#define REP_EMIT 1
#endif
    for (int rsl = 0; rsl < REP_SEL; ++rsl)
    for (int j = 0; j < 4; ++j) {
        const int t = t0 + j;
        const LAS u32x4* rw = (const LAS u32x4*)(rows + j * 2048) + 4 * lane;
        unsigned kp[16];
#pragma unroll
        for (int v4 = 0; v4 < 4; ++v4) { const u32x4 d = rw[v4]; kp[4 * v4] = d.x; kp[4 * v4 + 1] = d.y; kp[4 * v4 + 2] = d.z; kp[4 * v4 + 3] = d.w; }
        const int nv = t + 1 - 32 * lane;
#pragma unroll
        for (int d = 0; d < 16; ++d) kp[d] &= ((2 * d < nv) ? 0xffffu : 0u) | ((2 * d + 1 < nv) ? 0xffff0000u : 0u);
        unsigned thr = 0u; int need = 0;
        for (int rb_ = 0; rb_ < REP_BIS; ++rb_)
        if (t + 1 > 256) {
            LAS unsigned* hist = (LAS unsigned*)(X.lds + LDS_HIST_OFF + X.wave * 512);
            *(LAS u32x2*)(hist + 2 * lane) = (u32x2){0u, 0u};
#pragma unroll
            for (int d = 0; d < 16; ++d) { const unsigned klo = kp[d] & 0xffffu, khi = kp[d] >> 16;
                if (klo) __hip_atomic_fetch_add(hist + (klo >> 9), (klo & 0x100u) ? 0x10000u : 1u, __ATOMIC_RELAXED, __HIP_MEMORY_SCOPE_WORKGROUP);
                if (khi) __hip_atomic_fetch_add(hist + (khi >> 9), (khi & 0x100u) ? 0x10000u : 1u, __ATOMIC_RELAXED, __HIP_MEMORY_SCOPE_WORKGROUP); }
            int B1, above1, in1; radix_pick(hist, lane, 256, B1, above1, in1);
            *(LAS u32x2*)(hist + 2 * lane) = (u32x2){0u, 0u};
#pragma unroll
            for (int d = 0; d < 16; ++d) { const unsigned klo = kp[d] & 0xffffu, khi = kp[d] >> 16;
                if ((int)(klo >> 8) == B1) __hip_atomic_fetch_add(hist + ((klo & 0xffu) >> 1), (klo & 1u) ? 0x10000u : 1u, __ATOMIC_RELAXED, __HIP_MEMORY_SCOPE_WORKGROUP);
                if ((int)(khi >> 8) == B1) __hip_atomic_fetch_add(hist + ((khi & 0xffu) >> 1), (khi & 1u) ? 0x10000u : 1u, __ATOMIC_RELAXED, __HIP_MEMORY_SCOPE_WORKGROUP); }
            int B2, above2, in2; radix_pick(hist, lane, 256 - above1, B2, above2, in2);
            const unsigned tk = ((unsigned)B1 << 8) | (unsigned)B2;
            const int rest = 256 - (above1 + above2);
            if (rest >= in2) { thr = tk - 1u; need = 0; } else { thr = tk; need = rest; }
        }
        unsigned word = 0u, eqw = 0u;
        const unsigned thr2 = __builtin_amdgcn_readfirstlane(thr | (thr << 16)), one2 = __builtin_amdgcn_readfirstlane(0x00010001u);
#pragma unroll
        for (int d = 0; d < 16; ++d) { unsigned g;
            asm("v_pk_sub_u16 %0, %1, %2 clamp\n\tv_pk_min_u16 %0, %0, %3" : "=&v"(g) : "v"(kp[d]), "s"(thr2), "s"(one2));
            word |= ((g | (g >> 15)) & 3u) << (2 * d); }
        if (need > 0) {
#pragma unroll
            for (int d = 0; d < 16; ++d) { unsigned g; const unsigned x = kp[d] ^ thr2;
                asm("v_pk_min_u16 %0, %1, %2" : "=v"(g) : "v"(x), "s"(one2));
                eqw |= ((~(g | (g >> 15))) & 3u) << (2 * d); }
            if (thr == 0u) eqw = 0u;
            const int ne = __builtin_popcount(eqw); const int inc = wave_scan_incl(ne);
            int take = need - (inc - ne); take = take < 0 ? 0 : (take > ne ? ne : take);
            while (__any(take > 0)) { if (take > 0) { const unsigned lowbit = eqw & (0u - eqw); word |= lowbit; eqw ^= lowbit; --take; } }
        }
        BMp[(seq0 + t) * 64 + lane] = word;
    }
}

__device__ __forceinline__ void dil_combine(const Ctx& X) {
    const bf16* OD = (const bf16*)(X.ws + WS_OD); const float* LS = (const float*)(X.ws + WS_LSE); bf16* O = (bf16*)(X.ws + WS_XB);
    const int gw = X.vcu * 8 + X.wave, NGW = X.G * 8, lane = X.lane, hh = lane >> 4;
    for (int t = gw; t < NT; t += NGW) {
        const int b = t >> 11, s = t & 2047;
        const int r0 = t, r1 = (b << 11) + ((s & 3) << 9) + (s >> 2), r2 = (b << 11) + ((s & 15) << 7) + (s >> 4);
        const float L0 = LS[(size_t)r0 * 4 + hh], L1 = LS[((size_t)NT + r1) * 4 + hh], L2 = LS[((size_t)2 * NT + r2) * 4 + hh];
        const float mx = fmaxf(L0, fmaxf(L1, L2));
        float w0 = __builtin_amdgcn_exp2f(L0 - mx), w1 = __builtin_amdgcn_exp2f(L1 - mx), w2 = __builtin_amdgcn_exp2f(L2 - mx);
        const float inv = 1.0f / (w0 + w1 + w2); w0 *= inv; w1 *= inv; w2 *= inv;
        const u32x2 a = *(const u32x2*)(OD + (size_t)r0 * 256 + 4 * lane), bq = *(const u32x2*)(OD + ((size_t)NT + r1) * 256 + 4 * lane), cq = *(const u32x2*)(OD + ((size_t)2 * NT + r2) * 256 + 4 * lane);
        u32x2 o;
        o.x = pk2(w0 * bflo(a.x) + w1 * bflo(bq.x) + w2 * bflo(cq.x), w0 * bfhi(a.x) + w1 * bfhi(bq.x) + w2 * bfhi(cq.x));
        o.y = pk2(w0 * bflo(a.y) + w1 * bflo(bq.y) + w2 * bflo(cq.y), w0 * bfhi(a.y) + w1 * bfhi(bq.y) + w2 * bfhi(cq.y));
        stg8<NT_ATT>(O + (size_t)t * DM + 768 + 4 * lane, o);
    }
}

__device__ __forceinline__ void ln1_router(const Ctx& X, const CArgs* ap, int l, bool first, bool dummy = false) {
    struct { const float *ln1g, *ln1b, *rgb, *reb; float* out; } a = {ap->ln1g, ap->ln1b, ap->rgb, ap->reb, dummy ? (float*)(X.ws + WS_QA) : ap->out}; const float* xin = first ? ap->x : ap->out;
    const int lane = X.lane; const bf16* MIX = (const bf16*)(X.ws + WS_MIX); bf16* X1B = (bf16*)(X.ws + (dummy ? WS_Y : WS_XB));
    LAS float* reT = (LAS float*)X.lds;
    LAS float* rgT = (LAS float*)(X.lds + LDS_X_OFF);
    LAS int* hist = (LAS int*)(X.lds + LDSCTL_OFF + 256);
    { const u32x4* s1 = (const u32x4*)(X.ws + WS_RET + (size_t)l * 32 * DM * 4); for (int i = X.tid; i < 32 * DM / 4; i += 512) ((LAS u32x4*)reT)[i] = s1[i];
      const u32x4* s2 = (const u32x4*)(X.ws + WS_RGT + (size_t)l * 4 * DM * 4); for (int i = X.tid; i < 4 * DM / 4; i += 512) ((LAS u32x4*)rgT)[i] = s2[i]; }
    f32x4 g[4], bb[4];
#pragma unroll
    for (int j = 0; j < 4; ++j) { g[j] = *(const f32x4*)(a.ln1g + l * DM + 4 * lane + 256 * j); bb[j] = *(const f32x4*)(a.ln1b + l * DM + 4 * lane + 256 * j); }
    const float* rgb = a.rgb + l * 4; const float* reb = a.reb + l * 32;
    for (int rb = X.c; rb < NT / 256; rb += X.G) {
        if (X.tid < 32) hist[X.tid] = 0;
        __syncthreads();
        f32x4 xa[4], xb[4]; u32x2 ma[4], mb[4];
        { const int t = rb * 256 + X.wave * 32;
#pragma unroll
          for (int j = 0; j < 4; ++j) { xa[j] = ldg_s<f32x4>(xin + (size_t)t * DM + 4 * lane + 256 * j); ma[j] = *(const u32x2*)(MIX + (size_t)t * DM + 4 * lane + 256 * j); }
#pragma unroll
          for (int j = 0; j < 4; ++j) { xb[j] = ldg_s<f32x4>(xin + (size_t)(t + 1) * DM + 4 * lane + 256 * j); mb[j] = *(const u32x2*)(MIX + (size_t)(t + 1) * DM + 4 * lane + 256 * j); } }
        auto row = [&](f32x4 (&xn)[4], u32x2 (&mn)[4], const int i) __attribute__((always_inline)) {
            const int t = rb * 256 + X.wave * 32 + i;
            f32x4 v[4]; float s = 0.f;
#pragma unroll
            for (int j = 0; j < 4; ++j) { const f32x4 xv = xn[j]; const u32x2 mw = mn[j];
                v[j][0] = ALPHA * xv[0] + bflo(mw.x); v[j][1] = ALPHA * xv[1] + bfhi(mw.x); v[j][2] = ALPHA * xv[2] + bflo(mw.y); v[j][3] = ALPHA * xv[3] + bfhi(mw.y);
                s += (v[j][0] + v[j][1]) + (v[j][2] + v[j][3]); }
            if (i + 2 < 32) {
#pragma unroll
                for (int j = 0; j < 4; ++j) { xn[j] = ldg_s<f32x4>(xin + (size_t)(t + 2) * DM + 4 * lane + 256 * j); mn[j] = *(const u32x2*)(MIX + (size_t)(t + 2) * DM + 4 * lane + 256 * j); } }
            const float mean = wave_sum(s) * (1.f / DM); float s2 = 0.f;
#pragma unroll
            for (int j = 0; j < 4; ++j) { v[j] = v[j] - mean; s2 += (v[j][0] * v[j][0] + v[j][1] * v[j][1]) + (v[j][2] * v[j][2] + v[j][3] * v[j][3]); }
            const float rstd = 1.0f / sqrtf(wave_sum(s2) * (1.f / DM) + 1e-5f);
#pragma unroll
            for (int j = 0; j < 4; ++j) { v[j] = v[j] * rstd * g[j] + bb[j];
                u32x2 w; w.x = pk2(v[j][0], v[j][1]); w.y = pk2(v[j][2], v[j][3]); stg8<NT_LN>(X1B + (size_t)t * DM + 4 * lane + 256 * j, w); }
            float lg[4];
#pragma unroll
            for (int gi = 0; gi < 4; ++gi) { f32x2 p2 = {0.f, 0.f};
#pragma unroll
                for (int j = 0; j < 4; ++j) { const f32x4 w = *(const LAS f32x4*)(rgT + gi * DM + 4 * lane + 256 * j);
                    p2 = __builtin_elementwise_fma((f32x2){v[j][0], v[j][1]}, (f32x2){w[0], w[1]}, p2); p2 = __builtin_elementwise_fma((f32x2){v[j][2], v[j][3]}, (f32x2){w[2], w[3]}, p2); }
                lg[gi] = wave_sum(p2.x + p2.y) + rgb[gi]; }
            int gs = 0; float gm = lg[0];
#pragma unroll
            for (int gi = 1; gi < 4; ++gi) if (lg[gi] > gm) { gm = lg[gi]; gs = gi; }
            float den = 0.f;
#pragma unroll
            for (int gi = 0; gi < 4; ++gi) den += __expf(lg[gi] - gm);
            const float ptop = __builtin_amdgcn_rcpf(den);
            gs = __builtin_amdgcn_readfirstlane(gs);
            float le[8];
#pragma unroll
            for (int e = 0; e < 8; ++e) { f32x2 p2 = {0.f, 0.f};
#pragma unroll
                for (int j = 0; j < 4; ++j) { const f32x4 w = *(const LAS f32x4*)(reT + (gs * 8 + e) * DM + 4 * lane + 256 * j);
                    p2 = __builtin_elementwise_fma((f32x2){v[j][0], v[j][1]}, (f32x2){w[0], w[1]}, p2); p2 = __builtin_elementwise_fma((f32x2){v[j][2], v[j][3]}, (f32x2){w[2], w[3]}, p2); }
                le[e] = wave_sum(p2.x + p2.y) + reb[gs * 8 + e]; }
            int e1 = 0; float v1 = le[0];
#pragma unroll
            for (int e = 1; e < 8; ++e) if (le[e] > v1) { v1 = le[e]; e1 = e; }
            int e2 = -1; float v2 = -INFINITY;
#pragma unroll
            for (int e = 0; e < 8; ++e) if (e != e1 && le[e] > v2) { v2 = le[e]; e2 = e; }
            const float wa = __builtin_amdgcn_rcpf(1.0f + __expf(v2 - v1)), wb = 1.0f - wa;
            if (lane == 0) { u32x4 ro; ro.x = (unsigned)(gs * 8 + e1); ro.y = (unsigned)(gs * 8 + e2); ro.z = __builtin_bit_cast(unsigned, ptop * wa); ro.w = __builtin_bit_cast(unsigned, ptop * wb);
                *(u32x4*)(X.ws + WS_ROUTE + (size_t)t * 16) = ro;
                __hip_atomic_fetch_add(hist + gs * 8 + e1, 1, __ATOMIC_RELAXED, __HIP_MEMORY_SCOPE_WORKGROUP); __hip_atomic_fetch_add(hist + gs * 8 + e2, 1, __ATOMIC_RELAXED, __HIP_MEMORY_SCOPE_WORKGROUP); }
        };
#pragma unroll 1
        for (int i = 0; i < 32; i += 2) { row(xa, ma, i); row(xb, mb, i + 1); }
        __syncthreads();
        if (X.tid < 32) ((int*)(X.ws + WS_HIST))[rb * 32 + X.tid] = hist[X.tid];
        __syncthreads();
    }
}

__device__ __forceinline__ void moe_dispatch(const Ctx& X) {
    LAS int* cnt = (LAS int*)(X.lds);
    LAS int* pre = cnt + 32;
    LAS int* ebase = cnt + 64;
    LAS int* wcnt = cnt + 128;
    const int* HIST = (const int*)(X.ws + WS_HIST); int* STOK = (int*)(X.ws + WS_STOK); float* SW = (float*)(X.ws + WS_SW); int* TSLOT = (int*)(X.ws + WS_TSLOT); int* TILEE = (int*)(X.ws + WS_TILEE);
    for (int rb = X.c; rb < NT / 256; rb += X.G) {
        if (X.tid < 64) cnt[X.tid] = 0;
        __syncthreads();
        { const int e = X.tid & 31, part = X.tid >> 5; int sa = 0, sp = 0;
          for (int q = 0; q < 16; ++q) { const int b2 = part * 16 + q; const int hv = HIST[b2 * 32 + e]; sa += hv; if (b2 < rb) sp += hv; }
          __hip_atomic_fetch_add(cnt + e, sa, __ATOMIC_RELAXED, __HIP_MEMORY_SCOPE_WORKGROUP); __hip_atomic_fetch_add(pre + e, sp, __ATOMIC_RELAXED, __HIP_MEMORY_SCOPE_WORKGROUP); }
        __syncthreads();
        if (X.tid < 64) { const int n = X.tid < 32 ? cnt[X.tid] : 0; const int pad = (n + 255) & ~255; int inc = pad;
#pragma unroll
            for (int o = 1; o < 32; o <<= 1) { const int u = __shfl_up(inc, o); if ((X.tid & 63) >= o) inc += u; }
            if (X.tid < 32) { ebase[X.tid] = inc - pad; if (X.tid == 31) ebase[32] = inc; } }
        __syncthreads();
        const int tl = X.tid >> 1, kk = X.tid & 1, t = rb * 256 + tl;
        const u32x4 ro = *(const u32x4*)(X.ws + WS_ROUTE + (size_t)t * 16);
        const int e = (int)(kk ? ro.y : ro.x); const float w = __builtin_bit_cast(float, kk ? ro.w : ro.z);
        int rank = 0;
        for (int ee = 0; ee < 32; ++ee) { const unsigned long long mm = __ballot(e == ee);
            if (e == ee) rank = __builtin_popcountll(mm & ((1ull << X.lane) - 1ull));
            if (X.lane == 0) wcnt[X.wave * 32 + ee] = __builtin_popcountll(mm); }
        __syncthreads();
        int off = 0;
        for (int w2 = 0; w2 < X.wave; ++w2) off += wcnt[w2 * 32 + e];
        const int slot = ebase[e] + pre[e] + off + rank;
        STOK[slot] = t; SW[slot] = w; TSLOT[2 * t + kk] = slot;
        if (rb < 32) { const int e2 = rb; for (int s = ebase[e2] + cnt[e2] + X.tid; s < ebase[e2 + 1]; s += 512) { STOK[s] = 0; SW[s] = 0.f; } }
        if (rb == 0) { const int ntl = ebase[32] >> 8;
            for (int tile = X.tid; tile < ntl; tile += 512) { int ee = 0; while (ee < 31 && ebase[ee + 1] <= tile * 256) ++ee; TILEE[tile] = ee; }
            if (X.tid == 0) TILEE[1024] = ntl; }
        __syncthreads();
    }
}

__device__ __forceinline__ void ln2_phase(const Ctx& X, const CArgs* ap, int l, bool first, bool dummy = false) {
    struct { const float *ln1g, *ln1b, *ln2g, *ln2b; } a = {ap->ln1g, ap->ln1b, ap->ln2g, ap->ln2b}; float* outw = dummy ? (float*)(X.ws + WS_Y + 272 * MiB) : ap->out;
    const float* xin = first ? ap->x : ap->out;
    const int lane = X.lane; const bf16* Y = (const bf16*)(X.ws + WS_Y); const bf16* MIX = (const bf16*)(X.ws + WS_MIX); const int* TSLOT = (const int*)(X.ws + WS_TSLOT); bf16* XBp = (bf16*)(X.ws + (dummy ? WS_MIX : WS_XB));
    f32x4 g1[4], b1[4], g[4], bb[4];
#pragma unroll
    for (int j = 0; j < 4; ++j) { g1[j] = *(const f32x4*)(a.ln1g + l * DM + 4 * lane + 256 * j); b1[j] = *(const f32x4*)(a.ln1b + l * DM + 4 * lane + 256 * j);
        g[j] = *(const f32x4*)(a.ln2g + l * DM + 4 * lane + 256 * j); bb[j] = *(const f32x4*)(a.ln2b + l * DM + 4 * lane + 256 * j); }
    for (int rb = X.c; rb < NT / 256; rb += X.G) {
        const int tb = rb * 256 + X.wave * 32;
        const int myslots_a = TSLOT[2 * (tb + (lane & 31))], myslots_b = TSLOT[2 * (tb + (lane & 31)) + 1];
        f32x4 xn[4]; u32x2 mn[4], yan[4], ybn[4];
        { const int sa = __builtin_amdgcn_readlane(myslots_a, 0), sb = __builtin_amdgcn_readlane(myslots_b, 0);
#pragma unroll
          for (int j = 0; j < 4; ++j) { xn[j] = ldg_s<f32x4>(xin + (size_t)tb * DM + 4 * lane + 256 * j); mn[j] = *(const u32x2*)(MIX + (size_t)tb * DM + 4 * lane + 256 * j);
              yan[j] = ldg_s<u32x2>(Y + (size_t)sa * DM + 4 * lane + 256 * j); ybn[j] = ldg_s<u32x2>(Y + (size_t)sb * DM + 4 * lane + 256 * j); } }
        for (int i = 0; i < 32; ++i) {
            const int t = tb + i;
            f32x4 v[4]; float s = 0.f;
#pragma unroll
            for (int j = 0; j < 4; ++j) { const f32x4 xv = xn[j]; const u32x2 mw = mn[j];
                v[j][0] = ALPHA * xv[0] + bflo(mw.x); v[j][1] = ALPHA * xv[1] + bfhi(mw.x); v[j][2] = ALPHA * xv[2] + bflo(mw.y); v[j][3] = ALPHA * xv[3] + bfhi(mw.y);
                s += (v[j][0] + v[j][1]) + (v[j][2] + v[j][3]); }
            u32x2 ya[4], yb[4];
#pragma unroll
            for (int j = 0; j < 4; ++j) { ya[j] = yan[j]; yb[j] = ybn[j]; }
            if (i + 1 < 32) { const int sa = __shfl(myslots_a, i + 1), sb = __shfl(myslots_b, i + 1);
#pragma unroll
                for (int j = 0; j < 4; ++j) { xn[j] = ldg_s<f32x4>(xin + (size_t)(t + 1) * DM + 4 * lane + 256 * j); mn[j] = *(const u32x2*)(MIX + (size_t)(t + 1) * DM + 4 * lane + 256 * j);
                    yan[j] = ldg_s<u32x2>(Y + (size_t)sa * DM + 4 * lane + 256 * j); ybn[j] = ldg_s<u32x2>(Y + (size_t)sb * DM + 4 * lane + 256 * j); } }
            { const float mean = wave_sum(s) * (1.f / DM); float s2 = 0.f;
#pragma unroll
              for (int j = 0; j < 4; ++j) { v[j] = v[j] - mean; s2 += (v[j][0] * v[j][0] + v[j][1] * v[j][1]) + (v[j][2] * v[j][2] + v[j][3] * v[j][3]); }
              const float rstd = 1.0f / sqrtf(wave_sum(s2) * (1.f / DM) + 1e-5f);
#pragma unroll
              for (int j = 0; j < 4; ++j) v[j] = v[j] * rstd * g1[j] + b1[j]; }
            s = 0.f;
#pragma unroll
            for (int j = 0; j < 4; ++j) { const f32x4 xv = v[j];
                v[j][0] = ALPHA * xv[0] + (bflo(ya[j].x) + bflo(yb[j].x)); v[j][1] = ALPHA * xv[1] + (bfhi(ya[j].x) + bfhi(yb[j].x)); v[j][2] = ALPHA * xv[2] + (bflo(ya[j].y) + bflo(yb[j].y)); v[j][3] = ALPHA * xv[3] + (bfhi(ya[j].y) + bfhi(yb[j].y));
                s += (v[j][0] + v[j][1]) + (v[j][2] + v[j][3]); }
            const float mean = wave_sum(s) * (1.f / DM); float s2 = 0.f;
#pragma unroll
            for (int j = 0; j < 4; ++j) { v[j] = v[j] - mean; s2 += (v[j][0] * v[j][0] + v[j][1] * v[j][1]) + (v[j][2] * v[j][2] + v[j][3] * v[j][3]); }
            const float rstd = 1.0f / sqrtf(wave_sum(s2) * (1.f / DM) + 1e-5f);
#pragma unroll
            for (int j = 0; j < 4; ++j) { v[j] = v[j] * rstd * g[j] + bb[j];
                stgf4<NT_LN>(outw + (size_t)t * DM + 4 * lane + 256 * j, v[j]);
                if (l + 1 < DEPTH) { u32x2 w; w.x = pk2(v[j][0], v[j][1]); w.y = pk2(v[j][2], v[j][3]); stg8<NT_LN>(XBp + (size_t)t * DM + 4 * lane + 256 * j, w); } }
        }
    }
}

#ifndef REP_P0
#define REP_P0 1
#endif
#ifndef REP_P5
#define REP_P5 1
#endif
#ifndef REP_P9
#define REP_P9 1
#endif
#ifndef REP_BAR
#define REP_BAR 1
#endif
#ifndef REP_P1
#define REP_P1 1
#endif
#ifndef REP_P2A
#define REP_P2A 1
#endif
#ifndef REP_P2B
#define REP_P2B 1
#endif
#ifndef REP_P2C
#define REP_P2C 1
#endif
#ifndef REP_P2D
#define REP_P2D 1
#endif
#ifndef REP_P3A
#define REP_P3A 1
#endif
#ifndef REP_P3B
#define REP_P3B 1
#endif
#ifndef REP_P3C
#define REP_P3C 1
#endif
#ifndef REP_P4
#define REP_P4 1
#endif
#ifndef REP_P6
#define REP_P6 1
#endif
#ifndef REP_P7
#define REP_P7 1
#endif
#ifndef REP_P8
#define REP_P8 1
#endif
__global__ void __launch_bounds__(512, 2) mk_fwd(Args a) {
    extern __shared__ __attribute__((aligned(16))) unsigned char lds_raw[];
    LAS unsigned char* const lds0 = (LAS unsigned char*)lds_raw;
    for (int u = threadIdx.x; u < (LDS_BYTES - LDSCTL_OFF) / 4; u += 512) ((LAS unsigned*)(lds0 + LDSCTL_OFF))[u] = 0u;
    __syncthreads();
    unsigned* barw = (unsigned*)(a.ws + WS_CTL) + CW_BAR;
    XcdBarrier bar; bar.bar = barw; bar.x = 0; bar.st = nullptr;
    if (a.use_bar) bar = xcd_barrier_post(barw, (volatile LAS unsigned*)(lds0 + LDSCTL_OFF) + 8);
#define MKCTX() Ctx X; const CArgs* ap = (const CArgs*)__builtin_amdgcn_kernarg_segment_ptr(); asm volatile("" : "+s"(ap)); { int t_ = threadIdx.x; asm volatile("" : "+v"(t_)); X.lds = lds0; X.tid = t_; X.lane = t_ & 63; X.wave = __builtin_amdgcn_readfirstlane(t_ >> 6); \
        unsigned char* w_ = ap->ws; X.G = gridDim.x; X.c = blockIdx.x; X.vcu = (X.G % 8 == 0) ? (X.c % 8) * (X.G / 8) + X.c / 8 : X.c; X.ws = w_; }
#ifndef P2M
#define P2M 31
#endif
#ifndef PH_MASK0
#define PH_MASK0 1
#endif
#define GBAR() do { if (a.use_bar) for (int rb_ = 0; rb_ < REP_BAR; ++rb_) xcd_barrier(bar); } while (0)

    if ((PH_MASK0 & 1) && a.l_lo == 0 && a.ph_lo == 0) { MKCTX(); for (int rep = 0; rep < REP_P0; ++rep) { prologue(X, ap); __syncthreads(); } GBAR(); }

    for (int l = a.l_lo; l < a.l_hi; ++l) {
        const int lo = (l == a.l_lo) ? (a.ph_lo < 1 ? 1 : a.ph_lo) : 1, hi = (l == a.l_hi - 1) ? a.ph_hi : 10;
#ifndef PH_MASK
#define PH_MASK 0x3ff
#endif
#define IN(k) (((PH_MASK >> (k)) & 1) && lo <= (k) && (k) < hi)
        if (IN(1)) { MKCTX();
            pg8::Gemm g{(const bf16*)(X.ws + WS_XB), (const bf16*)(X.ws + WS_WIN) + (size_t)l * NIN * DM, DM, nullptr};
            pg8::StaticOrder S; S.init(NT, NIN, X.G, X.c, REP_P1);
            pg8::RopeTabs R{ap->pos};
            pg8::EpiGroups<InProjDesc> E{InProjDesc{X.ws}, R, nullptr, 0, 0.f, 0.f};
            pg8::gemm_phase<pg8::EpiGroups<InProjDesc>, pg8::StaticOrder, false>(X.lds, g, S, E, X.tid);
            GBAR();
        }
        if (IN(2)) { MKCTX();
            {
                pg8::Gemm g{(const bf16*)(X.ws + WS_CQ), (const bf16*)(X.ws + WS_WUQ) + (size_t)l * 768 * 256, 256, nullptr};
                pg8::StaticOrder S; S.init(NT, 768, X.G, X.c, REP_P2A);
                pg8::RopeTabs R{ap->pos};
                pg8::EpiGroups<UqDesc> E{UqDesc{X.ws}, R, (const float*)(X.ws + WS_SSQ), 8, 1.0f / 256.0f, 1e-6f};
                pg8::gemm_phase<pg8::EpiGroups<UqDesc>, pg8::StaticOrder, false>(X.lds, g, S, E, X.tid);
            }
            {
                pg8::Gemm g{(const bf16*)(X.ws + WS_T1), (const bf16*)(X.ws + WS_WUKV) + (size_t)l * 1024 * 256, 256, nullptr};
                pg8::StaticOrder S; S.init(NT, 1024, X.G, X.c, REP_P2A);
                pg8::EpiPlainT<NT_KVA> E{(bf16*)(X.ws + WS_KVA), 1024, (const float*)(X.ws + WS_SSQ) + (size_t)NT * 8, 4, 1.0f / 128.0f, 1e-6f, X.lds + LDS_X_OFF};
                pg8::gemm_phase<decltype(E), pg8::StaticOrder, false>(X.lds, g, S, E, X.tid);
            }
            __syncthreads();
            for (int rep = 0; rep < REP_P2B; ++rep) convert_experts(X, ap, l);
            __syncthreads();
            for (int rep = 0; rep < REP_P2C; ++rep) for (int U = X.vcu; U < NB * 32; U += X.G) { const int b = U >> 5, pr = U & 31;
                dsa_index_unit(X, b, 32 * pr); dsa_index_unit(X, b, 32 * (63 - pr)); }
            __syncthreads();
#pragma unroll 1
            for (int cfg = 0; cfg < 3 * REP_P2D; ++cfg) { const int cfgi = cfg % 3;
                fa::Params P; const size_t co = (size_t)cfgi * NT * 256;
                P.Q = (const bf16*)(X.ws + WS_DQ) + co; P.q_pitch = 256; P.K1 = (const bf16*)(X.ws + WS_DK) + co; P.k1_pitch = 256; P.K2 = nullptr; P.k2_pitch = 0; P.k2_col = 0;
                P.V = (const bf16*)(X.ws + WS_DV) + co; P.v_pitch = 256; P.O = (bf16*)(X.ws + WS_OD) + co; P.o_pitch = 256; P.LSE = (float*)(X.ws + WS_LSE) + (size_t)cfgi * NT * 4; P.lse_pitch = 4; P.BM = nullptr;
                P.CL = cfgi == 0 ? 2048 : (cfgi == 1 ? 512 : 128); P.W = 128;
                const int vcu = X.vcu, G = X.G, wv = X.wave, CLc = P.CL;
                fa::attn_stream<64, 0>(P, X.lds, X.tid, (NB * 4 * 8 - vcu + G - 1) / G, [=](int j) { const int U = vcu + j * G, bh = U >> 3, qb = U & 7, b = bh >> 2, hh = bh & 3;
                    const int q0 = 256 * qb; int klo = q0 & ~(CLc - 1); if (q0 - 128 > klo) klo = q0 - 128;
                    return fa::UnitDesc{b * SEQ, q0 + 32 * wv, 64 * hh, 64 * hh, hh, 64 * hh, 64 * hh, klo >> 6, (q0 + 255) >> 6}; });
            }
            GBAR();
        }
        if (IN(3)) { MKCTX();
            {   fa::Params P; P.Q = (const bf16*)(X.ws + WS_QA); P.q_pitch = 768; P.K1 = (const bf16*)(X.ws + WS_KVA); P.k1_pitch = 1024; P.K2 = (const bf16*)(X.ws + WS_KPE); P.k2_pitch = 32; P.k2_col = 0;
                P.V = (const bf16*)(X.ws + WS_KVA); P.v_pitch = 1024; P.O = (bf16*)(X.ws + WS_XB); P.o_pitch = DM; P.LSE = nullptr; P.lse_pitch = 0; P.BM = nullptr; P.CL = 2048; P.W = 1 << 20;
                const int vcu = X.vcu, G = X.G, wv = X.wave;
                fa::attn_stream<96, 2>(P, X.lds, X.tid, 2 * ((NB * 8 * 4 - vcu + G - 1) / G), [=](int j) { const int U = vcu + (j >> 1) * G, bh = U >> 2, pr = U & 3, b = bh >> 3, hd = bh & 7;
                    const int qb = (j & 1) ? 7 - pr : pr, q0 = 256 * qb;
                    return fa::UnitDesc{b * SEQ, q0 + 32 * wv, 96 * hd, 64 * hd, 0, 128 * hd, 128 * hd + 64, 0, (q0 + 255) >> 6}; });
            }
            {   fa::Params P; P.Q = (const bf16*)(X.ws + WS_BQ); P.q_pitch = 256; P.K1 = (const bf16*)(X.ws + WS_T1); P.k1_pitch = 256; P.k1_col = 192; P.K2 = nullptr; P.k2_pitch = 0; P.k2_col = 0;
                P.V = (const bf16*)(X.ws + WS_BV); P.v_pitch = 64; P.v_col = 0; P.O = (bf16*)(X.ws + WS_XB); P.o_pitch = DM; P.LSE = nullptr; P.lse_pitch = 0; P.BM = (const unsigned*)(X.ws + WS_BM); P.CL = 2048; P.W = 1 << 20;
                const int hd = X.wave & 3, sub = X.wave >> 2, vcu = X.vcu, G = X.G;
                fa::attn_stream<64, 1>(P, X.lds, X.tid, 2 * ((NB * 16 - vcu + G - 1) / G), [=](int j) { const int U = vcu + (j >> 1) * G, b = U >> 4, pr = U & 15;
                    const int qb = (j & 1) ? 31 - pr : pr, q0 = 64 * qb;
                    return fa::UnitDesc{b * SEQ, q0 + 32 * sub, 64 * hd, 512 + 64 * hd, 0, 192, 0, 0, qb}; });
            }
            for (int rep = 0; rep < REP_P3C; ++rep) dil_combine(X);
            GBAR();
        }
        if (IN(4)) { MKCTX();
            pg8::Gemm g{(const bf16*)(X.ws + WS_XB), (const bf16*)(X.ws + WS_WO) + (size_t)l * DM * DM, DM, nullptr};
            pg8::StaticOrder S; S.init(NT, DM, X.G, X.c, REP_P4);
            pg8::EpiPlainT<NT_MIX> E{(bf16*)(X.ws + WS_MIX), DM, nullptr, 0, 0.f, 0.f, X.lds + LDS_X_OFF};
            pg8::gemm_phase<decltype(E), pg8::StaticOrder, false>(X.lds, g, S, E, X.tid);
            GBAR();
        }
        if (IN(5)) { MKCTX(); if (REP_P5 > 1) ln1_router(X, ap, l, l == 0, true); ln1_router(X, ap, l, l == 0); GBAR(); }
        if (IN(6)) { MKCTX(); for (int rep = 0; rep < REP_P6; ++rep) moe_dispatch(X); GBAR(); }
        if (IN(7)) { MKCTX();
            const int* TILEE = (const int*)(X.ws + WS_TILEE);
            pg8::Gemm g{(const bf16*)(X.ws + WS_XB), (const bf16*)(X.ws + WS_WGU), DM, (const int*)(X.ws + WS_STOK)};
            pg8::GroupedOrder S{TILEE, TILEE[1024], 2, X.G, X.c};
            pg8::EpiGateUpT<NT_H> E{(bf16*)(X.ws + WS_H), (const float*)(X.ws + WS_SW)};
            for (int rep = 0; rep < REP_P7; ++rep) pg8::gemm_phase<decltype(E), pg8::GroupedOrder, true>(X.lds, g, S, E, X.tid);
            GBAR();
        }
        if (IN(8)) { MKCTX();
            const int* TILEE = (const int*)(X.ws + WS_TILEE);
            pg8::Gemm g{(const bf16*)(X.ws + WS_H), (const bf16*)(X.ws + WS_WD), FH, nullptr};
            pg8::GroupedOrder S{TILEE, TILEE[1024], 4, X.G, X.c};
            pg8::EpiPlainT<NT_Y> E{(bf16*)(X.ws + WS_Y), DM, nullptr, 0, 0.f, 0.f, X.lds + LDS_X_OFF};
            for (int rep = 0; rep < REP_P8; ++rep) pg8::gemm_phase<decltype(E), pg8::GroupedOrder, false>(X.lds, g, S, E, X.tid);
            GBAR();
        }
        if (IN(9)) { MKCTX(); if (REP_P9 > 1) ln2_phase(X, ap, l, l == 0, true); ln2_phase(X, ap, l, l == 0); if (!(l == a.l_hi - 1)) GBAR(); }
#undef IN
    }
#undef GBAR
}

extern "C" void kernel_launch(void* const* d_in, const int* in_sizes, int n_in, void* d_out, int out_size, void* d_ws, size_t ws_size, hipStream_t stream) {
    static int grid = 0;
    if (grid == 0) {
        if (n_in != 19 || in_sizes[0] != NT * DM || out_size != NT * DM || ws_size < WS_END) { fprintf(stderr, "kernel_launch: unexpected shapes (n_in %d, in0 %d, out %d, ws %zu < %zu); nothing launched\n", n_in, n_in > 0 ? in_sizes[0] : -1, out_size, ws_size, (size_t)WS_END); grid = -1; return; }
        int dev = 0, cus = 0, per_cu = 0;
        if (hipGetDevice(&dev) != hipSuccess || hipDeviceGetAttribute(&cus, hipDeviceAttributeMultiprocessorCount, dev) != hipSuccess) { grid = -1; return; }
        if (hipFuncSetAttribute((const void*)mk_fwd, hipFuncAttributeMaxDynamicSharedMemorySize, LDS_BYTES) != hipSuccess) { fprintf(stderr, "kernel_launch: hipFuncSetAttribute failed\n"); grid = -1; return; }
        if (hipOccupancyMaxActiveBlocksPerMultiprocessor(&per_cu, (const void*)mk_fwd, 512, LDS_BYTES) != hipSuccess || per_cu < 1) fprintf(stderr, "kernel_launch: occupancy query reports %d\n", per_cu);
        (void)hipGetLastError();
        grid = cus;
    }
    if (grid < 0) return;
    (void)hipMemsetAsync((char*)d_ws + WS_CTL, 0, CTL_BYTES, stream);
    Args a{};
    a.x = (const float*)d_in[0]; a.pos = (const int*)d_in[1]; a.w_in = (const float*)d_in[2]; a.qn = (const float*)d_in[3]; a.kvn = (const float*)d_in[4];
    a.w_uq = (const float*)d_in[5]; a.w_ukv = (const float*)d_in[6]; a.w_o = (const float*)d_in[7]; a.ln1g = (const float*)d_in[8]; a.ln1b = (const float*)d_in[9];
    a.rgw = (const float*)d_in[10]; a.rgb = (const float*)d_in[11]; a.rew = (const float*)d_in[12]; a.reb = (const float*)d_in[13];
    a.wg = (const float*)d_in[14]; a.wu = (const float*)d_in[15]; a.wd = (const float*)d_in[16]; a.ln2g = (const float*)d_in[17]; a.ln2b = (const float*)d_in[18];
    a.out = (float*)d_out; a.ws = (unsigned char*)d_ws; a.pad = 0;
#if MK_MULTI
    a.use_bar = 0;
    a.l_lo = 0; a.l_hi = 0; a.ph_lo = 0; a.ph_hi = 0;
    hipLaunchKernelGGL(mk_fwd, dim3(grid), dim3(512), LDS_BYTES, stream, a);
    for (int l = 0; l < DEPTH; ++l)
        for (int ph = 1; ph < 10; ++ph) { a.l_lo = l; a.l_hi = l + 1; a.ph_lo = ph; a.ph_hi = ph + 1; hipLaunchKernelGGL(mk_fwd, dim3(grid), dim3(512), LDS_BYTES, stream, a); }
#else
    a.use_bar = 1; a.l_lo = 0; a.l_hi = DEPTH; a.ph_lo = 0; a.ph_hi = 10;
    hipLaunchKernelGGL(mk_fwd, dim3(grid), dim3(512), LDS_BYTES, stream, a);
#endif
    const hipError_t le = hipPeekAtLastError();
    if (le != hipSuccess) fprintf(stderr, "kernel_launch: launch failed: %s\n", hipGetErrorName(le));
}
```

```cpp
#include <hip/hip_runtime.h>
#include <cstdio>
#include <cstdint>

#define LAS __attribute__((address_space(3)))
#define GAS __attribute__((address_space(1)))
typedef unsigned short bf16;
typedef short bf16x8 __attribute__((ext_vector_type(8)));
typedef short s16x4 __attribute__((ext_vector_type(4)));
typedef float f32x2 __attribute__((ext_vector_type(2)));
typedef float f32x4 __attribute__((ext_vector_type(4)));
typedef float f32x16 __attribute__((ext_vector_type(16)));
typedef unsigned u32x2 __attribute__((ext_vector_type(2)));
typedef unsigned u32x4 __attribute__((ext_vector_type(4)));
typedef __bf16 bf16x2_t __attribute__((ext_vector_type(2)));

#ifndef MK_MULTI
#define MK_MULTI 0
#endif

constexpr int NB = 32, SEQ = 2048, NT = NB * SEQ, DM = 1024, DEPTH = 4;
constexpr int IN_COLS = 3400, NIN = 3584;
constexpr int NEXP = 32, FH = 256;
constexpr int NSLOT = 2 * NT + NEXP * 256;
constexpr int MAXTILES = NSLOT / 256;
constexpr float ALPHA = 1.681792830507429f;
constexpr float LOG2E = 1.4426950408889634f;
constexpr float QSC64 = 0.125f * LOG2E;
constexpr float QSC96 = 0.10206207261596577f * LOG2E;
constexpr float IDX_SCALE = 0.0625f;

constexpr size_t MiB = 1u << 20;
constexpr size_t WS_CTL = 0, CTL_BYTES = 1 * MiB;
constexpr size_t WS_WIN = 1 * MiB;
constexpr size_t WS_WUQ = 29 * MiB;
constexpr size_t WS_WUKV = WS_WUQ + 3 * MiB / 2;
constexpr size_t WS_WO = WS_WUKV + 2 * MiB;
constexpr size_t WS_RGT = WS_WO + 8 * MiB;
constexpr size_t WS_RET = WS_RGT + 64 * 1024;
constexpr size_t WS_ROPE = 42 * MiB;
constexpr size_t WS_WGU = 56 * MiB;
constexpr size_t WS_WD = 88 * MiB;
constexpr size_t WS_XB = 104 * MiB;
constexpr size_t WS_A = 232 * MiB;
constexpr size_t WS_CQ = WS_A;
constexpr size_t WS_T1 = WS_CQ + 32 * MiB;
constexpr size_t WS_BQ = WS_T1 + 32 * MiB;
constexpr size_t WS_BV = WS_BQ + 32 * MiB;
constexpr size_t WS_WI = WS_BV + 8 * MiB;
constexpr size_t WS_BQI = WS_WI + 2 * MiB;
constexpr size_t WS_SSQ = WS_BQI + 32 * MiB;
constexpr size_t WS_DQ = WS_SSQ + 4 * MiB;
constexpr size_t WS_DK = WS_DQ + 96 * MiB;
constexpr size_t WS_DV = WS_DK + 96 * MiB;
constexpr size_t WS_B = WS_DV + 96 * MiB;
constexpr size_t WS_QA = WS_B;
constexpr size_t WS_KVA = WS_QA + 96 * MiB;
constexpr size_t WS_BM = WS_KVA + 128 * MiB;
constexpr size_t WS_OD = WS_BM + 16 * MiB;
constexpr size_t WS_LSE = WS_OD + 96 * MiB;
constexpr size_t WS_MOE = WS_LSE + 4 * MiB;
constexpr size_t WS_ROUTE = WS_MOE;
constexpr size_t WS_HIST = WS_ROUTE + 1 * MiB;
constexpr size_t WS_STOK = WS_HIST + 64 * 1024;
constexpr size_t WS_SW = WS_STOK + 640 * 1024;
constexpr size_t WS_TSLOT = WS_SW + 640 * 1024;
constexpr size_t WS_TILEE = WS_TSLOT + 512 * 1024;
constexpr size_t WS_KPE = WS_MOE + 4 * MiB;
constexpr size_t WS_KI = WS_KPE + 4 * MiB;
constexpr size_t WS_END = WS_KI + 4 * MiB;
constexpr size_t WS_MIX = WS_A;
constexpr size_t WS_H = WS_A + 128 * MiB;
constexpr size_t WS_Y = WS_H + 68 * MiB;
static_assert(WS_RET + 512 * 1024 <= WS_ROPE && WS_ROPE + 14 * MiB <= WS_WGU && WS_WD + 16 * MiB <= WS_XB && WS_XB + 128 * MiB <= WS_A, "ws map 1");
static_assert(WS_Y + 272 * MiB <= WS_MOE && WS_TILEE + 8192 <= WS_END && WS_END <= 1024 * MiB, "ws map 2");
constexpr size_t ROPE_C16 = 0, ROPE_S16 = (size_t)NT * 16 * 4, ROPE_C8 = 2 * ROPE_S16, ROPE_S8 = ROPE_C8 + (size_t)NT * 8 * 4,
                 ROPE_C4 = ROPE_S8 + (size_t)NT * 8 * 4, ROPE_S4 = ROPE_C4 + (size_t)NT * 4 * 4;

constexpr int CW_BAR = 4096;
constexpr int RING_BYTES = 131072;
constexpr int LDS_X_OFF = 131072;
constexpr int LDSCTL_OFF = 147456;
constexpr int LDS_HIST_OFF = LDSCTL_OFF + 4096;
constexpr int LDS_BYTES = LDS_HIST_OFF + 4096;

#define RLX_AGENT __ATOMIC_RELAXED, __HIP_MEMORY_SCOPE_AGENT
__device__ __forceinline__ unsigned f2bf(float f) { unsigned u = __builtin_bit_cast(unsigned, f); return (u + 0x7fffu + ((u >> 16) & 1u)) >> 16; }
#ifndef NT_EPI
#define NT_EPI 1
#endif
#ifndef NT_KVA
#define NT_KVA 1
#endif
#ifndef NT_MIX
#define NT_MIX 0
#endif
#ifndef NT_H
#define NT_H 0
#endif
#ifndef NT_Y
#define NT_Y 1
#endif
#ifndef NT_LN
#define NT_LN 0
#endif
#ifndef NT_ATT
#define NT_ATT 1
#endif
#define STG_ASM(W, POL) asm volatile("global_store_dwordx" W " %0, %1, off " POL "\n\ts_nop 1" :: "v"(p), "v"(w))
template <int M, class T> __device__ __forceinline__ void stg_any16(void* p, T w) {
    if constexpr (M == 0) *(T*)p = w; else if constexpr (M == 1) __builtin_nontemporal_store(w, (T*)p);
    else if constexpr (M == 2) STG_ASM("4", "sc1"); else if constexpr (M == 3) STG_ASM("4", "sc0 sc1"); else if constexpr (M == 4) STG_ASM("4", "sc1 nt"); else STG_ASM("4", "sc0 sc1 nt"); }
template <int M> __device__ __forceinline__ void stgf4(void* p, f32x4 w) { stg_any16<M>(p, w); }
template <int M> __device__ __forceinline__ void stg16(void* p, u32x4 w) { stg_any16<M>(p, w); }
template <int M> __device__ __forceinline__ void stg8(void* p, u32x2 w) {
    if constexpr (M == 0) *(u32x2*)p = w; else if constexpr (M == 1) __builtin_nontemporal_store(w, (u32x2*)p);
    else if constexpr (M == 2) STG_ASM("2", "sc1"); else if constexpr (M == 3) STG_ASM("2", "sc0 sc1"); else if constexpr (M == 4) STG_ASM("2", "sc1 nt"); else STG_ASM("2", "sc0 sc1 nt"); }
#ifndef NT_LD
#define NT_LD 1
#endif
template <class T> __device__ __forceinline__ T ldg_s(const void* p) { if constexpr (NT_LD) return __builtin_nontemporal_load((const T*)p); else return *(const T*)p; }
__device__ __forceinline__ unsigned pk2(float lo, float hi) { f32x2 v = {lo, hi}; bf16x2_t b = __builtin_convertvector(v, bf16x2_t); return __builtin_bit_cast(unsigned, b); }
__device__ __forceinline__ float bf2f(unsigned short b) { return __builtin_bit_cast(float, ((unsigned)b) << 16); }
__device__ __forceinline__ float bflo(unsigned w) { return __builtin_bit_cast(float, w << 16); }
__device__ __forceinline__ float bfhi(unsigned w) { return __builtin_bit_cast(float, w & 0xffff0000u); }
template <int CTRL> __device__ __forceinline__ float dppf(float x) { return __builtin_bit_cast(float, __builtin_amdgcn_mov_dpp(__builtin_bit_cast(int, x), CTRL, 0xf, 0xf, true)); }
__device__ __forceinline__ float xhalf_sum(float v) { const auto t = __builtin_amdgcn_permlane32_swap(__float_as_uint(v), __float_as_uint(v), false, false); return __uint_as_float(t[0]) + __uint_as_float(t[1]); }
__device__ __forceinline__ float xhalf_max(float v) { const auto t = __builtin_amdgcn_permlane32_swap(__float_as_uint(v), __float_as_uint(v), false, false); return fmaxf(__uint_as_float(t[0]), __uint_as_float(t[1])); }
__device__ __forceinline__ float wave_sum(float v) {
    v += dppf<0xB1>(v); v += dppf<0x4E>(v); v += dppf<0x141>(v); v += dppf<0x140>(v);
    const auto s = __builtin_amdgcn_permlane16_swap(__float_as_uint(v), __float_as_uint(v), false, false);
    v = __uint_as_float(s[0]) + __uint_as_float(s[1]);
    return xhalf_sum(v);
}
__device__ __forceinline__ int crow(int r, int hi) { return (r & 3) + 8 * (r >> 2) + 4 * hi; }

#define XB_TMO      128
#define XB_XCNT(j)  (256  + 64 * (j))
#define XB_XSUB(j)  (1280 + 64 * (j))
#define XB_XGEN(j)  (2304 + 64 * (j))
#define XB_TOP      3328
#define XB_TOPGEN   3392
#define XCD_BAR_WORDS 3456
#define XB_SPIN_CAP (1u << 18)
__device__ __forceinline__ unsigned xb_ld(unsigned* p)              { return __hip_atomic_load(p, __ATOMIC_RELAXED, __HIP_MEMORY_SCOPE_AGENT); }
__device__ __forceinline__ unsigned xb_add(unsigned* p, unsigned v) { return __hip_atomic_fetch_add(p, v, __ATOMIC_RELAXED, __HIP_MEMORY_SCOPE_AGENT); }
__device__ __forceinline__ unsigned xb_xcc_id() { return (unsigned)__builtin_amdgcn_s_getreg((3 << 11) | 20) & 0xFu; }
#define XB_SPIN(cond, bar) do { unsigned _sp = 0; while (cond) { __builtin_amdgcn_s_sleep(1); \
    if ((++_sp & 255u) == 0u) { if (xb_ld(&(bar)[XB_TMO])) break; if (_sp > XB_SPIN_CAP) { atomicAdd(&(bar)[XB_TMO], 1u); break; } } } } while (0)
struct XcdBarrier { unsigned* bar; unsigned x; volatile LAS unsigned* st; };
__device__ __forceinline__ XcdBarrier xcd_barrier_post(unsigned* bar, volatile LAS unsigned* st) {
    XcdBarrier b; b.bar = bar; b.x = xb_xcc_id(); b.st = st;
    if (threadIdx.x == 0) (void)xb_add(&bar[XB_XCNT(b.x)], 1u);
    return b;
}
__device__ __forceinline__ void xcd_barrier_complete(unsigned* bar, unsigned x, unsigned& nloc, unsigned& nx) {
    const unsigned G = gridDim.x * gridDim.y * gridDim.z;
    unsigned sum, cnt, mine, sp = 0u;
    for (;;) {
        sum = 0u; cnt = 0u; mine = 0u;
#pragma unroll
        for (unsigned j = 0; j < 16; ++j) { const unsigned c = xb_ld(&bar[XB_XCNT(j)]); sum += c; cnt += (c > 0u) ? 1u : 0u; mine = (j == x) ? c : mine; }
        if (sum == G) break;
        __builtin_amdgcn_s_sleep(1);
        if ((++sp & 255u) == 0u) { if (xb_ld(&bar[XB_TMO])) break; if (sp > XB_SPIN_CAP) { atomicAdd(&bar[XB_TMO], 1u); break; } }
    }
    nloc = mine > 0u ? mine : 1u; nx = cnt > 0u ? cnt : 1u;
}
__device__ __forceinline__ void xcd_barrier(const XcdBarrier& b) {
    asm volatile("s_waitcnt vmcnt(0)" ::: "memory");
    __syncthreads();
    if (threadIdx.x == 0) {
        unsigned* bar = b.bar;
        __builtin_amdgcn_s_waitcnt(0);
        unsigned nloc = b.st[0], nx = b.st[1];
        if (nloc == 0u) { xcd_barrier_complete(bar, b.x, nloc, nx); b.st[0] = nloc; b.st[1] = nx; }
        const unsigned old = xb_add(&bar[XB_XSUB(b.x)], 1u);
        const unsigned gen = old / nloc;
        if (old + 1u == (gen + 1u) * nloc) {
            __builtin_amdgcn_fence(__ATOMIC_RELEASE, "agent");
            asm volatile("s_waitcnt vmcnt(0)" ::: "memory");
            const unsigned og = xb_add(&bar[XB_TOP], 1u);
            const unsigned tg = og / nx;
            if (og + 1u == (tg + 1u) * nx) xb_add(&bar[XB_TOPGEN], 1u);
            else XB_SPIN(xb_ld(&bar[XB_TOPGEN]) == tg, bar);
            __builtin_amdgcn_fence(__ATOMIC_ACQUIRE, "agent");
            xb_add(&bar[XB_XGEN(b.x)], 1u);
            asm volatile("s_waitcnt vmcnt(0)" ::: "memory");
        } else {
            XB_SPIN(xb_ld(&bar[XB_XGEN(b.x)]) == gen, bar);
            __builtin_amdgcn_fence(__ATOMIC_ACQUIRE, "agent");
            asm volatile("s_waitcnt vmcnt(0)" ::: "memory");
        }
    }
    __syncthreads();
}

namespace pg8 {
constexpr int BM = 256, BK = 64, HALF = 128, HTB = HALF * BK * 2, STAGE_BYTES = 8 * HTB, NXCD = 8, WGM = 8;
__host__ __device__ __forceinline__ int lds_byte(int r, int c) { const int st = (r >> 4) * 2 + (c >> 5), rr = r & 15, cc = c & 31, ob = rr * 64 + cc * 2; return st * 1024 + (ob ^ (((ob >> 9) & 1) << 5)); }
__host__ __device__ __forceinline__ void stage_rc(int b, int& R, int& C) { const int st = b / 1024, sb = b % 1024, swz = sb ^ (((sb >> 9) & 1) << 5); R = (st >> 1) * 16 + swz / 64; C = (st & 1) * 32 + (swz % 64) / 2; }
__host__ __device__ __forceinline__ int perm32(int rho) { const int n = rho >> 4, i = rho & 15; return 8 * (i >> 2) + 4 * n + (i & 3); }

#ifndef PROBE_P1
#define PROBE_P1 0
#endif
struct Unit { int pm, pn, pb;
#if PROBE_P1
    int fl;
#endif
};
struct Gemm { const bf16* A; const bf16* Bt; int K; const int* gidx; };

__device__ __forceinline__ int xcd_remap(int wgid, int nwg) { const int q = nwg / NXCD, r = nwg % NXCD, xcd = wgid % NXCD, off = wgid / NXCD; return (xcd < r ? xcd * (q + 1) : r * (q + 1) + (xcd - r) * q) + off; }
struct StaticOrder {
    int nM, nN, nwg, G, c, rep;
    __device__ void init(int M, int N, int G_, int c_, int rep_ = 1) { nM = M / BM; nN = N / BM; nwg = nM * nN; G = G_; c = c_; rep = rep_; }
    __device__ bool next(int i, Unit& u) const {
        long L = (long)i * G + c; if (L >= (long)nwg * rep) return false;
#if PROBE_P1
        u.fl = (rep > 1 && L < nwg) ? 1 : 0;
#endif
        L %= nwg;
        const int wgid = xcd_remap((int)L, nwg);
        const int nig = WGM * nN, gid = wgid / nig, fm = gid * WGM, gsz = (nM - fm) < WGM ? (nM - fm) : WGM;
        u.pm = fm + ((wgid % nig) % gsz); u.pn = (wgid % nig) / gsz; u.pb = u.pn; return true;
    }
};
struct GroupedOrder {
    const int* tile_e; int ntiles, npn, G, c;
    __device__ bool next(int i, Unit& u) const {
        const long L = (long)i * G + c; const int nwg = ntiles * npn; if (L >= nwg) return false;
        const int wgid = xcd_remap((int)L, nwg);
        u.pm = wgid / npn; u.pn = wgid % npn; u.pb = tile_e[u.pm] * npn + u.pn;
#if PROBE_P1
        u.fl = 0;
#endif
        return true;
    }
};

__device__ __forceinline__ unsigned cvt_pk_bf16(float lo, float hi) { unsigned r; asm volatile("v_cvt_pk_bf16_f32 %0, %1, %2" : "=v"(r) : "v"(lo), "v"(hi)); return r; }

template <int STM> struct EpiPlainT {
    static constexpr bool PERM = true;
    bf16* O; int ldc; const float* ssq; int ssq_n; float ssq_inv; float eps;
    LAS unsigned char* xl;
    __device__ __forceinline__ void operator()(const f32x4 (&acc)[2][2][4][2], const Unit& u, int wr, int wc, int fr, int fq) const {
        const int lane = fq * 16 + fr; LAS unsigned char* t = xl + (wr * 4 + wc) * 2048;
        const int wsw = fr & 7, rrow = lane >> 3, rch = lane & 7;
#pragma unroll
        for (int ai = 0; ai < 2; ++ai)
#pragma unroll
            for (int m = 0; m < 4; ++m) { const int rowb = u.pm * BM + ai * HALF + wr * 64 + m * 16;
                float sc = 1.f;
                if (ssq) { const f32x4 p = *(const f32x4*)(ssq + (size_t)(rowb + fr) * ssq_n); sc = __builtin_amdgcn_rsqf((p[0] + p[1] + p[2] + p[3]) * ssq_inv + eps); }
#pragma unroll
                for (int bj = 0; bj < 2; ++bj) { const f32x4 v0 = acc[ai][bj][m][0] * sc, v1 = acc[ai][bj][m][1] * sc;
                    u32x4 w; w.x = cvt_pk_bf16(v0[0], v0[1]); w.y = cvt_pk_bf16(v0[2], v0[3]); w.z = cvt_pk_bf16(v1[0], v1[1]); w.w = cvt_pk_bf16(v1[2], v1[3]);
                    *(LAS u32x4*)(t + fr * 128 + 16 * ((4 * bj + fq) ^ wsw)) = w; }
#pragma unroll
                for (int i = 0; i < 2; ++i) { const int rr = 8 * i + rrow;
                    const u32x4 w = *(const LAS u32x4*)(t + rr * 128 + 16 * (rch ^ (rr & 7)));
                    stg16<STM>(O + (size_t)(rowb + rr) * ldc + u.pn * BM + wc * 64 + 8 * rch, w); }
            }
    }
};
template <int STM> struct EpiGateUpT {
    static constexpr bool PERM = true;
    bf16* H; const float* sw;
    __device__ __forceinline__ void operator()(const f32x4 (&acc)[2][2][4][2], const Unit& u, int wr, int wc, int fr, int fq) const {
        const int row0 = u.pm * BM + wr * 64 + fr; const int col0 = u.pn * HALF + wc * 32 + 8 * fq;
#pragma unroll
        for (int ai = 0; ai < 2; ++ai)
#pragma unroll
            for (int m = 0; m < 4; ++m) { const int row = row0 + ai * HALF + m * 16; const float w = sw[row]; f32x4 hv[2];
#pragma unroll
                for (int n = 0; n < 2; ++n) { const f32x4 g = acc[ai][0][m][n], up = acc[ai][1][m][n];
#pragma unroll
                    for (int e = 0; e < 4; ++e) { const float sg = g[e] * __builtin_amdgcn_rcpf(1.0f + __builtin_amdgcn_exp2f(-g[e] * LOG2E)); hv[n][e] = sg * up[e] * w; } }
                u32x4 o; o.x = cvt_pk_bf16(hv[0][0], hv[0][1]); o.y = cvt_pk_bf16(hv[0][2], hv[0][3]); o.z = cvt_pk_bf16(hv[1][0], hv[1][1]); o.w = cvt_pk_bf16(hv[1][2], hv[1][3]);
                stg16<STM>(H + (size_t)row * FH + col0, o); }
    }
};

enum { GK_SKIP = 0, GK_PLAIN = 1, GK_ROPE32 = 2, GK_HEAD16 = 3, GK_IDX8 = 4, GK_WI = 5 };
struct GroupDesc { int kind; bf16* dst; int pitch; int col; float scale; int perm; float* ssq; int ssq_n; int ssq_i; };
struct RopeTabs { const int* pos; };
__device__ __forceinline__ int perm_row(int row, int perm) {
    if (perm == 0) return row; const int b = row >> 11, s = row & 2047;
    return perm == 4 ? (b << 11) + ((s & 3) << 9) + (s >> 2) : (b << 11) + ((s & 15) << 7) + (s >> 4);
}
__device__ __forceinline__ void st16(bf16* p, u32x2 a, u32x2 b) { u32x4 w; w.x = a.x; w.y = a.y; w.z = b.x; w.w = b.y; stg16<NT_EPI>(p, w); }
__device__ __forceinline__ u32x2 pk4(f32x4 v) { u32x2 w; w.x = cvt_pk_bf16(v[0], v[1]); w.y = cvt_pk_bf16(v[2], v[3]); return w; }
__device__ __forceinline__ void swap16(u32x2& X, u32x2& Y) {
    const auto a = __builtin_amdgcn_permlane16_swap(X.x, Y.x, false, false); const auto b = __builtin_amdgcn_permlane16_swap(X.y, Y.y, false, false);
    X.x = a[0]; Y.x = a[1]; X.y = b[0]; Y.y = b[1];
}
__device__ __forceinline__ float rope_k(int i, int rd) { return __builtin_amdgcn_exp2f(-18.931568569324174f * (float)(2 * i) / (float)rd) * 0.15915494309189535f; }
__device__ __forceinline__ void rope_cs(float posf, int i0, int rd, f32x4& c, f32x4& s) {
#pragma unroll
    for (int e = 0; e < 4; ++e) { const float f = __builtin_amdgcn_fractf(posf * rope_k(i0 + e, rd)); s[e] = __builtin_amdgcn_sinf(f); c[e] = __builtin_amdgcn_cosf(f); }
}
template <class DescFn> struct EpiGroups {
    static constexpr bool PERM = true;
    DescFn F; RopeTabs R; const float* rs_ssq; int rs_n; float rs_inv, rs_eps;
    __device__ __forceinline__ void operator()(const f32x4 (&acc)[2][2][4][2], const Unit& u, int wr, int wc, int fr, int fq) const {
        const int row0 = u.pm * BM + wr * 64 + fr;
#pragma unroll
        for (int bj = 0; bj < 2; ++bj) {
            const GroupDesc d = F(u.pn, bj, wc);
            if (d.kind == GK_SKIP) continue;
#if PROBE_P1 == 1
            if (u.fl) continue;
#endif
            const int ki0 = d.kind == GK_ROPE32 ? 4 * fq : (d.kind == GK_HEAD16 ? 4 * (fq & 1) : 0), krd = d.kind == GK_ROPE32 ? 32 : (d.kind == GK_HEAD16 ? 16 : 8);
#pragma unroll
            for (int ai = 0; ai < 2; ++ai)
#pragma unroll
                for (int m = 0; m < 4; ++m) {
                    const int row = row0 + ai * HALF + m * 16;
                    float sc = d.scale;
                    if (rs_ssq) { float s = 0.f; for (int i = 0; i < rs_n; ++i) s += rs_ssq[(size_t)row * rs_n + i]; sc *= __builtin_amdgcn_rsqf(s * rs_inv + rs_eps); }
                    f32x4 v0 = acc[ai][bj][m][0], v1 = acc[ai][bj][m][1];
                    if (d.ssq) {
                        float q = (v0[0] * v0[0] + v0[1] * v0[1]) + (v0[2] * v0[2] + v0[3] * v0[3]) + (v1[0] * v1[0] + v1[1] * v1[1]) + (v1[2] * v1[2] + v1[3] * v1[3]);
                        q += __shfl_xor(q, 16); q += __shfl_xor(q, 32);
                        if (fq == 0) d.ssq[(size_t)row * d.ssq_n + d.ssq_i] = q;
                    }
                    v0 = v0 * sc; v1 = v1 * sc;
                    if (d.kind == GK_WI) { if (fq == 0) { float* wp = (float*)d.dst + (size_t)row * 8; *(f32x4*)wp = v0; *(f32x4*)(wp + 4) = v1; } continue; }
                    bf16* rp = d.dst + (size_t)perm_row(row, d.perm) * d.pitch + d.col;
                    if (d.kind == GK_PLAIN) { st16(rp + 8 * fq, pk4(v0), pk4(v1)); }
                    else if (d.kind == GK_IDX8) {
                        f32x4 c, s; rope_cs((float)R.pos[row], ki0, krd, c, s);
                        const f32x4 o1 = fq == 0 ? v0 * c - v1 * s : v0, o2 = fq == 0 ? v1 * c + v0 * s : v1;
                        st16(rp + 8 * fq, pk4(o1), pk4(o2));
                    } else if (d.kind == GK_ROPE32) {
                        f32x4 c, s; rope_cs((float)R.pos[row], ki0, krd, c, s);
                        u32x2 X = pk4(v0 * c - v1 * s), Y = pk4(v1 * c + v0 * s);
                        swap16(X, Y);
                        st16(rp + ((fq & 1) ? 16 + 4 * (fq - 1) : 4 * fq), X, Y);
                    } else {
                        f32x4 c, s; rope_cs((float)R.pos[row], ki0, krd, c, s);
                        u32x2 X = pk4(fq < 2 ? v0 * c - v1 * s : v0), Y = pk4(fq < 2 ? v1 * c + v0 * s : v1);
                        swap16(X, Y);
                        st16(rp + 16 * (fq >> 1) + 8 * (fq & 1), X, Y);
                    }
                }
        }
    }
};

template <class Epi, class Sched, bool GATHER, int LDA = 0>
__device__ __forceinline__ void gemm_phase(LAS unsigned char* lds, const Gemm g, const Sched& S, const Epi& E, const int tid) {
    const int wid = __builtin_amdgcn_readfirstlane(tid >> 6), lane = tid & 63, wr = wid >> 2, wc = wid & 3, fr = lane & 15, fq = lane >> 4;
    const int K = g.K, nt = K / BK, lda = LDA ? LDA : K;
    unsigned voA[2][2], voB[2]; int RA[2], CA[2];
#pragma unroll
    for (int i = 0; i < 2; ++i) { int R, C; stage_rc(tid * 16 + i * 8192, R, C); const int Rb = Epi::PERM ? ((R & ~31) + perm32(R & 31)) : R;
        RA[i] = R; CA[i] = C; voA[0][i] = (unsigned)(R * lda + C) * 2u; voA[1][i] = (unsigned)((R + HALF) * lda + C) * 2u; voB[i] = (unsigned)(Rb * K + C) * 2u; }
    const size_t kstep = (size_t)(BK * 2);
    const size_t hstep = (size_t)HALF * K * 2;
    const size_t tstep = 2 * hstep;
    const size_t tstepA = (size_t)BM * lda * 2;
    const unsigned ldsw = (unsigned)wid * 1024u;
    const int aoff = lds_byte(wr * 64 + fr, fq * 8), boff = lds_byte(wc * 32 + fr, fq * 8);
#define PG8_SA(b, h) (((b) * 2 + (h)) * HTB)
#define PG8_SB(b, h) ((4 + (b) * 2 + (h)) * HTB)
#define PG8_STAGE(bufoff, gbase, voff) do { _Pragma("unroll") for (int _i = 0; _i < 2; ++_i) \
        __builtin_amdgcn_global_load_lds((const unsigned*)((const char*)(gbase) + (voff)[_i]), (LAS unsigned*)(lds + (bufoff) + ldsw + _i * 8192), 16, 0, 0); } while (0)
#define PG8_LDA(dst, b, h) do { _Pragma("unroll") for (int m = 0; m < 4; ++m) _Pragma("unroll") for (int k = 0; k < 2; ++k) dst[m][k] = *(const LAS bf16x8*)(lds + PG8_SA(b, h) + aoff + m * 2048 + k * 1024); } while (0)
#define PG8_LDB(dst, b, h) do { _Pragma("unroll") for (int n = 0; n < 2; ++n) _Pragma("unroll") for (int k = 0; k < 2; ++k) dst[n][k] = *(const LAS bf16x8*)(lds + PG8_SB(b, h) + boff + n * 2048 + k * 1024); } while (0)
#define PG8_MMA(ai, bj, At, Bt) do { __builtin_amdgcn_s_setprio(1); _Pragma("unroll") for (int m = 0; m < 4; ++m) _Pragma("unroll") for (int n = 0; n < 2; ++n) _Pragma("unroll") for (int k = 0; k < 2; ++k) \
        acc[ai][bj][m][n] = __builtin_amdgcn_mfma_f32_16x16x32_bf16(Bt[n][k], At[m][k], acc[ai][bj][m][n], 0, 0, 0); __builtin_amdgcn_s_setprio(0); } while (0)
#define PG8_WAIT_V(n) asm volatile("s_waitcnt vmcnt(" #n ")" ::: "memory")
#define PG8_WAIT_L(n) asm volatile("s_waitcnt lgkmcnt(" #n ")" ::: "memory")
#define PG8_BAR __builtin_amdgcn_s_barrier()
#define PG8_SCHED __builtin_amdgcn_sched_barrier(0)
    Unit cur, nxt; int ui = 0;
    if (!S.next(0, cur)) return;
    f32x4 acc[2][2][4][2];
#pragma unroll
    for (int a = 0; a < 2; ++a)
#pragma unroll
        for (int b = 0; b < 2; ++b)
#pragma unroll
            for (int m = 0; m < 4; ++m)
#pragma unroll
                for (int n = 0; n < 2; ++n) acc[a][b][m][n] = (f32x4){0.f, 0.f, 0.f, 0.f};
    bf16x8 At[4][2], B0[2][2], B1[2][2];
    unsigned nvA[2][2];
    const char* cA; const char* cB = (const char*)g.Bt + (size_t)cur.pb * tstep;
    if constexpr (GATHER) { cA = (const char*)g.A;
#pragma unroll
        for (int h = 0; h < 2; ++h)
#pragma unroll
            for (int i = 0; i < 2; ++i) voA[h][i] = (unsigned)g.gidx[cur.pm * BM + h * HALF + RA[i]] * (unsigned)(lda * 2) + (unsigned)CA[i] * 2u;
    } else cA = (const char*)g.A + (size_t)cur.pm * tstepA;
    PG8_STAGE(PG8_SB(0, 0), cB, voB); PG8_STAGE(PG8_SB(0, 1), cB + hstep, voB); PG8_STAGE(PG8_SA(0, 0), cA, voA[0]); PG8_STAGE(PG8_SA(0, 1), cA, voA[1]);
    if (wr == 1) PG8_BAR;
    PG8_WAIT_V(2); PG8_BAR;
    PG8_STAGE(PG8_SB(1, 0), cB + kstep, voB); PG8_STAGE(PG8_SA(1, 0), cA + kstep, voA[0]); PG8_STAGE(PG8_SB(1, 1), cB + hstep + kstep, voB);
    PG8_WAIT_V(6); PG8_BAR;
    for (;;) {
        const bool has_next = S.next(ui + 1, nxt);
        const char* nA; const char* nB = has_next ? (const char*)g.Bt + (size_t)nxt.pb * tstep : cB;
        if constexpr (GATHER) { nA = cA;
#pragma unroll
            for (int h = 0; h < 2; ++h)
#pragma unroll
                for (int i = 0; i < 2; ++i) nvA[h][i] = has_next ? (unsigned)g.gidx[nxt.pm * BM + h * HALF + RA[i]] * (unsigned)(lda * 2) + (unsigned)CA[i] * 2u : voA[h][i];
        } else nA = has_next ? (const char*)g.A + (size_t)nxt.pm * tstepA : cA;
#if PROBE_P1 == 2
        const int ntu = cur.fl ? 2 : nt;
#else
        const int ntu = nt;
#endif
#pragma nounroll
        for (int t = 0; t < ntu; t += 2) {
            const bool last = (t == ntu - 2);
            const char* a1 = cA + (size_t)(t + 1) * kstep;
            const char* a2 = last ? nA : cA + (size_t)(t + 2) * kstep; const char* b2 = last ? nB : cB + (size_t)(t + 2) * kstep;
            const char* a3 = a2 + kstep; const char* b3 = b2 + kstep;
            unsigned xA[2][2];
#pragma unroll
            for (int h = 0; h < 2; ++h)
#pragma unroll
                for (int i = 0; i < 2; ++i) xA[h][i] = (GATHER && last) ? nvA[h][i] : voA[h][i];
            PG8_LDB(B0, 0, 0); PG8_LDB(B1, 0, 1); PG8_SCHED; PG8_LDA(At, 0, 0); PG8_STAGE(PG8_SA(1, 1), a1, voA[1]);
            PG8_WAIT_V(8); PG8_WAIT_L(0); PG8_BAR; PG8_MMA(0, 0, At, B0); PG8_MMA(0, 1, At, B1); PG8_BAR; PG8_SCHED;
            PG8_LDA(At, 0, 1); PG8_STAGE(PG8_SB(0, 0), b2, voB); PG8_STAGE(PG8_SB(0, 1), b2 + hstep, voB); PG8_STAGE(PG8_SA(0, 0), a2, xA[0]);
            PG8_WAIT_V(8); PG8_WAIT_L(0); PG8_BAR; PG8_MMA(1, 0, At, B0); PG8_MMA(1, 1, At, B1); PG8_BAR; PG8_SCHED;
            PG8_LDB(B0, 1, 0); PG8_LDB(B1, 1, 1); PG8_SCHED; PG8_LDA(At, 1, 0); PG8_STAGE(PG8_SA(0, 1), a2, xA[1]);
            PG8_WAIT_V(8); PG8_WAIT_L(0); PG8_BAR; PG8_MMA(0, 0, At, B0); PG8_MMA(0, 1, At, B1); PG8_BAR; PG8_SCHED;
            PG8_LDA(At, 1, 1); PG8_STAGE(PG8_SB(1, 0), b3, voB); PG8_STAGE(PG8_SB(1, 1), b3 + hstep, voB); PG8_STAGE(PG8_SA(1, 0), a3, xA[0]);
            PG8_WAIT_V(8); PG8_WAIT_L(0); PG8_BAR; PG8_MMA(1, 0, At, B0); PG8_MMA(1, 1, At, B1); PG8_BAR; PG8_SCHED;
        }
        if (wr == 0) PG8_BAR;
        E(acc, cur, wr, wc, fr, fq);
        if (!has_next) break;
#pragma unroll
        for (int a = 0; a < 2; ++a)
#pragma unroll
            for (int b = 0; b < 2; ++b)
#pragma unroll
                for (int m = 0; m < 4; ++m)
#pragma unroll
                    for (int n = 0; n < 2; ++n) acc[a][b][m][n] = (f32x4){0.f, 0.f, 0.f, 0.f};
        cur = nxt; cA = nA; cB = nB; ++ui;
        if constexpr (GATHER) {
#pragma unroll
            for (int h = 0; h < 2; ++h)
#pragma unroll
                for (int i = 0; i < 2; ++i) voA[h][i] = nvA[h][i];
        }
        if (wr == 1) PG8_BAR;
    }
    PG8_WAIT_V(0);
    PG8_BAR;
#undef PG8_SA
#undef PG8_SB
#undef PG8_STAGE
#undef PG8_LDA
#undef PG8_LDB
#undef PG8_MMA
#undef PG8_WAIT_V
#undef PG8_WAIT_L
#undef PG8_BAR
#undef PG8_SCHED
}
}

#ifndef PROBE_LDS2
#define PROBE_LDS2 0
#endif
#ifndef PROBE_EXP2
#define PROBE_EXP2 0
#endif
#ifndef SOFTMAX_PK
#define SOFTMAX_PK 0
#endif
#ifndef FA_FUSE
#define FA_FUSE 0
#endif
namespace fa {
constexpr int VBYTES_T = 64 * 128;
typedef short v4i16_t __attribute__((ext_vector_type(4)));
__device__ __forceinline__ u32x2 vtr(const LAS unsigned char* p) { return __builtin_bit_cast(u32x2, __builtin_amdgcn_ds_read_tr16_b64_v4i16((LAS v4i16_t*)p)); }
__device__ __forceinline__ float max16(const f32x16& c) { float r;
    asm("v_max3_f32 %0, %1, %2, %3\n\tv_max3_f32 %0, %0, %4, %5\n\tv_max3_f32 %0, %0, %6, %7\n\tv_max3_f32 %0, %0, %8, %9\n\tv_max3_f32 %0, %0, %10, %11\n\tv_max3_f32 %0, %0, %12, %13\n\tv_max3_f32 %0, %0, %14, %15\n\tv_max_f32 %0, %0, %16"
        : "=&v"(r) : "v"(c[0]), "v"(c[1]), "v"(c[2]), "v"(c[3]), "v"(c[4]), "v"(c[5]), "v"(c[6]), "v"(c[7]), "v"(c[8]), "v"(c[9]), "v"(c[10]), "v"(c[11]), "v"(c[12]), "v"(c[13]), "v"(c[14]), "v"(c[15]));
    return r; }
__device__ __forceinline__ void mask_init(f32x16& S, unsigned nw) { float t0, t1, t2, t3, t4, t5, t6, t7, t8, t9, t10, t11, t12, t13, t14, t15;
    asm("v_bfe_i32 %0, %16, 0, 1\n\tv_lshlrev_b32 %0, 23, %0\n\tv_bfe_i32 %1, %16, 1, 1\n\tv_lshlrev_b32 %1, 23, %1\n\tv_bfe_i32 %2, %16, 2, 1\n\tv_lshlrev_b32 %2, 23, %2\n\tv_bfe_i32 %3, %16, 3, 1\n\tv_lshlrev_b32 %3, 23, %3\n\tv_bfe_i32 %4, %16, 8, 1\n\tv_lshlrev_b32 %4, 23, %4\n\tv_bfe_i32 %5, %16, 9, 1\n\tv_lshlrev_b32 %5, 23, %5\n\tv_bfe_i32 %6, %16, 10, 1\n\tv_lshlrev_b32 %6, 23, %6\n\tv_bfe_i32 %7, %16, 11, 1\n\tv_lshlrev_b32 %7, 23, %7\n\tv_bfe_i32 %8, %16, 16, 1\n\tv_lshlrev_b32 %8, 23, %8\n\tv_bfe_i32 %9, %16, 17, 1\n\tv_lshlrev_b32 %9, 23, %9\n\tv_bfe_i32 %10, %16, 18, 1\n\tv_lshlrev_b32 %10, 23, %10\n\tv_bfe_i32 %11, %16, 19, 1\n\tv_lshlrev_b32 %11, 23, %11\n\tv_bfe_i32 %12, %16, 24, 1\n\tv_lshlrev_b32 %12, 23, %12\n\tv_bfe_i32 %13, %16, 25, 1\n\tv_lshlrev_b32 %13, 23, %13\n\tv_bfe_i32 %14, %16, 26, 1\n\tv_lshlrev_b32 %14, 23, %14\n\tv_bfe_i32 %15, %16, 27, 1\n\tv_lshlrev_b32 %15, 23, %15"
        : "=&v"(t0), "=&v"(t1), "=&v"(t2), "=&v"(t3), "=&v"(t4), "=&v"(t5), "=&v"(t6), "=&v"(t7), "=&v"(t8), "=&v"(t9), "=&v"(t10), "=&v"(t11), "=&v"(t12), "=&v"(t13), "=&v"(t14), "=&v"(t15) : "v"(nw));
    S[0] = t0; S[1] = t1; S[2] = t2; S[3] = t3; S[4] = t4; S[5] = t5; S[6] = t6; S[7] = t7; S[8] = t8; S[9] = t9; S[10] = t10; S[11] = t11; S[12] = t12; S[13] = t13; S[14] = t14; S[15] = t15; }
struct Params {
    const bf16* Q;  int q_pitch;
    const bf16* K1; int k1_pitch, k1_col;
    const bf16* K2; int k2_pitch, k2_col;
    const bf16* V;  int v_pitch, v_col;
    bf16* O; int o_pitch;
    float* LSE; int lse_pitch;
    const unsigned* BM;
    int CL, W;
};
struct UnitDesc { int seq0, qw, q_col, o_col, lse_col, k1_col, v_col, kt_lo, kt_hi; };
template <int DQK, int MODE, int NH, class DescFn>
__device__ __forceinline__ void attn_stream(const Params& P, LAS unsigned char* lds, const int tid, const int n_units, DescFn desc) {
    constexpr int NKS = DQK / 16, AHEAD = (NH == 2 ? 3 : 4), NST = AHEAD + 1, K1B = 8192 * NH, K2B = (DQK == 96 ? 4096 : 0), BMOFF = K1B + K2B + 8192 * NH, STB = BMOFF + (MODE == 1 ? 8192 : 0);
    constexpr int NDMA = 2 * NH + (DQK == 96 ? 1 : 0) + (MODE == 1 ? 1 : 0);
    static_assert(NH == 1 || (DQK == 64 && MODE != 1), "two-head stages: head dim 64 only");
    constexpr bool active = true;
    if (n_units <= 0) return;
    const int lane = tid & 63, r = lane & 31, h = lane >> 5, wave = __builtin_amdgcn_readfirstlane(tid >> 6);
    const int tq_ = (lane & 15) >> 2, tp_ = lane & 3, tg_ = lane >> 4;
    const int hsel = NH == 2 ? (wave >> 2) * 8192 : 0;
    const int vtoff = K1B + K2B + hsel + (4 * h + tq_) * 128, vxb = 2 * (16 * (tg_ & 1) + 4 * tp_), vsw = (tq_ >> 1) & 1;
    const int vx0 = vxb + ((0 ^ vsw) << 6), vx1 = vxb + ((1 ^ vsw) << 6);
    const int s1_ = (r >> 1) & 7, s2_ = (r >> 2) & 3;
    const int k1row = hsel + r * 128, k2row = K1B + r * 64;
    const int row1 = 8 * wave + (lane >> 3), row2 = 16 * (wave & 3) + (lane >> 2);
    const size_t tk1 = (size_t)64 * P.k1_pitch, tk2 = (size_t)64 * P.k2_pitch, tv = (size_t)64 * P.v_pitch;
    const int d_k1 = wave * 1024, d_k2 = K1B + (wave & 3) * 1024, d_v = K1B + K2B + wave * 1024;
    const bf16* src_k1; const bf16* src_v; const bf16* src_k2 = nullptr; const unsigned* bmp = nullptr;
    int ji = -1, kti = 1, kti_hi = 0;
    auto fa_issue = [&](const int st) __attribute__((always_inline)) {
        if (kti > kti_hi) {
            if (ji + 1 < n_units) { ++ji; const UnitDesc t = desc(ji); kti = t.kt_lo; kti_hi = t.kt_hi;
                src_k1 = P.K1 + (size_t)(t.seq0 + row1) * P.k1_pitch + t.k1_col + 8 * ((lane & 7) ^ ((row1 >> 1) & 7));
                src_v = P.V + (size_t)(t.seq0 + row1) * P.v_pitch + t.v_col + 8 * ((lane & 7) ^ (((row1 >> 1) & 1) << 2));
                if constexpr (DQK == 96) src_k2 = P.K2 + (size_t)(t.seq0 + row2) * P.k2_pitch + P.k2_col + 8 * ((lane & 3) ^ ((row2 >> 2) & 3));
                if constexpr (MODE == 1) bmp = P.BM + (size_t)(t.seq0 + t.qw + r) * 64;
            } else kti = kti_hi; }
        LAS unsigned char* sb_ = lds + st * STB;
        __builtin_amdgcn_global_load_lds((const unsigned*)(src_k1 + kti * tk1), (LAS unsigned*)(sb_ + d_k1), 16, 0, 0);
        __builtin_amdgcn_global_load_lds((const unsigned*)(src_v + kti * tv), (LAS unsigned*)(sb_ + d_v), 16, 0, 0);
        if constexpr (NH == 2) {
            __builtin_amdgcn_global_load_lds((const unsigned*)(src_k1 + 64 + kti * tk1), (LAS unsigned*)(sb_ + d_k1 + 8192), 16, 0, 0);
            __builtin_amdgcn_global_load_lds((const unsigned*)(src_v + 64 + kti * tv), (LAS unsigned*)(sb_ + d_v + 8192), 16, 0, 0); }
        if constexpr (DQK == 96) __builtin_amdgcn_global_load_lds((const unsigned*)(src_k2 + kti * tk2), (LAS unsigned*)(sb_ + d_k2), 16, 0, 0);
        if constexpr (MODE == 1) __builtin_amdgcn_global_load_lds(bmp + (kti & ~1) * 2, (LAS unsigned*)(sb_ + BMOFF + wave * 1024), 16, 0, 0);
        ++kti; };
#define FA_ISSUE(TILE, ST) fa_issue(ST)
    int st_is = 0, st_c = 0, st_n = 1;
    bf16x8 qf[NKS];
#define FA_LOADQ(D) do { const bf16* qp_ = P.Q + (size_t)((D).seq0 + (D).qw + r) * P.q_pitch + (D).q_col + 8 * h; \
        _Pragma("unroll") for (int ks = 0; ks < NKS; ++ks) asm volatile("global_load_dwordx4 %0, %1, off offset:%2" : "=&v"(qf[ks]) : "v"(qp_), "n"(32 * ks) : "memory"); } while (0)
#define FA_WAITQ(N) do { if constexpr (NKS == 6) asm volatile("s_waitcnt vmcnt(%6)" : "+v"(qf[0]), "+v"(qf[1]), "+v"(qf[2]), "+v"(qf[3]), "+v"(qf[4]), "+v"(qf[5]) : "n"(N) : "memory"); \
        else asm volatile("s_waitcnt vmcnt(%4)" : "+v"(qf[0]), "+v"(qf[1]), "+v"(qf[2]), "+v"(qf[3]) : "n"(N) : "memory"); } while (0)
    { const UnitDesc d0 = desc(0); FA_LOADQ(d0); FA_WAITQ(0); }
#pragma unroll 1
    for (int ju = 0; ju < n_units; ++ju) {
    const UnitDesc du = desc(ju);
    const int seq0 = du.seq0, qw = du.qw, q_col = du.q_col, o_col = du.o_col, lse_col = du.lse_col, kt_lo = du.kt_lo, kt_hi = du.kt_hi;
    const int q = qw + r;
    const int lo_q = MODE == 0 ? max(q & ~(P.CL - 1), q - P.W) : 0;
    const int qh = q - 4 * h, lqh = lo_q - 4 * h;
    const int lo_w0 = MODE == 0 ? max(qw & ~(P.CL - 1), qw - P.W) : 0;
    const int lo_w1 = MODE == 0 ? max((qw + 31) & ~(P.CL - 1), qw + 31 - P.W) : 0;
#define FA_WAITBAR(N) do { asm volatile("s_waitcnt vmcnt(%0)" :: "n"(N) : "memory"); __builtin_amdgcn_s_barrier(); asm volatile("" ::: "memory"); } while (0)
    f32x16 o0, o1, c0, c1, n0, n1;
#pragma unroll
    for (int i = 0; i < 16; ++i) { o0[i] = 0.f; o1[i] = 0.f; c0[i] = 0.f; c1[i] = 0.f; n0[i] = 0.f; n1[i] = 0.f; }
    float m = -INFINITY, l = 0.f;
#define FA_PART(kt_) (active && (MODE == 0 ? ((kt_) * 64 <= qw + 31 && (kt_) * 64 + 63 >= lo_w0) : ((kt_) * 64 <= qw + 31)))
#define FA_KADDR(SB_, ROFF, ks) ((ks) < 4 ? (SB_) + (ROFF) * 128 + k1row + 16 * ((2 * (ks) + h) ^ s1_) : (SB_) + (ROFF) * 64 + k2row + 16 * ((2 * ((ks) - 4) + h) ^ s2_))
#define FA_QKH(S, SB_, ROFF, NW) do { bf16x8 fa_[NKS]; \
        _Pragma("unroll") for (int ks = 0; ks < NKS; ++ks) fa_[ks] = *(const LAS bf16x8*)FA_KADDR(SB_, ROFF, ks); \
        if (PROBE_LDS2) { _Pragma("unroll") for (int ks = 0; ks < NKS; ++ks) { const bf16x8 fb_ = *(const volatile LAS bf16x8*)FA_KADDR(SB_, (ROFF) ^ 32, ks); asm volatile("" :: "v"(fb_)); } } \
        if constexpr (MODE == 1) {        \
            mask_init(S, NW); \
        } else { _Pragma("unroll") for (int i = 0; i < 16; ++i) S[i] = 0.f; } \
        _Pragma("unroll") for (int ks = 0; ks < NKS; ++ks) S = __builtin_amdgcn_mfma_f32_32x32x16_bf16(fa_[ks], qf[ks], S, 0, 0, 0); \
        __builtin_amdgcn_sched_group_barrier(0x100, NKS, 0); __builtin_amdgcn_sched_group_barrier(0x008, NKS, 0); } while (0)
#define FA_QK(S0, S1, SB_, KT) do { unsigned nwa_ = 0u, nwb_ = 0u; \
        if constexpr (MODE == 1) { const u32x4 bw_ = *(const LAS u32x4*)((SB_) + BMOFF + wave * 1024 + lane * 16);        \
            nwa_ = ~((((KT) & 1) ? bw_.z : bw_.x) >> (4 * h)); nwb_ = ~((((KT) & 1) ? bw_.w : bw_.y) >> (4 * h)); } \
        FA_QKH(S0, SB_, 0, nwa_); FA_QKH(S1, SB_, 32, nwb_); } while (0)
#define FA_QKX(S, SB_, ROFF) do { bf16x8 fa_[NKS]; \
        _Pragma("unroll") for (int ks = 0; ks < NKS; ++ks) fa_[ks] = *(const LAS bf16x8*)FA_KADDR(SB_, ROFF, ks); \
        _Pragma("unroll") for (int i = 0; i < 16; ++i) S[i] = 0.f; \
        _Pragma("unroll") for (int ks = 0; ks < NKS; ++ks) S = __builtin_amdgcn_mfma_f32_32x32x16_bf16(fa_[ks], qf[ks], S, 0, 0, 0); } while (0)
    if (ju == 0) {
#pragma unroll 1
        for (int a = 0; a < AHEAD; ++a) { FA_ISSUE(kt_lo + a, st_is); st_is = st_is + 1; }
        FA_WAITBAR((AHEAD - 2) * NDMA);
    }
    if (FA_PART(kt_lo)) FA_QK(c0, c1, lds + st_c * STB, kt_lo);
    auto fa_step = [&](f32x16& c0, f32x16& c1, f32x16& n0, f32x16& n1, const int kt) __attribute__((always_inline)) {
        FA_ISSUE(kt + AHEAD, st_is); st_is = (st_is + 1 == NST) ? 0 : st_is + 1;
        const bool more1 = kt < kt_hi;
        const bool qnext = !more1 && (ju + 1 < n_units);
        if (qnext) { const UnitDesc dq = desc(ju + 1); FA_LOADQ(dq); }
        const int k0 = kt * 64;
        const bool part_c = FA_PART(kt), part_n = more1 && FA_PART(kt + 1);
        const LAS unsigned char* Sn = lds + st_n * STB; const LAS unsigned char* Vb = lds + st_c * STB;
        const bool fused = FA_FUSE && (DQK == 64) && part_c && part_n;
        if (part_n && !fused) FA_QK(n0, n1, Sn, kt + 1);
        if (part_c) {
            float alpha;
#define FA_SOFTMAX(MASKED) do { \
            if (MASKED) { if constexpr (MODE == 2) { const int qa = qh - k0, qa1 = qa - 32; \
                    _Pragma("unroll") for (int i = 0; i < 16; ++i) { const int ci = (i & 3) + 8 * (i >> 2); \
                        c0[i] = (ci > qa) ? -INFINITY : c0[i]; c1[i] = (ci > qa1) ? -INFINITY : c1[i]; } \
                } else if constexpr (MODE == 0) { const int lb = lqh - k0; const unsigned span = (unsigned)(q - lo_q), lb1 = (unsigned)(lb - 32);     \
                    _Pragma("unroll") for (int i = 0; i < 16; ++i) { const int ci = (i & 3) + 8 * (i >> 2); \
                        c0[i] = ((unsigned)(ci - lb) > span) ? -INFINITY : c0[i]; c1[i] = ((unsigned)ci - lb1 > span) ? -INFINITY : c1[i]; } \
                } } \
            float mx = xhalf_max(fmaxf(max16(c0), max16(c1))); \
            const float mn = fmaxf(m, mx); \
            const float ms = (mn == -INFINITY) ? 0.f : mn; \
            alpha = __builtin_amdgcn_exp2f(m - ms); \
            m = mn; \
            float ls = 0.f; \
            if (PROBE_EXP2) { float dm_ = 0.f; _Pragma("unroll") for (int i = 0; i < 16; ++i) { dm_ += __builtin_amdgcn_exp2f(c0[i] - mx) + __builtin_amdgcn_exp2f(c1[i] - mx); } asm volatile("" :: "v"(dm_)); } \
            if (SOFTMAX_PK) { const f32x2 ms2 = {ms, ms}; f32x2 lsa = {0.f, 0.f}, lsb = {0.f, 0.f};            \
              _Pragma("unroll") for (int i = 0; i < 16; i += 2) { \
                  f32x2 ta = {c0[i], c0[i + 1]}, tb = {c1[i], c1[i + 1]}; ta = ta - ms2; tb = tb - ms2; \
                  ta.x = __builtin_amdgcn_exp2f(ta.x); ta.y = __builtin_amdgcn_exp2f(ta.y); tb.x = __builtin_amdgcn_exp2f(tb.x); tb.y = __builtin_amdgcn_exp2f(tb.y); \
                  c0[i] = ta.x; c0[i + 1] = ta.y; c1[i] = tb.x; c1[i + 1] = tb.y; lsa = lsa + ta; lsb = lsb + tb; } \
              lsa = lsa + lsb; ls = lsa.x + lsa.y; \
            } else {        \
              _Pragma("unroll") for (int i = 0; i < 16; ++i) { c0[i] = __builtin_amdgcn_exp2f(c0[i] - ms); c1[i] = __builtin_amdgcn_exp2f(c1[i] - ms); ls += c0[i] + c1[i]; } } \
            l = l * alpha + ls; } while (0)
            const bool need_mask = MODE == 1 ? false : (MODE == 2 ? (k0 + 63 > qw) : ((k0 + 63 > qw) || (k0 < lo_w1)));
#define FA_FUSED(MASKED) do { FA_QKX(n0, Sn, 0); FA_QKX(n1, Sn, 32); FA_SOFTMAX(MASKED); \
            _Pragma("unroll") for (int hh_ = 0; hh_ < 2; ++hh_) { \
                __builtin_amdgcn_sched_group_barrier(0x100, NKS, 0); \
                _Pragma("unroll") for (int i = 0; i < NKS; ++i) { __builtin_amdgcn_sched_group_barrier(0x008, 1, 0); __builtin_amdgcn_sched_group_barrier(0x002, 120 / (2 * NKS), 0); } } } while (0)
            if (fused) { if (need_mask) FA_FUSED(true); else FA_FUSED(false); }
            else { if (need_mask) FA_SOFTMAX(true); else FA_SOFTMAX(false); }
#undef FA_FUSED
#undef FA_SOFTMAX
            if (!__all(alpha == 1.0f)) {
#pragma unroll
                for (int i = 0; i < 16; ++i) { o0[i] *= alpha; o1[i] *= alpha; } }
#pragma unroll
            for (int kb = 0; kb < 2; ++kb) {
                const f32x16& s = kb ? c1 : c0;
                u32x2 va[2][2], vb[2][2];
                const unsigned vaddr = (unsigned)(size_t)(Vb + (32 * kb) * 128 + vtoff);
#pragma unroll
                for (int sk = 0; sk < 2; ++sk) {
                    asm volatile("ds_read_b64_tr_b16 %0, %1" : "=&v"(va[sk][0]) : "v"(vaddr + (unsigned)(sk * 2048 + vx0)) : "memory");
                    asm volatile("ds_read_b64_tr_b16 %0, %1" : "=&v"(vb[sk][0]) : "v"(vaddr + (unsigned)(sk * 2048 + 1024 + vx0)) : "memory");
                    asm volatile("ds_read_b64_tr_b16 %0, %1" : "=&v"(va[sk][1]) : "v"(vaddr + (unsigned)(sk * 2048 + vx1)) : "memory");
                    asm volatile("ds_read_b64_tr_b16 %0, %1" : "=&v"(vb[sk][1]) : "v"(vaddr + (unsigned)(sk * 2048 + 1024 + vx1)) : "memory");
                }
                bf16x8 pf[2];
#pragma unroll
                for (int sk = 0; sk < 2; ++sk) { u32x4 pw; pw.x = pk2(s[8 * sk + 0], s[8 * sk + 1]); pw.y = pk2(s[8 * sk + 2], s[8 * sk + 3]); pw.z = pk2(s[8 * sk + 4], s[8 * sk + 5]); pw.w = pk2(s[8 * sk + 6], s[8 * sk + 7]); pf[sk] = __builtin_bit_cast(bf16x8, pw); }
                asm volatile("s_waitcnt lgkmcnt(0)" : "+v"(va[0][0]), "+v"(vb[0][0]), "+v"(va[0][1]), "+v"(vb[0][1]), "+v"(va[1][0]), "+v"(vb[1][0]), "+v"(va[1][1]), "+v"(vb[1][1]) :: "memory");
                __builtin_amdgcn_sched_barrier(0);
#pragma unroll
                for (int sk = 0; sk < 2; ++sk) {
                    const u32x4 v0w = {va[sk][0].x, va[sk][0].y, vb[sk][0].x, vb[sk][0].y}, v1w = {va[sk][1].x, va[sk][1].y, vb[sk][1].x, vb[sk][1].y};
                    o0 = __builtin_amdgcn_mfma_f32_32x32x16_bf16(__builtin_bit_cast(bf16x8, v0w), pf[sk], o0, 0, 0, 0);
                    o1 = __builtin_amdgcn_mfma_f32_32x32x16_bf16(__builtin_bit_cast(bf16x8, v1w), pf[sk], o1, 0, 0, 0);
                }
            }
        }
        if (qnext) FA_WAITBAR((AHEAD - 2) * NDMA + NKS); else FA_WAITBAR((AHEAD - 2) * NDMA);
        st_c = st_n; st_n = (st_n + 1 == NST) ? 0 : st_n + 1;
    };
    for (int kt = kt_lo;;) { fa_step(c0, c1, n0, n1, kt); if (++kt > kt_hi) break; fa_step(n0, n1, c0, c1, kt); if (++kt > kt_hi) break; }
#undef FA_PART
#undef FA_QK
#undef FA_QKH
#undef FA_QKX
#undef FA_KADDR
    const float lt = xhalf_sum(l);
    const float inv = 1.0f / lt;
    if (active) {
    bf16* op = P.O + (size_t)(seq0 + q) * P.o_pitch + o_col + 8 * h;
#pragma unroll
    for (int db = 0; db < 2; ++db) {
        const f32x16& o = db ? o1 : o0;
#pragma unroll
        for (int j = 0; j < 2; ++j) {
            u32x2 X, Y;
            X.x = pk2(o[8 * j] * inv, o[8 * j + 1] * inv); X.y = pk2(o[8 * j + 2] * inv, o[8 * j + 3] * inv);
            Y.x = pk2(o[8 * j + 4] * inv, o[8 * j + 5] * inv); Y.y = pk2(o[8 * j + 6] * inv, o[8 * j + 7] * inv);
            const auto a = __builtin_amdgcn_permlane32_swap(X.x, Y.x, false, false); const auto b = __builtin_amdgcn_permlane32_swap(X.y, Y.y, false, false);
            u32x4 w; w.x = a[0]; w.y = b[0]; w.z = a[1]; w.w = b[1];
            stg16<NT_ATT>(op + 32 * db + 16 * j, w);
        }
    }
    if (P.LSE && h == 0) P.LSE[(size_t)(seq0 + q) * P.lse_pitch + lse_col] = m + __builtin_amdgcn_logf(lt);
    }
    __builtin_amdgcn_sched_barrier(0);
    FA_WAITQ(4);
    }
    asm volatile("s_waitcnt vmcnt(0)" ::: "memory"); __builtin_amdgcn_s_barrier(); asm volatile("" ::: "memory");
#undef FA_ISSUE
#undef FA_LOADQ
#undef FA_WAITQ
#undef FA_WAITBAR
}
}

struct Args {
    const float* x; const int* pos; const float* w_in; const float* qn; const float* kvn; const float* w_uq; const float* w_ukv; const float* w_o;
    const float* ln1g; const float* ln1b; const float* rgw; const float* rgb; const float* rew; const float* reb;
    const float* wg; const float* wu; const float* wd; const float* ln2g; const float* ln2b;
    float* out; unsigned char* ws; int l_lo, l_hi, ph_lo, ph_hi, use_bar, pad;
};
typedef const __attribute__((address_space(4))) Args CArgs;
struct Ctx { LAS unsigned char* lds; int tid, lane, wave, G, c, vcu; unsigned char* ws; };

struct ColIdent { int off; __device__ __forceinline__ int operator()(int P) const { return off + P; } };
struct ColAdj { __device__ __forceinline__ int operator()(int P) const { const int p = P & 255; return (P & ~255) + 64 * ((p >> 5) & 3) + 32 * (p >> 7) + (p & 31); } };
__device__ __forceinline__ int map_rope32(int p) { return 16 * ((p >> 2) & 1) + 4 * (p >> 3) + (p & 3); }
__device__ __forceinline__ int map_head16(int p) { const int fq = p >> 3; return 16 * (fq >> 1) + 8 * ((p >> 2) & 1) + 4 * (fq & 1) + (p & 3); }
struct ColWin {
    __device__ __forceinline__ int operator()(int P) const {
        const int G = P >> 5, p = P & 31;
        if (G < 8) return 32 * G + p;
        if (G < 12) return 256 + 32 * (G - 8) + p;
        if (G == 12) return 384 + map_rope32(p);
        if (G == 13) return 1056 + p;
        if (G == 14) return 672 + map_head16(p);
        if (G == 15) return 704 + p;
        if (G < 24) { const int hh = (G - 16) >> 1; return 416 + 64 * hh + (((G - 16) & 1) ? 32 + p : map_head16(p)); }
        if (G < 26) return 736 + 32 * (G - 24) + p;
        if (G == 26) return p < 8 ? 1088 + p : -1;
        if (G < 32) return -1;
        if (G < 40) return 800 + 32 * (G - 32) + p;
        if (G < 64) { const int j = G - 40; return 1096 + 64 * (j >> 1) + ((j & 1) ? 32 + p : map_head16(p)); }
        if (G < 88) { const int j = G - 64; return 1096 + 768 + 64 * (j >> 1) + ((j & 1) ? 32 + p : map_head16(p)); }
        return 1096 + 1536 + 32 * (G - 88) + p;
    }
};
struct ColUq {
    __device__ __forceinline__ int operator()(int P) const { const int G = P >> 5, p = P & 31; return 32 * G + ((G % 3 == 2) ? map_rope32(p) : p); }
};
template <class ColFn>
__device__ __forceinline__ void transpose_item(const float* W, int ldw, int kvalid, bf16* WT, int ldt, int k0, int P0, const ColFn& cf, const float* rowscale, LAS float* scr, int lane) {
    const int c = lane & 31, col = cf(P0 + c);
#pragma unroll 8
    for (int i = 0; i < 32; ++i) { const int kk = 2 * i + (lane >> 5), k = k0 + kk; float v = 0.f;
        if (col >= 0 && k < kvalid) { v = W[(size_t)k * ldw + col]; if (rowscale) v *= rowscale[k]; }
        scr[kk * 33 + c] = v; }
    asm volatile("s_waitcnt lgkmcnt(0)" ::: "memory");
    const int cc = lane & 7;
#pragma unroll
    for (int j = 0; j < 4; ++j) { const int n = (lane >> 3) + 8 * j; const LAS float* s = scr + (8 * cc) * 33 + n;
        u32x4 o; o.x = pk2(s[0 * 33], s[1 * 33]); o.y = pk2(s[2 * 33], s[3 * 33]); o.z = pk2(s[4 * 33], s[5 * 33]); o.w = pk2(s[6 * 33], s[7 * 33]);
        *(u32x4*)(WT + (size_t)(P0 + n) * ldt + k0 + 8 * cc) = o; }
    asm volatile("s_waitcnt lgkmcnt(0)" ::: "memory");
}
__device__ __forceinline__ void prologue(const Ctx& X, const CArgs* ap) {
    struct { const float* x; const float *w_in, *qn, *kvn, *w_uq, *w_ukv, *w_o, *rgw, *rew; } a = {ap->x, ap->w_in, ap->qn, ap->kvn, ap->w_uq, ap->w_ukv, ap->w_o, ap->rgw, ap->rew};
    LAS float* scr = (LAS float*)(X.lds + X.wave * 16384);
    const int gw = X.vcu * 8 + X.wave, NGW = X.G * 8;
    constexpr int I_WIN = 16 * 112, I_UQ = 4 * 24, I_UKV = 4 * 32, I_WO = 16 * 32, I_L = I_WIN + I_UQ + I_UKV + I_WO;
    for (int it = gw; it < DEPTH * I_L; it += NGW) {
        const int l = it / I_L; int r = it % I_L;
        if (r < I_WIN) { transpose_item(a.w_in + (size_t)l * DM * IN_COLS, IN_COLS, DM, (bf16*)(X.ws + WS_WIN) + (size_t)l * NIN * DM, DM, 64 * (r / 112), 32 * (r % 112), ColWin{}, nullptr, scr, X.lane); continue; }
        r -= I_WIN;
        if (r < I_UQ) { transpose_item(a.w_uq + (size_t)l * 256 * 768, 768, 256, (bf16*)(X.ws + WS_WUQ) + (size_t)l * 768 * 256, 256, 64 * (r / 24), 32 * (r % 24), ColUq{}, a.qn + l * 256, scr, X.lane); continue; }
        r -= I_UQ;
        if (r < I_UKV) { transpose_item(a.w_ukv + (size_t)l * 128 * 1024, 1024, 128, (bf16*)(X.ws + WS_WUKV) + (size_t)l * 1024 * 256, 256, 64 * (r / 32), 32 * (r % 32), ColAdj{}, a.kvn + l * 128, scr, X.lane); continue; }
        r -= I_UKV;
        transpose_item(a.w_o + (size_t)l * DM * DM, DM, DM, (bf16*)(X.ws + WS_WO) + (size_t)l * DM * DM, DM, 64 * (r / 32), 32 * (r % 32), ColAdj{}, nullptr, scr, X.lane);
    }
    const size_t gt = (size_t)X.vcu * 512 + X.tid, NGT = (size_t)X.G * 512;
    { float* rgt = (float*)(X.ws + WS_RGT); float* ret = (float*)(X.ws + WS_RET);
      for (size_t i = gt; i < (size_t)DEPTH * 4 * DM; i += NGT) { const int l = (int)(i / (4 * DM)), g = (int)(i / DM) & 3, k = (int)(i % DM); rgt[i] = a.rgw[((size_t)l * DM + k) * 4 + g]; }
      for (size_t i = gt; i < (size_t)DEPTH * 32 * DM; i += NGT) { const int l = (int)(i / (32 * DM)), ge = (int)(i / DM) & 31, k = (int)(i % DM); ret[i] = a.rew[(((size_t)l * 4 + (ge >> 3)) * DM + k) * 8 + (ge & 7)]; } }
    { u32x4* z = (u32x4*)(X.ws + WS_T1); for (size_t i = gt; i < (size_t)NT * 256 * 2 / 16; i += NGT) z[i] = (u32x4){0u, 0u, 0u, 0u}; }
    { const f32x4* xs = (const f32x4*)a.x; u32x2* xb = (u32x2*)(X.ws + WS_XB);
      for (size_t i = gt; i < (size_t)NT * DM / 4; i += NGT) { const f32x4 v = xs[i]; u32x2 w; w.x = pk2(v[0], v[1]); w.y = pk2(v[2], v[3]); xb[i] = w; } }
}
__device__ __forceinline__ void convert_experts(const Ctx& X, const CArgs* ap, int l) {
    struct { const float *wg, *wu, *wd; } a = {ap->wg, ap->wu, ap->wd};
    LAS float* scr = (LAS float*)(X.lds + X.wave * 16384);
    const int gw = X.vcu * 8 + X.wave, NGW = X.G * 8;
    constexpr int I_GU = 32 * 16 * 16, I_D = 32 * 4 * 32;
    for (int it = gw; it < I_GU + I_D; it += NGW) {
        if (it < I_GU) { const int e = it >> 8, r = it & 255, G32 = r >> 4, kb = r & 15; const int pn = G32 >> 3, r0 = (G32 & 7) * 32; const bool up = r0 >= 128;
            const float* W = (up ? a.wu : a.wg) + ((size_t)l * NEXP + e) * DM * FH;
            transpose_item(W, FH, DM, (bf16*)(X.ws + WS_WGU) + (size_t)e * 512 * DM, DM, 64 * kb, 32 * G32, ColIdent{128 * pn + (r0 & 127) - 32 * G32}, nullptr, scr, X.lane);
        } else { const int r = it - I_GU, e = r >> 7, q = r & 127, kb = q >> 5, pg = q & 31;
            transpose_item(a.wd + ((size_t)l * NEXP + e) * FH * DM, DM, FH, (bf16*)(X.ws + WS_WD) + (size_t)e * DM * FH, FH, 64 * kb, 32 * pg, ColAdj{}, nullptr, scr, X.lane); }
    }
}

struct InProjDesc {
    unsigned char* ws;
    __device__ __forceinline__ pg8::GroupDesc operator()(int pn, int bj, int wc) const {
        using namespace pg8; const int G = 8 * pn + 4 * bj + wc; GroupDesc d; d.kind = GK_PLAIN; d.dst = nullptr; d.pitch = 256; d.col = 0; d.scale = 1.f; d.perm = 0; d.ssq = nullptr; d.ssq_n = 0; d.ssq_i = 0;
        if (G < 8) { d.dst = (bf16*)(ws + WS_CQ); d.col = 32 * G; d.ssq = (float*)(ws + WS_SSQ); d.ssq_n = 8; d.ssq_i = G; }
        else if (G < 12) { d.dst = (bf16*)(ws + WS_T1); d.col = 32 * (G - 8); d.ssq = (float*)(ws + WS_SSQ) + (size_t)NT * 8; d.ssq_n = 4; d.ssq_i = G - 8; }
        else if (G == 12) { d.kind = GK_ROPE32; d.dst = (bf16*)(ws + WS_KPE); d.pitch = 32; d.col = 0; }
        else if (G == 13) { d.kind = GK_IDX8; d.dst = (bf16*)(ws + WS_KI); d.pitch = 32; d.col = 0; }
        else if (G == 14) { d.kind = GK_HEAD16; d.dst = (bf16*)(ws + WS_T1); d.col = 192; }
        else if (G == 15) { d.dst = (bf16*)(ws + WS_T1); d.col = 224; }
        else if (G < 24) { d.kind = ((G - 16) & 1) ? GK_PLAIN : GK_HEAD16; d.dst = (bf16*)(ws + WS_BQ); d.col = 32 * (G - 16); d.scale = QSC64; }
        else if (G < 26) { d.dst = (bf16*)(ws + WS_BV); d.pitch = 64; d.col = 32 * (G - 24); }
        else if (G == 26) { d.kind = GK_WI; d.dst = (bf16*)(ws + WS_WI); }
        else if (G < 32) { d.kind = GK_SKIP; }
        else if (G < 40) { d.kind = GK_IDX8; d.dst = (bf16*)(ws + WS_BQI); d.col = 32 * (G - 32); }
        else if (G < 64) { const int j = G - 40, cfg = j >> 3; d.kind = (j & 1) ? GK_PLAIN : GK_HEAD16; d.dst = (bf16*)(ws + WS_DQ) + (size_t)cfg * NT * 256; d.col = 32 * (j & 7); d.scale = QSC64; d.perm = cfg == 0 ? 0 : (cfg == 1 ? 4 : 16); }
        else if (G < 88) { const int j = G - 64, cfg = j >> 3; d.kind = (j & 1) ? GK_PLAIN : GK_HEAD16; d.dst = (bf16*)(ws + WS_DK) + (size_t)cfg * NT * 256; d.col = 32 * (j & 7); d.perm = cfg == 0 ? 0 : (cfg == 1 ? 4 : 16); }
        else { const int j = G - 88, cfg = j >> 3; d.dst = (bf16*)(ws + WS_DV) + (size_t)cfg * NT * 256; d.col = 32 * (j & 7); d.perm = cfg == 0 ? 0 : (cfg == 1 ? 4 : 16); }
        return d;
    }
};
struct UqDesc {
    unsigned char* ws;
    __device__ __forceinline__ pg8::GroupDesc operator()(int pn, int bj, int wc) const {
        using namespace pg8; const int G = 8 * pn + 4 * bj + wc; GroupDesc d; d.kind = (G % 3 == 2) ? GK_ROPE32 : GK_PLAIN; d.dst = (bf16*)(ws + WS_QA); d.pitch = 768; d.col = 32 * G; d.scale = QSC96; d.perm = 0; d.ssq = nullptr; d.ssq_n = 0; d.ssq_i = 0;
        return d;
    }
};

__device__ __forceinline__ unsigned f16key(float v) { const _Float16 hf = (_Float16)v; const unsigned u = (unsigned)__builtin_bit_cast(unsigned short, hf); return (u ^ ((unsigned)__builtin_amdgcn_sbfe((int)u, 15, 1) | 0x8000u)) & 0xffffu; }
__device__ __forceinline__ unsigned pk_cnt(unsigned acc, unsigned kp2, unsigned mid2, unsigned one2) {
    unsigned t;
    asm("v_pk_sub_u16 %0, %2, %3 clamp\n\tv_pk_min_u16 %0, %0, %4\n\tv_pk_add_u16 %1, %1, %0" : "=&v"(t), "+v"(acc) : "v"(kp2), "s"(mid2), "s"(one2));
    return acc;
}
__device__ __forceinline__ int count_gt(const unsigned (&kp)[16], unsigned mid) {
    const unsigned m2 = __builtin_amdgcn_readfirstlane(mid | (mid << 16)), one2 = __builtin_amdgcn_readfirstlane(0x00010001u);
    unsigned a0 = 0u, a1 = 0u;
#pragma unroll
    for (int i = 0; i < 16; i += 2) { a0 = pk_cnt(a0, kp[i], m2, one2); a1 = pk_cnt(a1, kp[i + 1], m2, one2); }
    unsigned aw; asm("v_pk_add_u16 %0, %1, %2" : "=v"(aw) : "v"(a0), "v"(a1));
    const unsigned c = (aw & 0xffffu) + (aw >> 16);
    int tot = 0;
#pragma unroll
    for (int b = 0; b < 6; ++b) tot += __builtin_popcountll(__ballot((c >> b) & 1u)) << b;
    return tot;
}
__device__ __forceinline__ int wave_scan_incl(int v) {
    v += __builtin_amdgcn_update_dpp(0, v, 0x111, 0xf, 0xf, false); v += __builtin_amdgcn_update_dpp(0, v, 0x112, 0xf, 0xf, false);
    v += __builtin_amdgcn_update_dpp(0, v, 0x114, 0xf, 0xf, false); v += __builtin_amdgcn_update_dpp(0, v, 0x118, 0xf, 0xf, false);
    v += __builtin_amdgcn_update_dpp(0, v, 0x142, 0xa, 0xf, false); v += __builtin_amdgcn_update_dpp(0, v, 0x143, 0xc, 0xf, false);
    return v;
}
__device__ __forceinline__ void radix_pick(const LAS unsigned* hist, int lane, int target, int& B, int& above, int& inbin) {
    const u32x2 hw = *(const LAS u32x2*)(hist + 2 * lane);
    const int c0 = (int)(hw.x & 0xffffu), c1 = (int)(hw.x >> 16), c2 = (int)(hw.y & 0xffffu), c3 = (int)(hw.y >> 16);
    const int tl = (c0 + c1) + (c2 + c3);
    const int pre = wave_scan_incl(tl);
    const int suf = __builtin_amdgcn_readlane(pre, 63) - pre + tl;
    const unsigned long long reach = __ballot(suf >= target);
    const int ls = 63 - __builtin_clzll(reach | 1ull);
    int a = suf - tl, b = 4 * lane + 3, ib = c3;
    if (a + c3 < target) { a += c3; b = 4 * lane + 2; ib = c2; if (a + c2 < target) { a += c2; b = 4 * lane + 1; ib = c1; if (a + c1 < target) { a += c1; b = 4 * lane; ib = c0; } } }
    B = __builtin_amdgcn_readlane(b, ls); above = __builtin_amdgcn_readlane(a, ls); inbin = __builtin_amdgcn_readlane(ib, ls);
}
__device__ __forceinline__ float relu_i(float x) { const int i = __builtin_bit_cast(int, x); return __builtin_bit_cast(float, i > 0 ? i : 0); }
__device__ __forceinline__ void dsa_index_unit(const Ctx& X, int b, int q0) {
    const int lane = X.lane, r = lane & 31, h = lane >> 5; const size_t seq0 = (size_t)b * SEQ; const int t0 = q0 + 4 * X.wave;
    const bf16* BQI = (const bf16*)(X.ws + WS_BQI); const bf16* KI = (const bf16*)(X.ws + WS_KI); const float* WI = (const float*)(X.ws + WS_WI);
    LAS unsigned short* rows = (LAS unsigned short*)(X.lds + X.wave * 16384);
    LAS unsigned char* kbuf = X.lds + LDS_X_OFF;
    const bf16* ap = BQI + (seq0 + t0 + (r >> 3)) * 256 + 32 * (r & 7) + 16 * h;
    const bf16x8 a0 = *(const bf16x8*)ap, a1 = *(const bf16x8*)(ap + 8);
    f32x2 wq[4][2];
#pragma unroll
    for (int j = 0; j < 4; ++j) { const f32x4 w = *(const f32x4*)(WI + (seq0 + t0 + j) * 8 + 4 * h);
        wq[j][0] = (f32x2){w[0] * IDX_SCALE, w[1] * IDX_SCALE}; wq[j][1] = (f32x2){w[2] * IDX_SCALE, w[3] * IDX_SCALE}; }
    const int nch = ((q0 + 31) >> 7) + 1;
    const int skey = X.tid >> 2, spc = X.tid & 3;
    const bf16* sp = KI + (seq0 + skey) * 32 + 8 * spc;
    const int sdst = skey * 64 + ((spc ^ ((skey >> 2) & 3)) << 4);
    u32x4 stg0 = *(const u32x4*)sp, stg1 = stg0, stg2 = stg0, stg3 = stg0;
    if (1 < nch) stg1 = *(const u32x4*)(sp + (size_t)1 * 128 * 32);
    if (2 < nch) stg2 = *(const u32x4*)(sp + (size_t)2 * 128 * 32);
    if (3 < nch) stg3 = *(const u32x4*)(sp + (size_t)3 * 128 * 32);
    *(LAS u32x4*)(kbuf + sdst) = stg0;
    __syncthreads();
#define DSA_STEP(J, RCUR, RNEXT) { const int c = c0 + (J); \
        if (c + 4 < nch) RCUR = *(const u32x4*)(sp + (size_t)(c + 4) * 128 * 32); \
        const LAS unsigned char* kb = kbuf + (c & 1) * 8192; \
        _Pragma("unroll") for (int tq = 0; tq < 4; ++tq) { \
            const int key = 32 * tq + r, sw = (key >> 2) & 3; \
            const bf16x8 b0 = *(const LAS bf16x8*)(kb + key * 64 + (((2 * h) ^ sw) << 4)), b1 = *(const LAS bf16x8*)(kb + key * 64 + (((2 * h + 1) ^ sw) << 4)); \
            f32x16 acc; \
            _Pragma("unroll") for (int i = 0; i < 16; ++i) acc[i] = 0.f; \
            acc = __builtin_amdgcn_mfma_f32_32x32x16_bf16(a0, b0, acc, 0, 0, 0); \
            acc = __builtin_amdgcn_mfma_f32_32x32x16_bf16(a1, b1, acc, 0, 0, 0); \
            float p[4]; \
            _Pragma("unroll") for (int j = 0; j < 4; ++j) {            \
                const f32x2 ra = {relu_i(acc[4 * j]), relu_i(acc[4 * j + 1])}, rb = {relu_i(acc[4 * j + 2]), relu_i(acc[4 * j + 3])}; \
                const f32x2 pp = __builtin_elementwise_fma(rb, wq[j][1], ra * wq[j][0]); \
                p[j] = pp.x + pp.y; } \
            const auto s01 = __builtin_amdgcn_permlane32_swap(__float_as_uint(p[0]), __float_as_uint(p[1]), false, false); \
            const auto s23 = __builtin_amdgcn_permlane32_swap(__float_as_uint(p[2]), __float_as_uint(p[3]), false, false); \
            const float va = __uint_as_float(s01[0]) + __uint_as_float(s01[1]), vb = __uint_as_float(s23[0]) + __uint_as_float(s23[1]); \
            const int hw = 128 * c + 32 * tq + r;                                      \
            rows[h * 2048 + hw] = (unsigned short)f16key(va); \
            rows[(2 + h) * 2048 + hw] = (unsigned short)f16key(vb); \
        } \
        if (c + 1 < nch) *(LAS u32x4*)(kbuf + ((c + 1) & 1) * 8192 + sdst) = RNEXT; \
        __syncthreads(); }
#ifndef REP_SCORE
#define REP_SCORE 1
#endif
#ifndef REP_SEL
#define REP_SEL 1
#endif
    for (int rsc = 0; rsc < REP_SCORE; ++rsc) {
    if (rsc > 0) { stg0 = *(const u32x4*)sp; stg1 = stg0; stg2 = stg0; stg3 = stg0; if (1 < nch) stg1 = *(const u32x4*)(sp + (size_t)1 * 128 * 32); if (2 < nch) stg2 = *(const u32x4*)(sp + (size_t)2 * 128 * 32); if (3 < nch) stg3 = *(const u32x4*)(sp + (size_t)3 * 128 * 32); *(LAS u32x4*)(kbuf + sdst) = stg0; __syncthreads(); }
    for (int c0 = 0; c0 < nch; c0 += 4) {
        DSA_STEP(0, stg0, stg1)
        if (c0 + 1 >= nch) break;
        DSA_STEP(1, stg1, stg2)
        if (c0 + 2 >= nch) break;
        DSA_STEP(2, stg2, stg3)
        if (c0 + 3 >= nch) break;
        DSA_STEP(3, stg3, stg0)
    }
    }
#undef DSA_STEP
    unsigned* BMp = (unsigned*)(X.ws + WS_BM);
#ifndef REP_BIS
#define REP_BIS 1
#endif
#ifndef REP_EMIT
#define REP_EMIT 1
#endif
    for (int rsl = 0; rsl < REP_SEL; ++rsl)
    for (int j = 0; j < 4; ++j) {
        const int t = t0 + j;
        const LAS u32x4* rw = (const LAS u32x4*)(rows + j * 2048) + 4 * lane;
        unsigned kp[16];
#pragma unroll
        for (int v4 = 0; v4 < 4; ++v4) { const u32x4 d = rw[v4]; kp[4 * v4] = d.x; kp[4 * v4 + 1] = d.y; kp[4 * v4 + 2] = d.z; kp[4 * v4 + 3] = d.w; }
        const int nv = t + 1 - 32 * lane;
#pragma unroll
        for (int d = 0; d < 16; ++d) kp[d] &= ((2 * d < nv) ? 0xffffu : 0u) | ((2 * d + 1 < nv) ? 0xffff0000u : 0u);
        unsigned thr = 0u; int need = 0;
        for (int rb_ = 0; rb_ < REP_BIS; ++rb_)
        if (t + 1 > 256) {
            LAS unsigned* hist = (LAS unsigned*)(X.lds + LDS_HIST_OFF + X.wave * 512);
            *(LAS u32x2*)(hist + 2 * lane) = (u32x2){0u, 0u};
#pragma unroll
            for (int d = 0; d < 16; ++d) { const unsigned klo = kp[d] & 0xffffu, khi = kp[d] >> 16;
                if (klo) __hip_atomic_fetch_add(hist + (klo >> 9), (klo & 0x100u) ? 0x10000u : 1u, __ATOMIC_RELAXED, __HIP_MEMORY_SCOPE_WORKGROUP);
                if (khi) __hip_atomic_fetch_add(hist + (khi >> 9), (khi & 0x100u) ? 0x10000u : 1u, __ATOMIC_RELAXED, __HIP_MEMORY_SCOPE_WORKGROUP); }
            int B1, above1, in1; radix_pick(hist, lane, 256, B1, above1, in1);
            *(LAS u32x2*)(hist + 2 * lane) = (u32x2){0u, 0u};
#pragma unroll
            for (int d = 0; d < 16; ++d) { const unsigned klo = kp[d] & 0xffffu, khi = kp[d] >> 16;
                if ((int)(klo >> 8) == B1) __hip_atomic_fetch_add(hist + ((klo & 0xffu) >> 1), (klo & 1u) ? 0x10000u : 1u, __ATOMIC_RELAXED, __HIP_MEMORY_SCOPE_WORKGROUP);
                if ((int)(khi >> 8) == B1) __hip_atomic_fetch_add(hist + ((khi & 0xffu) >> 1), (khi & 1u) ? 0x10000u : 1u, __ATOMIC_RELAXED, __HIP_MEMORY_SCOPE_WORKGROUP); }
            int B2, above2, in2; radix_pick(hist, lane, 256 - above1, B2, above2, in2);
            const unsigned tk = ((unsigned)B1 << 8) | (unsigned)B2;
            const int rest = 256 - (above1 + above2);
            if (rest >= in2) { thr = tk - 1u; need = 0; } else { thr = tk; need = rest; }
        }
        unsigned word = 0u, eqw = 0u;
        const unsigned thr2 = __builtin_amdgcn_readfirstlane(thr | (thr << 16)), one2 = __builtin_amdgcn_readfirstlane(0x00010001u);
#pragma unroll
        for (int d = 0; d < 16; ++d) { unsigned g;
            asm("v_pk_sub_u16 %0, %1, %2 clamp\n\tv_pk_min_u16 %0, %0, %3" : "=&v"(g) : "v"(kp[d]), "s"(thr2), "s"(one2));
            word |= ((g | (g >> 15)) & 3u) << (2 * d); }
        if (need > 0) {
#pragma unroll
            for (int d = 0; d < 16; ++d) { unsigned g; const unsigned x = kp[d] ^ thr2;
                asm("v_pk_min_u16 %0, %1, %2" : "=v"(g) : "v"(x), "s"(one2));
                eqw |= ((~(g | (g >> 15))) & 3u) << (2 * d); }
            if (thr == 0u) eqw = 0u;
            const int ne = __builtin_popcount(eqw); const int inc = wave_scan_incl(ne);
            int take = need - (inc - ne); take = take < 0 ? 0 : (take > ne ? ne : take);
            while (__any(take > 0)) { if (take > 0) { const unsigned lowbit = eqw & (0u - eqw); word |= lowbit; eqw ^= lowbit; --take; } }
        }
        BMp[(seq0 + t) * 64 + lane] = word;
    }
}

__device__ __forceinline__ void dil_combine(const Ctx& X) {
    const bf16* OD = (const bf16*)(X.ws + WS_OD); const float* LS = (const float*)(X.ws + WS_LSE); bf16* O = (bf16*)(X.ws + WS_XB);
    const int gw = X.vcu * 8 + X.wave, NGW = X.G * 8, lane = X.lane, hh = lane >> 4;
    for (int t = gw; t < NT; t += NGW) {
        const int b = t >> 11, s = t & 2047;
        const int r0 = t, r1 = (b << 11) + ((s & 3) << 9) + (s >> 2), r2 = (b << 11) + ((s & 15) << 7) + (s >> 4);
        const float L0 = LS[(size_t)r0 * 4 + hh], L1 = LS[((size_t)NT + r1) * 4 + hh], L2 = LS[((size_t)2 * NT + r2) * 4 + hh];
        const float mx = fmaxf(L0, fmaxf(L1, L2));
        float w0 = __builtin_amdgcn_exp2f(L0 - mx), w1 = __builtin_amdgcn_exp2f(L1 - mx), w2 = __builtin_amdgcn_exp2f(L2 - mx);
        const float inv = 1.0f / (w0 + w1 + w2); w0 *= inv; w1 *= inv; w2 *= inv;
        const u32x2 a = *(const u32x2*)(OD + (size_t)r0 * 256 + 4 * lane), bq = *(const u32x2*)(OD + ((size_t)NT + r1) * 256 + 4 * lane), cq = *(const u32x2*)(OD + ((size_t)2 * NT + r2) * 256 + 4 * lane);
        u32x2 o;
        o.x = pk2(w0 * bflo(a.x) + w1 * bflo(bq.x) + w2 * bflo(cq.x), w0 * bfhi(a.x) + w1 * bfhi(bq.x) + w2 * bfhi(cq.x));
        o.y = pk2(w0 * bflo(a.y) + w1 * bflo(bq.y) + w2 * bflo(cq.y), w0 * bfhi(a.y) + w1 * bfhi(bq.y) + w2 * bfhi(cq.y));
        stg8<NT_ATT>(O + (size_t)t * DM + 768 + 4 * lane, o);
    }
}

__device__ __forceinline__ void ln1_router(const Ctx& X, const CArgs* ap, int l, bool first, bool dummy = false) {
    struct { const float *ln1g, *ln1b, *rgb, *reb; float* out; } a = {ap->ln1g, ap->ln1b, ap->rgb, ap->reb, dummy ? (float*)(X.ws + WS_QA) : ap->out}; const float* xin = first ? ap->x : ap->out;
    const int lane = X.lane; const bf16* MIX = (const bf16*)(X.ws + WS_MIX); bf16* X1B = (bf16*)(X.ws + (dummy ? WS_Y : WS_XB));
    LAS float* reT = (LAS float*)X.lds;
    LAS float* rgT = (LAS float*)(X.lds + LDS_X_OFF);
    LAS int* hist = (LAS int*)(X.lds + LDSCTL_OFF + 256);
    { const u32x4* s1 = (const u32x4*)(X.ws + WS_RET + (size_t)l * 32 * DM * 4); for (int i = X.tid; i < 32 * DM / 4; i += 512) ((LAS u32x4*)reT)[i] = s1[i];
      const u32x4* s2 = (const u32x4*)(X.ws + WS_RGT + (size_t)l * 4 * DM * 4); for (int i = X.tid; i < 4 * DM / 4; i += 512) ((LAS u32x4*)rgT)[i] = s2[i]; }
    f32x4 g[4], bb[4];
#pragma unroll
    for (int j = 0; j < 4; ++j) { g[j] = *(const f32x4*)(a.ln1g + l * DM + 4 * lane + 256 * j); bb[j] = *(const f32x4*)(a.ln1b + l * DM + 4 * lane + 256 * j); }
    const float* rgb = a.rgb + l * 4; const float* reb = a.reb + l * 32;
    for (int rb = X.c; rb < NT / 256; rb += X.G) {
        if (X.tid < 32) hist[X.tid] = 0;
        __syncthreads();
        f32x4 xa[4], xb[4]; u32x2 ma[4], mb[4];
        { const int t = rb * 256 + X.wave * 32;
#pragma unroll
          for (int j = 0; j < 4; ++j) { xa[j] = ldg_s<f32x4>(xin + (size_t)t * DM + 4 * lane + 256 * j); ma[j] = *(const u32x2*)(MIX + (size_t)t * DM + 4 * lane + 256 * j); }
#pragma unroll
          for (int j = 0; j < 4; ++j) { xb[j] = ldg_s<f32x4>(xin + (size_t)(t + 1) * DM + 4 * lane + 256 * j); mb[j] = *(const u32x2*)(MIX + (size_t)(t + 1) * DM + 4 * lane + 256 * j); } }
        auto row = [&](f32x4 (&xn)[4], u32x2 (&mn)[4], const int i) __attribute__((always_inline)) {
            const int t = rb * 256 + X.wave * 32 + i;
            f32x4 v[4]; float s = 0.f;
#pragma unroll
            for (int j = 0; j < 4; ++j) { const f32x4 xv = xn[j]; const u32x2 mw = mn[j];
                v[j][0] = ALPHA * xv[0] + bflo(mw.x); v[j][1] = ALPHA * xv[1] + bfhi(mw.x); v[j][2] = ALPHA * xv[2] + bflo(mw.y); v[j][3] = ALPHA * xv[3] + bfhi(mw.y);
                s += (v[j][0] + v[j][1]) + (v[j][2] + v[j][3]); }
            if (i + 2 < 32) {
#pragma unroll
                for (int j = 0; j < 4; ++j) { xn[j] = ldg_s<f32x4>(xin + (size_t)(t + 2) * DM + 4 * lane + 256 * j); mn[j] = *(const u32x2*)(MIX + (size_t)(t + 2) * DM + 4 * lane + 256 * j); } }
            const float mean = wave_sum(s) * (1.f / DM); float s2 = 0.f;
#pragma unroll
            for (int j = 0; j < 4; ++j) { v[j] = v[j] - mean; s2 += (v[j][0] * v[j][0] + v[j][1] * v[j][1]) + (v[j][2] * v[j][2] + v[j][3] * v[j][3]); }
            const float rstd = 1.0f / sqrtf(wave_sum(s2) * (1.f / DM) + 1e-5f);
#pragma unroll
            for (int j = 0; j < 4; ++j) { v[j] = v[j] * rstd * g[j] + bb[j];
                u32x2 w; w.x = pk2(v[j][0], v[j][1]); w.y = pk2(v[j][2], v[j][3]); stg8<NT_LN>(X1B + (size_t)t * DM + 4 * lane + 256 * j, w); }
            float lg[4];
#pragma unroll
            for (int gi = 0; gi < 4; ++gi) { f32x2 p2 = {0.f, 0.f};
#pragma unroll
                for (int j = 0; j < 4; ++j) { const f32x4 w = *(const LAS f32x4*)(rgT + gi * DM + 4 * lane + 256 * j);
                    p2 = __builtin_elementwise_fma((f32x2){v[j][0], v[j][1]}, (f32x2){w[0], w[1]}, p2); p2 = __builtin_elementwise_fma((f32x2){v[j][2], v[j][3]}, (f32x2){w[2], w[3]}, p2); }
                lg[gi] = wave_sum(p2.x + p2.y) + rgb[gi]; }
            int gs = 0; float gm = lg[0];
#pragma unroll
            for (int gi = 1; gi < 4; ++gi) if (lg[gi] > gm) { gm = lg[gi]; gs = gi; }
            float den = 0.f;
#pragma unroll
            for (int gi = 0; gi < 4; ++gi) den += __expf(lg[gi] - gm);
            const float ptop = __builtin_amdgcn_rcpf(den);
            gs = __builtin_amdgcn_readfirstlane(gs);
            float le[8];
#pragma unroll
            for (int e = 0; e < 8; ++e) { f32x2 p2 = {0.f, 0.f};
#pragma unroll
                for (int j = 0; j < 4; ++j) { const f32x4 w = *(const LAS f32x4*)(reT + (gs * 8 + e) * DM + 4 * lane + 256 * j);
                    p2 = __builtin_elementwise_fma((f32x2){v[j][0], v[j][1]}, (f32x2){w[0], w[1]}, p2); p2 = __builtin_elementwise_fma((f32x2){v[j][2], v[j][3]}, (f32x2){w[2], w[3]}, p2); }
                le[e] = wave_sum(p2.x + p2.y) + reb[gs * 8 + e]; }
            int e1 = 0; float v1 = le[0];
#pragma unroll
            for (int e = 1; e < 8; ++e) if (le[e] > v1) { v1 = le[e]; e1 = e; }
            int e2 = -1; float v2 = -INFINITY;
#pragma unroll
            for (int e = 0; e < 8; ++e) if (e != e1 && le[e] > v2) { v2 = le[e]; e2 = e; }
            const float wa = __builtin_amdgcn_rcpf(1.0f + __expf(v2 - v1)), wb = 1.0f - wa;
            if (lane == 0) { u32x4 ro; ro.x = (unsigned)(gs * 8 + e1); ro.y = (unsigned)(gs * 8 + e2); ro.z = __builtin_bit_cast(unsigned, ptop * wa); ro.w = __builtin_bit_cast(unsigned, ptop * wb);
                *(u32x4*)(X.ws + WS_ROUTE + (size_t)t * 16) = ro;
                __hip_atomic_fetch_add(hist + gs * 8 + e1, 1, __ATOMIC_RELAXED, __HIP_MEMORY_SCOPE_WORKGROUP); __hip_atomic_fetch_add(hist + gs * 8 + e2, 1, __ATOMIC_RELAXED, __HIP_MEMORY_SCOPE_WORKGROUP); }
        };
#pragma unroll 1
        for (int i = 0; i < 32; i += 2) { row(xa, ma, i); row(xb, mb, i + 1); }
        __syncthreads();
        if (X.tid < 32) ((int*)(X.ws + WS_HIST))[rb * 32 + X.tid] = hist[X.tid];
        __syncthreads();
    }
}

__device__ __forceinline__ void moe_dispatch(const Ctx& X) {
    LAS int* cnt = (LAS int*)(X.lds);
    LAS int* pre = cnt + 32;
    LAS int* ebase = cnt + 64;
    LAS int* wcnt = cnt + 128;
    const int* HIST = (const int*)(X.ws + WS_HIST); int* STOK = (int*)(X.ws + WS_STOK); float* SW = (float*)(X.ws + WS_SW); int* TSLOT = (int*)(X.ws + WS_TSLOT); int* TILEE = (int*)(X.ws + WS_TILEE);
    for (int rb = X.c; rb < NT / 256; rb += X.G) {
        if (X.tid < 64) cnt[X.tid] = 0;
        __syncthreads();
        { const int e = X.tid & 31, part = X.tid >> 5; int sa = 0, sp = 0;
          for (int q = 0; q < 16; ++q) { const int b2 = part * 16 + q; const int hv = HIST[b2 * 32 + e]; sa += hv; if (b2 < rb) sp += hv; }
          __hip_atomic_fetch_add(cnt + e, sa, __ATOMIC_RELAXED, __HIP_MEMORY_SCOPE_WORKGROUP); __hip_atomic_fetch_add(pre + e, sp, __ATOMIC_RELAXED, __HIP_MEMORY_SCOPE_WORKGROUP); }
        __syncthreads();
        if (X.tid < 64) { const int n = X.tid < 32 ? cnt[X.tid] : 0; const int pad = (n + 255) & ~255; int inc = pad;
#pragma unroll
            for (int o = 1; o < 32; o <<= 1) { const int u = __shfl_up(inc, o); if ((X.tid & 63) >= o) inc += u; }
            if (X.tid < 32) { ebase[X.tid] = inc - pad; if (X.tid == 31) ebase[32] = inc; } }
        __syncthreads();
        const int tl = X.tid >> 1, kk = X.tid & 1, t = rb * 256 + tl;
        const u32x4 ro = *(const u32x4*)(X.ws + WS_ROUTE + (size_t)t * 16);
        const int e = (int)(kk ? ro.y : ro.x); const float w = __builtin_bit_cast(float, kk ? ro.w : ro.z);
        int rank = 0;
        for (int ee = 0; ee < 32; ++ee) { const unsigned long long mm = __ballot(e == ee);
            if (e == ee) rank = __builtin_popcountll(mm & ((1ull << X.lane) - 1ull));
            if (X.lane == 0) wcnt[X.wave * 32 + ee] = __builtin_popcountll(mm); }
        __syncthreads();
        int off = 0;
        for (int w2 = 0; w2 < X.wave; ++w2) off += wcnt[w2 * 32 + e];
        const int slot = ebase[e] + pre[e] + off + rank;
        STOK[slot] = t; SW[slot] = w; TSLOT[2 * t + kk] = slot;
        if (rb < 32) { const int e2 = rb; for (int s = ebase[e2] + cnt[e2] + X.tid; s < ebase[e2 + 1]; s += 512) { STOK[s] = 0; SW[s] = 0.f; } }
        if (rb == 0) { const int ntl = ebase[32] >> 8;
            for (int tile = X.tid; tile < ntl; tile += 512) { int ee = 0; while (ee < 31 && ebase[ee + 1] <= tile * 256) ++ee; TILEE[tile] = ee; }
            if (X.tid == 0) TILEE[1024] = ntl; }
        __syncthreads();
    }
}

__device__ __forceinline__ void ln2_phase(const Ctx& X, const CArgs* ap, int l, bool first, bool dummy = false) {
    struct { const float *ln1g, *ln1b, *ln2g, *ln2b; } a = {ap->ln1g, ap->ln1b, ap->ln2g, ap->ln2b}; float* outw = dummy ? (float*)(X.ws + WS_Y + 272 * MiB) : ap->out;
    const float* xin = first ? ap->x : ap->out;
    const int lane = X.lane; const bf16* Y = (const bf16*)(X.ws + WS_Y); const bf16* MIX = (const bf16*)(X.ws + WS_MIX); const int* TSLOT = (const int*)(X.ws + WS_TSLOT); bf16* XBp = (bf16*)(X.ws + (dummy ? WS_MIX : WS_XB));
    f32x4 g1[4], b1[4], g[4], bb[4];
#pragma unroll
    for (int j = 0; j < 4; ++j) { g1[j] = *(const f32x4*)(a.ln1g + l * DM + 4 * lane + 256 * j); b1[j] = *(const f32x4*)(a.ln1b + l * DM + 4 * lane + 256 * j);
        g[j] = *(const f32x4*)(a.ln2g + l * DM + 4 * lane + 256 * j); bb[j] = *(const f32x4*)(a.ln2b + l * DM + 4 * lane + 256 * j); }
    for (int rb = X.c; rb < NT / 256; rb += X.G) {
        const int tb = rb * 256 + X.wave * 32;
        const int myslots_a = TSLOT[2 * (tb + (lane & 31))], myslots_b = TSLOT[2 * (tb + (lane & 31)) + 1];
        f32x4 xn[4]; u32x2 mn[4], yan[4], ybn[4];
        { const int sa = __builtin_amdgcn_readlane(myslots_a, 0), sb = __builtin_amdgcn_readlane(myslots_b, 0);
#pragma unroll
          for (int j = 0; j < 4; ++j) { xn[j] = ldg_s<f32x4>(xin + (size_t)tb * DM + 4 * lane + 256 * j); mn[j] = *(const u32x2*)(MIX + (size_t)tb * DM + 4 * lane + 256 * j);
              yan[j] = ldg_s<u32x2>(Y + (size_t)sa * DM + 4 * lane + 256 * j); ybn[j] = ldg_s<u32x2>(Y + (size_t)sb * DM + 4 * lane + 256 * j); } }
        for (int i = 0; i < 32; ++i) {
            const int t = tb + i;
            f32x4 v[4]; float s = 0.f;
#pragma unroll
            for (int j = 0; j < 4; ++j) { const f32x4 xv = xn[j]; const u32x2 mw = mn[j];
                v[j][0] = ALPHA * xv[0] + bflo(mw.x); v[j][1] = ALPHA * xv[1] + bfhi(mw.x); v[j][2] = ALPHA * xv[2] + bflo(mw.y); v[j][3] = ALPHA * xv[3] + bfhi(mw.y);
                s += (v[j][0] + v[j][1]) + (v[j][2] + v[j][3]); }
            u32x2 ya[4], yb[4];
#pragma unroll
            for (int j = 0; j < 4; ++j) { ya[j] = yan[j]; yb[j] = ybn[j]; }
            if (i + 1 < 32) { const int sa = __shfl(myslots_a, i + 1), sb = __shfl(myslots_b, i + 1);
#pragma unroll
                for (int j = 0; j < 4; ++j) { xn[j] = ldg_s<f32x4>(xin + (size_t)(t + 1) * DM + 4 * lane + 256 * j); mn[j] = *(const u32x2*)(MIX + (size_t)(t + 1) * DM + 4 * lane + 256 * j);
                    yan[j] = ldg_s<u32x2>(Y + (size_t)sa * DM + 4 * lane + 256 * j); ybn[j] = ldg_s<u32x2>(Y + (size_t)sb * DM + 4 * lane + 256 * j); } }
            { const float mean = wave_sum(s) * (1.f / DM); float s2 = 0.f;
#pragma unroll
              for (int j = 0; j < 4; ++j) { v[j] = v[j] - mean; s2 += (v[j][0] * v[j][0] + v[j][1] * v[j][1]) + (v[j][2] * v[j][2] + v[j][3] * v[j][3]); }
              const float rstd = 1.0f / sqrtf(wave_sum(s2) * (1.f / DM) + 1e-5f);
#pragma unroll
              for (int j = 0; j < 4; ++j) v[j] = v[j] * rstd * g1[j] + b1[j]; }
            s = 0.f;
#pragma unroll
            for (int j = 0; j < 4; ++j) { const f32x4 xv = v[j];
                v[j][0] = ALPHA * xv[0] + (bflo(ya[j].x) + bflo(yb[j].x)); v[j][1] = ALPHA * xv[1] + (bfhi(ya[j].x) + bfhi(yb[j].x)); v[j][2] = ALPHA * xv[2] + (bflo(ya[j].y) + bflo(yb[j].y)); v[j][3] = ALPHA * xv[3] + (bfhi(ya[j].y) + bfhi(yb[j].y));
                s += (v[j][0] + v[j][1]) + (v[j][2] + v[j][3]); }
            const float mean = wave_sum(s) * (1.f / DM); float s2 = 0.f;
#pragma unroll
            for (int j = 0; j < 4; ++j) { v[j] = v[j] - mean; s2 += (v[j][0] * v[j][0] + v[j][1] * v[j][1]) + (v[j][2] * v[j][2] + v[j][3] * v[j][3]); }
            const float rstd = 1.0f / sqrtf(wave_sum(s2) * (1.f / DM) + 1e-5f);
#pragma unroll
            for (int j = 0; j < 4; ++j) { v[j] = v[j] * rstd * g[j] + bb[j];
                stgf4<NT_LN>(outw + (size_t)t * DM + 4 * lane + 256 * j, v[j]);
                if (l + 1 < DEPTH) { u32x2 w; w.x = pk2(v[j][0], v[j][1]); w.y = pk2(v[j][2], v[j][3]); stg8<NT_LN>(XBp + (size_t)t * DM + 4 * lane + 256 * j, w); } }
        }
    }
}

#ifndef REP_P0
#define REP_P0 1
#endif
#ifndef REP_P5
#define REP_P5 1
#endif
#ifndef REP_P9
#define REP_P9 1
#endif
#ifndef REP_BAR
#define REP_BAR 1
#endif
#ifndef REP_P1
#define REP_P1 1
#endif
#ifndef REP_P2A
#define REP_P2A 1
#endif
#ifndef REP_P2B
#define REP_P2B 1
#endif
#ifndef REP_P2C
#define REP_P2C 1
#endif
#ifndef REP_P2D
#define REP_P2D 1
#endif
#ifndef REP_P3A
#define REP_P3A 1
#endif
#ifndef REP_P3B
#define REP_P3B 1
#endif
#ifndef REP_P3C
#define REP_P3C 1
#endif
#ifndef REP_P4
#define REP_P4 1
#endif
#ifndef REP_P6
#define REP_P6 1
#endif
#ifndef REP_P7
#define REP_P7 1
#endif
#ifndef REP_P8
#define REP_P8 1
#endif
__global__ void __launch_bounds__(512, 2) mk_fwd(Args a) {
    extern __shared__ __attribute__((aligned(16))) unsigned char lds_raw[];
    LAS unsigned char* const lds0 = (LAS unsigned char*)lds_raw;
    for (int u = threadIdx.x; u < (LDS_BYTES - LDSCTL_OFF) / 4; u += 512) ((LAS unsigned*)(lds0 + LDSCTL_OFF))[u] = 0u;
    __syncthreads();
    unsigned* barw = (unsigned*)(a.ws + WS_CTL) + CW_BAR;
    XcdBarrier bar; bar.bar = barw; bar.x = 0; bar.st = nullptr;
    if (a.use_bar) bar = xcd_barrier_post(barw, (volatile LAS unsigned*)(lds0 + LDSCTL_OFF) + 8);
#define MKCTX() Ctx X; const CArgs* ap = (const CArgs*)__builtin_amdgcn_kernarg_segment_ptr(); asm volatile("" : "+s"(ap)); { int t_ = threadIdx.x; asm volatile("" : "+v"(t_)); X.lds = lds0; X.tid = t_; X.lane = t_ & 63; X.wave = __builtin_amdgcn_readfirstlane(t_ >> 6); \
        unsigned char* w_ = ap->ws; X.G = gridDim.x; X.c = blockIdx.x; X.vcu = (X.G % 8 == 0) ? (X.c % 8) * (X.G / 8) + X.c / 8 : X.c; X.ws = w_; }
#ifndef P2M
#define P2M 31
#endif
#ifndef PH_MASK0
#define PH_MASK0 1
#endif
#define GBAR() do { if (a.use_bar) for (int rb_ = 0; rb_ < REP_BAR; ++rb_) xcd_barrier(bar); } while (0)

    if ((PH_MASK0 & 1) && a.l_lo == 0 && a.ph_lo == 0) { MKCTX(); for (int rep = 0; rep < REP_P0; ++rep) { prologue(X, ap); __syncthreads(); } GBAR(); }

    for (int l = a.l_lo; l < a.l_hi; ++l) {
        const int lo = (l == a.l_lo) ? (a.ph_lo < 1 ? 1 : a.ph_lo) : 1, hi = (l == a.l_hi - 1) ? a.ph_hi : 10;
#ifndef PH_MASK
#define PH_MASK 0x3ff
#endif
#define IN(k) (((PH_MASK >> (k)) & 1) && lo <= (k) && (k) < hi)
        if (IN(1)) { MKCTX();
            pg8::Gemm g{(const bf16*)(X.ws + WS_XB), (const bf16*)(X.ws + WS_WIN) + (size_t)l * NIN * DM, DM, nullptr};
            pg8::StaticOrder S; S.init(NT, NIN, X.G, X.c, REP_P1);
            pg8::RopeTabs R{ap->pos};
            pg8::EpiGroups<InProjDesc> E{InProjDesc{X.ws}, R, nullptr, 0, 0.f, 0.f};
            pg8::gemm_phase<pg8::EpiGroups<InProjDesc>, pg8::StaticOrder, false>(X.lds, g, S, E, X.tid);
            GBAR();
        }
        if (IN(2)) { MKCTX();
            {
                pg8::Gemm g{(const bf16*)(X.ws + WS_CQ), (const bf16*)(X.ws + WS_WUQ) + (size_t)l * 768 * 256, 256, nullptr};
                pg8::StaticOrder S; S.init(NT, 768, X.G, X.c, REP_P2A);
                pg8::RopeTabs R{ap->pos};
                pg8::EpiGroups<UqDesc> E{UqDesc{X.ws}, R, (const float*)(X.ws + WS_SSQ), 8, 1.0f / 256.0f, 1e-6f};
                pg8::gemm_phase<pg8::EpiGroups<UqDesc>, pg8::StaticOrder, false>(X.lds, g, S, E, X.tid);
            }
            {
                pg8::Gemm g{(const bf16*)(X.ws + WS_T1), (const bf16*)(X.ws + WS_WUKV) + (size_t)l * 1024 * 256, 256, nullptr};
                pg8::StaticOrder S; S.init(NT, 1024, X.G, X.c, REP_P2A);
                pg8::EpiPlainT<NT_KVA> E{(bf16*)(X.ws + WS_KVA), 1024, (const float*)(X.ws + WS_SSQ) + (size_t)NT * 8, 4, 1.0f / 128.0f, 1e-6f, X.lds + LDS_X_OFF};
                pg8::gemm_phase<decltype(E), pg8::StaticOrder, false>(X.lds, g, S, E, X.tid);
            }
            __syncthreads();
            for (int rep = 0; rep < REP_P2B; ++rep) convert_experts(X, ap, l);
            __syncthreads();
            for (int rep = 0; rep < REP_P2C; ++rep) for (int U = X.vcu; U < NB * 32; U += X.G) { const int b = U >> 5, pr = U & 31;
                dsa_index_unit(X, b, 32 * pr); dsa_index_unit(X, b, 32 * (63 - pr)); }
            __syncthreads();
#pragma unroll 1
            for (int cfg = 0; cfg < 3 * REP_P2D; ++cfg) { const int cfgi = cfg % 3;
                fa::Params P; const size_t co = (size_t)cfgi * NT * 256;
                P.Q = (const bf16*)(X.ws + WS_DQ) + co; P.q_pitch = 256; P.K1 = (const bf16*)(X.ws + WS_DK) + co; P.k1_pitch = 256; P.K2 = nullptr; P.k2_pitch = 0; P.k2_col = 0;
                P.V = (const bf16*)(X.ws + WS_DV) + co; P.v_pitch = 256; P.O = (bf16*)(X.ws + WS_OD) + co; P.o_pitch = 256; P.LSE = (float*)(X.ws + WS_LSE) + (size_t)cfgi * NT * 4; P.lse_pitch = 4; P.BM = nullptr;
                P.CL = cfgi == 0 ? 2048 : (cfgi == 1 ? 512 : 128); P.W = 128;
                const int vcu = X.vcu, G = X.G, wv = X.wave, CLc = P.CL;
                fa::attn_stream<64, 0, 2>(P, X.lds, X.tid, (NB * 2 * 16 - vcu + G - 1) / G, [=](int j) { const int U = vcu + j * G, bh = U >> 4, qb = U & 15, b = bh >> 1, hp = bh & 1;
                    const int q0 = 128 * qb, hh = 2 * hp + (wv >> 2); int klo = q0 & ~(CLc - 1); if (q0 - 128 > klo) klo = q0 - 128;
                    return fa::UnitDesc{b * SEQ, q0 + 32 * (wv & 3), 64 * hh, 64 * hh, hh, 128 * hp, 128 * hp, klo >> 6, (q0 + 127) >> 6}; });
            }
            GBAR();
        }
        if (IN(3)) { MKCTX();
            {   fa::Params P; P.Q = (const bf16*)(X.ws + WS_QA); P.q_pitch = 768; P.K1 = (const bf16*)(X.ws + WS_KVA); P.k1_pitch = 1024; P.K2 = (const bf16*)(X.ws + WS_KPE); P.k2_pitch = 32; P.k2_col = 0;
                P.V = (const bf16*)(X.ws + WS_KVA); P.v_pitch = 1024; P.O = (bf16*)(X.ws + WS_XB); P.o_pitch = DM; P.LSE = nullptr; P.lse_pitch = 0; P.BM = nullptr; P.CL = 2048; P.W = 1 << 20;
                const int vcu = X.vcu, G = X.G, wv = X.wave;
                fa::attn_stream<96, 2, 1>(P, X.lds, X.tid, 2 * ((NB * 8 * 4 - vcu + G - 1) / G), [=](int j) { const int U = vcu + (j >> 1) * G, bh = U >> 2, pr = U & 3, b = bh >> 3, hd = bh & 7;
                    const int qb = (j & 1) ? 7 - pr : pr, q0 = 256 * qb;
                    return fa::UnitDesc{b * SEQ, q0 + 32 * wv, 96 * hd, 64 * hd, 0, 128 * hd, 128 * hd + 64, 0, (q0 + 255) >> 6}; });
            }
            {   fa::Params P; P.Q = (const bf16*)(X.ws + WS_BQ); P.q_pitch = 256; P.K1 = (const bf16*)(X.ws + WS_T1); P.k1_pitch = 256; P.k1_col = 192; P.K2 = nullptr; P.k2_pitch = 0; P.k2_col = 0;
                P.V = (const bf16*)(X.ws + WS_BV); P.v_pitch = 64; P.v_col = 0; P.O = (bf16*)(X.ws + WS_XB); P.o_pitch = DM; P.LSE = nullptr; P.lse_pitch = 0; P.BM = (const unsigned*)(X.ws + WS_BM); P.CL = 2048; P.W = 1 << 20;
                const int hd = X.wave & 3, sub = X.wave >> 2, vcu = X.vcu, G = X.G;
                fa::attn_stream<64, 1, 1>(P, X.lds, X.tid, 2 * ((NB * 16 - vcu + G - 1) / G), [=](int j) { const int U = vcu + (j >> 1) * G, b = U >> 4, pr = U & 15;
                    const int qb = (j & 1) ? 31 - pr : pr, q0 = 64 * qb;
                    return fa::UnitDesc{b * SEQ, q0 + 32 * sub, 64 * hd, 512 + 64 * hd, 0, 192, 0, 0, qb}; });
            }
            for (int rep = 0; rep < REP_P3C; ++rep) dil_combine(X);
            GBAR();
        }
        if (IN(4)) { MKCTX();
            pg8::Gemm g{(const bf16*)(X.ws + WS_XB), (const bf16*)(X.ws + WS_WO) + (size_t)l * DM * DM, DM, nullptr};
            pg8::StaticOrder S; S.init(NT, DM, X.G, X.c, REP_P4);
            pg8::EpiPlainT<NT_MIX> E{(bf16*)(X.ws + WS_MIX), DM, nullptr, 0, 0.f, 0.f, X.lds + LDS_X_OFF};
            pg8::gemm_phase<decltype(E), pg8::StaticOrder, false>(X.lds, g, S, E, X.tid);
            GBAR();
        }
        if (IN(5)) { MKCTX(); if (REP_P5 > 1) ln1_router(X, ap, l, l == 0, true); ln1_router(X, ap, l, l == 0); GBAR(); }
        if (IN(6)) { MKCTX(); for (int rep = 0; rep < REP_P6; ++rep) moe_dispatch(X); GBAR(); }
        if (IN(7)) { MKCTX();
            const int* TILEE = (const int*)(X.ws + WS_TILEE);
            pg8::Gemm g{(const bf16*)(X.ws + WS_XB), (const bf16*)(X.ws + WS_WGU), DM, (const int*)(X.ws + WS_STOK)};
            pg8::GroupedOrder S{TILEE, TILEE[1024], 2, X.G, X.c};
            pg8::EpiGateUpT<NT_H> E{(bf16*)(X.ws + WS_H), (const float*)(X.ws + WS_SW)};
            for (int rep = 0; rep < REP_P7; ++rep) pg8::gemm_phase<decltype(E), pg8::GroupedOrder, true>(X.lds, g, S, E, X.tid);
            GBAR();
        }
        if (IN(8)) { MKCTX();
            const int* TILEE = (const int*)(X.ws + WS_TILEE);
            pg8::Gemm g{(const bf16*)(X.ws + WS_H), (const bf16*)(X.ws + WS_WD), FH, nullptr};
            pg8::GroupedOrder S{TILEE, TILEE[1024], 4, X.G, X.c};
            pg8::EpiPlainT<NT_Y> E{(bf16*)(X.ws + WS_Y), DM, nullptr, 0, 0.f, 0.f, X.lds + LDS_X_OFF};
            for (int rep = 0; rep < REP_P8; ++rep) pg8::gemm_phase<decltype(E), pg8::GroupedOrder, false>(X.lds, g, S, E, X.tid);
            GBAR();
        }
        if (IN(9)) { MKCTX(); if (REP_P9 > 1) ln2_phase(X, ap, l, l == 0, true); ln2_phase(X, ap, l, l == 0); if (!(l == a.l_hi - 1)) GBAR(); }
#undef IN
    }
#undef GBAR
}

extern "C" void kernel_launch(void* const* d_in, const int* in_sizes, int n_in, void* d_out, int out_size, void* d_ws, size_t ws_size, hipStream_t stream) {
    static int grid = 0;
    if (grid == 0) {
        if (n_in != 19 || in_sizes[0] != NT * DM || out_size != NT * DM || ws_size < WS_END) { fprintf(stderr, "kernel_launch: unexpected shapes (n_in %d, in0 %d, out %d, ws %zu < %zu); nothing launched\n", n_in, n_in > 0 ? in_sizes[0] : -1, out_size, ws_size, (size_t)WS_END); grid = -1; return; }
        int dev = 0, cus = 0, per_cu = 0;
        if (hipGetDevice(&dev) != hipSuccess || hipDeviceGetAttribute(&cus, hipDeviceAttributeMultiprocessorCount, dev) != hipSuccess) { grid = -1; return; }
        if (hipFuncSetAttribute((const void*)mk_fwd, hipFuncAttributeMaxDynamicSharedMemorySize, LDS_BYTES) != hipSuccess) { fprintf(stderr, "kernel_launch: hipFuncSetAttribute failed\n"); grid = -1; return; }
        if (hipOccupancyMaxActiveBlocksPerMultiprocessor(&per_cu, (const void*)mk_fwd, 512, LDS_BYTES) != hipSuccess || per_cu < 1) fprintf(stderr, "kernel_launch: occupancy query reports %d\n", per_cu);
        (void)hipGetLastError();
        grid = cus;
    }
    if (grid < 0) return;
    (void)hipMemsetAsync((char*)d_ws + WS_CTL, 0, CTL_BYTES, stream);
    Args a{};
    a.x = (const float*)d_in[0]; a.pos = (const int*)d_in[1]; a.w_in = (const float*)d_in[2]; a.qn = (const float*)d_in[3]; a.kvn = (const float*)d_in[4];
    a.w_uq = (const float*)d_in[5]; a.w_ukv = (const float*)d_in[6]; a.w_o = (const float*)d_in[7]; a.ln1g = (const float*)d_in[8]; a.ln1b = (const float*)d_in[9];
    a.rgw = (const float*)d_in[10]; a.rgb = (const float*)d_in[11]; a.rew = (const float*)d_in[12]; a.reb = (const float*)d_in[13];
    a.wg = (const float*)d_in[14]; a.wu = (const float*)d_in[15]; a.wd = (const float*)d_in[16]; a.ln2g = (const float*)d_in[17]; a.ln2b = (const float*)d_in[18];
    a.out = (float*)d_out; a.ws = (unsigned char*)d_ws; a.pad = 0;
#if MK_MULTI
    a.use_bar = 0;
    a.l_lo = 0; a.l_hi = 0; a.ph_lo = 0; a.ph_hi = 0;
    hipLaunchKernelGGL(mk_fwd, dim3(grid), dim3(512), LDS_BYTES, stream, a);
    for (int l = 0; l < DEPTH; ++l)
        for (int ph = 1; ph < 10; ++ph) { a.l_lo = l; a.l_hi = l + 1; a.ph_lo = ph; a.ph_hi = ph + 1; hipLaunchKernelGGL(mk_fwd, dim3(grid), dim3(512), LDS_BYTES, stream, a); }
#else
    a.use_bar = 1; a.l_lo = 0; a.l_hi = DEPTH; a.ph_lo = 0; a.ph_hi = 10;
    hipLaunchKernelGGL(mk_fwd, dim3(grid), dim3(512), LDS_BYTES, stream, a);
#endif
    const hipError_t le = hipPeekAtLastError();
    if (le != hipSuccess) fprintf(stderr, "kernel_launch: launch failed: %s\n", hipGetErrorName(le));
}
```

```cpp
#include <hip/hip_runtime.h>
#include <cstdio>
#include <cstdint>

#define LAS __attribute__((address_space(3)))
#define GAS __attribute__((address_space(1)))
typedef unsigned short bf16;
typedef short bf16x8 __attribute__((ext_vector_type(8)));
typedef short s16x4 __attribute__((ext_vector_type(4)));
typedef float f32x2 __attribute__((ext_vector_type(2)));
typedef float f32x4 __attribute__((ext_vector_type(4)));
typedef float f32x16 __attribute__((ext_vector_type(16)));
typedef unsigned u32x2 __attribute__((ext_vector_type(2)));
typedef unsigned u32x4 __attribute__((ext_vector_type(4)));
typedef __bf16 bf16x2_t __attribute__((ext_vector_type(2)));

#ifndef MK_MULTI
#define MK_MULTI 0
#endif

constexpr int NB = 32, SEQ = 2048, NT = NB * SEQ, DM = 1024, DEPTH = 4;
constexpr int IN_COLS = 3400, NIN = 3584;
constexpr int NEXP = 32, FH = 256;
constexpr int NSLOT = 2 * NT + NEXP * 256;
constexpr int MAXTILES = NSLOT / 256;
constexpr float ALPHA = 1.681792830507429f;
constexpr float LOG2E = 1.4426950408889634f;
constexpr float QSC64 = 0.125f * LOG2E;
constexpr float QSC96 = 0.10206207261596577f * LOG2E;
constexpr float IDX_SCALE = 0.0625f;

constexpr size_t MiB = 1u << 20;
constexpr size_t WS_CTL = 0, CTL_BYTES = 1 * MiB;
constexpr size_t WS_WIN = 1 * MiB;
constexpr size_t WS_WUQ = 29 * MiB;
constexpr size_t WS_WUKV = WS_WUQ + 3 * MiB / 2;
constexpr size_t WS_WO = WS_WUKV + 2 * MiB;
constexpr size_t WS_RGT = WS_WO + 8 * MiB;
constexpr size_t WS_RET = WS_RGT + 64 * 1024;
constexpr size_t WS_ROPE = 42 * MiB;
constexpr size_t WS_WGU = 56 * MiB;
constexpr size_t WS_WD = 88 * MiB;
constexpr size_t WS_XB = 104 * MiB;
constexpr size_t WS_A = 232 * MiB;
constexpr size_t WS_CQ = WS_A;
constexpr size_t WS_T1 = WS_CQ + 32 * MiB;
constexpr size_t WS_BQ = WS_T1 + 32 * MiB;
constexpr size_t WS_BV = WS_BQ + 32 * MiB;
constexpr size_t WS_WI = WS_BV + 8 * MiB;
constexpr size_t WS_BQI = WS_WI + 2 * MiB;
constexpr size_t WS_SSQ = WS_BQI + 32 * MiB;
constexpr size_t WS_DQ = WS_SSQ + 4 * MiB;
constexpr size_t WS_DK = WS_DQ + 96 * MiB;
constexpr size_t WS_DV = WS_DK + 96 * MiB;
constexpr size_t WS_B = WS_DV + 96 * MiB;
constexpr size_t WS_QA = WS_B;
constexpr size_t WS_KVA = WS_QA + 96 * MiB;
constexpr size_t WS_BM = WS_KVA + 128 * MiB;
constexpr size_t WS_OD = WS_BM + 16 * MiB;
constexpr size_t WS_LSE = WS_OD + 96 * MiB;
constexpr size_t WS_MOE = WS_LSE + 4 * MiB;
constexpr size_t WS_ROUTE = WS_MOE;
constexpr size_t WS_HIST = WS_ROUTE + 1 * MiB;
constexpr size_t WS_STOK = WS_HIST + 64 * 1024;
constexpr size_t WS_SW = WS_STOK + 640 * 1024;
constexpr size_t WS_TSLOT = WS_SW + 640 * 1024;
constexpr size_t WS_TILEE = WS_TSLOT + 512 * 1024;
constexpr size_t WS_KPE = WS_MOE + 4 * MiB;
constexpr size_t WS_KI = WS_KPE + 4 * MiB;
constexpr size_t WS_END = WS_KI + 4 * MiB;
constexpr size_t WS_MIX = WS_A;
constexpr size_t WS_H = WS_A + 128 * MiB;
constexpr size_t WS_Y = WS_H + 68 * MiB;
static_assert(WS_RET + 512 * 1024 <= WS_ROPE && WS_ROPE + 14 * MiB <= WS_WGU && WS_WD + 16 * MiB <= WS_XB && WS_XB + 128 * MiB <= WS_A, "ws map 1");
static_assert(WS_Y + 272 * MiB <= WS_MOE && WS_TILEE + 8192 <= WS_END && WS_END <= 1024 * MiB, "ws map 2");
constexpr size_t ROPE_C16 = 0, ROPE_S16 = (size_t)NT * 16 * 4, ROPE_C8 = 2 * ROPE_S16, ROPE_S8 = ROPE_C8 + (size_t)NT * 8 * 4,
                 ROPE_C4 = ROPE_S8 + (size_t)NT * 8 * 4, ROPE_S4 = ROPE_C4 + (size_t)NT * 4 * 4;

constexpr int CW_BAR = 4096;
constexpr int RING_BYTES = 131072;
constexpr int LDS_X_OFF = 131072;
constexpr int LDSCTL_OFF = 147456;
constexpr int LDS_HIST_OFF = LDSCTL_OFF + 4096;
constexpr int LDS_BYTES = LDS_HIST_OFF + 4096;

#define RLX_AGENT __ATOMIC_RELAXED, __HIP_MEMORY_SCOPE_AGENT
__device__ __forceinline__ unsigned f2bf(float f) { unsigned u = __builtin_bit_cast(unsigned, f); return (u + 0x7fffu + ((u >> 16) & 1u)) >> 16; }
constexpr size_t XR_OFF = (size_t)NT * DM * 2;
#ifndef NT_EPI
#define NT_EPI 1
#endif
#ifndef NT_KVA
#define NT_KVA 1
#endif
#ifndef NT_MIX
#define NT_MIX 0
#endif
#ifndef NT_H
#define NT_H 0
#endif
#ifndef NT_Y
#define NT_Y 1
#endif
#ifndef NT_LN
#define NT_LN 0
#endif
#ifndef NT_ATT
#define NT_ATT 1
#endif
#define STG_ASM(W, POL) asm volatile("global_store_dwordx" W " %0, %1, off " POL "\n\ts_nop 1" :: "v"(p), "v"(w))
template <int M, class T> __device__ __forceinline__ void stg_any16(void* p, T w) {
    if constexpr (M == 0) *(T*)p = w; else if constexpr (M == 1) __builtin_nontemporal_store(w, (T*)p);
    else if constexpr (M == 2) STG_ASM("4", "sc1"); else if constexpr (M == 3) STG_ASM("4", "sc0 sc1"); else if constexpr (M == 4) STG_ASM("4", "sc1 nt"); else STG_ASM("4", "sc0 sc1 nt"); }
template <int M> __device__ __forceinline__ void stgf4(void* p, f32x4 w) { stg_any16<M>(p, w); }
template <int M> __device__ __forceinline__ void stg16(void* p, u32x4 w) { stg_any16<M>(p, w); }
template <int M> __device__ __forceinline__ void stg8(void* p, u32x2 w) {
    if constexpr (M == 0) *(u32x2*)p = w; else if constexpr (M == 1) __builtin_nontemporal_store(w, (u32x2*)p);
    else if constexpr (M == 2) STG_ASM("2", "sc1"); else if constexpr (M == 3) STG_ASM("2", "sc0 sc1"); else if constexpr (M == 4) STG_ASM("2", "sc1 nt"); else STG_ASM("2", "sc0 sc1 nt"); }
#ifndef NT_LD
#define NT_LD 1
#endif
template <class T> __device__ __forceinline__ T ldg_s(const void* p) { if constexpr (NT_LD) return __builtin_nontemporal_load((const T*)p); else return *(const T*)p; }
__device__ __forceinline__ unsigned pk2(float lo, float hi) { f32x2 v = {lo, hi}; bf16x2_t b = __builtin_convertvector(v, bf16x2_t); return __builtin_bit_cast(unsigned, b); }
__device__ __forceinline__ float bf2f(unsigned short b) { return __builtin_bit_cast(float, ((unsigned)b) << 16); }
__device__ __forceinline__ float bflo(unsigned w) { return __builtin_bit_cast(float, w << 16); }
__device__ __forceinline__ float bfhi(unsigned w) { return __builtin_bit_cast(float, w & 0xffff0000u); }
template <int CTRL> __device__ __forceinline__ float dppf(float x) { return __builtin_bit_cast(float, __builtin_amdgcn_mov_dpp(__builtin_bit_cast(int, x), CTRL, 0xf, 0xf, true)); }
__device__ __forceinline__ float xhalf_sum(float v) { const auto t = __builtin_amdgcn_permlane32_swap(__float_as_uint(v), __float_as_uint(v), false, false); return __uint_as_float(t[0]) + __uint_as_float(t[1]); }
__device__ __forceinline__ float xhalf_max(float v) { const auto t = __builtin_amdgcn_permlane32_swap(__float_as_uint(v), __float_as_uint(v), false, false); return fmaxf(__uint_as_float(t[0]), __uint_as_float(t[1])); }
__device__ __forceinline__ float wave_sum(float v) {
    v += dppf<0xB1>(v); v += dppf<0x4E>(v); v += dppf<0x141>(v); v += dppf<0x140>(v);
    const auto s = __builtin_amdgcn_permlane16_swap(__float_as_uint(v), __float_as_uint(v), false, false);
    v = __uint_as_float(s[0]) + __uint_as_float(s[1]);
    return xhalf_sum(v);
}
__device__ __forceinline__ int crow(int r, int hi) { return (r & 3) + 8 * (r >> 2) + 4 * hi; }

#define XB_TMO      128
#define XB_XCNT(j)  (256  + 64 * (j))
#define XB_XSUB(j)  (1280 + 64 * (j))
#define XB_XGEN(j)  (2304 + 64 * (j))
#define XB_TOP      3328
#define XB_TOPGEN   3392
#define XCD_BAR_WORDS 3456
#define XB_SPIN_CAP (1u << 18)
__device__ __forceinline__ unsigned xb_ld(unsigned* p)              { return __hip_atomic_load(p, __ATOMIC_RELAXED, __HIP_MEMORY_SCOPE_AGENT); }
__device__ __forceinline__ unsigned xb_add(unsigned* p, unsigned v) { return __hip_atomic_fetch_add(p, v, __ATOMIC_RELAXED, __HIP_MEMORY_SCOPE_AGENT); }
__device__ __forceinline__ unsigned xb_xcc_id() { return (unsigned)__builtin_amdgcn_s_getreg((3 << 11) | 20) & 0xFu; }
#define XB_SPIN(cond, bar) do { unsigned _sp = 0; while (cond) { __builtin_amdgcn_s_sleep(1); \
    if ((++_sp & 255u) == 0u) { if (xb_ld(&(bar)[XB_TMO])) break; if (_sp > XB_SPIN_CAP) { atomicAdd(&(bar)[XB_TMO], 1u); break; } } } } while (0)
struct XcdBarrier { unsigned* bar; unsigned x; volatile LAS unsigned* st; };
__device__ __forceinline__ XcdBarrier xcd_barrier_post(unsigned* bar, volatile LAS unsigned* st) {
    XcdBarrier b; b.bar = bar; b.x = xb_xcc_id(); b.st = st;
    if (threadIdx.x == 0) (void)xb_add(&bar[XB_XCNT(b.x)], 1u);
    return b;
}
__device__ __forceinline__ void xcd_barrier_complete(unsigned* bar, unsigned x, unsigned& nloc, unsigned& nx) {
    const unsigned G = gridDim.x * gridDim.y * gridDim.z;
    unsigned sum, cnt, mine, sp = 0u;
    for (;;) {
        sum = 0u; cnt = 0u; mine = 0u;
#pragma unroll
        for (unsigned j = 0; j < 16; ++j) { const unsigned c = xb_ld(&bar[XB_XCNT(j)]); sum += c; cnt += (c > 0u) ? 1u : 0u; mine = (j == x) ? c : mine; }
        if (sum == G) break;
        __builtin_amdgcn_s_sleep(1);
        if ((++sp & 255u) == 0u) { if (xb_ld(&bar[XB_TMO])) break; if (sp > XB_SPIN_CAP) { atomicAdd(&bar[XB_TMO], 1u); break; } }
    }
    nloc = mine > 0u ? mine : 1u; nx = cnt > 0u ? cnt : 1u;
}
__device__ __forceinline__ void xcd_barrier(const XcdBarrier& b) {
    asm volatile("s_waitcnt vmcnt(0)" ::: "memory");
    __syncthreads();
    if (threadIdx.x == 0) {
        unsigned* bar = b.bar;
        __builtin_amdgcn_s_waitcnt(0);
        unsigned nloc = b.st[0], nx = b.st[1];
        if (nloc == 0u) { xcd_barrier_complete(bar, b.x, nloc, nx); b.st[0] = nloc; b.st[1] = nx; }
        const unsigned old = xb_add(&bar[XB_XSUB(b.x)], 1u);
        const unsigned gen = old / nloc;
        if (old + 1u == (gen + 1u) * nloc) {
            __builtin_amdgcn_fence(__ATOMIC_RELEASE, "agent");
            asm volatile("s_waitcnt vmcnt(0)" ::: "memory");
            const unsigned og = xb_add(&bar[XB_TOP], 1u);
            const unsigned tg = og / nx;
            if (og + 1u == (tg + 1u) * nx) xb_add(&bar[XB_TOPGEN], 1u);
            else XB_SPIN(xb_ld(&bar[XB_TOPGEN]) == tg, bar);
            __builtin_amdgcn_fence(__ATOMIC_ACQUIRE, "agent");
            xb_add(&bar[XB_XGEN(b.x)], 1u);
            asm volatile("s_waitcnt vmcnt(0)" ::: "memory");
        } else {
            XB_SPIN(xb_ld(&bar[XB_XGEN(b.x)]) == gen, bar);
            __builtin_amdgcn_fence(__ATOMIC_ACQUIRE, "agent");
            asm volatile("s_waitcnt vmcnt(0)" ::: "memory");
        }
    }
    __syncthreads();
}

namespace pg8 {
constexpr int BM = 256, BK = 64, HALF = 128, HTB = HALF * BK * 2, STAGE_BYTES = 8 * HTB, NXCD = 8, WGM = 8;
__host__ __device__ __forceinline__ int lds_byte(int r, int c) { const int st = (r >> 4) * 2 + (c >> 5), rr = r & 15, cc = c & 31, ob = rr * 64 + cc * 2; return st * 1024 + (ob ^ (((ob >> 9) & 1) << 5)); }
__host__ __device__ __forceinline__ void stage_rc(int b, int& R, int& C) { const int st = b / 1024, sb = b % 1024, swz = sb ^ (((sb >> 9) & 1) << 5); R = (st >> 1) * 16 + swz / 64; C = (st & 1) * 32 + (swz % 64) / 2; }
__host__ __device__ __forceinline__ int perm32(int rho) { const int n = rho >> 4, i = rho & 15; return 8 * (i >> 2) + 4 * n + (i & 3); }

#ifndef PROBE_P1
#define PROBE_P1 0
#endif
struct Unit { int pm, pn, pb;
#if PROBE_P1
    int fl;
#endif
};
struct Gemm { const bf16* A; const bf16* Bt; int K; const int* gidx; };

__device__ __forceinline__ int xcd_remap(int wgid, int nwg) { const int q = nwg / NXCD, r = nwg % NXCD, xcd = wgid % NXCD, off = wgid / NXCD; return (xcd < r ? xcd * (q + 1) : r * (q + 1) + (xcd - r) * q) + off; }
struct StaticOrder {
    int nM, nN, nwg, G, c, rep;
    __device__ void init(int M, int N, int G_, int c_, int rep_ = 1) { nM = M / BM; nN = N / BM; nwg = nM * nN; G = G_; c = c_; rep = rep_; }
    __device__ bool next(int i, Unit& u) const {
        long L = (long)i * G + c; if (L >= (long)nwg * rep) return false;
#if PROBE_P1
        u.fl = (rep > 1 && L < nwg) ? 1 : 0;
#endif
        L %= nwg;
        const int wgid = xcd_remap((int)L, nwg);
        const int nig = WGM * nN, gid = wgid / nig, fm = gid * WGM, gsz = (nM - fm) < WGM ? (nM - fm) : WGM;
        u.pm = fm + ((wgid % nig) % gsz); u.pn = (wgid % nig) / gsz; u.pb = u.pn; return true;
    }
};
struct GroupedOrder {
    const int* tile_e; int ntiles, npn, G, c;
    __device__ bool next(int i, Unit& u) const {
        const long L = (long)i * G + c; const int nwg = ntiles * npn; if (L >= nwg) return false;
        const int wgid = xcd_remap((int)L, nwg);
        u.pm = wgid / npn; u.pn = wgid % npn; u.pb = tile_e[u.pm] * npn + u.pn;
#if PROBE_P1
        u.fl = 0;
#endif
        return true;
    }
};

__device__ __forceinline__ unsigned cvt_pk_bf16(float lo, float hi) { unsigned r; asm volatile("v_cvt_pk_bf16_f32 %0, %1, %2" : "=v"(r) : "v"(lo), "v"(hi)); return r; }

template <int STM> struct EpiPlainT {
    static constexpr bool PERM = true;
    bf16* O; int ldc; const float* ssq; int ssq_n; float ssq_inv; float eps;
    LAS unsigned char* xl;
    __device__ __forceinline__ void operator()(const f32x4 (&acc)[2][2][4][2], const Unit& u, int wr, int wc, int fr, int fq) const {
        const int lane = fq * 16 + fr; LAS unsigned char* t = xl + (wr * 4 + wc) * 2048;
        const int wsw = fr & 7, rrow = lane >> 3, rch = lane & 7;
#pragma unroll
        for (int ai = 0; ai < 2; ++ai)
#pragma unroll
            for (int m = 0; m < 4; ++m) { const int rowb = u.pm * BM + ai * HALF + wr * 64 + m * 16;
                float sc = 1.f;
                if (ssq) { const f32x4 p = *(const f32x4*)(ssq + (size_t)(rowb + fr) * ssq_n); sc = __builtin_amdgcn_rsqf((p[0] + p[1] + p[2] + p[3]) * ssq_inv + eps); }
#pragma unroll
                for (int bj = 0; bj < 2; ++bj) { const f32x4 v0 = acc[ai][bj][m][0] * sc, v1 = acc[ai][bj][m][1] * sc;
                    u32x4 w; w.x = cvt_pk_bf16(v0[0], v0[1]); w.y = cvt_pk_bf16(v0[2], v0[3]); w.z = cvt_pk_bf16(v1[0], v1[1]); w.w = cvt_pk_bf16(v1[2], v1[3]);
                    *(LAS u32x4*)(t + fr * 128 + 16 * ((4 * bj + fq) ^ wsw)) = w; }
#pragma unroll
                for (int i = 0; i < 2; ++i) { const int rr = 8 * i + rrow;
                    const u32x4 w = *(const LAS u32x4*)(t + rr * 128 + 16 * (rch ^ (rr & 7)));
                    stg16<STM>(O + (size_t)(rowb + rr) * ldc + u.pn * BM + wc * 64 + 8 * rch, w); }
            }
    }
};
template <int STM> struct EpiGateUpT {
    static constexpr bool PERM = true;
    bf16* H; const float* sw;
    __device__ __forceinline__ void operator()(const f32x4 (&acc)[2][2][4][2], const Unit& u, int wr, int wc, int fr, int fq) const {
        const int row0 = u.pm * BM + wr * 64 + fr; const int col0 = u.pn * HALF + wc * 32 + 8 * fq;
#pragma unroll
        for (int ai = 0; ai < 2; ++ai)
#pragma unroll
            for (int m = 0; m < 4; ++m) { const int row = row0 + ai * HALF + m * 16; const float w = sw[row]; f32x4 hv[2];
#pragma unroll
                for (int n = 0; n < 2; ++n) { const f32x4 g = acc[ai][0][m][n], up = acc[ai][1][m][n];
#pragma unroll
                    for (int e = 0; e < 4; ++e) { const float sg = g[e] * __builtin_amdgcn_rcpf(1.0f + __builtin_amdgcn_exp2f(-g[e] * LOG2E)); hv[n][e] = sg * up[e] * w; } }
                u32x4 o; o.x = cvt_pk_bf16(hv[0][0], hv[0][1]); o.y = cvt_pk_bf16(hv[0][2], hv[0][3]); o.z = cvt_pk_bf16(hv[1][0], hv[1][1]); o.w = cvt_pk_bf16(hv[1][2], hv[1][3]);
                stg16<STM>(H + (size_t)row * FH + col0, o); }
    }
};

enum { GK_SKIP = 0, GK_PLAIN = 1, GK_ROPE32 = 2, GK_HEAD16 = 3, GK_IDX8 = 4, GK_WI = 5 };
struct GroupDesc { int kind; bf16* dst; int pitch; int col; float scale; int perm; float* ssq; int ssq_n; int ssq_i; };
struct RopeTabs { const int* pos; };
__device__ __forceinline__ int perm_row(int row, int perm) {
    if (perm == 0) return row; const int b = row >> 11, s = row & 2047;
    return perm == 4 ? (b << 11) + ((s & 3) << 9) + (s >> 2) : (b << 11) + ((s & 15) << 7) + (s >> 4);
}
__device__ __forceinline__ void st16(bf16* p, u32x2 a, u32x2 b) { u32x4 w; w.x = a.x; w.y = a.y; w.z = b.x; w.w = b.y; stg16<NT_EPI>(p, w); }
__device__ __forceinline__ u32x2 pk4(f32x4 v) { u32x2 w; w.x = cvt_pk_bf16(v[0], v[1]); w.y = cvt_pk_bf16(v[2], v[3]); return w; }
__device__ __forceinline__ void swap16(u32x2& X, u32x2& Y) {
    const auto a = __builtin_amdgcn_permlane16_swap(X.x, Y.x, false, false); const auto b = __builtin_amdgcn_permlane16_swap(X.y, Y.y, false, false);
    X.x = a[0]; Y.x = a[1]; X.y = b[0]; Y.y = b[1];
}
__device__ __forceinline__ float rope_k(int i, int rd) { return __builtin_amdgcn_exp2f(-18.931568569324174f * (float)(2 * i) / (float)rd) * 0.15915494309189535f; }
__device__ __forceinline__ void rope_cs(float posf, int i0, int rd, f32x4& c, f32x4& s) {
#pragma unroll
    for (int e = 0; e < 4; ++e) { const float f = __builtin_amdgcn_fractf(posf * rope_k(i0 + e, rd)); s[e] = __builtin_amdgcn_sinf(f); c[e] = __builtin_amdgcn_cosf(f); }
}
template <class DescFn> struct EpiGroups {
    static constexpr bool PERM = true;
    DescFn F; RopeTabs R; const float* rs_ssq; int rs_n; float rs_inv, rs_eps;
    __device__ __forceinline__ void operator()(const f32x4 (&acc)[2][2][4][2], const Unit& u, int wr, int wc, int fr, int fq) const {
        const int row0 = u.pm * BM + wr * 64 + fr;
#pragma unroll
        for (int bj = 0; bj < 2; ++bj) {
            const GroupDesc d = F(u.pn, bj, wc);
            if (d.kind == GK_SKIP) continue;
#if PROBE_P1 == 1
            if (u.fl) continue;
#endif
            const int ki0 = d.kind == GK_ROPE32 ? 4 * fq : (d.kind == GK_HEAD16 ? 4 * (fq & 1) : 0), krd = d.kind == GK_ROPE32 ? 32 : (d.kind == GK_HEAD16 ? 16 : 8);
#pragma unroll
            for (int ai = 0; ai < 2; ++ai)
#pragma unroll
                for (int m = 0; m < 4; ++m) {
                    const int row = row0 + ai * HALF + m * 16;
                    float sc = d.scale;
                    if (rs_ssq) { float s = 0.f; for (int i = 0; i < rs_n; ++i) s += rs_ssq[(size_t)row * rs_n + i]; sc *= __builtin_amdgcn_rsqf(s * rs_inv + rs_eps); }
                    f32x4 v0 = acc[ai][bj][m][0], v1 = acc[ai][bj][m][1];
                    if (d.ssq) {
                        float q = (v0[0] * v0[0] + v0[1] * v0[1]) + (v0[2] * v0[2] + v0[3] * v0[3]) + (v1[0] * v1[0] + v1[1] * v1[1]) + (v1[2] * v1[2] + v1[3] * v1[3]);
                        q += __shfl_xor(q, 16); q += __shfl_xor(q, 32);
                        if (fq == 0) d.ssq[(size_t)row * d.ssq_n + d.ssq_i] = q;
                    }
                    v0 = v0 * sc; v1 = v1 * sc;
                    if (d.kind == GK_WI) { if (fq == 0) { float* wp = (float*)d.dst + (size_t)row * 8; *(f32x4*)wp = v0; *(f32x4*)(wp + 4) = v1; } continue; }
                    bf16* rp = d.dst + (size_t)perm_row(row, d.perm) * d.pitch + d.col;
                    if (d.kind == GK_PLAIN) { st16(rp + 8 * fq, pk4(v0), pk4(v1)); }
                    else if (d.kind == GK_IDX8) {
                        f32x4 c, s; rope_cs((float)R.pos[row], ki0, krd, c, s);
                        const f32x4 o1 = fq == 0 ? v0 * c - v1 * s : v0, o2 = fq == 0 ? v1 * c + v0 * s : v1;
                        st16(rp + 8 * fq, pk4(o1), pk4(o2));
                    } else if (d.kind == GK_ROPE32) {
                        f32x4 c, s; rope_cs((float)R.pos[row], ki0, krd, c, s);
                        u32x2 X = pk4(v0 * c - v1 * s), Y = pk4(v1 * c + v0 * s);
                        swap16(X, Y);
                        st16(rp + ((fq & 1) ? 16 + 4 * (fq - 1) : 4 * fq), X, Y);
                    } else {
                        f32x4 c, s; rope_cs((float)R.pos[row], ki0, krd, c, s);
                        u32x2 X = pk4(fq < 2 ? v0 * c - v1 * s : v0), Y = pk4(fq < 2 ? v1 * c + v0 * s : v1);
                        swap16(X, Y);
                        st16(rp + 16 * (fq >> 1) + 8 * (fq & 1), X, Y);
                    }
                }
        }
    }
};

template <class Epi, class Sched, bool GATHER, int LDA = 0>
__device__ __forceinline__ void gemm_phase(LAS unsigned char* lds, const Gemm g, const Sched& S, const Epi& E, const int tid) {
    const int wid = __builtin_amdgcn_readfirstlane(tid >> 6), lane = tid & 63, wr = wid >> 2, wc = wid & 3, fr = lane & 15, fq = lane >> 4;
    const int K = g.K, nt = K / BK, lda = LDA ? LDA : K;
    unsigned voA[2][2], voB[2]; int RA[2], CA[2];
#pragma unroll
    for (int i = 0; i < 2; ++i) { int R, C; stage_rc(tid * 16 + i * 8192, R, C); const int Rb = Epi::PERM ? ((R & ~31) + perm32(R & 31)) : R;
        RA[i] = R; CA[i] = C; voA[0][i] = (unsigned)(R * lda + C) * 2u; voA[1][i] = (unsigned)((R + HALF) * lda + C) * 2u; voB[i] = (unsigned)(Rb * K + C) * 2u; }
    const size_t kstep = (size_t)(BK * 2);
    const size_t hstep = (size_t)HALF * K * 2;
    const size_t tstep = 2 * hstep;
    const size_t tstepA = (size_t)BM * lda * 2;
    const unsigned ldsw = (unsigned)wid * 1024u;
    const int aoff = lds_byte(wr * 64 + fr, fq * 8), boff = lds_byte(wc * 32 + fr, fq * 8);
#define PG8_SA(b, h) (((b) * 2 + (h)) * HTB)
#define PG8_SB(b, h) ((4 + (b) * 2 + (h)) * HTB)
#define PG8_STAGE(bufoff, gbase, voff) do { _Pragma("unroll") for (int _i = 0; _i < 2; ++_i) \
        __builtin_amdgcn_global_load_lds((const unsigned*)((const char*)(gbase) + (voff)[_i]), (LAS unsigned*)(lds + (bufoff) + ldsw + _i * 8192), 16, 0, 0); } while (0)
#define PG8_LDA(dst, b, h) do { _Pragma("unroll") for (int m = 0; m < 4; ++m) _Pragma("unroll") for (int k = 0; k < 2; ++k) dst[m][k] = *(const LAS bf16x8*)(lds + PG8_SA(b, h) + aoff + m * 2048 + k * 1024); } while (0)
#define PG8_LDB(dst, b, h) do { _Pragma("unroll") for (int n = 0; n < 2; ++n) _Pragma("unroll") for (int k = 0; k < 2; ++k) dst[n][k] = *(const LAS bf16x8*)(lds + PG8_SB(b, h) + boff + n * 2048 + k * 1024); } while (0)
#define PG8_MMA(ai, bj, At, Bt) do { __builtin_amdgcn_s_setprio(1); _Pragma("unroll") for (int m = 0; m < 4; ++m) _Pragma("unroll") for (int n = 0; n < 2; ++n) _Pragma("unroll") for (int k = 0; k < 2; ++k) \
        acc[ai][bj][m][n] = __builtin_amdgcn_mfma_f32_16x16x32_bf16(Bt[n][k], At[m][k], acc[ai][bj][m][n], 0, 0, 0); __builtin_amdgcn_s_setprio(0); } while (0)
#define PG8_WAIT_V(n) asm volatile("s_waitcnt vmcnt(" #n ")" ::: "memory")
#define PG8_WAIT_L(n) asm volatile("s_waitcnt lgkmcnt(" #n ")" ::: "memory")
#define PG8_BAR __builtin_amdgcn_s_barrier()
#define PG8_SCHED __builtin_amdgcn_sched_barrier(0)
    Unit cur, nxt; int ui = 0;
    if (!S.next(0, cur)) return;
    f32x4 acc[2][2][4][2];
#pragma unroll
    for (int a = 0; a < 2; ++a)
#pragma unroll
        for (int b = 0; b < 2; ++b)
#pragma unroll
            for (int m = 0; m < 4; ++m)
#pragma unroll
                for (int n = 0; n < 2; ++n) acc[a][b][m][n] = (f32x4){0.f, 0.f, 0.f, 0.f};
    bf16x8 At[4][2], B0[2][2], B1[2][2];
    unsigned nvA[2][2];
    const char* cA; const char* cB = (const char*)g.Bt + (size_t)cur.pb * tstep;
    if constexpr (GATHER) { cA = (const char*)g.A;
#pragma unroll
        for (int h = 0; h < 2; ++h)
#pragma unroll
            for (int i = 0; i < 2; ++i) voA[h][i] = (unsigned)g.gidx[cur.pm * BM + h * HALF + RA[i]] * (unsigned)(lda * 2) + (unsigned)CA[i] * 2u;
    } else cA = (const char*)g.A + (size_t)cur.pm * tstepA;
    PG8_STAGE(PG8_SB(0, 0), cB, voB); PG8_STAGE(PG8_SB(0, 1), cB + hstep, voB); PG8_STAGE(PG8_SA(0, 0), cA, voA[0]); PG8_STAGE(PG8_SA(0, 1), cA, voA[1]);
    if (wr == 1) PG8_BAR;
    PG8_WAIT_V(2); PG8_BAR;
    PG8_STAGE(PG8_SB(1, 0), cB + kstep, voB); PG8_STAGE(PG8_SA(1, 0), cA + kstep, voA[0]); PG8_STAGE(PG8_SB(1, 1), cB + hstep + kstep, voB);
    PG8_WAIT_V(6); PG8_BAR;
    for (;;) {
        const bool has_next = S.next(ui + 1, nxt);
        const char* nA; const char* nB = has_next ? (const char*)g.Bt + (size_t)nxt.pb * tstep : cB;
        if constexpr (GATHER) { nA = cA;
#pragma unroll
            for (int h = 0; h < 2; ++h)
#pragma unroll
                for (int i = 0; i < 2; ++i) nvA[h][i] = has_next ? (unsigned)g.gidx[nxt.pm * BM + h * HALF + RA[i]] * (unsigned)(lda * 2) + (unsigned)CA[i] * 2u : voA[h][i];
        } else nA = has_next ? (const char*)g.A + (size_t)nxt.pm * tstepA : cA;
#if PROBE_P1 == 2
        const int ntu = cur.fl ? 2 : nt;
#else
        const int ntu = nt;
#endif
#pragma nounroll
        for (int t = 0; t < ntu; t += 2) {
            const bool last = (t == ntu - 2);
            const char* a1 = cA + (size_t)(t + 1) * kstep;
            const char* a2 = last ? nA : cA + (size_t)(t + 2) * kstep; const char* b2 = last ? nB : cB + (size_t)(t + 2) * kstep;
            const char* a3 = a2 + kstep; const char* b3 = b2 + kstep;
            unsigned xA[2][2];
#pragma unroll
            for (int h = 0; h < 2; ++h)
#pragma unroll
                for (int i = 0; i < 2; ++i) xA[h][i] = (GATHER && last) ? nvA[h][i] : voA[h][i];
            PG8_LDB(B0, 0, 0); PG8_LDB(B1, 0, 1); PG8_SCHED; PG8_LDA(At, 0, 0); PG8_STAGE(PG8_SA(1, 1), a1, voA[1]);
            PG8_WAIT_V(8); PG8_WAIT_L(0); PG8_BAR; PG8_MMA(0, 0, At, B0); PG8_MMA(0, 1, At, B1); PG8_BAR; PG8_SCHED;
            PG8_LDA(At, 0, 1); PG8_STAGE(PG8_SB(0, 0), b2, voB); PG8_STAGE(PG8_SB(0, 1), b2 + hstep, voB); PG8_STAGE(PG8_SA(0, 0), a2, xA[0]);
            PG8_WAIT_V(8); PG8_WAIT_L(0); PG8_BAR; PG8_MMA(1, 0, At, B0); PG8_MMA(1, 1, At, B1); PG8_BAR; PG8_SCHED;
            PG8_LDB(B0, 1, 0); PG8_LDB(B1, 1, 1); PG8_SCHED; PG8_LDA(At, 1, 0); PG8_STAGE(PG8_SA(0, 1), a2, xA[1]);
            PG8_WAIT_V(8); PG8_WAIT_L(0); PG8_BAR; PG8_MMA(0, 0, At, B0); PG8_MMA(0, 1, At, B1); PG8_BAR; PG8_SCHED;
            PG8_LDA(At, 1, 1); PG8_STAGE(PG8_SB(1, 0), b3, voB); PG8_STAGE(PG8_SB(1, 1), b3 + hstep, voB); PG8_STAGE(PG8_SA(1, 0), a3, xA[0]);
            PG8_WAIT_V(8); PG8_WAIT_L(0); PG8_BAR; PG8_MMA(1, 0, At, B0); PG8_MMA(1, 1, At, B1); PG8_BAR; PG8_SCHED;
        }
        if (wr == 0) PG8_BAR;
        E(acc, cur, wr, wc, fr, fq);
        if (!has_next) break;
#pragma unroll
        for (int a = 0; a < 2; ++a)
#pragma unroll
            for (int b = 0; b < 2; ++b)
#pragma unroll
                for (int m = 0; m < 4; ++m)
#pragma unroll
                    for (int n = 0; n < 2; ++n) acc[a][b][m][n] = (f32x4){0.f, 0.f, 0.f, 0.f};
        cur = nxt; cA = nA; cB = nB; ++ui;
        if constexpr (GATHER) {
#pragma unroll
            for (int h = 0; h < 2; ++h)
#pragma unroll
                for (int i = 0; i < 2; ++i) voA[h][i] = nvA[h][i];
        }
        if (wr == 1) PG8_BAR;
    }
    PG8_WAIT_V(0);
    PG8_BAR;
#undef PG8_SA
#undef PG8_SB
#undef PG8_STAGE
#undef PG8_LDA
#undef PG8_LDB
#undef PG8_MMA
#undef PG8_WAIT_V
#undef PG8_WAIT_L
#undef PG8_BAR
#undef PG8_SCHED
}
}

#ifndef PROBE_LDS2
#define PROBE_LDS2 0
#endif
#ifndef PROBE_EXP2
#define PROBE_EXP2 0
#endif
#ifndef SOFTMAX_PK
#define SOFTMAX_PK 0
#endif
#ifndef FA_FUSE
#define FA_FUSE 0
#endif
namespace fa {
constexpr int VBYTES_T = 64 * 128;
typedef short v4i16_t __attribute__((ext_vector_type(4)));
__device__ __forceinline__ u32x2 vtr(const LAS unsigned char* p) { return __builtin_bit_cast(u32x2, __builtin_amdgcn_ds_read_tr16_b64_v4i16((LAS v4i16_t*)p)); }
__device__ __forceinline__ float max16(const f32x16& c) { float r;
    asm("v_max3_f32 %0, %1, %2, %3\n\tv_max3_f32 %0, %0, %4, %5\n\tv_max3_f32 %0, %0, %6, %7\n\tv_max3_f32 %0, %0, %8, %9\n\tv_max3_f32 %0, %0, %10, %11\n\tv_max3_f32 %0, %0, %12, %13\n\tv_max3_f32 %0, %0, %14, %15\n\tv_max_f32 %0, %0, %16"
        : "=&v"(r) : "v"(c[0]), "v"(c[1]), "v"(c[2]), "v"(c[3]), "v"(c[4]), "v"(c[5]), "v"(c[6]), "v"(c[7]), "v"(c[8]), "v"(c[9]), "v"(c[10]), "v"(c[11]), "v"(c[12]), "v"(c[13]), "v"(c[14]), "v"(c[15]));
    return r; }
__device__ __forceinline__ void mask_init(f32x16& S, unsigned nw) { float t0, t1, t2, t3, t4, t5, t6, t7, t8, t9, t10, t11, t12, t13, t14, t15;
    asm("v_bfe_i32 %0, %16, 0, 1\n\tv_lshlrev_b32 %0, 23, %0\n\tv_bfe_i32 %1, %16, 1, 1\n\tv_lshlrev_b32 %1, 23, %1\n\tv_bfe_i32 %2, %16, 2, 1\n\tv_lshlrev_b32 %2, 23, %2\n\tv_bfe_i32 %3, %16, 3, 1\n\tv_lshlrev_b32 %3, 23, %3\n\tv_bfe_i32 %4, %16, 8, 1\n\tv_lshlrev_b32 %4, 23, %4\n\tv_bfe_i32 %5, %16, 9, 1\n\tv_lshlrev_b32 %5, 23, %5\n\tv_bfe_i32 %6, %16, 10, 1\n\tv_lshlrev_b32 %6, 23, %6\n\tv_bfe_i32 %7, %16, 11, 1\n\tv_lshlrev_b32 %7, 23, %7\n\tv_bfe_i32 %8, %16, 16, 1\n\tv_lshlrev_b32 %8, 23, %8\n\tv_bfe_i32 %9, %16, 17, 1\n\tv_lshlrev_b32 %9, 23, %9\n\tv_bfe_i32 %10, %16, 18, 1\n\tv_lshlrev_b32 %10, 23, %10\n\tv_bfe_i32 %11, %16, 19, 1\n\tv_lshlrev_b32 %11, 23, %11\n\tv_bfe_i32 %12, %16, 24, 1\n\tv_lshlrev_b32 %12, 23, %12\n\tv_bfe_i32 %13, %16, 25, 1\n\tv_lshlrev_b32 %13, 23, %13\n\tv_bfe_i32 %14, %16, 26, 1\n\tv_lshlrev_b32 %14, 23, %14\n\tv_bfe_i32 %15, %16, 27, 1\n\tv_lshlrev_b32 %15, 23, %15"
        : "=&v"(t0), "=&v"(t1), "=&v"(t2), "=&v"(t3), "=&v"(t4), "=&v"(t5), "=&v"(t6), "=&v"(t7), "=&v"(t8), "=&v"(t9), "=&v"(t10), "=&v"(t11), "=&v"(t12), "=&v"(t13), "=&v"(t14), "=&v"(t15) : "v"(nw));
    S[0] = t0; S[1] = t1; S[2] = t2; S[3] = t3; S[4] = t4; S[5] = t5; S[6] = t6; S[7] = t7; S[8] = t8; S[9] = t9; S[10] = t10; S[11] = t11; S[12] = t12; S[13] = t13; S[14] = t14; S[15] = t15; }
struct Params {
    const bf16* Q;  int q_pitch;
    const bf16* K1; int k1_pitch, k1_col;
    const bf16* K2; int k2_pitch, k2_col;
    const bf16* V;  int v_pitch, v_col;
    bf16* O; int o_pitch;
    float* LSE; int lse_pitch;
    const unsigned* BM;
    int CL, W;
};
struct UnitDesc { int seq0, qw, q_col, o_col, lse_col, k1_col, v_col, kt_lo, kt_hi; };
template <int DQK, int MODE, int NH, class DescFn>
__device__ __forceinline__ void attn_stream(const Params& P, LAS unsigned char* lds, const int tid, const int n_units, DescFn desc) {
    constexpr int NKS = DQK / 16, AHEAD = (NH == 2 ? 3 : 4), NST = AHEAD + 1, K1B = 8192 * NH, K2B = (DQK == 96 ? 4096 : 0), BMOFF = K1B + K2B + 8192 * NH, STB = BMOFF + (MODE == 1 ? 8192 : 0);
    constexpr int NDMA = 2 * NH + (DQK == 96 ? 1 : 0) + (MODE == 1 ? 1 : 0);
    static_assert(NH == 1 || (DQK == 64 && MODE != 1), "two-head stages: head dim 64 only");
    constexpr bool active = true;
    if (n_units <= 0) return;
    const int lane = tid & 63, r = lane & 31, h = lane >> 5, wave = __builtin_amdgcn_readfirstlane(tid >> 6);
    const int tq_ = (lane & 15) >> 2, tp_ = lane & 3, tg_ = lane >> 4;
    const int hsel = NH == 2 ? (wave >> 2) * 8192 : 0;
    const int vtoff = K1B + K2B + hsel + (4 * h + tq_) * 128, vxb = 2 * (16 * (tg_ & 1) + 4 * tp_), vsw = (tq_ >> 1) & 1;
    const int vx0 = vxb + ((0 ^ vsw) << 6), vx1 = vxb + ((1 ^ vsw) << 6);
    const int s1_ = (r >> 1) & 7, s2_ = (r >> 2) & 3;
    const int k1row = hsel + r * 128, k2row = K1B + r * 64;
    const int row1 = 8 * wave + (lane >> 3), row2 = 16 * (wave & 3) + (lane >> 2);
    const size_t tk1 = (size_t)64 * P.k1_pitch, tk2 = (size_t)64 * P.k2_pitch, tv = (size_t)64 * P.v_pitch;
    const int d_k1 = wave * 1024, d_k2 = K1B + (wave & 3) * 1024, d_v = K1B + K2B + wave * 1024;
    const bf16* src_k1; const bf16* src_v; const bf16* src_k2 = nullptr; const unsigned* bmp = nullptr;
    int ji = -1, kti = 1, kti_hi = 0;
    auto fa_issue = [&](const int st) __attribute__((always_inline)) {
        if (kti > kti_hi) {
            if (ji + 1 < n_units) { ++ji; const UnitDesc t = desc(ji); kti = t.kt_lo; kti_hi = t.kt_hi;
                src_k1 = P.K1 + (size_t)(t.seq0 + row1) * P.k1_pitch + t.k1_col + 8 * ((lane & 7) ^ ((row1 >> 1) & 7));
                src_v = P.V + (size_t)(t.seq0 + row1) * P.v_pitch + t.v_col + 8 * ((lane & 7) ^ (((row1 >> 1) & 1) << 2));
                if constexpr (DQK == 96) src_k2 = P.K2 + (size_t)(t.seq0 + row2) * P.k2_pitch + P.k2_col + 8 * ((lane & 3) ^ ((row2 >> 2) & 3));
                if constexpr (MODE == 1) bmp = P.BM + (size_t)(t.seq0 + t.qw + r) * 64;
            } else kti = kti_hi; }
        LAS unsigned char* sb_ = lds + st * STB;
        __builtin_amdgcn_global_load_lds((const unsigned*)(src_k1 + kti * tk1), (LAS unsigned*)(sb_ + d_k1), 16, 0, 0);
        __builtin_amdgcn_global_load_lds((const unsigned*)(src_v + kti * tv), (LAS unsigned*)(sb_ + d_v), 16, 0, 0);
        if constexpr (NH == 2) {
            __builtin_amdgcn_global_load_lds((const unsigned*)(src_k1 + 64 + kti * tk1), (LAS unsigned*)(sb_ + d_k1 + 8192), 16, 0, 0);
            __builtin_amdgcn_global_load_lds((const unsigned*)(src_v + 64 + kti * tv), (LAS unsigned*)(sb_ + d_v + 8192), 16, 0, 0); }
        if constexpr (DQK == 96) __builtin_amdgcn_global_load_lds((const unsigned*)(src_k2 + kti * tk2), (LAS unsigned*)(sb_ + d_k2), 16, 0, 0);
        if constexpr (MODE == 1) __builtin_amdgcn_global_load_lds(bmp + (kti & ~1) * 2, (LAS unsigned*)(sb_ + BMOFF + wave * 1024), 16, 0, 0);
        ++kti; };
#define FA_ISSUE(TILE, ST) fa_issue(ST)
    int st_is = 0, st_c = 0, st_n = 1;
    bf16x8 qf[NKS];
#define FA_LOADQ(D) do { const bf16* qp_ = P.Q + (size_t)((D).seq0 + (D).qw + r) * P.q_pitch + (D).q_col + 8 * h; \
        _Pragma("unroll") for (int ks = 0; ks < NKS; ++ks) asm volatile("global_load_dwordx4 %0, %1, off offset:%2" : "=&v"(qf[ks]) : "v"(qp_), "n"(32 * ks) : "memory"); } while (0)
#define FA_WAITQ(N) do { if constexpr (NKS == 6) asm volatile("s_waitcnt vmcnt(%6)" : "+v"(qf[0]), "+v"(qf[1]), "+v"(qf[2]), "+v"(qf[3]), "+v"(qf[4]), "+v"(qf[5]) : "n"(N) : "memory"); \
        else asm volatile("s_waitcnt vmcnt(%4)" : "+v"(qf[0]), "+v"(qf[1]), "+v"(qf[2]), "+v"(qf[3]) : "n"(N) : "memory"); } while (0)
    { const UnitDesc d0 = desc(0); FA_LOADQ(d0); FA_WAITQ(0); }
#pragma unroll 1
    for (int ju = 0; ju < n_units; ++ju) {
    const UnitDesc du = desc(ju);
    const int seq0 = du.seq0, qw = du.qw, q_col = du.q_col, o_col = du.o_col, lse_col = du.lse_col, kt_lo = du.kt_lo, kt_hi = du.kt_hi;
    const int q = qw + r;
    const int lo_q = MODE == 0 ? max(q & ~(P.CL - 1), q - P.W) : 0;
    const int qh = q - 4 * h, lqh = lo_q - 4 * h;
    const int lo_w0 = MODE == 0 ? max(qw & ~(P.CL - 1), qw - P.W) : 0;
    const int lo_w1 = MODE == 0 ? max((qw + 31) & ~(P.CL - 1), qw + 31 - P.W) : 0;
#define FA_WAITBAR(N) do { asm volatile("s_waitcnt vmcnt(%0)" :: "n"(N) : "memory"); __builtin_amdgcn_s_barrier(); asm volatile("" ::: "memory"); } while (0)
    f32x16 o0, o1, c0, c1, n0, n1;
#pragma unroll
    for (int i = 0; i < 16; ++i) { o0[i] = 0.f; o1[i] = 0.f; c0[i] = 0.f; c1[i] = 0.f; n0[i] = 0.f; n1[i] = 0.f; }
    float m = -INFINITY, l = 0.f;
#define FA_PART(kt_) (active && (MODE == 0 ? ((kt_) * 64 <= qw + 31 && (kt_) * 64 + 63 >= lo_w0) : ((kt_) * 64 <= qw + 31)))
#define FA_KADDR(SB_, ROFF, ks) ((ks) < 4 ? (SB_) + (ROFF) * 128 + k1row + 16 * ((2 * (ks) + h) ^ s1_) : (SB_) + (ROFF) * 64 + k2row + 16 * ((2 * ((ks) - 4) + h) ^ s2_))
#define FA_QKH(S, SB_, ROFF, NW) do { bf16x8 fa_[NKS]; \
        _Pragma("unroll") for (int ks = 0; ks < NKS; ++ks) fa_[ks] = *(const LAS bf16x8*)FA_KADDR(SB_, ROFF, ks); \
        if (PROBE_LDS2) { _Pragma("unroll") for (int ks = 0; ks < NKS; ++ks) { const bf16x8 fb_ = *(const volatile LAS bf16x8*)FA_KADDR(SB_, (ROFF) ^ 32, ks); asm volatile("" :: "v"(fb_)); } } \
        if constexpr (MODE == 1) {        \
            mask_init(S, NW); \
        } else { _Pragma("unroll") for (int i = 0; i < 16; ++i) S[i] = 0.f; } \
        _Pragma("unroll") for (int ks = 0; ks < NKS; ++ks) S = __builtin_amdgcn_mfma_f32_32x32x16_bf16(fa_[ks], qf[ks], S, 0, 0, 0); \
        __builtin_amdgcn_sched_group_barrier(0x100, NKS, 0); __builtin_amdgcn_sched_group_barrier(0x008, NKS, 0); } while (0)
#define FA_QK(S0, S1, SB_, KT) do { unsigned nwa_ = 0u, nwb_ = 0u; \
        if constexpr (MODE == 1) { const u32x4 bw_ = *(const LAS u32x4*)((SB_) + BMOFF + wave * 1024 + lane * 16);        \
            nwa_ = ~((((KT) & 1) ? bw_.z : bw_.x) >> (4 * h)); nwb_ = ~((((KT) & 1) ? bw_.w : bw_.y) >> (4 * h)); } \
        FA_QKH(S0, SB_, 0, nwa_); FA_QKH(S1, SB_, 32, nwb_); } while (0)
#define FA_QKX(S, SB_, ROFF) do { bf16x8 fa_[NKS]; \
        _Pragma("unroll") for (int ks = 0; ks < NKS; ++ks) fa_[ks] = *(const LAS bf16x8*)FA_KADDR(SB_, ROFF, ks); \
        _Pragma("unroll") for (int i = 0; i < 16; ++i) S[i] = 0.f; \
        _Pragma("unroll") for (int ks = 0; ks < NKS; ++ks) S = __builtin_amdgcn_mfma_f32_32x32x16_bf16(fa_[ks], qf[ks], S, 0, 0, 0); } while (0)
    if (ju == 0) {
#pragma unroll 1
        for (int a = 0; a < AHEAD; ++a) { FA_ISSUE(kt_lo + a, st_is); st_is = st_is + 1; }
        FA_WAITBAR((AHEAD - 2) * NDMA);
    }
    if (FA_PART(kt_lo)) FA_QK(c0, c1, lds + st_c * STB, kt_lo);
    auto fa_step = [&](f32x16& c0, f32x16& c1, f32x16& n0, f32x16& n1, const int kt) __attribute__((always_inline)) {
        FA_ISSUE(kt + AHEAD, st_is); st_is = (st_is + 1 == NST) ? 0 : st_is + 1;
        const bool more1 = kt < kt_hi;
        const bool qnext = !more1 && (ju + 1 < n_units);
        if (qnext) { const UnitDesc dq = desc(ju + 1); FA_LOADQ(dq); }
        const int k0 = kt * 64;
        const bool part_c = FA_PART(kt), part_n = more1 && FA_PART(kt + 1);
        const LAS unsigned char* Sn = lds + st_n * STB; const LAS unsigned char* Vb = lds + st_c * STB;
        const bool fused = FA_FUSE && (DQK == 64) && part_c && part_n;
        if (part_n && !fused) FA_QK(n0, n1, Sn, kt + 1);
        if (part_c) {
            float alpha;
#define FA_SOFTMAX(MASKED) do { \
            if (MASKED) { if constexpr (MODE == 2) { const int qa = qh - k0, qa1 = qa - 32; \
                    _Pragma("unroll") for (int i = 0; i < 16; ++i) { const int ci = (i & 3) + 8 * (i >> 2); \
                        c0[i] = (ci > qa) ? -INFINITY : c0[i]; c1[i] = (ci > qa1) ? -INFINITY : c1[i]; } \
                } else if constexpr (MODE == 0) { const int lb = lqh - k0; const unsigned span = (unsigned)(q - lo_q), lb1 = (unsigned)(lb - 32);     \
                    _Pragma("unroll") for (int i = 0; i < 16; ++i) { const int ci = (i & 3) + 8 * (i >> 2); \
                        c0[i] = ((unsigned)(ci - lb) > span) ? -INFINITY : c0[i]; c1[i] = ((unsigned)ci - lb1 > span) ? -INFINITY : c1[i]; } \
                } } \
            float mx = xhalf_max(fmaxf(max16(c0), max16(c1))); \
            const float mn = fmaxf(m, mx); \
            const float ms = (mn == -INFINITY) ? 0.f : mn; \
            alpha = __builtin_amdgcn_exp2f(m - ms); \
            m = mn; \
            float ls = 0.f; \
            if (PROBE_EXP2) { float dm_ = 0.f; _Pragma("unroll") for (int i = 0; i < 16; ++i) { dm_ += __builtin_amdgcn_exp2f(c0[i] - mx) + __builtin_amdgcn_exp2f(c1[i] - mx); } asm volatile("" :: "v"(dm_)); } \
            if (SOFTMAX_PK) { const f32x2 ms2 = {ms, ms}; f32x2 lsa = {0.f, 0.f}, lsb = {0.f, 0.f};            \
              _Pragma("unroll") for (int i = 0; i < 16; i += 2) { \
                  f32x2 ta = {c0[i], c0[i + 1]}, tb = {c1[i], c1[i + 1]}; ta = ta - ms2; tb = tb - ms2; \
                  ta.x = __builtin_amdgcn_exp2f(ta.x); ta.y = __builtin_amdgcn_exp2f(ta.y); tb.x = __builtin_amdgcn_exp2f(tb.x); tb.y = __builtin_amdgcn_exp2f(tb.y); \
                  c0[i] = ta.x; c0[i + 1] = ta.y; c1[i] = tb.x; c1[i + 1] = tb.y; lsa = lsa + ta; lsb = lsb + tb; } \
              lsa = lsa + lsb; ls = lsa.x + lsa.y; \
            } else {        \
              _Pragma("unroll") for (int i = 0; i < 16; ++i) { c0[i] = __builtin_amdgcn_exp2f(c0[i] - ms); c1[i] = __builtin_amdgcn_exp2f(c1[i] - ms); ls += c0[i] + c1[i]; } } \
            l = l * alpha + ls; } while (0)
            const bool need_mask = MODE == 1 ? false : (MODE == 2 ? (k0 + 63 > qw) : ((k0 + 63 > qw) || (k0 < lo_w1)));
#define FA_FUSED(MASKED) do { FA_QKX(n0, Sn, 0); FA_QKX(n1, Sn, 32); FA_SOFTMAX(MASKED); \
            _Pragma("unroll") for (int hh_ = 0; hh_ < 2; ++hh_) { \
                __builtin_amdgcn_sched_group_barrier(0x100, NKS, 0); \
                _Pragma("unroll") for (int i = 0; i < NKS; ++i) { __builtin_amdgcn_sched_group_barrier(0x008, 1, 0); __builtin_amdgcn_sched_group_barrier(0x002, 120 / (2 * NKS), 0); } } } while (0)
            if (fused) { if (need_mask) FA_FUSED(true); else FA_FUSED(false); }
            else { if (need_mask) FA_SOFTMAX(true); else FA_SOFTMAX(false); }
#undef FA_FUSED
#undef FA_SOFTMAX
            if (!__all(alpha == 1.0f)) {
#pragma unroll
                for (int i = 0; i < 16; ++i) { o0[i] *= alpha; o1[i] *= alpha; } }
#pragma unroll
            for (int kb = 0; kb < 2; ++kb) {
                const f32x16& s = kb ? c1 : c0;
                u32x2 va[2][2], vb[2][2];
                const unsigned vaddr = (unsigned)(size_t)(Vb + (32 * kb) * 128 + vtoff);
#pragma unroll
                for (int sk = 0; sk < 2; ++sk) {
                    asm volatile("ds_read_b64_tr_b16 %0, %1" : "=&v"(va[sk][0]) : "v"(vaddr + (unsigned)(sk * 2048 + vx0)) : "memory");
                    asm volatile("ds_read_b64_tr_b16 %0, %1" : "=&v"(vb[sk][0]) : "v"(vaddr + (unsigned)(sk * 2048 + 1024 + vx0)) : "memory");
                    asm volatile("ds_read_b64_tr_b16 %0, %1" : "=&v"(va[sk][1]) : "v"(vaddr + (unsigned)(sk * 2048 + vx1)) : "memory");
                    asm volatile("ds_read_b64_tr_b16 %0, %1" : "=&v"(vb[sk][1]) : "v"(vaddr + (unsigned)(sk * 2048 + 1024 + vx1)) : "memory");
                }
                bf16x8 pf[2];
#pragma unroll
                for (int sk = 0; sk < 2; ++sk) { u32x4 pw; pw.x = pk2(s[8 * sk + 0], s[8 * sk + 1]); pw.y = pk2(s[8 * sk + 2], s[8 * sk + 3]); pw.z = pk2(s[8 * sk + 4], s[8 * sk + 5]); pw.w = pk2(s[8 * sk + 6], s[8 * sk + 7]); pf[sk] = __builtin_bit_cast(bf16x8, pw); }
                asm volatile("s_waitcnt lgkmcnt(0)" : "+v"(va[0][0]), "+v"(vb[0][0]), "+v"(va[0][1]), "+v"(vb[0][1]), "+v"(va[1][0]), "+v"(vb[1][0]), "+v"(va[1][1]), "+v"(vb[1][1]) :: "memory");
                __builtin_amdgcn_sched_barrier(0);
#pragma unroll
                for (int sk = 0; sk < 2; ++sk) {
                    const u32x4 v0w = {va[sk][0].x, va[sk][0].y, vb[sk][0].x, vb[sk][0].y}, v1w = {va[sk][1].x, va[sk][1].y, vb[sk][1].x, vb[sk][1].y};
                    o0 = __builtin_amdgcn_mfma_f32_32x32x16_bf16(__builtin_bit_cast(bf16x8, v0w), pf[sk], o0, 0, 0, 0);
                    o1 = __builtin_amdgcn_mfma_f32_32x32x16_bf16(__builtin_bit_cast(bf16x8, v1w), pf[sk], o1, 0, 0, 0);
                }
            }
        }
        if (qnext) FA_WAITBAR((AHEAD - 2) * NDMA + NKS); else FA_WAITBAR((AHEAD - 2) * NDMA);
        st_c = st_n; st_n = (st_n + 1 == NST) ? 0 : st_n + 1;
    };
    for (int kt = kt_lo;;) { fa_step(c0, c1, n0, n1, kt); if (++kt > kt_hi) break; fa_step(n0, n1, c0, c1, kt); if (++kt > kt_hi) break; }
#undef FA_PART
#undef FA_QK
#undef FA_QKH
#undef FA_QKX
#undef FA_KADDR
    const float lt = xhalf_sum(l);
    const float inv = 1.0f / lt;
    if (active) {
    bf16* op = P.O + (size_t)(seq0 + q) * P.o_pitch + o_col + 8 * h;
#pragma unroll
    for (int db = 0; db < 2; ++db) {
        const f32x16& o = db ? o1 : o0;
#pragma unroll
        for (int j = 0; j < 2; ++j) {
            u32x2 X, Y;
            X.x = pk2(o[8 * j] * inv, o[8 * j + 1] * inv); X.y = pk2(o[8 * j + 2] * inv, o[8 * j + 3] * inv);
            Y.x = pk2(o[8 * j + 4] * inv, o[8 * j + 5] * inv); Y.y = pk2(o[8 * j + 6] * inv, o[8 * j + 7] * inv);
            const auto a = __builtin_amdgcn_permlane32_swap(X.x, Y.x, false, false); const auto b = __builtin_amdgcn_permlane32_swap(X.y, Y.y, false, false);
            u32x4 w; w.x = a[0]; w.y = b[0]; w.z = a[1]; w.w = b[1];
            stg16<NT_ATT>(op + 32 * db + 16 * j, w);
        }
    }
    if (P.LSE && h == 0) P.LSE[(size_t)(seq0 + q) * P.lse_pitch + lse_col] = m + __builtin_amdgcn_logf(lt);
    }
    __builtin_amdgcn_sched_barrier(0);
    FA_WAITQ(4);
    }
    asm volatile("s_waitcnt vmcnt(0)" ::: "memory"); __builtin_amdgcn_s_barrier(); asm volatile("" ::: "memory");
#undef FA_ISSUE
#undef FA_LOADQ
#undef FA_WAITQ
#undef FA_WAITBAR
}
}

struct Args {
    const float* x; const int* pos; const float* w_in; const float* qn; const float* kvn; const float* w_uq; const float* w_ukv; const float* w_o;
    const float* ln1g; const float* ln1b; const float* rgw; const float* rgb; const float* rew; const float* reb;
    const float* wg; const float* wu; const float* wd; const float* ln2g; const float* ln2b;
    float* out; unsigned char* ws; int l_lo, l_hi, ph_lo, ph_hi, use_bar, pad;
};
typedef const __attribute__((address_space(4))) Args CArgs;
struct Ctx { LAS unsigned char* lds; int tid, lane, wave, G, c, vcu; unsigned char* ws; };

struct ColIdent { int off; __device__ __forceinline__ int operator()(int P) const { return off + P; } };
struct ColAdj { __device__ __forceinline__ int operator()(int P) const { const int p = P & 255; return (P & ~255) + 64 * ((p >> 5) & 3) + 32 * (p >> 7) + (p & 31); } };
__device__ __forceinline__ int map_rope32(int p) { return 16 * ((p >> 2) & 1) + 4 * (p >> 3) + (p & 3); }
__device__ __forceinline__ int map_head16(int p) { const int fq = p >> 3; return 16 * (fq >> 1) + 8 * ((p >> 2) & 1) + 4 * (fq & 1) + (p & 3); }
struct ColWin {
    __device__ __forceinline__ int operator()(int P) const {
        const int G = P >> 5, p = P & 31;
        if (G < 8) return 32 * G + p;
        if (G < 12) return 256 + 32 * (G - 8) + p;
        if (G == 12) return 384 + map_rope32(p);
        if (G == 13) return 1056 + p;
        if (G == 14) return 672 + map_head16(p);
        if (G == 15) return 704 + p;
        if (G < 24) { const int hh = (G - 16) >> 1; return 416 + 64 * hh + (((G - 16) & 1) ? 32 + p : map_head16(p)); }
        if (G < 26) return 736 + 32 * (G - 24) + p;
        if (G == 26) return p < 8 ? 1088 + p : -1;
        if (G < 32) return -1;
        if (G < 40) return 800 + 32 * (G - 32) + p;
        if (G < 64) { const int j = G - 40; return 1096 + 64 * (j >> 1) + ((j & 1) ? 32 + p : map_head16(p)); }
        if (G < 88) { const int j = G - 64; return 1096 + 768 + 64 * (j >> 1) + ((j & 1) ? 32 + p : map_head16(p)); }
        return 1096 + 1536 + 32 * (G - 88) + p;
    }
};
struct ColUq {
    __device__ __forceinline__ int operator()(int P) const { const int G = P >> 5, p = P & 31; return 32 * G + ((G % 3 == 2) ? map_rope32(p) : p); }
};
template <class ColFn>
__device__ __forceinline__ void transpose_item(const float* W, int ldw, int kvalid, bf16* WT, int ldt, int k0, int P0, const ColFn& cf, const float* rowscale, LAS float* scr, int lane) {
    const int c = lane & 31, col = cf(P0 + c);
#pragma unroll 8
    for (int i = 0; i < 32; ++i) { const int kk = 2 * i + (lane >> 5), k = k0 + kk; float v = 0.f;
        if (col >= 0 && k < kvalid) { v = W[(size_t)k * ldw + col]; if (rowscale) v *= rowscale[k]; }
        scr[kk * 33 + c] = v; }
    asm volatile("s_waitcnt lgkmcnt(0)" ::: "memory");
    const int cc = lane & 7;
#pragma unroll
    for (int j = 0; j < 4; ++j) { const int n = (lane >> 3) + 8 * j; const LAS float* s = scr + (8 * cc) * 33 + n;
        u32x4 o; o.x = pk2(s[0 * 33], s[1 * 33]); o.y = pk2(s[2 * 33], s[3 * 33]); o.z = pk2(s[4 * 33], s[5 * 33]); o.w = pk2(s[6 * 33], s[7 * 33]);
        *(u32x4*)(WT + (size_t)(P0 + n) * ldt + k0 + 8 * cc) = o; }
    asm volatile("s_waitcnt lgkmcnt(0)" ::: "memory");
}
__device__ __forceinline__ void prologue(const Ctx& X, const CArgs* ap) {
    struct { const float* x; const float *w_in, *qn, *kvn, *w_uq, *w_ukv, *w_o, *rgw, *rew; } a = {ap->x, ap->w_in, ap->qn, ap->kvn, ap->w_uq, ap->w_ukv, ap->w_o, ap->rgw, ap->rew};
    LAS float* scr = (LAS float*)(X.lds + X.wave * 16384);
    const int gw = X.vcu * 8 + X.wave, NGW = X.G * 8;
    constexpr int I_WIN = 16 * 112, I_UQ = 4 * 24, I_UKV = 4 * 32, I_WO = 16 * 32, I_L = I_WIN + I_UQ + I_UKV + I_WO;
    for (int it = gw; it < DEPTH * I_L; it += NGW) {
        const int l = it / I_L; int r = it % I_L;
        if (r < I_WIN) { transpose_item(a.w_in + (size_t)l * DM * IN_COLS, IN_COLS, DM, (bf16*)(X.ws + WS_WIN) + (size_t)l * NIN * DM, DM, 64 * (r / 112), 32 * (r % 112), ColWin{}, nullptr, scr, X.lane); continue; }
        r -= I_WIN;
        if (r < I_UQ) { transpose_item(a.w_uq + (size_t)l * 256 * 768, 768, 256, (bf16*)(X.ws + WS_WUQ) + (size_t)l * 768 * 256, 256, 64 * (r / 24), 32 * (r % 24), ColUq{}, a.qn + l * 256, scr, X.lane); continue; }
        r -= I_UQ;
        if (r < I_UKV) { transpose_item(a.w_ukv + (size_t)l * 128 * 1024, 1024, 128, (bf16*)(X.ws + WS_WUKV) + (size_t)l * 1024 * 256, 256, 64 * (r / 32), 32 * (r % 32), ColAdj{}, a.kvn + l * 128, scr, X.lane); continue; }
        r -= I_UKV;
        transpose_item(a.w_o + (size_t)l * DM * DM, DM, DM, (bf16*)(X.ws + WS_WO) + (size_t)l * DM * DM, DM, 64 * (r / 32), 32 * (r % 32), ColAdj{}, nullptr, scr, X.lane);
    }
    const size_t gt = (size_t)X.vcu * 512 + X.tid, NGT = (size_t)X.G * 512;
    { float* rgt = (float*)(X.ws + WS_RGT); float* ret = (float*)(X.ws + WS_RET);
      for (size_t i = gt; i < (size_t)DEPTH * 4 * DM; i += NGT) { const int l = (int)(i / (4 * DM)), g = (int)(i / DM) & 3, k = (int)(i % DM); rgt[i] = a.rgw[((size_t)l * DM + k) * 4 + g]; }
      for (size_t i = gt; i < (size_t)DEPTH * 32 * DM; i += NGT) { const int l = (int)(i / (32 * DM)), ge = (int)(i / DM) & 31, k = (int)(i % DM); ret[i] = a.rew[(((size_t)l * 4 + (ge >> 3)) * DM + k) * 8 + (ge & 7)]; } }
    { u32x4* z = (u32x4*)(X.ws + WS_T1); for (size_t i = gt; i < (size_t)NT * 256 * 2 / 16; i += NGT) z[i] = (u32x4){0u, 0u, 0u, 0u}; }
    { const f32x4* xs = (const f32x4*)a.x; u32x2* xb = (u32x2*)((unsigned char*)ap->out + XR_OFF);
      for (size_t i = gt; i < (size_t)NT * DM / 4; i += NGT) { const f32x4 v = xs[i]; u32x2 w; w.x = pk2(v[0], v[1]); w.y = pk2(v[2], v[3]); xb[i] = w; } }
}
__device__ __forceinline__ void convert_experts(const Ctx& X, const CArgs* ap, int l) {
    struct { const float *wg, *wu, *wd; } a = {ap->wg, ap->wu, ap->wd};
    LAS float* scr = (LAS float*)(X.lds + X.wave * 16384);
    const int gw = X.vcu * 8 + X.wave, NGW = X.G * 8;
    constexpr int I_GU = 32 * 16 * 16, I_D = 32 * 4 * 32;
    for (int it = gw; it < I_GU + I_D; it += NGW) {
        if (it < I_GU) { const int e = it >> 8, r = it & 255, G32 = r >> 4, kb = r & 15; const int pn = G32 >> 3, r0 = (G32 & 7) * 32; const bool up = r0 >= 128;
            const float* W = (up ? a.wu : a.wg) + ((size_t)l * NEXP + e) * DM * FH;
            transpose_item(W, FH, DM, (bf16*)(X.ws + WS_WGU) + (size_t)e * 512 * DM, DM, 64 * kb, 32 * G32, ColIdent{128 * pn + (r0 & 127) - 32 * G32}, nullptr, scr, X.lane);
        } else { const int r = it - I_GU, e = r >> 7, q = r & 127, kb = q >> 5, pg = q & 31;
            transpose_item(a.wd + ((size_t)l * NEXP + e) * FH * DM, DM, FH, (bf16*)(X.ws + WS_WD) + (size_t)e * DM * FH, FH, 64 * kb, 32 * pg, ColAdj{}, nullptr, scr, X.lane); }
    }
}

struct InProjDesc {
    unsigned char* ws;
    __device__ __forceinline__ pg8::GroupDesc operator()(int pn, int bj, int wc) const {
        using namespace pg8; const int G = 8 * pn + 4 * bj + wc; GroupDesc d; d.kind = GK_PLAIN; d.dst = nullptr; d.pitch = 256; d.col = 0; d.scale = 1.f; d.perm = 0; d.ssq = nullptr; d.ssq_n = 0; d.ssq_i = 0;
        if (G < 8) { d.dst = (bf16*)(ws + WS_CQ); d.col = 32 * G; d.ssq = (float*)(ws + WS_SSQ); d.ssq_n = 8; d.ssq_i = G; }
        else if (G < 12) { d.dst = (bf16*)(ws + WS_T1); d.col = 32 * (G - 8); d.ssq = (float*)(ws + WS_SSQ) + (size_t)NT * 8; d.ssq_n = 4; d.ssq_i = G - 8; }
        else if (G == 12) { d.kind = GK_ROPE32; d.dst = (bf16*)(ws + WS_KPE); d.pitch = 32; d.col = 0; }
        else if (G == 13) { d.kind = GK_IDX8; d.dst = (bf16*)(ws + WS_KI); d.pitch = 32; d.col = 0; }
        else if (G == 14) { d.kind = GK_HEAD16; d.dst = (bf16*)(ws + WS_T1); d.col = 192; }
        else if (G == 15) { d.dst = (bf16*)(ws + WS_T1); d.col = 224; }
        else if (G < 24) { d.kind = ((G - 16) & 1) ? GK_PLAIN : GK_HEAD16; d.dst = (bf16*)(ws + WS_BQ); d.col = 32 * (G - 16); d.scale = QSC64; }
        else if (G < 26) { d.dst = (bf16*)(ws + WS_BV); d.pitch = 64; d.col = 32 * (G - 24); }
        else if (G == 26) { d.kind = GK_WI; d.dst = (bf16*)(ws + WS_WI); }
        else if (G < 32) { d.kind = GK_SKIP; }
        else if (G < 40) { d.kind = GK_IDX8; d.dst = (bf16*)(ws + WS_BQI); d.col = 32 * (G - 32); }
        else if (G < 64) { const int j = G - 40, cfg = j >> 3; d.kind = (j & 1) ? GK_PLAIN : GK_HEAD16; d.dst = (bf16*)(ws + WS_DQ) + (size_t)cfg * NT * 256; d.col = 32 * (j & 7); d.scale = QSC64; d.perm = cfg == 0 ? 0 : (cfg == 1 ? 4 : 16); }
        else if (G < 88) { const int j = G - 64, cfg = j >> 3; d.kind = (j & 1) ? GK_PLAIN : GK_HEAD16; d.dst = (bf16*)(ws + WS_DK) + (size_t)cfg * NT * 256; d.col = 32 * (j & 7); d.perm = cfg == 0 ? 0 : (cfg == 1 ? 4 : 16); }
        else { const int j = G - 88, cfg = j >> 3; d.dst = (bf16*)(ws + WS_DV) + (size_t)cfg * NT * 256; d.col = 32 * (j & 7); d.perm = cfg == 0 ? 0 : (cfg == 1 ? 4 : 16); }
        return d;
    }
};
struct UqDesc {
    unsigned char* ws;
    __device__ __forceinline__ pg8::GroupDesc operator()(int pn, int bj, int wc) const {
        using namespace pg8; const int G = 8 * pn + 4 * bj + wc; GroupDesc d; d.kind = (G % 3 == 2) ? GK_ROPE32 : GK_PLAIN; d.dst = (bf16*)(ws + WS_QA); d.pitch = 768; d.col = 32 * G; d.scale = QSC96; d.perm = 0; d.ssq = nullptr; d.ssq_n = 0; d.ssq_i = 0;
        return d;
    }
};

__device__ __forceinline__ unsigned f16key(float v) { const _Float16 hf = (_Float16)v; const unsigned u = (unsigned)__builtin_bit_cast(unsigned short, hf); return (u ^ ((unsigned)__builtin_amdgcn_sbfe((int)u, 15, 1) | 0x8000u)) & 0xffffu; }
__device__ __forceinline__ unsigned pk_cnt(unsigned acc, unsigned kp2, unsigned mid2, unsigned one2) {
    unsigned t;
    asm("v_pk_sub_u16 %0, %2, %3 clamp\n\tv_pk_min_u16 %0, %0, %4\n\tv_pk_add_u16 %1, %1, %0" : "=&v"(t), "+v"(acc) : "v"(kp2), "s"(mid2), "s"(one2));
    return acc;
}
__device__ __forceinline__ int count_gt(const unsigned (&kp)[16], unsigned mid) {
    const unsigned m2 = __builtin_amdgcn_readfirstlane(mid | (mid << 16)), one2 = __builtin_amdgcn_readfirstlane(0x00010001u);
    unsigned a0 = 0u, a1 = 0u;
#pragma unroll
    for (int i = 0; i < 16; i += 2) { a0 = pk_cnt(a0, kp[i], m2, one2); a1 = pk_cnt(a1, kp[i + 1], m2, one2); }
    unsigned aw; asm("v_pk_add_u16 %0, %1, %2" : "=v"(aw) : "v"(a0), "v"(a1));
    const unsigned c = (aw & 0xffffu) + (aw >> 16);
    int tot = 0;
#pragma unroll
    for (int b = 0; b < 6; ++b) tot += __builtin_popcountll(__ballot((c >> b) & 1u)) << b;
    return tot;
}
__device__ __forceinline__ int wave_scan_incl(int v) {
    v += __builtin_amdgcn_update_dpp(0, v, 0x111, 0xf, 0xf, false); v += __builtin_amdgcn_update_dpp(0, v, 0x112, 0xf, 0xf, false);
    v += __builtin_amdgcn_update_dpp(0, v, 0x114, 0xf, 0xf, false); v += __builtin_amdgcn_update_dpp(0, v, 0x118, 0xf, 0xf, false);
    v += __builtin_amdgcn_update_dpp(0, v, 0x142, 0xa, 0xf, false); v += __builtin_amdgcn_update_dpp(0, v, 0x143, 0xc, 0xf, false);
    return v;
}
__device__ __forceinline__ void radix_pick(const LAS unsigned* hist, int lane, int target, int& B, int& above, int& inbin) {
    const u32x2 hw = *(const LAS u32x2*)(hist + 2 * lane);
    const int c0 = (int)(hw.x & 0xffffu), c1 = (int)(hw.x >> 16), c2 = (int)(hw.y & 0xffffu), c3 = (int)(hw.y >> 16);
    const int tl = (c0 + c1) + (c2 + c3);
    const int pre = wave_scan_incl(tl);
    const int suf = __builtin_amdgcn_readlane(pre, 63) - pre + tl;
    const unsigned long long reach = __ballot(suf >= target);
    const int ls = 63 - __builtin_clzll(reach | 1ull);
    int a = suf - tl, b = 4 * lane + 3, ib = c3;
    if (a + c3 < target) { a += c3; b = 4 * lane + 2; ib = c2; if (a + c2 < target) { a += c2; b = 4 * lane + 1; ib = c1; if (a + c1 < target) { a += c1; b = 4 * lane; ib = c0; } } }
    B = __builtin_amdgcn_readlane(b, ls); above = __builtin_amdgcn_readlane(a, ls); inbin = __builtin_amdgcn_readlane(ib, ls);
}
__device__ __forceinline__ float relu_i(float x) { const int i = __builtin_bit_cast(int, x); return __builtin_bit_cast(float, i > 0 ? i : 0); }
__device__ __forceinline__ void dsa_index_unit(const Ctx& X, int b, int q0) {
    const int lane = X.lane, r = lane & 31, h = lane >> 5; const size_t seq0 = (size_t)b * SEQ; const int t0 = q0 + 4 * X.wave;
    const bf16* BQI = (const bf16*)(X.ws + WS_BQI); const bf16* KI = (const bf16*)(X.ws + WS_KI); const float* WI = (const float*)(X.ws + WS_WI);
    LAS unsigned short* rows = (LAS unsigned short*)(X.lds + X.wave * 16384);
    LAS unsigned char* kbuf = X.lds + LDS_X_OFF;
    const bf16* ap = BQI + (seq0 + t0 + (r >> 3)) * 256 + 32 * (r & 7) + 16 * h;
    const bf16x8 a0 = *(const bf16x8*)ap, a1 = *(const bf16x8*)(ap + 8);
    f32x2 wq[4][2];
#pragma unroll
    for (int j = 0; j < 4; ++j) { const f32x4 w = *(const f32x4*)(WI + (seq0 + t0 + j) * 8 + 4 * h);
        wq[j][0] = (f32x2){w[0] * IDX_SCALE, w[1] * IDX_SCALE}; wq[j][1] = (f32x2){w[2] * IDX_SCALE, w[3] * IDX_SCALE}; }
    const int nch = ((q0 + 31) >> 7) + 1;
    const int skey = X.tid >> 2, spc = X.tid & 3;
    const bf16* sp = KI + (seq0 + skey) * 32 + 8 * spc;
    const int sdst = skey * 64 + ((spc ^ ((skey >> 2) & 3)) << 4);
    u32x4 stg0 = *(const u32x4*)sp, stg1 = stg0, stg2 = stg0, stg3 = stg0;
    if (1 < nch) stg1 = *(const u32x4*)(sp + (size_t)1 * 128 * 32);
    if (2 < nch) stg2 = *(const u32x4*)(sp + (size_t)2 * 128 * 32);
    if (3 < nch) stg3 = *(const u32x4*)(sp + (size_t)3 * 128 * 32);
    *(LAS u32x4*)(kbuf + sdst) = stg0;
    __syncthreads();
#define DSA_STEP(J, RCUR, RNEXT) { const int c = c0 + (J); \
        if (c + 4 < nch) RCUR = *(const u32x4*)(sp + (size_t)(c + 4) * 128 * 32); \
        const LAS unsigned char* kb = kbuf + (c & 1) * 8192; \
        _Pragma("unroll") for (int tq = 0; tq < 4; ++tq) { \
            const int key = 32 * tq + r, sw = (key >> 2) & 3; \
            const bf16x8 b0 = *(const LAS bf16x8*)(kb + key * 64 + (((2 * h) ^ sw) << 4)), b1 = *(const LAS bf16x8*)(kb + key * 64 + (((2 * h + 1) ^ sw) << 4)); \
            f32x16 acc; \
            _Pragma("unroll") for (int i = 0; i < 16; ++i) acc[i] = 0.f; \
            acc = __builtin_amdgcn_mfma_f32_32x32x16_bf16(a0, b0, acc, 0, 0, 0); \
            acc = __builtin_amdgcn_mfma_f32_32x32x16_bf16(a1, b1, acc, 0, 0, 0); \
            float p[4]; \
            _Pragma("unroll") for (int j = 0; j < 4; ++j) {            \
                const f32x2 ra = {relu_i(acc[4 * j]), relu_i(acc[4 * j + 1])}, rb = {relu_i(acc[4 * j + 2]), relu_i(acc[4 * j + 3])}; \
                const f32x2 pp = __builtin_elementwise_fma(rb, wq[j][1], ra * wq[j][0]); \
                p[j] = pp.x + pp.y; } \
            const auto s01 = __builtin_amdgcn_permlane32_swap(__float_as_uint(p[0]), __float_as_uint(p[1]), false, false); \
            const auto s23 = __builtin_amdgcn_permlane32_swap(__float_as_uint(p[2]), __float_as_uint(p[3]), false, false); \
            const float va = __uint_as_float(s01[0]) + __uint_as_float(s01[1]), vb = __uint_as_float(s23[0]) + __uint_as_float(s23[1]); \
            const int hw = 128 * c + 32 * tq + r;                                      \
            rows[h * 2048 + hw] = (unsigned short)f16key(va); \
            rows[(2 + h) * 2048 + hw] = (unsigned short)f16key(vb); \
        } \
        if (c + 1 < nch) *(LAS u32x4*)(kbuf + ((c + 1) & 1) * 8192 + sdst) = RNEXT; \
        __syncthreads(); }
#ifndef REP_SCORE
#define REP_SCORE 1
#endif
#ifndef REP_SEL
#define REP_SEL 1
#endif
    for (int rsc = 0; rsc < REP_SCORE; ++rsc) {
    if (rsc > 0) { stg0 = *(const u32x4*)sp; stg1 = stg0; stg2 = stg0; stg3 = stg0; if (1 < nch) stg1 = *(const u32x4*)(sp + (size_t)1 * 128 * 32); if (2 < nch) stg2 = *(const u32x4*)(sp + (size_t)2 * 128 * 32); if (3 < nch) stg3 = *(const u32x4*)(sp + (size_t)3 * 128 * 32); *(LAS u32x4*)(kbuf + sdst) = stg0; __syncthreads(); }
    for (int c0 = 0; c0 < nch; c0 += 4) {
        DSA_STEP(0, stg0, stg1)
        if (c0 + 1 >= nch) break;
        DSA_STEP(1, stg1, stg2)
        if (c0 + 2 >= nch) break;
        DSA_STEP(2, stg2, stg3)
        if (c0 + 3 >= nch) break;
        DSA_STEP(3, stg3, stg0)
    }
    }
#undef DSA_STEP
    unsigned* BMp = (unsigned*)(X.ws + WS_BM);
#ifndef REP_BIS
#define REP_BIS 1
#endif
#ifndef REP_EMIT
#define REP_EMIT 1
#endif
    for (int rsl = 0; rsl < REP_SEL; ++rsl)
    for (int j = 0; j < 4; ++j) {
        const int t = t0 + j;
        const LAS u32x4* rw = (const LAS u32x4*)(rows + j * 2048) + 4 * lane;
        unsigned kp[16];
#pragma unroll
        for (int v4 = 0; v4 < 4; ++v4) { const u32x4 d = rw[v4]; kp[4 * v4] = d.x; kp[4 * v4 + 1] = d.y; kp[4 * v4 + 2] = d.z; kp[4 * v4 + 3] = d.w; }
        const int nv = t + 1 - 32 * lane;
#pragma unroll
        for (int d = 0; d < 16; ++d) kp[d] &= ((2 * d < nv) ? 0xffffu : 0u) | ((2 * d + 1 < nv) ? 0xffff0000u : 0u);
        unsigned thr = 0u; int need = 0;
        for (int rb_ = 0; rb_ < REP_BIS; ++rb_)
        if (t + 1 > 256) {
            LAS unsigned* hist = (LAS unsigned*)(X.lds + LDS_HIST_OFF + X.wave * 512);
            *(LAS u32x2*)(hist + 2 * lane) = (u32x2){0u, 0u};
#pragma unroll
            for (int d = 0; d < 16; ++d) { const unsigned klo = kp[d] & 0xffffu, khi = kp[d] >> 16;
                if (klo) __hip_atomic_fetch_add(hist + (klo >> 9), (klo & 0x100u) ? 0x10000u : 1u, __ATOMIC_RELAXED, __HIP_MEMORY_SCOPE_WORKGROUP);
                if (khi) __hip_atomic_fetch_add(hist + (khi >> 9), (khi & 0x100u) ? 0x10000u : 1u, __ATOMIC_RELAXED, __HIP_MEMORY_SCOPE_WORKGROUP); }
            int B1, above1, in1; radix_pick(hist, lane, 256, B1, above1, in1);
            *(LAS u32x2*)(hist + 2 * lane) = (u32x2){0u, 0u};
#pragma unroll
            for (int d = 0; d < 16; ++d) { const unsigned klo = kp[d] & 0xffffu, khi = kp[d] >> 16;
                if ((int)(klo >> 8) == B1) __hip_atomic_fetch_add(hist + ((klo & 0xffu) >> 1), (klo & 1u) ? 0x10000u : 1u, __ATOMIC_RELAXED, __HIP_MEMORY_SCOPE_WORKGROUP);
                if ((int)(khi >> 8) == B1) __hip_atomic_fetch_add(hist + ((khi & 0xffu) >> 1), (khi & 1u) ? 0x10000u : 1u, __ATOMIC_RELAXED, __HIP_MEMORY_SCOPE_WORKGROUP); }
            int B2, above2, in2; radix_pick(hist, lane, 256 - above1, B2, above2, in2);
            const unsigned tk = ((unsigned)B1 << 8) | (unsigned)B2;
            const int rest = 256 - (above1 + above2);
            if (rest >= in2) { thr = tk - 1u; need = 0; } else { thr = tk; need = rest; }
        }
        unsigned word = 0u, eqw = 0u;
        const unsigned thr2 = __builtin_amdgcn_readfirstlane(thr | (thr << 16)), one2 = __builtin_amdgcn_readfirstlane(0x00010001u);
#pragma unroll
        for (int d = 0; d < 16; ++d) { unsigned g;
            asm("v_pk_sub_u16 %0, %1, %2 clamp\n\tv_pk_min_u16 %0, %0, %3" : "=&v"(g) : "v"(kp[d]), "s"(thr2), "s"(one2));
            word |= ((g | (g >> 15)) & 3u) << (2 * d); }
        if (need > 0) {
#pragma unroll
            for (int d = 0; d < 16; ++d) { unsigned g; const unsigned x = kp[d] ^ thr2;
                asm("v_pk_min_u16 %0, %1, %2" : "=v"(g) : "v"(x), "s"(one2));
                eqw |= ((~(g | (g >> 15))) & 3u) << (2 * d); }
            if (thr == 0u) eqw = 0u;
            const int ne = __builtin_popcount(eqw); const int inc = wave_scan_incl(ne);
            int take = need - (inc - ne); take = take < 0 ? 0 : (take > ne ? ne : take);
            while (__any(take > 0)) { if (take > 0) { const unsigned lowbit = eqw & (0u - eqw); word |= lowbit; eqw ^= lowbit; --take; } }
        }
        BMp[(seq0 + t) * 64 + lane] = word;
    }
}

__device__ __forceinline__ void dil_combine(const Ctx& X) {
    const bf16* OD = (const bf16*)(X.ws + WS_OD); const float* LS = (const float*)(X.ws + WS_LSE); bf16* O = (bf16*)(X.ws + WS_XB);
    const int gw = X.vcu * 8 + X.wave, NGW = X.G * 8, lane = X.lane, hh = lane >> 4;
    for (int t = gw; t < NT; t += NGW) {
        const int b = t >> 11, s = t & 2047;
        const int r0 = t, r1 = (b << 11) + ((s & 3) << 9) + (s >> 2), r2 = (b << 11) + ((s & 15) << 7) + (s >> 4);
        const float L0 = LS[(size_t)r0 * 4 + hh], L1 = LS[((size_t)NT + r1) * 4 + hh], L2 = LS[((size_t)2 * NT + r2) * 4 + hh];
        const float mx = fmaxf(L0, fmaxf(L1, L2));
        float w0 = __builtin_amdgcn_exp2f(L0 - mx), w1 = __builtin_amdgcn_exp2f(L1 - mx), w2 = __builtin_amdgcn_exp2f(L2 - mx);
        const float inv = 1.0f / (w0 + w1 + w2); w0 *= inv; w1 *= inv; w2 *= inv;
        const u32x2 a = *(const u32x2*)(OD + (size_t)r0 * 256 + 4 * lane), bq = *(const u32x2*)(OD + ((size_t)NT + r1) * 256 + 4 * lane), cq = *(const u32x2*)(OD + ((size_t)2 * NT + r2) * 256 + 4 * lane);
        u32x2 o;
        o.x = pk2(w0 * bflo(a.x) + w1 * bflo(bq.x) + w2 * bflo(cq.x), w0 * bfhi(a.x) + w1 * bfhi(bq.x) + w2 * bfhi(cq.x));
        o.y = pk2(w0 * bflo(a.y) + w1 * bflo(bq.y) + w2 * bflo(cq.y), w0 * bfhi(a.y) + w1 * bfhi(bq.y) + w2 * bfhi(cq.y));
        stg8<NT_ATT>(O + (size_t)t * DM + 768 + 4 * lane, o);
    }
}

__device__ __forceinline__ void ln1_router(const Ctx& X, const CArgs* ap, int l, bool first, bool dummy = false) {
    struct { const float *ln1g, *ln1b, *rgb, *reb; } a = {ap->ln1g, ap->ln1b, ap->rgb, ap->reb}; (void)first;
    const bf16* xin = (const bf16*)((const unsigned char*)ap->out + XR_OFF);
    const bool keep_copy = (l == DEPTH - 1) && !dummy; bf16* XC = (bf16*)(X.ws + WS_KVA);
    const int lane = X.lane; const bf16* MIX = (const bf16*)(X.ws + WS_MIX); bf16* X1B = (bf16*)(X.ws + (dummy ? WS_Y : WS_XB));
    LAS float* reT = (LAS float*)X.lds;
    LAS float* rgT = (LAS float*)(X.lds + LDS_X_OFF);
    LAS int* hist = (LAS int*)(X.lds + LDSCTL_OFF + 256);
    { const u32x4* s1 = (const u32x4*)(X.ws + WS_RET + (size_t)l * 32 * DM * 4); for (int i = X.tid; i < 32 * DM / 4; i += 512) ((LAS u32x4*)reT)[i] = s1[i];
      const u32x4* s2 = (const u32x4*)(X.ws + WS_RGT + (size_t)l * 4 * DM * 4); for (int i = X.tid; i < 4 * DM / 4; i += 512) ((LAS u32x4*)rgT)[i] = s2[i]; }
    f32x4 g[4], bb[4];
#pragma unroll
    for (int j = 0; j < 4; ++j) { g[j] = *(const f32x4*)(a.ln1g + l * DM + 4 * lane + 256 * j); bb[j] = *(const f32x4*)(a.ln1b + l * DM + 4 * lane + 256 * j); }
    const float* rgb = a.rgb + l * 4; const float* reb = a.reb + l * 32;
    for (int rb = X.c; rb < NT / 256; rb += X.G) {
        if (X.tid < 32) hist[X.tid] = 0;
        __syncthreads();
        u32x2 xa[4], xb[4]; u32x2 ma[4], mb[4];
        { const int t = rb * 256 + X.wave * 32;
#pragma unroll
          for (int j = 0; j < 4; ++j) { xa[j] = *(const u32x2*)(xin + (size_t)t * DM + 4 * lane + 256 * j); ma[j] = *(const u32x2*)(MIX + (size_t)t * DM + 4 * lane + 256 * j); }
#pragma unroll
          for (int j = 0; j < 4; ++j) { xb[j] = *(const u32x2*)(xin + (size_t)(t + 1) * DM + 4 * lane + 256 * j); mb[j] = *(const u32x2*)(MIX + (size_t)(t + 1) * DM + 4 * lane + 256 * j); } }
        auto row = [&](u32x2 (&xn)[4], u32x2 (&mn)[4], const int i) __attribute__((always_inline)) {
            const int t = rb * 256 + X.wave * 32 + i;
            f32x4 v[4]; float s = 0.f;
#pragma unroll
            for (int j = 0; j < 4; ++j) { const u32x2 xw = xn[j]; const u32x2 mw = mn[j];
                if (keep_copy) *(u32x2*)(XC + (size_t)t * DM + 4 * lane + 256 * j) = xw;
                v[j][0] = ALPHA * bflo(xw.x) + bflo(mw.x); v[j][1] = ALPHA * bfhi(xw.x) + bfhi(mw.x); v[j][2] = ALPHA * bflo(xw.y) + bflo(mw.y); v[j][3] = ALPHA * bfhi(xw.y) + bfhi(mw.y);
                s += (v[j][0] + v[j][1]) + (v[j][2] + v[j][3]); }
            if (i + 2 < 32) {
#pragma unroll
                for (int j = 0; j < 4; ++j) { xn[j] = *(const u32x2*)(xin + (size_t)(t + 2) * DM + 4 * lane + 256 * j); mn[j] = *(const u32x2*)(MIX + (size_t)(t + 2) * DM + 4 * lane + 256 * j); } }
            const float mean = wave_sum(s) * (1.f / DM); float s2 = 0.f;
#pragma unroll
            for (int j = 0; j < 4; ++j) { v[j] = v[j] - mean; s2 += (v[j][0] * v[j][0] + v[j][1] * v[j][1]) + (v[j][2] * v[j][2] + v[j][3] * v[j][3]); }
            const float rstd = 1.0f / sqrtf(wave_sum(s2) * (1.f / DM) + 1e-5f);
#pragma unroll
            for (int j = 0; j < 4; ++j) { v[j] = v[j] * rstd * g[j] + bb[j];
                u32x2 w; w.x = pk2(v[j][0], v[j][1]); w.y = pk2(v[j][2], v[j][3]); stg8<NT_LN>(X1B + (size_t)t * DM + 4 * lane + 256 * j, w); }
            float lg[4];
#pragma unroll
            for (int gi = 0; gi < 4; ++gi) { f32x2 p2 = {0.f, 0.f};
#pragma unroll
                for (int j = 0; j < 4; ++j) { const f32x4 w = *(const LAS f32x4*)(rgT + gi * DM + 4 * lane + 256 * j);
                    p2 = __builtin_elementwise_fma((f32x2){v[j][0], v[j][1]}, (f32x2){w[0], w[1]}, p2); p2 = __builtin_elementwise_fma((f32x2){v[j][2], v[j][3]}, (f32x2){w[2], w[3]}, p2); }
                lg[gi] = wave_sum(p2.x + p2.y) + rgb[gi]; }
            int gs = 0; float gm = lg[0];
#pragma unroll
            for (int gi = 1; gi < 4; ++gi) if (lg[gi] > gm) { gm = lg[gi]; gs = gi; }
            float den = 0.f;
#pragma unroll
            for (int gi = 0; gi < 4; ++gi) den += __expf(lg[gi] - gm);
            const float ptop = __builtin_amdgcn_rcpf(den);
            gs = __builtin_amdgcn_readfirstlane(gs);
            float le[8];
#pragma unroll
            for (int e = 0; e < 8; ++e) { f32x2 p2 = {0.f, 0.f};
#pragma unroll
                for (int j = 0; j < 4; ++j) { const f32x4 w = *(const LAS f32x4*)(reT + (gs * 8 + e) * DM + 4 * lane + 256 * j);
                    p2 = __builtin_elementwise_fma((f32x2){v[j][0], v[j][1]}, (f32x2){w[0], w[1]}, p2); p2 = __builtin_elementwise_fma((f32x2){v[j][2], v[j][3]}, (f32x2){w[2], w[3]}, p2); }
                le[e] = wave_sum(p2.x + p2.y) + reb[gs * 8 + e]; }
            int e1 = 0; float v1 = le[0];
#pragma unroll
            for (int e = 1; e < 8; ++e) if (le[e] > v1) { v1 = le[e]; e1 = e; }
            int e2 = -1; float v2 = -INFINITY;
#pragma unroll
            for (int e = 0; e < 8; ++e) if (e != e1 && le[e] > v2) { v2 = le[e]; e2 = e; }
            const float wa = __builtin_amdgcn_rcpf(1.0f + __expf(v2 - v1)), wb = 1.0f - wa;
            if (lane == 0) { u32x4 ro; ro.x = (unsigned)(gs * 8 + e1); ro.y = (unsigned)(gs * 8 + e2); ro.z = __builtin_bit_cast(unsigned, ptop * wa); ro.w = __builtin_bit_cast(unsigned, ptop * wb);
                *(u32x4*)(X.ws + WS_ROUTE + (size_t)t * 16) = ro;
                __hip_atomic_fetch_add(hist + gs * 8 + e1, 1, __ATOMIC_RELAXED, __HIP_MEMORY_SCOPE_WORKGROUP); __hip_atomic_fetch_add(hist + gs * 8 + e2, 1, __ATOMIC_RELAXED, __HIP_MEMORY_SCOPE_WORKGROUP); }
        };
#pragma unroll 1
        for (int i = 0; i < 32; i += 2) { row(xa, ma, i); row(xb, mb, i + 1); }
        __syncthreads();
        if (X.tid < 32) ((int*)(X.ws + WS_HIST))[rb * 32 + X.tid] = hist[X.tid];
        __syncthreads();
    }
}

__device__ __forceinline__ void moe_dispatch(const Ctx& X) {
    LAS int* cnt = (LAS int*)(X.lds);
    LAS int* pre = cnt + 32;
    LAS int* ebase = cnt + 64;
    LAS int* wcnt = cnt + 128;
    const int* HIST = (const int*)(X.ws + WS_HIST); int* STOK = (int*)(X.ws + WS_STOK); float* SW = (float*)(X.ws + WS_SW); int* TSLOT = (int*)(X.ws + WS_TSLOT); int* TILEE = (int*)(X.ws + WS_TILEE);
    for (int rb = X.c; rb < NT / 256; rb += X.G) {
        if (X.tid < 64) cnt[X.tid] = 0;
        __syncthreads();
        { const int e = X.tid & 31, part = X.tid >> 5; int sa = 0, sp = 0;
          for (int q = 0; q < 16; ++q) { const int b2 = part * 16 + q; const int hv = HIST[b2 * 32 + e]; sa += hv; if (b2 < rb) sp += hv; }
          __hip_atomic_fetch_add(cnt + e, sa, __ATOMIC_RELAXED, __HIP_MEMORY_SCOPE_WORKGROUP); __hip_atomic_fetch_add(pre + e, sp, __ATOMIC_RELAXED, __HIP_MEMORY_SCOPE_WORKGROUP); }
        __syncthreads();
        if (X.tid < 64) { const int n = X.tid < 32 ? cnt[X.tid] : 0; const int pad = (n + 255) & ~255; int inc = pad;
#pragma unroll
            for (int o = 1; o < 32; o <<= 1) { const int u = __shfl_up(inc, o); if ((X.tid & 63) >= o) inc += u; }
            if (X.tid < 32) { ebase[X.tid] = inc - pad; if (X.tid == 31) ebase[32] = inc; } }
        __syncthreads();
        const int tl = X.tid >> 1, kk = X.tid & 1, t = rb * 256 + tl;
        const u32x4 ro = *(const u32x4*)(X.ws + WS_ROUTE + (size_t)t * 16);
        const int e = (int)(kk ? ro.y : ro.x); const float w = __builtin_bit_cast(float, kk ? ro.w : ro.z);
        int rank = 0;
        for (int ee = 0; ee < 32; ++ee) { const unsigned long long mm = __ballot(e == ee);
            if (e == ee) rank = __builtin_popcountll(mm & ((1ull << X.lane) - 1ull));
            if (X.lane == 0) wcnt[X.wave * 32 + ee] = __builtin_popcountll(mm); }
        __syncthreads();
        int off = 0;
        for (int w2 = 0; w2 < X.wave; ++w2) off += wcnt[w2 * 32 + e];
        const int slot = ebase[e] + pre[e] + off + rank;
        STOK[slot] = t; SW[slot] = w; TSLOT[2 * t + kk] = slot;
        if (rb < 32) { const int e2 = rb; for (int s = ebase[e2] + cnt[e2] + X.tid; s < ebase[e2 + 1]; s += 512) { STOK[s] = 0; SW[s] = 0.f; } }
        if (rb == 0) { const int ntl = ebase[32] >> 8;
            for (int tile = X.tid; tile < ntl; tile += 512) { int ee = 0; while (ee < 31 && ebase[ee + 1] <= tile * 256) ++ee; TILEE[tile] = ee; }
            if (X.tid == 0) TILEE[1024] = ntl; }
        __syncthreads();
    }
}

__device__ __forceinline__ void ln2_phase(const Ctx& X, const CArgs* ap, int l, bool first, bool dummy = false) {
    struct { const float *ln1g, *ln1b, *ln2g, *ln2b; } a = {ap->ln1g, ap->ln1b, ap->ln2g, ap->ln2b}; float* outw = dummy ? (float*)(X.ws + WS_Y + 272 * MiB) : ap->out; (void)first;
    const bool last = (l + 1 == DEPTH);
    const bf16* xin = last ? (const bf16*)(X.ws + WS_KVA) : (const bf16*)((const unsigned char*)ap->out + XR_OFF);
    const int lane = X.lane; const bf16* Y = (const bf16*)(X.ws + WS_Y); const bf16* MIX = (const bf16*)(X.ws + WS_MIX); const int* TSLOT = (const int*)(X.ws + WS_TSLOT); bf16* XBp = dummy ? (bf16*)(X.ws + WS_MIX) : (bf16*)((unsigned char*)ap->out + XR_OFF);
    f32x4 g1[4], b1[4], g[4], bb[4];
#pragma unroll
    for (int j = 0; j < 4; ++j) { g1[j] = *(const f32x4*)(a.ln1g + l * DM + 4 * lane + 256 * j); b1[j] = *(const f32x4*)(a.ln1b + l * DM + 4 * lane + 256 * j);
        g[j] = *(const f32x4*)(a.ln2g + l * DM + 4 * lane + 256 * j); bb[j] = *(const f32x4*)(a.ln2b + l * DM + 4 * lane + 256 * j); }
    for (int rb = X.c; rb < NT / 256; rb += X.G) {
        const int tb = rb * 256 + X.wave * 32;
        const int myslots_a = TSLOT[2 * (tb + (lane & 31))], myslots_b = TSLOT[2 * (tb + (lane & 31)) + 1];
        u32x2 xn[4]; u32x2 mn[4], yan[4], ybn[4];
        { const int sa = __builtin_amdgcn_readlane(myslots_a, 0), sb = __builtin_amdgcn_readlane(myslots_b, 0);
#pragma unroll
          for (int j = 0; j < 4; ++j) { xn[j] = *(const u32x2*)(xin + (size_t)tb * DM + 4 * lane + 256 * j); mn[j] = *(const u32x2*)(MIX + (size_t)tb * DM + 4 * lane + 256 * j);
              yan[j] = ldg_s<u32x2>(Y + (size_t)sa * DM + 4 * lane + 256 * j); ybn[j] = ldg_s<u32x2>(Y + (size_t)sb * DM + 4 * lane + 256 * j); } }
        for (int i = 0; i < 32; ++i) {
            const int t = tb + i;
            f32x4 v[4]; float s = 0.f;
#pragma unroll
            for (int j = 0; j < 4; ++j) { const u32x2 xw = xn[j]; const u32x2 mw = mn[j];
                v[j][0] = ALPHA * bflo(xw.x) + bflo(mw.x); v[j][1] = ALPHA * bfhi(xw.x) + bfhi(mw.x); v[j][2] = ALPHA * bflo(xw.y) + bflo(mw.y); v[j][3] = ALPHA * bfhi(xw.y) + bfhi(mw.y);
                s += (v[j][0] + v[j][1]) + (v[j][2] + v[j][3]); }
            u32x2 ya[4], yb[4];
#pragma unroll
            for (int j = 0; j < 4; ++j) { ya[j] = yan[j]; yb[j] = ybn[j]; }
            if (i + 1 < 32) { const int sa = __shfl(myslots_a, i + 1), sb = __shfl(myslots_b, i + 1);
#pragma unroll
                for (int j = 0; j < 4; ++j) { xn[j] = *(const u32x2*)(xin + (size_t)(t + 1) * DM + 4 * lane + 256 * j); mn[j] = *(const u32x2*)(MIX + (size_t)(t + 1) * DM + 4 * lane + 256 * j);
                    yan[j] = ldg_s<u32x2>(Y + (size_t)sa * DM + 4 * lane + 256 * j); ybn[j] = ldg_s<u32x2>(Y + (size_t)sb * DM + 4 * lane + 256 * j); } }
            { const float mean = wave_sum(s) * (1.f / DM); float s2 = 0.f;
#pragma unroll
              for (int j = 0; j < 4; ++j) { v[j] = v[j] - mean; s2 += (v[j][0] * v[j][0] + v[j][1] * v[j][1]) + (v[j][2] * v[j][2] + v[j][3] * v[j][3]); }
              const float rstd = 1.0f / sqrtf(wave_sum(s2) * (1.f / DM) + 1e-5f);
#pragma unroll
              for (int j = 0; j < 4; ++j) v[j] = v[j] * rstd * g1[j] + b1[j]; }
            s = 0.f;
#pragma unroll
            for (int j = 0; j < 4; ++j) { const f32x4 xv = v[j];
                v[j][0] = ALPHA * xv[0] + (bflo(ya[j].x) + bflo(yb[j].x)); v[j][1] = ALPHA * xv[1] + (bfhi(ya[j].x) + bfhi(yb[j].x)); v[j][2] = ALPHA * xv[2] + (bflo(ya[j].y) + bflo(yb[j].y)); v[j][3] = ALPHA * xv[3] + (bfhi(ya[j].y) + bfhi(yb[j].y));
                s += (v[j][0] + v[j][1]) + (v[j][2] + v[j][3]); }
            const float mean = wave_sum(s) * (1.f / DM); float s2 = 0.f;
#pragma unroll
            for (int j = 0; j < 4; ++j) { v[j] = v[j] - mean; s2 += (v[j][0] * v[j][0] + v[j][1] * v[j][1]) + (v[j][2] * v[j][2] + v[j][3] * v[j][3]); }
            const float rstd = 1.0f / sqrtf(wave_sum(s2) * (1.f / DM) + 1e-5f);
#pragma unroll
            for (int j = 0; j < 4; ++j) { v[j] = v[j] * rstd * g[j] + bb[j];
                if (last || dummy) stgf4<NT_LN>(outw + (size_t)t * DM + 4 * lane + 256 * j, v[j]);
                else { u32x2 w; w.x = pk2(v[j][0], v[j][1]); w.y = pk2(v[j][2], v[j][3]); stg8<NT_LN>(XBp + (size_t)t * DM + 4 * lane + 256 * j, w); } }
        }
    }
}

#ifndef REP_P0
#define REP_P0 1
#endif
#ifndef REP_P5
#define REP_P5 1
#endif
#ifndef REP_P9
#define REP_P9 1
#endif
#ifndef REP_BAR
#define REP_BAR 1
#endif
#ifndef REP_P1
#define REP_P1 1
#endif
#ifndef REP_P2A
#define REP_P2A 1
#endif
#ifndef REP_P2B
#define REP_P2B 1
#endif
#ifndef REP_P2C
#define REP_P2C 1
#endif
#ifndef REP_P2D
#define REP_P2D 1
#endif
#ifndef REP_P3A
#define REP_P3A 1
#endif
#ifndef REP_P3B
#define REP_P3B 1
#endif
#ifndef REP_P3C
#define REP_P3C 1
#endif
#ifndef REP_P4
#define REP_P4 1
#endif
#ifndef REP_P6
#define REP_P6 1
#endif
#ifndef REP_P7
#define REP_P7 1
#endif
#ifndef REP_P8
#define REP_P8 1
#endif
__global__ void __launch_bounds__(512, 2) mk_fwd(Args a) {
    extern __shared__ __attribute__((aligned(16))) unsigned char lds_raw[];
    LAS unsigned char* const lds0 = (LAS unsigned char*)lds_raw;
    for (int u = threadIdx.x; u < (LDS_BYTES - LDSCTL_OFF) / 4; u += 512) ((LAS unsigned*)(lds0 + LDSCTL_OFF))[u] = 0u;
    __syncthreads();
    unsigned* barw = (unsigned*)(a.ws + WS_CTL) + CW_BAR;
    XcdBarrier bar; bar.bar = barw; bar.x = 0; bar.st = nullptr;
    if (a.use_bar) bar = xcd_barrier_post(barw, (volatile LAS unsigned*)(lds0 + LDSCTL_OFF) + 8);
#define MKCTX() Ctx X; const CArgs* ap = (const CArgs*)__builtin_amdgcn_kernarg_segment_ptr(); asm volatile("" : "+s"(ap)); { int t_ = threadIdx.x; asm volatile("" : "+v"(t_)); X.lds = lds0; X.tid = t_; X.lane = t_ & 63; X.wave = __builtin_amdgcn_readfirstlane(t_ >> 6); \
        unsigned char* w_ = ap->ws; X.G = gridDim.x; X.c = blockIdx.x; X.vcu = (X.G % 8 == 0) ? (X.c % 8) * (X.G / 8) + X.c / 8 : X.c; X.ws = w_; }
#ifndef P2M
#define P2M 31
#endif
#ifndef PH_MASK0
#define PH_MASK0 1
#endif
#define GBAR() do { if (a.use_bar) for (int rb_ = 0; rb_ < REP_BAR; ++rb_) xcd_barrier(bar); } while (0)

    if ((PH_MASK0 & 1) && a.l_lo == 0 && a.ph_lo == 0) { MKCTX(); for (int rep = 0; rep < REP_P0; ++rep) { prologue(X, ap); __syncthreads(); } GBAR(); }

    for (int l = a.l_lo; l < a.l_hi; ++l) {
        const int lo = (l == a.l_lo) ? (a.ph_lo < 1 ? 1 : a.ph_lo) : 1, hi = (l == a.l_hi - 1) ? a.ph_hi : 10;
#ifndef PH_MASK
#define PH_MASK 0x3ff
#endif
#define IN(k) (((PH_MASK >> (k)) & 1) && lo <= (k) && (k) < hi)
        if (IN(1)) { MKCTX();
            pg8::Gemm g{(const bf16*)((const unsigned char*)ap->out + XR_OFF), (const bf16*)(X.ws + WS_WIN) + (size_t)l * NIN * DM, DM, nullptr};
            pg8::StaticOrder S; S.init(NT, NIN, X.G, X.c, REP_P1);
            pg8::RopeTabs R{ap->pos};
            pg8::EpiGroups<InProjDesc> E{InProjDesc{X.ws}, R, nullptr, 0, 0.f, 0.f};
            pg8::gemm_phase<pg8::EpiGroups<InProjDesc>, pg8::StaticOrder, false>(X.lds, g, S, E, X.tid);
            GBAR();
        }
        if (IN(2)) { MKCTX();
            {
                pg8::Gemm g{(const bf16*)(X.ws + WS_CQ), (const bf16*)(X.ws + WS_WUQ) + (size_t)l * 768 * 256, 256, nullptr};
                pg8::StaticOrder S; S.init(NT, 768, X.G, X.c, REP_P2A);
                pg8::RopeTabs R{ap->pos};
                pg8::EpiGroups<UqDesc> E{UqDesc{X.ws}, R, (const float*)(X.ws + WS_SSQ), 8, 1.0f / 256.0f, 1e-6f};
                pg8::gemm_phase<pg8::EpiGroups<UqDesc>, pg8::StaticOrder, false>(X.lds, g, S, E, X.tid);
            }
            {
                pg8::Gemm g{(const bf16*)(X.ws + WS_T1), (const bf16*)(X.ws + WS_WUKV) + (size_t)l * 1024 * 256, 256, nullptr};
                pg8::StaticOrder S; S.init(NT, 1024, X.G, X.c, REP_P2A);
                pg8::EpiPlainT<NT_KVA> E{(bf16*)(X.ws + WS_KVA), 1024, (const float*)(X.ws + WS_SSQ) + (size_t)NT * 8, 4, 1.0f / 128.0f, 1e-6f, X.lds + LDS_X_OFF};
                pg8::gemm_phase<decltype(E), pg8::StaticOrder, false>(X.lds, g, S, E, X.tid);
            }
            __syncthreads();
            for (int rep = 0; rep < REP_P2B; ++rep) convert_experts(X, ap, l);
            __syncthreads();
            for (int rep = 0; rep < REP_P2C; ++rep) for (int U = X.vcu; U < NB * 32; U += X.G) { const int b = U >> 5, pr = U & 31;
                dsa_index_unit(X, b, 32 * pr); dsa_index_unit(X, b, 32 * (63 - pr)); }
            __syncthreads();
#pragma unroll 1
            for (int cfg = 0; cfg < 3 * REP_P2D; ++cfg) { const int cfgi = cfg % 3;
                fa::Params P; const size_t co = (size_t)cfgi * NT * 256;
                P.Q = (const bf16*)(X.ws + WS_DQ) + co; P.q_pitch = 256; P.K1 = (const bf16*)(X.ws + WS_DK) + co; P.k1_pitch = 256; P.K2 = nullptr; P.k2_pitch = 0; P.k2_col = 0;
                P.V = (const bf16*)(X.ws + WS_DV) + co; P.v_pitch = 256; P.O = (bf16*)(X.ws + WS_OD) + co; P.o_pitch = 256; P.LSE = (float*)(X.ws + WS_LSE) + (size_t)cfgi * NT * 4; P.lse_pitch = 4; P.BM = nullptr;
                P.CL = cfgi == 0 ? 2048 : (cfgi == 1 ? 512 : 128); P.W = 128;
                const int vcu = X.vcu, G = X.G, wv = X.wave, CLc = P.CL;
                fa::attn_stream<64, 0, 2>(P, X.lds, X.tid, (NB * 2 * 16 - vcu + G - 1) / G, [=](int j) { const int U = vcu + j * G, bh = U >> 4, qb = U & 15, b = bh >> 1, hp = bh & 1;
                    const int q0 = 128 * qb, hh = 2 * hp + (wv >> 2); int klo = q0 & ~(CLc - 1); if (q0 - 128 > klo) klo = q0 - 128;
                    return fa::UnitDesc{b * SEQ, q0 + 32 * (wv & 3), 64 * hh, 64 * hh, hh, 128 * hp, 128 * hp, klo >> 6, (q0 + 127) >> 6}; });
            }
            GBAR();
        }
        if (IN(3)) { MKCTX();
            {   fa::Params P; P.Q = (const bf16*)(X.ws + WS_QA); P.q_pitch = 768; P.K1 = (const bf16*)(X.ws + WS_KVA); P.k1_pitch = 1024; P.K2 = (const bf16*)(X.ws + WS_KPE); P.k2_pitch = 32; P.k2_col = 0;
                P.V = (const bf16*)(X.ws + WS_KVA); P.v_pitch = 1024; P.O = (bf16*)(X.ws + WS_XB); P.o_pitch = DM; P.LSE = nullptr; P.lse_pitch = 0; P.BM = nullptr; P.CL = 2048; P.W = 1 << 20;
                const int vcu = X.vcu, G = X.G, wv = X.wave;
                fa::attn_stream<96, 2, 1>(P, X.lds, X.tid, 2 * ((NB * 8 * 4 - vcu + G - 1) / G), [=](int j) { const int U = vcu + (j >> 1) * G, bh = U >> 2, pr = U & 3, b = bh >> 3, hd = bh & 7;
                    const int qb = (j & 1) ? 7 - pr : pr, q0 = 256 * qb;
                    return fa::UnitDesc{b * SEQ, q0 + 32 * wv, 96 * hd, 64 * hd, 0, 128 * hd, 128 * hd + 64, 0, (q0 + 255) >> 6}; });
            }
            {   fa::Params P; P.Q = (const bf16*)(X.ws + WS_BQ); P.q_pitch = 256; P.K1 = (const bf16*)(X.ws + WS_T1); P.k1_pitch = 256; P.k1_col = 192; P.K2 = nullptr; P.k2_pitch = 0; P.k2_col = 0;
                P.V = (const bf16*)(X.ws + WS_BV); P.v_pitch = 64; P.v_col = 0; P.O = (bf16*)(X.ws + WS_XB); P.o_pitch = DM; P.LSE = nullptr; P.lse_pitch = 0; P.BM = (const unsigned*)(X.ws + WS_BM); P.CL = 2048; P.W = 1 << 20;
                const int hd = X.wave & 3, sub = X.wave >> 2, vcu = X.vcu, G = X.G;
                fa::attn_stream<64, 1, 1>(P, X.lds, X.tid, 2 * ((NB * 16 - vcu + G - 1) / G), [=](int j) { const int U = vcu + (j >> 1) * G, b = U >> 4, pr = U & 15;
                    const int qb = (j & 1) ? 31 - pr : pr, q0 = 64 * qb;
                    return fa::UnitDesc{b * SEQ, q0 + 32 * sub, 64 * hd, 512 + 64 * hd, 0, 192, 0, 0, qb}; });
            }
            for (int rep = 0; rep < REP_P3C; ++rep) dil_combine(X);
            GBAR();
        }
        if (IN(4)) { MKCTX();
            pg8::Gemm g{(const bf16*)(X.ws + WS_XB), (const bf16*)(X.ws + WS_WO) + (size_t)l * DM * DM, DM, nullptr};
            pg8::StaticOrder S; S.init(NT, DM, X.G, X.c, REP_P4);
            pg8::EpiPlainT<NT_MIX> E{(bf16*)(X.ws + WS_MIX), DM, nullptr, 0, 0.f, 0.f, X.lds + LDS_X_OFF};
            pg8::gemm_phase<decltype(E), pg8::StaticOrder, false>(X.lds, g, S, E, X.tid);
            GBAR();
        }
        if (IN(5)) { MKCTX(); if (REP_P5 > 1) ln1_router(X, ap, l, l == 0, true); ln1_router(X, ap, l, l == 0); GBAR(); }
        if (IN(6)) { MKCTX(); for (int rep = 0; rep < REP_P6; ++rep) moe_dispatch(X); GBAR(); }
        if (IN(7)) { MKCTX();
            const int* TILEE = (const int*)(X.ws + WS_TILEE);
            pg8::Gemm g{(const bf16*)(X.ws + WS_XB), (const bf16*)(X.ws + WS_WGU), DM, (const int*)(X.ws + WS_STOK)};
            pg8::GroupedOrder S{TILEE, TILEE[1024], 2, X.G, X.c};
            pg8::EpiGateUpT<NT_H> E{(bf16*)(X.ws + WS_H), (const float*)(X.ws + WS_SW)};
            for (int rep = 0; rep < REP_P7; ++rep) pg8::gemm_phase<decltype(E), pg8::GroupedOrder, true>(X.lds, g, S, E, X.tid);
            GBAR();
        }
        if (IN(8)) { MKCTX();
            const int* TILEE = (const int*)(X.ws + WS_TILEE);
            pg8::Gemm g{(const bf16*)(X.ws + WS_H), (const bf16*)(X.ws + WS_WD), FH, nullptr};
            pg8::GroupedOrder S{TILEE, TILEE[1024], 4, X.G, X.c};
            pg8::EpiPlainT<NT_Y> E{(bf16*)(X.ws + WS_Y), DM, nullptr, 0, 0.f, 0.f, X.lds + LDS_X_OFF};
            for (int rep = 0; rep < REP_P8; ++rep) pg8::gemm_phase<decltype(E), pg8::GroupedOrder, false>(X.lds, g, S, E, X.tid);
            GBAR();
        }
        if (IN(9)) { MKCTX(); if (REP_P9 > 1) ln2_phase(X, ap, l, l == 0, true); ln2_phase(X, ap, l, l == 0); if (!(l == a.l_hi - 1)) GBAR(); }
#undef IN
    }
#undef GBAR
}

extern "C" void kernel_launch(void* const* d_in, const int* in_sizes, int n_in, void* d_out, int out_size, void* d_ws, size_t ws_size, hipStream_t stream) {
    static int grid = 0;
    if (grid == 0) {
        if (n_in != 19 || in_sizes[0] != NT * DM || out_size != NT * DM || ws_size < WS_END) { fprintf(stderr, "kernel_launch: unexpected shapes (n_in %d, in0 %d, out %d, ws %zu < %zu); nothing launched\n", n_in, n_in > 0 ? in_sizes[0] : -1, out_size, ws_size, (size_t)WS_END); grid = -1; return; }
        int dev = 0, cus = 0, per_cu = 0;
        if (hipGetDevice(&dev) != hipSuccess || hipDeviceGetAttribute(&cus, hipDeviceAttributeMultiprocessorCount, dev) != hipSuccess) { grid = -1; return; }
        if (hipFuncSetAttribute((const void*)mk_fwd, hipFuncAttributeMaxDynamicSharedMemorySize, LDS_BYTES) != hipSuccess) { fprintf(stderr, "kernel_launch: hipFuncSetAttribute failed\n"); grid = -1; return; }
        if (hipOccupancyMaxActiveBlocksPerMultiprocessor(&per_cu, (const void*)mk_fwd, 512, LDS_BYTES) != hipSuccess || per_cu < 1) fprintf(stderr, "kernel_launch: occupancy query reports %d\n", per_cu);
        (void)hipGetLastError();
        grid = cus;
    }
    if (grid < 0) return;
    (void)hipMemsetAsync((char*)d_ws + WS_CTL, 0, CTL_BYTES, stream);
    Args a{};
    a.x = (const float*)d_in[0]; a.pos = (const int*)d_in[1]; a.w_in = (const float*)d_in[2]; a.qn = (const float*)d_in[3]; a.kvn = (const float*)d_in[4];
    a.w_uq = (const float*)d_in[5]; a.w_ukv = (const float*)d_in[6]; a.w_o = (const float*)d_in[7]; a.ln1g = (const float*)d_in[8]; a.ln1b = (const float*)d_in[9];
    a.rgw = (const float*)d_in[10]; a.rgb = (const float*)d_in[11]; a.rew = (const float*)d_in[12]; a.reb = (const float*)d_in[13];
    a.wg = (const float*)d_in[14]; a.wu = (const float*)d_in[15]; a.wd = (const float*)d_in[16]; a.ln2g = (const float*)d_in[17]; a.ln2b = (const float*)d_in[18];
    a.out = (float*)d_out; a.ws = (unsigned char*)d_ws; a.pad = 0;
#if MK_MULTI
    a.use_bar = 0;
    a.l_lo = 0; a.l_hi = 0; a.ph_lo = 0; a.ph_hi = 0;
    hipLaunchKernelGGL(mk_fwd, dim3(grid), dim3(512), LDS_BYTES, stream, a);
    for (int l = 0; l < DEPTH; ++l)
        for (int ph = 1; ph < 10; ++ph) { a.l_lo = l; a.l_hi = l + 1; a.ph_lo = ph; a.ph_hi = ph + 1; hipLaunchKernelGGL(mk_fwd, dim3(grid), dim3(512), LDS_BYTES, stream, a); }
#else
    a.use_bar = 1; a.l_lo = 0; a.l_hi = DEPTH; a.ph_lo = 0; a.ph_hi = 10;
    hipLaunchKernelGGL(mk_fwd, dim3(grid), dim3(512), LDS_BYTES, stream, a);
#endif
    const hipError_t le = hipPeekAtLastError();
    if (le != hipSuccess) fprintf(stderr, "kernel_launch: launch failed: %s\n", hipGetErrorName(le));
}
```

```cpp
#include <hip/hip_runtime.h>
#include <cstdio>
#include <cstdint>

#define LAS __attribute__((address_space(3)))
#define GAS __attribute__((address_space(1)))
typedef unsigned short bf16;
typedef short bf16x8 __attribute__((ext_vector_type(8)));
typedef short s16x4 __attribute__((ext_vector_type(4)));
typedef float f32x2 __attribute__((ext_vector_type(2)));
typedef float f32x4 __attribute__((ext_vector_type(4)));
typedef float f32x16 __attribute__((ext_vector_type(16)));
typedef unsigned u32x2 __attribute__((ext_vector_type(2)));
typedef unsigned u32x4 __attribute__((ext_vector_type(4)));
typedef __bf16 bf16x2_t __attribute__((ext_vector_type(2)));

#ifndef MK_MULTI
#define MK_MULTI 0
#endif

constexpr int NB = 32, SEQ = 2048, NT = NB * SEQ, DM = 1024, DEPTH = 4;
constexpr int IN_COLS = 3400, NIN = 3584;
constexpr int NEXP = 32, FH = 256;
constexpr int NSLOT = 2 * NT + NEXP * 256;
constexpr int MAXTILES = NSLOT / 256;
constexpr float ALPHA = 1.681792830507429f;
constexpr float LOG2E = 1.4426950408889634f;
constexpr float QSC64 = 0.125f * LOG2E;
constexpr float QSC96 = 0.10206207261596577f * LOG2E;
constexpr float IDX_SCALE = 0.0625f;

constexpr size_t MiB = 1u << 20;
constexpr size_t WS_CTL = 0, CTL_BYTES = 1 * MiB;
constexpr size_t WS_WIN = 1 * MiB;
constexpr size_t WS_WUQ = 29 * MiB;
constexpr size_t WS_WUKV = WS_WUQ + 3 * MiB / 2;
constexpr size_t WS_WO = WS_WUKV + 2 * MiB;
constexpr size_t WS_RGT = WS_WO + 8 * MiB;
constexpr size_t WS_RET = WS_RGT + 64 * 1024;
constexpr size_t WS_ROPE = 42 * MiB;
constexpr size_t WS_WGU = 56 * MiB;
constexpr size_t WS_WD = 88 * MiB;
constexpr size_t WS_XB = 104 * MiB;
constexpr size_t WS_A = 232 * MiB;
constexpr size_t WS_CQ = WS_A;
constexpr size_t WS_T1 = WS_CQ + 32 * MiB;
constexpr size_t WS_BQ = WS_T1 + 32 * MiB;
constexpr size_t WS_BV = WS_BQ + 32 * MiB;
constexpr size_t WS_WI = WS_BV + 8 * MiB;
constexpr size_t WS_BQI = WS_WI + 2 * MiB;
constexpr size_t WS_SSQ = WS_BQI + 32 * MiB;
constexpr size_t WS_DQ = WS_SSQ + 4 * MiB;
constexpr size_t WS_DK = WS_DQ + 96 * MiB;
constexpr size_t WS_DV = WS_DK + 96 * MiB;
constexpr size_t WS_B = WS_DV + 96 * MiB;
constexpr size_t WS_QA = WS_B;
constexpr size_t WS_KVA = WS_QA + 96 * MiB;
constexpr size_t WS_BM = WS_KVA + 128 * MiB;
constexpr size_t WS_OD = WS_BM + 16 * MiB;
constexpr size_t WS_LSE = WS_OD + 96 * MiB;
constexpr size_t WS_MOE = WS_LSE + 4 * MiB;
constexpr size_t WS_ROUTE = WS_MOE;
constexpr size_t WS_HIST = WS_ROUTE + 1 * MiB;
constexpr size_t WS_STOK = WS_HIST + 64 * 1024;
constexpr size_t WS_SW = WS_STOK + 640 * 1024;
constexpr size_t WS_TSLOT = WS_SW + 640 * 1024;
constexpr size_t WS_TILEE = WS_TSLOT + 512 * 1024;
constexpr size_t WS_KPE = WS_MOE + 4 * MiB;
constexpr size_t WS_KI = WS_KPE + 4 * MiB;
constexpr size_t WS_END = WS_KI + 4 * MiB;
constexpr size_t WS_MIX = WS_A;
constexpr size_t WS_H = WS_A + 128 * MiB;
constexpr size_t WS_Y = WS_H + 68 * MiB;
static_assert(WS_RET + 512 * 1024 <= WS_ROPE && WS_ROPE + 14 * MiB <= WS_WGU && WS_WD + 16 * MiB <= WS_XB && WS_XB + 128 * MiB <= WS_A, "ws map 1");
static_assert(WS_Y + 272 * MiB <= WS_MOE && WS_TILEE + 8192 <= WS_END && WS_END <= 1024 * MiB, "ws map 2");
constexpr size_t ROPE_C16 = 0, ROPE_S16 = (size_t)NT * 16 * 4, ROPE_C8 = 2 * ROPE_S16, ROPE_S8 = ROPE_C8 + (size_t)NT * 8 * 4,
                 ROPE_C4 = ROPE_S8 + (size_t)NT * 8 * 4, ROPE_S4 = ROPE_C4 + (size_t)NT * 4 * 4;

constexpr int CW_BAR = 4096;
constexpr int RING_BYTES = 131072;
constexpr int LDS_X_OFF = 131072;
constexpr int LDSCTL_OFF = 147456;
constexpr int LDS_HIST_OFF = LDSCTL_OFF + 4096;
constexpr int LDS_BYTES = LDS_HIST_OFF + 4096;

#define RLX_AGENT __ATOMIC_RELAXED, __HIP_MEMORY_SCOPE_AGENT
__device__ __forceinline__ unsigned f2bf(float f) { unsigned u = __builtin_bit_cast(unsigned, f); return (u + 0x7fffu + ((u >> 16) & 1u)) >> 16; }
#ifndef LN2_X1B
#define LN2_X1B 1
#endif
constexpr size_t XR_OFF = (size_t)NT * DM * 2;
#ifndef NT_EPI
#define NT_EPI 1
#endif
#ifndef NT_KVA
#define NT_KVA 1
#endif
#ifndef NT_MIX
#define NT_MIX 0
#endif
#ifndef NT_H
#define NT_H 0
#endif
#ifndef NT_Y
#define NT_Y 1
#endif
#ifndef NT_LN
#define NT_LN 0
#endif
#ifndef NT_ATT
#define NT_ATT 1
#endif
#define STG_ASM(W, POL) asm volatile("global_store_dwordx" W " %0, %1, off " POL "\n\ts_nop 1" :: "v"(p), "v"(w))
template <int M, class T> __device__ __forceinline__ void stg_any16(void* p, T w) {
    if constexpr (M == 0) *(T*)p = w; else if constexpr (M == 1) __builtin_nontemporal_store(w, (T*)p);
    else if constexpr (M == 2) STG_ASM("4", "sc1"); else if constexpr (M == 3) STG_ASM("4", "sc0 sc1"); else if constexpr (M == 4) STG_ASM("4", "sc1 nt"); else STG_ASM("4", "sc0 sc1 nt"); }
template <int M> __device__ __forceinline__ void stgf4(void* p, f32x4 w) { stg_any16<M>(p, w); }
template <int M> __device__ __forceinline__ void stg16(void* p, u32x4 w) { stg_any16<M>(p, w); }
template <int M> __device__ __forceinline__ void stg8(void* p, u32x2 w) {
    if constexpr (M == 0) *(u32x2*)p = w; else if constexpr (M == 1) __builtin_nontemporal_store(w, (u32x2*)p);
    else if constexpr (M == 2) STG_ASM("2", "sc1"); else if constexpr (M == 3) STG_ASM("2", "sc0 sc1"); else if constexpr (M == 4) STG_ASM("2", "sc1 nt"); else STG_ASM("2", "sc0 sc1 nt"); }
#ifndef NT_LD
#define NT_LD 1
#endif
template <class T> __device__ __forceinline__ T ldg_s(const void* p) { if constexpr (NT_LD) return __builtin_nontemporal_load((const T*)p); else return *(const T*)p; }
__device__ __forceinline__ unsigned pk2(float lo, float hi) { f32x2 v = {lo, hi}; bf16x2_t b = __builtin_convertvector(v, bf16x2_t); return __builtin_bit_cast(unsigned, b); }
__device__ __forceinline__ float bf2f(unsigned short b) { return __builtin_bit_cast(float, ((unsigned)b) << 16); }
__device__ __forceinline__ float bflo(unsigned w) { return __builtin_bit_cast(float, w << 16); }
__device__ __forceinline__ float bfhi(unsigned w) { return __builtin_bit_cast(float, w & 0xffff0000u); }
template <int CTRL> __device__ __forceinline__ float dppf(float x) { return __builtin_bit_cast(float, __builtin_amdgcn_mov_dpp(__builtin_bit_cast(int, x), CTRL, 0xf, 0xf, true)); }
__device__ __forceinline__ float xhalf_sum(float v) { const auto t = __builtin_amdgcn_permlane32_swap(__float_as_uint(v), __float_as_uint(v), false, false); return __uint_as_float(t[0]) + __uint_as_float(t[1]); }
__device__ __forceinline__ float xhalf_max(float v) { const auto t = __builtin_amdgcn_permlane32_swap(__float_as_uint(v), __float_as_uint(v), false, false); return fmaxf(__uint_as_float(t[0]), __uint_as_float(t[1])); }
__device__ __forceinline__ float wave_sum(float v) {
    v += dppf<0xB1>(v); v += dppf<0x4E>(v); v += dppf<0x141>(v); v += dppf<0x140>(v);
    const auto s = __builtin_amdgcn_permlane16_swap(__float_as_uint(v), __float_as_uint(v), false, false);
    v = __uint_as_float(s[0]) + __uint_as_float(s[1]);
    return xhalf_sum(v);
}
__device__ __forceinline__ int crow(int r, int hi) { return (r & 3) + 8 * (r >> 2) + 4 * hi; }

#define XB_TMO      128
#define XB_XCNT(j)  (256  + 64 * (j))
#define XB_XSUB(j)  (1280 + 64 * (j))
#define XB_XGEN(j)  (2304 + 64 * (j))
#define XB_TOP      3328
#define XB_TOPGEN   3392
#define XCD_BAR_WORDS 3456
#define XB_SPIN_CAP (1u << 18)
__device__ __forceinline__ unsigned xb_ld(unsigned* p)              { return __hip_atomic_load(p, __ATOMIC_RELAXED, __HIP_MEMORY_SCOPE_AGENT); }
__device__ __forceinline__ unsigned xb_add(unsigned* p, unsigned v) { return __hip_atomic_fetch_add(p, v, __ATOMIC_RELAXED, __HIP_MEMORY_SCOPE_AGENT); }
__device__ __forceinline__ unsigned xb_xcc_id() { return (unsigned)__builtin_amdgcn_s_getreg((3 << 11) | 20) & 0xFu; }
#define XB_SPIN(cond, bar) do { unsigned _sp = 0; while (cond) { __builtin_amdgcn_s_sleep(1); \
    if ((++_sp & 255u) == 0u) { if (xb_ld(&(bar)[XB_TMO])) break; if (_sp > XB_SPIN_CAP) { atomicAdd(&(bar)[XB_TMO], 1u); break; } } } } while (0)
struct XcdBarrier { unsigned* bar; unsigned x; volatile LAS unsigned* st; };
__device__ __forceinline__ XcdBarrier xcd_barrier_post(unsigned* bar, volatile LAS unsigned* st) {
    XcdBarrier b; b.bar = bar; b.x = xb_xcc_id(); b.st = st;
    if (threadIdx.x == 0) (void)xb_add(&bar[XB_XCNT(b.x)], 1u);
    return b;
}
__device__ __forceinline__ void xcd_barrier_complete(unsigned* bar, unsigned x, unsigned& nloc, unsigned& nx) {
    const unsigned G = gridDim.x * gridDim.y * gridDim.z;
    unsigned sum, cnt, mine, sp = 0u;
    for (;;) {
        sum = 0u; cnt = 0u; mine = 0u;
#pragma unroll
        for (unsigned j = 0; j < 16; ++j) { const unsigned c = xb_ld(&bar[XB_XCNT(j)]); sum += c; cnt += (c > 0u) ? 1u : 0u; mine = (j == x) ? c : mine; }
        if (sum == G) break;
        __builtin_amdgcn_s_sleep(1);
        if ((++sp & 255u) == 0u) { if (xb_ld(&bar[XB_TMO])) break; if (sp > XB_SPIN_CAP) { atomicAdd(&bar[XB_TMO], 1u); break; } }
    }
    nloc = mine > 0u ? mine : 1u; nx = cnt > 0u ? cnt : 1u;
}
__device__ __forceinline__ void xcd_barrier(const XcdBarrier& b) {
    asm volatile("s_waitcnt vmcnt(0)" ::: "memory");
    __syncthreads();
    if (threadIdx.x == 0) {
        unsigned* bar = b.bar;
        __builtin_amdgcn_s_waitcnt(0);
        unsigned nloc = b.st[0], nx = b.st[1];
        if (nloc == 0u) { xcd_barrier_complete(bar, b.x, nloc, nx); b.st[0] = nloc; b.st[1] = nx; }
        const unsigned old = xb_add(&bar[XB_XSUB(b.x)], 1u);
        const unsigned gen = old / nloc;
        if (old + 1u == (gen + 1u) * nloc) {
            __builtin_amdgcn_fence(__ATOMIC_RELEASE, "agent");
            asm volatile("s_waitcnt vmcnt(0)" ::: "memory");
            const unsigned og = xb_add(&bar[XB_TOP], 1u);
            const unsigned tg = og / nx;
            if (og + 1u == (tg + 1u) * nx) xb_add(&bar[XB_TOPGEN], 1u);
            else XB_SPIN(xb_ld(&bar[XB_TOPGEN]) == tg, bar);
            __builtin_amdgcn_fence(__ATOMIC_ACQUIRE, "agent");
            xb_add(&bar[XB_XGEN(b.x)], 1u);
            asm volatile("s_waitcnt vmcnt(0)" ::: "memory");
        } else {
            XB_SPIN(xb_ld(&bar[XB_XGEN(b.x)]) == gen, bar);
            __builtin_amdgcn_fence(__ATOMIC_ACQUIRE, "agent");
            asm volatile("s_waitcnt vmcnt(0)" ::: "memory");
        }
    }
    __syncthreads();
}

namespace pg8 {
constexpr int BM = 256, BK = 64, HALF = 128, HTB = HALF * BK * 2, STAGE_BYTES = 8 * HTB, NXCD = 8, WGM = 8;
__host__ __device__ __forceinline__ int lds_byte(int r, int c) { const int st = (r >> 4) * 2 + (c >> 5), rr = r & 15, cc = c & 31, ob = rr * 64 + cc * 2; return st * 1024 + (ob ^ (((ob >> 9) & 1) << 5)); }
__host__ __device__ __forceinline__ void stage_rc(int b, int& R, int& C) { const int st = b / 1024, sb = b % 1024, swz = sb ^ (((sb >> 9) & 1) << 5); R = (st >> 1) * 16 + swz / 64; C = (st & 1) * 32 + (swz % 64) / 2; }
__host__ __device__ __forceinline__ int perm32(int rho) { const int n = rho >> 4, i = rho & 15; return 8 * (i >> 2) + 4 * n + (i & 3); }

#ifndef PROBE_P1
#define PROBE_P1 0
#endif
struct Unit { int pm, pn, pb;
#if PROBE_P1
    int fl;
#endif
};
struct Gemm { const bf16* A; const bf16* Bt; int K; const int* gidx; };

__device__ __forceinline__ int xcd_remap(int wgid, int nwg) { const int q = nwg / NXCD, r = nwg % NXCD, xcd = wgid % NXCD, off = wgid / NXCD; return (xcd < r ? xcd * (q + 1) : r * (q + 1) + (xcd - r) * q) + off; }
struct StaticOrder {
    int nM, nN, nwg, G, c, rep;
    __device__ void init(int M, int N, int G_, int c_, int rep_ = 1) { nM = M / BM; nN = N / BM; nwg = nM * nN; G = G_; c = c_; rep = rep_; }
    __device__ bool next(int i, Unit& u) const {
        long L = (long)i * G + c; if (L >= (long)nwg * rep) return false;
#if PROBE_P1
        u.fl = (rep > 1 && L < nwg) ? 1 : 0;
#endif
        L %= nwg;
        const int wgid = xcd_remap((int)L, nwg);
        const int nig = WGM * nN, gid = wgid / nig, fm = gid * WGM, gsz = (nM - fm) < WGM ? (nM - fm) : WGM;
        u.pm = fm + ((wgid % nig) % gsz); u.pn = (wgid % nig) / gsz; u.pb = u.pn; return true;
    }
};
struct GroupedOrder {
    const int* tile_e; int ntiles, npn, G, c;
    __device__ bool next(int i, Unit& u) const {
        const long L = (long)i * G + c; const int nwg = ntiles * npn; if (L >= nwg) return false;
        const int wgid = xcd_remap((int)L, nwg);
        u.pm = wgid / npn; u.pn = wgid % npn; u.pb = tile_e[u.pm] * npn + u.pn;
#if PROBE_P1
        u.fl = 0;
#endif
        return true;
    }
};

__device__ __forceinline__ unsigned cvt_pk_bf16(float lo, float hi) { unsigned r; asm volatile("v_cvt_pk_bf16_f32 %0, %1, %2" : "=v"(r) : "v"(lo), "v"(hi)); return r; }

template <int STM> struct EpiPlainT {
    static constexpr bool PERM = true;
    bf16* O; int ldc; const float* ssq; int ssq_n; float ssq_inv; float eps;
    LAS unsigned char* xl;
    __device__ __forceinline__ void operator()(const f32x4 (&acc)[2][2][4][2], const Unit& u, int wr, int wc, int fr, int fq) const {
        const int lane = fq * 16 + fr; LAS unsigned char* t = xl + (wr * 4 + wc) * 2048;
        const int wsw = fr & 7, rrow = lane >> 3, rch = lane & 7;
#pragma unroll
        for (int ai = 0; ai < 2; ++ai)
#pragma unroll
            for (int m = 0; m < 4; ++m) { const int rowb = u.pm * BM + ai * HALF + wr * 64 + m * 16;
                float sc = 1.f;
                if (ssq) { const f32x4 p = *(const f32x4*)(ssq + (size_t)(rowb + fr) * ssq_n); sc = __builtin_amdgcn_rsqf((p[0] + p[1] + p[2] + p[3]) * ssq_inv + eps); }
#pragma unroll
                for (int bj = 0; bj < 2; ++bj) { const f32x4 v0 = acc[ai][bj][m][0] * sc, v1 = acc[ai][bj][m][1] * sc;
                    u32x4 w; w.x = cvt_pk_bf16(v0[0], v0[1]); w.y = cvt_pk_bf16(v0[2], v0[3]); w.z = cvt_pk_bf16(v1[0], v1[1]); w.w = cvt_pk_bf16(v1[2], v1[3]);
                    *(LAS u32x4*)(t + fr * 128 + 16 * ((4 * bj + fq) ^ wsw)) = w; }
#pragma unroll
                for (int i = 0; i < 2; ++i) { const int rr = 8 * i + rrow;
                    const u32x4 w = *(const LAS u32x4*)(t + rr * 128 + 16 * (rch ^ (rr & 7)));
                    stg16<STM>(O + (size_t)(rowb + rr) * ldc + u.pn * BM + wc * 64 + 8 * rch, w); }
            }
    }
};
template <int STM> struct EpiGateUpT {
    static constexpr bool PERM = true;
    bf16* H; const float* sw;
    __device__ __forceinline__ void operator()(const f32x4 (&acc)[2][2][4][2], const Unit& u, int wr, int wc, int fr, int fq) const {
        const int row0 = u.pm * BM + wr * 64 + fr; const int col0 = u.pn * HALF + wc * 32 + 8 * fq;
#pragma unroll
        for (int ai = 0; ai < 2; ++ai)
#pragma unroll
            for (int m = 0; m < 4; ++m) { const int row = row0 + ai * HALF + m * 16; const float w = sw[row]; f32x4 hv[2];
#pragma unroll
                for (int n = 0; n < 2; ++n) { const f32x4 g = acc[ai][0][m][n], up = acc[ai][1][m][n];
#pragma unroll
                    for (int e = 0; e < 4; ++e) { const float sg = g[e] * __builtin_amdgcn_rcpf(1.0f + __builtin_amdgcn_exp2f(-g[e] * LOG2E)); hv[n][e] = sg * up[e] * w; } }
                u32x4 o; o.x = cvt_pk_bf16(hv[0][0], hv[0][1]); o.y = cvt_pk_bf16(hv[0][2], hv[0][3]); o.z = cvt_pk_bf16(hv[1][0], hv[1][1]); o.w = cvt_pk_bf16(hv[1][2], hv[1][3]);
                stg16<STM>(H + (size_t)row * FH + col0, o); }
    }
};

enum { GK_SKIP = 0, GK_PLAIN = 1, GK_ROPE32 = 2, GK_HEAD16 = 3, GK_IDX8 = 4, GK_WI = 5 };
struct GroupDesc { int kind; bf16* dst; int pitch; int col; float scale; int perm; float* ssq; int ssq_n; int ssq_i; };
struct RopeTabs { const int* pos; };
__device__ __forceinline__ int perm_row(int row, int perm) {
    if (perm == 0) return row; const int b = row >> 11, s = row & 2047;
    return perm == 4 ? (b << 11) + ((s & 3) << 9) + (s >> 2) : (b << 11) + ((s & 15) << 7) + (s >> 4);
}
__device__ __forceinline__ void st16(bf16* p, u32x2 a, u32x2 b) { u32x4 w; w.x = a.x; w.y = a.y; w.z = b.x; w.w = b.y; stg16<NT_EPI>(p, w); }
__device__ __forceinline__ u32x2 pk4(f32x4 v) { u32x2 w; w.x = cvt_pk_bf16(v[0], v[1]); w.y = cvt_pk_bf16(v[2], v[3]); return w; }
__device__ __forceinline__ void swap16(u32x2& X, u32x2& Y) {
    const auto a = __builtin_amdgcn_permlane16_swap(X.x, Y.x, false, false); const auto b = __builtin_amdgcn_permlane16_swap(X.y, Y.y, false, false);
    X.x = a[0]; Y.x = a[1]; X.y = b[0]; Y.y = b[1];
}
__device__ __forceinline__ float rope_k(int i, int rd) { return __builtin_amdgcn_exp2f(-18.931568569324174f * (float)(2 * i) / (float)rd) * 0.15915494309189535f; }
__device__ __forceinline__ void rope_cs(float posf, int i0, int rd, f32x4& c, f32x4& s) {
#pragma unroll
    for (int e = 0; e < 4; ++e) { const float f = __builtin_amdgcn_fractf(posf * rope_k(i0 + e, rd)); s[e] = __builtin_amdgcn_sinf(f); c[e] = __builtin_amdgcn_cosf(f); }
}
template <class DescFn> struct EpiGroups {
    static constexpr bool PERM = true;
    DescFn F; RopeTabs R; const float* rs_ssq; int rs_n; float rs_inv, rs_eps;
    __device__ __forceinline__ void operator()(const f32x4 (&acc)[2][2][4][2], const Unit& u, int wr, int wc, int fr, int fq) const {
        const int row0 = u.pm * BM + wr * 64 + fr;
#pragma unroll
        for (int bj = 0; bj < 2; ++bj) {
            const GroupDesc d = F(u.pn, bj, wc);
            if (d.kind == GK_SKIP) continue;
#if PROBE_P1 == 1
            if (u.fl) continue;
#endif
            const int ki0 = d.kind == GK_ROPE32 ? 4 * fq : (d.kind == GK_HEAD16 ? 4 * (fq & 1) : 0), krd = d.kind == GK_ROPE32 ? 32 : (d.kind == GK_HEAD16 ? 16 : 8);
#pragma unroll
            for (int ai = 0; ai < 2; ++ai)
#pragma unroll
                for (int m = 0; m < 4; ++m) {
                    const int row = row0 + ai * HALF + m * 16;
                    float sc = d.scale;
                    if (rs_ssq) { float s = 0.f; for (int i = 0; i < rs_n; ++i) s += rs_ssq[(size_t)row * rs_n + i]; sc *= __builtin_amdgcn_rsqf(s * rs_inv + rs_eps); }
                    f32x4 v0 = acc[ai][bj][m][0], v1 = acc[ai][bj][m][1];
                    if (d.ssq) {
                        float q = (v0[0] * v0[0] + v0[1] * v0[1]) + (v0[2] * v0[2] + v0[3] * v0[3]) + (v1[0] * v1[0] + v1[1] * v1[1]) + (v1[2] * v1[2] + v1[3] * v1[3]);
                        q += __shfl_xor(q, 16); q += __shfl_xor(q, 32);
                        if (fq == 0) d.ssq[(size_t)row * d.ssq_n + d.ssq_i] = q;
                    }
                    v0 = v0 * sc; v1 = v1 * sc;
                    if (d.kind == GK_WI) { if (fq == 0) { float* wp = (float*)d.dst + (size_t)row * 8; *(f32x4*)wp = v0; *(f32x4*)(wp + 4) = v1; } continue; }
                    bf16* rp = d.dst + (size_t)perm_row(row, d.perm) * d.pitch + d.col;
                    if (d.kind == GK_PLAIN) { st16(rp + 8 * fq, pk4(v0), pk4(v1)); }
                    else if (d.kind == GK_IDX8) {
                        f32x4 c, s; rope_cs((float)R.pos[row], ki0, krd, c, s);
                        const f32x4 o1 = fq == 0 ? v0 * c - v1 * s : v0, o2 = fq == 0 ? v1 * c + v0 * s : v1;
                        st16(rp + 8 * fq, pk4(o1), pk4(o2));
                    } else if (d.kind == GK_ROPE32) {
                        f32x4 c, s; rope_cs((float)R.pos[row], ki0, krd, c, s);
                        u32x2 X = pk4(v0 * c - v1 * s), Y = pk4(v1 * c + v0 * s);
                        swap16(X, Y);
                        st16(rp + ((fq & 1) ? 16 + 4 * (fq - 1) : 4 * fq), X, Y);
                    } else {
                        f32x4 c, s; rope_cs((float)R.pos[row], ki0, krd, c, s);
                        u32x2 X = pk4(fq < 2 ? v0 * c - v1 * s : v0), Y = pk4(fq < 2 ? v1 * c + v0 * s : v1);
                        swap16(X, Y);
                        st16(rp + 16 * (fq >> 1) + 8 * (fq & 1), X, Y);
                    }
                }
        }
    }
};

template <class Epi, class Sched, bool GATHER, int LDA = 0>
__device__ __forceinline__ void gemm_phase(LAS unsigned char* lds, const Gemm g, const Sched& S, const Epi& E, const int tid) {
    const int wid = __builtin_amdgcn_readfirstlane(tid >> 6), lane = tid & 63, wr = wid >> 2, wc = wid & 3, fr = lane & 15, fq = lane >> 4;
    const int K = g.K, nt = K / BK, lda = LDA ? LDA : K;
    unsigned voA[2][2], voB[2]; int RA[2], CA[2];
#pragma unroll
    for (int i = 0; i < 2; ++i) { int R, C; stage_rc(tid * 16 + i * 8192, R, C); const int Rb = Epi::PERM ? ((R & ~31) + perm32(R & 31)) : R;
        RA[i] = R; CA[i] = C; voA[0][i] = (unsigned)(R * lda + C) * 2u; voA[1][i] = (unsigned)((R + HALF) * lda + C) * 2u; voB[i] = (unsigned)(Rb * K + C) * 2u; }
    const size_t kstep = (size_t)(BK * 2);
    const size_t hstep = (size_t)HALF * K * 2;
    const size_t tstep = 2 * hstep;
    const size_t tstepA = (size_t)BM * lda * 2;
    const unsigned ldsw = (unsigned)wid * 1024u;
    const int aoff = lds_byte(wr * 64 + fr, fq * 8), boff = lds_byte(wc * 32 + fr, fq * 8);
#define PG8_SA(b, h) (((b) * 2 + (h)) * HTB)
#define PG8_SB(b, h) ((4 + (b) * 2 + (h)) * HTB)
#define PG8_STAGE(bufoff, gbase, voff) do { _Pragma("unroll") for (int _i = 0; _i < 2; ++_i) \
        __builtin_amdgcn_global_load_lds((const unsigned*)((const char*)(gbase) + (voff)[_i]), (LAS unsigned*)(lds + (bufoff) + ldsw + _i * 8192), 16, 0, 0); } while (0)
#define PG8_LDA(dst, b, h) do { _Pragma("unroll") for (int m = 0; m < 4; ++m) _Pragma("unroll") for (int k = 0; k < 2; ++k) dst[m][k] = *(const LAS bf16x8*)(lds + PG8_SA(b, h) + aoff + m * 2048 + k * 1024); } while (0)
#define PG8_LDB(dst, b, h) do { _Pragma("unroll") for (int n = 0; n < 2; ++n) _Pragma("unroll") for (int k = 0; k < 2; ++k) dst[n][k] = *(const LAS bf16x8*)(lds + PG8_SB(b, h) + boff + n * 2048 + k * 1024); } while (0)
#define PG8_MMA(ai, bj, At, Bt) do { __builtin_amdgcn_s_setprio(1); _Pragma("unroll") for (int m = 0; m < 4; ++m) _Pragma("unroll") for (int n = 0; n < 2; ++n) _Pragma("unroll") for (int k = 0; k < 2; ++k) \
        acc[ai][bj][m][n] = __builtin_amdgcn_mfma_f32_16x16x32_bf16(Bt[n][k], At[m][k], acc[ai][bj][m][n], 0, 0, 0); __builtin_amdgcn_s_setprio(0); } while (0)
#define PG8_WAIT_V(n) asm volatile("s_waitcnt vmcnt(" #n ")" ::: "memory")
#define PG8_WAIT_L(n) asm volatile("s_waitcnt lgkmcnt(" #n ")" ::: "memory")
#define PG8_BAR __builtin_amdgcn_s_barrier()
#define PG8_SCHED __builtin_amdgcn_sched_barrier(0)
    Unit cur, nxt; int ui = 0;
    if (!S.next(0, cur)) return;
    f32x4 acc[2][2][4][2];
#pragma unroll
    for (int a = 0; a < 2; ++a)
#pragma unroll
        for (int b = 0; b < 2; ++b)
#pragma unroll
            for (int m = 0; m < 4; ++m)
#pragma unroll
                for (int n = 0; n < 2; ++n) acc[a][b][m][n] = (f32x4){0.f, 0.f, 0.f, 0.f};
    bf16x8 At[4][2], B0[2][2], B1[2][2];
    unsigned nvA[2][2];
    const char* cA; const char* cB = (const char*)g.Bt + (size_t)cur.pb * tstep;
    if constexpr (GATHER) { cA = (const char*)g.A;
#pragma unroll
        for (int h = 0; h < 2; ++h)
#pragma unroll
            for (int i = 0; i < 2; ++i) voA[h][i] = (unsigned)g.gidx[cur.pm * BM + h * HALF + RA[i]] * (unsigned)(lda * 2) + (unsigned)CA[i] * 2u;
    } else cA = (const char*)g.A + (size_t)cur.pm * tstepA;
    PG8_STAGE(PG8_SB(0, 0), cB, voB); PG8_STAGE(PG8_SB(0, 1), cB + hstep, voB); PG8_STAGE(PG8_SA(0, 0), cA, voA[0]); PG8_STAGE(PG8_SA(0, 1), cA, voA[1]);
    if (wr == 1) PG8_BAR;
    PG8_WAIT_V(2); PG8_BAR;
    PG8_STAGE(PG8_SB(1, 0), cB + kstep, voB); PG8_STAGE(PG8_SA(1, 0), cA + kstep, voA[0]); PG8_STAGE(PG8_SB(1, 1), cB + hstep + kstep, voB);
    PG8_WAIT_V(6); PG8_BAR;
    for (;;) {
        const bool has_next = S.next(ui + 1, nxt);
        const char* nA; const char* nB = has_next ? (const char*)g.Bt + (size_t)nxt.pb * tstep : cB;
        if constexpr (GATHER) { nA = cA;
#pragma unroll
            for (int h = 0; h < 2; ++h)
#pragma unroll
                for (int i = 0; i < 2; ++i) nvA[h][i] = has_next ? (unsigned)g.gidx[nxt.pm * BM + h * HALF + RA[i]] * (unsigned)(lda * 2) + (unsigned)CA[i] * 2u : voA[h][i];
        } else nA = has_next ? (const char*)g.A + (size_t)nxt.pm * tstepA : cA;
#if PROBE_P1 == 2
        const int ntu = cur.fl ? 2 : nt;
#else
        const int ntu = nt;
#endif
#pragma nounroll
        for (int t = 0; t < ntu; t += 2) {
            const bool last = (t == ntu - 2);
            const char* a1 = cA + (size_t)(t + 1) * kstep;
            const char* a2 = last ? nA : cA + (size_t)(t + 2) * kstep; const char* b2 = last ? nB : cB + (size_t)(t + 2) * kstep;
            const char* a3 = a2 + kstep; const char* b3 = b2 + kstep;
            unsigned xA[2][2];
#pragma unroll
            for (int h = 0; h < 2; ++h)
#pragma unroll
                for (int i = 0; i < 2; ++i) xA[h][i] = (GATHER && last) ? nvA[h][i] : voA[h][i];
            PG8_LDB(B0, 0, 0); PG8_LDB(B1, 0, 1); PG8_SCHED; PG8_LDA(At, 0, 0); PG8_STAGE(PG8_SA(1, 1), a1, voA[1]);
            PG8_WAIT_V(8); PG8_WAIT_L(0); PG8_BAR; PG8_MMA(0, 0, At, B0); PG8_MMA(0, 1, At, B1); PG8_BAR; PG8_SCHED;
            PG8_LDA(At, 0, 1); PG8_STAGE(PG8_SB(0, 0), b2, voB); PG8_STAGE(PG8_SB(0, 1), b2 + hstep, voB); PG8_STAGE(PG8_SA(0, 0), a2, xA[0]);
            PG8_WAIT_V(8); PG8_WAIT_L(0); PG8_BAR; PG8_MMA(1, 0, At, B0); PG8_MMA(1, 1, At, B1); PG8_BAR; PG8_SCHED;
            PG8_LDB(B0, 1, 0); PG8_LDB(B1, 1, 1); PG8_SCHED; PG8_LDA(At, 1, 0); PG8_STAGE(PG8_SA(0, 1), a2, xA[1]);
            PG8_WAIT_V(8); PG8_WAIT_L(0); PG8_BAR; PG8_MMA(0, 0, At, B0); PG8_MMA(0, 1, At, B1); PG8_BAR; PG8_SCHED;
            PG8_LDA(At, 1, 1); PG8_STAGE(PG8_SB(1, 0), b3, voB); PG8_STAGE(PG8_SB(1, 1), b3 + hstep, voB); PG8_STAGE(PG8_SA(1, 0), a3, xA[0]);
            PG8_WAIT_V(8); PG8_WAIT_L(0); PG8_BAR; PG8_MMA(1, 0, At, B0); PG8_MMA(1, 1, At, B1); PG8_BAR; PG8_SCHED;
        }
        if (wr == 0) PG8_BAR;
        E(acc, cur, wr, wc, fr, fq);
        if (!has_next) break;
#pragma unroll
        for (int a = 0; a < 2; ++a)
#pragma unroll
            for (int b = 0; b < 2; ++b)
#pragma unroll
                for (int m = 0; m < 4; ++m)
#pragma unroll
                    for (int n = 0; n < 2; ++n) acc[a][b][m][n] = (f32x4){0.f, 0.f, 0.f, 0.f};
        cur = nxt; cA = nA; cB = nB; ++ui;
        if constexpr (GATHER) {
#pragma unroll
            for (int h = 0; h < 2; ++h)
#pragma unroll
                for (int i = 0; i < 2; ++i) voA[h][i] = nvA[h][i];
        }
        if (wr == 1) PG8_BAR;
    }
    PG8_WAIT_V(0);
    PG8_BAR;
#undef PG8_SA
#undef PG8_SB
#undef PG8_STAGE
#undef PG8_LDA
#undef PG8_LDB
#undef PG8_MMA
#undef PG8_WAIT_V
#undef PG8_WAIT_L
#undef PG8_BAR
#undef PG8_SCHED
}
}

#ifndef PROBE_LDS2
#define PROBE_LDS2 0
#endif
#ifndef PROBE_EXP2
#define PROBE_EXP2 0
#endif
#ifndef SOFTMAX_PK
#define SOFTMAX_PK 0
#endif
#ifndef FA_FUSE
#define FA_FUSE 0
#endif
namespace fa {
constexpr int VBYTES_T = 64 * 128;
typedef short v4i16_t __attribute__((ext_vector_type(4)));
__device__ __forceinline__ u32x2 vtr(const LAS unsigned char* p) { return __builtin_bit_cast(u32x2, __builtin_amdgcn_ds_read_tr16_b64_v4i16((LAS v4i16_t*)p)); }
__device__ __forceinline__ float max16(const f32x16& c) { float r;
    asm("v_max3_f32 %0, %1, %2, %3\n\tv_max3_f32 %0, %0, %4, %5\n\tv_max3_f32 %0, %0, %6, %7\n\tv_max3_f32 %0, %0, %8, %9\n\tv_max3_f32 %0, %0, %10, %11\n\tv_max3_f32 %0, %0, %12, %13\n\tv_max3_f32 %0, %0, %14, %15\n\tv_max_f32 %0, %0, %16"
        : "=&v"(r) : "v"(c[0]), "v"(c[1]), "v"(c[2]), "v"(c[3]), "v"(c[4]), "v"(c[5]), "v"(c[6]), "v"(c[7]), "v"(c[8]), "v"(c[9]), "v"(c[10]), "v"(c[11]), "v"(c[12]), "v"(c[13]), "v"(c[14]), "v"(c[15]));
    return r; }
__device__ __forceinline__ void mask_init(f32x16& S, unsigned nw) { float t0, t1, t2, t3, t4, t5, t6, t7, t8, t9, t10, t11, t12, t13, t14, t15;
    asm("v_bfe_i32 %0, %16, 0, 1\n\tv_lshlrev_b32 %0, 23, %0\n\tv_bfe_i32 %1, %16, 1, 1\n\tv_lshlrev_b32 %1, 23, %1\n\tv_bfe_i32 %2, %16, 2, 1\n\tv_lshlrev_b32 %2, 23, %2\n\tv_bfe_i32 %3, %16, 3, 1\n\tv_lshlrev_b32 %3, 23, %3\n\tv_bfe_i32 %4, %16, 8, 1\n\tv_lshlrev_b32 %4, 23, %4\n\tv_bfe_i32 %5, %16, 9, 1\n\tv_lshlrev_b32 %5, 23, %5\n\tv_bfe_i32 %6, %16, 10, 1\n\tv_lshlrev_b32 %6, 23, %6\n\tv_bfe_i32 %7, %16, 11, 1\n\tv_lshlrev_b32 %7, 23, %7\n\tv_bfe_i32 %8, %16, 16, 1\n\tv_lshlrev_b32 %8, 23, %8\n\tv_bfe_i32 %9, %16, 17, 1\n\tv_lshlrev_b32 %9, 23, %9\n\tv_bfe_i32 %10, %16, 18, 1\n\tv_lshlrev_b32 %10, 23, %10\n\tv_bfe_i32 %11, %16, 19, 1\n\tv_lshlrev_b32 %11, 23, %11\n\tv_bfe_i32 %12, %16, 24, 1\n\tv_lshlrev_b32 %12, 23, %12\n\tv_bfe_i32 %13, %16, 25, 1\n\tv_lshlrev_b32 %13, 23, %13\n\tv_bfe_i32 %14, %16, 26, 1\n\tv_lshlrev_b32 %14, 23, %14\n\tv_bfe_i32 %15, %16, 27, 1\n\tv_lshlrev_b32 %15, 23, %15"
        : "=&v"(t0), "=&v"(t1), "=&v"(t2), "=&v"(t3), "=&v"(t4), "=&v"(t5), "=&v"(t6), "=&v"(t7), "=&v"(t8), "=&v"(t9), "=&v"(t10), "=&v"(t11), "=&v"(t12), "=&v"(t13), "=&v"(t14), "=&v"(t15) : "v"(nw));
    S[0] = t0; S[1] = t1; S[2] = t2; S[3] = t3; S[4] = t4; S[5] = t5; S[6] = t6; S[7] = t7; S[8] = t8; S[9] = t9; S[10] = t10; S[11] = t11; S[12] = t12; S[13] = t13; S[14] = t14; S[15] = t15; }
struct Params {
    const bf16* Q;  int q_pitch;
    const bf16* K1; int k1_pitch, k1_col;
    const bf16* K2; int k2_pitch, k2_col;
    const bf16* V;  int v_pitch, v_col;
    bf16* O; int o_pitch;
    float* LSE; int lse_pitch;
    const unsigned* BM;
    int CL, W;
};
struct UnitDesc { int seq0, qw, q_col, o_col, lse_col, k1_col, v_col, kt_lo, kt_hi; };
template <int DQK, int MODE, int NH, class DescFn>
__device__ __forceinline__ void attn_stream(const Params& P, LAS unsigned char* lds, const int tid, const int n_units, DescFn desc) {
    constexpr int NKS = DQK / 16, AHEAD = (NH == 2 ? 3 : 4), NST = AHEAD + 1, K1B = 8192 * NH, K2B = (DQK == 96 ? 4096 : 0), BMOFF = K1B + K2B + 8192 * NH, STB = BMOFF + (MODE == 1 ? 8192 : 0);
    constexpr int NDMA = 2 * NH + (DQK == 96 ? 1 : 0) + (MODE == 1 ? 1 : 0);
    static_assert(NH == 1 || (DQK == 64 && MODE != 1), "two-head stages: head dim 64 only");
    constexpr bool active = true;
    if (n_units <= 0) return;
    const int lane = tid & 63, r = lane & 31, h = lane >> 5, wave = __builtin_amdgcn_readfirstlane(tid >> 6);
    const int tq_ = (lane & 15) >> 2, tp_ = lane & 3, tg_ = lane >> 4;
    const int hsel = NH == 2 ? (wave >> 2) * 8192 : 0;
    const int vtoff = K1B + K2B + hsel + (4 * h + tq_) * 128, vxb = 2 * (16 * (tg_ & 1) + 4 * tp_), vsw = (tq_ >> 1) & 1;
    const int vx0 = vxb + ((0 ^ vsw) << 6), vx1 = vxb + ((1 ^ vsw) << 6);
    const int s1_ = (r >> 1) & 7, s2_ = (r >> 2) & 3;
    const int k1row = hsel + r * 128, k2row = K1B + r * 64;
    const int row1 = 8 * wave + (lane >> 3), row2 = 16 * (wave & 3) + (lane >> 2);
    const size_t tk1 = (size_t)64 * P.k1_pitch, tk2 = (size_t)64 * P.k2_pitch, tv = (size_t)64 * P.v_pitch;
    const int d_k1 = wave * 1024, d_k2 = K1B + (wave & 3) * 1024, d_v = K1B + K2B + wave * 1024;
    const bf16* src_k1; const bf16* src_v; const bf16* src_k2 = nullptr; const unsigned* bmp = nullptr;
    int ji = -1, kti = 1, kti_hi = 0;
    auto fa_issue = [&](const int st) __attribute__((always_inline)) {
        if (kti > kti_hi) {
            if (ji + 1 < n_units) { ++ji; const UnitDesc t = desc(ji); kti = t.kt_lo; kti_hi = t.kt_hi;
                src_k1 = P.K1 + (size_t)(t.seq0 + row1) * P.k1_pitch + t.k1_col + 8 * ((lane & 7) ^ ((row1 >> 1) & 7));
                src_v = P.V + (size_t)(t.seq0 + row1) * P.v_pitch + t.v_col + 8 * ((lane & 7) ^ (((row1 >> 1) & 1) << 2));
                if constexpr (DQK == 96) src_k2 = P.K2 + (size_t)(t.seq0 + row2) * P.k2_pitch + P.k2_col + 8 * ((lane & 3) ^ ((row2 >> 2) & 3));
                if constexpr (MODE == 1) bmp = P.BM + (size_t)(t.seq0 + t.qw + r) * 64;
            } else kti = kti_hi; }
        LAS unsigned char* sb_ = lds + st * STB;
        __builtin_amdgcn_global_load_lds((const unsigned*)(src_k1 + kti * tk1), (LAS unsigned*)(sb_ + d_k1), 16, 0, 0);
        __builtin_amdgcn_global_load_lds((const unsigned*)(src_v + kti * tv), (LAS unsigned*)(sb_ + d_v), 16, 0, 0);
        if constexpr (NH == 2) {
            __builtin_amdgcn_global_load_lds((const unsigned*)(src_k1 + 64 + kti * tk1), (LAS unsigned*)(sb_ + d_k1 + 8192), 16, 0, 0);
            __builtin_amdgcn_global_load_lds((const unsigned*)(src_v + 64 + kti * tv), (LAS unsigned*)(sb_ + d_v + 8192), 16, 0, 0); }
        if constexpr (DQK == 96) __builtin_amdgcn_global_load_lds((const unsigned*)(src_k2 + kti * tk2), (LAS unsigned*)(sb_ + d_k2), 16, 0, 0);
        if constexpr (MODE == 1) __builtin_amdgcn_global_load_lds(bmp + (kti & ~1) * 2, (LAS unsigned*)(sb_ + BMOFF + wave * 1024), 16, 0, 0);
        ++kti; };
#define FA_ISSUE(TILE, ST) fa_issue(ST)
    int st_is = 0, st_c = 0, st_n = 1;
    bf16x8 qf[NKS];
#define FA_LOADQ(D) do { const bf16* qp_ = P.Q + (size_t)((D).seq0 + (D).qw + r) * P.q_pitch + (D).q_col + 8 * h; \
        _Pragma("unroll") for (int ks = 0; ks < NKS; ++ks) asm volatile("global_load_dwordx4 %0, %1, off offset:%2" : "=&v"(qf[ks]) : "v"(qp_), "n"(32 * ks) : "memory"); } while (0)
#define FA_WAITQ(N) do { if constexpr (NKS == 6) asm volatile("s_waitcnt vmcnt(%6)" : "+v"(qf[0]), "+v"(qf[1]), "+v"(qf[2]), "+v"(qf[3]), "+v"(qf[4]), "+v"(qf[5]) : "n"(N) : "memory"); \
        else asm volatile("s_waitcnt vmcnt(%4)" : "+v"(qf[0]), "+v"(qf[1]), "+v"(qf[2]), "+v"(qf[3]) : "n"(N) : "memory"); } while (0)
    { const UnitDesc d0 = desc(0); FA_LOADQ(d0); FA_WAITQ(0); }
#pragma unroll 1
    for (int ju = 0; ju < n_units; ++ju) {
    const UnitDesc du = desc(ju);
    const int seq0 = du.seq0, qw = du.qw, q_col = du.q_col, o_col = du.o_col, lse_col = du.lse_col, kt_lo = du.kt_lo, kt_hi = du.kt_hi;
    const int q = qw + r;
    const int lo_q = MODE == 0 ? max(q & ~(P.CL - 1), q - P.W) : 0;
    const int qh = q - 4 * h, lqh = lo_q - 4 * h;
    const int lo_w0 = MODE == 0 ? max(qw & ~(P.CL - 1), qw - P.W) : 0;
    const int lo_w1 = MODE == 0 ? max((qw + 31) & ~(P.CL - 1), qw + 31 - P.W) : 0;
#define FA_WAITBAR(N) do { asm volatile("s_waitcnt vmcnt(%0)" :: "n"(N) : "memory"); __builtin_amdgcn_s_barrier(); asm volatile("" ::: "memory"); } while (0)
    f32x16 o0, o1, c0, c1, n0, n1;
#pragma unroll
    for (int i = 0; i < 16; ++i) { o0[i] = 0.f; o1[i] = 0.f; c0[i] = 0.f; c1[i] = 0.f; n0[i] = 0.f; n1[i] = 0.f; }
    float m = -INFINITY, l = 0.f;
#define FA_PART(kt_) (active && (MODE == 0 ? ((kt_) * 64 <= qw + 31 && (kt_) * 64 + 63 >= lo_w0) : ((kt_) * 64 <= qw + 31)))
#define FA_KADDR(SB_, ROFF, ks) ((ks) < 4 ? (SB_) + (ROFF) * 128 + k1row + 16 * ((2 * (ks) + h) ^ s1_) : (SB_) + (ROFF) * 64 + k2row + 16 * ((2 * ((ks) - 4) + h) ^ s2_))
#define FA_QKH(S, SB_, ROFF, NW) do { bf16x8 fa_[NKS]; \
        _Pragma("unroll") for (int ks = 0; ks < NKS; ++ks) fa_[ks] = *(const LAS bf16x8*)FA_KADDR(SB_, ROFF, ks); \
        if (PROBE_LDS2) { _Pragma("unroll") for (int ks = 0; ks < NKS; ++ks) { const bf16x8 fb_ = *(const volatile LAS bf16x8*)FA_KADDR(SB_, (ROFF) ^ 32, ks); asm volatile("" :: "v"(fb_)); } } \
        if constexpr (MODE == 1) {        \
            mask_init(S, NW); \
        } else { _Pragma("unroll") for (int i = 0; i < 16; ++i) S[i] = 0.f; } \
        _Pragma("unroll") for (int ks = 0; ks < NKS; ++ks) S = __builtin_amdgcn_mfma_f32_32x32x16_bf16(fa_[ks], qf[ks], S, 0, 0, 0); \
        __builtin_amdgcn_sched_group_barrier(0x100, NKS, 0); __builtin_amdgcn_sched_group_barrier(0x008, NKS, 0); } while (0)
#define FA_QK(S0, S1, SB_, KT) do { unsigned nwa_ = 0u, nwb_ = 0u; \
        if constexpr (MODE == 1) { const u32x4 bw_ = *(const LAS u32x4*)((SB_) + BMOFF + wave * 1024 + lane * 16);        \
            nwa_ = ~((((KT) & 1) ? bw_.z : bw_.x) >> (4 * h)); nwb_ = ~((((KT) & 1) ? bw_.w : bw_.y) >> (4 * h)); } \
        FA_QKH(S0, SB_, 0, nwa_); FA_QKH(S1, SB_, 32, nwb_); } while (0)
#define FA_QKX(S, SB_, ROFF) do { bf16x8 fa_[NKS]; \
        _Pragma("unroll") for (int ks = 0; ks < NKS; ++ks) fa_[ks] = *(const LAS bf16x8*)FA_KADDR(SB_, ROFF, ks); \
        _Pragma("unroll") for (int i = 0; i < 16; ++i) S[i] = 0.f; \
        _Pragma("unroll") for (int ks = 0; ks < NKS; ++ks) S = __builtin_amdgcn_mfma_f32_32x32x16_bf16(fa_[ks], qf[ks], S, 0, 0, 0); } while (0)
    if (ju == 0) {
#pragma unroll 1
        for (int a = 0; a < AHEAD; ++a) { FA_ISSUE(kt_lo + a, st_is); st_is = st_is + 1; }
        FA_WAITBAR((AHEAD - 2) * NDMA);
    }
    if (FA_PART(kt_lo)) FA_QK(c0, c1, lds + st_c * STB, kt_lo);
    auto fa_step = [&](f32x16& c0, f32x16& c1, f32x16& n0, f32x16& n1, const int kt) __attribute__((always_inline)) {
        FA_ISSUE(kt + AHEAD, st_is); st_is = (st_is + 1 == NST) ? 0 : st_is + 1;
        const bool more1 = kt < kt_hi;
        const bool qnext = !more1 && (ju + 1 < n_units);
        if (qnext) { const UnitDesc dq = desc(ju + 1); FA_LOADQ(dq); }
        const int k0 = kt * 64;
        const bool part_c = FA_PART(kt), part_n = more1 && FA_PART(kt + 1);
        const LAS unsigned char* Sn = lds + st_n * STB; const LAS unsigned char* Vb = lds + st_c * STB;
        const bool fused = FA_FUSE && (DQK == 64) && part_c && part_n;
        if (part_n && !fused) FA_QK(n0, n1, Sn, kt + 1);
        if (part_c) {
            float alpha;
#define FA_SOFTMAX(MASKED) do { \
            if (MASKED) { if constexpr (MODE == 2) { const int qa = qh - k0, qa1 = qa - 32; \
                    _Pragma("unroll") for (int i = 0; i < 16; ++i) { const int ci = (i & 3) + 8 * (i >> 2); \
                        c0[i] = (ci > qa) ? -INFINITY : c0[i]; c1[i] = (ci > qa1) ? -INFINITY : c1[i]; } \
                } else if constexpr (MODE == 0) { const int lb = lqh - k0; const unsigned span = (unsigned)(q - lo_q), lb1 = (unsigned)(lb - 32);     \
                    _Pragma("unroll") for (int i = 0; i < 16; ++i) { const int ci = (i & 3) + 8 * (i >> 2); \
                        c0[i] = ((unsigned)(ci - lb) > span) ? -INFINITY : c0[i]; c1[i] = ((unsigned)ci - lb1 > span) ? -INFINITY : c1[i]; } \
                } } \
            float mx = xhalf_max(fmaxf(max16(c0), max16(c1))); \
            const float mn = fmaxf(m, mx); \
            const float ms = (mn == -INFINITY) ? 0.f : mn; \
            alpha = __builtin_amdgcn_exp2f(m - ms); \
            m = mn; \
            float ls = 0.f; \
            if (PROBE_EXP2) { float dm_ = 0.f; _Pragma("unroll") for (int i = 0; i < 16; ++i) { dm_ += __builtin_amdgcn_exp2f(c0[i] - mx) + __builtin_amdgcn_exp2f(c1[i] - mx); } asm volatile("" :: "v"(dm_)); } \
            if (SOFTMAX_PK) { const f32x2 ms2 = {ms, ms}; f32x2 lsa = {0.f, 0.f}, lsb = {0.f, 0.f};            \
              _Pragma("unroll") for (int i = 0; i < 16; i += 2) { \
                  f32x2 ta = {c0[i], c0[i + 1]}, tb = {c1[i], c1[i + 1]}; ta = ta - ms2; tb = tb - ms2; \
                  ta.x = __builtin_amdgcn_exp2f(ta.x); ta.y = __builtin_amdgcn_exp2f(ta.y); tb.x = __builtin_amdgcn_exp2f(tb.x); tb.y = __builtin_amdgcn_exp2f(tb.y); \
                  c0[i] = ta.x; c0[i + 1] = ta.y; c1[i] = tb.x; c1[i + 1] = tb.y; lsa = lsa + ta; lsb = lsb + tb; } \
              lsa = lsa + lsb; ls = lsa.x + lsa.y; \
            } else {        \
              _Pragma("unroll") for (int i = 0; i < 16; ++i) { c0[i] = __builtin_amdgcn_exp2f(c0[i] - ms); c1[i] = __builtin_amdgcn_exp2f(c1[i] - ms); ls += c0[i] + c1[i]; } } \
            l = l * alpha + ls; } while (0)
            const bool need_mask = MODE == 1 ? false : (MODE == 2 ? (k0 + 63 > qw) : ((k0 + 63 > qw) || (k0 < lo_w1)));
#define FA_FUSED(MASKED) do { FA_QKX(n0, Sn, 0); FA_QKX(n1, Sn, 32); FA_SOFTMAX(MASKED); \
            _Pragma("unroll") for (int hh_ = 0; hh_ < 2; ++hh_) { \
                __builtin_amdgcn_sched_group_barrier(0x100, NKS, 0); \
                _Pragma("unroll") for (int i = 0; i < NKS; ++i) { __builtin_amdgcn_sched_group_barrier(0x008, 1, 0); __builtin_amdgcn_sched_group_barrier(0x002, 120 / (2 * NKS), 0); } } } while (0)
            if (fused) { if (need_mask) FA_FUSED(true); else FA_FUSED(false); }
            else { if (need_mask) FA_SOFTMAX(true); else FA_SOFTMAX(false); }
#undef FA_FUSED
#undef FA_SOFTMAX
            if (!__all(alpha == 1.0f)) {
#pragma unroll
                for (int i = 0; i < 16; ++i) { o0[i] *= alpha; o1[i] *= alpha; } }
#pragma unroll
            for (int kb = 0; kb < 2; ++kb) {
                const f32x16& s = kb ? c1 : c0;
                u32x2 va[2][2], vb[2][2];
                const unsigned vaddr = (unsigned)(size_t)(Vb + (32 * kb) * 128 + vtoff);
#pragma unroll
                for (int sk = 0; sk < 2; ++sk) {
                    asm volatile("ds_read_b64_tr_b16 %0, %1" : "=&v"(va[sk][0]) : "v"(vaddr + (unsigned)(sk * 2048 + vx0)) : "memory");
                    asm volatile("ds_read_b64_tr_b16 %0, %1" : "=&v"(vb[sk][0]) : "v"(vaddr + (unsigned)(sk * 2048 + 1024 + vx0)) : "memory");
                    asm volatile("ds_read_b64_tr_b16 %0, %1" : "=&v"(va[sk][1]) : "v"(vaddr + (unsigned)(sk * 2048 + vx1)) : "memory");
                    asm volatile("ds_read_b64_tr_b16 %0, %1" : "=&v"(vb[sk][1]) : "v"(vaddr + (unsigned)(sk * 2048 + 1024 + vx1)) : "memory");
                }
                bf16x8 pf[2];
#pragma unroll
                for (int sk = 0; sk < 2; ++sk) { u32x4 pw; pw.x = pk2(s[8 * sk + 0], s[8 * sk + 1]); pw.y = pk2(s[8 * sk + 2], s[8 * sk + 3]); pw.z = pk2(s[8 * sk + 4], s[8 * sk + 5]); pw.w = pk2(s[8 * sk + 6], s[8 * sk + 7]); pf[sk] = __builtin_bit_cast(bf16x8, pw); }
                asm volatile("s_waitcnt lgkmcnt(0)" : "+v"(va[0][0]), "+v"(vb[0][0]), "+v"(va[0][1]), "+v"(vb[0][1]), "+v"(va[1][0]), "+v"(vb[1][0]), "+v"(va[1][1]), "+v"(vb[1][1]) :: "memory");
                __builtin_amdgcn_sched_barrier(0);
#pragma unroll
                for (int sk = 0; sk < 2; ++sk) {
                    const u32x4 v0w = {va[sk][0].x, va[sk][0].y, vb[sk][0].x, vb[sk][0].y}, v1w = {va[sk][1].x, va[sk][1].y, vb[sk][1].x, vb[sk][1].y};
                    o0 = __builtin_amdgcn_mfma_f32_32x32x16_bf16(__builtin_bit_cast(bf16x8, v0w), pf[sk], o0, 0, 0, 0);
                    o1 = __builtin_amdgcn_mfma_f32_32x32x16_bf16(__builtin_bit_cast(bf16x8, v1w), pf[sk], o1, 0, 0, 0);
                }
            }
        }
        if (qnext) FA_WAITBAR((AHEAD - 2) * NDMA + NKS); else FA_WAITBAR((AHEAD - 2) * NDMA);
        st_c = st_n; st_n = (st_n + 1 == NST) ? 0 : st_n + 1;
    };
    for (int kt = kt_lo;;) { fa_step(c0, c1, n0, n1, kt); if (++kt > kt_hi) break; fa_step(n0, n1, c0, c1, kt); if (++kt > kt_hi) break; }
#undef FA_PART
#undef FA_QK
#undef FA_QKH
#undef FA_QKX
#undef FA_KADDR
    const float lt = xhalf_sum(l);
    const float inv = 1.0f / lt;
    if (active) {
    bf16* op = P.O + (size_t)(seq0 + q) * P.o_pitch + o_col + 8 * h;
#pragma unroll
    for (int db = 0; db < 2; ++db) {
        const f32x16& o = db ? o1 : o0;
#pragma unroll
        for (int j = 0; j < 2; ++j) {
            u32x2 X, Y;
            X.x = pk2(o[8 * j] * inv, o[8 * j + 1] * inv); X.y = pk2(o[8 * j + 2] * inv, o[8 * j + 3] * inv);
            Y.x = pk2(o[8 * j + 4] * inv, o[8 * j + 5] * inv); Y.y = pk2(o[8 * j + 6] * inv, o[8 * j + 7] * inv);
            const auto a = __builtin_amdgcn_permlane32_swap(X.x, Y.x, false, false); const auto b = __builtin_amdgcn_permlane32_swap(X.y, Y.y, false, false);
            u32x4 w; w.x = a[0]; w.y = b[0]; w.z = a[1]; w.w = b[1];
            stg16<NT_ATT>(op + 32 * db + 16 * j, w);
        }
    }
    if (P.LSE && h == 0) P.LSE[(size_t)(seq0 + q) * P.lse_pitch + lse_col] = m + __builtin_amdgcn_logf(lt);
    }
    __builtin_amdgcn_sched_barrier(0);
    FA_WAITQ(4);
    }
    asm volatile("s_waitcnt vmcnt(0)" ::: "memory"); __builtin_amdgcn_s_barrier(); asm volatile("" ::: "memory");
#undef FA_ISSUE
#undef FA_LOADQ
#undef FA_WAITQ
#undef FA_WAITBAR
}
}

struct Args {
    const float* x; const int* pos; const float* w_in; const float* qn; const float* kvn; const float* w_uq; const float* w_ukv; const float* w_o;
    const float* ln1g; const float* ln1b; const float* rgw; const float* rgb; const float* rew; const float* reb;
    const float* wg; const float* wu; const float* wd; const float* ln2g; const float* ln2b;
    float* out; unsigned char* ws; int l_lo, l_hi, ph_lo, ph_hi, use_bar, pad;
};
typedef const __attribute__((address_space(4))) Args CArgs;
struct Ctx { LAS unsigned char* lds; int tid, lane, wave, G, c, vcu; unsigned char* ws; };

struct ColIdent { int off; __device__ __forceinline__ int operator()(int P) const { return off + P; } };
struct ColAdj { __device__ __forceinline__ int operator()(int P) const { const int p = P & 255; return (P & ~255) + 64 * ((p >> 5) & 3) + 32 * (p >> 7) + (p & 31); } };
__device__ __forceinline__ int map_rope32(int p) { return 16 * ((p >> 2) & 1) + 4 * (p >> 3) + (p & 3); }
__device__ __forceinline__ int map_head16(int p) { const int fq = p >> 3; return 16 * (fq >> 1) + 8 * ((p >> 2) & 1) + 4 * (fq & 1) + (p & 3); }
struct ColWin {
    __device__ __forceinline__ int operator()(int P) const {
        const int G = P >> 5, p = P & 31;
        if (G < 8) return 32 * G + p;
        if (G < 12) return 256 + 32 * (G - 8) + p;
        if (G == 12) return 384 + map_rope32(p);
        if (G == 13) return 1056 + p;
        if (G == 14) return 672 + map_head16(p);
        if (G == 15) return 704 + p;
        if (G < 24) { const int hh = (G - 16) >> 1; return 416 + 64 * hh + (((G - 16) & 1) ? 32 + p : map_head16(p)); }
        if (G < 26) return 736 + 32 * (G - 24) + p;
        if (G == 26) return p < 8 ? 1088 + p : -1;
        if (G < 32) return -1;
        if (G < 40) return 800 + 32 * (G - 32) + p;
        if (G < 64) { const int j = G - 40; return 1096 + 64 * (j >> 1) + ((j & 1) ? 32 + p : map_head16(p)); }
        if (G < 88) { const int j = G - 64; return 1096 + 768 + 64 * (j >> 1) + ((j & 1) ? 32 + p : map_head16(p)); }
        return 1096 + 1536 + 32 * (G - 88) + p;
    }
};
struct ColUq {
    __device__ __forceinline__ int operator()(int P) const { const int G = P >> 5, p = P & 31; return 32 * G + ((G % 3 == 2) ? map_rope32(p) : p); }
};
template <class ColFn>
__device__ __forceinline__ void transpose_item(const float* W, int ldw, int kvalid, bf16* WT, int ldt, int k0, int P0, const ColFn& cf, const float* rowscale, LAS float* scr, int lane) {
    const int c = lane & 31, col = cf(P0 + c);
#pragma unroll 8
    for (int i = 0; i < 32; ++i) { const int kk = 2 * i + (lane >> 5), k = k0 + kk; float v = 0.f;
        if (col >= 0 && k < kvalid) { v = W[(size_t)k * ldw + col]; if (rowscale) v *= rowscale[k]; }
        scr[kk * 33 + c] = v; }
    asm volatile("s_waitcnt lgkmcnt(0)" ::: "memory");
    const int cc = lane & 7;
#pragma unroll
    for (int j = 0; j < 4; ++j) { const int n = (lane >> 3) + 8 * j; const LAS float* s = scr + (8 * cc) * 33 + n;
        u32x4 o; o.x = pk2(s[0 * 33], s[1 * 33]); o.y = pk2(s[2 * 33], s[3 * 33]); o.z = pk2(s[4 * 33], s[5 * 33]); o.w = pk2(s[6 * 33], s[7 * 33]);
        *(u32x4*)(WT + (size_t)(P0 + n) * ldt + k0 + 8 * cc) = o; }
    asm volatile("s_waitcnt lgkmcnt(0)" ::: "memory");
}
__device__ __forceinline__ void prologue(const Ctx& X, const CArgs* ap) {
    struct { const float* x; const float *w_in, *qn, *kvn, *w_uq, *w_ukv, *w_o, *rgw, *rew; } a = {ap->x, ap->w_in, ap->qn, ap->kvn, ap->w_uq, ap->w_ukv, ap->w_o, ap->rgw, ap->rew};
    LAS float* scr = (LAS float*)(X.lds + X.wave * 16384);
    const int gw = X.vcu * 8 + X.wave, NGW = X.G * 8;
    constexpr int I_WIN = 16 * 112, I_UQ = 4 * 24, I_UKV = 4 * 32, I_WO = 16 * 32, I_L = I_WIN + I_UQ + I_UKV + I_WO;
    for (int it = gw; it < DEPTH * I_L; it += NGW) {
        const int l = it / I_L; int r = it % I_L;
        if (r < I_WIN) { transpose_item(a.w_in + (size_t)l * DM * IN_COLS, IN_COLS, DM, (bf16*)(X.ws + WS_WIN) + (size_t)l * NIN * DM, DM, 64 * (r / 112), 32 * (r % 112), ColWin{}, nullptr, scr, X.lane); continue; }
        r -= I_WIN;
        if (r < I_UQ) { transpose_item(a.w_uq + (size_t)l * 256 * 768, 768, 256, (bf16*)(X.ws + WS_WUQ) + (size_t)l * 768 * 256, 256, 64 * (r / 24), 32 * (r % 24), ColUq{}, a.qn + l * 256, scr, X.lane); continue; }
        r -= I_UQ;
        if (r < I_UKV) { transpose_item(a.w_ukv + (size_t)l * 128 * 1024, 1024, 128, (bf16*)(X.ws + WS_WUKV) + (size_t)l * 1024 * 256, 256, 64 * (r / 32), 32 * (r % 32), ColAdj{}, a.kvn + l * 128, scr, X.lane); continue; }
        r -= I_UKV;
        transpose_item(a.w_o + (size_t)l * DM * DM, DM, DM, (bf16*)(X.ws + WS_WO) + (size_t)l * DM * DM, DM, 64 * (r / 32), 32 * (r % 32), ColAdj{}, nullptr, scr, X.lane);
    }
    const size_t gt = (size_t)X.vcu * 512 + X.tid, NGT = (size_t)X.G * 512;
    { float* rgt = (float*)(X.ws + WS_RGT); float* ret = (float*)(X.ws + WS_RET);
      for (size_t i = gt; i < (size_t)DEPTH * 4 * DM; i += NGT) { const int l = (int)(i / (4 * DM)), g = (int)(i / DM) & 3, k = (int)(i % DM); rgt[i] = a.rgw[((size_t)l * DM + k) * 4 + g]; }
      for (size_t i = gt; i < (size_t)DEPTH * 32 * DM; i += NGT) { const int l = (int)(i / (32 * DM)), ge = (int)(i / DM) & 31, k = (int)(i % DM); ret[i] = a.rew[(((size_t)l * 4 + (ge >> 3)) * DM + k) * 8 + (ge & 7)]; } }
    { u32x4* z = (u32x4*)(X.ws + WS_T1); for (size_t i = gt; i < (size_t)NT * 256 * 2 / 16; i += NGT) z[i] = (u32x4){0u, 0u, 0u, 0u}; }
    { const f32x4* xs = (const f32x4*)a.x; u32x2* xb = (u32x2*)((unsigned char*)ap->out + XR_OFF);
      for (size_t i = gt; i < (size_t)NT * DM / 4; i += NGT) { const f32x4 v = xs[i]; u32x2 w; w.x = pk2(v[0], v[1]); w.y = pk2(v[2], v[3]); xb[i] = w; } }
}
__device__ __forceinline__ void convert_experts(const Ctx& X, const CArgs* ap, int l) {
    struct { const float *wg, *wu, *wd; } a = {ap->wg, ap->wu, ap->wd};
    LAS float* scr = (LAS float*)(X.lds + X.wave * 16384);
    const int gw = X.vcu * 8 + X.wave, NGW = X.G * 8;
    constexpr int I_GU = 32 * 16 * 16, I_D = 32 * 4 * 32;
    for (int it = gw; it < I_GU + I_D; it += NGW) {
        if (it < I_GU) { const int e = it >> 8, r = it & 255, G32 = r >> 4, kb = r & 15; const int pn = G32 >> 3, r0 = (G32 & 7) * 32; const bool up = r0 >= 128;
            const float* W = (up ? a.wu : a.wg) + ((size_t)l * NEXP + e) * DM * FH;
            transpose_item(W, FH, DM, (bf16*)(X.ws + WS_WGU) + (size_t)e * 512 * DM, DM, 64 * kb, 32 * G32, ColIdent{128 * pn + (r0 & 127) - 32 * G32}, nullptr, scr, X.lane);
        } else { const int r = it - I_GU, e = r >> 7, q = r & 127, kb = q >> 5, pg = q & 31;
            transpose_item(a.wd + ((size_t)l * NEXP + e) * FH * DM, DM, FH, (bf16*)(X.ws + WS_WD) + (size_t)e * DM * FH, FH, 64 * kb, 32 * pg, ColAdj{}, nullptr, scr, X.lane); }
    }
}

struct InProjDesc {
    unsigned char* ws;
    __device__ __forceinline__ pg8::GroupDesc operator()(int pn, int bj, int wc) const {
        using namespace pg8; const int G = 8 * pn + 4 * bj + wc; GroupDesc d; d.kind = GK_PLAIN; d.dst = nullptr; d.pitch = 256; d.col = 0; d.scale = 1.f; d.perm = 0; d.ssq = nullptr; d.ssq_n = 0; d.ssq_i = 0;
        if (G < 8) { d.dst = (bf16*)(ws + WS_CQ); d.col = 32 * G; d.ssq = (float*)(ws + WS_SSQ); d.ssq_n = 8; d.ssq_i = G; }
        else if (G < 12) { d.dst = (bf16*)(ws + WS_T1); d.col = 32 * (G - 8); d.ssq = (float*)(ws + WS_SSQ) + (size_t)NT * 8; d.ssq_n = 4; d.ssq_i = G - 8; }
        else if (G == 12) { d.kind = GK_ROPE32; d.dst = (bf16*)(ws + WS_KPE); d.pitch = 32; d.col = 0; }
        else if (G == 13) { d.kind = GK_IDX8; d.dst = (bf16*)(ws + WS_KI); d.pitch = 32; d.col = 0; }
        else if (G == 14) { d.kind = GK_HEAD16; d.dst = (bf16*)(ws + WS_T1); d.col = 192; }
        else if (G == 15) { d.dst = (bf16*)(ws + WS_T1); d.col = 224; }
        else if (G < 24) { d.kind = ((G - 16) & 1) ? GK_PLAIN : GK_HEAD16; d.dst = (bf16*)(ws + WS_BQ); d.col = 32 * (G - 16); d.scale = QSC64; }
        else if (G < 26) { d.dst = (bf16*)(ws + WS_BV); d.pitch = 64; d.col = 32 * (G - 24); }
        else if (G == 26) { d.kind = GK_WI; d.dst = (bf16*)(ws + WS_WI); }
        else if (G < 32) { d.kind = GK_SKIP; }
        else if (G < 40) { d.kind = GK_IDX8; d.dst = (bf16*)(ws + WS_BQI); d.col = 32 * (G - 32); }
        else if (G < 64) { const int j = G - 40, cfg = j >> 3; d.kind = (j & 1) ? GK_PLAIN : GK_HEAD16; d.dst = (bf16*)(ws + WS_DQ) + (size_t)cfg * NT * 256; d.col = 32 * (j & 7); d.scale = QSC64; d.perm = cfg == 0 ? 0 : (cfg == 1 ? 4 : 16); }
        else if (G < 88) { const int j = G - 64, cfg = j >> 3; d.kind = (j & 1) ? GK_PLAIN : GK_HEAD16; d.dst = (bf16*)(ws + WS_DK) + (size_t)cfg * NT * 256; d.col = 32 * (j & 7); d.perm = cfg == 0 ? 0 : (cfg == 1 ? 4 : 16); }
        else { const int j = G - 88, cfg = j >> 3; d.dst = (bf16*)(ws + WS_DV) + (size_t)cfg * NT * 256; d.col = 32 * (j & 7); d.perm = cfg == 0 ? 0 : (cfg == 1 ? 4 : 16); }
        return d;
    }
};
struct UqDesc {
    unsigned char* ws;
    __device__ __forceinline__ pg8::GroupDesc operator()(int pn, int bj, int wc) const {
        using namespace pg8; const int G = 8 * pn + 4 * bj + wc; GroupDesc d; d.kind = (G % 3 == 2) ? GK_ROPE32 : GK_PLAIN; d.dst = (bf16*)(ws + WS_QA); d.pitch = 768; d.col = 32 * G; d.scale = QSC96; d.perm = 0; d.ssq = nullptr; d.ssq_n = 0; d.ssq_i = 0;
        return d;
    }
};

__device__ __forceinline__ unsigned f16key(float v) { const _Float16 hf = (_Float16)v; const unsigned u = (unsigned)__builtin_bit_cast(unsigned short, hf); return (u ^ ((unsigned)__builtin_amdgcn_sbfe((int)u, 15, 1) | 0x8000u)) & 0xffffu; }
__device__ __forceinline__ unsigned pk_cnt(unsigned acc, unsigned kp2, unsigned mid2, unsigned one2) {
    unsigned t;
    asm("v_pk_sub_u16 %0, %2, %3 clamp\n\tv_pk_min_u16 %0, %0, %4\n\tv_pk_add_u16 %1, %1, %0" : "=&v"(t), "+v"(acc) : "v"(kp2), "s"(mid2), "s"(one2));
    return acc;
}
__device__ __forceinline__ int count_gt(const unsigned (&kp)[16], unsigned mid) {
    const unsigned m2 = __builtin_amdgcn_readfirstlane(mid | (mid << 16)), one2 = __builtin_amdgcn_readfirstlane(0x00010001u);
    unsigned a0 = 0u, a1 = 0u;
#pragma unroll
    for (int i = 0; i < 16; i += 2) { a0 = pk_cnt(a0, kp[i], m2, one2); a1 = pk_cnt(a1, kp[i + 1], m2, one2); }
    unsigned aw; asm("v_pk_add_u16 %0, %1, %2" : "=v"(aw) : "v"(a0), "v"(a1));
    const unsigned c = (aw & 0xffffu) + (aw >> 16);
    int tot = 0;
#pragma unroll
    for (int b = 0; b < 6; ++b) tot += __builtin_popcountll(__ballot((c >> b) & 1u)) << b;
    return tot;
}
__device__ __forceinline__ int wave_scan_incl(int v) {
    v += __builtin_amdgcn_update_dpp(0, v, 0x111, 0xf, 0xf, false); v += __builtin_amdgcn_update_dpp(0, v, 0x112, 0xf, 0xf, false);
    v += __builtin_amdgcn_update_dpp(0, v, 0x114, 0xf, 0xf, false); v += __builtin_amdgcn_update_dpp(0, v, 0x118, 0xf, 0xf, false);
    v += __builtin_amdgcn_update_dpp(0, v, 0x142, 0xa, 0xf, false); v += __builtin_amdgcn_update_dpp(0, v, 0x143, 0xc, 0xf, false);
    return v;
}
__device__ __forceinline__ void radix_pick(const LAS unsigned* hist, int lane, int target, int& B, int& above, int& inbin) {
    const u32x2 hw = *(const LAS u32x2*)(hist + 2 * lane);
    const int c0 = (int)(hw.x & 0xffffu), c1 = (int)(hw.x >> 16), c2 = (int)(hw.y & 0xffffu), c3 = (int)(hw.y >> 16);
    const int tl = (c0 + c1) + (c2 + c3);
    const int pre = wave_scan_incl(tl);
    const int suf = __builtin_amdgcn_readlane(pre, 63) - pre + tl;
    const unsigned long long reach = __ballot(suf >= target);
    const int ls = 63 - __builtin_clzll(reach | 1ull);
    int a = suf - tl, b = 4 * lane + 3, ib = c3;
    if (a + c3 < target) { a += c3; b = 4 * lane + 2; ib = c2; if (a + c2 < target) { a += c2; b = 4 * lane + 1; ib = c1; if (a + c1 < target) { a += c1; b = 4 * lane; ib = c0; } } }
    B = __builtin_amdgcn_readlane(b, ls); above = __builtin_amdgcn_readlane(a, ls); inbin = __builtin_amdgcn_readlane(ib, ls);
}
__device__ __forceinline__ float relu_i(float x) { const int i = __builtin_bit_cast(int, x); return __builtin_bit_cast(float, i > 0 ? i : 0); }
__device__ __forceinline__ void dsa_index_unit(const Ctx& X, int b, int q0) {
    const int lane = X.lane, r = lane & 31, h = lane >> 5; const size_t seq0 = (size_t)b * SEQ; const int t0 = q0 + 4 * X.wave;
    const bf16* BQI = (const bf16*)(X.ws + WS_BQI); const bf16* KI = (const bf16*)(X.ws + WS_KI); const float* WI = (const float*)(X.ws + WS_WI);
    LAS unsigned short* rows = (LAS unsigned short*)(X.lds + X.wave * 16384);
    LAS unsigned char* kbuf = X.lds + LDS_X_OFF;
    const bf16* ap = BQI + (seq0 + t0 + (r >> 3)) * 256 + 32 * (r & 7) + 16 * h;
    const bf16x8 a0 = *(const bf16x8*)ap, a1 = *(const bf16x8*)(ap + 8);
    f32x2 wq[4][2];
#pragma unroll
    for (int j = 0; j < 4; ++j) { const f32x4 w = *(const f32x4*)(WI + (seq0 + t0 + j) * 8 + 4 * h);
        wq[j][0] = (f32x2){w[0] * IDX_SCALE, w[1] * IDX_SCALE}; wq[j][1] = (f32x2){w[2] * IDX_SCALE, w[3] * IDX_SCALE}; }
    const int nch = ((q0 + 31) >> 7) + 1;
    const int skey = X.tid >> 2, spc = X.tid & 3;
    const bf16* sp = KI + (seq0 + skey) * 32 + 8 * spc;
    const int sdst = skey * 64 + ((spc ^ ((skey >> 2) & 3)) << 4);
    u32x4 stg0 = *(const u32x4*)sp, stg1 = stg0, stg2 = stg0, stg3 = stg0;
    if (1 < nch) stg1 = *(const u32x4*)(sp + (size_t)1 * 128 * 32);
    if (2 < nch) stg2 = *(const u32x4*)(sp + (size_t)2 * 128 * 32);
    if (3 < nch) stg3 = *(const u32x4*)(sp + (size_t)3 * 128 * 32);
    *(LAS u32x4*)(kbuf + sdst) = stg0;
    __syncthreads();
#define DSA_STEP(J, RCUR, RNEXT) { const int c = c0 + (J); \
        if (c + 4 < nch) RCUR = *(const u32x4*)(sp + (size_t)(c + 4) * 128 * 32); \
        const LAS unsigned char* kb = kbuf + (c & 1) * 8192; \
        _Pragma("unroll") for (int tq = 0; tq < 4; ++tq) { \
            const int key = 32 * tq + r, sw = (key >> 2) & 3; \
            const bf16x8 b0 = *(const LAS bf16x8*)(kb + key * 64 + (((2 * h) ^ sw) << 4)), b1 = *(const LAS bf16x8*)(kb + key * 64 + (((2 * h + 1) ^ sw) << 4)); \
            f32x16 acc; \
            _Pragma("unroll") for (int i = 0; i < 16; ++i) acc[i] = 0.f; \
            acc = __builtin_amdgcn_mfma_f32_32x32x16_bf16(a0, b0, acc, 0, 0, 0); \
            acc = __builtin_amdgcn_mfma_f32_32x32x16_bf16(a1, b1, acc, 0, 0, 0); \
            float p[4]; \
            _Pragma("unroll") for (int j = 0; j < 4; ++j) {            \
                const f32x2 ra = {relu_i(acc[4 * j]), relu_i(acc[4 * j + 1])}, rb = {relu_i(acc[4 * j + 2]), relu_i(acc[4 * j + 3])}; \
                const f32x2 pp = __builtin_elementwise_fma(rb, wq[j][1], ra * wq[j][0]); \
                p[j] = pp.x + pp.y; } \
            const auto s01 = __builtin_amdgcn_permlane32_swap(__float_as_uint(p[0]), __float_as_uint(p[1]), false, false); \
            const auto s23 = __builtin_amdgcn_permlane32_swap(__float_as_uint(p[2]), __float_as_uint(p[3]), false, false); \
            const float va = __uint_as_float(s01[0]) + __uint_as_float(s01[1]), vb = __uint_as_float(s23[0]) + __uint_as_float(s23[1]); \
            const int hw = 128 * c + 32 * tq + r;                                      \
            rows[h * 2048 + hw] = (unsigned short)f16key(va); \
            rows[(2 + h) * 2048 + hw] = (unsigned short)f16key(vb); \
        } \
        if (c + 1 < nch) *(LAS u32x4*)(kbuf + ((c + 1) & 1) * 8192 + sdst) = RNEXT; \
        __syncthreads(); }
#ifndef REP_SCORE
#define REP_SCORE 1
#endif
#ifndef REP_SEL
#define REP_SEL 1
#endif
    for (int rsc = 0; rsc < REP_SCORE; ++rsc) {
    if (rsc > 0) { stg0 = *(const u32x4*)sp; stg1 = stg0; stg2 = stg0; stg3 = stg0; if (1 < nch) stg1 = *(const u32x4*)(sp + (size_t)1 * 128 * 32); if (2 < nch) stg2 = *(const u32x4*)(sp + (size_t)2 * 128 * 32); if (3 < nch) stg3 = *(const u32x4*)(sp + (size_t)3 * 128 * 32); *(LAS u32x4*)(kbuf + sdst) = stg0; __syncthreads(); }
    for (int c0 = 0; c0 < nch; c0 += 4) {
        DSA_STEP(0, stg0, stg1)
        if (c0 + 1 >= nch) break;
        DSA_STEP(1, stg1, stg2)
        if (c0 + 2 >= nch) break;
        DSA_STEP(2, stg2, stg3)
        if (c0 + 3 >= nch) break;
        DSA_STEP(3, stg3, stg0)
    }
    }
#undef DSA_STEP
    unsigned* BMp = (unsigned*)(X.ws + WS_BM);
#ifndef REP_BIS
#define REP_BIS 1
#endif
#ifndef REP_EMIT
#define REP_EMIT 1
#endif
    for (int rsl = 0; rsl < REP_SEL; ++rsl)
    for (int j = 0; j < 4; ++j) {
        const int t = t0 + j;
        const LAS u32x4* rw = (const LAS u32x4*)(rows + j * 2048) + 4 * lane;
        unsigned kp[16];
#pragma unroll
        for (int v4 = 0; v4 < 4; ++v4) { const u32x4 d = rw[v4]; kp[4 * v4] = d.x; kp[4 * v4 + 1] = d.y; kp[4 * v4 + 2] = d.z; kp[4 * v4 + 3] = d.w; }
        const int nv = t + 1 - 32 * lane;
#pragma unroll
        for (int d = 0; d < 16; ++d) kp[d] &= ((2 * d < nv) ? 0xffffu : 0u) | ((2 * d + 1 < nv) ? 0xffff0000u : 0u);
        unsigned thr = 0u; int need = 0;
        for (int rb_ = 0; rb_ < REP_BIS; ++rb_)
        if (t + 1 > 256) {
            LAS unsigned* hist = (LAS unsigned*)(X.lds + LDS_HIST_OFF + X.wave * 512);
            *(LAS u32x2*)(hist + 2 * lane) = (u32x2){0u, 0u};
#pragma unroll
            for (int d = 0; d < 16; ++d) { const unsigned klo = kp[d] & 0xffffu, khi = kp[d] >> 16;
                if (klo) __hip_atomic_fetch_add(hist + (klo >> 9), (klo & 0x100u) ? 0x10000u : 1u, __ATOMIC_RELAXED, __HIP_MEMORY_SCOPE_WORKGROUP);
                if (khi) __hip_atomic_fetch_add(hist + (khi >> 9), (khi & 0x100u) ? 0x10000u : 1u, __ATOMIC_RELAXED, __HIP_MEMORY_SCOPE_WORKGROUP); }
            int B1, above1, in1; radix_pick(hist, lane, 256, B1, above1, in1);
            *(LAS u32x2*)(hist + 2 * lane) = (u32x2){0u, 0u};
#pragma unroll
            for (int d = 0; d < 16; ++d) { const unsigned klo = kp[d] & 0xffffu, khi = kp[d] >> 16;
                if ((int)(klo >> 8) == B1) __hip_atomic_fetch_add(hist + ((klo & 0xffu) >> 1), (klo & 1u) ? 0x10000u : 1u, __ATOMIC_RELAXED, __HIP_MEMORY_SCOPE_WORKGROUP);
                if ((int)(khi >> 8) == B1) __hip_atomic_fetch_add(hist + ((khi & 0xffu) >> 1), (khi & 1u) ? 0x10000u : 1u, __ATOMIC_RELAXED, __HIP_MEMORY_SCOPE_WORKGROUP); }
            int B2, above2, in2; radix_pick(hist, lane, 256 - above1, B2, above2, in2);
            const unsigned tk = ((unsigned)B1 << 8) | (unsigned)B2;
            const int rest = 256 - (above1 + above2);
            if (rest >= in2) { thr = tk - 1u; need = 0; } else { thr = tk; need = rest; }
        }
        unsigned word = 0u, eqw = 0u;
        const unsigned thr2 = __builtin_amdgcn_readfirstlane(thr | (thr << 16)), one2 = __builtin_amdgcn_readfirstlane(0x00010001u);
#pragma unroll
        for (int d = 0; d < 16; ++d) { unsigned g;
            asm("v_pk_sub_u16 %0, %1, %2 clamp\n\tv_pk_min_u16 %0, %0, %3" : "=&v"(g) : "v"(kp[d]), "s"(thr2), "s"(one2));
            word |= ((g | (g >> 15)) & 3u) << (2 * d); }
        if (need > 0) {
#pragma unroll
            for (int d = 0; d < 16; ++d) { unsigned g; const unsigned x = kp[d] ^ thr2;
                asm("v_pk_min_u16 %0, %1, %2" : "=v"(g) : "v"(x), "s"(one2));
                eqw |= ((~(g | (g >> 15))) & 3u) << (2 * d); }
            if (thr == 0u) eqw = 0u;
            const int ne = __builtin_popcount(eqw); const int inc = wave_scan_incl(ne);
            int take = need - (inc - ne); take = take < 0 ? 0 : (take > ne ? ne : take);
            while (__any(take > 0)) { if (take > 0) { const unsigned lowbit = eqw & (0u - eqw); word |= lowbit; eqw ^= lowbit; --take; } }
        }
        BMp[(seq0 + t) * 64 + lane] = word;
    }
}

__device__ __forceinline__ void dil_combine(const Ctx& X) {
    const bf16* OD = (const bf16*)(X.ws + WS_OD); const float* LS = (const float*)(X.ws + WS_LSE); bf16* O = (bf16*)(X.ws + WS_XB);
    const int gw = X.vcu * 8 + X.wave, NGW = X.G * 8, lane = X.lane, hh = lane >> 4;
    for (int t = gw; t < NT; t += NGW) {
        const int b = t >> 11, s = t & 2047;
        const int r0 = t, r1 = (b << 11) + ((s & 3) << 9) + (s >> 2), r2 = (b << 11) + ((s & 15) << 7) + (s >> 4);
        const float L0 = LS[(size_t)r0 * 4 + hh], L1 = LS[((size_t)NT + r1) * 4 + hh], L2 = LS[((size_t)2 * NT + r2) * 4 + hh];
        const float mx = fmaxf(L0, fmaxf(L1, L2));
        float w0 = __builtin_amdgcn_exp2f(L0 - mx), w1 = __builtin_amdgcn_exp2f(L1 - mx), w2 = __builtin_amdgcn_exp2f(L2 - mx);
        const float inv = 1.0f / (w0 + w1 + w2); w0 *= inv; w1 *= inv; w2 *= inv;
        const u32x2 a = *(const u32x2*)(OD + (size_t)r0 * 256 + 4 * lane), bq = *(const u32x2*)(OD + ((size_t)NT + r1) * 256 + 4 * lane), cq = *(const u32x2*)(OD + ((size_t)2 * NT + r2) * 256 + 4 * lane);
        u32x2 o;
        o.x = pk2(w0 * bflo(a.x) + w1 * bflo(bq.x) + w2 * bflo(cq.x), w0 * bfhi(a.x) + w1 * bfhi(bq.x) + w2 * bfhi(cq.x));
        o.y = pk2(w0 * bflo(a.y) + w1 * bflo(bq.y) + w2 * bflo(cq.y), w0 * bfhi(a.y) + w1 * bfhi(bq.y) + w2 * bfhi(cq.y));
        stg8<NT_ATT>(O + (size_t)t * DM + 768 + 4 * lane, o);
    }
}

__device__ __forceinline__ void ln1_router(const Ctx& X, const CArgs* ap, int l, bool first, bool dummy = false) {
    struct { const float *ln1g, *ln1b, *rgb, *reb; } a = {ap->ln1g, ap->ln1b, ap->rgb, ap->reb}; (void)first;
    const bf16* xin = (const bf16*)((const unsigned char*)ap->out + XR_OFF);
    const bool keep_copy = !LN2_X1B && (l == DEPTH - 1) && !dummy; bf16* XC = (bf16*)(X.ws + WS_KVA);
    const int lane = X.lane; const bf16* MIX = (const bf16*)(X.ws + WS_MIX); bf16* X1B = (bf16*)(X.ws + (dummy ? WS_Y : WS_XB));
    LAS float* reT = (LAS float*)X.lds;
    LAS float* rgT = (LAS float*)(X.lds + LDS_X_OFF);
    LAS int* hist = (LAS int*)(X.lds + LDSCTL_OFF + 256);
    { const u32x4* s1 = (const u32x4*)(X.ws + WS_RET + (size_t)l * 32 * DM * 4); for (int i = X.tid; i < 32 * DM / 4; i += 512) ((LAS u32x4*)reT)[i] = s1[i];
      const u32x4* s2 = (const u32x4*)(X.ws + WS_RGT + (size_t)l * 4 * DM * 4); for (int i = X.tid; i < 4 * DM / 4; i += 512) ((LAS u32x4*)rgT)[i] = s2[i]; }
    f32x4 g[4], bb[4];
#pragma unroll
    for (int j = 0; j < 4; ++j) { g[j] = *(const f32x4*)(a.ln1g + l * DM + 4 * lane + 256 * j); bb[j] = *(const f32x4*)(a.ln1b + l * DM + 4 * lane + 256 * j); }
    const float* rgb = a.rgb + l * 4; const float* reb = a.reb + l * 32;
    for (int rb = X.c; rb < NT / 256; rb += X.G) {
        if (X.tid < 32) hist[X.tid] = 0;
        __syncthreads();
        u32x2 xa[4], xb[4]; u32x2 ma[4], mb[4];
        { const int t = rb * 256 + X.wave * 32;
#pragma unroll
          for (int j = 0; j < 4; ++j) { xa[j] = *(const u32x2*)(xin + (size_t)t * DM + 4 * lane + 256 * j); ma[j] = *(const u32x2*)(MIX + (size_t)t * DM + 4 * lane + 256 * j); }
#pragma unroll
          for (int j = 0; j < 4; ++j) { xb[j] = *(const u32x2*)(xin + (size_t)(t + 1) * DM + 4 * lane + 256 * j); mb[j] = *(const u32x2*)(MIX + (size_t)(t + 1) * DM + 4 * lane + 256 * j); } }
        auto row = [&](u32x2 (&xn)[4], u32x2 (&mn)[4], const int i) __attribute__((always_inline)) {
            const int t = rb * 256 + X.wave * 32 + i;
            f32x4 v[4]; float s = 0.f;
#pragma unroll
            for (int j = 0; j < 4; ++j) { const u32x2 xw = xn[j]; const u32x2 mw = mn[j];
                if (keep_copy) *(u32x2*)(XC + (size_t)t * DM + 4 * lane + 256 * j) = xw;
                v[j][0] = ALPHA * bflo(xw.x) + bflo(mw.x); v[j][1] = ALPHA * bfhi(xw.x) + bfhi(mw.x); v[j][2] = ALPHA * bflo(xw.y) + bflo(mw.y); v[j][3] = ALPHA * bfhi(xw.y) + bfhi(mw.y);
                s += (v[j][0] + v[j][1]) + (v[j][2] + v[j][3]); }
            if (i + 2 < 32) {
#pragma unroll
                for (int j = 0; j < 4; ++j) { xn[j] = *(const u32x2*)(xin + (size_t)(t + 2) * DM + 4 * lane + 256 * j); mn[j] = *(const u32x2*)(MIX + (size_t)(t + 2) * DM + 4 * lane + 256 * j); } }
            const float mean = wave_sum(s) * (1.f / DM); float s2 = 0.f;
#pragma unroll
            for (int j = 0; j < 4; ++j) { v[j] = v[j] - mean; s2 += (v[j][0] * v[j][0] + v[j][1] * v[j][1]) + (v[j][2] * v[j][2] + v[j][3] * v[j][3]); }
            const float rstd = 1.0f / sqrtf(wave_sum(s2) * (1.f / DM) + 1e-5f);
#pragma unroll
            for (int j = 0; j < 4; ++j) { v[j] = v[j] * rstd * g[j] + bb[j];
                u32x2 w; w.x = pk2(v[j][0], v[j][1]); w.y = pk2(v[j][2], v[j][3]); stg8<NT_LN>(X1B + (size_t)t * DM + 4 * lane + 256 * j, w); }
            float lg[4];
#pragma unroll
            for (int gi = 0; gi < 4; ++gi) { f32x2 p2 = {0.f, 0.f};
#pragma unroll
                for (int j = 0; j < 4; ++j) { const f32x4 w = *(const LAS f32x4*)(rgT + gi * DM + 4 * lane + 256 * j);
                    p2 = __builtin_elementwise_fma((f32x2){v[j][0], v[j][1]}, (f32x2){w[0], w[1]}, p2); p2 = __builtin_elementwise_fma((f32x2){v[j][2], v[j][3]}, (f32x2){w[2], w[3]}, p2); }
                lg[gi] = wave_sum(p2.x + p2.y) + rgb[gi]; }
            int gs = 0; float gm = lg[0];
#pragma unroll
            for (int gi = 1; gi < 4; ++gi) if (lg[gi] > gm) { gm = lg[gi]; gs = gi; }
            float den = 0.f;
#pragma unroll
            for (int gi = 0; gi < 4; ++gi) den += __expf(lg[gi] - gm);
            const float ptop = __builtin_amdgcn_rcpf(den);
            gs = __builtin_amdgcn_readfirstlane(gs);
            float le[8];
#pragma unroll
            for (int e = 0; e < 8; ++e) { f32x2 p2 = {0.f, 0.f};
#pragma unroll
                for (int j = 0; j < 4; ++j) { const f32x4 w = *(const LAS f32x4*)(reT + (gs * 8 + e) * DM + 4 * lane + 256 * j);
                    p2 = __builtin_elementwise_fma((f32x2){v[j][0], v[j][1]}, (f32x2){w[0], w[1]}, p2); p2 = __builtin_elementwise_fma((f32x2){v[j][2], v[j][3]}, (f32x2){w[2], w[3]}, p2); }
                le[e] = wave_sum(p2.x + p2.y) + reb[gs * 8 + e]; }
            int e1 = 0; float v1 = le[0];
#pragma unroll
            for (int e = 1; e < 8; ++e) if (le[e] > v1) { v1 = le[e]; e1 = e; }
            int e2 = -1; float v2 = -INFINITY;
#pragma unroll
            for (int e = 0; e < 8; ++e) if (e != e1 && le[e] > v2) { v2 = le[e]; e2 = e; }
            const float wa = __builtin_amdgcn_rcpf(1.0f + __expf(v2 - v1)), wb = 1.0f - wa;
            if (lane == 0) { u32x4 ro; ro.x = (unsigned)(gs * 8 + e1); ro.y = (unsigned)(gs * 8 + e2); ro.z = __builtin_bit_cast(unsigned, ptop * wa); ro.w = __builtin_bit_cast(unsigned, ptop * wb);
                *(u32x4*)(X.ws + WS_ROUTE + (size_t)t * 16) = ro;
                __hip_atomic_fetch_add(hist + gs * 8 + e1, 1, __ATOMIC_RELAXED, __HIP_MEMORY_SCOPE_WORKGROUP); __hip_atomic_fetch_add(hist + gs * 8 + e2, 1, __ATOMIC_RELAXED, __HIP_MEMORY_SCOPE_WORKGROUP); }
        };
#pragma unroll 1
        for (int i = 0; i < 32; i += 2) { row(xa, ma, i); row(xb, mb, i + 1); }
        __syncthreads();
        if (X.tid < 32) ((int*)(X.ws + WS_HIST))[rb * 32 + X.tid] = hist[X.tid];
        __syncthreads();
    }
}

__device__ __forceinline__ void moe_dispatch(const Ctx& X) {
    LAS int* cnt = (LAS int*)(X.lds);
    LAS int* pre = cnt + 32;
    LAS int* ebase = cnt + 64;
    LAS int* wcnt = cnt + 128;
    const int* HIST = (const int*)(X.ws + WS_HIST); int* STOK = (int*)(X.ws + WS_STOK); float* SW = (float*)(X.ws + WS_SW); int* TSLOT = (int*)(X.ws + WS_TSLOT); int* TILEE = (int*)(X.ws + WS_TILEE);
    for (int rb = X.c; rb < NT / 256; rb += X.G) {
        if (X.tid < 64) cnt[X.tid] = 0;
        __syncthreads();
        { const int e = X.tid & 31, part = X.tid >> 5; int sa = 0, sp = 0;
          for (int q = 0; q < 16; ++q) { const int b2 = part * 16 + q; const int hv = HIST[b2 * 32 + e]; sa += hv; if (b2 < rb) sp += hv; }
          __hip_atomic_fetch_add(cnt + e, sa, __ATOMIC_RELAXED, __HIP_MEMORY_SCOPE_WORKGROUP); __hip_atomic_fetch_add(pre + e, sp, __ATOMIC_RELAXED, __HIP_MEMORY_SCOPE_WORKGROUP); }
        __syncthreads();
        if (X.tid < 64) { const int n = X.tid < 32 ? cnt[X.tid] : 0; const int pad = (n + 255) & ~255; int inc = pad;
#pragma unroll
            for (int o = 1; o < 32; o <<= 1) { const int u = __shfl_up(inc, o); if ((X.tid & 63) >= o) inc += u; }
            if (X.tid < 32) { ebase[X.tid] = inc - pad; if (X.tid == 31) ebase[32] = inc; } }
        __syncthreads();
        const int tl = X.tid >> 1, kk = X.tid & 1, t = rb * 256 + tl;
        const u32x4 ro = *(const u32x4*)(X.ws + WS_ROUTE + (size_t)t * 16);
        const int e = (int)(kk ? ro.y : ro.x); const float w = __builtin_bit_cast(float, kk ? ro.w : ro.z);
        int rank = 0;
        for (int ee = 0; ee < 32; ++ee) { const unsigned long long mm = __ballot(e == ee);
            if (e == ee) rank = __builtin_popcountll(mm & ((1ull << X.lane) - 1ull));
            if (X.lane == 0) wcnt[X.wave * 32 + ee] = __builtin_popcountll(mm); }
        __syncthreads();
        int off = 0;
        for (int w2 = 0; w2 < X.wave; ++w2) off += wcnt[w2 * 32 + e];
        const int slot = ebase[e] + pre[e] + off + rank;
        STOK[slot] = t; SW[slot] = w; TSLOT[2 * t + kk] = slot;
        if (rb < 32) { const int e2 = rb; for (int s = ebase[e2] + cnt[e2] + X.tid; s < ebase[e2 + 1]; s += 512) { STOK[s] = 0; SW[s] = 0.f; } }
        if (rb == 0) { const int ntl = ebase[32] >> 8;
            for (int tile = X.tid; tile < ntl; tile += 512) { int ee = 0; while (ee < 31 && ebase[ee + 1] <= tile * 256) ++ee; TILEE[tile] = ee; }
            if (X.tid == 0) TILEE[1024] = ntl; }
        __syncthreads();
    }
}

__device__ __forceinline__ void ln2_phase(const Ctx& X, const CArgs* ap, int l, bool first, bool dummy = false) {
    struct { const float *ln1g, *ln1b, *ln2g, *ln2b; } a = {ap->ln1g, ap->ln1b, ap->ln2g, ap->ln2b}; float* outw = dummy ? (float*)(X.ws + WS_Y + 272 * MiB) : ap->out; (void)first;
    const bool last = (l + 1 == DEPTH);
    const bf16* xin = LN2_X1B ? (const bf16*)(X.ws + WS_XB) : (last ? (const bf16*)(X.ws + WS_KVA) : (const bf16*)((const unsigned char*)ap->out + XR_OFF));
    const int lane = X.lane; const bf16* Y = (const bf16*)(X.ws + WS_Y); const bf16* MIX = (const bf16*)(X.ws + WS_MIX); const int* TSLOT = (const int*)(X.ws + WS_TSLOT); bf16* XBp = dummy ? (bf16*)(X.ws + WS_MIX) : (bf16*)((unsigned char*)ap->out + XR_OFF);
    f32x4 g1[4], b1[4], g[4], bb[4];
#pragma unroll
    for (int j = 0; j < 4; ++j) { g1[j] = *(const f32x4*)(a.ln1g + l * DM + 4 * lane + 256 * j); b1[j] = *(const f32x4*)(a.ln1b + l * DM + 4 * lane + 256 * j);
        g[j] = *(const f32x4*)(a.ln2g + l * DM + 4 * lane + 256 * j); bb[j] = *(const f32x4*)(a.ln2b + l * DM + 4 * lane + 256 * j); }
    for (int rb = X.c; rb < NT / 256; rb += X.G) {
        const int tb = rb * 256 + X.wave * 32;
        const int myslots_a = TSLOT[2 * (tb + (lane & 31))], myslots_b = TSLOT[2 * (tb + (lane & 31)) + 1];
        u32x2 xn[4]; u32x2 mn[4], yan[4], ybn[4];
        { const int sa = __builtin_amdgcn_readlane(myslots_a, 0), sb = __builtin_amdgcn_readlane(myslots_b, 0);
#pragma unroll
          for (int j = 0; j < 4; ++j) { xn[j] = *(const u32x2*)(xin + (size_t)tb * DM + 4 * lane + 256 * j); mn[j] = LN2_X1B ? (u32x2){0u, 0u} : *(const u32x2*)(MIX + (size_t)tb * DM + 4 * lane + 256 * j);
              yan[j] = ldg_s<u32x2>(Y + (size_t)sa * DM + 4 * lane + 256 * j); ybn[j] = ldg_s<u32x2>(Y + (size_t)sb * DM + 4 * lane + 256 * j); } }
        for (int i = 0; i < 32; ++i) {
            const int t = tb + i;
            f32x4 v[4]; float s = 0.f;
#pragma unroll
            for (int j = 0; j < 4; ++j) { const u32x2 xw = xn[j]; const u32x2 mw = mn[j];
                if (LN2_X1B) { v[j][0] = bflo(xw.x); v[j][1] = bfhi(xw.x); v[j][2] = bflo(xw.y); v[j][3] = bfhi(xw.y); }
                else { v[j][0] = ALPHA * bflo(xw.x) + bflo(mw.x); v[j][1] = ALPHA * bfhi(xw.x) + bfhi(mw.x); v[j][2] = ALPHA * bflo(xw.y) + bflo(mw.y); v[j][3] = ALPHA * bfhi(xw.y) + bfhi(mw.y);
                    s += (v[j][0] + v[j][1]) + (v[j][2] + v[j][3]); } }
            u32x2 ya[4], yb[4];
#pragma unroll
            for (int j = 0; j < 4; ++j) { ya[j] = yan[j]; yb[j] = ybn[j]; }
            if (i + 1 < 32) { const int sa = __shfl(myslots_a, i + 1), sb = __shfl(myslots_b, i + 1);
#pragma unroll
                for (int j = 0; j < 4; ++j) { xn[j] = *(const u32x2*)(xin + (size_t)(t + 1) * DM + 4 * lane + 256 * j); if (!LN2_X1B) mn[j] = *(const u32x2*)(MIX + (size_t)(t + 1) * DM + 4 * lane + 256 * j);
                    yan[j] = ldg_s<u32x2>(Y + (size_t)sa * DM + 4 * lane + 256 * j); ybn[j] = ldg_s<u32x2>(Y + (size_t)sb * DM + 4 * lane + 256 * j); } }
            if (!LN2_X1B) { const float mean = wave_sum(s) * (1.f / DM); float s2 = 0.f;
#pragma unroll
              for (int j = 0; j < 4; ++j) { v[j] = v[j] - mean; s2 += (v[j][0] * v[j][0] + v[j][1] * v[j][1]) + (v[j][2] * v[j][2] + v[j][3] * v[j][3]); }
              const float rstd = 1.0f / sqrtf(wave_sum(s2) * (1.f / DM) + 1e-5f);
#pragma unroll
              for (int j = 0; j < 4; ++j) v[j] = v[j] * rstd * g1[j] + b1[j]; }
            s = 0.f;
#pragma unroll
            for (int j = 0; j < 4; ++j) { const f32x4 xv = v[j];
                v[j][0] = ALPHA * xv[0] + (bflo(ya[j].x) + bflo(yb[j].x)); v[j][1] = ALPHA * xv[1] + (bfhi(ya[j].x) + bfhi(yb[j].x)); v[j][2] = ALPHA * xv[2] + (bflo(ya[j].y) + bflo(yb[j].y)); v[j][3] = ALPHA * xv[3] + (bfhi(ya[j].y) + bfhi(yb[j].y));
                s += (v[j][0] + v[j][1]) + (v[j][2] + v[j][3]); }
            const float mean = wave_sum(s) * (1.f / DM); float s2 = 0.f;
#pragma unroll
            for (int j = 0; j < 4; ++j) { v[j] = v[j] - mean; s2 += (v[j][0] * v[j][0] + v[j][1] * v[j][1]) + (v[j][2] * v[j][2] + v[j][3] * v[j][3]); }
            const float rstd = 1.0f / sqrtf(wave_sum(s2) * (1.f / DM) + 1e-5f);
#pragma unroll
            for (int j = 0; j < 4; ++j) { v[j] = v[j] * rstd * g[j] + bb[j];
                if (last || dummy) stgf4<NT_LN>(outw + (size_t)t * DM + 4 * lane + 256 * j, v[j]);
                else { u32x2 w; w.x = pk2(v[j][0], v[j][1]); w.y = pk2(v[j][2], v[j][3]); stg8<NT_LN>(XBp + (size_t)t * DM + 4 * lane + 256 * j, w); } }
        }
    }
}

#ifndef REP_P0
#define REP_P0 1
#endif
#ifndef REP_P5
#define REP_P5 1
#endif
#ifndef REP_P9
#define REP_P9 1
#endif
#ifndef REP_BAR
#define REP_BAR 1
#endif
#ifndef REP_P1
#define REP_P1 1
#endif
#ifndef REP_P2A
#define REP_P2A 1
#endif
#ifndef REP_P2B
#define REP_P2B 1
#endif
#ifndef REP_P2C
#define REP_P2C 1
#endif
#ifndef REP_P2D
#define REP_P2D 1
#endif
#ifndef REP_P3A
#define REP_P3A 1
#endif
#ifndef REP_P3B
#define REP_P3B 1
#endif
#ifndef REP_P3C
#define REP_P3C 1
#endif
#ifndef REP_P4
#define REP_P4 1
#endif
#ifndef REP_P6
#define REP_P6 1
#endif
#ifndef REP_P7
#define REP_P7 1
#endif
#ifndef REP_P8
#define REP_P8 1
#endif
__global__ void __launch_bounds__(512, 2) mk_fwd(Args a) {
    extern __shared__ __attribute__((aligned(16))) unsigned char lds_raw[];
    LAS unsigned char* const lds0 = (LAS unsigned char*)lds_raw;
    for (int u = threadIdx.x; u < (LDS_BYTES - LDSCTL_OFF) / 4; u += 512) ((LAS unsigned*)(lds0 + LDSCTL_OFF))[u] = 0u;
    __syncthreads();
    unsigned* barw = (unsigned*)(a.ws + WS_CTL) + CW_BAR;
    XcdBarrier bar; bar.bar = barw; bar.x = 0; bar.st = nullptr;
    if (a.use_bar) bar = xcd_barrier_post(barw, (volatile LAS unsigned*)(lds0 + LDSCTL_OFF) + 8);
#define MKCTX() Ctx X; const CArgs* ap = (const CArgs*)__builtin_amdgcn_kernarg_segment_ptr(); asm volatile("" : "+s"(ap)); { int t_ = threadIdx.x; asm volatile("" : "+v"(t_)); X.lds = lds0; X.tid = t_; X.lane = t_ & 63; X.wave = __builtin_amdgcn_readfirstlane(t_ >> 6); \
        unsigned char* w_ = ap->ws; X.G = gridDim.x; X.c = blockIdx.x; X.vcu = (X.G % 8 == 0) ? (X.c % 8) * (X.G / 8) + X.c / 8 : X.c; X.ws = w_; }
#ifndef P2M
#define P2M 31
#endif
#ifndef PH_MASK0
#define PH_MASK0 1
#endif
#define GBAR() do { if (a.use_bar) for (int rb_ = 0; rb_ < REP_BAR; ++rb_) xcd_barrier(bar); } while (0)

    if ((PH_MASK0 & 1) && a.l_lo == 0 && a.ph_lo == 0) { MKCTX(); for (int rep = 0; rep < REP_P0; ++rep) { prologue(X, ap); __syncthreads(); } GBAR(); }

    for (int l = a.l_lo; l < a.l_hi; ++l) {
        const int lo = (l == a.l_lo) ? (a.ph_lo < 1 ? 1 : a.ph_lo) : 1, hi = (l == a.l_hi - 1) ? a.ph_hi : 10;
#ifndef PH_MASK
#define PH_MASK 0x3ff
#endif
#define IN(k) (((PH_MASK >> (k)) & 1) && lo <= (k) && (k) < hi)
        if (IN(1)) { MKCTX();
            pg8::Gemm g{(const bf16*)((const unsigned char*)ap->out + XR_OFF), (const bf16*)(X.ws + WS_WIN) + (size_t)l * NIN * DM, DM, nullptr};
            pg8::StaticOrder S; S.init(NT, NIN, X.G, X.c, REP_P1);
            pg8::RopeTabs R{ap->pos};
            pg8::EpiGroups<InProjDesc> E{InProjDesc{X.ws}, R, nullptr, 0, 0.f, 0.f};
            pg8::gemm_phase<pg8::EpiGroups<InProjDesc>, pg8::StaticOrder, false>(X.lds, g, S, E, X.tid);
            GBAR();
        }
        if (IN(2)) { MKCTX();
            {
                pg8::Gemm g{(const bf16*)(X.ws + WS_CQ), (const bf16*)(X.ws + WS_WUQ) + (size_t)l * 768 * 256, 256, nullptr};
                pg8::StaticOrder S; S.init(NT, 768, X.G, X.c, REP_P2A);
                pg8::RopeTabs R{ap->pos};
                pg8::EpiGroups<UqDesc> E{UqDesc{X.ws}, R, (const float*)(X.ws + WS_SSQ), 8, 1.0f / 256.0f, 1e-6f};
                pg8::gemm_phase<pg8::EpiGroups<UqDesc>, pg8::StaticOrder, false>(X.lds, g, S, E, X.tid);
            }
            {
                pg8::Gemm g{(const bf16*)(X.ws + WS_T1), (const bf16*)(X.ws + WS_WUKV) + (size_t)l * 1024 * 256, 256, nullptr};
                pg8::StaticOrder S; S.init(NT, 1024, X.G, X.c, REP_P2A);
                pg8::EpiPlainT<NT_KVA> E{(bf16*)(X.ws + WS_KVA), 1024, (const float*)(X.ws + WS_SSQ) + (size_t)NT * 8, 4, 1.0f / 128.0f, 1e-6f, X.lds + LDS_X_OFF};
                pg8::gemm_phase<decltype(E), pg8::StaticOrder, false>(X.lds, g, S, E, X.tid);
            }
            __syncthreads();
            for (int rep = 0; rep < REP_P2B; ++rep) convert_experts(X, ap, l);
            __syncthreads();
            for (int rep = 0; rep < REP_P2C; ++rep) for (int U = X.vcu; U < NB * 32; U += X.G) { const int b = U >> 5, pr = U & 31;
                dsa_index_unit(X, b, 32 * pr); dsa_index_unit(X, b, 32 * (63 - pr)); }
            __syncthreads();
#pragma unroll 1
            for (int cfg = 0; cfg < 3 * REP_P2D; ++cfg) { const int cfgi = cfg % 3;
                fa::Params P; const size_t co = (size_t)cfgi * NT * 256;
                P.Q = (const bf16*)(X.ws + WS_DQ) + co; P.q_pitch = 256; P.K1 = (const bf16*)(X.ws + WS_DK) + co; P.k1_pitch = 256; P.K2 = nullptr; P.k2_pitch = 0; P.k2_col = 0;
                P.V = (const bf16*)(X.ws + WS_DV) + co; P.v_pitch = 256; P.O = (bf16*)(X.ws + WS_OD) + co; P.o_pitch = 256; P.LSE = (float*)(X.ws + WS_LSE) + (size_t)cfgi * NT * 4; P.lse_pitch = 4; P.BM = nullptr;
                P.CL = cfgi == 0 ? 2048 : (cfgi == 1 ? 512 : 128); P.W = 128;
                const int vcu = X.vcu, G = X.G, wv = X.wave, CLc = P.CL;
                fa::attn_stream<64, 0, 2>(P, X.lds, X.tid, (NB * 2 * 16 - vcu + G - 1) / G, [=](int j) { const int U = vcu + j * G, bh = U >> 4, qb = U & 15, b = bh >> 1, hp = bh & 1;
                    const int q0 = 128 * qb, hh = 2 * hp + (wv >> 2); int klo = q0 & ~(CLc - 1); if (q0 - 128 > klo) klo = q0 - 128;
                    return fa::UnitDesc{b * SEQ, q0 + 32 * (wv & 3), 64 * hh, 64 * hh, hh, 128 * hp, 128 * hp, klo >> 6, (q0 + 127) >> 6}; });
            }
            GBAR();
        }
        if (IN(3)) { MKCTX();
            {   fa::Params P; P.Q = (const bf16*)(X.ws + WS_QA); P.q_pitch = 768; P.K1 = (const bf16*)(X.ws + WS_KVA); P.k1_pitch = 1024; P.K2 = (const bf16*)(X.ws + WS_KPE); P.k2_pitch = 32; P.k2_col = 0;
                P.V = (const bf16*)(X.ws + WS_KVA); P.v_pitch = 1024; P.O = (bf16*)(X.ws + WS_XB); P.o_pitch = DM; P.LSE = nullptr; P.lse_pitch = 0; P.BM = nullptr; P.CL = 2048; P.W = 1 << 20;
                const int vcu = X.vcu, G = X.G, wv = X.wave;
                fa::attn_stream<96, 2, 1>(P, X.lds, X.tid, 2 * ((NB * 8 * 4 - vcu + G - 1) / G), [=](int j) { const int U = vcu + (j >> 1) * G, bh = U >> 2, pr = U & 3, b = bh >> 3, hd = bh & 7;
                    const int qb = (j & 1) ? 7 - pr : pr, q0 = 256 * qb;
                    return fa::UnitDesc{b * SEQ, q0 + 32 * wv, 96 * hd, 64 * hd, 0, 128 * hd, 128 * hd + 64, 0, (q0 + 255) >> 6}; });
            }
            {   fa::Params P; P.Q = (const bf16*)(X.ws + WS_BQ); P.q_pitch = 256; P.K1 = (const bf16*)(X.ws + WS_T1); P.k1_pitch = 256; P.k1_col = 192; P.K2 = nullptr; P.k2_pitch = 0; P.k2_col = 0;
                P.V = (const bf16*)(X.ws + WS_BV); P.v_pitch = 64; P.v_col = 0; P.O = (bf16*)(X.ws + WS_XB); P.o_pitch = DM; P.LSE = nullptr; P.lse_pitch = 0; P.BM = (const unsigned*)(X.ws + WS_BM); P.CL = 2048; P.W = 1 << 20;
                const int hd = X.wave & 3, sub = X.wave >> 2, vcu = X.vcu, G = X.G;
                fa::attn_stream<64, 1, 1>(P, X.lds, X.tid, 2 * ((NB * 16 - vcu + G - 1) / G), [=](int j) { const int U = vcu + (j >> 1) * G, b = U >> 4, pr = U & 15;
                    const int qb = (j & 1) ? 31 - pr : pr, q0 = 64 * qb;
                    return fa::UnitDesc{b * SEQ, q0 + 32 * sub, 64 * hd, 512 + 64 * hd, 0, 192, 0, 0, qb}; });
            }
            for (int rep = 0; rep < REP_P3C; ++rep) dil_combine(X);
            GBAR();
        }
        if (IN(4)) { MKCTX();
            pg8::Gemm g{(const bf16*)(X.ws + WS_XB), (const bf16*)(X.ws + WS_WO) + (size_t)l * DM * DM, DM, nullptr};
            pg8::StaticOrder S; S.init(NT, DM, X.G, X.c, REP_P4);
            pg8::EpiPlainT<NT_MIX> E{(bf16*)(X.ws + WS_MIX), DM, nullptr, 0, 0.f, 0.f, X.lds + LDS_X_OFF};
            pg8::gemm_phase<decltype(E), pg8::StaticOrder, false>(X.lds, g, S, E, X.tid);
            GBAR();
        }
        if (IN(5)) { MKCTX(); if (REP_P5 > 1) ln1_router(X, ap, l, l == 0, true); ln1_router(X, ap, l, l == 0); GBAR(); }
        if (IN(6)) { MKCTX(); for (int rep = 0; rep < REP_P6; ++rep) moe_dispatch(X); GBAR(); }
        if (IN(7)) { MKCTX();
            const int* TILEE = (const int*)(X.ws + WS_TILEE);
            pg8::Gemm g{(const bf16*)(X.ws + WS_XB), (const bf16*)(X.ws + WS_WGU), DM, (const int*)(X.ws + WS_STOK)};
            pg8::GroupedOrder S{TILEE, TILEE[1024], 2, X.G, X.c};
            pg8::EpiGateUpT<NT_H> E{(bf16*)(X.ws + WS_H), (const float*)(X.ws + WS_SW)};
            for (int rep = 0; rep < REP_P7; ++rep) pg8::gemm_phase<decltype(E), pg8::GroupedOrder, true>(X.lds, g, S, E, X.tid);
            GBAR();
        }
        if (IN(8)) { MKCTX();
            const int* TILEE = (const int*)(X.ws + WS_TILEE);
            pg8::Gemm g{(const bf16*)(X.ws + WS_H), (const bf16*)(X.ws + WS_WD), FH, nullptr};
            pg8::GroupedOrder S{TILEE, TILEE[1024], 4, X.G, X.c};
            pg8::EpiPlainT<NT_Y> E{(bf16*)(X.ws + WS_Y), DM, nullptr, 0, 0.f, 0.f, X.lds + LDS_X_OFF};
            for (int rep = 0; rep < REP_P8; ++rep) pg8::gemm_phase<decltype(E), pg8::GroupedOrder, false>(X.lds, g, S, E, X.tid);
            GBAR();
        }
        if (IN(9)) { MKCTX(); if (REP_P9 > 1) ln2_phase(X, ap, l, l == 0, true); ln2_phase(X, ap, l, l == 0); if (!(l == a.l_hi - 1)) GBAR(); }
#undef IN
    }
#undef GBAR
}

extern "C" void kernel_launch(void* const* d_in, const int* in_sizes, int n_in, void* d_out, int out_size, void* d_ws, size_t ws_size, hipStream_t stream) {
    static int grid = 0;
    if (grid == 0) {
        if (n_in != 19 || in_sizes[0] != NT * DM || out_size != NT * DM || ws_size < WS_END) { fprintf(stderr, "kernel_launch: unexpected shapes (n_in %d, in0 %d, out %d, ws %zu < %zu); nothing launched\n", n_in, n_in > 0 ? in_sizes[0] : -1, out_size, ws_size, (size_t)WS_END); grid = -1; return; }
        int dev = 0, cus = 0, per_cu = 0;
        if (hipGetDevice(&dev) != hipSuccess || hipDeviceGetAttribute(&cus, hipDeviceAttributeMultiprocessorCount, dev) != hipSuccess) { grid = -1; return; }
        if (hipFuncSetAttribute((const void*)mk_fwd, hipFuncAttributeMaxDynamicSharedMemorySize, LDS_BYTES) != hipSuccess) { fprintf(stderr, "kernel_launch: hipFuncSetAttribute failed\n"); grid = -1; return; }
        if (hipOccupancyMaxActiveBlocksPerMultiprocessor(&per_cu, (const void*)mk_fwd, 512, LDS_BYTES) != hipSuccess || per_cu < 1) fprintf(stderr, "kernel_launch: occupancy query reports %d\n", per_cu);
        (void)hipGetLastError();
        grid = cus;
    }
    if (grid < 0) return;
    (void)hipMemsetAsync((char*)d_ws + WS_CTL, 0, CTL_BYTES, stream);
    Args a{};
    a.x = (const float*)d_in[0]; a.pos = (const int*)d_in[1]; a.w_in = (const float*)d_in[2]; a.qn = (const float*)d_in[3]; a.kvn = (const float*)d_in[4];
    a.w_uq = (const float*)d_in[5]; a.w_ukv = (const float*)d_in[6]; a.w_o = (const float*)d_in[7]; a.ln1g = (const float*)d_in[8]; a.ln1b = (const float*)d_in[9];
    a.rgw = (const float*)d_in[10]; a.rgb = (const float*)d_in[11]; a.rew = (const float*)d_in[12]; a.reb = (const float*)d_in[13];
    a.wg = (const float*)d_in[14]; a.wu = (const float*)d_in[15]; a.wd = (const float*)d_in[16]; a.ln2g = (const float*)d_in[17]; a.ln2b = (const float*)d_in[18];
    a.out = (float*)d_out; a.ws = (unsigned char*)d_ws; a.pad = 0;
#if MK_MULTI
    a.use_bar = 0;
    a.l_lo = 0; a.l_hi = 0; a.ph_lo = 0; a.ph_hi = 0;
    hipLaunchKernelGGL(mk_fwd, dim3(grid), dim3(512), LDS_BYTES, stream, a);
    for (int l = 0; l < DEPTH; ++l)
        for (int ph = 1; ph < 10; ++ph) { a.l_lo = l; a.l_hi = l + 1; a.ph_lo = ph; a.ph_hi = ph + 1; hipLaunchKernelGGL(mk_fwd, dim3(grid), dim3(512), LDS_BYTES, stream, a); }
#else
    a.use_bar = 1; a.l_lo = 0; a.l_hi = DEPTH; a.ph_lo = 0; a.ph_hi = 10;
    hipLaunchKernelGGL(mk_fwd, dim3(grid), dim3(512), LDS_BYTES, stream, a);
#endif
    const hipError_t le = hipPeekAtLastError();
    if (le != hipSuccess) fprintf(stderr, "kernel_launch: launch failed: %s\n", hipGetErrorName(le));
}
```

```cpp
#include <hip/hip_runtime.h>
#include <cstdio>
#include <cstdint>

#define LAS __attribute__((address_space(3)))
#define GAS __attribute__((address_space(1)))
typedef unsigned short bf16;
typedef short bf16x8 __attribute__((ext_vector_type(8)));
typedef short s16x4 __attribute__((ext_vector_type(4)));
typedef float f32x2 __attribute__((ext_vector_type(2)));
typedef float f32x4 __attribute__((ext_vector_type(4)));
typedef float f32x16 __attribute__((ext_vector_type(16)));
typedef unsigned u32x2 __attribute__((ext_vector_type(2)));
typedef unsigned u32x4 __attribute__((ext_vector_type(4)));
typedef __bf16 bf16x2_t __attribute__((ext_vector_type(2)));

#ifndef MK_MULTI
#define MK_MULTI 0
#endif

constexpr int NB = 32, SEQ = 2048, NT = NB * SEQ, DM = 1024, DEPTH = 4;
constexpr int IN_COLS = 3400, NIN = 3584;
constexpr int NEXP = 32, FH = 256;
constexpr int NSLOT = 2 * NT + NEXP * 256;
constexpr int MAXTILES = NSLOT / 256;
constexpr float ALPHA = 1.681792830507429f;
constexpr float LOG2E = 1.4426950408889634f;
constexpr float QSC64 = 0.125f * LOG2E;
constexpr float QSC96 = 0.10206207261596577f * LOG2E;
constexpr float IDX_SCALE = 0.0625f;

constexpr size_t MiB = 1u << 20;
constexpr size_t WS_CTL = 0, CTL_BYTES = 1 * MiB;
constexpr size_t WS_WIN = 1 * MiB;
constexpr size_t WS_WUQ = 29 * MiB;
constexpr size_t WS_WUKV = WS_WUQ + 3 * MiB / 2;
constexpr size_t WS_WO = WS_WUKV + 2 * MiB;
constexpr size_t WS_RGT = WS_WO + 8 * MiB;
constexpr size_t WS_RET = WS_RGT + 64 * 1024;
constexpr size_t WS_ROPE = 42 * MiB;
constexpr size_t WS_WGU = 56 * MiB;
constexpr size_t WS_WD = 88 * MiB;
constexpr size_t WS_XB = 104 * MiB;
constexpr size_t WS_A = 232 * MiB;
constexpr size_t WS_CQ = WS_A;
constexpr size_t WS_T1 = WS_CQ + 32 * MiB;
constexpr size_t WS_BQ = WS_T1 + 32 * MiB;
constexpr size_t WS_BV = WS_BQ + 32 * MiB;
constexpr size_t WS_WI = WS_BV + 8 * MiB;
constexpr size_t WS_BQI = WS_WI + 2 * MiB;
constexpr size_t WS_SSQ = WS_BQI + 32 * MiB;
constexpr size_t WS_DQ = WS_SSQ + 4 * MiB;
constexpr size_t WS_DK = WS_DQ + 96 * MiB;
constexpr size_t WS_DV = WS_DK + 96 * MiB;
constexpr size_t WS_B = WS_DV + 96 * MiB;
constexpr size_t WS_QA = WS_B;
constexpr size_t WS_KVA = WS_QA + 96 * MiB;
constexpr size_t WS_BM = WS_KVA + 128 * MiB;
constexpr size_t WS_OD = WS_BM + 16 * MiB;
constexpr size_t WS_LSE = WS_OD + 96 * MiB;
constexpr size_t WS_MOE = WS_LSE + 4 * MiB;
constexpr size_t WS_ROUTE = WS_MOE;
constexpr size_t WS_HIST = WS_ROUTE + 1 * MiB;
constexpr size_t WS_STOK = WS_HIST + 64 * 1024;
constexpr size_t WS_SW = WS_STOK + 640 * 1024;
constexpr size_t WS_TSLOT = WS_SW + 640 * 1024;
constexpr size_t WS_TILEE = WS_TSLOT + 512 * 1024;
constexpr size_t WS_KPE = WS_MOE + 4 * MiB;
constexpr size_t WS_KI = WS_KPE + 4 * MiB;
constexpr size_t WS_END = WS_KI + 4 * MiB;
constexpr size_t WS_MIX = WS_A;
constexpr size_t WS_H = WS_A + 128 * MiB;
constexpr size_t WS_Y = WS_H + 68 * MiB;
static_assert(WS_RET + 512 * 1024 <= WS_ROPE && WS_ROPE + 14 * MiB <= WS_WGU && WS_WD + 16 * MiB <= WS_XB && WS_XB + 128 * MiB <= WS_A, "ws map 1");
static_assert(WS_Y + 272 * MiB <= WS_MOE && WS_TILEE + 8192 <= WS_END && WS_END <= 1024 * MiB, "ws map 2");
constexpr size_t ROPE_C16 = 0, ROPE_S16 = (size_t)NT * 16 * 4, ROPE_C8 = 2 * ROPE_S16, ROPE_S8 = ROPE_C8 + (size_t)NT * 8 * 4,
                 ROPE_C4 = ROPE_S8 + (size_t)NT * 8 * 4, ROPE_S4 = ROPE_C4 + (size_t)NT * 4 * 4;

constexpr int CW_BAR = 4096;
constexpr int RING_BYTES = 131072;
constexpr int LDS_X_OFF = 131072;
constexpr int LDSCTL_OFF = 147456;
constexpr int LDS_HIST_OFF = LDSCTL_OFF + 4096;
constexpr int LDS_BYTES = LDS_HIST_OFF + 4096;

#define RLX_AGENT __ATOMIC_RELAXED, __HIP_MEMORY_SCOPE_AGENT
__device__ __forceinline__ unsigned f2bf(float f) { unsigned u = __builtin_bit_cast(unsigned, f); return (u + 0x7fffu + ((u >> 16) & 1u)) >> 16; }
#ifndef Y_FP8
#define Y_FP8 1
#endif
#define Y_SCALE 64.0f
#ifndef LN2_X1B
#define LN2_X1B 1
#endif
constexpr size_t XR_OFF = (size_t)NT * DM * 2;
#ifndef NT_EPI
#define NT_EPI 1
#endif
#ifndef NT_KVA
#define NT_KVA 1
#endif
#ifndef NT_MIX
#define NT_MIX 0
#endif
#ifndef NT_H
#define NT_H 0
#endif
#ifndef NT_Y
#define NT_Y 1
#endif
#ifndef NT_LN
#define NT_LN 0
#endif
#ifndef NT_ATT
#define NT_ATT 1
#endif
#define STG_ASM(W, POL) asm volatile("global_store_dwordx" W " %0, %1, off " POL "\n\ts_nop 1" :: "v"(p), "v"(w))
template <int M, class T> __device__ __forceinline__ void stg_any16(void* p, T w) {
    if constexpr (M == 0) *(T*)p = w; else if constexpr (M == 1) __builtin_nontemporal_store(w, (T*)p);
    else if constexpr (M == 2) STG_ASM("4", "sc1"); else if constexpr (M == 3) STG_ASM("4", "sc0 sc1"); else if constexpr (M == 4) STG_ASM("4", "sc1 nt"); else STG_ASM("4", "sc0 sc1 nt"); }
template <int M> __device__ __forceinline__ void stgf4(void* p, f32x4 w) { stg_any16<M>(p, w); }
template <int M> __device__ __forceinline__ void stg16(void* p, u32x4 w) { stg_any16<M>(p, w); }
template <int M> __device__ __forceinline__ void stg8(void* p, u32x2 w) {
    if constexpr (M == 0) *(u32x2*)p = w; else if constexpr (M == 1) __builtin_nontemporal_store(w, (u32x2*)p);
    else if constexpr (M == 2) STG_ASM("2", "sc1"); else if constexpr (M == 3) STG_ASM("2", "sc0 sc1"); else if constexpr (M == 4) STG_ASM("2", "sc1 nt"); else STG_ASM("2", "sc0 sc1 nt"); }
#ifndef NT_LD
#define NT_LD 1
#endif
template <class T> __device__ __forceinline__ T ldg_s(const void* p) { if constexpr (NT_LD) return __builtin_nontemporal_load((const T*)p); else return *(const T*)p; }
__device__ __forceinline__ unsigned pk2(float lo, float hi) { f32x2 v = {lo, hi}; bf16x2_t b = __builtin_convertvector(v, bf16x2_t); return __builtin_bit_cast(unsigned, b); }
__device__ __forceinline__ float bf2f(unsigned short b) { return __builtin_bit_cast(float, ((unsigned)b) << 16); }
__device__ __forceinline__ float bflo(unsigned w) { return __builtin_bit_cast(float, w << 16); }
__device__ __forceinline__ float bfhi(unsigned w) { return __builtin_bit_cast(float, w & 0xffff0000u); }
template <int CTRL> __device__ __forceinline__ float dppf(float x) { return __builtin_bit_cast(float, __builtin_amdgcn_mov_dpp(__builtin_bit_cast(int, x), CTRL, 0xf, 0xf, true)); }
__device__ __forceinline__ float xhalf_sum(float v) { const auto t = __builtin_amdgcn_permlane32_swap(__float_as_uint(v), __float_as_uint(v), false, false); return __uint_as_float(t[0]) + __uint_as_float(t[1]); }
__device__ __forceinline__ float xhalf_max(float v) { const auto t = __builtin_amdgcn_permlane32_swap(__float_as_uint(v), __float_as_uint(v), false, false); return fmaxf(__uint_as_float(t[0]), __uint_as_float(t[1])); }
__device__ __forceinline__ float wave_sum(float v) {
    v += dppf<0xB1>(v); v += dppf<0x4E>(v); v += dppf<0x141>(v); v += dppf<0x140>(v);
    const auto s = __builtin_amdgcn_permlane16_swap(__float_as_uint(v), __float_as_uint(v), false, false);
    v = __uint_as_float(s[0]) + __uint_as_float(s[1]);
    return xhalf_sum(v);
}
__device__ __forceinline__ int crow(int r, int hi) { return (r & 3) + 8 * (r >> 2) + 4 * hi; }

#define XB_TMO      128
#define XB_XCNT(j)  (256  + 64 * (j))
#define XB_XSUB(j)  (1280 + 64 * (j))
#define XB_XGEN(j)  (2304 + 64 * (j))
#define XB_TOP      3328
#define XB_TOPGEN   3392
#define XCD_BAR_WORDS 3456
#define XB_SPIN_CAP (1u << 18)
__device__ __forceinline__ unsigned xb_ld(unsigned* p)              { return __hip_atomic_load(p, __ATOMIC_RELAXED, __HIP_MEMORY_SCOPE_AGENT); }
__device__ __forceinline__ unsigned xb_add(unsigned* p, unsigned v) { return __hip_atomic_fetch_add(p, v, __ATOMIC_RELAXED, __HIP_MEMORY_SCOPE_AGENT); }
__device__ __forceinline__ unsigned xb_xcc_id() { return (unsigned)__builtin_amdgcn_s_getreg((3 << 11) | 20) & 0xFu; }
#define XB_SPIN(cond, bar) do { unsigned _sp = 0; while (cond) { __builtin_amdgcn_s_sleep(1); \
    if ((++_sp & 255u) == 0u) { if (xb_ld(&(bar)[XB_TMO])) break; if (_sp > XB_SPIN_CAP) { atomicAdd(&(bar)[XB_TMO], 1u); break; } } } } while (0)
struct XcdBarrier { unsigned* bar; unsigned x; volatile LAS unsigned* st; };
__device__ __forceinline__ XcdBarrier xcd_barrier_post(unsigned* bar, volatile LAS unsigned* st) {
    XcdBarrier b; b.bar = bar; b.x = xb_xcc_id(); b.st = st;
    if (threadIdx.x == 0) (void)xb_add(&bar[XB_XCNT(b.x)], 1u);
    return b;
}
__device__ __forceinline__ void xcd_barrier_complete(unsigned* bar, unsigned x, unsigned& nloc, unsigned& nx) {
    const unsigned G = gridDim.x * gridDim.y * gridDim.z;
    unsigned sum, cnt, mine, sp = 0u;
    for (;;) {
        sum = 0u; cnt = 0u; mine = 0u;
#pragma unroll
        for (unsigned j = 0; j < 16; ++j) { const unsigned c = xb_ld(&bar[XB_XCNT(j)]); sum += c; cnt += (c > 0u) ? 1u : 0u; mine = (j == x) ? c : mine; }
        if (sum == G) break;
        __builtin_amdgcn_s_sleep(1);
        if ((++sp & 255u) == 0u) { if (xb_ld(&bar[XB_TMO])) break; if (sp > XB_SPIN_CAP) { atomicAdd(&bar[XB_TMO], 1u); break; } }
    }
    nloc = mine > 0u ? mine : 1u; nx = cnt > 0u ? cnt : 1u;
}
__device__ __forceinline__ void xcd_barrier(const XcdBarrier& b) {
    asm volatile("s_waitcnt vmcnt(0)" ::: "memory");
    __syncthreads();
    if (threadIdx.x == 0) {
        unsigned* bar = b.bar;
        __builtin_amdgcn_s_waitcnt(0);
        unsigned nloc = b.st[0], nx = b.st[1];
        if (nloc == 0u) { xcd_barrier_complete(bar, b.x, nloc, nx); b.st[0] = nloc; b.st[1] = nx; }
        const unsigned old = xb_add(&bar[XB_XSUB(b.x)], 1u);
        const unsigned gen = old / nloc;
        if (old + 1u == (gen + 1u) * nloc) {
            __builtin_amdgcn_fence(__ATOMIC_RELEASE, "agent");
            asm volatile("s_waitcnt vmcnt(0)" ::: "memory");
            const unsigned og = xb_add(&bar[XB_TOP], 1u);
            const unsigned tg = og / nx;
            if (og + 1u == (tg + 1u) * nx) xb_add(&bar[XB_TOPGEN], 1u);
            else XB_SPIN(xb_ld(&bar[XB_TOPGEN]) == tg, bar);
            __builtin_amdgcn_fence(__ATOMIC_ACQUIRE, "agent");
            xb_add(&bar[XB_XGEN(b.x)], 1u);
            asm volatile("s_waitcnt vmcnt(0)" ::: "memory");
        } else {
            XB_SPIN(xb_ld(&bar[XB_XGEN(b.x)]) == gen, bar);
            __builtin_amdgcn_fence(__ATOMIC_ACQUIRE, "agent");
            asm volatile("s_waitcnt vmcnt(0)" ::: "memory");
        }
    }
    __syncthreads();
}

namespace pg8 {
constexpr int BM = 256, BK = 64, HALF = 128, HTB = HALF * BK * 2, STAGE_BYTES = 8 * HTB, NXCD = 8, WGM = 8;
__host__ __device__ __forceinline__ int lds_byte(int r, int c) { const int st = (r >> 4) * 2 + (c >> 5), rr = r & 15, cc = c & 31, ob = rr * 64 + cc * 2; return st * 1024 + (ob ^ (((ob >> 9) & 1) << 5)); }
__host__ __device__ __forceinline__ void stage_rc(int b, int& R, int& C) { const int st = b / 1024, sb = b % 1024, swz = sb ^ (((sb >> 9) & 1) << 5); R = (st >> 1) * 16 + swz / 64; C = (st & 1) * 32 + (swz % 64) / 2; }
__host__ __device__ __forceinline__ int perm32(int rho) { const int n = rho >> 4, i = rho & 15; return 8 * (i >> 2) + 4 * n + (i & 3); }

#ifndef PROBE_P1
#define PROBE_P1 0
#endif
struct Unit { int pm, pn, pb;
#if PROBE_P1
    int fl;
#endif
};
struct Gemm { const bf16* A; const bf16* Bt; int K; const int* gidx; };

__device__ __forceinline__ int xcd_remap(int wgid, int nwg) { const int q = nwg / NXCD, r = nwg % NXCD, xcd = wgid % NXCD, off = wgid / NXCD; return (xcd < r ? xcd * (q + 1) : r * (q + 1) + (xcd - r) * q) + off; }
struct StaticOrder {
    int nM, nN, nwg, G, c, rep;
    __device__ void init(int M, int N, int G_, int c_, int rep_ = 1) { nM = M / BM; nN = N / BM; nwg = nM * nN; G = G_; c = c_; rep = rep_; }
    __device__ bool next(int i, Unit& u) const {
        long L = (long)i * G + c; if (L >= (long)nwg * rep) return false;
#if PROBE_P1
        u.fl = (rep > 1 && L < nwg) ? 1 : 0;
#endif
        L %= nwg;
        const int wgid = xcd_remap((int)L, nwg);
        const int nig = WGM * nN, gid = wgid / nig, fm = gid * WGM, gsz = (nM - fm) < WGM ? (nM - fm) : WGM;
        u.pm = fm + ((wgid % nig) % gsz); u.pn = (wgid % nig) / gsz; u.pb = u.pn; return true;
    }
};
struct GroupedOrder {
    const int* tile_e; int ntiles, npn, G, c;
    __device__ bool next(int i, Unit& u) const {
        const long L = (long)i * G + c; const int nwg = ntiles * npn; if (L >= nwg) return false;
        const int wgid = xcd_remap((int)L, nwg);
        u.pm = wgid / npn; u.pn = wgid % npn; u.pb = tile_e[u.pm] * npn + u.pn;
#if PROBE_P1
        u.fl = 0;
#endif
        return true;
    }
};

__device__ __forceinline__ unsigned cvt_pk_bf16(float lo, float hi) { unsigned r; asm volatile("v_cvt_pk_bf16_f32 %0, %1, %2" : "=v"(r) : "v"(lo), "v"(hi)); return r; }

template <int STM> struct EpiPlainT {
    static constexpr bool PERM = true;
    bf16* O; int ldc; const float* ssq; int ssq_n; float ssq_inv; float eps;
    LAS unsigned char* xl;
    __device__ __forceinline__ void operator()(const f32x4 (&acc)[2][2][4][2], const Unit& u, int wr, int wc, int fr, int fq) const {
        const int lane = fq * 16 + fr; LAS unsigned char* t = xl + (wr * 4 + wc) * 2048;
        const int wsw = fr & 7, rrow = lane >> 3, rch = lane & 7;
#pragma unroll
        for (int ai = 0; ai < 2; ++ai)
#pragma unroll
            for (int m = 0; m < 4; ++m) { const int rowb = u.pm * BM + ai * HALF + wr * 64 + m * 16;
                float sc = 1.f;
                if (ssq) { const f32x4 p = *(const f32x4*)(ssq + (size_t)(rowb + fr) * ssq_n); sc = __builtin_amdgcn_rsqf((p[0] + p[1] + p[2] + p[3]) * ssq_inv + eps); }
#pragma unroll
                for (int bj = 0; bj < 2; ++bj) { const f32x4 v0 = acc[ai][bj][m][0] * sc, v1 = acc[ai][bj][m][1] * sc;
                    u32x4 w; w.x = cvt_pk_bf16(v0[0], v0[1]); w.y = cvt_pk_bf16(v0[2], v0[3]); w.z = cvt_pk_bf16(v1[0], v1[1]); w.w = cvt_pk_bf16(v1[2], v1[3]);
                    *(LAS u32x4*)(t + fr * 128 + 16 * ((4 * bj + fq) ^ wsw)) = w; }
#pragma unroll
                for (int i = 0; i < 2; ++i) { const int rr = 8 * i + rrow;
                    const u32x4 w = *(const LAS u32x4*)(t + rr * 128 + 16 * (rch ^ (rr & 7)));
                    stg16<STM>(O + (size_t)(rowb + rr) * ldc + u.pn * BM + wc * 64 + 8 * rch, w); }
            }
    }
};
template <int STM> struct EpiFp8T {
    static constexpr bool PERM = true;
    unsigned char* O; int ldc; float scale; LAS unsigned char* xl;
    __device__ __forceinline__ void operator()(const f32x4 (&acc)[2][2][4][2], const Unit& u, int wr, int wc, int fr, int fq) const {
        const int lane = fq * 16 + fr; LAS unsigned char* t = xl + (wr * 4 + wc) * 2048;
        const int rrow = lane >> 2, rch = lane & 3;
#pragma unroll
        for (int ai = 0; ai < 2; ++ai)
#pragma unroll
            for (int m = 0; m < 4; ++m) { const int rowb = u.pm * BM + ai * HALF + wr * 64 + m * 16;
#pragma unroll
                for (int bj = 0; bj < 2; ++bj) { f32x4 v0 = acc[ai][bj][m][0] * scale, v1 = acc[ai][bj][m][1] * scale;
#pragma unroll
                    for (int e = 0; e < 4; ++e) { v0[e] = __builtin_amdgcn_fmed3f(v0[e], -448.f, 448.f); v1[e] = __builtin_amdgcn_fmed3f(v1[e], -448.f, 448.f); }
                    int lo = __builtin_amdgcn_cvt_pk_fp8_f32(v0[0], v0[1], 0, false); lo = __builtin_amdgcn_cvt_pk_fp8_f32(v0[2], v0[3], lo, true);
                    int hi = __builtin_amdgcn_cvt_pk_fp8_f32(v1[0], v1[1], 0, false); hi = __builtin_amdgcn_cvt_pk_fp8_f32(v1[2], v1[3], hi, true);
                    *(LAS u32x2*)(t + fr * 64 + 32 * bj + 8 * fq) = (u32x2){(unsigned)lo, (unsigned)hi}; }
                const u32x4 w = *(const LAS u32x4*)(t + lane * 16);
                stg16<STM>(O + (size_t)(rowb + rrow) * ldc + u.pn * BM + wc * 64 + 16 * rch, w); }
    }
};
__device__ __forceinline__ f32x4 fp8x4_to_f32(unsigned w) { const f32x2 a = __builtin_amdgcn_cvt_pk_f32_fp8((int)w, false), b = __builtin_amdgcn_cvt_pk_f32_fp8((int)w, true); return (f32x4){a.x, a.y, b.x, b.y}; }
template <int STM> struct EpiGateUpT {
    static constexpr bool PERM = true;
    bf16* H; const float* sw;
    __device__ __forceinline__ void operator()(const f32x4 (&acc)[2][2][4][2], const Unit& u, int wr, int wc, int fr, int fq) const {
        const int row0 = u.pm * BM + wr * 64 + fr; const int col0 = u.pn * HALF + wc * 32 + 8 * fq;
#pragma unroll
        for (int ai = 0; ai < 2; ++ai)
#pragma unroll
            for (int m = 0; m < 4; ++m) { const int row = row0 + ai * HALF + m * 16; const float w = sw[row]; f32x4 hv[2];
#pragma unroll
                for (int n = 0; n < 2; ++n) { const f32x4 g = acc[ai][0][m][n], up = acc[ai][1][m][n];
#pragma unroll
                    for (int e = 0; e < 4; ++e) { const float sg = g[e] * __builtin_amdgcn_rcpf(1.0f + __builtin_amdgcn_exp2f(-g[e] * LOG2E)); hv[n][e] = sg * up[e] * w; } }
                u32x4 o; o.x = cvt_pk_bf16(hv[0][0], hv[0][1]); o.y = cvt_pk_bf16(hv[0][2], hv[0][3]); o.z = cvt_pk_bf16(hv[1][0], hv[1][1]); o.w = cvt_pk_bf16(hv[1][2], hv[1][3]);
                stg16<STM>(H + (size_t)row * FH + col0, o); }
    }
};

enum { GK_SKIP = 0, GK_PLAIN = 1, GK_ROPE32 = 2, GK_HEAD16 = 3, GK_IDX8 = 4, GK_WI = 5 };
struct GroupDesc { int kind; bf16* dst; int pitch; int col; float scale; int perm; float* ssq; int ssq_n; int ssq_i; };
struct RopeTabs { const int* pos; };
__device__ __forceinline__ int perm_row(int row, int perm) {
    if (perm == 0) return row; const int b = row >> 11, s = row & 2047;
    return perm == 4 ? (b << 11) + ((s & 3) << 9) + (s >> 2) : (b << 11) + ((s & 15) << 7) + (s >> 4);
}
__device__ __forceinline__ void st16(bf16* p, u32x2 a, u32x2 b) { u32x4 w; w.x = a.x; w.y = a.y; w.z = b.x; w.w = b.y; stg16<NT_EPI>(p, w); }
__device__ __forceinline__ u32x2 pk4(f32x4 v) { u32x2 w; w.x = cvt_pk_bf16(v[0], v[1]); w.y = cvt_pk_bf16(v[2], v[3]); return w; }
__device__ __forceinline__ void swap16(u32x2& X, u32x2& Y) {
    const auto a = __builtin_amdgcn_permlane16_swap(X.x, Y.x, false, false); const auto b = __builtin_amdgcn_permlane16_swap(X.y, Y.y, false, false);
    X.x = a[0]; Y.x = a[1]; X.y = b[0]; Y.y = b[1];
}
__device__ __forceinline__ float rope_k(int i, int rd) { return __builtin_amdgcn_exp2f(-18.931568569324174f * (float)(2 * i) / (float)rd) * 0.15915494309189535f; }
__device__ __forceinline__ void rope_cs(float posf, int i0, int rd, f32x4& c, f32x4& s) {
#pragma unroll
    for (int e = 0; e < 4; ++e) { const float f = __builtin_amdgcn_fractf(posf * rope_k(i0 + e, rd)); s[e] = __builtin_amdgcn_sinf(f); c[e] = __builtin_amdgcn_cosf(f); }
}
template <class DescFn> struct EpiGroups {
    static constexpr bool PERM = true;
    DescFn F; RopeTabs R; const float* rs_ssq; int rs_n; float rs_inv, rs_eps;
    __device__ __forceinline__ void operator()(const f32x4 (&acc)[2][2][4][2], const Unit& u, int wr, int wc, int fr, int fq) const {
        const int row0 = u.pm * BM + wr * 64 + fr;
#pragma unroll
        for (int bj = 0; bj < 2; ++bj) {
            const GroupDesc d = F(u.pn, bj, wc);
            if (d.kind == GK_SKIP) continue;
#if PROBE_P1 == 1
            if (u.fl) continue;
#endif
            const int ki0 = d.kind == GK_ROPE32 ? 4 * fq : (d.kind == GK_HEAD16 ? 4 * (fq & 1) : 0), krd = d.kind == GK_ROPE32 ? 32 : (d.kind == GK_HEAD16 ? 16 : 8);
#pragma unroll
            for (int ai = 0; ai < 2; ++ai)
#pragma unroll
                for (int m = 0; m < 4; ++m) {
                    const int row = row0 + ai * HALF + m * 16;
                    float sc = d.scale;
                    if (rs_ssq) { float s = 0.f; for (int i = 0; i < rs_n; ++i) s += rs_ssq[(size_t)row * rs_n + i]; sc *= __builtin_amdgcn_rsqf(s * rs_inv + rs_eps); }
                    f32x4 v0 = acc[ai][bj][m][0], v1 = acc[ai][bj][m][1];
                    if (d.ssq) {
                        float q = (v0[0] * v0[0] + v0[1] * v0[1]) + (v0[2] * v0[2] + v0[3] * v0[3]) + (v1[0] * v1[0] + v1[1] * v1[1]) + (v1[2] * v1[2] + v1[3] * v1[3]);
                        q += __shfl_xor(q, 16); q += __shfl_xor(q, 32);
                        if (fq == 0) d.ssq[(size_t)row * d.ssq_n + d.ssq_i] = q;
                    }
                    v0 = v0 * sc; v1 = v1 * sc;
                    if (d.kind == GK_WI) { if (fq == 0) { float* wp = (float*)d.dst + (size_t)row * 8; *(f32x4*)wp = v0; *(f32x4*)(wp + 4) = v1; } continue; }
                    bf16* rp = d.dst + (size_t)perm_row(row, d.perm) * d.pitch + d.col;
                    if (d.kind == GK_PLAIN) { st16(rp + 8 * fq, pk4(v0), pk4(v1)); }
                    else if (d.kind == GK_IDX8) {
                        f32x4 c, s; rope_cs((float)R.pos[row], ki0, krd, c, s);
                        const f32x4 o1 = fq == 0 ? v0 * c - v1 * s : v0, o2 = fq == 0 ? v1 * c + v0 * s : v1;
                        st16(rp + 8 * fq, pk4(o1), pk4(o2));
                    } else if (d.kind == GK_ROPE32) {
                        f32x4 c, s; rope_cs((float)R.pos[row], ki0, krd, c, s);
                        u32x2 X = pk4(v0 * c - v1 * s), Y = pk4(v1 * c + v0 * s);
                        swap16(X, Y);
                        st16(rp + ((fq & 1) ? 16 + 4 * (fq - 1) : 4 * fq), X, Y);
                    } else {
                        f32x4 c, s; rope_cs((float)R.pos[row], ki0, krd, c, s);
                        u32x2 X = pk4(fq < 2 ? v0 * c - v1 * s : v0), Y = pk4(fq < 2 ? v1 * c + v0 * s : v1);
                        swap16(X, Y);
                        st16(rp + 16 * (fq >> 1) + 8 * (fq & 1), X, Y);
                    }
                }
        }
    }
};

template <class Epi, class Sched, bool GATHER, int LDA = 0>
__device__ __forceinline__ void gemm_phase(LAS unsigned char* lds, const Gemm g, const Sched& S, const Epi& E, const int tid) {
    const int wid = __builtin_amdgcn_readfirstlane(tid >> 6), lane = tid & 63, wr = wid >> 2, wc = wid & 3, fr = lane & 15, fq = lane >> 4;
    const int K = g.K, nt = K / BK, lda = LDA ? LDA : K;
    unsigned voA[2][2], voB[2]; int RA[2], CA[2];
#pragma unroll
    for (int i = 0; i < 2; ++i) { int R, C; stage_rc(tid * 16 + i * 8192, R, C); const int Rb = Epi::PERM ? ((R & ~31) + perm32(R & 31)) : R;
        RA[i] = R; CA[i] = C; voA[0][i] = (unsigned)(R * lda + C) * 2u; voA[1][i] = (unsigned)((R + HALF) * lda + C) * 2u; voB[i] = (unsigned)(Rb * K + C) * 2u; }
    const size_t kstep = (size_t)(BK * 2);
    const size_t hstep = (size_t)HALF * K * 2;
    const size_t tstep = 2 * hstep;
    const size_t tstepA = (size_t)BM * lda * 2;
    const unsigned ldsw = (unsigned)wid * 1024u;
    const int aoff = lds_byte(wr * 64 + fr, fq * 8), boff = lds_byte(wc * 32 + fr, fq * 8);
#define PG8_SA(b, h) (((b) * 2 + (h)) * HTB)
#define PG8_SB(b, h) ((4 + (b) * 2 + (h)) * HTB)
#define PG8_STAGE(bufoff, gbase, voff) do { _Pragma("unroll") for (int _i = 0; _i < 2; ++_i) \
        __builtin_amdgcn_global_load_lds((const unsigned*)((const char*)(gbase) + (voff)[_i]), (LAS unsigned*)(lds + (bufoff) + ldsw + _i * 8192), 16, 0, 0); } while (0)
#define PG8_LDA(dst, b, h) do { _Pragma("unroll") for (int m = 0; m < 4; ++m) _Pragma("unroll") for (int k = 0; k < 2; ++k) dst[m][k] = *(const LAS bf16x8*)(lds + PG8_SA(b, h) + aoff + m * 2048 + k * 1024); } while (0)
#define PG8_LDB(dst, b, h) do { _Pragma("unroll") for (int n = 0; n < 2; ++n) _Pragma("unroll") for (int k = 0; k < 2; ++k) dst[n][k] = *(const LAS bf16x8*)(lds + PG8_SB(b, h) + boff + n * 2048 + k * 1024); } while (0)
#define PG8_MMA(ai, bj, At, Bt) do { __builtin_amdgcn_s_setprio(1); _Pragma("unroll") for (int m = 0; m < 4; ++m) _Pragma("unroll") for (int n = 0; n < 2; ++n) _Pragma("unroll") for (int k = 0; k < 2; ++k) \
        acc[ai][bj][m][n] = __builtin_amdgcn_mfma_f32_16x16x32_bf16(Bt[n][k], At[m][k], acc[ai][bj][m][n], 0, 0, 0); __builtin_amdgcn_s_setprio(0); } while (0)
#define PG8_WAIT_V(n) asm volatile("s_waitcnt vmcnt(" #n ")" ::: "memory")
#define PG8_WAIT_L(n) asm volatile("s_waitcnt lgkmcnt(" #n ")" ::: "memory")
#define PG8_BAR __builtin_amdgcn_s_barrier()
#define PG8_SCHED __builtin_amdgcn_sched_barrier(0)
    Unit cur, nxt; int ui = 0;
    if (!S.next(0, cur)) return;
    f32x4 acc[2][2][4][2];
#pragma unroll
    for (int a = 0; a < 2; ++a)
#pragma unroll
        for (int b = 0; b < 2; ++b)
#pragma unroll
            for (int m = 0; m < 4; ++m)
#pragma unroll
                for (int n = 0; n < 2; ++n) acc[a][b][m][n] = (f32x4){0.f, 0.f, 0.f, 0.f};
    bf16x8 At[4][2], B0[2][2], B1[2][2];
    unsigned nvA[2][2];
    const char* cA; const char* cB = (const char*)g.Bt + (size_t)cur.pb * tstep;
    if constexpr (GATHER) { cA = (const char*)g.A;
#pragma unroll
        for (int h = 0; h < 2; ++h)
#pragma unroll
            for (int i = 0; i < 2; ++i) voA[h][i] = (unsigned)g.gidx[cur.pm * BM + h * HALF + RA[i]] * (unsigned)(lda * 2) + (unsigned)CA[i] * 2u;
    } else cA = (const char*)g.A + (size_t)cur.pm * tstepA;
    PG8_STAGE(PG8_SB(0, 0), cB, voB); PG8_STAGE(PG8_SB(0, 1), cB + hstep, voB); PG8_STAGE(PG8_SA(0, 0), cA, voA[0]); PG8_STAGE(PG8_SA(0, 1), cA, voA[1]);
    if (wr == 1) PG8_BAR;
    PG8_WAIT_V(2); PG8_BAR;
    PG8_STAGE(PG8_SB(1, 0), cB + kstep, voB); PG8_STAGE(PG8_SA(1, 0), cA + kstep, voA[0]); PG8_STAGE(PG8_SB(1, 1), cB + hstep + kstep, voB);
    PG8_WAIT_V(6); PG8_BAR;
    for (;;) {
        const bool has_next = S.next(ui + 1, nxt);
        const char* nA; const char* nB = has_next ? (const char*)g.Bt + (size_t)nxt.pb * tstep : cB;
        if constexpr (GATHER) { nA = cA;
#pragma unroll
            for (int h = 0; h < 2; ++h)
#pragma unroll
                for (int i = 0; i < 2; ++i) nvA[h][i] = has_next ? (unsigned)g.gidx[nxt.pm * BM + h * HALF + RA[i]] * (unsigned)(lda * 2) + (unsigned)CA[i] * 2u : voA[h][i];
        } else nA = has_next ? (const char*)g.A + (size_t)nxt.pm * tstepA : cA;
#if PROBE_P1 == 2
        const int ntu = cur.fl ? 2 : nt;
#else
        const int ntu = nt;
#endif
#pragma nounroll
        for (int t = 0; t < ntu; t += 2) {
            const bool last = (t == ntu - 2);
            const char* a1 = cA + (size_t)(t + 1) * kstep;
            const char* a2 = last ? nA : cA + (size_t)(t + 2) * kstep; const char* b2 = last ? nB : cB + (size_t)(t + 2) * kstep;
            const char* a3 = a2 + kstep; const char* b3 = b2 + kstep;
            unsigned xA[2][2];
#pragma unroll
            for (int h = 0; h < 2; ++h)
#pragma unroll
                for (int i = 0; i < 2; ++i) xA[h][i] = (GATHER && last) ? nvA[h][i] : voA[h][i];
            PG8_LDB(B0, 0, 0); PG8_LDB(B1, 0, 1); PG8_SCHED; PG8_LDA(At, 0, 0); PG8_STAGE(PG8_SA(1, 1), a1, voA[1]);
            PG8_WAIT_V(8); PG8_WAIT_L(0); PG8_BAR; PG8_MMA(0, 0, At, B0); PG8_MMA(0, 1, At, B1); PG8_BAR; PG8_SCHED;
            PG8_LDA(At, 0, 1); PG8_STAGE(PG8_SB(0, 0), b2, voB); PG8_STAGE(PG8_SB(0, 1), b2 + hstep, voB); PG8_STAGE(PG8_SA(0, 0), a2, xA[0]);
            PG8_WAIT_V(8); PG8_WAIT_L(0); PG8_BAR; PG8_MMA(1, 0, At, B0); PG8_MMA(1, 1, At, B1); PG8_BAR; PG8_SCHED;
            PG8_LDB(B0, 1, 0); PG8_LDB(B1, 1, 1); PG8_SCHED; PG8_LDA(At, 1, 0); PG8_STAGE(PG8_SA(0, 1), a2, xA[1]);
            PG8_WAIT_V(8); PG8_WAIT_L(0); PG8_BAR; PG8_MMA(0, 0, At, B0); PG8_MMA(0, 1, At, B1); PG8_BAR; PG8_SCHED;
            PG8_LDA(At, 1, 1); PG8_STAGE(PG8_SB(1, 0), b3, voB); PG8_STAGE(PG8_SB(1, 1), b3 + hstep, voB); PG8_STAGE(PG8_SA(1, 0), a3, xA[0]);
            PG8_WAIT_V(8); PG8_WAIT_L(0); PG8_BAR; PG8_MMA(1, 0, At, B0); PG8_MMA(1, 1, At, B1); PG8_BAR; PG8_SCHED;
        }
        if (wr == 0) PG8_BAR;
        E(acc, cur, wr, wc, fr, fq);
        if (!has_next) break;
#pragma unroll
        for (int a = 0; a < 2; ++a)
#pragma unroll
            for (int b = 0; b < 2; ++b)
#pragma unroll
                for (int m = 0; m < 4; ++m)
#pragma unroll
                    for (int n = 0; n < 2; ++n) acc[a][b][m][n] = (f32x4){0.f, 0.f, 0.f, 0.f};
        cur = nxt; cA = nA; cB = nB; ++ui;
        if constexpr (GATHER) {
#pragma unroll
            for (int h = 0; h < 2; ++h)
#pragma unroll
                for (int i = 0; i < 2; ++i) voA[h][i] = nvA[h][i];
        }
        if (wr == 1) PG8_BAR;
    }
    PG8_WAIT_V(0);
    PG8_BAR;
#undef PG8_SA
#undef PG8_SB
#undef PG8_STAGE
#undef PG8_LDA
#undef PG8_LDB
#undef PG8_MMA
#undef PG8_WAIT_V
#undef PG8_WAIT_L
#undef PG8_BAR
#undef PG8_SCHED
}
}

#ifndef PROBE_LDS2
#define PROBE_LDS2 0
#endif
#ifndef PROBE_EXP2
#define PROBE_EXP2 0
#endif
#ifndef SOFTMAX_PK
#define SOFTMAX_PK 0
#endif
#ifndef FA_FUSE
#define FA_FUSE 0
#endif
namespace fa {
constexpr int VBYTES_T = 64 * 128;
typedef short v4i16_t __attribute__((ext_vector_type(4)));
__device__ __forceinline__ u32x2 vtr(const LAS unsigned char* p) { return __builtin_bit_cast(u32x2, __builtin_amdgcn_ds_read_tr16_b64_v4i16((LAS v4i16_t*)p)); }
__device__ __forceinline__ float max16(const f32x16& c) { float r;
    asm("v_max3_f32 %0, %1, %2, %3\n\tv_max3_f32 %0, %0, %4, %5\n\tv_max3_f32 %0, %0, %6, %7\n\tv_max3_f32 %0, %0, %8, %9\n\tv_max3_f32 %0, %0, %10, %11\n\tv_max3_f32 %0, %0, %12, %13\n\tv_max3_f32 %0, %0, %14, %15\n\tv_max_f32 %0, %0, %16"
        : "=&v"(r) : "v"(c[0]), "v"(c[1]), "v"(c[2]), "v"(c[3]), "v"(c[4]), "v"(c[5]), "v"(c[6]), "v"(c[7]), "v"(c[8]), "v"(c[9]), "v"(c[10]), "v"(c[11]), "v"(c[12]), "v"(c[13]), "v"(c[14]), "v"(c[15]));
    return r; }
__device__ __forceinline__ void mask_init(f32x16& S, unsigned nw) { float t0, t1, t2, t3, t4, t5, t6, t7, t8, t9, t10, t11, t12, t13, t14, t15;
    asm("v_bfe_i32 %0, %16, 0, 1\n\tv_lshlrev_b32 %0, 23, %0\n\tv_bfe_i32 %1, %16, 1, 1\n\tv_lshlrev_b32 %1, 23, %1\n\tv_bfe_i32 %2, %16, 2, 1\n\tv_lshlrev_b32 %2, 23, %2\n\tv_bfe_i32 %3, %16, 3, 1\n\tv_lshlrev_b32 %3, 23, %3\n\tv_bfe_i32 %4, %16, 8, 1\n\tv_lshlrev_b32 %4, 23, %4\n\tv_bfe_i32 %5, %16, 9, 1\n\tv_lshlrev_b32 %5, 23, %5\n\tv_bfe_i32 %6, %16, 10, 1\n\tv_lshlrev_b32 %6, 23, %6\n\tv_bfe_i32 %7, %16, 11, 1\n\tv_lshlrev_b32 %7, 23, %7\n\tv_bfe_i32 %8, %16, 16, 1\n\tv_lshlrev_b32 %8, 23, %8\n\tv_bfe_i32 %9, %16, 17, 1\n\tv_lshlrev_b32 %9, 23, %9\n\tv_bfe_i32 %10, %16, 18, 1\n\tv_lshlrev_b32 %10, 23, %10\n\tv_bfe_i32 %11, %16, 19, 1\n\tv_lshlrev_b32 %11, 23, %11\n\tv_bfe_i32 %12, %16, 24, 1\n\tv_lshlrev_b32 %12, 23, %12\n\tv_bfe_i32 %13, %16, 25, 1\n\tv_lshlrev_b32 %13, 23, %13\n\tv_bfe_i32 %14, %16, 26, 1\n\tv_lshlrev_b32 %14, 23, %14\n\tv_bfe_i32 %15, %16, 27, 1\n\tv_lshlrev_b32 %15, 23, %15"
        : "=&v"(t0), "=&v"(t1), "=&v"(t2), "=&v"(t3), "=&v"(t4), "=&v"(t5), "=&v"(t6), "=&v"(t7), "=&v"(t8), "=&v"(t9), "=&v"(t10), "=&v"(t11), "=&v"(t12), "=&v"(t13), "=&v"(t14), "=&v"(t15) : "v"(nw));
    S[0] = t0; S[1] = t1; S[2] = t2; S[3] = t3; S[4] = t4; S[5] = t5; S[6] = t6; S[7] = t7; S[8] = t8; S[9] = t9; S[10] = t10; S[11] = t11; S[12] = t12; S[13] = t13; S[14] = t14; S[15] = t15; }
struct Params {
    const bf16* Q;  int q_pitch;
    const bf16* K1; int k1_pitch, k1_col;
    const bf16* K2; int k2_pitch, k2_col;
    const bf16* V;  int v_pitch, v_col;
    bf16* O; int o_pitch;
    float* LSE; int lse_pitch;
    const unsigned* BM;
    int CL, W;
};
struct UnitDesc { int seq0, qw, q_col, o_col, lse_col, k1_col, v_col, kt_lo, kt_hi; };
template <int DQK, int MODE, int NH, class DescFn>
__device__ __forceinline__ void attn_stream(const Params& P, LAS unsigned char* lds, const int tid, const int n_units, DescFn desc) {
    constexpr int NKS = DQK / 16, AHEAD = (NH == 2 ? 3 : 4), NST = AHEAD + 1, K1B = 8192 * NH, K2B = (DQK == 96 ? 4096 : 0), BMOFF = K1B + K2B + 8192 * NH, STB = BMOFF + (MODE == 1 ? 8192 : 0);
    constexpr int NDMA = 2 * NH + (DQK == 96 ? 1 : 0) + (MODE == 1 ? 1 : 0);
    static_assert(NH == 1 || (DQK == 64 && MODE != 1), "two-head stages: head dim 64 only");
    constexpr bool active = true;
    if (n_units <= 0) return;
    const int lane = tid & 63, r = lane & 31, h = lane >> 5, wave = __builtin_amdgcn_readfirstlane(tid >> 6);
    const int tq_ = (lane & 15) >> 2, tp_ = lane & 3, tg_ = lane >> 4;
    const int hsel = NH == 2 ? (wave >> 2) * 8192 : 0;
    const int vtoff = K1B + K2B + hsel + (4 * h + tq_) * 128, vxb = 2 * (16 * (tg_ & 1) + 4 * tp_), vsw = (tq_ >> 1) & 1;
    const int vx0 = vxb + ((0 ^ vsw) << 6), vx1 = vxb + ((1 ^ vsw) << 6);
    const int s1_ = (r >> 1) & 7, s2_ = (r >> 2) & 3;
    const int k1row = hsel + r * 128, k2row = K1B + r * 64;
    const int row1 = 8 * wave + (lane >> 3), row2 = 16 * (wave & 3) + (lane >> 2);
    const size_t tk1 = (size_t)64 * P.k1_pitch, tk2 = (size_t)64 * P.k2_pitch, tv = (size_t)64 * P.v_pitch;
    const int d_k1 = wave * 1024, d_k2 = K1B + (wave & 3) * 1024, d_v = K1B + K2B + wave * 1024;
    const bf16* src_k1; const bf16* src_v; const bf16* src_k2 = nullptr; const unsigned* bmp = nullptr;
    int ji = -1, kti = 1, kti_hi = 0;
    auto fa_issue = [&](const int st) __attribute__((always_inline)) {
        if (kti > kti_hi) {
            if (ji + 1 < n_units) { ++ji; const UnitDesc t = desc(ji); kti = t.kt_lo; kti_hi = t.kt_hi;
                src_k1 = P.K1 + (size_t)(t.seq0 + row1) * P.k1_pitch + t.k1_col + 8 * ((lane & 7) ^ ((row1 >> 1) & 7));
                src_v = P.V + (size_t)(t.seq0 + row1) * P.v_pitch + t.v_col + 8 * ((lane & 7) ^ (((row1 >> 1) & 1) << 2));
                if constexpr (DQK == 96) src_k2 = P.K2 + (size_t)(t.seq0 + row2) * P.k2_pitch + P.k2_col + 8 * ((lane & 3) ^ ((row2 >> 2) & 3));
                if constexpr (MODE == 1) bmp = P.BM + (size_t)(t.seq0 + t.qw + r) * 64;
            } else kti = kti_hi; }
        LAS unsigned char* sb_ = lds + st * STB;
        __builtin_amdgcn_global_load_lds((const unsigned*)(src_k1 + kti * tk1), (LAS unsigned*)(sb_ + d_k1), 16, 0, 0);
        __builtin_amdgcn_global_load_lds((const unsigned*)(src_v + kti * tv), (LAS unsigned*)(sb_ + d_v), 16, 0, 0);
        if constexpr (NH == 2) {
            __builtin_amdgcn_global_load_lds((const unsigned*)(src_k1 + 64 + kti * tk1), (LAS unsigned*)(sb_ + d_k1 + 8192), 16, 0, 0);
            __builtin_amdgcn_global_load_lds((const unsigned*)(src_v + 64 + kti * tv), (LAS unsigned*)(sb_ + d_v + 8192), 16, 0, 0); }
        if constexpr (DQK == 96) __builtin_amdgcn_global_load_lds((const unsigned*)(src_k2 + kti * tk2), (LAS unsigned*)(sb_ + d_k2), 16, 0, 0);
        if constexpr (MODE == 1) __builtin_amdgcn_global_load_lds(bmp + (kti & ~1) * 2, (LAS unsigned*)(sb_ + BMOFF + wave * 1024), 16, 0, 0);
        ++kti; };
#define FA_ISSUE(TILE, ST) fa_issue(ST)
    int st_is = 0, st_c = 0, st_n = 1;
    bf16x8 qf[NKS];
#define FA_LOADQ(D) do { const bf16* qp_ = P.Q + (size_t)((D).seq0 + (D).qw + r) * P.q_pitch + (D).q_col + 8 * h; \
        _Pragma("unroll") for (int ks = 0; ks < NKS; ++ks) asm volatile("global_load_dwordx4 %0, %1, off offset:%2" : "=&v"(qf[ks]) : "v"(qp_), "n"(32 * ks) : "memory"); } while (0)
#define FA_WAITQ(N) do { if constexpr (NKS == 6) asm volatile("s_waitcnt vmcnt(%6)" : "+v"(qf[0]), "+v"(qf[1]), "+v"(qf[2]), "+v"(qf[3]), "+v"(qf[4]), "+v"(qf[5]) : "n"(N) : "memory"); \
        else asm volatile("s_waitcnt vmcnt(%4)" : "+v"(qf[0]), "+v"(qf[1]), "+v"(qf[2]), "+v"(qf[3]) : "n"(N) : "memory"); } while (0)
    { const UnitDesc d0 = desc(0); FA_LOADQ(d0); FA_WAITQ(0); }
#pragma unroll 1
    for (int ju = 0; ju < n_units; ++ju) {
    const UnitDesc du = desc(ju);
    const int seq0 = du.seq0, qw = du.qw, q_col = du.q_col, o_col = du.o_col, lse_col = du.lse_col, kt_lo = du.kt_lo, kt_hi = du.kt_hi;
    const int q = qw + r;
    const int lo_q = MODE == 0 ? max(q & ~(P.CL - 1), q - P.W) : 0;
    const int qh = q - 4 * h, lqh = lo_q - 4 * h;
    const int lo_w0 = MODE == 0 ? max(qw & ~(P.CL - 1), qw - P.W) : 0;
    const int lo_w1 = MODE == 0 ? max((qw + 31) & ~(P.CL - 1), qw + 31 - P.W) : 0;
#define FA_WAITBAR(N) do { asm volatile("s_waitcnt vmcnt(%0)" :: "n"(N) : "memory"); __builtin_amdgcn_s_barrier(); asm volatile("" ::: "memory"); } while (0)
    f32x16 o0, o1, c0, c1, n0, n1;
#pragma unroll
    for (int i = 0; i < 16; ++i) { o0[i] = 0.f; o1[i] = 0.f; c0[i] = 0.f; c1[i] = 0.f; n0[i] = 0.f; n1[i] = 0.f; }
    float m = -INFINITY, l = 0.f;
#define FA_PART(kt_) (active && (MODE == 0 ? ((kt_) * 64 <= qw + 31 && (kt_) * 64 + 63 >= lo_w0) : ((kt_) * 64 <= qw + 31)))
#define FA_KADDR(SB_, ROFF, ks) ((ks) < 4 ? (SB_) + (ROFF) * 128 + k1row + 16 * ((2 * (ks) + h) ^ s1_) : (SB_) + (ROFF) * 64 + k2row + 16 * ((2 * ((ks) - 4) + h) ^ s2_))
#define FA_QKH(S, SB_, ROFF, NW) do { bf16x8 fa_[NKS]; \
        _Pragma("unroll") for (int ks = 0; ks < NKS; ++ks) fa_[ks] = *(const LAS bf16x8*)FA_KADDR(SB_, ROFF, ks); \
        if (PROBE_LDS2) { _Pragma("unroll") for (int ks = 0; ks < NKS; ++ks) { const bf16x8 fb_ = *(const volatile LAS bf16x8*)FA_KADDR(SB_, (ROFF) ^ 32, ks); asm volatile("" :: "v"(fb_)); } } \
        if constexpr (MODE == 1) {        \
            mask_init(S, NW); \
        } else { _Pragma("unroll") for (int i = 0; i < 16; ++i) S[i] = 0.f; } \
        _Pragma("unroll") for (int ks = 0; ks < NKS; ++ks) S = __builtin_amdgcn_mfma_f32_32x32x16_bf16(fa_[ks], qf[ks], S, 0, 0, 0); \
        __builtin_amdgcn_sched_group_barrier(0x100, NKS, 0); __builtin_amdgcn_sched_group_barrier(0x008, NKS, 0); } while (0)
#define FA_QK(S0, S1, SB_, KT) do { unsigned nwa_ = 0u, nwb_ = 0u; \
        if constexpr (MODE == 1) { const u32x4 bw_ = *(const LAS u32x4*)((SB_) + BMOFF + wave * 1024 + lane * 16);        \
            nwa_ = ~((((KT) & 1) ? bw_.z : bw_.x) >> (4 * h)); nwb_ = ~((((KT) & 1) ? bw_.w : bw_.y) >> (4 * h)); } \
        FA_QKH(S0, SB_, 0, nwa_); FA_QKH(S1, SB_, 32, nwb_); } while (0)
#define FA_QKX(S, SB_, ROFF) do { bf16x8 fa_[NKS]; \
        _Pragma("unroll") for (int ks = 0; ks < NKS; ++ks) fa_[ks] = *(const LAS bf16x8*)FA_KADDR(SB_, ROFF, ks); \
        _Pragma("unroll") for (int i = 0; i < 16; ++i) S[i] = 0.f; \
        _Pragma("unroll") for (int ks = 0; ks < NKS; ++ks) S = __builtin_amdgcn_mfma_f32_32x32x16_bf16(fa_[ks], qf[ks], S, 0, 0, 0); } while (0)
    if (ju == 0) {
#pragma unroll 1
        for (int a = 0; a < AHEAD; ++a) { FA_ISSUE(kt_lo + a, st_is); st_is = st_is + 1; }
        FA_WAITBAR((AHEAD - 2) * NDMA);
    }
    if (FA_PART(kt_lo)) FA_QK(c0, c1, lds + st_c * STB, kt_lo);
    auto fa_step = [&](f32x16& c0, f32x16& c1, f32x16& n0, f32x16& n1, const int kt) __attribute__((always_inline)) {
        FA_ISSUE(kt + AHEAD, st_is); st_is = (st_is + 1 == NST) ? 0 : st_is + 1;
        const bool more1 = kt < kt_hi;
        const bool qnext = !more1 && (ju + 1 < n_units);
        if (qnext) { const UnitDesc dq = desc(ju + 1); FA_LOADQ(dq); }
        const int k0 = kt * 64;
        const bool part_c = FA_PART(kt), part_n = more1 && FA_PART(kt + 1);
        const LAS unsigned char* Sn = lds + st_n * STB; const LAS unsigned char* Vb = lds + st_c * STB;
        const bool fused = FA_FUSE && (DQK == 64) && part_c && part_n;
        if (part_n && !fused) FA_QK(n0, n1, Sn, kt + 1);
        if (part_c) {
            float alpha;
#define FA_SOFTMAX(MASKED) do { \
            if (MASKED) { if constexpr (MODE == 2) { const int qa = qh - k0, qa1 = qa - 32; \
                    _Pragma("unroll") for (int i = 0; i < 16; ++i) { const int ci = (i & 3) + 8 * (i >> 2); \
                        c0[i] = (ci > qa) ? -INFINITY : c0[i]; c1[i] = (ci > qa1) ? -INFINITY : c1[i]; } \
                } else if constexpr (MODE == 0) { const int lb = lqh - k0; const unsigned span = (unsigned)(q - lo_q), lb1 = (unsigned)(lb - 32);     \
                    _Pragma("unroll") for (int i = 0; i < 16; ++i) { const int ci = (i & 3) + 8 * (i >> 2); \
                        c0[i] = ((unsigned)(ci - lb) > span) ? -INFINITY : c0[i]; c1[i] = ((unsigned)ci - lb1 > span) ? -INFINITY : c1[i]; } \
                } } \
            float mx = xhalf_max(fmaxf(max16(c0), max16(c1))); \
            const float mn = fmaxf(m, mx); \
            const float ms = (mn == -INFINITY) ? 0.f : mn; \
            alpha = __builtin_amdgcn_exp2f(m - ms); \
            m = mn; \
            float ls = 0.f; \
            if (PROBE_EXP2) { float dm_ = 0.f; _Pragma("unroll") for (int i = 0; i < 16; ++i) { dm_ += __builtin_amdgcn_exp2f(c0[i] - mx) + __builtin_amdgcn_exp2f(c1[i] - mx); } asm volatile("" :: "v"(dm_)); } \
            if (SOFTMAX_PK) { const f32x2 ms2 = {ms, ms}; f32x2 lsa = {0.f, 0.f}, lsb = {0.f, 0.f};            \
              _Pragma("unroll") for (int i = 0; i < 16; i += 2) { \
                  f32x2 ta = {c0[i], c0[i + 1]}, tb = {c1[i], c1[i + 1]}; ta = ta - ms2; tb = tb - ms2; \
                  ta.x = __builtin_amdgcn_exp2f(ta.x); ta.y = __builtin_amdgcn_exp2f(ta.y); tb.x = __builtin_amdgcn_exp2f(tb.x); tb.y = __builtin_amdgcn_exp2f(tb.y); \
                  c0[i] = ta.x; c0[i + 1] = ta.y; c1[i] = tb.x; c1[i + 1] = tb.y; lsa = lsa + ta; lsb = lsb + tb; } \
              lsa = lsa + lsb; ls = lsa.x + lsa.y; \
            } else {        \
              _Pragma("unroll") for (int i = 0; i < 16; ++i) { c0[i] = __builtin_amdgcn_exp2f(c0[i] - ms); c1[i] = __builtin_amdgcn_exp2f(c1[i] - ms); ls += c0[i] + c1[i]; } } \
            l = l * alpha + ls; } while (0)
            const bool need_mask = MODE == 1 ? false : (MODE == 2 ? (k0 + 63 > qw) : ((k0 + 63 > qw) || (k0 < lo_w1)));
#define FA_FUSED(MASKED) do { FA_QKX(n0, Sn, 0); FA_QKX(n1, Sn, 32); FA_SOFTMAX(MASKED); \
            _Pragma("unroll") for (int hh_ = 0; hh_ < 2; ++hh_) { \
                __builtin_amdgcn_sched_group_barrier(0x100, NKS, 0); \
                _Pragma("unroll") for (int i = 0; i < NKS; ++i) { __builtin_amdgcn_sched_group_barrier(0x008, 1, 0); __builtin_amdgcn_sched_group_barrier(0x002, 120 / (2 * NKS), 0); } } } while (0)
            if (fused) { if (need_mask) FA_FUSED(true); else FA_FUSED(false); }
            else { if (need_mask) FA_SOFTMAX(true); else FA_SOFTMAX(false); }
#undef FA_FUSED
#undef FA_SOFTMAX
            if (!__all(alpha == 1.0f)) {
#pragma unroll
                for (int i = 0; i < 16; ++i) { o0[i] *= alpha; o1[i] *= alpha; } }
#pragma unroll
            for (int kb = 0; kb < 2; ++kb) {
                const f32x16& s = kb ? c1 : c0;
                u32x2 va[2][2], vb[2][2];
                const unsigned vaddr = (unsigned)(size_t)(Vb + (32 * kb) * 128 + vtoff);
#pragma unroll
                for (int sk = 0; sk < 2; ++sk) {
                    asm volatile("ds_read_b64_tr_b16 %0, %1" : "=&v"(va[sk][0]) : "v"(vaddr + (unsigned)(sk * 2048 + vx0)) : "memory");
                    asm volatile("ds_read_b64_tr_b16 %0, %1" : "=&v"(vb[sk][0]) : "v"(vaddr + (unsigned)(sk * 2048 + 1024 + vx0)) : "memory");
                    asm volatile("ds_read_b64_tr_b16 %0, %1" : "=&v"(va[sk][1]) : "v"(vaddr + (unsigned)(sk * 2048 + vx1)) : "memory");
                    asm volatile("ds_read_b64_tr_b16 %0, %1" : "=&v"(vb[sk][1]) : "v"(vaddr + (unsigned)(sk * 2048 + 1024 + vx1)) : "memory");
                }
                bf16x8 pf[2];
#pragma unroll
                for (int sk = 0; sk < 2; ++sk) { u32x4 pw; pw.x = pk2(s[8 * sk + 0], s[8 * sk + 1]); pw.y = pk2(s[8 * sk + 2], s[8 * sk + 3]); pw.z = pk2(s[8 * sk + 4], s[8 * sk + 5]); pw.w = pk2(s[8 * sk + 6], s[8 * sk + 7]); pf[sk] = __builtin_bit_cast(bf16x8, pw); }
                asm volatile("s_waitcnt lgkmcnt(0)" : "+v"(va[0][0]), "+v"(vb[0][0]), "+v"(va[0][1]), "+v"(vb[0][1]), "+v"(va[1][0]), "+v"(vb[1][0]), "+v"(va[1][1]), "+v"(vb[1][1]) :: "memory");
                __builtin_amdgcn_sched_barrier(0);
#pragma unroll
                for (int sk = 0; sk < 2; ++sk) {
                    const u32x4 v0w = {va[sk][0].x, va[sk][0].y, vb[sk][0].x, vb[sk][0].y}, v1w = {va[sk][1].x, va[sk][1].y, vb[sk][1].x, vb[sk][1].y};
                    o0 = __builtin_amdgcn_mfma_f32_32x32x16_bf16(__builtin_bit_cast(bf16x8, v0w), pf[sk], o0, 0, 0, 0);
                    o1 = __builtin_amdgcn_mfma_f32_32x32x16_bf16(__builtin_bit_cast(bf16x8, v1w), pf[sk], o1, 0, 0, 0);
                }
            }
        }
        if (qnext) FA_WAITBAR((AHEAD - 2) * NDMA + NKS); else FA_WAITBAR((AHEAD - 2) * NDMA);
        st_c = st_n; st_n = (st_n + 1 == NST) ? 0 : st_n + 1;
    };
    for (int kt = kt_lo;;) { fa_step(c0, c1, n0, n1, kt); if (++kt > kt_hi) break; fa_step(n0, n1, c0, c1, kt); if (++kt > kt_hi) break; }
#undef FA_PART
#undef FA_QK
#undef FA_QKH
#undef FA_QKX
#undef FA_KADDR
    const float lt = xhalf_sum(l);
    const float inv = 1.0f / lt;
    if (active) {
    bf16* op = P.O + (size_t)(seq0 + q) * P.o_pitch + o_col + 8 * h;
#pragma unroll
    for (int db = 0; db < 2; ++db) {
        const f32x16& o = db ? o1 : o0;
#pragma unroll
        for (int j = 0; j < 2; ++j) {
            u32x2 X, Y;
            X.x = pk2(o[8 * j] * inv, o[8 * j + 1] * inv); X.y = pk2(o[8 * j + 2] * inv, o[8 * j + 3] * inv);
            Y.x = pk2(o[8 * j + 4] * inv, o[8 * j + 5] * inv); Y.y = pk2(o[8 * j + 6] * inv, o[8 * j + 7] * inv);
            const auto a = __builtin_amdgcn_permlane32_swap(X.x, Y.x, false, false); const auto b = __builtin_amdgcn_permlane32_swap(X.y, Y.y, false, false);
            u32x4 w; w.x = a[0]; w.y = b[0]; w.z = a[1]; w.w = b[1];
            stg16<NT_ATT>(op + 32 * db + 16 * j, w);
        }
    }
    if (P.LSE && h == 0) P.LSE[(size_t)(seq0 + q) * P.lse_pitch + lse_col] = m + __builtin_amdgcn_logf(lt);
    }
    __builtin_amdgcn_sched_barrier(0);
    FA_WAITQ(4);
    }
    asm volatile("s_waitcnt vmcnt(0)" ::: "memory"); __builtin_amdgcn_s_barrier(); asm volatile("" ::: "memory");
#undef FA_ISSUE
#undef FA_LOADQ
#undef FA_WAITQ
#undef FA_WAITBAR
}
}

struct Args {
    const float* x; const int* pos; const float* w_in; const float* qn; const float* kvn; const float* w_uq; const float* w_ukv; const float* w_o;
    const float* ln1g; const float* ln1b; const float* rgw; const float* rgb; const float* rew; const float* reb;
    const float* wg; const float* wu; const float* wd; const float* ln2g; const float* ln2b;
    float* out; unsigned char* ws; int l_lo, l_hi, ph_lo, ph_hi, use_bar, pad;
};
typedef const __attribute__((address_space(4))) Args CArgs;
struct Ctx { LAS unsigned char* lds; int tid, lane, wave, G, c, vcu; unsigned char* ws; };

struct ColIdent { int off; __device__ __forceinline__ int operator()(int P) const { return off + P; } };
struct ColAdj { __device__ __forceinline__ int operator()(int P) const { const int p = P & 255; return (P & ~255) + 64 * ((p >> 5) & 3) + 32 * (p >> 7) + (p & 31); } };
__device__ __forceinline__ int map_rope32(int p) { return 16 * ((p >> 2) & 1) + 4 * (p >> 3) + (p & 3); }
__device__ __forceinline__ int map_head16(int p) { const int fq = p >> 3; return 16 * (fq >> 1) + 8 * ((p >> 2) & 1) + 4 * (fq & 1) + (p & 3); }
struct ColWin {
    __device__ __forceinline__ int operator()(int P) const {
        const int G = P >> 5, p = P & 31;
        if (G < 8) return 32 * G + p;
        if (G < 12) return 256 + 32 * (G - 8) + p;
        if (G == 12) return 384 + map_rope32(p);
        if (G == 13) return 1056 + p;
        if (G == 14) return 672 + map_head16(p);
        if (G == 15) return 704 + p;
        if (G < 24) { const int hh = (G - 16) >> 1; return 416 + 64 * hh + (((G - 16) & 1) ? 32 + p : map_head16(p)); }
        if (G < 26) return 736 + 32 * (G - 24) + p;
        if (G == 26) return p < 8 ? 1088 + p : -1;
        if (G < 32) return -1;
        if (G < 40) return 800 + 32 * (G - 32) + p;
        if (G < 64) { const int j = G - 40; return 1096 + 64 * (j >> 1) + ((j & 1) ? 32 + p : map_head16(p)); }
        if (G < 88) { const int j = G - 64; return 1096 + 768 + 64 * (j >> 1) + ((j & 1) ? 32 + p : map_head16(p)); }
        return 1096 + 1536 + 32 * (G - 88) + p;
    }
};
struct ColUq {
    __device__ __forceinline__ int operator()(int P) const { const int G = P >> 5, p = P & 31; return 32 * G + ((G % 3 == 2) ? map_rope32(p) : p); }
};
template <class ColFn>
__device__ __forceinline__ void transpose_item(const float* W, int ldw, int kvalid, bf16* WT, int ldt, int k0, int P0, const ColFn& cf, const float* rowscale, LAS float* scr, int lane) {
    const int c = lane & 31, col = cf(P0 + c);
#pragma unroll 8
    for (int i = 0; i < 32; ++i) { const int kk = 2 * i + (lane >> 5), k = k0 + kk; float v = 0.f;
        if (col >= 0 && k < kvalid) { v = W[(size_t)k * ldw + col]; if (rowscale) v *= rowscale[k]; }
        scr[kk * 33 + c] = v; }
    asm volatile("s_waitcnt lgkmcnt(0)" ::: "memory");
    const int cc = lane & 7;
#pragma unroll
    for (int j = 0; j < 4; ++j) { const int n = (lane >> 3) + 8 * j; const LAS float* s = scr + (8 * cc) * 33 + n;
        u32x4 o; o.x = pk2(s[0 * 33], s[1 * 33]); o.y = pk2(s[2 * 33], s[3 * 33]); o.z = pk2(s[4 * 33], s[5 * 33]); o.w = pk2(s[6 * 33], s[7 * 33]);
        *(u32x4*)(WT + (size_t)(P0 + n) * ldt + k0 + 8 * cc) = o; }
    asm volatile("s_waitcnt lgkmcnt(0)" ::: "memory");
}
__device__ __forceinline__ void prologue(const Ctx& X, const CArgs* ap) {
    struct { const float* x; const float *w_in, *qn, *kvn, *w_uq, *w_ukv, *w_o, *rgw, *rew; } a = {ap->x, ap->w_in, ap->qn, ap->kvn, ap->w_uq, ap->w_ukv, ap->w_o, ap->rgw, ap->rew};
    LAS float* scr = (LAS float*)(X.lds + X.wave * 16384);
    const int gw = X.vcu * 8 + X.wave, NGW = X.G * 8;
    constexpr int I_WIN = 16 * 112, I_UQ = 4 * 24, I_UKV = 4 * 32, I_WO = 16 * 32, I_L = I_WIN + I_UQ + I_UKV + I_WO;
    for (int it = gw; it < DEPTH * I_L; it += NGW) {
        const int l = it / I_L; int r = it % I_L;
        if (r < I_WIN) { transpose_item(a.w_in + (size_t)l * DM * IN_COLS, IN_COLS, DM, (bf16*)(X.ws + WS_WIN) + (size_t)l * NIN * DM, DM, 64 * (r / 112), 32 * (r % 112), ColWin{}, nullptr, scr, X.lane); continue; }
        r -= I_WIN;
        if (r < I_UQ) { transpose_item(a.w_uq + (size_t)l * 256 * 768, 768, 256, (bf16*)(X.ws + WS_WUQ) + (size_t)l * 768 * 256, 256, 64 * (r / 24), 32 * (r % 24), ColUq{}, a.qn + l * 256, scr, X.lane); continue; }
        r -= I_UQ;
        if (r < I_UKV) { transpose_item(a.w_ukv + (size_t)l * 128 * 1024, 1024, 128, (bf16*)(X.ws + WS_WUKV) + (size_t)l * 1024 * 256, 256, 64 * (r / 32), 32 * (r % 32), ColAdj{}, a.kvn + l * 128, scr, X.lane); continue; }
        r -= I_UKV;
        transpose_item(a.w_o + (size_t)l * DM * DM, DM, DM, (bf16*)(X.ws + WS_WO) + (size_t)l * DM * DM, DM, 64 * (r / 32), 32 * (r % 32), ColAdj{}, nullptr, scr, X.lane);
    }
    const size_t gt = (size_t)X.vcu * 512 + X.tid, NGT = (size_t)X.G * 512;
    { float* rgt = (float*)(X.ws + WS_RGT); float* ret = (float*)(X.ws + WS_RET);
      for (size_t i = gt; i < (size_t)DEPTH * 4 * DM; i += NGT) { const int l = (int)(i / (4 * DM)), g = (int)(i / DM) & 3, k = (int)(i % DM); rgt[i] = a.rgw[((size_t)l * DM + k) * 4 + g]; }
      for (size_t i = gt; i < (size_t)DEPTH * 32 * DM; i += NGT) { const int l = (int)(i / (32 * DM)), ge = (int)(i / DM) & 31, k = (int)(i % DM); ret[i] = a.rew[(((size_t)l * 4 + (ge >> 3)) * DM + k) * 8 + (ge & 7)]; } }
    { u32x4* z = (u32x4*)(X.ws + WS_T1); for (size_t i = gt; i < (size_t)NT * 256 * 2 / 16; i += NGT) z[i] = (u32x4){0u, 0u, 0u, 0u}; }
    { const f32x4* xs = (const f32x4*)a.x; u32x2* xb = (u32x2*)((unsigned char*)ap->out + XR_OFF);
      for (size_t i = gt; i < (size_t)NT * DM / 4; i += NGT) { const f32x4 v = xs[i]; u32x2 w; w.x = pk2(v[0], v[1]); w.y = pk2(v[2], v[3]); xb[i] = w; } }
}
__device__ __forceinline__ void convert_experts(const Ctx& X, const CArgs* ap, int l) {
    struct { const float *wg, *wu, *wd; } a = {ap->wg, ap->wu, ap->wd};
    LAS float* scr = (LAS float*)(X.lds + X.wave * 16384);
    const int gw = X.vcu * 8 + X.wave, NGW = X.G * 8;
    constexpr int I_GU = 32 * 16 * 16, I_D = 32 * 4 * 32;
    for (int it = gw; it < I_GU + I_D; it += NGW) {
        if (it < I_GU) { const int e = it >> 8, r = it & 255, G32 = r >> 4, kb = r & 15; const int pn = G32 >> 3, r0 = (G32 & 7) * 32; const bool up = r0 >= 128;
            const float* W = (up ? a.wu : a.wg) + ((size_t)l * NEXP + e) * DM * FH;
            transpose_item(W, FH, DM, (bf16*)(X.ws + WS_WGU) + (size_t)e * 512 * DM, DM, 64 * kb, 32 * G32, ColIdent{128 * pn + (r0 & 127) - 32 * G32}, nullptr, scr, X.lane);
        } else { const int r = it - I_GU, e = r >> 7, q = r & 127, kb = q >> 5, pg = q & 31;
            transpose_item(a.wd + ((size_t)l * NEXP + e) * FH * DM, DM, FH, (bf16*)(X.ws + WS_WD) + (size_t)e * DM * FH, FH, 64 * kb, 32 * pg, ColAdj{}, nullptr, scr, X.lane); }
    }
}

struct InProjDesc {
    unsigned char* ws;
    __device__ __forceinline__ pg8::GroupDesc operator()(int pn, int bj, int wc) const {
        using namespace pg8; const int G = 8 * pn + 4 * bj + wc; GroupDesc d; d.kind = GK_PLAIN; d.dst = nullptr; d.pitch = 256; d.col = 0; d.scale = 1.f; d.perm = 0; d.ssq = nullptr; d.ssq_n = 0; d.ssq_i = 0;
        if (G < 8) { d.dst = (bf16*)(ws + WS_CQ); d.col = 32 * G; d.ssq = (float*)(ws + WS_SSQ); d.ssq_n = 8; d.ssq_i = G; }
        else if (G < 12) { d.dst = (bf16*)(ws + WS_T1); d.col = 32 * (G - 8); d.ssq = (float*)(ws + WS_SSQ) + (size_t)NT * 8; d.ssq_n = 4; d.ssq_i = G - 8; }
        else if (G == 12) { d.kind = GK_ROPE32; d.dst = (bf16*)(ws + WS_KPE); d.pitch = 32; d.col = 0; }
        else if (G == 13) { d.kind = GK_IDX8; d.dst = (bf16*)(ws + WS_KI); d.pitch = 32; d.col = 0; }
        else if (G == 14) { d.kind = GK_HEAD16; d.dst = (bf16*)(ws + WS_T1); d.col = 192; }
        else if (G == 15) { d.dst = (bf16*)(ws + WS_T1); d.col = 224; }
        else if (G < 24) { d.kind = ((G - 16) & 1) ? GK_PLAIN : GK_HEAD16; d.dst = (bf16*)(ws + WS_BQ); d.col = 32 * (G - 16); d.scale = QSC64; }
        else if (G < 26) { d.dst = (bf16*)(ws + WS_BV); d.pitch = 64; d.col = 32 * (G - 24); }
        else if (G == 26) { d.kind = GK_WI; d.dst = (bf16*)(ws + WS_WI); }
        else if (G < 32) { d.kind = GK_SKIP; }
        else if (G < 40) { d.kind = GK_IDX8; d.dst = (bf16*)(ws + WS_BQI); d.col = 32 * (G - 32); }
        else if (G < 64) { const int j = G - 40, cfg = j >> 3; d.kind = (j & 1) ? GK_PLAIN : GK_HEAD16; d.dst = (bf16*)(ws + WS_DQ) + (size_t)cfg * NT * 256; d.col = 32 * (j & 7); d.scale = QSC64; d.perm = cfg == 0 ? 0 : (cfg == 1 ? 4 : 16); }
        else if (G < 88) { const int j = G - 64, cfg = j >> 3; d.kind = (j & 1) ? GK_PLAIN : GK_HEAD16; d.dst = (bf16*)(ws + WS_DK) + (size_t)cfg * NT * 256; d.col = 32 * (j & 7); d.perm = cfg == 0 ? 0 : (cfg == 1 ? 4 : 16); }
        else { const int j = G - 88, cfg = j >> 3; d.dst = (bf16*)(ws + WS_DV) + (size_t)cfg * NT * 256; d.col = 32 * (j & 7); d.perm = cfg == 0 ? 0 : (cfg == 1 ? 4 : 16); }
        return d;
    }
};
struct UqDesc {
    unsigned char* ws;
    __device__ __forceinline__ pg8::GroupDesc operator()(int pn, int bj, int wc) const {
        using namespace pg8; const int G = 8 * pn + 4 * bj + wc; GroupDesc d; d.kind = (G % 3 == 2) ? GK_ROPE32 : GK_PLAIN; d.dst = (bf16*)(ws + WS_QA); d.pitch = 768; d.col = 32 * G; d.scale = QSC96; d.perm = 0; d.ssq = nullptr; d.ssq_n = 0; d.ssq_i = 0;
        return d;
    }
};

__device__ __forceinline__ unsigned f16key(float v) { const _Float16 hf = (_Float16)v; const unsigned u = (unsigned)__builtin_bit_cast(unsigned short, hf); return (u ^ ((unsigned)__builtin_amdgcn_sbfe((int)u, 15, 1) | 0x8000u)) & 0xffffu; }
__device__ __forceinline__ unsigned pk_cnt(unsigned acc, unsigned kp2, unsigned mid2, unsigned one2) {
    unsigned t;
    asm("v_pk_sub_u16 %0, %2, %3 clamp\n\tv_pk_min_u16 %0, %0, %4\n\tv_pk_add_u16 %1, %1, %0" : "=&v"(t), "+v"(acc) : "v"(kp2), "s"(mid2), "s"(one2));
    return acc;
}
__device__ __forceinline__ int count_gt(const unsigned (&kp)[16], unsigned mid) {
    const unsigned m2 = __builtin_amdgcn_readfirstlane(mid | (mid << 16)), one2 = __builtin_amdgcn_readfirstlane(0x00010001u);
    unsigned a0 = 0u, a1 = 0u;
#pragma unroll
    for (int i = 0; i < 16; i += 2) { a0 = pk_cnt(a0, kp[i], m2, one2); a1 = pk_cnt(a1, kp[i + 1], m2, one2); }
    unsigned aw; asm("v_pk_add_u16 %0, %1, %2" : "=v"(aw) : "v"(a0), "v"(a1));
    const unsigned c = (aw & 0xffffu) + (aw >> 16);
    int tot = 0;
#pragma unroll
    for (int b = 0; b < 6; ++b) tot += __builtin_popcountll(__ballot((c >> b) & 1u)) << b;
    return tot;
}
__device__ __forceinline__ int wave_scan_incl(int v) {
    v += __builtin_amdgcn_update_dpp(0, v, 0x111, 0xf, 0xf, false); v += __builtin_amdgcn_update_dpp(0, v, 0x112, 0xf, 0xf, false);
    v += __builtin_amdgcn_update_dpp(0, v, 0x114, 0xf, 0xf, false); v += __builtin_amdgcn_update_dpp(0, v, 0x118, 0xf, 0xf, false);
    v += __builtin_amdgcn_update_dpp(0, v, 0x142, 0xa, 0xf, false); v += __builtin_amdgcn_update_dpp(0, v, 0x143, 0xc, 0xf, false);
    return v;
}
__device__ __forceinline__ void radix_pick(const LAS unsigned* hist, int lane, int target, int& B, int& above, int& inbin) {
    const u32x2 hw = *(const LAS u32x2*)(hist + 2 * lane);
    const int c0 = (int)(hw.x & 0xffffu), c1 = (int)(hw.x >> 16), c2 = (int)(hw.y & 0xffffu), c3 = (int)(hw.y >> 16);
    const int tl = (c0 + c1) + (c2 + c3);
    const int pre = wave_scan_incl(tl);
    const int suf = __builtin_amdgcn_readlane(pre, 63) - pre + tl;
    const unsigned long long reach = __ballot(suf >= target);
    const int ls = 63 - __builtin_clzll(reach | 1ull);
    int a = suf - tl, b = 4 * lane + 3, ib = c3;
    if (a + c3 < target) { a += c3; b = 4 * lane + 2; ib = c2; if (a + c2 < target) { a += c2; b = 4 * lane + 1; ib = c1; if (a + c1 < target) { a += c1; b = 4 * lane; ib = c0; } } }
    B = __builtin_amdgcn_readlane(b, ls); above = __builtin_amdgcn_readlane(a, ls); inbin = __builtin_amdgcn_readlane(ib, ls);
}
__device__ __forceinline__ float relu_i(float x) { const int i = __builtin_bit_cast(int, x); return __builtin_bit_cast(float, i > 0 ? i : 0); }
__device__ __forceinline__ void dsa_index_unit(const Ctx& X, int b, int q0) {
    const int lane = X.lane, r = lane & 31, h = lane >> 5; const size_t seq0 = (size_t)b * SEQ; const int t0 = q0 + 4 * X.wave;
    const bf16* BQI = (const bf16*)(X.ws + WS_BQI); const bf16* KI = (const bf16*)(X.ws + WS_KI); const float* WI = (const float*)(X.ws + WS_WI);
    LAS unsigned short* rows = (LAS unsigned short*)(X.lds + X.wave * 16384);
    LAS unsigned char* kbuf = X.lds + LDS_X_OFF;
    const bf16* ap = BQI + (seq0 + t0 + (r >> 3)) * 256 + 32 * (r & 7) + 16 * h;
    const bf16x8 a0 = *(const bf16x8*)ap, a1 = *(const bf16x8*)(ap + 8);
    f32x2 wq[4][2];
#pragma unroll
    for (int j = 0; j < 4; ++j) { const f32x4 w = *(const f32x4*)(WI + (seq0 + t0 + j) * 8 + 4 * h);
        wq[j][0] = (f32x2){w[0] * IDX_SCALE, w[1] * IDX_SCALE}; wq[j][1] = (f32x2){w[2] * IDX_SCALE, w[3] * IDX_SCALE}; }
    const int nch = ((q0 + 31) >> 7) + 1;
    const int skey = X.tid >> 2, spc = X.tid & 3;
    const bf16* sp = KI + (seq0 + skey) * 32 + 8 * spc;
    const int sdst = skey * 64 + ((spc ^ ((skey >> 2) & 3)) << 4);
    u32x4 stg0 = *(const u32x4*)sp, stg1 = stg0, stg2 = stg0, stg3 = stg0;
    if (1 < nch) stg1 = *(const u32x4*)(sp + (size_t)1 * 128 * 32);
    if (2 < nch) stg2 = *(const u32x4*)(sp + (size_t)2 * 128 * 32);
    if (3 < nch) stg3 = *(const u32x4*)(sp + (size_t)3 * 128 * 32);
    *(LAS u32x4*)(kbuf + sdst) = stg0;
    __syncthreads();
#define DSA_STEP(J, RCUR, RNEXT) { const int c = c0 + (J); \
        if (c + 4 < nch) RCUR = *(const u32x4*)(sp + (size_t)(c + 4) * 128 * 32); \
        const LAS unsigned char* kb = kbuf + (c & 1) * 8192; \
        _Pragma("unroll") for (int tq = 0; tq < 4; ++tq) { \
            const int key = 32 * tq + r, sw = (key >> 2) & 3; \
            const bf16x8 b0 = *(const LAS bf16x8*)(kb + key * 64 + (((2 * h) ^ sw) << 4)), b1 = *(const LAS bf16x8*)(kb + key * 64 + (((2 * h + 1) ^ sw) << 4)); \
            f32x16 acc; \
            _Pragma("unroll") for (int i = 0; i < 16; ++i) acc[i] = 0.f; \
            acc = __builtin_amdgcn_mfma_f32_32x32x16_bf16(a0, b0, acc, 0, 0, 0); \
            acc = __builtin_amdgcn_mfma_f32_32x32x16_bf16(a1, b1, acc, 0, 0, 0); \
            float p[4]; \
            _Pragma("unroll") for (int j = 0; j < 4; ++j) {            \
                const f32x2 ra = {relu_i(acc[4 * j]), relu_i(acc[4 * j + 1])}, rb = {relu_i(acc[4 * j + 2]), relu_i(acc[4 * j + 3])}; \
                const f32x2 pp = __builtin_elementwise_fma(rb, wq[j][1], ra * wq[j][0]); \
                p[j] = pp.x + pp.y; } \
            const auto s01 = __builtin_amdgcn_permlane32_swap(__float_as_uint(p[0]), __float_as_uint(p[1]), false, false); \
            const auto s23 = __builtin_amdgcn_permlane32_swap(__float_as_uint(p[2]), __float_as_uint(p[3]), false, false); \
            const float va = __uint_as_float(s01[0]) + __uint_as_float(s01[1]), vb = __uint_as_float(s23[0]) + __uint_as_float(s23[1]); \
            const int hw = 128 * c + 32 * tq + r;                                      \
            rows[h * 2048 + hw] = (unsigned short)f16key(va); \
            rows[(2 + h) * 2048 + hw] = (unsigned short)f16key(vb); \
        } \
        if (c + 1 < nch) *(LAS u32x4*)(kbuf + ((c + 1) & 1) * 8192 + sdst) = RNEXT; \
        __syncthreads(); }
#ifndef REP_SCORE
#define REP_SCORE 1
#endif
#ifndef REP_SEL
#define REP_SEL 1
#endif
    for (int rsc = 0; rsc < REP_SCORE; ++rsc) {
    if (rsc > 0) { stg0 = *(const u32x4*)sp; stg1 = stg0; stg2 = stg0; stg3 = stg0; if (1 < nch) stg1 = *(const u32x4*)(sp + (size_t)1 * 128 * 32); if (2 < nch) stg2 = *(const u32x4*)(sp + (size_t)2 * 128 * 32); if (3 < nch) stg3 = *(const u32x4*)(sp + (size_t)3 * 128 * 32); *(LAS u32x4*)(kbuf + sdst) = stg0; __syncthreads(); }
    for (int c0 = 0; c0 < nch; c0 += 4) {
        DSA_STEP(0, stg0, stg1)
        if (c0 + 1 >= nch) break;
        DSA_STEP(1, stg1, stg2)
        if (c0 + 2 >= nch) break;
        DSA_STEP(2, stg2, stg3)
        if (c0 + 3 >= nch) break;
        DSA_STEP(3, stg3, stg0)
    }
    }
#undef DSA_STEP
    unsigned* BMp = (unsigned*)(X.ws + WS_BM);
#ifndef REP_BIS
#define REP_BIS 1
#endif
#ifndef REP_EMIT
#define REP_EMIT 1
#endif
    for (int rsl = 0; rsl < REP_SEL; ++rsl)
    for (int j = 0; j < 4; ++j) {
        const int t = t0 + j;
        const LAS u32x4* rw = (const LAS u32x4*)(rows + j * 2048) + 4 * lane;
        unsigned kp[16];
#pragma unroll
        for (int v4 = 0; v4 < 4; ++v4) { const u32x4 d = rw[v4]; kp[4 * v4] = d.x; kp[4 * v4 + 1] = d.y; kp[4 * v4 + 2] = d.z; kp[4 * v4 + 3] = d.w; }
        const int nv = t + 1 - 32 * lane;
#pragma unroll
        for (int d = 0; d < 16; ++d) kp[d] &= ((2 * d < nv) ? 0xffffu : 0u) | ((2 * d + 1 < nv) ? 0xffff0000u : 0u);
        unsigned thr = 0u; int need = 0;
        for (int rb_ = 0; rb_ < REP_BIS; ++rb_)
        if (t + 1 > 256) {
            LAS unsigned* hist = (LAS unsigned*)(X.lds + LDS_HIST_OFF + X.wave * 512);
            *(LAS u32x2*)(hist + 2 * lane) = (u32x2){0u, 0u};
#pragma unroll
            for (int d = 0; d < 16; ++d) { const unsigned klo = kp[d] & 0xffffu, khi = kp[d] >> 16;
                if (klo) __hip_atomic_fetch_add(hist + (klo >> 9), (klo & 0x100u) ? 0x10000u : 1u, __ATOMIC_RELAXED, __HIP_MEMORY_SCOPE_WORKGROUP);
                if (khi) __hip_atomic_fetch_add(hist + (khi >> 9), (khi & 0x100u) ? 0x10000u : 1u, __ATOMIC_RELAXED, __HIP_MEMORY_SCOPE_WORKGROUP); }
            int B1, above1, in1; radix_pick(hist, lane, 256, B1, above1, in1);
            *(LAS u32x2*)(hist + 2 * lane) = (u32x2){0u, 0u};
#pragma unroll
            for (int d = 0; d < 16; ++d) { const unsigned klo = kp[d] & 0xffffu, khi = kp[d] >> 16;
                if ((int)(klo >> 8) == B1) __hip_atomic_fetch_add(hist + ((klo & 0xffu) >> 1), (klo & 1u) ? 0x10000u : 1u, __ATOMIC_RELAXED, __HIP_MEMORY_SCOPE_WORKGROUP);
                if ((int)(khi >> 8) == B1) __hip_atomic_fetch_add(hist + ((khi & 0xffu) >> 1), (khi & 1u) ? 0x10000u : 1u, __ATOMIC_RELAXED, __HIP_MEMORY_SCOPE_WORKGROUP); }
            int B2, above2, in2; radix_pick(hist, lane, 256 - above1, B2, above2, in2);
            const unsigned tk = ((unsigned)B1 << 8) | (unsigned)B2;
            const int rest = 256 - (above1 + above2);
            if (rest >= in2) { thr = tk - 1u; need = 0; } else { thr = tk; need = rest; }
        }
        unsigned word = 0u, eqw = 0u;
        const unsigned thr2 = __builtin_amdgcn_readfirstlane(thr | (thr << 16)), one2 = __builtin_amdgcn_readfirstlane(0x00010001u);
#pragma unroll
        for (int d = 0; d < 16; ++d) { unsigned g;
            asm("v_pk_sub_u16 %0, %1, %2 clamp\n\tv_pk_min_u16 %0, %0, %3" : "=&v"(g) : "v"(kp[d]), "s"(thr2), "s"(one2));
            word |= ((g | (g >> 15)) & 3u) << (2 * d); }
        if (need > 0) {
#pragma unroll
            for (int d = 0; d < 16; ++d) { unsigned g; const unsigned x = kp[d] ^ thr2;
                asm("v_pk_min_u16 %0, %1, %2" : "=v"(g) : "v"(x), "s"(one2));
                eqw |= ((~(g | (g >> 15))) & 3u) << (2 * d); }
            if (thr == 0u) eqw = 0u;
            const int ne = __builtin_popcount(eqw); const int inc = wave_scan_incl(ne);
            int take = need - (inc - ne); take = take < 0 ? 0 : (take > ne ? ne : take);
            while (__any(take > 0)) { if (take > 0) { const unsigned lowbit = eqw & (0u - eqw); word |= lowbit; eqw ^= lowbit; --take; } }
        }
        BMp[(seq0 + t) * 64 + lane] = word;
    }
}

__device__ __forceinline__ void dil_combine(const Ctx& X) {
    const bf16* OD = (const bf16*)(X.ws + WS_OD); const float* LS = (const float*)(X.ws + WS_LSE); bf16* O = (bf16*)(X.ws + WS_XB);
    const int gw = X.vcu * 8 + X.wave, NGW = X.G * 8, lane = X.lane, hh = lane >> 4;
    for (int t = gw; t < NT; t += NGW) {
        const int b = t >> 11, s = t & 2047;
        const int r0 = t, r1 = (b << 11) + ((s & 3) << 9) + (s >> 2), r2 = (b << 11) + ((s & 15) << 7) + (s >> 4);
        const float L0 = LS[(size_t)r0 * 4 + hh], L1 = LS[((size_t)NT + r1) * 4 + hh], L2 = LS[((size_t)2 * NT + r2) * 4 + hh];
        const float mx = fmaxf(L0, fmaxf(L1, L2));
        float w0 = __builtin_amdgcn_exp2f(L0 - mx), w1 = __builtin_amdgcn_exp2f(L1 - mx), w2 = __builtin_amdgcn_exp2f(L2 - mx);
        const float inv = 1.0f / (w0 + w1 + w2); w0 *= inv; w1 *= inv; w2 *= inv;
        const u32x2 a = *(const u32x2*)(OD + (size_t)r0 * 256 + 4 * lane), bq = *(const u32x2*)(OD + ((size_t)NT + r1) * 256 + 4 * lane), cq = *(const u32x2*)(OD + ((size_t)2 * NT + r2) * 256 + 4 * lane);
        u32x2 o;
        o.x = pk2(w0 * bflo(a.x) + w1 * bflo(bq.x) + w2 * bflo(cq.x), w0 * bfhi(a.x) + w1 * bfhi(bq.x) + w2 * bfhi(cq.x));
        o.y = pk2(w0 * bflo(a.y) + w1 * bflo(bq.y) + w2 * bflo(cq.y), w0 * bfhi(a.y) + w1 * bfhi(bq.y) + w2 * bfhi(cq.y));
        stg8<NT_ATT>(O + (size_t)t * DM + 768 + 4 * lane, o);
    }
}

__device__ __forceinline__ void ln1_router(const Ctx& X, const CArgs* ap, int l, bool first, bool dummy = false) {
    struct { const float *ln1g, *ln1b, *rgb, *reb; } a = {ap->ln1g, ap->ln1b, ap->rgb, ap->reb}; (void)first;
    const bf16* xin = (const bf16*)((const unsigned char*)ap->out + XR_OFF);
    const bool keep_copy = !LN2_X1B && (l == DEPTH - 1) && !dummy; bf16* XC = (bf16*)(X.ws + WS_KVA);
    const int lane = X.lane; const bf16* MIX = (const bf16*)(X.ws + WS_MIX); bf16* X1B = (bf16*)(X.ws + (dummy ? WS_Y : WS_XB));
    LAS float* reT = (LAS float*)X.lds;
    LAS float* rgT = (LAS float*)(X.lds + LDS_X_OFF);
    LAS int* hist = (LAS int*)(X.lds + LDSCTL_OFF + 256);
    { const u32x4* s1 = (const u32x4*)(X.ws + WS_RET + (size_t)l * 32 * DM * 4); for (int i = X.tid; i < 32 * DM / 4; i += 512) ((LAS u32x4*)reT)[i] = s1[i];
      const u32x4* s2 = (const u32x4*)(X.ws + WS_RGT + (size_t)l * 4 * DM * 4); for (int i = X.tid; i < 4 * DM / 4; i += 512) ((LAS u32x4*)rgT)[i] = s2[i]; }
    f32x4 g[4], bb[4];
#pragma unroll
    for (int j = 0; j < 4; ++j) { g[j] = *(const f32x4*)(a.ln1g + l * DM + 4 * lane + 256 * j); bb[j] = *(const f32x4*)(a.ln1b + l * DM + 4 * lane + 256 * j); }
    const float* rgb = a.rgb + l * 4; const float* reb = a.reb + l * 32;
    for (int rb = X.c; rb < NT / 256; rb += X.G) {
        if (X.tid < 32) hist[X.tid] = 0;
        __syncthreads();
        u32x2 xa[4], xb[4]; u32x2 ma[4], mb[4];
        { const int t = rb * 256 + X.wave * 32;
#pragma unroll
          for (int j = 0; j < 4; ++j) { xa[j] = *(const u32x2*)(xin + (size_t)t * DM + 4 * lane + 256 * j); ma[j] = *(const u32x2*)(MIX + (size_t)t * DM + 4 * lane + 256 * j); }
#pragma unroll
          for (int j = 0; j < 4; ++j) { xb[j] = *(const u32x2*)(xin + (size_t)(t + 1) * DM + 4 * lane + 256 * j); mb[j] = *(const u32x2*)(MIX + (size_t)(t + 1) * DM + 4 * lane + 256 * j); } }
        auto row = [&](u32x2 (&xn)[4], u32x2 (&mn)[4], const int i) __attribute__((always_inline)) {
            const int t = rb * 256 + X.wave * 32 + i;
            f32x4 v[4]; float s = 0.f;
#pragma unroll
            for (int j = 0; j < 4; ++j) { const u32x2 xw = xn[j]; const u32x2 mw = mn[j];
                if (keep_copy) *(u32x2*)(XC + (size_t)t * DM + 4 * lane + 256 * j) = xw;
                v[j][0] = ALPHA * bflo(xw.x) + bflo(mw.x); v[j][1] = ALPHA * bfhi(xw.x) + bfhi(mw.x); v[j][2] = ALPHA * bflo(xw.y) + bflo(mw.y); v[j][3] = ALPHA * bfhi(xw.y) + bfhi(mw.y);
                s += (v[j][0] + v[j][1]) + (v[j][2] + v[j][3]); }
            if (i + 2 < 32) {
#pragma unroll
                for (int j = 0; j < 4; ++j) { xn[j] = *(const u32x2*)(xin + (size_t)(t + 2) * DM + 4 * lane + 256 * j); mn[j] = *(const u32x2*)(MIX + (size_t)(t + 2) * DM + 4 * lane + 256 * j); } }
            const float mean = wave_sum(s) * (1.f / DM); float s2 = 0.f;
#pragma unroll
            for (int j = 0; j < 4; ++j) { v[j] = v[j] - mean; s2 += (v[j][0] * v[j][0] + v[j][1] * v[j][1]) + (v[j][2] * v[j][2] + v[j][3] * v[j][3]); }
            const float rstd = 1.0f / sqrtf(wave_sum(s2) * (1.f / DM) + 1e-5f);
#pragma unroll
            for (int j = 0; j < 4; ++j) { v[j] = v[j] * rstd * g[j] + bb[j];
                u32x2 w; w.x = pk2(v[j][0], v[j][1]); w.y = pk2(v[j][2], v[j][3]); stg8<NT_LN>(X1B + (size_t)t * DM + 4 * lane + 256 * j, w); }
            float lg[4];
#pragma unroll
            for (int gi = 0; gi < 4; ++gi) { f32x2 p2 = {0.f, 0.f};
#pragma unroll
                for (int j = 0; j < 4; ++j) { const f32x4 w = *(const LAS f32x4*)(rgT + gi * DM + 4 * lane + 256 * j);
                    p2 = __builtin_elementwise_fma((f32x2){v[j][0], v[j][1]}, (f32x2){w[0], w[1]}, p2); p2 = __builtin_elementwise_fma((f32x2){v[j][2], v[j][3]}, (f32x2){w[2], w[3]}, p2); }
                lg[gi] = wave_sum(p2.x + p2.y) + rgb[gi]; }
            int gs = 0; float gm = lg[0];
#pragma unroll
            for (int gi = 1; gi < 4; ++gi) if (lg[gi] > gm) { gm = lg[gi]; gs = gi; }
            float den = 0.f;
#pragma unroll
            for (int gi = 0; gi < 4; ++gi) den += __expf(lg[gi] - gm);
            const float ptop = __builtin_amdgcn_rcpf(den);
            gs = __builtin_amdgcn_readfirstlane(gs);
            float le[8];
#pragma unroll
            for (int e = 0; e < 8; ++e) { f32x2 p2 = {0.f, 0.f};
#pragma unroll
                for (int j = 0; j < 4; ++j) { const f32x4 w = *(const LAS f32x4*)(reT + (gs * 8 + e) * DM + 4 * lane + 256 * j);
                    p2 = __builtin_elementwise_fma((f32x2){v[j][0], v[j][1]}, (f32x2){w[0], w[1]}, p2); p2 = __builtin_elementwise_fma((f32x2){v[j][2], v[j][3]}, (f32x2){w[2], w[3]}, p2); }
                le[e] = wave_sum(p2.x + p2.y) + reb[gs * 8 + e]; }
            int e1 = 0; float v1 = le[0];
#pragma unroll
            for (int e = 1; e < 8; ++e) if (le[e] > v1) { v1 = le[e]; e1 = e; }
            int e2 = -1; float v2 = -INFINITY;
#pragma unroll
            for (int e = 0; e < 8; ++e) if (e != e1 && le[e] > v2) { v2 = le[e]; e2 = e; }
            const float wa = __builtin_amdgcn_rcpf(1.0f + __expf(v2 - v1)), wb = 1.0f - wa;
            if (lane == 0) { u32x4 ro; ro.x = (unsigned)(gs * 8 + e1); ro.y = (unsigned)(gs * 8 + e2); ro.z = __builtin_bit_cast(unsigned, ptop * wa); ro.w = __builtin_bit_cast(unsigned, ptop * wb);
                *(u32x4*)(X.ws + WS_ROUTE + (size_t)t * 16) = ro;
                __hip_atomic_fetch_add(hist + gs * 8 + e1, 1, __ATOMIC_RELAXED, __HIP_MEMORY_SCOPE_WORKGROUP); __hip_atomic_fetch_add(hist + gs * 8 + e2, 1, __ATOMIC_RELAXED, __HIP_MEMORY_SCOPE_WORKGROUP); }
        };
#pragma unroll 1
        for (int i = 0; i < 32; i += 2) { row(xa, ma, i); row(xb, mb, i + 1); }
        __syncthreads();
        if (X.tid < 32) ((int*)(X.ws + WS_HIST))[rb * 32 + X.tid] = hist[X.tid];
        __syncthreads();
    }
}

__device__ __forceinline__ void moe_dispatch(const Ctx& X) {
    LAS int* cnt = (LAS int*)(X.lds);
    LAS int* pre = cnt + 32;
    LAS int* ebase = cnt + 64;
    LAS int* wcnt = cnt + 128;
    const int* HIST = (const int*)(X.ws + WS_HIST); int* STOK = (int*)(X.ws + WS_STOK); float* SW = (float*)(X.ws + WS_SW); int* TSLOT = (int*)(X.ws + WS_TSLOT); int* TILEE = (int*)(X.ws + WS_TILEE);
    for (int rb = X.c; rb < NT / 256; rb += X.G) {
        if (X.tid < 64) cnt[X.tid] = 0;
        __syncthreads();
        { const int e = X.tid & 31, part = X.tid >> 5; int sa = 0, sp = 0;
          for (int q = 0; q < 16; ++q) { const int b2 = part * 16 + q; const int hv = HIST[b2 * 32 + e]; sa += hv; if (b2 < rb) sp += hv; }
          __hip_atomic_fetch_add(cnt + e, sa, __ATOMIC_RELAXED, __HIP_MEMORY_SCOPE_WORKGROUP); __hip_atomic_fetch_add(pre + e, sp, __ATOMIC_RELAXED, __HIP_MEMORY_SCOPE_WORKGROUP); }
        __syncthreads();
        if (X.tid < 64) { const int n = X.tid < 32 ? cnt[X.tid] : 0; const int pad = (n + 255) & ~255; int inc = pad;
#pragma unroll
            for (int o = 1; o < 32; o <<= 1) { const int u = __shfl_up(inc, o); if ((X.tid & 63) >= o) inc += u; }
            if (X.tid < 32) { ebase[X.tid] = inc - pad; if (X.tid == 31) ebase[32] = inc; } }
        __syncthreads();
        const int tl = X.tid >> 1, kk = X.tid & 1, t = rb * 256 + tl;
        const u32x4 ro = *(const u32x4*)(X.ws + WS_ROUTE + (size_t)t * 16);
        const int e = (int)(kk ? ro.y : ro.x); const float w = __builtin_bit_cast(float, kk ? ro.w : ro.z);
        int rank = 0;
        for (int ee = 0; ee < 32; ++ee) { const unsigned long long mm = __ballot(e == ee);
            if (e == ee) rank = __builtin_popcountll(mm & ((1ull << X.lane) - 1ull));
            if (X.lane == 0) wcnt[X.wave * 32 + ee] = __builtin_popcountll(mm); }
        __syncthreads();
        int off = 0;
        for (int w2 = 0; w2 < X.wave; ++w2) off += wcnt[w2 * 32 + e];
        const int slot = ebase[e] + pre[e] + off + rank;
        STOK[slot] = t; SW[slot] = w; TSLOT[2 * t + kk] = slot;
        if (rb < 32) { const int e2 = rb; for (int s = ebase[e2] + cnt[e2] + X.tid; s < ebase[e2 + 1]; s += 512) { STOK[s] = 0; SW[s] = 0.f; } }
        if (rb == 0) { const int ntl = ebase[32] >> 8;
            for (int tile = X.tid; tile < ntl; tile += 512) { int ee = 0; while (ee < 31 && ebase[ee + 1] <= tile * 256) ++ee; TILEE[tile] = ee; }
            if (X.tid == 0) TILEE[1024] = ntl; }
        __syncthreads();
    }
}

__device__ __forceinline__ void ln2_phase(const Ctx& X, const CArgs* ap, int l, bool first, bool dummy = false) {
    struct { const float *ln1g, *ln1b, *ln2g, *ln2b; } a = {ap->ln1g, ap->ln1b, ap->ln2g, ap->ln2b}; float* outw = dummy ? (float*)(X.ws + WS_Y + 272 * MiB) : ap->out; (void)first;
    const bool last = (l + 1 == DEPTH);
    const bf16* xin = LN2_X1B ? (const bf16*)(X.ws + WS_XB) : (last ? (const bf16*)(X.ws + WS_KVA) : (const bf16*)((const unsigned char*)ap->out + XR_OFF));
    const int lane = X.lane; const bf16* Y = (const bf16*)(X.ws + WS_Y); const bf16* MIX = (const bf16*)(X.ws + WS_MIX); const int* TSLOT = (const int*)(X.ws + WS_TSLOT); bf16* XBp = dummy ? (bf16*)(X.ws + WS_MIX) : (bf16*)((unsigned char*)ap->out + XR_OFF);
    auto ldy = [&](int slot, int j) __attribute__((always_inline)) -> u32x2 {
        if (Y_FP8) { u32x2 r; r.x = ldg_s<unsigned>((const unsigned char*)Y + (size_t)slot * DM + 4 * lane + 256 * j); r.y = 0u; return r; }
        return ldg_s<u32x2>(Y + (size_t)slot * DM + 4 * lane + 256 * j); };
    f32x4 g1[4], b1[4], g[4], bb[4];
#pragma unroll
    for (int j = 0; j < 4; ++j) { g1[j] = *(const f32x4*)(a.ln1g + l * DM + 4 * lane + 256 * j); b1[j] = *(const f32x4*)(a.ln1b + l * DM + 4 * lane + 256 * j);
        g[j] = *(const f32x4*)(a.ln2g + l * DM + 4 * lane + 256 * j); bb[j] = *(const f32x4*)(a.ln2b + l * DM + 4 * lane + 256 * j); }
    for (int rb = X.c; rb < NT / 256; rb += X.G) {
        const int tb = rb * 256 + X.wave * 32;
        const int myslots_a = TSLOT[2 * (tb + (lane & 31))], myslots_b = TSLOT[2 * (tb + (lane & 31)) + 1];
        u32x2 xn[4]; u32x2 mn[4], yan[4], ybn[4];
        { const int sa = __builtin_amdgcn_readlane(myslots_a, 0), sb = __builtin_amdgcn_readlane(myslots_b, 0);
#pragma unroll
          for (int j = 0; j < 4; ++j) { xn[j] = *(const u32x2*)(xin + (size_t)tb * DM + 4 * lane + 256 * j); mn[j] = LN2_X1B ? (u32x2){0u, 0u} : *(const u32x2*)(MIX + (size_t)tb * DM + 4 * lane + 256 * j);
              yan[j] = ldy(sa, j); ybn[j] = ldy(sb, j); } }
        for (int i = 0; i < 32; ++i) {
            const int t = tb + i;
            f32x4 v[4]; float s = 0.f;
#pragma unroll
            for (int j = 0; j < 4; ++j) { const u32x2 xw = xn[j]; const u32x2 mw = mn[j];
                if (LN2_X1B) { v[j][0] = bflo(xw.x); v[j][1] = bfhi(xw.x); v[j][2] = bflo(xw.y); v[j][3] = bfhi(xw.y); }
                else { v[j][0] = ALPHA * bflo(xw.x) + bflo(mw.x); v[j][1] = ALPHA * bfhi(xw.x) + bfhi(mw.x); v[j][2] = ALPHA * bflo(xw.y) + bflo(mw.y); v[j][3] = ALPHA * bfhi(xw.y) + bfhi(mw.y);
                    s += (v[j][0] + v[j][1]) + (v[j][2] + v[j][3]); } }
            u32x2 ya[4], yb[4];
#pragma unroll
            for (int j = 0; j < 4; ++j) { ya[j] = yan[j]; yb[j] = ybn[j]; }
            if (i + 1 < 32) { const int sa = __shfl(myslots_a, i + 1), sb = __shfl(myslots_b, i + 1);
#pragma unroll
                for (int j = 0; j < 4; ++j) { xn[j] = *(const u32x2*)(xin + (size_t)(t + 1) * DM + 4 * lane + 256 * j); if (!LN2_X1B) mn[j] = *(const u32x2*)(MIX + (size_t)(t + 1) * DM + 4 * lane + 256 * j);
                    yan[j] = ldy(sa, j); ybn[j] = ldy(sb, j); } }
            if (!LN2_X1B) { const float mean = wave_sum(s) * (1.f / DM); float s2 = 0.f;
#pragma unroll
              for (int j = 0; j < 4; ++j) { v[j] = v[j] - mean; s2 += (v[j][0] * v[j][0] + v[j][1] * v[j][1]) + (v[j][2] * v[j][2] + v[j][3] * v[j][3]); }
              const float rstd = 1.0f / sqrtf(wave_sum(s2) * (1.f / DM) + 1e-5f);
#pragma unroll
              for (int j = 0; j < 4; ++j) v[j] = v[j] * rstd * g1[j] + b1[j]; }
            s = 0.f;
#pragma unroll
            for (int j = 0; j < 4; ++j) { const f32x4 xv = v[j];
                if (Y_FP8) { const f32x4 fa = pg8::fp8x4_to_f32(ya[j].x), fb = pg8::fp8x4_to_f32(yb[j].x);
#pragma unroll
                    for (int e = 0; e < 4; ++e) v[j][e] = ALPHA * xv[e] + (fa[e] + fb[e]) * (1.0f / Y_SCALE);
                } else { v[j][0] = ALPHA * xv[0] + (bflo(ya[j].x) + bflo(yb[j].x)); v[j][1] = ALPHA * xv[1] + (bfhi(ya[j].x) + bfhi(yb[j].x)); v[j][2] = ALPHA * xv[2] + (bflo(ya[j].y) + bflo(yb[j].y)); v[j][3] = ALPHA * xv[3] + (bfhi(ya[j].y) + bfhi(yb[j].y)); }
                s += (v[j][0] + v[j][1]) + (v[j][2] + v[j][3]); }
            const float mean = wave_sum(s) * (1.f / DM); float s2 = 0.f;
#pragma unroll
            for (int j = 0; j < 4; ++j) { v[j] = v[j] - mean; s2 += (v[j][0] * v[j][0] + v[j][1] * v[j][1]) + (v[j][2] * v[j][2] + v[j][3] * v[j][3]); }
            const float rstd = 1.0f / sqrtf(wave_sum(s2) * (1.f / DM) + 1e-5f);
#pragma unroll
            for (int j = 0; j < 4; ++j) { v[j] = v[j] * rstd * g[j] + bb[j];
                if (last || dummy) stgf4<NT_LN>(outw + (size_t)t * DM + 4 * lane + 256 * j, v[j]);
                else { u32x2 w; w.x = pk2(v[j][0], v[j][1]); w.y = pk2(v[j][2], v[j][3]); stg8<NT_LN>(XBp + (size_t)t * DM + 4 * lane + 256 * j, w); } }
        }
    }
}

#ifndef REP_P0
#define REP_P0 1
#endif
#ifndef REP_P5
#define REP_P5 1
#endif
#ifndef REP_P9
#define REP_P9 1
#endif
#ifndef REP_BAR
#define REP_BAR 1
#endif
#ifndef REP_P1
#define REP_P1 1
#endif
#ifndef REP_P2A
#define REP_P2A 1
#endif
#ifndef REP_P2B
#define REP_P2B 1
#endif
#ifndef REP_P2C
#define REP_P2C 1
#endif
#ifndef REP_P2D
#define REP_P2D 1
#endif
#ifndef REP_P3A
#define REP_P3A 1
#endif
#ifndef REP_P3B
#define REP_P3B 1
#endif
#ifndef REP_P3C
#define REP_P3C 1
#endif
#ifndef REP_P4
#define REP_P4 1
#endif
#ifndef REP_P6
#define REP_P6 1
#endif
#ifndef REP_P7
#define REP_P7 1
#endif
#ifndef REP_P8
#define REP_P8 1
#endif
__global__ void __launch_bounds__(512, 2) mk_fwd(Args a) {
    extern __shared__ __attribute__((aligned(16))) unsigned char lds_raw[];
    LAS unsigned char* const lds0 = (LAS unsigned char*)lds_raw;
    for (int u = threadIdx.x; u < (LDS_BYTES - LDSCTL_OFF) / 4; u += 512) ((LAS unsigned*)(lds0 + LDSCTL_OFF))[u] = 0u;
    __syncthreads();
    unsigned* barw = (unsigned*)(a.ws + WS_CTL) + CW_BAR;
    XcdBarrier bar; bar.bar = barw; bar.x = 0; bar.st = nullptr;
    if (a.use_bar) bar = xcd_barrier_post(barw, (volatile LAS unsigned*)(lds0 + LDSCTL_OFF) + 8);
#define MKCTX() Ctx X; const CArgs* ap = (const CArgs*)__builtin_amdgcn_kernarg_segment_ptr(); asm volatile("" : "+s"(ap)); { int t_ = threadIdx.x; asm volatile("" : "+v"(t_)); X.lds = lds0; X.tid = t_; X.lane = t_ & 63; X.wave = __builtin_amdgcn_readfirstlane(t_ >> 6); \
        unsigned char* w_ = ap->ws; X.G = gridDim.x; X.c = blockIdx.x; X.vcu = (X.G % 8 == 0) ? (X.c % 8) * (X.G / 8) + X.c / 8 : X.c; X.ws = w_; }
#ifndef P2M
#define P2M 31
#endif
#ifndef PH_MASK0
#define PH_MASK0 1
#endif
#define GBAR() do { if (a.use_bar) for (int rb_ = 0; rb_ < REP_BAR; ++rb_) xcd_barrier(bar); } while (0)

    if ((PH_MASK0 & 1) && a.l_lo == 0 && a.ph_lo == 0) { MKCTX(); for (int rep = 0; rep < REP_P0; ++rep) { prologue(X, ap); __syncthreads(); } GBAR(); }

    for (int l = a.l_lo; l < a.l_hi; ++l) {
        const int lo = (l == a.l_lo) ? (a.ph_lo < 1 ? 1 : a.ph_lo) : 1, hi = (l == a.l_hi - 1) ? a.ph_hi : 10;
#ifndef PH_MASK
#define PH_MASK 0x3ff
#endif
#define IN(k) (((PH_MASK >> (k)) & 1) && lo <= (k) && (k) < hi)
        if (IN(1)) { MKCTX();
            pg8::Gemm g{(const bf16*)((const unsigned char*)ap->out + XR_OFF), (const bf16*)(X.ws + WS_WIN) + (size_t)l * NIN * DM, DM, nullptr};
            pg8::StaticOrder S; S.init(NT, NIN, X.G, X.c, REP_P1);
            pg8::RopeTabs R{ap->pos};
            pg8::EpiGroups<InProjDesc> E{InProjDesc{X.ws}, R, nullptr, 0, 0.f, 0.f};
            pg8::gemm_phase<pg8::EpiGroups<InProjDesc>, pg8::StaticOrder, false>(X.lds, g, S, E, X.tid);
            GBAR();
        }
        if (IN(2)) { MKCTX();
            {
                pg8::Gemm g{(const bf16*)(X.ws + WS_CQ), (const bf16*)(X.ws + WS_WUQ) + (size_t)l * 768 * 256, 256, nullptr};
                pg8::StaticOrder S; S.init(NT, 768, X.G, X.c, REP_P2A);
                pg8::RopeTabs R{ap->pos};
                pg8::EpiGroups<UqDesc> E{UqDesc{X.ws}, R, (const float*)(X.ws + WS_SSQ), 8, 1.0f / 256.0f, 1e-6f};
                pg8::gemm_phase<pg8::EpiGroups<UqDesc>, pg8::StaticOrder, false>(X.lds, g, S, E, X.tid);
            }
            {
                pg8::Gemm g{(const bf16*)(X.ws + WS_T1), (const bf16*)(X.ws + WS_WUKV) + (size_t)l * 1024 * 256, 256, nullptr};
                pg8::StaticOrder S; S.init(NT, 1024, X.G, X.c, REP_P2A);
                pg8::EpiPlainT<NT_KVA> E{(bf16*)(X.ws + WS_KVA), 1024, (const float*)(X.ws + WS_SSQ) + (size_t)NT * 8, 4, 1.0f / 128.0f, 1e-6f, X.lds + LDS_X_OFF};
                pg8::gemm_phase<decltype(E), pg8::StaticOrder, false>(X.lds, g, S, E, X.tid);
            }
            __syncthreads();
            for (int rep = 0; rep < REP_P2B; ++rep) convert_experts(X, ap, l);
            __syncthreads();
            for (int rep = 0; rep < REP_P2C; ++rep) for (int U = X.vcu; U < NB * 32; U += X.G) { const int b = U >> 5, pr = U & 31;
                dsa_index_unit(X, b, 32 * pr); dsa_index_unit(X, b, 32 * (63 - pr)); }
            __syncthreads();
#pragma unroll 1
            for (int cfg = 0; cfg < 3 * REP_P2D; ++cfg) { const int cfgi = cfg % 3;
                fa::Params P; const size_t co = (size_t)cfgi * NT * 256;
                P.Q = (const bf16*)(X.ws + WS_DQ) + co; P.q_pitch = 256; P.K1 = (const bf16*)(X.ws + WS_DK) + co; P.k1_pitch = 256; P.K2 = nullptr; P.k2_pitch = 0; P.k2_col = 0;
                P.V = (const bf16*)(X.ws + WS_DV) + co; P.v_pitch = 256; P.O = (bf16*)(X.ws + WS_OD) + co; P.o_pitch = 256; P.LSE = (float*)(X.ws + WS_LSE) + (size_t)cfgi * NT * 4; P.lse_pitch = 4; P.BM = nullptr;
                P.CL = cfgi == 0 ? 2048 : (cfgi == 1 ? 512 : 128); P.W = 128;
                const int vcu = X.vcu, G = X.G, wv = X.wave, CLc = P.CL;
                fa::attn_stream<64, 0, 2>(P, X.lds, X.tid, (NB * 2 * 16 - vcu + G - 1) / G, [=](int j) { const int U = vcu + j * G, bh = U >> 4, qb = U & 15, b = bh >> 1, hp = bh & 1;
                    const int q0 = 128 * qb, hh = 2 * hp + (wv >> 2); int klo = q0 & ~(CLc - 1); if (q0 - 128 > klo) klo = q0 - 128;
                    return fa::UnitDesc{b * SEQ, q0 + 32 * (wv & 3), 64 * hh, 64 * hh, hh, 128 * hp, 128 * hp, klo >> 6, (q0 + 127) >> 6}; });
            }
            GBAR();
        }
        if (IN(3)) { MKCTX();
            {   fa::Params P; P.Q = (const bf16*)(X.ws + WS_QA); P.q_pitch = 768; P.K1 = (const bf16*)(X.ws + WS_KVA); P.k1_pitch = 1024; P.K2 = (const bf16*)(X.ws + WS_KPE); P.k2_pitch = 32; P.k2_col = 0;
                P.V = (const bf16*)(X.ws + WS_KVA); P.v_pitch = 1024; P.O = (bf16*)(X.ws + WS_XB); P.o_pitch = DM; P.LSE = nullptr; P.lse_pitch = 0; P.BM = nullptr; P.CL = 2048; P.W = 1 << 20;
                const int vcu = X.vcu, G = X.G, wv = X.wave;
                fa::attn_stream<96, 2, 1>(P, X.lds, X.tid, 2 * ((NB * 8 * 4 - vcu + G - 1) / G), [=](int j) { const int U = vcu + (j >> 1) * G, bh = U >> 2, pr = U & 3, b = bh >> 3, hd = bh & 7;
                    const int qb = (j & 1) ? 7 - pr : pr, q0 = 256 * qb;
                    return fa::UnitDesc{b * SEQ, q0 + 32 * wv, 96 * hd, 64 * hd, 0, 128 * hd, 128 * hd + 64, 0, (q0 + 255) >> 6}; });
            }
            {   fa::Params P; P.Q = (const bf16*)(X.ws + WS_BQ); P.q_pitch = 256; P.K1 = (const bf16*)(X.ws + WS_T1); P.k1_pitch = 256; P.k1_col = 192; P.K2 = nullptr; P.k2_pitch = 0; P.k2_col = 0;
                P.V = (const bf16*)(X.ws + WS_BV); P.v_pitch = 64; P.v_col = 0; P.O = (bf16*)(X.ws + WS_XB); P.o_pitch = DM; P.LSE = nullptr; P.lse_pitch = 0; P.BM = (const unsigned*)(X.ws + WS_BM); P.CL = 2048; P.W = 1 << 20;
                const int hd = X.wave & 3, sub = X.wave >> 2, vcu = X.vcu, G = X.G;
                fa::attn_stream<64, 1, 1>(P, X.lds, X.tid, 2 * ((NB * 16 - vcu + G - 1) / G), [=](int j) { const int U = vcu + (j >> 1) * G, b = U >> 4, pr = U & 15;
                    const int qb = (j & 1) ? 31 - pr : pr, q0 = 64 * qb;
                    return fa::UnitDesc{b * SEQ, q0 + 32 * sub, 64 * hd, 512 + 64 * hd, 0, 192, 0, 0, qb}; });
            }
            for (int rep = 0; rep < REP_P3C; ++rep) dil_combine(X);
            GBAR();
        }
        if (IN(4)) { MKCTX();
            pg8::Gemm g{(const bf16*)(X.ws + WS_XB), (const bf16*)(X.ws + WS_WO) + (size_t)l * DM * DM, DM, nullptr};
            pg8::StaticOrder S; S.init(NT, DM, X.G, X.c, REP_P4);
            pg8::EpiPlainT<NT_MIX> E{(bf16*)(X.ws + WS_MIX), DM, nullptr, 0, 0.f, 0.f, X.lds + LDS_X_OFF};
            pg8::gemm_phase<decltype(E), pg8::StaticOrder, false>(X.lds, g, S, E, X.tid);
            GBAR();
        }
        if (IN(5)) { MKCTX(); if (REP_P5 > 1) ln1_router(X, ap, l, l == 0, true); ln1_router(X, ap, l, l == 0); GBAR(); }
        if (IN(6)) { MKCTX(); for (int rep = 0; rep < REP_P6; ++rep) moe_dispatch(X); GBAR(); }
        if (IN(7)) { MKCTX();
            const int* TILEE = (const int*)(X.ws + WS_TILEE);
            pg8::Gemm g{(const bf16*)(X.ws + WS_XB), (const bf16*)(X.ws + WS_WGU), DM, (const int*)(X.ws + WS_STOK)};
            pg8::GroupedOrder S{TILEE, TILEE[1024], 2, X.G, X.c};
            pg8::EpiGateUpT<NT_H> E{(bf16*)(X.ws + WS_H), (const float*)(X.ws + WS_SW)};
            for (int rep = 0; rep < REP_P7; ++rep) pg8::gemm_phase<decltype(E), pg8::GroupedOrder, true>(X.lds, g, S, E, X.tid);
            GBAR();
        }
        if (IN(8)) { MKCTX();
            const int* TILEE = (const int*)(X.ws + WS_TILEE);
            pg8::Gemm g{(const bf16*)(X.ws + WS_H), (const bf16*)(X.ws + WS_WD), FH, nullptr};
            pg8::GroupedOrder S{TILEE, TILEE[1024], 4, X.G, X.c};
#if Y_FP8
            pg8::EpiFp8T<NT_Y> E{X.ws + WS_Y, DM, Y_SCALE, X.lds + LDS_X_OFF};
#else
            pg8::EpiPlainT<NT_Y> E{(bf16*)(X.ws + WS_Y), DM, nullptr, 0, 0.f, 0.f, X.lds + LDS_X_OFF};
#endif
            for (int rep = 0; rep < REP_P8; ++rep) pg8::gemm_phase<decltype(E), pg8::GroupedOrder, false>(X.lds, g, S, E, X.tid);
            GBAR();
        }
        if (IN(9)) { MKCTX(); if (REP_P9 > 1) ln2_phase(X, ap, l, l == 0, true); ln2_phase(X, ap, l, l == 0); if (!(l == a.l_hi - 1)) GBAR(); }
#undef IN
    }
#undef GBAR
}

extern "C" void kernel_launch(void* const* d_in, const int* in_sizes, int n_in, void* d_out, int out_size, void* d_ws, size_t ws_size, hipStream_t stream) {
    static int grid = 0;
    if (grid == 0) {
        if (n_in != 19 || in_sizes[0] != NT * DM || out_size != NT * DM || ws_size < WS_END) { fprintf(stderr, "kernel_launch: unexpected shapes (n_in %d, in0 %d, out %d, ws %zu < %zu); nothing launched\n", n_in, n_in > 0 ? in_sizes[0] : -1, out_size, ws_size, (size_t)WS_END); grid = -1; return; }
        int dev = 0, cus = 0, per_cu = 0;
        if (hipGetDevice(&dev) != hipSuccess || hipDeviceGetAttribute(&cus, hipDeviceAttributeMultiprocessorCount, dev) != hipSuccess) { grid = -1; return; }
        if (hipFuncSetAttribute((const void*)mk_fwd, hipFuncAttributeMaxDynamicSharedMemorySize, LDS_BYTES) != hipSuccess) { fprintf(stderr, "kernel_launch: hipFuncSetAttribute failed\n"); grid = -1; return; }
        if (hipOccupancyMaxActiveBlocksPerMultiprocessor(&per_cu, (const void*)mk_fwd, 512, LDS_BYTES) != hipSuccess || per_cu < 1) fprintf(stderr, "kernel_launch: occupancy query reports %d\n", per_cu);
        (void)hipGetLastError();
        grid = cus;
    }
    if (grid < 0) return;
    (void)hipMemsetAsync((char*)d_ws + WS_CTL, 0, CTL_BYTES, stream);
    Args a{};
    a.x = (const float*)d_in[0]; a.pos = (const int*)d_in[1]; a.w_in = (const float*)d_in[2]; a.qn = (const float*)d_in[3]; a.kvn = (const float*)d_in[4];
    a.w_uq = (const float*)d_in[5]; a.w_ukv = (const float*)d_in[6]; a.w_o = (const float*)d_in[7]; a.ln1g = (const float*)d_in[8]; a.ln1b = (const float*)d_in[9];
    a.rgw = (const float*)d_in[10]; a.rgb = (const float*)d_in[11]; a.rew = (const float*)d_in[12]; a.reb = (const float*)d_in[13];
    a.wg = (const float*)d_in[14]; a.wu = (const float*)d_in[15]; a.wd = (const float*)d_in[16]; a.ln2g = (const float*)d_in[17]; a.ln2b = (const float*)d_in[18];
    a.out = (float*)d_out; a.ws = (unsigned char*)d_ws; a.pad = 0;
#if MK_MULTI
    a.use_bar = 0;
    a.l_lo = 0; a.l_hi = 0; a.ph_lo = 0; a.ph_hi = 0;
    hipLaunchKernelGGL(mk_fwd, dim3(grid), dim3(512), LDS_BYTES, stream, a);
    for (int l = 0; l < DEPTH; ++l)
        for (int ph = 1; ph < 10; ++ph) { a.l_lo = l; a.l_hi = l + 1; a.ph_lo = ph; a.ph_hi = ph + 1; hipLaunchKernelGGL(mk_fwd, dim3(grid), dim3(512), LDS_BYTES, stream, a); }
#else
    a.use_bar = 1; a.l_lo = 0; a.l_hi = DEPTH; a.ph_lo = 0; a.ph_hi = 10;
    hipLaunchKernelGGL(mk_fwd, dim3(grid), dim3(512), LDS_BYTES, stream, a);
#endif
    const hipError_t le = hipPeekAtLastError();
    if (le != hipSuccess) fprintf(stderr, "kernel_launch: launch failed: %s\n", hipGetErrorName(le));
}
```

```cpp
#include <hip/hip_runtime.h>
#include <cstdio>
#include <cstdint>

#define LAS __attribute__((address_space(3)))
#define GAS __attribute__((address_space(1)))
typedef unsigned short bf16;
typedef short bf16x8 __attribute__((ext_vector_type(8)));
typedef short s16x4 __attribute__((ext_vector_type(4)));
typedef float f32x2 __attribute__((ext_vector_type(2)));
typedef float f32x4 __attribute__((ext_vector_type(4)));
typedef float f32x16 __attribute__((ext_vector_type(16)));
typedef unsigned u32x2 __attribute__((ext_vector_type(2)));
typedef unsigned u32x4 __attribute__((ext_vector_type(4)));
typedef __bf16 bf16x2_t __attribute__((ext_vector_type(2)));

#ifndef MK_MULTI
#define MK_MULTI 0
#endif

constexpr int NB = 32, SEQ = 2048, NT = NB * SEQ, DM = 1024, DEPTH = 4;
constexpr int IN_COLS = 3400, NIN = 3584;
constexpr int NEXP = 32, FH = 256;
constexpr int NSLOT = 2 * NT + NEXP * 256;
constexpr int MAXTILES = NSLOT / 256;
constexpr float ALPHA = 1.681792830507429f;
constexpr float LOG2E = 1.4426950408889634f;
constexpr float QSC64 = 0.125f * LOG2E;
constexpr float QSC96 = 0.10206207261596577f * LOG2E;
constexpr float IDX_SCALE = 0.0625f;

constexpr size_t MiB = 1u << 20;
constexpr size_t WS_CTL = 0, CTL_BYTES = 1 * MiB;
constexpr size_t WS_WIN = 1 * MiB;
constexpr size_t WS_WUQ = 29 * MiB;
constexpr size_t WS_WUKV = WS_WUQ + 3 * MiB / 2;
constexpr size_t WS_WO = WS_WUKV + 2 * MiB;
constexpr size_t WS_RGT = WS_WO + 8 * MiB;
constexpr size_t WS_RET = WS_RGT + 64 * 1024;
constexpr size_t WS_ROPE = 42 * MiB;
constexpr size_t WS_WGU = 56 * MiB;
constexpr size_t WS_WD = 88 * MiB;
constexpr size_t WS_XB = 104 * MiB;
constexpr size_t WS_A = 232 * MiB;
constexpr size_t WS_CQ = WS_A;
constexpr size_t WS_T1 = WS_CQ + 32 * MiB;
constexpr size_t WS_BQ = WS_T1 + 32 * MiB;
constexpr size_t WS_BV = WS_BQ + 32 * MiB;
constexpr size_t WS_WI = WS_BV + 8 * MiB;
constexpr size_t WS_BQI = WS_WI + 2 * MiB;
constexpr size_t WS_SSQ = WS_BQI + 32 * MiB;
constexpr size_t WS_DQ = WS_SSQ + 4 * MiB;
constexpr size_t WS_DK = WS_DQ + 96 * MiB;
constexpr size_t WS_DV = WS_DK + 96 * MiB;
constexpr size_t WS_B = WS_DV + 96 * MiB;
constexpr size_t WS_QA = WS_B;
constexpr size_t WS_KVA = WS_QA + 96 * MiB;
constexpr size_t WS_BM = WS_KVA + 128 * MiB;
constexpr size_t WS_OD = WS_BM + 16 * MiB;
constexpr size_t WS_LSE = WS_OD + 96 * MiB;
constexpr size_t WS_MOE = WS_LSE + 4 * MiB;
constexpr size_t WS_ROUTE = WS_MOE;
constexpr size_t WS_HIST = WS_ROUTE + 1 * MiB;
constexpr size_t WS_STOK = WS_HIST + 64 * 1024;
constexpr size_t WS_SW = WS_STOK + 640 * 1024;
constexpr size_t WS_TSLOT = WS_SW + 640 * 1024;
constexpr size_t WS_TILEE = WS_TSLOT + 512 * 1024;
constexpr size_t WS_KPE = WS_MOE + 4 * MiB;
constexpr size_t WS_KI = WS_KPE + 4 * MiB;
constexpr size_t WS_END = WS_KI + 4 * MiB;
constexpr size_t WS_MIX = WS_A;
constexpr size_t WS_H = WS_A + 128 * MiB;
constexpr size_t WS_Y = WS_H + 68 * MiB;
static_assert(WS_RET + 512 * 1024 <= WS_ROPE && WS_ROPE + 14 * MiB <= WS_WGU && WS_WD + 16 * MiB <= WS_XB && WS_XB + 128 * MiB <= WS_A, "ws map 1");
static_assert(WS_Y + 272 * MiB <= WS_MOE && WS_TILEE + 8192 <= WS_END && WS_END <= 1024 * MiB, "ws map 2");
constexpr size_t ROPE_C16 = 0, ROPE_S16 = (size_t)NT * 16 * 4, ROPE_C8 = 2 * ROPE_S16, ROPE_S8 = ROPE_C8 + (size_t)NT * 8 * 4,
                 ROPE_C4 = ROPE_S8 + (size_t)NT * 8 * 4, ROPE_S4 = ROPE_C4 + (size_t)NT * 4 * 4;

constexpr int CW_BAR = 4096;
constexpr int RING_BYTES = 131072;
constexpr int LDS_X_OFF = 131072;
constexpr int LDSCTL_OFF = 147456;
constexpr int LDS_HIST_OFF = LDSCTL_OFF + 4096;
constexpr int LDS_BYTES = LDS_HIST_OFF + 4096;

#define RLX_AGENT __ATOMIC_RELAXED, __HIP_MEMORY_SCOPE_AGENT
__device__ __forceinline__ unsigned f2bf(float f) { unsigned u = __builtin_bit_cast(unsigned, f); return (u + 0x7fffu + ((u >> 16) & 1u)) >> 16; }
#ifndef Y_FP8
#define Y_FP8 1
#endif
#define Y_SCALE 64.0f
#ifndef LN2_X1B
#define LN2_X1B 1
#endif
constexpr size_t XR_OFF = (size_t)NT * DM * 2;
#ifndef NT_EPI
#define NT_EPI 1
#endif
#ifndef NT_KVA
#define NT_KVA 1
#endif
#ifndef NT_MIX
#define NT_MIX 0
#endif
#ifndef NT_H
#define NT_H 0
#endif
#ifndef NT_Y
#define NT_Y 1
#endif
#ifndef NT_LN
#define NT_LN 0
#endif
#ifndef NT_ATT
#define NT_ATT 1
#endif
#define STG_ASM(W, POL) asm volatile("global_store_dwordx" W " %0, %1, off " POL "\n\ts_nop 1" :: "v"(p), "v"(w))
template <int M, class T> __device__ __forceinline__ void stg_any16(void* p, T w) {
    if constexpr (M == 0) *(T*)p = w; else if constexpr (M == 1) __builtin_nontemporal_store(w, (T*)p);
    else if constexpr (M == 2) STG_ASM("4", "sc1"); else if constexpr (M == 3) STG_ASM("4", "sc0 sc1"); else if constexpr (M == 4) STG_ASM("4", "sc1 nt"); else STG_ASM("4", "sc0 sc1 nt"); }
template <int M> __device__ __forceinline__ void stgf4(void* p, f32x4 w) { stg_any16<M>(p, w); }
template <int M> __device__ __forceinline__ void stg16(void* p, u32x4 w) { stg_any16<M>(p, w); }
template <int M> __device__ __forceinline__ void stg8(void* p, u32x2 w) {
    if constexpr (M == 0) *(u32x2*)p = w; else if constexpr (M == 1) __builtin_nontemporal_store(w, (u32x2*)p);
    else if constexpr (M == 2) STG_ASM("2", "sc1"); else if constexpr (M == 3) STG_ASM("2", "sc0 sc1"); else if constexpr (M == 4) STG_ASM("2", "sc1 nt"); else STG_ASM("2", "sc0 sc1 nt"); }
#ifndef NT_LD
#define NT_LD 1
#endif
template <class T> __device__ __forceinline__ T ldg_s(const void* p) { if constexpr (NT_LD) return __builtin_nontemporal_load((const T*)p); else return *(const T*)p; }
__device__ __forceinline__ unsigned pk2(float lo, float hi) { f32x2 v = {lo, hi}; bf16x2_t b = __builtin_convertvector(v, bf16x2_t); return __builtin_bit_cast(unsigned, b); }
__device__ __forceinline__ float bf2f(unsigned short b) { return __builtin_bit_cast(float, ((unsigned)b) << 16); }
__device__ __forceinline__ float bflo(unsigned w) { return __builtin_bit_cast(float, w << 16); }
__device__ __forceinline__ float bfhi(unsigned w) { return __builtin_bit_cast(float, w & 0xffff0000u); }
template <int CTRL> __device__ __forceinline__ float dppf(float x) { return __builtin_bit_cast(float, __builtin_amdgcn_mov_dpp(__builtin_bit_cast(int, x), CTRL, 0xf, 0xf, true)); }
__device__ __forceinline__ float xhalf_sum(float v) { const auto t = __builtin_amdgcn_permlane32_swap(__float_as_uint(v), __float_as_uint(v), false, false); return __uint_as_float(t[0]) + __uint_as_float(t[1]); }
__device__ __forceinline__ float xhalf_max(float v) { const auto t = __builtin_amdgcn_permlane32_swap(__float_as_uint(v), __float_as_uint(v), false, false); return fmaxf(__uint_as_float(t[0]), __uint_as_float(t[1])); }
__device__ __forceinline__ float wave_sum(float v) {
    v += dppf<0xB1>(v); v += dppf<0x4E>(v); v += dppf<0x141>(v); v += dppf<0x140>(v);
    const auto s = __builtin_amdgcn_permlane16_swap(__float_as_uint(v), __float_as_uint(v), false, false);
    v = __uint_as_float(s[0]) + __uint_as_float(s[1]);
    return xhalf_sum(v);
}
__device__ __forceinline__ int crow(int r, int hi) { return (r & 3) + 8 * (r >> 2) + 4 * hi; }

#define XB_TMO      128
#define XB_XCNT(j)  (256  + 64 * (j))
#define XB_XSUB(j)  (1280 + 64 * (j))
#define XB_XGEN(j)  (2304 + 64 * (j))
#define XB_TOP      3328
#define XB_TOPGEN   3392
#define XCD_BAR_WORDS 3456
#define XB_SPIN_CAP (1u << 18)
__device__ __forceinline__ unsigned xb_ld(unsigned* p)              { return __hip_atomic_load(p, __ATOMIC_RELAXED, __HIP_MEMORY_SCOPE_AGENT); }
__device__ __forceinline__ unsigned xb_add(unsigned* p, unsigned v) { return __hip_atomic_fetch_add(p, v, __ATOMIC_RELAXED, __HIP_MEMORY_SCOPE_AGENT); }
__device__ __forceinline__ unsigned xb_xcc_id() { return (unsigned)__builtin_amdgcn_s_getreg((3 << 11) | 20) & 0xFu; }
#define XB_SPIN(cond, bar) do { unsigned _sp = 0; while (cond) { __builtin_amdgcn_s_sleep(1); \
    if ((++_sp & 255u) == 0u) { if (xb_ld(&(bar)[XB_TMO])) break; if (_sp > XB_SPIN_CAP) { atomicAdd(&(bar)[XB_TMO], 1u); break; } } } } while (0)
struct XcdBarrier { unsigned* bar; unsigned x; volatile LAS unsigned* st; };
__device__ __forceinline__ XcdBarrier xcd_barrier_post(unsigned* bar, volatile LAS unsigned* st) {
    XcdBarrier b; b.bar = bar; b.x = xb_xcc_id(); b.st = st;
    if (threadIdx.x == 0) (void)xb_add(&bar[XB_XCNT(b.x)], 1u);
    return b;
}
__device__ __forceinline__ void xcd_barrier_complete(unsigned* bar, unsigned x, unsigned& nloc, unsigned& nx) {
    const unsigned G = gridDim.x * gridDim.y * gridDim.z;
    unsigned sum, cnt, mine, sp = 0u;
    for (;;) {
        sum = 0u; cnt = 0u; mine = 0u;
#pragma unroll
        for (unsigned j = 0; j < 16; ++j) { const unsigned c = xb_ld(&bar[XB_XCNT(j)]); sum += c; cnt += (c > 0u) ? 1u : 0u; mine = (j == x) ? c : mine; }
        if (sum == G) break;
        __builtin_amdgcn_s_sleep(1);
        if ((++sp & 255u) == 0u) { if (xb_ld(&bar[XB_TMO])) break; if (sp > XB_SPIN_CAP) { atomicAdd(&bar[XB_TMO], 1u); break; } }
    }
    nloc = mine > 0u ? mine : 1u; nx = cnt > 0u ? cnt : 1u;
}
__device__ __forceinline__ void xcd_barrier(const XcdBarrier& b) {
    asm volatile("s_waitcnt vmcnt(0)" ::: "memory");
    __syncthreads();
    if (threadIdx.x == 0) {
        unsigned* bar = b.bar;
        __builtin_amdgcn_s_waitcnt(0);
        unsigned nloc = b.st[0], nx = b.st[1];
        if (nloc == 0u) { xcd_barrier_complete(bar, b.x, nloc, nx); b.st[0] = nloc; b.st[1] = nx; }
        const unsigned old = xb_add(&bar[XB_XSUB(b.x)], 1u);
        const unsigned gen = old / nloc;
        if (old + 1u == (gen + 1u) * nloc) {
            __builtin_amdgcn_fence(__ATOMIC_RELEASE, "agent");
            asm volatile("s_waitcnt vmcnt(0)" ::: "memory");
            const unsigned og = xb_add(&bar[XB_TOP], 1u);
            const unsigned tg = og / nx;
            if (og + 1u == (tg + 1u) * nx) xb_add(&bar[XB_TOPGEN], 1u);
            else XB_SPIN(xb_ld(&bar[XB_TOPGEN]) == tg, bar);
            __builtin_amdgcn_fence(__ATOMIC_ACQUIRE, "agent");
            xb_add(&bar[XB_XGEN(b.x)], 1u);
            asm volatile("s_waitcnt vmcnt(0)" ::: "memory");
        } else {
            XB_SPIN(xb_ld(&bar[XB_XGEN(b.x)]) == gen, bar);
            __builtin_amdgcn_fence(__ATOMIC_ACQUIRE, "agent");
            asm volatile("s_waitcnt vmcnt(0)" ::: "memory");
        }
    }
    __syncthreads();
}

namespace pg8 {
constexpr int BM = 256, BK = 64, HALF = 128, HTB = HALF * BK * 2, STAGE_BYTES = 8 * HTB, NXCD = 8, WGM = 8;
__host__ __device__ __forceinline__ int lds_byte(int r, int c) { const int st = (r >> 4) * 2 + (c >> 5), rr = r & 15, cc = c & 31, ob = rr * 64 + cc * 2; return st * 1024 + (ob ^ (((ob >> 9) & 1) << 5)); }
__host__ __device__ __forceinline__ void stage_rc(int b, int& R, int& C) { const int st = b / 1024, sb = b % 1024, swz = sb ^ (((sb >> 9) & 1) << 5); R = (st >> 1) * 16 + swz / 64; C = (st & 1) * 32 + (swz % 64) / 2; }
__host__ __device__ __forceinline__ int perm32(int rho) { const int n = rho >> 4, i = rho & 15; return 8 * (i >> 2) + 4 * n + (i & 3); }

#ifndef PROBE_P1
#define PROBE_P1 0
#endif
struct Unit { int pm, pn, pb;
#if PROBE_P1
    int fl;
#endif
};
struct Gemm { const bf16* A; const bf16* Bt; int K; const int* gidx; };

__device__ __forceinline__ int xcd_remap(int wgid, int nwg) { const int q = nwg / NXCD, r = nwg % NXCD, xcd = wgid % NXCD, off = wgid / NXCD; return (xcd < r ? xcd * (q + 1) : r * (q + 1) + (xcd - r) * q) + off; }
struct StaticOrder {
    int nM, nN, nwg, G, c, rep;
    __device__ void init(int M, int N, int G_, int c_, int rep_ = 1) { nM = M / BM; nN = N / BM; nwg = nM * nN; G = G_; c = c_; rep = rep_; }
    __device__ bool next(int i, Unit& u) const {
        long L = (long)i * G + c; if (L >= (long)nwg * rep) return false;
#if PROBE_P1
        u.fl = (rep > 1 && L < nwg) ? 1 : 0;
#endif
        L %= nwg;
        const int wgid = xcd_remap((int)L, nwg);
        const int nig = WGM * nN, gid = wgid / nig, fm = gid * WGM, gsz = (nM - fm) < WGM ? (nM - fm) : WGM;
        u.pm = fm + ((wgid % nig) % gsz); u.pn = (wgid % nig) / gsz; u.pb = u.pn; return true;
    }
};
struct GroupedOrder {
    const int* tile_e; int ntiles, npn, G, c;
    __device__ bool next(int i, Unit& u) const {
        const long L = (long)i * G + c; const int nwg = ntiles * npn; if (L >= nwg) return false;
        const int wgid = xcd_remap((int)L, nwg);
        u.pm = wgid / npn; u.pn = wgid % npn; u.pb = tile_e[u.pm] * npn + u.pn;
#if PROBE_P1
        u.fl = 0;
#endif
        return true;
    }
};

__device__ __forceinline__ unsigned cvt_pk_bf16(float lo, float hi) { unsigned r; asm volatile("v_cvt_pk_bf16_f32 %0, %1, %2" : "=v"(r) : "v"(lo), "v"(hi)); return r; }

template <int STM> struct EpiPlainT {
    static constexpr bool PERM = true;
    bf16* O; int ldc; const float* ssq; int ssq_n; float ssq_inv; float eps;
    LAS unsigned char* xl;
    __device__ __forceinline__ void operator()(const f32x4 (&acc)[2][2][4][2], const Unit& u, int wr, int wc, int fr, int fq) const {
        const int lane = fq * 16 + fr; LAS unsigned char* t = xl + (wr * 4 + wc) * 2048;
        const int wsw = fr & 7, rrow = lane >> 3, rch = lane & 7;
#pragma unroll
        for (int ai = 0; ai < 2; ++ai)
#pragma unroll
            for (int m = 0; m < 4; ++m) { const int rowb = u.pm * BM + ai * HALF + wr * 64 + m * 16;
                float sc = 1.f;
                if (ssq) { const f32x4 p = *(const f32x4*)(ssq + (size_t)(rowb + fr) * ssq_n); sc = __builtin_amdgcn_rsqf((p[0] + p[1] + p[2] + p[3]) * ssq_inv + eps); }
#pragma unroll
                for (int bj = 0; bj < 2; ++bj) { const f32x4 v0 = acc[ai][bj][m][0] * sc, v1 = acc[ai][bj][m][1] * sc;
                    u32x4 w; w.x = cvt_pk_bf16(v0[0], v0[1]); w.y = cvt_pk_bf16(v0[2], v0[3]); w.z = cvt_pk_bf16(v1[0], v1[1]); w.w = cvt_pk_bf16(v1[2], v1[3]);
                    *(LAS u32x4*)(t + fr * 128 + 16 * ((4 * bj + fq) ^ wsw)) = w; }
#pragma unroll
                for (int i = 0; i < 2; ++i) { const int rr = 8 * i + rrow;
                    const u32x4 w = *(const LAS u32x4*)(t + rr * 128 + 16 * (rch ^ (rr & 7)));
                    stg16<STM>(O + (size_t)(rowb + rr) * ldc + u.pn * BM + wc * 64 + 8 * rch, w); }
            }
    }
};
template <int STM> struct EpiFp8T {
    static constexpr bool PERM = true;
    unsigned char* O; int ldc; float scale; LAS unsigned char* xl;
    __device__ __forceinline__ void operator()(const f32x4 (&acc)[2][2][4][2], const Unit& u, int wr, int wc, int fr, int fq) const {
        const int lane = fq * 16 + fr; LAS unsigned char* t = xl + (wr * 4 + wc) * 2048;
        const int rrow = lane >> 2, rch = lane & 3;
#pragma unroll
        for (int ai = 0; ai < 2; ++ai)
#pragma unroll
            for (int m = 0; m < 4; ++m) { const int rowb = u.pm * BM + ai * HALF + wr * 64 + m * 16;
#pragma unroll
                for (int bj = 0; bj < 2; ++bj) { f32x4 v0 = acc[ai][bj][m][0] * scale, v1 = acc[ai][bj][m][1] * scale;
#pragma unroll
                    for (int e = 0; e < 4; ++e) { v0[e] = __builtin_amdgcn_fmed3f(v0[e], -448.f, 448.f); v1[e] = __builtin_amdgcn_fmed3f(v1[e], -448.f, 448.f); }
                    int lo = __builtin_amdgcn_cvt_pk_fp8_f32(v0[0], v0[1], 0, false); lo = __builtin_amdgcn_cvt_pk_fp8_f32(v0[2], v0[3], lo, true);
                    int hi = __builtin_amdgcn_cvt_pk_fp8_f32(v1[0], v1[1], 0, false); hi = __builtin_amdgcn_cvt_pk_fp8_f32(v1[2], v1[3], hi, true);
                    *(LAS u32x2*)(t + fr * 64 + 32 * bj + 8 * fq) = (u32x2){(unsigned)lo, (unsigned)hi}; }
                const u32x4 w = *(const LAS u32x4*)(t + lane * 16);
                stg16<STM>(O + (size_t)(rowb + rrow) * ldc + u.pn * BM + wc * 64 + 16 * rch, w); }
    }
};
__device__ __forceinline__ f32x4 fp8x4_to_f32(unsigned w) { const f32x2 a = __builtin_amdgcn_cvt_pk_f32_fp8((int)w, false), b = __builtin_amdgcn_cvt_pk_f32_fp8((int)w, true); return (f32x4){a.x, a.y, b.x, b.y}; }
template <int STM> struct EpiGateUpT {
    static constexpr bool PERM = true;
    bf16* H; const float* sw;
    __device__ __forceinline__ void operator()(const f32x4 (&acc)[2][2][4][2], const Unit& u, int wr, int wc, int fr, int fq) const {
        const int row0 = u.pm * BM + wr * 64 + fr; const int col0 = u.pn * HALF + wc * 32 + 8 * fq;
#pragma unroll
        for (int ai = 0; ai < 2; ++ai)
#pragma unroll
            for (int m = 0; m < 4; ++m) { const int row = row0 + ai * HALF + m * 16; const float w = sw[row]; f32x4 hv[2];
#pragma unroll
                for (int n = 0; n < 2; ++n) { const f32x4 g = acc[ai][0][m][n], up = acc[ai][1][m][n];
#pragma unroll
                    for (int e = 0; e < 4; ++e) { const float sg = g[e] * __builtin_amdgcn_rcpf(1.0f + __builtin_amdgcn_exp2f(-g[e] * LOG2E)); hv[n][e] = sg * up[e] * w; } }
                u32x4 o; o.x = cvt_pk_bf16(hv[0][0], hv[0][1]); o.y = cvt_pk_bf16(hv[0][2], hv[0][3]); o.z = cvt_pk_bf16(hv[1][0], hv[1][1]); o.w = cvt_pk_bf16(hv[1][2], hv[1][3]);
                stg16<STM>(H + (size_t)row * FH + col0, o); }
    }
};

enum { GK_SKIP = 0, GK_PLAIN = 1, GK_ROPE32 = 2, GK_HEAD16 = 3, GK_IDX8 = 4, GK_WI = 5 };
struct GroupDesc { int kind; bf16* dst; int pitch; int col; float scale; int perm; float* ssq; int ssq_n; int ssq_i; };
struct RopeTabs { const int* pos; };
__device__ __forceinline__ int perm_row(int row, int perm) {
    if (perm == 0) return row; const int b = row >> 11, s = row & 2047;
    return perm == 4 ? (b << 11) + ((s & 3) << 9) + (s >> 2) : (b << 11) + ((s & 15) << 7) + (s >> 4);
}
__device__ __forceinline__ void st16(bf16* p, u32x2 a, u32x2 b) { u32x4 w; w.x = a.x; w.y = a.y; w.z = b.x; w.w = b.y; stg16<NT_EPI>(p, w); }
__device__ __forceinline__ u32x2 pk4(f32x4 v) { u32x2 w; w.x = cvt_pk_bf16(v[0], v[1]); w.y = cvt_pk_bf16(v[2], v[3]); return w; }
__device__ __forceinline__ void swap16(u32x2& X, u32x2& Y) {
    const auto a = __builtin_amdgcn_permlane16_swap(X.x, Y.x, false, false); const auto b = __builtin_amdgcn_permlane16_swap(X.y, Y.y, false, false);
    X.x = a[0]; Y.x = a[1]; X.y = b[0]; Y.y = b[1];
}
__device__ __forceinline__ float rope_k(int i, int rd) { return __builtin_amdgcn_exp2f(-18.931568569324174f * (float)(2 * i) / (float)rd) * 0.15915494309189535f; }
__device__ __forceinline__ void rope_cs(float posf, int i0, int rd, f32x4& c, f32x4& s) {
#pragma unroll
    for (int e = 0; e < 4; ++e) { const float f = __builtin_amdgcn_fractf(posf * rope_k(i0 + e, rd)); s[e] = __builtin_amdgcn_sinf(f); c[e] = __builtin_amdgcn_cosf(f); }
}
template <class DescFn> struct EpiGroups {
    static constexpr bool PERM = true;
    DescFn F; RopeTabs R; const float* rs_ssq; int rs_n; float rs_inv, rs_eps;
    __device__ __forceinline__ void operator()(const f32x4 (&acc)[2][2][4][2], const Unit& u, int wr, int wc, int fr, int fq) const {
        const int row0 = u.pm * BM + wr * 64 + fr;
#pragma unroll
        for (int bj = 0; bj < 2; ++bj) {
            const GroupDesc d = F(u.pn, bj, wc);
            if (d.kind == GK_SKIP) continue;
#if PROBE_P1 == 1
            if (u.fl) continue;
#endif
            const int ki0 = d.kind == GK_ROPE32 ? 4 * fq : (d.kind == GK_HEAD16 ? 4 * (fq & 1) : 0), krd = d.kind == GK_ROPE32 ? 32 : (d.kind == GK_HEAD16 ? 16 : 8);
#pragma unroll
            for (int ai = 0; ai < 2; ++ai)
#pragma unroll
                for (int m = 0; m < 4; ++m) {
                    const int row = row0 + ai * HALF + m * 16;
                    float sc = d.scale;
                    if (rs_ssq) { float s = 0.f; for (int i = 0; i < rs_n; ++i) s += rs_ssq[(size_t)row * rs_n + i]; sc *= __builtin_amdgcn_rsqf(s * rs_inv + rs_eps); }
                    f32x4 v0 = acc[ai][bj][m][0], v1 = acc[ai][bj][m][1];
                    if (d.ssq) {
                        float q = (v0[0] * v0[0] + v0[1] * v0[1]) + (v0[2] * v0[2] + v0[3] * v0[3]) + (v1[0] * v1[0] + v1[1] * v1[1]) + (v1[2] * v1[2] + v1[3] * v1[3]);
                        q += __shfl_xor(q, 16); q += __shfl_xor(q, 32);
                        if (fq == 0) d.ssq[(size_t)row * d.ssq_n + d.ssq_i] = q;
                    }
                    v0 = v0 * sc; v1 = v1 * sc;
                    if (d.kind == GK_WI) { if (fq == 0) { float* wp = (float*)d.dst + (size_t)row * 8; *(f32x4*)wp = v0; *(f32x4*)(wp + 4) = v1; } continue; }
                    bf16* rp = d.dst + (size_t)perm_row(row, d.perm) * d.pitch + d.col;
                    if (d.kind == GK_PLAIN) { st16(rp + 8 * fq, pk4(v0), pk4(v1)); }
                    else if (d.kind == GK_IDX8) {
                        f32x4 c, s; rope_cs((float)R.pos[row], ki0, krd, c, s);
                        const f32x4 o1 = fq == 0 ? v0 * c - v1 * s : v0, o2 = fq == 0 ? v1 * c + v0 * s : v1;
                        st16(rp + 8 * fq, pk4(o1), pk4(o2));
                    } else if (d.kind == GK_ROPE32) {
                        f32x4 c, s; rope_cs((float)R.pos[row], ki0, krd, c, s);
                        u32x2 X = pk4(v0 * c - v1 * s), Y = pk4(v1 * c + v0 * s);
                        swap16(X, Y);
                        st16(rp + ((fq & 1) ? 16 + 4 * (fq - 1) : 4 * fq), X, Y);
                    } else {
                        f32x4 c, s; rope_cs((float)R.pos[row], ki0, krd, c, s);
                        u32x2 X = pk4(fq < 2 ? v0 * c - v1 * s : v0), Y = pk4(fq < 2 ? v1 * c + v0 * s : v1);
                        swap16(X, Y);
                        st16(rp + 16 * (fq >> 1) + 8 * (fq & 1), X, Y);
                    }
                }
        }
    }
};

template <class Epi, class Sched, bool GATHER, int LDA = 0>
__device__ __forceinline__ void gemm_phase(LAS unsigned char* lds, const Gemm g, const Sched& S, const Epi& E, const int tid) {
    const int wid = __builtin_amdgcn_readfirstlane(tid >> 6), lane = tid & 63, wr = wid >> 2, wc = wid & 3, fr = lane & 15, fq = lane >> 4;
    const int K = g.K, nt = K / BK, lda = LDA ? LDA : K;
    unsigned voA[2][2], voB[2]; int RA[2], CA[2];
#pragma unroll
    for (int i = 0; i < 2; ++i) { int R, C; stage_rc(tid * 16 + i * 8192, R, C); const int Rb = Epi::PERM ? ((R & ~31) + perm32(R & 31)) : R;
        RA[i] = R; CA[i] = C; voA[0][i] = (unsigned)(R * lda + C) * 2u; voA[1][i] = (unsigned)((R + HALF) * lda + C) * 2u; voB[i] = (unsigned)(Rb * K + C) * 2u; }
    const size_t kstep = (size_t)(BK * 2);
    const size_t hstep = (size_t)HALF * K * 2;
    const size_t tstep = 2 * hstep;
    const size_t tstepA = (size_t)BM * lda * 2;
    const unsigned ldsw = (unsigned)wid * 1024u;
    const int aoff = lds_byte(wr * 64 + fr, fq * 8), boff = lds_byte(wc * 32 + fr, fq * 8);
#define PG8_SA(b, h) (((b) * 2 + (h)) * HTB)
#define PG8_SB(b, h) ((4 + (b) * 2 + (h)) * HTB)
#define PG8_STAGE(bufoff, gbase, voff) do { _Pragma("unroll") for (int _i = 0; _i < 2; ++_i) \
        __builtin_amdgcn_global_load_lds((const unsigned*)((const char*)(gbase) + (voff)[_i]), (LAS unsigned*)(lds + (bufoff) + ldsw + _i * 8192), 16, 0, 0); } while (0)
#define PG8_LDA(dst, b, h) do { _Pragma("unroll") for (int m = 0; m < 4; ++m) _Pragma("unroll") for (int k = 0; k < 2; ++k) dst[m][k] = *(const LAS bf16x8*)(lds + PG8_SA(b, h) + aoff + m * 2048 + k * 1024); } while (0)
#define PG8_LDB(dst, b, h) do { _Pragma("unroll") for (int n = 0; n < 2; ++n) _Pragma("unroll") for (int k = 0; k < 2; ++k) dst[n][k] = *(const LAS bf16x8*)(lds + PG8_SB(b, h) + boff + n * 2048 + k * 1024); } while (0)
#define PG8_MMA(ai, bj, At, Bt) do { __builtin_amdgcn_s_setprio(1); _Pragma("unroll") for (int m = 0; m < 4; ++m) _Pragma("unroll") for (int n = 0; n < 2; ++n) _Pragma("unroll") for (int k = 0; k < 2; ++k) \
        acc[ai][bj][m][n] = __builtin_amdgcn_mfma_f32_16x16x32_bf16(Bt[n][k], At[m][k], acc[ai][bj][m][n], 0, 0, 0); __builtin_amdgcn_s_setprio(0); } while (0)
#define PG8_WAIT_V(n) asm volatile("s_waitcnt vmcnt(" #n ")" ::: "memory")
#define PG8_WAIT_L(n) asm volatile("s_waitcnt lgkmcnt(" #n ")" ::: "memory")
#define PG8_BAR __builtin_amdgcn_s_barrier()
#define PG8_SCHED __builtin_amdgcn_sched_barrier(0)
    Unit cur, nxt; int ui = 0;
    if (!S.next(0, cur)) return;
    f32x4 acc[2][2][4][2];
#pragma unroll
    for (int a = 0; a < 2; ++a)
#pragma unroll
        for (int b = 0; b < 2; ++b)
#pragma unroll
            for (int m = 0; m < 4; ++m)
#pragma unroll
                for (int n = 0; n < 2; ++n) acc[a][b][m][n] = (f32x4){0.f, 0.f, 0.f, 0.f};
    bf16x8 At[4][2], B0[2][2], B1[2][2];
    unsigned nvA[2][2];
    const char* cA; const char* cB = (const char*)g.Bt + (size_t)cur.pb * tstep;
    if constexpr (GATHER) { cA = (const char*)g.A;
#pragma unroll
        for (int h = 0; h < 2; ++h)
#pragma unroll
            for (int i = 0; i < 2; ++i) voA[h][i] = (unsigned)g.gidx[cur.pm * BM + h * HALF + RA[i]] * (unsigned)(lda * 2) + (unsigned)CA[i] * 2u;
    } else cA = (const char*)g.A + (size_t)cur.pm * tstepA;
    PG8_STAGE(PG8_SB(0, 0), cB, voB); PG8_STAGE(PG8_SB(0, 1), cB + hstep, voB); PG8_STAGE(PG8_SA(0, 0), cA, voA[0]); PG8_STAGE(PG8_SA(0, 1), cA, voA[1]);
    if (wr == 1) PG8_BAR;
    PG8_WAIT_V(2); PG8_BAR;
    PG8_STAGE(PG8_SB(1, 0), cB + kstep, voB); PG8_STAGE(PG8_SA(1, 0), cA + kstep, voA[0]); PG8_STAGE(PG8_SB(1, 1), cB + hstep + kstep, voB);
    PG8_WAIT_V(6); PG8_BAR;
    for (;;) {
        const bool has_next = S.next(ui + 1, nxt);
        const char* nA; const char* nB = has_next ? (const char*)g.Bt + (size_t)nxt.pb * tstep : cB;
        if constexpr (GATHER) { nA = cA;
#pragma unroll
            for (int h = 0; h < 2; ++h)
#pragma unroll
                for (int i = 0; i < 2; ++i) nvA[h][i] = has_next ? (unsigned)g.gidx[nxt.pm * BM + h * HALF + RA[i]] * (unsigned)(lda * 2) + (unsigned)CA[i] * 2u : voA[h][i];
        } else nA = has_next ? (const char*)g.A + (size_t)nxt.pm * tstepA : cA;
#if PROBE_P1 == 2
        const int ntu = cur.fl ? 2 : nt;
#else
        const int ntu = nt;
#endif
#pragma nounroll
        for (int t = 0; t < ntu; t += 2) {
            const bool last = (t == ntu - 2);
            const char* a1 = cA + (size_t)(t + 1) * kstep;
            const char* a2 = last ? nA : cA + (size_t)(t + 2) * kstep; const char* b2 = last ? nB : cB + (size_t)(t + 2) * kstep;
            const char* a3 = a2 + kstep; const char* b3 = b2 + kstep;
            unsigned xA[2][2];
#pragma unroll
            for (int h = 0; h < 2; ++h)
#pragma unroll
                for (int i = 0; i < 2; ++i) xA[h][i] = (GATHER && last) ? nvA[h][i] : voA[h][i];
            PG8_LDB(B0, 0, 0); PG8_LDB(B1, 0, 1); PG8_SCHED; PG8_LDA(At, 0, 0); PG8_STAGE(PG8_SA(1, 1), a1, voA[1]);
            PG8_WAIT_V(8); PG8_WAIT_L(0); PG8_BAR; PG8_MMA(0, 0, At, B0); PG8_MMA(0, 1, At, B1); PG8_BAR; PG8_SCHED;
            PG8_LDA(At, 0, 1); PG8_STAGE(PG8_SB(0, 0), b2, voB); PG8_STAGE(PG8_SB(0, 1), b2 + hstep, voB); PG8_STAGE(PG8_SA(0, 0), a2, xA[0]);
            PG8_WAIT_V(8); PG8_WAIT_L(0); PG8_BAR; PG8_MMA(1, 0, At, B0); PG8_MMA(1, 1, At, B1); PG8_BAR; PG8_SCHED;
            PG8_LDB(B0, 1, 0); PG8_LDB(B1, 1, 1); PG8_SCHED; PG8_LDA(At, 1, 0); PG8_STAGE(PG8_SA(0, 1), a2, xA[1]);
            PG8_WAIT_V(8); PG8_WAIT_L(0); PG8_BAR; PG8_MMA(0, 0, At, B0); PG8_MMA(0, 1, At, B1); PG8_BAR; PG8_SCHED;
            PG8_LDA(At, 1, 1); PG8_STAGE(PG8_SB(1, 0), b3, voB); PG8_STAGE(PG8_SB(1, 1), b3 + hstep, voB); PG8_STAGE(PG8_SA(1, 0), a3, xA[0]);
            PG8_WAIT_V(8); PG8_WAIT_L(0); PG8_BAR; PG8_MMA(1, 0, At, B0); PG8_MMA(1, 1, At, B1); PG8_BAR; PG8_SCHED;
        }
        if (wr == 0) PG8_BAR;
        E(acc, cur, wr, wc, fr, fq);
        if (!has_next) break;
#pragma unroll
        for (int a = 0; a < 2; ++a)
#pragma unroll
            for (int b = 0; b < 2; ++b)
#pragma unroll
                for (int m = 0; m < 4; ++m)
#pragma unroll
                    for (int n = 0; n < 2; ++n) acc[a][b][m][n] = (f32x4){0.f, 0.f, 0.f, 0.f};
        cur = nxt; cA = nA; cB = nB; ++ui;
        if constexpr (GATHER) {
#pragma unroll
            for (int h = 0; h < 2; ++h)
#pragma unroll
                for (int i = 0; i < 2; ++i) voA[h][i] = nvA[h][i];
        }
        if (wr == 1) PG8_BAR;
    }
    PG8_WAIT_V(0);
    PG8_BAR;
#undef PG8_SA
#undef PG8_SB
#undef PG8_STAGE
#undef PG8_LDA
#undef PG8_LDB
#undef PG8_MMA
#undef PG8_WAIT_V
#undef PG8_WAIT_L
#undef PG8_BAR
#undef PG8_SCHED
}
}

#ifndef PROBE_LDS2
#define PROBE_LDS2 0
#endif
#ifndef PROBE_EXP2
#define PROBE_EXP2 0
#endif
#ifndef SOFTMAX_PK
#define SOFTMAX_PK 0
#endif
#ifndef FA_FUSE
#define FA_FUSE 0
#endif
namespace fa {
constexpr int VBYTES_T = 64 * 128;
typedef short v4i16_t __attribute__((ext_vector_type(4)));
__device__ __forceinline__ u32x2 vtr(const LAS unsigned char* p) { return __builtin_bit_cast(u32x2, __builtin_amdgcn_ds_read_tr16_b64_v4i16((LAS v4i16_t*)p)); }
__device__ __forceinline__ float max16(const f32x16& c) { float r;
    asm("v_max3_f32 %0, %1, %2, %3\n\tv_max3_f32 %0, %0, %4, %5\n\tv_max3_f32 %0, %0, %6, %7\n\tv_max3_f32 %0, %0, %8, %9\n\tv_max3_f32 %0, %0, %10, %11\n\tv_max3_f32 %0, %0, %12, %13\n\tv_max3_f32 %0, %0, %14, %15\n\tv_max_f32 %0, %0, %16"
        : "=&v"(r) : "v"(c[0]), "v"(c[1]), "v"(c[2]), "v"(c[3]), "v"(c[4]), "v"(c[5]), "v"(c[6]), "v"(c[7]), "v"(c[8]), "v"(c[9]), "v"(c[10]), "v"(c[11]), "v"(c[12]), "v"(c[13]), "v"(c[14]), "v"(c[15]));
    return r; }
__device__ __forceinline__ void mask_init(f32x16& S, unsigned nw) { float t0, t1, t2, t3, t4, t5, t6, t7, t8, t9, t10, t11, t12, t13, t14, t15;
    asm("v_bfe_i32 %0, %16, 0, 1\n\tv_lshlrev_b32 %0, 23, %0\n\tv_bfe_i32 %1, %16, 1, 1\n\tv_lshlrev_b32 %1, 23, %1\n\tv_bfe_i32 %2, %16, 2, 1\n\tv_lshlrev_b32 %2, 23, %2\n\tv_bfe_i32 %3, %16, 3, 1\n\tv_lshlrev_b32 %3, 23, %3\n\tv_bfe_i32 %4, %16, 8, 1\n\tv_lshlrev_b32 %4, 23, %4\n\tv_bfe_i32 %5, %16, 9, 1\n\tv_lshlrev_b32 %5, 23, %5\n\tv_bfe_i32 %6, %16, 10, 1\n\tv_lshlrev_b32 %6, 23, %6\n\tv_bfe_i32 %7, %16, 11, 1\n\tv_lshlrev_b32 %7, 23, %7\n\tv_bfe_i32 %8, %16, 16, 1\n\tv_lshlrev_b32 %8, 23, %8\n\tv_bfe_i32 %9, %16, 17, 1\n\tv_lshlrev_b32 %9, 23, %9\n\tv_bfe_i32 %10, %16, 18, 1\n\tv_lshlrev_b32 %10, 23, %10\n\tv_bfe_i32 %11, %16, 19, 1\n\tv_lshlrev_b32 %11, 23, %11\n\tv_bfe_i32 %12, %16, 24, 1\n\tv_lshlrev_b32 %12, 23, %12\n\tv_bfe_i32 %13, %16, 25, 1\n\tv_lshlrev_b32 %13, 23, %13\n\tv_bfe_i32 %14, %16, 26, 1\n\tv_lshlrev_b32 %14, 23, %14\n\tv_bfe_i32 %15, %16, 27, 1\n\tv_lshlrev_b32 %15, 23, %15"
        : "=&v"(t0), "=&v"(t1), "=&v"(t2), "=&v"(t3), "=&v"(t4), "=&v"(t5), "=&v"(t6), "=&v"(t7), "=&v"(t8), "=&v"(t9), "=&v"(t10), "=&v"(t11), "=&v"(t12), "=&v"(t13), "=&v"(t14), "=&v"(t15) : "v"(nw));
    S[0] = t0; S[1] = t1; S[2] = t2; S[3] = t3; S[4] = t4; S[5] = t5; S[6] = t6; S[7] = t7; S[8] = t8; S[9] = t9; S[10] = t10; S[11] = t11; S[12] = t12; S[13] = t13; S[14] = t14; S[15] = t15; }
struct Params {
    const bf16* Q;  int q_pitch;
    const bf16* K1; int k1_pitch, k1_col;
    const bf16* K2; int k2_pitch, k2_col;
    const bf16* V;  int v_pitch, v_col;
    bf16* O; int o_pitch;
    float* LSE; int lse_pitch;
    const unsigned* BM;
    int CL, W;
};
struct UnitDesc { int seq0, qw, q_col, o_col, lse_col, k1_col, v_col, kt_lo, kt_hi; };
template <int DQK, int MODE, int NH, class DescFn>
__device__ __forceinline__ void attn_stream(const Params& P, LAS unsigned char* lds, const int tid, const int n_units, DescFn desc) {
    constexpr int NKS = DQK / 16, AHEAD = (NH == 2 ? 3 : 4), NST = AHEAD + 1, K1B = 8192 * NH, K2B = (DQK == 96 ? 4096 : 0), BMOFF = K1B + K2B + 8192 * NH, STB = BMOFF + (MODE == 1 ? 8192 : 0);
    constexpr int NDMA = 2 * NH + (DQK == 96 ? 1 : 0) + (MODE == 1 ? 1 : 0);
    static_assert(NH == 1 || (DQK == 64 && MODE != 1), "two-head stages: head dim 64 only");
    constexpr bool active = true;
    if (n_units <= 0) return;
    const int lane = tid & 63, r = lane & 31, h = lane >> 5, wave = __builtin_amdgcn_readfirstlane(tid >> 6);
    const int tq_ = (lane & 15) >> 2, tp_ = lane & 3, tg_ = lane >> 4;
    const int hsel = NH == 2 ? (wave >> 2) * 8192 : 0;
    const int vtoff = K1B + K2B + hsel + (4 * h + tq_) * 128, vxb = 2 * (16 * (tg_ & 1) + 4 * tp_), vsw = (tq_ >> 1) & 1;
    const int vx0 = vxb + ((0 ^ vsw) << 6), vx1 = vxb + ((1 ^ vsw) << 6);
    const int s1_ = (r >> 1) & 7, s2_ = (r >> 2) & 3;
    const int k1row = hsel + r * 128, k2row = K1B + r * 64;
    const int row1 = 8 * wave + (lane >> 3), row2 = 16 * (wave & 3) + (lane >> 2);
    const size_t tk1 = (size_t)64 * P.k1_pitch, tk2 = (size_t)64 * P.k2_pitch, tv = (size_t)64 * P.v_pitch;
    const int d_k1 = wave * 1024, d_k2 = K1B + (wave & 3) * 1024, d_v = K1B + K2B + wave * 1024;
    const bf16* src_k1; const bf16* src_v; const bf16* src_k2 = nullptr; const unsigned* bmp = nullptr;
    int ji = -1, kti = 1, kti_hi = 0;
    auto fa_issue = [&](const int st) __attribute__((always_inline)) {
        if (kti > kti_hi) {
            if (ji + 1 < n_units) { ++ji; const UnitDesc t = desc(ji); kti = t.kt_lo; kti_hi = t.kt_hi;
                src_k1 = P.K1 + (size_t)(t.seq0 + row1) * P.k1_pitch + t.k1_col + 8 * ((lane & 7) ^ ((row1 >> 1) & 7));
                src_v = P.V + (size_t)(t.seq0 + row1) * P.v_pitch + t.v_col + 8 * ((lane & 7) ^ (((row1 >> 1) & 1) << 2));
                if constexpr (DQK == 96) src_k2 = P.K2 + (size_t)(t.seq0 + row2) * P.k2_pitch + P.k2_col + 8 * ((lane & 3) ^ ((row2 >> 2) & 3));
                if constexpr (MODE == 1) bmp = P.BM + (size_t)(t.seq0 + t.qw + r) * 64;
            } else kti = kti_hi; }
        LAS unsigned char* sb_ = lds + st * STB;
        __builtin_amdgcn_global_load_lds((const unsigned*)(src_k1 + kti * tk1), (LAS unsigned*)(sb_ + d_k1), 16, 0, 0);
        __builtin_amdgcn_global_load_lds((const unsigned*)(src_v + kti * tv), (LAS unsigned*)(sb_ + d_v), 16, 0, 0);
        if constexpr (NH == 2) {
            __builtin_amdgcn_global_load_lds((const unsigned*)(src_k1 + 64 + kti * tk1), (LAS unsigned*)(sb_ + d_k1 + 8192), 16, 0, 0);
            __builtin_amdgcn_global_load_lds((const unsigned*)(src_v + 64 + kti * tv), (LAS unsigned*)(sb_ + d_v + 8192), 16, 0, 0); }
        if constexpr (DQK == 96) __builtin_amdgcn_global_load_lds((const unsigned*)(src_k2 + kti * tk2), (LAS unsigned*)(sb_ + d_k2), 16, 0, 0);
        if constexpr (MODE == 1) __builtin_amdgcn_global_load_lds(bmp + (kti & ~1) * 2, (LAS unsigned*)(sb_ + BMOFF + wave * 1024), 16, 0, 0);
        ++kti; };
#define FA_ISSUE(TILE, ST) fa_issue(ST)
    int st_is = 0, st_c = 0, st_n = 1;
    bf16x8 qf[NKS];
#define FA_LOADQ(D) do { const bf16* qp_ = P.Q + (size_t)((D).seq0 + (D).qw + r) * P.q_pitch + (D).q_col + 8 * h; \
        _Pragma("unroll") for (int ks = 0; ks < NKS; ++ks) asm volatile("global_load_dwordx4 %0, %1, off offset:%2" : "=&v"(qf[ks]) : "v"(qp_), "n"(32 * ks) : "memory"); } while (0)
#define FA_WAITQ(N) do { if constexpr (NKS == 6) asm volatile("s_waitcnt vmcnt(%6)" : "+v"(qf[0]), "+v"(qf[1]), "+v"(qf[2]), "+v"(qf[3]), "+v"(qf[4]), "+v"(qf[5]) : "n"(N) : "memory"); \
        else asm volatile("s_waitcnt vmcnt(%4)" : "+v"(qf[0]), "+v"(qf[1]), "+v"(qf[2]), "+v"(qf[3]) : "n"(N) : "memory"); } while (0)
    { const UnitDesc d0 = desc(0); FA_LOADQ(d0); FA_WAITQ(0); }
#pragma unroll 1
    for (int ju = 0; ju < n_units; ++ju) {
    const UnitDesc du = desc(ju);
    const int seq0 = du.seq0, qw = du.qw, q_col = du.q_col, o_col = du.o_col, lse_col = du.lse_col, kt_lo = du.kt_lo, kt_hi = du.kt_hi;
    const int q = qw + r;
    const int lo_q = MODE == 0 ? max(q & ~(P.CL - 1), q - P.W) : 0;
    const int qh = q - 4 * h, lqh = lo_q - 4 * h;
    const int lo_w0 = MODE == 0 ? max(qw & ~(P.CL - 1), qw - P.W) : 0;
    const int lo_w1 = MODE == 0 ? max((qw + 31) & ~(P.CL - 1), qw + 31 - P.W) : 0;
#define FA_WAITBAR(N) do { asm volatile("s_waitcnt vmcnt(%0)" :: "n"(N) : "memory"); __builtin_amdgcn_s_barrier(); asm volatile("" ::: "memory"); } while (0)
    f32x16 o0, o1, c0, c1, n0, n1;
#pragma unroll
    for (int i = 0; i < 16; ++i) { o0[i] = 0.f; o1[i] = 0.f; c0[i] = 0.f; c1[i] = 0.f; n0[i] = 0.f; n1[i] = 0.f; }
    float m = -INFINITY, l = 0.f;
#define FA_PART(kt_) (active && (MODE == 0 ? ((kt_) * 64 <= qw + 31 && (kt_) * 64 + 63 >= lo_w0) : ((kt_) * 64 <= qw + 31)))
#define FA_KADDR(SB_, ROFF, ks) ((ks) < 4 ? (SB_) + (ROFF) * 128 + k1row + 16 * ((2 * (ks) + h) ^ s1_) : (SB_) + (ROFF) * 64 + k2row + 16 * ((2 * ((ks) - 4) + h) ^ s2_))
#define FA_QKH(S, SB_, ROFF, NW) do { bf16x8 fa_[NKS]; \
        _Pragma("unroll") for (int ks = 0; ks < NKS; ++ks) fa_[ks] = *(const LAS bf16x8*)FA_KADDR(SB_, ROFF, ks); \
        if (PROBE_LDS2) { _Pragma("unroll") for (int ks = 0; ks < NKS; ++ks) { const bf16x8 fb_ = *(const volatile LAS bf16x8*)FA_KADDR(SB_, (ROFF) ^ 32, ks); asm volatile("" :: "v"(fb_)); } } \
        if constexpr (MODE == 1) {        \
            mask_init(S, NW); \
        } else { _Pragma("unroll") for (int i = 0; i < 16; ++i) S[i] = 0.f; } \
        _Pragma("unroll") for (int ks = 0; ks < NKS; ++ks) S = __builtin_amdgcn_mfma_f32_32x32x16_bf16(fa_[ks], qf[ks], S, 0, 0, 0); \
        __builtin_amdgcn_sched_group_barrier(0x100, NKS, 0); __builtin_amdgcn_sched_group_barrier(0x008, NKS, 0); } while (0)
#define FA_QK(S0, S1, SB_, KT) do { unsigned nwa_ = 0u, nwb_ = 0u; \
        if constexpr (MODE == 1) { const u32x4 bw_ = *(const LAS u32x4*)((SB_) + BMOFF + wave * 1024 + lane * 16);        \
            nwa_ = ~((((KT) & 1) ? bw_.z : bw_.x) >> (4 * h)); nwb_ = ~((((KT) & 1) ? bw_.w : bw_.y) >> (4 * h)); } \
        FA_QKH(S0, SB_, 0, nwa_); FA_QKH(S1, SB_, 32, nwb_); } while (0)
#define FA_QKX(S, SB_, ROFF) do { bf16x8 fa_[NKS]; \
        _Pragma("unroll") for (int ks = 0; ks < NKS; ++ks) fa_[ks] = *(const LAS bf16x8*)FA_KADDR(SB_, ROFF, ks); \
        _Pragma("unroll") for (int i = 0; i < 16; ++i) S[i] = 0.f; \
        _Pragma("unroll") for (int ks = 0; ks < NKS; ++ks) S = __builtin_amdgcn_mfma_f32_32x32x16_bf16(fa_[ks], qf[ks], S, 0, 0, 0); } while (0)
    if (ju == 0) {
#pragma unroll 1
        for (int a = 0; a < AHEAD; ++a) { FA_ISSUE(kt_lo + a, st_is); st_is = st_is + 1; }
        FA_WAITBAR((AHEAD - 2) * NDMA);
    }
    if (FA_PART(kt_lo)) FA_QK(c0, c1, lds + st_c * STB, kt_lo);
    auto fa_step = [&](f32x16& c0, f32x16& c1, f32x16& n0, f32x16& n1, const int kt) __attribute__((always_inline)) {
        FA_ISSUE(kt + AHEAD, st_is); st_is = (st_is + 1 == NST) ? 0 : st_is + 1;
        const bool more1 = kt < kt_hi;
        const bool qnext = !more1 && (ju + 1 < n_units);
        if (qnext) { const UnitDesc dq = desc(ju + 1); FA_LOADQ(dq); }
        const int k0 = kt * 64;
        const bool part_c = FA_PART(kt), part_n = more1 && FA_PART(kt + 1);
        const LAS unsigned char* Sn = lds + st_n * STB; const LAS unsigned char* Vb = lds + st_c * STB;
        const bool fused = FA_FUSE && (DQK == 64) && part_c && part_n;
        if (part_n && !fused) FA_QK(n0, n1, Sn, kt + 1);
        if (part_c) {
            float alpha;
#define FA_SOFTMAX(MASKED) do { \
            if (MASKED) { if constexpr (MODE == 2) { const int qa = qh - k0, qa1 = qa - 32; \
                    _Pragma("unroll") for (int i = 0; i < 16; ++i) { const int ci = (i & 3) + 8 * (i >> 2); \
                        c0[i] = (ci > qa) ? -INFINITY : c0[i]; c1[i] = (ci > qa1) ? -INFINITY : c1[i]; } \
                } else if constexpr (MODE == 0) { const int lb = lqh - k0; const unsigned span = (unsigned)(q - lo_q), lb1 = (unsigned)(lb - 32);     \
                    _Pragma("unroll") for (int i = 0; i < 16; ++i) { const int ci = (i & 3) + 8 * (i >> 2); \
                        c0[i] = ((unsigned)(ci - lb) > span) ? -INFINITY : c0[i]; c1[i] = ((unsigned)ci - lb1 > span) ? -INFINITY : c1[i]; } \
                } } \
            float mx = xhalf_max(fmaxf(max16(c0), max16(c1))); \
            const float mn = fmaxf(m, mx); \
            const float ms = (mn == -INFINITY) ? 0.f : mn; \
            alpha = __builtin_amdgcn_exp2f(m - ms); \
            m = mn; \
            float ls = 0.f; \
            if (PROBE_EXP2) { float dm_ = 0.f; _Pragma("unroll") for (int i = 0; i < 16; ++i) { dm_ += __builtin_amdgcn_exp2f(c0[i] - mx) + __builtin_amdgcn_exp2f(c1[i] - mx); } asm volatile("" :: "v"(dm_)); } \
            if (SOFTMAX_PK) { const f32x2 ms2 = {ms, ms}; f32x2 lsa = {0.f, 0.f}, lsb = {0.f, 0.f};            \
              _Pragma("unroll") for (int i = 0; i < 16; i += 2) { \
                  f32x2 ta = {c0[i], c0[i + 1]}, tb = {c1[i], c1[i + 1]}; ta = ta - ms2; tb = tb - ms2; \
                  ta.x = __builtin_amdgcn_exp2f(ta.x); ta.y = __builtin_amdgcn_exp2f(ta.y); tb.x = __builtin_amdgcn_exp2f(tb.x); tb.y = __builtin_amdgcn_exp2f(tb.y); \
                  c0[i] = ta.x; c0[i + 1] = ta.y; c1[i] = tb.x; c1[i + 1] = tb.y; lsa = lsa + ta; lsb = lsb + tb; } \
              lsa = lsa + lsb; ls = lsa.x + lsa.y; \
            } else {        \
              _Pragma("unroll") for (int i = 0; i < 16; ++i) { c0[i] = __builtin_amdgcn_exp2f(c0[i] - ms); c1[i] = __builtin_amdgcn_exp2f(c1[i] - ms); ls += c0[i] + c1[i]; } } \
            l = l * alpha + ls; } while (0)
            const bool need_mask = MODE == 1 ? false : (MODE == 2 ? (k0 + 63 > qw) : ((k0 + 63 > qw) || (k0 < lo_w1)));
#define FA_FUSED(MASKED) do { FA_QKX(n0, Sn, 0); FA_QKX(n1, Sn, 32); FA_SOFTMAX(MASKED); \
            _Pragma("unroll") for (int hh_ = 0; hh_ < 2; ++hh_) { \
                __builtin_amdgcn_sched_group_barrier(0x100, NKS, 0); \
                _Pragma("unroll") for (int i = 0; i < NKS; ++i) { __builtin_amdgcn_sched_group_barrier(0x008, 1, 0); __builtin_amdgcn_sched_group_barrier(0x002, 120 / (2 * NKS), 0); } } } while (0)
            if (fused) { if (need_mask) FA_FUSED(true); else FA_FUSED(false); }
            else { if (need_mask) FA_SOFTMAX(true); else FA_SOFTMAX(false); }
#undef FA_FUSED
#undef FA_SOFTMAX
            if (!__all(alpha == 1.0f)) {
#pragma unroll
                for (int i = 0; i < 16; ++i) { o0[i] *= alpha; o1[i] *= alpha; } }
            const unsigned va0_ = (unsigned)(size_t)(Vb + vtoff + vx0), va1_ = (unsigned)(size_t)(Vb + vtoff + vx1);
#define FA_PV(S_, O0, O1, O2, O3) do { \
                u32x2 va00, vb00, va01, vb01, va10, vb10, va11, vb11;                           \
                asm volatile("ds_read_b64_tr_b16 %0, %8 offset:%10\n\tds_read_b64_tr_b16 %1, %8 offset:%11\n\tds_read_b64_tr_b16 %2, %9 offset:%10\n\tds_read_b64_tr_b16 %3, %9 offset:%11\n\t" \
                             "ds_read_b64_tr_b16 %4, %8 offset:%12\n\tds_read_b64_tr_b16 %5, %8 offset:%13\n\tds_read_b64_tr_b16 %6, %9 offset:%12\n\tds_read_b64_tr_b16 %7, %9 offset:%13" \
                             : "=&v"(va00), "=&v"(vb00), "=&v"(va01), "=&v"(vb01), "=&v"(va10), "=&v"(vb10), "=&v"(va11), "=&v"(vb11) \
                             : "v"(va0_), "v"(va1_), "n"(O0), "n"(O1), "n"(O2), "n"(O3) : "memory"); \
                bf16x8 pf[2]; \
                _Pragma("unroll") for (int sk = 0; sk < 2; ++sk) { u32x4 pw; pw.x = pk2(S_[8 * sk + 0], S_[8 * sk + 1]); pw.y = pk2(S_[8 * sk + 2], S_[8 * sk + 3]); pw.z = pk2(S_[8 * sk + 4], S_[8 * sk + 5]); pw.w = pk2(S_[8 * sk + 6], S_[8 * sk + 7]); pf[sk] = __builtin_bit_cast(bf16x8, pw); } \
                asm volatile("s_waitcnt lgkmcnt(0)" : "+v"(va00), "+v"(vb00), "+v"(va01), "+v"(vb01), "+v"(va10), "+v"(vb10), "+v"(va11), "+v"(vb11) :: "memory"); \
                __builtin_amdgcn_sched_barrier(0); \
                { const u32x4 v0w = {va00.x, va00.y, vb00.x, vb00.y}, v1w = {va01.x, va01.y, vb01.x, vb01.y}; \
                  o0 = __builtin_amdgcn_mfma_f32_32x32x16_bf16(__builtin_bit_cast(bf16x8, v0w), pf[0], o0, 0, 0, 0); \
                  o1 = __builtin_amdgcn_mfma_f32_32x32x16_bf16(__builtin_bit_cast(bf16x8, v1w), pf[0], o1, 0, 0, 0); } \
                { const u32x4 v0w = {va10.x, va10.y, vb10.x, vb10.y}, v1w = {va11.x, va11.y, vb11.x, vb11.y}; \
                  o0 = __builtin_amdgcn_mfma_f32_32x32x16_bf16(__builtin_bit_cast(bf16x8, v0w), pf[1], o0, 0, 0, 0); \
                  o1 = __builtin_amdgcn_mfma_f32_32x32x16_bf16(__builtin_bit_cast(bf16x8, v1w), pf[1], o1, 0, 0, 0); } } while (0)
            FA_PV(c0, 0, 1024, 2048, 3072);
            FA_PV(c1, 4096, 5120, 6144, 7168);
#undef FA_PV
        }
        if (qnext) FA_WAITBAR((AHEAD - 2) * NDMA + NKS); else FA_WAITBAR((AHEAD - 2) * NDMA);
        st_c = st_n; st_n = (st_n + 1 == NST) ? 0 : st_n + 1;
    };
    for (int kt = kt_lo;;) { fa_step(c0, c1, n0, n1, kt); if (++kt > kt_hi) break; fa_step(n0, n1, c0, c1, kt); if (++kt > kt_hi) break; }
#undef FA_PART
#undef FA_QK
#undef FA_QKH
#undef FA_QKX
#undef FA_KADDR
    const float lt = xhalf_sum(l);
    const float inv = 1.0f / lt;
    if (active) {
    bf16* op = P.O + (size_t)(seq0 + q) * P.o_pitch + o_col + 8 * h;
#pragma unroll
    for (int db = 0; db < 2; ++db) {
        const f32x16& o = db ? o1 : o0;
#pragma unroll
        for (int j = 0; j < 2; ++j) {
            u32x2 X, Y;
            X.x = pk2(o[8 * j] * inv, o[8 * j + 1] * inv); X.y = pk2(o[8 * j + 2] * inv, o[8 * j + 3] * inv);
            Y.x = pk2(o[8 * j + 4] * inv, o[8 * j + 5] * inv); Y.y = pk2(o[8 * j + 6] * inv, o[8 * j + 7] * inv);
            const auto a = __builtin_amdgcn_permlane32_swap(X.x, Y.x, false, false); const auto b = __builtin_amdgcn_permlane32_swap(X.y, Y.y, false, false);
            u32x4 w; w.x = a[0]; w.y = b[0]; w.z = a[1]; w.w = b[1];
            stg16<NT_ATT>(op + 32 * db + 16 * j, w);
        }
    }
    if (P.LSE && h == 0) P.LSE[(size_t)(seq0 + q) * P.lse_pitch + lse_col] = m + __builtin_amdgcn_logf(lt);
    }
    __builtin_amdgcn_sched_barrier(0);
    FA_WAITQ(4);
    }
    asm volatile("s_waitcnt vmcnt(0)" ::: "memory"); __builtin_amdgcn_s_barrier(); asm volatile("" ::: "memory");
#undef FA_ISSUE
#undef FA_LOADQ
#undef FA_WAITQ
#undef FA_WAITBAR
}
}

struct Args {
    const float* x; const int* pos; const float* w_in; const float* qn; const float* kvn; const float* w_uq; const float* w_ukv; const float* w_o;
    const float* ln1g; const float* ln1b; const float* rgw; const float* rgb; const float* rew; const float* reb;
    const float* wg; const float* wu; const float* wd; const float* ln2g; const float* ln2b;
    float* out; unsigned char* ws; int l_lo, l_hi, ph_lo, ph_hi, use_bar, pad;
};
typedef const __attribute__((address_space(4))) Args CArgs;
struct Ctx { LAS unsigned char* lds; int tid, lane, wave, G, c, vcu; unsigned char* ws; };

struct ColIdent { int off; __device__ __forceinline__ int operator()(int P) const { return off + P; } };
struct ColAdj { __device__ __forceinline__ int operator()(int P) const { const int p = P & 255; return (P & ~255) + 64 * ((p >> 5) & 3) + 32 * (p >> 7) + (p & 31); } };
__device__ __forceinline__ int map_rope32(int p) { return 16 * ((p >> 2) & 1) + 4 * (p >> 3) + (p & 3); }
__device__ __forceinline__ int map_head16(int p) { const int fq = p >> 3; return 16 * (fq >> 1) + 8 * ((p >> 2) & 1) + 4 * (fq & 1) + (p & 3); }
struct ColWin {
    __device__ __forceinline__ int operator()(int P) const {
        const int G = P >> 5, p = P & 31;
        if (G < 8) return 32 * G + p;
        if (G < 12) return 256 + 32 * (G - 8) + p;
        if (G == 12) return 384 + map_rope32(p);
        if (G == 13) return 1056 + p;
        if (G == 14) return 672 + map_head16(p);
        if (G == 15) return 704 + p;
        if (G < 24) { const int hh = (G - 16) >> 1; return 416 + 64 * hh + (((G - 16) & 1) ? 32 + p : map_head16(p)); }
        if (G < 26) return 736 + 32 * (G - 24) + p;
        if (G == 26) return p < 8 ? 1088 + p : -1;
        if (G < 32) return -1;
        if (G < 40) return 800 + 32 * (G - 32) + p;
        if (G < 64) { const int j = G - 40; return 1096 + 64 * (j >> 1) + ((j & 1) ? 32 + p : map_head16(p)); }
        if (G < 88) { const int j = G - 64; return 1096 + 768 + 64 * (j >> 1) + ((j & 1) ? 32 + p : map_head16(p)); }
        return 1096 + 1536 + 32 * (G - 88) + p;
    }
};
struct ColUq {
    __device__ __forceinline__ int operator()(int P) const { const int G = P >> 5, p = P & 31; return 32 * G + ((G % 3 == 2) ? map_rope32(p) : p); }
};
template <class ColFn>
__device__ __forceinline__ void transpose_item(const float* W, int ldw, int kvalid, bf16* WT, int ldt, int k0, int P0, const ColFn& cf, const float* rowscale, LAS float* scr, int lane) {
    const int c = lane & 31, col = cf(P0 + c);
#pragma unroll 8
    for (int i = 0; i < 32; ++i) { const int kk = 2 * i + (lane >> 5), k = k0 + kk; float v = 0.f;
        if (col >= 0 && k < kvalid) { v = W[(size_t)k * ldw + col]; if (rowscale) v *= rowscale[k]; }
        scr[kk * 33 + c] = v; }
    asm volatile("s_waitcnt lgkmcnt(0)" ::: "memory");
    const int cc = lane & 7;
#pragma unroll
    for (int j = 0; j < 4; ++j) { const int n = (lane >> 3) + 8 * j; const LAS float* s = scr + (8 * cc) * 33 + n;
        u32x4 o; o.x = pk2(s[0 * 33], s[1 * 33]); o.y = pk2(s[2 * 33], s[3 * 33]); o.z = pk2(s[4 * 33], s[5 * 33]); o.w = pk2(s[6 * 33], s[7 * 33]);
        *(u32x4*)(WT + (size_t)(P0 + n) * ldt + k0 + 8 * cc) = o; }
    asm volatile("s_waitcnt lgkmcnt(0)" ::: "memory");
}
__device__ __forceinline__ void prologue(const Ctx& X, const CArgs* ap) {
    struct { const float* x; const float *w_in, *qn, *kvn, *w_uq, *w_ukv, *w_o, *rgw, *rew; } a = {ap->x, ap->w_in, ap->qn, ap->kvn, ap->w_uq, ap->w_ukv, ap->w_o, ap->rgw, ap->rew};
    LAS float* scr = (LAS float*)(X.lds + X.wave * 16384);
    const int gw = X.vcu * 8 + X.wave, NGW = X.G * 8;
    constexpr int I_WIN = 16 * 112, I_UQ = 4 * 24, I_UKV = 4 * 32, I_WO = 16 * 32, I_L = I_WIN + I_UQ + I_UKV + I_WO;
    for (int it = gw; it < DEPTH * I_L; it += NGW) {
        const int l = it / I_L; int r = it % I_L;
        if (r < I_WIN) { transpose_item(a.w_in + (size_t)l * DM * IN_COLS, IN_COLS, DM, (bf16*)(X.ws + WS_WIN) + (size_t)l * NIN * DM, DM, 64 * (r / 112), 32 * (r % 112), ColWin{}, nullptr, scr, X.lane); continue; }
        r -= I_WIN;
        if (r < I_UQ) { transpose_item(a.w_uq + (size_t)l * 256 * 768, 768, 256, (bf16*)(X.ws + WS_WUQ) + (size_t)l * 768 * 256, 256, 64 * (r / 24), 32 * (r % 24), ColUq{}, a.qn + l * 256, scr, X.lane); continue; }
        r -= I_UQ;
        if (r < I_UKV) { transpose_item(a.w_ukv + (size_t)l * 128 * 1024, 1024, 128, (bf16*)(X.ws + WS_WUKV) + (size_t)l * 1024 * 256, 256, 64 * (r / 32), 32 * (r % 32), ColAdj{}, a.kvn + l * 128, scr, X.lane); continue; }
        r -= I_UKV;
        transpose_item(a.w_o + (size_t)l * DM * DM, DM, DM, (bf16*)(X.ws + WS_WO) + (size_t)l * DM * DM, DM, 64 * (r / 32), 32 * (r % 32), ColAdj{}, nullptr, scr, X.lane);
    }
    const size_t gt = (size_t)X.vcu * 512 + X.tid, NGT = (size_t)X.G * 512;
    { float* rgt = (float*)(X.ws + WS_RGT); float* ret = (float*)(X.ws + WS_RET);
      for (size_t i = gt; i < (size_t)DEPTH * 4 * DM; i += NGT) { const int l = (int)(i / (4 * DM)), g = (int)(i / DM) & 3, k = (int)(i % DM); rgt[i] = a.rgw[((size_t)l * DM + k) * 4 + g]; }
      for (size_t i = gt; i < (size_t)DEPTH * 32 * DM; i += NGT) { const int l = (int)(i / (32 * DM)), ge = (int)(i / DM) & 31, k = (int)(i % DM); ret[i] = a.rew[(((size_t)l * 4 + (ge >> 3)) * DM + k) * 8 + (ge & 7)]; } }
    { u32x4* z = (u32x4*)(X.ws + WS_T1); for (size_t i = gt; i < (size_t)NT * 256 * 2 / 16; i += NGT) z[i] = (u32x4){0u, 0u, 0u, 0u}; }
    { const f32x4* xs = (const f32x4*)a.x; u32x2* xb = (u32x2*)((unsigned char*)ap->out + XR_OFF);
      for (size_t i = gt; i < (size_t)NT * DM / 4; i += NGT) { const f32x4 v = xs[i]; u32x2 w; w.x = pk2(v[0], v[1]); w.y = pk2(v[2], v[3]); xb[i] = w; } }
}
__device__ __forceinline__ void convert_experts(const Ctx& X, const CArgs* ap, int l) {
    struct { const float *wg, *wu, *wd; } a = {ap->wg, ap->wu, ap->wd};
    LAS float* scr = (LAS float*)(X.lds + X.wave * 16384);
    const int gw = X.vcu * 8 + X.wave, NGW = X.G * 8;
    constexpr int I_GU = 32 * 16 * 16, I_D = 32 * 4 * 32;
    for (int it = gw; it < I_GU + I_D; it += NGW) {
        if (it < I_GU) { const int e = it >> 8, r = it & 255, G32 = r >> 4, kb = r & 15; const int pn = G32 >> 3, r0 = (G32 & 7) * 32; const bool up = r0 >= 128;
            const float* W = (up ? a.wu : a.wg) + ((size_t)l * NEXP + e) * DM * FH;
            transpose_item(W, FH, DM, (bf16*)(X.ws + WS_WGU) + (size_t)e * 512 * DM, DM, 64 * kb, 32 * G32, ColIdent{128 * pn + (r0 & 127) - 32 * G32}, nullptr, scr, X.lane);
        } else { const int r = it - I_GU, e = r >> 7, q = r & 127, kb = q >> 5, pg = q & 31;
            transpose_item(a.wd + ((size_t)l * NEXP + e) * FH * DM, DM, FH, (bf16*)(X.ws + WS_WD) + (size_t)e * DM * FH, FH, 64 * kb, 32 * pg, ColAdj{}, nullptr, scr, X.lane); }
    }
}

struct InProjDesc {
    unsigned char* ws;
    __device__ __forceinline__ pg8::GroupDesc operator()(int pn, int bj, int wc) const {
        using namespace pg8; const int G = 8 * pn + 4 * bj + wc; GroupDesc d; d.kind = GK_PLAIN; d.dst = nullptr; d.pitch = 256; d.col = 0; d.scale = 1.f; d.perm = 0; d.ssq = nullptr; d.ssq_n = 0; d.ssq_i = 0;
        if (G < 8) { d.dst = (bf16*)(ws + WS_CQ); d.col = 32 * G; d.ssq = (float*)(ws + WS_SSQ); d.ssq_n = 8; d.ssq_i = G; }
        else if (G < 12) { d.dst = (bf16*)(ws + WS_T1); d.col = 32 * (G - 8); d.ssq = (float*)(ws + WS_SSQ) + (size_t)NT * 8; d.ssq_n = 4; d.ssq_i = G - 8; }
        else if (G == 12) { d.kind = GK_ROPE32; d.dst = (bf16*)(ws + WS_KPE); d.pitch = 32; d.col = 0; }
        else if (G == 13) { d.kind = GK_IDX8; d.dst = (bf16*)(ws + WS_KI); d.pitch = 32; d.col = 0; }
        else if (G == 14) { d.kind = GK_HEAD16; d.dst = (bf16*)(ws + WS_T1); d.col = 192; }
        else if (G == 15) { d.dst = (bf16*)(ws + WS_T1); d.col = 224; }
        else if (G < 24) { d.kind = ((G - 16) & 1) ? GK_PLAIN : GK_HEAD16; d.dst = (bf16*)(ws + WS_BQ); d.col = 32 * (G - 16); d.scale = QSC64; }
        else if (G < 26) { d.dst = (bf16*)(ws + WS_BV); d.pitch = 64; d.col = 32 * (G - 24); }
        else if (G == 26) { d.kind = GK_WI; d.dst = (bf16*)(ws + WS_WI); }
        else if (G < 32) { d.kind = GK_SKIP; }
        else if (G < 40) { d.kind = GK_IDX8; d.dst = (bf16*)(ws + WS_BQI); d.col = 32 * (G - 32); }
        else if (G < 64) { const int j = G - 40, cfg = j >> 3; d.kind = (j & 1) ? GK_PLAIN : GK_HEAD16; d.dst = (bf16*)(ws + WS_DQ) + (size_t)cfg * NT * 256; d.col = 32 * (j & 7); d.scale = QSC64; d.perm = cfg == 0 ? 0 : (cfg == 1 ? 4 : 16); }
        else if (G < 88) { const int j = G - 64, cfg = j >> 3; d.kind = (j & 1) ? GK_PLAIN : GK_HEAD16; d.dst = (bf16*)(ws + WS_DK) + (size_t)cfg * NT * 256; d.col = 32 * (j & 7); d.perm = cfg == 0 ? 0 : (cfg == 1 ? 4 : 16); }
        else { const int j = G - 88, cfg = j >> 3; d.dst = (bf16*)(ws + WS_DV) + (size_t)cfg * NT * 256; d.col = 32 * (j & 7); d.perm = cfg == 0 ? 0 : (cfg == 1 ? 4 : 16); }
        return d;
    }
};
struct UqDesc {
    unsigned char* ws;
    __device__ __forceinline__ pg8::GroupDesc operator()(int pn, int bj, int wc) const {
        using namespace pg8; const int G = 8 * pn + 4 * bj + wc; GroupDesc d; d.kind = (G % 3 == 2) ? GK_ROPE32 : GK_PLAIN; d.dst = (bf16*)(ws + WS_QA); d.pitch = 768; d.col = 32 * G; d.scale = QSC96; d.perm = 0; d.ssq = nullptr; d.ssq_n = 0; d.ssq_i = 0;
        return d;
    }
};

__device__ __forceinline__ unsigned f16key(float v) { const _Float16 hf = (_Float16)v; const unsigned u = (unsigned)__builtin_bit_cast(unsigned short, hf); return (u ^ ((unsigned)__builtin_amdgcn_sbfe((int)u, 15, 1) | 0x8000u)) & 0xffffu; }
__device__ __forceinline__ unsigned pk_cnt(unsigned acc, unsigned kp2, unsigned mid2, unsigned one2) {
    unsigned t;
    asm("v_pk_sub_u16 %0, %2, %3 clamp\n\tv_pk_min_u16 %0, %0, %4\n\tv_pk_add_u16 %1, %1, %0" : "=&v"(t), "+v"(acc) : "v"(kp2), "s"(mid2), "s"(one2));
    return acc;
}
__device__ __forceinline__ int count_gt(const unsigned (&kp)[16], unsigned mid) {
    const unsigned m2 = __builtin_amdgcn_readfirstlane(mid | (mid << 16)), one2 = __builtin_amdgcn_readfirstlane(0x00010001u);
    unsigned a0 = 0u, a1 = 0u;
#pragma unroll
    for (int i = 0; i < 16; i += 2) { a0 = pk_cnt(a0, kp[i], m2, one2); a1 = pk_cnt(a1, kp[i + 1], m2, one2); }
    unsigned aw; asm("v_pk_add_u16 %0, %1, %2" : "=v"(aw) : "v"(a0), "v"(a1));
    const unsigned c = (aw & 0xffffu) + (aw >> 16);
    int tot = 0;
#pragma unroll
    for (int b = 0; b < 6; ++b) tot += __builtin_popcountll(__ballot((c >> b) & 1u)) << b;
    return tot;
}
__device__ __forceinline__ int wave_scan_incl(int v) {
    v += __builtin_amdgcn_update_dpp(0, v, 0x111, 0xf, 0xf, false); v += __builtin_amdgcn_update_dpp(0, v, 0x112, 0xf, 0xf, false);
    v += __builtin_amdgcn_update_dpp(0, v, 0x114, 0xf, 0xf, false); v += __builtin_amdgcn_update_dpp(0, v, 0x118, 0xf, 0xf, false);
    v += __builtin_amdgcn_update_dpp(0, v, 0x142, 0xa, 0xf, false); v += __builtin_amdgcn_update_dpp(0, v, 0x143, 0xc, 0xf, false);
    return v;
}
__device__ __forceinline__ void radix_pick(const LAS unsigned* hist, int lane, int target, int& B, int& above, int& inbin) {
    const u32x2 hw = *(const LAS u32x2*)(hist + 2 * lane);
    const int c0 = (int)(hw.x & 0xffffu), c1 = (int)(hw.x >> 16), c2 = (int)(hw.y & 0xffffu), c3 = (int)(hw.y >> 16);
    const int tl = (c0 + c1) + (c2 + c3);
    const int pre = wave_scan_incl(tl);
    const int suf = __builtin_amdgcn_readlane(pre, 63) - pre + tl;
    const unsigned long long reach = __ballot(suf >= target);
    const int ls = 63 - __builtin_clzll(reach | 1ull);
    int a = suf - tl, b = 4 * lane + 3, ib = c3;
    if (a + c3 < target) { a += c3; b = 4 * lane + 2; ib = c2; if (a + c2 < target) { a += c2; b = 4 * lane + 1; ib = c1; if (a + c1 < target) { a += c1; b = 4 * lane; ib = c0; } } }
    B = __builtin_amdgcn_readlane(b, ls); above = __builtin_amdgcn_readlane(a, ls); inbin = __builtin_amdgcn_readlane(ib, ls);
}
__device__ __forceinline__ float relu_i(float x) { const int i = __builtin_bit_cast(int, x); return __builtin_bit_cast(float, i > 0 ? i : 0); }
__device__ __forceinline__ void dsa_index_unit(const Ctx& X, int b, int q0) {
    const int lane = X.lane, r = lane & 31, h = lane >> 5; const size_t seq0 = (size_t)b * SEQ; const int t0 = q0 + 4 * X.wave;
    const bf16* BQI = (const bf16*)(X.ws + WS_BQI); const bf16* KI = (const bf16*)(X.ws + WS_KI); const float* WI = (const float*)(X.ws + WS_WI);
    LAS unsigned short* rows = (LAS unsigned short*)(X.lds + X.wave * 16384);
    LAS unsigned char* kbuf = X.lds + LDS_X_OFF;
    const bf16* ap = BQI + (seq0 + t0 + (r >> 3)) * 256 + 32 * (r & 7) + 16 * h;
    const bf16x8 a0 = *(const bf16x8*)ap, a1 = *(const bf16x8*)(ap + 8);
    f32x2 wq[4][2];
#pragma unroll
    for (int j = 0; j < 4; ++j) { const f32x4 w = *(const f32x4*)(WI + (seq0 + t0 + j) * 8 + 4 * h);
        wq[j][0] = (f32x2){w[0] * IDX_SCALE, w[1] * IDX_SCALE}; wq[j][1] = (f32x2){w[2] * IDX_SCALE, w[3] * IDX_SCALE}; }
    const int nch = ((q0 + 31) >> 7) + 1;
    const int skey = X.tid >> 2, spc = X.tid & 3;
    const bf16* sp = KI + (seq0 + skey) * 32 + 8 * spc;
    const int sdst = skey * 64 + ((spc ^ ((skey >> 2) & 3)) << 4);
    u32x4 stg0 = *(const u32x4*)sp, stg1 = stg0, stg2 = stg0, stg3 = stg0;
    if (1 < nch) stg1 = *(const u32x4*)(sp + (size_t)1 * 128 * 32);
    if (2 < nch) stg2 = *(const u32x4*)(sp + (size_t)2 * 128 * 32);
    if (3 < nch) stg3 = *(const u32x4*)(sp + (size_t)3 * 128 * 32);
    *(LAS u32x4*)(kbuf + sdst) = stg0;
    __syncthreads();
#define DSA_STEP(J, RCUR, RNEXT) { const int c = c0 + (J); \
        if (c + 4 < nch) RCUR = *(const u32x4*)(sp + (size_t)(c + 4) * 128 * 32); \
        const LAS unsigned char* kb = kbuf + (c & 1) * 8192; \
        _Pragma("unroll") for (int tq = 0; tq < 4; ++tq) { \
            const int key = 32 * tq + r, sw = (key >> 2) & 3; \
            const bf16x8 b0 = *(const LAS bf16x8*)(kb + key * 64 + (((2 * h) ^ sw) << 4)), b1 = *(const LAS bf16x8*)(kb + key * 64 + (((2 * h + 1) ^ sw) << 4)); \
            f32x16 acc; \
            _Pragma("unroll") for (int i = 0; i < 16; ++i) acc[i] = 0.f; \
            acc = __builtin_amdgcn_mfma_f32_32x32x16_bf16(a0, b0, acc, 0, 0, 0); \
            acc = __builtin_amdgcn_mfma_f32_32x32x16_bf16(a1, b1, acc, 0, 0, 0); \
            float p[4]; \
            _Pragma("unroll") for (int j = 0; j < 4; ++j) {            \
                const f32x2 ra = {relu_i(acc[4 * j]), relu_i(acc[4 * j + 1])}, rb = {relu_i(acc[4 * j + 2]), relu_i(acc[4 * j + 3])}; \
                const f32x2 pp = __builtin_elementwise_fma(rb, wq[j][1], ra * wq[j][0]); \
                p[j] = pp.x + pp.y; } \
            const auto s01 = __builtin_amdgcn_permlane32_swap(__float_as_uint(p[0]), __float_as_uint(p[1]), false, false); \
            const auto s23 = __builtin_amdgcn_permlane32_swap(__float_as_uint(p[2]), __float_as_uint(p[3]), false, false); \
            const float va = __uint_as_float(s01[0]) + __uint_as_float(s01[1]), vb = __uint_as_float(s23[0]) + __uint_as_float(s23[1]); \
            const int hw = 128 * c + 32 * tq + r;                                      \
            rows[h * 2048 + hw] = (unsigned short)f16key(va); \
            rows[(2 + h) * 2048 + hw] = (unsigned short)f16key(vb); \
        } \
        if (c + 1 < nch) *(LAS u32x4*)(kbuf + ((c + 1) & 1) * 8192 + sdst) = RNEXT; \
        __syncthreads(); }
#ifndef REP_SCORE
#define REP_SCORE 1
#endif
#ifndef REP_SEL
#define REP_SEL 1
#endif
    for (int rsc = 0; rsc < REP_SCORE; ++rsc) {
    if (rsc > 0) { stg0 = *(const u32x4*)sp; stg1 = stg0; stg2 = stg0; stg3 = stg0; if (1 < nch) stg1 = *(const u32x4*)(sp + (size_t)1 * 128 * 32); if (2 < nch) stg2 = *(const u32x4*)(sp + (size_t)2 * 128 * 32); if (3 < nch) stg3 = *(const u32x4*)(sp + (size_t)3 * 128 * 32); *(LAS u32x4*)(kbuf + sdst) = stg0; __syncthreads(); }
    for (int c0 = 0; c0 < nch; c0 += 4) {
        DSA_STEP(0, stg0, stg1)
        if (c0 + 1 >= nch) break;
        DSA_STEP(1, stg1, stg2)
        if (c0 + 2 >= nch) break;
        DSA_STEP(2, stg2, stg3)
        if (c0 + 3 >= nch) break;
        DSA_STEP(3, stg3, stg0)
    }
    }
#undef DSA_STEP
    unsigned* BMp = (unsigned*)(X.ws + WS_BM);
#ifndef REP_BIS
#define REP_BIS 1
#endif
#ifndef REP_EMIT
#define REP_EMIT 1
#endif
    for (int rsl = 0; rsl < REP_SEL; ++rsl)
    for (int j = 0; j < 4; ++j) {
        const int t = t0 + j;
        const LAS u32x4* rw = (const LAS u32x4*)(rows + j * 2048) + 4 * lane;
        unsigned kp[16];
#pragma unroll
        for (int v4 = 0; v4 < 4; ++v4) { const u32x4 d = rw[v4]; kp[4 * v4] = d.x; kp[4 * v4 + 1] = d.y; kp[4 * v4 + 2] = d.z; kp[4 * v4 + 3] = d.w; }
        const int nv = t + 1 - 32 * lane;
#pragma unroll
        for (int d = 0; d < 16; ++d) kp[d] &= ((2 * d < nv) ? 0xffffu : 0u) | ((2 * d + 1 < nv) ? 0xffff0000u : 0u);
        unsigned thr = 0u; int need = 0;
        for (int rb_ = 0; rb_ < REP_BIS; ++rb_)
        if (t + 1 > 256) {
            LAS unsigned* hist = (LAS unsigned*)(X.lds + LDS_HIST_OFF + X.wave * 512);
            *(LAS u32x2*)(hist + 2 * lane) = (u32x2){0u, 0u};
#pragma unroll
            for (int d = 0; d < 16; ++d) { const unsigned klo = kp[d] & 0xffffu, khi = kp[d] >> 16;
                if (klo) __hip_atomic_fetch_add(hist + (klo >> 9), (klo & 0x100u) ? 0x10000u : 1u, __ATOMIC_RELAXED, __HIP_MEMORY_SCOPE_WORKGROUP);
                if (khi) __hip_atomic_fetch_add(hist + (khi >> 9), (khi & 0x100u) ? 0x10000u : 1u, __ATOMIC_RELAXED, __HIP_MEMORY_SCOPE_WORKGROUP); }
            int B1, above1, in1; radix_pick(hist, lane, 256, B1, above1, in1);
            *(LAS u32x2*)(hist + 2 * lane) = (u32x2){0u, 0u};
#pragma unroll
            for (int d = 0; d < 16; ++d) { const unsigned klo = kp[d] & 0xffffu, khi = kp[d] >> 16;
                if ((int)(klo >> 8) == B1) __hip_atomic_fetch_add(hist + ((klo & 0xffu) >> 1), (klo & 1u) ? 0x10000u : 1u, __ATOMIC_RELAXED, __HIP_MEMORY_SCOPE_WORKGROUP);
                if ((int)(khi >> 8) == B1) __hip_atomic_fetch_add(hist + ((khi & 0xffu) >> 1), (khi & 1u) ? 0x10000u : 1u, __ATOMIC_RELAXED, __HIP_MEMORY_SCOPE_WORKGROUP); }
            int B2, above2, in2; radix_pick(hist, lane, 256 - above1, B2, above2, in2);
            const unsigned tk = ((unsigned)B1 << 8) | (unsigned)B2;
            const int rest = 256 - (above1 + above2);
            if (rest >= in2) { thr = tk - 1u; need = 0; } else { thr = tk; need = rest; }
        }
        unsigned word = 0u, eqw = 0u;
        const unsigned thr2 = __builtin_amdgcn_readfirstlane(thr | (thr << 16)), one2 = __builtin_amdgcn_readfirstlane(0x00010001u);
#pragma unroll
        for (int d = 0; d < 16; ++d) { unsigned g;
            asm("v_pk_sub_u16 %0, %1, %2 clamp\n\tv_pk_min_u16 %0, %0, %3" : "=&v"(g) : "v"(kp[d]), "s"(thr2), "s"(one2));
            word |= ((g | (g >> 15)) & 3u) << (2 * d); }
        if (need > 0) {
#pragma unroll
            for (int d = 0; d < 16; ++d) { unsigned g; const unsigned x = kp[d] ^ thr2;
                asm("v_pk_min_u16 %0, %1, %2" : "=v"(g) : "v"(x), "s"(one2));
                eqw |= ((~(g | (g >> 15))) & 3u) << (2 * d); }
            if (thr == 0u) eqw = 0u;
            const int ne = __builtin_popcount(eqw); const int inc = wave_scan_incl(ne);
            int take = need - (inc - ne); take = take < 0 ? 0 : (take > ne ? ne : take);
            while (__any(take > 0)) { if (take > 0) { const unsigned lowbit = eqw & (0u - eqw); word |= lowbit; eqw ^= lowbit; --take; } }
        }
        BMp[(seq0 + t) * 64 + lane] = word;
    }
}

__device__ __forceinline__ void dil_combine(const Ctx& X) {
    const bf16* OD = (const bf16*)(X.ws + WS_OD); const float* LS = (const float*)(X.ws + WS_LSE); bf16* O = (bf16*)(X.ws + WS_XB);
    const int gw = X.vcu * 8 + X.wave, NGW = X.G * 8, lane = X.lane, hh = lane >> 4;
    for (int t = gw; t < NT; t += NGW) {
        const int b = t >> 11, s = t & 2047;
        const int r0 = t, r1 = (b << 11) + ((s & 3) << 9) + (s >> 2), r2 = (b << 11) + ((s & 15) << 7) + (s >> 4);
        const float L0 = LS[(size_t)r0 * 4 + hh], L1 = LS[((size_t)NT + r1) * 4 + hh], L2 = LS[((size_t)2 * NT + r2) * 4 + hh];
        const float mx = fmaxf(L0, fmaxf(L1, L2));
        float w0 = __builtin_amdgcn_exp2f(L0 - mx), w1 = __builtin_amdgcn_exp2f(L1 - mx), w2 = __builtin_amdgcn_exp2f(L2 - mx);
        const float inv = 1.0f / (w0 + w1 + w2); w0 *= inv; w1 *= inv; w2 *= inv;
        const u32x2 a = *(const u32x2*)(OD + (size_t)r0 * 256 + 4 * lane), bq = *(const u32x2*)(OD + ((size_t)NT + r1) * 256 + 4 * lane), cq = *(const u32x2*)(OD + ((size_t)2 * NT + r2) * 256 + 4 * lane);
        u32x2 o;
        o.x = pk2(w0 * bflo(a.x) + w1 * bflo(bq.x) + w2 * bflo(cq.x), w0 * bfhi(a.x) + w1 * bfhi(bq.x) + w2 * bfhi(cq.x));
        o.y = pk2(w0 * bflo(a.y) + w1 * bflo(bq.y) + w2 * bflo(cq.y), w0 * bfhi(a.y) + w1 * bfhi(bq.y) + w2 * bfhi(cq.y));
        stg8<NT_ATT>(O + (size_t)t * DM + 768 + 4 * lane, o);
    }
}

__device__ __forceinline__ void ln1_router(const Ctx& X, const CArgs* ap, int l, bool first, bool dummy = false) {
    struct { const float *ln1g, *ln1b, *rgb, *reb; } a = {ap->ln1g, ap->ln1b, ap->rgb, ap->reb}; (void)first;
    const bf16* xin = (const bf16*)((const unsigned char*)ap->out + XR_OFF);
    const bool keep_copy = !LN2_X1B && (l == DEPTH - 1) && !dummy; bf16* XC = (bf16*)(X.ws + WS_KVA);
    const int lane = X.lane; const bf16* MIX = (const bf16*)(X.ws + WS_MIX); bf16* X1B = (bf16*)(X.ws + (dummy ? WS_Y : WS_XB));
    LAS float* reT = (LAS float*)X.lds;
    LAS float* rgT = (LAS float*)(X.lds + LDS_X_OFF);
    LAS int* hist = (LAS int*)(X.lds + LDSCTL_OFF + 256);
    { const u32x4* s1 = (const u32x4*)(X.ws + WS_RET + (size_t)l * 32 * DM * 4); for (int i = X.tid; i < 32 * DM / 4; i += 512) ((LAS u32x4*)reT)[i] = s1[i];
      const u32x4* s2 = (const u32x4*)(X.ws + WS_RGT + (size_t)l * 4 * DM * 4); for (int i = X.tid; i < 4 * DM / 4; i += 512) ((LAS u32x4*)rgT)[i] = s2[i]; }
    f32x4 g[4], bb[4];
#pragma unroll
    for (int j = 0; j < 4; ++j) { g[j] = *(const f32x4*)(a.ln1g + l * DM + 4 * lane + 256 * j); bb[j] = *(const f32x4*)(a.ln1b + l * DM + 4 * lane + 256 * j); }
    const float* rgb = a.rgb + l * 4; const float* reb = a.reb + l * 32;
    for (int rb = X.c; rb < NT / 256; rb += X.G) {
        if (X.tid < 32) hist[X.tid] = 0;
        __syncthreads();
        u32x2 xa[4], xb[4]; u32x2 ma[4], mb[4];
        { const int t = rb * 256 + X.wave * 32;
#pragma unroll
          for (int j = 0; j < 4; ++j) { xa[j] = *(const u32x2*)(xin + (size_t)t * DM + 4 * lane + 256 * j); ma[j] = *(const u32x2*)(MIX + (size_t)t * DM + 4 * lane + 256 * j); }
#pragma unroll
          for (int j = 0; j < 4; ++j) { xb[j] = *(const u32x2*)(xin + (size_t)(t + 1) * DM + 4 * lane + 256 * j); mb[j] = *(const u32x2*)(MIX + (size_t)(t + 1) * DM + 4 * lane + 256 * j); } }
        auto row = [&](u32x2 (&xn)[4], u32x2 (&mn)[4], const int i) __attribute__((always_inline)) {
            const int t = rb * 256 + X.wave * 32 + i;
            f32x4 v[4]; float s = 0.f;
#pragma unroll
            for (int j = 0; j < 4; ++j) { const u32x2 xw = xn[j]; const u32x2 mw = mn[j];
                if (keep_copy) *(u32x2*)(XC + (size_t)t * DM + 4 * lane + 256 * j) = xw;
                v[j][0] = ALPHA * bflo(xw.x) + bflo(mw.x); v[j][1] = ALPHA * bfhi(xw.x) + bfhi(mw.x); v[j][2] = ALPHA * bflo(xw.y) + bflo(mw.y); v[j][3] = ALPHA * bfhi(xw.y) + bfhi(mw.y);
                s += (v[j][0] + v[j][1]) + (v[j][2] + v[j][3]); }
            if (i + 2 < 32) {
#pragma unroll
                for (int j = 0; j < 4; ++j) { xn[j] = *(const u32x2*)(xin + (size_t)(t + 2) * DM + 4 * lane + 256 * j); mn[j] = *(const u32x2*)(MIX + (size_t)(t + 2) * DM + 4 * lane + 256 * j); } }
            const float mean = wave_sum(s) * (1.f / DM); float s2 = 0.f;
#pragma unroll
            for (int j = 0; j < 4; ++j) { v[j] = v[j] - mean; s2 += (v[j][0] * v[j][0] + v[j][1] * v[j][1]) + (v[j][2] * v[j][2] + v[j][3] * v[j][3]); }
            const float rstd = 1.0f / sqrtf(wave_sum(s2) * (1.f / DM) + 1e-5f);
#pragma unroll
            for (int j = 0; j < 4; ++j) { v[j] = v[j] * rstd * g[j] + bb[j];
                u32x2 w; w.x = pk2(v[j][0], v[j][1]); w.y = pk2(v[j][2], v[j][3]); stg8<NT_LN>(X1B + (size_t)t * DM + 4 * lane + 256 * j, w); }
            float lg[4];
#pragma unroll
            for (int gi = 0; gi < 4; ++gi) { f32x2 p2 = {0.f, 0.f};
#pragma unroll
                for (int j = 0; j < 4; ++j) { const f32x4 w = *(const LAS f32x4*)(rgT + gi * DM + 4 * lane + 256 * j);
                    p2 = __builtin_elementwise_fma((f32x2){v[j][0], v[j][1]}, (f32x2){w[0], w[1]}, p2); p2 = __builtin_elementwise_fma((f32x2){v[j][2], v[j][3]}, (f32x2){w[2], w[3]}, p2); }
                lg[gi] = wave_sum(p2.x + p2.y) + rgb[gi]; }
            int gs = 0; float gm = lg[0];
#pragma unroll
            for (int gi = 1; gi < 4; ++gi) if (lg[gi] > gm) { gm = lg[gi]; gs = gi; }
            float den = 0.f;
#pragma unroll
            for (int gi = 0; gi < 4; ++gi) den += __expf(lg[gi] - gm);
            const float ptop = __builtin_amdgcn_rcpf(den);
            gs = __builtin_amdgcn_readfirstlane(gs);
            float le[8];
#pragma unroll
            for (int e = 0; e < 8; ++e) { f32x2 p2 = {0.f, 0.f};
#pragma unroll
                for (int j = 0; j < 4; ++j) { const f32x4 w = *(const LAS f32x4*)(reT + (gs * 8 + e) * DM + 4 * lane + 256 * j);
                    p2 = __builtin_elementwise_fma((f32x2){v[j][0], v[j][1]}, (f32x2){w[0], w[1]}, p2); p2 = __builtin_elementwise_fma((f32x2){v[j][2], v[j][3]}, (f32x2){w[2], w[3]}, p2); }
                le[e] = wave_sum(p2.x + p2.y) + reb[gs * 8 + e]; }
            int e1 = 0; float v1 = le[0];
#pragma unroll
            for (int e = 1; e < 8; ++e) if (le[e] > v1) { v1 = le[e]; e1 = e; }
            int e2 = -1; float v2 = -INFINITY;
#pragma unroll
            for (int e = 0; e < 8; ++e) if (e != e1 && le[e] > v2) { v2 = le[e]; e2 = e; }
            const float wa = __builtin_amdgcn_rcpf(1.0f + __expf(v2 - v1)), wb = 1.0f - wa;
            if (lane == 0) { u32x4 ro; ro.x = (unsigned)(gs * 8 + e1); ro.y = (unsigned)(gs * 8 + e2); ro.z = __builtin_bit_cast(unsigned, ptop * wa); ro.w = __builtin_bit_cast(unsigned, ptop * wb);
                *(u32x4*)(X.ws + WS_ROUTE + (size_t)t * 16) = ro;
                __hip_atomic_fetch_add(hist + gs * 8 + e1, 1, __ATOMIC_RELAXED, __HIP_MEMORY_SCOPE_WORKGROUP); __hip_atomic_fetch_add(hist + gs * 8 + e2, 1, __ATOMIC_RELAXED, __HIP_MEMORY_SCOPE_WORKGROUP); }
        };
#pragma unroll 1
        for (int i = 0; i < 32; i += 2) { row(xa, ma, i); row(xb, mb, i + 1); }
        __syncthreads();
        if (X.tid < 32) ((int*)(X.ws + WS_HIST))[rb * 32 + X.tid] = hist[X.tid];
        __syncthreads();
    }
}

__device__ __forceinline__ void moe_dispatch(const Ctx& X) {
    LAS int* cnt = (LAS int*)(X.lds);
    LAS int* pre = cnt + 32;
    LAS int* ebase = cnt + 64;
    LAS int* wcnt = cnt + 128;
    const int* HIST = (const int*)(X.ws + WS_HIST); int* STOK = (int*)(X.ws + WS_STOK); float* SW = (float*)(X.ws + WS_SW); int* TSLOT = (int*)(X.ws + WS_TSLOT); int* TILEE = (int*)(X.ws + WS_TILEE);
    for (int rb = X.c; rb < NT / 256; rb += X.G) {
        if (X.tid < 64) cnt[X.tid] = 0;
        __syncthreads();
        { const int e = X.tid & 31, part = X.tid >> 5; int sa = 0, sp = 0;
          for (int q = 0; q < 16; ++q) { const int b2 = part * 16 + q; const int hv = HIST[b2 * 32 + e]; sa += hv; if (b2 < rb) sp += hv; }
          __hip_atomic_fetch_add(cnt + e, sa, __ATOMIC_RELAXED, __HIP_MEMORY_SCOPE_WORKGROUP); __hip_atomic_fetch_add(pre + e, sp, __ATOMIC_RELAXED, __HIP_MEMORY_SCOPE_WORKGROUP); }
        __syncthreads();
        if (X.tid < 64) { const int n = X.tid < 32 ? cnt[X.tid] : 0; const int pad = (n + 255) & ~255; int inc = pad;
#pragma unroll
            for (int o = 1; o < 32; o <<= 1) { const int u = __shfl_up(inc, o); if ((X.tid & 63) >= o) inc += u; }
            if (X.tid < 32) { ebase[X.tid] = inc - pad; if (X.tid == 31) ebase[32] = inc; } }
        __syncthreads();
        const int tl = X.tid >> 1, kk = X.tid & 1, t = rb * 256 + tl;
        const u32x4 ro = *(const u32x4*)(X.ws + WS_ROUTE + (size_t)t * 16);
        const int e = (int)(kk ? ro.y : ro.x); const float w = __builtin_bit_cast(float, kk ? ro.w : ro.z);
        int rank = 0;
        for (int ee = 0; ee < 32; ++ee) { const unsigned long long mm = __ballot(e == ee);
            if (e == ee) rank = __builtin_popcountll(mm & ((1ull << X.lane) - 1ull));
            if (X.lane == 0) wcnt[X.wave * 32 + ee] = __builtin_popcountll(mm); }
        __syncthreads();
        int off = 0;
        for (int w2 = 0; w2 < X.wave; ++w2) off += wcnt[w2 * 32 + e];
        const int slot = ebase[e] + pre[e] + off + rank;
        STOK[slot] = t; SW[slot] = w; TSLOT[2 * t + kk] = slot;
        if (rb < 32) { const int e2 = rb; for (int s = ebase[e2] + cnt[e2] + X.tid; s < ebase[e2 + 1]; s += 512) { STOK[s] = 0; SW[s] = 0.f; } }
        if (rb == 0) { const int ntl = ebase[32] >> 8;
            for (int tile = X.tid; tile < ntl; tile += 512) { int ee = 0; while (ee < 31 && ebase[ee + 1] <= tile * 256) ++ee; TILEE[tile] = ee; }
            if (X.tid == 0) TILEE[1024] = ntl; }
        __syncthreads();
    }
}

__device__ __forceinline__ void ln2_phase(const Ctx& X, const CArgs* ap, int l, bool first, bool dummy = false) {
    struct { const float *ln1g, *ln1b, *ln2g, *ln2b; } a = {ap->ln1g, ap->ln1b, ap->ln2g, ap->ln2b}; float* outw = dummy ? (float*)(X.ws + WS_Y + 272 * MiB) : ap->out; (void)first;
    const bool last = (l + 1 == DEPTH);
    const bf16* xin = LN2_X1B ? (const bf16*)(X.ws + WS_XB) : (last ? (const bf16*)(X.ws + WS_KVA) : (const bf16*)((const unsigned char*)ap->out + XR_OFF));
    const int lane = X.lane; const bf16* Y = (const bf16*)(X.ws + WS_Y); const bf16* MIX = (const bf16*)(X.ws + WS_MIX); const int* TSLOT = (const int*)(X.ws + WS_TSLOT); bf16* XBp = dummy ? (bf16*)(X.ws + WS_MIX) : (bf16*)((unsigned char*)ap->out + XR_OFF);
    auto ldy = [&](int slot, int j) __attribute__((always_inline)) -> u32x2 {
        if (Y_FP8) { u32x2 r; r.x = ldg_s<unsigned>((const unsigned char*)Y + (size_t)slot * DM + 4 * lane + 256 * j); r.y = 0u; return r; }
        return ldg_s<u32x2>(Y + (size_t)slot * DM + 4 * lane + 256 * j); };
    f32x4 g1[4], b1[4], g[4], bb[4];
#pragma unroll
    for (int j = 0; j < 4; ++j) { g1[j] = *(const f32x4*)(a.ln1g + l * DM + 4 * lane + 256 * j); b1[j] = *(const f32x4*)(a.ln1b + l * DM + 4 * lane + 256 * j);
        g[j] = *(const f32x4*)(a.ln2g + l * DM + 4 * lane + 256 * j); bb[j] = *(const f32x4*)(a.ln2b + l * DM + 4 * lane + 256 * j); }
    for (int rb = X.c; rb < NT / 256; rb += X.G) {
        const int tb = rb * 256 + X.wave * 32;
        const int myslots_a = TSLOT[2 * (tb + (lane & 31))], myslots_b = TSLOT[2 * (tb + (lane & 31)) + 1];
        u32x2 xn[4]; u32x2 mn[4], yan[4], ybn[4];
        { const int sa = __builtin_amdgcn_readlane(myslots_a, 0), sb = __builtin_amdgcn_readlane(myslots_b, 0);
#pragma unroll
          for (int j = 0; j < 4; ++j) { xn[j] = *(const u32x2*)(xin + (size_t)tb * DM + 4 * lane + 256 * j); mn[j] = LN2_X1B ? (u32x2){0u, 0u} : *(const u32x2*)(MIX + (size_t)tb * DM + 4 * lane + 256 * j);
              yan[j] = ldy(sa, j); ybn[j] = ldy(sb, j); } }
        for (int i = 0; i < 32; ++i) {
            const int t = tb + i;
            f32x4 v[4]; float s = 0.f;
#pragma unroll
            for (int j = 0; j < 4; ++j) { const u32x2 xw = xn[j]; const u32x2 mw = mn[j];
                if (LN2_X1B) { v[j][0] = bflo(xw.x); v[j][1] = bfhi(xw.x); v[j][2] = bflo(xw.y); v[j][3] = bfhi(xw.y); }
                else { v[j][0] = ALPHA * bflo(xw.x) + bflo(mw.x); v[j][1] = ALPHA * bfhi(xw.x) + bfhi(mw.x); v[j][2] = ALPHA * bflo(xw.y) + bflo(mw.y); v[j][3] = ALPHA * bfhi(xw.y) + bfhi(mw.y);
                    s += (v[j][0] + v[j][1]) + (v[j][2] + v[j][3]); } }
            u32x2 ya[4], yb[4];
#pragma unroll
            for (int j = 0; j < 4; ++j) { ya[j] = yan[j]; yb[j] = ybn[j]; }
            if (i + 1 < 32) { const int sa = __shfl(myslots_a, i + 1), sb = __shfl(myslots_b, i + 1);
#pragma unroll
                for (int j = 0; j < 4; ++j) { xn[j] = *(const u32x2*)(xin + (size_t)(t + 1) * DM + 4 * lane + 256 * j); if (!LN2_X1B) mn[j] = *(const u32x2*)(MIX + (size_t)(t + 1) * DM + 4 * lane + 256 * j);
                    yan[j] = ldy(sa, j); ybn[j] = ldy(sb, j); } }
            if (!LN2_X1B) { const float mean = wave_sum(s) * (1.f / DM); float s2 = 0.f;
#pragma unroll
              for (int j = 0; j < 4; ++j) { v[j] = v[j] - mean; s2 += (v[j][0] * v[j][0] + v[j][1] * v[j][1]) + (v[j][2] * v[j][2] + v[j][3] * v[j][3]); }
              const float rstd = 1.0f / sqrtf(wave_sum(s2) * (1.f / DM) + 1e-5f);
#pragma unroll
              for (int j = 0; j < 4; ++j) v[j] = v[j] * rstd * g1[j] + b1[j]; }
            s = 0.f;
#pragma unroll
            for (int j = 0; j < 4; ++j) { const f32x4 xv = v[j];
                if (Y_FP8) { const f32x4 fa = pg8::fp8x4_to_f32(ya[j].x), fb = pg8::fp8x4_to_f32(yb[j].x);
#pragma unroll
                    for (int e = 0; e < 4; ++e) v[j][e] = ALPHA * xv[e] + (fa[e] + fb[e]) * (1.0f / Y_SCALE);
                } else { v[j][0] = ALPHA * xv[0] + (bflo(ya[j].x) + bflo(yb[j].x)); v[j][1] = ALPHA * xv[1] + (bfhi(ya[j].x) + bfhi(yb[j].x)); v[j][2] = ALPHA * xv[2] + (bflo(ya[j].y) + bflo(yb[j].y)); v[j][3] = ALPHA * xv[3] + (bfhi(ya[j].y) + bfhi(yb[j].y)); }
                s += (v[j][0] + v[j][1]) + (v[j][2] + v[j][3]); }
            const float mean = wave_sum(s) * (1.f / DM); float s2 = 0.f;
#pragma unroll
            for (int j = 0; j < 4; ++j) { v[j] = v[j] - mean; s2 += (v[j][0] * v[j][0] + v[j][1] * v[j][1]) + (v[j][2] * v[j][2] + v[j][3] * v[j][3]); }
            const float rstd = 1.0f / sqrtf(wave_sum(s2) * (1.f / DM) + 1e-5f);
#pragma unroll
            for (int j = 0; j < 4; ++j) { v[j] = v[j] * rstd * g[j] + bb[j];
                if (last || dummy) stgf4<NT_LN>(outw + (size_t)t * DM + 4 * lane + 256 * j, v[j]);
                else { u32x2 w; w.x = pk2(v[j][0], v[j][1]); w.y = pk2(v[j][2], v[j][3]); stg8<NT_LN>(XBp + (size_t)t * DM + 4 * lane + 256 * j, w); } }
        }
    }
}

#ifndef REP_P0
#define REP_P0 1
#endif
#ifndef REP_P5
#define REP_P5 1
#endif
#ifndef REP_P9
#define REP_P9 1
#endif
#ifndef REP_BAR
#define REP_BAR 1
#endif
#ifndef REP_P1
#define REP_P1 1
#endif
#ifndef REP_P2A
#define REP_P2A 1
#endif
#ifndef REP_P2B
#define REP_P2B 1
#endif
#ifndef REP_P2C
#define REP_P2C 1
#endif
#ifndef REP_P2D
#define REP_P2D 1
#endif
#ifndef REP_P3A
#define REP_P3A 1
#endif
#ifndef REP_P3B
#define REP_P3B 1
#endif
#ifndef REP_P3C
#define REP_P3C 1
#endif
#ifndef REP_P4
#define REP_P4 1
#endif
#ifndef REP_P6
#define REP_P6 1
#endif
#ifndef REP_P7
#define REP_P7 1
#endif
#ifndef REP_P8
#define REP_P8 1
#endif
__global__ void __launch_bounds__(512, 2) mk_fwd(Args a) {
    extern __shared__ __attribute__((aligned(16))) unsigned char lds_raw[];
    LAS unsigned char* const lds0 = (LAS unsigned char*)lds_raw;
    for (int u = threadIdx.x; u < (LDS_BYTES - LDSCTL_OFF) / 4; u += 512) ((LAS unsigned*)(lds0 + LDSCTL_OFF))[u] = 0u;
    __syncthreads();
    unsigned* barw = (unsigned*)(a.ws + WS_CTL) + CW_BAR;
    XcdBarrier bar; bar.bar = barw; bar.x = 0; bar.st = nullptr;
    if (a.use_bar) bar = xcd_barrier_post(barw, (volatile LAS unsigned*)(lds0 + LDSCTL_OFF) + 8);
#define MKCTX() Ctx X; const CArgs* ap = (const CArgs*)__builtin_amdgcn_kernarg_segment_ptr(); asm volatile("" : "+s"(ap)); { int t_ = threadIdx.x; asm volatile("" : "+v"(t_)); X.lds = lds0; X.tid = t_; X.lane = t_ & 63; X.wave = __builtin_amdgcn_readfirstlane(t_ >> 6); \
        unsigned char* w_ = ap->ws; X.G = gridDim.x; X.c = blockIdx.x; X.vcu = (X.G % 8 == 0) ? (X.c % 8) * (X.G / 8) + X.c / 8 : X.c; X.ws = w_; }
#ifndef P2M
#define P2M 31
#endif
#ifndef PH_MASK0
#define PH_MASK0 1
#endif
#define GBAR() do { if (a.use_bar) for (int rb_ = 0; rb_ < REP_BAR; ++rb_) xcd_barrier(bar); } while (0)

    if ((PH_MASK0 & 1) && a.l_lo == 0 && a.ph_lo == 0) { MKCTX(); for (int rep = 0; rep < REP_P0; ++rep) { prologue(X, ap); __syncthreads(); } GBAR(); }

    for (int l = a.l_lo; l < a.l_hi; ++l) {
        const int lo = (l == a.l_lo) ? (a.ph_lo < 1 ? 1 : a.ph_lo) : 1, hi = (l == a.l_hi - 1) ? a.ph_hi : 10;
#ifndef PH_MASK
#define PH_MASK 0x3ff
#endif
#define IN(k) (((PH_MASK >> (k)) & 1) && lo <= (k) && (k) < hi)
        if (IN(1)) { MKCTX();
            pg8::Gemm g{(const bf16*)((const unsigned char*)ap->out + XR_OFF), (const bf16*)(X.ws + WS_WIN) + (size_t)l * NIN * DM, DM, nullptr};
            pg8::StaticOrder S; S.init(NT, NIN, X.G, X.c, REP_P1);
            pg8::RopeTabs R{ap->pos};
            pg8::EpiGroups<InProjDesc> E{InProjDesc{X.ws}, R, nullptr, 0, 0.f, 0.f};
            pg8::gemm_phase<pg8::EpiGroups<InProjDesc>, pg8::StaticOrder, false>(X.lds, g, S, E, X.tid);
            GBAR();
        }
        if (IN(2)) { MKCTX();
            {
                pg8::Gemm g{(const bf16*)(X.ws + WS_CQ), (const bf16*)(X.ws + WS_WUQ) + (size_t)l * 768 * 256, 256, nullptr};
                pg8::StaticOrder S; S.init(NT, 768, X.G, X.c, REP_P2A);
                pg8::RopeTabs R{ap->pos};
                pg8::EpiGroups<UqDesc> E{UqDesc{X.ws}, R, (const float*)(X.ws + WS_SSQ), 8, 1.0f / 256.0f, 1e-6f};
                pg8::gemm_phase<pg8::EpiGroups<UqDesc>, pg8::StaticOrder, false>(X.lds, g, S, E, X.tid);
            }
            {
                pg8::Gemm g{(const bf16*)(X.ws + WS_T1), (const bf16*)(X.ws + WS_WUKV) + (size_t)l * 1024 * 256, 256, nullptr};
                pg8::StaticOrder S; S.init(NT, 1024, X.G, X.c, REP_P2A);
                pg8::EpiPlainT<NT_KVA> E{(bf16*)(X.ws + WS_KVA), 1024, (const float*)(X.ws + WS_SSQ) + (size_t)NT * 8, 4, 1.0f / 128.0f, 1e-6f, X.lds + LDS_X_OFF};
                pg8::gemm_phase<decltype(E), pg8::StaticOrder, false>(X.lds, g, S, E, X.tid);
            }
            __syncthreads();
            for (int rep = 0; rep < REP_P2B; ++rep) convert_experts(X, ap, l);
            __syncthreads();
            for (int rep = 0; rep < REP_P2C; ++rep) for (int U = X.vcu; U < NB * 32; U += X.G) { const int b = U >> 5, pr = U & 31;
                dsa_index_unit(X, b, 32 * pr); dsa_index_unit(X, b, 32 * (63 - pr)); }
            __syncthreads();
#pragma unroll 1
            for (int cfg = 0; cfg < 3 * REP_P2D; ++cfg) { const int cfgi = cfg % 3;
                fa::Params P; const size_t co = (size_t)cfgi * NT * 256;
                P.Q = (const bf16*)(X.ws + WS_DQ) + co; P.q_pitch = 256; P.K1 = (const bf16*)(X.ws + WS_DK) + co; P.k1_pitch = 256; P.K2 = nullptr; P.k2_pitch = 0; P.k2_col = 0;
                P.V = (const bf16*)(X.ws + WS_DV) + co; P.v_pitch = 256; P.O = (bf16*)(X.ws + WS_OD) + co; P.o_pitch = 256; P.LSE = (float*)(X.ws + WS_LSE) + (size_t)cfgi * NT * 4; P.lse_pitch = 4; P.BM = nullptr;
                P.CL = cfgi == 0 ? 2048 : (cfgi == 1 ? 512 : 128); P.W = 128;
                const int vcu = X.vcu, G = X.G, wv = X.wave, CLc = P.CL;
                fa::attn_stream<64, 0, 2>(P, X.lds, X.tid, (NB * 2 * 16 - vcu + G - 1) / G, [=](int j) { const int U = vcu + j * G, bh = U >> 4, qb = U & 15, b = bh >> 1, hp = bh & 1;
                    const int q0 = 128 * qb, hh = 2 * hp + (wv >> 2); int klo = q0 & ~(CLc - 1); if (q0 - 128 > klo) klo = q0 - 128;
                    return fa::UnitDesc{b * SEQ, q0 + 32 * (wv & 3), 64 * hh, 64 * hh, hh, 128 * hp, 128 * hp, klo >> 6, (q0 + 127) >> 6}; });
            }
            GBAR();
        }
        if (IN(3)) { MKCTX();
            {   fa::Params P; P.Q = (const bf16*)(X.ws + WS_QA); P.q_pitch = 768; P.K1 = (const bf16*)(X.ws + WS_KVA); P.k1_pitch = 1024; P.K2 = (const bf16*)(X.ws + WS_KPE); P.k2_pitch = 32; P.k2_col = 0;
                P.V = (const bf16*)(X.ws + WS_KVA); P.v_pitch = 1024; P.O = (bf16*)(X.ws + WS_XB); P.o_pitch = DM; P.LSE = nullptr; P.lse_pitch = 0; P.BM = nullptr; P.CL = 2048; P.W = 1 << 20;
                const int vcu = X.vcu, G = X.G, wv = X.wave;
                fa::attn_stream<96, 2, 1>(P, X.lds, X.tid, 2 * ((NB * 8 * 4 - vcu + G - 1) / G), [=](int j) { const int U = vcu + (j >> 1) * G, bh = U >> 2, pr = U & 3, b = bh >> 3, hd = bh & 7;
                    const int qb = (j & 1) ? 7 - pr : pr, q0 = 256 * qb;
                    return fa::UnitDesc{b * SEQ, q0 + 32 * wv, 96 * hd, 64 * hd, 0, 128 * hd, 128 * hd + 64, 0, (q0 + 255) >> 6}; });
            }
            {   fa::Params P; P.Q = (const bf16*)(X.ws + WS_BQ); P.q_pitch = 256; P.K1 = (const bf16*)(X.ws + WS_T1); P.k1_pitch = 256; P.k1_col = 192; P.K2 = nullptr; P.k2_pitch = 0; P.k2_col = 0;
                P.V = (const bf16*)(X.ws + WS_BV); P.v_pitch = 64; P.v_col = 0; P.O = (bf16*)(X.ws + WS_XB); P.o_pitch = DM; P.LSE = nullptr; P.lse_pitch = 0; P.BM = (const unsigned*)(X.ws + WS_BM); P.CL = 2048; P.W = 1 << 20;
                const int hd = X.wave & 3, sub = X.wave >> 2, vcu = X.vcu, G = X.G;
                fa::attn_stream<64, 1, 1>(P, X.lds, X.tid, 2 * ((NB * 16 - vcu + G - 1) / G), [=](int j) { const int U = vcu + (j >> 1) * G, b = U >> 4, pr = U & 15;
                    const int qb = (j & 1) ? 31 - pr : pr, q0 = 64 * qb;
                    return fa::UnitDesc{b * SEQ, q0 + 32 * sub, 64 * hd, 512 + 64 * hd, 0, 192, 0, 0, qb}; });
            }
            for (int rep = 0; rep < REP_P3C; ++rep) dil_combine(X);
            GBAR();
        }
        if (IN(4)) { MKCTX();
            pg8::Gemm g{(const bf16*)(X.ws + WS_XB), (const bf16*)(X.ws + WS_WO) + (size_t)l * DM * DM, DM, nullptr};
            pg8::StaticOrder S; S.init(NT, DM, X.G, X.c, REP_P4);
            pg8::EpiPlainT<NT_MIX> E{(bf16*)(X.ws + WS_MIX), DM, nullptr, 0, 0.f, 0.f, X.lds + LDS_X_OFF};
            pg8::gemm_phase<decltype(E), pg8::StaticOrder, false>(X.lds, g, S, E, X.tid);
            GBAR();
        }
        if (IN(5)) { MKCTX(); if (REP_P5 > 1) ln1_router(X, ap, l, l == 0, true); ln1_router(X, ap, l, l == 0); GBAR(); }
        if (IN(6)) { MKCTX(); for (int rep = 0; rep < REP_P6; ++rep) moe_dispatch(X); GBAR(); }
        if (IN(7)) { MKCTX();
            const int* TILEE = (const int*)(X.ws + WS_TILEE);
            pg8::Gemm g{(const bf16*)(X.ws + WS_XB), (const bf16*)(X.ws + WS_WGU), DM, (const int*)(X.ws + WS_STOK)};
            pg8::GroupedOrder S{TILEE, TILEE[1024], 2, X.G, X.c};
            pg8::EpiGateUpT<NT_H> E{(bf16*)(X.ws + WS_H), (const float*)(X.ws + WS_SW)};
            for (int rep = 0; rep < REP_P7; ++rep) pg8::gemm_phase<decltype(E), pg8::GroupedOrder, true>(X.lds, g, S, E, X.tid);
            GBAR();
        }
        if (IN(8)) { MKCTX();
            const int* TILEE = (const int*)(X.ws + WS_TILEE);
            pg8::Gemm g{(const bf16*)(X.ws + WS_H), (const bf16*)(X.ws + WS_WD), FH, nullptr};
            pg8::GroupedOrder S{TILEE, TILEE[1024], 4, X.G, X.c};
#if Y_FP8
            pg8::EpiFp8T<NT_Y> E{X.ws + WS_Y, DM, Y_SCALE, X.lds + LDS_X_OFF};
#else
            pg8::EpiPlainT<NT_Y> E{(bf16*)(X.ws + WS_Y), DM, nullptr, 0, 0.f, 0.f, X.lds + LDS_X_OFF};
#endif
            for (int rep = 0; rep < REP_P8; ++rep) pg8::gemm_phase<decltype(E), pg8::GroupedOrder, false>(X.lds, g, S, E, X.tid);
            GBAR();
        }
        if (IN(9)) { MKCTX(); if (REP_P9 > 1) ln2_phase(X, ap, l, l == 0, true); ln2_phase(X, ap, l, l == 0); if (!(l == a.l_hi - 1)) GBAR(); }
#undef IN
    }
#undef GBAR
}

extern "C" void kernel_launch(void* const* d_in, const int* in_sizes, int n_in, void* d_out, int out_size, void* d_ws, size_t ws_size, hipStream_t stream) {
    static int grid = 0;
    if (grid == 0) {
        if (n_in != 19 || in_sizes[0] != NT * DM || out_size != NT * DM || ws_size < WS_END) { fprintf(stderr, "kernel_launch: unexpected shapes (n_in %d, in0 %d, out %d, ws %zu < %zu); nothing launched\n", n_in, n_in > 0 ? in_sizes[0] : -1, out_size, ws_size, (size_t)WS_END); grid = -1; return; }
        int dev = 0, cus = 0, per_cu = 0;
        if (hipGetDevice(&dev) != hipSuccess || hipDeviceGetAttribute(&cus, hipDeviceAttributeMultiprocessorCount, dev) != hipSuccess) { grid = -1; return; }
        if (hipFuncSetAttribute((const void*)mk_fwd, hipFuncAttributeMaxDynamicSharedMemorySize, LDS_BYTES) != hipSuccess) { fprintf(stderr, "kernel_launch: hipFuncSetAttribute failed\n"); grid = -1; return; }
        if (hipOccupancyMaxActiveBlocksPerMultiprocessor(&per_cu, (const void*)mk_fwd, 512, LDS_BYTES) != hipSuccess || per_cu < 1) fprintf(stderr, "kernel_launch: occupancy query reports %d\n", per_cu);
        (void)hipGetLastError();
        grid = cus;
    }
    if (grid < 0) return;
    (void)hipMemsetAsync((char*)d_ws + WS_CTL, 0, CTL_BYTES, stream);
    Args a{};
    a.x = (const float*)d_in[0]; a.pos = (const int*)d_in[1]; a.w_in = (const float*)d_in[2]; a.qn = (const float*)d_in[3]; a.kvn = (const float*)d_in[4];
    a.w_uq = (const float*)d_in[5]; a.w_ukv = (const float*)d_in[6]; a.w_o = (const float*)d_in[7]; a.ln1g = (const float*)d_in[8]; a.ln1b = (const float*)d_in[9];
    a.rgw = (const float*)d_in[10]; a.rgb = (const float*)d_in[11]; a.rew = (const float*)d_in[12]; a.reb = (const float*)d_in[13];
    a.wg = (const float*)d_in[14]; a.wu = (const float*)d_in[15]; a.wd = (const float*)d_in[16]; a.ln2g = (const float*)d_in[17]; a.ln2b = (const float*)d_in[18];
    a.out = (float*)d_out; a.ws = (unsigned char*)d_ws; a.pad = 0;
#if MK_MULTI
    a.use_bar = 0;
    a.l_lo = 0; a.l_hi = 0; a.ph_lo = 0; a.ph_hi = 0;
    hipLaunchKernelGGL(mk_fwd, dim3(grid), dim3(512), LDS_BYTES, stream, a);
    for (int l = 0; l < DEPTH; ++l)
        for (int ph = 1; ph < 10; ++ph) { a.l_lo = l; a.l_hi = l + 1; a.ph_lo = ph; a.ph_hi = ph + 1; hipLaunchKernelGGL(mk_fwd, dim3(grid), dim3(512), LDS_BYTES, stream, a); }
#else
    a.use_bar = 1; a.l_lo = 0; a.l_hi = DEPTH; a.ph_lo = 0; a.ph_hi = 10;
    hipLaunchKernelGGL(mk_fwd, dim3(grid), dim3(512), LDS_BYTES, stream, a);
#endif
    const hipError_t le = hipPeekAtLastError();
    if (le != hipSuccess) fprintf(stderr, "kernel_launch: launch failed: %s\n", hipGetErrorName(le));
}
```

```cpp
#include <hip/hip_runtime.h>
#include <cstdio>
#include <cstdint>

#define LAS __attribute__((address_space(3)))
#define GAS __attribute__((address_space(1)))
typedef unsigned short bf16;
typedef short bf16x8 __attribute__((ext_vector_type(8)));
typedef short s16x4 __attribute__((ext_vector_type(4)));
typedef float f32x2 __attribute__((ext_vector_type(2)));
typedef float f32x4 __attribute__((ext_vector_type(4)));
typedef float f32x16 __attribute__((ext_vector_type(16)));
typedef unsigned u32x2 __attribute__((ext_vector_type(2)));
typedef unsigned u32x4 __attribute__((ext_vector_type(4)));
typedef __bf16 bf16x2_t __attribute__((ext_vector_type(2)));

#ifndef MK_MULTI
#define MK_MULTI 0
#endif

constexpr int NB = 32, SEQ = 2048, NT = NB * SEQ, DM = 1024, DEPTH = 4;
constexpr int IN_COLS = 3400, NIN = 3584;
constexpr int NEXP = 32, FH = 256;
constexpr int NSLOT = 2 * NT + NEXP * 256;
constexpr int MAXTILES = NSLOT / 256;
constexpr float ALPHA = 1.681792830507429f;
constexpr float LOG2E = 1.4426950408889634f;
constexpr float QSC64 = 0.125f * LOG2E;
constexpr float QSC96 = 0.10206207261596577f * LOG2E;
constexpr float IDX_SCALE = 0.0625f;

constexpr size_t MiB = 1u << 20;
constexpr size_t WS_CTL = 0, CTL_BYTES = 1 * MiB;
constexpr size_t WS_WIN = 1 * MiB;
constexpr size_t WS_WUQ = 29 * MiB;
constexpr size_t WS_WUKV = WS_WUQ + 3 * MiB / 2;
constexpr size_t WS_WO = WS_WUKV + 2 * MiB;
constexpr size_t WS_RGT = WS_WO + 8 * MiB;
constexpr size_t WS_RET = WS_RGT + 64 * 1024;
constexpr size_t WS_ROPE = 42 * MiB;
constexpr size_t WS_WGU = 56 * MiB;
constexpr size_t WS_WD = 88 * MiB;
constexpr size_t WS_XB = 104 * MiB;
constexpr size_t WS_A = 232 * MiB;
constexpr size_t WS_CQ = WS_A;
constexpr size_t WS_T1 = WS_CQ + 32 * MiB;
constexpr size_t WS_BQ = WS_T1 + 32 * MiB;
constexpr size_t WS_BV = WS_BQ + 32 * MiB;
constexpr size_t WS_WI = WS_BV + 8 * MiB;
constexpr size_t WS_BQI = WS_WI + 2 * MiB;
constexpr size_t WS_SSQ = WS_BQI + 32 * MiB;
constexpr size_t WS_DQ = WS_SSQ + 4 * MiB;
constexpr size_t WS_DK = WS_DQ + 96 * MiB;
constexpr size_t WS_DV = WS_DK + 96 * MiB;
constexpr size_t WS_B = WS_DV + 96 * MiB;
constexpr size_t WS_QA = WS_B;
constexpr size_t WS_KVA = WS_QA + 96 * MiB;
constexpr size_t WS_BM = WS_KVA + 128 * MiB;
constexpr size_t WS_OD = WS_BM + 16 * MiB;
constexpr size_t WS_LSE = WS_OD + 96 * MiB;
constexpr size_t WS_MOE = WS_LSE + 4 * MiB;
constexpr size_t WS_ROUTE = WS_MOE;
constexpr size_t WS_HIST = WS_ROUTE + 1 * MiB;
constexpr size_t WS_STOK = WS_HIST + 64 * 1024;
constexpr size_t WS_SW = WS_STOK + 640 * 1024;
constexpr size_t WS_TSLOT = WS_SW + 640 * 1024;
constexpr size_t WS_TILEE = WS_TSLOT + 512 * 1024;
constexpr size_t WS_KPE = WS_MOE + 4 * MiB;
constexpr size_t WS_KI = WS_KPE + 4 * MiB;
constexpr size_t WS_END = WS_KI + 4 * MiB;
constexpr size_t WS_MIX = WS_A;
constexpr size_t WS_H = WS_A + 128 * MiB;
constexpr size_t WS_Y = WS_H + 68 * MiB;
static_assert(WS_RET + 512 * 1024 <= WS_ROPE && WS_ROPE + 14 * MiB <= WS_WGU && WS_WD + 16 * MiB <= WS_XB && WS_XB + 128 * MiB <= WS_A, "ws map 1");
static_assert(WS_Y + 272 * MiB <= WS_MOE && WS_TILEE + 8192 <= WS_END && WS_END <= 1024 * MiB, "ws map 2");
constexpr size_t ROPE_C16 = 0, ROPE_S16 = (size_t)NT * 16 * 4, ROPE_C8 = 2 * ROPE_S16, ROPE_S8 = ROPE_C8 + (size_t)NT * 8 * 4,
                 ROPE_C4 = ROPE_S8 + (size_t)NT * 8 * 4, ROPE_S4 = ROPE_C4 + (size_t)NT * 4 * 4;

constexpr int CW_BAR = 4096;
constexpr int RING_BYTES = 131072;
constexpr int LDS_X_OFF = 131072;
constexpr int LDSCTL_OFF = 147456;
constexpr int LDS_HIST_OFF = LDSCTL_OFF + 4096;
constexpr int LDS_BYTES = LDS_HIST_OFF + 4096;

#define RLX_AGENT __ATOMIC_RELAXED, __HIP_MEMORY_SCOPE_AGENT
__device__ __forceinline__ unsigned f2bf(float f) { unsigned u = __builtin_bit_cast(unsigned, f); return (u + 0x7fffu + ((u >> 16) & 1u)) >> 16; }
#ifndef Y_FP8
#define Y_FP8 1
#endif
#define Y_SCALE 64.0f
#ifndef LN2_X1B
#define LN2_X1B 1
#endif
constexpr size_t XR_OFF = (size_t)NT * DM * 2;
#ifndef NT_EPI
#define NT_EPI 1
#endif
#ifndef NT_KVA
#define NT_KVA 1
#endif
#ifndef NT_MIX
#define NT_MIX 0
#endif
#ifndef NT_H
#define NT_H 0
#endif
#ifndef NT_Y
#define NT_Y 1
#endif
#ifndef NT_LN
#define NT_LN 0
#endif
#ifndef NT_ATT
#define NT_ATT 1
#endif
#define STG_ASM(W, POL) asm volatile("global_store_dwordx" W " %0, %1, off " POL "\n\ts_nop 1" :: "v"(p), "v"(w))
template <int M, class T> __device__ __forceinline__ void stg_any16(void* p, T w) {
    if constexpr (M == 0) *(T*)p = w; else if constexpr (M == 1) __builtin_nontemporal_store(w, (T*)p);
    else if constexpr (M == 2) STG_ASM("4", "sc1"); else if constexpr (M == 3) STG_ASM("4", "sc0 sc1"); else if constexpr (M == 4) STG_ASM("4", "sc1 nt"); else STG_ASM("4", "sc0 sc1 nt"); }
template <int M> __device__ __forceinline__ void stgf4(void* p, f32x4 w) { stg_any16<M>(p, w); }
template <int M> __device__ __forceinline__ void stg16(void* p, u32x4 w) { stg_any16<M>(p, w); }
template <int M> __device__ __forceinline__ void stg8(void* p, u32x2 w) {
    if constexpr (M == 0) *(u32x2*)p = w; else if constexpr (M == 1) __builtin_nontemporal_store(w, (u32x2*)p);
    else if constexpr (M == 2) STG_ASM("2", "sc1"); else if constexpr (M == 3) STG_ASM("2", "sc0 sc1"); else if constexpr (M == 4) STG_ASM("2", "sc1 nt"); else STG_ASM("2", "sc0 sc1 nt"); }
#ifndef NT_LD
#define NT_LD 1
#endif
template <class T> __device__ __forceinline__ T ldg_s(const void* p) { if constexpr (NT_LD) return __builtin_nontemporal_load((const T*)p); else return *(const T*)p; }
__device__ __forceinline__ unsigned pk2(float lo, float hi) { f32x2 v = {lo, hi}; bf16x2_t b = __builtin_convertvector(v, bf16x2_t); return __builtin_bit_cast(unsigned, b); }
__device__ __forceinline__ float bf2f(unsigned short b) { return __builtin_bit_cast(float, ((unsigned)b) << 16); }
__device__ __forceinline__ float bflo(unsigned w) { return __builtin_bit_cast(float, w << 16); }
__device__ __forceinline__ float bfhi(unsigned w) { return __builtin_bit_cast(float, w & 0xffff0000u); }
template <int CTRL> __device__ __forceinline__ float dppf(float x) { return __builtin_bit_cast(float, __builtin_amdgcn_mov_dpp(__builtin_bit_cast(int, x), CTRL, 0xf, 0xf, true)); }
__device__ __forceinline__ float xhalf_sum(float v) { const auto t = __builtin_amdgcn_permlane32_swap(__float_as_uint(v), __float_as_uint(v), false, false); return __uint_as_float(t[0]) + __uint_as_float(t[1]); }
__device__ __forceinline__ float xhalf_max(float v) { const auto t = __builtin_amdgcn_permlane32_swap(__float_as_uint(v), __float_as_uint(v), false, false); return fmaxf(__uint_as_float(t[0]), __uint_as_float(t[1])); }
__device__ __forceinline__ float wave_sum(float v) {
    v += dppf<0xB1>(v); v += dppf<0x4E>(v); v += dppf<0x141>(v); v += dppf<0x140>(v);
    const auto s = __builtin_amdgcn_permlane16_swap(__float_as_uint(v), __float_as_uint(v), false, false);
    v = __uint_as_float(s[0]) + __uint_as_float(s[1]);
    return xhalf_sum(v);
}
template <int N> __device__ __forceinline__ void wave_sum_n(float (&v)[N]) {
#pragma unroll
    for (int i = 0; i < N; ++i) v[i] += dppf<0xB1>(v[i]);
#pragma unroll
    for (int i = 0; i < N; ++i) v[i] += dppf<0x4E>(v[i]);
#pragma unroll
    for (int i = 0; i < N; ++i) v[i] += dppf<0x141>(v[i]);
#pragma unroll
    for (int i = 0; i < N; ++i) v[i] += dppf<0x140>(v[i]);
#pragma unroll
    for (int i = 0; i < N; ++i) { const auto s = __builtin_amdgcn_permlane16_swap(__float_as_uint(v[i]), __float_as_uint(v[i]), false, false); v[i] = __uint_as_float(s[0]) + __uint_as_float(s[1]); }
#pragma unroll
    for (int i = 0; i < N; ++i) v[i] = xhalf_sum(v[i]);
}
__device__ __forceinline__ int crow(int r, int hi) { return (r & 3) + 8 * (r >> 2) + 4 * hi; }

#define XB_TMO      128
#define XB_XCNT(j)  (256  + 64 * (j))
#define XB_XSUB(j)  (1280 + 64 * (j))
#define XB_XGEN(j)  (2304 + 64 * (j))
#define XB_TOP      3328
#define XB_TOPGEN   3392
#define XCD_BAR_WORDS 3456
#define XB_SPIN_CAP (1u << 18)
__device__ __forceinline__ unsigned xb_ld(unsigned* p)              { return __hip_atomic_load(p, __ATOMIC_RELAXED, __HIP_MEMORY_SCOPE_AGENT); }
__device__ __forceinline__ unsigned xb_add(unsigned* p, unsigned v) { return __hip_atomic_fetch_add(p, v, __ATOMIC_RELAXED, __HIP_MEMORY_SCOPE_AGENT); }
__device__ __forceinline__ unsigned xb_xcc_id() { return (unsigned)__builtin_amdgcn_s_getreg((3 << 11) | 20) & 0xFu; }
#define XB_SPIN(cond, bar) do { unsigned _sp = 0; while (cond) { __builtin_amdgcn_s_sleep(1); \
    if ((++_sp & 255u) == 0u) { if (xb_ld(&(bar)[XB_TMO])) break; if (_sp > XB_SPIN_CAP) { atomicAdd(&(bar)[XB_TMO], 1u); break; } } } } while (0)
struct XcdBarrier { unsigned* bar; unsigned x; volatile LAS unsigned* st; };
__device__ __forceinline__ XcdBarrier xcd_barrier_post(unsigned* bar, volatile LAS unsigned* st) {
    XcdBarrier b; b.bar = bar; b.x = xb_xcc_id(); b.st = st;
    if (threadIdx.x == 0) (void)xb_add(&bar[XB_XCNT(b.x)], 1u);
    return b;
}
__device__ __forceinline__ void xcd_barrier_complete(unsigned* bar, unsigned x, unsigned& nloc, unsigned& nx) {
    const unsigned G = gridDim.x * gridDim.y * gridDim.z;
    unsigned sum, cnt, mine, sp = 0u;
    for (;;) {
        sum = 0u; cnt = 0u; mine = 0u;
#pragma unroll
        for (unsigned j = 0; j < 16; ++j) { const unsigned c = xb_ld(&bar[XB_XCNT(j)]); sum += c; cnt += (c > 0u) ? 1u : 0u; mine = (j == x) ? c : mine; }
        if (sum == G) break;
        __builtin_amdgcn_s_sleep(1);
        if ((++sp & 255u) == 0u) { if (xb_ld(&bar[XB_TMO])) break; if (sp > XB_SPIN_CAP) { atomicAdd(&bar[XB_TMO], 1u); break; } }
    }
    nloc = mine > 0u ? mine : 1u; nx = cnt > 0u ? cnt : 1u;
}
__device__ __forceinline__ void xcd_barrier(const XcdBarrier& b) {
    asm volatile("s_waitcnt vmcnt(0)" ::: "memory");
    __syncthreads();
    if (threadIdx.x == 0) {
        unsigned* bar = b.bar;
        __builtin_amdgcn_s_waitcnt(0);
        unsigned nloc = b.st[0], nx = b.st[1];
        if (nloc == 0u) { xcd_barrier_complete(bar, b.x, nloc, nx); b.st[0] = nloc; b.st[1] = nx; }
        const unsigned old = xb_add(&bar[XB_XSUB(b.x)], 1u);
        const unsigned gen = old / nloc;
        if (old + 1u == (gen + 1u) * nloc) {
            __builtin_amdgcn_fence(__ATOMIC_RELEASE, "agent");
            asm volatile("s_waitcnt vmcnt(0)" ::: "memory");
            const unsigned og = xb_add(&bar[XB_TOP], 1u);
            const unsigned tg = og / nx;
            if (og + 1u == (tg + 1u) * nx) xb_add(&bar[XB_TOPGEN], 1u);
            else XB_SPIN(xb_ld(&bar[XB_TOPGEN]) == tg, bar);
            __builtin_amdgcn_fence(__ATOMIC_ACQUIRE, "agent");
            xb_add(&bar[XB_XGEN(b.x)], 1u);
            asm volatile("s_waitcnt vmcnt(0)" ::: "memory");
        } else {
            XB_SPIN(xb_ld(&bar[XB_XGEN(b.x)]) == gen, bar);
            __builtin_amdgcn_fence(__ATOMIC_ACQUIRE, "agent");
            asm volatile("s_waitcnt vmcnt(0)" ::: "memory");
        }
    }
    __syncthreads();
}

namespace pg8 {
constexpr int BM = 256, BK = 64, HALF = 128, HTB = HALF * BK * 2, STAGE_BYTES = 8 * HTB, NXCD = 8, WGM = 8;
__host__ __device__ __forceinline__ int lds_byte(int r, int c) { const int st = (r >> 4) * 2 + (c >> 5), rr = r & 15, cc = c & 31, ob = rr * 64 + cc * 2; return st * 1024 + (ob ^ (((ob >> 9) & 1) << 5)); }
__host__ __device__ __forceinline__ void stage_rc(int b, int& R, int& C) { const int st = b / 1024, sb = b % 1024, swz = sb ^ (((sb >> 9) & 1) << 5); R = (st >> 1) * 16 + swz / 64; C = (st & 1) * 32 + (swz % 64) / 2; }
__host__ __device__ __forceinline__ int perm32(int rho) { const int n = rho >> 4, i = rho & 15; return 8 * (i >> 2) + 4 * n + (i & 3); }

#ifndef PROBE_P1
#define PROBE_P1 0
#endif
struct Unit { int pm, pn, pb;
#if PROBE_P1
    int fl;
#endif
};
struct Gemm { const bf16* A; const bf16* Bt; int K; const int* gidx; };

__device__ __forceinline__ int xcd_remap(int wgid, int nwg) { const int q = nwg / NXCD, r = nwg % NXCD, xcd = wgid % NXCD, off = wgid / NXCD; return (xcd < r ? xcd * (q + 1) : r * (q + 1) + (xcd - r) * q) + off; }
struct StaticOrder {
    int nM, nN, nwg, G, c, rep;
    __device__ void init(int M, int N, int G_, int c_, int rep_ = 1) { nM = M / BM; nN = N / BM; nwg = nM * nN; G = G_; c = c_; rep = rep_; }
    __device__ bool next(int i, Unit& u) const {
        long L = (long)i * G + c; if (L >= (long)nwg * rep) return false;
#if PROBE_P1
        u.fl = (rep > 1 && L < nwg) ? 1 : 0;
#endif
        L %= nwg;
        const int wgid = xcd_remap((int)L, nwg);
        const int nig = WGM * nN, gid = wgid / nig, fm = gid * WGM, gsz = (nM - fm) < WGM ? (nM - fm) : WGM;
        u.pm = fm + ((wgid % nig) % gsz); u.pn = (wgid % nig) / gsz; u.pb = u.pn; return true;
    }
};
struct GroupedOrder {
    const int* tile_e; int ntiles, npn, G, c;
    __device__ bool next(int i, Unit& u) const {
        const long L = (long)i * G + c; const int nwg = ntiles * npn; if (L >= nwg) return false;
        const int wgid = xcd_remap((int)L, nwg);
        u.pm = wgid / npn; u.pn = wgid % npn; u.pb = tile_e[u.pm] * npn + u.pn;
#if PROBE_P1
        u.fl = 0;
#endif
        return true;
    }
};

__device__ __forceinline__ unsigned cvt_pk_bf16(float lo, float hi) { unsigned r; asm volatile("v_cvt_pk_bf16_f32 %0, %1, %2" : "=v"(r) : "v"(lo), "v"(hi)); return r; }

template <int STM> struct EpiPlainT {
    static constexpr bool PERM = true;
    bf16* O; int ldc; const float* ssq; int ssq_n; float ssq_inv; float eps;
    LAS unsigned char* xl;
    __device__ __forceinline__ void operator()(const f32x4 (&acc)[2][2][4][2], const Unit& u, int wr, int wc, int fr, int fq) const {
        const int lane = fq * 16 + fr; LAS unsigned char* t = xl + (wr * 4 + wc) * 2048;
        const int wsw = fr & 7, rrow = lane >> 3, rch = lane & 7;
#pragma unroll
        for (int ai = 0; ai < 2; ++ai)
#pragma unroll
            for (int m = 0; m < 4; ++m) { const int rowb = u.pm * BM + ai * HALF + wr * 64 + m * 16;
                float sc = 1.f;
                if (ssq) { const f32x4 p = *(const f32x4*)(ssq + (size_t)(rowb + fr) * ssq_n); sc = __builtin_amdgcn_rsqf((p[0] + p[1] + p[2] + p[3]) * ssq_inv + eps); }
#pragma unroll
                for (int bj = 0; bj < 2; ++bj) { const f32x4 v0 = acc[ai][bj][m][0] * sc, v1 = acc[ai][bj][m][1] * sc;
                    u32x4 w; w.x = cvt_pk_bf16(v0[0], v0[1]); w.y = cvt_pk_bf16(v0[2], v0[3]); w.z = cvt_pk_bf16(v1[0], v1[1]); w.w = cvt_pk_bf16(v1[2], v1[3]);
                    *(LAS u32x4*)(t + fr * 128 + 16 * ((4 * bj + fq) ^ wsw)) = w; }
#pragma unroll
                for (int i = 0; i < 2; ++i) { const int rr = 8 * i + rrow;
                    const u32x4 w = *(const LAS u32x4*)(t + rr * 128 + 16 * (rch ^ (rr & 7)));
                    stg16<STM>(O + (size_t)(rowb + rr) * ldc + u.pn * BM + wc * 64 + 8 * rch, w); }
            }
    }
};
template <int STM> struct EpiFp8T {
    static constexpr bool PERM = true;
    unsigned char* O; int ldc; float scale; LAS unsigned char* xl;
    __device__ __forceinline__ void operator()(const f32x4 (&acc)[2][2][4][2], const Unit& u, int wr, int wc, int fr, int fq) const {
        const int lane = fq * 16 + fr; LAS unsigned char* t = xl + (wr * 4 + wc) * 2048;
        const int rrow = lane >> 2, rch = lane & 3;
#pragma unroll
        for (int ai = 0; ai < 2; ++ai)
#pragma unroll
            for (int m = 0; m < 4; ++m) { const int rowb = u.pm * BM + ai * HALF + wr * 64 + m * 16;
#pragma unroll
                for (int bj = 0; bj < 2; ++bj) { f32x4 v0 = acc[ai][bj][m][0] * scale, v1 = acc[ai][bj][m][1] * scale;
#pragma unroll
                    for (int e = 0; e < 4; ++e) { v0[e] = __builtin_amdgcn_fmed3f(v0[e], -448.f, 448.f); v1[e] = __builtin_amdgcn_fmed3f(v1[e], -448.f, 448.f); }
                    int lo = __builtin_amdgcn_cvt_pk_fp8_f32(v0[0], v0[1], 0, false); lo = __builtin_amdgcn_cvt_pk_fp8_f32(v0[2], v0[3], lo, true);
                    int hi = __builtin_amdgcn_cvt_pk_fp8_f32(v1[0], v1[1], 0, false); hi = __builtin_amdgcn_cvt_pk_fp8_f32(v1[2], v1[3], hi, true);
                    *(LAS u32x2*)(t + fr * 64 + 32 * bj + 8 * fq) = (u32x2){(unsigned)lo, (unsigned)hi}; }
                const u32x4 w = *(const LAS u32x4*)(t + lane * 16);
                stg16<STM>(O + (size_t)(rowb + rrow) * ldc + u.pn * BM + wc * 64 + 16 * rch, w); }
    }
};
__device__ __forceinline__ f32x4 fp8x4_to_f32(unsigned w) { const f32x2 a = __builtin_amdgcn_cvt_pk_f32_fp8((int)w, false), b = __builtin_amdgcn_cvt_pk_f32_fp8((int)w, true); return (f32x4){a.x, a.y, b.x, b.y}; }
template <int STM> struct EpiGateUpT {
    static constexpr bool PERM = true;
    bf16* H; const float* sw;
    __device__ __forceinline__ void operator()(const f32x4 (&acc)[2][2][4][2], const Unit& u, int wr, int wc, int fr, int fq) const {
        const int row0 = u.pm * BM + wr * 64 + fr; const int col0 = u.pn * HALF + wc * 32 + 8 * fq;
#pragma unroll
        for (int ai = 0; ai < 2; ++ai)
#pragma unroll
            for (int m = 0; m < 4; ++m) { const int row = row0 + ai * HALF + m * 16; const float w = sw[row]; f32x4 hv[2];
#pragma unroll
                for (int n = 0; n < 2; ++n) { const f32x4 g = acc[ai][0][m][n], up = acc[ai][1][m][n];
#pragma unroll
                    for (int e = 0; e < 4; ++e) { const float sg = g[e] * __builtin_amdgcn_rcpf(1.0f + __builtin_amdgcn_exp2f(-g[e] * LOG2E)); hv[n][e] = sg * up[e] * w; } }
                u32x4 o; o.x = cvt_pk_bf16(hv[0][0], hv[0][1]); o.y = cvt_pk_bf16(hv[0][2], hv[0][3]); o.z = cvt_pk_bf16(hv[1][0], hv[1][1]); o.w = cvt_pk_bf16(hv[1][2], hv[1][3]);
                stg16<STM>(H + (size_t)row * FH + col0, o); }
    }
};

enum { GK_SKIP = 0, GK_PLAIN = 1, GK_ROPE32 = 2, GK_HEAD16 = 3, GK_IDX8 = 4, GK_WI = 5 };
struct GroupDesc { int kind; bf16* dst; int pitch; int col; float scale; int perm; float* ssq; int ssq_n; int ssq_i; };
struct RopeTabs { const int* pos; };
__device__ __forceinline__ int perm_row(int row, int perm) {
    if (perm == 0) return row; const int b = row >> 11, s = row & 2047;
    return perm == 4 ? (b << 11) + ((s & 3) << 9) + (s >> 2) : (b << 11) + ((s & 15) << 7) + (s >> 4);
}
__device__ __forceinline__ void st16(bf16* p, u32x2 a, u32x2 b) { u32x4 w; w.x = a.x; w.y = a.y; w.z = b.x; w.w = b.y; stg16<NT_EPI>(p, w); }
__device__ __forceinline__ u32x2 pk4(f32x4 v) { u32x2 w; w.x = cvt_pk_bf16(v[0], v[1]); w.y = cvt_pk_bf16(v[2], v[3]); return w; }
__device__ __forceinline__ void swap16(u32x2& X, u32x2& Y) {
    const auto a = __builtin_amdgcn_permlane16_swap(X.x, Y.x, false, false); const auto b = __builtin_amdgcn_permlane16_swap(X.y, Y.y, false, false);
    X.x = a[0]; Y.x = a[1]; X.y = b[0]; Y.y = b[1];
}
__device__ __forceinline__ float rope_k(int i, int rd) { return __builtin_amdgcn_exp2f(-18.931568569324174f * (float)(2 * i) / (float)rd) * 0.15915494309189535f; }
__device__ __forceinline__ void rope_cs(float posf, int i0, int rd, f32x4& c, f32x4& s) {
#pragma unroll
    for (int e = 0; e < 4; ++e) { const float f = __builtin_amdgcn_fractf(posf * rope_k(i0 + e, rd)); s[e] = __builtin_amdgcn_sinf(f); c[e] = __builtin_amdgcn_cosf(f); }
}
template <class DescFn> struct EpiGroups {
    static constexpr bool PERM = true;
    DescFn F; RopeTabs R; const float* rs_ssq; int rs_n; float rs_inv, rs_eps;
    __device__ __forceinline__ void operator()(const f32x4 (&acc)[2][2][4][2], const Unit& u, int wr, int wc, int fr, int fq) const {
        const int row0 = u.pm * BM + wr * 64 + fr;
#pragma unroll
        for (int bj = 0; bj < 2; ++bj) {
            const GroupDesc d = F(u.pn, bj, wc);
            if (d.kind == GK_SKIP) continue;
#if PROBE_P1 == 1
            if (u.fl) continue;
#endif
            const int ki0 = d.kind == GK_ROPE32 ? 4 * fq : (d.kind == GK_HEAD16 ? 4 * (fq & 1) : 0), krd = d.kind == GK_ROPE32 ? 32 : (d.kind == GK_HEAD16 ? 16 : 8);
#pragma unroll
            for (int ai = 0; ai < 2; ++ai)
#pragma unroll
                for (int m = 0; m < 4; ++m) {
                    const int row = row0 + ai * HALF + m * 16;
                    float sc = d.scale;
                    if (rs_ssq) { float s = 0.f; for (int i = 0; i < rs_n; ++i) s += rs_ssq[(size_t)row * rs_n + i]; sc *= __builtin_amdgcn_rsqf(s * rs_inv + rs_eps); }
                    f32x4 v0 = acc[ai][bj][m][0], v1 = acc[ai][bj][m][1];
                    if (d.ssq) {
                        float q = (v0[0] * v0[0] + v0[1] * v0[1]) + (v0[2] * v0[2] + v0[3] * v0[3]) + (v1[0] * v1[0] + v1[1] * v1[1]) + (v1[2] * v1[2] + v1[3] * v1[3]);
                        q += __shfl_xor(q, 16); q += __shfl_xor(q, 32);
                        if (fq == 0) d.ssq[(size_t)row * d.ssq_n + d.ssq_i] = q;
                    }
                    v0 = v0 * sc; v1 = v1 * sc;
                    if (d.kind == GK_WI) { if (fq == 0) { float* wp = (float*)d.dst + (size_t)row * 8; *(f32x4*)wp = v0; *(f32x4*)(wp + 4) = v1; } continue; }
                    bf16* rp = d.dst + (size_t)perm_row(row, d.perm) * d.pitch + d.col;
                    if (d.kind == GK_PLAIN) { st16(rp + 8 * fq, pk4(v0), pk4(v1)); }
                    else if (d.kind == GK_IDX8) {
                        f32x4 c, s; rope_cs((float)R.pos[row], ki0, krd, c, s);
                        const f32x4 o1 = fq == 0 ? v0 * c - v1 * s : v0, o2 = fq == 0 ? v1 * c + v0 * s : v1;
                        st16(rp + 8 * fq, pk4(o1), pk4(o2));
                    } else if (d.kind == GK_ROPE32) {
                        f32x4 c, s; rope_cs((float)R.pos[row], ki0, krd, c, s);
                        u32x2 X = pk4(v0 * c - v1 * s), Y = pk4(v1 * c + v0 * s);
                        swap16(X, Y);
                        st16(rp + ((fq & 1) ? 16 + 4 * (fq - 1) : 4 * fq), X, Y);
                    } else {
                        f32x4 c, s; rope_cs((float)R.pos[row], ki0, krd, c, s);
                        u32x2 X = pk4(fq < 2 ? v0 * c - v1 * s : v0), Y = pk4(fq < 2 ? v1 * c + v0 * s : v1);
                        swap16(X, Y);
                        st16(rp + 16 * (fq >> 1) + 8 * (fq & 1), X, Y);
                    }
                }
        }
    }
};

template <class Epi, class Sched, bool GATHER, int LDA = 0>
__device__ __forceinline__ void gemm_phase(LAS unsigned char* lds, const Gemm g, const Sched& S, const Epi& E, const int tid) {
    const int wid = __builtin_amdgcn_readfirstlane(tid >> 6), lane = tid & 63, wr = wid >> 2, wc = wid & 3, fr = lane & 15, fq = lane >> 4;
    const int K = g.K, nt = K / BK, lda = LDA ? LDA : K;
    unsigned voA[2][2], voB[2]; int RA[2], CA[2];
#pragma unroll
    for (int i = 0; i < 2; ++i) { int R, C; stage_rc(tid * 16 + i * 8192, R, C); const int Rb = Epi::PERM ? ((R & ~31) + perm32(R & 31)) : R;
        RA[i] = R; CA[i] = C; voA[0][i] = (unsigned)(R * lda + C) * 2u; voA[1][i] = (unsigned)((R + HALF) * lda + C) * 2u; voB[i] = (unsigned)(Rb * K + C) * 2u; }
    const size_t kstep = (size_t)(BK * 2);
    const size_t hstep = (size_t)HALF * K * 2;
    const size_t tstep = 2 * hstep;
    const size_t tstepA = (size_t)BM * lda * 2;
    const unsigned ldsw = (unsigned)wid * 1024u;
    const int aoff = lds_byte(wr * 64 + fr, fq * 8), boff = lds_byte(wc * 32 + fr, fq * 8);
#define PG8_SA(b, h) (((b) * 2 + (h)) * HTB)
#define PG8_SB(b, h) ((4 + (b) * 2 + (h)) * HTB)
#define PG8_STAGE(bufoff, gbase, voff) do { _Pragma("unroll") for (int _i = 0; _i < 2; ++_i) \
        __builtin_amdgcn_global_load_lds((const unsigned*)((const char*)(gbase) + (voff)[_i]), (LAS unsigned*)(lds + (bufoff) + ldsw + _i * 8192), 16, 0, 0); } while (0)
#define PG8_LDA(dst, b, h) do { _Pragma("unroll") for (int m = 0; m < 4; ++m) _Pragma("unroll") for (int k = 0; k < 2; ++k) dst[m][k] = *(const LAS bf16x8*)(lds + PG8_SA(b, h) + aoff + m * 2048 + k * 1024); } while (0)
#define PG8_LDB(dst, b, h) do { _Pragma("unroll") for (int n = 0; n < 2; ++n) _Pragma("unroll") for (int k = 0; k < 2; ++k) dst[n][k] = *(const LAS bf16x8*)(lds + PG8_SB(b, h) + boff + n * 2048 + k * 1024); } while (0)
#define PG8_MMA(ai, bj, At, Bt) do { __builtin_amdgcn_s_setprio(1); _Pragma("unroll") for (int m = 0; m < 4; ++m) _Pragma("unroll") for (int n = 0; n < 2; ++n) _Pragma("unroll") for (int k = 0; k < 2; ++k) \
        acc[ai][bj][m][n] = __builtin_amdgcn_mfma_f32_16x16x32_bf16(Bt[n][k], At[m][k], acc[ai][bj][m][n], 0, 0, 0); __builtin_amdgcn_s_setprio(0); } while (0)
#define PG8_WAIT_V(n) asm volatile("s_waitcnt vmcnt(" #n ")" ::: "memory")
#define PG8_WAIT_L(n) asm volatile("s_waitcnt lgkmcnt(" #n ")" ::: "memory")
#define PG8_BAR __builtin_amdgcn_s_barrier()
#define PG8_SCHED __builtin_amdgcn_sched_barrier(0)
    Unit cur, nxt; int ui = 0;
    if (!S.next(0, cur)) return;
    f32x4 acc[2][2][4][2];
#pragma unroll
    for (int a = 0; a < 2; ++a)
#pragma unroll
        for (int b = 0; b < 2; ++b)
#pragma unroll
            for (int m = 0; m < 4; ++m)
#pragma unroll
                for (int n = 0; n < 2; ++n) acc[a][b][m][n] = (f32x4){0.f, 0.f, 0.f, 0.f};
    bf16x8 At[4][2], B0[2][2], B1[2][2];
    unsigned nvA[2][2];
    const char* cA; const char* cB = (const char*)g.Bt + (size_t)cur.pb * tstep;
    if constexpr (GATHER) { cA = (const char*)g.A;
#pragma unroll
        for (int h = 0; h < 2; ++h)
#pragma unroll
            for (int i = 0; i < 2; ++i) voA[h][i] = (unsigned)g.gidx[cur.pm * BM + h * HALF + RA[i]] * (unsigned)(lda * 2) + (unsigned)CA[i] * 2u;
    } else cA = (const char*)g.A + (size_t)cur.pm * tstepA;
    PG8_STAGE(PG8_SB(0, 0), cB, voB); PG8_STAGE(PG8_SB(0, 1), cB + hstep, voB); PG8_STAGE(PG8_SA(0, 0), cA, voA[0]); PG8_STAGE(PG8_SA(0, 1), cA, voA[1]);
    if (wr == 1) PG8_BAR;
    PG8_WAIT_V(2); PG8_BAR;
    PG8_STAGE(PG8_SB(1, 0), cB + kstep, voB); PG8_STAGE(PG8_SA(1, 0), cA + kstep, voA[0]); PG8_STAGE(PG8_SB(1, 1), cB + hstep + kstep, voB);
    PG8_WAIT_V(6); PG8_BAR;
    for (;;) {
        const bool has_next = S.next(ui + 1, nxt);
        const char* nA; const char* nB = has_next ? (const char*)g.Bt + (size_t)nxt.pb * tstep : cB;
        if constexpr (GATHER) { nA = cA;
#pragma unroll
            for (int h = 0; h < 2; ++h)
#pragma unroll
                for (int i = 0; i < 2; ++i) nvA[h][i] = has_next ? (unsigned)g.gidx[nxt.pm * BM + h * HALF + RA[i]] * (unsigned)(lda * 2) + (unsigned)CA[i] * 2u : voA[h][i];
        } else nA = has_next ? (const char*)g.A + (size_t)nxt.pm * tstepA : cA;
#if PROBE_P1 == 2
        const int ntu = cur.fl ? 2 : nt;
#else
        const int ntu = nt;
#endif
#pragma nounroll
        for (int t = 0; t < ntu; t += 2) {
            const bool last = (t == ntu - 2);
            const char* a1 = cA + (size_t)(t + 1) * kstep;
            const char* a2 = last ? nA : cA + (size_t)(t + 2) * kstep; const char* b2 = last ? nB : cB + (size_t)(t + 2) * kstep;
            const char* a3 = a2 + kstep; const char* b3 = b2 + kstep;
            unsigned xA[2][2];
#pragma unroll
            for (int h = 0; h < 2; ++h)
#pragma unroll
                for (int i = 0; i < 2; ++i) xA[h][i] = (GATHER && last) ? nvA[h][i] : voA[h][i];
            PG8_LDB(B0, 0, 0); PG8_LDB(B1, 0, 1); PG8_SCHED; PG8_LDA(At, 0, 0); PG8_STAGE(PG8_SA(1, 1), a1, voA[1]);
            PG8_WAIT_V(8); PG8_WAIT_L(0); PG8_BAR; PG8_MMA(0, 0, At, B0); PG8_MMA(0, 1, At, B1); PG8_BAR; PG8_SCHED;
            PG8_LDA(At, 0, 1); PG8_STAGE(PG8_SB(0, 0), b2, voB); PG8_STAGE(PG8_SB(0, 1), b2 + hstep, voB); PG8_STAGE(PG8_SA(0, 0), a2, xA[0]);
            PG8_WAIT_V(8); PG8_WAIT_L(0); PG8_BAR; PG8_MMA(1, 0, At, B0); PG8_MMA(1, 1, At, B1); PG8_BAR; PG8_SCHED;
            PG8_LDB(B0, 1, 0); PG8_LDB(B1, 1, 1); PG8_SCHED; PG8_LDA(At, 1, 0); PG8_STAGE(PG8_SA(0, 1), a2, xA[1]);
            PG8_WAIT_V(8); PG8_WAIT_L(0); PG8_BAR; PG8_MMA(0, 0, At, B0); PG8_MMA(0, 1, At, B1); PG8_BAR; PG8_SCHED;
            PG8_LDA(At, 1, 1); PG8_STAGE(PG8_SB(1, 0), b3, voB); PG8_STAGE(PG8_SB(1, 1), b3 + hstep, voB); PG8_STAGE(PG8_SA(1, 0), a3, xA[0]);
            PG8_WAIT_V(8); PG8_WAIT_L(0); PG8_BAR; PG8_MMA(1, 0, At, B0); PG8_MMA(1, 1, At, B1); PG8_BAR; PG8_SCHED;
        }
        if (wr == 0) PG8_BAR;
        E(acc, cur, wr, wc, fr, fq);
        if (!has_next) break;
#pragma unroll
        for (int a = 0; a < 2; ++a)
#pragma unroll
            for (int b = 0; b < 2; ++b)
#pragma unroll
                for (int m = 0; m < 4; ++m)
#pragma unroll
                    for (int n = 0; n < 2; ++n) acc[a][b][m][n] = (f32x4){0.f, 0.f, 0.f, 0.f};
        cur = nxt; cA = nA; cB = nB; ++ui;
        if constexpr (GATHER) {
#pragma unroll
            for (int h = 0; h < 2; ++h)
#pragma unroll
                for (int i = 0; i < 2; ++i) voA[h][i] = nvA[h][i];
        }
        if (wr == 1) PG8_BAR;
    }
    PG8_WAIT_V(0);
    PG8_BAR;
#undef PG8_SA
#undef PG8_SB
#undef PG8_STAGE
#undef PG8_LDA
#undef PG8_LDB
#undef PG8_MMA
#undef PG8_WAIT_V
#undef PG8_WAIT_L
#undef PG8_BAR
#undef PG8_SCHED
}
}

#ifndef PROBE_LDS2
#define PROBE_LDS2 0
#endif
#ifndef PROBE_EXP2
#define PROBE_EXP2 0
#endif
#ifndef SOFTMAX_PK
#define SOFTMAX_PK 0
#endif
#ifndef FA_FUSE
#define FA_FUSE 0
#endif
namespace fa {
constexpr int VBYTES_T = 64 * 128;
typedef short v4i16_t __attribute__((ext_vector_type(4)));
__device__ __forceinline__ u32x2 vtr(const LAS unsigned char* p) { return __builtin_bit_cast(u32x2, __builtin_amdgcn_ds_read_tr16_b64_v4i16((LAS v4i16_t*)p)); }
__device__ __forceinline__ float max16(const f32x16& c) { float r;
    asm("v_max3_f32 %0, %1, %2, %3\n\tv_max3_f32 %0, %0, %4, %5\n\tv_max3_f32 %0, %0, %6, %7\n\tv_max3_f32 %0, %0, %8, %9\n\tv_max3_f32 %0, %0, %10, %11\n\tv_max3_f32 %0, %0, %12, %13\n\tv_max3_f32 %0, %0, %14, %15\n\tv_max_f32 %0, %0, %16"
        : "=&v"(r) : "v"(c[0]), "v"(c[1]), "v"(c[2]), "v"(c[3]), "v"(c[4]), "v"(c[5]), "v"(c[6]), "v"(c[7]), "v"(c[8]), "v"(c[9]), "v"(c[10]), "v"(c[11]), "v"(c[12]), "v"(c[13]), "v"(c[14]), "v"(c[15]));
    return r; }
__device__ __forceinline__ void mask_init(f32x16& S, unsigned nw) { float t0, t1, t2, t3, t4, t5, t6, t7, t8, t9, t10, t11, t12, t13, t14, t15;
    asm("v_bfe_i32 %0, %16, 0, 1\n\tv_lshlrev_b32 %0, 23, %0\n\tv_bfe_i32 %1, %16, 1, 1\n\tv_lshlrev_b32 %1, 23, %1\n\tv_bfe_i32 %2, %16, 2, 1\n\tv_lshlrev_b32 %2, 23, %2\n\tv_bfe_i32 %3, %16, 3, 1\n\tv_lshlrev_b32 %3, 23, %3\n\tv_bfe_i32 %4, %16, 8, 1\n\tv_lshlrev_b32 %4, 23, %4\n\tv_bfe_i32 %5, %16, 9, 1\n\tv_lshlrev_b32 %5, 23, %5\n\tv_bfe_i32 %6, %16, 10, 1\n\tv_lshlrev_b32 %6, 23, %6\n\tv_bfe_i32 %7, %16, 11, 1\n\tv_lshlrev_b32 %7, 23, %7\n\tv_bfe_i32 %8, %16, 16, 1\n\tv_lshlrev_b32 %8, 23, %8\n\tv_bfe_i32 %9, %16, 17, 1\n\tv_lshlrev_b32 %9, 23, %9\n\tv_bfe_i32 %10, %16, 18, 1\n\tv_lshlrev_b32 %10, 23, %10\n\tv_bfe_i32 %11, %16, 19, 1\n\tv_lshlrev_b32 %11, 23, %11\n\tv_bfe_i32 %12, %16, 24, 1\n\tv_lshlrev_b32 %12, 23, %12\n\tv_bfe_i32 %13, %16, 25, 1\n\tv_lshlrev_b32 %13, 23, %13\n\tv_bfe_i32 %14, %16, 26, 1\n\tv_lshlrev_b32 %14, 23, %14\n\tv_bfe_i32 %15, %16, 27, 1\n\tv_lshlrev_b32 %15, 23, %15"
        : "=&v"(t0), "=&v"(t1), "=&v"(t2), "=&v"(t3), "=&v"(t4), "=&v"(t5), "=&v"(t6), "=&v"(t7), "=&v"(t8), "=&v"(t9), "=&v"(t10), "=&v"(t11), "=&v"(t12), "=&v"(t13), "=&v"(t14), "=&v"(t15) : "v"(nw));
    S[0] = t0; S[1] = t1; S[2] = t2; S[3] = t3; S[4] = t4; S[5] = t5; S[6] = t6; S[7] = t7; S[8] = t8; S[9] = t9; S[10] = t10; S[11] = t11; S[12] = t12; S[13] = t13; S[14] = t14; S[15] = t15; }
struct Params {
    const bf16* Q;  int q_pitch;
    const bf16* K1; int k1_pitch, k1_col;
    const bf16* K2; int k2_pitch, k2_col;
    const bf16* V;  int v_pitch, v_col;
    bf16* O; int o_pitch;
    float* LSE; int lse_pitch;
    const unsigned* BM;
    int CL, W;
};
struct UnitDesc { int seq0, qw, q_col, o_col, lse_col, k1_col, v_col, kt_lo, kt_hi; };
template <int DQK, int MODE, int NH, class DescFn>
__device__ __forceinline__ void attn_stream(const Params& P, LAS unsigned char* lds, const int tid, const int n_units, DescFn desc) {
    constexpr int NKS = DQK / 16, AHEAD = (NH == 2 ? 3 : 4), NST = AHEAD + 1, K1B = 8192 * NH, K2B = (DQK == 96 ? 4096 : 0), BMOFF = K1B + K2B + 8192 * NH, STB = BMOFF + (MODE == 1 ? 8192 : 0);
    constexpr int NDMA = 2 * NH + (DQK == 96 ? 1 : 0) + (MODE == 1 ? 1 : 0);
    static_assert(NH == 1 || (DQK == 64 && MODE != 1), "two-head stages: head dim 64 only");
    constexpr bool active = true;
    if (n_units <= 0) return;
    const int lane = tid & 63, r = lane & 31, h = lane >> 5, wave = __builtin_amdgcn_readfirstlane(tid >> 6);
    const int tq_ = (lane & 15) >> 2, tp_ = lane & 3, tg_ = lane >> 4;
    const int hsel = NH == 2 ? (wave >> 2) * 8192 : 0;
    const int vtoff = K1B + K2B + hsel + (4 * h + tq_) * 128, vxb = 2 * (16 * (tg_ & 1) + 4 * tp_), vsw = (tq_ >> 1) & 1;
    const int vx0 = vxb + ((0 ^ vsw) << 6), vx1 = vxb + ((1 ^ vsw) << 6);
    const int s1_ = (r >> 1) & 7, s2_ = (r >> 2) & 3;
    const int k1row = hsel + r * 128, k2row = K1B + r * 64;
    const int row1 = 8 * wave + (lane >> 3), row2 = 16 * (wave & 3) + (lane >> 2);
    const size_t tk1 = (size_t)64 * P.k1_pitch, tk2 = (size_t)64 * P.k2_pitch, tv = (size_t)64 * P.v_pitch;
    const int d_k1 = wave * 1024, d_k2 = K1B + (wave & 3) * 1024, d_v = K1B + K2B + wave * 1024;
    const bf16* src_k1; const bf16* src_v; const bf16* src_k2 = nullptr; const unsigned* bmp = nullptr;
    int ji = -1, kti = 1, kti_hi = 0;
    auto fa_issue = [&](const int st) __attribute__((always_inline)) {
        if (kti > kti_hi) {
            if (ji + 1 < n_units) { ++ji; const UnitDesc t = desc(ji); kti = t.kt_lo; kti_hi = t.kt_hi;
                src_k1 = P.K1 + (size_t)(t.seq0 + row1) * P.k1_pitch + t.k1_col + 8 * ((lane & 7) ^ ((row1 >> 1) & 7));
                src_v = P.V + (size_t)(t.seq0 + row1) * P.v_pitch + t.v_col + 8 * ((lane & 7) ^ (((row1 >> 1) & 1) << 2));
                if constexpr (DQK == 96) src_k2 = P.K2 + (size_t)(t.seq0 + row2) * P.k2_pitch + P.k2_col + 8 * ((lane & 3) ^ ((row2 >> 2) & 3));
                if constexpr (MODE == 1) bmp = P.BM + (size_t)(t.seq0 + t.qw + r) * 64;
            } else kti = kti_hi; }
        LAS unsigned char* sb_ = lds + st * STB;
        __builtin_amdgcn_global_load_lds((const unsigned*)(src_k1 + kti * tk1), (LAS unsigned*)(sb_ + d_k1), 16, 0, 0);
        __builtin_amdgcn_global_load_lds((const unsigned*)(src_v + kti * tv), (LAS unsigned*)(sb_ + d_v), 16, 0, 0);
        if constexpr (NH == 2) {
            __builtin_amdgcn_global_load_lds((const unsigned*)(src_k1 + 64 + kti * tk1), (LAS unsigned*)(sb_ + d_k1 + 8192), 16, 0, 0);
            __builtin_amdgcn_global_load_lds((const unsigned*)(src_v + 64 + kti * tv), (LAS unsigned*)(sb_ + d_v + 8192), 16, 0, 0); }
        if constexpr (DQK == 96) __builtin_amdgcn_global_load_lds((const unsigned*)(src_k2 + kti * tk2), (LAS unsigned*)(sb_ + d_k2), 16, 0, 0);
        if constexpr (MODE == 1) __builtin_amdgcn_global_load_lds(bmp + (kti & ~1) * 2, (LAS unsigned*)(sb_ + BMOFF + wave * 1024), 16, 0, 0);
        ++kti; };
#define FA_ISSUE(TILE, ST) fa_issue(ST)
    int st_is = 0, st_c = 0, st_n = 1;
    bf16x8 qf[NKS];
#define FA_LOADQ(D) do { const bf16* qp_ = P.Q + (size_t)((D).seq0 + (D).qw + r) * P.q_pitch + (D).q_col + 8 * h; \
        _Pragma("unroll") for (int ks = 0; ks < NKS; ++ks) asm volatile("global_load_dwordx4 %0, %1, off offset:%2" : "=&v"(qf[ks]) : "v"(qp_), "n"(32 * ks) : "memory"); } while (0)
#define FA_WAITQ(N) do { if constexpr (NKS == 6) asm volatile("s_waitcnt vmcnt(%6)" : "+v"(qf[0]), "+v"(qf[1]), "+v"(qf[2]), "+v"(qf[3]), "+v"(qf[4]), "+v"(qf[5]) : "n"(N) : "memory"); \
        else asm volatile("s_waitcnt vmcnt(%4)" : "+v"(qf[0]), "+v"(qf[1]), "+v"(qf[2]), "+v"(qf[3]) : "n"(N) : "memory"); } while (0)
    { const UnitDesc d0 = desc(0); FA_LOADQ(d0); FA_WAITQ(0); }
#pragma unroll 1
    for (int ju = 0; ju < n_units; ++ju) {
    const UnitDesc du = desc(ju);
    const int seq0 = du.seq0, qw = du.qw, q_col = du.q_col, o_col = du.o_col, lse_col = du.lse_col, kt_lo = du.kt_lo, kt_hi = du.kt_hi;
    const int q = qw + r;
    const int lo_q = MODE == 0 ? max(q & ~(P.CL - 1), q - P.W) : 0;
    const int qh = q - 4 * h, lqh = lo_q - 4 * h;
    const int lo_w0 = MODE == 0 ? max(qw & ~(P.CL - 1), qw - P.W) : 0;
    const int lo_w1 = MODE == 0 ? max((qw + 31) & ~(P.CL - 1), qw + 31 - P.W) : 0;
#define FA_WAITBAR(N) do { asm volatile("s_waitcnt vmcnt(%0)" :: "n"(N) : "memory"); __builtin_amdgcn_s_barrier(); asm volatile("" ::: "memory"); } while (0)
    f32x16 o0, o1, c0, c1, n0, n1;
#pragma unroll
    for (int i = 0; i < 16; ++i) { o0[i] = 0.f; o1[i] = 0.f; c0[i] = 0.f; c1[i] = 0.f; n0[i] = 0.f; n1[i] = 0.f; }
    float m = -INFINITY, l = 0.f;
#define FA_PART(kt_) (active && (MODE == 0 ? ((kt_) * 64 <= qw + 31 && (kt_) * 64 + 63 >= lo_w0) : ((kt_) * 64 <= qw + 31)))
#define FA_KADDR(SB_, ROFF, ks) ((ks) < 4 ? (SB_) + (ROFF) * 128 + k1row + 16 * ((2 * (ks) + h) ^ s1_) : (SB_) + (ROFF) * 64 + k2row + 16 * ((2 * ((ks) - 4) + h) ^ s2_))
#define FA_QKH(S, SB_, ROFF, NW) do { bf16x8 fa_[NKS]; \
        _Pragma("unroll") for (int ks = 0; ks < NKS; ++ks) fa_[ks] = *(const LAS bf16x8*)FA_KADDR(SB_, ROFF, ks); \
        if (PROBE_LDS2) { _Pragma("unroll") for (int ks = 0; ks < NKS; ++ks) { const bf16x8 fb_ = *(const volatile LAS bf16x8*)FA_KADDR(SB_, (ROFF) ^ 32, ks); asm volatile("" :: "v"(fb_)); } } \
        if constexpr (MODE == 1) {        \
            mask_init(S, NW); \
        } else { _Pragma("unroll") for (int i = 0; i < 16; ++i) S[i] = 0.f; } \
        _Pragma("unroll") for (int ks = 0; ks < NKS; ++ks) S = __builtin_amdgcn_mfma_f32_32x32x16_bf16(fa_[ks], qf[ks], S, 0, 0, 0); \
        __builtin_amdgcn_sched_group_barrier(0x100, NKS, 0); __builtin_amdgcn_sched_group_barrier(0x008, NKS, 0); } while (0)
#define FA_QK(S0, S1, SB_, KT) do { unsigned nwa_ = 0u, nwb_ = 0u; \
        if constexpr (MODE == 1) { const u32x4 bw_ = *(const LAS u32x4*)((SB_) + BMOFF + wave * 1024 + lane * 16);        \
            nwa_ = ~((((KT) & 1) ? bw_.z : bw_.x) >> (4 * h)); nwb_ = ~((((KT) & 1) ? bw_.w : bw_.y) >> (4 * h)); } \
        FA_QKH(S0, SB_, 0, nwa_); FA_QKH(S1, SB_, 32, nwb_); } while (0)
#define FA_QKX(S, SB_, ROFF) do { bf16x8 fa_[NKS]; \
        _Pragma("unroll") for (int ks = 0; ks < NKS; ++ks) fa_[ks] = *(const LAS bf16x8*)FA_KADDR(SB_, ROFF, ks); \
        _Pragma("unroll") for (int i = 0; i < 16; ++i) S[i] = 0.f; \
        _Pragma("unroll") for (int ks = 0; ks < NKS; ++ks) S = __builtin_amdgcn_mfma_f32_32x32x16_bf16(fa_[ks], qf[ks], S, 0, 0, 0); } while (0)
    if (ju == 0) {
#pragma unroll 1
        for (int a = 0; a < AHEAD; ++a) { FA_ISSUE(kt_lo + a, st_is); st_is = st_is + 1; }
        FA_WAITBAR((AHEAD - 2) * NDMA);
    }
    if (FA_PART(kt_lo)) FA_QK(c0, c1, lds + st_c * STB, kt_lo);
    auto fa_step = [&](f32x16& c0, f32x16& c1, f32x16& n0, f32x16& n1, const int kt) __attribute__((always_inline)) {
        FA_ISSUE(kt + AHEAD, st_is); st_is = (st_is + 1 == NST) ? 0 : st_is + 1;
        const bool more1 = kt < kt_hi;
        const bool qnext = !more1 && (ju + 1 < n_units);
        if (qnext) { const UnitDesc dq = desc(ju + 1); FA_LOADQ(dq); }
        const int k0 = kt * 64;
        const bool part_c = FA_PART(kt), part_n = more1 && FA_PART(kt + 1);
        const LAS unsigned char* Sn = lds + st_n * STB; const LAS unsigned char* Vb = lds + st_c * STB;
        const bool fused = FA_FUSE && (DQK == 64) && part_c && part_n;
        if (part_n && !fused) FA_QK(n0, n1, Sn, kt + 1);
        if (part_c) {
            float alpha;
#define FA_SOFTMAX(MASKED) do { \
            if (MASKED) { if constexpr (MODE == 2) { const int qa = qh - k0, qa1 = qa - 32; \
                    _Pragma("unroll") for (int i = 0; i < 16; ++i) { const int ci = (i & 3) + 8 * (i >> 2); \
                        c0[i] = (ci > qa) ? -INFINITY : c0[i]; c1[i] = (ci > qa1) ? -INFINITY : c1[i]; } \
                } else if constexpr (MODE == 0) { const int lb = lqh - k0; const unsigned span = (unsigned)(q - lo_q), lb1 = (unsigned)(lb - 32);     \
                    _Pragma("unroll") for (int i = 0; i < 16; ++i) { const int ci = (i & 3) + 8 * (i >> 2); \
                        c0[i] = ((unsigned)(ci - lb) > span) ? -INFINITY : c0[i]; c1[i] = ((unsigned)ci - lb1 > span) ? -INFINITY : c1[i]; } \
                } } \
            float mx = xhalf_max(fmaxf(max16(c0), max16(c1))); \
            const float mn = fmaxf(m, mx); \
            const float ms = (mn == -INFINITY) ? 0.f : mn; \
            alpha = __builtin_amdgcn_exp2f(m - ms); \
            m = mn; \
            float ls = 0.f; \
            if (PROBE_EXP2) { float dm_ = 0.f; _Pragma("unroll") for (int i = 0; i < 16; ++i) { dm_ += __builtin_amdgcn_exp2f(c0[i] - mx) + __builtin_amdgcn_exp2f(c1[i] - mx); } asm volatile("" :: "v"(dm_)); } \
            if (SOFTMAX_PK) { const f32x2 ms2 = {ms, ms}; f32x2 lsa = {0.f, 0.f}, lsb = {0.f, 0.f};            \
              _Pragma("unroll") for (int i = 0; i < 16; i += 2) { \
                  f32x2 ta = {c0[i], c0[i + 1]}, tb = {c1[i], c1[i + 1]}; ta = ta - ms2; tb = tb - ms2; \
                  ta.x = __builtin_amdgcn_exp2f(ta.x); ta.y = __builtin_amdgcn_exp2f(ta.y); tb.x = __builtin_amdgcn_exp2f(tb.x); tb.y = __builtin_amdgcn_exp2f(tb.y); \
                  c0[i] = ta.x; c0[i + 1] = ta.y; c1[i] = tb.x; c1[i + 1] = tb.y; lsa = lsa + ta; lsb = lsb + tb; } \
              lsa = lsa + lsb; ls = lsa.x + lsa.y; \
            } else {        \
              _Pragma("unroll") for (int i = 0; i < 16; ++i) { c0[i] = __builtin_amdgcn_exp2f(c0[i] - ms); c1[i] = __builtin_amdgcn_exp2f(c1[i] - ms); ls += c0[i] + c1[i]; } } \
            l = l * alpha + ls; } while (0)
            const bool need_mask = MODE == 1 ? false : (MODE == 2 ? (k0 + 63 > qw) : ((k0 + 63 > qw) || (k0 < lo_w1)));
#define FA_FUSED(MASKED) do { FA_QKX(n0, Sn, 0); FA_QKX(n1, Sn, 32); FA_SOFTMAX(MASKED); \
            _Pragma("unroll") for (int hh_ = 0; hh_ < 2; ++hh_) { \
                __builtin_amdgcn_sched_group_barrier(0x100, NKS, 0); \
                _Pragma("unroll") for (int i = 0; i < NKS; ++i) { __builtin_amdgcn_sched_group_barrier(0x008, 1, 0); __builtin_amdgcn_sched_group_barrier(0x002, 120 / (2 * NKS), 0); } } } while (0)
            if (fused) { if (need_mask) FA_FUSED(true); else FA_FUSED(false); }
            else { if (need_mask) FA_SOFTMAX(true); else FA_SOFTMAX(false); }
#undef FA_FUSED
#undef FA_SOFTMAX
            if (!__all(alpha == 1.0f)) {
#pragma unroll
                for (int i = 0; i < 16; ++i) { o0[i] *= alpha; o1[i] *= alpha; } }
            const unsigned va0_ = (unsigned)(size_t)(Vb + vtoff + vx0), va1_ = (unsigned)(size_t)(Vb + vtoff + vx1);
#define FA_PV(S_, O0, O1, O2, O3) do { \
                u32x2 va00, vb00, va01, vb01, va10, vb10, va11, vb11;                           \
                asm volatile("ds_read_b64_tr_b16 %0, %8 offset:%10\n\tds_read_b64_tr_b16 %1, %8 offset:%11\n\tds_read_b64_tr_b16 %2, %9 offset:%10\n\tds_read_b64_tr_b16 %3, %9 offset:%11\n\t" \
                             "ds_read_b64_tr_b16 %4, %8 offset:%12\n\tds_read_b64_tr_b16 %5, %8 offset:%13\n\tds_read_b64_tr_b16 %6, %9 offset:%12\n\tds_read_b64_tr_b16 %7, %9 offset:%13" \
                             : "=&v"(va00), "=&v"(vb00), "=&v"(va01), "=&v"(vb01), "=&v"(va10), "=&v"(vb10), "=&v"(va11), "=&v"(vb11) \
                             : "v"(va0_), "v"(va1_), "n"(O0), "n"(O1), "n"(O2), "n"(O3) : "memory"); \
                bf16x8 pf[2]; \
                _Pragma("unroll") for (int sk = 0; sk < 2; ++sk) { u32x4 pw; pw.x = pk2(S_[8 * sk + 0], S_[8 * sk + 1]); pw.y = pk2(S_[8 * sk + 2], S_[8 * sk + 3]); pw.z = pk2(S_[8 * sk + 4], S_[8 * sk + 5]); pw.w = pk2(S_[8 * sk + 6], S_[8 * sk + 7]); pf[sk] = __builtin_bit_cast(bf16x8, pw); } \
                asm volatile("s_waitcnt lgkmcnt(0)" : "+v"(va00), "+v"(vb00), "+v"(va01), "+v"(vb01), "+v"(va10), "+v"(vb10), "+v"(va11), "+v"(vb11) :: "memory"); \
                __builtin_amdgcn_sched_barrier(0); \
                { const u32x4 v0w = {va00.x, va00.y, vb00.x, vb00.y}, v1w = {va01.x, va01.y, vb01.x, vb01.y}; \
                  o0 = __builtin_amdgcn_mfma_f32_32x32x16_bf16(__builtin_bit_cast(bf16x8, v0w), pf[0], o0, 0, 0, 0); \
                  o1 = __builtin_amdgcn_mfma_f32_32x32x16_bf16(__builtin_bit_cast(bf16x8, v1w), pf[0], o1, 0, 0, 0); } \
                { const u32x4 v0w = {va10.x, va10.y, vb10.x, vb10.y}, v1w = {va11.x, va11.y, vb11.x, vb11.y}; \
                  o0 = __builtin_amdgcn_mfma_f32_32x32x16_bf16(__builtin_bit_cast(bf16x8, v0w), pf[1], o0, 0, 0, 0); \
                  o1 = __builtin_amdgcn_mfma_f32_32x32x16_bf16(__builtin_bit_cast(bf16x8, v1w), pf[1], o1, 0, 0, 0); } } while (0)
            FA_PV(c0, 0, 1024, 2048, 3072);
            FA_PV(c1, 4096, 5120, 6144, 7168);
#undef FA_PV
        }
        if (qnext) FA_WAITBAR((AHEAD - 2) * NDMA + NKS); else FA_WAITBAR((AHEAD - 2) * NDMA);
        st_c = st_n; st_n = (st_n + 1 == NST) ? 0 : st_n + 1;
    };
    for (int kt = kt_lo;;) { fa_step(c0, c1, n0, n1, kt); if (++kt > kt_hi) break; fa_step(n0, n1, c0, c1, kt); if (++kt > kt_hi) break; }
#undef FA_PART
#undef FA_QK
#undef FA_QKH
#undef FA_QKX
#undef FA_KADDR
    const float lt = xhalf_sum(l);
    const float inv = 1.0f / lt;
    if (active) {
    bf16* op = P.O + (size_t)(seq0 + q) * P.o_pitch + o_col + 8 * h;
#pragma unroll
    for (int db = 0; db < 2; ++db) {
        const f32x16& o = db ? o1 : o0;
#pragma unroll
        for (int j = 0; j < 2; ++j) {
            u32x2 X, Y;
            X.x = pk2(o[8 * j] * inv, o[8 * j + 1] * inv); X.y = pk2(o[8 * j + 2] * inv, o[8 * j + 3] * inv);
            Y.x = pk2(o[8 * j + 4] * inv, o[8 * j + 5] * inv); Y.y = pk2(o[8 * j + 6] * inv, o[8 * j + 7] * inv);
            const auto a = __builtin_amdgcn_permlane32_swap(X.x, Y.x, false, false); const auto b = __builtin_amdgcn_permlane32_swap(X.y, Y.y, false, false);
            u32x4 w; w.x = a[0]; w.y = b[0]; w.z = a[1]; w.w = b[1];
            stg16<NT_ATT>(op + 32 * db + 16 * j, w);
        }
    }
    if (P.LSE && h == 0) P.LSE[(size_t)(seq0 + q) * P.lse_pitch + lse_col] = m + __builtin_amdgcn_logf(lt);
    }
    __builtin_amdgcn_sched_barrier(0);
    FA_WAITQ(4);
    }
    asm volatile("s_waitcnt vmcnt(0)" ::: "memory"); __builtin_amdgcn_s_barrier(); asm volatile("" ::: "memory");
#undef FA_ISSUE
#undef FA_LOADQ
#undef FA_WAITQ
#undef FA_WAITBAR
}
}

struct Args {
    const float* x; const int* pos; const float* w_in; const float* qn; const float* kvn; const float* w_uq; const float* w_ukv; const float* w_o;
    const float* ln1g; const float* ln1b; const float* rgw; const float* rgb; const float* rew; const float* reb;
    const float* wg; const float* wu; const float* wd; const float* ln2g; const float* ln2b;
    float* out; unsigned char* ws; int l_lo, l_hi, ph_lo, ph_hi, use_bar, pad;
};
typedef const __attribute__((address_space(4))) Args CArgs;
struct Ctx { LAS unsigned char* lds; int tid, lane, wave, G, c, vcu; unsigned char* ws; };

struct ColIdent { int off; __device__ __forceinline__ int operator()(int P) const { return off + P; } };
struct ColAdj { __device__ __forceinline__ int operator()(int P) const { const int p = P & 255; return (P & ~255) + 64 * ((p >> 5) & 3) + 32 * (p >> 7) + (p & 31); } };
__device__ __forceinline__ int map_rope32(int p) { return 16 * ((p >> 2) & 1) + 4 * (p >> 3) + (p & 3); }
__device__ __forceinline__ int map_head16(int p) { const int fq = p >> 3; return 16 * (fq >> 1) + 8 * ((p >> 2) & 1) + 4 * (fq & 1) + (p & 3); }
struct ColWin {
    __device__ __forceinline__ int operator()(int P) const {
        const int G = P >> 5, p = P & 31;
        if (G < 8) return 32 * G + p;
        if (G < 12) return 256 + 32 * (G - 8) + p;
        if (G == 12) return 384 + map_rope32(p);
        if (G == 13) return 1056 + p;
        if (G == 14) return 672 + map_head16(p);
        if (G == 15) return 704 + p;
        if (G < 24) { const int hh = (G - 16) >> 1; return 416 + 64 * hh + (((G - 16) & 1) ? 32 + p : map_head16(p)); }
        if (G < 26) return 736 + 32 * (G - 24) + p;
        if (G == 26) return p < 8 ? 1088 + p : -1;
        if (G < 32) return -1;
        if (G < 40) return 800 + 32 * (G - 32) + p;
        if (G < 64) { const int j = G - 40; return 1096 + 64 * (j >> 1) + ((j & 1) ? 32 + p : map_head16(p)); }
        if (G < 88) { const int j = G - 64; return 1096 + 768 + 64 * (j >> 1) + ((j & 1) ? 32 + p : map_head16(p)); }
        return 1096 + 1536 + 32 * (G - 88) + p;
    }
};
struct ColUq {
    __device__ __forceinline__ int operator()(int P) const { const int G = P >> 5, p = P & 31; return 32 * G + ((G % 3 == 2) ? map_rope32(p) : p); }
};
template <class ColFn>
__device__ __forceinline__ void transpose_item(const float* W, int ldw, int kvalid, bf16* WT, int ldt, int k0, int P0, const ColFn& cf, const float* rowscale, LAS float* scr, int lane) {
    const int c = lane & 31, col = cf(P0 + c);
#pragma unroll 8
    for (int i = 0; i < 32; ++i) { const int kk = 2 * i + (lane >> 5), k = k0 + kk; float v = 0.f;
        if (col >= 0 && k < kvalid) { v = W[(size_t)k * ldw + col]; if (rowscale) v *= rowscale[k]; }
        scr[kk * 33 + c] = v; }
    asm volatile("s_waitcnt lgkmcnt(0)" ::: "memory");
    const int cc = lane & 7;
#pragma unroll
    for (int j = 0; j < 4; ++j) { const int n = (lane >> 3) + 8 * j; const LAS float* s = scr + (8 * cc) * 33 + n;
        u32x4 o; o.x = pk2(s[0 * 33], s[1 * 33]); o.y = pk2(s[2 * 33], s[3 * 33]); o.z = pk2(s[4 * 33], s[5 * 33]); o.w = pk2(s[6 * 33], s[7 * 33]);
        *(u32x4*)(WT + (size_t)(P0 + n) * ldt + k0 + 8 * cc) = o; }
    asm volatile("s_waitcnt lgkmcnt(0)" ::: "memory");
}
__device__ __forceinline__ void prologue(const Ctx& X, const CArgs* ap) {
    struct { const float* x; const float *w_in, *qn, *kvn, *w_uq, *w_ukv, *w_o, *rgw, *rew; } a = {ap->x, ap->w_in, ap->qn, ap->kvn, ap->w_uq, ap->w_ukv, ap->w_o, ap->rgw, ap->rew};
    LAS float* scr = (LAS float*)(X.lds + X.wave * 16384);
    const int gw = X.vcu * 8 + X.wave, NGW = X.G * 8;
    constexpr int I_WIN = 16 * 112, I_UQ = 4 * 24, I_UKV = 4 * 32, I_WO = 16 * 32, I_L = I_WIN + I_UQ + I_UKV + I_WO;
    for (int it = gw; it < DEPTH * I_L; it += NGW) {
        const int l = it / I_L; int r = it % I_L;
        if (r < I_WIN) { transpose_item(a.w_in + (size_t)l * DM * IN_COLS, IN_COLS, DM, (bf16*)(X.ws + WS_WIN) + (size_t)l * NIN * DM, DM, 64 * (r / 112), 32 * (r % 112), ColWin{}, nullptr, scr, X.lane); continue; }
        r -= I_WIN;
        if (r < I_UQ) { transpose_item(a.w_uq + (size_t)l * 256 * 768, 768, 256, (bf16*)(X.ws + WS_WUQ) + (size_t)l * 768 * 256, 256, 64 * (r / 24), 32 * (r % 24), ColUq{}, a.qn + l * 256, scr, X.lane); continue; }
        r -= I_UQ;
        if (r < I_UKV) { transpose_item(a.w_ukv + (size_t)l * 128 * 1024, 1024, 128, (bf16*)(X.ws + WS_WUKV) + (size_t)l * 1024 * 256, 256, 64 * (r / 32), 32 * (r % 32), ColAdj{}, a.kvn + l * 128, scr, X.lane); continue; }
        r -= I_UKV;
        transpose_item(a.w_o + (size_t)l * DM * DM, DM, DM, (bf16*)(X.ws + WS_WO) + (size_t)l * DM * DM, DM, 64 * (r / 32), 32 * (r % 32), ColAdj{}, nullptr, scr, X.lane);
    }
    const size_t gt = (size_t)X.vcu * 512 + X.tid, NGT = (size_t)X.G * 512;
    { float* rgt = (float*)(X.ws + WS_RGT); float* ret = (float*)(X.ws + WS_RET);
      for (size_t i = gt; i < (size_t)DEPTH * 4 * DM; i += NGT) { const int l = (int)(i / (4 * DM)), g = (int)(i / DM) & 3, k = (int)(i % DM); rgt[i] = a.rgw[((size_t)l * DM + k) * 4 + g]; }
      for (size_t i = gt; i < (size_t)DEPTH * 32 * DM; i += NGT) { const int l = (int)(i / (32 * DM)), ge = (int)(i / DM) & 31, k = (int)(i % DM); ret[i] = a.rew[(((size_t)l * 4 + (ge >> 3)) * DM + k) * 8 + (ge & 7)]; } }
    { u32x4* z = (u32x4*)(X.ws + WS_T1); for (size_t i = gt; i < (size_t)NT * 256 * 2 / 16; i += NGT) z[i] = (u32x4){0u, 0u, 0u, 0u}; }
    { const f32x4* xs = (const f32x4*)a.x; u32x2* xb = (u32x2*)((unsigned char*)ap->out + XR_OFF);
      for (size_t i = gt; i < (size_t)NT * DM / 4; i += NGT) { const f32x4 v = xs[i]; u32x2 w; w.x = pk2(v[0], v[1]); w.y = pk2(v[2], v[3]); xb[i] = w; } }
}
__device__ __forceinline__ void convert_experts(const Ctx& X, const CArgs* ap, int l) {
    struct { const float *wg, *wu, *wd; } a = {ap->wg, ap->wu, ap->wd};
    LAS float* scr = (LAS float*)(X.lds + X.wave * 16384);
    const int gw = X.vcu * 8 + X.wave, NGW = X.G * 8;
    constexpr int I_GU = 32 * 16 * 16, I_D = 32 * 4 * 32;
    for (int it = gw; it < I_GU + I_D; it += NGW) {
        if (it < I_GU) { const int e = it >> 8, r = it & 255, G32 = r >> 4, kb = r & 15; const int pn = G32 >> 3, r0 = (G32 & 7) * 32; const bool up = r0 >= 128;
            const float* W = (up ? a.wu : a.wg) + ((size_t)l * NEXP + e) * DM * FH;
            transpose_item(W, FH, DM, (bf16*)(X.ws + WS_WGU) + (size_t)e * 512 * DM, DM, 64 * kb, 32 * G32, ColIdent{128 * pn + (r0 & 127) - 32 * G32}, nullptr, scr, X.lane);
        } else { const int r = it - I_GU, e = r >> 7, q = r & 127, kb = q >> 5, pg = q & 31;
            transpose_item(a.wd + ((size_t)l * NEXP + e) * FH * DM, DM, FH, (bf16*)(X.ws + WS_WD) + (size_t)e * DM * FH, FH, 64 * kb, 32 * pg, ColAdj{}, nullptr, scr, X.lane); }
    }
}

struct InProjDesc {
    unsigned char* ws;
    __device__ __forceinline__ pg8::GroupDesc operator()(int pn, int bj, int wc) const {
        using namespace pg8; const int G = 8 * pn + 4 * bj + wc; GroupDesc d; d.kind = GK_PLAIN; d.dst = nullptr; d.pitch = 256; d.col = 0; d.scale = 1.f; d.perm = 0; d.ssq = nullptr; d.ssq_n = 0; d.ssq_i = 0;
        if (G < 8) { d.dst = (bf16*)(ws + WS_CQ); d.col = 32 * G; d.ssq = (float*)(ws + WS_SSQ); d.ssq_n = 8; d.ssq_i = G; }
        else if (G < 12) { d.dst = (bf16*)(ws + WS_T1); d.col = 32 * (G - 8); d.ssq = (float*)(ws + WS_SSQ) + (size_t)NT * 8; d.ssq_n = 4; d.ssq_i = G - 8; }
        else if (G == 12) { d.kind = GK_ROPE32; d.dst = (bf16*)(ws + WS_KPE); d.pitch = 32; d.col = 0; }
        else if (G == 13) { d.kind = GK_IDX8; d.dst = (bf16*)(ws + WS_KI); d.pitch = 32; d.col = 0; }
        else if (G == 14) { d.kind = GK_HEAD16; d.dst = (bf16*)(ws + WS_T1); d.col = 192; }
        else if (G == 15) { d.dst = (bf16*)(ws + WS_T1); d.col = 224; }
        else if (G < 24) { d.kind = ((G - 16) & 1) ? GK_PLAIN : GK_HEAD16; d.dst = (bf16*)(ws + WS_BQ); d.col = 32 * (G - 16); d.scale = QSC64; }
        else if (G < 26) { d.dst = (bf16*)(ws + WS_BV); d.pitch = 64; d.col = 32 * (G - 24); }
        else if (G == 26) { d.kind = GK_WI; d.dst = (bf16*)(ws + WS_WI); }
        else if (G < 32) { d.kind = GK_SKIP; }
        else if (G < 40) { d.kind = GK_IDX8; d.dst = (bf16*)(ws + WS_BQI); d.col = 32 * (G - 32); }
        else if (G < 64) { const int j = G - 40, cfg = j >> 3; d.kind = (j & 1) ? GK_PLAIN : GK_HEAD16; d.dst = (bf16*)(ws + WS_DQ) + (size_t)cfg * NT * 256; d.col = 32 * (j & 7); d.scale = QSC64; d.perm = cfg == 0 ? 0 : (cfg == 1 ? 4 : 16); }
        else if (G < 88) { const int j = G - 64, cfg = j >> 3; d.kind = (j & 1) ? GK_PLAIN : GK_HEAD16; d.dst = (bf16*)(ws + WS_DK) + (size_t)cfg * NT * 256; d.col = 32 * (j & 7); d.perm = cfg == 0 ? 0 : (cfg == 1 ? 4 : 16); }
        else { const int j = G - 88, cfg = j >> 3; d.dst = (bf16*)(ws + WS_DV) + (size_t)cfg * NT * 256; d.col = 32 * (j & 7); d.perm = cfg == 0 ? 0 : (cfg == 1 ? 4 : 16); }
        return d;
    }
};
struct UqDesc {
    unsigned char* ws;
    __device__ __forceinline__ pg8::GroupDesc operator()(int pn, int bj, int wc) const {
        using namespace pg8; const int G = 8 * pn + 4 * bj + wc; GroupDesc d; d.kind = (G % 3 == 2) ? GK_ROPE32 : GK_PLAIN; d.dst = (bf16*)(ws + WS_QA); d.pitch = 768; d.col = 32 * G; d.scale = QSC96; d.perm = 0; d.ssq = nullptr; d.ssq_n = 0; d.ssq_i = 0;
        return d;
    }
};

__device__ __forceinline__ unsigned f16key(float v) { const _Float16 hf = (_Float16)v; const unsigned u = (unsigned)__builtin_bit_cast(unsigned short, hf); return (u ^ ((unsigned)__builtin_amdgcn_sbfe((int)u, 15, 1) | 0x8000u)) & 0xffffu; }
__device__ __forceinline__ unsigned pk_cnt(unsigned acc, unsigned kp2, unsigned mid2, unsigned one2) {
    unsigned t;
    asm("v_pk_sub_u16 %0, %2, %3 clamp\n\tv_pk_min_u16 %0, %0, %4\n\tv_pk_add_u16 %1, %1, %0" : "=&v"(t), "+v"(acc) : "v"(kp2), "s"(mid2), "s"(one2));
    return acc;
}
__device__ __forceinline__ int count_gt(const unsigned (&kp)[16], unsigned mid) {
    const unsigned m2 = __builtin_amdgcn_readfirstlane(mid | (mid << 16)), one2 = __builtin_amdgcn_readfirstlane(0x00010001u);
    unsigned a0 = 0u, a1 = 0u;
#pragma unroll
    for (int i = 0; i < 16; i += 2) { a0 = pk_cnt(a0, kp[i], m2, one2); a1 = pk_cnt(a1, kp[i + 1], m2, one2); }
    unsigned aw; asm("v_pk_add_u16 %0, %1, %2" : "=v"(aw) : "v"(a0), "v"(a1));
    const unsigned c = (aw & 0xffffu) + (aw >> 16);
    int tot = 0;
#pragma unroll
    for (int b = 0; b < 6; ++b) tot += __builtin_popcountll(__ballot((c >> b) & 1u)) << b;
    return tot;
}
__device__ __forceinline__ int wave_scan_incl(int v) {
    v += __builtin_amdgcn_update_dpp(0, v, 0x111, 0xf, 0xf, false); v += __builtin_amdgcn_update_dpp(0, v, 0x112, 0xf, 0xf, false);
    v += __builtin_amdgcn_update_dpp(0, v, 0x114, 0xf, 0xf, false); v += __builtin_amdgcn_update_dpp(0, v, 0x118, 0xf, 0xf, false);
    v += __builtin_amdgcn_update_dpp(0, v, 0x142, 0xa, 0xf, false); v += __builtin_amdgcn_update_dpp(0, v, 0x143, 0xc, 0xf, false);
    return v;
}
__device__ __forceinline__ void radix_pick(const LAS unsigned* hist, int lane, int target, int& B, int& above, int& inbin) {
    const u32x2 hw = *(const LAS u32x2*)(hist + 2 * lane);
    const int c0 = (int)(hw.x & 0xffffu), c1 = (int)(hw.x >> 16), c2 = (int)(hw.y & 0xffffu), c3 = (int)(hw.y >> 16);
    const int tl = (c0 + c1) + (c2 + c3);
    const int pre = wave_scan_incl(tl);
    const int suf = __builtin_amdgcn_readlane(pre, 63) - pre + tl;
    const unsigned long long reach = __ballot(suf >= target);
    const int ls = 63 - __builtin_clzll(reach | 1ull);
    int a = suf - tl, b = 4 * lane + 3, ib = c3;
    if (a + c3 < target) { a += c3; b = 4 * lane + 2; ib = c2; if (a + c2 < target) { a += c2; b = 4 * lane + 1; ib = c1; if (a + c1 < target) { a += c1; b = 4 * lane; ib = c0; } } }
    B = __builtin_amdgcn_readlane(b, ls); above = __builtin_amdgcn_readlane(a, ls); inbin = __builtin_amdgcn_readlane(ib, ls);
}
__device__ __forceinline__ float relu_i(float x) { const int i = __builtin_bit_cast(int, x); return __builtin_bit_cast(float, i > 0 ? i : 0); }
__device__ __forceinline__ void dsa_index_unit(const Ctx& X, int b, int q0) {
    const int lane = X.lane, r = lane & 31, h = lane >> 5; const size_t seq0 = (size_t)b * SEQ; const int t0 = q0 + 4 * X.wave;
    const bf16* BQI = (const bf16*)(X.ws + WS_BQI); const bf16* KI = (const bf16*)(X.ws + WS_KI); const float* WI = (const float*)(X.ws + WS_WI);
    LAS unsigned short* rows = (LAS unsigned short*)(X.lds + X.wave * 16384);
    LAS unsigned char* kbuf = X.lds + LDS_X_OFF;
    const bf16* ap = BQI + (seq0 + t0 + (r >> 3)) * 256 + 32 * (r & 7) + 16 * h;
    const bf16x8 a0 = *(const bf16x8*)ap, a1 = *(const bf16x8*)(ap + 8);
    f32x2 wq[4][2];
#pragma unroll
    for (int j = 0; j < 4; ++j) { const f32x4 w = *(const f32x4*)(WI + (seq0 + t0 + j) * 8 + 4 * h);
        wq[j][0] = (f32x2){w[0] * IDX_SCALE, w[1] * IDX_SCALE}; wq[j][1] = (f32x2){w[2] * IDX_SCALE, w[3] * IDX_SCALE}; }
    const int nch = ((q0 + 31) >> 7) + 1;
    const int skey = X.tid >> 2, spc = X.tid & 3;
    const bf16* sp = KI + (seq0 + skey) * 32 + 8 * spc;
    const int sdst = skey * 64 + ((spc ^ ((skey >> 2) & 3)) << 4);
    u32x4 stg0 = *(const u32x4*)sp, stg1 = stg0, stg2 = stg0, stg3 = stg0;
    if (1 < nch) stg1 = *(const u32x4*)(sp + (size_t)1 * 128 * 32);
    if (2 < nch) stg2 = *(const u32x4*)(sp + (size_t)2 * 128 * 32);
    if (3 < nch) stg3 = *(const u32x4*)(sp + (size_t)3 * 128 * 32);
    *(LAS u32x4*)(kbuf + sdst) = stg0;
    __syncthreads();
#define DSA_STEP(J, RCUR, RNEXT) { const int c = c0 + (J); \
        if (c + 4 < nch) RCUR = *(const u32x4*)(sp + (size_t)(c + 4) * 128 * 32); \
        const LAS unsigned char* kb = kbuf + (c & 1) * 8192; \
        f32x16 accq[4];        \
        _Pragma("unroll") for (int tq = 0; tq < 4; ++tq) { \
            const int key = 32 * tq + r, sw = (key >> 2) & 3; \
            const bf16x8 b0 = *(const LAS bf16x8*)(kb + key * 64 + (((2 * h) ^ sw) << 4)), b1 = *(const LAS bf16x8*)(kb + key * 64 + (((2 * h + 1) ^ sw) << 4)); \
            _Pragma("unroll") for (int i = 0; i < 16; ++i) accq[tq][i] = 0.f; \
            accq[tq] = __builtin_amdgcn_mfma_f32_32x32x16_bf16(a0, b0, accq[tq], 0, 0, 0); \
            accq[tq] = __builtin_amdgcn_mfma_f32_32x32x16_bf16(a1, b1, accq[tq], 0, 0, 0); } \
        __builtin_amdgcn_sched_barrier(0); \
        _Pragma("unroll") for (int tq = 0; tq < 4; ++tq) { const f32x16& acc = accq[tq]; \
            float p[4]; \
            _Pragma("unroll") for (int j = 0; j < 4; ++j) {            \
                const f32x2 ra = {relu_i(acc[4 * j]), relu_i(acc[4 * j + 1])}, rb = {relu_i(acc[4 * j + 2]), relu_i(acc[4 * j + 3])}; \
                const f32x2 pp = __builtin_elementwise_fma(rb, wq[j][1], ra * wq[j][0]); \
                p[j] = pp.x + pp.y; } \
            const auto s01 = __builtin_amdgcn_permlane32_swap(__float_as_uint(p[0]), __float_as_uint(p[1]), false, false); \
            const auto s23 = __builtin_amdgcn_permlane32_swap(__float_as_uint(p[2]), __float_as_uint(p[3]), false, false); \
            const float va = __uint_as_float(s01[0]) + __uint_as_float(s01[1]), vb = __uint_as_float(s23[0]) + __uint_as_float(s23[1]); \
            const int hw = 128 * c + 32 * tq + r;                                      \
            rows[h * 2048 + hw] = (unsigned short)f16key(va); \
            rows[(2 + h) * 2048 + hw] = (unsigned short)f16key(vb); \
        } \
        if (c + 1 < nch) *(LAS u32x4*)(kbuf + ((c + 1) & 1) * 8192 + sdst) = RNEXT; \
        __syncthreads(); }
#ifndef REP_SCORE
#define REP_SCORE 1
#endif
#ifndef REP_SEL
#define REP_SEL 1
#endif
    for (int rsc = 0; rsc < REP_SCORE; ++rsc) {
    if (rsc > 0) { stg0 = *(const u32x4*)sp; stg1 = stg0; stg2 = stg0; stg3 = stg0; if (1 < nch) stg1 = *(const u32x4*)(sp + (size_t)1 * 128 * 32); if (2 < nch) stg2 = *(const u32x4*)(sp + (size_t)2 * 128 * 32); if (3 < nch) stg3 = *(const u32x4*)(sp + (size_t)3 * 128 * 32); *(LAS u32x4*)(kbuf + sdst) = stg0; __syncthreads(); }
    for (int c0 = 0; c0 < nch; c0 += 4) {
        DSA_STEP(0, stg0, stg1)
        if (c0 + 1 >= nch) break;
        DSA_STEP(1, stg1, stg2)
        if (c0 + 2 >= nch) break;
        DSA_STEP(2, stg2, stg3)
        if (c0 + 3 >= nch) break;
        DSA_STEP(3, stg3, stg0)
    }
    }
#undef DSA_STEP
    unsigned* BMp = (unsigned*)(X.ws + WS_BM);
#ifndef REP_BIS
#define REP_BIS 1
#endif
#ifndef REP_EMIT
#define REP_EMIT 1
#endif
    for (int rsl = 0; rsl < REP_SEL; ++rsl)
    for (int j = 0; j < 4; ++j) {
        const int t = t0 + j;
        const LAS u32x4* rw = (const LAS u32x4*)(rows + j * 2048) + 4 * lane;
        unsigned kp[16];
#pragma unroll
        for (int v4 = 0; v4 < 4; ++v4) { const u32x4 d = rw[v4]; kp[4 * v4] = d.x; kp[4 * v4 + 1] = d.y; kp[4 * v4 + 2] = d.z; kp[4 * v4 + 3] = d.w; }
        const int nv = t + 1 - 32 * lane;
#pragma unroll
        for (int d = 0; d < 16; ++d) kp[d] &= ((2 * d < nv) ? 0xffffu : 0u) | ((2 * d + 1 < nv) ? 0xffff0000u : 0u);
        unsigned thr = 0u; int need = 0;
        for (int rb_ = 0; rb_ < REP_BIS; ++rb_)
        if (t + 1 > 256) {
            LAS unsigned* hist = (LAS unsigned*)(X.lds + LDS_HIST_OFF + X.wave * 512);
            *(LAS u32x2*)(hist + 2 * lane) = (u32x2){0u, 0u};
#pragma unroll
            for (int d = 0; d < 16; ++d) { const unsigned klo = kp[d] & 0xffffu, khi = kp[d] >> 16;
                if (klo) __hip_atomic_fetch_add(hist + (klo >> 9), (klo & 0x100u) ? 0x10000u : 1u, __ATOMIC_RELAXED, __HIP_MEMORY_SCOPE_WORKGROUP);
                if (khi) __hip_atomic_fetch_add(hist + (khi >> 9), (khi & 0x100u) ? 0x10000u : 1u, __ATOMIC_RELAXED, __HIP_MEMORY_SCOPE_WORKGROUP); }
            int B1, above1, in1; radix_pick(hist, lane, 256, B1, above1, in1);
            *(LAS u32x2*)(hist + 2 * lane) = (u32x2){0u, 0u};
#pragma unroll
            for (int d = 0; d < 16; ++d) { const unsigned klo = kp[d] & 0xffffu, khi = kp[d] >> 16;
                if ((int)(klo >> 8) == B1) __hip_atomic_fetch_add(hist + ((klo & 0xffu) >> 1), (klo & 1u) ? 0x10000u : 1u, __ATOMIC_RELAXED, __HIP_MEMORY_SCOPE_WORKGROUP);
                if ((int)(khi >> 8) == B1) __hip_atomic_fetch_add(hist + ((khi & 0xffu) >> 1), (khi & 1u) ? 0x10000u : 1u, __ATOMIC_RELAXED, __HIP_MEMORY_SCOPE_WORKGROUP); }
            int B2, above2, in2; radix_pick(hist, lane, 256 - above1, B2, above2, in2);
            const unsigned tk = ((unsigned)B1 << 8) | (unsigned)B2;
            const int rest = 256 - (above1 + above2);
            if (rest >= in2) { thr = tk - 1u; need = 0; } else { thr = tk; need = rest; }
        }
        unsigned word = 0u, eqw = 0u;
        const unsigned thr2 = __builtin_amdgcn_readfirstlane(thr | (thr << 16)), one2 = __builtin_amdgcn_readfirstlane(0x00010001u);
#pragma unroll
        for (int d = 0; d < 16; ++d) { unsigned g;
            asm("v_pk_sub_u16 %0, %1, %2 clamp\n\tv_pk_min_u16 %0, %0, %3" : "=&v"(g) : "v"(kp[d]), "s"(thr2), "s"(one2));
            word |= ((g | (g >> 15)) & 3u) << (2 * d); }
        if (need > 0) {
#pragma unroll
            for (int d = 0; d < 16; ++d) { unsigned g; const unsigned x = kp[d] ^ thr2;
                asm("v_pk_min_u16 %0, %1, %2" : "=v"(g) : "v"(x), "s"(one2));
                eqw |= ((~(g | (g >> 15))) & 3u) << (2 * d); }
            if (thr == 0u) eqw = 0u;
            const int ne = __builtin_popcount(eqw); const int inc = wave_scan_incl(ne);
            int take = need - (inc - ne); take = take < 0 ? 0 : (take > ne ? ne : take);
            while (__any(take > 0)) { if (take > 0) { const unsigned lowbit = eqw & (0u - eqw); word |= lowbit; eqw ^= lowbit; --take; } }
        }
        BMp[(seq0 + t) * 64 + lane] = word;
    }
}

__device__ __forceinline__ void dil_combine(const Ctx& X) {
    const bf16* OD = (const bf16*)(X.ws + WS_OD); const float* LS = (const float*)(X.ws + WS_LSE); bf16* O = (bf16*)(X.ws + WS_XB);
    const int gw = X.vcu * 8 + X.wave, NGW = X.G * 8, lane = X.lane, hh = lane >> 4;
    for (int t = gw; t < NT; t += NGW) {
        const int b = t >> 11, s = t & 2047;
        const int r0 = t, r1 = (b << 11) + ((s & 3) << 9) + (s >> 2), r2 = (b << 11) + ((s & 15) << 7) + (s >> 4);
        const float L0 = LS[(size_t)r0 * 4 + hh], L1 = LS[((size_t)NT + r1) * 4 + hh], L2 = LS[((size_t)2 * NT + r2) * 4 + hh];
        const float mx = fmaxf(L0, fmaxf(L1, L2));
        float w0 = __builtin_amdgcn_exp2f(L0 - mx), w1 = __builtin_amdgcn_exp2f(L1 - mx), w2 = __builtin_amdgcn_exp2f(L2 - mx);
        const float inv = 1.0f / (w0 + w1 + w2); w0 *= inv; w1 *= inv; w2 *= inv;
        const u32x2 a = *(const u32x2*)(OD + (size_t)r0 * 256 + 4 * lane), bq = *(const u32x2*)(OD + ((size_t)NT + r1) * 256 + 4 * lane), cq = *(const u32x2*)(OD + ((size_t)2 * NT + r2) * 256 + 4 * lane);
        u32x2 o;
        o.x = pk2(w0 * bflo(a.x) + w1 * bflo(bq.x) + w2 * bflo(cq.x), w0 * bfhi(a.x) + w1 * bfhi(bq.x) + w2 * bfhi(cq.x));
        o.y = pk2(w0 * bflo(a.y) + w1 * bflo(bq.y) + w2 * bflo(cq.y), w0 * bfhi(a.y) + w1 * bfhi(bq.y) + w2 * bfhi(cq.y));
        stg8<NT_ATT>(O + (size_t)t * DM + 768 + 4 * lane, o);
    }
}

__device__ __forceinline__ void ln1_router(const Ctx& X, const CArgs* ap, int l, bool first, bool dummy = false) {
    struct { const float *ln1g, *ln1b, *rgb, *reb; } a = {ap->ln1g, ap->ln1b, ap->rgb, ap->reb}; (void)first;
    const bf16* xin = (const bf16*)((const unsigned char*)ap->out + XR_OFF);
    const bool keep_copy = !LN2_X1B && (l == DEPTH - 1) && !dummy; bf16* XC = (bf16*)(X.ws + WS_KVA);
    const int lane = X.lane; const bf16* MIX = (const bf16*)(X.ws + WS_MIX); bf16* X1B = (bf16*)(X.ws + (dummy ? WS_Y : WS_XB));
    LAS float* reT = (LAS float*)X.lds;
    LAS float* rgT = (LAS float*)(X.lds + LDS_X_OFF);
    LAS int* hist = (LAS int*)(X.lds + LDSCTL_OFF + 256);
    { const u32x4* s1 = (const u32x4*)(X.ws + WS_RET + (size_t)l * 32 * DM * 4); for (int i = X.tid; i < 32 * DM / 4; i += 512) ((LAS u32x4*)reT)[i] = s1[i];
      const u32x4* s2 = (const u32x4*)(X.ws + WS_RGT + (size_t)l * 4 * DM * 4); for (int i = X.tid; i < 4 * DM / 4; i += 512) ((LAS u32x4*)rgT)[i] = s2[i]; }
    f32x4 g[4], bb[4];
#pragma unroll
    for (int j = 0; j < 4; ++j) { g[j] = *(const f32x4*)(a.ln1g + l * DM + 4 * lane + 256 * j); bb[j] = *(const f32x4*)(a.ln1b + l * DM + 4 * lane + 256 * j); }
    const float* rgb = a.rgb + l * 4; const float* reb = a.reb + l * 32;
    for (int rb = X.c; rb < NT / 256; rb += X.G) {
        if (X.tid < 32) hist[X.tid] = 0;
        __syncthreads();
        u32x2 xa[4], xb[4]; u32x2 ma[4], mb[4];
        { const int t = rb * 256 + X.wave * 32;
#pragma unroll
          for (int j = 0; j < 4; ++j) { xa[j] = *(const u32x2*)(xin + (size_t)t * DM + 4 * lane + 256 * j); ma[j] = *(const u32x2*)(MIX + (size_t)t * DM + 4 * lane + 256 * j); }
#pragma unroll
          for (int j = 0; j < 4; ++j) { xb[j] = *(const u32x2*)(xin + (size_t)(t + 1) * DM + 4 * lane + 256 * j); mb[j] = *(const u32x2*)(MIX + (size_t)(t + 1) * DM + 4 * lane + 256 * j); } }
        auto row = [&](u32x2 (&xn)[4], u32x2 (&mn)[4], const int i) __attribute__((always_inline)) {
            const int t = rb * 256 + X.wave * 32 + i;
            f32x4 v[4]; float s = 0.f;
#pragma unroll
            for (int j = 0; j < 4; ++j) { const u32x2 xw = xn[j]; const u32x2 mw = mn[j];
                if (keep_copy) *(u32x2*)(XC + (size_t)t * DM + 4 * lane + 256 * j) = xw;
                v[j][0] = ALPHA * bflo(xw.x) + bflo(mw.x); v[j][1] = ALPHA * bfhi(xw.x) + bfhi(mw.x); v[j][2] = ALPHA * bflo(xw.y) + bflo(mw.y); v[j][3] = ALPHA * bfhi(xw.y) + bfhi(mw.y);
                s += (v[j][0] + v[j][1]) + (v[j][2] + v[j][3]); }
            if (i + 2 < 32) {
#pragma unroll
                for (int j = 0; j < 4; ++j) { xn[j] = *(const u32x2*)(xin + (size_t)(t + 2) * DM + 4 * lane + 256 * j); mn[j] = *(const u32x2*)(MIX + (size_t)(t + 2) * DM + 4 * lane + 256 * j); } }
            const float mean = wave_sum(s) * (1.f / DM); float s2 = 0.f;
#pragma unroll
            for (int j = 0; j < 4; ++j) { v[j] = v[j] - mean; s2 += (v[j][0] * v[j][0] + v[j][1] * v[j][1]) + (v[j][2] * v[j][2] + v[j][3] * v[j][3]); }
            const float rstd = 1.0f / sqrtf(wave_sum(s2) * (1.f / DM) + 1e-5f);
#pragma unroll
            for (int j = 0; j < 4; ++j) { v[j] = v[j] * rstd * g[j] + bb[j];
                u32x2 w; w.x = pk2(v[j][0], v[j][1]); w.y = pk2(v[j][2], v[j][3]); stg8<NT_LN>(X1B + (size_t)t * DM + 4 * lane + 256 * j, w); }
            float lg[4];
            { f32x2 pa[4], pb[4];
#pragma unroll
              for (int gi = 0; gi < 4; ++gi) { pa[gi] = (f32x2){0.f, 0.f}; pb[gi] = (f32x2){0.f, 0.f}; }
#pragma unroll
              for (int j = 0; j < 4; ++j) { const f32x2 vxy = {v[j][0], v[j][1]}, vzw = {v[j][2], v[j][3]};
#pragma unroll
                  for (int gi = 0; gi < 4; ++gi) { const f32x4 w = *(const LAS f32x4*)(rgT + gi * DM + 4 * lane + 256 * j);
                      pa[gi] = __builtin_elementwise_fma(vxy, (f32x2){w[0], w[1]}, pa[gi]); pb[gi] = __builtin_elementwise_fma(vzw, (f32x2){w[2], w[3]}, pb[gi]); } }
#pragma unroll
              for (int gi = 0; gi < 4; ++gi) { const f32x2 q = pa[gi] + pb[gi]; lg[gi] = q.x + q.y; }
              wave_sum_n<4>(lg);
#pragma unroll
              for (int gi = 0; gi < 4; ++gi) lg[gi] += rgb[gi]; }
            int gs = 0; float gm = lg[0];
#pragma unroll
            for (int gi = 1; gi < 4; ++gi) if (lg[gi] > gm) { gm = lg[gi]; gs = gi; }
            float den = 0.f;
#pragma unroll
            for (int gi = 0; gi < 4; ++gi) den += __expf(lg[gi] - gm);
            const float ptop = __builtin_amdgcn_rcpf(den);
            gs = __builtin_amdgcn_readfirstlane(gs);
            float le[8];
            { f32x2 pa[8], pb[8]; const LAS float* reG = reT + gs * 8 * DM + 4 * lane;
#pragma unroll
              for (int e = 0; e < 8; ++e) { pa[e] = (f32x2){0.f, 0.f}; pb[e] = (f32x2){0.f, 0.f}; }
#pragma unroll
              for (int j = 0; j < 4; ++j) { const f32x2 vxy = {v[j][0], v[j][1]}, vzw = {v[j][2], v[j][3]};
#pragma unroll
                  for (int e = 0; e < 8; ++e) { const f32x4 w = *(const LAS f32x4*)(reG + e * DM + 256 * j);
                      pa[e] = __builtin_elementwise_fma(vxy, (f32x2){w[0], w[1]}, pa[e]); pb[e] = __builtin_elementwise_fma(vzw, (f32x2){w[2], w[3]}, pb[e]); } }
#pragma unroll
              for (int e = 0; e < 8; ++e) { const f32x2 q = pa[e] + pb[e]; le[e] = q.x + q.y; }
              wave_sum_n<8>(le);
#pragma unroll
              for (int e = 0; e < 8; ++e) le[e] += reb[gs * 8 + e]; }
            int e1 = 0; float v1 = le[0];
#pragma unroll
            for (int e = 1; e < 8; ++e) if (le[e] > v1) { v1 = le[e]; e1 = e; }
            int e2 = -1; float v2 = -INFINITY;
#pragma unroll
            for (int e = 0; e < 8; ++e) if (e != e1 && le[e] > v2) { v2 = le[e]; e2 = e; }
            const float wa = __builtin_amdgcn_rcpf(1.0f + __expf(v2 - v1)), wb = 1.0f - wa;
            if (lane == 0) { u32x4 ro; ro.x = (unsigned)(gs * 8 + e1); ro.y = (unsigned)(gs * 8 + e2); ro.z = __builtin_bit_cast(unsigned, ptop * wa); ro.w = __builtin_bit_cast(unsigned, ptop * wb);
                *(u32x4*)(X.ws + WS_ROUTE + (size_t)t * 16) = ro;
                __hip_atomic_fetch_add(hist + gs * 8 + e1, 1, __ATOMIC_RELAXED, __HIP_MEMORY_SCOPE_WORKGROUP); __hip_atomic_fetch_add(hist + gs * 8 + e2, 1, __ATOMIC_RELAXED, __HIP_MEMORY_SCOPE_WORKGROUP); }
        };
#pragma unroll 1
        for (int i = 0; i < 32; i += 2) { row(xa, ma, i); row(xb, mb, i + 1); }
        __syncthreads();
        if (X.tid < 32) ((int*)(X.ws + WS_HIST))[rb * 32 + X.tid] = hist[X.tid];
        __syncthreads();
    }
}

__device__ __forceinline__ void moe_dispatch(const Ctx& X) {
    LAS int* cnt = (LAS int*)(X.lds);
    LAS int* pre = cnt + 32;
    LAS int* ebase = cnt + 64;
    LAS int* wcnt = cnt + 128;
    const int* HIST = (const int*)(X.ws + WS_HIST); int* STOK = (int*)(X.ws + WS_STOK); float* SW = (float*)(X.ws + WS_SW); int* TSLOT = (int*)(X.ws + WS_TSLOT); int* TILEE = (int*)(X.ws + WS_TILEE);
    for (int rb = X.c; rb < NT / 256; rb += X.G) {
        if (X.tid < 64) cnt[X.tid] = 0;
        __syncthreads();
        { const int e = X.tid & 31, part = X.tid >> 5; int sa = 0, sp = 0;
          for (int q = 0; q < 16; ++q) { const int b2 = part * 16 + q; const int hv = HIST[b2 * 32 + e]; sa += hv; if (b2 < rb) sp += hv; }
          __hip_atomic_fetch_add(cnt + e, sa, __ATOMIC_RELAXED, __HIP_MEMORY_SCOPE_WORKGROUP); __hip_atomic_fetch_add(pre + e, sp, __ATOMIC_RELAXED, __HIP_MEMORY_SCOPE_WORKGROUP); }
        __syncthreads();
        if (X.tid < 64) { const int n = X.tid < 32 ? cnt[X.tid] : 0; const int pad = (n + 255) & ~255; int inc = pad;
#pragma unroll
            for (int o = 1; o < 32; o <<= 1) { const int u = __shfl_up(inc, o); if ((X.tid & 63) >= o) inc += u; }
            if (X.tid < 32) { ebase[X.tid] = inc - pad; if (X.tid == 31) ebase[32] = inc; } }
        __syncthreads();
        const int tl = X.tid >> 1, kk = X.tid & 1, t = rb * 256 + tl;
        const u32x4 ro = *(const u32x4*)(X.ws + WS_ROUTE + (size_t)t * 16);
        const int e = (int)(kk ? ro.y : ro.x); const float w = __builtin_bit_cast(float, kk ? ro.w : ro.z);
        int rank = 0;
        for (int ee = 0; ee < 32; ++ee) { const unsigned long long mm = __ballot(e == ee);
            if (e == ee) rank = __builtin_popcountll(mm & ((1ull << X.lane) - 1ull));
            if (X.lane == 0) wcnt[X.wave * 32 + ee] = __builtin_popcountll(mm); }
        __syncthreads();
        int off = 0;
        for (int w2 = 0; w2 < X.wave; ++w2) off += wcnt[w2 * 32 + e];
        const int slot = ebase[e] + pre[e] + off + rank;
        STOK[slot] = t; SW[slot] = w; TSLOT[2 * t + kk] = slot;
        if (rb < 32) { const int e2 = rb; for (int s = ebase[e2] + cnt[e2] + X.tid; s < ebase[e2 + 1]; s += 512) { STOK[s] = 0; SW[s] = 0.f; } }
        if (rb == 0) { const int ntl = ebase[32] >> 8;
            for (int tile = X.tid; tile < ntl; tile += 512) { int ee = 0; while (ee < 31 && ebase[ee + 1] <= tile * 256) ++ee; TILEE[tile] = ee; }
            if (X.tid == 0) TILEE[1024] = ntl; }
        __syncthreads();
    }
}

__device__ __forceinline__ void ln2_phase(const Ctx& X, const CArgs* ap, int l, bool first, bool dummy = false) {
    struct { const float *ln1g, *ln1b, *ln2g, *ln2b; } a = {ap->ln1g, ap->ln1b, ap->ln2g, ap->ln2b}; float* outw = dummy ? (float*)(X.ws + WS_Y + 272 * MiB) : ap->out; (void)first;
    const bool last = (l + 1 == DEPTH);
    const bf16* xin = LN2_X1B ? (const bf16*)(X.ws + WS_XB) : (last ? (const bf16*)(X.ws + WS_KVA) : (const bf16*)((const unsigned char*)ap->out + XR_OFF));
    const int lane = X.lane; const bf16* Y = (const bf16*)(X.ws + WS_Y); const bf16* MIX = (const bf16*)(X.ws + WS_MIX); const int* TSLOT = (const int*)(X.ws + WS_TSLOT); bf16* XBp = dummy ? (bf16*)(X.ws + WS_MIX) : (bf16*)((unsigned char*)ap->out + XR_OFF);
    auto ldy = [&](int slot, int j) __attribute__((always_inline)) -> u32x2 {
        if (Y_FP8) { u32x2 r; r.x = ldg_s<unsigned>((const unsigned char*)Y + (size_t)slot * DM + 4 * lane + 256 * j); r.y = 0u; return r; }
        return ldg_s<u32x2>(Y + (size_t)slot * DM + 4 * lane + 256 * j); };
    f32x4 g1[4], b1[4], g[4], bb[4];
#pragma unroll
    for (int j = 0; j < 4; ++j) { g1[j] = *(const f32x4*)(a.ln1g + l * DM + 4 * lane + 256 * j); b1[j] = *(const f32x4*)(a.ln1b + l * DM + 4 * lane + 256 * j);
        g[j] = *(const f32x4*)(a.ln2g + l * DM + 4 * lane + 256 * j); bb[j] = *(const f32x4*)(a.ln2b + l * DM + 4 * lane + 256 * j); }
    for (int rb = X.c; rb < NT / 256; rb += X.G) {
        const int tb = rb * 256 + X.wave * 32;
        const int myslots_a = TSLOT[2 * (tb + (lane & 31))], myslots_b = TSLOT[2 * (tb + (lane & 31)) + 1];
        u32x2 xn[4]; u32x2 mn[4], yan[4], ybn[4];
        { const int sa = __builtin_amdgcn_readlane(myslots_a, 0), sb = __builtin_amdgcn_readlane(myslots_b, 0);
#pragma unroll
          for (int j = 0; j < 4; ++j) { xn[j] = *(const u32x2*)(xin + (size_t)tb * DM + 4 * lane + 256 * j); mn[j] = LN2_X1B ? (u32x2){0u, 0u} : *(const u32x2*)(MIX + (size_t)tb * DM + 4 * lane + 256 * j);
              yan[j] = ldy(sa, j); ybn[j] = ldy(sb, j); } }
        for (int i = 0; i < 32; ++i) {
            const int t = tb + i;
            f32x4 v[4]; float s = 0.f;
#pragma unroll
            for (int j = 0; j < 4; ++j) { const u32x2 xw = xn[j]; const u32x2 mw = mn[j];
                if (LN2_X1B) { v[j][0] = bflo(xw.x); v[j][1] = bfhi(xw.x); v[j][2] = bflo(xw.y); v[j][3] = bfhi(xw.y); }
                else { v[j][0] = ALPHA * bflo(xw.x) + bflo(mw.x); v[j][1] = ALPHA * bfhi(xw.x) + bfhi(mw.x); v[j][2] = ALPHA * bflo(xw.y) + bflo(mw.y); v[j][3] = ALPHA * bfhi(xw.y) + bfhi(mw.y);
                    s += (v[j][0] + v[j][1]) + (v[j][2] + v[j][3]); } }
            u32x2 ya[4], yb[4];
#pragma unroll
            for (int j = 0; j < 4; ++j) { ya[j] = yan[j]; yb[j] = ybn[j]; }
            if (i + 1 < 32) { const int sa = __shfl(myslots_a, i + 1), sb = __shfl(myslots_b, i + 1);
#pragma unroll
                for (int j = 0; j < 4; ++j) { xn[j] = *(const u32x2*)(xin + (size_t)(t + 1) * DM + 4 * lane + 256 * j); if (!LN2_X1B) mn[j] = *(const u32x2*)(MIX + (size_t)(t + 1) * DM + 4 * lane + 256 * j);
                    yan[j] = ldy(sa, j); ybn[j] = ldy(sb, j); } }
            if (!LN2_X1B) { const float mean = wave_sum(s) * (1.f / DM); float s2 = 0.f;
#pragma unroll
              for (int j = 0; j < 4; ++j) { v[j] = v[j] - mean; s2 += (v[j][0] * v[j][0] + v[j][1] * v[j][1]) + (v[j][2] * v[j][2] + v[j][3] * v[j][3]); }
              const float rstd = 1.0f / sqrtf(wave_sum(s2) * (1.f / DM) + 1e-5f);
#pragma unroll
              for (int j = 0; j < 4; ++j) v[j] = v[j] * rstd * g1[j] + b1[j]; }
            s = 0.f;
#pragma unroll
            for (int j = 0; j < 4; ++j) { const f32x4 xv = v[j];
                if (Y_FP8) { const f32x4 fa = pg8::fp8x4_to_f32(ya[j].x), fb = pg8::fp8x4_to_f32(yb[j].x);
#pragma unroll
                    for (int e = 0; e < 4; ++e) v[j][e] = ALPHA * xv[e] + (fa[e] + fb[e]) * (1.0f / Y_SCALE);
                } else { v[j][0] = ALPHA * xv[0] + (bflo(ya[j].x) + bflo(yb[j].x)); v[j][1] = ALPHA * xv[1] + (bfhi(ya[j].x) + bfhi(yb[j].x)); v[j][2] = ALPHA * xv[2] + (bflo(ya[j].y) + bflo(yb[j].y)); v[j][3] = ALPHA * xv[3] + (bfhi(ya[j].y) + bfhi(yb[j].y)); }
                s += (v[j][0] + v[j][1]) + (v[j][2] + v[j][3]); }
            const float mean = wave_sum(s) * (1.f / DM); float s2 = 0.f;
#pragma unroll
            for (int j = 0; j < 4; ++j) { v[j] = v[j] - mean; s2 += (v[j][0] * v[j][0] + v[j][1] * v[j][1]) + (v[j][2] * v[j][2] + v[j][3] * v[j][3]); }
            const float rstd = 1.0f / sqrtf(wave_sum(s2) * (1.f / DM) + 1e-5f);
#pragma unroll
            for (int j = 0; j < 4; ++j) { v[j] = v[j] * rstd * g[j] + bb[j];
                if (last || dummy) stgf4<NT_LN>(outw + (size_t)t * DM + 4 * lane + 256 * j, v[j]);
                else { u32x2 w; w.x = pk2(v[j][0], v[j][1]); w.y = pk2(v[j][2], v[j][3]); stg8<NT_LN>(XBp + (size_t)t * DM + 4 * lane + 256 * j, w); } }
        }
    }
}

#ifndef REP_P0
#define REP_P0 1
#endif
#ifndef REP_P5
#define REP_P5 1
#endif
#ifndef REP_P9
#define REP_P9 1
#endif
#ifndef REP_BAR
#define REP_BAR 1
#endif
#ifndef REP_P1
#define REP_P1 1
#endif
#ifndef REP_P2A
#define REP_P2A 1
#endif
#ifndef REP_P2B
#define REP_P2B 1
#endif
#ifndef REP_P2C
#define REP_P2C 1
#endif
#ifndef REP_P2D
#define REP_P2D 1
#endif
#ifndef REP_P3A
#define REP_P3A 1
#endif
#ifndef REP_P3B
#define REP_P3B 1
#endif
#ifndef REP_P3C
#define REP_P3C 1
#endif
#ifndef REP_P4
#define REP_P4 1
#endif
#ifndef REP_P6
#define REP_P6 1
#endif
#ifndef REP_P7
#define REP_P7 1
#endif
#ifndef REP_P8
#define REP_P8 1
#endif
__global__ void __launch_bounds__(512, 2) mk_fwd(Args a) {
    extern __shared__ __attribute__((aligned(16))) unsigned char lds_raw[];
    LAS unsigned char* const lds0 = (LAS unsigned char*)lds_raw;
    for (int u = threadIdx.x; u < (LDS_BYTES - LDSCTL_OFF) / 4; u += 512) ((LAS unsigned*)(lds0 + LDSCTL_OFF))[u] = 0u;
    __syncthreads();
    unsigned* barw = (unsigned*)(a.ws + WS_CTL) + CW_BAR;
    XcdBarrier bar; bar.bar = barw; bar.x = 0; bar.st = nullptr;
    if (a.use_bar) bar = xcd_barrier_post(barw, (volatile LAS unsigned*)(lds0 + LDSCTL_OFF) + 8);
#define MKCTX() Ctx X; const CArgs* ap = (const CArgs*)__builtin_amdgcn_kernarg_segment_ptr(); asm volatile("" : "+s"(ap)); { int t_ = threadIdx.x; asm volatile("" : "+v"(t_)); X.lds = lds0; X.tid = t_; X.lane = t_ & 63; X.wave = __builtin_amdgcn_readfirstlane(t_ >> 6); \
        unsigned char* w_ = ap->ws; X.G = gridDim.x; X.c = blockIdx.x; X.vcu = (X.G % 8 == 0) ? (X.c % 8) * (X.G / 8) + X.c / 8 : X.c; X.ws = w_; }
#ifndef P2M
#define P2M 31
#endif
#ifndef PH_MASK0
#define PH_MASK0 1
#endif
#define GBAR() do { if (a.use_bar) for (int rb_ = 0; rb_ < REP_BAR; ++rb_) xcd_barrier(bar); } while (0)

    if ((PH_MASK0 & 1) && a.l_lo == 0 && a.ph_lo == 0) { MKCTX(); for (int rep = 0; rep < REP_P0; ++rep) { prologue(X, ap); __syncthreads(); } GBAR(); }

    for (int l = a.l_lo; l < a.l_hi; ++l) {
        const int lo = (l == a.l_lo) ? (a.ph_lo < 1 ? 1 : a.ph_lo) : 1, hi = (l == a.l_hi - 1) ? a.ph_hi : 10;
#ifndef PH_MASK
#define PH_MASK 0x3ff
#endif
#define IN(k) (((PH_MASK >> (k)) & 1) && lo <= (k) && (k) < hi)
        if (IN(1)) { MKCTX();
            pg8::Gemm g{(const bf16*)((const unsigned char*)ap->out + XR_OFF), (const bf16*)(X.ws + WS_WIN) + (size_t)l * NIN * DM, DM, nullptr};
            pg8::StaticOrder S; S.init(NT, NIN, X.G, X.c, REP_P1);
            pg8::RopeTabs R{ap->pos};
            pg8::EpiGroups<InProjDesc> E{InProjDesc{X.ws}, R, nullptr, 0, 0.f, 0.f};
            pg8::gemm_phase<pg8::EpiGroups<InProjDesc>, pg8::StaticOrder, false>(X.lds, g, S, E, X.tid);
            GBAR();
        }
        if (IN(2)) { MKCTX();
            {
                pg8::Gemm g{(const bf16*)(X.ws + WS_CQ), (const bf16*)(X.ws + WS_WUQ) + (size_t)l * 768 * 256, 256, nullptr};
                pg8::StaticOrder S; S.init(NT, 768, X.G, X.c, REP_P2A);
                pg8::RopeTabs R{ap->pos};
                pg8::EpiGroups<UqDesc> E{UqDesc{X.ws}, R, (const float*)(X.ws + WS_SSQ), 8, 1.0f / 256.0f, 1e-6f};
                pg8::gemm_phase<pg8::EpiGroups<UqDesc>, pg8::StaticOrder, false>(X.lds, g, S, E, X.tid);
            }
            {
                pg8::Gemm g{(const bf16*)(X.ws + WS_T1), (const bf16*)(X.ws + WS_WUKV) + (size_t)l * 1024 * 256, 256, nullptr};
                pg8::StaticOrder S; S.init(NT, 1024, X.G, X.c, REP_P2A);
                pg8::EpiPlainT<NT_KVA> E{(bf16*)(X.ws + WS_KVA), 1024, (const float*)(X.ws + WS_SSQ) + (size_t)NT * 8, 4, 1.0f / 128.0f, 1e-6f, X.lds + LDS_X_OFF};
                pg8::gemm_phase<decltype(E), pg8::StaticOrder, false>(X.lds, g, S, E, X.tid);
            }
            __syncthreads();
            for (int rep = 0; rep < REP_P2B; ++rep) convert_experts(X, ap, l);
            __syncthreads();
            for (int rep = 0; rep < REP_P2C; ++rep) for (int U = X.vcu; U < NB * 32; U += X.G) { const int b = U >> 5, pr = U & 31;
                dsa_index_unit(X, b, 32 * pr); dsa_index_unit(X, b, 32 * (63 - pr)); }
            __syncthreads();
#pragma unroll 1
            for (int cfg = 0; cfg < 3 * REP_P2D; ++cfg) { const int cfgi = cfg % 3;
                fa::Params P; const size_t co = (size_t)cfgi * NT * 256;
                P.Q = (const bf16*)(X.ws + WS_DQ) + co; P.q_pitch = 256; P.K1 = (const bf16*)(X.ws + WS_DK) + co; P.k1_pitch = 256; P.K2 = nullptr; P.k2_pitch = 0; P.k2_col = 0;
                P.V = (const bf16*)(X.ws + WS_DV) + co; P.v_pitch = 256; P.O = (bf16*)(X.ws + WS_OD) + co; P.o_pitch = 256; P.LSE = (float*)(X.ws + WS_LSE) + (size_t)cfgi * NT * 4; P.lse_pitch = 4; P.BM = nullptr;
                P.CL = cfgi == 0 ? 2048 : (cfgi == 1 ? 512 : 128); P.W = 128;
                const int vcu = X.vcu, G = X.G, wv = X.wave, CLc = P.CL;
                fa::attn_stream<64, 0, 2>(P, X.lds, X.tid, (NB * 2 * 16 - vcu + G - 1) / G, [=](int j) { const int U = vcu + j * G, bh = U >> 4, qb = U & 15, b = bh >> 1, hp = bh & 1;
                    const int q0 = 128 * qb, hh = 2 * hp + (wv >> 2); int klo = q0 & ~(CLc - 1); if (q0 - 128 > klo) klo = q0 - 128;
                    return fa::UnitDesc{b * SEQ, q0 + 32 * (wv & 3), 64 * hh, 64 * hh, hh, 128 * hp, 128 * hp, klo >> 6, (q0 + 127) >> 6}; });
            }
            GBAR();
        }
        if (IN(3)) { MKCTX();
            {   fa::Params P; P.Q = (const bf16*)(X.ws + WS_QA); P.q_pitch = 768; P.K1 = (const bf16*)(X.ws + WS_KVA); P.k1_pitch = 1024; P.K2 = (const bf16*)(X.ws + WS_KPE); P.k2_pitch = 32; P.k2_col = 0;
                P.V = (const bf16*)(X.ws + WS_KVA); P.v_pitch = 1024; P.O = (bf16*)(X.ws + WS_XB); P.o_pitch = DM; P.LSE = nullptr; P.lse_pitch = 0; P.BM = nullptr; P.CL = 2048; P.W = 1 << 20;
                const int vcu = X.vcu, G = X.G, wv = X.wave;
                fa::attn_stream<96, 2, 1>(P, X.lds, X.tid, 2 * ((NB * 8 * 4 - vcu + G - 1) / G), [=](int j) { const int U = vcu + (j >> 1) * G, bh = U >> 2, pr = U & 3, b = bh >> 3, hd = bh & 7;
                    const int qb = (j & 1) ? 7 - pr : pr, q0 = 256 * qb;
                    return fa::UnitDesc{b * SEQ, q0 + 32 * wv, 96 * hd, 64 * hd, 0, 128 * hd, 128 * hd + 64, 0, (q0 + 255) >> 6}; });
            }
            {   fa::Params P; P.Q = (const bf16*)(X.ws + WS_BQ); P.q_pitch = 256; P.K1 = (const bf16*)(X.ws + WS_T1); P.k1_pitch = 256; P.k1_col = 192; P.K2 = nullptr; P.k2_pitch = 0; P.k2_col = 0;
                P.V = (const bf16*)(X.ws + WS_BV); P.v_pitch = 64; P.v_col = 0; P.O = (bf16*)(X.ws + WS_XB); P.o_pitch = DM; P.LSE = nullptr; P.lse_pitch = 0; P.BM = (const unsigned*)(X.ws + WS_BM); P.CL = 2048; P.W = 1 << 20;
                const int hd = X.wave & 3, sub = X.wave >> 2, vcu = X.vcu, G = X.G;
                fa::attn_stream<64, 1, 1>(P, X.lds, X.tid, 2 * ((NB * 16 - vcu + G - 1) / G), [=](int j) { const int U = vcu + (j >> 1) * G, b = U >> 4, pr = U & 15;
                    const int qb = (j & 1) ? 31 - pr : pr, q0 = 64 * qb;
                    return fa::UnitDesc{b * SEQ, q0 + 32 * sub, 64 * hd, 512 + 64 * hd, 0, 192, 0, 0, qb}; });
            }
            for (int rep = 0; rep < REP_P3C; ++rep) dil_combine(X);
            GBAR();
        }
        if (IN(4)) { MKCTX();
            pg8::Gemm g{(const bf16*)(X.ws + WS_XB), (const bf16*)(X.ws + WS_WO) + (size_t)l * DM * DM, DM, nullptr};
            pg8::StaticOrder S; S.init(NT, DM, X.G, X.c, REP_P4);
            pg8::EpiPlainT<NT_MIX> E{(bf16*)(X.ws + WS_MIX), DM, nullptr, 0, 0.f, 0.f, X.lds + LDS_X_OFF};
            pg8::gemm_phase<decltype(E), pg8::StaticOrder, false>(X.lds, g, S, E, X.tid);
            GBAR();
        }
        if (IN(5)) { MKCTX(); if (REP_P5 > 1) ln1_router(X, ap, l, l == 0, true); ln1_router(X, ap, l, l == 0); GBAR(); }
        if (IN(6)) { MKCTX(); for (int rep = 0; rep < REP_P6; ++rep) moe_dispatch(X); GBAR(); }
        if (IN(7)) { MKCTX();
            const int* TILEE = (const int*)(X.ws + WS_TILEE);
            pg8::Gemm g{(const bf16*)(X.ws + WS_XB), (const bf16*)(X.ws + WS_WGU), DM, (const int*)(X.ws + WS_STOK)};
            pg8::GroupedOrder S{TILEE, TILEE[1024], 2, X.G, X.c};
            pg8::EpiGateUpT<NT_H> E{(bf16*)(X.ws + WS_H), (const float*)(X.ws + WS_SW)};
            for (int rep = 0; rep < REP_P7; ++rep) pg8::gemm_phase<decltype(E), pg8::GroupedOrder, true>(X.lds, g, S, E, X.tid);
            GBAR();
        }
        if (IN(8)) { MKCTX();
            const int* TILEE = (const int*)(X.ws + WS_TILEE);
            pg8::Gemm g{(const bf16*)(X.ws + WS_H), (const bf16*)(X.ws + WS_WD), FH, nullptr};
            pg8::GroupedOrder S{TILEE, TILEE[1024], 4, X.G, X.c};
#if Y_FP8
            pg8::EpiFp8T<NT_Y> E{X.ws + WS_Y, DM, Y_SCALE, X.lds + LDS_X_OFF};
#else
            pg8::EpiPlainT<NT_Y> E{(bf16*)(X.ws + WS_Y), DM, nullptr, 0, 0.f, 0.f, X.lds + LDS_X_OFF};
#endif
            for (int rep = 0; rep < REP_P8; ++rep) pg8::gemm_phase<decltype(E), pg8::GroupedOrder, false>(X.lds, g, S, E, X.tid);
            GBAR();
        }
        if (IN(9)) { MKCTX(); if (REP_P9 > 1) ln2_phase(X, ap, l, l == 0, true); ln2_phase(X, ap, l, l == 0); if (!(l == a.l_hi - 1)) GBAR(); }
#undef IN
    }
#undef GBAR
}

extern "C" void kernel_launch(void* const* d_in, const int* in_sizes, int n_in, void* d_out, int out_size, void* d_ws, size_t ws_size, hipStream_t stream) {
    static int grid = 0;
    if (grid == 0) {
        if (n_in != 19 || in_sizes[0] != NT * DM || out_size != NT * DM || ws_size < WS_END) { fprintf(stderr, "kernel_launch: unexpected shapes (n_in %d, in0 %d, out %d, ws %zu < %zu); nothing launched\n", n_in, n_in > 0 ? in_sizes[0] : -1, out_size, ws_size, (size_t)WS_END); grid = -1; return; }
        int dev = 0, cus = 0, per_cu = 0;
        if (hipGetDevice(&dev) != hipSuccess || hipDeviceGetAttribute(&cus, hipDeviceAttributeMultiprocessorCount, dev) != hipSuccess) { grid = -1; return; }
        if (hipFuncSetAttribute((const void*)mk_fwd, hipFuncAttributeMaxDynamicSharedMemorySize, LDS_BYTES) != hipSuccess) { fprintf(stderr, "kernel_launch: hipFuncSetAttribute failed\n"); grid = -1; return; }
        if (hipOccupancyMaxActiveBlocksPerMultiprocessor(&per_cu, (const void*)mk_fwd, 512, LDS_BYTES) != hipSuccess || per_cu < 1) fprintf(stderr, "kernel_launch: occupancy query reports %d\n", per_cu);
        (void)hipGetLastError();
        grid = cus;
    }
    if (grid < 0) return;
    (void)hipMemsetAsync((char*)d_ws + WS_CTL, 0, CTL_BYTES, stream);
    Args a{};
    a.x = (const float*)d_in[0]; a.pos = (const int*)d_in[1]; a.w_in = (const float*)d_in[2]; a.qn = (const float*)d_in[3]; a.kvn = (const float*)d_in[4];
    a.w_uq = (const float*)d_in[5]; a.w_ukv = (const float*)d_in[6]; a.w_o = (const float*)d_in[7]; a.ln1g = (const float*)d_in[8]; a.ln1b = (const float*)d_in[9];
    a.rgw = (const float*)d_in[10]; a.rgb = (const float*)d_in[11]; a.rew = (const float*)d_in[12]; a.reb = (const float*)d_in[13];
    a.wg = (const float*)d_in[14]; a.wu = (const float*)d_in[15]; a.wd = (const float*)d_in[16]; a.ln2g = (const float*)d_in[17]; a.ln2b = (const float*)d_in[18];
    a.out = (float*)d_out; a.ws = (unsigned char*)d_ws; a.pad = 0;
#if MK_MULTI
    a.use_bar = 0;
    a.l_lo = 0; a.l_hi = 0; a.ph_lo = 0; a.ph_hi = 0;
    hipLaunchKernelGGL(mk_fwd, dim3(grid), dim3(512), LDS_BYTES, stream, a);
    for (int l = 0; l < DEPTH; ++l)
        for (int ph = 1; ph < 10; ++ph) { a.l_lo = l; a.l_hi = l + 1; a.ph_lo = ph; a.ph_hi = ph + 1; hipLaunchKernelGGL(mk_fwd, dim3(grid), dim3(512), LDS_BYTES, stream, a); }
#else
    a.use_bar = 1; a.l_lo = 0; a.l_hi = DEPTH; a.ph_lo = 0; a.ph_hi = 10;
    hipLaunchKernelGGL(mk_fwd, dim3(grid), dim3(512), LDS_BYTES, stream, a);
#endif
    const hipError_t le = hipPeekAtLastError();
    if (le != hipSuccess) fprintf(stderr, "kernel_launch: launch failed: %s\n", hipGetErrorName(le));
}
```

```cpp
#include <hip/hip_runtime.h>
#include <cstdio>
#include <cstdint>

#define LAS __attribute__((address_space(3)))
#define GAS __attribute__((address_space(1)))
typedef unsigned short bf16;
typedef short bf16x8 __attribute__((ext_vector_type(8)));
typedef short s16x4 __attribute__((ext_vector_type(4)));
typedef float f32x2 __attribute__((ext_vector_type(2)));
typedef float f32x4 __attribute__((ext_vector_type(4)));
typedef float f32x16 __attribute__((ext_vector_type(16)));
typedef unsigned u32x2 __attribute__((ext_vector_type(2)));
typedef unsigned u32x4 __attribute__((ext_vector_type(4)));
typedef __bf16 bf16x2_t __attribute__((ext_vector_type(2)));

#ifndef MK_MULTI
#define MK_MULTI 0
#endif

constexpr int NB = 32, SEQ = 2048, NT = NB * SEQ, DM = 1024, DEPTH = 4;
constexpr int IN_COLS = 3400, NIN = 3584;
constexpr int NEXP = 32, FH = 256;
constexpr int NSLOT = 2 * NT + NEXP * 256;
constexpr int MAXTILES = NSLOT / 256;
constexpr float ALPHA = 1.681792830507429f;
constexpr float LOG2E = 1.4426950408889634f;
constexpr float QSC64 = 0.125f * LOG2E;
constexpr float QSC96 = 0.10206207261596577f * LOG2E;
constexpr float IDX_SCALE = 0.0625f;

constexpr size_t MiB = 1u << 20;
constexpr size_t WS_CTL = 0, CTL_BYTES = 1 * MiB;
constexpr size_t WS_WIN = 1 * MiB;
constexpr size_t WS_WUQ = 29 * MiB;
constexpr size_t WS_WUKV = WS_WUQ + 3 * MiB / 2;
constexpr size_t WS_WO = WS_WUKV + 2 * MiB;
constexpr size_t WS_RGT = WS_WO + 8 * MiB;
constexpr size_t WS_RET = WS_RGT + 64 * 1024;
constexpr size_t WS_ROPE = 42 * MiB;
constexpr size_t WS_WGU = 56 * MiB;
constexpr size_t WS_WD = 88 * MiB;
constexpr size_t WS_XB = 104 * MiB;
constexpr size_t WS_A = 232 * MiB;
constexpr size_t WS_CQ = WS_A;
constexpr size_t WS_T1 = WS_CQ + 32 * MiB;
constexpr size_t WS_BQ = WS_T1 + 32 * MiB;
constexpr size_t WS_BV = WS_BQ + 32 * MiB;
constexpr size_t WS_WI = WS_BV + 8 * MiB;
constexpr size_t WS_BQI = WS_WI + 2 * MiB;
constexpr size_t WS_SSQ = WS_BQI + 32 * MiB;
constexpr size_t WS_DQ = WS_SSQ + 4 * MiB;
constexpr size_t WS_DK = WS_DQ + 96 * MiB;
constexpr size_t WS_DV = WS_DK + 96 * MiB;
constexpr size_t WS_B = WS_DV + 96 * MiB;
constexpr size_t WS_QA = WS_B;
constexpr size_t WS_KVA = WS_QA + 96 * MiB;
constexpr size_t WS_BM = WS_KVA + 128 * MiB;
constexpr size_t WS_OD = WS_BM + 16 * MiB;
constexpr size_t WS_LSE = WS_OD + 96 * MiB;
constexpr size_t WS_MOE = WS_LSE + 4 * MiB;
constexpr size_t WS_ROUTE = WS_MOE;
constexpr size_t WS_HIST = WS_ROUTE + 1 * MiB;
constexpr size_t WS_STOK = WS_HIST + 64 * 1024;
constexpr size_t WS_SW = WS_STOK + 640 * 1024;
constexpr size_t WS_TSLOT = WS_SW + 640 * 1024;
constexpr size_t WS_TILEE = WS_TSLOT + 512 * 1024;
constexpr size_t WS_KPE = WS_MOE + 4 * MiB;
constexpr size_t WS_KI = WS_KPE + 4 * MiB;
constexpr size_t WS_END = WS_KI + 4 * MiB;
constexpr size_t WS_MIX = WS_A;
constexpr size_t WS_H = WS_A + 128 * MiB;
constexpr size_t WS_Y = WS_H + 68 * MiB;
static_assert(WS_RET + 512 * 1024 <= WS_ROPE && WS_ROPE + 14 * MiB <= WS_WGU && WS_WD + 16 * MiB <= WS_XB && WS_XB + 128 * MiB <= WS_A, "ws map 1");
static_assert(WS_Y + 272 * MiB <= WS_MOE && WS_TILEE + 8192 <= WS_END && WS_END <= 1024 * MiB, "ws map 2");
constexpr size_t ROPE_C16 = 0, ROPE_S16 = (size_t)NT * 16 * 4, ROPE_C8 = 2 * ROPE_S16, ROPE_S8 = ROPE_C8 + (size_t)NT * 8 * 4,
                 ROPE_C4 = ROPE_S8 + (size_t)NT * 8 * 4, ROPE_S4 = ROPE_C4 + (size_t)NT * 4 * 4;

constexpr int CW_BAR = 4096;
constexpr int RING_BYTES = 131072;
constexpr int LDS_X_OFF = 131072;
constexpr int LDSCTL_OFF = 147456;
constexpr int LDS_HIST_OFF = LDSCTL_OFF + 4096;
constexpr int LDS_BYTES = LDS_HIST_OFF + 4096;

#define RLX_AGENT __ATOMIC_RELAXED, __HIP_MEMORY_SCOPE_AGENT
__device__ __forceinline__ unsigned f2bf(float f) { unsigned u = __builtin_bit_cast(unsigned, f); return (u + 0x7fffu + ((u >> 16) & 1u)) >> 16; }
#ifndef Y_FP8
#define Y_FP8 1
#endif
#define Y_SCALE 64.0f
#ifndef ROUTER_MFMA
#define ROUTER_MFMA 1
#endif
#ifndef LN2_X1B
#define LN2_X1B 1
#endif
constexpr size_t XR_OFF = (size_t)NT * DM * 2;
#ifndef NT_EPI
#define NT_EPI 1
#endif
#ifndef NT_KVA
#define NT_KVA 1
#endif
#ifndef NT_MIX
#define NT_MIX 0
#endif
#ifndef NT_H
#define NT_H 0
#endif
#ifndef NT_Y
#define NT_Y 1
#endif
#ifndef NT_LN
#define NT_LN 0
#endif
#ifndef NT_ATT
#define NT_ATT 1
#endif
#define STG_ASM(W, POL) asm volatile("global_store_dwordx" W " %0, %1, off " POL "\n\ts_nop 1" :: "v"(p), "v"(w))
template <int M, class T> __device__ __forceinline__ void stg_any16(void* p, T w) {
    if constexpr (M == 0) *(T*)p = w; else if constexpr (M == 1) __builtin_nontemporal_store(w, (T*)p);
    else if constexpr (M == 2) STG_ASM("4", "sc1"); else if constexpr (M == 3) STG_ASM("4", "sc0 sc1"); else if constexpr (M == 4) STG_ASM("4", "sc1 nt"); else STG_ASM("4", "sc0 sc1 nt"); }
template <int M> __device__ __forceinline__ void stgf4(void* p, f32x4 w) { stg_any16<M>(p, w); }
template <int M> __device__ __forceinline__ void stg16(void* p, u32x4 w) { stg_any16<M>(p, w); }
template <int M> __device__ __forceinline__ void stg8(void* p, u32x2 w) {
    if constexpr (M == 0) *(u32x2*)p = w; else if constexpr (M == 1) __builtin_nontemporal_store(w, (u32x2*)p);
    else if constexpr (M == 2) STG_ASM("2", "sc1"); else if constexpr (M == 3) STG_ASM("2", "sc0 sc1"); else if constexpr (M == 4) STG_ASM("2", "sc1 nt"); else STG_ASM("2", "sc0 sc1 nt"); }
#ifndef NT_LD
#define NT_LD 1
#endif
template <class T> __device__ __forceinline__ T ldg_s(const void* p) { if constexpr (NT_LD) return __builtin_nontemporal_load((const T*)p); else return *(const T*)p; }
__device__ __forceinline__ unsigned pk2(float lo, float hi) { f32x2 v = {lo, hi}; bf16x2_t b = __builtin_convertvector(v, bf16x2_t); return __builtin_bit_cast(unsigned, b); }
__device__ __forceinline__ float bf2f(unsigned short b) { return __builtin_bit_cast(float, ((unsigned)b) << 16); }
__device__ __forceinline__ float bflo(unsigned w) { return __builtin_bit_cast(float, w << 16); }
__device__ __forceinline__ float bfhi(unsigned w) { return __builtin_bit_cast(float, w & 0xffff0000u); }
template <int CTRL> __device__ __forceinline__ float dppf(float x) { return __builtin_bit_cast(float, __builtin_amdgcn_mov_dpp(__builtin_bit_cast(int, x), CTRL, 0xf, 0xf, true)); }
__device__ __forceinline__ float xhalf_sum(float v) { const auto t = __builtin_amdgcn_permlane32_swap(__float_as_uint(v), __float_as_uint(v), false, false); return __uint_as_float(t[0]) + __uint_as_float(t[1]); }
__device__ __forceinline__ float xhalf_max(float v) { const auto t = __builtin_amdgcn_permlane32_swap(__float_as_uint(v), __float_as_uint(v), false, false); return fmaxf(__uint_as_float(t[0]), __uint_as_float(t[1])); }
__device__ __forceinline__ float wave_sum(float v) {
    v += dppf<0xB1>(v); v += dppf<0x4E>(v); v += dppf<0x141>(v); v += dppf<0x140>(v);
    const auto s = __builtin_amdgcn_permlane16_swap(__float_as_uint(v), __float_as_uint(v), false, false);
    v = __uint_as_float(s[0]) + __uint_as_float(s[1]);
    return xhalf_sum(v);
}
template <int N> __device__ __forceinline__ void wave_sum_n(float (&v)[N]) {
#pragma unroll
    for (int i = 0; i < N; ++i) v[i] += dppf<0xB1>(v[i]);
#pragma unroll
    for (int i = 0; i < N; ++i) v[i] += dppf<0x4E>(v[i]);
#pragma unroll
    for (int i = 0; i < N; ++i) v[i] += dppf<0x141>(v[i]);
#pragma unroll
    for (int i = 0; i < N; ++i) v[i] += dppf<0x140>(v[i]);
#pragma unroll
    for (int i = 0; i < N; ++i) { const auto s = __builtin_amdgcn_permlane16_swap(__float_as_uint(v[i]), __float_as_uint(v[i]), false, false); v[i] = __uint_as_float(s[0]) + __uint_as_float(s[1]); }
#pragma unroll
    for (int i = 0; i < N; ++i) v[i] = xhalf_sum(v[i]);
}
__device__ __forceinline__ int crow(int r, int hi) { return (r & 3) + 8 * (r >> 2) + 4 * hi; }

#define XB_TMO      128
#define XB_XCNT(j)  (256  + 64 * (j))
#define XB_XSUB(j)  (1280 + 64 * (j))
#define XB_XGEN(j)  (2304 + 64 * (j))
#define XB_TOP      3328
#define XB_TOPGEN   3392
#define XCD_BAR_WORDS 3456
#define XB_SPIN_CAP (1u << 18)
__device__ __forceinline__ unsigned xb_ld(unsigned* p)              { return __hip_atomic_load(p, __ATOMIC_RELAXED, __HIP_MEMORY_SCOPE_AGENT); }
__device__ __forceinline__ unsigned xb_add(unsigned* p, unsigned v) { return __hip_atomic_fetch_add(p, v, __ATOMIC_RELAXED, __HIP_MEMORY_SCOPE_AGENT); }
__device__ __forceinline__ unsigned xb_xcc_id() { return (unsigned)__builtin_amdgcn_s_getreg((3 << 11) | 20) & 0xFu; }
#define XB_SPIN(cond, bar) do { unsigned _sp = 0; while (cond) { __builtin_amdgcn_s_sleep(1); \
    if ((++_sp & 255u) == 0u) { if (xb_ld(&(bar)[XB_TMO])) break; if (_sp > XB_SPIN_CAP) { atomicAdd(&(bar)[XB_TMO], 1u); break; } } } } while (0)
struct XcdBarrier { unsigned* bar; unsigned x; volatile LAS unsigned* st; };
__device__ __forceinline__ XcdBarrier xcd_barrier_post(unsigned* bar, volatile LAS unsigned* st) {
    XcdBarrier b; b.bar = bar; b.x = xb_xcc_id(); b.st = st;
    if (threadIdx.x == 0) (void)xb_add(&bar[XB_XCNT(b.x)], 1u);
    return b;
}
__device__ __forceinline__ void xcd_barrier_complete(unsigned* bar, unsigned x, unsigned& nloc, unsigned& nx) {
    const unsigned G = gridDim.x * gridDim.y * gridDim.z;
    unsigned sum, cnt, mine, sp = 0u;
    for (;;) {
        sum = 0u; cnt = 0u; mine = 0u;
#pragma unroll
        for (unsigned j = 0; j < 16; ++j) { const unsigned c = xb_ld(&bar[XB_XCNT(j)]); sum += c; cnt += (c > 0u) ? 1u : 0u; mine = (j == x) ? c : mine; }
        if (sum == G) break;
        __builtin_amdgcn_s_sleep(1);
        if ((++sp & 255u) == 0u) { if (xb_ld(&bar[XB_TMO])) break; if (sp > XB_SPIN_CAP) { atomicAdd(&bar[XB_TMO], 1u); break; } }
    }
    nloc = mine > 0u ? mine : 1u; nx = cnt > 0u ? cnt : 1u;
}
__device__ __forceinline__ void xcd_barrier(const XcdBarrier& b) {
    asm volatile("s_waitcnt vmcnt(0)" ::: "memory");
    __syncthreads();
    if (threadIdx.x == 0) {
        unsigned* bar = b.bar;
        __builtin_amdgcn_s_waitcnt(0);
        unsigned nloc = b.st[0], nx = b.st[1];
        if (nloc == 0u) { xcd_barrier_complete(bar, b.x, nloc, nx); b.st[0] = nloc; b.st[1] = nx; }
        const unsigned old = xb_add(&bar[XB_XSUB(b.x)], 1u);
        const unsigned gen = old / nloc;
        if (old + 1u == (gen + 1u) * nloc) {
            __builtin_amdgcn_fence(__ATOMIC_RELEASE, "agent");
            asm volatile("s_waitcnt vmcnt(0)" ::: "memory");
            const unsigned og = xb_add(&bar[XB_TOP], 1u);
            const unsigned tg = og / nx;
            if (og + 1u == (tg + 1u) * nx) xb_add(&bar[XB_TOPGEN], 1u);
            else XB_SPIN(xb_ld(&bar[XB_TOPGEN]) == tg, bar);
            __builtin_amdgcn_fence(__ATOMIC_ACQUIRE, "agent");
            xb_add(&bar[XB_XGEN(b.x)], 1u);
            asm volatile("s_waitcnt vmcnt(0)" ::: "memory");
        } else {
            XB_SPIN(xb_ld(&bar[XB_XGEN(b.x)]) == gen, bar);
            __builtin_amdgcn_fence(__ATOMIC_ACQUIRE, "agent");
            asm volatile("s_waitcnt vmcnt(0)" ::: "memory");
        }
    }
    __syncthreads();
}

namespace pg8 {
constexpr int BM = 256, BK = 64, HALF = 128, HTB = HALF * BK * 2, STAGE_BYTES = 8 * HTB, NXCD = 8, WGM = 8;
__host__ __device__ __forceinline__ int lds_byte(int r, int c) { const int st = (r >> 4) * 2 + (c >> 5), rr = r & 15, cc = c & 31, ob = rr * 64 + cc * 2; return st * 1024 + (ob ^ (((ob >> 9) & 1) << 5)); }
__host__ __device__ __forceinline__ void stage_rc(int b, int& R, int& C) { const int st = b / 1024, sb = b % 1024, swz = sb ^ (((sb >> 9) & 1) << 5); R = (st >> 1) * 16 + swz / 64; C = (st & 1) * 32 + (swz % 64) / 2; }
__host__ __device__ __forceinline__ int perm32(int rho) { const int n = rho >> 4, i = rho & 15; return 8 * (i >> 2) + 4 * n + (i & 3); }

#ifndef PROBE_P1
#define PROBE_P1 0
#endif
struct Unit { int pm, pn, pb;
#if PROBE_P1
    int fl;
#endif
};
struct Gemm { const bf16* A; const bf16* Bt; int K; const int* gidx; };

__device__ __forceinline__ int xcd_remap(int wgid, int nwg) { const int q = nwg / NXCD, r = nwg % NXCD, xcd = wgid % NXCD, off = wgid / NXCD; return (xcd < r ? xcd * (q + 1) : r * (q + 1) + (xcd - r) * q) + off; }
struct StaticOrder {
    int nM, nN, nwg, G, c, rep;
    __device__ void init(int M, int N, int G_, int c_, int rep_ = 1) { nM = M / BM; nN = N / BM; nwg = nM * nN; G = G_; c = c_; rep = rep_; }
    __device__ bool next(int i, Unit& u) const {
        long L = (long)i * G + c; if (L >= (long)nwg * rep) return false;
#if PROBE_P1
        u.fl = (rep > 1 && L < nwg) ? 1 : 0;
#endif
        L %= nwg;
        const int wgid = xcd_remap((int)L, nwg);
        const int nig = WGM * nN, gid = wgid / nig, fm = gid * WGM, gsz = (nM - fm) < WGM ? (nM - fm) : WGM;
        u.pm = fm + ((wgid % nig) % gsz); u.pn = (wgid % nig) / gsz; u.pb = u.pn; return true;
    }
};
struct GroupedOrder {
    const int* tile_e; int ntiles, npn, G, c;
    __device__ bool next(int i, Unit& u) const {
        const long L = (long)i * G + c; const int nwg = ntiles * npn; if (L >= nwg) return false;
        const int wgid = xcd_remap((int)L, nwg);
        u.pm = wgid / npn; u.pn = wgid % npn; u.pb = tile_e[u.pm] * npn + u.pn;
#if PROBE_P1
        u.fl = 0;
#endif
        return true;
    }
};

__device__ __forceinline__ unsigned cvt_pk_bf16(float lo, float hi) { unsigned r; asm volatile("v_cvt_pk_bf16_f32 %0, %1, %2" : "=v"(r) : "v"(lo), "v"(hi)); return r; }

template <int STM> struct EpiPlainT {
    static constexpr bool PERM = true;
    bf16* O; int ldc; const float* ssq; int ssq_n; float ssq_inv; float eps;
    LAS unsigned char* xl;
    __device__ __forceinline__ void operator()(const f32x4 (&acc)[2][2][4][2], const Unit& u, int wr, int wc, int fr, int fq) const {
        const int lane = fq * 16 + fr; LAS unsigned char* t = xl + (wr * 4 + wc) * 2048;
        const int wsw = fr & 7, rrow = lane >> 3, rch = lane & 7;
#pragma unroll
        for (int ai = 0; ai < 2; ++ai)
#pragma unroll
            for (int m = 0; m < 4; ++m) { const int rowb = u.pm * BM + ai * HALF + wr * 64 + m * 16;
                float sc = 1.f;
                if (ssq) { const f32x4 p = *(const f32x4*)(ssq + (size_t)(rowb + fr) * ssq_n); sc = __builtin_amdgcn_rsqf((p[0] + p[1] + p[2] + p[3]) * ssq_inv + eps); }
#pragma unroll
                for (int bj = 0; bj < 2; ++bj) { const f32x4 v0 = acc[ai][bj][m][0] * sc, v1 = acc[ai][bj][m][1] * sc;
                    u32x4 w; w.x = cvt_pk_bf16(v0[0], v0[1]); w.y = cvt_pk_bf16(v0[2], v0[3]); w.z = cvt_pk_bf16(v1[0], v1[1]); w.w = cvt_pk_bf16(v1[2], v1[3]);
                    *(LAS u32x4*)(t + fr * 128 + 16 * ((4 * bj + fq) ^ wsw)) = w; }
#pragma unroll
                for (int i = 0; i < 2; ++i) { const int rr = 8 * i + rrow;
                    const u32x4 w = *(const LAS u32x4*)(t + rr * 128 + 16 * (rch ^ (rr & 7)));
                    stg16<STM>(O + (size_t)(rowb + rr) * ldc + u.pn * BM + wc * 64 + 8 * rch, w); }
            }
    }
};
template <int STM> struct EpiFp8T {
    static constexpr bool PERM = true;
    unsigned char* O; int ldc; float scale; LAS unsigned char* xl;
    __device__ __forceinline__ void operator()(const f32x4 (&acc)[2][2][4][2], const Unit& u, int wr, int wc, int fr, int fq) const {
        const int lane = fq * 16 + fr; LAS unsigned char* t = xl + (wr * 4 + wc) * 2048;
        const int rrow = lane >> 2, rch = lane & 3;
#pragma unroll
        for (int ai = 0; ai < 2; ++ai)
#pragma unroll
            for (int m = 0; m < 4; ++m) { const int rowb = u.pm * BM + ai * HALF + wr * 64 + m * 16;
#pragma unroll
                for (int bj = 0; bj < 2; ++bj) { f32x4 v0 = acc[ai][bj][m][0] * scale, v1 = acc[ai][bj][m][1] * scale;
#pragma unroll
                    for (int e = 0; e < 4; ++e) { v0[e] = __builtin_amdgcn_fmed3f(v0[e], -448.f, 448.f); v1[e] = __builtin_amdgcn_fmed3f(v1[e], -448.f, 448.f); }
                    int lo = __builtin_amdgcn_cvt_pk_fp8_f32(v0[0], v0[1], 0, false); lo = __builtin_amdgcn_cvt_pk_fp8_f32(v0[2], v0[3], lo, true);
                    int hi = __builtin_amdgcn_cvt_pk_fp8_f32(v1[0], v1[1], 0, false); hi = __builtin_amdgcn_cvt_pk_fp8_f32(v1[2], v1[3], hi, true);
                    *(LAS u32x2*)(t + fr * 64 + 32 * bj + 8 * fq) = (u32x2){(unsigned)lo, (unsigned)hi}; }
                const u32x4 w = *(const LAS u32x4*)(t + lane * 16);
                stg16<STM>(O + (size_t)(rowb + rrow) * ldc + u.pn * BM + wc * 64 + 16 * rch, w); }
    }
};
__device__ __forceinline__ f32x4 fp8x4_to_f32(unsigned w) { const f32x2 a = __builtin_amdgcn_cvt_pk_f32_fp8((int)w, false), b = __builtin_amdgcn_cvt_pk_f32_fp8((int)w, true); return (f32x4){a.x, a.y, b.x, b.y}; }
template <int STM> struct EpiGateUpT {
    static constexpr bool PERM = true;
    bf16* H; const float* sw;
    __device__ __forceinline__ void operator()(const f32x4 (&acc)[2][2][4][2], const Unit& u, int wr, int wc, int fr, int fq) const {
        const int row0 = u.pm * BM + wr * 64 + fr; const int col0 = u.pn * HALF + wc * 32 + 8 * fq;
#pragma unroll
        for (int ai = 0; ai < 2; ++ai)
#pragma unroll
            for (int m = 0; m < 4; ++m) { const int row = row0 + ai * HALF + m * 16; const float w = sw[row]; f32x4 hv[2];
#pragma unroll
                for (int n = 0; n < 2; ++n) { const f32x4 g = acc[ai][0][m][n], up = acc[ai][1][m][n];
#pragma unroll
                    for (int e = 0; e < 4; ++e) { const float sg = g[e] * __builtin_amdgcn_rcpf(1.0f + __builtin_amdgcn_exp2f(-g[e] * LOG2E)); hv[n][e] = sg * up[e] * w; } }
                u32x4 o; o.x = cvt_pk_bf16(hv[0][0], hv[0][1]); o.y = cvt_pk_bf16(hv[0][2], hv[0][3]); o.z = cvt_pk_bf16(hv[1][0], hv[1][1]); o.w = cvt_pk_bf16(hv[1][2], hv[1][3]);
                stg16<STM>(H + (size_t)row * FH + col0, o); }
    }
};

enum { GK_SKIP = 0, GK_PLAIN = 1, GK_ROPE32 = 2, GK_HEAD16 = 3, GK_IDX8 = 4, GK_WI = 5 };
struct GroupDesc { int kind; bf16* dst; int pitch; int col; float scale; int perm; float* ssq; int ssq_n; int ssq_i; };
struct RopeTabs { const int* pos; };
__device__ __forceinline__ int perm_row(int row, int perm) {
    if (perm == 0) return row; const int b = row >> 11, s = row & 2047;
    return perm == 4 ? (b << 11) + ((s & 3) << 9) + (s >> 2) : (b << 11) + ((s & 15) << 7) + (s >> 4);
}
__device__ __forceinline__ void st16(bf16* p, u32x2 a, u32x2 b) { u32x4 w; w.x = a.x; w.y = a.y; w.z = b.x; w.w = b.y; stg16<NT_EPI>(p, w); }
__device__ __forceinline__ u32x2 pk4(f32x4 v) { u32x2 w; w.x = cvt_pk_bf16(v[0], v[1]); w.y = cvt_pk_bf16(v[2], v[3]); return w; }
__device__ __forceinline__ void swap16(u32x2& X, u32x2& Y) {
    const auto a = __builtin_amdgcn_permlane16_swap(X.x, Y.x, false, false); const auto b = __builtin_amdgcn_permlane16_swap(X.y, Y.y, false, false);
    X.x = a[0]; Y.x = a[1]; X.y = b[0]; Y.y = b[1];
}
__device__ __forceinline__ float rope_k(int i, int rd) { return __builtin_amdgcn_exp2f(-18.931568569324174f * (float)(2 * i) / (float)rd) * 0.15915494309189535f; }
__device__ __forceinline__ void rope_cs(float posf, int i0, int rd, f32x4& c, f32x4& s) {
#pragma unroll
    for (int e = 0; e < 4; ++e) { const float f = __builtin_amdgcn_fractf(posf * rope_k(i0 + e, rd)); s[e] = __builtin_amdgcn_sinf(f); c[e] = __builtin_amdgcn_cosf(f); }
}
template <class DescFn> struct EpiGroups {
    static constexpr bool PERM = true;
    DescFn F; RopeTabs R; const float* rs_ssq; int rs_n; float rs_inv, rs_eps;
    __device__ __forceinline__ void operator()(const f32x4 (&acc)[2][2][4][2], const Unit& u, int wr, int wc, int fr, int fq) const {
        const int row0 = u.pm * BM + wr * 64 + fr;
#pragma unroll
        for (int bj = 0; bj < 2; ++bj) {
            const GroupDesc d = F(u.pn, bj, wc);
            if (d.kind == GK_SKIP) continue;
#if PROBE_P1 == 1
            if (u.fl) continue;
#endif
            const int ki0 = d.kind == GK_ROPE32 ? 4 * fq : (d.kind == GK_HEAD16 ? 4 * (fq & 1) : 0), krd = d.kind == GK_ROPE32 ? 32 : (d.kind == GK_HEAD16 ? 16 : 8);
#pragma unroll
            for (int ai = 0; ai < 2; ++ai)
#pragma unroll
                for (int m = 0; m < 4; ++m) {
                    const int row = row0 + ai * HALF + m * 16;
                    float sc = d.scale;
                    if (rs_ssq) { float s = 0.f; for (int i = 0; i < rs_n; ++i) s += rs_ssq[(size_t)row * rs_n + i]; sc *= __builtin_amdgcn_rsqf(s * rs_inv + rs_eps); }
                    f32x4 v0 = acc[ai][bj][m][0], v1 = acc[ai][bj][m][1];
                    if (d.ssq) {
                        float q = (v0[0] * v0[0] + v0[1] * v0[1]) + (v0[2] * v0[2] + v0[3] * v0[3]) + (v1[0] * v1[0] + v1[1] * v1[1]) + (v1[2] * v1[2] + v1[3] * v1[3]);
                        q += __shfl_xor(q, 16); q += __shfl_xor(q, 32);
                        if (fq == 0) d.ssq[(size_t)row * d.ssq_n + d.ssq_i] = q;
                    }
                    v0 = v0 * sc; v1 = v1 * sc;
                    if (d.kind == GK_WI) { if (fq == 0) { float* wp = (float*)d.dst + (size_t)row * 8; *(f32x4*)wp = v0; *(f32x4*)(wp + 4) = v1; } continue; }
                    bf16* rp = d.dst + (size_t)perm_row(row, d.perm) * d.pitch + d.col;
                    if (d.kind == GK_PLAIN) { st16(rp + 8 * fq, pk4(v0), pk4(v1)); }
                    else if (d.kind == GK_IDX8) {
                        f32x4 c, s; rope_cs((float)R.pos[row], ki0, krd, c, s);
                        const f32x4 o1 = fq == 0 ? v0 * c - v1 * s : v0, o2 = fq == 0 ? v1 * c + v0 * s : v1;
                        st16(rp + 8 * fq, pk4(o1), pk4(o2));
                    } else if (d.kind == GK_ROPE32) {
                        f32x4 c, s; rope_cs((float)R.pos[row], ki0, krd, c, s);
                        u32x2 X = pk4(v0 * c - v1 * s), Y = pk4(v1 * c + v0 * s);
                        swap16(X, Y);
                        st16(rp + ((fq & 1) ? 16 + 4 * (fq - 1) : 4 * fq), X, Y);
                    } else {
                        f32x4 c, s; rope_cs((float)R.pos[row], ki0, krd, c, s);
                        u32x2 X = pk4(fq < 2 ? v0 * c - v1 * s : v0), Y = pk4(fq < 2 ? v1 * c + v0 * s : v1);
                        swap16(X, Y);
                        st16(rp + 16 * (fq >> 1) + 8 * (fq & 1), X, Y);
                    }
                }
        }
    }
};

template <class Epi, class Sched, bool GATHER, int LDA = 0>
__device__ __forceinline__ void gemm_phase(LAS unsigned char* lds, const Gemm g, const Sched& S, const Epi& E, const int tid) {
    const int wid = __builtin_amdgcn_readfirstlane(tid >> 6), lane = tid & 63, wr = wid >> 2, wc = wid & 3, fr = lane & 15, fq = lane >> 4;
    const int K = g.K, nt = K / BK, lda = LDA ? LDA : K;
    unsigned voA[2][2], voB[2]; int RA[2], CA[2];
#pragma unroll
    for (int i = 0; i < 2; ++i) { int R, C; stage_rc(tid * 16 + i * 8192, R, C); const int Rb = Epi::PERM ? ((R & ~31) + perm32(R & 31)) : R;
        RA[i] = R; CA[i] = C; voA[0][i] = (unsigned)(R * lda + C) * 2u; voA[1][i] = (unsigned)((R + HALF) * lda + C) * 2u; voB[i] = (unsigned)(Rb * K + C) * 2u; }
    const size_t kstep = (size_t)(BK * 2);
    const size_t hstep = (size_t)HALF * K * 2;
    const size_t tstep = 2 * hstep;
    const size_t tstepA = (size_t)BM * lda * 2;
    const unsigned ldsw = (unsigned)wid * 1024u;
    const int aoff = lds_byte(wr * 64 + fr, fq * 8), boff = lds_byte(wc * 32 + fr, fq * 8);
#define PG8_SA(b, h) (((b) * 2 + (h)) * HTB)
#define PG8_SB(b, h) ((4 + (b) * 2 + (h)) * HTB)
#define PG8_STAGE(bufoff, gbase, voff) do { _Pragma("unroll") for (int _i = 0; _i < 2; ++_i) \
        __builtin_amdgcn_global_load_lds((const unsigned*)((const char*)(gbase) + (voff)[_i]), (LAS unsigned*)(lds + (bufoff) + ldsw + _i * 8192), 16, 0, 0); } while (0)
#define PG8_LDA(dst, b, h) do { _Pragma("unroll") for (int m = 0; m < 4; ++m) _Pragma("unroll") for (int k = 0; k < 2; ++k) dst[m][k] = *(const LAS bf16x8*)(lds + PG8_SA(b, h) + aoff + m * 2048 + k * 1024); } while (0)
#define PG8_LDB(dst, b, h) do { _Pragma("unroll") for (int n = 0; n < 2; ++n) _Pragma("unroll") for (int k = 0; k < 2; ++k) dst[n][k] = *(const LAS bf16x8*)(lds + PG8_SB(b, h) + boff + n * 2048 + k * 1024); } while (0)
#define PG8_MMA(ai, bj, At, Bt) do { __builtin_amdgcn_s_setprio(1); _Pragma("unroll") for (int m = 0; m < 4; ++m) _Pragma("unroll") for (int n = 0; n < 2; ++n) _Pragma("unroll") for (int k = 0; k < 2; ++k) \
        acc[ai][bj][m][n] = __builtin_amdgcn_mfma_f32_16x16x32_bf16(Bt[n][k], At[m][k], acc[ai][bj][m][n], 0, 0, 0); __builtin_amdgcn_s_setprio(0); } while (0)
#define PG8_WAIT_V(n) asm volatile("s_waitcnt vmcnt(" #n ")" ::: "memory")
#define PG8_WAIT_L(n) asm volatile("s_waitcnt lgkmcnt(" #n ")" ::: "memory")
#define PG8_BAR __builtin_amdgcn_s_barrier()
#define PG8_SCHED __builtin_amdgcn_sched_barrier(0)
    Unit cur, nxt; int ui = 0;
    if (!S.next(0, cur)) return;
    f32x4 acc[2][2][4][2];
#pragma unroll
    for (int a = 0; a < 2; ++a)
#pragma unroll
        for (int b = 0; b < 2; ++b)
#pragma unroll
            for (int m = 0; m < 4; ++m)
#pragma unroll
                for (int n = 0; n < 2; ++n) acc[a][b][m][n] = (f32x4){0.f, 0.f, 0.f, 0.f};
    bf16x8 At[4][2], B0[2][2], B1[2][2];
    unsigned nvA[2][2];
    const char* cA; const char* cB = (const char*)g.Bt + (size_t)cur.pb * tstep;
    if constexpr (GATHER) { cA = (const char*)g.A;
#pragma unroll
        for (int h = 0; h < 2; ++h)
#pragma unroll
            for (int i = 0; i < 2; ++i) voA[h][i] = (unsigned)g.gidx[cur.pm * BM + h * HALF + RA[i]] * (unsigned)(lda * 2) + (unsigned)CA[i] * 2u;
    } else cA = (const char*)g.A + (size_t)cur.pm * tstepA;
    PG8_STAGE(PG8_SB(0, 0), cB, voB); PG8_STAGE(PG8_SB(0, 1), cB + hstep, voB); PG8_STAGE(PG8_SA(0, 0), cA, voA[0]); PG8_STAGE(PG8_SA(0, 1), cA, voA[1]);
    if (wr == 1) PG8_BAR;
    PG8_WAIT_V(2); PG8_BAR;
    PG8_STAGE(PG8_SB(1, 0), cB + kstep, voB); PG8_STAGE(PG8_SA(1, 0), cA + kstep, voA[0]); PG8_STAGE(PG8_SB(1, 1), cB + hstep + kstep, voB);
    PG8_WAIT_V(6); PG8_BAR;
    for (;;) {
        const bool has_next = S.next(ui + 1, nxt);
        const char* nA; const char* nB = has_next ? (const char*)g.Bt + (size_t)nxt.pb * tstep : cB;
        if constexpr (GATHER) { nA = cA;
#pragma unroll
            for (int h = 0; h < 2; ++h)
#pragma unroll
                for (int i = 0; i < 2; ++i) nvA[h][i] = has_next ? (unsigned)g.gidx[nxt.pm * BM + h * HALF + RA[i]] * (unsigned)(lda * 2) + (unsigned)CA[i] * 2u : voA[h][i];
        } else nA = has_next ? (const char*)g.A + (size_t)nxt.pm * tstepA : cA;
#if PROBE_P1 == 2
        const int ntu = cur.fl ? 2 : nt;
#else
        const int ntu = nt;
#endif
#pragma nounroll
        for (int t = 0; t < ntu; t += 2) {
            const bool last = (t == ntu - 2);
            const char* a1 = cA + (size_t)(t + 1) * kstep;
            const char* a2 = last ? nA : cA + (size_t)(t + 2) * kstep; const char* b2 = last ? nB : cB + (size_t)(t + 2) * kstep;
            const char* a3 = a2 + kstep; const char* b3 = b2 + kstep;
            unsigned xA[2][2];
#pragma unroll
            for (int h = 0; h < 2; ++h)
#pragma unroll
                for (int i = 0; i < 2; ++i) xA[h][i] = (GATHER && last) ? nvA[h][i] : voA[h][i];
            PG8_LDB(B0, 0, 0); PG8_LDB(B1, 0, 1); PG8_SCHED; PG8_LDA(At, 0, 0); PG8_STAGE(PG8_SA(1, 1), a1, voA[1]);
            PG8_WAIT_V(8); PG8_WAIT_L(0); PG8_BAR; PG8_MMA(0, 0, At, B0); PG8_MMA(0, 1, At, B1); PG8_BAR; PG8_SCHED;
            PG8_LDA(At, 0, 1); PG8_STAGE(PG8_SB(0, 0), b2, voB); PG8_STAGE(PG8_SB(0, 1), b2 + hstep, voB); PG8_STAGE(PG8_SA(0, 0), a2, xA[0]);
            PG8_WAIT_V(8); PG8_WAIT_L(0); PG8_BAR; PG8_MMA(1, 0, At, B0); PG8_MMA(1, 1, At, B1); PG8_BAR; PG8_SCHED;
            PG8_LDB(B0, 1, 0); PG8_LDB(B1, 1, 1); PG8_SCHED; PG8_LDA(At, 1, 0); PG8_STAGE(PG8_SA(0, 1), a2, xA[1]);
            PG8_WAIT_V(8); PG8_WAIT_L(0); PG8_BAR; PG8_MMA(0, 0, At, B0); PG8_MMA(0, 1, At, B1); PG8_BAR; PG8_SCHED;
            PG8_LDA(At, 1, 1); PG8_STAGE(PG8_SB(1, 0), b3, voB); PG8_STAGE(PG8_SB(1, 1), b3 + hstep, voB); PG8_STAGE(PG8_SA(1, 0), a3, xA[0]);
            PG8_WAIT_V(8); PG8_WAIT_L(0); PG8_BAR; PG8_MMA(1, 0, At, B0); PG8_MMA(1, 1, At, B1); PG8_BAR; PG8_SCHED;
        }
        if (wr == 0) PG8_BAR;
        E(acc, cur, wr, wc, fr, fq);
        if (!has_next) break;
#pragma unroll
        for (int a = 0; a < 2; ++a)
#pragma unroll
            for (int b = 0; b < 2; ++b)
#pragma unroll
                for (int m = 0; m < 4; ++m)
#pragma unroll
                    for (int n = 0; n < 2; ++n) acc[a][b][m][n] = (f32x4){0.f, 0.f, 0.f, 0.f};
        cur = nxt; cA = nA; cB = nB; ++ui;
        if constexpr (GATHER) {
#pragma unroll
            for (int h = 0; h < 2; ++h)
#pragma unroll
                for (int i = 0; i < 2; ++i) voA[h][i] = nvA[h][i];
        }
        if (wr == 1) PG8_BAR;
    }
    PG8_WAIT_V(0);
    PG8_BAR;
#undef PG8_SA
#undef PG8_SB
#undef PG8_STAGE
#undef PG8_LDA
#undef PG8_LDB
#undef PG8_MMA
#undef PG8_WAIT_V
#undef PG8_WAIT_L
#undef PG8_BAR
#undef PG8_SCHED
}
}

#ifndef PROBE_LDS2
#define PROBE_LDS2 0
#endif
#ifndef PROBE_EXP2
#define PROBE_EXP2 0
#endif
#ifndef SOFTMAX_PK
#define SOFTMAX_PK 0
#endif
#ifndef FA_FUSE
#define FA_FUSE 0
#endif
namespace fa {
constexpr int VBYTES_T = 64 * 128;
typedef short v4i16_t __attribute__((ext_vector_type(4)));
__device__ __forceinline__ u32x2 vtr(const LAS unsigned char* p) { return __builtin_bit_cast(u32x2, __builtin_amdgcn_ds_read_tr16_b64_v4i16((LAS v4i16_t*)p)); }
__device__ __forceinline__ float max16(const f32x16& c) { float r;
    asm("v_max3_f32 %0, %1, %2, %3\n\tv_max3_f32 %0, %0, %4, %5\n\tv_max3_f32 %0, %0, %6, %7\n\tv_max3_f32 %0, %0, %8, %9\n\tv_max3_f32 %0, %0, %10, %11\n\tv_max3_f32 %0, %0, %12, %13\n\tv_max3_f32 %0, %0, %14, %15\n\tv_max_f32 %0, %0, %16"
        : "=&v"(r) : "v"(c[0]), "v"(c[1]), "v"(c[2]), "v"(c[3]), "v"(c[4]), "v"(c[5]), "v"(c[6]), "v"(c[7]), "v"(c[8]), "v"(c[9]), "v"(c[10]), "v"(c[11]), "v"(c[12]), "v"(c[13]), "v"(c[14]), "v"(c[15]));
    return r; }
__device__ __forceinline__ void mask_init(f32x16& S, unsigned nw) { float t0, t1, t2, t3, t4, t5, t6, t7, t8, t9, t10, t11, t12, t13, t14, t15;
    asm("v_bfe_i32 %0, %16, 0, 1\n\tv_lshlrev_b32 %0, 23, %0\n\tv_bfe_i32 %1, %16, 1, 1\n\tv_lshlrev_b32 %1, 23, %1\n\tv_bfe_i32 %2, %16, 2, 1\n\tv_lshlrev_b32 %2, 23, %2\n\tv_bfe_i32 %3, %16, 3, 1\n\tv_lshlrev_b32 %3, 23, %3\n\tv_bfe_i32 %4, %16, 8, 1\n\tv_lshlrev_b32 %4, 23, %4\n\tv_bfe_i32 %5, %16, 9, 1\n\tv_lshlrev_b32 %5, 23, %5\n\tv_bfe_i32 %6, %16, 10, 1\n\tv_lshlrev_b32 %6, 23, %6\n\tv_bfe_i32 %7, %16, 11, 1\n\tv_lshlrev_b32 %7, 23, %7\n\tv_bfe_i32 %8, %16, 16, 1\n\tv_lshlrev_b32 %8, 23, %8\n\tv_bfe_i32 %9, %16, 17, 1\n\tv_lshlrev_b32 %9, 23, %9\n\tv_bfe_i32 %10, %16, 18, 1\n\tv_lshlrev_b32 %10, 23, %10\n\tv_bfe_i32 %11, %16, 19, 1\n\tv_lshlrev_b32 %11, 23, %11\n\tv_bfe_i32 %12, %16, 24, 1\n\tv_lshlrev_b32 %12, 23, %12\n\tv_bfe_i32 %13, %16, 25, 1\n\tv_lshlrev_b32 %13, 23, %13\n\tv_bfe_i32 %14, %16, 26, 1\n\tv_lshlrev_b32 %14, 23, %14\n\tv_bfe_i32 %15, %16, 27, 1\n\tv_lshlrev_b32 %15, 23, %15"
        : "=&v"(t0), "=&v"(t1), "=&v"(t2), "=&v"(t3), "=&v"(t4), "=&v"(t5), "=&v"(t6), "=&v"(t7), "=&v"(t8), "=&v"(t9), "=&v"(t10), "=&v"(t11), "=&v"(t12), "=&v"(t13), "=&v"(t14), "=&v"(t15) : "v"(nw));
    S[0] = t0; S[1] = t1; S[2] = t2; S[3] = t3; S[4] = t4; S[5] = t5; S[6] = t6; S[7] = t7; S[8] = t8; S[9] = t9; S[10] = t10; S[11] = t11; S[12] = t12; S[13] = t13; S[14] = t14; S[15] = t15; }
struct Params {
    const bf16* Q;  int q_pitch;
    const bf16* K1; int k1_pitch, k1_col;
    const bf16* K2; int k2_pitch, k2_col;
    const bf16* V;  int v_pitch, v_col;
    bf16* O; int o_pitch;
    float* LSE; int lse_pitch;
    const unsigned* BM;
    int CL, W;
};
struct UnitDesc { int seq0, qw, q_col, o_col, lse_col, k1_col, v_col, kt_lo, kt_hi; };
template <int DQK, int MODE, int NH, class DescFn>
__device__ __forceinline__ void attn_stream(const Params& P, LAS unsigned char* lds, const int tid, const int n_units, DescFn desc) {
    constexpr int NKS = DQK / 16, AHEAD = (NH == 2 ? 3 : 4), NST = AHEAD + 1, K1B = 8192 * NH, K2B = (DQK == 96 ? 4096 : 0), BMOFF = K1B + K2B + 8192 * NH, STB = BMOFF + (MODE == 1 ? 8192 : 0);
    constexpr int NDMA = 2 * NH + (DQK == 96 ? 1 : 0) + (MODE == 1 ? 1 : 0);
    static_assert(NH == 1 || (DQK == 64 && MODE != 1), "two-head stages: head dim 64 only");
    constexpr bool active = true;
    if (n_units <= 0) return;
    const int lane = tid & 63, r = lane & 31, h = lane >> 5, wave = __builtin_amdgcn_readfirstlane(tid >> 6);
    const int tq_ = (lane & 15) >> 2, tp_ = lane & 3, tg_ = lane >> 4;
    const int hsel = NH == 2 ? (wave >> 2) * 8192 : 0;
    const int vtoff = K1B + K2B + hsel + (4 * h + tq_) * 128, vxb = 2 * (16 * (tg_ & 1) + 4 * tp_), vsw = (tq_ >> 1) & 1;
    const int vx0 = vxb + ((0 ^ vsw) << 6), vx1 = vxb + ((1 ^ vsw) << 6);
    const int s1_ = (r >> 1) & 7, s2_ = (r >> 2) & 3;
    const int k1row = hsel + r * 128, k2row = K1B + r * 64;
    const int row1 = 8 * wave + (lane >> 3), row2 = 16 * (wave & 3) + (lane >> 2);
    const size_t tk1 = (size_t)64 * P.k1_pitch, tk2 = (size_t)64 * P.k2_pitch, tv = (size_t)64 * P.v_pitch;
    const int d_k1 = wave * 1024, d_k2 = K1B + (wave & 3) * 1024, d_v = K1B + K2B + wave * 1024;
    const bf16* src_k1; const bf16* src_v; const bf16* src_k2 = nullptr; const unsigned* bmp = nullptr;
    int ji = -1, kti = 1, kti_hi = 0;
    auto fa_issue = [&](const int st) __attribute__((always_inline)) {
        if (kti > kti_hi) {
            if (ji + 1 < n_units) { ++ji; const UnitDesc t = desc(ji); kti = t.kt_lo; kti_hi = t.kt_hi;
                src_k1 = P.K1 + (size_t)(t.seq0 + row1) * P.k1_pitch + t.k1_col + 8 * ((lane & 7) ^ ((row1 >> 1) & 7));
                src_v = P.V + (size_t)(t.seq0 + row1) * P.v_pitch + t.v_col + 8 * ((lane & 7) ^ (((row1 >> 1) & 1) << 2));
                if constexpr (DQK == 96) src_k2 = P.K2 + (size_t)(t.seq0 + row2) * P.k2_pitch + P.k2_col + 8 * ((lane & 3) ^ ((row2 >> 2) & 3));
                if constexpr (MODE == 1) bmp = P.BM + (size_t)(t.seq0 + t.qw + r) * 64;
            } else kti = kti_hi; }
        LAS unsigned char* sb_ = lds + st * STB;
        __builtin_amdgcn_global_load_lds((const unsigned*)(src_k1 + kti * tk1), (LAS unsigned*)(sb_ + d_k1), 16, 0, 0);
        __builtin_amdgcn_global_load_lds((const unsigned*)(src_v + kti * tv), (LAS unsigned*)(sb_ + d_v), 16, 0, 0);
        if constexpr (NH == 2) {
            __builtin_amdgcn_global_load_lds((const unsigned*)(src_k1 + 64 + kti * tk1), (LAS unsigned*)(sb_ + d_k1 + 8192), 16, 0, 0);
            __builtin_amdgcn_global_load_lds((const unsigned*)(src_v + 64 + kti * tv), (LAS unsigned*)(sb_ + d_v + 8192), 16, 0, 0); }
        if constexpr (DQK == 96) __builtin_amdgcn_global_load_lds((const unsigned*)(src_k2 + kti * tk2), (LAS unsigned*)(sb_ + d_k2), 16, 0, 0);
        if constexpr (MODE == 1) __builtin_amdgcn_global_load_lds(bmp + (kti & ~1) * 2, (LAS unsigned*)(sb_ + BMOFF + wave * 1024), 16, 0, 0);
        ++kti; };
#define FA_ISSUE(TILE, ST) fa_issue(ST)
    int st_is = 0, st_c = 0, st_n = 1;
    bf16x8 qf[NKS];
#define FA_LOADQ(D) do { const bf16* qp_ = P.Q + (size_t)((D).seq0 + (D).qw + r) * P.q_pitch + (D).q_col + 8 * h; \
        _Pragma("unroll") for (int ks = 0; ks < NKS; ++ks) asm volatile("global_load_dwordx4 %0, %1, off offset:%2" : "=&v"(qf[ks]) : "v"(qp_), "n"(32 * ks) : "memory"); } while (0)
#define FA_WAITQ(N) do { if constexpr (NKS == 6) asm volatile("s_waitcnt vmcnt(%6)" : "+v"(qf[0]), "+v"(qf[1]), "+v"(qf[2]), "+v"(qf[3]), "+v"(qf[4]), "+v"(qf[5]) : "n"(N) : "memory"); \
        else asm volatile("s_waitcnt vmcnt(%4)" : "+v"(qf[0]), "+v"(qf[1]), "+v"(qf[2]), "+v"(qf[3]) : "n"(N) : "memory"); } while (0)
    { const UnitDesc d0 = desc(0); FA_LOADQ(d0); FA_WAITQ(0); }
#pragma unroll 1
    for (int ju = 0; ju < n_units; ++ju) {
    const UnitDesc du = desc(ju);
    const int seq0 = du.seq0, qw = du.qw, q_col = du.q_col, o_col = du.o_col, lse_col = du.lse_col, kt_lo = du.kt_lo, kt_hi = du.kt_hi;
    const int q = qw + r;
    const int lo_q = MODE == 0 ? max(q & ~(P.CL - 1), q - P.W) : 0;
    const int qh = q - 4 * h, lqh = lo_q - 4 * h;
    const int lo_w0 = MODE == 0 ? max(qw & ~(P.CL - 1), qw - P.W) : 0;
    const int lo_w1 = MODE == 0 ? max((qw + 31) & ~(P.CL - 1), qw + 31 - P.W) : 0;
#define FA_WAITBAR(N) do { asm volatile("s_waitcnt vmcnt(%0)" :: "n"(N) : "memory"); __builtin_amdgcn_s_barrier(); asm volatile("" ::: "memory"); } while (0)
    f32x16 o0, o1, c0, c1, n0, n1;
#pragma unroll
    for (int i = 0; i < 16; ++i) { o0[i] = 0.f; o1[i] = 0.f; c0[i] = 0.f; c1[i] = 0.f; n0[i] = 0.f; n1[i] = 0.f; }
    float m = -INFINITY, l = 0.f;
#define FA_PART(kt_) (active && (MODE == 0 ? ((kt_) * 64 <= qw + 31 && (kt_) * 64 + 63 >= lo_w0) : ((kt_) * 64 <= qw + 31)))
#define FA_KADDR(SB_, ROFF, ks) ((ks) < 4 ? (SB_) + (ROFF) * 128 + k1row + 16 * ((2 * (ks) + h) ^ s1_) : (SB_) + (ROFF) * 64 + k2row + 16 * ((2 * ((ks) - 4) + h) ^ s2_))
#define FA_QKH(S, SB_, ROFF, NW) do { bf16x8 fa_[NKS]; \
        _Pragma("unroll") for (int ks = 0; ks < NKS; ++ks) fa_[ks] = *(const LAS bf16x8*)FA_KADDR(SB_, ROFF, ks); \
        if (PROBE_LDS2) { _Pragma("unroll") for (int ks = 0; ks < NKS; ++ks) { const bf16x8 fb_ = *(const volatile LAS bf16x8*)FA_KADDR(SB_, (ROFF) ^ 32, ks); asm volatile("" :: "v"(fb_)); } } \
        if constexpr (MODE == 1) {        \
            mask_init(S, NW); \
        } else { _Pragma("unroll") for (int i = 0; i < 16; ++i) S[i] = 0.f; } \
        _Pragma("unroll") for (int ks = 0; ks < NKS; ++ks) S = __builtin_amdgcn_mfma_f32_32x32x16_bf16(fa_[ks], qf[ks], S, 0, 0, 0); \
        __builtin_amdgcn_sched_group_barrier(0x100, NKS, 0); __builtin_amdgcn_sched_group_barrier(0x008, NKS, 0); } while (0)
#define FA_QK(S0, S1, SB_, KT) do { unsigned nwa_ = 0u, nwb_ = 0u; \
        if constexpr (MODE == 1) { const u32x4 bw_ = *(const LAS u32x4*)((SB_) + BMOFF + wave * 1024 + lane * 16);        \
            nwa_ = ~((((KT) & 1) ? bw_.z : bw_.x) >> (4 * h)); nwb_ = ~((((KT) & 1) ? bw_.w : bw_.y) >> (4 * h)); } \
        FA_QKH(S0, SB_, 0, nwa_); FA_QKH(S1, SB_, 32, nwb_); } while (0)
#define FA_QKX(S, SB_, ROFF) do { bf16x8 fa_[NKS]; \
        _Pragma("unroll") for (int ks = 0; ks < NKS; ++ks) fa_[ks] = *(const LAS bf16x8*)FA_KADDR(SB_, ROFF, ks); \
        _Pragma("unroll") for (int i = 0; i < 16; ++i) S[i] = 0.f; \
        _Pragma("unroll") for (int ks = 0; ks < NKS; ++ks) S = __builtin_amdgcn_mfma_f32_32x32x16_bf16(fa_[ks], qf[ks], S, 0, 0, 0); } while (0)
    if (ju == 0) {
#pragma unroll 1
        for (int a = 0; a < AHEAD; ++a) { FA_ISSUE(kt_lo + a, st_is); st_is = st_is + 1; }
        FA_WAITBAR((AHEAD - 2) * NDMA);
    }
    if (FA_PART(kt_lo)) FA_QK(c0, c1, lds + st_c * STB, kt_lo);
    auto fa_step = [&](f32x16& c0, f32x16& c1, f32x16& n0, f32x16& n1, const int kt) __attribute__((always_inline)) {
        FA_ISSUE(kt + AHEAD, st_is); st_is = (st_is + 1 == NST) ? 0 : st_is + 1;
        const bool more1 = kt < kt_hi;
        const bool qnext = !more1 && (ju + 1 < n_units);
        if (qnext) { const UnitDesc dq = desc(ju + 1); FA_LOADQ(dq); }
        const int k0 = kt * 64;
        const bool part_c = FA_PART(kt), part_n = more1 && FA_PART(kt + 1);
        const LAS unsigned char* Sn = lds + st_n * STB; const LAS unsigned char* Vb = lds + st_c * STB;
        const bool fused = FA_FUSE && (DQK == 64) && part_c && part_n;
        if (part_n && !fused) FA_QK(n0, n1, Sn, kt + 1);
        if (part_c) {
            float alpha;
#define FA_SOFTMAX(MASKED) do { \
            if (MASKED) { if constexpr (MODE == 2) { const int qa = qh - k0, qa1 = qa - 32; \
                    _Pragma("unroll") for (int i = 0; i < 16; ++i) { const int ci = (i & 3) + 8 * (i >> 2); \
                        c0[i] = (ci > qa) ? -INFINITY : c0[i]; c1[i] = (ci > qa1) ? -INFINITY : c1[i]; } \
                } else if constexpr (MODE == 0) { const int lb = lqh - k0; const unsigned span = (unsigned)(q - lo_q), lb1 = (unsigned)(lb - 32);     \
                    _Pragma("unroll") for (int i = 0; i < 16; ++i) { const int ci = (i & 3) + 8 * (i >> 2); \
                        c0[i] = ((unsigned)(ci - lb) > span) ? -INFINITY : c0[i]; c1[i] = ((unsigned)ci - lb1 > span) ? -INFINITY : c1[i]; } \
                } } \
            float mx = xhalf_max(fmaxf(max16(c0), max16(c1))); \
            const float mn = fmaxf(m, mx); \
            const float ms = (mn == -INFINITY) ? 0.f : mn; \
            alpha = __builtin_amdgcn_exp2f(m - ms); \
            m = mn; \
            float ls = 0.f; \
            if (PROBE_EXP2) { float dm_ = 0.f; _Pragma("unroll") for (int i = 0; i < 16; ++i) { dm_ += __builtin_amdgcn_exp2f(c0[i] - mx) + __builtin_amdgcn_exp2f(c1[i] - mx); } asm volatile("" :: "v"(dm_)); } \
            if (SOFTMAX_PK) { const f32x2 ms2 = {ms, ms}; f32x2 lsa = {0.f, 0.f}, lsb = {0.f, 0.f};            \
              _Pragma("unroll") for (int i = 0; i < 16; i += 2) { \
                  f32x2 ta = {c0[i], c0[i + 1]}, tb = {c1[i], c1[i + 1]}; ta = ta - ms2; tb = tb - ms2; \
                  ta.x = __builtin_amdgcn_exp2f(ta.x); ta.y = __builtin_amdgcn_exp2f(ta.y); tb.x = __builtin_amdgcn_exp2f(tb.x); tb.y = __builtin_amdgcn_exp2f(tb.y); \
                  c0[i] = ta.x; c0[i + 1] = ta.y; c1[i] = tb.x; c1[i + 1] = tb.y; lsa = lsa + ta; lsb = lsb + tb; } \
              lsa = lsa + lsb; ls = lsa.x + lsa.y; \
            } else {        \
              _Pragma("unroll") for (int i = 0; i < 16; ++i) { c0[i] = __builtin_amdgcn_exp2f(c0[i] - ms); c1[i] = __builtin_amdgcn_exp2f(c1[i] - ms); ls += c0[i] + c1[i]; } } \
            l = l * alpha + ls; } while (0)
            const bool need_mask = MODE == 1 ? false : (MODE == 2 ? (k0 + 63 > qw) : ((k0 + 63 > qw) || (k0 < lo_w1)));
#define FA_FUSED(MASKED) do { FA_QKX(n0, Sn, 0); FA_QKX(n1, Sn, 32); FA_SOFTMAX(MASKED); \
            _Pragma("unroll") for (int hh_ = 0; hh_ < 2; ++hh_) { \
                __builtin_amdgcn_sched_group_barrier(0x100, NKS, 0); \
                _Pragma("unroll") for (int i = 0; i < NKS; ++i) { __builtin_amdgcn_sched_group_barrier(0x008, 1, 0); __builtin_amdgcn_sched_group_barrier(0x002, 120 / (2 * NKS), 0); } } } while (0)
            if (fused) { if (need_mask) FA_FUSED(true); else FA_FUSED(false); }
            else { if (need_mask) FA_SOFTMAX(true); else FA_SOFTMAX(false); }
#undef FA_FUSED
#undef FA_SOFTMAX
            if (!__all(alpha == 1.0f)) {
#pragma unroll
                for (int i = 0; i < 16; ++i) { o0[i] *= alpha; o1[i] *= alpha; } }
            const unsigned va0_ = (unsigned)(size_t)(Vb + vtoff + vx0), va1_ = (unsigned)(size_t)(Vb + vtoff + vx1);
#define FA_PV(S_, O0, O1, O2, O3) do { \
                u32x2 va00, vb00, va01, vb01, va10, vb10, va11, vb11;                           \
                asm volatile("ds_read_b64_tr_b16 %0, %8 offset:%10\n\tds_read_b64_tr_b16 %1, %8 offset:%11\n\tds_read_b64_tr_b16 %2, %9 offset:%10\n\tds_read_b64_tr_b16 %3, %9 offset:%11\n\t" \
                             "ds_read_b64_tr_b16 %4, %8 offset:%12\n\tds_read_b64_tr_b16 %5, %8 offset:%13\n\tds_read_b64_tr_b16 %6, %9 offset:%12\n\tds_read_b64_tr_b16 %7, %9 offset:%13" \
                             : "=&v"(va00), "=&v"(vb00), "=&v"(va01), "=&v"(vb01), "=&v"(va10), "=&v"(vb10), "=&v"(va11), "=&v"(vb11) \
                             : "v"(va0_), "v"(va1_), "n"(O0), "n"(O1), "n"(O2), "n"(O3) : "memory"); \
                bf16x8 pf[2]; \
                _Pragma("unroll") for (int sk = 0; sk < 2; ++sk) { u32x4 pw; pw.x = pk2(S_[8 * sk + 0], S_[8 * sk + 1]); pw.y = pk2(S_[8 * sk + 2], S_[8 * sk + 3]); pw.z = pk2(S_[8 * sk + 4], S_[8 * sk + 5]); pw.w = pk2(S_[8 * sk + 6], S_[8 * sk + 7]); pf[sk] = __builtin_bit_cast(bf16x8, pw); } \
                asm volatile("s_waitcnt lgkmcnt(0)" : "+v"(va00), "+v"(vb00), "+v"(va01), "+v"(vb01), "+v"(va10), "+v"(vb10), "+v"(va11), "+v"(vb11) :: "memory"); \
                __builtin_amdgcn_sched_barrier(0); \
                { const u32x4 v0w = {va00.x, va00.y, vb00.x, vb00.y}, v1w = {va01.x, va01.y, vb01.x, vb01.y}; \
                  o0 = __builtin_amdgcn_mfma_f32_32x32x16_bf16(__builtin_bit_cast(bf16x8, v0w), pf[0], o0, 0, 0, 0); \
                  o1 = __builtin_amdgcn_mfma_f32_32x32x16_bf16(__builtin_bit_cast(bf16x8, v1w), pf[0], o1, 0, 0, 0); } \
                { const u32x4 v0w = {va10.x, va10.y, vb10.x, vb10.y}, v1w = {va11.x, va11.y, vb11.x, vb11.y}; \
                  o0 = __builtin_amdgcn_mfma_f32_32x32x16_bf16(__builtin_bit_cast(bf16x8, v0w), pf[1], o0, 0, 0, 0); \
                  o1 = __builtin_amdgcn_mfma_f32_32x32x16_bf16(__builtin_bit_cast(bf16x8, v1w), pf[1], o1, 0, 0, 0); } } while (0)
            FA_PV(c0, 0, 1024, 2048, 3072);
            FA_PV(c1, 4096, 5120, 6144, 7168);
#undef FA_PV
        }
        if (qnext) FA_WAITBAR((AHEAD - 2) * NDMA + NKS); else FA_WAITBAR((AHEAD - 2) * NDMA);
        st_c = st_n; st_n = (st_n + 1 == NST) ? 0 : st_n + 1;
    };
    for (int kt = kt_lo;;) { fa_step(c0, c1, n0, n1, kt); if (++kt > kt_hi) break; fa_step(n0, n1, c0, c1, kt); if (++kt > kt_hi) break; }
#undef FA_PART
#undef FA_QK
#undef FA_QKH
#undef FA_QKX
#undef FA_KADDR
    const float lt = xhalf_sum(l);
    const float inv = 1.0f / lt;
    if (active) {
    bf16* op = P.O + (size_t)(seq0 + q) * P.o_pitch + o_col + 8 * h;
#pragma unroll
    for (int db = 0; db < 2; ++db) {
        const f32x16& o = db ? o1 : o0;
#pragma unroll
        for (int j = 0; j < 2; ++j) {
            u32x2 X, Y;
            X.x = pk2(o[8 * j] * inv, o[8 * j + 1] * inv); X.y = pk2(o[8 * j + 2] * inv, o[8 * j + 3] * inv);
            Y.x = pk2(o[8 * j + 4] * inv, o[8 * j + 5] * inv); Y.y = pk2(o[8 * j + 6] * inv, o[8 * j + 7] * inv);
            const auto a = __builtin_amdgcn_permlane32_swap(X.x, Y.x, false, false); const auto b = __builtin_amdgcn_permlane32_swap(X.y, Y.y, false, false);
            u32x4 w; w.x = a[0]; w.y = b[0]; w.z = a[1]; w.w = b[1];
            stg16<NT_ATT>(op + 32 * db + 16 * j, w);
        }
    }
    if (P.LSE && h == 0) P.LSE[(size_t)(seq0 + q) * P.lse_pitch + lse_col] = m + __builtin_amdgcn_logf(lt);
    }
    __builtin_amdgcn_sched_barrier(0);
    FA_WAITQ(4);
    }
    asm volatile("s_waitcnt vmcnt(0)" ::: "memory"); __builtin_amdgcn_s_barrier(); asm volatile("" ::: "memory");
#undef FA_ISSUE
#undef FA_LOADQ
#undef FA_WAITQ
#undef FA_WAITBAR
}
}

struct Args {
    const float* x; const int* pos; const float* w_in; const float* qn; const float* kvn; const float* w_uq; const float* w_ukv; const float* w_o;
    const float* ln1g; const float* ln1b; const float* rgw; const float* rgb; const float* rew; const float* reb;
    const float* wg; const float* wu; const float* wd; const float* ln2g; const float* ln2b;
    float* out; unsigned char* ws; int l_lo, l_hi, ph_lo, ph_hi, use_bar, pad;
};
typedef const __attribute__((address_space(4))) Args CArgs;
struct Ctx { LAS unsigned char* lds; int tid, lane, wave, G, c, vcu; unsigned char* ws; };

struct ColIdent { int off; __device__ __forceinline__ int operator()(int P) const { return off + P; } };
struct ColAdj { __device__ __forceinline__ int operator()(int P) const { const int p = P & 255; return (P & ~255) + 64 * ((p >> 5) & 3) + 32 * (p >> 7) + (p & 31); } };
__device__ __forceinline__ int map_rope32(int p) { return 16 * ((p >> 2) & 1) + 4 * (p >> 3) + (p & 3); }
__device__ __forceinline__ int map_head16(int p) { const int fq = p >> 3; return 16 * (fq >> 1) + 8 * ((p >> 2) & 1) + 4 * (fq & 1) + (p & 3); }
struct ColWin {
    __device__ __forceinline__ int operator()(int P) const {
        const int G = P >> 5, p = P & 31;
        if (G < 8) return 32 * G + p;
        if (G < 12) return 256 + 32 * (G - 8) + p;
        if (G == 12) return 384 + map_rope32(p);
        if (G == 13) return 1056 + p;
        if (G == 14) return 672 + map_head16(p);
        if (G == 15) return 704 + p;
        if (G < 24) { const int hh = (G - 16) >> 1; return 416 + 64 * hh + (((G - 16) & 1) ? 32 + p : map_head16(p)); }
        if (G < 26) return 736 + 32 * (G - 24) + p;
        if (G == 26) return p < 8 ? 1088 + p : -1;
        if (G < 32) return -1;
        if (G < 40) return 800 + 32 * (G - 32) + p;
        if (G < 64) { const int j = G - 40; return 1096 + 64 * (j >> 1) + ((j & 1) ? 32 + p : map_head16(p)); }
        if (G < 88) { const int j = G - 64; return 1096 + 768 + 64 * (j >> 1) + ((j & 1) ? 32 + p : map_head16(p)); }
        return 1096 + 1536 + 32 * (G - 88) + p;
    }
};
struct ColUq {
    __device__ __forceinline__ int operator()(int P) const { const int G = P >> 5, p = P & 31; return 32 * G + ((G % 3 == 2) ? map_rope32(p) : p); }
};
template <class ColFn>
__device__ __forceinline__ void transpose_item(const float* W, int ldw, int kvalid, bf16* WT, int ldt, int k0, int P0, const ColFn& cf, const float* rowscale, LAS float* scr, int lane) {
    const int c = lane & 31, col = cf(P0 + c);
#pragma unroll 8
    for (int i = 0; i < 32; ++i) { const int kk = 2 * i + (lane >> 5), k = k0 + kk; float v = 0.f;
        if (col >= 0 && k < kvalid) { v = W[(size_t)k * ldw + col]; if (rowscale) v *= rowscale[k]; }
        scr[kk * 33 + c] = v; }
    asm volatile("s_waitcnt lgkmcnt(0)" ::: "memory");
    const int cc = lane & 7;
#pragma unroll
    for (int j = 0; j < 4; ++j) { const int n = (lane >> 3) + 8 * j; const LAS float* s = scr + (8 * cc) * 33 + n;
        u32x4 o; o.x = pk2(s[0 * 33], s[1 * 33]); o.y = pk2(s[2 * 33], s[3 * 33]); o.z = pk2(s[4 * 33], s[5 * 33]); o.w = pk2(s[6 * 33], s[7 * 33]);
        *(u32x4*)(WT + (size_t)(P0 + n) * ldt + k0 + 8 * cc) = o; }
    asm volatile("s_waitcnt lgkmcnt(0)" ::: "memory");
}
__device__ __forceinline__ void prologue(const Ctx& X, const CArgs* ap) {
    struct { const float* x; const float *w_in, *qn, *kvn, *w_uq, *w_ukv, *w_o, *rgw, *rew; } a = {ap->x, ap->w_in, ap->qn, ap->kvn, ap->w_uq, ap->w_ukv, ap->w_o, ap->rgw, ap->rew};
    LAS float* scr = (LAS float*)(X.lds + X.wave * 16384);
    const int gw = X.vcu * 8 + X.wave, NGW = X.G * 8;
    constexpr int I_WIN = 16 * 112, I_UQ = 4 * 24, I_UKV = 4 * 32, I_WO = 16 * 32, I_L = I_WIN + I_UQ + I_UKV + I_WO;
    for (int it = gw; it < DEPTH * I_L; it += NGW) {
        const int l = it / I_L; int r = it % I_L;
        if (r < I_WIN) { transpose_item(a.w_in + (size_t)l * DM * IN_COLS, IN_COLS, DM, (bf16*)(X.ws + WS_WIN) + (size_t)l * NIN * DM, DM, 64 * (r / 112), 32 * (r % 112), ColWin{}, nullptr, scr, X.lane); continue; }
        r -= I_WIN;
        if (r < I_UQ) { transpose_item(a.w_uq + (size_t)l * 256 * 768, 768, 256, (bf16*)(X.ws + WS_WUQ) + (size_t)l * 768 * 256, 256, 64 * (r / 24), 32 * (r % 24), ColUq{}, a.qn + l * 256, scr, X.lane); continue; }
        r -= I_UQ;
        if (r < I_UKV) { transpose_item(a.w_ukv + (size_t)l * 128 * 1024, 1024, 128, (bf16*)(X.ws + WS_WUKV) + (size_t)l * 1024 * 256, 256, 64 * (r / 32), 32 * (r % 32), ColAdj{}, a.kvn + l * 128, scr, X.lane); continue; }
        r -= I_UKV;
        transpose_item(a.w_o + (size_t)l * DM * DM, DM, DM, (bf16*)(X.ws + WS_WO) + (size_t)l * DM * DM, DM, 64 * (r / 32), 32 * (r % 32), ColAdj{}, nullptr, scr, X.lane);
    }
    const size_t gt = (size_t)X.vcu * 512 + X.tid, NGT = (size_t)X.G * 512;
    { float* rgt = (float*)(X.ws + WS_RGT); float* ret = (float*)(X.ws + WS_RET);
      for (size_t i = gt; i < (size_t)DEPTH * 4 * DM; i += NGT) { const int l = (int)(i / (4 * DM)), g = (int)(i / DM) & 3, k = (int)(i % DM); rgt[i] = a.rgw[((size_t)l * DM + k) * 4 + g]; }
      for (size_t i = gt; i < (size_t)DEPTH * 32 * DM; i += NGT) { const int l = (int)(i / (32 * DM)), ge = (int)(i / DM) & 31, k = (int)(i % DM); ret[i] = a.rew[(((size_t)l * 4 + (ge >> 3)) * DM + k) * 8 + (ge & 7)]; } }
    { u32x4* z = (u32x4*)(X.ws + WS_T1); for (size_t i = gt; i < (size_t)NT * 256 * 2 / 16; i += NGT) z[i] = (u32x4){0u, 0u, 0u, 0u}; }
    { const f32x4* xs = (const f32x4*)a.x; u32x2* xb = (u32x2*)((unsigned char*)ap->out + XR_OFF);
      for (size_t i = gt; i < (size_t)NT * DM / 4; i += NGT) { const f32x4 v = xs[i]; u32x2 w; w.x = pk2(v[0], v[1]); w.y = pk2(v[2], v[3]); xb[i] = w; } }
}
__device__ __forceinline__ void convert_experts(const Ctx& X, const CArgs* ap, int l) {
    struct { const float *wg, *wu, *wd; } a = {ap->wg, ap->wu, ap->wd};
    LAS float* scr = (LAS float*)(X.lds + X.wave * 16384);
    const int gw = X.vcu * 8 + X.wave, NGW = X.G * 8;
    constexpr int I_GU = 32 * 16 * 16, I_D = 32 * 4 * 32;
    for (int it = gw; it < I_GU + I_D; it += NGW) {
        if (it < I_GU) { const int e = it >> 8, r = it & 255, G32 = r >> 4, kb = r & 15; const int pn = G32 >> 3, r0 = (G32 & 7) * 32; const bool up = r0 >= 128;
            const float* W = (up ? a.wu : a.wg) + ((size_t)l * NEXP + e) * DM * FH;
            transpose_item(W, FH, DM, (bf16*)(X.ws + WS_WGU) + (size_t)e * 512 * DM, DM, 64 * kb, 32 * G32, ColIdent{128 * pn + (r0 & 127) - 32 * G32}, nullptr, scr, X.lane);
        } else { const int r = it - I_GU, e = r >> 7, q = r & 127, kb = q >> 5, pg = q & 31;
            transpose_item(a.wd + ((size_t)l * NEXP + e) * FH * DM, DM, FH, (bf16*)(X.ws + WS_WD) + (size_t)e * DM * FH, FH, 64 * kb, 32 * pg, ColAdj{}, nullptr, scr, X.lane); }
    }
}

struct InProjDesc {
    unsigned char* ws;
    __device__ __forceinline__ pg8::GroupDesc operator()(int pn, int bj, int wc) const {
        using namespace pg8; const int G = 8 * pn + 4 * bj + wc; GroupDesc d; d.kind = GK_PLAIN; d.dst = nullptr; d.pitch = 256; d.col = 0; d.scale = 1.f; d.perm = 0; d.ssq = nullptr; d.ssq_n = 0; d.ssq_i = 0;
        if (G < 8) { d.dst = (bf16*)(ws + WS_CQ); d.col = 32 * G; d.ssq = (float*)(ws + WS_SSQ); d.ssq_n = 8; d.ssq_i = G; }
        else if (G < 12) { d.dst = (bf16*)(ws + WS_T1); d.col = 32 * (G - 8); d.ssq = (float*)(ws + WS_SSQ) + (size_t)NT * 8; d.ssq_n = 4; d.ssq_i = G - 8; }
        else if (G == 12) { d.kind = GK_ROPE32; d.dst = (bf16*)(ws + WS_KPE); d.pitch = 32; d.col = 0; }
        else if (G == 13) { d.kind = GK_IDX8; d.dst = (bf16*)(ws + WS_KI); d.pitch = 32; d.col = 0; }
        else if (G == 14) { d.kind = GK_HEAD16; d.dst = (bf16*)(ws + WS_T1); d.col = 192; }
        else if (G == 15) { d.dst = (bf16*)(ws + WS_T1); d.col = 224; }
        else if (G < 24) { d.kind = ((G - 16) & 1) ? GK_PLAIN : GK_HEAD16; d.dst = (bf16*)(ws + WS_BQ); d.col = 32 * (G - 16); d.scale = QSC64; }
        else if (G < 26) { d.dst = (bf16*)(ws + WS_BV); d.pitch = 64; d.col = 32 * (G - 24); }
        else if (G == 26) { d.kind = GK_WI; d.dst = (bf16*)(ws + WS_WI); }
        else if (G < 32) { d.kind = GK_SKIP; }
        else if (G < 40) { d.kind = GK_IDX8; d.dst = (bf16*)(ws + WS_BQI); d.col = 32 * (G - 32); }
        else if (G < 64) { const int j = G - 40, cfg = j >> 3; d.kind = (j & 1) ? GK_PLAIN : GK_HEAD16; d.dst = (bf16*)(ws + WS_DQ) + (size_t)cfg * NT * 256; d.col = 32 * (j & 7); d.scale = QSC64; d.perm = cfg == 0 ? 0 : (cfg == 1 ? 4 : 16); }
        else if (G < 88) { const int j = G - 64, cfg = j >> 3; d.kind = (j & 1) ? GK_PLAIN : GK_HEAD16; d.dst = (bf16*)(ws + WS_DK) + (size_t)cfg * NT * 256; d.col = 32 * (j & 7); d.perm = cfg == 0 ? 0 : (cfg == 1 ? 4 : 16); }
        else { const int j = G - 88, cfg = j >> 3; d.dst = (bf16*)(ws + WS_DV) + (size_t)cfg * NT * 256; d.col = 32 * (j & 7); d.perm = cfg == 0 ? 0 : (cfg == 1 ? 4 : 16); }
        return d;
    }
};
struct UqDesc {
    unsigned char* ws;
    __device__ __forceinline__ pg8::GroupDesc operator()(int pn, int bj, int wc) const {
        using namespace pg8; const int G = 8 * pn + 4 * bj + wc; GroupDesc d; d.kind = (G % 3 == 2) ? GK_ROPE32 : GK_PLAIN; d.dst = (bf16*)(ws + WS_QA); d.pitch = 768; d.col = 32 * G; d.scale = QSC96; d.perm = 0; d.ssq = nullptr; d.ssq_n = 0; d.ssq_i = 0;
        return d;
    }
};

__device__ __forceinline__ unsigned f16key(float v) { const _Float16 hf = (_Float16)v; const unsigned u = (unsigned)__builtin_bit_cast(unsigned short, hf); return (u ^ ((unsigned)__builtin_amdgcn_sbfe((int)u, 15, 1) | 0x8000u)) & 0xffffu; }
__device__ __forceinline__ unsigned pk_cnt(unsigned acc, unsigned kp2, unsigned mid2, unsigned one2) {
    unsigned t;
    asm("v_pk_sub_u16 %0, %2, %3 clamp\n\tv_pk_min_u16 %0, %0, %4\n\tv_pk_add_u16 %1, %1, %0" : "=&v"(t), "+v"(acc) : "v"(kp2), "s"(mid2), "s"(one2));
    return acc;
}
__device__ __forceinline__ int count_gt(const unsigned (&kp)[16], unsigned mid) {
    const unsigned m2 = __builtin_amdgcn_readfirstlane(mid | (mid << 16)), one2 = __builtin_amdgcn_readfirstlane(0x00010001u);
    unsigned a0 = 0u, a1 = 0u;
#pragma unroll
    for (int i = 0; i < 16; i += 2) { a0 = pk_cnt(a0, kp[i], m2, one2); a1 = pk_cnt(a1, kp[i + 1], m2, one2); }
    unsigned aw; asm("v_pk_add_u16 %0, %1, %2" : "=v"(aw) : "v"(a0), "v"(a1));
    const unsigned c = (aw & 0xffffu) + (aw >> 16);
    int tot = 0;
#pragma unroll
    for (int b = 0; b < 6; ++b) tot += __builtin_popcountll(__ballot((c >> b) & 1u)) << b;
    return tot;
}
__device__ __forceinline__ int wave_scan_incl(int v) {
    v += __builtin_amdgcn_update_dpp(0, v, 0x111, 0xf, 0xf, false); v += __builtin_amdgcn_update_dpp(0, v, 0x112, 0xf, 0xf, false);
    v += __builtin_amdgcn_update_dpp(0, v, 0x114, 0xf, 0xf, false); v += __builtin_amdgcn_update_dpp(0, v, 0x118, 0xf, 0xf, false);
    v += __builtin_amdgcn_update_dpp(0, v, 0x142, 0xa, 0xf, false); v += __builtin_amdgcn_update_dpp(0, v, 0x143, 0xc, 0xf, false);
    return v;
}
__device__ __forceinline__ void radix_pick(const LAS unsigned* hist, int lane, int target, int& B, int& above, int& inbin) {
    const u32x2 hw = *(const LAS u32x2*)(hist + 2 * lane);
    const int c0 = (int)(hw.x & 0xffffu), c1 = (int)(hw.x >> 16), c2 = (int)(hw.y & 0xffffu), c3 = (int)(hw.y >> 16);
    const int tl = (c0 + c1) + (c2 + c3);
    const int pre = wave_scan_incl(tl);
    const int suf = __builtin_amdgcn_readlane(pre, 63) - pre + tl;
    const unsigned long long reach = __ballot(suf >= target);
    const int ls = 63 - __builtin_clzll(reach | 1ull);
    int a = suf - tl, b = 4 * lane + 3, ib = c3;
    if (a + c3 < target) { a += c3; b = 4 * lane + 2; ib = c2; if (a + c2 < target) { a += c2; b = 4 * lane + 1; ib = c1; if (a + c1 < target) { a += c1; b = 4 * lane; ib = c0; } } }
    B = __builtin_amdgcn_readlane(b, ls); above = __builtin_amdgcn_readlane(a, ls); inbin = __builtin_amdgcn_readlane(ib, ls);
}
__device__ __forceinline__ float relu_i(float x) { const int i = __builtin_bit_cast(int, x); return __builtin_bit_cast(float, i > 0 ? i : 0); }
__device__ __forceinline__ void dsa_index_unit(const Ctx& X, int b, int q0) {
    const int lane = X.lane, r = lane & 31, h = lane >> 5; const size_t seq0 = (size_t)b * SEQ; const int t0 = q0 + 4 * X.wave;
    const bf16* BQI = (const bf16*)(X.ws + WS_BQI); const bf16* KI = (const bf16*)(X.ws + WS_KI); const float* WI = (const float*)(X.ws + WS_WI);
    LAS unsigned short* rows = (LAS unsigned short*)(X.lds + X.wave * 16384);
    LAS unsigned char* kbuf = X.lds + LDS_X_OFF;
    const bf16* ap = BQI + (seq0 + t0 + (r >> 3)) * 256 + 32 * (r & 7) + 16 * h;
    const bf16x8 a0 = *(const bf16x8*)ap, a1 = *(const bf16x8*)(ap + 8);
    f32x2 wq[4][2];
#pragma unroll
    for (int j = 0; j < 4; ++j) { const f32x4 w = *(const f32x4*)(WI + (seq0 + t0 + j) * 8 + 4 * h);
        wq[j][0] = (f32x2){w[0] * IDX_SCALE, w[1] * IDX_SCALE}; wq[j][1] = (f32x2){w[2] * IDX_SCALE, w[3] * IDX_SCALE}; }
    const int nch = ((q0 + 31) >> 7) + 1;
    const int skey = X.tid >> 2, spc = X.tid & 3;
    const bf16* sp = KI + (seq0 + skey) * 32 + 8 * spc;
    const int sdst = skey * 64 + ((spc ^ ((skey >> 2) & 3)) << 4);
    u32x4 stg0 = *(const u32x4*)sp, stg1 = stg0, stg2 = stg0, stg3 = stg0;
    if (1 < nch) stg1 = *(const u32x4*)(sp + (size_t)1 * 128 * 32);
    if (2 < nch) stg2 = *(const u32x4*)(sp + (size_t)2 * 128 * 32);
    if (3 < nch) stg3 = *(const u32x4*)(sp + (size_t)3 * 128 * 32);
    *(LAS u32x4*)(kbuf + sdst) = stg0;
    __syncthreads();
#define DSA_STEP(J, RCUR, RNEXT) { const int c = c0 + (J); \
        if (c + 4 < nch) RCUR = *(const u32x4*)(sp + (size_t)(c + 4) * 128 * 32); \
        const LAS unsigned char* kb = kbuf + (c & 1) * 8192; \
        f32x16 accq[4];        \
        _Pragma("unroll") for (int tq = 0; tq < 4; ++tq) { \
            const int key = 32 * tq + r, sw = (key >> 2) & 3; \
            const bf16x8 b0 = *(const LAS bf16x8*)(kb + key * 64 + (((2 * h) ^ sw) << 4)), b1 = *(const LAS bf16x8*)(kb + key * 64 + (((2 * h + 1) ^ sw) << 4)); \
            _Pragma("unroll") for (int i = 0; i < 16; ++i) accq[tq][i] = 0.f; \
            accq[tq] = __builtin_amdgcn_mfma_f32_32x32x16_bf16(a0, b0, accq[tq], 0, 0, 0); \
            accq[tq] = __builtin_amdgcn_mfma_f32_32x32x16_bf16(a1, b1, accq[tq], 0, 0, 0); } \
        __builtin_amdgcn_sched_barrier(0); \
        _Pragma("unroll") for (int tq = 0; tq < 4; ++tq) { const f32x16& acc = accq[tq]; \
            float p[4]; \
            _Pragma("unroll") for (int j = 0; j < 4; ++j) {            \
                const f32x2 ra = {relu_i(acc[4 * j]), relu_i(acc[4 * j + 1])}, rb = {relu_i(acc[4 * j + 2]), relu_i(acc[4 * j + 3])}; \
                const f32x2 pp = __builtin_elementwise_fma(rb, wq[j][1], ra * wq[j][0]); \
                p[j] = pp.x + pp.y; } \
            const auto s01 = __builtin_amdgcn_permlane32_swap(__float_as_uint(p[0]), __float_as_uint(p[1]), false, false); \
            const auto s23 = __builtin_amdgcn_permlane32_swap(__float_as_uint(p[2]), __float_as_uint(p[3]), false, false); \
            const float va = __uint_as_float(s01[0]) + __uint_as_float(s01[1]), vb = __uint_as_float(s23[0]) + __uint_as_float(s23[1]); \
            const int hw = 128 * c + 32 * tq + r;                                      \
            rows[h * 2048 + hw] = (unsigned short)f16key(va); \
            rows[(2 + h) * 2048 + hw] = (unsigned short)f16key(vb); \
        } \
        if (c + 1 < nch) *(LAS u32x4*)(kbuf + ((c + 1) & 1) * 8192 + sdst) = RNEXT; \
        __syncthreads(); }
#ifndef REP_SCORE
#define REP_SCORE 1
#endif
#ifndef REP_SEL
#define REP_SEL 1
#endif
    for (int rsc = 0; rsc < REP_SCORE; ++rsc) {
    if (rsc > 0) { stg0 = *(const u32x4*)sp; stg1 = stg0; stg2 = stg0; stg3 = stg0; if (1 < nch) stg1 = *(const u32x4*)(sp + (size_t)1 * 128 * 32); if (2 < nch) stg2 = *(const u32x4*)(sp + (size_t)2 * 128 * 32); if (3 < nch) stg3 = *(const u32x4*)(sp + (size_t)3 * 128 * 32); *(LAS u32x4*)(kbuf + sdst) = stg0; __syncthreads(); }
    for (int c0 = 0; c0 < nch; c0 += 4) {
        DSA_STEP(0, stg0, stg1)
        if (c0 + 1 >= nch) break;
        DSA_STEP(1, stg1, stg2)
        if (c0 + 2 >= nch) break;
        DSA_STEP(2, stg2, stg3)
        if (c0 + 3 >= nch) break;
        DSA_STEP(3, stg3, stg0)
    }
    }
#undef DSA_STEP
    unsigned* BMp = (unsigned*)(X.ws + WS_BM);
#ifndef REP_BIS
#define REP_BIS 1
#endif
#ifndef REP_EMIT
#define REP_EMIT 1
#endif
    for (int rsl = 0; rsl < REP_SEL; ++rsl)
    for (int j = 0; j < 4; ++j) {
        const int t = t0 + j;
        const LAS u32x4* rw = (const LAS u32x4*)(rows + j * 2048) + 4 * lane;
        unsigned kp[16];
#pragma unroll
        for (int v4 = 0; v4 < 4; ++v4) { const u32x4 d = rw[v4]; kp[4 * v4] = d.x; kp[4 * v4 + 1] = d.y; kp[4 * v4 + 2] = d.z; kp[4 * v4 + 3] = d.w; }
        const int nv = t + 1 - 32 * lane;
#pragma unroll
        for (int d = 0; d < 16; ++d) kp[d] &= ((2 * d < nv) ? 0xffffu : 0u) | ((2 * d + 1 < nv) ? 0xffff0000u : 0u);
        unsigned thr = 0u; int need = 0;
        for (int rb_ = 0; rb_ < REP_BIS; ++rb_)
        if (t + 1 > 256) {
            LAS unsigned* hist = (LAS unsigned*)(X.lds + LDS_HIST_OFF + X.wave * 512);
            *(LAS u32x2*)(hist + 2 * lane) = (u32x2){0u, 0u};
#pragma unroll
            for (int d = 0; d < 16; ++d) { const unsigned klo = kp[d] & 0xffffu, khi = kp[d] >> 16;
                if (klo) __hip_atomic_fetch_add(hist + (klo >> 9), (klo & 0x100u) ? 0x10000u : 1u, __ATOMIC_RELAXED, __HIP_MEMORY_SCOPE_WORKGROUP);
                if (khi) __hip_atomic_fetch_add(hist + (khi >> 9), (khi & 0x100u) ? 0x10000u : 1u, __ATOMIC_RELAXED, __HIP_MEMORY_SCOPE_WORKGROUP); }
            int B1, above1, in1; radix_pick(hist, lane, 256, B1, above1, in1);
            *(LAS u32x2*)(hist + 2 * lane) = (u32x2){0u, 0u};
#pragma unroll
            for (int d = 0; d < 16; ++d) { const unsigned klo = kp[d] & 0xffffu, khi = kp[d] >> 16;
                if ((int)(klo >> 8) == B1) __hip_atomic_fetch_add(hist + ((klo & 0xffu) >> 1), (klo & 1u) ? 0x10000u : 1u, __ATOMIC_RELAXED, __HIP_MEMORY_SCOPE_WORKGROUP);
                if ((int)(khi >> 8) == B1) __hip_atomic_fetch_add(hist + ((khi & 0xffu) >> 1), (khi & 1u) ? 0x10000u : 1u, __ATOMIC_RELAXED, __HIP_MEMORY_SCOPE_WORKGROUP); }
            int B2, above2, in2; radix_pick(hist, lane, 256 - above1, B2, above2, in2);
            const unsigned tk = ((unsigned)B1 << 8) | (unsigned)B2;
            const int rest = 256 - (above1 + above2);
            if (rest >= in2) { thr = tk - 1u; need = 0; } else { thr = tk; need = rest; }
        }
        unsigned word = 0u, eqw = 0u;
        const unsigned thr2 = __builtin_amdgcn_readfirstlane(thr | (thr << 16)), one2 = __builtin_amdgcn_readfirstlane(0x00010001u);
#pragma unroll
        for (int d = 0; d < 16; ++d) { unsigned g;
            asm("v_pk_sub_u16 %0, %1, %2 clamp\n\tv_pk_min_u16 %0, %0, %3" : "=&v"(g) : "v"(kp[d]), "s"(thr2), "s"(one2));
            word |= ((g | (g >> 15)) & 3u) << (2 * d); }
        if (need > 0) {
#pragma unroll
            for (int d = 0; d < 16; ++d) { unsigned g; const unsigned x = kp[d] ^ thr2;
                asm("v_pk_min_u16 %0, %1, %2" : "=v"(g) : "v"(x), "s"(one2));
                eqw |= ((~(g | (g >> 15))) & 3u) << (2 * d); }
            if (thr == 0u) eqw = 0u;
            const int ne = __builtin_popcount(eqw); const int inc = wave_scan_incl(ne);
            int take = need - (inc - ne); take = take < 0 ? 0 : (take > ne ? ne : take);
            while (__any(take > 0)) { if (take > 0) { const unsigned lowbit = eqw & (0u - eqw); word |= lowbit; eqw ^= lowbit; --take; } }
        }
        BMp[(seq0 + t) * 64 + lane] = word;
    }
}

__device__ __forceinline__ void dil_combine(const Ctx& X) {
    const bf16* OD = (const bf16*)(X.ws + WS_OD); const float* LS = (const float*)(X.ws + WS_LSE); bf16* O = (bf16*)(X.ws + WS_XB);
    const int gw = X.vcu * 8 + X.wave, NGW = X.G * 8, lane = X.lane, hh = lane >> 4;
    for (int t = gw; t < NT; t += NGW) {
        const int b = t >> 11, s = t & 2047;
        const int r0 = t, r1 = (b << 11) + ((s & 3) << 9) + (s >> 2), r2 = (b << 11) + ((s & 15) << 7) + (s >> 4);
        const float L0 = LS[(size_t)r0 * 4 + hh], L1 = LS[((size_t)NT + r1) * 4 + hh], L2 = LS[((size_t)2 * NT + r2) * 4 + hh];
        const float mx = fmaxf(L0, fmaxf(L1, L2));
        float w0 = __builtin_amdgcn_exp2f(L0 - mx), w1 = __builtin_amdgcn_exp2f(L1 - mx), w2 = __builtin_amdgcn_exp2f(L2 - mx);
        const float inv = 1.0f / (w0 + w1 + w2); w0 *= inv; w1 *= inv; w2 *= inv;
        const u32x2 a = *(const u32x2*)(OD + (size_t)r0 * 256 + 4 * lane), bq = *(const u32x2*)(OD + ((size_t)NT + r1) * 256 + 4 * lane), cq = *(const u32x2*)(OD + ((size_t)2 * NT + r2) * 256 + 4 * lane);
        u32x2 o;
        o.x = pk2(w0 * bflo(a.x) + w1 * bflo(bq.x) + w2 * bflo(cq.x), w0 * bfhi(a.x) + w1 * bfhi(bq.x) + w2 * bfhi(cq.x));
        o.y = pk2(w0 * bflo(a.y) + w1 * bflo(bq.y) + w2 * bflo(cq.y), w0 * bfhi(a.y) + w1 * bfhi(bq.y) + w2 * bfhi(cq.y));
        stg8<NT_ATT>(O + (size_t)t * DM + 768 + 4 * lane, o);
    }
}

__device__ __forceinline__ void ln1_router(const Ctx& X, const CArgs* ap, int l, bool first, bool dummy = false) {
    struct { const float *ln1g, *ln1b, *rgb, *reb; } a = {ap->ln1g, ap->ln1b, ap->rgb, ap->reb}; (void)first;
    const bf16* xin = (const bf16*)((const unsigned char*)ap->out + XR_OFF);
    const bool keep_copy = !LN2_X1B && (l == DEPTH - 1) && !dummy; bf16* XC = (bf16*)(X.ws + WS_KVA);
    const int lane = X.lane; const bf16* MIX = (const bf16*)(X.ws + WS_MIX); bf16* X1B = (bf16*)(X.ws + (dummy ? WS_Y : WS_XB));
    LAS float* reT = (LAS float*)X.lds;
    LAS float* rgT = (LAS float*)(X.lds + LDS_X_OFF);
    LAS int* hist = (LAS int*)(X.lds + LDSCTL_OFF + 256);
    { const u32x4* s1 = (const u32x4*)(X.ws + WS_RET + (size_t)l * 32 * DM * 4); for (int i = X.tid; i < 32 * DM / 4; i += 512) ((LAS u32x4*)reT)[i] = s1[i];
      const u32x4* s2 = (const u32x4*)(X.ws + WS_RGT + (size_t)l * 4 * DM * 4); for (int i = X.tid; i < 4 * DM / 4; i += 512) ((LAS u32x4*)rgT)[i] = s2[i]; }
    f32x4 g[4], bb[4];
#pragma unroll
    for (int j = 0; j < 4; ++j) { g[j] = *(const f32x4*)(a.ln1g + l * DM + 4 * lane + 256 * j); bb[j] = *(const f32x4*)(a.ln1b + l * DM + 4 * lane + 256 * j); }
    const float* rgb = a.rgb + l * 4; const float* reb = a.reb + l * 32;
    for (int rb = X.c; rb < NT / 256; rb += X.G) {
        if (X.tid < 32) hist[X.tid] = 0;
        __syncthreads();
        u32x2 xa[4], xb[4]; u32x2 ma[4], mb[4];
        { const int t = rb * 256 + X.wave * 32;
#pragma unroll
          for (int j = 0; j < 4; ++j) { xa[j] = *(const u32x2*)(xin + (size_t)t * DM + 4 * lane + 256 * j); ma[j] = *(const u32x2*)(MIX + (size_t)t * DM + 4 * lane + 256 * j); }
#pragma unroll
          for (int j = 0; j < 4; ++j) { xb[j] = *(const u32x2*)(xin + (size_t)(t + 1) * DM + 4 * lane + 256 * j); mb[j] = *(const u32x2*)(MIX + (size_t)(t + 1) * DM + 4 * lane + 256 * j); } }
        auto row = [&](u32x2 (&xn)[4], u32x2 (&mn)[4], const int i) __attribute__((always_inline)) {
            const int t = rb * 256 + X.wave * 32 + i;
            f32x4 v[4]; float s = 0.f;
#pragma unroll
            for (int j = 0; j < 4; ++j) { const u32x2 xw = xn[j]; const u32x2 mw = mn[j];
                if (keep_copy) *(u32x2*)(XC + (size_t)t * DM + 4 * lane + 256 * j) = xw;
                v[j][0] = ALPHA * bflo(xw.x) + bflo(mw.x); v[j][1] = ALPHA * bfhi(xw.x) + bfhi(mw.x); v[j][2] = ALPHA * bflo(xw.y) + bflo(mw.y); v[j][3] = ALPHA * bfhi(xw.y) + bfhi(mw.y);
                s += (v[j][0] + v[j][1]) + (v[j][2] + v[j][3]); }
            if (i + 2 < 32) {
#pragma unroll
                for (int j = 0; j < 4; ++j) { xn[j] = *(const u32x2*)(xin + (size_t)(t + 2) * DM + 4 * lane + 256 * j); mn[j] = *(const u32x2*)(MIX + (size_t)(t + 2) * DM + 4 * lane + 256 * j); } }
            const float mean = wave_sum(s) * (1.f / DM); float s2 = 0.f;
#pragma unroll
            for (int j = 0; j < 4; ++j) { v[j] = v[j] - mean; s2 += (v[j][0] * v[j][0] + v[j][1] * v[j][1]) + (v[j][2] * v[j][2] + v[j][3] * v[j][3]); }
            const float rstd = 1.0f / sqrtf(wave_sum(s2) * (1.f / DM) + 1e-5f);
#pragma unroll
            for (int j = 0; j < 4; ++j) { v[j] = v[j] * rstd * g[j] + bb[j];
                u32x2 w; w.x = pk2(v[j][0], v[j][1]); w.y = pk2(v[j][2], v[j][3]); stg8<NT_LN>(X1B + (size_t)t * DM + 4 * lane + 256 * j, w); }
            float lg[4];
            { f32x2 pa[4], pb[4];
#pragma unroll
              for (int gi = 0; gi < 4; ++gi) { pa[gi] = (f32x2){0.f, 0.f}; pb[gi] = (f32x2){0.f, 0.f}; }
#pragma unroll
              for (int j = 0; j < 4; ++j) { const f32x2 vxy = {v[j][0], v[j][1]}, vzw = {v[j][2], v[j][3]};
#pragma unroll
                  for (int gi = 0; gi < 4; ++gi) { const f32x4 w = *(const LAS f32x4*)(rgT + gi * DM + 4 * lane + 256 * j);
                      pa[gi] = __builtin_elementwise_fma(vxy, (f32x2){w[0], w[1]}, pa[gi]); pb[gi] = __builtin_elementwise_fma(vzw, (f32x2){w[2], w[3]}, pb[gi]); } }
#pragma unroll
              for (int gi = 0; gi < 4; ++gi) { const f32x2 q = pa[gi] + pb[gi]; lg[gi] = q.x + q.y; }
              wave_sum_n<4>(lg);
#pragma unroll
              for (int gi = 0; gi < 4; ++gi) lg[gi] += rgb[gi]; }
            int gs = 0; float gm = lg[0];
#pragma unroll
            for (int gi = 1; gi < 4; ++gi) if (lg[gi] > gm) { gm = lg[gi]; gs = gi; }
            float den = 0.f;
#pragma unroll
            for (int gi = 0; gi < 4; ++gi) den += __expf(lg[gi] - gm);
            const float ptop = __builtin_amdgcn_rcpf(den);
            gs = __builtin_amdgcn_readfirstlane(gs);
            float le[8];
            { f32x2 pa[8], pb[8]; const LAS float* reG = reT + gs * 8 * DM + 4 * lane;
#pragma unroll
              for (int e = 0; e < 8; ++e) { pa[e] = (f32x2){0.f, 0.f}; pb[e] = (f32x2){0.f, 0.f}; }
#pragma unroll
              for (int j = 0; j < 4; ++j) { const f32x2 vxy = {v[j][0], v[j][1]}, vzw = {v[j][2], v[j][3]};
#pragma unroll
                  for (int e = 0; e < 8; ++e) { const f32x4 w = *(const LAS f32x4*)(reG + e * DM + 256 * j);
                      pa[e] = __builtin_elementwise_fma(vxy, (f32x2){w[0], w[1]}, pa[e]); pb[e] = __builtin_elementwise_fma(vzw, (f32x2){w[2], w[3]}, pb[e]); } }
#pragma unroll
              for (int e = 0; e < 8; ++e) { const f32x2 q = pa[e] + pb[e]; le[e] = q.x + q.y; }
              wave_sum_n<8>(le);
#pragma unroll
              for (int e = 0; e < 8; ++e) le[e] += reb[gs * 8 + e]; }
            int e1 = 0; float v1 = le[0];
#pragma unroll
            for (int e = 1; e < 8; ++e) if (le[e] > v1) { v1 = le[e]; e1 = e; }
            int e2 = -1; float v2 = -INFINITY;
#pragma unroll
            for (int e = 0; e < 8; ++e) if (e != e1 && le[e] > v2) { v2 = le[e]; e2 = e; }
            const float wa = __builtin_amdgcn_rcpf(1.0f + __expf(v2 - v1)), wb = 1.0f - wa;
            if (lane == 0) { u32x4 ro; ro.x = (unsigned)(gs * 8 + e1); ro.y = (unsigned)(gs * 8 + e2); ro.z = __builtin_bit_cast(unsigned, ptop * wa); ro.w = __builtin_bit_cast(unsigned, ptop * wb);
                *(u32x4*)(X.ws + WS_ROUTE + (size_t)t * 16) = ro;
                __hip_atomic_fetch_add(hist + gs * 8 + e1, 1, __ATOMIC_RELAXED, __HIP_MEMORY_SCOPE_WORKGROUP); __hip_atomic_fetch_add(hist + gs * 8 + e2, 1, __ATOMIC_RELAXED, __HIP_MEMORY_SCOPE_WORKGROUP); }
        };
#pragma unroll 1
        for (int i = 0; i < 32; i += 2) { row(xa, ma, i); row(xb, mb, i + 1); }
        __syncthreads();
        if (X.tid < 32) ((int*)(X.ws + WS_HIST))[rb * 32 + X.tid] = hist[X.tid];
        __syncthreads();
    }
}

__device__ __forceinline__ void ln1_router_mfma(const Ctx& X, const CArgs* ap, int l, bool dummy = false) {
    struct { const float *ln1g, *ln1b, *rgb, *reb; } a = {ap->ln1g, ap->ln1b, ap->rgb, ap->reb};
    const bf16* xin = (const bf16*)((const unsigned char*)ap->out + XR_OFF);
    const int lane = X.lane, jr = lane & 31, hh = lane >> 5; const bf16* MIX = (const bf16*)(X.ws + WS_MIX); bf16* X1B = (bf16*)(X.ws + (dummy ? WS_Y : WS_XB));
    constexpr int WP = 1032;
    LAS bf16* wr = (LAS bf16*)X.lds;
    LAS float* rbias = (LAS float*)(X.lds + 40 * WP * 2);
    LAS int* hist = (LAS int*)(X.lds + LDSCTL_OFF + 256);
    { const float* ret = (const float*)(X.ws + WS_RET) + (size_t)l * 32 * DM; const float* rgt = (const float*)(X.ws + WS_RGT) + (size_t)l * 4 * DM;
      for (int i = X.tid; i < 40 * 256; i += 512) { const int row = i >> 8, c4 = i & 255; f32x4 w = {0.f, 0.f, 0.f, 0.f};
          if (row < 32) w = *(const f32x4*)(ret + (size_t)row * DM + 4 * c4); else if (row < 36) w = *(const f32x4*)(rgt + (size_t)(row - 32) * DM + 4 * c4);
          u32x2 p; p.x = pk2(w[0], w[1]); p.y = pk2(w[2], w[3]); *(LAS u32x2*)(wr + row * WP + 4 * c4) = p; }
      if (X.tid < 32) rbias[X.tid] = a.reb[l * 32 + X.tid]; else if (X.tid < 36) rbias[X.tid] = a.rgb[l * 4 + X.tid - 32]; }
    f32x4 g[4], bb[4];
#pragma unroll
    for (int j = 0; j < 4; ++j) { g[j] = *(const f32x4*)(a.ln1g + l * DM + 4 * lane + 256 * j); bb[j] = *(const f32x4*)(a.ln1b + l * DM + 4 * lane + 256 * j); }
    for (int rb = X.c; rb < NT / 256; rb += X.G) {
        if (X.tid < 32) hist[X.tid] = 0;
        __syncthreads();
        const int tw = rb * 256 + X.wave * 32;
        u32x2 xa[4], xb[4]; u32x2 ma[4], mb[4];
#pragma unroll
        for (int j = 0; j < 4; ++j) { xa[j] = *(const u32x2*)(xin + (size_t)tw * DM + 4 * lane + 256 * j); ma[j] = *(const u32x2*)(MIX + (size_t)tw * DM + 4 * lane + 256 * j); }
#pragma unroll
        for (int j = 0; j < 4; ++j) { xb[j] = *(const u32x2*)(xin + (size_t)(tw + 1) * DM + 4 * lane + 256 * j); mb[j] = *(const u32x2*)(MIX + (size_t)(tw + 1) * DM + 4 * lane + 256 * j); }
        auto row = [&](u32x2 (&xn)[4], u32x2 (&mn)[4], const int i) __attribute__((always_inline)) {
            const int t = tw + i;
            f32x4 v[4]; float s = 0.f;
#pragma unroll
            for (int j = 0; j < 4; ++j) { const u32x2 xw = xn[j]; const u32x2 mw = mn[j];
                v[j][0] = ALPHA * bflo(xw.x) + bflo(mw.x); v[j][1] = ALPHA * bfhi(xw.x) + bfhi(mw.x); v[j][2] = ALPHA * bflo(xw.y) + bflo(mw.y); v[j][3] = ALPHA * bfhi(xw.y) + bfhi(mw.y);
                s += (v[j][0] + v[j][1]) + (v[j][2] + v[j][3]); }
            if (i + 2 < 32) {
#pragma unroll
                for (int j = 0; j < 4; ++j) { xn[j] = *(const u32x2*)(xin + (size_t)(t + 2) * DM + 4 * lane + 256 * j); mn[j] = *(const u32x2*)(MIX + (size_t)(t + 2) * DM + 4 * lane + 256 * j); } }
            const float mean = wave_sum(s) * (1.f / DM); float s2 = 0.f;
#pragma unroll
            for (int j = 0; j < 4; ++j) { v[j] = v[j] - mean; s2 += (v[j][0] * v[j][0] + v[j][1] * v[j][1]) + (v[j][2] * v[j][2] + v[j][3] * v[j][3]); }
            const float rstd = __builtin_amdgcn_rsqf(wave_sum(s2) * (1.f / DM) + 1e-5f);
#pragma unroll
            for (int j = 0; j < 4; ++j) { v[j] = v[j] * rstd * g[j] + bb[j];
                u32x2 w; w.x = pk2(v[j][0], v[j][1]); w.y = pk2(v[j][2], v[j][3]); stg8<NT_LN>(X1B + (size_t)t * DM + 4 * lane + 256 * j, w); }
        };
#pragma unroll 1
        for (int i = 0; i < 32; i += 2) { row(xa, ma, i); row(xb, mb, i + 1); }
        asm volatile("s_waitcnt vmcnt(0)" ::: "memory");
        f32x16 acc0, acc1;
#pragma unroll
        for (int i = 0; i < 16; ++i) { acc0[i] = 0.f; acc1[i] = 0.f; }
        const bf16* bp = X1B + (size_t)(tw + jr) * DM + 16 * hh;
        const LAS bf16* a0p = wr + jr * WP + 16 * hh; const LAS bf16* a1p = wr + (32 + (jr < 8 ? jr : 7)) * WP + 16 * hh;
#pragma unroll 4
        for (int t2 = 0; t2 < 32; ++t2) {
            const bf16x8 b0 = *(const bf16x8*)(bp + 32 * t2), b1 = *(const bf16x8*)(bp + 32 * t2 + 8);
            const bf16x8 a00 = *(const LAS bf16x8*)(a0p + 32 * t2), a01 = *(const LAS bf16x8*)(a0p + 32 * t2 + 8), a10 = *(const LAS bf16x8*)(a1p + 32 * t2), a11 = *(const LAS bf16x8*)(a1p + 32 * t2 + 8);
            acc0 = __builtin_amdgcn_mfma_f32_32x32x16_bf16(a00, b0, acc0, 0, 0, 0); acc1 = __builtin_amdgcn_mfma_f32_32x32x16_bf16(a10, b0, acc1, 0, 0, 0);
            acc0 = __builtin_amdgcn_mfma_f32_32x32x16_bf16(a01, b1, acc0, 0, 0, 0); acc1 = __builtin_amdgcn_mfma_f32_32x32x16_bf16(a11, b1, acc1, 0, 0, 0);
        }
        float gl[4];
#pragma unroll
        for (int i = 0; i < 4; ++i) { const auto tt = __builtin_amdgcn_permlane32_swap(__float_as_uint(acc1[i]), __float_as_uint(acc1[i]), false, false); gl[i] = __uint_as_float(tt[0]) + rbias[32 + i]; }
        int gs = 0; float gm = gl[0];
#pragma unroll
        for (int gi = 1; gi < 4; ++gi) if (gl[gi] > gm) { gm = gl[gi]; gs = gi; }
        float den = 0.f;
#pragma unroll
        for (int gi = 0; gi < 4; ++gi) den += __expf(gl[gi] - gm);
        const float ptop = __builtin_amdgcn_rcpf(den);
        float le[8];
#pragma unroll
        for (int k = 0; k < 4; ++k) { const float mine = gs == 0 ? acc0[k] : (gs == 1 ? acc0[4 + k] : (gs == 2 ? acc0[8 + k] : acc0[12 + k]));
            const auto tt = __builtin_amdgcn_permlane32_swap(__float_as_uint(mine), __float_as_uint(mine), false, false);
            le[k] = __uint_as_float(tt[0]); le[4 + k] = __uint_as_float(tt[1]); }
#pragma unroll
        for (int e = 0; e < 8; ++e) le[e] += rbias[gs * 8 + e];
        int e1 = 0; float v1 = le[0];
#pragma unroll
        for (int e = 1; e < 8; ++e) if (le[e] > v1) { v1 = le[e]; e1 = e; }
        int e2 = -1; float v2 = -INFINITY;
#pragma unroll
        for (int e = 0; e < 8; ++e) if (e != e1 && le[e] > v2) { v2 = le[e]; e2 = e; }
        const float wa = __builtin_amdgcn_rcpf(1.0f + __expf(v2 - v1)), wb = 1.0f - wa;
        if (hh == 0) { u32x4 ro; ro.x = (unsigned)(gs * 8 + e1); ro.y = (unsigned)(gs * 8 + e2); ro.z = __builtin_bit_cast(unsigned, ptop * wa); ro.w = __builtin_bit_cast(unsigned, ptop * wb);
            *(u32x4*)(X.ws + WS_ROUTE + (size_t)(tw + jr) * 16) = ro;
            __hip_atomic_fetch_add(hist + gs * 8 + e1, 1, __ATOMIC_RELAXED, __HIP_MEMORY_SCOPE_WORKGROUP); __hip_atomic_fetch_add(hist + gs * 8 + e2, 1, __ATOMIC_RELAXED, __HIP_MEMORY_SCOPE_WORKGROUP); }
        __syncthreads();
        if (X.tid < 32) ((int*)(X.ws + WS_HIST))[rb * 32 + X.tid] = hist[X.tid];
        __syncthreads();
    }
}

__device__ __forceinline__ void moe_dispatch(const Ctx& X) {
    LAS int* cnt = (LAS int*)(X.lds);
    LAS int* pre = cnt + 32;
    LAS int* ebase = cnt + 64;
    LAS int* wcnt = cnt + 128;
    const int* HIST = (const int*)(X.ws + WS_HIST); int* STOK = (int*)(X.ws + WS_STOK); float* SW = (float*)(X.ws + WS_SW); int* TSLOT = (int*)(X.ws + WS_TSLOT); int* TILEE = (int*)(X.ws + WS_TILEE);
    for (int rb = X.c; rb < NT / 256; rb += X.G) {
        if (X.tid < 64) cnt[X.tid] = 0;
        __syncthreads();
        { const int e = X.tid & 31, part = X.tid >> 5; int sa = 0, sp = 0;
          for (int q = 0; q < 16; ++q) { const int b2 = part * 16 + q; const int hv = HIST[b2 * 32 + e]; sa += hv; if (b2 < rb) sp += hv; }
          __hip_atomic_fetch_add(cnt + e, sa, __ATOMIC_RELAXED, __HIP_MEMORY_SCOPE_WORKGROUP); __hip_atomic_fetch_add(pre + e, sp, __ATOMIC_RELAXED, __HIP_MEMORY_SCOPE_WORKGROUP); }
        __syncthreads();
        if (X.tid < 64) { const int n = X.tid < 32 ? cnt[X.tid] : 0; const int pad = (n + 255) & ~255; int inc = pad;
#pragma unroll
            for (int o = 1; o < 32; o <<= 1) { const int u = __shfl_up(inc, o); if ((X.tid & 63) >= o) inc += u; }
            if (X.tid < 32) { ebase[X.tid] = inc - pad; if (X.tid == 31) ebase[32] = inc; } }
        __syncthreads();
        const int tl = X.tid >> 1, kk = X.tid & 1, t = rb * 256 + tl;
        const u32x4 ro = *(const u32x4*)(X.ws + WS_ROUTE + (size_t)t * 16);
        const int e = (int)(kk ? ro.y : ro.x); const float w = __builtin_bit_cast(float, kk ? ro.w : ro.z);
        int rank = 0;
        for (int ee = 0; ee < 32; ++ee) { const unsigned long long mm = __ballot(e == ee);
            if (e == ee) rank = __builtin_popcountll(mm & ((1ull << X.lane) - 1ull));
            if (X.lane == 0) wcnt[X.wave * 32 + ee] = __builtin_popcountll(mm); }
        __syncthreads();
        int off = 0;
        for (int w2 = 0; w2 < X.wave; ++w2) off += wcnt[w2 * 32 + e];
        const int slot = ebase[e] + pre[e] + off + rank;
        STOK[slot] = t; SW[slot] = w; TSLOT[2 * t + kk] = slot;
        if (rb < 32) { const int e2 = rb; for (int s = ebase[e2] + cnt[e2] + X.tid; s < ebase[e2 + 1]; s += 512) { STOK[s] = 0; SW[s] = 0.f; } }
        if (rb == 0) { const int ntl = ebase[32] >> 8;
            for (int tile = X.tid; tile < ntl; tile += 512) { int ee = 0; while (ee < 31 && ebase[ee + 1] <= tile * 256) ++ee; TILEE[tile] = ee; }
            if (X.tid == 0) TILEE[1024] = ntl; }
        __syncthreads();
    }
}

__device__ __forceinline__ void ln2_phase(const Ctx& X, const CArgs* ap, int l, bool first, bool dummy = false) {
    struct { const float *ln1g, *ln1b, *ln2g, *ln2b; } a = {ap->ln1g, ap->ln1b, ap->ln2g, ap->ln2b}; float* outw = dummy ? (float*)(X.ws + WS_Y + 272 * MiB) : ap->out; (void)first;
    const bool last = (l + 1 == DEPTH);
    const bf16* xin = LN2_X1B ? (const bf16*)(X.ws + WS_XB) : (last ? (const bf16*)(X.ws + WS_KVA) : (const bf16*)((const unsigned char*)ap->out + XR_OFF));
    const int lane = X.lane; const bf16* Y = (const bf16*)(X.ws + WS_Y); const bf16* MIX = (const bf16*)(X.ws + WS_MIX); const int* TSLOT = (const int*)(X.ws + WS_TSLOT); bf16* XBp = dummy ? (bf16*)(X.ws + WS_MIX) : (bf16*)((unsigned char*)ap->out + XR_OFF);
    auto ldy = [&](int slot, int j) __attribute__((always_inline)) -> u32x2 {
        if (Y_FP8) { u32x2 r; r.x = ldg_s<unsigned>((const unsigned char*)Y + (size_t)slot * DM + 4 * lane + 256 * j); r.y = 0u; return r; }
        return ldg_s<u32x2>(Y + (size_t)slot * DM + 4 * lane + 256 * j); };
    f32x4 g1[4], b1[4], g[4], bb[4];
#pragma unroll
    for (int j = 0; j < 4; ++j) { g1[j] = *(const f32x4*)(a.ln1g + l * DM + 4 * lane + 256 * j); b1[j] = *(const f32x4*)(a.ln1b + l * DM + 4 * lane + 256 * j);
        g[j] = *(const f32x4*)(a.ln2g + l * DM + 4 * lane + 256 * j); bb[j] = *(const f32x4*)(a.ln2b + l * DM + 4 * lane + 256 * j); }
    for (int rb = X.c; rb < NT / 256; rb += X.G) {
        const int tb = rb * 256 + X.wave * 32;
        const int myslots_a = TSLOT[2 * (tb + (lane & 31))], myslots_b = TSLOT[2 * (tb + (lane & 31)) + 1];
        u32x2 xn[4]; u32x2 mn[4], yan[4], ybn[4];
        { const int sa = __builtin_amdgcn_readlane(myslots_a, 0), sb = __builtin_amdgcn_readlane(myslots_b, 0);
#pragma unroll
          for (int j = 0; j < 4; ++j) { xn[j] = *(const u32x2*)(xin + (size_t)tb * DM + 4 * lane + 256 * j); mn[j] = LN2_X1B ? (u32x2){0u, 0u} : *(const u32x2*)(MIX + (size_t)tb * DM + 4 * lane + 256 * j);
              yan[j] = ldy(sa, j); ybn[j] = ldy(sb, j); } }
        for (int i = 0; i < 32; ++i) {
            const int t = tb + i;
            f32x4 v[4]; float s = 0.f;
#pragma unroll
            for (int j = 0; j < 4; ++j) { const u32x2 xw = xn[j]; const u32x2 mw = mn[j];
                if (LN2_X1B) { v[j][0] = bflo(xw.x); v[j][1] = bfhi(xw.x); v[j][2] = bflo(xw.y); v[j][3] = bfhi(xw.y); }
                else { v[j][0] = ALPHA * bflo(xw.x) + bflo(mw.x); v[j][1] = ALPHA * bfhi(xw.x) + bfhi(mw.x); v[j][2] = ALPHA * bflo(xw.y) + bflo(mw.y); v[j][3] = ALPHA * bfhi(xw.y) + bfhi(mw.y);
                    s += (v[j][0] + v[j][1]) + (v[j][2] + v[j][3]); } }
            u32x2 ya[4], yb[4];
#pragma unroll
            for (int j = 0; j < 4; ++j) { ya[j] = yan[j]; yb[j] = ybn[j]; }
            if (i + 1 < 32) { const int sa = __shfl(myslots_a, i + 1), sb = __shfl(myslots_b, i + 1);
#pragma unroll
                for (int j = 0; j < 4; ++j) { xn[j] = *(const u32x2*)(xin + (size_t)(t + 1) * DM + 4 * lane + 256 * j); if (!LN2_X1B) mn[j] = *(const u32x2*)(MIX + (size_t)(t + 1) * DM + 4 * lane + 256 * j);
                    yan[j] = ldy(sa, j); ybn[j] = ldy(sb, j); } }
            if (!LN2_X1B) { const float mean = wave_sum(s) * (1.f / DM); float s2 = 0.f;
#pragma unroll
              for (int j = 0; j < 4; ++j) { v[j] = v[j] - mean; s2 += (v[j][0] * v[j][0] + v[j][1] * v[j][1]) + (v[j][2] * v[j][2] + v[j][3] * v[j][3]); }
              const float rstd = 1.0f / sqrtf(wave_sum(s2) * (1.f / DM) + 1e-5f);
#pragma unroll
              for (int j = 0; j < 4; ++j) v[j] = v[j] * rstd * g1[j] + b1[j]; }
            s = 0.f;
#pragma unroll
            for (int j = 0; j < 4; ++j) { const f32x4 xv = v[j];
                if (Y_FP8) { const f32x4 fa = pg8::fp8x4_to_f32(ya[j].x), fb = pg8::fp8x4_to_f32(yb[j].x);
#pragma unroll
                    for (int e = 0; e < 4; ++e) v[j][e] = ALPHA * xv[e] + (fa[e] + fb[e]) * (1.0f / Y_SCALE);
                } else { v[j][0] = ALPHA * xv[0] + (bflo(ya[j].x) + bflo(yb[j].x)); v[j][1] = ALPHA * xv[1] + (bfhi(ya[j].x) + bfhi(yb[j].x)); v[j][2] = ALPHA * xv[2] + (bflo(ya[j].y) + bflo(yb[j].y)); v[j][3] = ALPHA * xv[3] + (bfhi(ya[j].y) + bfhi(yb[j].y)); }
                s += (v[j][0] + v[j][1]) + (v[j][2] + v[j][3]); }
            const float mean = wave_sum(s) * (1.f / DM); float s2 = 0.f;
#pragma unroll
            for (int j = 0; j < 4; ++j) { v[j] = v[j] - mean; s2 += (v[j][0] * v[j][0] + v[j][1] * v[j][1]) + (v[j][2] * v[j][2] + v[j][3] * v[j][3]); }
            const float rstd = 1.0f / sqrtf(wave_sum(s2) * (1.f / DM) + 1e-5f);
#pragma unroll
            for (int j = 0; j < 4; ++j) { v[j] = v[j] * rstd * g[j] + bb[j];
                if (last || dummy) stgf4<NT_LN>(outw + (size_t)t * DM + 4 * lane + 256 * j, v[j]);
                else { u32x2 w; w.x = pk2(v[j][0], v[j][1]); w.y = pk2(v[j][2], v[j][3]); stg8<NT_LN>(XBp + (size_t)t * DM + 4 * lane + 256 * j, w); } }
        }
    }
}

#ifndef REP_P0
#define REP_P0 1
#endif
#ifndef REP_P5
#define REP_P5 1
#endif
#ifndef REP_P9
#define REP_P9 1
#endif
#ifndef REP_BAR
#define REP_BAR 1
#endif
#ifndef REP_P1
#define REP_P1 1
#endif
#ifndef REP_P2A
#define REP_P2A 1
#endif
#ifndef REP_P2B
#define REP_P2B 1
#endif
#ifndef REP_P2C
#define REP_P2C 1
#endif
#ifndef REP_P2D
#define REP_P2D 1
#endif
#ifndef REP_P3A
#define REP_P3A 1
#endif
#ifndef REP_P3B
#define REP_P3B 1
#endif
#ifndef REP_P3C
#define REP_P3C 1
#endif
#ifndef REP_P4
#define REP_P4 1
#endif
#ifndef REP_P6
#define REP_P6 1
#endif
#ifndef REP_P7
#define REP_P7 1
#endif
#ifndef REP_P8
#define REP_P8 1
#endif
__global__ void __launch_bounds__(512, 2) mk_fwd(Args a) {
    extern __shared__ __attribute__((aligned(16))) unsigned char lds_raw[];
    LAS unsigned char* const lds0 = (LAS unsigned char*)lds_raw;
    for (int u = threadIdx.x; u < (LDS_BYTES - LDSCTL_OFF) / 4; u += 512) ((LAS unsigned*)(lds0 + LDSCTL_OFF))[u] = 0u;
    __syncthreads();
    unsigned* barw = (unsigned*)(a.ws + WS_CTL) + CW_BAR;
    XcdBarrier bar; bar.bar = barw; bar.x = 0; bar.st = nullptr;
    if (a.use_bar) bar = xcd_barrier_post(barw, (volatile LAS unsigned*)(lds0 + LDSCTL_OFF) + 8);
#define MKCTX() Ctx X; const CArgs* ap = (const CArgs*)__builtin_amdgcn_kernarg_segment_ptr(); asm volatile("" : "+s"(ap)); { int t_ = threadIdx.x; asm volatile("" : "+v"(t_)); X.lds = lds0; X.tid = t_; X.lane = t_ & 63; X.wave = __builtin_amdgcn_readfirstlane(t_ >> 6); \
        unsigned char* w_ = ap->ws; X.G = gridDim.x; X.c = blockIdx.x; X.vcu = (X.G % 8 == 0) ? (X.c % 8) * (X.G / 8) + X.c / 8 : X.c; X.ws = w_; }
#ifndef P2M
#define P2M 31
#endif
#ifndef PH_MASK0
#define PH_MASK0 1
#endif
#define GBAR() do { if (a.use_bar) for (int rb_ = 0; rb_ < REP_BAR; ++rb_) xcd_barrier(bar); } while (0)

    if ((PH_MASK0 & 1) && a.l_lo == 0 && a.ph_lo == 0) { MKCTX(); for (int rep = 0; rep < REP_P0; ++rep) { prologue(X, ap); __syncthreads(); } GBAR(); }

    for (int l = a.l_lo; l < a.l_hi; ++l) {
        const int lo = (l == a.l_lo) ? (a.ph_lo < 1 ? 1 : a.ph_lo) : 1, hi = (l == a.l_hi - 1) ? a.ph_hi : 10;
#ifndef PH_MASK
#define PH_MASK 0x3ff
#endif
#define IN(k) (((PH_MASK >> (k)) & 1) && lo <= (k) && (k) < hi)
        if (IN(1)) { MKCTX();
            pg8::Gemm g{(const bf16*)((const unsigned char*)ap->out + XR_OFF), (const bf16*)(X.ws + WS_WIN) + (size_t)l * NIN * DM, DM, nullptr};
            pg8::StaticOrder S; S.init(NT, NIN, X.G, X.c, REP_P1);
            pg8::RopeTabs R{ap->pos};
            pg8::EpiGroups<InProjDesc> E{InProjDesc{X.ws}, R, nullptr, 0, 0.f, 0.f};
            pg8::gemm_phase<pg8::EpiGroups<InProjDesc>, pg8::StaticOrder, false>(X.lds, g, S, E, X.tid);
            GBAR();
        }
        if (IN(2)) { MKCTX();
            {
                pg8::Gemm g{(const bf16*)(X.ws + WS_CQ), (const bf16*)(X.ws + WS_WUQ) + (size_t)l * 768 * 256, 256, nullptr};
                pg8::StaticOrder S; S.init(NT, 768, X.G, X.c, REP_P2A);
                pg8::RopeTabs R{ap->pos};
                pg8::EpiGroups<UqDesc> E{UqDesc{X.ws}, R, (const float*)(X.ws + WS_SSQ), 8, 1.0f / 256.0f, 1e-6f};
                pg8::gemm_phase<pg8::EpiGroups<UqDesc>, pg8::StaticOrder, false>(X.lds, g, S, E, X.tid);
            }
            {
                pg8::Gemm g{(const bf16*)(X.ws + WS_T1), (const bf16*)(X.ws + WS_WUKV) + (size_t)l * 1024 * 256, 256, nullptr};
                pg8::StaticOrder S; S.init(NT, 1024, X.G, X.c, REP_P2A);
                pg8::EpiPlainT<NT_KVA> E{(bf16*)(X.ws + WS_KVA), 1024, (const float*)(X.ws + WS_SSQ) + (size_t)NT * 8, 4, 1.0f / 128.0f, 1e-6f, X.lds + LDS_X_OFF};
                pg8::gemm_phase<decltype(E), pg8::StaticOrder, false>(X.lds, g, S, E, X.tid);
            }
            __syncthreads();
            for (int rep = 0; rep < REP_P2B; ++rep) convert_experts(X, ap, l);
            __syncthreads();
            for (int rep = 0; rep < REP_P2C; ++rep) for (int U = X.vcu; U < NB * 32; U += X.G) { const int b = U >> 5, pr = U & 31;
                dsa_index_unit(X, b, 32 * pr); dsa_index_unit(X, b, 32 * (63 - pr)); }
            __syncthreads();
#pragma unroll 1
            for (int cfg = 0; cfg < 3 * REP_P2D; ++cfg) { const int cfgi = cfg % 3;
                fa::Params P; const size_t co = (size_t)cfgi * NT * 256;
                P.Q = (const bf16*)(X.ws + WS_DQ) + co; P.q_pitch = 256; P.K1 = (const bf16*)(X.ws + WS_DK) + co; P.k1_pitch = 256; P.K2 = nullptr; P.k2_pitch = 0; P.k2_col = 0;
                P.V = (const bf16*)(X.ws + WS_DV) + co; P.v_pitch = 256; P.O = (bf16*)(X.ws + WS_OD) + co; P.o_pitch = 256; P.LSE = (float*)(X.ws + WS_LSE) + (size_t)cfgi * NT * 4; P.lse_pitch = 4; P.BM = nullptr;
                P.CL = cfgi == 0 ? 2048 : (cfgi == 1 ? 512 : 128); P.W = 128;
                const int vcu = X.vcu, G = X.G, wv = X.wave, CLc = P.CL;
                fa::attn_stream<64, 0, 2>(P, X.lds, X.tid, (NB * 2 * 16 - vcu + G - 1) / G, [=](int j) { const int U = vcu + j * G, bh = U >> 4, qb = U & 15, b = bh >> 1, hp = bh & 1;
                    const int q0 = 128 * qb, hh = 2 * hp + (wv >> 2); int klo = q0 & ~(CLc - 1); if (q0 - 128 > klo) klo = q0 - 128;
                    return fa::UnitDesc{b * SEQ, q0 + 32 * (wv & 3), 64 * hh, 64 * hh, hh, 128 * hp, 128 * hp, klo >> 6, (q0 + 127) >> 6}; });
            }
            GBAR();
        }
        if (IN(3)) { MKCTX();
            {   fa::Params P; P.Q = (const bf16*)(X.ws + WS_QA); P.q_pitch = 768; P.K1 = (const bf16*)(X.ws + WS_KVA); P.k1_pitch = 1024; P.K2 = (const bf16*)(X.ws + WS_KPE); P.k2_pitch = 32; P.k2_col = 0;
                P.V = (const bf16*)(X.ws + WS_KVA); P.v_pitch = 1024; P.O = (bf16*)(X.ws + WS_XB); P.o_pitch = DM; P.LSE = nullptr; P.lse_pitch = 0; P.BM = nullptr; P.CL = 2048; P.W = 1 << 20;
                const int vcu = X.vcu, G = X.G, wv = X.wave;
                fa::attn_stream<96, 2, 1>(P, X.lds, X.tid, 2 * ((NB * 8 * 4 - vcu + G - 1) / G), [=](int j) { const int U = vcu + (j >> 1) * G, bh = U >> 2, pr = U & 3, b = bh >> 3, hd = bh & 7;
                    const int qb = (j & 1) ? 7 - pr : pr, q0 = 256 * qb;
                    return fa::UnitDesc{b * SEQ, q0 + 32 * wv, 96 * hd, 64 * hd, 0, 128 * hd, 128 * hd + 64, 0, (q0 + 255) >> 6}; });
            }
            {   fa::Params P; P.Q = (const bf16*)(X.ws + WS_BQ); P.q_pitch = 256; P.K1 = (const bf16*)(X.ws + WS_T1); P.k1_pitch = 256; P.k1_col = 192; P.K2 = nullptr; P.k2_pitch = 0; P.k2_col = 0;
                P.V = (const bf16*)(X.ws + WS_BV); P.v_pitch = 64; P.v_col = 0; P.O = (bf16*)(X.ws + WS_XB); P.o_pitch = DM; P.LSE = nullptr; P.lse_pitch = 0; P.BM = (const unsigned*)(X.ws + WS_BM); P.CL = 2048; P.W = 1 << 20;
                const int hd = X.wave & 3, sub = X.wave >> 2, vcu = X.vcu, G = X.G;
                fa::attn_stream<64, 1, 1>(P, X.lds, X.tid, 2 * ((NB * 16 - vcu + G - 1) / G), [=](int j) { const int U = vcu + (j >> 1) * G, b = U >> 4, pr = U & 15;
                    const int qb = (j & 1) ? 31 - pr : pr, q0 = 64 * qb;
                    return fa::UnitDesc{b * SEQ, q0 + 32 * sub, 64 * hd, 512 + 64 * hd, 0, 192, 0, 0, qb}; });
            }
            for (int rep = 0; rep < REP_P3C; ++rep) dil_combine(X);
            GBAR();
        }
        if (IN(4)) { MKCTX();
            pg8::Gemm g{(const bf16*)(X.ws + WS_XB), (const bf16*)(X.ws + WS_WO) + (size_t)l * DM * DM, DM, nullptr};
            pg8::StaticOrder S; S.init(NT, DM, X.G, X.c, REP_P4);
            pg8::EpiPlainT<NT_MIX> E{(bf16*)(X.ws + WS_MIX), DM, nullptr, 0, 0.f, 0.f, X.lds + LDS_X_OFF};
            pg8::gemm_phase<decltype(E), pg8::StaticOrder, false>(X.lds, g, S, E, X.tid);
            GBAR();
        }
#if ROUTER_MFMA
        if (IN(5)) { MKCTX(); if (REP_P5 > 1) ln1_router_mfma(X, ap, l, true); ln1_router_mfma(X, ap, l); GBAR(); }
#else
        if (IN(5)) { MKCTX(); if (REP_P5 > 1) ln1_router(X, ap, l, l == 0, true); ln1_router(X, ap, l, l == 0); GBAR(); }
#endif
        if (IN(6)) { MKCTX(); for (int rep = 0; rep < REP_P6; ++rep) moe_dispatch(X); GBAR(); }
        if (IN(7)) { MKCTX();
            const int* TILEE = (const int*)(X.ws + WS_TILEE);
            pg8::Gemm g{(const bf16*)(X.ws + WS_XB), (const bf16*)(X.ws + WS_WGU), DM, (const int*)(X.ws + WS_STOK)};
            pg8::GroupedOrder S{TILEE, TILEE[1024], 2, X.G, X.c};
            pg8::EpiGateUpT<NT_H> E{(bf16*)(X.ws + WS_H), (const float*)(X.ws + WS_SW)};
            for (int rep = 0; rep < REP_P7; ++rep) pg8::gemm_phase<decltype(E), pg8::GroupedOrder, true>(X.lds, g, S, E, X.tid);
            GBAR();
        }
        if (IN(8)) { MKCTX();
            const int* TILEE = (const int*)(X.ws + WS_TILEE);
            pg8::Gemm g{(const bf16*)(X.ws + WS_H), (const bf16*)(X.ws + WS_WD), FH, nullptr};
            pg8::GroupedOrder S{TILEE, TILEE[1024], 4, X.G, X.c};
#if Y_FP8
            pg8::EpiFp8T<NT_Y> E{X.ws + WS_Y, DM, Y_SCALE, X.lds + LDS_X_OFF};
#else
            pg8::EpiPlainT<NT_Y> E{(bf16*)(X.ws + WS_Y), DM, nullptr, 0, 0.f, 0.f, X.lds + LDS_X_OFF};
#endif
            for (int rep = 0; rep < REP_P8; ++rep) pg8::gemm_phase<decltype(E), pg8::GroupedOrder, false>(X.lds, g, S, E, X.tid);
            GBAR();
        }
        if (IN(9)) { MKCTX(); if (REP_P9 > 1) ln2_phase(X, ap, l, l == 0, true); ln2_phase(X, ap, l, l == 0); if (!(l == a.l_hi - 1)) GBAR(); }
#undef IN
    }
#undef GBAR
}

extern "C" void kernel_launch(void* const* d_in, const int* in_sizes, int n_in, void* d_out, int out_size, void* d_ws, size_t ws_size, hipStream_t stream) {
    static int grid = 0;
    if (grid == 0) {
        if (n_in != 19 || in_sizes[0] != NT * DM || out_size != NT * DM || ws_size < WS_END) { fprintf(stderr, "kernel_launch: unexpected shapes (n_in %d, in0 %d, out %d, ws %zu < %zu); nothing launched\n", n_in, n_in > 0 ? in_sizes[0] : -1, out_size, ws_size, (size_t)WS_END); grid = -1; return; }
        int dev = 0, cus = 0, per_cu = 0;
        if (hipGetDevice(&dev) != hipSuccess || hipDeviceGetAttribute(&cus, hipDeviceAttributeMultiprocessorCount, dev) != hipSuccess) { grid = -1; return; }
        if (hipFuncSetAttribute((const void*)mk_fwd, hipFuncAttributeMaxDynamicSharedMemorySize, LDS_BYTES) != hipSuccess) { fprintf(stderr, "kernel_launch: hipFuncSetAttribute failed\n"); grid = -1; return; }
        if (hipOccupancyMaxActiveBlocksPerMultiprocessor(&per_cu, (const void*)mk_fwd, 512, LDS_BYTES) != hipSuccess || per_cu < 1) fprintf(stderr, "kernel_launch: occupancy query reports %d\n", per_cu);
        (void)hipGetLastError();
        grid = cus;
    }
    if (grid < 0) return;
    (void)hipMemsetAsync((char*)d_ws + WS_CTL, 0, CTL_BYTES, stream);
    Args a{};
    a.x = (const float*)d_in[0]; a.pos = (const int*)d_in[1]; a.w_in = (const float*)d_in[2]; a.qn = (const float*)d_in[3]; a.kvn = (const float*)d_in[4];
    a.w_uq = (const float*)d_in[5]; a.w_ukv = (const float*)d_in[6]; a.w_o = (const float*)d_in[7]; a.ln1g = (const float*)d_in[8]; a.ln1b = (const float*)d_in[9];
    a.rgw = (const float*)d_in[10]; a.rgb = (const float*)d_in[11]; a.rew = (const float*)d_in[12]; a.reb = (const float*)d_in[13];
    a.wg = (const float*)d_in[14]; a.wu = (const float*)d_in[15]; a.wd = (const float*)d_in[16]; a.ln2g = (const float*)d_in[17]; a.ln2b = (const float*)d_in[18];
    a.out = (float*)d_out; a.ws = (unsigned char*)d_ws; a.pad = 0;
#if MK_MULTI
    a.use_bar = 0;
    a.l_lo = 0; a.l_hi = 0; a.ph_lo = 0; a.ph_hi = 0;
    hipLaunchKernelGGL(mk_fwd, dim3(grid), dim3(512), LDS_BYTES, stream, a);
    for (int l = 0; l < DEPTH; ++l)
        for (int ph = 1; ph < 10; ++ph) { a.l_lo = l; a.l_hi = l + 1; a.ph_lo = ph; a.ph_hi = ph + 1; hipLaunchKernelGGL(mk_fwd, dim3(grid), dim3(512), LDS_BYTES, stream, a); }
#else
    a.use_bar = 1; a.l_lo = 0; a.l_hi = DEPTH; a.ph_lo = 0; a.ph_hi = 10;
    hipLaunchKernelGGL(mk_fwd, dim3(grid), dim3(512), LDS_BYTES, stream, a);
#endif
    const hipError_t le = hipPeekAtLastError();
    if (le != hipSuccess) fprintf(stderr, "kernel_launch: launch failed: %s\n", hipGetErrorName(le));
}
```

```cpp
#include <hip/hip_runtime.h>
#include <cstdio>
#include <cstdint>

#define LAS __attribute__((address_space(3)))
#define GAS __attribute__((address_space(1)))
typedef unsigned short bf16;
typedef short bf16x8 __attribute__((ext_vector_type(8)));
typedef short s16x4 __attribute__((ext_vector_type(4)));
typedef float f32x2 __attribute__((ext_vector_type(2)));
typedef float f32x4 __attribute__((ext_vector_type(4)));
typedef float f32x16 __attribute__((ext_vector_type(16)));
typedef unsigned u32x2 __attribute__((ext_vector_type(2)));
typedef unsigned u32x4 __attribute__((ext_vector_type(4)));
typedef __bf16 bf16x2_t __attribute__((ext_vector_type(2)));

#ifndef MK_MULTI
#define MK_MULTI 0
#endif

constexpr int NB = 32, SEQ = 2048, NT = NB * SEQ, DM = 1024, DEPTH = 4;
constexpr int IN_COLS = 3400, NIN = 3584;
constexpr int NEXP = 32, FH = 256;
constexpr int NSLOT = 2 * NT + NEXP * 256;
constexpr int MAXTILES = NSLOT / 256;
constexpr float ALPHA = 1.681792830507429f;
constexpr float LOG2E = 1.4426950408889634f;
constexpr float QSC64 = 0.125f * LOG2E;
constexpr float QSC96 = 0.10206207261596577f * LOG2E;
constexpr float IDX_SCALE = 0.0625f;

constexpr size_t MiB = 1u << 20;
constexpr size_t WS_CTL = 0, CTL_BYTES = 1 * MiB;
constexpr size_t WS_WIN = 1 * MiB;
constexpr size_t WS_WUQ = 29 * MiB;
constexpr size_t WS_WUKV = WS_WUQ + 3 * MiB / 2;
constexpr size_t WS_WO = WS_WUKV + 2 * MiB;
constexpr size_t WS_RGT = WS_WO + 8 * MiB;
constexpr size_t WS_RET = WS_RGT + 64 * 1024;
constexpr size_t WS_ROPE = 42 * MiB;
constexpr size_t WS_WGU = 56 * MiB;
constexpr size_t WS_WD = 88 * MiB;
constexpr size_t WS_XB = 104 * MiB;
constexpr size_t WS_A = 232 * MiB;
constexpr size_t WS_CQ = WS_A;
constexpr size_t WS_T1 = WS_CQ + 32 * MiB;
constexpr size_t WS_BQ = WS_T1 + 32 * MiB;
constexpr size_t WS_BV = WS_BQ + 32 * MiB;
constexpr size_t WS_WI = WS_BV + 8 * MiB;
constexpr size_t WS_BQI = WS_WI + 2 * MiB;
constexpr size_t WS_SSQ = WS_BQI + 32 * MiB;
constexpr size_t WS_DQ = WS_SSQ + 4 * MiB;
constexpr size_t WS_DK = WS_DQ + 96 * MiB;
constexpr size_t WS_DV = WS_DK + 96 * MiB;
constexpr size_t WS_B = WS_DV + 96 * MiB;
constexpr size_t WS_QA = WS_B;
constexpr size_t WS_KVA = WS_QA + 96 * MiB;
constexpr size_t WS_BM = WS_KVA + 128 * MiB;
constexpr size_t WS_OD = WS_BM + 16 * MiB;
constexpr size_t WS_LSE = WS_OD + 96 * MiB;
constexpr size_t WS_MOE = WS_LSE + 4 * MiB;
constexpr size_t WS_ROUTE = WS_MOE;
constexpr size_t WS_HIST = WS_ROUTE + 1 * MiB;
constexpr size_t WS_STOK = WS_HIST + 64 * 1024;
constexpr size_t WS_SW = WS_STOK + 640 * 1024;
constexpr size_t WS_TSLOT = WS_SW + 640 * 1024;
constexpr size_t WS_TILEE = WS_TSLOT + 512 * 1024;
constexpr size_t WS_KPE = WS_MOE + 4 * MiB;
constexpr size_t WS_KI = WS_KPE + 4 * MiB;
constexpr size_t WS_END = WS_KI + 4 * MiB;
constexpr size_t WS_MIX = WS_A;
constexpr size_t WS_H = WS_A + 128 * MiB;
constexpr size_t WS_Y = WS_H + 68 * MiB;
static_assert(WS_RET + 512 * 1024 <= WS_ROPE && WS_ROPE + 14 * MiB <= WS_WGU && WS_WD + 16 * MiB <= WS_XB && WS_XB + 128 * MiB <= WS_A, "ws map 1");
static_assert(WS_Y + 272 * MiB <= WS_MOE && WS_TILEE + 8192 <= WS_END && WS_END <= 1024 * MiB, "ws map 2");
constexpr size_t ROPE_C16 = 0, ROPE_S16 = (size_t)NT * 16 * 4, ROPE_C8 = 2 * ROPE_S16, ROPE_S8 = ROPE_C8 + (size_t)NT * 8 * 4,
                 ROPE_C4 = ROPE_S8 + (size_t)NT * 8 * 4, ROPE_S4 = ROPE_C4 + (size_t)NT * 4 * 4;

constexpr int CW_BAR = 4096;
constexpr int RING_BYTES = 131072;
constexpr int LDS_X_OFF = 131072;
constexpr int LDSCTL_OFF = 147456;
constexpr int LDS_HIST_OFF = LDSCTL_OFF + 4096;
constexpr int LDS_BYTES = LDS_HIST_OFF + 4096;

#define RLX_AGENT __ATOMIC_RELAXED, __HIP_MEMORY_SCOPE_AGENT
__device__ __forceinline__ unsigned f2bf(float f) { unsigned u = __builtin_bit_cast(unsigned, f); return (u + 0x7fffu + ((u >> 16) & 1u)) >> 16; }
#ifndef Y_FP8
#define Y_FP8 1
#endif
#define Y_SCALE 64.0f
#ifndef MIX_FP8
#define MIX_FP8 0
#endif
#define MIX_SCALE 256.0f
#ifndef ROUTER_MFMA
#define ROUTER_MFMA 1
#endif
#ifndef LN2_X1B
#define LN2_X1B 1
#endif
constexpr size_t XR_OFF = (size_t)NT * DM * 2;
#ifndef NT_EPI
#define NT_EPI 1
#endif
#ifndef NT_KVA
#define NT_KVA 1
#endif
#ifndef NT_MIX
#define NT_MIX 0
#endif
#ifndef NT_H
#define NT_H 0
#endif
#ifndef NT_Y
#define NT_Y 1
#endif
#ifndef NT_LN
#define NT_LN 0
#endif
#ifndef NT_ATT
#define NT_ATT 1
#endif
#define STG_ASM(W, POL) asm volatile("global_store_dwordx" W " %0, %1, off " POL "\n\ts_nop 1" :: "v"(p), "v"(w))
template <int M, class T> __device__ __forceinline__ void stg_any16(void* p, T w) {
    if constexpr (M == 0) *(T*)p = w; else if constexpr (M == 1) __builtin_nontemporal_store(w, (T*)p);
    else if constexpr (M == 2) STG_ASM("4", "sc1"); else if constexpr (M == 3) STG_ASM("4", "sc0 sc1"); else if constexpr (M == 4) STG_ASM("4", "sc1 nt"); else STG_ASM("4", "sc0 sc1 nt"); }
template <int M> __device__ __forceinline__ void stgf4(void* p, f32x4 w) { stg_any16<M>(p, w); }
template <int M> __device__ __forceinline__ void stg16(void* p, u32x4 w) { stg_any16<M>(p, w); }
template <int M> __device__ __forceinline__ void stg8(void* p, u32x2 w) {
    if constexpr (M == 0) *(u32x2*)p = w; else if constexpr (M == 1) __builtin_nontemporal_store(w, (u32x2*)p);
    else if constexpr (M == 2) STG_ASM("2", "sc1"); else if constexpr (M == 3) STG_ASM("2", "sc0 sc1"); else if constexpr (M == 4) STG_ASM("2", "sc1 nt"); else STG_ASM("2", "sc0 sc1 nt"); }
#ifndef NT_LD
#define NT_LD 1
#endif
template <class T> __device__ __forceinline__ T ldg_s(const void* p) { if constexpr (NT_LD) return __builtin_nontemporal_load((const T*)p); else return *(const T*)p; }
__device__ __forceinline__ unsigned pk2(float lo, float hi) { f32x2 v = {lo, hi}; bf16x2_t b = __builtin_convertvector(v, bf16x2_t); return __builtin_bit_cast(unsigned, b); }
__device__ __forceinline__ float bf2f(unsigned short b) { return __builtin_bit_cast(float, ((unsigned)b) << 16); }
__device__ __forceinline__ float bflo(unsigned w) { return __builtin_bit_cast(float, w << 16); }
__device__ __forceinline__ float bfhi(unsigned w) { return __builtin_bit_cast(float, w & 0xffff0000u); }
template <int CTRL> __device__ __forceinline__ float dppf(float x) { return __builtin_bit_cast(float, __builtin_amdgcn_mov_dpp(__builtin_bit_cast(int, x), CTRL, 0xf, 0xf, true)); }
__device__ __forceinline__ float xhalf_sum(float v) { const auto t = __builtin_amdgcn_permlane32_swap(__float_as_uint(v), __float_as_uint(v), false, false); return __uint_as_float(t[0]) + __uint_as_float(t[1]); }
__device__ __forceinline__ float xhalf_max(float v) { const auto t = __builtin_amdgcn_permlane32_swap(__float_as_uint(v), __float_as_uint(v), false, false); return fmaxf(__uint_as_float(t[0]), __uint_as_float(t[1])); }
__device__ __forceinline__ float wave_sum(float v) {
    v += dppf<0xB1>(v); v += dppf<0x4E>(v); v += dppf<0x141>(v); v += dppf<0x140>(v);
    const auto s = __builtin_amdgcn_permlane16_swap(__float_as_uint(v), __float_as_uint(v), false, false);
    v = __uint_as_float(s[0]) + __uint_as_float(s[1]);
    return xhalf_sum(v);
}
template <int N> __device__ __forceinline__ void wave_sum_n(float (&v)[N]) {
#pragma unroll
    for (int i = 0; i < N; ++i) v[i] += dppf<0xB1>(v[i]);
#pragma unroll
    for (int i = 0; i < N; ++i) v[i] += dppf<0x4E>(v[i]);
#pragma unroll
    for (int i = 0; i < N; ++i) v[i] += dppf<0x141>(v[i]);
#pragma unroll
    for (int i = 0; i < N; ++i) v[i] += dppf<0x140>(v[i]);
#pragma unroll
    for (int i = 0; i < N; ++i) { const auto s = __builtin_amdgcn_permlane16_swap(__float_as_uint(v[i]), __float_as_uint(v[i]), false, false); v[i] = __uint_as_float(s[0]) + __uint_as_float(s[1]); }
#pragma unroll
    for (int i = 0; i < N; ++i) v[i] = xhalf_sum(v[i]);
}
__device__ __forceinline__ int crow(int r, int hi) { return (r & 3) + 8 * (r >> 2) + 4 * hi; }

#define XB_TMO      128
#define XB_XCNT(j)  (256  + 64 * (j))
#define XB_XSUB(j)  (1280 + 64 * (j))
#define XB_XGEN(j)  (2304 + 64 * (j))
#define XB_TOP      3328
#define XB_TOPGEN   3392
#define XCD_BAR_WORDS 3456
#define XB_SPIN_CAP (1u << 18)
__device__ __forceinline__ unsigned xb_ld(unsigned* p)              { return __hip_atomic_load(p, __ATOMIC_RELAXED, __HIP_MEMORY_SCOPE_AGENT); }
__device__ __forceinline__ unsigned xb_add(unsigned* p, unsigned v) { return __hip_atomic_fetch_add(p, v, __ATOMIC_RELAXED, __HIP_MEMORY_SCOPE_AGENT); }
__device__ __forceinline__ unsigned xb_xcc_id() { return (unsigned)__builtin_amdgcn_s_getreg((3 << 11) | 20) & 0xFu; }
#define XB_SPIN(cond, bar) do { unsigned _sp = 0; while (cond) { __builtin_amdgcn_s_sleep(1); \
    if ((++_sp & 255u) == 0u) { if (xb_ld(&(bar)[XB_TMO])) break; if (_sp > XB_SPIN_CAP) { atomicAdd(&(bar)[XB_TMO], 1u); break; } } } } while (0)
struct XcdBarrier { unsigned* bar; unsigned x; volatile LAS unsigned* st; };
__device__ __forceinline__ XcdBarrier xcd_barrier_post(unsigned* bar, volatile LAS unsigned* st) {
    XcdBarrier b; b.bar = bar; b.x = xb_xcc_id(); b.st = st;
    if (threadIdx.x == 0) (void)xb_add(&bar[XB_XCNT(b.x)], 1u);
    return b;
}
__device__ __forceinline__ void xcd_barrier_complete(unsigned* bar, unsigned x, unsigned& nloc, unsigned& nx) {
    const unsigned G = gridDim.x * gridDim.y * gridDim.z;
    unsigned sum, cnt, mine, sp = 0u;
    for (;;) {
        sum = 0u; cnt = 0u; mine = 0u;
#pragma unroll
        for (unsigned j = 0; j < 16; ++j) { const unsigned c = xb_ld(&bar[XB_XCNT(j)]); sum += c; cnt += (c > 0u) ? 1u : 0u; mine = (j == x) ? c : mine; }
        if (sum == G) break;
        __builtin_amdgcn_s_sleep(1);
        if ((++sp & 255u) == 0u) { if (xb_ld(&bar[XB_TMO])) break; if (sp > XB_SPIN_CAP) { atomicAdd(&bar[XB_TMO], 1u); break; } }
    }
    nloc = mine > 0u ? mine : 1u; nx = cnt > 0u ? cnt : 1u;
}
__device__ __forceinline__ void xcd_barrier(const XcdBarrier& b) {
    asm volatile("s_waitcnt vmcnt(0)" ::: "memory");
    __syncthreads();
    if (threadIdx.x == 0) {
        unsigned* bar = b.bar;
        __builtin_amdgcn_s_waitcnt(0);
        unsigned nloc = b.st[0], nx = b.st[1];
        if (nloc == 0u) { xcd_barrier_complete(bar, b.x, nloc, nx); b.st[0] = nloc; b.st[1] = nx; }
        const unsigned old = xb_add(&bar[XB_XSUB(b.x)], 1u);
        const unsigned gen = old / nloc;
        if (old + 1u == (gen + 1u) * nloc) {
            __builtin_amdgcn_fence(__ATOMIC_RELEASE, "agent");
            asm volatile("s_waitcnt vmcnt(0)" ::: "memory");
            const unsigned og = xb_add(&bar[XB_TOP], 1u);
            const unsigned tg = og / nx;
            if (og + 1u == (tg + 1u) * nx) xb_add(&bar[XB_TOPGEN], 1u);
            else XB_SPIN(xb_ld(&bar[XB_TOPGEN]) == tg, bar);
            __builtin_amdgcn_fence(__ATOMIC_ACQUIRE, "agent");
            xb_add(&bar[XB_XGEN(b.x)], 1u);
            asm volatile("s_waitcnt vmcnt(0)" ::: "memory");
        } else {
            XB_SPIN(xb_ld(&bar[XB_XGEN(b.x)]) == gen, bar);
            __builtin_amdgcn_fence(__ATOMIC_ACQUIRE, "agent");
            asm volatile("s_waitcnt vmcnt(0)" ::: "memory");
        }
    }
    __syncthreads();
}

namespace pg8 {
constexpr int BM = 256, BK = 64, HALF = 128, HTB = HALF * BK * 2, STAGE_BYTES = 8 * HTB, NXCD = 8, WGM = 8;
__host__ __device__ __forceinline__ int lds_byte(int r, int c) { const int st = (r >> 4) * 2 + (c >> 5), rr = r & 15, cc = c & 31, ob = rr * 64 + cc * 2; return st * 1024 + (ob ^ (((ob >> 9) & 1) << 5)); }
__host__ __device__ __forceinline__ void stage_rc(int b, int& R, int& C) { const int st = b / 1024, sb = b % 1024, swz = sb ^ (((sb >> 9) & 1) << 5); R = (st >> 1) * 16 + swz / 64; C = (st & 1) * 32 + (swz % 64) / 2; }
__host__ __device__ __forceinline__ int perm32(int rho) { const int n = rho >> 4, i = rho & 15; return 8 * (i >> 2) + 4 * n + (i & 3); }

#ifndef PROBE_P1
#define PROBE_P1 0
#endif
struct Unit { int pm, pn, pb;
#if PROBE_P1
    int fl;
#endif
};
struct Gemm { const bf16* A; const bf16* Bt; int K; const int* gidx; };

__device__ __forceinline__ int xcd_remap(int wgid, int nwg) { const int q = nwg / NXCD, r = nwg % NXCD, xcd = wgid % NXCD, off = wgid / NXCD; return (xcd < r ? xcd * (q + 1) : r * (q + 1) + (xcd - r) * q) + off; }
struct StaticOrder {
    int nM, nN, nwg, G, c, rep;
    __device__ void init(int M, int N, int G_, int c_, int rep_ = 1) { nM = M / BM; nN = N / BM; nwg = nM * nN; G = G_; c = c_; rep = rep_; }
    __device__ bool next(int i, Unit& u) const {
        long L = (long)i * G + c; if (L >= (long)nwg * rep) return false;
#if PROBE_P1
        u.fl = (rep > 1 && L < nwg) ? 1 : 0;
#endif
        L %= nwg;
        const int wgid = xcd_remap((int)L, nwg);
        const int nig = WGM * nN, gid = wgid / nig, fm = gid * WGM, gsz = (nM - fm) < WGM ? (nM - fm) : WGM;
        u.pm = fm + ((wgid % nig) % gsz); u.pn = (wgid % nig) / gsz; u.pb = u.pn; return true;
    }
};
struct GroupedOrder {
    const int* tile_e; int ntiles, npn, G, c;
    __device__ bool next(int i, Unit& u) const {
        const long L = (long)i * G + c; const int nwg = ntiles * npn; if (L >= nwg) return false;
        const int wgid = xcd_remap((int)L, nwg);
        u.pm = wgid / npn; u.pn = wgid % npn; u.pb = tile_e[u.pm] * npn + u.pn;
#if PROBE_P1
        u.fl = 0;
#endif
        return true;
    }
};

__device__ __forceinline__ unsigned cvt_pk_bf16(float lo, float hi) { unsigned r; asm volatile("v_cvt_pk_bf16_f32 %0, %1, %2" : "=v"(r) : "v"(lo), "v"(hi)); return r; }

template <int STM> struct EpiPlainT {
    static constexpr bool PERM = true;
    bf16* O; int ldc; const float* ssq; int ssq_n; float ssq_inv; float eps;
    LAS unsigned char* xl;
    __device__ __forceinline__ void operator()(const f32x4 (&acc)[2][2][4][2], const Unit& u, int wr, int wc, int fr, int fq) const {
        const int lane = fq * 16 + fr; LAS unsigned char* t = xl + (wr * 4 + wc) * 2048;
        const int wsw = fr & 7, rrow = lane >> 3, rch = lane & 7;
#pragma unroll
        for (int ai = 0; ai < 2; ++ai)
#pragma unroll
            for (int m = 0; m < 4; ++m) { const int rowb = u.pm * BM + ai * HALF + wr * 64 + m * 16;
                float sc = 1.f;
                if (ssq) { const f32x4 p = *(const f32x4*)(ssq + (size_t)(rowb + fr) * ssq_n); sc = __builtin_amdgcn_rsqf((p[0] + p[1] + p[2] + p[3]) * ssq_inv + eps); }
#pragma unroll
                for (int bj = 0; bj < 2; ++bj) { const f32x4 v0 = acc[ai][bj][m][0] * sc, v1 = acc[ai][bj][m][1] * sc;
                    u32x4 w; w.x = cvt_pk_bf16(v0[0], v0[1]); w.y = cvt_pk_bf16(v0[2], v0[3]); w.z = cvt_pk_bf16(v1[0], v1[1]); w.w = cvt_pk_bf16(v1[2], v1[3]);
                    *(LAS u32x4*)(t + fr * 128 + 16 * ((4 * bj + fq) ^ wsw)) = w; }
#pragma unroll
                for (int i = 0; i < 2; ++i) { const int rr = 8 * i + rrow;
                    const u32x4 w = *(const LAS u32x4*)(t + rr * 128 + 16 * (rch ^ (rr & 7)));
                    stg16<STM>(O + (size_t)(rowb + rr) * ldc + u.pn * BM + wc * 64 + 8 * rch, w); }
            }
    }
};
template <int STM> struct EpiFp8T {
    static constexpr bool PERM = true;
    unsigned char* O; int ldc; float scale; LAS unsigned char* xl;
    __device__ __forceinline__ void operator()(const f32x4 (&acc)[2][2][4][2], const Unit& u, int wr, int wc, int fr, int fq) const {
        const int lane = fq * 16 + fr; LAS unsigned char* t = xl + (wr * 4 + wc) * 2048;
        const int rrow = lane >> 2, rch = lane & 3;
#pragma unroll
        for (int ai = 0; ai < 2; ++ai)
#pragma unroll
            for (int m = 0; m < 4; ++m) { const int rowb = u.pm * BM + ai * HALF + wr * 64 + m * 16;
#pragma unroll
                for (int bj = 0; bj < 2; ++bj) { f32x4 v0 = acc[ai][bj][m][0] * scale, v1 = acc[ai][bj][m][1] * scale;
#pragma unroll
                    for (int e = 0; e < 4; ++e) { v0[e] = __builtin_amdgcn_fmed3f(v0[e], -448.f, 448.f); v1[e] = __builtin_amdgcn_fmed3f(v1[e], -448.f, 448.f); }
                    int lo = __builtin_amdgcn_cvt_pk_fp8_f32(v0[0], v0[1], 0, false); lo = __builtin_amdgcn_cvt_pk_fp8_f32(v0[2], v0[3], lo, true);
                    int hi = __builtin_amdgcn_cvt_pk_fp8_f32(v1[0], v1[1], 0, false); hi = __builtin_amdgcn_cvt_pk_fp8_f32(v1[2], v1[3], hi, true);
                    *(LAS u32x2*)(t + fr * 64 + 32 * bj + 8 * fq) = (u32x2){(unsigned)lo, (unsigned)hi}; }
                const u32x4 w = *(const LAS u32x4*)(t + lane * 16);
                stg16<STM>(O + (size_t)(rowb + rrow) * ldc + u.pn * BM + wc * 64 + 16 * rch, w); }
    }
};
__device__ __forceinline__ f32x4 fp8x4_to_f32(unsigned w) { const f32x2 a = __builtin_amdgcn_cvt_pk_f32_fp8((int)w, false), b = __builtin_amdgcn_cvt_pk_f32_fp8((int)w, true); return (f32x4){a.x, a.y, b.x, b.y}; }
template <int STM> struct EpiGateUpT {
    static constexpr bool PERM = true;
    bf16* H; const float* sw;
    __device__ __forceinline__ void operator()(const f32x4 (&acc)[2][2][4][2], const Unit& u, int wr, int wc, int fr, int fq) const {
        const int row0 = u.pm * BM + wr * 64 + fr; const int col0 = u.pn * HALF + wc * 32 + 8 * fq;
#pragma unroll
        for (int ai = 0; ai < 2; ++ai)
#pragma unroll
            for (int m = 0; m < 4; ++m) { const int row = row0 + ai * HALF + m * 16; const float w = sw[row]; f32x4 hv[2];
#pragma unroll
                for (int n = 0; n < 2; ++n) { const f32x4 g = acc[ai][0][m][n], up = acc[ai][1][m][n];
#pragma unroll
                    for (int e = 0; e < 4; ++e) { const float sg = g[e] * __builtin_amdgcn_rcpf(1.0f + __builtin_amdgcn_exp2f(-g[e] * LOG2E)); hv[n][e] = sg * up[e] * w; } }
                u32x4 o; o.x = cvt_pk_bf16(hv[0][0], hv[0][1]); o.y = cvt_pk_bf16(hv[0][2], hv[0][3]); o.z = cvt_pk_bf16(hv[1][0], hv[1][1]); o.w = cvt_pk_bf16(hv[1][2], hv[1][3]);
                stg16<STM>(H + (size_t)row * FH + col0, o); }
    }
};

enum { GK_SKIP = 0, GK_PLAIN = 1, GK_ROPE32 = 2, GK_HEAD16 = 3, GK_IDX8 = 4, GK_WI = 5 };
struct GroupDesc { int kind; bf16* dst; int pitch; int col; float scale; int perm; float* ssq; int ssq_n; int ssq_i; };
struct RopeTabs { const int* pos; };
__device__ __forceinline__ int perm_row(int row, int perm) {
    if (perm == 0) return row; const int b = row >> 11, s = row & 2047;
    return perm == 4 ? (b << 11) + ((s & 3) << 9) + (s >> 2) : (b << 11) + ((s & 15) << 7) + (s >> 4);
}
__device__ __forceinline__ void st16(bf16* p, u32x2 a, u32x2 b) { u32x4 w; w.x = a.x; w.y = a.y; w.z = b.x; w.w = b.y; stg16<NT_EPI>(p, w); }
__device__ __forceinline__ u32x2 pk4(f32x4 v) { u32x2 w; w.x = cvt_pk_bf16(v[0], v[1]); w.y = cvt_pk_bf16(v[2], v[3]); return w; }
__device__ __forceinline__ void swap16(u32x2& X, u32x2& Y) {
    const auto a = __builtin_amdgcn_permlane16_swap(X.x, Y.x, false, false); const auto b = __builtin_amdgcn_permlane16_swap(X.y, Y.y, false, false);
    X.x = a[0]; Y.x = a[1]; X.y = b[0]; Y.y = b[1];
}
__device__ __forceinline__ float rope_k(int i, int rd) { return __builtin_amdgcn_exp2f(-18.931568569324174f * (float)(2 * i) / (float)rd) * 0.15915494309189535f; }
__device__ __forceinline__ void rope_cs(float posf, int i0, int rd, f32x4& c, f32x4& s) {
#pragma unroll
    for (int e = 0; e < 4; ++e) { const float f = __builtin_amdgcn_fractf(posf * rope_k(i0 + e, rd)); s[e] = __builtin_amdgcn_sinf(f); c[e] = __builtin_amdgcn_cosf(f); }
}
template <class DescFn> struct EpiGroups {
    static constexpr bool PERM = true;
    DescFn F; RopeTabs R; const float* rs_ssq; int rs_n; float rs_inv, rs_eps;
    __device__ __forceinline__ void operator()(const f32x4 (&acc)[2][2][4][2], const Unit& u, int wr, int wc, int fr, int fq) const {
        const int row0 = u.pm * BM + wr * 64 + fr;
#pragma unroll
        for (int bj = 0; bj < 2; ++bj) {
            const GroupDesc d = F(u.pn, bj, wc);
            if (d.kind == GK_SKIP) continue;
#if PROBE_P1 == 1
            if (u.fl) continue;
#endif
            const int ki0 = d.kind == GK_ROPE32 ? 4 * fq : (d.kind == GK_HEAD16 ? 4 * (fq & 1) : 0), krd = d.kind == GK_ROPE32 ? 32 : (d.kind == GK_HEAD16 ? 16 : 8);
#pragma unroll
            for (int ai = 0; ai < 2; ++ai)
#pragma unroll
                for (int m = 0; m < 4; ++m) {
                    const int row = row0 + ai * HALF + m * 16;
                    float sc = d.scale;
                    if (rs_ssq) { float s = 0.f; for (int i = 0; i < rs_n; ++i) s += rs_ssq[(size_t)row * rs_n + i]; sc *= __builtin_amdgcn_rsqf(s * rs_inv + rs_eps); }
                    f32x4 v0 = acc[ai][bj][m][0], v1 = acc[ai][bj][m][1];
                    if (d.ssq) {
                        float q = (v0[0] * v0[0] + v0[1] * v0[1]) + (v0[2] * v0[2] + v0[3] * v0[3]) + (v1[0] * v1[0] + v1[1] * v1[1]) + (v1[2] * v1[2] + v1[3] * v1[3]);
                        q += __shfl_xor(q, 16); q += __shfl_xor(q, 32);
                        if (fq == 0) d.ssq[(size_t)row * d.ssq_n + d.ssq_i] = q;
                    }
                    v0 = v0 * sc; v1 = v1 * sc;
                    if (d.kind == GK_WI) { if (fq == 0) { float* wp = (float*)d.dst + (size_t)row * 8; *(f32x4*)wp = v0; *(f32x4*)(wp + 4) = v1; } continue; }
                    bf16* rp = d.dst + (size_t)perm_row(row, d.perm) * d.pitch + d.col;
                    if (d.kind == GK_PLAIN) { st16(rp + 8 * fq, pk4(v0), pk4(v1)); }
                    else if (d.kind == GK_IDX8) {
                        f32x4 c, s; rope_cs((float)R.pos[row], ki0, krd, c, s);
                        const f32x4 o1 = fq == 0 ? v0 * c - v1 * s : v0, o2 = fq == 0 ? v1 * c + v0 * s : v1;
                        st16(rp + 8 * fq, pk4(o1), pk4(o2));
                    } else if (d.kind == GK_ROPE32) {
                        f32x4 c, s; rope_cs((float)R.pos[row], ki0, krd, c, s);
                        u32x2 X = pk4(v0 * c - v1 * s), Y = pk4(v1 * c + v0 * s);
                        swap16(X, Y);
                        st16(rp + ((fq & 1) ? 16 + 4 * (fq - 1) : 4 * fq), X, Y);
                    } else {
                        f32x4 c, s; rope_cs((float)R.pos[row], ki0, krd, c, s);
                        u32x2 X = pk4(fq < 2 ? v0 * c - v1 * s : v0), Y = pk4(fq < 2 ? v1 * c + v0 * s : v1);
                        swap16(X, Y);
                        st16(rp + 16 * (fq >> 1) + 8 * (fq & 1), X, Y);
                    }
                }
        }
    }
};

template <class Epi, class Sched, bool GATHER, int LDA = 0>
__device__ __forceinline__ void gemm_phase(LAS unsigned char* lds, const Gemm g, const Sched& S, const Epi& E, const int tid) {
    const int wid = __builtin_amdgcn_readfirstlane(tid >> 6), lane = tid & 63, wr = wid >> 2, wc = wid & 3, fr = lane & 15, fq = lane >> 4;
    const int K = g.K, nt = K / BK, lda = LDA ? LDA : K;
    unsigned voA[2][2], voB[2]; int RA[2], CA[2];
#pragma unroll
    for (int i = 0; i < 2; ++i) { int R, C; stage_rc(tid * 16 + i * 8192, R, C); const int Rb = Epi::PERM ? ((R & ~31) + perm32(R & 31)) : R;
        RA[i] = R; CA[i] = C; voA[0][i] = (unsigned)(R * lda + C) * 2u; voA[1][i] = (unsigned)((R + HALF) * lda + C) * 2u; voB[i] = (unsigned)(Rb * K + C) * 2u; }
    const size_t kstep = (size_t)(BK * 2);
    const size_t hstep = (size_t)HALF * K * 2;
    const size_t tstep = 2 * hstep;
    const size_t tstepA = (size_t)BM * lda * 2;
    const unsigned ldsw = (unsigned)wid * 1024u;
    const int aoff = lds_byte(wr * 64 + fr, fq * 8), boff = lds_byte(wc * 32 + fr, fq * 8);
#define PG8_SA(b, h) (((b) * 2 + (h)) * HTB)
#define PG8_SB(b, h) ((4 + (b) * 2 + (h)) * HTB)
#define PG8_STAGE(bufoff, gbase, voff) do { _Pragma("unroll") for (int _i = 0; _i < 2; ++_i) \
        __builtin_amdgcn_global_load_lds((const unsigned*)((const char*)(gbase) + (voff)[_i]), (LAS unsigned*)(lds + (bufoff) + ldsw + _i * 8192), 16, 0, 0); } while (0)
#define PG8_LDA(dst, b, h) do { _Pragma("unroll") for (int m = 0; m < 4; ++m) _Pragma("unroll") for (int k = 0; k < 2; ++k) dst[m][k] = *(const LAS bf16x8*)(lds + PG8_SA(b, h) + aoff + m * 2048 + k * 1024); } while (0)
#define PG8_LDB(dst, b, h) do { _Pragma("unroll") for (int n = 0; n < 2; ++n) _Pragma("unroll") for (int k = 0; k < 2; ++k) dst[n][k] = *(const LAS bf16x8*)(lds + PG8_SB(b, h) + boff + n * 2048 + k * 1024); } while (0)
#define PG8_MMA(ai, bj, At, Bt) do { __builtin_amdgcn_s_setprio(1); _Pragma("unroll") for (int m = 0; m < 4; ++m) _Pragma("unroll") for (int n = 0; n < 2; ++n) _Pragma("unroll") for (int k = 0; k < 2; ++k) \
        acc[ai][bj][m][n] = __builtin_amdgcn_mfma_f32_16x16x32_bf16(Bt[n][k], At[m][k], acc[ai][bj][m][n], 0, 0, 0); __builtin_amdgcn_s_setprio(0); } while (0)
#define PG8_WAIT_V(n) asm volatile("s_waitcnt vmcnt(" #n ")" ::: "memory")
#define PG8_WAIT_L(n) asm volatile("s_waitcnt lgkmcnt(" #n ")" ::: "memory")
#define PG8_BAR __builtin_amdgcn_s_barrier()
#define PG8_SCHED __builtin_amdgcn_sched_barrier(0)
    Unit cur, nxt; int ui = 0;
    if (!S.next(0, cur)) return;
    f32x4 acc[2][2][4][2];
#pragma unroll
    for (int a = 0; a < 2; ++a)
#pragma unroll
        for (int b = 0; b < 2; ++b)
#pragma unroll
            for (int m = 0; m < 4; ++m)
#pragma unroll
                for (int n = 0; n < 2; ++n) acc[a][b][m][n] = (f32x4){0.f, 0.f, 0.f, 0.f};
    bf16x8 At[4][2], B0[2][2], B1[2][2];
    unsigned nvA[2][2];
    const char* cA; const char* cB = (const char*)g.Bt + (size_t)cur.pb * tstep;
    if constexpr (GATHER) { cA = (const char*)g.A;
#pragma unroll
        for (int h = 0; h < 2; ++h)
#pragma unroll
            for (int i = 0; i < 2; ++i) voA[h][i] = (unsigned)g.gidx[cur.pm * BM + h * HALF + RA[i]] * (unsigned)(lda * 2) + (unsigned)CA[i] * 2u;
    } else cA = (const char*)g.A + (size_t)cur.pm * tstepA;
    PG8_STAGE(PG8_SB(0, 0), cB, voB); PG8_STAGE(PG8_SB(0, 1), cB + hstep, voB); PG8_STAGE(PG8_SA(0, 0), cA, voA[0]); PG8_STAGE(PG8_SA(0, 1), cA, voA[1]);
    if (wr == 1) PG8_BAR;
    PG8_WAIT_V(2); PG8_BAR;
    PG8_STAGE(PG8_SB(1, 0), cB + kstep, voB); PG8_STAGE(PG8_SA(1, 0), cA + kstep, voA[0]); PG8_STAGE(PG8_SB(1, 1), cB + hstep + kstep, voB);
    PG8_WAIT_V(6); PG8_BAR;
    for (;;) {
        const bool has_next = S.next(ui + 1, nxt);
        const char* nA; const char* nB = has_next ? (const char*)g.Bt + (size_t)nxt.pb * tstep : cB;
        if constexpr (GATHER) { nA = cA;
#pragma unroll
            for (int h = 0; h < 2; ++h)
#pragma unroll
                for (int i = 0; i < 2; ++i) nvA[h][i] = has_next ? (unsigned)g.gidx[nxt.pm * BM + h * HALF + RA[i]] * (unsigned)(lda * 2) + (unsigned)CA[i] * 2u : voA[h][i];
        } else nA = has_next ? (const char*)g.A + (size_t)nxt.pm * tstepA : cA;
#if PROBE_P1 == 2
        const int ntu = cur.fl ? 2 : nt;
#else
        const int ntu = nt;
#endif
#pragma nounroll
        for (int t = 0; t < ntu; t += 2) {
            const bool last = (t == ntu - 2);
            const char* a1 = cA + (size_t)(t + 1) * kstep;
            const char* a2 = last ? nA : cA + (size_t)(t + 2) * kstep; const char* b2 = last ? nB : cB + (size_t)(t + 2) * kstep;
            const char* a3 = a2 + kstep; const char* b3 = b2 + kstep;
            unsigned xA[2][2];
#pragma unroll
            for (int h = 0; h < 2; ++h)
#pragma unroll
                for (int i = 0; i < 2; ++i) xA[h][i] = (GATHER && last) ? nvA[h][i] : voA[h][i];
            PG8_LDB(B0, 0, 0); PG8_LDB(B1, 0, 1); PG8_SCHED; PG8_LDA(At, 0, 0); PG8_STAGE(PG8_SA(1, 1), a1, voA[1]);
            PG8_WAIT_V(8); PG8_WAIT_L(0); PG8_BAR; PG8_MMA(0, 0, At, B0); PG8_MMA(0, 1, At, B1); PG8_BAR; PG8_SCHED;
            PG8_LDA(At, 0, 1); PG8_STAGE(PG8_SB(0, 0), b2, voB); PG8_STAGE(PG8_SB(0, 1), b2 + hstep, voB); PG8_STAGE(PG8_SA(0, 0), a2, xA[0]);
            PG8_WAIT_V(8); PG8_WAIT_L(0); PG8_BAR; PG8_MMA(1, 0, At, B0); PG8_MMA(1, 1, At, B1); PG8_BAR; PG8_SCHED;
            PG8_LDB(B0, 1, 0); PG8_LDB(B1, 1, 1); PG8_SCHED; PG8_LDA(At, 1, 0); PG8_STAGE(PG8_SA(0, 1), a2, xA[1]);
            PG8_WAIT_V(8); PG8_WAIT_L(0); PG8_BAR; PG8_MMA(0, 0, At, B0); PG8_MMA(0, 1, At, B1); PG8_BAR; PG8_SCHED;
            PG8_LDA(At, 1, 1); PG8_STAGE(PG8_SB(1, 0), b3, voB); PG8_STAGE(PG8_SB(1, 1), b3 + hstep, voB); PG8_STAGE(PG8_SA(1, 0), a3, xA[0]);
            PG8_WAIT_V(8); PG8_WAIT_L(0); PG8_BAR; PG8_MMA(1, 0, At, B0); PG8_MMA(1, 1, At, B1); PG8_BAR; PG8_SCHED;
        }
        if (wr == 0) PG8_BAR;
        E(acc, cur, wr, wc, fr, fq);
        if (!has_next) break;
#pragma unroll
        for (int a = 0; a < 2; ++a)
#pragma unroll
            for (int b = 0; b < 2; ++b)
#pragma unroll
                for (int m = 0; m < 4; ++m)
#pragma unroll
                    for (int n = 0; n < 2; ++n) acc[a][b][m][n] = (f32x4){0.f, 0.f, 0.f, 0.f};
        cur = nxt; cA = nA; cB = nB; ++ui;
        if constexpr (GATHER) {
#pragma unroll
            for (int h = 0; h < 2; ++h)
#pragma unroll
                for (int i = 0; i < 2; ++i) voA[h][i] = nvA[h][i];
        }
        if (wr == 1) PG8_BAR;
    }
    PG8_WAIT_V(0);
    PG8_BAR;
#undef PG8_SA
#undef PG8_SB
#undef PG8_STAGE
#undef PG8_LDA
#undef PG8_LDB
#undef PG8_MMA
#undef PG8_WAIT_V
#undef PG8_WAIT_L
#undef PG8_BAR
#undef PG8_SCHED
}
}

#ifndef PROBE_LDS2
#define PROBE_LDS2 0
#endif
#ifndef PROBE_EXP2
#define PROBE_EXP2 0
#endif
#ifndef SOFTMAX_PK
#define SOFTMAX_PK 0
#endif
#ifndef FA_FUSE
#define FA_FUSE 0
#endif
namespace fa {
constexpr int VBYTES_T = 64 * 128;
typedef short v4i16_t __attribute__((ext_vector_type(4)));
__device__ __forceinline__ u32x2 vtr(const LAS unsigned char* p) { return __builtin_bit_cast(u32x2, __builtin_amdgcn_ds_read_tr16_b64_v4i16((LAS v4i16_t*)p)); }
__device__ __forceinline__ float max16(const f32x16& c) { float r;
    asm("v_max3_f32 %0, %1, %2, %3\n\tv_max3_f32 %0, %0, %4, %5\n\tv_max3_f32 %0, %0, %6, %7\n\tv_max3_f32 %0, %0, %8, %9\n\tv_max3_f32 %0, %0, %10, %11\n\tv_max3_f32 %0, %0, %12, %13\n\tv_max3_f32 %0, %0, %14, %15\n\tv_max_f32 %0, %0, %16"
        : "=&v"(r) : "v"(c[0]), "v"(c[1]), "v"(c[2]), "v"(c[3]), "v"(c[4]), "v"(c[5]), "v"(c[6]), "v"(c[7]), "v"(c[8]), "v"(c[9]), "v"(c[10]), "v"(c[11]), "v"(c[12]), "v"(c[13]), "v"(c[14]), "v"(c[15]));
    return r; }
__device__ __forceinline__ void mask_init(f32x16& S, unsigned nw) { float t0, t1, t2, t3, t4, t5, t6, t7, t8, t9, t10, t11, t12, t13, t14, t15;
    asm("v_bfe_i32 %0, %16, 0, 1\n\tv_lshlrev_b32 %0, 23, %0\n\tv_bfe_i32 %1, %16, 1, 1\n\tv_lshlrev_b32 %1, 23, %1\n\tv_bfe_i32 %2, %16, 2, 1\n\tv_lshlrev_b32 %2, 23, %2\n\tv_bfe_i32 %3, %16, 3, 1\n\tv_lshlrev_b32 %3, 23, %3\n\tv_bfe_i32 %4, %16, 8, 1\n\tv_lshlrev_b32 %4, 23, %4\n\tv_bfe_i32 %5, %16, 9, 1\n\tv_lshlrev_b32 %5, 23, %5\n\tv_bfe_i32 %6, %16, 10, 1\n\tv_lshlrev_b32 %6, 23, %6\n\tv_bfe_i32 %7, %16, 11, 1\n\tv_lshlrev_b32 %7, 23, %7\n\tv_bfe_i32 %8, %16, 16, 1\n\tv_lshlrev_b32 %8, 23, %8\n\tv_bfe_i32 %9, %16, 17, 1\n\tv_lshlrev_b32 %9, 23, %9\n\tv_bfe_i32 %10, %16, 18, 1\n\tv_lshlrev_b32 %10, 23, %10\n\tv_bfe_i32 %11, %16, 19, 1\n\tv_lshlrev_b32 %11, 23, %11\n\tv_bfe_i32 %12, %16, 24, 1\n\tv_lshlrev_b32 %12, 23, %12\n\tv_bfe_i32 %13, %16, 25, 1\n\tv_lshlrev_b32 %13, 23, %13\n\tv_bfe_i32 %14, %16, 26, 1\n\tv_lshlrev_b32 %14, 23, %14\n\tv_bfe_i32 %15, %16, 27, 1\n\tv_lshlrev_b32 %15, 23, %15"
        : "=&v"(t0), "=&v"(t1), "=&v"(t2), "=&v"(t3), "=&v"(t4), "=&v"(t5), "=&v"(t6), "=&v"(t7), "=&v"(t8), "=&v"(t9), "=&v"(t10), "=&v"(t11), "=&v"(t12), "=&v"(t13), "=&v"(t14), "=&v"(t15) : "v"(nw));
    S[0] = t0; S[1] = t1; S[2] = t2; S[3] = t3; S[4] = t4; S[5] = t5; S[6] = t6; S[7] = t7; S[8] = t8; S[9] = t9; S[10] = t10; S[11] = t11; S[12] = t12; S[13] = t13; S[14] = t14; S[15] = t15; }
struct Params {
    const bf16* Q;  int q_pitch;
    const bf16* K1; int k1_pitch, k1_col;
    const bf16* K2; int k2_pitch, k2_col;
    const bf16* V;  int v_pitch, v_col;
    bf16* O; int o_pitch;
    float* LSE; int lse_pitch;
    const unsigned* BM;
    int CL, W;
};
struct UnitDesc { int seq0, qw, q_col, o_col, lse_col, k1_col, v_col, kt_lo, kt_hi; };
template <int DQK, int MODE, int NH, class DescFn>
__device__ __forceinline__ void attn_stream(const Params& P, LAS unsigned char* lds, const int tid, const int n_units, DescFn desc) {
    constexpr int NKS = DQK / 16, AHEAD = (NH == 2 ? 3 : 4), NST = AHEAD + 1, K1B = 8192 * NH, K2B = (DQK == 96 ? 4096 : 0), BMOFF = K1B + K2B + 8192 * NH, STB = BMOFF + (MODE == 1 ? 8192 : 0);
    constexpr int NDMA = 2 * NH + (DQK == 96 ? 1 : 0) + (MODE == 1 ? 1 : 0);
    static_assert(NH == 1 || (DQK == 64 && MODE != 1), "two-head stages: head dim 64 only");
    constexpr bool active = true;
    if (n_units <= 0) return;
    const int lane = tid & 63, r = lane & 31, h = lane >> 5, wave = __builtin_amdgcn_readfirstlane(tid >> 6);
    const int tq_ = (lane & 15) >> 2, tp_ = lane & 3, tg_ = lane >> 4;
    const int hsel = NH == 2 ? (wave >> 2) * 8192 : 0;
    const int vtoff = K1B + K2B + hsel + (4 * h + tq_) * 128, vxb = 2 * (16 * (tg_ & 1) + 4 * tp_), vsw = (tq_ >> 1) & 1;
    const int vx0 = vxb + ((0 ^ vsw) << 6), vx1 = vxb + ((1 ^ vsw) << 6);
    const int s1_ = (r >> 1) & 7, s2_ = (r >> 2) & 3;
    const int k1row = hsel + r * 128, k2row = K1B + r * 64;
    const int row1 = 8 * wave + (lane >> 3), row2 = 16 * (wave & 3) + (lane >> 2);
    const size_t tk1 = (size_t)64 * P.k1_pitch, tk2 = (size_t)64 * P.k2_pitch, tv = (size_t)64 * P.v_pitch;
    const int d_k1 = wave * 1024, d_k2 = K1B + (wave & 3) * 1024, d_v = K1B + K2B + wave * 1024;
    const bf16* src_k1; const bf16* src_v; const bf16* src_k2 = nullptr; const unsigned* bmp = nullptr;
    int ji = -1, kti = 1, kti_hi = 0;
    auto fa_issue = [&](const int st) __attribute__((always_inline)) {
        if (kti > kti_hi) {
            if (ji + 1 < n_units) { ++ji; const UnitDesc t = desc(ji); kti = t.kt_lo; kti_hi = t.kt_hi;
                src_k1 = P.K1 + (size_t)(t.seq0 + row1) * P.k1_pitch + t.k1_col + 8 * ((lane & 7) ^ ((row1 >> 1) & 7));
                src_v = P.V + (size_t)(t.seq0 + row1) * P.v_pitch + t.v_col + 8 * ((lane & 7) ^ (((row1 >> 1) & 1) << 2));
                if constexpr (DQK == 96) src_k2 = P.K2 + (size_t)(t.seq0 + row2) * P.k2_pitch + P.k2_col + 8 * ((lane & 3) ^ ((row2 >> 2) & 3));
                if constexpr (MODE == 1) bmp = P.BM + (size_t)(t.seq0 + t.qw + r) * 64;
            } else kti = kti_hi; }
        LAS unsigned char* sb_ = lds + st * STB;
        __builtin_amdgcn_global_load_lds((const unsigned*)(src_k1 + kti * tk1), (LAS unsigned*)(sb_ + d_k1), 16, 0, 0);
        __builtin_amdgcn_global_load_lds((const unsigned*)(src_v + kti * tv), (LAS unsigned*)(sb_ + d_v), 16, 0, 0);
        if constexpr (NH == 2) {
            __builtin_amdgcn_global_load_lds((const unsigned*)(src_k1 + 64 + kti * tk1), (LAS unsigned*)(sb_ + d_k1 + 8192), 16, 0, 0);
            __builtin_amdgcn_global_load_lds((const unsigned*)(src_v + 64 + kti * tv), (LAS unsigned*)(sb_ + d_v + 8192), 16, 0, 0); }
        if constexpr (DQK == 96) __builtin_amdgcn_global_load_lds((const unsigned*)(src_k2 + kti * tk2), (LAS unsigned*)(sb_ + d_k2), 16, 0, 0);
        if constexpr (MODE == 1) __builtin_amdgcn_global_load_lds(bmp + (kti & ~1) * 2, (LAS unsigned*)(sb_ + BMOFF + wave * 1024), 16, 0, 0);
        ++kti; };
#define FA_ISSUE(TILE, ST) fa_issue(ST)
    int st_is = 0, st_c = 0, st_n = 1;
    bf16x8 qf[NKS];
#define FA_LOADQ(D) do { const bf16* qp_ = P.Q + (size_t)((D).seq0 + (D).qw + r) * P.q_pitch + (D).q_col + 8 * h; \
        _Pragma("unroll") for (int ks = 0; ks < NKS; ++ks) asm volatile("global_load_dwordx4 %0, %1, off offset:%2" : "=&v"(qf[ks]) : "v"(qp_), "n"(32 * ks) : "memory"); } while (0)
#define FA_WAITQ(N) do { if constexpr (NKS == 6) asm volatile("s_waitcnt vmcnt(%6)" : "+v"(qf[0]), "+v"(qf[1]), "+v"(qf[2]), "+v"(qf[3]), "+v"(qf[4]), "+v"(qf[5]) : "n"(N) : "memory"); \
        else asm volatile("s_waitcnt vmcnt(%4)" : "+v"(qf[0]), "+v"(qf[1]), "+v"(qf[2]), "+v"(qf[3]) : "n"(N) : "memory"); } while (0)
    { const UnitDesc d0 = desc(0); FA_LOADQ(d0); FA_WAITQ(0); }
#pragma unroll 1
    for (int ju = 0; ju < n_units; ++ju) {
    const UnitDesc du = desc(ju);
    const int seq0 = du.seq0, qw = du.qw, q_col = du.q_col, o_col = du.o_col, lse_col = du.lse_col, kt_lo = du.kt_lo, kt_hi = du.kt_hi;
    const int q = qw + r;
    const int lo_q = MODE == 0 ? max(q & ~(P.CL - 1), q - P.W) : 0;
    const int qh = q - 4 * h, lqh = lo_q - 4 * h;
    const int lo_w0 = MODE == 0 ? max(qw & ~(P.CL - 1), qw - P.W) : 0;
    const int lo_w1 = MODE == 0 ? max((qw + 31) & ~(P.CL - 1), qw + 31 - P.W) : 0;
#define FA_WAITBAR(N) do { asm volatile("s_waitcnt vmcnt(%0)" :: "n"(N) : "memory"); __builtin_amdgcn_s_barrier(); asm volatile("" ::: "memory"); } while (0)
    f32x16 o0, o1, c0, c1, n0, n1;
#pragma unroll
    for (int i = 0; i < 16; ++i) { o0[i] = 0.f; o1[i] = 0.f; c0[i] = 0.f; c1[i] = 0.f; n0[i] = 0.f; n1[i] = 0.f; }
    float m = -INFINITY, l = 0.f;
#define FA_PART(kt_) (active && (MODE == 0 ? ((kt_) * 64 <= qw + 31 && (kt_) * 64 + 63 >= lo_w0) : ((kt_) * 64 <= qw + 31)))
#define FA_KADDR(SB_, ROFF, ks) ((ks) < 4 ? (SB_) + (ROFF) * 128 + k1row + 16 * ((2 * (ks) + h) ^ s1_) : (SB_) + (ROFF) * 64 + k2row + 16 * ((2 * ((ks) - 4) + h) ^ s2_))
#define FA_QKH(S, SB_, ROFF, NW) do { bf16x8 fa_[NKS]; \
        _Pragma("unroll") for (int ks = 0; ks < NKS; ++ks) fa_[ks] = *(const LAS bf16x8*)FA_KADDR(SB_, ROFF, ks); \
        if (PROBE_LDS2) { _Pragma("unroll") for (int ks = 0; ks < NKS; ++ks) { const bf16x8 fb_ = *(const volatile LAS bf16x8*)FA_KADDR(SB_, (ROFF) ^ 32, ks); asm volatile("" :: "v"(fb_)); } } \
        if constexpr (MODE == 1) {        \
            mask_init(S, NW); \
        } else { _Pragma("unroll") for (int i = 0; i < 16; ++i) S[i] = 0.f; } \
        _Pragma("unroll") for (int ks = 0; ks < NKS; ++ks) S = __builtin_amdgcn_mfma_f32_32x32x16_bf16(fa_[ks], qf[ks], S, 0, 0, 0); \
        __builtin_amdgcn_sched_group_barrier(0x100, NKS, 0); __builtin_amdgcn_sched_group_barrier(0x008, NKS, 0); } while (0)
#define FA_QK(S0, S1, SB_, KT) do { unsigned nwa_ = 0u, nwb_ = 0u; \
        if constexpr (MODE == 1) { const u32x4 bw_ = *(const LAS u32x4*)((SB_) + BMOFF + wave * 1024 + lane * 16);        \
            nwa_ = ~((((KT) & 1) ? bw_.z : bw_.x) >> (4 * h)); nwb_ = ~((((KT) & 1) ? bw_.w : bw_.y) >> (4 * h)); } \
        FA_QKH(S0, SB_, 0, nwa_); FA_QKH(S1, SB_, 32, nwb_); } while (0)
#define FA_QKX(S, SB_, ROFF) do { bf16x8 fa_[NKS]; \
        _Pragma("unroll") for (int ks = 0; ks < NKS; ++ks) fa_[ks] = *(const LAS bf16x8*)FA_KADDR(SB_, ROFF, ks); \
        _Pragma("unroll") for (int i = 0; i < 16; ++i) S[i] = 0.f; \
        _Pragma("unroll") for (int ks = 0; ks < NKS; ++ks) S = __builtin_amdgcn_mfma_f32_32x32x16_bf16(fa_[ks], qf[ks], S, 0, 0, 0); } while (0)
    if (ju == 0) {
#pragma unroll 1
        for (int a = 0; a < AHEAD; ++a) { FA_ISSUE(kt_lo + a, st_is); st_is = st_is + 1; }
        FA_WAITBAR((AHEAD - 2) * NDMA);
    }
    if (FA_PART(kt_lo)) FA_QK(c0, c1, lds + st_c * STB, kt_lo);
    auto fa_step = [&](f32x16& c0, f32x16& c1, f32x16& n0, f32x16& n1, const int kt) __attribute__((always_inline)) {
        FA_ISSUE(kt + AHEAD, st_is); st_is = (st_is + 1 == NST) ? 0 : st_is + 1;
        const bool more1 = kt < kt_hi;
        const bool qnext = !more1 && (ju + 1 < n_units);
        if (qnext) { const UnitDesc dq = desc(ju + 1); FA_LOADQ(dq); }
        const int k0 = kt * 64;
        const bool part_c = FA_PART(kt), part_n = more1 && FA_PART(kt + 1);
        const LAS unsigned char* Sn = lds + st_n * STB; const LAS unsigned char* Vb = lds + st_c * STB;
        const bool fused = FA_FUSE && (DQK == 64) && part_c && part_n;
        if (part_n && !fused) FA_QK(n0, n1, Sn, kt + 1);
        if (part_c) {
            float alpha;
#define FA_SOFTMAX(MASKED) do { \
            if (MASKED) { if constexpr (MODE == 2) { const int qa = qh - k0, qa1 = qa - 32; \
                    _Pragma("unroll") for (int i = 0; i < 16; ++i) { const int ci = (i & 3) + 8 * (i >> 2); \
                        c0[i] = (ci > qa) ? -INFINITY : c0[i]; c1[i] = (ci > qa1) ? -INFINITY : c1[i]; } \
                } else if constexpr (MODE == 0) { const int lb = lqh - k0; const unsigned span = (unsigned)(q - lo_q), lb1 = (unsigned)(lb - 32);     \
                    _Pragma("unroll") for (int i = 0; i < 16; ++i) { const int ci = (i & 3) + 8 * (i >> 2); \
                        c0[i] = ((unsigned)(ci - lb) > span) ? -INFINITY : c0[i]; c1[i] = ((unsigned)ci - lb1 > span) ? -INFINITY : c1[i]; } \
                } } \
            float mx = xhalf_max(fmaxf(max16(c0), max16(c1))); \
            const float mn = fmaxf(m, mx); \
            const float ms = (mn == -INFINITY) ? 0.f : mn; \
            alpha = __builtin_amdgcn_exp2f(m - ms); \
            m = mn; \
            float ls = 0.f; \
            if (PROBE_EXP2) { float dm_ = 0.f; _Pragma("unroll") for (int i = 0; i < 16; ++i) { dm_ += __builtin_amdgcn_exp2f(c0[i] - mx) + __builtin_amdgcn_exp2f(c1[i] - mx); } asm volatile("" :: "v"(dm_)); } \
            if (SOFTMAX_PK) { const f32x2 ms2 = {ms, ms}; f32x2 lsa = {0.f, 0.f}, lsb = {0.f, 0.f};            \
              _Pragma("unroll") for (int i = 0; i < 16; i += 2) { \
                  f32x2 ta = {c0[i], c0[i + 1]}, tb = {c1[i], c1[i + 1]}; ta = ta - ms2; tb = tb - ms2; \
                  ta.x = __builtin_amdgcn_exp2f(ta.x); ta.y = __builtin_amdgcn_exp2f(ta.y); tb.x = __builtin_amdgcn_exp2f(tb.x); tb.y = __builtin_amdgcn_exp2f(tb.y); \
                  c0[i] = ta.x; c0[i + 1] = ta.y; c1[i] = tb.x; c1[i + 1] = tb.y; lsa = lsa + ta; lsb = lsb + tb; } \
              lsa = lsa + lsb; ls = lsa.x + lsa.y; \
            } else {        \
              _Pragma("unroll") for (int i = 0; i < 16; ++i) { c0[i] = __builtin_amdgcn_exp2f(c0[i] - ms); c1[i] = __builtin_amdgcn_exp2f(c1[i] - ms); ls += c0[i] + c1[i]; } } \
            l = l * alpha + ls; } while (0)
            const bool need_mask = MODE == 1 ? false : (MODE == 2 ? (k0 + 63 > qw) : ((k0 + 63 > qw) || (k0 < lo_w1)));
#define FA_FUSED(MASKED) do { FA_QKX(n0, Sn, 0); FA_QKX(n1, Sn, 32); FA_SOFTMAX(MASKED); \
            _Pragma("unroll") for (int hh_ = 0; hh_ < 2; ++hh_) { \
                __builtin_amdgcn_sched_group_barrier(0x100, NKS, 0); \
                _Pragma("unroll") for (int i = 0; i < NKS; ++i) { __builtin_amdgcn_sched_group_barrier(0x008, 1, 0); __builtin_amdgcn_sched_group_barrier(0x002, 120 / (2 * NKS), 0); } } } while (0)
            if (fused) { if (need_mask) FA_FUSED(true); else FA_FUSED(false); }
            else { if (need_mask) FA_SOFTMAX(true); else FA_SOFTMAX(false); }
#undef FA_FUSED
#undef FA_SOFTMAX
            if (!__all(alpha == 1.0f)) {
#pragma unroll
                for (int i = 0; i < 16; ++i) { o0[i] *= alpha; o1[i] *= alpha; } }
            const unsigned va0_ = (unsigned)(size_t)(Vb + vtoff + vx0), va1_ = (unsigned)(size_t)(Vb + vtoff + vx1);
#define FA_PV(S_, O0, O1, O2, O3) do { \
                u32x2 va00, vb00, va01, vb01, va10, vb10, va11, vb11;                           \
                asm volatile("ds_read_b64_tr_b16 %0, %8 offset:%10\n\tds_read_b64_tr_b16 %1, %8 offset:%11\n\tds_read_b64_tr_b16 %2, %9 offset:%10\n\tds_read_b64_tr_b16 %3, %9 offset:%11\n\t" \
                             "ds_read_b64_tr_b16 %4, %8 offset:%12\n\tds_read_b64_tr_b16 %5, %8 offset:%13\n\tds_read_b64_tr_b16 %6, %9 offset:%12\n\tds_read_b64_tr_b16 %7, %9 offset:%13" \
                             : "=&v"(va00), "=&v"(vb00), "=&v"(va01), "=&v"(vb01), "=&v"(va10), "=&v"(vb10), "=&v"(va11), "=&v"(vb11) \
                             : "v"(va0_), "v"(va1_), "n"(O0), "n"(O1), "n"(O2), "n"(O3) : "memory"); \
                bf16x8 pf[2]; \
                _Pragma("unroll") for (int sk = 0; sk < 2; ++sk) { u32x4 pw; pw.x = pk2(S_[8 * sk + 0], S_[8 * sk + 1]); pw.y = pk2(S_[8 * sk + 2], S_[8 * sk + 3]); pw.z = pk2(S_[8 * sk + 4], S_[8 * sk + 5]); pw.w = pk2(S_[8 * sk + 6], S_[8 * sk + 7]); pf[sk] = __builtin_bit_cast(bf16x8, pw); } \
                asm volatile("s_waitcnt lgkmcnt(0)" : "+v"(va00), "+v"(vb00), "+v"(va01), "+v"(vb01), "+v"(va10), "+v"(vb10), "+v"(va11), "+v"(vb11) :: "memory"); \
                __builtin_amdgcn_sched_barrier(0); \
                { const u32x4 v0w = {va00.x, va00.y, vb00.x, vb00.y}, v1w = {va01.x, va01.y, vb01.x, vb01.y}; \
                  o0 = __builtin_amdgcn_mfma_f32_32x32x16_bf16(__builtin_bit_cast(bf16x8, v0w), pf[0], o0, 0, 0, 0); \
                  o1 = __builtin_amdgcn_mfma_f32_32x32x16_bf16(__builtin_bit_cast(bf16x8, v1w), pf[0], o1, 0, 0, 0); } \
                { const u32x4 v0w = {va10.x, va10.y, vb10.x, vb10.y}, v1w = {va11.x, va11.y, vb11.x, vb11.y}; \
                  o0 = __builtin_amdgcn_mfma_f32_32x32x16_bf16(__builtin_bit_cast(bf16x8, v0w), pf[1], o0, 0, 0, 0); \
                  o1 = __builtin_amdgcn_mfma_f32_32x32x16_bf16(__builtin_bit_cast(bf16x8, v1w), pf[1], o1, 0, 0, 0); } } while (0)
            FA_PV(c0, 0, 1024, 2048, 3072);
            FA_PV(c1, 4096, 5120, 6144, 7168);
#undef FA_PV
        }
        if (qnext) FA_WAITBAR((AHEAD - 2) * NDMA + NKS); else FA_WAITBAR((AHEAD - 2) * NDMA);
        st_c = st_n; st_n = (st_n + 1 == NST) ? 0 : st_n + 1;
    };
    for (int kt = kt_lo;;) { fa_step(c0, c1, n0, n1, kt); if (++kt > kt_hi) break; fa_step(n0, n1, c0, c1, kt); if (++kt > kt_hi) break; }
#undef FA_PART
#undef FA_QK
#undef FA_QKH
#undef FA_QKX
#undef FA_KADDR
    const float lt = xhalf_sum(l);
    const float inv = 1.0f / lt;
    if (active) {
    bf16* op = P.O + (size_t)(seq0 + q) * P.o_pitch + o_col + 8 * h;
#pragma unroll
    for (int db = 0; db < 2; ++db) {
        const f32x16& o = db ? o1 : o0;
#pragma unroll
        for (int j = 0; j < 2; ++j) {
            u32x2 X, Y;
            X.x = pk2(o[8 * j] * inv, o[8 * j + 1] * inv); X.y = pk2(o[8 * j + 2] * inv, o[8 * j + 3] * inv);
            Y.x = pk2(o[8 * j + 4] * inv, o[8 * j + 5] * inv); Y.y = pk2(o[8 * j + 6] * inv, o[8 * j + 7] * inv);
            const auto a = __builtin_amdgcn_permlane32_swap(X.x, Y.x, false, false); const auto b = __builtin_amdgcn_permlane32_swap(X.y, Y.y, false, false);
            u32x4 w; w.x = a[0]; w.y = b[0]; w.z = a[1]; w.w = b[1];
            stg16<NT_ATT>(op + 32 * db + 16 * j, w);
        }
    }
    if (P.LSE && h == 0) P.LSE[(size_t)(seq0 + q) * P.lse_pitch + lse_col] = m + __builtin_amdgcn_logf(lt);
    }
    __builtin_amdgcn_sched_barrier(0);
    FA_WAITQ(4);
    }
    asm volatile("s_waitcnt vmcnt(0)" ::: "memory"); __builtin_amdgcn_s_barrier(); asm volatile("" ::: "memory");
#undef FA_ISSUE
#undef FA_LOADQ
#undef FA_WAITQ
#undef FA_WAITBAR
}
}

struct Args {
    const float* x; const int* pos; const float* w_in; const float* qn; const float* kvn; const float* w_uq; const float* w_ukv; const float* w_o;
    const float* ln1g; const float* ln1b; const float* rgw; const float* rgb; const float* rew; const float* reb;
    const float* wg; const float* wu; const float* wd; const float* ln2g; const float* ln2b;
    float* out; unsigned char* ws; int l_lo, l_hi, ph_lo, ph_hi, use_bar, pad;
};
typedef const __attribute__((address_space(4))) Args CArgs;
struct Ctx { LAS unsigned char* lds; int tid, lane, wave, G, c, vcu; unsigned char* ws; };

struct ColIdent { int off; __device__ __forceinline__ int operator()(int P) const { return off + P; } };
struct ColAdj { __device__ __forceinline__ int operator()(int P) const { const int p = P & 255; return (P & ~255) + 64 * ((p >> 5) & 3) + 32 * (p >> 7) + (p & 31); } };
__device__ __forceinline__ int map_rope32(int p) { return 16 * ((p >> 2) & 1) + 4 * (p >> 3) + (p & 3); }
__device__ __forceinline__ int map_head16(int p) { const int fq = p >> 3; return 16 * (fq >> 1) + 8 * ((p >> 2) & 1) + 4 * (fq & 1) + (p & 3); }
struct ColWin {
    __device__ __forceinline__ int operator()(int P) const {
        const int G = P >> 5, p = P & 31;
        if (G < 8) return 32 * G + p;
        if (G < 12) return 256 + 32 * (G - 8) + p;
        if (G == 12) return 384 + map_rope32(p);
        if (G == 13) return 1056 + p;
        if (G == 14) return 672 + map_head16(p);
        if (G == 15) return 704 + p;
        if (G < 24) { const int hh = (G - 16) >> 1; return 416 + 64 * hh + (((G - 16) & 1) ? 32 + p : map_head16(p)); }
        if (G < 26) return 736 + 32 * (G - 24) + p;
        if (G == 26) return p < 8 ? 1088 + p : -1;
        if (G < 32) return -1;
        if (G < 40) return 800 + 32 * (G - 32) + p;
        if (G < 64) { const int j = G - 40; return 1096 + 64 * (j >> 1) + ((j & 1) ? 32 + p : map_head16(p)); }
        if (G < 88) { const int j = G - 64; return 1096 + 768 + 64 * (j >> 1) + ((j & 1) ? 32 + p : map_head16(p)); }
        return 1096 + 1536 + 32 * (G - 88) + p;
    }
};
struct ColUq {
    __device__ __forceinline__ int operator()(int P) const { const int G = P >> 5, p = P & 31; return 32 * G + ((G % 3 == 2) ? map_rope32(p) : p); }
};
template <class ColFn>
__device__ __forceinline__ void transpose_item(const float* W, int ldw, int kvalid, bf16* WT, int ldt, int k0, int P0, const ColFn& cf, const float* rowscale, LAS float* scr, int lane) {
    const int c = lane & 31, col = cf(P0 + c);
#pragma unroll 8
    for (int i = 0; i < 32; ++i) { const int kk = 2 * i + (lane >> 5), k = k0 + kk; float v = 0.f;
        if (col >= 0 && k < kvalid) { v = W[(size_t)k * ldw + col]; if (rowscale) v *= rowscale[k]; }
        scr[kk * 33 + c] = v; }
    asm volatile("s_waitcnt lgkmcnt(0)" ::: "memory");
    const int cc = lane & 7;
#pragma unroll
    for (int j = 0; j < 4; ++j) { const int n = (lane >> 3) + 8 * j; const LAS float* s = scr + (8 * cc) * 33 + n;
        u32x4 o; o.x = pk2(s[0 * 33], s[1 * 33]); o.y = pk2(s[2 * 33], s[3 * 33]); o.z = pk2(s[4 * 33], s[5 * 33]); o.w = pk2(s[6 * 33], s[7 * 33]);
        *(u32x4*)(WT + (size_t)(P0 + n) * ldt + k0 + 8 * cc) = o; }
    asm volatile("s_waitcnt lgkmcnt(0)" ::: "memory");
}
__device__ __forceinline__ void prologue(const Ctx& X, const CArgs* ap) {
    struct { const float* x; const float *w_in, *qn, *kvn, *w_uq, *w_ukv, *w_o, *rgw, *rew; } a = {ap->x, ap->w_in, ap->qn, ap->kvn, ap->w_uq, ap->w_ukv, ap->w_o, ap->rgw, ap->rew};
    LAS float* scr = (LAS float*)(X.lds + X.wave * 16384);
    const int gw = X.vcu * 8 + X.wave, NGW = X.G * 8;
    constexpr int I_WIN = 16 * 112, I_UQ = 4 * 24, I_UKV = 4 * 32, I_WO = 16 * 32, I_L = I_WIN + I_UQ + I_UKV + I_WO;
    for (int it = gw; it < DEPTH * I_L; it += NGW) {
        const int l = it / I_L; int r = it % I_L;
        if (r < I_WIN) { transpose_item(a.w_in + (size_t)l * DM * IN_COLS, IN_COLS, DM, (bf16*)(X.ws + WS_WIN) + (size_t)l * NIN * DM, DM, 64 * (r / 112), 32 * (r % 112), ColWin{}, nullptr, scr, X.lane); continue; }
        r -= I_WIN;
        if (r < I_UQ) { transpose_item(a.w_uq + (size_t)l * 256 * 768, 768, 256, (bf16*)(X.ws + WS_WUQ) + (size_t)l * 768 * 256, 256, 64 * (r / 24), 32 * (r % 24), ColUq{}, a.qn + l * 256, scr, X.lane); continue; }
        r -= I_UQ;
        if (r < I_UKV) { transpose_item(a.w_ukv + (size_t)l * 128 * 1024, 1024, 128, (bf16*)(X.ws + WS_WUKV) + (size_t)l * 1024 * 256, 256, 64 * (r / 32), 32 * (r % 32), ColAdj{}, a.kvn + l * 128, scr, X.lane); continue; }
        r -= I_UKV;
        transpose_item(a.w_o + (size_t)l * DM * DM, DM, DM, (bf16*)(X.ws + WS_WO) + (size_t)l * DM * DM, DM, 64 * (r / 32), 32 * (r % 32), ColAdj{}, nullptr, scr, X.lane);
    }
    const size_t gt = (size_t)X.vcu * 512 + X.tid, NGT = (size_t)X.G * 512;
    { float* rgt = (float*)(X.ws + WS_RGT); float* ret = (float*)(X.ws + WS_RET);
      for (size_t i = gt; i < (size_t)DEPTH * 4 * DM; i += NGT) { const int l = (int)(i / (4 * DM)), g = (int)(i / DM) & 3, k = (int)(i % DM); rgt[i] = a.rgw[((size_t)l * DM + k) * 4 + g]; }
      for (size_t i = gt; i < (size_t)DEPTH * 32 * DM; i += NGT) { const int l = (int)(i / (32 * DM)), ge = (int)(i / DM) & 31, k = (int)(i % DM); ret[i] = a.rew[(((size_t)l * 4 + (ge >> 3)) * DM + k) * 8 + (ge & 7)]; } }
    { u32x4* z = (u32x4*)(X.ws + WS_T1); for (size_t i = gt; i < (size_t)NT * 256 * 2 / 16; i += NGT) z[i] = (u32x4){0u, 0u, 0u, 0u}; }
    { const f32x4* xs = (const f32x4*)a.x; u32x2* xb = (u32x2*)((unsigned char*)ap->out + XR_OFF);
      for (size_t i = gt; i < (size_t)NT * DM / 4; i += NGT) { const f32x4 v = xs[i]; u32x2 w; w.x = pk2(v[0], v[1]); w.y = pk2(v[2], v[3]); xb[i] = w; } }
}
__device__ __forceinline__ void convert_experts(const Ctx& X, const CArgs* ap, int l) {
    struct { const float *wg, *wu, *wd; } a = {ap->wg, ap->wu, ap->wd};
    LAS float* scr = (LAS float*)(X.lds + X.wave * 16384);
    const int gw = X.vcu * 8 + X.wave, NGW = X.G * 8;
    constexpr int I_GU = 32 * 16 * 16, I_D = 32 * 4 * 32;
    for (int it = gw; it < I_GU + I_D; it += NGW) {
        if (it < I_GU) { const int e = it >> 8, r = it & 255, G32 = r >> 4, kb = r & 15; const int pn = G32 >> 3, r0 = (G32 & 7) * 32; const bool up = r0 >= 128;
            const float* W = (up ? a.wu : a.wg) + ((size_t)l * NEXP + e) * DM * FH;
            transpose_item(W, FH, DM, (bf16*)(X.ws + WS_WGU) + (size_t)e * 512 * DM, DM, 64 * kb, 32 * G32, ColIdent{128 * pn + (r0 & 127) - 32 * G32}, nullptr, scr, X.lane);
        } else { const int r = it - I_GU, e = r >> 7, q = r & 127, kb = q >> 5, pg = q & 31;
            transpose_item(a.wd + ((size_t)l * NEXP + e) * FH * DM, DM, FH, (bf16*)(X.ws + WS_WD) + (size_t)e * DM * FH, FH, 64 * kb, 32 * pg, ColAdj{}, nullptr, scr, X.lane); }
    }
}

struct InProjDesc {
    unsigned char* ws;
    __device__ __forceinline__ pg8::GroupDesc operator()(int pn, int bj, int wc) const {
        using namespace pg8; const int G = 8 * pn + 4 * bj + wc; GroupDesc d; d.kind = GK_PLAIN; d.dst = nullptr; d.pitch = 256; d.col = 0; d.scale = 1.f; d.perm = 0; d.ssq = nullptr; d.ssq_n = 0; d.ssq_i = 0;
        if (G < 8) { d.dst = (bf16*)(ws + WS_CQ); d.col = 32 * G; d.ssq = (float*)(ws + WS_SSQ); d.ssq_n = 8; d.ssq_i = G; }
        else if (G < 12) { d.dst = (bf16*)(ws + WS_T1); d.col = 32 * (G - 8); d.ssq = (float*)(ws + WS_SSQ) + (size_t)NT * 8; d.ssq_n = 4; d.ssq_i = G - 8; }
        else if (G == 12) { d.kind = GK_ROPE32; d.dst = (bf16*)(ws + WS_KPE); d.pitch = 32; d.col = 0; }
        else if (G == 13) { d.kind = GK_IDX8; d.dst = (bf16*)(ws + WS_KI); d.pitch = 32; d.col = 0; }
        else if (G == 14) { d.kind = GK_HEAD16; d.dst = (bf16*)(ws + WS_T1); d.col = 192; }
        else if (G == 15) { d.dst = (bf16*)(ws + WS_T1); d.col = 224; }
        else if (G < 24) { d.kind = ((G - 16) & 1) ? GK_PLAIN : GK_HEAD16; d.dst = (bf16*)(ws + WS_BQ); d.col = 32 * (G - 16); d.scale = QSC64; }
        else if (G < 26) { d.dst = (bf16*)(ws + WS_BV); d.pitch = 64; d.col = 32 * (G - 24); }
        else if (G == 26) { d.kind = GK_WI; d.dst = (bf16*)(ws + WS_WI); }
        else if (G < 32) { d.kind = GK_SKIP; }
        else if (G < 40) { d.kind = GK_IDX8; d.dst = (bf16*)(ws + WS_BQI); d.col = 32 * (G - 32); }
        else if (G < 64) { const int j = G - 40, cfg = j >> 3; d.kind = (j & 1) ? GK_PLAIN : GK_HEAD16; d.dst = (bf16*)(ws + WS_DQ) + (size_t)cfg * NT * 256; d.col = 32 * (j & 7); d.scale = QSC64; d.perm = cfg == 0 ? 0 : (cfg == 1 ? 4 : 16); }
        else if (G < 88) { const int j = G - 64, cfg = j >> 3; d.kind = (j & 1) ? GK_PLAIN : GK_HEAD16; d.dst = (bf16*)(ws + WS_DK) + (size_t)cfg * NT * 256; d.col = 32 * (j & 7); d.perm = cfg == 0 ? 0 : (cfg == 1 ? 4 : 16); }
        else { const int j = G - 88, cfg = j >> 3; d.dst = (bf16*)(ws + WS_DV) + (size_t)cfg * NT * 256; d.col = 32 * (j & 7); d.perm = cfg == 0 ? 0 : (cfg == 1 ? 4 : 16); }
        return d;
    }
};
struct UqDesc {
    unsigned char* ws;
    __device__ __forceinline__ pg8::GroupDesc operator()(int pn, int bj, int wc) const {
        using namespace pg8; const int G = 8 * pn + 4 * bj + wc; GroupDesc d; d.kind = (G % 3 == 2) ? GK_ROPE32 : GK_PLAIN; d.dst = (bf16*)(ws + WS_QA); d.pitch = 768; d.col = 32 * G; d.scale = QSC96; d.perm = 0; d.ssq = nullptr; d.ssq_n = 0; d.ssq_i = 0;
        return d;
    }
};

__device__ __forceinline__ unsigned f16key(float v) { const _Float16 hf = (_Float16)v; const unsigned u = (unsigned)__builtin_bit_cast(unsigned short, hf); return (u ^ ((unsigned)__builtin_amdgcn_sbfe((int)u, 15, 1) | 0x8000u)) & 0xffffu; }
__device__ __forceinline__ unsigned pk_cnt(unsigned acc, unsigned kp2, unsigned mid2, unsigned one2) {
    unsigned t;
    asm("v_pk_sub_u16 %0, %2, %3 clamp\n\tv_pk_min_u16 %0, %0, %4\n\tv_pk_add_u16 %1, %1, %0" : "=&v"(t), "+v"(acc) : "v"(kp2), "s"(mid2), "s"(one2));
    return acc;
}
__device__ __forceinline__ int count_gt(const unsigned (&kp)[16], unsigned mid) {
    const unsigned m2 = __builtin_amdgcn_readfirstlane(mid | (mid << 16)), one2 = __builtin_amdgcn_readfirstlane(0x00010001u);
    unsigned a0 = 0u, a1 = 0u;
#pragma unroll
    for (int i = 0; i < 16; i += 2) { a0 = pk_cnt(a0, kp[i], m2, one2); a1 = pk_cnt(a1, kp[i + 1], m2, one2); }
    unsigned aw; asm("v_pk_add_u16 %0, %1, %2" : "=v"(aw) : "v"(a0), "v"(a1));
    const unsigned c = (aw & 0xffffu) + (aw >> 16);
    int tot = 0;
#pragma unroll
    for (int b = 0; b < 6; ++b) tot += __builtin_popcountll(__ballot((c >> b) & 1u)) << b;
    return tot;
}
__device__ __forceinline__ int wave_scan_incl(int v) {
    v += __builtin_amdgcn_update_dpp(0, v, 0x111, 0xf, 0xf, false); v += __builtin_amdgcn_update_dpp(0, v, 0x112, 0xf, 0xf, false);
    v += __builtin_amdgcn_update_dpp(0, v, 0x114, 0xf, 0xf, false); v += __builtin_amdgcn_update_dpp(0, v, 0x118, 0xf, 0xf, false);
    v += __builtin_amdgcn_update_dpp(0, v, 0x142, 0xa, 0xf, false); v += __builtin_amdgcn_update_dpp(0, v, 0x143, 0xc, 0xf, false);
    return v;
}
__device__ __forceinline__ void radix_pick(const LAS unsigned* hist, int lane, int target, int& B, int& above, int& inbin) {
    const u32x2 hw = *(const LAS u32x2*)(hist + 2 * lane);
    const int c0 = (int)(hw.x & 0xffffu), c1 = (int)(hw.x >> 16), c2 = (int)(hw.y & 0xffffu), c3 = (int)(hw.y >> 16);
    const int tl = (c0 + c1) + (c2 + c3);
    const int pre = wave_scan_incl(tl);
    const int suf = __builtin_amdgcn_readlane(pre, 63) - pre + tl;
    const unsigned long long reach = __ballot(suf >= target);
    const int ls = 63 - __builtin_clzll(reach | 1ull);
    int a = suf - tl, b = 4 * lane + 3, ib = c3;
    if (a + c3 < target) { a += c3; b = 4 * lane + 2; ib = c2; if (a + c2 < target) { a += c2; b = 4 * lane + 1; ib = c1; if (a + c1 < target) { a += c1; b = 4 * lane; ib = c0; } } }
    B = __builtin_amdgcn_readlane(b, ls); above = __builtin_amdgcn_readlane(a, ls); inbin = __builtin_amdgcn_readlane(ib, ls);
}
__device__ __forceinline__ float relu_i(float x) { const int i = __builtin_bit_cast(int, x); return __builtin_bit_cast(float, i > 0 ? i : 0); }
__device__ __forceinline__ void dsa_index_unit(const Ctx& X, int b, int q0) {
    const int lane = X.lane, r = lane & 31, h = lane >> 5; const size_t seq0 = (size_t)b * SEQ; const int t0 = q0 + 4 * X.wave;
    const bf16* BQI = (const bf16*)(X.ws + WS_BQI); const bf16* KI = (const bf16*)(X.ws + WS_KI); const float* WI = (const float*)(X.ws + WS_WI);
    LAS unsigned short* rows = (LAS unsigned short*)(X.lds + X.wave * 16384);
    LAS unsigned char* kbuf = X.lds + LDS_X_OFF;
    const bf16* ap = BQI + (seq0 + t0 + (r >> 3)) * 256 + 32 * (r & 7) + 16 * h;
    const bf16x8 a0 = *(const bf16x8*)ap, a1 = *(const bf16x8*)(ap + 8);
    f32x2 wq[4][2];
#pragma unroll
    for (int j = 0; j < 4; ++j) { const f32x4 w = *(const f32x4*)(WI + (seq0 + t0 + j) * 8 + 4 * h);
        wq[j][0] = (f32x2){w[0] * IDX_SCALE, w[1] * IDX_SCALE}; wq[j][1] = (f32x2){w[2] * IDX_SCALE, w[3] * IDX_SCALE}; }
    const int nch = ((q0 + 31) >> 7) + 1;
    const int skey = X.tid >> 2, spc = X.tid & 3;
    const bf16* sp = KI + (seq0 + skey) * 32 + 8 * spc;
    const int sdst = skey * 64 + ((spc ^ ((skey >> 2) & 3)) << 4);
    u32x4 stg0 = *(const u32x4*)sp, stg1 = stg0, stg2 = stg0, stg3 = stg0;
    if (1 < nch) stg1 = *(const u32x4*)(sp + (size_t)1 * 128 * 32);
    if (2 < nch) stg2 = *(const u32x4*)(sp + (size_t)2 * 128 * 32);
    if (3 < nch) stg3 = *(const u32x4*)(sp + (size_t)3 * 128 * 32);
    *(LAS u32x4*)(kbuf + sdst) = stg0;
    __syncthreads();
#define DSA_STEP(J, RCUR, RNEXT) { const int c = c0 + (J); \
        if (c + 4 < nch) RCUR = *(const u32x4*)(sp + (size_t)(c + 4) * 128 * 32); \
        const LAS unsigned char* kb = kbuf + (c & 1) * 8192; \
        f32x16 accq[4];        \
        _Pragma("unroll") for (int tq = 0; tq < 4; ++tq) { \
            const int key = 32 * tq + r, sw = (key >> 2) & 3; \
            const bf16x8 b0 = *(const LAS bf16x8*)(kb + key * 64 + (((2 * h) ^ sw) << 4)), b1 = *(const LAS bf16x8*)(kb + key * 64 + (((2 * h + 1) ^ sw) << 4)); \
            _Pragma("unroll") for (int i = 0; i < 16; ++i) accq[tq][i] = 0.f; \
            accq[tq] = __builtin_amdgcn_mfma_f32_32x32x16_bf16(a0, b0, accq[tq], 0, 0, 0); \
            accq[tq] = __builtin_amdgcn_mfma_f32_32x32x16_bf16(a1, b1, accq[tq], 0, 0, 0); } \
        __builtin_amdgcn_sched_barrier(0); \
        _Pragma("unroll") for (int tq = 0; tq < 4; ++tq) { const f32x16& acc = accq[tq]; \
            float p[4]; \
            _Pragma("unroll") for (int j = 0; j < 4; ++j) {            \
                const f32x2 ra = {relu_i(acc[4 * j]), relu_i(acc[4 * j + 1])}, rb = {relu_i(acc[4 * j + 2]), relu_i(acc[4 * j + 3])}; \
                const f32x2 pp = __builtin_elementwise_fma(rb, wq[j][1], ra * wq[j][0]); \
                p[j] = pp.x + pp.y; } \
            const auto s01 = __builtin_amdgcn_permlane32_swap(__float_as_uint(p[0]), __float_as_uint(p[1]), false, false); \
            const auto s23 = __builtin_amdgcn_permlane32_swap(__float_as_uint(p[2]), __float_as_uint(p[3]), false, false); \
            const float va = __uint_as_float(s01[0]) + __uint_as_float(s01[1]), vb = __uint_as_float(s23[0]) + __uint_as_float(s23[1]); \
            const int hw = 128 * c + 32 * tq + r;                                      \
            rows[h * 2048 + hw] = (unsigned short)f16key(va); \
            rows[(2 + h) * 2048 + hw] = (unsigned short)f16key(vb); \
        } \
        if (c + 1 < nch) *(LAS u32x4*)(kbuf + ((c + 1) & 1) * 8192 + sdst) = RNEXT; \
        __syncthreads(); }
#ifndef REP_SCORE
#define REP_SCORE 1
#endif
#ifndef REP_SEL
#define REP_SEL 1
#endif
    for (int rsc = 0; rsc < REP_SCORE; ++rsc) {
    if (rsc > 0) { stg0 = *(const u32x4*)sp; stg1 = stg0; stg2 = stg0; stg3 = stg0; if (1 < nch) stg1 = *(const u32x4*)(sp + (size_t)1 * 128 * 32); if (2 < nch) stg2 = *(const u32x4*)(sp + (size_t)2 * 128 * 32); if (3 < nch) stg3 = *(const u32x4*)(sp + (size_t)3 * 128 * 32); *(LAS u32x4*)(kbuf + sdst) = stg0; __syncthreads(); }
    for (int c0 = 0; c0 < nch; c0 += 4) {
        DSA_STEP(0, stg0, stg1)
        if (c0 + 1 >= nch) break;
        DSA_STEP(1, stg1, stg2)
        if (c0 + 2 >= nch) break;
        DSA_STEP(2, stg2, stg3)
        if (c0 + 3 >= nch) break;
        DSA_STEP(3, stg3, stg0)
    }
    }
#undef DSA_STEP
    unsigned* BMp = (unsigned*)(X.ws + WS_BM);
#ifndef REP_BIS
#define REP_BIS 1
#endif
#ifndef REP_EMIT
#define REP_EMIT 1
#endif
    for (int rsl = 0; rsl < REP_SEL; ++rsl)
    for (int j = 0; j < 4; ++j) {
        const int t = t0 + j;
        const LAS u32x4* rw = (const LAS u32x4*)(rows + j * 2048) + 4 * lane;
        unsigned kp[16];
#pragma unroll
        for (int v4 = 0; v4 < 4; ++v4) { const u32x4 d = rw[v4]; kp[4 * v4] = d.x; kp[4 * v4 + 1] = d.y; kp[4 * v4 + 2] = d.z; kp[4 * v4 + 3] = d.w; }
        const int nv = t + 1 - 32 * lane;
#pragma unroll
        for (int d = 0; d < 16; ++d) kp[d] &= ((2 * d < nv) ? 0xffffu : 0u) | ((2 * d + 1 < nv) ? 0xffff0000u : 0u);
        unsigned thr = 0u; int need = 0;
        for (int rb_ = 0; rb_ < REP_BIS; ++rb_)
        if (t + 1 > 256) {
            LAS unsigned* hist = (LAS unsigned*)(X.lds + LDS_HIST_OFF + X.wave * 512);
            *(LAS u32x2*)(hist + 2 * lane) = (u32x2){0u, 0u};
#pragma unroll
            for (int d = 0; d < 16; ++d) { const unsigned klo = kp[d] & 0xffffu, khi = kp[d] >> 16;
                if (klo) __hip_atomic_fetch_add(hist + (klo >> 9), (klo & 0x100u) ? 0x10000u : 1u, __ATOMIC_RELAXED, __HIP_MEMORY_SCOPE_WORKGROUP);
                if (khi) __hip_atomic_fetch_add(hist + (khi >> 9), (khi & 0x100u) ? 0x10000u : 1u, __ATOMIC_RELAXED, __HIP_MEMORY_SCOPE_WORKGROUP); }
            int B1, above1, in1; radix_pick(hist, lane, 256, B1, above1, in1);
            *(LAS u32x2*)(hist + 2 * lane) = (u32x2){0u, 0u};
#pragma unroll
            for (int d = 0; d < 16; ++d) { const unsigned klo = kp[d] & 0xffffu, khi = kp[d] >> 16;
                if ((int)(klo >> 8) == B1) __hip_atomic_fetch_add(hist + ((klo & 0xffu) >> 1), (klo & 1u) ? 0x10000u : 1u, __ATOMIC_RELAXED, __HIP_MEMORY_SCOPE_WORKGROUP);
                if ((int)(khi >> 8) == B1) __hip_atomic_fetch_add(hist + ((khi & 0xffu) >> 1), (khi & 1u) ? 0x10000u : 1u, __ATOMIC_RELAXED, __HIP_MEMORY_SCOPE_WORKGROUP); }
            int B2, above2, in2; radix_pick(hist, lane, 256 - above1, B2, above2, in2);
            const unsigned tk = ((unsigned)B1 << 8) | (unsigned)B2;
            const int rest = 256 - (above1 + above2);
            if (rest >= in2) { thr = tk - 1u; need = 0; } else { thr = tk; need = rest; }
        }
        unsigned word = 0u, eqw = 0u;
        const unsigned thr2 = __builtin_amdgcn_readfirstlane(thr | (thr << 16)), one2 = __builtin_amdgcn_readfirstlane(0x00010001u);
#pragma unroll
        for (int d = 0; d < 16; ++d) { unsigned g;
            asm("v_pk_sub_u16 %0, %1, %2 clamp\n\tv_pk_min_u16 %0, %0, %3" : "=&v"(g) : "v"(kp[d]), "s"(thr2), "s"(one2));
            word |= ((g | (g >> 15)) & 3u) << (2 * d); }
        if (need > 0) {
#pragma unroll
            for (int d = 0; d < 16; ++d) { unsigned g; const unsigned x = kp[d] ^ thr2;
                asm("v_pk_min_u16 %0, %1, %2" : "=v"(g) : "v"(x), "s"(one2));
                eqw |= ((~(g | (g >> 15))) & 3u) << (2 * d); }
            if (thr == 0u) eqw = 0u;
            const int ne = __builtin_popcount(eqw); const int inc = wave_scan_incl(ne);
            int take = need - (inc - ne); take = take < 0 ? 0 : (take > ne ? ne : take);
            while (__any(take > 0)) { if (take > 0) { const unsigned lowbit = eqw & (0u - eqw); word |= lowbit; eqw ^= lowbit; --take; } }
        }
        BMp[(seq0 + t) * 64 + lane] = word;
    }
}

__device__ __forceinline__ void dil_combine(const Ctx& X) {
    const bf16* OD = (const bf16*)(X.ws + WS_OD); const float* LS = (const float*)(X.ws + WS_LSE); bf16* O = (bf16*)(X.ws + WS_XB);
    const int gw = X.vcu * 8 + X.wave, NGW = X.G * 8, lane = X.lane, hh = lane >> 4;
    for (int t = gw; t < NT; t += NGW) {
        const int b = t >> 11, s = t & 2047;
        const int r0 = t, r1 = (b << 11) + ((s & 3) << 9) + (s >> 2), r2 = (b << 11) + ((s & 15) << 7) + (s >> 4);
        const float L0 = LS[(size_t)r0 * 4 + hh], L1 = LS[((size_t)NT + r1) * 4 + hh], L2 = LS[((size_t)2 * NT + r2) * 4 + hh];
        const float mx = fmaxf(L0, fmaxf(L1, L2));
        float w0 = __builtin_amdgcn_exp2f(L0 - mx), w1 = __builtin_amdgcn_exp2f(L1 - mx), w2 = __builtin_amdgcn_exp2f(L2 - mx);
        const float inv = 1.0f / (w0 + w1 + w2); w0 *= inv; w1 *= inv; w2 *= inv;
        const u32x2 a = *(const u32x2*)(OD + (size_t)r0 * 256 + 4 * lane), bq = *(const u32x2*)(OD + ((size_t)NT + r1) * 256 + 4 * lane), cq = *(const u32x2*)(OD + ((size_t)2 * NT + r2) * 256 + 4 * lane);
        u32x2 o;
        o.x = pk2(w0 * bflo(a.x) + w1 * bflo(bq.x) + w2 * bflo(cq.x), w0 * bfhi(a.x) + w1 * bfhi(bq.x) + w2 * bfhi(cq.x));
        o.y = pk2(w0 * bflo(a.y) + w1 * bflo(bq.y) + w2 * bflo(cq.y), w0 * bfhi(a.y) + w1 * bfhi(bq.y) + w2 * bfhi(cq.y));
        stg8<NT_ATT>(O + (size_t)t * DM + 768 + 4 * lane, o);
    }
}

__device__ __forceinline__ void ln1_router(const Ctx& X, const CArgs* ap, int l, bool first, bool dummy = false) {
    struct { const float *ln1g, *ln1b, *rgb, *reb; } a = {ap->ln1g, ap->ln1b, ap->rgb, ap->reb}; (void)first;
    const bf16* xin = (const bf16*)((const unsigned char*)ap->out + XR_OFF);
    const bool keep_copy = !LN2_X1B && (l == DEPTH - 1) && !dummy; bf16* XC = (bf16*)(X.ws + WS_KVA);
    const int lane = X.lane; const bf16* MIX = (const bf16*)(X.ws + WS_MIX); bf16* X1B = (bf16*)(X.ws + (dummy ? WS_Y : WS_XB));
    LAS float* reT = (LAS float*)X.lds;
    LAS float* rgT = (LAS float*)(X.lds + LDS_X_OFF);
    LAS int* hist = (LAS int*)(X.lds + LDSCTL_OFF + 256);
    { const u32x4* s1 = (const u32x4*)(X.ws + WS_RET + (size_t)l * 32 * DM * 4); for (int i = X.tid; i < 32 * DM / 4; i += 512) ((LAS u32x4*)reT)[i] = s1[i];
      const u32x4* s2 = (const u32x4*)(X.ws + WS_RGT + (size_t)l * 4 * DM * 4); for (int i = X.tid; i < 4 * DM / 4; i += 512) ((LAS u32x4*)rgT)[i] = s2[i]; }
    f32x4 g[4], bb[4];
#pragma unroll
    for (int j = 0; j < 4; ++j) { g[j] = *(const f32x4*)(a.ln1g + l * DM + 4 * lane + 256 * j); bb[j] = *(const f32x4*)(a.ln1b + l * DM + 4 * lane + 256 * j); }
    const float* rgb = a.rgb + l * 4; const float* reb = a.reb + l * 32;
    for (int rb = X.c; rb < NT / 256; rb += X.G) {
        if (X.tid < 32) hist[X.tid] = 0;
        __syncthreads();
        u32x2 xa[4], xb[4]; u32x2 ma[4], mb[4];
        { const int t = rb * 256 + X.wave * 32;
#pragma unroll
          for (int j = 0; j < 4; ++j) { xa[j] = *(const u32x2*)(xin + (size_t)t * DM + 4 * lane + 256 * j); ma[j] = *(const u32x2*)(MIX + (size_t)t * DM + 4 * lane + 256 * j); }
#pragma unroll
          for (int j = 0; j < 4; ++j) { xb[j] = *(const u32x2*)(xin + (size_t)(t + 1) * DM + 4 * lane + 256 * j); mb[j] = *(const u32x2*)(MIX + (size_t)(t + 1) * DM + 4 * lane + 256 * j); } }
        auto row = [&](u32x2 (&xn)[4], u32x2 (&mn)[4], const int i) __attribute__((always_inline)) {
            const int t = rb * 256 + X.wave * 32 + i;
            f32x4 v[4]; float s = 0.f;
#pragma unroll
            for (int j = 0; j < 4; ++j) { const u32x2 xw = xn[j]; const u32x2 mw = mn[j];
                if (keep_copy) *(u32x2*)(XC + (size_t)t * DM + 4 * lane + 256 * j) = xw;
                v[j][0] = ALPHA * bflo(xw.x) + bflo(mw.x); v[j][1] = ALPHA * bfhi(xw.x) + bfhi(mw.x); v[j][2] = ALPHA * bflo(xw.y) + bflo(mw.y); v[j][3] = ALPHA * bfhi(xw.y) + bfhi(mw.y);
                s += (v[j][0] + v[j][1]) + (v[j][2] + v[j][3]); }
            if (i + 2 < 32) {
#pragma unroll
                for (int j = 0; j < 4; ++j) { xn[j] = *(const u32x2*)(xin + (size_t)(t + 2) * DM + 4 * lane + 256 * j); mn[j] = *(const u32x2*)(MIX + (size_t)(t + 2) * DM + 4 * lane + 256 * j); } }
            const float mean = wave_sum(s) * (1.f / DM); float s2 = 0.f;
#pragma unroll
            for (int j = 0; j < 4; ++j) { v[j] = v[j] - mean; s2 += (v[j][0] * v[j][0] + v[j][1] * v[j][1]) + (v[j][2] * v[j][2] + v[j][3] * v[j][3]); }
            const float rstd = 1.0f / sqrtf(wave_sum(s2) * (1.f / DM) + 1e-5f);
#pragma unroll
            for (int j = 0; j < 4; ++j) { v[j] = v[j] * rstd * g[j] + bb[j];
                u32x2 w; w.x = pk2(v[j][0], v[j][1]); w.y = pk2(v[j][2], v[j][3]); stg8<NT_LN>(X1B + (size_t)t * DM + 4 * lane + 256 * j, w); }
            float lg[4];
            { f32x2 pa[4], pb[4];
#pragma unroll
              for (int gi = 0; gi < 4; ++gi) { pa[gi] = (f32x2){0.f, 0.f}; pb[gi] = (f32x2){0.f, 0.f}; }
#pragma unroll
              for (int j = 0; j < 4; ++j) { const f32x2 vxy = {v[j][0], v[j][1]}, vzw = {v[j][2], v[j][3]};
#pragma unroll
                  for (int gi = 0; gi < 4; ++gi) { const f32x4 w = *(const LAS f32x4*)(rgT + gi * DM + 4 * lane + 256 * j);
                      pa[gi] = __builtin_elementwise_fma(vxy, (f32x2){w[0], w[1]}, pa[gi]); pb[gi] = __builtin_elementwise_fma(vzw, (f32x2){w[2], w[3]}, pb[gi]); } }
#pragma unroll
              for (int gi = 0; gi < 4; ++gi) { const f32x2 q = pa[gi] + pb[gi]; lg[gi] = q.x + q.y; }
              wave_sum_n<4>(lg);
#pragma unroll
              for (int gi = 0; gi < 4; ++gi) lg[gi] += rgb[gi]; }
            int gs = 0; float gm = lg[0];
#pragma unroll
            for (int gi = 1; gi < 4; ++gi) if (lg[gi] > gm) { gm = lg[gi]; gs = gi; }
            float den = 0.f;
#pragma unroll
            for (int gi = 0; gi < 4; ++gi) den += __expf(lg[gi] - gm);
            const float ptop = __builtin_amdgcn_rcpf(den);
            gs = __builtin_amdgcn_readfirstlane(gs);
            float le[8];
            { f32x2 pa[8], pb[8]; const LAS float* reG = reT + gs * 8 * DM + 4 * lane;
#pragma unroll
              for (int e = 0; e < 8; ++e) { pa[e] = (f32x2){0.f, 0.f}; pb[e] = (f32x2){0.f, 0.f}; }
#pragma unroll
              for (int j = 0; j < 4; ++j) { const f32x2 vxy = {v[j][0], v[j][1]}, vzw = {v[j][2], v[j][3]};
#pragma unroll
                  for (int e = 0; e < 8; ++e) { const f32x4 w = *(const LAS f32x4*)(reG + e * DM + 256 * j);
                      pa[e] = __builtin_elementwise_fma(vxy, (f32x2){w[0], w[1]}, pa[e]); pb[e] = __builtin_elementwise_fma(vzw, (f32x2){w[2], w[3]}, pb[e]); } }
#pragma unroll
              for (int e = 0; e < 8; ++e) { const f32x2 q = pa[e] + pb[e]; le[e] = q.x + q.y; }
              wave_sum_n<8>(le);
#pragma unroll
              for (int e = 0; e < 8; ++e) le[e] += reb[gs * 8 + e]; }
            int e1 = 0; float v1 = le[0];
#pragma unroll
            for (int e = 1; e < 8; ++e) if (le[e] > v1) { v1 = le[e]; e1 = e; }
            int e2 = -1; float v2 = -INFINITY;
#pragma unroll
            for (int e = 0; e < 8; ++e) if (e != e1 && le[e] > v2) { v2 = le[e]; e2 = e; }
            const float wa = __builtin_amdgcn_rcpf(1.0f + __expf(v2 - v1)), wb = 1.0f - wa;
            if (lane == 0) { u32x4 ro; ro.x = (unsigned)(gs * 8 + e1); ro.y = (unsigned)(gs * 8 + e2); ro.z = __builtin_bit_cast(unsigned, ptop * wa); ro.w = __builtin_bit_cast(unsigned, ptop * wb);
                *(u32x4*)(X.ws + WS_ROUTE + (size_t)t * 16) = ro;
                __hip_atomic_fetch_add(hist + gs * 8 + e1, 1, __ATOMIC_RELAXED, __HIP_MEMORY_SCOPE_WORKGROUP); __hip_atomic_fetch_add(hist + gs * 8 + e2, 1, __ATOMIC_RELAXED, __HIP_MEMORY_SCOPE_WORKGROUP); }
        };
#pragma unroll 1
        for (int i = 0; i < 32; i += 2) { row(xa, ma, i); row(xb, mb, i + 1); }
        __syncthreads();
        if (X.tid < 32) ((int*)(X.ws + WS_HIST))[rb * 32 + X.tid] = hist[X.tid];
        __syncthreads();
    }
}

__device__ __forceinline__ void ln1_router_mfma(const Ctx& X, const CArgs* ap, int l, bool dummy = false) {
    struct { const float *ln1g, *ln1b, *rgb, *reb; } a = {ap->ln1g, ap->ln1b, ap->rgb, ap->reb};
    const bf16* xin = (const bf16*)((const unsigned char*)ap->out + XR_OFF);
    const int lane = X.lane, jr = lane & 31, hh = lane >> 5; const bf16* MIX = (const bf16*)(X.ws + WS_MIX); bf16* X1B = (bf16*)(X.ws + (dummy ? WS_Y : WS_XB));
    constexpr int WP = 1032;
    LAS bf16* wr = (LAS bf16*)X.lds;
    LAS float* rbias = (LAS float*)(X.lds + 40 * WP * 2);
    LAS int* hist = (LAS int*)(X.lds + LDSCTL_OFF + 256);
    { const float* ret = (const float*)(X.ws + WS_RET) + (size_t)l * 32 * DM; const float* rgt = (const float*)(X.ws + WS_RGT) + (size_t)l * 4 * DM;
      for (int i = X.tid; i < 40 * 256; i += 512) { const int row = i >> 8, c4 = i & 255; f32x4 w = {0.f, 0.f, 0.f, 0.f};
          if (row < 32) w = *(const f32x4*)(ret + (size_t)row * DM + 4 * c4); else if (row < 36) w = *(const f32x4*)(rgt + (size_t)(row - 32) * DM + 4 * c4);
          u32x2 p; p.x = pk2(w[0], w[1]); p.y = pk2(w[2], w[3]); *(LAS u32x2*)(wr + row * WP + 4 * c4) = p; }
      if (X.tid < 32) rbias[X.tid] = a.reb[l * 32 + X.tid]; else if (X.tid < 36) rbias[X.tid] = a.rgb[l * 4 + X.tid - 32]; }
    f32x4 g[4], bb[4];
#pragma unroll
    for (int j = 0; j < 4; ++j) { g[j] = *(const f32x4*)(a.ln1g + l * DM + 4 * lane + 256 * j); bb[j] = *(const f32x4*)(a.ln1b + l * DM + 4 * lane + 256 * j); }
    auto ldm = [&](int t, int j) __attribute__((always_inline)) -> u32x2 {
        if (MIX_FP8) { u32x2 r; r.x = *(const unsigned*)((const unsigned char*)MIX + (size_t)t * DM + 4 * lane + 256 * j); r.y = 0u; return r; }
        return *(const u32x2*)(MIX + (size_t)t * DM + 4 * lane + 256 * j); };
    for (int rb = X.c; rb < NT / 256; rb += X.G) {
        if (X.tid < 32) hist[X.tid] = 0;
        __syncthreads();
        const int tw = rb * 256 + X.wave * 32;
        u32x2 xa[4], xb[4]; u32x2 ma[4], mb[4];
#pragma unroll
        for (int j = 0; j < 4; ++j) { xa[j] = *(const u32x2*)(xin + (size_t)tw * DM + 4 * lane + 256 * j); ma[j] = ldm(tw, j); }
#pragma unroll
        for (int j = 0; j < 4; ++j) { xb[j] = *(const u32x2*)(xin + (size_t)(tw + 1) * DM + 4 * lane + 256 * j); mb[j] = ldm(tw + 1, j); }
        auto row = [&](u32x2 (&xn)[4], u32x2 (&mn)[4], const int i) __attribute__((always_inline)) {
            const int t = tw + i;
            f32x4 v[4]; float s = 0.f;
#pragma unroll
            for (int j = 0; j < 4; ++j) { const u32x2 xw = xn[j]; const u32x2 mw = mn[j];
                f32x4 mf;
                if (MIX_FP8) mf = pg8::fp8x4_to_f32(mw.x) * (1.0f / MIX_SCALE); else mf = (f32x4){bflo(mw.x), bfhi(mw.x), bflo(mw.y), bfhi(mw.y)};
                v[j][0] = ALPHA * bflo(xw.x) + mf[0]; v[j][1] = ALPHA * bfhi(xw.x) + mf[1]; v[j][2] = ALPHA * bflo(xw.y) + mf[2]; v[j][3] = ALPHA * bfhi(xw.y) + mf[3];
                s += (v[j][0] + v[j][1]) + (v[j][2] + v[j][3]); }
            if (i + 2 < 32) {
#pragma unroll
                for (int j = 0; j < 4; ++j) { xn[j] = *(const u32x2*)(xin + (size_t)(t + 2) * DM + 4 * lane + 256 * j); mn[j] = ldm(t + 2, j); } }
            const float mean = wave_sum(s) * (1.f / DM); float s2 = 0.f;
#pragma unroll
            for (int j = 0; j < 4; ++j) { v[j] = v[j] - mean; s2 += (v[j][0] * v[j][0] + v[j][1] * v[j][1]) + (v[j][2] * v[j][2] + v[j][3] * v[j][3]); }
            const float rstd = __builtin_amdgcn_rsqf(wave_sum(s2) * (1.f / DM) + 1e-5f);
#pragma unroll
            for (int j = 0; j < 4; ++j) { v[j] = v[j] * rstd * g[j] + bb[j];
                u32x2 w; w.x = pk2(v[j][0], v[j][1]); w.y = pk2(v[j][2], v[j][3]); stg8<NT_LN>(X1B + (size_t)t * DM + 4 * lane + 256 * j, w); }
        };
#pragma unroll 1
        for (int i = 0; i < 32; i += 2) { row(xa, ma, i); row(xb, mb, i + 1); }
        asm volatile("s_waitcnt vmcnt(0)" ::: "memory");
        f32x16 acc0, acc1;
#pragma unroll
        for (int i = 0; i < 16; ++i) { acc0[i] = 0.f; acc1[i] = 0.f; }
        const bf16* bp = X1B + (size_t)(tw + jr) * DM + 16 * hh;
        const LAS bf16* a0p = wr + jr * WP + 16 * hh; const LAS bf16* a1p = wr + (32 + (jr < 8 ? jr : 7)) * WP + 16 * hh;
#pragma unroll 4
        for (int t2 = 0; t2 < 32; ++t2) {
            const bf16x8 b0 = *(const bf16x8*)(bp + 32 * t2), b1 = *(const bf16x8*)(bp + 32 * t2 + 8);
            const bf16x8 a00 = *(const LAS bf16x8*)(a0p + 32 * t2), a01 = *(const LAS bf16x8*)(a0p + 32 * t2 + 8), a10 = *(const LAS bf16x8*)(a1p + 32 * t2), a11 = *(const LAS bf16x8*)(a1p + 32 * t2 + 8);
            acc0 = __builtin_amdgcn_mfma_f32_32x32x16_bf16(a00, b0, acc0, 0, 0, 0); acc1 = __builtin_amdgcn_mfma_f32_32x32x16_bf16(a10, b0, acc1, 0, 0, 0);
            acc0 = __builtin_amdgcn_mfma_f32_32x32x16_bf16(a01, b1, acc0, 0, 0, 0); acc1 = __builtin_amdgcn_mfma_f32_32x32x16_bf16(a11, b1, acc1, 0, 0, 0);
        }
        float gl[4];
#pragma unroll
        for (int i = 0; i < 4; ++i) { const auto tt = __builtin_amdgcn_permlane32_swap(__float_as_uint(acc1[i]), __float_as_uint(acc1[i]), false, false); gl[i] = __uint_as_float(tt[0]) + rbias[32 + i]; }
        int gs = 0; float gm = gl[0];
#pragma unroll
        for (int gi = 1; gi < 4; ++gi) if (gl[gi] > gm) { gm = gl[gi]; gs = gi; }
        float den = 0.f;
#pragma unroll
        for (int gi = 0; gi < 4; ++gi) den += __expf(gl[gi] - gm);
        const float ptop = __builtin_amdgcn_rcpf(den);
        float le[8];
#pragma unroll
        for (int k = 0; k < 4; ++k) { const float mine = gs == 0 ? acc0[k] : (gs == 1 ? acc0[4 + k] : (gs == 2 ? acc0[8 + k] : acc0[12 + k]));
            const auto tt = __builtin_amdgcn_permlane32_swap(__float_as_uint(mine), __float_as_uint(mine), false, false);
            le[k] = __uint_as_float(tt[0]); le[4 + k] = __uint_as_float(tt[1]); }
#pragma unroll
        for (int e = 0; e < 8; ++e) le[e] += rbias[gs * 8 + e];
        int e1 = 0; float v1 = le[0];
#pragma unroll
        for (int e = 1; e < 8; ++e) if (le[e] > v1) { v1 = le[e]; e1 = e; }
        int e2 = -1; float v2 = -INFINITY;
#pragma unroll
        for (int e = 0; e < 8; ++e) if (e != e1 && le[e] > v2) { v2 = le[e]; e2 = e; }
        const float wa = __builtin_amdgcn_rcpf(1.0f + __expf(v2 - v1)), wb = 1.0f - wa;
        if (hh == 0) { u32x4 ro; ro.x = (unsigned)(gs * 8 + e1); ro.y = (unsigned)(gs * 8 + e2); ro.z = __builtin_bit_cast(unsigned, ptop * wa); ro.w = __builtin_bit_cast(unsigned, ptop * wb);
            *(u32x4*)(X.ws + WS_ROUTE + (size_t)(tw + jr) * 16) = ro;
            __hip_atomic_fetch_add(hist + gs * 8 + e1, 1, __ATOMIC_RELAXED, __HIP_MEMORY_SCOPE_WORKGROUP); __hip_atomic_fetch_add(hist + gs * 8 + e2, 1, __ATOMIC_RELAXED, __HIP_MEMORY_SCOPE_WORKGROUP); }
        __syncthreads();
        if (X.tid < 32) ((int*)(X.ws + WS_HIST))[rb * 32 + X.tid] = hist[X.tid];
        __syncthreads();
    }
}

__device__ __forceinline__ void moe_dispatch(const Ctx& X) {
    LAS int* cnt = (LAS int*)(X.lds);
    LAS int* pre = cnt + 32;
    LAS int* ebase = cnt + 64;
    LAS int* wcnt = cnt + 128;
    const int* HIST = (const int*)(X.ws + WS_HIST); int* STOK = (int*)(X.ws + WS_STOK); float* SW = (float*)(X.ws + WS_SW); int* TSLOT = (int*)(X.ws + WS_TSLOT); int* TILEE = (int*)(X.ws + WS_TILEE);
    for (int rb = X.c; rb < NT / 256; rb += X.G) {
        if (X.tid < 64) cnt[X.tid] = 0;
        __syncthreads();
        { const int e = X.tid & 31, part = X.tid >> 5; int sa = 0, sp = 0;
          for (int q = 0; q < 16; ++q) { const int b2 = part * 16 + q; const int hv = HIST[b2 * 32 + e]; sa += hv; if (b2 < rb) sp += hv; }
          __hip_atomic_fetch_add(cnt + e, sa, __ATOMIC_RELAXED, __HIP_MEMORY_SCOPE_WORKGROUP); __hip_atomic_fetch_add(pre + e, sp, __ATOMIC_RELAXED, __HIP_MEMORY_SCOPE_WORKGROUP); }
        __syncthreads();
        if (X.tid < 64) { const int n = X.tid < 32 ? cnt[X.tid] : 0; const int pad = (n + 255) & ~255; int inc = pad;
#pragma unroll
            for (int o = 1; o < 32; o <<= 1) { const int u = __shfl_up(inc, o); if ((X.tid & 63) >= o) inc += u; }
            if (X.tid < 32) { ebase[X.tid] = inc - pad; if (X.tid == 31) ebase[32] = inc; } }
        __syncthreads();
        const int tl = X.tid >> 1, kk = X.tid & 1, t = rb * 256 + tl;
        const u32x4 ro = *(const u32x4*)(X.ws + WS_ROUTE + (size_t)t * 16);
        const int e = (int)(kk ? ro.y : ro.x); const float w = __builtin_bit_cast(float, kk ? ro.w : ro.z);
        int rank = 0;
        for (int ee = 0; ee < 32; ++ee) { const unsigned long long mm = __ballot(e == ee);
            if (e == ee) rank = __builtin_popcountll(mm & ((1ull << X.lane) - 1ull));
            if (X.lane == 0) wcnt[X.wave * 32 + ee] = __builtin_popcountll(mm); }
        __syncthreads();
        int off = 0;
        for (int w2 = 0; w2 < X.wave; ++w2) off += wcnt[w2 * 32 + e];
        const int slot = ebase[e] + pre[e] + off + rank;
        STOK[slot] = t; SW[slot] = w; TSLOT[2 * t + kk] = slot;
        if (rb < 32) { const int e2 = rb; for (int s = ebase[e2] + cnt[e2] + X.tid; s < ebase[e2 + 1]; s += 512) { STOK[s] = 0; SW[s] = 0.f; } }
        if (rb == 0) { const int ntl = ebase[32] >> 8;
            for (int tile = X.tid; tile < ntl; tile += 512) { int ee = 0; while (ee < 31 && ebase[ee + 1] <= tile * 256) ++ee; TILEE[tile] = ee; }
            if (X.tid == 0) TILEE[1024] = ntl; }
        __syncthreads();
    }
}

__device__ __forceinline__ void ln2_phase(const Ctx& X, const CArgs* ap, int l, bool first, bool dummy = false) {
    struct { const float *ln1g, *ln1b, *ln2g, *ln2b; } a = {ap->ln1g, ap->ln1b, ap->ln2g, ap->ln2b}; float* outw = dummy ? (float*)(X.ws + WS_Y + 272 * MiB) : ap->out; (void)first;
    const bool last = (l + 1 == DEPTH);
    const bf16* xin = LN2_X1B ? (const bf16*)(X.ws + WS_XB) : (last ? (const bf16*)(X.ws + WS_KVA) : (const bf16*)((const unsigned char*)ap->out + XR_OFF));
    const int lane = X.lane; const bf16* Y = (const bf16*)(X.ws + WS_Y); const bf16* MIX = (const bf16*)(X.ws + WS_MIX); const int* TSLOT = (const int*)(X.ws + WS_TSLOT); bf16* XBp = dummy ? (bf16*)(X.ws + WS_MIX) : (bf16*)((unsigned char*)ap->out + XR_OFF);
    auto ldy = [&](int slot, int j) __attribute__((always_inline)) -> u32x2 {
        if (Y_FP8) { u32x2 r; r.x = ldg_s<unsigned>((const unsigned char*)Y + (size_t)slot * DM + 4 * lane + 256 * j); r.y = 0u; return r; }
        return ldg_s<u32x2>(Y + (size_t)slot * DM + 4 * lane + 256 * j); };
    f32x4 g1[4], b1[4], g[4], bb[4];
#pragma unroll
    for (int j = 0; j < 4; ++j) { g1[j] = *(const f32x4*)(a.ln1g + l * DM + 4 * lane + 256 * j); b1[j] = *(const f32x4*)(a.ln1b + l * DM + 4 * lane + 256 * j);
        g[j] = *(const f32x4*)(a.ln2g + l * DM + 4 * lane + 256 * j); bb[j] = *(const f32x4*)(a.ln2b + l * DM + 4 * lane + 256 * j); }
    for (int rb = X.c; rb < NT / 256; rb += X.G) {
        const int tb = rb * 256 + X.wave * 32;
        const int myslots_a = TSLOT[2 * (tb + (lane & 31))], myslots_b = TSLOT[2 * (tb + (lane & 31)) + 1];
        u32x2 xn[4]; u32x2 mn[4], yan[4], ybn[4];
        { const int sa = __builtin_amdgcn_readlane(myslots_a, 0), sb = __builtin_amdgcn_readlane(myslots_b, 0);
#pragma unroll
          for (int j = 0; j < 4; ++j) { xn[j] = *(const u32x2*)(xin + (size_t)tb * DM + 4 * lane + 256 * j); mn[j] = LN2_X1B ? (u32x2){0u, 0u} : *(const u32x2*)(MIX + (size_t)tb * DM + 4 * lane + 256 * j);
              yan[j] = ldy(sa, j); ybn[j] = ldy(sb, j); } }
        for (int i = 0; i < 32; ++i) {
            const int t = tb + i;
            f32x4 v[4]; float s = 0.f;
#pragma unroll
            for (int j = 0; j < 4; ++j) { const u32x2 xw = xn[j]; const u32x2 mw = mn[j];
                if (LN2_X1B) { v[j][0] = bflo(xw.x); v[j][1] = bfhi(xw.x); v[j][2] = bflo(xw.y); v[j][3] = bfhi(xw.y); }
                else { v[j][0] = ALPHA * bflo(xw.x) + bflo(mw.x); v[j][1] = ALPHA * bfhi(xw.x) + bfhi(mw.x); v[j][2] = ALPHA * bflo(xw.y) + bflo(mw.y); v[j][3] = ALPHA * bfhi(xw.y) + bfhi(mw.y);
                    s += (v[j][0] + v[j][1]) + (v[j][2] + v[j][3]); } }
            u32x2 ya[4], yb[4];
#pragma unroll
            for (int j = 0; j < 4; ++j) { ya[j] = yan[j]; yb[j] = ybn[j]; }
            if (i + 1 < 32) { const int sa = __shfl(myslots_a, i + 1), sb = __shfl(myslots_b, i + 1);
#pragma unroll
                for (int j = 0; j < 4; ++j) { xn[j] = *(const u32x2*)(xin + (size_t)(t + 1) * DM + 4 * lane + 256 * j); if (!LN2_X1B) mn[j] = *(const u32x2*)(MIX + (size_t)(t + 1) * DM + 4 * lane + 256 * j);
                    yan[j] = ldy(sa, j); ybn[j] = ldy(sb, j); } }
            if (!LN2_X1B) { const float mean = wave_sum(s) * (1.f / DM); float s2 = 0.f;
#pragma unroll
              for (int j = 0; j < 4; ++j) { v[j] = v[j] - mean; s2 += (v[j][0] * v[j][0] + v[j][1] * v[j][1]) + (v[j][2] * v[j][2] + v[j][3] * v[j][3]); }
              const float rstd = 1.0f / sqrtf(wave_sum(s2) * (1.f / DM) + 1e-5f);
#pragma unroll
              for (int j = 0; j < 4; ++j) v[j] = v[j] * rstd * g1[j] + b1[j]; }
            s = 0.f;
#pragma unroll
            for (int j = 0; j < 4; ++j) { const f32x4 xv = v[j];
                if (Y_FP8) { const f32x4 fa = pg8::fp8x4_to_f32(ya[j].x), fb = pg8::fp8x4_to_f32(yb[j].x);
#pragma unroll
                    for (int e = 0; e < 4; ++e) v[j][e] = ALPHA * xv[e] + (fa[e] + fb[e]) * (1.0f / Y_SCALE);
                } else { v[j][0] = ALPHA * xv[0] + (bflo(ya[j].x) + bflo(yb[j].x)); v[j][1] = ALPHA * xv[1] + (bfhi(ya[j].x) + bfhi(yb[j].x)); v[j][2] = ALPHA * xv[2] + (bflo(ya[j].y) + bflo(yb[j].y)); v[j][3] = ALPHA * xv[3] + (bfhi(ya[j].y) + bfhi(yb[j].y)); }
                s += (v[j][0] + v[j][1]) + (v[j][2] + v[j][3]); }
            const float mean = wave_sum(s) * (1.f / DM); float s2 = 0.f;
#pragma unroll
            for (int j = 0; j < 4; ++j) { v[j] = v[j] - mean; s2 += (v[j][0] * v[j][0] + v[j][1] * v[j][1]) + (v[j][2] * v[j][2] + v[j][3] * v[j][3]); }
            const float rstd = 1.0f / sqrtf(wave_sum(s2) * (1.f / DM) + 1e-5f);
#pragma unroll
            for (int j = 0; j < 4; ++j) { v[j] = v[j] * rstd * g[j] + bb[j];
                if (last || dummy) stgf4<NT_LN>(outw + (size_t)t * DM + 4 * lane + 256 * j, v[j]);
                else { u32x2 w; w.x = pk2(v[j][0], v[j][1]); w.y = pk2(v[j][2], v[j][3]); stg8<NT_LN>(XBp + (size_t)t * DM + 4 * lane + 256 * j, w); } }
        }
    }
}

#ifndef REP_P0
#define REP_P0 1
#endif
#ifndef REP_P5
#define REP_P5 1
#endif
#ifndef REP_P9
#define REP_P9 1
#endif
#ifndef REP_BAR
#define REP_BAR 1
#endif
#ifndef REP_P1
#define REP_P1 1
#endif
#ifndef REP_P2A
#define REP_P2A 1
#endif
#ifndef REP_P2B
#define REP_P2B 1
#endif
#ifndef REP_P2C
#define REP_P2C 1
#endif
#ifndef REP_P2D
#define REP_P2D 1
#endif
#ifndef REP_P3A
#define REP_P3A 1
#endif
#ifndef REP_P3B
#define REP_P3B 1
#endif
#ifndef REP_P3C
#define REP_P3C 1
#endif
#ifndef REP_P4
#define REP_P4 1
#endif
#ifndef REP_P6
#define REP_P6 1
#endif
#ifndef REP_P7
#define REP_P7 1
#endif
#ifndef REP_P8
#define REP_P8 1
#endif
__global__ void __launch_bounds__(512, 2) mk_fwd(Args a) {
    extern __shared__ __attribute__((aligned(16))) unsigned char lds_raw[];
    LAS unsigned char* const lds0 = (LAS unsigned char*)lds_raw;
    for (int u = threadIdx.x; u < (LDS_BYTES - LDSCTL_OFF) / 4; u += 512) ((LAS unsigned*)(lds0 + LDSCTL_OFF))[u] = 0u;
    __syncthreads();
    unsigned* barw = (unsigned*)(a.ws + WS_CTL) + CW_BAR;
    XcdBarrier bar; bar.bar = barw; bar.x = 0; bar.st = nullptr;
    if (a.use_bar) bar = xcd_barrier_post(barw, (volatile LAS unsigned*)(lds0 + LDSCTL_OFF) + 8);
#define MKCTX() Ctx X; const CArgs* ap = (const CArgs*)__builtin_amdgcn_kernarg_segment_ptr(); asm volatile("" : "+s"(ap)); { int t_ = threadIdx.x; asm volatile("" : "+v"(t_)); X.lds = lds0; X.tid = t_; X.lane = t_ & 63; X.wave = __builtin_amdgcn_readfirstlane(t_ >> 6); \
        unsigned char* w_ = ap->ws; X.G = gridDim.x; X.c = blockIdx.x; X.vcu = (X.G % 8 == 0) ? (X.c % 8) * (X.G / 8) + X.c / 8 : X.c; X.ws = w_; }
#ifndef P2M
#define P2M 31
#endif
#ifndef PH_MASK0
#define PH_MASK0 1
#endif
#define GBAR() do { if (a.use_bar) for (int rb_ = 0; rb_ < REP_BAR; ++rb_) xcd_barrier(bar); } while (0)

    if ((PH_MASK0 & 1) && a.l_lo == 0 && a.ph_lo == 0) { MKCTX(); for (int rep = 0; rep < REP_P0; ++rep) { prologue(X, ap); __syncthreads(); } GBAR(); }

    for (int l = a.l_lo; l < a.l_hi; ++l) {
        const int lo = (l == a.l_lo) ? (a.ph_lo < 1 ? 1 : a.ph_lo) : 1, hi = (l == a.l_hi - 1) ? a.ph_hi : 10;
#ifndef PH_MASK
#define PH_MASK 0x3ff
#endif
#define IN(k) (((PH_MASK >> (k)) & 1) && lo <= (k) && (k) < hi)
        if (IN(1)) { MKCTX();
            pg8::Gemm g{(const bf16*)((const unsigned char*)ap->out + XR_OFF), (const bf16*)(X.ws + WS_WIN) + (size_t)l * NIN * DM, DM, nullptr};
            pg8::StaticOrder S; S.init(NT, NIN, X.G, X.c, REP_P1);
            pg8::RopeTabs R{ap->pos};
            pg8::EpiGroups<InProjDesc> E{InProjDesc{X.ws}, R, nullptr, 0, 0.f, 0.f};
            pg8::gemm_phase<pg8::EpiGroups<InProjDesc>, pg8::StaticOrder, false>(X.lds, g, S, E, X.tid);
            GBAR();
        }
        if (IN(2)) { MKCTX();
            {
                pg8::Gemm g{(const bf16*)(X.ws + WS_CQ), (const bf16*)(X.ws + WS_WUQ) + (size_t)l * 768 * 256, 256, nullptr};
                pg8::StaticOrder S; S.init(NT, 768, X.G, X.c, REP_P2A);
                pg8::RopeTabs R{ap->pos};
                pg8::EpiGroups<UqDesc> E{UqDesc{X.ws}, R, (const float*)(X.ws + WS_SSQ), 8, 1.0f / 256.0f, 1e-6f};
                pg8::gemm_phase<pg8::EpiGroups<UqDesc>, pg8::StaticOrder, false>(X.lds, g, S, E, X.tid);
            }
            {
                pg8::Gemm g{(const bf16*)(X.ws + WS_T1), (const bf16*)(X.ws + WS_WUKV) + (size_t)l * 1024 * 256, 256, nullptr};
                pg8::StaticOrder S; S.init(NT, 1024, X.G, X.c, REP_P2A);
                pg8::EpiPlainT<NT_KVA> E{(bf16*)(X.ws + WS_KVA), 1024, (const float*)(X.ws + WS_SSQ) + (size_t)NT * 8, 4, 1.0f / 128.0f, 1e-6f, X.lds + LDS_X_OFF};
                pg8::gemm_phase<decltype(E), pg8::StaticOrder, false>(X.lds, g, S, E, X.tid);
            }
            __syncthreads();
            for (int rep = 0; rep < REP_P2B; ++rep) convert_experts(X, ap, l);
            __syncthreads();
            for (int rep = 0; rep < REP_P2C; ++rep) for (int U = X.vcu; U < NB * 32; U += X.G) { const int b = U >> 5, pr = U & 31;
                dsa_index_unit(X, b, 32 * pr); dsa_index_unit(X, b, 32 * (63 - pr)); }
            __syncthreads();
#pragma unroll 1
            for (int cfg = 0; cfg < 3 * REP_P2D; ++cfg) { const int cfgi = cfg % 3;
                fa::Params P; const size_t co = (size_t)cfgi * NT * 256;
                P.Q = (const bf16*)(X.ws + WS_DQ) + co; P.q_pitch = 256; P.K1 = (const bf16*)(X.ws + WS_DK) + co; P.k1_pitch = 256; P.K2 = nullptr; P.k2_pitch = 0; P.k2_col = 0;
                P.V = (const bf16*)(X.ws + WS_DV) + co; P.v_pitch = 256; P.O = (bf16*)(X.ws + WS_OD) + co; P.o_pitch = 256; P.LSE = (float*)(X.ws + WS_LSE) + (size_t)cfgi * NT * 4; P.lse_pitch = 4; P.BM = nullptr;
                P.CL = cfgi == 0 ? 2048 : (cfgi == 1 ? 512 : 128); P.W = 128;
                const int vcu = X.vcu, G = X.G, wv = X.wave, CLc = P.CL;
                fa::attn_stream<64, 0, 2>(P, X.lds, X.tid, (NB * 2 * 16 - vcu + G - 1) / G, [=](int j) { const int U = vcu + j * G, bh = U >> 4, qb = U & 15, b = bh >> 1, hp = bh & 1;
                    const int q0 = 128 * qb, hh = 2 * hp + (wv >> 2); int klo = q0 & ~(CLc - 1); if (q0 - 128 > klo) klo = q0 - 128;
                    return fa::UnitDesc{b * SEQ, q0 + 32 * (wv & 3), 64 * hh, 64 * hh, hh, 128 * hp, 128 * hp, klo >> 6, (q0 + 127) >> 6}; });
            }
            GBAR();
        }
        if (IN(3)) { MKCTX();
            {   fa::Params P; P.Q = (const bf16*)(X.ws + WS_QA); P.q_pitch = 768; P.K1 = (const bf16*)(X.ws + WS_KVA); P.k1_pitch = 1024; P.K2 = (const bf16*)(X.ws + WS_KPE); P.k2_pitch = 32; P.k2_col = 0;
                P.V = (const bf16*)(X.ws + WS_KVA); P.v_pitch = 1024; P.O = (bf16*)(X.ws + WS_XB); P.o_pitch = DM; P.LSE = nullptr; P.lse_pitch = 0; P.BM = nullptr; P.CL = 2048; P.W = 1 << 20;
                const int vcu = X.vcu, G = X.G, wv = X.wave;
                fa::attn_stream<96, 2, 1>(P, X.lds, X.tid, 2 * ((NB * 8 * 4 - vcu + G - 1) / G), [=](int j) { const int U = vcu + (j >> 1) * G, bh = U >> 2, pr = U & 3, b = bh >> 3, hd = bh & 7;
                    const int qb = (j & 1) ? 7 - pr : pr, q0 = 256 * qb;
                    return fa::UnitDesc{b * SEQ, q0 + 32 * wv, 96 * hd, 64 * hd, 0, 128 * hd, 128 * hd + 64, 0, (q0 + 255) >> 6}; });
            }
            {   fa::Params P; P.Q = (const bf16*)(X.ws + WS_BQ); P.q_pitch = 256; P.K1 = (const bf16*)(X.ws + WS_T1); P.k1_pitch = 256; P.k1_col = 192; P.K2 = nullptr; P.k2_pitch = 0; P.k2_col = 0;
                P.V = (const bf16*)(X.ws + WS_BV); P.v_pitch = 64; P.v_col = 0; P.O = (bf16*)(X.ws + WS_XB); P.o_pitch = DM; P.LSE = nullptr; P.lse_pitch = 0; P.BM = (const unsigned*)(X.ws + WS_BM); P.CL = 2048; P.W = 1 << 20;
                const int hd = X.wave & 3, sub = X.wave >> 2, vcu = X.vcu, G = X.G;
                fa::attn_stream<64, 1, 1>(P, X.lds, X.tid, 2 * ((NB * 16 - vcu + G - 1) / G), [=](int j) { const int U = vcu + (j >> 1) * G, b = U >> 4, pr = U & 15;
                    const int qb = (j & 1) ? 31 - pr : pr, q0 = 64 * qb;
                    return fa::UnitDesc{b * SEQ, q0 + 32 * sub, 64 * hd, 512 + 64 * hd, 0, 192, 0, 0, qb}; });
            }
            for (int rep = 0; rep < REP_P3C; ++rep) dil_combine(X);
            GBAR();
        }
        if (IN(4)) { MKCTX();
            pg8::Gemm g{(const bf16*)(X.ws + WS_XB), (const bf16*)(X.ws + WS_WO) + (size_t)l * DM * DM, DM, nullptr};
            pg8::StaticOrder S; S.init(NT, DM, X.G, X.c, REP_P4);
#if MIX_FP8 && ROUTER_MFMA && LN2_X1B
            pg8::EpiFp8T<NT_MIX> E{X.ws + WS_MIX, DM, MIX_SCALE, X.lds + LDS_X_OFF};
#else
            pg8::EpiPlainT<NT_MIX> E{(bf16*)(X.ws + WS_MIX), DM, nullptr, 0, 0.f, 0.f, X.lds + LDS_X_OFF};
#endif
            pg8::gemm_phase<decltype(E), pg8::StaticOrder, false>(X.lds, g, S, E, X.tid);
            GBAR();
        }
#if ROUTER_MFMA
        if (IN(5)) { MKCTX(); if (REP_P5 > 1) ln1_router_mfma(X, ap, l, true); ln1_router_mfma(X, ap, l); GBAR(); }
#else
        if (IN(5)) { MKCTX(); if (REP_P5 > 1) ln1_router(X, ap, l, l == 0, true); ln1_router(X, ap, l, l == 0); GBAR(); }
#endif
        if (IN(6)) { MKCTX(); for (int rep = 0; rep < REP_P6; ++rep) moe_dispatch(X); GBAR(); }
        if (IN(7)) { MKCTX();
            const int* TILEE = (const int*)(X.ws + WS_TILEE);
            pg8::Gemm g{(const bf16*)(X.ws + WS_XB), (const bf16*)(X.ws + WS_WGU), DM, (const int*)(X.ws + WS_STOK)};
            pg8::GroupedOrder S{TILEE, TILEE[1024], 2, X.G, X.c};
            pg8::EpiGateUpT<NT_H> E{(bf16*)(X.ws + WS_H), (const float*)(X.ws + WS_SW)};
            for (int rep = 0; rep < REP_P7; ++rep) pg8::gemm_phase<decltype(E), pg8::GroupedOrder, true>(X.lds, g, S, E, X.tid);
            GBAR();
        }
        if (IN(8)) { MKCTX();
            const int* TILEE = (const int*)(X.ws + WS_TILEE);
            pg8::Gemm g{(const bf16*)(X.ws + WS_H), (const bf16*)(X.ws + WS_WD), FH, nullptr};
            pg8::GroupedOrder S{TILEE, TILEE[1024], 4, X.G, X.c};
#if Y_FP8
            pg8::EpiFp8T<NT_Y> E{X.ws + WS_Y, DM, Y_SCALE, X.lds + LDS_X_OFF};
#else
            pg8::EpiPlainT<NT_Y> E{(bf16*)(X.ws + WS_Y), DM, nullptr, 0, 0.f, 0.f, X.lds + LDS_X_OFF};
#endif
            for (int rep = 0; rep < REP_P8; ++rep) pg8::gemm_phase<decltype(E), pg8::GroupedOrder, false>(X.lds, g, S, E, X.tid);
            GBAR();
        }
        if (IN(9)) { MKCTX(); if (REP_P9 > 1) ln2_phase(X, ap, l, l == 0, true); ln2_phase(X, ap, l, l == 0); if (!(l == a.l_hi - 1)) GBAR(); }
#undef IN
    }
#undef GBAR
}

extern "C" void kernel_launch(void* const* d_in, const int* in_sizes, int n_in, void* d_out, int out_size, void* d_ws, size_t ws_size, hipStream_t stream) {
    static int grid = 0;
    if (grid == 0) {
        if (n_in != 19 || in_sizes[0] != NT * DM || out_size != NT * DM || ws_size < WS_END) { fprintf(stderr, "kernel_launch: unexpected shapes (n_in %d, in0 %d, out %d, ws %zu < %zu); nothing launched\n", n_in, n_in > 0 ? in_sizes[0] : -1, out_size, ws_size, (size_t)WS_END); grid = -1; return; }
        int dev = 0, cus = 0, per_cu = 0;
        if (hipGetDevice(&dev) != hipSuccess || hipDeviceGetAttribute(&cus, hipDeviceAttributeMultiprocessorCount, dev) != hipSuccess) { grid = -1; return; }
        if (hipFuncSetAttribute((const void*)mk_fwd, hipFuncAttributeMaxDynamicSharedMemorySize, LDS_BYTES) != hipSuccess) { fprintf(stderr, "kernel_launch: hipFuncSetAttribute failed\n"); grid = -1; return; }
        if (hipOccupancyMaxActiveBlocksPerMultiprocessor(&per_cu, (const void*)mk_fwd, 512, LDS_BYTES) != hipSuccess || per_cu < 1) fprintf(stderr, "kernel_launch: occupancy query reports %d\n", per_cu);
        (void)hipGetLastError();
        grid = cus;
    }
    if (grid < 0) return;
    (void)hipMemsetAsync((char*)d_ws + WS_CTL, 0, CTL_BYTES, stream);
    Args a{};
    a.x = (const float*)d_in[0]; a.pos = (const int*)d_in[1]; a.w_in = (const float*)d_in[2]; a.qn = (const float*)d_in[3]; a.kvn = (const float*)d_in[4];
    a.w_uq = (const float*)d_in[5]; a.w_ukv = (const float*)d_in[6]; a.w_o = (const float*)d_in[7]; a.ln1g = (const float*)d_in[8]; a.ln1b = (const float*)d_in[9];
    a.rgw = (const float*)d_in[10]; a.rgb = (const float*)d_in[11]; a.rew = (const float*)d_in[12]; a.reb = (const float*)d_in[13];
    a.wg = (const float*)d_in[14]; a.wu = (const float*)d_in[15]; a.wd = (const float*)d_in[16]; a.ln2g = (const float*)d_in[17]; a.ln2b = (const float*)d_in[18];
    a.out = (float*)d_out; a.ws = (unsigned char*)d_ws; a.pad = 0;
#if MK_MULTI
    a.use_bar = 0;
    a.l_lo = 0; a.l_hi = 0; a.ph_lo = 0; a.ph_hi = 0;
    hipLaunchKernelGGL(mk_fwd, dim3(grid), dim3(512), LDS_BYTES, stream, a);
    for (int l = 0; l < DEPTH; ++l)
        for (int ph = 1; ph < 10; ++ph) { a.l_lo = l; a.l_hi = l + 1; a.ph_lo = ph; a.ph_hi = ph + 1; hipLaunchKernelGGL(mk_fwd, dim3(grid), dim3(512), LDS_BYTES, stream, a); }
#else
    a.use_bar = 1; a.l_lo = 0; a.l_hi = DEPTH; a.ph_lo = 0; a.ph_hi = 10;
    hipLaunchKernelGGL(mk_fwd, dim3(grid), dim3(512), LDS_BYTES, stream, a);
#endif
    const hipError_t le = hipPeekAtLastError();
    if (le != hipSuccess) fprintf(stderr, "kernel_launch: launch failed: %s\n", hipGetErrorName(le));
}
```

```cpp
#include <hip/hip_runtime.h>
#include <cstdio>
#include <cstdint>

#define LAS __attribute__((address_space(3)))
#define GAS __attribute__((address_space(1)))
typedef unsigned short bf16;
typedef short bf16x8 __attribute__((ext_vector_type(8)));
typedef short s16x4 __attribute__((ext_vector_type(4)));
typedef float f32x2 __attribute__((ext_vector_type(2)));
typedef float f32x4 __attribute__((ext_vector_type(4)));
typedef float f32x16 __attribute__((ext_vector_type(16)));
typedef unsigned u32x2 __attribute__((ext_vector_type(2)));
typedef unsigned u32x4 __attribute__((ext_vector_type(4)));
typedef __bf16 bf16x2_t __attribute__((ext_vector_type(2)));

#ifndef MK_MULTI
#define MK_MULTI 0
#endif

constexpr int NB = 32, SEQ = 2048, NT = NB * SEQ, DM = 1024, DEPTH = 4;
constexpr int IN_COLS = 3400, NIN = 3584;
constexpr int NEXP = 32, FH = 256;
constexpr int NSLOT = 2 * NT + NEXP * 256;
constexpr int MAXTILES = NSLOT / 256;
constexpr float ALPHA = 1.681792830507429f;
constexpr float LOG2E = 1.4426950408889634f;
constexpr float QSC64 = 0.125f * LOG2E;
constexpr float QSC96 = 0.10206207261596577f * LOG2E;
constexpr float IDX_SCALE = 0.0625f;

constexpr size_t MiB = 1u << 20;
constexpr size_t WS_CTL = 0, CTL_BYTES = 1 * MiB;
constexpr size_t WS_WIN = 1 * MiB;
constexpr size_t WS_WUQ = 29 * MiB;
constexpr size_t WS_WUKV = WS_WUQ + 3 * MiB / 2;
constexpr size_t WS_WO = WS_WUKV + 2 * MiB;
constexpr size_t WS_RGT = WS_WO + 8 * MiB;
constexpr size_t WS_RET = WS_RGT + 64 * 1024;
constexpr size_t WS_ROPE = 42 * MiB;
constexpr size_t WS_WGU = 56 * MiB;
constexpr size_t WS_WD = 88 * MiB;
constexpr size_t WS_XB = 104 * MiB;
constexpr size_t WS_A = 232 * MiB;
constexpr size_t WS_CQ = WS_A;
constexpr size_t WS_T1 = WS_CQ + 32 * MiB;
constexpr size_t WS_BK = WS_T1 + 16 * MiB;
constexpr size_t WS_BQ = WS_T1 + 32 * MiB;
constexpr size_t WS_BV = WS_BQ + 32 * MiB;
constexpr size_t WS_WI = WS_BV + 8 * MiB;
constexpr size_t WS_BQI = WS_WI + 2 * MiB;
constexpr size_t WS_SSQ = WS_BQI + 32 * MiB;
constexpr size_t WS_DQ = WS_SSQ + 4 * MiB;
constexpr size_t WS_DK = WS_DQ + 96 * MiB;
constexpr size_t WS_DV = WS_DK + 96 * MiB;
constexpr size_t WS_B = WS_DV + 96 * MiB;
constexpr size_t WS_QA = WS_B;
constexpr size_t WS_KVA = WS_QA + 96 * MiB;
constexpr size_t WS_BM = WS_KVA + 128 * MiB;
constexpr size_t WS_OD = WS_BM + 16 * MiB;
constexpr size_t WS_LSE = WS_OD + 96 * MiB;
constexpr size_t WS_MOE = WS_LSE + 4 * MiB;
constexpr size_t WS_ROUTE = WS_MOE;
constexpr size_t WS_HIST = WS_ROUTE + 1 * MiB;
constexpr size_t WS_STOK = WS_HIST + 64 * 1024;
constexpr size_t WS_SW = WS_STOK + 640 * 1024;
constexpr size_t WS_TSLOT = WS_SW + 640 * 1024;
constexpr size_t WS_TILEE = WS_TSLOT + 512 * 1024;
constexpr size_t WS_KPE = WS_MOE + 4 * MiB;
constexpr size_t WS_KI = WS_KPE + 4 * MiB;
constexpr size_t WS_END = WS_KI + 4 * MiB;
constexpr size_t WS_MIX = WS_A;
constexpr size_t WS_H = WS_A + 128 * MiB;
constexpr size_t WS_Y = WS_H + 68 * MiB;
static_assert(WS_RET + 512 * 1024 <= WS_ROPE && WS_ROPE + 14 * MiB <= WS_WGU && WS_WD + 16 * MiB <= WS_XB && WS_XB + 128 * MiB <= WS_A, "ws map 1");
static_assert(WS_Y + 272 * MiB <= WS_MOE && WS_TILEE + 8192 <= WS_END && WS_END <= 1024 * MiB, "ws map 2");
constexpr size_t ROPE_C16 = 0, ROPE_S16 = (size_t)NT * 16 * 4, ROPE_C8 = 2 * ROPE_S16, ROPE_S8 = ROPE_C8 + (size_t)NT * 8 * 4,
                 ROPE_C4 = ROPE_S8 + (size_t)NT * 8 * 4, ROPE_S4 = ROPE_C4 + (size_t)NT * 4 * 4;

constexpr int CW_BAR = 4096;
constexpr int RING_BYTES = 131072;
constexpr int LDS_X_OFF = 131072;
constexpr int LDSCTL_OFF = 147456;
constexpr int LDS_HIST_OFF = LDSCTL_OFF + 4096;
constexpr int LDS_BYTES = LDS_HIST_OFF + 4096;

#define RLX_AGENT __ATOMIC_RELAXED, __HIP_MEMORY_SCOPE_AGENT
__device__ __forceinline__ unsigned f2bf(float f) { unsigned u = __builtin_bit_cast(unsigned, f); return (u + 0x7fffu + ((u >> 16) & 1u)) >> 16; }
#ifndef Y_FP8
#define Y_FP8 1
#endif
#define Y_SCALE 64.0f
#ifndef MIX_FP8
#define MIX_FP8 0
#endif
#define MIX_SCALE 256.0f
#ifndef ROUTER_MFMA
#define ROUTER_MFMA 1
#endif
#ifndef LN2_X1B
#define LN2_X1B 1
#endif
constexpr size_t XR_OFF = (size_t)NT * DM * 2;
#ifndef NT_EPI
#define NT_EPI 1
#endif
#ifndef NT_KVA
#define NT_KVA 1
#endif
#ifndef NT_MIX
#define NT_MIX 0
#endif
#ifndef NT_H
#define NT_H 0
#endif
#ifndef NT_Y
#define NT_Y 1
#endif
#ifndef NT_LN
#define NT_LN 0
#endif
#ifndef NT_ATT
#define NT_ATT 1
#endif
#define STG_ASM(W, POL) asm volatile("global_store_dwordx" W " %0, %1, off " POL "\n\ts_nop 1" :: "v"(p), "v"(w))
template <int M, class T> __device__ __forceinline__ void stg_any16(void* p, T w) {
    if constexpr (M == 0) *(T*)p = w; else if constexpr (M == 1) __builtin_nontemporal_store(w, (T*)p);
    else if constexpr (M == 2) STG_ASM("4", "sc1"); else if constexpr (M == 3) STG_ASM("4", "sc0 sc1"); else if constexpr (M == 4) STG_ASM("4", "sc1 nt"); else STG_ASM("4", "sc0 sc1 nt"); }
template <int M> __device__ __forceinline__ void stgf4(void* p, f32x4 w) { stg_any16<M>(p, w); }
template <int M> __device__ __forceinline__ void stg16(void* p, u32x4 w) { stg_any16<M>(p, w); }
template <int M> __device__ __forceinline__ void stg8(void* p, u32x2 w) {
    if constexpr (M == 0) *(u32x2*)p = w; else if constexpr (M == 1) __builtin_nontemporal_store(w, (u32x2*)p);
    else if constexpr (M == 2) STG_ASM("2", "sc1"); else if constexpr (M == 3) STG_ASM("2", "sc0 sc1"); else if constexpr (M == 4) STG_ASM("2", "sc1 nt"); else STG_ASM("2", "sc0 sc1 nt"); }
#ifndef NT_LD
#define NT_LD 1
#endif
template <class T> __device__ __forceinline__ T ldg_s(const void* p) { if constexpr (NT_LD) return __builtin_nontemporal_load((const T*)p); else return *(const T*)p; }
__device__ __forceinline__ unsigned pk2(float lo, float hi) { f32x2 v = {lo, hi}; bf16x2_t b = __builtin_convertvector(v, bf16x2_t); return __builtin_bit_cast(unsigned, b); }
__device__ __forceinline__ float bf2f(unsigned short b) { return __builtin_bit_cast(float, ((unsigned)b) << 16); }
__device__ __forceinline__ float bflo(unsigned w) { return __builtin_bit_cast(float, w << 16); }
__device__ __forceinline__ float bfhi(unsigned w) { return __builtin_bit_cast(float, w & 0xffff0000u); }
template <int CTRL> __device__ __forceinline__ float dppf(float x) { return __builtin_bit_cast(float, __builtin_amdgcn_mov_dpp(__builtin_bit_cast(int, x), CTRL, 0xf, 0xf, true)); }
__device__ __forceinline__ float xhalf_sum(float v) { const auto t = __builtin_amdgcn_permlane32_swap(__float_as_uint(v), __float_as_uint(v), false, false); return __uint_as_float(t[0]) + __uint_as_float(t[1]); }
__device__ __forceinline__ float xhalf_max(float v) { const auto t = __builtin_amdgcn_permlane32_swap(__float_as_uint(v), __float_as_uint(v), false, false); return fmaxf(__uint_as_float(t[0]), __uint_as_float(t[1])); }
__device__ __forceinline__ float wave_sum(float v) {
    v += dppf<0xB1>(v); v += dppf<0x4E>(v); v += dppf<0x141>(v); v += dppf<0x140>(v);
    const auto s = __builtin_amdgcn_permlane16_swap(__float_as_uint(v), __float_as_uint(v), false, false);
    v = __uint_as_float(s[0]) + __uint_as_float(s[1]);
    return xhalf_sum(v);
}
template <int N> __device__ __forceinline__ void wave_sum_n(float (&v)[N]) {
#pragma unroll
    for (int i = 0; i < N; ++i) v[i] += dppf<0xB1>(v[i]);
#pragma unroll
    for (int i = 0; i < N; ++i) v[i] += dppf<0x4E>(v[i]);
#pragma unroll
    for (int i = 0; i < N; ++i) v[i] += dppf<0x141>(v[i]);
#pragma unroll
    for (int i = 0; i < N; ++i) v[i] += dppf<0x140>(v[i]);
#pragma unroll
    for (int i = 0; i < N; ++i) { const auto s = __builtin_amdgcn_permlane16_swap(__float_as_uint(v[i]), __float_as_uint(v[i]), false, false); v[i] = __uint_as_float(s[0]) + __uint_as_float(s[1]); }
#pragma unroll
    for (int i = 0; i < N; ++i) v[i] = xhalf_sum(v[i]);
}
__device__ __forceinline__ int crow(int r, int hi) { return (r & 3) + 8 * (r >> 2) + 4 * hi; }

#define XB_TMO      128
#define XB_XCNT(j)  (256  + 64 * (j))
#define XB_XSUB(j)  (1280 + 64 * (j))
#define XB_XGEN(j)  (2304 + 64 * (j))
#define XB_TOP      3328
#define XB_TOPGEN   3392
#define XCD_BAR_WORDS 3456
#define XB_SPIN_CAP (1u << 18)
__device__ __forceinline__ unsigned xb_ld(unsigned* p)              { return __hip_atomic_load(p, __ATOMIC_RELAXED, __HIP_MEMORY_SCOPE_AGENT); }
__device__ __forceinline__ unsigned xb_add(unsigned* p, unsigned v) { return __hip_atomic_fetch_add(p, v, __ATOMIC_RELAXED, __HIP_MEMORY_SCOPE_AGENT); }
__device__ __forceinline__ unsigned xb_xcc_id() { return (unsigned)__builtin_amdgcn_s_getreg((3 << 11) | 20) & 0xFu; }
#define XB_SPIN(cond, bar) do { unsigned _sp = 0; while (cond) { __builtin_amdgcn_s_sleep(1); \
    if ((++_sp & 255u) == 0u) { if (xb_ld(&(bar)[XB_TMO])) break; if (_sp > XB_SPIN_CAP) { atomicAdd(&(bar)[XB_TMO], 1u); break; } } } } while (0)
struct XcdBarrier { unsigned* bar; unsigned x; volatile LAS unsigned* st; };
__device__ __forceinline__ XcdBarrier xcd_barrier_post(unsigned* bar, volatile LAS unsigned* st) {
    XcdBarrier b; b.bar = bar; b.x = xb_xcc_id(); b.st = st;
    if (threadIdx.x == 0) (void)xb_add(&bar[XB_XCNT(b.x)], 1u);
    return b;
}
__device__ __forceinline__ void xcd_barrier_complete(unsigned* bar, unsigned x, unsigned& nloc, unsigned& nx) {
    const unsigned G = gridDim.x * gridDim.y * gridDim.z;
    unsigned sum, cnt, mine, sp = 0u;
    for (;;) {
        sum = 0u; cnt = 0u; mine = 0u;
#pragma unroll
        for (unsigned j = 0; j < 16; ++j) { const unsigned c = xb_ld(&bar[XB_XCNT(j)]); sum += c; cnt += (c > 0u) ? 1u : 0u; mine = (j == x) ? c : mine; }
        if (sum == G) break;
        __builtin_amdgcn_s_sleep(1);
        if ((++sp & 255u) == 0u) { if (xb_ld(&bar[XB_TMO])) break; if (sp > XB_SPIN_CAP) { atomicAdd(&bar[XB_TMO], 1u); break; } }
    }
    nloc = mine > 0u ? mine : 1u; nx = cnt > 0u ? cnt : 1u;
}
__device__ __forceinline__ void xcd_barrier(const XcdBarrier& b) {
    asm volatile("s_waitcnt vmcnt(0)" ::: "memory");
    __syncthreads();
    if (threadIdx.x == 0) {
        unsigned* bar = b.bar;
        __builtin_amdgcn_s_waitcnt(0);
        unsigned nloc = b.st[0], nx = b.st[1];
        if (nloc == 0u) { xcd_barrier_complete(bar, b.x, nloc, nx); b.st[0] = nloc; b.st[1] = nx; }
        const unsigned old = xb_add(&bar[XB_XSUB(b.x)], 1u);
        const unsigned gen = old / nloc;
        if (old + 1u == (gen + 1u) * nloc) {
            __builtin_amdgcn_fence(__ATOMIC_RELEASE, "agent");
            asm volatile("s_waitcnt vmcnt(0)" ::: "memory");
            const unsigned og = xb_add(&bar[XB_TOP], 1u);
            const unsigned tg = og / nx;
            if (og + 1u == (tg + 1u) * nx) xb_add(&bar[XB_TOPGEN], 1u);
            else XB_SPIN(xb_ld(&bar[XB_TOPGEN]) == tg, bar);
            __builtin_amdgcn_fence(__ATOMIC_ACQUIRE, "agent");
            xb_add(&bar[XB_XGEN(b.x)], 1u);
            asm volatile("s_waitcnt vmcnt(0)" ::: "memory");
        } else {
            XB_SPIN(xb_ld(&bar[XB_XGEN(b.x)]) == gen, bar);
            __builtin_amdgcn_fence(__ATOMIC_ACQUIRE, "agent");
            asm volatile("s_waitcnt vmcnt(0)" ::: "memory");
        }
    }
    __syncthreads();
}

namespace pg8 {
constexpr int BM = 256, BK = 64, HALF = 128, HTB = HALF * BK * 2, STAGE_BYTES = 8 * HTB, NXCD = 8, WGM = 8;
__host__ __device__ __forceinline__ int lds_byte(int r, int c) { const int st = (r >> 4) * 2 + (c >> 5), rr = r & 15, cc = c & 31, ob = rr * 64 + cc * 2; return st * 1024 + (ob ^ (((ob >> 9) & 1) << 5)); }
__host__ __device__ __forceinline__ void stage_rc(int b, int& R, int& C) { const int st = b / 1024, sb = b % 1024, swz = sb ^ (((sb >> 9) & 1) << 5); R = (st >> 1) * 16 + swz / 64; C = (st & 1) * 32 + (swz % 64) / 2; }
__host__ __device__ __forceinline__ int perm32(int rho) { const int n = rho >> 4, i = rho & 15; return 8 * (i >> 2) + 4 * n + (i & 3); }

#ifndef PROBE_P1
#define PROBE_P1 0
#endif
struct Unit { int pm, pn, pb;
#if PROBE_P1
    int fl;
#endif
};
struct Gemm { const bf16* A; const bf16* Bt; int K; const int* gidx; };

__device__ __forceinline__ int xcd_remap(int wgid, int nwg) { const int q = nwg / NXCD, r = nwg % NXCD, xcd = wgid % NXCD, off = wgid / NXCD; return (xcd < r ? xcd * (q + 1) : r * (q + 1) + (xcd - r) * q) + off; }
struct StaticOrder {
    int nM, nN, nwg, G, c, rep;
    __device__ void init(int M, int N, int G_, int c_, int rep_ = 1) { nM = M / BM; nN = N / BM; nwg = nM * nN; G = G_; c = c_; rep = rep_; }
    __device__ bool next(int i, Unit& u) const {
        long L = (long)i * G + c; if (L >= (long)nwg * rep) return false;
#if PROBE_P1
        u.fl = (rep > 1 && L < nwg) ? 1 : 0;
#endif
        L %= nwg;
        const int wgid = xcd_remap((int)L, nwg);
        const int nig = WGM * nN, gid = wgid / nig, fm = gid * WGM, gsz = (nM - fm) < WGM ? (nM - fm) : WGM;
        u.pm = fm + ((wgid % nig) % gsz); u.pn = (wgid % nig) / gsz; u.pb = u.pn; return true;
    }
};
struct GroupedOrder {
    const int* tile_e; int ntiles, npn, G, c;
    __device__ bool next(int i, Unit& u) const {
        const long L = (long)i * G + c; const int nwg = ntiles * npn; if (L >= nwg) return false;
        const int wgid = xcd_remap((int)L, nwg);
        u.pm = wgid / npn; u.pn = wgid % npn; u.pb = tile_e[u.pm] * npn + u.pn;
#if PROBE_P1
        u.fl = 0;
#endif
        return true;
    }
};

__device__ __forceinline__ unsigned cvt_pk_bf16(float lo, float hi) { unsigned r; asm volatile("v_cvt_pk_bf16_f32 %0, %1, %2" : "=v"(r) : "v"(lo), "v"(hi)); return r; }

template <int STM> struct EpiPlainT {
    static constexpr bool PERM = true;
    bf16* O; int ldc; const float* ssq; int ssq_n; float ssq_inv; float eps;
    LAS unsigned char* xl;
    __device__ __forceinline__ void operator()(const f32x4 (&acc)[2][2][4][2], const Unit& u, int wr, int wc, int fr, int fq) const {
        const int lane = fq * 16 + fr; LAS unsigned char* t = xl + (wr * 4 + wc) * 2048;
        const int wsw = fr & 7, rrow = lane >> 3, rch = lane & 7;
#pragma unroll
        for (int ai = 0; ai < 2; ++ai)
#pragma unroll
            for (int m = 0; m < 4; ++m) { const int rowb = u.pm * BM + ai * HALF + wr * 64 + m * 16;
                float sc = 1.f;
                if (ssq) { const f32x4 p = *(const f32x4*)(ssq + (size_t)(rowb + fr) * ssq_n); sc = __builtin_amdgcn_rsqf((p[0] + p[1] + p[2] + p[3]) * ssq_inv + eps); }
#pragma unroll
                for (int bj = 0; bj < 2; ++bj) { const f32x4 v0 = acc[ai][bj][m][0] * sc, v1 = acc[ai][bj][m][1] * sc;
                    u32x4 w; w.x = cvt_pk_bf16(v0[0], v0[1]); w.y = cvt_pk_bf16(v0[2], v0[3]); w.z = cvt_pk_bf16(v1[0], v1[1]); w.w = cvt_pk_bf16(v1[2], v1[3]);
                    *(LAS u32x4*)(t + fr * 128 + 16 * ((4 * bj + fq) ^ wsw)) = w; }
#pragma unroll
                for (int i = 0; i < 2; ++i) { const int rr = 8 * i + rrow;
                    const u32x4 w = *(const LAS u32x4*)(t + rr * 128 + 16 * (rch ^ (rr & 7)));
                    stg16<STM>(O + (size_t)(rowb + rr) * ldc + u.pn * BM + wc * 64 + 8 * rch, w); }
            }
    }
};
template <int STM> struct EpiFp8T {
    static constexpr bool PERM = true;
    unsigned char* O; int ldc; float scale; LAS unsigned char* xl;
    __device__ __forceinline__ void operator()(const f32x4 (&acc)[2][2][4][2], const Unit& u, int wr, int wc, int fr, int fq) const {
        const int lane = fq * 16 + fr; LAS unsigned char* t = xl + (wr * 4 + wc) * 2048;
        const int rrow = lane >> 2, rch = lane & 3;
#pragma unroll
        for (int ai = 0; ai < 2; ++ai)
#pragma unroll
            for (int m = 0; m < 4; ++m) { const int rowb = u.pm * BM + ai * HALF + wr * 64 + m * 16;
#pragma unroll
                for (int bj = 0; bj < 2; ++bj) { f32x4 v0 = acc[ai][bj][m][0] * scale, v1 = acc[ai][bj][m][1] * scale;
#pragma unroll
                    for (int e = 0; e < 4; ++e) { v0[e] = __builtin_amdgcn_fmed3f(v0[e], -448.f, 448.f); v1[e] = __builtin_amdgcn_fmed3f(v1[e], -448.f, 448.f); }
                    int lo = __builtin_amdgcn_cvt_pk_fp8_f32(v0[0], v0[1], 0, false); lo = __builtin_amdgcn_cvt_pk_fp8_f32(v0[2], v0[3], lo, true);
                    int hi = __builtin_amdgcn_cvt_pk_fp8_f32(v1[0], v1[1], 0, false); hi = __builtin_amdgcn_cvt_pk_fp8_f32(v1[2], v1[3], hi, true);
                    *(LAS u32x2*)(t + fr * 64 + 32 * bj + 8 * fq) = (u32x2){(unsigned)lo, (unsigned)hi}; }
                const u32x4 w = *(const LAS u32x4*)(t + lane * 16);
                stg16<STM>(O + (size_t)(rowb + rrow) * ldc + u.pn * BM + wc * 64 + 16 * rch, w); }
    }
};
__device__ __forceinline__ f32x4 fp8x4_to_f32(unsigned w) { const f32x2 a = __builtin_amdgcn_cvt_pk_f32_fp8((int)w, false), b = __builtin_amdgcn_cvt_pk_f32_fp8((int)w, true); return (f32x4){a.x, a.y, b.x, b.y}; }
template <int STM> struct EpiGateUpT {
    static constexpr bool PERM = true;
    bf16* H; const float* sw;
    __device__ __forceinline__ void operator()(const f32x4 (&acc)[2][2][4][2], const Unit& u, int wr, int wc, int fr, int fq) const {
        const int row0 = u.pm * BM + wr * 64 + fr; const int col0 = u.pn * HALF + wc * 32 + 8 * fq;
#pragma unroll
        for (int ai = 0; ai < 2; ++ai)
#pragma unroll
            for (int m = 0; m < 4; ++m) { const int row = row0 + ai * HALF + m * 16; const float w = sw[row]; f32x4 hv[2];
#pragma unroll
                for (int n = 0; n < 2; ++n) { const f32x4 g = acc[ai][0][m][n], up = acc[ai][1][m][n];
#pragma unroll
                    for (int e = 0; e < 4; ++e) { const float sg = g[e] * __builtin_amdgcn_rcpf(1.0f + __builtin_amdgcn_exp2f(-g[e] * LOG2E)); hv[n][e] = sg * up[e] * w; } }
                u32x4 o; o.x = cvt_pk_bf16(hv[0][0], hv[0][1]); o.y = cvt_pk_bf16(hv[0][2], hv[0][3]); o.z = cvt_pk_bf16(hv[1][0], hv[1][1]); o.w = cvt_pk_bf16(hv[1][2], hv[1][3]);
                stg16<STM>(H + (size_t)row * FH + col0, o); }
    }
};

enum { GK_SKIP = 0, GK_PLAIN = 1, GK_ROPE32 = 2, GK_HEAD16 = 3, GK_IDX8 = 4, GK_WI = 5 };
struct GroupDesc { int kind; bf16* dst; int pitch; int col; float scale; int perm; float* ssq; int ssq_n; int ssq_i; };
struct RopeTabs { const int* pos; };
__device__ __forceinline__ int perm_row(int row, int perm) {
    if (perm == 0) return row; const int b = row >> 11, s = row & 2047;
    return perm == 4 ? (b << 11) + ((s & 3) << 9) + (s >> 2) : (b << 11) + ((s & 15) << 7) + (s >> 4);
}
__device__ __forceinline__ void st16(bf16* p, u32x2 a, u32x2 b) { u32x4 w; w.x = a.x; w.y = a.y; w.z = b.x; w.w = b.y; stg16<NT_EPI>(p, w); }
__device__ __forceinline__ u32x2 pk4(f32x4 v) { u32x2 w; w.x = cvt_pk_bf16(v[0], v[1]); w.y = cvt_pk_bf16(v[2], v[3]); return w; }
__device__ __forceinline__ void swap16(u32x2& X, u32x2& Y) {
    const auto a = __builtin_amdgcn_permlane16_swap(X.x, Y.x, false, false); const auto b = __builtin_amdgcn_permlane16_swap(X.y, Y.y, false, false);
    X.x = a[0]; Y.x = a[1]; X.y = b[0]; Y.y = b[1];
}
__device__ __forceinline__ float rope_k(int i, int rd) { return __builtin_amdgcn_exp2f(-18.931568569324174f * (float)(2 * i) / (float)rd) * 0.15915494309189535f; }
__device__ __forceinline__ void rope_cs(float posf, int i0, int rd, f32x4& c, f32x4& s) {
#pragma unroll
    for (int e = 0; e < 4; ++e) { const float f = __builtin_amdgcn_fractf(posf * rope_k(i0 + e, rd)); s[e] = __builtin_amdgcn_sinf(f); c[e] = __builtin_amdgcn_cosf(f); }
}
template <class DescFn> struct EpiGroups {
    static constexpr bool PERM = true;
    DescFn F; RopeTabs R; const float* rs_ssq; int rs_n; float rs_inv, rs_eps;
    __device__ __forceinline__ void operator()(const f32x4 (&acc)[2][2][4][2], const Unit& u, int wr, int wc, int fr, int fq) const {
        const int row0 = u.pm * BM + wr * 64 + fr;
#pragma unroll
        for (int bj = 0; bj < 2; ++bj) {
            const GroupDesc d = F(u.pn, bj, wc);
            if (d.kind == GK_SKIP) continue;
#if PROBE_P1 == 1
            if (u.fl) continue;
#endif
            const int ki0 = d.kind == GK_ROPE32 ? 4 * fq : (d.kind == GK_HEAD16 ? 4 * (fq & 1) : 0), krd = d.kind == GK_ROPE32 ? 32 : (d.kind == GK_HEAD16 ? 16 : 8);
#pragma unroll
            for (int ai = 0; ai < 2; ++ai)
#pragma unroll
                for (int m = 0; m < 4; ++m) {
                    const int row = row0 + ai * HALF + m * 16;
                    float sc = d.scale;
                    if (rs_ssq) { float s = 0.f; for (int i = 0; i < rs_n; ++i) s += rs_ssq[(size_t)row * rs_n + i]; sc *= __builtin_amdgcn_rsqf(s * rs_inv + rs_eps); }
                    f32x4 v0 = acc[ai][bj][m][0], v1 = acc[ai][bj][m][1];
                    if (d.ssq) {
                        float q = (v0[0] * v0[0] + v0[1] * v0[1]) + (v0[2] * v0[2] + v0[3] * v0[3]) + (v1[0] * v1[0] + v1[1] * v1[1]) + (v1[2] * v1[2] + v1[3] * v1[3]);
                        q += __shfl_xor(q, 16); q += __shfl_xor(q, 32);
                        if (fq == 0) d.ssq[(size_t)row * d.ssq_n + d.ssq_i] = q;
                    }
                    v0 = v0 * sc; v1 = v1 * sc;
                    if (d.kind == GK_WI) { if (fq == 0) { float* wp = (float*)d.dst + (size_t)row * 8; *(f32x4*)wp = v0; *(f32x4*)(wp + 4) = v1; } continue; }
                    bf16* rp = d.dst + (size_t)perm_row(row, d.perm) * d.pitch + d.col;
                    if (d.kind == GK_PLAIN) { st16(rp + 8 * fq, pk4(v0), pk4(v1)); }
                    else if (d.kind == GK_IDX8) {
                        f32x4 c, s; rope_cs((float)R.pos[row], ki0, krd, c, s);
                        const f32x4 o1 = fq == 0 ? v0 * c - v1 * s : v0, o2 = fq == 0 ? v1 * c + v0 * s : v1;
                        st16(rp + 8 * fq, pk4(o1), pk4(o2));
                    } else if (d.kind == GK_ROPE32) {
                        f32x4 c, s; rope_cs((float)R.pos[row], ki0, krd, c, s);
                        u32x2 X = pk4(v0 * c - v1 * s), Y = pk4(v1 * c + v0 * s);
                        swap16(X, Y);
                        st16(rp + ((fq & 1) ? 16 + 4 * (fq - 1) : 4 * fq), X, Y);
                    } else {
                        f32x4 c, s; rope_cs((float)R.pos[row], ki0, krd, c, s);
                        u32x2 X = pk4(fq < 2 ? v0 * c - v1 * s : v0), Y = pk4(fq < 2 ? v1 * c + v0 * s : v1);
                        swap16(X, Y);
                        st16(rp + 16 * (fq >> 1) + 8 * (fq & 1), X, Y);
                    }
                }
        }
    }
};

template <class Epi, class Sched, bool GATHER, int LDA = 0>
__device__ __forceinline__ void gemm_phase(LAS unsigned char* lds, const Gemm g, const Sched& S, const Epi& E, const int tid) {
    const int wid = __builtin_amdgcn_readfirstlane(tid >> 6), lane = tid & 63, wr = wid >> 2, wc = wid & 3, fr = lane & 15, fq = lane >> 4;
    const int K = g.K, nt = K / BK, lda = LDA ? LDA : K;
    unsigned voA[2][2], voB[2]; int RA[2], CA[2];
#pragma unroll
    for (int i = 0; i < 2; ++i) { int R, C; stage_rc(tid * 16 + i * 8192, R, C); const int Rb = Epi::PERM ? ((R & ~31) + perm32(R & 31)) : R;
        RA[i] = R; CA[i] = C; voA[0][i] = (unsigned)(R * lda + C) * 2u; voA[1][i] = (unsigned)((R + HALF) * lda + C) * 2u; voB[i] = (unsigned)(Rb * K + C) * 2u; }
    const size_t kstep = (size_t)(BK * 2);
    const size_t hstep = (size_t)HALF * K * 2;
    const size_t tstep = 2 * hstep;
    const size_t tstepA = (size_t)BM * lda * 2;
    const unsigned ldsw = (unsigned)wid * 1024u;
    const int aoff = lds_byte(wr * 64 + fr, fq * 8), boff = lds_byte(wc * 32 + fr, fq * 8);
#define PG8_SA(b, h) (((b) * 2 + (h)) * HTB)
#define PG8_SB(b, h) ((4 + (b) * 2 + (h)) * HTB)
#define PG8_STAGE(bufoff, gbase, voff) do { _Pragma("unroll") for (int _i = 0; _i < 2; ++_i) \
        __builtin_amdgcn_global_load_lds((const unsigned*)((const char*)(gbase) + (voff)[_i]), (LAS unsigned*)(lds + (bufoff) + ldsw + _i * 8192), 16, 0, 0); } while (0)
#define PG8_LDA(dst, b, h) do { _Pragma("unroll") for (int m = 0; m < 4; ++m) _Pragma("unroll") for (int k = 0; k < 2; ++k) dst[m][k] = *(const LAS bf16x8*)(lds + PG8_SA(b, h) + aoff + m * 2048 + k * 1024); } while (0)
#define PG8_LDB(dst, b, h) do { _Pragma("unroll") for (int n = 0; n < 2; ++n) _Pragma("unroll") for (int k = 0; k < 2; ++k) dst[n][k] = *(const LAS bf16x8*)(lds + PG8_SB(b, h) + boff + n * 2048 + k * 1024); } while (0)
#define PG8_MMA(ai, bj, At, Bt) do { __builtin_amdgcn_s_setprio(1); _Pragma("unroll") for (int m = 0; m < 4; ++m) _Pragma("unroll") for (int n = 0; n < 2; ++n) _Pragma("unroll") for (int k = 0; k < 2; ++k) \
        acc[ai][bj][m][n] = __builtin_amdgcn_mfma_f32_16x16x32_bf16(Bt[n][k], At[m][k], acc[ai][bj][m][n], 0, 0, 0); __builtin_amdgcn_s_setprio(0); } while (0)
#define PG8_WAIT_V(n) asm volatile("s_waitcnt vmcnt(" #n ")" ::: "memory")
#define PG8_WAIT_L(n) asm volatile("s_waitcnt lgkmcnt(" #n ")" ::: "memory")
#define PG8_BAR __builtin_amdgcn_s_barrier()
#define PG8_SCHED __builtin_amdgcn_sched_barrier(0)
    Unit cur, nxt; int ui = 0;
    if (!S.next(0, cur)) return;
    f32x4 acc[2][2][4][2];
#pragma unroll
    for (int a = 0; a < 2; ++a)
#pragma unroll
        for (int b = 0; b < 2; ++b)
#pragma unroll
            for (int m = 0; m < 4; ++m)
#pragma unroll
                for (int n = 0; n < 2; ++n) acc[a][b][m][n] = (f32x4){0.f, 0.f, 0.f, 0.f};
    bf16x8 At[4][2], B0[2][2], B1[2][2];
    unsigned nvA[2][2];
    const char* cA; const char* cB = (const char*)g.Bt + (size_t)cur.pb * tstep;
    if constexpr (GATHER) { cA = (const char*)g.A;
#pragma unroll
        for (int h = 0; h < 2; ++h)
#pragma unroll
            for (int i = 0; i < 2; ++i) voA[h][i] = (unsigned)g.gidx[cur.pm * BM + h * HALF + RA[i]] * (unsigned)(lda * 2) + (unsigned)CA[i] * 2u;
    } else cA = (const char*)g.A + (size_t)cur.pm * tstepA;
    PG8_STAGE(PG8_SB(0, 0), cB, voB); PG8_STAGE(PG8_SB(0, 1), cB + hstep, voB); PG8_STAGE(PG8_SA(0, 0), cA, voA[0]); PG8_STAGE(PG8_SA(0, 1), cA, voA[1]);
    if (wr == 1) PG8_BAR;
    PG8_WAIT_V(2); PG8_BAR;
    PG8_STAGE(PG8_SB(1, 0), cB + kstep, voB); PG8_STAGE(PG8_SA(1, 0), cA + kstep, voA[0]); PG8_STAGE(PG8_SB(1, 1), cB + hstep + kstep, voB);
    PG8_WAIT_V(6); PG8_BAR;
    for (;;) {
        const bool has_next = S.next(ui + 1, nxt);
        const char* nA; const char* nB = has_next ? (const char*)g.Bt + (size_t)nxt.pb * tstep : cB;
        if constexpr (GATHER) { nA = cA;
#pragma unroll
            for (int h = 0; h < 2; ++h)
#pragma unroll
                for (int i = 0; i < 2; ++i) nvA[h][i] = has_next ? (unsigned)g.gidx[nxt.pm * BM + h * HALF + RA[i]] * (unsigned)(lda * 2) + (unsigned)CA[i] * 2u : voA[h][i];
        } else nA = has_next ? (const char*)g.A + (size_t)nxt.pm * tstepA : cA;
#if PROBE_P1 == 2
        const int ntu = cur.fl ? 2 : nt;
#else
        const int ntu = nt;
#endif
#pragma nounroll
        for (int t = 0; t < ntu; t += 2) {
            const bool last = (t == ntu - 2);
            const char* a1 = cA + (size_t)(t + 1) * kstep;
            const char* a2 = last ? nA : cA + (size_t)(t + 2) * kstep; const char* b2 = last ? nB : cB + (size_t)(t + 2) * kstep;
            const char* a3 = a2 + kstep; const char* b3 = b2 + kstep;
            unsigned xA[2][2];
#pragma unroll
            for (int h = 0; h < 2; ++h)
#pragma unroll
                for (int i = 0; i < 2; ++i) xA[h][i] = (GATHER && last) ? nvA[h][i] : voA[h][i];
            PG8_LDB(B0, 0, 0); PG8_LDB(B1, 0, 1); PG8_SCHED; PG8_LDA(At, 0, 0); PG8_STAGE(PG8_SA(1, 1), a1, voA[1]);
            PG8_WAIT_V(8); PG8_WAIT_L(0); PG8_BAR; PG8_MMA(0, 0, At, B0); PG8_MMA(0, 1, At, B1); PG8_BAR; PG8_SCHED;
            PG8_LDA(At, 0, 1); PG8_STAGE(PG8_SB(0, 0), b2, voB); PG8_STAGE(PG8_SB(0, 1), b2 + hstep, voB); PG8_STAGE(PG8_SA(0, 0), a2, xA[0]);
            PG8_WAIT_V(8); PG8_WAIT_L(0); PG8_BAR; PG8_MMA(1, 0, At, B0); PG8_MMA(1, 1, At, B1); PG8_BAR; PG8_SCHED;
            PG8_LDB(B0, 1, 0); PG8_LDB(B1, 1, 1); PG8_SCHED; PG8_LDA(At, 1, 0); PG8_STAGE(PG8_SA(0, 1), a2, xA[1]);
            PG8_WAIT_V(8); PG8_WAIT_L(0); PG8_BAR; PG8_MMA(0, 0, At, B0); PG8_MMA(0, 1, At, B1); PG8_BAR; PG8_SCHED;
            PG8_LDA(At, 1, 1); PG8_STAGE(PG8_SB(1, 0), b3, voB); PG8_STAGE(PG8_SB(1, 1), b3 + hstep, voB); PG8_STAGE(PG8_SA(1, 0), a3, xA[0]);
            PG8_WAIT_V(8); PG8_WAIT_L(0); PG8_BAR; PG8_MMA(1, 0, At, B0); PG8_MMA(1, 1, At, B1); PG8_BAR; PG8_SCHED;
        }
        if (wr == 0) PG8_BAR;
        E(acc, cur, wr, wc, fr, fq);
        if (!has_next) break;
#pragma unroll
        for (int a = 0; a < 2; ++a)
#pragma unroll
            for (int b = 0; b < 2; ++b)
#pragma unroll
                for (int m = 0; m < 4; ++m)
#pragma unroll
                    for (int n = 0; n < 2; ++n) acc[a][b][m][n] = (f32x4){0.f, 0.f, 0.f, 0.f};
        cur = nxt; cA = nA; cB = nB; ++ui;
        if constexpr (GATHER) {
#pragma unroll
            for (int h = 0; h < 2; ++h)
#pragma unroll
                for (int i = 0; i < 2; ++i) voA[h][i] = nvA[h][i];
        }
        if (wr == 1) PG8_BAR;
    }
    PG8_WAIT_V(0);
    PG8_BAR;
#undef PG8_SA
#undef PG8_SB
#undef PG8_STAGE
#undef PG8_LDA
#undef PG8_LDB
#undef PG8_MMA
#undef PG8_WAIT_V
#undef PG8_WAIT_L
#undef PG8_BAR
#undef PG8_SCHED
}
}

#ifndef PROBE_LDS2
#define PROBE_LDS2 0
#endif
#ifndef PROBE_EXP2
#define PROBE_EXP2 0
#endif
#ifndef SOFTMAX_PK
#define SOFTMAX_PK 0
#endif
#ifndef FA_FUSE
#define FA_FUSE 0
#endif
namespace fa {
constexpr int VBYTES_T = 64 * 128;
typedef short v4i16_t __attribute__((ext_vector_type(4)));
__device__ __forceinline__ u32x2 vtr(const LAS unsigned char* p) { return __builtin_bit_cast(u32x2, __builtin_amdgcn_ds_read_tr16_b64_v4i16((LAS v4i16_t*)p)); }
__device__ __forceinline__ float max16(const f32x16& c) { float r;
    asm("v_max3_f32 %0, %1, %2, %3\n\tv_max3_f32 %0, %0, %4, %5\n\tv_max3_f32 %0, %0, %6, %7\n\tv_max3_f32 %0, %0, %8, %9\n\tv_max3_f32 %0, %0, %10, %11\n\tv_max3_f32 %0, %0, %12, %13\n\tv_max3_f32 %0, %0, %14, %15\n\tv_max_f32 %0, %0, %16"
        : "=&v"(r) : "v"(c[0]), "v"(c[1]), "v"(c[2]), "v"(c[3]), "v"(c[4]), "v"(c[5]), "v"(c[6]), "v"(c[7]), "v"(c[8]), "v"(c[9]), "v"(c[10]), "v"(c[11]), "v"(c[12]), "v"(c[13]), "v"(c[14]), "v"(c[15]));
    return r; }
__device__ __forceinline__ void mask_init(f32x16& S, unsigned nw) { float t0, t1, t2, t3, t4, t5, t6, t7, t8, t9, t10, t11, t12, t13, t14, t15;
    asm("v_bfe_i32 %0, %16, 0, 1\n\tv_lshlrev_b32 %0, 23, %0\n\tv_bfe_i32 %1, %16, 1, 1\n\tv_lshlrev_b32 %1, 23, %1\n\tv_bfe_i32 %2, %16, 2, 1\n\tv_lshlrev_b32 %2, 23, %2\n\tv_bfe_i32 %3, %16, 3, 1\n\tv_lshlrev_b32 %3, 23, %3\n\tv_bfe_i32 %4, %16, 8, 1\n\tv_lshlrev_b32 %4, 23, %4\n\tv_bfe_i32 %5, %16, 9, 1\n\tv_lshlrev_b32 %5, 23, %5\n\tv_bfe_i32 %6, %16, 10, 1\n\tv_lshlrev_b32 %6, 23, %6\n\tv_bfe_i32 %7, %16, 11, 1\n\tv_lshlrev_b32 %7, 23, %7\n\tv_bfe_i32 %8, %16, 16, 1\n\tv_lshlrev_b32 %8, 23, %8\n\tv_bfe_i32 %9, %16, 17, 1\n\tv_lshlrev_b32 %9, 23, %9\n\tv_bfe_i32 %10, %16, 18, 1\n\tv_lshlrev_b32 %10, 23, %10\n\tv_bfe_i32 %11, %16, 19, 1\n\tv_lshlrev_b32 %11, 23, %11\n\tv_bfe_i32 %12, %16, 24, 1\n\tv_lshlrev_b32 %12, 23, %12\n\tv_bfe_i32 %13, %16, 25, 1\n\tv_lshlrev_b32 %13, 23, %13\n\tv_bfe_i32 %14, %16, 26, 1\n\tv_lshlrev_b32 %14, 23, %14\n\tv_bfe_i32 %15, %16, 27, 1\n\tv_lshlrev_b32 %15, 23, %15"
        : "=&v"(t0), "=&v"(t1), "=&v"(t2), "=&v"(t3), "=&v"(t4), "=&v"(t5), "=&v"(t6), "=&v"(t7), "=&v"(t8), "=&v"(t9), "=&v"(t10), "=&v"(t11), "=&v"(t12), "=&v"(t13), "=&v"(t14), "=&v"(t15) : "v"(nw));
    S[0] = t0; S[1] = t1; S[2] = t2; S[3] = t3; S[4] = t4; S[5] = t5; S[6] = t6; S[7] = t7; S[8] = t8; S[9] = t9; S[10] = t10; S[11] = t11; S[12] = t12; S[13] = t13; S[14] = t14; S[15] = t15; }
struct Params {
    const bf16* Q;  int q_pitch;
    const bf16* K1; int k1_pitch, k1_col;
    const bf16* K2; int k2_pitch, k2_col;
    const bf16* V;  int v_pitch, v_col;
    bf16* O; int o_pitch;
    float* LSE; int lse_pitch;
    const unsigned* BM;
    int CL, W;
};
struct UnitDesc { int seq0, qw, q_col, o_col, lse_col, k1_col, v_col, kt_lo, kt_hi; };
template <int DQK, int MODE, int NH, class DescFn>
__device__ __forceinline__ void attn_stream(const Params& P, LAS unsigned char* lds, const int tid, const int n_units, DescFn desc) {
    constexpr int NKS = DQK / 16, AHEAD = (NH == 2 ? 3 : 4), NST = AHEAD + 1, K1B = 8192 * NH, K2B = (DQK == 96 ? 4096 : 0), BMOFF = K1B + K2B + 8192 * NH, STB = BMOFF + (MODE == 1 ? 8192 : 0);
    constexpr int NDMA = 2 * NH + (DQK == 96 ? 1 : 0) + (MODE == 1 ? 1 : 0);
    static_assert(NH == 1 || (DQK == 64 && MODE != 1), "two-head stages: head dim 64 only");
    constexpr bool active = true;
    if (n_units <= 0) return;
    const int lane = tid & 63, r = lane & 31, h = lane >> 5, wave = __builtin_amdgcn_readfirstlane(tid >> 6);
    const int tq_ = (lane & 15) >> 2, tp_ = lane & 3, tg_ = lane >> 4;
    const int hsel = NH == 2 ? (wave >> 2) * 8192 : 0;
    const int vtoff = K1B + K2B + hsel + (4 * h + tq_) * 128, vxb = 2 * (16 * (tg_ & 1) + 4 * tp_), vsw = (tq_ >> 1) & 1;
    const int vx0 = vxb + ((0 ^ vsw) << 6), vx1 = vxb + ((1 ^ vsw) << 6);
    const int s1_ = (r >> 1) & 7, s2_ = (r >> 2) & 3;
    const int k1row = hsel + r * 128, k2row = K1B + r * 64;
    const int row1 = 8 * wave + (lane >> 3), row2 = 16 * (wave & 3) + (lane >> 2);
    const size_t tk1 = (size_t)64 * P.k1_pitch, tk2 = (size_t)64 * P.k2_pitch, tv = (size_t)64 * P.v_pitch;
    const int d_k1 = wave * 1024, d_k2 = K1B + (wave & 3) * 1024, d_v = K1B + K2B + wave * 1024;
    const bf16* src_k1; const bf16* src_v; const bf16* src_k2 = nullptr; const unsigned* bmp = nullptr;
    int ji = -1, kti = 1, kti_hi = 0;
    auto fa_issue = [&](const int st) __attribute__((always_inline)) {
        if (kti > kti_hi) {
            if (ji + 1 < n_units) { ++ji; const UnitDesc t = desc(ji); kti = t.kt_lo; kti_hi = t.kt_hi;
                src_k1 = P.K1 + (size_t)(t.seq0 + row1) * P.k1_pitch + t.k1_col + 8 * ((lane & 7) ^ ((row1 >> 1) & 7));
                src_v = P.V + (size_t)(t.seq0 + row1) * P.v_pitch + t.v_col + 8 * ((lane & 7) ^ (((row1 >> 1) & 1) << 2));
                if constexpr (DQK == 96) src_k2 = P.K2 + (size_t)(t.seq0 + row2) * P.k2_pitch + P.k2_col + 8 * ((lane & 3) ^ ((row2 >> 2) & 3));
                if constexpr (MODE == 1) bmp = P.BM + (size_t)(t.seq0 + t.qw + r) * 64;
            } else kti = kti_hi; }
        LAS unsigned char* sb_ = lds + st * STB;
        __builtin_amdgcn_global_load_lds((const unsigned*)(src_k1 + kti * tk1), (LAS unsigned*)(sb_ + d_k1), 16, 0, 0);
        __builtin_amdgcn_global_load_lds((const unsigned*)(src_v + kti * tv), (LAS unsigned*)(sb_ + d_v), 16, 0, 0);
        if constexpr (NH == 2) {
            __builtin_amdgcn_global_load_lds((const unsigned*)(src_k1 + 64 + kti * tk1), (LAS unsigned*)(sb_ + d_k1 + 8192), 16, 0, 0);
            __builtin_amdgcn_global_load_lds((const unsigned*)(src_v + 64 + kti * tv), (LAS unsigned*)(sb_ + d_v + 8192), 16, 0, 0); }
        if constexpr (DQK == 96) __builtin_amdgcn_global_load_lds((const unsigned*)(src_k2 + kti * tk2), (LAS unsigned*)(sb_ + d_k2), 16, 0, 0);
        if constexpr (MODE == 1) __builtin_amdgcn_global_load_lds(bmp + (kti & ~1) * 2, (LAS unsigned*)(sb_ + BMOFF + wave * 1024), 16, 0, 0);
        ++kti; };
#define FA_ISSUE(TILE, ST) fa_issue(ST)
    int st_is = 0, st_c = 0, st_n = 1;
    bf16x8 qf[NKS];
#define FA_LOADQ(D) do { const bf16* qp_ = P.Q + (size_t)((D).seq0 + (D).qw + r) * P.q_pitch + (D).q_col + 8 * h; \
        _Pragma("unroll") for (int ks = 0; ks < NKS; ++ks) asm volatile("global_load_dwordx4 %0, %1, off offset:%2" : "=&v"(qf[ks]) : "v"(qp_), "n"(32 * ks) : "memory"); } while (0)
#define FA_WAITQ(N) do { if constexpr (NKS == 6) asm volatile("s_waitcnt vmcnt(%6)" : "+v"(qf[0]), "+v"(qf[1]), "+v"(qf[2]), "+v"(qf[3]), "+v"(qf[4]), "+v"(qf[5]) : "n"(N) : "memory"); \
        else asm volatile("s_waitcnt vmcnt(%4)" : "+v"(qf[0]), "+v"(qf[1]), "+v"(qf[2]), "+v"(qf[3]) : "n"(N) : "memory"); } while (0)
    { const UnitDesc d0 = desc(0); FA_LOADQ(d0); FA_WAITQ(0); }
#pragma unroll 1
    for (int ju = 0; ju < n_units; ++ju) {
    const UnitDesc du = desc(ju);
    const int seq0 = du.seq0, qw = du.qw, q_col = du.q_col, o_col = du.o_col, lse_col = du.lse_col, kt_lo = du.kt_lo, kt_hi = du.kt_hi;
    const int q = qw + r;
    const int lo_q = MODE == 0 ? max(q & ~(P.CL - 1), q - P.W) : 0;
    const int qh = q - 4 * h, lqh = lo_q - 4 * h;
    const int lo_w0 = MODE == 0 ? max(qw & ~(P.CL - 1), qw - P.W) : 0;
    const int lo_w1 = MODE == 0 ? max((qw + 31) & ~(P.CL - 1), qw + 31 - P.W) : 0;
#define FA_WAITBAR(N) do { asm volatile("s_waitcnt vmcnt(%0)" :: "n"(N) : "memory"); __builtin_amdgcn_s_barrier(); asm volatile("" ::: "memory"); } while (0)
    f32x16 o0, o1, c0, c1, n0, n1;
#pragma unroll
    for (int i = 0; i < 16; ++i) { o0[i] = 0.f; o1[i] = 0.f; c0[i] = 0.f; c1[i] = 0.f; n0[i] = 0.f; n1[i] = 0.f; }
    float m = -INFINITY, l = 0.f;
#define FA_PART(kt_) (active && (MODE == 0 ? ((kt_) * 64 <= qw + 31 && (kt_) * 64 + 63 >= lo_w0) : ((kt_) * 64 <= qw + 31)))
#define FA_KADDR(SB_, ROFF, ks) ((ks) < 4 ? (SB_) + (ROFF) * 128 + k1row + 16 * ((2 * (ks) + h) ^ s1_) : (SB_) + (ROFF) * 64 + k2row + 16 * ((2 * ((ks) - 4) + h) ^ s2_))
#define FA_QKH(S, SB_, ROFF, NW) do { bf16x8 fa_[NKS]; \
        _Pragma("unroll") for (int ks = 0; ks < NKS; ++ks) fa_[ks] = *(const LAS bf16x8*)FA_KADDR(SB_, ROFF, ks); \
        if (PROBE_LDS2) { _Pragma("unroll") for (int ks = 0; ks < NKS; ++ks) { const bf16x8 fb_ = *(const volatile LAS bf16x8*)FA_KADDR(SB_, (ROFF) ^ 32, ks); asm volatile("" :: "v"(fb_)); } } \
        if constexpr (MODE == 1) {        \
            mask_init(S, NW); \
        } else { _Pragma("unroll") for (int i = 0; i < 16; ++i) S[i] = 0.f; } \
        _Pragma("unroll") for (int ks = 0; ks < NKS; ++ks) S = __builtin_amdgcn_mfma_f32_32x32x16_bf16(fa_[ks], qf[ks], S, 0, 0, 0); \
        __builtin_amdgcn_sched_group_barrier(0x100, NKS, 0); __builtin_amdgcn_sched_group_barrier(0x008, NKS, 0); } while (0)
#define FA_QK(S0, S1, SB_, KT) do { unsigned nwa_ = 0u, nwb_ = 0u; \
        if constexpr (MODE == 1) { const u32x4 bw_ = *(const LAS u32x4*)((SB_) + BMOFF + wave * 1024 + lane * 16);        \
            nwa_ = ~((((KT) & 1) ? bw_.z : bw_.x) >> (4 * h)); nwb_ = ~((((KT) & 1) ? bw_.w : bw_.y) >> (4 * h)); } \
        FA_QKH(S0, SB_, 0, nwa_); FA_QKH(S1, SB_, 32, nwb_); } while (0)
#define FA_QKX(S, SB_, ROFF) do { bf16x8 fa_[NKS]; \
        _Pragma("unroll") for (int ks = 0; ks < NKS; ++ks) fa_[ks] = *(const LAS bf16x8*)FA_KADDR(SB_, ROFF, ks); \
        _Pragma("unroll") for (int i = 0; i < 16; ++i) S[i] = 0.f; \
        _Pragma("unroll") for (int ks = 0; ks < NKS; ++ks) S = __builtin_amdgcn_mfma_f32_32x32x16_bf16(fa_[ks], qf[ks], S, 0, 0, 0); } while (0)
    if (ju == 0) {
#pragma unroll 1
        for (int a = 0; a < AHEAD; ++a) { FA_ISSUE(kt_lo + a, st_is); st_is = st_is + 1; }
        FA_WAITBAR((AHEAD - 2) * NDMA);
    }
    if (FA_PART(kt_lo)) FA_QK(c0, c1, lds + st_c * STB, kt_lo);
    auto fa_step = [&](f32x16& c0, f32x16& c1, f32x16& n0, f32x16& n1, const int kt) __attribute__((always_inline)) {
        FA_ISSUE(kt + AHEAD, st_is); st_is = (st_is + 1 == NST) ? 0 : st_is + 1;
        const bool more1 = kt < kt_hi;
        const bool qnext = !more1 && (ju + 1 < n_units);
        if (qnext) { const UnitDesc dq = desc(ju + 1); FA_LOADQ(dq); }
        const int k0 = kt * 64;
        const bool part_c = FA_PART(kt), part_n = more1 && FA_PART(kt + 1);
        const LAS unsigned char* Sn = lds + st_n * STB; const LAS unsigned char* Vb = lds + st_c * STB;
        const bool fused = FA_FUSE && (DQK == 64) && part_c && part_n;
        if (part_n && !fused) FA_QK(n0, n1, Sn, kt + 1);
        if (part_c) {
            float alpha;
#define FA_SOFTMAX(MASKED) do { \
            if (MASKED) { if constexpr (MODE == 2) { const int qa = qh - k0, qa1 = qa - 32; \
                    _Pragma("unroll") for (int i = 0; i < 16; ++i) { const int ci = (i & 3) + 8 * (i >> 2); \
                        c0[i] = (ci > qa) ? -INFINITY : c0[i]; c1[i] = (ci > qa1) ? -INFINITY : c1[i]; } \
                } else if constexpr (MODE == 0) { const int lb = lqh - k0; const unsigned span = (unsigned)(q - lo_q), lb1 = (unsigned)(lb - 32);     \
                    _Pragma("unroll") for (int i = 0; i < 16; ++i) { const int ci = (i & 3) + 8 * (i >> 2); \
                        c0[i] = ((unsigned)(ci - lb) > span) ? -INFINITY : c0[i]; c1[i] = ((unsigned)ci - lb1 > span) ? -INFINITY : c1[i]; } \
                } } \
            float mx = xhalf_max(fmaxf(max16(c0), max16(c1))); \
            const float mn = fmaxf(m, mx); \
            const float ms = (mn == -INFINITY) ? 0.f : mn; \
            alpha = __builtin_amdgcn_exp2f(m - ms); \
            m = mn; \
            float ls = 0.f; \
            if (PROBE_EXP2) { float dm_ = 0.f; _Pragma("unroll") for (int i = 0; i < 16; ++i) { dm_ += __builtin_amdgcn_exp2f(c0[i] - mx) + __builtin_amdgcn_exp2f(c1[i] - mx); } asm volatile("" :: "v"(dm_)); } \
            if (SOFTMAX_PK) { const f32x2 ms2 = {ms, ms}; f32x2 lsa = {0.f, 0.f}, lsb = {0.f, 0.f};            \
              _Pragma("unroll") for (int i = 0; i < 16; i += 2) { \
                  f32x2 ta = {c0[i], c0[i + 1]}, tb = {c1[i], c1[i + 1]}; ta = ta - ms2; tb = tb - ms2; \
                  ta.x = __builtin_amdgcn_exp2f(ta.x); ta.y = __builtin_amdgcn_exp2f(ta.y); tb.x = __builtin_amdgcn_exp2f(tb.x); tb.y = __builtin_amdgcn_exp2f(tb.y); \
                  c0[i] = ta.x; c0[i + 1] = ta.y; c1[i] = tb.x; c1[i + 1] = tb.y; lsa = lsa + ta; lsb = lsb + tb; } \
              lsa = lsa + lsb; ls = lsa.x + lsa.y; \
            } else {        \
              _Pragma("unroll") for (int i = 0; i < 16; ++i) { c0[i] = __builtin_amdgcn_exp2f(c0[i] - ms); c1[i] = __builtin_amdgcn_exp2f(c1[i] - ms); ls += c0[i] + c1[i]; } } \
            l = l * alpha + ls; } while (0)
            const bool need_mask = MODE == 1 ? false : (MODE == 2 ? (k0 + 63 > qw) : ((k0 + 63 > qw) || (k0 < lo_w1)));
#define FA_FUSED(MASKED) do { FA_QKX(n0, Sn, 0); FA_QKX(n1, Sn, 32); FA_SOFTMAX(MASKED); \
            _Pragma("unroll") for (int hh_ = 0; hh_ < 2; ++hh_) { \
                __builtin_amdgcn_sched_group_barrier(0x100, NKS, 0); \
                _Pragma("unroll") for (int i = 0; i < NKS; ++i) { __builtin_amdgcn_sched_group_barrier(0x008, 1, 0); __builtin_amdgcn_sched_group_barrier(0x002, 120 / (2 * NKS), 0); } } } while (0)
            if (fused) { if (need_mask) FA_FUSED(true); else FA_FUSED(false); }
            else { if (need_mask) FA_SOFTMAX(true); else FA_SOFTMAX(false); }
#undef FA_FUSED
#undef FA_SOFTMAX
            if (!__all(alpha == 1.0f)) {
#pragma unroll
                for (int i = 0; i < 16; ++i) { o0[i] *= alpha; o1[i] *= alpha; } }
            const unsigned va0_ = (unsigned)(size_t)(Vb + vtoff + vx0), va1_ = (unsigned)(size_t)(Vb + vtoff + vx1);
#define FA_PV(S_, O0, O1, O2, O3) do { \
                u32x2 va00, vb00, va01, vb01, va10, vb10, va11, vb11;                           \
                asm volatile("ds_read_b64_tr_b16 %0, %8 offset:%10\n\tds_read_b64_tr_b16 %1, %8 offset:%11\n\tds_read_b64_tr_b16 %2, %9 offset:%10\n\tds_read_b64_tr_b16 %3, %9 offset:%11\n\t" \
                             "ds_read_b64_tr_b16 %4, %8 offset:%12\n\tds_read_b64_tr_b16 %5, %8 offset:%13\n\tds_read_b64_tr_b16 %6, %9 offset:%12\n\tds_read_b64_tr_b16 %7, %9 offset:%13" \
                             : "=&v"(va00), "=&v"(vb00), "=&v"(va01), "=&v"(vb01), "=&v"(va10), "=&v"(vb10), "=&v"(va11), "=&v"(vb11) \
                             : "v"(va0_), "v"(va1_), "n"(O0), "n"(O1), "n"(O2), "n"(O3) : "memory"); \
                bf16x8 pf[2]; \
                _Pragma("unroll") for (int sk = 0; sk < 2; ++sk) { u32x4 pw; pw.x = pk2(S_[8 * sk + 0], S_[8 * sk + 1]); pw.y = pk2(S_[8 * sk + 2], S_[8 * sk + 3]); pw.z = pk2(S_[8 * sk + 4], S_[8 * sk + 5]); pw.w = pk2(S_[8 * sk + 6], S_[8 * sk + 7]); pf[sk] = __builtin_bit_cast(bf16x8, pw); } \
                asm volatile("s_waitcnt lgkmcnt(0)" : "+v"(va00), "+v"(vb00), "+v"(va01), "+v"(vb01), "+v"(va10), "+v"(vb10), "+v"(va11), "+v"(vb11) :: "memory"); \
                __builtin_amdgcn_sched_barrier(0); \
                { const u32x4 v0w = {va00.x, va00.y, vb00.x, vb00.y}, v1w = {va01.x, va01.y, vb01.x, vb01.y}; \
                  o0 = __builtin_amdgcn_mfma_f32_32x32x16_bf16(__builtin_bit_cast(bf16x8, v0w), pf[0], o0, 0, 0, 0); \
                  o1 = __builtin_amdgcn_mfma_f32_32x32x16_bf16(__builtin_bit_cast(bf16x8, v1w), pf[0], o1, 0, 0, 0); } \
                { const u32x4 v0w = {va10.x, va10.y, vb10.x, vb10.y}, v1w = {va11.x, va11.y, vb11.x, vb11.y}; \
                  o0 = __builtin_amdgcn_mfma_f32_32x32x16_bf16(__builtin_bit_cast(bf16x8, v0w), pf[1], o0, 0, 0, 0); \
                  o1 = __builtin_amdgcn_mfma_f32_32x32x16_bf16(__builtin_bit_cast(bf16x8, v1w), pf[1], o1, 0, 0, 0); } } while (0)
            FA_PV(c0, 0, 1024, 2048, 3072);
            FA_PV(c1, 4096, 5120, 6144, 7168);
#undef FA_PV
        }
        if (qnext) FA_WAITBAR((AHEAD - 2) * NDMA + NKS); else FA_WAITBAR((AHEAD - 2) * NDMA);
        st_c = st_n; st_n = (st_n + 1 == NST) ? 0 : st_n + 1;
    };
    for (int kt = kt_lo;;) { fa_step(c0, c1, n0, n1, kt); if (++kt > kt_hi) break; fa_step(n0, n1, c0, c1, kt); if (++kt > kt_hi) break; }
#undef FA_PART
#undef FA_QK
#undef FA_QKH
#undef FA_QKX
#undef FA_KADDR
    const float lt = xhalf_sum(l);
    const float inv = 1.0f / lt;
    if (active) {
    bf16* op = P.O + (size_t)(seq0 + q) * P.o_pitch + o_col + 8 * h;
#pragma unroll
    for (int db = 0; db < 2; ++db) {
        const f32x16& o = db ? o1 : o0;
#pragma unroll
        for (int j = 0; j < 2; ++j) {
            u32x2 X, Y;
            X.x = pk2(o[8 * j] * inv, o[8 * j + 1] * inv); X.y = pk2(o[8 * j + 2] * inv, o[8 * j + 3] * inv);
            Y.x = pk2(o[8 * j + 4] * inv, o[8 * j + 5] * inv); Y.y = pk2(o[8 * j + 6] * inv, o[8 * j + 7] * inv);
            const auto a = __builtin_amdgcn_permlane32_swap(X.x, Y.x, false, false); const auto b = __builtin_amdgcn_permlane32_swap(X.y, Y.y, false, false);
            u32x4 w; w.x = a[0]; w.y = b[0]; w.z = a[1]; w.w = b[1];
            stg16<NT_ATT>(op + 32 * db + 16 * j, w);
        }
    }
    if (P.LSE && h == 0) P.LSE[(size_t)(seq0 + q) * P.lse_pitch + lse_col] = m + __builtin_amdgcn_logf(lt);
    }
    __builtin_amdgcn_sched_barrier(0);
    FA_WAITQ(4);
    }
    asm volatile("s_waitcnt vmcnt(0)" ::: "memory"); __builtin_amdgcn_s_barrier(); asm volatile("" ::: "memory");
#undef FA_ISSUE
#undef FA_LOADQ
#undef FA_WAITQ
#undef FA_WAITBAR
}
}

struct Args {
    const float* x; const int* pos; const float* w_in; const float* qn; const float* kvn; const float* w_uq; const float* w_ukv; const float* w_o;
    const float* ln1g; const float* ln1b; const float* rgw; const float* rgb; const float* rew; const float* reb;
    const float* wg; const float* wu; const float* wd; const float* ln2g; const float* ln2b;
    float* out; unsigned char* ws; int l_lo, l_hi, ph_lo, ph_hi, use_bar, pad;
};
typedef const __attribute__((address_space(4))) Args CArgs;
struct Ctx { LAS unsigned char* lds; int tid, lane, wave, G, c, vcu; unsigned char* ws; };

struct ColIdent { int off; __device__ __forceinline__ int operator()(int P) const { return off + P; } };
struct ColAdj { __device__ __forceinline__ int operator()(int P) const { const int p = P & 255; return (P & ~255) + 64 * ((p >> 5) & 3) + 32 * (p >> 7) + (p & 31); } };
__device__ __forceinline__ int map_rope32(int p) { return 16 * ((p >> 2) & 1) + 4 * (p >> 3) + (p & 3); }
__device__ __forceinline__ int map_head16(int p) { const int fq = p >> 3; return 16 * (fq >> 1) + 8 * ((p >> 2) & 1) + 4 * (fq & 1) + (p & 3); }
struct ColWin {
    __device__ __forceinline__ int operator()(int P) const {
        const int G = P >> 5, p = P & 31;
        if (G < 8) return 32 * G + p;
        if (G < 12) return 256 + 32 * (G - 8) + p;
        if (G == 12) return 384 + map_rope32(p);
        if (G == 13) return 1056 + p;
        if (G == 14) return 672 + map_head16(p);
        if (G == 15) return 704 + p;
        if (G < 24) { const int hh = (G - 16) >> 1; return 416 + 64 * hh + (((G - 16) & 1) ? 32 + p : map_head16(p)); }
        if (G < 26) return 736 + 32 * (G - 24) + p;
        if (G == 26) return p < 8 ? 1088 + p : -1;
        if (G < 32) return -1;
        if (G < 40) return 800 + 32 * (G - 32) + p;
        if (G < 64) { const int j = G - 40; return 1096 + 64 * (j >> 1) + ((j & 1) ? 32 + p : map_head16(p)); }
        if (G < 88) { const int j = G - 64; return 1096 + 768 + 64 * (j >> 1) + ((j & 1) ? 32 + p : map_head16(p)); }
        return 1096 + 1536 + 32 * (G - 88) + p;
    }
};
struct ColUq {
    __device__ __forceinline__ int operator()(int P) const { const int G = P >> 5, p = P & 31; return 32 * G + ((G % 3 == 2) ? map_rope32(p) : p); }
};
template <class ColFn>
__device__ __forceinline__ void transpose_item(const float* W, int ldw, int kvalid, bf16* WT, int ldt, int k0, int P0, const ColFn& cf, const float* rowscale, LAS float* scr, int lane) {
    const int c = lane & 31, col = cf(P0 + c);
#pragma unroll 8
    for (int i = 0; i < 32; ++i) { const int kk = 2 * i + (lane >> 5), k = k0 + kk; float v = 0.f;
        if (col >= 0 && k < kvalid) { v = W[(size_t)k * ldw + col]; if (rowscale) v *= rowscale[k]; }
        scr[kk * 33 + c] = v; }
    asm volatile("s_waitcnt lgkmcnt(0)" ::: "memory");
    const int cc = lane & 7;
#pragma unroll
    for (int j = 0; j < 4; ++j) { const int n = (lane >> 3) + 8 * j; const LAS float* s = scr + (8 * cc) * 33 + n;
        u32x4 o; o.x = pk2(s[0 * 33], s[1 * 33]); o.y = pk2(s[2 * 33], s[3 * 33]); o.z = pk2(s[4 * 33], s[5 * 33]); o.w = pk2(s[6 * 33], s[7 * 33]);
        *(u32x4*)(WT + (size_t)(P0 + n) * ldt + k0 + 8 * cc) = o; }
    asm volatile("s_waitcnt lgkmcnt(0)" ::: "memory");
}
__device__ __forceinline__ void prologue(const Ctx& X, const CArgs* ap) {
    struct { const float* x; const float *w_in, *qn, *kvn, *w_uq, *w_ukv, *w_o, *rgw, *rew; } a = {ap->x, ap->w_in, ap->qn, ap->kvn, ap->w_uq, ap->w_ukv, ap->w_o, ap->rgw, ap->rew};
    LAS float* scr = (LAS float*)(X.lds + X.wave * 16384);
    const int gw = X.vcu * 8 + X.wave, NGW = X.G * 8;
    constexpr int I_WIN = 16 * 112, I_UQ = 4 * 24, I_UKV = 2 * 32, I_WO = 16 * 32, I_L = I_WIN + I_UQ + I_UKV + I_WO;
    for (int it = gw; it < DEPTH * I_L; it += NGW) {
        const int l = it / I_L; int r = it % I_L;
        if (r < I_WIN) { transpose_item(a.w_in + (size_t)l * DM * IN_COLS, IN_COLS, DM, (bf16*)(X.ws + WS_WIN) + (size_t)l * NIN * DM, DM, 64 * (r / 112), 32 * (r % 112), ColWin{}, nullptr, scr, X.lane); continue; }
        r -= I_WIN;
        if (r < I_UQ) { transpose_item(a.w_uq + (size_t)l * 256 * 768, 768, 256, (bf16*)(X.ws + WS_WUQ) + (size_t)l * 768 * 256, 256, 64 * (r / 24), 32 * (r % 24), ColUq{}, a.qn + l * 256, scr, X.lane); continue; }
        r -= I_UQ;
        if (r < I_UKV) { transpose_item(a.w_ukv + (size_t)l * 128 * 1024, 1024, 128, (bf16*)(X.ws + WS_WUKV) + (size_t)l * 1024 * 128, 128, 64 * (r / 32), 32 * (r % 32), ColAdj{}, a.kvn + l * 128, scr, X.lane); continue; }
        r -= I_UKV;
        transpose_item(a.w_o + (size_t)l * DM * DM, DM, DM, (bf16*)(X.ws + WS_WO) + (size_t)l * DM * DM, DM, 64 * (r / 32), 32 * (r % 32), ColAdj{}, nullptr, scr, X.lane);
    }
    const size_t gt = (size_t)X.vcu * 512 + X.tid, NGT = (size_t)X.G * 512;
    { float* rgt = (float*)(X.ws + WS_RGT); float* ret = (float*)(X.ws + WS_RET);
      for (size_t i = gt; i < (size_t)DEPTH * 4 * DM; i += NGT) { const int l = (int)(i / (4 * DM)), g = (int)(i / DM) & 3, k = (int)(i % DM); rgt[i] = a.rgw[((size_t)l * DM + k) * 4 + g]; }
      for (size_t i = gt; i < (size_t)DEPTH * 32 * DM; i += NGT) { const int l = (int)(i / (32 * DM)), ge = (int)(i / DM) & 31, k = (int)(i % DM); ret[i] = a.rew[(((size_t)l * 4 + (ge >> 3)) * DM + k) * 8 + (ge & 7)]; } }
    { const f32x4* xs = (const f32x4*)a.x; u32x2* xb = (u32x2*)((unsigned char*)ap->out + XR_OFF);
      for (size_t i = gt; i < (size_t)NT * DM / 4; i += NGT) { const f32x4 v = xs[i]; u32x2 w; w.x = pk2(v[0], v[1]); w.y = pk2(v[2], v[3]); xb[i] = w; } }
}
__device__ __forceinline__ void convert_experts(const Ctx& X, const CArgs* ap, int l) {
    struct { const float *wg, *wu, *wd; } a = {ap->wg, ap->wu, ap->wd};
    LAS float* scr = (LAS float*)(X.lds + X.wave * 16384);
    const int gw = X.vcu * 8 + X.wave, NGW = X.G * 8;
    constexpr int I_GU = 32 * 16 * 16, I_D = 32 * 4 * 32;
    for (int it = gw; it < I_GU + I_D; it += NGW) {
        if (it < I_GU) { const int e = it >> 8, r = it & 255, G32 = r >> 4, kb = r & 15; const int pn = G32 >> 3, r0 = (G32 & 7) * 32; const bool up = r0 >= 128;
            const float* W = (up ? a.wu : a.wg) + ((size_t)l * NEXP + e) * DM * FH;
            transpose_item(W, FH, DM, (bf16*)(X.ws + WS_WGU) + (size_t)e * 512 * DM, DM, 64 * kb, 32 * G32, ColIdent{128 * pn + (r0 & 127) - 32 * G32}, nullptr, scr, X.lane);
        } else { const int r = it - I_GU, e = r >> 7, q = r & 127, kb = q >> 5, pg = q & 31;
            transpose_item(a.wd + ((size_t)l * NEXP + e) * FH * DM, DM, FH, (bf16*)(X.ws + WS_WD) + (size_t)e * DM * FH, FH, 64 * kb, 32 * pg, ColAdj{}, nullptr, scr, X.lane); }
    }
}

struct InProjDesc {
    unsigned char* ws;
    __device__ __forceinline__ pg8::GroupDesc operator()(int pn, int bj, int wc) const {
        using namespace pg8; const int G = 8 * pn + 4 * bj + wc; GroupDesc d; d.kind = GK_PLAIN; d.dst = nullptr; d.pitch = 256; d.col = 0; d.scale = 1.f; d.perm = 0; d.ssq = nullptr; d.ssq_n = 0; d.ssq_i = 0;
        if (G < 8) { d.dst = (bf16*)(ws + WS_CQ); d.col = 32 * G; d.ssq = (float*)(ws + WS_SSQ); d.ssq_n = 8; d.ssq_i = G; }
        else if (G < 12) { d.dst = (bf16*)(ws + WS_T1); d.pitch = 128; d.col = 32 * (G - 8); d.ssq = (float*)(ws + WS_SSQ) + (size_t)NT * 8; d.ssq_n = 4; d.ssq_i = G - 8; }
        else if (G == 12) { d.kind = GK_ROPE32; d.dst = (bf16*)(ws + WS_KPE); d.pitch = 32; d.col = 0; }
        else if (G == 13) { d.kind = GK_IDX8; d.dst = (bf16*)(ws + WS_KI); d.pitch = 32; d.col = 0; }
        else if (G == 14) { d.kind = GK_HEAD16; d.dst = (bf16*)(ws + WS_BK); d.pitch = 64; d.col = 0; }
        else if (G == 15) { d.dst = (bf16*)(ws + WS_BK); d.pitch = 64; d.col = 32; }
        else if (G < 24) { d.kind = ((G - 16) & 1) ? GK_PLAIN : GK_HEAD16; d.dst = (bf16*)(ws + WS_BQ); d.col = 32 * (G - 16); d.scale = QSC64; }
        else if (G < 26) { d.dst = (bf16*)(ws + WS_BV); d.pitch = 64; d.col = 32 * (G - 24); }
        else if (G == 26) { d.kind = GK_WI; d.dst = (bf16*)(ws + WS_WI); }
        else if (G < 32) { d.kind = GK_SKIP; }
        else if (G < 40) { d.kind = GK_IDX8; d.dst = (bf16*)(ws + WS_BQI); d.col = 32 * (G - 32); }
        else if (G < 64) { const int j = G - 40, cfg = j >> 3; d.kind = (j & 1) ? GK_PLAIN : GK_HEAD16; d.dst = (bf16*)(ws + WS_DQ) + (size_t)cfg * NT * 256; d.col = 32 * (j & 7); d.scale = QSC64; d.perm = cfg == 0 ? 0 : (cfg == 1 ? 4 : 16); }
        else if (G < 88) { const int j = G - 64, cfg = j >> 3; d.kind = (j & 1) ? GK_PLAIN : GK_HEAD16; d.dst = (bf16*)(ws + WS_DK) + (size_t)cfg * NT * 256; d.col = 32 * (j & 7); d.perm = cfg == 0 ? 0 : (cfg == 1 ? 4 : 16); }
        else { const int j = G - 88, cfg = j >> 3; d.dst = (bf16*)(ws + WS_DV) + (size_t)cfg * NT * 256; d.col = 32 * (j & 7); d.perm = cfg == 0 ? 0 : (cfg == 1 ? 4 : 16); }
        return d;
    }
};
struct UqDesc {
    unsigned char* ws;
    __device__ __forceinline__ pg8::GroupDesc operator()(int pn, int bj, int wc) const {
        using namespace pg8; const int G = 8 * pn + 4 * bj + wc; GroupDesc d; d.kind = (G % 3 == 2) ? GK_ROPE32 : GK_PLAIN; d.dst = (bf16*)(ws + WS_QA); d.pitch = 768; d.col = 32 * G; d.scale = QSC96; d.perm = 0; d.ssq = nullptr; d.ssq_n = 0; d.ssq_i = 0;
        return d;
    }
};

__device__ __forceinline__ unsigned f16key(float v) { const _Float16 hf = (_Float16)v; const unsigned u = (unsigned)__builtin_bit_cast(unsigned short, hf); return (u ^ ((unsigned)__builtin_amdgcn_sbfe((int)u, 15, 1) | 0x8000u)) & 0xffffu; }
__device__ __forceinline__ unsigned pk_cnt(unsigned acc, unsigned kp2, unsigned mid2, unsigned one2) {
    unsigned t;
    asm("v_pk_sub_u16 %0, %2, %3 clamp\n\tv_pk_min_u16 %0, %0, %4\n\tv_pk_add_u16 %1, %1, %0" : "=&v"(t), "+v"(acc) : "v"(kp2), "s"(mid2), "s"(one2));
    return acc;
}
__device__ __forceinline__ int count_gt(const unsigned (&kp)[16], unsigned mid) {
    const unsigned m2 = __builtin_amdgcn_readfirstlane(mid | (mid << 16)), one2 = __builtin_amdgcn_readfirstlane(0x00010001u);
    unsigned a0 = 0u, a1 = 0u;
#pragma unroll
    for (int i = 0; i < 16; i += 2) { a0 = pk_cnt(a0, kp[i], m2, one2); a1 = pk_cnt(a1, kp[i + 1], m2, one2); }
    unsigned aw; asm("v_pk_add_u16 %0, %1, %2" : "=v"(aw) : "v"(a0), "v"(a1));
    const unsigned c = (aw & 0xffffu) + (aw >> 16);
    int tot = 0;
#pragma unroll
    for (int b = 0; b < 6; ++b) tot += __builtin_popcountll(__ballot((c >> b) & 1u)) << b;
    return tot;
}
__device__ __forceinline__ int wave_scan_incl(int v) {
    v += __builtin_amdgcn_update_dpp(0, v, 0x111, 0xf, 0xf, false); v += __builtin_amdgcn_update_dpp(0, v, 0x112, 0xf, 0xf, false);
    v += __builtin_amdgcn_update_dpp(0, v, 0x114, 0xf, 0xf, false); v += __builtin_amdgcn_update_dpp(0, v, 0x118, 0xf, 0xf, false);
    v += __builtin_amdgcn_update_dpp(0, v, 0x142, 0xa, 0xf, false); v += __builtin_amdgcn_update_dpp(0, v, 0x143, 0xc, 0xf, false);
    return v;
}
__device__ __forceinline__ void radix_pick(const LAS unsigned* hist, int lane, int target, int& B, int& above, int& inbin) {
    const u32x2 hw = *(const LAS u32x2*)(hist + 2 * lane);
    const int c0 = (int)(hw.x & 0xffffu), c1 = (int)(hw.x >> 16), c2 = (int)(hw.y & 0xffffu), c3 = (int)(hw.y >> 16);
    const int tl = (c0 + c1) + (c2 + c3);
    const int pre = wave_scan_incl(tl);
    const int suf = __builtin_amdgcn_readlane(pre, 63) - pre + tl;
    const unsigned long long reach = __ballot(suf >= target);
    const int ls = 63 - __builtin_clzll(reach | 1ull);
    int a = suf - tl, b = 4 * lane + 3, ib = c3;
    if (a + c3 < target) { a += c3; b = 4 * lane + 2; ib = c2; if (a + c2 < target) { a += c2; b = 4 * lane + 1; ib = c1; if (a + c1 < target) { a += c1; b = 4 * lane; ib = c0; } } }
    B = __builtin_amdgcn_readlane(b, ls); above = __builtin_amdgcn_readlane(a, ls); inbin = __builtin_amdgcn_readlane(ib, ls);
}
__device__ __forceinline__ float relu_i(float x) { const int i = __builtin_bit_cast(int, x); return __builtin_bit_cast(float, i > 0 ? i : 0); }
__device__ __forceinline__ void dsa_index_unit(const Ctx& X, int b, int q0) {
    const int lane = X.lane, r = lane & 31, h = lane >> 5; const size_t seq0 = (size_t)b * SEQ; const int t0 = q0 + 4 * X.wave;
    const bf16* BQI = (const bf16*)(X.ws + WS_BQI); const bf16* KI = (const bf16*)(X.ws + WS_KI); const float* WI = (const float*)(X.ws + WS_WI);
    LAS unsigned short* rows = (LAS unsigned short*)(X.lds + X.wave * 16384);
    LAS unsigned char* kbuf = X.lds + LDS_X_OFF;
    const bf16* ap = BQI + (seq0 + t0 + (r >> 3)) * 256 + 32 * (r & 7) + 16 * h;
    const bf16x8 a0 = *(const bf16x8*)ap, a1 = *(const bf16x8*)(ap + 8);
    f32x2 wq[4][2];
#pragma unroll
    for (int j = 0; j < 4; ++j) { const f32x4 w = *(const f32x4*)(WI + (seq0 + t0 + j) * 8 + 4 * h);
        wq[j][0] = (f32x2){w[0] * IDX_SCALE, w[1] * IDX_SCALE}; wq[j][1] = (f32x2){w[2] * IDX_SCALE, w[3] * IDX_SCALE}; }
    const int nch = ((q0 + 31) >> 7) + 1;
    const int skey = X.tid >> 2, spc = X.tid & 3;
    const bf16* sp = KI + (seq0 + skey) * 32 + 8 * spc;
    const int sdst = skey * 64 + ((spc ^ ((skey >> 2) & 3)) << 4);
    u32x4 stg0 = *(const u32x4*)sp, stg1 = stg0, stg2 = stg0, stg3 = stg0;
    if (1 < nch) stg1 = *(const u32x4*)(sp + (size_t)1 * 128 * 32);
    if (2 < nch) stg2 = *(const u32x4*)(sp + (size_t)2 * 128 * 32);
    if (3 < nch) stg3 = *(const u32x4*)(sp + (size_t)3 * 128 * 32);
    *(LAS u32x4*)(kbuf + sdst) = stg0;
    __syncthreads();
#define DSA_STEP(J, RCUR, RNEXT) { const int c = c0 + (J); \
        if (c + 4 < nch) RCUR = *(const u32x4*)(sp + (size_t)(c + 4) * 128 * 32); \
        const LAS unsigned char* kb = kbuf + (c & 1) * 8192; \
        f32x16 accq[4];        \
        _Pragma("unroll") for (int tq = 0; tq < 4; ++tq) { \
            const int key = 32 * tq + r, sw = (key >> 2) & 3; \
            const bf16x8 b0 = *(const LAS bf16x8*)(kb + key * 64 + (((2 * h) ^ sw) << 4)), b1 = *(const LAS bf16x8*)(kb + key * 64 + (((2 * h + 1) ^ sw) << 4)); \
            _Pragma("unroll") for (int i = 0; i < 16; ++i) accq[tq][i] = 0.f; \
            accq[tq] = __builtin_amdgcn_mfma_f32_32x32x16_bf16(a0, b0, accq[tq], 0, 0, 0); \
            accq[tq] = __builtin_amdgcn_mfma_f32_32x32x16_bf16(a1, b1, accq[tq], 0, 0, 0); } \
        __builtin_amdgcn_sched_barrier(0); \
        _Pragma("unroll") for (int tq = 0; tq < 4; ++tq) { const f32x16& acc = accq[tq]; \
            float p[4]; \
            _Pragma("unroll") for (int j = 0; j < 4; ++j) {            \
                const f32x2 ra = {relu_i(acc[4 * j]), relu_i(acc[4 * j + 1])}, rb = {relu_i(acc[4 * j + 2]), relu_i(acc[4 * j + 3])}; \
                const f32x2 pp = __builtin_elementwise_fma(rb, wq[j][1], ra * wq[j][0]); \
                p[j] = pp.x + pp.y; } \
            const auto s01 = __builtin_amdgcn_permlane32_swap(__float_as_uint(p[0]), __float_as_uint(p[1]), false, false); \
            const auto s23 = __builtin_amdgcn_permlane32_swap(__float_as_uint(p[2]), __float_as_uint(p[3]), false, false); \
            const float va = __uint_as_float(s01[0]) + __uint_as_float(s01[1]), vb = __uint_as_float(s23[0]) + __uint_as_float(s23[1]); \
            const int hw = 128 * c + 32 * tq + r;                                      \
            rows[h * 2048 + hw] = (unsigned short)f16key(va); \
            rows[(2 + h) * 2048 + hw] = (unsigned short)f16key(vb); \
        } \
        if (c + 1 < nch) *(LAS u32x4*)(kbuf + ((c + 1) & 1) * 8192 + sdst) = RNEXT; \
        __syncthreads(); }
#ifndef REP_SCORE
#define REP_SCORE 1
#endif
#ifndef REP_SEL
#define REP_SEL 1
#endif
    for (int rsc = 0; rsc < REP_SCORE; ++rsc) {
    if (rsc > 0) { stg0 = *(const u32x4*)sp; stg1 = stg0; stg2 = stg0; stg3 = stg0; if (1 < nch) stg1 = *(const u32x4*)(sp + (size_t)1 * 128 * 32); if (2 < nch) stg2 = *(const u32x4*)(sp + (size_t)2 * 128 * 32); if (3 < nch) stg3 = *(const u32x4*)(sp + (size_t)3 * 128 * 32); *(LAS u32x4*)(kbuf + sdst) = stg0; __syncthreads(); }
    for (int c0 = 0; c0 < nch; c0 += 4) {
        DSA_STEP(0, stg0, stg1)
        if (c0 + 1 >= nch) break;
        DSA_STEP(1, stg1, stg2)
        if (c0 + 2 >= nch) break;
        DSA_STEP(2, stg2, stg3)
        if (c0 + 3 >= nch) break;
        DSA_STEP(3, stg3, stg0)
    }
    }
#undef DSA_STEP
    unsigned* BMp = (unsigned*)(X.ws + WS_BM);
#ifndef REP_BIS
#define REP_BIS 1
#endif
#ifndef REP_EMIT
#define REP_EMIT 1
#endif
    for (int rsl = 0; rsl < REP_SEL; ++rsl)
    for (int j = 0; j < 4; ++j) {
        const int t = t0 + j;
        const LAS u32x4* rw = (const LAS u32x4*)(rows + j * 2048) + 4 * lane;
        unsigned kp[16];
#pragma unroll
        for (int v4 = 0; v4 < 4; ++v4) { const u32x4 d = rw[v4]; kp[4 * v4] = d.x; kp[4 * v4 + 1] = d.y; kp[4 * v4 + 2] = d.z; kp[4 * v4 + 3] = d.w; }
        const int nv = t + 1 - 32 * lane;
#pragma unroll
        for (int d = 0; d < 16; ++d) kp[d] &= ((2 * d < nv) ? 0xffffu : 0u) | ((2 * d + 1 < nv) ? 0xffff0000u : 0u);
        unsigned thr = 0u; int need = 0;
        for (int rb_ = 0; rb_ < REP_BIS; ++rb_)
        if (t + 1 > 256) {
            LAS unsigned* hist = (LAS unsigned*)(X.lds + LDS_HIST_OFF + X.wave * 512);
            *(LAS u32x2*)(hist + 2 * lane) = (u32x2){0u, 0u};
#pragma unroll
            for (int d = 0; d < 16; ++d) { const unsigned klo = kp[d] & 0xffffu, khi = kp[d] >> 16;
                if (klo) __hip_atomic_fetch_add(hist + (klo >> 9), (klo & 0x100u) ? 0x10000u : 1u, __ATOMIC_RELAXED, __HIP_MEMORY_SCOPE_WORKGROUP);
                if (khi) __hip_atomic_fetch_add(hist + (khi >> 9), (khi & 0x100u) ? 0x10000u : 1u, __ATOMIC_RELAXED, __HIP_MEMORY_SCOPE_WORKGROUP); }
            int B1, above1, in1; radix_pick(hist, lane, 256, B1, above1, in1);
            *(LAS u32x2*)(hist + 2 * lane) = (u32x2){0u, 0u};
#pragma unroll
            for (int d = 0; d < 16; ++d) { const unsigned klo = kp[d] & 0xffffu, khi = kp[d] >> 16;
                if ((int)(klo >> 8) == B1) __hip_atomic_fetch_add(hist + ((klo & 0xffu) >> 1), (klo & 1u) ? 0x10000u : 1u, __ATOMIC_RELAXED, __HIP_MEMORY_SCOPE_WORKGROUP);
                if ((int)(khi >> 8) == B1) __hip_atomic_fetch_add(hist + ((khi & 0xffu) >> 1), (khi & 1u) ? 0x10000u : 1u, __ATOMIC_RELAXED, __HIP_MEMORY_SCOPE_WORKGROUP); }
            int B2, above2, in2; radix_pick(hist, lane, 256 - above1, B2, above2, in2);
            const unsigned tk = ((unsigned)B1 << 8) | (unsigned)B2;
            const int rest = 256 - (above1 + above2);
            if (rest >= in2) { thr = tk - 1u; need = 0; } else { thr = tk; need = rest; }
        }
        unsigned word = 0u, eqw = 0u;
        const unsigned thr2 = __builtin_amdgcn_readfirstlane(thr | (thr << 16)), one2 = __builtin_amdgcn_readfirstlane(0x00010001u);
#pragma unroll
        for (int d = 0; d < 16; ++d) { unsigned g;
            asm("v_pk_sub_u16 %0, %1, %2 clamp\n\tv_pk_min_u16 %0, %0, %3" : "=&v"(g) : "v"(kp[d]), "s"(thr2), "s"(one2));
            word |= ((g | (g >> 15)) & 3u) << (2 * d); }
        if (need > 0) {
#pragma unroll
            for (int d = 0; d < 16; ++d) { unsigned g; const unsigned x = kp[d] ^ thr2;
                asm("v_pk_min_u16 %0, %1, %2" : "=v"(g) : "v"(x), "s"(one2));
                eqw |= ((~(g | (g >> 15))) & 3u) << (2 * d); }
            if (thr == 0u) eqw = 0u;
            const int ne = __builtin_popcount(eqw); const int inc = wave_scan_incl(ne);
            int take = need - (inc - ne); take = take < 0 ? 0 : (take > ne ? ne : take);
            while (__any(take > 0)) { if (take > 0) { const unsigned lowbit = eqw & (0u - eqw); word |= lowbit; eqw ^= lowbit; --take; } }
        }
        BMp[(seq0 + t) * 64 + lane] = word;
    }
}

__device__ __forceinline__ void dil_combine(const Ctx& X) {
    const bf16* OD = (const bf16*)(X.ws + WS_OD); const float* LS = (const float*)(X.ws + WS_LSE); bf16* O = (bf16*)(X.ws + WS_XB);
    const int gw = X.vcu * 8 + X.wave, NGW = X.G * 8, lane = X.lane, hh = lane >> 4;
    for (int t = gw; t < NT; t += NGW) {
        const int b = t >> 11, s = t & 2047;
        const int r0 = t, r1 = (b << 11) + ((s & 3) << 9) + (s >> 2), r2 = (b << 11) + ((s & 15) << 7) + (s >> 4);
        const float L0 = LS[(size_t)r0 * 4 + hh], L1 = LS[((size_t)NT + r1) * 4 + hh], L2 = LS[((size_t)2 * NT + r2) * 4 + hh];
        const float mx = fmaxf(L0, fmaxf(L1, L2));
        float w0 = __builtin_amdgcn_exp2f(L0 - mx), w1 = __builtin_amdgcn_exp2f(L1 - mx), w2 = __builtin_amdgcn_exp2f(L2 - mx);
        const float inv = 1.0f / (w0 + w1 + w2); w0 *= inv; w1 *= inv; w2 *= inv;
        const u32x2 a = *(const u32x2*)(OD + (size_t)r0 * 256 + 4 * lane), bq = *(const u32x2*)(OD + ((size_t)NT + r1) * 256 + 4 * lane), cq = *(const u32x2*)(OD + ((size_t)2 * NT + r2) * 256 + 4 * lane);
        u32x2 o;
        o.x = pk2(w0 * bflo(a.x) + w1 * bflo(bq.x) + w2 * bflo(cq.x), w0 * bfhi(a.x) + w1 * bfhi(bq.x) + w2 * bfhi(cq.x));
        o.y = pk2(w0 * bflo(a.y) + w1 * bflo(bq.y) + w2 * bflo(cq.y), w0 * bfhi(a.y) + w1 * bfhi(bq.y) + w2 * bfhi(cq.y));
        stg8<NT_ATT>(O + (size_t)t * DM + 768 + 4 * lane, o);
    }
}

__device__ __forceinline__ void ln1_router(const Ctx& X, const CArgs* ap, int l, bool first, bool dummy = false) {
    struct { const float *ln1g, *ln1b, *rgb, *reb; } a = {ap->ln1g, ap->ln1b, ap->rgb, ap->reb}; (void)first;
    const bf16* xin = (const bf16*)((const unsigned char*)ap->out + XR_OFF);
    const bool keep_copy = !LN2_X1B && (l == DEPTH - 1) && !dummy; bf16* XC = (bf16*)(X.ws + WS_KVA);
    const int lane = X.lane; const bf16* MIX = (const bf16*)(X.ws + WS_MIX); bf16* X1B = (bf16*)(X.ws + (dummy ? WS_Y : WS_XB));
    LAS float* reT = (LAS float*)X.lds;
    LAS float* rgT = (LAS float*)(X.lds + LDS_X_OFF);
    LAS int* hist = (LAS int*)(X.lds + LDSCTL_OFF + 256);
    { const u32x4* s1 = (const u32x4*)(X.ws + WS_RET + (size_t)l * 32 * DM * 4); for (int i = X.tid; i < 32 * DM / 4; i += 512) ((LAS u32x4*)reT)[i] = s1[i];
      const u32x4* s2 = (const u32x4*)(X.ws + WS_RGT + (size_t)l * 4 * DM * 4); for (int i = X.tid; i < 4 * DM / 4; i += 512) ((LAS u32x4*)rgT)[i] = s2[i]; }
    f32x4 g[4], bb[4];
#pragma unroll
    for (int j = 0; j < 4; ++j) { g[j] = *(const f32x4*)(a.ln1g + l * DM + 4 * lane + 256 * j); bb[j] = *(const f32x4*)(a.ln1b + l * DM + 4 * lane + 256 * j); }
    const float* rgb = a.rgb + l * 4; const float* reb = a.reb + l * 32;
    for (int rb = X.c; rb < NT / 256; rb += X.G) {
        if (X.tid < 32) hist[X.tid] = 0;
        __syncthreads();
        u32x2 xa[4], xb[4]; u32x2 ma[4], mb[4];
        { const int t = rb * 256 + X.wave * 32;
#pragma unroll
          for (int j = 0; j < 4; ++j) { xa[j] = *(const u32x2*)(xin + (size_t)t * DM + 4 * lane + 256 * j); ma[j] = *(const u32x2*)(MIX + (size_t)t * DM + 4 * lane + 256 * j); }
#pragma unroll
          for (int j = 0; j < 4; ++j) { xb[j] = *(const u32x2*)(xin + (size_t)(t + 1) * DM + 4 * lane + 256 * j); mb[j] = *(const u32x2*)(MIX + (size_t)(t + 1) * DM + 4 * lane + 256 * j); } }
        auto row = [&](u32x2 (&xn)[4], u32x2 (&mn)[4], const int i) __attribute__((always_inline)) {
            const int t = rb * 256 + X.wave * 32 + i;
            f32x4 v[4]; float s = 0.f;
#pragma unroll
            for (int j = 0; j < 4; ++j) { const u32x2 xw = xn[j]; const u32x2 mw = mn[j];
                if (keep_copy) *(u32x2*)(XC + (size_t)t * DM + 4 * lane + 256 * j) = xw;
                v[j][0] = ALPHA * bflo(xw.x) + bflo(mw.x); v[j][1] = ALPHA * bfhi(xw.x) + bfhi(mw.x); v[j][2] = ALPHA * bflo(xw.y) + bflo(mw.y); v[j][3] = ALPHA * bfhi(xw.y) + bfhi(mw.y);
                s += (v[j][0] + v[j][1]) + (v[j][2] + v[j][3]); }
            if (i + 2 < 32) {
#pragma unroll
                for (int j = 0; j < 4; ++j) { xn[j] = *(const u32x2*)(xin + (size_t)(t + 2) * DM + 4 * lane + 256 * j); mn[j] = *(const u32x2*)(MIX + (size_t)(t + 2) * DM + 4 * lane + 256 * j); } }
            const float mean = wave_sum(s) * (1.f / DM); float s2 = 0.f;
#pragma unroll
            for (int j = 0; j < 4; ++j) { v[j] = v[j] - mean; s2 += (v[j][0] * v[j][0] + v[j][1] * v[j][1]) + (v[j][2] * v[j][2] + v[j][3] * v[j][3]); }
            const float rstd = 1.0f / sqrtf(wave_sum(s2) * (1.f / DM) + 1e-5f);
#pragma unroll
            for (int j = 0; j < 4; ++j) { v[j] = v[j] * rstd * g[j] + bb[j];
                u32x2 w; w.x = pk2(v[j][0], v[j][1]); w.y = pk2(v[j][2], v[j][3]); stg8<NT_LN>(X1B + (size_t)t * DM + 4 * lane + 256 * j, w); }
            float lg[4];
            { f32x2 pa[4], pb[4];
#pragma unroll
              for (int gi = 0; gi < 4; ++gi) { pa[gi] = (f32x2){0.f, 0.f}; pb[gi] = (f32x2){0.f, 0.f}; }
#pragma unroll
              for (int j = 0; j < 4; ++j) { const f32x2 vxy = {v[j][0], v[j][1]}, vzw = {v[j][2], v[j][3]};
#pragma unroll
                  for (int gi = 0; gi < 4; ++gi) { const f32x4 w = *(const LAS f32x4*)(rgT + gi * DM + 4 * lane + 256 * j);
                      pa[gi] = __builtin_elementwise_fma(vxy, (f32x2){w[0], w[1]}, pa[gi]); pb[gi] = __builtin_elementwise_fma(vzw, (f32x2){w[2], w[3]}, pb[gi]); } }
#pragma unroll
              for (int gi = 0; gi < 4; ++gi) { const f32x2 q = pa[gi] + pb[gi]; lg[gi] = q.x + q.y; }
              wave_sum_n<4>(lg);
#pragma unroll
              for (int gi = 0; gi < 4; ++gi) lg[gi] += rgb[gi]; }
            int gs = 0; float gm = lg[0];
#pragma unroll
            for (int gi = 1; gi < 4; ++gi) if (lg[gi] > gm) { gm = lg[gi]; gs = gi; }
            float den = 0.f;
#pragma unroll
            for (int gi = 0; gi < 4; ++gi) den += __expf(lg[gi] - gm);
            const float ptop = __builtin_amdgcn_rcpf(den);
            gs = __builtin_amdgcn_readfirstlane(gs);
            float le[8];
            { f32x2 pa[8], pb[8]; const LAS float* reG = reT + gs * 8 * DM + 4 * lane;
#pragma unroll
              for (int e = 0; e < 8; ++e) { pa[e] = (f32x2){0.f, 0.f}; pb[e] = (f32x2){0.f, 0.f}; }
#pragma unroll
              for (int j = 0; j < 4; ++j) { const f32x2 vxy = {v[j][0], v[j][1]}, vzw = {v[j][2], v[j][3]};
#pragma unroll
                  for (int e = 0; e < 8; ++e) { const f32x4 w = *(const LAS f32x4*)(reG + e * DM + 256 * j);
                      pa[e] = __builtin_elementwise_fma(vxy, (f32x2){w[0], w[1]}, pa[e]); pb[e] = __builtin_elementwise_fma(vzw, (f32x2){w[2], w[3]}, pb[e]); } }
#pragma unroll
              for (int e = 0; e < 8; ++e) { const f32x2 q = pa[e] + pb[e]; le[e] = q.x + q.y; }
              wave_sum_n<8>(le);
#pragma unroll
              for (int e = 0; e < 8; ++e) le[e] += reb[gs * 8 + e]; }
            int e1 = 0; float v1 = le[0];
#pragma unroll
            for (int e = 1; e < 8; ++e) if (le[e] > v1) { v1 = le[e]; e1 = e; }
            int e2 = -1; float v2 = -INFINITY;
#pragma unroll
            for (int e = 0; e < 8; ++e) if (e != e1 && le[e] > v2) { v2 = le[e]; e2 = e; }
            const float wa = __builtin_amdgcn_rcpf(1.0f + __expf(v2 - v1)), wb = 1.0f - wa;
            if (lane == 0) { u32x4 ro; ro.x = (unsigned)(gs * 8 + e1); ro.y = (unsigned)(gs * 8 + e2); ro.z = __builtin_bit_cast(unsigned, ptop * wa); ro.w = __builtin_bit_cast(unsigned, ptop * wb);
                *(u32x4*)(X.ws + WS_ROUTE + (size_t)t * 16) = ro;
                __hip_atomic_fetch_add(hist + gs * 8 + e1, 1, __ATOMIC_RELAXED, __HIP_MEMORY_SCOPE_WORKGROUP); __hip_atomic_fetch_add(hist + gs * 8 + e2, 1, __ATOMIC_RELAXED, __HIP_MEMORY_SCOPE_WORKGROUP); }
        };
#pragma unroll 1
        for (int i = 0; i < 32; i += 2) { row(xa, ma, i); row(xb, mb, i + 1); }
        __syncthreads();
        if (X.tid < 32) ((int*)(X.ws + WS_HIST))[rb * 32 + X.tid] = hist[X.tid];
        __syncthreads();
    }
}

__device__ __forceinline__ void ln1_router_mfma(const Ctx& X, const CArgs* ap, int l, bool dummy = false) {
    struct { const float *ln1g, *ln1b, *rgb, *reb; } a = {ap->ln1g, ap->ln1b, ap->rgb, ap->reb};
    const bf16* xin = (const bf16*)((const unsigned char*)ap->out + XR_OFF);
    const int lane = X.lane, jr = lane & 31, hh = lane >> 5; const bf16* MIX = (const bf16*)(X.ws + WS_MIX); bf16* X1B = (bf16*)(X.ws + (dummy ? WS_Y : WS_XB));
    constexpr int WP = 1032;
    LAS bf16* wr = (LAS bf16*)X.lds;
    LAS float* rbias = (LAS float*)(X.lds + 40 * WP * 2);
    LAS int* hist = (LAS int*)(X.lds + LDSCTL_OFF + 256);
    { const float* ret = (const float*)(X.ws + WS_RET) + (size_t)l * 32 * DM; const float* rgt = (const float*)(X.ws + WS_RGT) + (size_t)l * 4 * DM;
      for (int i = X.tid; i < 40 * 256; i += 512) { const int row = i >> 8, c4 = i & 255; f32x4 w = {0.f, 0.f, 0.f, 0.f};
          if (row < 32) w = *(const f32x4*)(ret + (size_t)row * DM + 4 * c4); else if (row < 36) w = *(const f32x4*)(rgt + (size_t)(row - 32) * DM + 4 * c4);
          u32x2 p; p.x = pk2(w[0], w[1]); p.y = pk2(w[2], w[3]); *(LAS u32x2*)(wr + row * WP + 4 * c4) = p; }
      if (X.tid < 32) rbias[X.tid] = a.reb[l * 32 + X.tid]; else if (X.tid < 36) rbias[X.tid] = a.rgb[l * 4 + X.tid - 32]; }
    f32x4 g[4], bb[4];
#pragma unroll
    for (int j = 0; j < 4; ++j) { g[j] = *(const f32x4*)(a.ln1g + l * DM + 4 * lane + 256 * j); bb[j] = *(const f32x4*)(a.ln1b + l * DM + 4 * lane + 256 * j); }
    auto ldm = [&](int t, int j) __attribute__((always_inline)) -> u32x2 {
        if (MIX_FP8) { u32x2 r; r.x = *(const unsigned*)((const unsigned char*)MIX + (size_t)t * DM + 4 * lane + 256 * j); r.y = 0u; return r; }
        return *(const u32x2*)(MIX + (size_t)t * DM + 4 * lane + 256 * j); };
    for (int rb = X.c; rb < NT / 256; rb += X.G) {
        if (X.tid < 32) hist[X.tid] = 0;
        __syncthreads();
        const int tw = rb * 256 + X.wave * 32;
        u32x2 xa[4], xb[4]; u32x2 ma[4], mb[4];
#pragma unroll
        for (int j = 0; j < 4; ++j) { xa[j] = *(const u32x2*)(xin + (size_t)tw * DM + 4 * lane + 256 * j); ma[j] = ldm(tw, j); }
#pragma unroll
        for (int j = 0; j < 4; ++j) { xb[j] = *(const u32x2*)(xin + (size_t)(tw + 1) * DM + 4 * lane + 256 * j); mb[j] = ldm(tw + 1, j); }
        auto row = [&](u32x2 (&xn)[4], u32x2 (&mn)[4], const int i) __attribute__((always_inline)) {
            const int t = tw + i;
            f32x4 v[4]; float s = 0.f;
#pragma unroll
            for (int j = 0; j < 4; ++j) { const u32x2 xw = xn[j]; const u32x2 mw = mn[j];
                f32x4 mf;
                if (MIX_FP8) mf = pg8::fp8x4_to_f32(mw.x) * (1.0f / MIX_SCALE); else mf = (f32x4){bflo(mw.x), bfhi(mw.x), bflo(mw.y), bfhi(mw.y)};
                v[j][0] = ALPHA * bflo(xw.x) + mf[0]; v[j][1] = ALPHA * bfhi(xw.x) + mf[1]; v[j][2] = ALPHA * bflo(xw.y) + mf[2]; v[j][3] = ALPHA * bfhi(xw.y) + mf[3];
                s += (v[j][0] + v[j][1]) + (v[j][2] + v[j][3]); }
            if (i + 2 < 32) {
#pragma unroll
                for (int j = 0; j < 4; ++j) { xn[j] = *(const u32x2*)(xin + (size_t)(t + 2) * DM + 4 * lane + 256 * j); mn[j] = ldm(t + 2, j); } }
            const float mean = wave_sum(s) * (1.f / DM); float s2 = 0.f;
#pragma unroll
            for (int j = 0; j < 4; ++j) { v[j] = v[j] - mean; s2 += (v[j][0] * v[j][0] + v[j][1] * v[j][1]) + (v[j][2] * v[j][2] + v[j][3] * v[j][3]); }
            const float rstd = __builtin_amdgcn_rsqf(wave_sum(s2) * (1.f / DM) + 1e-5f);
#pragma unroll
            for (int j = 0; j < 4; ++j) { v[j] = v[j] * rstd * g[j] + bb[j];
                u32x2 w; w.x = pk2(v[j][0], v[j][1]); w.y = pk2(v[j][2], v[j][3]); stg8<NT_LN>(X1B + (size_t)t * DM + 4 * lane + 256 * j, w); }
        };
#pragma unroll 1
        for (int i = 0; i < 32; i += 2) { row(xa, ma, i); row(xb, mb, i + 1); }
        asm volatile("s_waitcnt vmcnt(0)" ::: "memory");
        f32x16 acc0, acc1;
#pragma unroll
        for (int i = 0; i < 16; ++i) { acc0[i] = 0.f; acc1[i] = 0.f; }
        const bf16* bp = X1B + (size_t)(tw + jr) * DM + 16 * hh;
        const LAS bf16* a0p = wr + jr * WP + 16 * hh; const LAS bf16* a1p = wr + (32 + (jr < 8 ? jr : 7)) * WP + 16 * hh;
#pragma unroll 4
        for (int t2 = 0; t2 < 32; ++t2) {
            const bf16x8 b0 = *(const bf16x8*)(bp + 32 * t2), b1 = *(const bf16x8*)(bp + 32 * t2 + 8);
            const bf16x8 a00 = *(const LAS bf16x8*)(a0p + 32 * t2), a01 = *(const LAS bf16x8*)(a0p + 32 * t2 + 8), a10 = *(const LAS bf16x8*)(a1p + 32 * t2), a11 = *(const LAS bf16x8*)(a1p + 32 * t2 + 8);
            acc0 = __builtin_amdgcn_mfma_f32_32x32x16_bf16(a00, b0, acc0, 0, 0, 0); acc1 = __builtin_amdgcn_mfma_f32_32x32x16_bf16(a10, b0, acc1, 0, 0, 0);
            acc0 = __builtin_amdgcn_mfma_f32_32x32x16_bf16(a01, b1, acc0, 0, 0, 0); acc1 = __builtin_amdgcn_mfma_f32_32x32x16_bf16(a11, b1, acc1, 0, 0, 0);
        }
        float gl[4];
#pragma unroll
        for (int i = 0; i < 4; ++i) { const auto tt = __builtin_amdgcn_permlane32_swap(__float_as_uint(acc1[i]), __float_as_uint(acc1[i]), false, false); gl[i] = __uint_as_float(tt[0]) + rbias[32 + i]; }
        int gs = 0; float gm = gl[0];
#pragma unroll
        for (int gi = 1; gi < 4; ++gi) if (gl[gi] > gm) { gm = gl[gi]; gs = gi; }
        float den = 0.f;
#pragma unroll
        for (int gi = 0; gi < 4; ++gi) den += __expf(gl[gi] - gm);
        const float ptop = __builtin_amdgcn_rcpf(den);
        float le[8];
#pragma unroll
        for (int k = 0; k < 4; ++k) { const float mine = gs == 0 ? acc0[k] : (gs == 1 ? acc0[4 + k] : (gs == 2 ? acc0[8 + k] : acc0[12 + k]));
            const auto tt = __builtin_amdgcn_permlane32_swap(__float_as_uint(mine), __float_as_uint(mine), false, false);
            le[k] = __uint_as_float(tt[0]); le[4 + k] = __uint_as_float(tt[1]); }
#pragma unroll
        for (int e = 0; e < 8; ++e) le[e] += rbias[gs * 8 + e];
        int e1 = 0; float v1 = le[0];
#pragma unroll
        for (int e = 1; e < 8; ++e) if (le[e] > v1) { v1 = le[e]; e1 = e; }
        int e2 = -1; float v2 = -INFINITY;
#pragma unroll
        for (int e = 0; e < 8; ++e) if (e != e1 && le[e] > v2) { v2 = le[e]; e2 = e; }
        const float wa = __builtin_amdgcn_rcpf(1.0f + __expf(v2 - v1)), wb = 1.0f - wa;
        if (hh == 0) { u32x4 ro; ro.x = (unsigned)(gs * 8 + e1); ro.y = (unsigned)(gs * 8 + e2); ro.z = __builtin_bit_cast(unsigned, ptop * wa); ro.w = __builtin_bit_cast(unsigned, ptop * wb);
            *(u32x4*)(X.ws + WS_ROUTE + (size_t)(tw + jr) * 16) = ro;
            __hip_atomic_fetch_add(hist + gs * 8 + e1, 1, __ATOMIC_RELAXED, __HIP_MEMORY_SCOPE_WORKGROUP); __hip_atomic_fetch_add(hist + gs * 8 + e2, 1, __ATOMIC_RELAXED, __HIP_MEMORY_SCOPE_WORKGROUP); }
        __syncthreads();
        if (X.tid < 32) ((int*)(X.ws + WS_HIST))[rb * 32 + X.tid] = hist[X.tid];
        __syncthreads();
    }
}

__device__ __forceinline__ void moe_dispatch(const Ctx& X) {
    LAS int* cnt = (LAS int*)(X.lds);
    LAS int* pre = cnt + 32;
    LAS int* ebase = cnt + 64;
    LAS int* wcnt = cnt + 128;
    const int* HIST = (const int*)(X.ws + WS_HIST); int* STOK = (int*)(X.ws + WS_STOK); float* SW = (float*)(X.ws + WS_SW); int* TSLOT = (int*)(X.ws + WS_TSLOT); int* TILEE = (int*)(X.ws + WS_TILEE);
    for (int rb = X.c; rb < NT / 256; rb += X.G) {
        if (X.tid < 64) cnt[X.tid] = 0;
        __syncthreads();
        { const int e = X.tid & 31, part = X.tid >> 5; int sa = 0, sp = 0;
          for (int q = 0; q < 16; ++q) { const int b2 = part * 16 + q; const int hv = HIST[b2 * 32 + e]; sa += hv; if (b2 < rb) sp += hv; }
          __hip_atomic_fetch_add(cnt + e, sa, __ATOMIC_RELAXED, __HIP_MEMORY_SCOPE_WORKGROUP); __hip_atomic_fetch_add(pre + e, sp, __ATOMIC_RELAXED, __HIP_MEMORY_SCOPE_WORKGROUP); }
        __syncthreads();
        if (X.tid < 64) { const int n = X.tid < 32 ? cnt[X.tid] : 0; const int pad = (n + 255) & ~255; int inc = pad;
#pragma unroll
            for (int o = 1; o < 32; o <<= 1) { const int u = __shfl_up(inc, o); if ((X.tid & 63) >= o) inc += u; }
            if (X.tid < 32) { ebase[X.tid] = inc - pad; if (X.tid == 31) ebase[32] = inc; } }
        __syncthreads();
        const int tl = X.tid >> 1, kk = X.tid & 1, t = rb * 256 + tl;
        const u32x4 ro = *(const u32x4*)(X.ws + WS_ROUTE + (size_t)t * 16);
        const int e = (int)(kk ? ro.y : ro.x); const float w = __builtin_bit_cast(float, kk ? ro.w : ro.z);
        int rank = 0;
        for (int ee = 0; ee < 32; ++ee) { const unsigned long long mm = __ballot(e == ee);
            if (e == ee) rank = __builtin_popcountll(mm & ((1ull << X.lane) - 1ull));
            if (X.lane == 0) wcnt[X.wave * 32 + ee] = __builtin_popcountll(mm); }
        __syncthreads();
        int off = 0;
        for (int w2 = 0; w2 < X.wave; ++w2) off += wcnt[w2 * 32 + e];
        const int slot = ebase[e] + pre[e] + off + rank;
        STOK[slot] = t; SW[slot] = w; TSLOT[2 * t + kk] = slot;
        if (rb < 32) { const int e2 = rb; for (int s = ebase[e2] + cnt[e2] + X.tid; s < ebase[e2 + 1]; s += 512) { STOK[s] = 0; SW[s] = 0.f; } }
        if (rb == 0) { const int ntl = ebase[32] >> 8;
            for (int tile = X.tid; tile < ntl; tile += 512) { int ee = 0; while (ee < 31 && ebase[ee + 1] <= tile * 256) ++ee; TILEE[tile] = ee; }
            if (X.tid == 0) TILEE[1024] = ntl; }
        __syncthreads();
    }
}

__device__ __forceinline__ void ln2_phase(const Ctx& X, const CArgs* ap, int l, bool first, bool dummy = false) {
    struct { const float *ln1g, *ln1b, *ln2g, *ln2b; } a = {ap->ln1g, ap->ln1b, ap->ln2g, ap->ln2b}; float* outw = dummy ? (float*)(X.ws + WS_Y + 272 * MiB) : ap->out; (void)first;
    const bool last = (l + 1 == DEPTH);
    const bf16* xin = LN2_X1B ? (const bf16*)(X.ws + WS_XB) : (last ? (const bf16*)(X.ws + WS_KVA) : (const bf16*)((const unsigned char*)ap->out + XR_OFF));
    const int lane = X.lane; const bf16* Y = (const bf16*)(X.ws + WS_Y); const bf16* MIX = (const bf16*)(X.ws + WS_MIX); const int* TSLOT = (const int*)(X.ws + WS_TSLOT); bf16* XBp = dummy ? (bf16*)(X.ws + WS_MIX) : (bf16*)((unsigned char*)ap->out + XR_OFF);
    auto ldy = [&](int slot, int j) __attribute__((always_inline)) -> u32x2 {
        if (Y_FP8) { u32x2 r; r.x = ldg_s<unsigned>((const unsigned char*)Y + (size_t)slot * DM + 4 * lane + 256 * j); r.y = 0u; return r; }
        return ldg_s<u32x2>(Y + (size_t)slot * DM + 4 * lane + 256 * j); };
    f32x4 g1[4], b1[4], g[4], bb[4];
#pragma unroll
    for (int j = 0; j < 4; ++j) { g1[j] = *(const f32x4*)(a.ln1g + l * DM + 4 * lane + 256 * j); b1[j] = *(const f32x4*)(a.ln1b + l * DM + 4 * lane + 256 * j);
        g[j] = *(const f32x4*)(a.ln2g + l * DM + 4 * lane + 256 * j); bb[j] = *(const f32x4*)(a.ln2b + l * DM + 4 * lane + 256 * j); }
    for (int rb = X.c; rb < NT / 256; rb += X.G) {
        const int tb = rb * 256 + X.wave * 32;
        const int myslots_a = TSLOT[2 * (tb + (lane & 31))], myslots_b = TSLOT[2 * (tb + (lane & 31)) + 1];
        u32x2 xn[4]; u32x2 mn[4], yan[4], ybn[4];
        { const int sa = __builtin_amdgcn_readlane(myslots_a, 0), sb = __builtin_amdgcn_readlane(myslots_b, 0);
#pragma unroll
          for (int j = 0; j < 4; ++j) { xn[j] = *(const u32x2*)(xin + (size_t)tb * DM + 4 * lane + 256 * j); mn[j] = LN2_X1B ? (u32x2){0u, 0u} : *(const u32x2*)(MIX + (size_t)tb * DM + 4 * lane + 256 * j);
              yan[j] = ldy(sa, j); ybn[j] = ldy(sb, j); } }
        for (int i = 0; i < 32; ++i) {
            const int t = tb + i;
            f32x4 v[4]; float s = 0.f;
#pragma unroll
            for (int j = 0; j < 4; ++j) { const u32x2 xw = xn[j]; const u32x2 mw = mn[j];
                if (LN2_X1B) { v[j][0] = bflo(xw.x); v[j][1] = bfhi(xw.x); v[j][2] = bflo(xw.y); v[j][3] = bfhi(xw.y); }
                else { v[j][0] = ALPHA * bflo(xw.x) + bflo(mw.x); v[j][1] = ALPHA * bfhi(xw.x) + bfhi(mw.x); v[j][2] = ALPHA * bflo(xw.y) + bflo(mw.y); v[j][3] = ALPHA * bfhi(xw.y) + bfhi(mw.y);
                    s += (v[j][0] + v[j][1]) + (v[j][2] + v[j][3]); } }
            u32x2 ya[4], yb[4];
#pragma unroll
            for (int j = 0; j < 4; ++j) { ya[j] = yan[j]; yb[j] = ybn[j]; }
            if (i + 1 < 32) { const int sa = __shfl(myslots_a, i + 1), sb = __shfl(myslots_b, i + 1);
#pragma unroll
                for (int j = 0; j < 4; ++j) { xn[j] = *(const u32x2*)(xin + (size_t)(t + 1) * DM + 4 * lane + 256 * j); if (!LN2_X1B) mn[j] = *(const u32x2*)(MIX + (size_t)(t + 1) * DM + 4 * lane + 256 * j);
                    yan[j] = ldy(sa, j); ybn[j] = ldy(sb, j); } }
            if (!LN2_X1B) { const float mean = wave_sum(s) * (1.f / DM); float s2 = 0.f;
#pragma unroll
              for (int j = 0; j < 4; ++j) { v[j] = v[j] - mean; s2 += (v[j][0] * v[j][0] + v[j][1] * v[j][1]) + (v[j][2] * v[j][2] + v[j][3] * v[j][3]); }
              const float rstd = 1.0f / sqrtf(wave_sum(s2) * (1.f / DM) + 1e-5f);
#pragma unroll
              for (int j = 0; j < 4; ++j) v[j] = v[j] * rstd * g1[j] + b1[j]; }
            s = 0.f;
#pragma unroll
            for (int j = 0; j < 4; ++j) { const f32x4 xv = v[j];
                if (Y_FP8) { const f32x4 fa = pg8::fp8x4_to_f32(ya[j].x), fb = pg8::fp8x4_to_f32(yb[j].x);
#pragma unroll
                    for (int e = 0; e < 4; ++e) v[j][e] = ALPHA * xv[e] + (fa[e] + fb[e]) * (1.0f / Y_SCALE);
                } else { v[j][0] = ALPHA * xv[0] + (bflo(ya[j].x) + bflo(yb[j].x)); v[j][1] = ALPHA * xv[1] + (bfhi(ya[j].x) + bfhi(yb[j].x)); v[j][2] = ALPHA * xv[2] + (bflo(ya[j].y) + bflo(yb[j].y)); v[j][3] = ALPHA * xv[3] + (bfhi(ya[j].y) + bfhi(yb[j].y)); }
                s += (v[j][0] + v[j][1]) + (v[j][2] + v[j][3]); }
            const float mean = wave_sum(s) * (1.f / DM); float s2 = 0.f;
#pragma unroll
            for (int j = 0; j < 4; ++j) { v[j] = v[j] - mean; s2 += (v[j][0] * v[j][0] + v[j][1] * v[j][1]) + (v[j][2] * v[j][2] + v[j][3] * v[j][3]); }
            const float rstd = 1.0f / sqrtf(wave_sum(s2) * (1.f / DM) + 1e-5f);
#pragma unroll
            for (int j = 0; j < 4; ++j) { v[j] = v[j] * rstd * g[j] + bb[j];
                if (last || dummy) stgf4<NT_LN>(outw + (size_t)t * DM + 4 * lane + 256 * j, v[j]);
                else { u32x2 w; w.x = pk2(v[j][0], v[j][1]); w.y = pk2(v[j][2], v[j][3]); stg8<NT_LN>(XBp + (size_t)t * DM + 4 * lane + 256 * j, w); } }
        }
    }
}

#ifndef REP_P0
#define REP_P0 1
#endif
#ifndef REP_P5
#define REP_P5 1
#endif
#ifndef REP_P9
#define REP_P9 1
#endif
#ifndef REP_BAR
#define REP_BAR 1
#endif
#ifndef REP_P1
#define REP_P1 1
#endif
#ifndef REP_P2A
#define REP_P2A 1
#endif
#ifndef REP_P2B
#define REP_P2B 1
#endif
#ifndef REP_P2C
#define REP_P2C 1
#endif
#ifndef REP_P2D
#define REP_P2D 1
#endif
#ifndef REP_P3A
#define REP_P3A 1
#endif
#ifndef REP_P3B
#define REP_P3B 1
#endif
#ifndef REP_P3C
#define REP_P3C 1
#endif
#ifndef REP_P4
#define REP_P4 1
#endif
#ifndef REP_P6
#define REP_P6 1
#endif
#ifndef REP_P7
#define REP_P7 1
#endif
#ifndef REP_P8
#define REP_P8 1
#endif
__global__ void __launch_bounds__(512, 2) mk_fwd(Args a) {
    extern __shared__ __attribute__((aligned(16))) unsigned char lds_raw[];
    LAS unsigned char* const lds0 = (LAS unsigned char*)lds_raw;
    for (int u = threadIdx.x; u < (LDS_BYTES - LDSCTL_OFF) / 4; u += 512) ((LAS unsigned*)(lds0 + LDSCTL_OFF))[u] = 0u;
    __syncthreads();
    unsigned* barw = (unsigned*)(a.ws + WS_CTL) + CW_BAR;
    XcdBarrier bar; bar.bar = barw; bar.x = 0; bar.st = nullptr;
    if (a.use_bar) bar = xcd_barrier_post(barw, (volatile LAS unsigned*)(lds0 + LDSCTL_OFF) + 8);
#define MKCTX() Ctx X; const CArgs* ap = (const CArgs*)__builtin_amdgcn_kernarg_segment_ptr(); asm volatile("" : "+s"(ap)); { int t_ = threadIdx.x; asm volatile("" : "+v"(t_)); X.lds = lds0; X.tid = t_; X.lane = t_ & 63; X.wave = __builtin_amdgcn_readfirstlane(t_ >> 6); \
        unsigned char* w_ = ap->ws; X.G = gridDim.x; X.c = blockIdx.x; X.vcu = (X.G % 8 == 0) ? (X.c % 8) * (X.G / 8) + X.c / 8 : X.c; X.ws = w_; }
#ifndef P2M
#define P2M 31
#endif
#ifndef PH_MASK0
#define PH_MASK0 1
#endif
#define GBAR() do { if (a.use_bar) for (int rb_ = 0; rb_ < REP_BAR; ++rb_) xcd_barrier(bar); } while (0)

    if ((PH_MASK0 & 1) && a.l_lo == 0 && a.ph_lo == 0) { MKCTX(); for (int rep = 0; rep < REP_P0; ++rep) { prologue(X, ap); __syncthreads(); } GBAR(); }

    for (int l = a.l_lo; l < a.l_hi; ++l) {
        const int lo = (l == a.l_lo) ? (a.ph_lo < 1 ? 1 : a.ph_lo) : 1, hi = (l == a.l_hi - 1) ? a.ph_hi : 10;
#ifndef PH_MASK
#define PH_MASK 0x3ff
#endif
#define IN(k) (((PH_MASK >> (k)) & 1) && lo <= (k) && (k) < hi)
        if (IN(1)) { MKCTX();
            pg8::Gemm g{(const bf16*)((const unsigned char*)ap->out + XR_OFF), (const bf16*)(X.ws + WS_WIN) + (size_t)l * NIN * DM, DM, nullptr};
            pg8::StaticOrder S; S.init(NT, NIN, X.G, X.c, REP_P1);
            pg8::RopeTabs R{ap->pos};
            pg8::EpiGroups<InProjDesc> E{InProjDesc{X.ws}, R, nullptr, 0, 0.f, 0.f};
            pg8::gemm_phase<pg8::EpiGroups<InProjDesc>, pg8::StaticOrder, false>(X.lds, g, S, E, X.tid);
            GBAR();
        }
        if (IN(2)) { MKCTX();
            {
                pg8::Gemm g{(const bf16*)(X.ws + WS_CQ), (const bf16*)(X.ws + WS_WUQ) + (size_t)l * 768 * 256, 256, nullptr};
                pg8::StaticOrder S; S.init(NT, 768, X.G, X.c, REP_P2A);
                pg8::RopeTabs R{ap->pos};
                pg8::EpiGroups<UqDesc> E{UqDesc{X.ws}, R, (const float*)(X.ws + WS_SSQ), 8, 1.0f / 256.0f, 1e-6f};
                pg8::gemm_phase<pg8::EpiGroups<UqDesc>, pg8::StaticOrder, false>(X.lds, g, S, E, X.tid);
            }
            {
                MKCTX();
                int kq = 128; asm volatile("" : "+s"(kq));
                pg8::Gemm g{(const bf16*)(X.ws + WS_T1), (const bf16*)(X.ws + WS_WUKV) + (size_t)l * 1024 * 128, kq, nullptr};
                pg8::StaticOrder S; S.init(NT, 1024, X.G, X.c, REP_P2A);
                pg8::EpiPlainT<NT_KVA> E{(bf16*)(X.ws + WS_KVA), 1024, (const float*)(X.ws + WS_SSQ) + (size_t)NT * 8, 4, 1.0f / 128.0f, 1e-6f, X.lds + LDS_X_OFF};
                pg8::gemm_phase<decltype(E), pg8::StaticOrder, false>(X.lds, g, S, E, X.tid);
            }
            __syncthreads();
            for (int rep = 0; rep < REP_P2B; ++rep) convert_experts(X, ap, l);
            __syncthreads();
            for (int rep = 0; rep < REP_P2C; ++rep) for (int U = X.vcu; U < NB * 32; U += X.G) { const int b = U >> 5, pr = U & 31;
                dsa_index_unit(X, b, 32 * pr); dsa_index_unit(X, b, 32 * (63 - pr)); }
            __syncthreads();
#pragma unroll 1
            for (int cfg = 0; cfg < 3 * REP_P2D; ++cfg) { const int cfgi = cfg % 3;
                fa::Params P; const size_t co = (size_t)cfgi * NT * 256;
                P.Q = (const bf16*)(X.ws + WS_DQ) + co; P.q_pitch = 256; P.K1 = (const bf16*)(X.ws + WS_DK) + co; P.k1_pitch = 256; P.K2 = nullptr; P.k2_pitch = 0; P.k2_col = 0;
                P.V = (const bf16*)(X.ws + WS_DV) + co; P.v_pitch = 256; P.O = (bf16*)(X.ws + WS_OD) + co; P.o_pitch = 256; P.LSE = (float*)(X.ws + WS_LSE) + (size_t)cfgi * NT * 4; P.lse_pitch = 4; P.BM = nullptr;
                P.CL = cfgi == 0 ? 2048 : (cfgi == 1 ? 512 : 128); P.W = 128;
                const int vcu = X.vcu, G = X.G, wv = X.wave, CLc = P.CL;
                fa::attn_stream<64, 0, 2>(P, X.lds, X.tid, (NB * 2 * 16 - vcu + G - 1) / G, [=](int j) { const int U = vcu + j * G, bh = U >> 4, qb = U & 15, b = bh >> 1, hp = bh & 1;
                    const int q0 = 128 * qb, hh = 2 * hp + (wv >> 2); int klo = q0 & ~(CLc - 1); if (q0 - 128 > klo) klo = q0 - 128;
                    return fa::UnitDesc{b * SEQ, q0 + 32 * (wv & 3), 64 * hh, 64 * hh, hh, 128 * hp, 128 * hp, klo >> 6, (q0 + 127) >> 6}; });
            }
            GBAR();
        }
        if (IN(3)) { MKCTX();
            {   fa::Params P; P.Q = (const bf16*)(X.ws + WS_QA); P.q_pitch = 768; P.K1 = (const bf16*)(X.ws + WS_KVA); P.k1_pitch = 1024; P.K2 = (const bf16*)(X.ws + WS_KPE); P.k2_pitch = 32; P.k2_col = 0;
                P.V = (const bf16*)(X.ws + WS_KVA); P.v_pitch = 1024; P.O = (bf16*)(X.ws + WS_XB); P.o_pitch = DM; P.LSE = nullptr; P.lse_pitch = 0; P.BM = nullptr; P.CL = 2048; P.W = 1 << 20;
                const int vcu = X.vcu, G = X.G, wv = X.wave;
                fa::attn_stream<96, 2, 1>(P, X.lds, X.tid, 2 * ((NB * 8 * 4 - vcu + G - 1) / G), [=](int j) { const int U = vcu + (j >> 1) * G, bh = U >> 2, pr = U & 3, b = bh >> 3, hd = bh & 7;
                    const int qb = (j & 1) ? 7 - pr : pr, q0 = 256 * qb;
                    return fa::UnitDesc{b * SEQ, q0 + 32 * wv, 96 * hd, 64 * hd, 0, 128 * hd, 128 * hd + 64, 0, (q0 + 255) >> 6}; });
            }
            {   fa::Params P; P.Q = (const bf16*)(X.ws + WS_BQ); P.q_pitch = 256; P.K1 = (const bf16*)(X.ws + WS_BK); P.k1_pitch = 64; P.k1_col = 0; P.K2 = nullptr; P.k2_pitch = 0; P.k2_col = 0;
                P.V = (const bf16*)(X.ws + WS_BV); P.v_pitch = 64; P.v_col = 0; P.O = (bf16*)(X.ws + WS_XB); P.o_pitch = DM; P.LSE = nullptr; P.lse_pitch = 0; P.BM = (const unsigned*)(X.ws + WS_BM); P.CL = 2048; P.W = 1 << 20;
                const int hd = X.wave & 3, sub = X.wave >> 2, vcu = X.vcu, G = X.G;
                fa::attn_stream<64, 1, 1>(P, X.lds, X.tid, 2 * ((NB * 16 - vcu + G - 1) / G), [=](int j) { const int U = vcu + (j >> 1) * G, b = U >> 4, pr = U & 15;
                    const int qb = (j & 1) ? 31 - pr : pr, q0 = 64 * qb;
                    return fa::UnitDesc{b * SEQ, q0 + 32 * sub, 64 * hd, 512 + 64 * hd, 0, 0, 0, 0, qb}; });
            }
            for (int rep = 0; rep < REP_P3C; ++rep) dil_combine(X);
            GBAR();
        }
        if (IN(4)) { MKCTX();
            pg8::Gemm g{(const bf16*)(X.ws + WS_XB), (const bf16*)(X.ws + WS_WO) + (size_t)l * DM * DM, DM, nullptr};
            pg8::StaticOrder S; S.init(NT, DM, X.G, X.c, REP_P4);
#if MIX_FP8 && ROUTER_MFMA && LN2_X1B
            pg8::EpiFp8T<NT_MIX> E{X.ws + WS_MIX, DM, MIX_SCALE, X.lds + LDS_X_OFF};
#else
            pg8::EpiPlainT<NT_MIX> E{(bf16*)(X.ws + WS_MIX), DM, nullptr, 0, 0.f, 0.f, X.lds + LDS_X_OFF};
#endif
            pg8::gemm_phase<decltype(E), pg8::StaticOrder, false>(X.lds, g, S, E, X.tid);
            GBAR();
        }
#if ROUTER_MFMA
        if (IN(5)) { MKCTX(); if (REP_P5 > 1) ln1_router_mfma(X, ap, l, true); ln1_router_mfma(X, ap, l); GBAR(); }
#else
        if (IN(5)) { MKCTX(); if (REP_P5 > 1) ln1_router(X, ap, l, l == 0, true); ln1_router(X, ap, l, l == 0); GBAR(); }
#endif
        if (IN(6)) { MKCTX(); for (int rep = 0; rep < REP_P6; ++rep) moe_dispatch(X); GBAR(); }
        if (IN(7)) { MKCTX();
            const int* TILEE = (const int*)(X.ws + WS_TILEE);
            pg8::Gemm g{(const bf16*)(X.ws + WS_XB), (const bf16*)(X.ws + WS_WGU), DM, (const int*)(X.ws + WS_STOK)};
            pg8::GroupedOrder S{TILEE, TILEE[1024], 2, X.G, X.c};
            pg8::EpiGateUpT<NT_H> E{(bf16*)(X.ws + WS_H), (const float*)(X.ws + WS_SW)};
            for (int rep = 0; rep < REP_P7; ++rep) pg8::gemm_phase<decltype(E), pg8::GroupedOrder, true>(X.lds, g, S, E, X.tid);
            GBAR();
        }
        if (IN(8)) { MKCTX();
            const int* TILEE = (const int*)(X.ws + WS_TILEE);
            pg8::Gemm g{(const bf16*)(X.ws + WS_H), (const bf16*)(X.ws + WS_WD), FH, nullptr};
            pg8::GroupedOrder S{TILEE, TILEE[1024], 4, X.G, X.c};
#if Y_FP8
            pg8::EpiFp8T<NT_Y> E{X.ws + WS_Y, DM, Y_SCALE, X.lds + LDS_X_OFF};
#else
            pg8::EpiPlainT<NT_Y> E{(bf16*)(X.ws + WS_Y), DM, nullptr, 0, 0.f, 0.f, X.lds + LDS_X_OFF};
#endif
            for (int rep = 0; rep < REP_P8; ++rep) pg8::gemm_phase<decltype(E), pg8::GroupedOrder, false>(X.lds, g, S, E, X.tid);
            GBAR();
        }
        if (IN(9)) { MKCTX(); if (REP_P9 > 1) ln2_phase(X, ap, l, l == 0, true); ln2_phase(X, ap, l, l == 0); if (!(l == a.l_hi - 1)) GBAR(); }
#undef IN
    }
#undef GBAR
}

extern "C" void kernel_launch(void* const* d_in, const int* in_sizes, int n_in, void* d_out, int out_size, void* d_ws, size_t ws_size, hipStream_t stream) {
    static int grid = 0;
    if (grid == 0) {
        if (n_in != 19 || in_sizes[0] != NT * DM || out_size != NT * DM || ws_size < WS_END) { fprintf(stderr, "kernel_launch: unexpected shapes (n_in %d, in0 %d, out %d, ws %zu < %zu); nothing launched\n", n_in, n_in > 0 ? in_sizes[0] : -1, out_size, ws_size, (size_t)WS_END); grid = -1; return; }
        int dev = 0, cus = 0, per_cu = 0;
        if (hipGetDevice(&dev) != hipSuccess || hipDeviceGetAttribute(&cus, hipDeviceAttributeMultiprocessorCount, dev) != hipSuccess) { grid = -1; return; }
        if (hipFuncSetAttribute((const void*)mk_fwd, hipFuncAttributeMaxDynamicSharedMemorySize, LDS_BYTES) != hipSuccess) { fprintf(stderr, "kernel_launch: hipFuncSetAttribute failed\n"); grid = -1; return; }
        if (hipOccupancyMaxActiveBlocksPerMultiprocessor(&per_cu, (const void*)mk_fwd, 512, LDS_BYTES) != hipSuccess || per_cu < 1) fprintf(stderr, "kernel_launch: occupancy query reports %d\n", per_cu);
        (void)hipGetLastError();
        grid = cus;
    }
    if (grid < 0) return;
    (void)hipMemsetAsync((char*)d_ws + WS_CTL, 0, CTL_BYTES, stream);
    Args a{};
    a.x = (const float*)d_in[0]; a.pos = (const int*)d_in[1]; a.w_in = (const float*)d_in[2]; a.qn = (const float*)d_in[3]; a.kvn = (const float*)d_in[4];
    a.w_uq = (const float*)d_in[5]; a.w_ukv = (const float*)d_in[6]; a.w_o = (const float*)d_in[7]; a.ln1g = (const float*)d_in[8]; a.ln1b = (const float*)d_in[9];
    a.rgw = (const float*)d_in[10]; a.rgb = (const float*)d_in[11]; a.rew = (const float*)d_in[12]; a.reb = (const float*)d_in[13];
    a.wg = (const float*)d_in[14]; a.wu = (const float*)d_in[15]; a.wd = (const float*)d_in[16]; a.ln2g = (const float*)d_in[17]; a.ln2b = (const float*)d_in[18];
    a.out = (float*)d_out; a.ws = (unsigned char*)d_ws; a.pad = 0;
#if MK_MULTI
    a.use_bar = 0;
    a.l_lo = 0; a.l_hi = 0; a.ph_lo = 0; a.ph_hi = 0;
    hipLaunchKernelGGL(mk_fwd, dim3(grid), dim3(512), LDS_BYTES, stream, a);
    for (int l = 0; l < DEPTH; ++l)
        for (int ph = 1; ph < 10; ++ph) { a.l_lo = l; a.l_hi = l + 1; a.ph_lo = ph; a.ph_hi = ph + 1; hipLaunchKernelGGL(mk_fwd, dim3(grid), dim3(512), LDS_BYTES, stream, a); }
#else
    a.use_bar = 1; a.l_lo = 0; a.l_hi = DEPTH; a.ph_lo = 0; a.ph_hi = 10;
    hipLaunchKernelGGL(mk_fwd, dim3(grid), dim3(512), LDS_BYTES, stream, a);
#endif
    const hipError_t le = hipPeekAtLastError();
    if (le != hipSuccess) fprintf(stderr, "kernel_launch: launch failed: %s\n", hipGetErrorName(le));
}
```

```cpp
#include <hip/hip_runtime.h>
#include <cstdio>
#include <cstdint>

#define LAS __attribute__((address_space(3)))
#define GAS __attribute__((address_space(1)))
typedef unsigned short bf16;
typedef short bf16x8 __attribute__((ext_vector_type(8)));
typedef short s16x4 __attribute__((ext_vector_type(4)));
typedef float f32x2 __attribute__((ext_vector_type(2)));
typedef float f32x4 __attribute__((ext_vector_type(4)));
typedef float f32x16 __attribute__((ext_vector_type(16)));
typedef unsigned u32x2 __attribute__((ext_vector_type(2)));
typedef unsigned u32x4 __attribute__((ext_vector_type(4)));
typedef __bf16 bf16x2_t __attribute__((ext_vector_type(2)));

#ifndef MK_MULTI
#define MK_MULTI 0
#endif

constexpr int NB = 32, SEQ = 2048, NT = NB * SEQ, DM = 1024, DEPTH = 4;
constexpr int IN_COLS = 3400, NIN = 3584;
constexpr int NEXP = 32, FH = 256;
constexpr int NSLOT = 2 * NT + NEXP * 256;
constexpr int MAXTILES = NSLOT / 256;
constexpr float ALPHA = 1.681792830507429f;
constexpr float LOG2E = 1.4426950408889634f;
constexpr float QSC64 = 0.125f * LOG2E;
constexpr float QSC96 = 0.10206207261596577f * LOG2E;
constexpr float IDX_SCALE = 0.0625f;

constexpr size_t MiB = 1u << 20;
constexpr size_t WS_CTL = 0, CTL_BYTES = 1 * MiB;
constexpr size_t WS_WIN = 1 * MiB;
constexpr size_t WS_WUQ = 29 * MiB;
constexpr size_t WS_WUKV = WS_WUQ + 3 * MiB / 2;
constexpr size_t WS_WO = WS_WUKV + 2 * MiB;
constexpr size_t WS_RGT = WS_WO + 8 * MiB;
constexpr size_t WS_RET = WS_RGT + 64 * 1024;
constexpr size_t WS_ROPE = 42 * MiB;
constexpr size_t WS_WGU = 56 * MiB;
constexpr size_t WS_WD = 88 * MiB;
constexpr size_t WS_XB = 104 * MiB;
constexpr size_t WS_A = 232 * MiB;
constexpr size_t WS_CQ = WS_A;
constexpr size_t WS_T1 = WS_CQ + 32 * MiB;
constexpr size_t WS_BK = WS_T1 + 16 * MiB;
constexpr size_t WS_BQ = WS_T1 + 32 * MiB;
constexpr size_t WS_BV = WS_BQ + 32 * MiB;
constexpr size_t WS_WI = WS_BV + 8 * MiB;
constexpr size_t WS_BQI = WS_WI + 2 * MiB;
constexpr size_t WS_SSQ = WS_BQI + 32 * MiB;
constexpr size_t WS_DQ = WS_SSQ + 4 * MiB;
constexpr size_t WS_DK = WS_DQ + 96 * MiB;
constexpr size_t WS_DV = WS_DK + 96 * MiB;
constexpr size_t WS_B = WS_DV + 96 * MiB;
constexpr size_t WS_QA = WS_B;
constexpr size_t WS_KVA = WS_QA + 96 * MiB;
constexpr size_t WS_BM = WS_KVA + 128 * MiB;
constexpr size_t WS_OD = WS_BM + 16 * MiB;
constexpr size_t WS_LSE = WS_OD + 96 * MiB;
constexpr size_t WS_MOE = WS_LSE + 4 * MiB;
constexpr size_t WS_ROUTE = WS_MOE;
constexpr size_t WS_HIST = WS_ROUTE + 1 * MiB;
constexpr size_t WS_STOK = WS_HIST + 64 * 1024;
constexpr size_t WS_SW = WS_STOK + 640 * 1024;
constexpr size_t WS_TSLOT = WS_SW + 640 * 1024;
constexpr size_t WS_TILEE = WS_TSLOT + 512 * 1024;
constexpr size_t WS_KPE = WS_MOE + 4 * MiB;
constexpr size_t WS_KI = WS_KPE + 4 * MiB;
constexpr size_t WS_END = WS_KI + 4 * MiB;
constexpr size_t WS_MIX = WS_A;
constexpr size_t WS_H = WS_A + 128 * MiB;
constexpr size_t WS_Y = WS_H + 68 * MiB;
static_assert(WS_RET + 512 * 1024 <= WS_ROPE && WS_ROPE + 14 * MiB <= WS_WGU && WS_WD + 16 * MiB <= WS_XB && WS_XB + 128 * MiB <= WS_A, "ws map 1");
static_assert(WS_Y + 272 * MiB <= WS_MOE && WS_TILEE + 8192 <= WS_END && WS_END <= 1024 * MiB, "ws map 2");
constexpr size_t ROPE_C16 = 0, ROPE_S16 = (size_t)NT * 16 * 4, ROPE_C8 = 2 * ROPE_S16, ROPE_S8 = ROPE_C8 + (size_t)NT * 8 * 4,
                 ROPE_C4 = ROPE_S8 + (size_t)NT * 8 * 4, ROPE_S4 = ROPE_C4 + (size_t)NT * 4 * 4;

constexpr int CW_BAR = 4096;
constexpr int RING_BYTES = 131072;
constexpr int LDS_X_OFF = 131072;
constexpr int LDSCTL_OFF = 147456;
constexpr int LDS_HIST_OFF = LDSCTL_OFF + 4096;
constexpr int LDS_BYTES = LDS_HIST_OFF + 4096;

#define RLX_AGENT __ATOMIC_RELAXED, __HIP_MEMORY_SCOPE_AGENT
__device__ __forceinline__ unsigned f2bf(float f) { unsigned u = __builtin_bit_cast(unsigned, f); return (u + 0x7fffu + ((u >> 16) & 1u)) >> 16; }
#ifndef Y_FP8
#define Y_FP8 1
#endif
#define Y_SCALE 64.0f
#ifndef MIX_FP8
#define MIX_FP8 0
#endif
#define MIX_SCALE 256.0f
#ifndef ROUTER_MFMA
#define ROUTER_MFMA 1
#endif
#ifndef LN2_X1B
#define LN2_X1B 1
#endif
constexpr size_t XR_OFF = (size_t)NT * DM * 2;
#ifndef NT_EPI
#define NT_EPI 1
#endif
#ifndef NT_KVA
#define NT_KVA 1
#endif
#ifndef NT_MIX
#define NT_MIX 0
#endif
#ifndef NT_H
#define NT_H 0
#endif
#ifndef NT_Y
#define NT_Y 1
#endif
#ifndef NT_LN
#define NT_LN 0
#endif
#ifndef NT_ATT
#define NT_ATT 1
#endif
#define STG_ASM(W, POL) asm volatile("global_store_dwordx" W " %0, %1, off " POL "\n\ts_nop 1" :: "v"(p), "v"(w))
template <int M, class T> __device__ __forceinline__ void stg_any16(void* p, T w) {
    if constexpr (M == 0) *(T*)p = w; else if constexpr (M == 1) __builtin_nontemporal_store(w, (T*)p);
    else if constexpr (M == 2) STG_ASM("4", "sc1"); else if constexpr (M == 3) STG_ASM("4", "sc0 sc1"); else if constexpr (M == 4) STG_ASM("4", "sc1 nt"); else STG_ASM("4", "sc0 sc1 nt"); }
template <int M> __device__ __forceinline__ void stgf4(void* p, f32x4 w) { stg_any16<M>(p, w); }
template <int M> __device__ __forceinline__ void stg16(void* p, u32x4 w) { stg_any16<M>(p, w); }
template <int M> __device__ __forceinline__ void stg8(void* p, u32x2 w) {
    if constexpr (M == 0) *(u32x2*)p = w; else if constexpr (M == 1) __builtin_nontemporal_store(w, (u32x2*)p);
    else if constexpr (M == 2) STG_ASM("2", "sc1"); else if constexpr (M == 3) STG_ASM("2", "sc0 sc1"); else if constexpr (M == 4) STG_ASM("2", "sc1 nt"); else STG_ASM("2", "sc0 sc1 nt"); }
#ifndef NT_LD
#define NT_LD 1
#endif
template <class T> __device__ __forceinline__ T ldg_s(const void* p) { if constexpr (NT_LD) return __builtin_nontemporal_load((const T*)p); else return *(const T*)p; }
__device__ __forceinline__ unsigned pk2(float lo, float hi) { f32x2 v = {lo, hi}; bf16x2_t b = __builtin_convertvector(v, bf16x2_t); return __builtin_bit_cast(unsigned, b); }
__device__ __forceinline__ float bf2f(unsigned short b) { return __builtin_bit_cast(float, ((unsigned)b) << 16); }
__device__ __forceinline__ float bflo(unsigned w) { return __builtin_bit_cast(float, w << 16); }
__device__ __forceinline__ float bfhi(unsigned w) { return __builtin_bit_cast(float, w & 0xffff0000u); }
template <int CTRL> __device__ __forceinline__ float dppf(float x) { return __builtin_bit_cast(float, __builtin_amdgcn_mov_dpp(__builtin_bit_cast(int, x), CTRL, 0xf, 0xf, true)); }
__device__ __forceinline__ float xhalf_sum(float v) { const auto t = __builtin_amdgcn_permlane32_swap(__float_as_uint(v), __float_as_uint(v), false, false); return __uint_as_float(t[0]) + __uint_as_float(t[1]); }
__device__ __forceinline__ float xhalf_max(float v) { const auto t = __builtin_amdgcn_permlane32_swap(__float_as_uint(v), __float_as_uint(v), false, false); return fmaxf(__uint_as_float(t[0]), __uint_as_float(t[1])); }
__device__ __forceinline__ float wave_sum(float v) {
    v += dppf<0xB1>(v); v += dppf<0x4E>(v); v += dppf<0x141>(v); v += dppf<0x140>(v);
    const auto s = __builtin_amdgcn_permlane16_swap(__float_as_uint(v), __float_as_uint(v), false, false);
    v = __uint_as_float(s[0]) + __uint_as_float(s[1]);
    return xhalf_sum(v);
}
template <int N> __device__ __forceinline__ void wave_sum_n(float (&v)[N]) {
#pragma unroll
    for (int i = 0; i < N; ++i) v[i] += dppf<0xB1>(v[i]);
#pragma unroll
    for (int i = 0; i < N; ++i) v[i] += dppf<0x4E>(v[i]);
#pragma unroll
    for (int i = 0; i < N; ++i) v[i] += dppf<0x141>(v[i]);
#pragma unroll
    for (int i = 0; i < N; ++i) v[i] += dppf<0x140>(v[i]);
#pragma unroll
    for (int i = 0; i < N; ++i) { const auto s = __builtin_amdgcn_permlane16_swap(__float_as_uint(v[i]), __float_as_uint(v[i]), false, false); v[i] = __uint_as_float(s[0]) + __uint_as_float(s[1]); }
#pragma unroll
    for (int i = 0; i < N; ++i) v[i] = xhalf_sum(v[i]);
}
__device__ __forceinline__ int crow(int r, int hi) { return (r & 3) + 8 * (r >> 2) + 4 * hi; }

#define XB_TMO      128
#define XB_XCNT(j)  (256  + 64 * (j))
#define XB_XSUB(j)  (1280 + 64 * (j))
#define XB_XGEN(j)  (2304 + 64 * (j))
#define XB_TOP      3328
#define XB_TOPGEN   3392
#define XCD_BAR_WORDS 3456
#define XB_SPIN_CAP (1u << 18)
__device__ __forceinline__ unsigned xb_ld(unsigned* p)              { return __hip_atomic_load(p, __ATOMIC_RELAXED, __HIP_MEMORY_SCOPE_AGENT); }
__device__ __forceinline__ unsigned xb_add(unsigned* p, unsigned v) { return __hip_atomic_fetch_add(p, v, __ATOMIC_RELAXED, __HIP_MEMORY_SCOPE_AGENT); }
__device__ __forceinline__ unsigned xb_xcc_id() { return (unsigned)__builtin_amdgcn_s_getreg((3 << 11) | 20) & 0xFu; }
#define XB_SPIN(cond, bar) do { unsigned _sp = 0; while (cond) { __builtin_amdgcn_s_sleep(1); \
    if ((++_sp & 255u) == 0u) { if (xb_ld(&(bar)[XB_TMO])) break; if (_sp > XB_SPIN_CAP) { atomicAdd(&(bar)[XB_TMO], 1u); break; } } } } while (0)
struct XcdBarrier { unsigned* bar; unsigned x; volatile LAS unsigned* st; };
__device__ __forceinline__ XcdBarrier xcd_barrier_post(unsigned* bar, volatile LAS unsigned* st) {
    XcdBarrier b; b.bar = bar; b.x = xb_xcc_id(); b.st = st;
    if (threadIdx.x == 0) (void)xb_add(&bar[XB_XCNT(b.x)], 1u);
    return b;
}
__device__ __forceinline__ void xcd_barrier_complete(unsigned* bar, unsigned x, unsigned& nloc, unsigned& nx) {
    const unsigned G = gridDim.x * gridDim.y * gridDim.z;
    unsigned sum, cnt, mine, sp = 0u;
    for (;;) {
        sum = 0u; cnt = 0u; mine = 0u;
#pragma unroll
        for (unsigned j = 0; j < 16; ++j) { const unsigned c = xb_ld(&bar[XB_XCNT(j)]); sum += c; cnt += (c > 0u) ? 1u : 0u; mine = (j == x) ? c : mine; }
        if (sum == G) break;
        __builtin_amdgcn_s_sleep(1);
        if ((++sp & 255u) == 0u) { if (xb_ld(&bar[XB_TMO])) break; if (sp > XB_SPIN_CAP) { atomicAdd(&bar[XB_TMO], 1u); break; } }
    }
    nloc = mine > 0u ? mine : 1u; nx = cnt > 0u ? cnt : 1u;
}
__device__ __forceinline__ void xcd_barrier(const XcdBarrier& b) {
    asm volatile("s_waitcnt vmcnt(0)" ::: "memory");
    __syncthreads();
    if (threadIdx.x == 0) {
        unsigned* bar = b.bar;
        __builtin_amdgcn_s_waitcnt(0);
        unsigned nloc = b.st[0], nx = b.st[1];
        if (nloc == 0u) { xcd_barrier_complete(bar, b.x, nloc, nx); b.st[0] = nloc; b.st[1] = nx; }
        const unsigned old = xb_add(&bar[XB_XSUB(b.x)], 1u);
        const unsigned gen = old / nloc;
        if (old + 1u == (gen + 1u) * nloc) {
            __builtin_amdgcn_fence(__ATOMIC_RELEASE, "agent");
            asm volatile("s_waitcnt vmcnt(0)" ::: "memory");
            const unsigned og = xb_add(&bar[XB_TOP], 1u);
            const unsigned tg = og / nx;
            if (og + 1u == (tg + 1u) * nx) xb_add(&bar[XB_TOPGEN], 1u);
            else XB_SPIN(xb_ld(&bar[XB_TOPGEN]) == tg, bar);
            __builtin_amdgcn_fence(__ATOMIC_ACQUIRE, "agent");
            xb_add(&bar[XB_XGEN(b.x)], 1u);
            asm volatile("s_waitcnt vmcnt(0)" ::: "memory");
        } else {
            XB_SPIN(xb_ld(&bar[XB_XGEN(b.x)]) == gen, bar);
            __builtin_amdgcn_fence(__ATOMIC_ACQUIRE, "agent");
            asm volatile("s_waitcnt vmcnt(0)" ::: "memory");
        }
    }
    __syncthreads();
}

namespace pg8 {
constexpr int BM = 256, BK = 64, HALF = 128, HTB = HALF * BK * 2, STAGE_BYTES = 8 * HTB, NXCD = 8, WGM = 8;
__host__ __device__ __forceinline__ int lds_byte(int r, int c) { const int st = (r >> 4) * 2 + (c >> 5), rr = r & 15, cc = c & 31, ob = rr * 64 + cc * 2; return st * 1024 + (ob ^ (((ob >> 9) & 1) << 5)); }
__host__ __device__ __forceinline__ void stage_rc(int b, int& R, int& C) { const int st = b / 1024, sb = b % 1024, swz = sb ^ (((sb >> 9) & 1) << 5); R = (st >> 1) * 16 + swz / 64; C = (st & 1) * 32 + (swz % 64) / 2; }
__host__ __device__ __forceinline__ int perm32(int rho) { const int n = rho >> 4, i = rho & 15; return 8 * (i >> 2) + 4 * n + (i & 3); }

#ifndef PROBE_P1
#define PROBE_P1 0
#endif
struct Unit { int pm, pn, pb;
#if PROBE_P1
    int fl;
#endif
};
struct Gemm { const bf16* A; const bf16* Bt; int K; const int* gidx; };

__device__ __forceinline__ int xcd_remap(int wgid, int nwg) { const int q = nwg / NXCD, r = nwg % NXCD, xcd = wgid % NXCD, off = wgid / NXCD; return (xcd < r ? xcd * (q + 1) : r * (q + 1) + (xcd - r) * q) + off; }
struct StaticOrder {
    int nM, nN, nwg, G, c, rep;
    __device__ void init(int M, int N, int G_, int c_, int rep_ = 1) { nM = M / BM; nN = N / BM; nwg = nM * nN; G = G_; c = c_; rep = rep_; }
    __device__ bool next(int i, Unit& u) const {
        long L = (long)i * G + c; if (L >= (long)nwg * rep) return false;
#if PROBE_P1
        u.fl = (rep > 1 && L < nwg) ? 1 : 0;
#endif
        L %= nwg;
        const int wgid = xcd_remap((int)L, nwg);
        const int nig = WGM * nN, gid = wgid / nig, fm = gid * WGM, gsz = (nM - fm) < WGM ? (nM - fm) : WGM;
        u.pm = fm + ((wgid % nig) % gsz); u.pn = (wgid % nig) / gsz; u.pb = u.pn; return true;
    }
};
struct GroupedOrder {
    const int* tile_e; int ntiles, npn, G, c;
    __device__ bool next(int i, Unit& u) const {
        const long L = (long)i * G + c; const int nwg = ntiles * npn; if (L >= nwg) return false;
        const int wgid = xcd_remap((int)L, nwg);
        u.pm = wgid / npn; u.pn = wgid % npn; u.pb = tile_e[u.pm] * npn + u.pn;
#if PROBE_P1
        u.fl = 0;
#endif
        return true;
    }
};

__device__ __forceinline__ unsigned cvt_pk_bf16(float lo, float hi) { unsigned r; asm volatile("v_cvt_pk_bf16_f32 %0, %1, %2" : "=v"(r) : "v"(lo), "v"(hi)); return r; }

template <int STM> struct EpiPlainT {
    static constexpr bool PERM = true;
    bf16* O; int ldc; const float* ssq; int ssq_n; float ssq_inv; float eps;
    LAS unsigned char* xl;
    __device__ __forceinline__ void operator()(const f32x4 (&acc)[2][2][4][2], const Unit& u, int wr, int wc, int fr, int fq) const {
        const int lane = fq * 16 + fr; LAS unsigned char* t = xl + (wr * 4 + wc) * 2048;
        const int wsw = fr & 7, rrow = lane >> 3, rch = lane & 7;
#pragma unroll
        for (int ai = 0; ai < 2; ++ai)
#pragma unroll
            for (int m = 0; m < 4; ++m) { const int rowb = u.pm * BM + ai * HALF + wr * 64 + m * 16;
                float sc = 1.f;
                if (ssq) { const f32x4 p = *(const f32x4*)(ssq + (size_t)(rowb + fr) * ssq_n); sc = __builtin_amdgcn_rsqf((p[0] + p[1] + p[2] + p[3]) * ssq_inv + eps); }
#pragma unroll
                for (int bj = 0; bj < 2; ++bj) { const f32x4 v0 = acc[ai][bj][m][0] * sc, v1 = acc[ai][bj][m][1] * sc;
                    u32x4 w; w.x = cvt_pk_bf16(v0[0], v0[1]); w.y = cvt_pk_bf16(v0[2], v0[3]); w.z = cvt_pk_bf16(v1[0], v1[1]); w.w = cvt_pk_bf16(v1[2], v1[3]);
                    *(LAS u32x4*)(t + fr * 128 + 16 * ((4 * bj + fq) ^ wsw)) = w; }
#pragma unroll
                for (int i = 0; i < 2; ++i) { const int rr = 8 * i + rrow;
                    const u32x4 w = *(const LAS u32x4*)(t + rr * 128 + 16 * (rch ^ (rr & 7)));
                    stg16<STM>(O + (size_t)(rowb + rr) * ldc + u.pn * BM + wc * 64 + 8 * rch, w); }
            }
    }
};
template <int STM> struct EpiFp8T {
    static constexpr bool PERM = true;
    unsigned char* O; int ldc; float scale; LAS unsigned char* xl;
    __device__ __forceinline__ void operator()(const f32x4 (&acc)[2][2][4][2], const Unit& u, int wr, int wc, int fr, int fq) const {
        const int lane = fq * 16 + fr; LAS unsigned char* t = xl + (wr * 4 + wc) * 2048;
        const int rrow = lane >> 2, rch = lane & 3;
#pragma unroll
        for (int ai = 0; ai < 2; ++ai)
#pragma unroll
            for (int m = 0; m < 4; ++m) { const int rowb = u.pm * BM + ai * HALF + wr * 64 + m * 16;
#pragma unroll
                for (int bj = 0; bj < 2; ++bj) { f32x4 v0 = acc[ai][bj][m][0] * scale, v1 = acc[ai][bj][m][1] * scale;
#pragma unroll
                    for (int e = 0; e < 4; ++e) { v0[e] = __builtin_amdgcn_fmed3f(v0[e], -448.f, 448.f); v1[e] = __builtin_amdgcn_fmed3f(v1[e], -448.f, 448.f); }
                    int lo = __builtin_amdgcn_cvt_pk_fp8_f32(v0[0], v0[1], 0, false); lo = __builtin_amdgcn_cvt_pk_fp8_f32(v0[2], v0[3], lo, true);
                    int hi = __builtin_amdgcn_cvt_pk_fp8_f32(v1[0], v1[1], 0, false); hi = __builtin_amdgcn_cvt_pk_fp8_f32(v1[2], v1[3], hi, true);
                    *(LAS u32x2*)(t + fr * 64 + 32 * bj + 8 * fq) = (u32x2){(unsigned)lo, (unsigned)hi}; }
                const u32x4 w = *(const LAS u32x4*)(t + lane * 16);
                stg16<STM>(O + (size_t)(rowb + rrow) * ldc + u.pn * BM + wc * 64 + 16 * rch, w); }
    }
};
__device__ __forceinline__ f32x4 fp8x4_to_f32(unsigned w) { const f32x2 a = __builtin_amdgcn_cvt_pk_f32_fp8((int)w, false), b = __builtin_amdgcn_cvt_pk_f32_fp8((int)w, true); return (f32x4){a.x, a.y, b.x, b.y}; }
template <int STM> struct EpiGateUpT {
    static constexpr bool PERM = true;
    bf16* H; const float* sw;
    __device__ __forceinline__ void operator()(const f32x4 (&acc)[2][2][4][2], const Unit& u, int wr, int wc, int fr, int fq) const {
        const int row0 = u.pm * BM + wr * 64 + fr; const int col0 = u.pn * HALF + wc * 32 + 8 * fq;
#pragma unroll
        for (int ai = 0; ai < 2; ++ai)
#pragma unroll
            for (int m = 0; m < 4; ++m) { const int row = row0 + ai * HALF + m * 16; const float w = sw[row]; f32x4 hv[2];
#pragma unroll
                for (int n = 0; n < 2; ++n) { const f32x4 g = acc[ai][0][m][n], up = acc[ai][1][m][n];
#pragma unroll
                    for (int e = 0; e < 4; ++e) { const float sg = g[e] * __builtin_amdgcn_rcpf(1.0f + __builtin_amdgcn_exp2f(-g[e] * LOG2E)); hv[n][e] = sg * up[e] * w; } }
                u32x4 o; o.x = cvt_pk_bf16(hv[0][0], hv[0][1]); o.y = cvt_pk_bf16(hv[0][2], hv[0][3]); o.z = cvt_pk_bf16(hv[1][0], hv[1][1]); o.w = cvt_pk_bf16(hv[1][2], hv[1][3]);
                stg16<STM>(H + (size_t)row * FH + col0, o); }
    }
};

enum { GK_SKIP = 0, GK_PLAIN = 1, GK_ROPE32 = 2, GK_HEAD16 = 3, GK_IDX8 = 4, GK_WI = 5 };
struct GroupDesc { int kind; bf16* dst; int pitch; int col; float scale; int perm; float* ssq; int ssq_n; int ssq_i; };
struct RopeTabs { const int* pos; };
__device__ __forceinline__ int perm_row(int row, int perm) {
    if (perm == 0) return row; const int b = row >> 11, s = row & 2047;
    return perm == 4 ? (b << 11) + ((s & 3) << 9) + (s >> 2) : (b << 11) + ((s & 15) << 7) + (s >> 4);
}
__device__ __forceinline__ void st16(bf16* p, u32x2 a, u32x2 b) { u32x4 w; w.x = a.x; w.y = a.y; w.z = b.x; w.w = b.y; stg16<NT_EPI>(p, w); }
__device__ __forceinline__ u32x2 pk4(f32x4 v) { u32x2 w; w.x = cvt_pk_bf16(v[0], v[1]); w.y = cvt_pk_bf16(v[2], v[3]); return w; }
__device__ __forceinline__ void swap16(u32x2& X, u32x2& Y) {
    const auto a = __builtin_amdgcn_permlane16_swap(X.x, Y.x, false, false); const auto b = __builtin_amdgcn_permlane16_swap(X.y, Y.y, false, false);
    X.x = a[0]; Y.x = a[1]; X.y = b[0]; Y.y = b[1];
}
__device__ __forceinline__ float rope_k(int i, int rd) { return __builtin_amdgcn_exp2f(-18.931568569324174f * (float)(2 * i) / (float)rd) * 0.15915494309189535f; }
__device__ __forceinline__ void rope_cs(float posf, int i0, int rd, f32x4& c, f32x4& s) {
#pragma unroll
    for (int e = 0; e < 4; ++e) { const float f = __builtin_amdgcn_fractf(posf * rope_k(i0 + e, rd)); s[e] = __builtin_amdgcn_sinf(f); c[e] = __builtin_amdgcn_cosf(f); }
}
template <class DescFn> struct EpiGroups {
    static constexpr bool PERM = true;
    DescFn F; RopeTabs R; const float* rs_ssq; int rs_n; float rs_inv, rs_eps;
    __device__ __forceinline__ void operator()(const f32x4 (&acc)[2][2][4][2], const Unit& u, int wr, int wc, int fr, int fq) const {
        const int row0 = u.pm * BM + wr * 64 + fr;
#pragma unroll
        for (int bj = 0; bj < 2; ++bj) {
            const GroupDesc d = F(u.pn, bj, wc);
            if (d.kind == GK_SKIP) continue;
#if PROBE_P1 == 1
            if (u.fl) continue;
#endif
            const int ki0 = d.kind == GK_ROPE32 ? 4 * fq : (d.kind == GK_HEAD16 ? 4 * (fq & 1) : 0), krd = d.kind == GK_ROPE32 ? 32 : (d.kind == GK_HEAD16 ? 16 : 8);
#pragma unroll
            for (int ai = 0; ai < 2; ++ai)
#pragma unroll
                for (int m = 0; m < 4; ++m) {
                    const int row = row0 + ai * HALF + m * 16;
                    float sc = d.scale;
                    if (rs_ssq) { float s = 0.f; for (int i = 0; i < rs_n; ++i) s += rs_ssq[(size_t)row * rs_n + i]; sc *= __builtin_amdgcn_rsqf(s * rs_inv + rs_eps); }
                    f32x4 v0 = acc[ai][bj][m][0], v1 = acc[ai][bj][m][1];
                    if (d.ssq) {
                        float q = (v0[0] * v0[0] + v0[1] * v0[1]) + (v0[2] * v0[2] + v0[3] * v0[3]) + (v1[0] * v1[0] + v1[1] * v1[1]) + (v1[2] * v1[2] + v1[3] * v1[3]);
                        q += __shfl_xor(q, 16); q += __shfl_xor(q, 32);
                        if (fq == 0) d.ssq[(size_t)row * d.ssq_n + d.ssq_i] = q;
                    }
                    v0 = v0 * sc; v1 = v1 * sc;
                    if (d.kind == GK_WI) { if (fq == 0) { float* wp = (float*)d.dst + (size_t)row * 8; *(f32x4*)wp = v0; *(f32x4*)(wp + 4) = v1; } continue; }
                    bf16* rp = d.dst + (size_t)perm_row(row, d.perm) * d.pitch + d.col;
                    if (d.kind == GK_PLAIN) { st16(rp + 8 * fq, pk4(v0), pk4(v1)); }
                    else if (d.kind == GK_IDX8) {
                        f32x4 c, s; rope_cs((float)R.pos[row], ki0, krd, c, s);
                        const f32x4 o1 = fq == 0 ? v0 * c - v1 * s : v0, o2 = fq == 0 ? v1 * c + v0 * s : v1;
                        st16(rp + 8 * fq, pk4(o1), pk4(o2));
                    } else if (d.kind == GK_ROPE32) {
                        f32x4 c, s; rope_cs((float)R.pos[row], ki0, krd, c, s);
                        u32x2 X = pk4(v0 * c - v1 * s), Y = pk4(v1 * c + v0 * s);
                        swap16(X, Y);
                        st16(rp + ((fq & 1) ? 16 + 4 * (fq - 1) : 4 * fq), X, Y);
                    } else {
                        f32x4 c, s; rope_cs((float)R.pos[row], ki0, krd, c, s);
                        u32x2 X = pk4(fq < 2 ? v0 * c - v1 * s : v0), Y = pk4(fq < 2 ? v1 * c + v0 * s : v1);
                        swap16(X, Y);
                        st16(rp + 16 * (fq >> 1) + 8 * (fq & 1), X, Y);
                    }
                }
        }
    }
};

template <class Epi, class Sched, bool GATHER, int LDA = 0>
__device__ __forceinline__ void gemm_phase(LAS unsigned char* lds, const Gemm g, const Sched& S, const Epi& E, const int tid) {
    const int wid = __builtin_amdgcn_readfirstlane(tid >> 6), lane = tid & 63, wr = wid >> 2, wc = wid & 3, fr = lane & 15, fq = lane >> 4;
    const int K = g.K, nt = K / BK, lda = LDA ? LDA : K;
    unsigned voA[2][2], voB[2]; int RA[2], CA[2];
#pragma unroll
    for (int i = 0; i < 2; ++i) { int R, C; stage_rc(tid * 16 + i * 8192, R, C); const int Rb = Epi::PERM ? ((R & ~31) + perm32(R & 31)) : R;
        RA[i] = R; CA[i] = C; voA[0][i] = (unsigned)(R * lda + C) * 2u; voA[1][i] = (unsigned)((R + HALF) * lda + C) * 2u; voB[i] = (unsigned)(Rb * K + C) * 2u; }
    const size_t kstep = (size_t)(BK * 2);
    const size_t hstep = (size_t)HALF * K * 2;
    const size_t tstep = 2 * hstep;
    const size_t tstepA = (size_t)BM * lda * 2;
    const unsigned ldsw = (unsigned)wid * 1024u;
    const int aoff = lds_byte(wr * 64 + fr, fq * 8), boff = lds_byte(wc * 32 + fr, fq * 8);
#define PG8_SA(b, h) (((b) * 2 + (h)) * HTB)
#define PG8_SB(b, h) ((4 + (b) * 2 + (h)) * HTB)
#define PG8_STAGE(bufoff, gbase, voff) do { _Pragma("unroll") for (int _i = 0; _i < 2; ++_i) \
        __builtin_amdgcn_global_load_lds((const unsigned*)((const char*)(gbase) + (voff)[_i]), (LAS unsigned*)(lds + (bufoff) + ldsw + _i * 8192), 16, 0, 0); } while (0)
#define PG8_LDA(dst, b, h) do { _Pragma("unroll") for (int m = 0; m < 4; ++m) _Pragma("unroll") for (int k = 0; k < 2; ++k) dst[m][k] = *(const LAS bf16x8*)(lds + PG8_SA(b, h) + aoff + m * 2048 + k * 1024); } while (0)
#define PG8_LDB(dst, b, h) do { _Pragma("unroll") for (int n = 0; n < 2; ++n) _Pragma("unroll") for (int k = 0; k < 2; ++k) dst[n][k] = *(const LAS bf16x8*)(lds + PG8_SB(b, h) + boff + n * 2048 + k * 1024); } while (0)
#define PG8_MMA(ai, bj, At, Bt) do { __builtin_amdgcn_s_setprio(1); _Pragma("unroll") for (int m = 0; m < 4; ++m) _Pragma("unroll") for (int n = 0; n < 2; ++n) _Pragma("unroll") for (int k = 0; k < 2; ++k) \
        acc[ai][bj][m][n] = __builtin_amdgcn_mfma_f32_16x16x32_bf16(Bt[n][k], At[m][k], acc[ai][bj][m][n], 0, 0, 0); __builtin_amdgcn_s_setprio(0); } while (0)
#define PG8_WAIT_V(n) asm volatile("s_waitcnt vmcnt(" #n ")" ::: "memory")
#define PG8_WAIT_L(n) asm volatile("s_waitcnt lgkmcnt(" #n ")" ::: "memory")
#define PG8_BAR __builtin_amdgcn_s_barrier()
#define PG8_SCHED __builtin_amdgcn_sched_barrier(0)
    Unit cur, nxt; int ui = 0;
    if (!S.next(0, cur)) return;
    f32x4 acc[2][2][4][2];
#pragma unroll
    for (int a = 0; a < 2; ++a)
#pragma unroll
        for (int b = 0; b < 2; ++b)
#pragma unroll
            for (int m = 0; m < 4; ++m)
#pragma unroll
                for (int n = 0; n < 2; ++n) acc[a][b][m][n] = (f32x4){0.f, 0.f, 0.f, 0.f};
    bf16x8 At[4][2], B0[2][2], B1[2][2];
    unsigned nvA[2][2];
    const char* cA; const char* cB = (const char*)g.Bt + (size_t)cur.pb * tstep;
    if constexpr (GATHER) { cA = (const char*)g.A;
#pragma unroll
        for (int h = 0; h < 2; ++h)
#pragma unroll
            for (int i = 0; i < 2; ++i) voA[h][i] = (unsigned)g.gidx[cur.pm * BM + h * HALF + RA[i]] * (unsigned)(lda * 2) + (unsigned)CA[i] * 2u;
    } else cA = (const char*)g.A + (size_t)cur.pm * tstepA;
    PG8_STAGE(PG8_SB(0, 0), cB, voB); PG8_STAGE(PG8_SB(0, 1), cB + hstep, voB); PG8_STAGE(PG8_SA(0, 0), cA, voA[0]); PG8_STAGE(PG8_SA(0, 1), cA, voA[1]);
    if (wr == 1) PG8_BAR;
    PG8_WAIT_V(2); PG8_BAR;
    PG8_STAGE(PG8_SB(1, 0), cB + kstep, voB); PG8_STAGE(PG8_SA(1, 0), cA + kstep, voA[0]); PG8_STAGE(PG8_SB(1, 1), cB + hstep + kstep, voB);
    PG8_WAIT_V(6); PG8_BAR;
    for (;;) {
        const bool has_next = S.next(ui + 1, nxt);
        const char* nA; const char* nB = has_next ? (const char*)g.Bt + (size_t)nxt.pb * tstep : cB;
        if constexpr (GATHER) { nA = cA;
#pragma unroll
            for (int h = 0; h < 2; ++h)
#pragma unroll
                for (int i = 0; i < 2; ++i) nvA[h][i] = has_next ? (unsigned)g.gidx[nxt.pm * BM + h * HALF + RA[i]] * (unsigned)(lda * 2) + (unsigned)CA[i] * 2u : voA[h][i];
        } else nA = has_next ? (const char*)g.A + (size_t)nxt.pm * tstepA : cA;
#if PROBE_P1 == 2
        const int ntu = cur.fl ? 2 : nt;
#else
        const int ntu = nt;
#endif
#pragma nounroll
        for (int t = 0; t < ntu; t += 2) {
            const bool last = (t == ntu - 2);
            const char* a1 = cA + (size_t)(t + 1) * kstep;
            const char* a2 = last ? nA : cA + (size_t)(t + 2) * kstep; const char* b2 = last ? nB : cB + (size_t)(t + 2) * kstep;
            const char* a3 = a2 + kstep; const char* b3 = b2 + kstep;
            unsigned xA[2][2];
#pragma unroll
            for (int h = 0; h < 2; ++h)
#pragma unroll
                for (int i = 0; i < 2; ++i) xA[h][i] = (GATHER && last) ? nvA[h][i] : voA[h][i];
            PG8_LDB(B0, 0, 0); PG8_LDB(B1, 0, 1); PG8_SCHED; PG8_LDA(At, 0, 0); PG8_STAGE(PG8_SA(1, 1), a1, voA[1]);
            PG8_WAIT_V(8); PG8_WAIT_L(0); PG8_BAR; PG8_MMA(0, 0, At, B0); PG8_MMA(0, 1, At, B1); PG8_BAR; PG8_SCHED;
            PG8_LDA(At, 0, 1); PG8_STAGE(PG8_SB(0, 0), b2, voB); PG8_STAGE(PG8_SB(0, 1), b2 + hstep, voB); PG8_STAGE(PG8_SA(0, 0), a2, xA[0]);
            PG8_WAIT_V(8); PG8_WAIT_L(0); PG8_BAR; PG8_MMA(1, 0, At, B0); PG8_MMA(1, 1, At, B1); PG8_BAR; PG8_SCHED;
            PG8_LDB(B0, 1, 0); PG8_LDB(B1, 1, 1); PG8_SCHED; PG8_LDA(At, 1, 0); PG8_STAGE(PG8_SA(0, 1), a2, xA[1]);
            PG8_WAIT_V(8); PG8_WAIT_L(0); PG8_BAR; PG8_MMA(0, 0, At, B0); PG8_MMA(0, 1, At, B1); PG8_BAR; PG8_SCHED;
            PG8_LDA(At, 1, 1); PG8_STAGE(PG8_SB(1, 0), b3, voB); PG8_STAGE(PG8_SB(1, 1), b3 + hstep, voB); PG8_STAGE(PG8_SA(1, 0), a3, xA[0]);
            PG8_WAIT_V(8); PG8_WAIT_L(0); PG8_BAR; PG8_MMA(1, 0, At, B0); PG8_MMA(1, 1, At, B1); PG8_BAR; PG8_SCHED;
        }
        if (wr == 0) PG8_BAR;
        E(acc, cur, wr, wc, fr, fq);
        if (!has_next) break;
#pragma unroll
        for (int a = 0; a < 2; ++a)
#pragma unroll
            for (int b = 0; b < 2; ++b)
#pragma unroll
                for (int m = 0; m < 4; ++m)
#pragma unroll
                    for (int n = 0; n < 2; ++n) acc[a][b][m][n] = (f32x4){0.f, 0.f, 0.f, 0.f};
        cur = nxt; cA = nA; cB = nB; ++ui;
        if constexpr (GATHER) {
#pragma unroll
            for (int h = 0; h < 2; ++h)
#pragma unroll
                for (int i = 0; i < 2; ++i) voA[h][i] = nvA[h][i];
        }
        if (wr == 1) PG8_BAR;
    }
    PG8_WAIT_V(0);
    PG8_BAR;
#undef PG8_SA
#undef PG8_SB
#undef PG8_STAGE
#undef PG8_LDA
#undef PG8_LDB
#undef PG8_MMA
#undef PG8_WAIT_V
#undef PG8_WAIT_L
#undef PG8_BAR
#undef PG8_SCHED
}
}

#ifndef PROBE_LDS2
#define PROBE_LDS2 0
#endif
#ifndef PROBE_EXP2
#define PROBE_EXP2 0
#endif
#ifndef SOFTMAX_PK
#define SOFTMAX_PK 0
#endif
#ifndef ATT_FUSE2
#define ATT_FUSE2 1
#endif
#ifndef FA_FUSE
#define FA_FUSE 0
#endif
namespace fa {
constexpr int VBYTES_T = 64 * 128;
typedef short v4i16_t __attribute__((ext_vector_type(4)));
__device__ __forceinline__ u32x2 vtr(const LAS unsigned char* p) { return __builtin_bit_cast(u32x2, __builtin_amdgcn_ds_read_tr16_b64_v4i16((LAS v4i16_t*)p)); }
__device__ __forceinline__ float max16(const f32x16& c) { float r;
    asm("v_max3_f32 %0, %1, %2, %3\n\tv_max3_f32 %0, %0, %4, %5\n\tv_max3_f32 %0, %0, %6, %7\n\tv_max3_f32 %0, %0, %8, %9\n\tv_max3_f32 %0, %0, %10, %11\n\tv_max3_f32 %0, %0, %12, %13\n\tv_max3_f32 %0, %0, %14, %15\n\tv_max_f32 %0, %0, %16"
        : "=&v"(r) : "v"(c[0]), "v"(c[1]), "v"(c[2]), "v"(c[3]), "v"(c[4]), "v"(c[5]), "v"(c[6]), "v"(c[7]), "v"(c[8]), "v"(c[9]), "v"(c[10]), "v"(c[11]), "v"(c[12]), "v"(c[13]), "v"(c[14]), "v"(c[15]));
    return r; }
__device__ __forceinline__ void mask_init(f32x16& S, unsigned nw) { float t0, t1, t2, t3, t4, t5, t6, t7, t8, t9, t10, t11, t12, t13, t14, t15;
    asm("v_bfe_i32 %0, %16, 0, 1\n\tv_lshlrev_b32 %0, 23, %0\n\tv_bfe_i32 %1, %16, 1, 1\n\tv_lshlrev_b32 %1, 23, %1\n\tv_bfe_i32 %2, %16, 2, 1\n\tv_lshlrev_b32 %2, 23, %2\n\tv_bfe_i32 %3, %16, 3, 1\n\tv_lshlrev_b32 %3, 23, %3\n\tv_bfe_i32 %4, %16, 8, 1\n\tv_lshlrev_b32 %4, 23, %4\n\tv_bfe_i32 %5, %16, 9, 1\n\tv_lshlrev_b32 %5, 23, %5\n\tv_bfe_i32 %6, %16, 10, 1\n\tv_lshlrev_b32 %6, 23, %6\n\tv_bfe_i32 %7, %16, 11, 1\n\tv_lshlrev_b32 %7, 23, %7\n\tv_bfe_i32 %8, %16, 16, 1\n\tv_lshlrev_b32 %8, 23, %8\n\tv_bfe_i32 %9, %16, 17, 1\n\tv_lshlrev_b32 %9, 23, %9\n\tv_bfe_i32 %10, %16, 18, 1\n\tv_lshlrev_b32 %10, 23, %10\n\tv_bfe_i32 %11, %16, 19, 1\n\tv_lshlrev_b32 %11, 23, %11\n\tv_bfe_i32 %12, %16, 24, 1\n\tv_lshlrev_b32 %12, 23, %12\n\tv_bfe_i32 %13, %16, 25, 1\n\tv_lshlrev_b32 %13, 23, %13\n\tv_bfe_i32 %14, %16, 26, 1\n\tv_lshlrev_b32 %14, 23, %14\n\tv_bfe_i32 %15, %16, 27, 1\n\tv_lshlrev_b32 %15, 23, %15"
        : "=&v"(t0), "=&v"(t1), "=&v"(t2), "=&v"(t3), "=&v"(t4), "=&v"(t5), "=&v"(t6), "=&v"(t7), "=&v"(t8), "=&v"(t9), "=&v"(t10), "=&v"(t11), "=&v"(t12), "=&v"(t13), "=&v"(t14), "=&v"(t15) : "v"(nw));
    S[0] = t0; S[1] = t1; S[2] = t2; S[3] = t3; S[4] = t4; S[5] = t5; S[6] = t6; S[7] = t7; S[8] = t8; S[9] = t9; S[10] = t10; S[11] = t11; S[12] = t12; S[13] = t13; S[14] = t14; S[15] = t15; }
template <int LO, int HI> __device__ __forceinline__ void sm_piece(f32x16& c0, f32x16& c1, const float ms, float& ls) {
#pragma unroll
    for (int e = LO; e < HI; ++e) { if (e < 16) { c0[e] = __builtin_amdgcn_exp2f(c0[e] - ms); ls += c0[e]; } else { c1[e - 16] = __builtin_amdgcn_exp2f(c1[e - 16] - ms); ls += c1[e - 16]; } }
}
struct Params {
    const bf16* Q;  int q_pitch;
    const bf16* K1; int k1_pitch, k1_col;
    const bf16* K2; int k2_pitch, k2_col;
    const bf16* V;  int v_pitch, v_col;
    bf16* O; int o_pitch;
    float* LSE; int lse_pitch;
    const unsigned* BM;
    int CL, W;
};
struct UnitDesc { int seq0, qw, q_col, o_col, lse_col, k1_col, v_col, kt_lo, kt_hi; };
template <int DQK, int MODE, int NH, class DescFn>
__device__ __forceinline__ void attn_stream(const Params& P, LAS unsigned char* lds, const int tid, const int n_units, DescFn desc) {
    constexpr int NKS = DQK / 16, AHEAD = (NH == 2 ? 3 : 4), NST = AHEAD + 1, K1B = 8192 * NH, K2B = (DQK == 96 ? 4096 : 0), BMOFF = K1B + K2B + 8192 * NH, STB = BMOFF + (MODE == 1 ? 8192 : 0);
    constexpr int NDMA = 2 * NH + (DQK == 96 ? 1 : 0) + (MODE == 1 ? 1 : 0);
    static_assert(NH == 1 || (DQK == 64 && MODE != 1), "two-head stages: head dim 64 only");
    constexpr bool active = true;
    if (n_units <= 0) return;
    const int lane = tid & 63, r = lane & 31, h = lane >> 5, wave = __builtin_amdgcn_readfirstlane(tid >> 6);
    const int tq_ = (lane & 15) >> 2, tp_ = lane & 3, tg_ = lane >> 4;
    const int hsel = NH == 2 ? (wave >> 2) * 8192 : 0;
    const int vtoff = K1B + K2B + hsel + (4 * h + tq_) * 128, vxb = 2 * (16 * (tg_ & 1) + 4 * tp_), vsw = (tq_ >> 1) & 1;
    const int vx0 = vxb + ((0 ^ vsw) << 6), vx1 = vxb + ((1 ^ vsw) << 6);
    const int s1_ = (r >> 1) & 7, s2_ = (r >> 2) & 3;
    const int k1row = hsel + r * 128, k2row = K1B + r * 64;
    const int row1 = 8 * wave + (lane >> 3), row2 = 16 * (wave & 3) + (lane >> 2);
    const size_t tk1 = (size_t)64 * P.k1_pitch, tk2 = (size_t)64 * P.k2_pitch, tv = (size_t)64 * P.v_pitch;
    const int d_k1 = wave * 1024, d_k2 = K1B + (wave & 3) * 1024, d_v = K1B + K2B + wave * 1024;
    const bf16* src_k1; const bf16* src_v; const bf16* src_k2 = nullptr; const unsigned* bmp = nullptr;
    int ji = -1, kti = 1, kti_hi = 0;
    auto fa_issue = [&](const int st) __attribute__((always_inline)) {
        if (kti > kti_hi) {
            if (ji + 1 < n_units) { ++ji; const UnitDesc t = desc(ji); kti = t.kt_lo; kti_hi = t.kt_hi;
                src_k1 = P.K1 + (size_t)(t.seq0 + row1) * P.k1_pitch + t.k1_col + 8 * ((lane & 7) ^ ((row1 >> 1) & 7));
                src_v = P.V + (size_t)(t.seq0 + row1) * P.v_pitch + t.v_col + 8 * ((lane & 7) ^ (((row1 >> 1) & 1) << 2));
                if constexpr (DQK == 96) src_k2 = P.K2 + (size_t)(t.seq0 + row2) * P.k2_pitch + P.k2_col + 8 * ((lane & 3) ^ ((row2 >> 2) & 3));
                if constexpr (MODE == 1) bmp = P.BM + (size_t)(t.seq0 + t.qw + r) * 64;
            } else kti = kti_hi; }
        LAS unsigned char* sb_ = lds + st * STB;
        __builtin_amdgcn_global_load_lds((const unsigned*)(src_k1 + kti * tk1), (LAS unsigned*)(sb_ + d_k1), 16, 0, 0);
        __builtin_amdgcn_global_load_lds((const unsigned*)(src_v + kti * tv), (LAS unsigned*)(sb_ + d_v), 16, 0, 0);
        if constexpr (NH == 2) {
            __builtin_amdgcn_global_load_lds((const unsigned*)(src_k1 + 64 + kti * tk1), (LAS unsigned*)(sb_ + d_k1 + 8192), 16, 0, 0);
            __builtin_amdgcn_global_load_lds((const unsigned*)(src_v + 64 + kti * tv), (LAS unsigned*)(sb_ + d_v + 8192), 16, 0, 0); }
        if constexpr (DQK == 96) __builtin_amdgcn_global_load_lds((const unsigned*)(src_k2 + kti * tk2), (LAS unsigned*)(sb_ + d_k2), 16, 0, 0);
        if constexpr (MODE == 1) __builtin_amdgcn_global_load_lds(bmp + (kti & ~1) * 2, (LAS unsigned*)(sb_ + BMOFF + wave * 1024), 16, 0, 0);
        ++kti; };
#define FA_ISSUE(TILE, ST) fa_issue(ST)
    int st_is = 0, st_c = 0, st_n = 1;
    bf16x8 qf[NKS];
#define FA_LOADQ(D) do { const bf16* qp_ = P.Q + (size_t)((D).seq0 + (D).qw + r) * P.q_pitch + (D).q_col + 8 * h; \
        _Pragma("unroll") for (int ks = 0; ks < NKS; ++ks) asm volatile("global_load_dwordx4 %0, %1, off offset:%2" : "=&v"(qf[ks]) : "v"(qp_), "n"(32 * ks) : "memory"); } while (0)
#define FA_WAITQ(N) do { if constexpr (NKS == 6) asm volatile("s_waitcnt vmcnt(%6)" : "+v"(qf[0]), "+v"(qf[1]), "+v"(qf[2]), "+v"(qf[3]), "+v"(qf[4]), "+v"(qf[5]) : "n"(N) : "memory"); \
        else asm volatile("s_waitcnt vmcnt(%4)" : "+v"(qf[0]), "+v"(qf[1]), "+v"(qf[2]), "+v"(qf[3]) : "n"(N) : "memory"); } while (0)
    { const UnitDesc d0 = desc(0); FA_LOADQ(d0); FA_WAITQ(0); }
#pragma unroll 1
    for (int ju = 0; ju < n_units; ++ju) {
    const UnitDesc du = desc(ju);
    const int seq0 = du.seq0, qw = du.qw, q_col = du.q_col, o_col = du.o_col, lse_col = du.lse_col, kt_lo = du.kt_lo, kt_hi = du.kt_hi;
    const int q = qw + r;
    const int lo_q = MODE == 0 ? max(q & ~(P.CL - 1), q - P.W) : 0;
    const int qh = q - 4 * h, lqh = lo_q - 4 * h;
    const int lo_w0 = MODE == 0 ? max(qw & ~(P.CL - 1), qw - P.W) : 0;
    const int lo_w1 = MODE == 0 ? max((qw + 31) & ~(P.CL - 1), qw + 31 - P.W) : 0;
#define FA_WAITBAR(N) do { asm volatile("s_waitcnt vmcnt(%0)" :: "n"(N) : "memory"); __builtin_amdgcn_s_barrier(); asm volatile("" ::: "memory"); } while (0)
    f32x16 o0, o1, c0, c1, n0, n1;
#pragma unroll
    for (int i = 0; i < 16; ++i) { o0[i] = 0.f; o1[i] = 0.f; c0[i] = 0.f; c1[i] = 0.f; n0[i] = 0.f; n1[i] = 0.f; }
    float m = -INFINITY, l = 0.f;
#define FA_PART(kt_) (active && (MODE == 0 ? ((kt_) * 64 <= qw + 31 && (kt_) * 64 + 63 >= lo_w0) : ((kt_) * 64 <= qw + 31)))
#define FA_KADDR(SB_, ROFF, ks) ((ks) < 4 ? (SB_) + (ROFF) * 128 + k1row + 16 * ((2 * (ks) + h) ^ s1_) : (SB_) + (ROFF) * 64 + k2row + 16 * ((2 * ((ks) - 4) + h) ^ s2_))
#define FA_QKH(S, SB_, ROFF, NW) do { bf16x8 fa_[NKS]; \
        _Pragma("unroll") for (int ks = 0; ks < NKS; ++ks) fa_[ks] = *(const LAS bf16x8*)FA_KADDR(SB_, ROFF, ks); \
        if (PROBE_LDS2) { _Pragma("unroll") for (int ks = 0; ks < NKS; ++ks) { const bf16x8 fb_ = *(const volatile LAS bf16x8*)FA_KADDR(SB_, (ROFF) ^ 32, ks); asm volatile("" :: "v"(fb_)); } } \
        if constexpr (MODE == 1) {        \
            mask_init(S, NW); \
        } else { _Pragma("unroll") for (int i = 0; i < 16; ++i) S[i] = 0.f; } \
        _Pragma("unroll") for (int ks = 0; ks < NKS; ++ks) S = __builtin_amdgcn_mfma_f32_32x32x16_bf16(fa_[ks], qf[ks], S, 0, 0, 0); \
        __builtin_amdgcn_sched_group_barrier(0x100, NKS, 0); __builtin_amdgcn_sched_group_barrier(0x008, NKS, 0); } while (0)
#define FA_QK(S0, S1, SB_, KT) do { unsigned nwa_ = 0u, nwb_ = 0u; \
        if constexpr (MODE == 1) { const u32x4 bw_ = *(const LAS u32x4*)((SB_) + BMOFF + wave * 1024 + lane * 16);        \
            nwa_ = ~((((KT) & 1) ? bw_.z : bw_.x) >> (4 * h)); nwb_ = ~((((KT) & 1) ? bw_.w : bw_.y) >> (4 * h)); } \
        FA_QKH(S0, SB_, 0, nwa_); FA_QKH(S1, SB_, 32, nwb_); } while (0)
#define FA_QKX(S, SB_, ROFF) do { bf16x8 fa_[NKS]; \
        _Pragma("unroll") for (int ks = 0; ks < NKS; ++ks) fa_[ks] = *(const LAS bf16x8*)FA_KADDR(SB_, ROFF, ks); \
        _Pragma("unroll") for (int i = 0; i < 16; ++i) S[i] = 0.f; \
        _Pragma("unroll") for (int ks = 0; ks < NKS; ++ks) S = __builtin_amdgcn_mfma_f32_32x32x16_bf16(fa_[ks], qf[ks], S, 0, 0, 0); } while (0)
    if (ju == 0) {
#pragma unroll 1
        for (int a = 0; a < AHEAD; ++a) { FA_ISSUE(kt_lo + a, st_is); st_is = st_is + 1; }
        FA_WAITBAR((AHEAD - 2) * NDMA);
    }
    if (FA_PART(kt_lo)) FA_QK(c0, c1, lds + st_c * STB, kt_lo);
    auto fa_step = [&](f32x16& c0, f32x16& c1, f32x16& n0, f32x16& n1, const int kt) __attribute__((always_inline)) {
        FA_ISSUE(kt + AHEAD, st_is); st_is = (st_is + 1 == NST) ? 0 : st_is + 1;
        const bool more1 = kt < kt_hi;
        const bool qnext = !more1 && (ju + 1 < n_units);
        if (qnext) { const UnitDesc dq = desc(ju + 1); FA_LOADQ(dq); }
        const int k0 = kt * 64;
        const bool part_c = FA_PART(kt), part_n = more1 && FA_PART(kt + 1);
        const LAS unsigned char* Sn = lds + st_n * STB; const LAS unsigned char* Vb = lds + st_c * STB;
        const unsigned va0_ = (unsigned)(size_t)(Vb + vtoff + vx0), va1_ = (unsigned)(size_t)(Vb + vtoff + vx1);
#define FA_PVR(R, O0, O1, O2, O3) asm volatile("ds_read_b64_tr_b16 %0, %8 offset:%10\n\tds_read_b64_tr_b16 %1, %8 offset:%11\n\tds_read_b64_tr_b16 %2, %9 offset:%10\n\tds_read_b64_tr_b16 %3, %9 offset:%11\n\t" \
                             "ds_read_b64_tr_b16 %4, %8 offset:%12\n\tds_read_b64_tr_b16 %5, %8 offset:%13\n\tds_read_b64_tr_b16 %6, %9 offset:%12\n\tds_read_b64_tr_b16 %7, %9 offset:%13" \
                             : "=&v"(R[0]), "=&v"(R[1]), "=&v"(R[2]), "=&v"(R[3]), "=&v"(R[4]), "=&v"(R[5]), "=&v"(R[6]), "=&v"(R[7]) \
                             : "v"(va0_), "v"(va1_), "n"(O0), "n"(O1), "n"(O2), "n"(O3) : "memory")
        u32x2 vr0[8];
        if (part_c) FA_PVR(vr0, 0, 1024, 2048, 3072);
        const bool smask = MODE == 1 ? false : (MODE == 2 ? (k0 + 63 > qw) : true);
        const bool fused = ATT_FUSE2 && (MODE != 0) && part_c && part_n && !smask;
        float alpha = 1.0f;
        if (fused) {
            bf16x8 fa0[NKS], fa1[NKS];
#pragma unroll
            for (int ks = 0; ks < NKS; ++ks) { fa0[ks] = *(const LAS bf16x8*)FA_KADDR(Sn, 0, ks); fa1[ks] = *(const LAS bf16x8*)FA_KADDR(Sn, 32, ks); }
            if constexpr (MODE == 1) { const u32x4 bw_ = *(const LAS u32x4*)(Sn + BMOFF + wave * 1024 + lane * 16);
                mask_init(n0, ~((((kt + 1) & 1) ? bw_.z : bw_.x) >> (4 * h))); mask_init(n1, ~((((kt + 1) & 1) ? bw_.w : bw_.y) >> (4 * h)));
            } else {
#pragma unroll
                for (int i = 0; i < 16; ++i) { n0[i] = 0.f; n1[i] = 0.f; } }
            float mxa, mxb, ms = 0.f, ls = 0.f;
#define FA_MF(S, F, KS) do { S = __builtin_amdgcn_mfma_f32_32x32x16_bf16(F[KS], qf[KS], S, 0, 0, 0); __builtin_amdgcn_sched_barrier(0); } while (0)
#define FA_PC(...) do { __VA_ARGS__; __builtin_amdgcn_sched_barrier(0); } while (0)
            __builtin_amdgcn_sched_barrier(0);
            FA_MF(n0, fa0, 0); FA_PC(mxa = max16(c0));
            FA_MF(n1, fa1, 0); FA_PC(mxb = max16(c1));
            FA_MF(n0, fa0, 1); FA_PC({ const float mx = xhalf_max(fmaxf(mxa, mxb)); const float mn = fmaxf(m, mx); ms = (mn == -INFINITY) ? 0.f : mn; alpha = __builtin_amdgcn_exp2f(m - ms); m = mn; });
            if constexpr (NKS == 6) {
                FA_MF(n1, fa1, 1); FA_PC(sm_piece<0, 4>(c0, c1, ms, ls));
                FA_MF(n0, fa0, 2); FA_PC(sm_piece<4, 8>(c0, c1, ms, ls));
                FA_MF(n1, fa1, 2); FA_PC(sm_piece<8, 12>(c0, c1, ms, ls));
                FA_MF(n0, fa0, 3); FA_PC(sm_piece<12, 16>(c0, c1, ms, ls));
                FA_MF(n1, fa1, 3); FA_PC(sm_piece<16, 20>(c0, c1, ms, ls));
                FA_MF(n0, fa0, 4); FA_PC(sm_piece<20, 23>(c0, c1, ms, ls));
                FA_MF(n1, fa1, 4); FA_PC(sm_piece<23, 26>(c0, c1, ms, ls));
                FA_MF(n0, fa0, 5); FA_PC(sm_piece<26, 29>(c0, c1, ms, ls));
                FA_MF(n1, fa1, 5); FA_PC(sm_piece<29, 32>(c0, c1, ms, ls));
            } else {
                FA_MF(n1, fa1, 1); FA_PC(sm_piece<0, 7>(c0, c1, ms, ls));
                FA_MF(n0, fa0, 2); FA_PC(sm_piece<7, 14>(c0, c1, ms, ls));
                FA_MF(n1, fa1, 2); FA_PC(sm_piece<14, 20>(c0, c1, ms, ls));
                FA_MF(n0, fa0, 3); FA_PC(sm_piece<20, 26>(c0, c1, ms, ls));
                FA_MF(n1, fa1, 3); FA_PC(sm_piece<26, 32>(c0, c1, ms, ls));
            }
#undef FA_MF
#undef FA_PC
            l = l * alpha + ls;
        } else if (part_n) FA_QK(n0, n1, Sn, kt + 1);
        if (part_c) {
#define FA_SOFTMAX(MASKED) do { \
            if (MASKED) { if constexpr (MODE == 2) { const int qa = qh - k0, qa1 = qa - 32; \
                    _Pragma("unroll") for (int i = 0; i < 16; ++i) { const int ci = (i & 3) + 8 * (i >> 2); \
                        c0[i] = (ci > qa) ? -INFINITY : c0[i]; c1[i] = (ci > qa1) ? -INFINITY : c1[i]; } \
                } else if constexpr (MODE == 0) { const int lb = lqh - k0; const unsigned span = (unsigned)(q - lo_q), lb1 = (unsigned)(lb - 32);     \
                    _Pragma("unroll") for (int i = 0; i < 16; ++i) { const int ci = (i & 3) + 8 * (i >> 2); \
                        c0[i] = ((unsigned)(ci - lb) > span) ? -INFINITY : c0[i]; c1[i] = ((unsigned)ci - lb1 > span) ? -INFINITY : c1[i]; } \
                } } \
            float mx = xhalf_max(fmaxf(max16(c0), max16(c1))); \
            const float mn = fmaxf(m, mx); \
            const float ms = (mn == -INFINITY) ? 0.f : mn; \
            alpha = __builtin_amdgcn_exp2f(m - ms); \
            m = mn; \
            float ls = 0.f; \
            if (PROBE_EXP2) { float dm_ = 0.f; _Pragma("unroll") for (int i = 0; i < 16; ++i) { dm_ += __builtin_amdgcn_exp2f(c0[i] - mx) + __builtin_amdgcn_exp2f(c1[i] - mx); } asm volatile("" :: "v"(dm_)); } \
            if (SOFTMAX_PK) { const f32x2 ms2 = {ms, ms}; f32x2 lsa = {0.f, 0.f}, lsb = {0.f, 0.f};            \
              _Pragma("unroll") for (int i = 0; i < 16; i += 2) { \
                  f32x2 ta = {c0[i], c0[i + 1]}, tb = {c1[i], c1[i + 1]}; ta = ta - ms2; tb = tb - ms2; \
                  ta.x = __builtin_amdgcn_exp2f(ta.x); ta.y = __builtin_amdgcn_exp2f(ta.y); tb.x = __builtin_amdgcn_exp2f(tb.x); tb.y = __builtin_amdgcn_exp2f(tb.y); \
                  c0[i] = ta.x; c0[i + 1] = ta.y; c1[i] = tb.x; c1[i + 1] = tb.y; lsa = lsa + ta; lsb = lsb + tb; } \
              lsa = lsa + lsb; ls = lsa.x + lsa.y; \
            } else {        \
              _Pragma("unroll") for (int i = 0; i < 16; ++i) { c0[i] = __builtin_amdgcn_exp2f(c0[i] - ms); c1[i] = __builtin_amdgcn_exp2f(c1[i] - ms); ls += c0[i] + c1[i]; } } \
            l = l * alpha + ls; } while (0)
            const bool need_mask = MODE == 1 ? false : (MODE == 2 ? (k0 + 63 > qw) : ((k0 + 63 > qw) || (k0 < lo_w1)));
            if (!fused) { if (need_mask) FA_SOFTMAX(true); else FA_SOFTMAX(false); }
#undef FA_SOFTMAX
            if (!__all(alpha == 1.0f)) {
#pragma unroll
                for (int i = 0; i < 16; ++i) { o0[i] *= alpha; o1[i] *= alpha; } }
#define FA_PVM(S_, R) do { bf16x8 pf[2]; \
                _Pragma("unroll") for (int sk = 0; sk < 2; ++sk) { u32x4 pw; pw.x = pk2(S_[8 * sk + 0], S_[8 * sk + 1]); pw.y = pk2(S_[8 * sk + 2], S_[8 * sk + 3]); pw.z = pk2(S_[8 * sk + 4], S_[8 * sk + 5]); pw.w = pk2(S_[8 * sk + 6], S_[8 * sk + 7]); pf[sk] = __builtin_bit_cast(bf16x8, pw); } \
                { const u32x4 v0w = {R[0].x, R[0].y, R[1].x, R[1].y}, v1w = {R[2].x, R[2].y, R[3].x, R[3].y}; \
                  o0 = __builtin_amdgcn_mfma_f32_32x32x16_bf16(__builtin_bit_cast(bf16x8, v0w), pf[0], o0, 0, 0, 0); \
                  o1 = __builtin_amdgcn_mfma_f32_32x32x16_bf16(__builtin_bit_cast(bf16x8, v1w), pf[0], o1, 0, 0, 0); } \
                { const u32x4 v0w = {R[4].x, R[4].y, R[5].x, R[5].y}, v1w = {R[6].x, R[6].y, R[7].x, R[7].y}; \
                  o0 = __builtin_amdgcn_mfma_f32_32x32x16_bf16(__builtin_bit_cast(bf16x8, v0w), pf[1], o0, 0, 0, 0); \
                  o1 = __builtin_amdgcn_mfma_f32_32x32x16_bf16(__builtin_bit_cast(bf16x8, v1w), pf[1], o1, 0, 0, 0); } } while (0)
            u32x2 vr1[8];
            FA_PVR(vr1, 4096, 5120, 6144, 7168);
            asm volatile("s_waitcnt lgkmcnt(8)" : "+v"(vr0[0]), "+v"(vr0[1]), "+v"(vr0[2]), "+v"(vr0[3]), "+v"(vr0[4]), "+v"(vr0[5]), "+v"(vr0[6]), "+v"(vr0[7]) :: "memory");
            __builtin_amdgcn_sched_barrier(0);
            FA_PVM(c0, vr0);
            asm volatile("s_waitcnt lgkmcnt(0)" : "+v"(vr1[0]), "+v"(vr1[1]), "+v"(vr1[2]), "+v"(vr1[3]), "+v"(vr1[4]), "+v"(vr1[5]), "+v"(vr1[6]), "+v"(vr1[7]) :: "memory");
            __builtin_amdgcn_sched_barrier(0);
            FA_PVM(c1, vr1);
#undef FA_PVM
#undef FA_PVR
        }
        if (qnext) FA_WAITBAR((AHEAD - 2) * NDMA + NKS); else FA_WAITBAR((AHEAD - 2) * NDMA);
        st_c = st_n; st_n = (st_n + 1 == NST) ? 0 : st_n + 1;
    };
    for (int kt = kt_lo;;) { fa_step(c0, c1, n0, n1, kt); if (++kt > kt_hi) break; fa_step(n0, n1, c0, c1, kt); if (++kt > kt_hi) break; }
#undef FA_PART
#undef FA_QK
#undef FA_QKH
#undef FA_QKX
#undef FA_KADDR
    const float lt = xhalf_sum(l);
    const float inv = 1.0f / lt;
    if (active) {
    bf16* op = P.O + (size_t)(seq0 + q) * P.o_pitch + o_col + 8 * h;
#pragma unroll
    for (int db = 0; db < 2; ++db) {
        const f32x16& o = db ? o1 : o0;
#pragma unroll
        for (int j = 0; j < 2; ++j) {
            u32x2 X, Y;
            X.x = pk2(o[8 * j] * inv, o[8 * j + 1] * inv); X.y = pk2(o[8 * j + 2] * inv, o[8 * j + 3] * inv);
            Y.x = pk2(o[8 * j + 4] * inv, o[8 * j + 5] * inv); Y.y = pk2(o[8 * j + 6] * inv, o[8 * j + 7] * inv);
            const auto a = __builtin_amdgcn_permlane32_swap(X.x, Y.x, false, false); const auto b = __builtin_amdgcn_permlane32_swap(X.y, Y.y, false, false);
            u32x4 w; w.x = a[0]; w.y = b[0]; w.z = a[1]; w.w = b[1];
            stg16<NT_ATT>(op + 32 * db + 16 * j, w);
        }
    }
    if (P.LSE && h == 0) P.LSE[(size_t)(seq0 + q) * P.lse_pitch + lse_col] = m + __builtin_amdgcn_logf(lt);
    }
    __builtin_amdgcn_sched_barrier(0);
    FA_WAITQ(4);
    }
    asm volatile("s_waitcnt vmcnt(0)" ::: "memory"); __builtin_amdgcn_s_barrier(); asm volatile("" ::: "memory");
#undef FA_ISSUE
#undef FA_LOADQ
#undef FA_WAITQ
#undef FA_WAITBAR
}
}

struct Args {
    const float* x; const int* pos; const float* w_in; const float* qn; const float* kvn; const float* w_uq; const float* w_ukv; const float* w_o;
    const float* ln1g; const float* ln1b; const float* rgw; const float* rgb; const float* rew; const float* reb;
    const float* wg; const float* wu; const float* wd; const float* ln2g; const float* ln2b;
    float* out; unsigned char* ws; int l_lo, l_hi, ph_lo, ph_hi, use_bar, pad;
};
typedef const __attribute__((address_space(4))) Args CArgs;
struct Ctx { LAS unsigned char* lds; int tid, lane, wave, G, c, vcu; unsigned char* ws; };

struct ColIdent { int off; __device__ __forceinline__ int operator()(int P) const { return off + P; } };
struct ColAdj { __device__ __forceinline__ int operator()(int P) const { const int p = P & 255; return (P & ~255) + 64 * ((p >> 5) & 3) + 32 * (p >> 7) + (p & 31); } };
__device__ __forceinline__ int map_rope32(int p) { return 16 * ((p >> 2) & 1) + 4 * (p >> 3) + (p & 3); }
__device__ __forceinline__ int map_head16(int p) { const int fq = p >> 3; return 16 * (fq >> 1) + 8 * ((p >> 2) & 1) + 4 * (fq & 1) + (p & 3); }
struct ColWin {
    __device__ __forceinline__ int operator()(int P) const {
        const int G = P >> 5, p = P & 31;
        if (G < 8) return 32 * G + p;
        if (G < 12) return 256 + 32 * (G - 8) + p;
        if (G == 12) return 384 + map_rope32(p);
        if (G == 13) return 1056 + p;
        if (G == 14) return 672 + map_head16(p);
        if (G == 15) return 704 + p;
        if (G < 24) { const int hh = (G - 16) >> 1; return 416 + 64 * hh + (((G - 16) & 1) ? 32 + p : map_head16(p)); }
        if (G < 26) return 736 + 32 * (G - 24) + p;
        if (G == 26) return p < 8 ? 1088 + p : -1;
        if (G < 32) return -1;
        if (G < 40) return 800 + 32 * (G - 32) + p;
        if (G < 64) { const int j = G - 40; return 1096 + 64 * (j >> 1) + ((j & 1) ? 32 + p : map_head16(p)); }
        if (G < 88) { const int j = G - 64; return 1096 + 768 + 64 * (j >> 1) + ((j & 1) ? 32 + p : map_head16(p)); }
        return 1096 + 1536 + 32 * (G - 88) + p;
    }
};
struct ColUq {
    __device__ __forceinline__ int operator()(int P) const { const int G = P >> 5, p = P & 31; return 32 * G + ((G % 3 == 2) ? map_rope32(p) : p); }
};
template <class ColFn>
__device__ __forceinline__ void transpose_item(const float* W, int ldw, int kvalid, bf16* WT, int ldt, int k0, int P0, const ColFn& cf, const float* rowscale, LAS float* scr, int lane) {
    const int c = lane & 31, col = cf(P0 + c);
#pragma unroll 8
    for (int i = 0; i < 32; ++i) { const int kk = 2 * i + (lane >> 5), k = k0 + kk; float v = 0.f;
        if (col >= 0 && k < kvalid) { v = W[(size_t)k * ldw + col]; if (rowscale) v *= rowscale[k]; }
        scr[kk * 33 + c] = v; }
    asm volatile("s_waitcnt lgkmcnt(0)" ::: "memory");
    const int cc = lane & 7;
#pragma unroll
    for (int j = 0; j < 4; ++j) { const int n = (lane >> 3) + 8 * j; const LAS float* s = scr + (8 * cc) * 33 + n;
        u32x4 o; o.x = pk2(s[0 * 33], s[1 * 33]); o.y = pk2(s[2 * 33], s[3 * 33]); o.z = pk2(s[4 * 33], s[5 * 33]); o.w = pk2(s[6 * 33], s[7 * 33]);
        *(u32x4*)(WT + (size_t)(P0 + n) * ldt + k0 + 8 * cc) = o; }
    asm volatile("s_waitcnt lgkmcnt(0)" ::: "memory");
}
__device__ __forceinline__ void prologue(const Ctx& X, const CArgs* ap) {
    struct { const float* x; const float *w_in, *qn, *kvn, *w_uq, *w_ukv, *w_o, *rgw, *rew; } a = {ap->x, ap->w_in, ap->qn, ap->kvn, ap->w_uq, ap->w_ukv, ap->w_o, ap->rgw, ap->rew};
    LAS float* scr = (LAS float*)(X.lds + X.wave * 16384);
    const int gw = X.vcu * 8 + X.wave, NGW = X.G * 8;
    constexpr int I_WIN = 16 * 112, I_UQ = 4 * 24, I_UKV = 2 * 32, I_WO = 16 * 32, I_L = I_WIN + I_UQ + I_UKV + I_WO;
    for (int it = gw; it < DEPTH * I_L; it += NGW) {
        const int l = it / I_L; int r = it % I_L;
        if (r < I_WIN) { transpose_item(a.w_in + (size_t)l * DM * IN_COLS, IN_COLS, DM, (bf16*)(X.ws + WS_WIN) + (size_t)l * NIN * DM, DM, 64 * (r / 112), 32 * (r % 112), ColWin{}, nullptr, scr, X.lane); continue; }
        r -= I_WIN;
        if (r < I_UQ) { transpose_item(a.w_uq + (size_t)l * 256 * 768, 768, 256, (bf16*)(X.ws + WS_WUQ) + (size_t)l * 768 * 256, 256, 64 * (r / 24), 32 * (r % 24), ColUq{}, a.qn + l * 256, scr, X.lane); continue; }
        r -= I_UQ;
        if (r < I_UKV) { transpose_item(a.w_ukv + (size_t)l * 128 * 1024, 1024, 128, (bf16*)(X.ws + WS_WUKV) + (size_t)l * 1024 * 128, 128, 64 * (r / 32), 32 * (r % 32), ColAdj{}, a.kvn + l * 128, scr, X.lane); continue; }
        r -= I_UKV;
        transpose_item(a.w_o + (size_t)l * DM * DM, DM, DM, (bf16*)(X.ws + WS_WO) + (size_t)l * DM * DM, DM, 64 * (r / 32), 32 * (r % 32), ColAdj{}, nullptr, scr, X.lane);
    }
    const size_t gt = (size_t)X.vcu * 512 + X.tid, NGT = (size_t)X.G * 512;
    { float* rgt = (float*)(X.ws + WS_RGT); float* ret = (float*)(X.ws + WS_RET);
      for (size_t i = gt; i < (size_t)DEPTH * 4 * DM; i += NGT) { const int l = (int)(i / (4 * DM)), g = (int)(i / DM) & 3, k = (int)(i % DM); rgt[i] = a.rgw[((size_t)l * DM + k) * 4 + g]; }
      for (size_t i = gt; i < (size_t)DEPTH * 32 * DM; i += NGT) { const int l = (int)(i / (32 * DM)), ge = (int)(i / DM) & 31, k = (int)(i % DM); ret[i] = a.rew[(((size_t)l * 4 + (ge >> 3)) * DM + k) * 8 + (ge & 7)]; } }
    { const f32x4* xs = (const f32x4*)a.x; u32x2* xb = (u32x2*)((unsigned char*)ap->out + XR_OFF);
      for (size_t i = gt; i < (size_t)NT * DM / 4; i += NGT) { const f32x4 v = xs[i]; u32x2 w; w.x = pk2(v[0], v[1]); w.y = pk2(v[2], v[3]); xb[i] = w; } }
}
__device__ __forceinline__ void convert_experts(const Ctx& X, const CArgs* ap, int l) {
    struct { const float *wg, *wu, *wd; } a = {ap->wg, ap->wu, ap->wd};
    LAS float* scr = (LAS float*)(X.lds + X.wave * 16384);
    const int gw = X.vcu * 8 + X.wave, NGW = X.G * 8;
    constexpr int I_GU = 32 * 16 * 16, I_D = 32 * 4 * 32;
    for (int it = gw; it < I_GU + I_D; it += NGW) {
        if (it < I_GU) { const int e = it >> 8, r = it & 255, G32 = r >> 4, kb = r & 15; const int pn = G32 >> 3, r0 = (G32 & 7) * 32; const bool up = r0 >= 128;
            const float* W = (up ? a.wu : a.wg) + ((size_t)l * NEXP + e) * DM * FH;
            transpose_item(W, FH, DM, (bf16*)(X.ws + WS_WGU) + (size_t)e * 512 * DM, DM, 64 * kb, 32 * G32, ColIdent{128 * pn + (r0 & 127) - 32 * G32}, nullptr, scr, X.lane);
        } else { const int r = it - I_GU, e = r >> 7, q = r & 127, kb = q >> 5, pg = q & 31;
            transpose_item(a.wd + ((size_t)l * NEXP + e) * FH * DM, DM, FH, (bf16*)(X.ws + WS_WD) + (size_t)e * DM * FH, FH, 64 * kb, 32 * pg, ColAdj{}, nullptr, scr, X.lane); }
    }
}

struct InProjDesc {
    unsigned char* ws;
    __device__ __forceinline__ pg8::GroupDesc operator()(int pn, int bj, int wc) const {
        using namespace pg8; const int G = 8 * pn + 4 * bj + wc; GroupDesc d; d.kind = GK_PLAIN; d.dst = nullptr; d.pitch = 256; d.col = 0; d.scale = 1.f; d.perm = 0; d.ssq = nullptr; d.ssq_n = 0; d.ssq_i = 0;
        if (G < 8) { d.dst = (bf16*)(ws + WS_CQ); d.col = 32 * G; d.ssq = (float*)(ws + WS_SSQ); d.ssq_n = 8; d.ssq_i = G; }
        else if (G < 12) { d.dst = (bf16*)(ws + WS_T1); d.pitch = 128; d.col = 32 * (G - 8); d.ssq = (float*)(ws + WS_SSQ) + (size_t)NT * 8; d.ssq_n = 4; d.ssq_i = G - 8; }
        else if (G == 12) { d.kind = GK_ROPE32; d.dst = (bf16*)(ws + WS_KPE); d.pitch = 32; d.col = 0; }
        else if (G == 13) { d.kind = GK_IDX8; d.dst = (bf16*)(ws + WS_KI); d.pitch = 32; d.col = 0; }
        else if (G == 14) { d.kind = GK_HEAD16; d.dst = (bf16*)(ws + WS_BK); d.pitch = 64; d.col = 0; }
        else if (G == 15) { d.dst = (bf16*)(ws + WS_BK); d.pitch = 64; d.col = 32; }
        else if (G < 24) { d.kind = ((G - 16) & 1) ? GK_PLAIN : GK_HEAD16; d.dst = (bf16*)(ws + WS_BQ); d.col = 32 * (G - 16); d.scale = QSC64; }
        else if (G < 26) { d.dst = (bf16*)(ws + WS_BV); d.pitch = 64; d.col = 32 * (G - 24); }
        else if (G == 26) { d.kind = GK_WI; d.dst = (bf16*)(ws + WS_WI); }
        else if (G < 32) { d.kind = GK_SKIP; }
        else if (G < 40) { d.kind = GK_IDX8; d.dst = (bf16*)(ws + WS_BQI); d.col = 32 * (G - 32); }
        else if (G < 64) { const int j = G - 40, cfg = j >> 3; d.kind = (j & 1) ? GK_PLAIN : GK_HEAD16; d.dst = (bf16*)(ws + WS_DQ) + (size_t)cfg * NT * 256; d.col = 32 * (j & 7); d.scale = QSC64; d.perm = cfg == 0 ? 0 : (cfg == 1 ? 4 : 16); }
        else if (G < 88) { const int j = G - 64, cfg = j >> 3; d.kind = (j & 1) ? GK_PLAIN : GK_HEAD16; d.dst = (bf16*)(ws + WS_DK) + (size_t)cfg * NT * 256; d.col = 32 * (j & 7); d.perm = cfg == 0 ? 0 : (cfg == 1 ? 4 : 16); }
        else { const int j = G - 88, cfg = j >> 3; d.dst = (bf16*)(ws + WS_DV) + (size_t)cfg * NT * 256; d.col = 32 * (j & 7); d.perm = cfg == 0 ? 0 : (cfg == 1 ? 4 : 16); }
        return d;
    }
};
struct UqDesc {
    unsigned char* ws;
    __device__ __forceinline__ pg8::GroupDesc operator()(int pn, int bj, int wc) const {
        using namespace pg8; const int G = 8 * pn + 4 * bj + wc; GroupDesc d; d.kind = (G % 3 == 2) ? GK_ROPE32 : GK_PLAIN; d.dst = (bf16*)(ws + WS_QA); d.pitch = 768; d.col = 32 * G; d.scale = QSC96; d.perm = 0; d.ssq = nullptr; d.ssq_n = 0; d.ssq_i = 0;
        return d;
    }
};

__device__ __forceinline__ unsigned f16key(float v) { const _Float16 hf = (_Float16)v; const unsigned u = (unsigned)__builtin_bit_cast(unsigned short, hf); return (u ^ ((unsigned)__builtin_amdgcn_sbfe((int)u, 15, 1) | 0x8000u)) & 0xffffu; }
__device__ __forceinline__ unsigned pk_cnt(unsigned acc, unsigned kp2, unsigned mid2, unsigned one2) {
    unsigned t;
    asm("v_pk_sub_u16 %0, %2, %3 clamp\n\tv_pk_min_u16 %0, %0, %4\n\tv_pk_add_u16 %1, %1, %0" : "=&v"(t), "+v"(acc) : "v"(kp2), "s"(mid2), "s"(one2));
    return acc;
}
__device__ __forceinline__ int count_gt(const unsigned (&kp)[16], unsigned mid) {
    const unsigned m2 = __builtin_amdgcn_readfirstlane(mid | (mid << 16)), one2 = __builtin_amdgcn_readfirstlane(0x00010001u);
    unsigned a0 = 0u, a1 = 0u;
#pragma unroll
    for (int i = 0; i < 16; i += 2) { a0 = pk_cnt(a0, kp[i], m2, one2); a1 = pk_cnt(a1, kp[i + 1], m2, one2); }
    unsigned aw; asm("v_pk_add_u16 %0, %1, %2" : "=v"(aw) : "v"(a0), "v"(a1));
    const unsigned c = (aw & 0xffffu) + (aw >> 16);
    int tot = 0;
#pragma unroll
    for (int b = 0; b < 6; ++b) tot += __builtin_popcountll(__ballot((c >> b) & 1u)) << b;
    return tot;
}
__device__ __forceinline__ int wave_scan_incl(int v) {
    v += __builtin_amdgcn_update_dpp(0, v, 0x111, 0xf, 0xf, false); v += __builtin_amdgcn_update_dpp(0, v, 0x112, 0xf, 0xf, false);
    v += __builtin_amdgcn_update_dpp(0, v, 0x114, 0xf, 0xf, false); v += __builtin_amdgcn_update_dpp(0, v, 0x118, 0xf, 0xf, false);
    v += __builtin_amdgcn_update_dpp(0, v, 0x142, 0xa, 0xf, false); v += __builtin_amdgcn_update_dpp(0, v, 0x143, 0xc, 0xf, false);
    return v;
}
__device__ __forceinline__ void radix_pick(const LAS unsigned* hist, int lane, int target, int& B, int& above, int& inbin) {
    const u32x2 hw = *(const LAS u32x2*)(hist + 2 * lane);
    const int c0 = (int)(hw.x & 0xffffu), c1 = (int)(hw.x >> 16), c2 = (int)(hw.y & 0xffffu), c3 = (int)(hw.y >> 16);
    const int tl = (c0 + c1) + (c2 + c3);
    const int pre = wave_scan_incl(tl);
    const int suf = __builtin_amdgcn_readlane(pre, 63) - pre + tl;
    const unsigned long long reach = __ballot(suf >= target);
    const int ls = 63 - __builtin_clzll(reach | 1ull);
    int a = suf - tl, b = 4 * lane + 3, ib = c3;
    if (a + c3 < target) { a += c3; b = 4 * lane + 2; ib = c2; if (a + c2 < target) { a += c2; b = 4 * lane + 1; ib = c1; if (a + c1 < target) { a += c1; b = 4 * lane; ib = c0; } } }
    B = __builtin_amdgcn_readlane(b, ls); above = __builtin_amdgcn_readlane(a, ls); inbin = __builtin_amdgcn_readlane(ib, ls);
}
__device__ __forceinline__ float relu_i(float x) { const int i = __builtin_bit_cast(int, x); return __builtin_bit_cast(float, i > 0 ? i : 0); }
__device__ __forceinline__ void dsa_index_unit(const Ctx& X, int b, int q0) {
    const int lane = X.lane, r = lane & 31, h = lane >> 5; const size_t seq0 = (size_t)b * SEQ; const int t0 = q0 + 4 * X.wave;
    const bf16* BQI = (const bf16*)(X.ws + WS_BQI); const bf16* KI = (const bf16*)(X.ws + WS_KI); const float* WI = (const float*)(X.ws + WS_WI);
    LAS unsigned short* rows = (LAS unsigned short*)(X.lds + X.wave * 16384);
    LAS unsigned char* kbuf = X.lds + LDS_X_OFF;
    const bf16* ap = BQI + (seq0 + t0 + (r >> 3)) * 256 + 32 * (r & 7) + 16 * h;
    const bf16x8 a0 = *(const bf16x8*)ap, a1 = *(const bf16x8*)(ap + 8);
    f32x2 wq[4][2];
#pragma unroll
    for (int j = 0; j < 4; ++j) { const f32x4 w = *(const f32x4*)(WI + (seq0 + t0 + j) * 8 + 4 * h);
        wq[j][0] = (f32x2){w[0] * IDX_SCALE, w[1] * IDX_SCALE}; wq[j][1] = (f32x2){w[2] * IDX_SCALE, w[3] * IDX_SCALE}; }
    const int nch = ((q0 + 31) >> 7) + 1;
    const int skey = X.tid >> 2, spc = X.tid & 3;
    const bf16* sp = KI + (seq0 + skey) * 32 + 8 * spc;
    const int sdst = skey * 64 + ((spc ^ ((skey >> 2) & 3)) << 4);
    u32x4 stg0 = *(const u32x4*)sp, stg1 = stg0, stg2 = stg0, stg3 = stg0;
    if (1 < nch) stg1 = *(const u32x4*)(sp + (size_t)1 * 128 * 32);
    if (2 < nch) stg2 = *(const u32x4*)(sp + (size_t)2 * 128 * 32);
    if (3 < nch) stg3 = *(const u32x4*)(sp + (size_t)3 * 128 * 32);
    *(LAS u32x4*)(kbuf + sdst) = stg0;
    __syncthreads();
#define DSA_STEP(J, RCUR, RNEXT) { const int c = c0 + (J); \
        if (c + 4 < nch) RCUR = *(const u32x4*)(sp + (size_t)(c + 4) * 128 * 32); \
        const LAS unsigned char* kb = kbuf + (c & 1) * 8192; \
        f32x16 accq[4];        \
        _Pragma("unroll") for (int tq = 0; tq < 4; ++tq) { \
            const int key = 32 * tq + r, sw = (key >> 2) & 3; \
            const bf16x8 b0 = *(const LAS bf16x8*)(kb + key * 64 + (((2 * h) ^ sw) << 4)), b1 = *(const LAS bf16x8*)(kb + key * 64 + (((2 * h + 1) ^ sw) << 4)); \
            _Pragma("unroll") for (int i = 0; i < 16; ++i) accq[tq][i] = 0.f; \
            accq[tq] = __builtin_amdgcn_mfma_f32_32x32x16_bf16(a0, b0, accq[tq], 0, 0, 0); \
            accq[tq] = __builtin_amdgcn_mfma_f32_32x32x16_bf16(a1, b1, accq[tq], 0, 0, 0); } \
        __builtin_amdgcn_sched_barrier(0); \
        _Pragma("unroll") for (int tq = 0; tq < 4; ++tq) { const f32x16& acc = accq[tq]; \
            float p[4]; \
            _Pragma("unroll") for (int j = 0; j < 4; ++j) {            \
                const f32x2 ra = {relu_i(acc[4 * j]), relu_i(acc[4 * j + 1])}, rb = {relu_i(acc[4 * j + 2]), relu_i(acc[4 * j + 3])}; \
                const f32x2 pp = __builtin_elementwise_fma(rb, wq[j][1], ra * wq[j][0]); \
                p[j] = pp.x + pp.y; } \
            const auto s01 = __builtin_amdgcn_permlane32_swap(__float_as_uint(p[0]), __float_as_uint(p[1]), false, false); \
            const auto s23 = __builtin_amdgcn_permlane32_swap(__float_as_uint(p[2]), __float_as_uint(p[3]), false, false); \
            const float va = __uint_as_float(s01[0]) + __uint_as_float(s01[1]), vb = __uint_as_float(s23[0]) + __uint_as_float(s23[1]); \
            const int hw = 128 * c + 32 * tq + r;                                      \
            rows[h * 2048 + hw] = (unsigned short)f16key(va); \
            rows[(2 + h) * 2048 + hw] = (unsigned short)f16key(vb); \
        } \
        if (c + 1 < nch) *(LAS u32x4*)(kbuf + ((c + 1) & 1) * 8192 + sdst) = RNEXT; \
        __syncthreads(); }
#ifndef REP_SCORE
#define REP_SCORE 1
#endif
#ifndef REP_SEL
#define REP_SEL 1
#endif
    for (int rsc = 0; rsc < REP_SCORE; ++rsc) {
    if (rsc > 0) { stg0 = *(const u32x4*)sp; stg1 = stg0; stg2 = stg0; stg3 = stg0; if (1 < nch) stg1 = *(const u32x4*)(sp + (size_t)1 * 128 * 32); if (2 < nch) stg2 = *(const u32x4*)(sp + (size_t)2 * 128 * 32); if (3 < nch) stg3 = *(const u32x4*)(sp + (size_t)3 * 128 * 32); *(LAS u32x4*)(kbuf + sdst) = stg0; __syncthreads(); }
    for (int c0 = 0; c0 < nch; c0 += 4) {
        DSA_STEP(0, stg0, stg1)
        if (c0 + 1 >= nch) break;
        DSA_STEP(1, stg1, stg2)
        if (c0 + 2 >= nch) break;
        DSA_STEP(2, stg2, stg3)
        if (c0 + 3 >= nch) break;
        DSA_STEP(3, stg3, stg0)
    }
    }
#undef DSA_STEP
    unsigned* BMp = (unsigned*)(X.ws + WS_BM);
#ifndef REP_BIS
#define REP_BIS 1
#endif
#ifndef REP_EMIT
#define REP_EMIT 1
#endif
    for (int rsl = 0; rsl < REP_SEL; ++rsl)
    for (int j = 0; j < 4; ++j) {
        const int t = t0 + j;
        const LAS u32x4* rw = (const LAS u32x4*)(rows + j * 2048) + 4 * lane;
        unsigned kp[16];
#pragma unroll
        for (int v4 = 0; v4 < 4; ++v4) { const u32x4 d = rw[v4]; kp[4 * v4] = d.x; kp[4 * v4 + 1] = d.y; kp[4 * v4 + 2] = d.z; kp[4 * v4 + 3] = d.w; }
        const int nv = t + 1 - 32 * lane;
#pragma unroll
        for (int d = 0; d < 16; ++d) kp[d] &= ((2 * d < nv) ? 0xffffu : 0u) | ((2 * d + 1 < nv) ? 0xffff0000u : 0u);
        unsigned thr = 0u; int need = 0;
        for (int rb_ = 0; rb_ < REP_BIS; ++rb_)
        if (t + 1 > 256) {
            LAS unsigned* hist = (LAS unsigned*)(X.lds + LDS_HIST_OFF + X.wave * 512);
            *(LAS u32x2*)(hist + 2 * lane) = (u32x2){0u, 0u};
#pragma unroll
            for (int d = 0; d < 16; ++d) { const unsigned klo = kp[d] & 0xffffu, khi = kp[d] >> 16;
                if (klo) __hip_atomic_fetch_add(hist + (klo >> 9), (klo & 0x100u) ? 0x10000u : 1u, __ATOMIC_RELAXED, __HIP_MEMORY_SCOPE_WORKGROUP);
                if (khi) __hip_atomic_fetch_add(hist + (khi >> 9), (khi & 0x100u) ? 0x10000u : 1u, __ATOMIC_RELAXED, __HIP_MEMORY_SCOPE_WORKGROUP); }
            int B1, above1, in1; radix_pick(hist, lane, 256, B1, above1, in1);
            *(LAS u32x2*)(hist + 2 * lane) = (u32x2){0u, 0u};
#pragma unroll
            for (int d = 0; d < 16; ++d) { const unsigned klo = kp[d] & 0xffffu, khi = kp[d] >> 16;
                if ((int)(klo >> 8) == B1) __hip_atomic_fetch_add(hist + ((klo & 0xffu) >> 1), (klo & 1u) ? 0x10000u : 1u, __ATOMIC_RELAXED, __HIP_MEMORY_SCOPE_WORKGROUP);
                if ((int)(khi >> 8) == B1) __hip_atomic_fetch_add(hist + ((khi & 0xffu) >> 1), (khi & 1u) ? 0x10000u : 1u, __ATOMIC_RELAXED, __HIP_MEMORY_SCOPE_WORKGROUP); }
            int B2, above2, in2; radix_pick(hist, lane, 256 - above1, B2, above2, in2);
            const unsigned tk = ((unsigned)B1 << 8) | (unsigned)B2;
            const int rest = 256 - (above1 + above2);
            if (rest >= in2) { thr = tk - 1u; need = 0; } else { thr = tk; need = rest; }
        }
        unsigned word = 0u, eqw = 0u;
        const unsigned thr2 = __builtin_amdgcn_readfirstlane(thr | (thr << 16)), one2 = __builtin_amdgcn_readfirstlane(0x00010001u);
#pragma unroll
        for (int d = 0; d < 16; ++d) { unsigned g;
            asm("v_pk_sub_u16 %0, %1, %2 clamp\n\tv_pk_min_u16 %0, %0, %3" : "=&v"(g) : "v"(kp[d]), "s"(thr2), "s"(one2));
            word |= ((g | (g >> 15)) & 3u) << (2 * d); }
        if (need > 0) {
#pragma unroll
            for (int d = 0; d < 16; ++d) { unsigned g; const unsigned x = kp[d] ^ thr2;
                asm("v_pk_min_u16 %0, %1, %2" : "=v"(g) : "v"(x), "s"(one2));
                eqw |= ((~(g | (g >> 15))) & 3u) << (2 * d); }
            if (thr == 0u) eqw = 0u;
            const int ne = __builtin_popcount(eqw); const int inc = wave_scan_incl(ne);
            int take = need - (inc - ne); take = take < 0 ? 0 : (take > ne ? ne : take);
            while (__any(take > 0)) { if (take > 0) { const unsigned lowbit = eqw & (0u - eqw); word |= lowbit; eqw ^= lowbit; --take; } }
        }
        BMp[(seq0 + t) * 64 + lane] = word;
    }
}

__device__ __forceinline__ void dil_combine(const Ctx& X) {
    const bf16* OD = (const bf16*)(X.ws + WS_OD); const float* LS = (const float*)(X.ws + WS_LSE); bf16* O = (bf16*)(X.ws + WS_XB);
    const int gw = X.vcu * 8 + X.wave, NGW = X.G * 8, lane = X.lane, hh = lane >> 4;
    for (int t = gw; t < NT; t += NGW) {
        const int b = t >> 11, s = t & 2047;
        const int r0 = t, r1 = (b << 11) + ((s & 3) << 9) + (s >> 2), r2 = (b << 11) + ((s & 15) << 7) + (s >> 4);
        const float L0 = LS[(size_t)r0 * 4 + hh], L1 = LS[((size_t)NT + r1) * 4 + hh], L2 = LS[((size_t)2 * NT + r2) * 4 + hh];
        const float mx = fmaxf(L0, fmaxf(L1, L2));
        float w0 = __builtin_amdgcn_exp2f(L0 - mx), w1 = __builtin_amdgcn_exp2f(L1 - mx), w2 = __builtin_amdgcn_exp2f(L2 - mx);
        const float inv = 1.0f / (w0 + w1 + w2); w0 *= inv; w1 *= inv; w2 *= inv;
        const u32x2 a = *(const u32x2*)(OD + (size_t)r0 * 256 + 4 * lane), bq = *(const u32x2*)(OD + ((size_t)NT + r1) * 256 + 4 * lane), cq = *(const u32x2*)(OD + ((size_t)2 * NT + r2) * 256 + 4 * lane);
        u32x2 o;
        o.x = pk2(w0 * bflo(a.x) + w1 * bflo(bq.x) + w2 * bflo(cq.x), w0 * bfhi(a.x) + w1 * bfhi(bq.x) + w2 * bfhi(cq.x));
        o.y = pk2(w0 * bflo(a.y) + w1 * bflo(bq.y) + w2 * bflo(cq.y), w0 * bfhi(a.y) + w1 * bfhi(bq.y) + w2 * bfhi(cq.y));
        stg8<NT_ATT>(O + (size_t)t * DM + 768 + 4 * lane, o);
    }
}

__device__ __forceinline__ void ln1_router(const Ctx& X, const CArgs* ap, int l, bool first, bool dummy = false) {
    struct { const float *ln1g, *ln1b, *rgb, *reb; } a = {ap->ln1g, ap->ln1b, ap->rgb, ap->reb}; (void)first;
    const bf16* xin = (const bf16*)((const unsigned char*)ap->out + XR_OFF);
    const bool keep_copy = !LN2_X1B && (l == DEPTH - 1) && !dummy; bf16* XC = (bf16*)(X.ws + WS_KVA);
    const int lane = X.lane; const bf16* MIX = (const bf16*)(X.ws + WS_MIX); bf16* X1B = (bf16*)(X.ws + (dummy ? WS_Y : WS_XB));
    LAS float* reT = (LAS float*)X.lds;
    LAS float* rgT = (LAS float*)(X.lds + LDS_X_OFF);
    LAS int* hist = (LAS int*)(X.lds + LDSCTL_OFF + 256);
    { const u32x4* s1 = (const u32x4*)(X.ws + WS_RET + (size_t)l * 32 * DM * 4); for (int i = X.tid; i < 32 * DM / 4; i += 512) ((LAS u32x4*)reT)[i] = s1[i];
      const u32x4* s2 = (const u32x4*)(X.ws + WS_RGT + (size_t)l * 4 * DM * 4); for (int i = X.tid; i < 4 * DM / 4; i += 512) ((LAS u32x4*)rgT)[i] = s2[i]; }
    f32x4 g[4], bb[4];
#pragma unroll
    for (int j = 0; j < 4; ++j) { g[j] = *(const f32x4*)(a.ln1g + l * DM + 4 * lane + 256 * j); bb[j] = *(const f32x4*)(a.ln1b + l * DM + 4 * lane + 256 * j); }
    const float* rgb = a.rgb + l * 4; const float* reb = a.reb + l * 32;
    for (int rb = X.c; rb < NT / 256; rb += X.G) {
        if (X.tid < 32) hist[X.tid] = 0;
        __syncthreads();
        u32x2 xa[4], xb[4]; u32x2 ma[4], mb[4];
        { const int t = rb * 256 + X.wave * 32;
#pragma unroll
          for (int j = 0; j < 4; ++j) { xa[j] = *(const u32x2*)(xin + (size_t)t * DM + 4 * lane + 256 * j); ma[j] = *(const u32x2*)(MIX + (size_t)t * DM + 4 * lane + 256 * j); }
#pragma unroll
          for (int j = 0; j < 4; ++j) { xb[j] = *(const u32x2*)(xin + (size_t)(t + 1) * DM + 4 * lane + 256 * j); mb[j] = *(const u32x2*)(MIX + (size_t)(t + 1) * DM + 4 * lane + 256 * j); } }
        auto row = [&](u32x2 (&xn)[4], u32x2 (&mn)[4], const int i) __attribute__((always_inline)) {
            const int t = rb * 256 + X.wave * 32 + i;
            f32x4 v[4]; float s = 0.f;
#pragma unroll
            for (int j = 0; j < 4; ++j) { const u32x2 xw = xn[j]; const u32x2 mw = mn[j];
                if (keep_copy) *(u32x2*)(XC + (size_t)t * DM + 4 * lane + 256 * j) = xw;
                v[j][0] = ALPHA * bflo(xw.x) + bflo(mw.x); v[j][1] = ALPHA * bfhi(xw.x) + bfhi(mw.x); v[j][2] = ALPHA * bflo(xw.y) + bflo(mw.y); v[j][3] = ALPHA * bfhi(xw.y) + bfhi(mw.y);
                s += (v[j][0] + v[j][1]) + (v[j][2] + v[j][3]); }
            if (i + 2 < 32) {
#pragma unroll
                for (int j = 0; j < 4; ++j) { xn[j] = *(const u32x2*)(xin + (size_t)(t + 2) * DM + 4 * lane + 256 * j); mn[j] = *(const u32x2*)(MIX + (size_t)(t + 2) * DM + 4 * lane + 256 * j); } }
            const float mean = wave_sum(s) * (1.f / DM); float s2 = 0.f;
#pragma unroll
            for (int j = 0; j < 4; ++j) { v[j] = v[j] - mean; s2 += (v[j][0] * v[j][0] + v[j][1] * v[j][1]) + (v[j][2] * v[j][2] + v[j][3] * v[j][3]); }
            const float rstd = 1.0f / sqrtf(wave_sum(s2) * (1.f / DM) + 1e-5f);
#pragma unroll
            for (int j = 0; j < 4; ++j) { v[j] = v[j] * rstd * g[j] + bb[j];
                u32x2 w; w.x = pk2(v[j][0], v[j][1]); w.y = pk2(v[j][2], v[j][3]); stg8<NT_LN>(X1B + (size_t)t * DM + 4 * lane + 256 * j, w); }
            float lg[4];
            { f32x2 pa[4], pb[4];
#pragma unroll
              for (int gi = 0; gi < 4; ++gi) { pa[gi] = (f32x2){0.f, 0.f}; pb[gi] = (f32x2){0.f, 0.f}; }
#pragma unroll
              for (int j = 0; j < 4; ++j) { const f32x2 vxy = {v[j][0], v[j][1]}, vzw = {v[j][2], v[j][3]};
#pragma unroll
                  for (int gi = 0; gi < 4; ++gi) { const f32x4 w = *(const LAS f32x4*)(rgT + gi * DM + 4 * lane + 256 * j);
                      pa[gi] = __builtin_elementwise_fma(vxy, (f32x2){w[0], w[1]}, pa[gi]); pb[gi] = __builtin_elementwise_fma(vzw, (f32x2){w[2], w[3]}, pb[gi]); } }
#pragma unroll
              for (int gi = 0; gi < 4; ++gi) { const f32x2 q = pa[gi] + pb[gi]; lg[gi] = q.x + q.y; }
              wave_sum_n<4>(lg);
#pragma unroll
              for (int gi = 0; gi < 4; ++gi) lg[gi] += rgb[gi]; }
            int gs = 0; float gm = lg[0];
#pragma unroll
            for (int gi = 1; gi < 4; ++gi) if (lg[gi] > gm) { gm = lg[gi]; gs = gi; }
            float den = 0.f;
#pragma unroll
            for (int gi = 0; gi < 4; ++gi) den += __expf(lg[gi] - gm);
            const float ptop = __builtin_amdgcn_rcpf(den);
            gs = __builtin_amdgcn_readfirstlane(gs);
            float le[8];
            { f32x2 pa[8], pb[8]; const LAS float* reG = reT + gs * 8 * DM + 4 * lane;
#pragma unroll
              for (int e = 0; e < 8; ++e) { pa[e] = (f32x2){0.f, 0.f}; pb[e] = (f32x2){0.f, 0.f}; }
#pragma unroll
              for (int j = 0; j < 4; ++j) { const f32x2 vxy = {v[j][0], v[j][1]}, vzw = {v[j][2], v[j][3]};
#pragma unroll
                  for (int e = 0; e < 8; ++e) { const f32x4 w = *(const LAS f32x4*)(reG + e * DM + 256 * j);
                      pa[e] = __builtin_elementwise_fma(vxy, (f32x2){w[0], w[1]}, pa[e]); pb[e] = __builtin_elementwise_fma(vzw, (f32x2){w[2], w[3]}, pb[e]); } }
#pragma unroll
              for (int e = 0; e < 8; ++e) { const f32x2 q = pa[e] + pb[e]; le[e] = q.x + q.y; }
              wave_sum_n<8>(le);
#pragma unroll
              for (int e = 0; e < 8; ++e) le[e] += reb[gs * 8 + e]; }
            int e1 = 0; float v1 = le[0];
#pragma unroll
            for (int e = 1; e < 8; ++e) if (le[e] > v1) { v1 = le[e]; e1 = e; }
            int e2 = -1; float v2 = -INFINITY;
#pragma unroll
            for (int e = 0; e < 8; ++e) if (e != e1 && le[e] > v2) { v2 = le[e]; e2 = e; }
            const float wa = __builtin_amdgcn_rcpf(1.0f + __expf(v2 - v1)), wb = 1.0f - wa;
            if (lane == 0) { u32x4 ro; ro.x = (unsigned)(gs * 8 + e1); ro.y = (unsigned)(gs * 8 + e2); ro.z = __builtin_bit_cast(unsigned, ptop * wa); ro.w = __builtin_bit_cast(unsigned, ptop * wb);
                *(u32x4*)(X.ws + WS_ROUTE + (size_t)t * 16) = ro;
                __hip_atomic_fetch_add(hist + gs * 8 + e1, 1, __ATOMIC_RELAXED, __HIP_MEMORY_SCOPE_WORKGROUP); __hip_atomic_fetch_add(hist + gs * 8 + e2, 1, __ATOMIC_RELAXED, __HIP_MEMORY_SCOPE_WORKGROUP); }
        };
#pragma unroll 1
        for (int i = 0; i < 32; i += 2) { row(xa, ma, i); row(xb, mb, i + 1); }
        __syncthreads();
        if (X.tid < 32) ((int*)(X.ws + WS_HIST))[rb * 32 + X.tid] = hist[X.tid];
        __syncthreads();
    }
}

__device__ __forceinline__ void ln1_router_mfma(const Ctx& X, const CArgs* ap, int l, bool dummy = false) {
    struct { const float *ln1g, *ln1b, *rgb, *reb; } a = {ap->ln1g, ap->ln1b, ap->rgb, ap->reb};
    const bf16* xin = (const bf16*)((const unsigned char*)ap->out + XR_OFF);
    const int lane = X.lane, jr = lane & 31, hh = lane >> 5; const bf16* MIX = (const bf16*)(X.ws + WS_MIX); bf16* X1B = (bf16*)(X.ws + (dummy ? WS_Y : WS_XB));
    constexpr int WP = 1032;
    LAS bf16* wr = (LAS bf16*)X.lds;
    LAS float* rbias = (LAS float*)(X.lds + 40 * WP * 2);
    LAS int* hist = (LAS int*)(X.lds + LDSCTL_OFF + 256);
    { const float* ret = (const float*)(X.ws + WS_RET) + (size_t)l * 32 * DM; const float* rgt = (const float*)(X.ws + WS_RGT) + (size_t)l * 4 * DM;
      for (int i = X.tid; i < 40 * 256; i += 512) { const int row = i >> 8, c4 = i & 255; f32x4 w = {0.f, 0.f, 0.f, 0.f};
          if (row < 32) w = *(const f32x4*)(ret + (size_t)row * DM + 4 * c4); else if (row < 36) w = *(const f32x4*)(rgt + (size_t)(row - 32) * DM + 4 * c4);
          u32x2 p; p.x = pk2(w[0], w[1]); p.y = pk2(w[2], w[3]); *(LAS u32x2*)(wr + row * WP + 4 * c4) = p; }
      if (X.tid < 32) rbias[X.tid] = a.reb[l * 32 + X.tid]; else if (X.tid < 36) rbias[X.tid] = a.rgb[l * 4 + X.tid - 32]; }
    f32x4 g[4], bb[4];
#pragma unroll
    for (int j = 0; j < 4; ++j) { g[j] = *(const f32x4*)(a.ln1g + l * DM + 4 * lane + 256 * j); bb[j] = *(const f32x4*)(a.ln1b + l * DM + 4 * lane + 256 * j); }
    auto ldm = [&](int t, int j) __attribute__((always_inline)) -> u32x2 {
        if (MIX_FP8) { u32x2 r; r.x = *(const unsigned*)((const unsigned char*)MIX + (size_t)t * DM + 4 * lane + 256 * j); r.y = 0u; return r; }
        return *(const u32x2*)(MIX + (size_t)t * DM + 4 * lane + 256 * j); };
    for (int rb = X.c; rb < NT / 256; rb += X.G) {
        if (X.tid < 32) hist[X.tid] = 0;
        __syncthreads();
        const int tw = rb * 256 + X.wave * 32;
        u32x2 xa[4], xb[4]; u32x2 ma[4], mb[4];
#pragma unroll
        for (int j = 0; j < 4; ++j) { xa[j] = *(const u32x2*)(xin + (size_t)tw * DM + 4 * lane + 256 * j); ma[j] = ldm(tw, j); }
#pragma unroll
        for (int j = 0; j < 4; ++j) { xb[j] = *(const u32x2*)(xin + (size_t)(tw + 1) * DM + 4 * lane + 256 * j); mb[j] = ldm(tw + 1, j); }
        auto row = [&](u32x2 (&xn)[4], u32x2 (&mn)[4], const int i) __attribute__((always_inline)) {
            const int t = tw + i;
            f32x4 v[4]; float s = 0.f;
#pragma unroll
            for (int j = 0; j < 4; ++j) { const u32x2 xw = xn[j]; const u32x2 mw = mn[j];
                f32x4 mf;
                if (MIX_FP8) mf = pg8::fp8x4_to_f32(mw.x) * (1.0f / MIX_SCALE); else mf = (f32x4){bflo(mw.x), bfhi(mw.x), bflo(mw.y), bfhi(mw.y)};
                v[j][0] = ALPHA * bflo(xw.x) + mf[0]; v[j][1] = ALPHA * bfhi(xw.x) + mf[1]; v[j][2] = ALPHA * bflo(xw.y) + mf[2]; v[j][3] = ALPHA * bfhi(xw.y) + mf[3];
                s += (v[j][0] + v[j][1]) + (v[j][2] + v[j][3]); }
            if (i + 2 < 32) {
#pragma unroll
                for (int j = 0; j < 4; ++j) { xn[j] = *(const u32x2*)(xin + (size_t)(t + 2) * DM + 4 * lane + 256 * j); mn[j] = ldm(t + 2, j); } }
            const float mean = wave_sum(s) * (1.f / DM); float s2 = 0.f;
#pragma unroll
            for (int j = 0; j < 4; ++j) { v[j] = v[j] - mean; s2 += (v[j][0] * v[j][0] + v[j][1] * v[j][1]) + (v[j][2] * v[j][2] + v[j][3] * v[j][3]); }
            const float rstd = __builtin_amdgcn_rsqf(wave_sum(s2) * (1.f / DM) + 1e-5f);
#pragma unroll
            for (int j = 0; j < 4; ++j) { v[j] = v[j] * rstd * g[j] + bb[j];
                u32x2 w; w.x = pk2(v[j][0], v[j][1]); w.y = pk2(v[j][2], v[j][3]); stg8<NT_LN>(X1B + (size_t)t * DM + 4 * lane + 256 * j, w); }
        };
#pragma unroll 1
        for (int i = 0; i < 32; i += 2) { row(xa, ma, i); row(xb, mb, i + 1); }
        asm volatile("s_waitcnt vmcnt(0)" ::: "memory");
        f32x16 acc0, acc1;
#pragma unroll
        for (int i = 0; i < 16; ++i) { acc0[i] = 0.f; acc1[i] = 0.f; }
        const bf16* bp = X1B + (size_t)(tw + jr) * DM + 16 * hh;
        const LAS bf16* a0p = wr + jr * WP + 16 * hh; const LAS bf16* a1p = wr + (32 + (jr < 8 ? jr : 7)) * WP + 16 * hh;
#pragma unroll 4
        for (int t2 = 0; t2 < 32; ++t2) {
            const bf16x8 b0 = *(const bf16x8*)(bp + 32 * t2), b1 = *(const bf16x8*)(bp + 32 * t2 + 8);
            const bf16x8 a00 = *(const LAS bf16x8*)(a0p + 32 * t2), a01 = *(const LAS bf16x8*)(a0p + 32 * t2 + 8), a10 = *(const LAS bf16x8*)(a1p + 32 * t2), a11 = *(const LAS bf16x8*)(a1p + 32 * t2 + 8);
            acc0 = __builtin_amdgcn_mfma_f32_32x32x16_bf16(a00, b0, acc0, 0, 0, 0); acc1 = __builtin_amdgcn_mfma_f32_32x32x16_bf16(a10, b0, acc1, 0, 0, 0);
            acc0 = __builtin_amdgcn_mfma_f32_32x32x16_bf16(a01, b1, acc0, 0, 0, 0); acc1 = __builtin_amdgcn_mfma_f32_32x32x16_bf16(a11, b1, acc1, 0, 0, 0);
        }
        float gl[4];
#pragma unroll
        for (int i = 0; i < 4; ++i) { const auto tt = __builtin_amdgcn_permlane32_swap(__float_as_uint(acc1[i]), __float_as_uint(acc1[i]), false, false); gl[i] = __uint_as_float(tt[0]) + rbias[32 + i]; }
        int gs = 0; float gm = gl[0];
#pragma unroll
        for (int gi = 1; gi < 4; ++gi) if (gl[gi] > gm) { gm = gl[gi]; gs = gi; }
        float den = 0.f;
#pragma unroll
        for (int gi = 0; gi < 4; ++gi) den += __expf(gl[gi] - gm);
        const float ptop = __builtin_amdgcn_rcpf(den);
        float le[8];
#pragma unroll
        for (int k = 0; k < 4; ++k) { const float mine = gs == 0 ? acc0[k] : (gs == 1 ? acc0[4 + k] : (gs == 2 ? acc0[8 + k] : acc0[12 + k]));
            const auto tt = __builtin_amdgcn_permlane32_swap(__float_as_uint(mine), __float_as_uint(mine), false, false);
            le[k] = __uint_as_float(tt[0]); le[4 + k] = __uint_as_float(tt[1]); }
#pragma unroll
        for (int e = 0; e < 8; ++e) le[e] += rbias[gs * 8 + e];
        int e1 = 0; float v1 = le[0];
#pragma unroll
        for (int e = 1; e < 8; ++e) if (le[e] > v1) { v1 = le[e]; e1 = e; }
        int e2 = -1; float v2 = -INFINITY;
#pragma unroll
        for (int e = 0; e < 8; ++e) if (e != e1 && le[e] > v2) { v2 = le[e]; e2 = e; }
        const float wa = __builtin_amdgcn_rcpf(1.0f + __expf(v2 - v1)), wb = 1.0f - wa;
        if (hh == 0) { u32x4 ro; ro.x = (unsigned)(gs * 8 + e1); ro.y = (unsigned)(gs * 8 + e2); ro.z = __builtin_bit_cast(unsigned, ptop * wa); ro.w = __builtin_bit_cast(unsigned, ptop * wb);
            *(u32x4*)(X.ws + WS_ROUTE + (size_t)(tw + jr) * 16) = ro;
            __hip_atomic_fetch_add(hist + gs * 8 + e1, 1, __ATOMIC_RELAXED, __HIP_MEMORY_SCOPE_WORKGROUP); __hip_atomic_fetch_add(hist + gs * 8 + e2, 1, __ATOMIC_RELAXED, __HIP_MEMORY_SCOPE_WORKGROUP); }
        __syncthreads();
        if (X.tid < 32) ((int*)(X.ws + WS_HIST))[rb * 32 + X.tid] = hist[X.tid];
        __syncthreads();
    }
}

__device__ __forceinline__ void moe_dispatch(const Ctx& X) {
    LAS int* cnt = (LAS int*)(X.lds);
    LAS int* pre = cnt + 32;
    LAS int* ebase = cnt + 64;
    LAS int* wcnt = cnt + 128;
    const int* HIST = (const int*)(X.ws + WS_HIST); int* STOK = (int*)(X.ws + WS_STOK); float* SW = (float*)(X.ws + WS_SW); int* TSLOT = (int*)(X.ws + WS_TSLOT); int* TILEE = (int*)(X.ws + WS_TILEE);
    for (int rb = X.c; rb < NT / 256; rb += X.G) {
        if (X.tid < 64) cnt[X.tid] = 0;
        __syncthreads();
        { const int e = X.tid & 31, part = X.tid >> 5; int sa = 0, sp = 0;
          for (int q = 0; q < 16; ++q) { const int b2 = part * 16 + q; const int hv = HIST[b2 * 32 + e]; sa += hv; if (b2 < rb) sp += hv; }
          __hip_atomic_fetch_add(cnt + e, sa, __ATOMIC_RELAXED, __HIP_MEMORY_SCOPE_WORKGROUP); __hip_atomic_fetch_add(pre + e, sp, __ATOMIC_RELAXED, __HIP_MEMORY_SCOPE_WORKGROUP); }
        __syncthreads();
        if (X.tid < 64) { const int n = X.tid < 32 ? cnt[X.tid] : 0; const int pad = (n + 255) & ~255; int inc = pad;
#pragma unroll
            for (int o = 1; o < 32; o <<= 1) { const int u = __shfl_up(inc, o); if ((X.tid & 63) >= o) inc += u; }
            if (X.tid < 32) { ebase[X.tid] = inc - pad; if (X.tid == 31) ebase[32] = inc; } }
        __syncthreads();
        const int tl = X.tid >> 1, kk = X.tid & 1, t = rb * 256 + tl;
        const u32x4 ro = *(const u32x4*)(X.ws + WS_ROUTE + (size_t)t * 16);
        const int e = (int)(kk ? ro.y : ro.x); const float w = __builtin_bit_cast(float, kk ? ro.w : ro.z);
        int rank = 0;
        for (int ee = 0; ee < 32; ++ee) { const unsigned long long mm = __ballot(e == ee);
            if (e == ee) rank = __builtin_popcountll(mm & ((1ull << X.lane) - 1ull));
            if (X.lane == 0) wcnt[X.wave * 32 + ee] = __builtin_popcountll(mm); }
        __syncthreads();
        int off = 0;
        for (int w2 = 0; w2 < X.wave; ++w2) off += wcnt[w2 * 32 + e];
        const int slot = ebase[e] + pre[e] + off + rank;
        STOK[slot] = t; SW[slot] = w; TSLOT[2 * t + kk] = slot;
        if (rb < 32) { const int e2 = rb; for (int s = ebase[e2] + cnt[e2] + X.tid; s < ebase[e2 + 1]; s += 512) { STOK[s] = 0; SW[s] = 0.f; } }
        if (rb == 0) { const int ntl = ebase[32] >> 8;
            for (int tile = X.tid; tile < ntl; tile += 512) { int ee = 0; while (ee < 31 && ebase[ee + 1] <= tile * 256) ++ee; TILEE[tile] = ee; }
            if (X.tid == 0) TILEE[1024] = ntl; }
        __syncthreads();
    }
}

__device__ __forceinline__ void ln2_phase(const Ctx& X, const CArgs* ap, int l, bool first, bool dummy = false) {
    struct { const float *ln1g, *ln1b, *ln2g, *ln2b; } a = {ap->ln1g, ap->ln1b, ap->ln2g, ap->ln2b}; float* outw = dummy ? (float*)(X.ws + WS_Y + 272 * MiB) : ap->out; (void)first;
    const bool last = (l + 1 == DEPTH);
    const bf16* xin = LN2_X1B ? (const bf16*)(X.ws + WS_XB) : (last ? (const bf16*)(X.ws + WS_KVA) : (const bf16*)((const unsigned char*)ap->out + XR_OFF));
    const int lane = X.lane; const bf16* Y = (const bf16*)(X.ws + WS_Y); const bf16* MIX = (const bf16*)(X.ws + WS_MIX); const int* TSLOT = (const int*)(X.ws + WS_TSLOT); bf16* XBp = dummy ? (bf16*)(X.ws + WS_MIX) : (bf16*)((unsigned char*)ap->out + XR_OFF);
    auto ldy = [&](int slot, int j) __attribute__((always_inline)) -> u32x2 {
        if (Y_FP8) { u32x2 r; r.x = ldg_s<unsigned>((const unsigned char*)Y + (size_t)slot * DM + 4 * lane + 256 * j); r.y = 0u; return r; }
        return ldg_s<u32x2>(Y + (size_t)slot * DM + 4 * lane + 256 * j); };
    f32x4 g1[4], b1[4], g[4], bb[4];
#pragma unroll
    for (int j = 0; j < 4; ++j) { g1[j] = *(const f32x4*)(a.ln1g + l * DM + 4 * lane + 256 * j); b1[j] = *(const f32x4*)(a.ln1b + l * DM + 4 * lane + 256 * j);
        g[j] = *(const f32x4*)(a.ln2g + l * DM + 4 * lane + 256 * j); bb[j] = *(const f32x4*)(a.ln2b + l * DM + 4 * lane + 256 * j); }
    for (int rb = X.c; rb < NT / 256; rb += X.G) {
        const int tb = rb * 256 + X.wave * 32;
        const int myslots_a = TSLOT[2 * (tb + (lane & 31))], myslots_b = TSLOT[2 * (tb + (lane & 31)) + 1];
        u32x2 xn[4]; u32x2 mn[4], yan[4], ybn[4];
        { const int sa = __builtin_amdgcn_readlane(myslots_a, 0), sb = __builtin_amdgcn_readlane(myslots_b, 0);
#pragma unroll
          for (int j = 0; j < 4; ++j) { xn[j] = *(const u32x2*)(xin + (size_t)tb * DM + 4 * lane + 256 * j); mn[j] = LN2_X1B ? (u32x2){0u, 0u} : *(const u32x2*)(MIX + (size_t)tb * DM + 4 * lane + 256 * j);
              yan[j] = ldy(sa, j); ybn[j] = ldy(sb, j); } }
        for (int i = 0; i < 32; ++i) {
            const int t = tb + i;
            f32x4 v[4]; float s = 0.f;
#pragma unroll
            for (int j = 0; j < 4; ++j) { const u32x2 xw = xn[j]; const u32x2 mw = mn[j];
                if (LN2_X1B) { v[j][0] = bflo(xw.x); v[j][1] = bfhi(xw.x); v[j][2] = bflo(xw.y); v[j][3] = bfhi(xw.y); }
                else { v[j][0] = ALPHA * bflo(xw.x) + bflo(mw.x); v[j][1] = ALPHA * bfhi(xw.x) + bfhi(mw.x); v[j][2] = ALPHA * bflo(xw.y) + bflo(mw.y); v[j][3] = ALPHA * bfhi(xw.y) + bfhi(mw.y);
                    s += (v[j][0] + v[j][1]) + (v[j][2] + v[j][3]); } }
            u32x2 ya[4], yb[4];
#pragma unroll
            for (int j = 0; j < 4; ++j) { ya[j] = yan[j]; yb[j] = ybn[j]; }
            if (i + 1 < 32) { const int sa = __shfl(myslots_a, i + 1), sb = __shfl(myslots_b, i + 1);
#pragma unroll
                for (int j = 0; j < 4; ++j) { xn[j] = *(const u32x2*)(xin + (size_t)(t + 1) * DM + 4 * lane + 256 * j); if (!LN2_X1B) mn[j] = *(const u32x2*)(MIX + (size_t)(t + 1) * DM + 4 * lane + 256 * j);
                    yan[j] = ldy(sa, j); ybn[j] = ldy(sb, j); } }
            if (!LN2_X1B) { const float mean = wave_sum(s) * (1.f / DM); float s2 = 0.f;
#pragma unroll
              for (int j = 0; j < 4; ++j) { v[j] = v[j] - mean; s2 += (v[j][0] * v[j][0] + v[j][1] * v[j][1]) + (v[j][2] * v[j][2] + v[j][3] * v[j][3]); }
              const float rstd = 1.0f / sqrtf(wave_sum(s2) * (1.f / DM) + 1e-5f);
#pragma unroll
              for (int j = 0; j < 4; ++j) v[j] = v[j] * rstd * g1[j] + b1[j]; }
            s = 0.f;
#pragma unroll
            for (int j = 0; j < 4; ++j) { const f32x4 xv = v[j];
                if (Y_FP8) { const f32x4 fa = pg8::fp8x4_to_f32(ya[j].x), fb = pg8::fp8x4_to_f32(yb[j].x);
#pragma unroll
                    for (int e = 0; e < 4; ++e) v[j][e] = ALPHA * xv[e] + (fa[e] + fb[e]) * (1.0f / Y_SCALE);
                } else { v[j][0] = ALPHA * xv[0] + (bflo(ya[j].x) + bflo(yb[j].x)); v[j][1] = ALPHA * xv[1] + (bfhi(ya[j].x) + bfhi(yb[j].x)); v[j][2] = ALPHA * xv[2] + (bflo(ya[j].y) + bflo(yb[j].y)); v[j][3] = ALPHA * xv[3] + (bfhi(ya[j].y) + bfhi(yb[j].y)); }
                s += (v[j][0] + v[j][1]) + (v[j][2] + v[j][3]); }
            const float mean = wave_sum(s) * (1.f / DM); float s2 = 0.f;
#pragma unroll
            for (int j = 0; j < 4; ++j) { v[j] = v[j] - mean; s2 += (v[j][0] * v[j][0] + v[j][1] * v[j][1]) + (v[j][2] * v[j][2] + v[j][3] * v[j][3]); }
            const float rstd = 1.0f / sqrtf(wave_sum(s2) * (1.f / DM) + 1e-5f);
#pragma unroll
            for (int j = 0; j < 4; ++j) { v[j] = v[j] * rstd * g[j] + bb[j];
                if (last || dummy) stgf4<NT_LN>(outw + (size_t)t * DM + 4 * lane + 256 * j, v[j]);
                else { u32x2 w; w.x = pk2(v[j][0], v[j][1]); w.y = pk2(v[j][2], v[j][3]); stg8<NT_LN>(XBp + (size_t)t * DM + 4 * lane + 256 * j, w); } }
        }
    }
}

#ifndef REP_P0
#define REP_P0 1
#endif
#ifndef REP_P5
#define REP_P5 1
#endif
#ifndef REP_P9
#define REP_P9 1
#endif
#ifndef REP_BAR
#define REP_BAR 1
#endif
#ifndef REP_P1
#define REP_P1 1
#endif
#ifndef REP_P2A
#define REP_P2A 1
#endif
#ifndef REP_P2B
#define REP_P2B 1
#endif
#ifndef REP_P2C
#define REP_P2C 1
#endif
#ifndef REP_P2D
#define REP_P2D 1
#endif
#ifndef REP_P3A
#define REP_P3A 1
#endif
#ifndef REP_P3B
#define REP_P3B 1
#endif
#ifndef REP_P3C
#define REP_P3C 1
#endif
#ifndef REP_P4
#define REP_P4 1
#endif
#ifndef REP_P6
#define REP_P6 1
#endif
#ifndef REP_P7
#define REP_P7 1
#endif
#ifndef REP_P8
#define REP_P8 1
#endif
__global__ void __launch_bounds__(512, 2) mk_fwd(Args a) {
    extern __shared__ __attribute__((aligned(16))) unsigned char lds_raw[];
    LAS unsigned char* const lds0 = (LAS unsigned char*)lds_raw;
    for (int u = threadIdx.x; u < (LDS_BYTES - LDSCTL_OFF) / 4; u += 512) ((LAS unsigned*)(lds0 + LDSCTL_OFF))[u] = 0u;
    __syncthreads();
    unsigned* barw = (unsigned*)(a.ws + WS_CTL) + CW_BAR;
    XcdBarrier bar; bar.bar = barw; bar.x = 0; bar.st = nullptr;
    if (a.use_bar) bar = xcd_barrier_post(barw, (volatile LAS unsigned*)(lds0 + LDSCTL_OFF) + 8);
#define MKCTX() Ctx X; const CArgs* ap = (const CArgs*)__builtin_amdgcn_kernarg_segment_ptr(); asm volatile("" : "+s"(ap)); { int t_ = threadIdx.x; asm volatile("" : "+v"(t_)); X.lds = lds0; X.tid = t_; X.lane = t_ & 63; X.wave = __builtin_amdgcn_readfirstlane(t_ >> 6); \
        unsigned char* w_ = ap->ws; X.G = gridDim.x; X.c = blockIdx.x; X.vcu = (X.G % 8 == 0) ? (X.c % 8) * (X.G / 8) + X.c / 8 : X.c; X.ws = w_; }
#ifndef P2M
#define P2M 31
#endif
#ifndef PH_MASK0
#define PH_MASK0 1
#endif
#define GBAR() do { if (a.use_bar) for (int rb_ = 0; rb_ < REP_BAR; ++rb_) xcd_barrier(bar); } while (0)

    if ((PH_MASK0 & 1) && a.l_lo == 0 && a.ph_lo == 0) { MKCTX(); for (int rep = 0; rep < REP_P0; ++rep) { prologue(X, ap); __syncthreads(); } GBAR(); }

    for (int l = a.l_lo; l < a.l_hi; ++l) {
        const int lo = (l == a.l_lo) ? (a.ph_lo < 1 ? 1 : a.ph_lo) : 1, hi = (l == a.l_hi - 1) ? a.ph_hi : 10;
#ifndef PH_MASK
#define PH_MASK 0x3ff
#endif
#define IN(k) (((PH_MASK >> (k)) & 1) && lo <= (k) && (k) < hi)
        if (IN(1)) { MKCTX();
            pg8::Gemm g{(const bf16*)((const unsigned char*)ap->out + XR_OFF), (const bf16*)(X.ws + WS_WIN) + (size_t)l * NIN * DM, DM, nullptr};
            pg8::StaticOrder S; S.init(NT, NIN, X.G, X.c, REP_P1);
            pg8::RopeTabs R{ap->pos};
            pg8::EpiGroups<InProjDesc> E{InProjDesc{X.ws}, R, nullptr, 0, 0.f, 0.f};
            pg8::gemm_phase<pg8::EpiGroups<InProjDesc>, pg8::StaticOrder, false>(X.lds, g, S, E, X.tid);
            GBAR();
        }
        if (IN(2)) { MKCTX();
            {
                pg8::Gemm g{(const bf16*)(X.ws + WS_CQ), (const bf16*)(X.ws + WS_WUQ) + (size_t)l * 768 * 256, 256, nullptr};
                pg8::StaticOrder S; S.init(NT, 768, X.G, X.c, REP_P2A);
                pg8::RopeTabs R{ap->pos};
                pg8::EpiGroups<UqDesc> E{UqDesc{X.ws}, R, (const float*)(X.ws + WS_SSQ), 8, 1.0f / 256.0f, 1e-6f};
                pg8::gemm_phase<pg8::EpiGroups<UqDesc>, pg8::StaticOrder, false>(X.lds, g, S, E, X.tid);
            }
            {
                MKCTX();
                int kq = 128; asm volatile("" : "+s"(kq));
                pg8::Gemm g{(const bf16*)(X.ws + WS_T1), (const bf16*)(X.ws + WS_WUKV) + (size_t)l * 1024 * 128, kq, nullptr};
                pg8::StaticOrder S; S.init(NT, 1024, X.G, X.c, REP_P2A);
                pg8::EpiPlainT<NT_KVA> E{(bf16*)(X.ws + WS_KVA), 1024, (const float*)(X.ws + WS_SSQ) + (size_t)NT * 8, 4, 1.0f / 128.0f, 1e-6f, X.lds + LDS_X_OFF};
                pg8::gemm_phase<decltype(E), pg8::StaticOrder, false>(X.lds, g, S, E, X.tid);
            }
            __syncthreads();
            for (int rep = 0; rep < REP_P2B; ++rep) convert_experts(X, ap, l);
            __syncthreads();
            for (int rep = 0; rep < REP_P2C; ++rep) for (int U = X.vcu; U < NB * 32; U += X.G) { const int b = U >> 5, pr = U & 31;
                dsa_index_unit(X, b, 32 * pr); dsa_index_unit(X, b, 32 * (63 - pr)); }
            __syncthreads();
#pragma unroll 1
            for (int cfg = 0; cfg < 3 * REP_P2D; ++cfg) { const int cfgi = cfg % 3;
                fa::Params P; const size_t co = (size_t)cfgi * NT * 256;
                P.Q = (const bf16*)(X.ws + WS_DQ) + co; P.q_pitch = 256; P.K1 = (const bf16*)(X.ws + WS_DK) + co; P.k1_pitch = 256; P.K2 = nullptr; P.k2_pitch = 0; P.k2_col = 0;
                P.V = (const bf16*)(X.ws + WS_DV) + co; P.v_pitch = 256; P.O = (bf16*)(X.ws + WS_OD) + co; P.o_pitch = 256; P.LSE = (float*)(X.ws + WS_LSE) + (size_t)cfgi * NT * 4; P.lse_pitch = 4; P.BM = nullptr;
                P.CL = cfgi == 0 ? 2048 : (cfgi == 1 ? 512 : 128); P.W = 128;
                const int vcu = X.vcu, G = X.G, wv = X.wave, CLc = P.CL;
                fa::attn_stream<64, 0, 2>(P, X.lds, X.tid, (NB * 2 * 16 - vcu + G - 1) / G, [=](int j) { const int U = vcu + j * G, bh = U >> 4, qb = U & 15, b = bh >> 1, hp = bh & 1;
                    const int q0 = 128 * qb, hh = 2 * hp + (wv >> 2); int klo = q0 & ~(CLc - 1); if (q0 - 128 > klo) klo = q0 - 128;
                    return fa::UnitDesc{b * SEQ, q0 + 32 * (wv & 3), 64 * hh, 64 * hh, hh, 128 * hp, 128 * hp, klo >> 6, (q0 + 127) >> 6}; });
            }
            GBAR();
        }
        if (IN(3)) { MKCTX();
            {   fa::Params P; P.Q = (const bf16*)(X.ws + WS_QA); P.q_pitch = 768; P.K1 = (const bf16*)(X.ws + WS_KVA); P.k1_pitch = 1024; P.K2 = (const bf16*)(X.ws + WS_KPE); P.k2_pitch = 32; P.k2_col = 0;
                P.V = (const bf16*)(X.ws + WS_KVA); P.v_pitch = 1024; P.O = (bf16*)(X.ws + WS_XB); P.o_pitch = DM; P.LSE = nullptr; P.lse_pitch = 0; P.BM = nullptr; P.CL = 2048; P.W = 1 << 20;
                const int vcu = X.vcu, G = X.G, wv = X.wave;
                fa::attn_stream<96, 2, 1>(P, X.lds, X.tid, 2 * ((NB * 8 * 4 - vcu + G - 1) / G), [=](int j) { const int U = vcu + (j >> 1) * G, bh = U >> 2, pr = U & 3, b = bh >> 3, hd = bh & 7;
                    const int qb = (j & 1) ? 7 - pr : pr, q0 = 256 * qb;
                    return fa::UnitDesc{b * SEQ, q0 + 32 * wv, 96 * hd, 64 * hd, 0, 128 * hd, 128 * hd + 64, 0, (q0 + 255) >> 6}; });
            }
            {   fa::Params P; P.Q = (const bf16*)(X.ws + WS_BQ); P.q_pitch = 256; P.K1 = (const bf16*)(X.ws + WS_BK); P.k1_pitch = 64; P.k1_col = 0; P.K2 = nullptr; P.k2_pitch = 0; P.k2_col = 0;
                P.V = (const bf16*)(X.ws + WS_BV); P.v_pitch = 64; P.v_col = 0; P.O = (bf16*)(X.ws + WS_XB); P.o_pitch = DM; P.LSE = nullptr; P.lse_pitch = 0; P.BM = (const unsigned*)(X.ws + WS_BM); P.CL = 2048; P.W = 1 << 20;
                const int hd = X.wave & 3, sub = X.wave >> 2, vcu = X.vcu, G = X.G;
                fa::attn_stream<64, 1, 1>(P, X.lds, X.tid, 2 * ((NB * 16 - vcu + G - 1) / G), [=](int j) { const int U = vcu + (j >> 1) * G, b = U >> 4, pr = U & 15;
                    const int qb = (j & 1) ? 31 - pr : pr, q0 = 64 * qb;
                    return fa::UnitDesc{b * SEQ, q0 + 32 * sub, 64 * hd, 512 + 64 * hd, 0, 0, 0, 0, qb}; });
            }
            for (int rep = 0; rep < REP_P3C; ++rep) dil_combine(X);
            GBAR();
        }
        if (IN(4)) { MKCTX();
            pg8::Gemm g{(const bf16*)(X.ws + WS_XB), (const bf16*)(X.ws + WS_WO) + (size_t)l * DM * DM, DM, nullptr};
            pg8::StaticOrder S; S.init(NT, DM, X.G, X.c, REP_P4);
#if MIX_FP8 && ROUTER_MFMA && LN2_X1B
            pg8::EpiFp8T<NT_MIX> E{X.ws + WS_MIX, DM, MIX_SCALE, X.lds + LDS_X_OFF};
#else
            pg8::EpiPlainT<NT_MIX> E{(bf16*)(X.ws + WS_MIX), DM, nullptr, 0, 0.f, 0.f, X.lds + LDS_X_OFF};
#endif
            pg8::gemm_phase<decltype(E), pg8::StaticOrder, false>(X.lds, g, S, E, X.tid);
            GBAR();
        }
#if ROUTER_MFMA
        if (IN(5)) { MKCTX(); if (REP_P5 > 1) ln1_router_mfma(X, ap, l, true); ln1_router_mfma(X, ap, l); GBAR(); }
#else
        if (IN(5)) { MKCTX(); if (REP_P5 > 1) ln1_router(X, ap, l, l == 0, true); ln1_router(X, ap, l, l == 0); GBAR(); }
#endif
        if (IN(6)) { MKCTX(); for (int rep = 0; rep < REP_P6; ++rep) moe_dispatch(X); GBAR(); }
        if (IN(7)) { MKCTX();
            const int* TILEE = (const int*)(X.ws + WS_TILEE);
            pg8::Gemm g{(const bf16*)(X.ws + WS_XB), (const bf16*)(X.ws + WS_WGU), DM, (const int*)(X.ws + WS_STOK)};
            pg8::GroupedOrder S{TILEE, TILEE[1024], 2, X.G, X.c};
            pg8::EpiGateUpT<NT_H> E{(bf16*)(X.ws + WS_H), (const float*)(X.ws + WS_SW)};
            for (int rep = 0; rep < REP_P7; ++rep) pg8::gemm_phase<decltype(E), pg8::GroupedOrder, true>(X.lds, g, S, E, X.tid);
            GBAR();
        }
        if (IN(8)) { MKCTX();
            const int* TILEE = (const int*)(X.ws + WS_TILEE);
            pg8::Gemm g{(const bf16*)(X.ws + WS_H), (const bf16*)(X.ws + WS_WD), FH, nullptr};
            pg8::GroupedOrder S{TILEE, TILEE[1024], 4, X.G, X.c};
#if Y_FP8
            pg8::EpiFp8T<NT_Y> E{X.ws + WS_Y, DM, Y_SCALE, X.lds + LDS_X_OFF};
#else
            pg8::EpiPlainT<NT_Y> E{(bf16*)(X.ws + WS_Y), DM, nullptr, 0, 0.f, 0.f, X.lds + LDS_X_OFF};
#endif
            for (int rep = 0; rep < REP_P8; ++rep) pg8::gemm_phase<decltype(E), pg8::GroupedOrder, false>(X.lds, g, S, E, X.tid);
            GBAR();
        }
        if (IN(9)) { MKCTX(); if (REP_P9 > 1) ln2_phase(X, ap, l, l == 0, true); ln2_phase(X, ap, l, l == 0); if (!(l == a.l_hi - 1)) GBAR(); }
#undef IN
    }
#undef GBAR
}

extern "C" void kernel_launch(void* const* d_in, const int* in_sizes, int n_in, void* d_out, int out_size, void* d_ws, size_t ws_size, hipStream_t stream) {
    static int grid = 0;
    if (grid == 0) {
        if (n_in != 19 || in_sizes[0] != NT * DM || out_size != NT * DM || ws_size < WS_END) { fprintf(stderr, "kernel_launch: unexpected shapes (n_in %d, in0 %d, out %d, ws %zu < %zu); nothing launched\n", n_in, n_in > 0 ? in_sizes[0] : -1, out_size, ws_size, (size_t)WS_END); grid = -1; return; }
        int dev = 0, cus = 0, per_cu = 0;
        if (hipGetDevice(&dev) != hipSuccess || hipDeviceGetAttribute(&cus, hipDeviceAttributeMultiprocessorCount, dev) != hipSuccess) { grid = -1; return; }
        if (hipFuncSetAttribute((const void*)mk_fwd, hipFuncAttributeMaxDynamicSharedMemorySize, LDS_BYTES) != hipSuccess) { fprintf(stderr, "kernel_launch: hipFuncSetAttribute failed\n"); grid = -1; return; }
        if (hipOccupancyMaxActiveBlocksPerMultiprocessor(&per_cu, (const void*)mk_fwd, 512, LDS_BYTES) != hipSuccess || per_cu < 1) fprintf(stderr, "kernel_launch: occupancy query reports %d\n", per_cu);
        (void)hipGetLastError();
        grid = cus;
    }
    if (grid < 0) return;
    (void)hipMemsetAsync((char*)d_ws + WS_CTL, 0, CTL_BYTES, stream);
    Args a{};
    a.x = (const float*)d_in[0]; a.pos = (const int*)d_in[1]; a.w_in = (const float*)d_in[2]; a.qn = (const float*)d_in[3]; a.kvn = (const float*)d_in[4];
    a.w_uq = (const float*)d_in[5]; a.w_ukv = (const float*)d_in[6]; a.w_o = (const float*)d_in[7]; a.ln1g = (const float*)d_in[8]; a.ln1b = (const float*)d_in[9];
    a.rgw = (const float*)d_in[10]; a.rgb = (const float*)d_in[11]; a.rew = (const float*)d_in[12]; a.reb = (const float*)d_in[13];
    a.wg = (const float*)d_in[14]; a.wu = (const float*)d_in[15]; a.wd = (const float*)d_in[16]; a.ln2g = (const float*)d_in[17]; a.ln2b = (const float*)d_in[18];
    a.out = (float*)d_out; a.ws = (unsigned char*)d_ws; a.pad = 0;
#if MK_MULTI
    a.use_bar = 0;
    a.l_lo = 0; a.l_hi = 0; a.ph_lo = 0; a.ph_hi = 0;
    hipLaunchKernelGGL(mk_fwd, dim3(grid), dim3(512), LDS_BYTES, stream, a);
    for (int l = 0; l < DEPTH; ++l)
        for (int ph = 1; ph < 10; ++ph) { a.l_lo = l; a.l_hi = l + 1; a.ph_lo = ph; a.ph_hi = ph + 1; hipLaunchKernelGGL(mk_fwd, dim3(grid), dim3(512), LDS_BYTES, stream, a); }
#else
    a.use_bar = 1; a.l_lo = 0; a.l_hi = DEPTH; a.ph_lo = 0; a.ph_hi = 10;
    hipLaunchKernelGGL(mk_fwd, dim3(grid), dim3(512), LDS_BYTES, stream, a);
#endif
    const hipError_t le = hipPeekAtLastError();
    if (le != hipSuccess) fprintf(stderr, "kernel_launch: launch failed: %s\n", hipGetErrorName(le));
}
```

```cpp
#include <hip/hip_runtime.h>
#include <cstdio>
#include <cstdint>

#define LAS __attribute__((address_space(3)))
#define GAS __attribute__((address_space(1)))
typedef unsigned short bf16;
typedef short bf16x8 __attribute__((ext_vector_type(8)));
typedef short s16x4 __attribute__((ext_vector_type(4)));
typedef float f32x2 __attribute__((ext_vector_type(2)));
typedef float f32x4 __attribute__((ext_vector_type(4)));
typedef float f32x16 __attribute__((ext_vector_type(16)));
typedef unsigned u32x2 __attribute__((ext_vector_type(2)));
typedef unsigned u32x4 __attribute__((ext_vector_type(4)));
typedef __bf16 bf16x2_t __attribute__((ext_vector_type(2)));

#ifndef MK_MULTI
#define MK_MULTI 0
#endif

constexpr int NB = 32, SEQ = 2048, NT = NB * SEQ, DM = 1024, DEPTH = 4;
constexpr int IN_COLS = 3400, NIN = 3584;
constexpr int NEXP = 32, FH = 256;
constexpr int NSLOT = 2 * NT + NEXP * 256;
constexpr int MAXTILES = NSLOT / 256;
constexpr float ALPHA = 1.681792830507429f;
constexpr float LOG2E = 1.4426950408889634f;
constexpr float QSC64 = 0.125f * LOG2E;
constexpr float QSC96 = 0.10206207261596577f * LOG2E;
constexpr float IDX_SCALE = 0.0625f;

constexpr size_t MiB = 1u << 20;
constexpr size_t WS_CTL = 0, CTL_BYTES = 1 * MiB;
constexpr size_t WS_WIN = 1 * MiB;
constexpr size_t WS_WUQ = 29 * MiB;
constexpr size_t WS_WUKV = WS_WUQ + 3 * MiB / 2;
constexpr size_t WS_WO = WS_WUKV + 2 * MiB;
constexpr size_t WS_RGT = WS_WO + 8 * MiB;
constexpr size_t WS_RET = WS_RGT + 64 * 1024;
constexpr size_t WS_ROPE = 42 * MiB;
constexpr size_t WS_WGU = 56 * MiB;
constexpr size_t WS_WD = 88 * MiB;
constexpr size_t WS_XB = 104 * MiB;
constexpr size_t WS_A = 232 * MiB;
constexpr size_t WS_CQ = WS_A;
constexpr size_t WS_T1 = WS_CQ + 32 * MiB;
constexpr size_t WS_BK = WS_T1 + 16 * MiB;
constexpr size_t WS_BQ = WS_T1 + 32 * MiB;
constexpr size_t WS_BV = WS_BQ + 32 * MiB;
constexpr size_t WS_WI = WS_BV + 8 * MiB;
constexpr size_t WS_BQI = WS_WI + 2 * MiB;
constexpr size_t WS_SSQ = WS_BQI + 32 * MiB;
constexpr size_t WS_DQ = WS_SSQ + 4 * MiB;
constexpr size_t WS_DK = WS_DQ + 96 * MiB;
constexpr size_t WS_DV = WS_DK + 96 * MiB;
constexpr size_t WS_B = WS_DV + 96 * MiB;
constexpr size_t WS_QA = WS_B;
constexpr size_t WS_KVA = WS_QA + 96 * MiB;
constexpr size_t WS_BM = WS_KVA + 128 * MiB;
constexpr size_t WS_OD = WS_BM + 16 * MiB;
constexpr size_t WS_LSE = WS_OD + 96 * MiB;
constexpr size_t WS_MOE = WS_LSE + 4 * MiB;
constexpr size_t WS_ROUTE = WS_MOE;
constexpr size_t WS_HIST = WS_ROUTE + 1 * MiB;
constexpr size_t WS_STOK = WS_HIST + 64 * 1024;
constexpr size_t WS_SW = WS_STOK + 640 * 1024;
constexpr size_t WS_TSLOT = WS_SW + 640 * 1024;
constexpr size_t WS_TILEE = WS_TSLOT + 512 * 1024;
constexpr size_t WS_KPE = WS_MOE + 4 * MiB;
constexpr size_t WS_KI = WS_KPE + 4 * MiB;
constexpr size_t WS_END = WS_KI + 4 * MiB;
constexpr size_t WS_MIX = WS_A;
constexpr size_t WS_H = WS_A + 128 * MiB;
constexpr size_t WS_Y = WS_H + 68 * MiB;
static_assert(WS_RET + 512 * 1024 <= WS_ROPE && WS_ROPE + 14 * MiB <= WS_WGU && WS_WD + 16 * MiB <= WS_XB && WS_XB + 128 * MiB <= WS_A, "ws map 1");
static_assert(WS_Y + 272 * MiB <= WS_MOE && WS_TILEE + 8192 <= WS_END && WS_END <= 1024 * MiB, "ws map 2");
constexpr size_t ROPE_C16 = 0, ROPE_S16 = (size_t)NT * 16 * 4, ROPE_C8 = 2 * ROPE_S16, ROPE_S8 = ROPE_C8 + (size_t)NT * 8 * 4,
                 ROPE_C4 = ROPE_S8 + (size_t)NT * 8 * 4, ROPE_S4 = ROPE_C4 + (size_t)NT * 4 * 4;

constexpr int CW_BAR = 4096;
constexpr int RING_BYTES = 131072;
constexpr int LDS_X_OFF = 131072;
constexpr int LDSCTL_OFF = 147456;
constexpr int LDS_HIST_OFF = LDSCTL_OFF + 4096;
constexpr int LDS_BYTES = LDS_HIST_OFF + 4096;

#define RLX_AGENT __ATOMIC_RELAXED, __HIP_MEMORY_SCOPE_AGENT
__device__ __forceinline__ unsigned f2bf(float f) { unsigned u = __builtin_bit_cast(unsigned, f); return (u + 0x7fffu + ((u >> 16) & 1u)) >> 16; }
#ifndef Y_FP8
#define Y_FP8 1
#endif
#define Y_SCALE 64.0f
#ifndef MIX_FP8
#define MIX_FP8 0
#endif
#define MIX_SCALE 256.0f
#ifndef ROUTER_MFMA
#define ROUTER_MFMA 1
#endif
#ifndef LN2_X1B
#define LN2_X1B 1
#endif
constexpr size_t XR_OFF = (size_t)NT * DM * 2;
#ifndef NT_EPI
#define NT_EPI 1
#endif
#ifndef NT_KVA
#define NT_KVA 1
#endif
#ifndef NT_MIX
#define NT_MIX 0
#endif
#ifndef NT_H
#define NT_H 0
#endif
#ifndef NT_Y
#define NT_Y 1
#endif
#ifndef NT_LN
#define NT_LN 0
#endif
#ifndef NT_ATT
#define NT_ATT 0
#endif
#define STG_ASM(W, POL) asm volatile("global_store_dwordx" W " %0, %1, off " POL "\n\ts_nop 1" :: "v"(p), "v"(w))
template <int M, class T> __device__ __forceinline__ void stg_any16(void* p, T w) {
    if constexpr (M == 0) *(T*)p = w; else if constexpr (M == 1) __builtin_nontemporal_store(w, (T*)p);
    else if constexpr (M == 2) STG_ASM("4", "sc1"); else if constexpr (M == 3) STG_ASM("4", "sc0 sc1"); else if constexpr (M == 4) STG_ASM("4", "sc1 nt"); else STG_ASM("4", "sc0 sc1 nt"); }
template <int M> __device__ __forceinline__ void stgf4(void* p, f32x4 w) { stg_any16<M>(p, w); }
template <int M> __device__ __forceinline__ void stg16(void* p, u32x4 w) { stg_any16<M>(p, w); }
template <int M> __device__ __forceinline__ void stg8(void* p, u32x2 w) {
    if constexpr (M == 0) *(u32x2*)p = w; else if constexpr (M == 1) __builtin_nontemporal_store(w, (u32x2*)p);
    else if constexpr (M == 2) STG_ASM("2", "sc1"); else if constexpr (M == 3) STG_ASM("2", "sc0 sc1"); else if constexpr (M == 4) STG_ASM("2", "sc1 nt"); else STG_ASM("2", "sc0 sc1 nt"); }
#ifndef NT_LD
#define NT_LD 1
#endif
template <class T> __device__ __forceinline__ T ldg_s(const void* p) { if constexpr (NT_LD) return __builtin_nontemporal_load((const T*)p); else return *(const T*)p; }
__device__ __forceinline__ unsigned pk2(float lo, float hi) { f32x2 v = {lo, hi}; bf16x2_t b = __builtin_convertvector(v, bf16x2_t); return __builtin_bit_cast(unsigned, b); }
__device__ __forceinline__ float bf2f(unsigned short b) { return __builtin_bit_cast(float, ((unsigned)b) << 16); }
__device__ __forceinline__ float bflo(unsigned w) { return __builtin_bit_cast(float, w << 16); }
__device__ __forceinline__ float bfhi(unsigned w) { return __builtin_bit_cast(float, w & 0xffff0000u); }
template <int CTRL> __device__ __forceinline__ float dppf(float x) { return __builtin_bit_cast(float, __builtin_amdgcn_mov_dpp(__builtin_bit_cast(int, x), CTRL, 0xf, 0xf, true)); }
__device__ __forceinline__ float xhalf_sum(float v) { const auto t = __builtin_amdgcn_permlane32_swap(__float_as_uint(v), __float_as_uint(v), false, false); return __uint_as_float(t[0]) + __uint_as_float(t[1]); }
__device__ __forceinline__ float xhalf_max(float v) { const auto t = __builtin_amdgcn_permlane32_swap(__float_as_uint(v), __float_as_uint(v), false, false); return fmaxf(__uint_as_float(t[0]), __uint_as_float(t[1])); }
__device__ __forceinline__ float wave_sum(float v) {
    v += dppf<0xB1>(v); v += dppf<0x4E>(v); v += dppf<0x141>(v); v += dppf<0x140>(v);
    const auto s = __builtin_amdgcn_permlane16_swap(__float_as_uint(v), __float_as_uint(v), false, false);
    v = __uint_as_float(s[0]) + __uint_as_float(s[1]);
    return xhalf_sum(v);
}
template <int N> __device__ __forceinline__ void wave_sum_n(float (&v)[N]) {
#pragma unroll
    for (int i = 0; i < N; ++i) v[i] += dppf<0xB1>(v[i]);
#pragma unroll
    for (int i = 0; i < N; ++i) v[i] += dppf<0x4E>(v[i]);
#pragma unroll
    for (int i = 0; i < N; ++i) v[i] += dppf<0x141>(v[i]);
#pragma unroll
    for (int i = 0; i < N; ++i) v[i] += dppf<0x140>(v[i]);
#pragma unroll
    for (int i = 0; i < N; ++i) { const auto s = __builtin_amdgcn_permlane16_swap(__float_as_uint(v[i]), __float_as_uint(v[i]), false, false); v[i] = __uint_as_float(s[0]) + __uint_as_float(s[1]); }
#pragma unroll
    for (int i = 0; i < N; ++i) v[i] = xhalf_sum(v[i]);
}
__device__ __forceinline__ int crow(int r, int hi) { return (r & 3) + 8 * (r >> 2) + 4 * hi; }

#define XB_TMO      128
#define XB_XCNT(j)  (256  + 64 * (j))
#define XB_XSUB(j)  (1280 + 64 * (j))
#define XB_XGEN(j)  (2304 + 64 * (j))
#define XB_TOP      3328
#define XB_TOPGEN   3392
#define XCD_BAR_WORDS 3456
#define XB_SPIN_CAP (1u << 18)
__device__ __forceinline__ unsigned xb_ld(unsigned* p)              { return __hip_atomic_load(p, __ATOMIC_RELAXED, __HIP_MEMORY_SCOPE_AGENT); }
__device__ __forceinline__ unsigned xb_add(unsigned* p, unsigned v) { return __hip_atomic_fetch_add(p, v, __ATOMIC_RELAXED, __HIP_MEMORY_SCOPE_AGENT); }
__device__ __forceinline__ unsigned xb_xcc_id() { return (unsigned)__builtin_amdgcn_s_getreg((3 << 11) | 20) & 0xFu; }
#define XB_SPIN(cond, bar) do { unsigned _sp = 0; while (cond) { __builtin_amdgcn_s_sleep(1); \
    if ((++_sp & 255u) == 0u) { if (xb_ld(&(bar)[XB_TMO])) break; if (_sp > XB_SPIN_CAP) { atomicAdd(&(bar)[XB_TMO], 1u); break; } } } } while (0)
struct XcdBarrier { unsigned* bar; unsigned x; volatile LAS unsigned* st; };
__device__ __forceinline__ XcdBarrier xcd_barrier_post(unsigned* bar, volatile LAS unsigned* st) {
    XcdBarrier b; b.bar = bar; b.x = xb_xcc_id(); b.st = st;
    if (threadIdx.x == 0) (void)xb_add(&bar[XB_XCNT(b.x)], 1u);
    return b;
}
__device__ __forceinline__ void xcd_barrier_complete(unsigned* bar, unsigned x, unsigned& nloc, unsigned& nx) {
    const unsigned G = gridDim.x * gridDim.y * gridDim.z;
    unsigned sum, cnt, mine, sp = 0u;
    for (;;) {
        sum = 0u; cnt = 0u; mine = 0u;
#pragma unroll
        for (unsigned j = 0; j < 16; ++j) { const unsigned c = xb_ld(&bar[XB_XCNT(j)]); sum += c; cnt += (c > 0u) ? 1u : 0u; mine = (j == x) ? c : mine; }
        if (sum == G) break;
        __builtin_amdgcn_s_sleep(1);
        if ((++sp & 255u) == 0u) { if (xb_ld(&bar[XB_TMO])) break; if (sp > XB_SPIN_CAP) { atomicAdd(&bar[XB_TMO], 1u); break; } }
    }
    nloc = mine > 0u ? mine : 1u; nx = cnt > 0u ? cnt : 1u;
}
__device__ __forceinline__ void xcd_barrier(const XcdBarrier& b) {
    asm volatile("s_waitcnt vmcnt(0)" ::: "memory");
    __syncthreads();
    if (threadIdx.x == 0) {
        unsigned* bar = b.bar;
        __builtin_amdgcn_s_waitcnt(0);
        unsigned nloc = b.st[0], nx = b.st[1];
        if (nloc == 0u) { xcd_barrier_complete(bar, b.x, nloc, nx); b.st[0] = nloc; b.st[1] = nx; }
        const unsigned old = xb_add(&bar[XB_XSUB(b.x)], 1u);
        const unsigned gen = old / nloc;
        if (old + 1u == (gen + 1u) * nloc) {
            __builtin_amdgcn_fence(__ATOMIC_RELEASE, "agent");
            asm volatile("s_waitcnt vmcnt(0)" ::: "memory");
            const unsigned og = xb_add(&bar[XB_TOP], 1u);
            const unsigned tg = og / nx;
            if (og + 1u == (tg + 1u) * nx) xb_add(&bar[XB_TOPGEN], 1u);
            else XB_SPIN(xb_ld(&bar[XB_TOPGEN]) == tg, bar);
            __builtin_amdgcn_fence(__ATOMIC_ACQUIRE, "agent");
            xb_add(&bar[XB_XGEN(b.x)], 1u);
            asm volatile("s_waitcnt vmcnt(0)" ::: "memory");
        } else {
            XB_SPIN(xb_ld(&bar[XB_XGEN(b.x)]) == gen, bar);
            __builtin_amdgcn_fence(__ATOMIC_ACQUIRE, "agent");
            asm volatile("s_waitcnt vmcnt(0)" ::: "memory");
        }
    }
    __syncthreads();
}

namespace pg8 {
constexpr int BM = 256, BK = 64, HALF = 128, HTB = HALF * BK * 2, STAGE_BYTES = 8 * HTB, NXCD = 8, WGM = 8;
__host__ __device__ __forceinline__ int lds_byte(int r, int c) { const int st = (r >> 4) * 2 + (c >> 5), rr = r & 15, cc = c & 31, ob = rr * 64 + cc * 2; return st * 1024 + (ob ^ (((ob >> 9) & 1) << 5)); }
__host__ __device__ __forceinline__ void stage_rc(int b, int& R, int& C) { const int st = b / 1024, sb = b % 1024, swz = sb ^ (((sb >> 9) & 1) << 5); R = (st >> 1) * 16 + swz / 64; C = (st & 1) * 32 + (swz % 64) / 2; }
__host__ __device__ __forceinline__ int perm32(int rho) { const int n = rho >> 4, i = rho & 15; return 8 * (i >> 2) + 4 * n + (i & 3); }

#ifndef PROBE_P1
#define PROBE_P1 0
#endif
struct Unit { int pm, pn, pb;
#if PROBE_P1
    int fl;
#endif
};
struct Gemm { const bf16* A; const bf16* Bt; int K; const int* gidx; };

__device__ __forceinline__ int xcd_remap(int wgid, int nwg) { const int q = nwg / NXCD, r = nwg % NXCD, xcd = wgid % NXCD, off = wgid / NXCD; return (xcd < r ? xcd * (q + 1) : r * (q + 1) + (xcd - r) * q) + off; }
struct StaticOrder {
    int nM, nN, nwg, G, c, rep;
    __device__ void init(int M, int N, int G_, int c_, int rep_ = 1) { nM = M / BM; nN = N / BM; nwg = nM * nN; G = G_; c = c_; rep = rep_; }
    __device__ bool next(int i, Unit& u) const {
        long L = (long)i * G + c; if (L >= (long)nwg * rep) return false;
#if PROBE_P1
        u.fl = (rep > 1 && L < nwg) ? 1 : 0;
#endif
        L %= nwg;
        const int wgid = xcd_remap((int)L, nwg);
        const int nig = WGM * nN, gid = wgid / nig, fm = gid * WGM, gsz = (nM - fm) < WGM ? (nM - fm) : WGM;
        u.pm = fm + ((wgid % nig) % gsz); u.pn = (wgid % nig) / gsz; u.pb = u.pn; return true;
    }
};
struct GroupedOrder {
    const int* tile_e; int ntiles, npn, G, c;
    __device__ bool next(int i, Unit& u) const {
        const long L = (long)i * G + c; const int nwg = ntiles * npn; if (L >= nwg) return false;
        const int wgid = xcd_remap((int)L, nwg);
        u.pm = wgid / npn; u.pn = wgid % npn; u.pb = tile_e[u.pm] * npn + u.pn;
#if PROBE_P1
        u.fl = 0;
#endif
        return true;
    }
};

__device__ __forceinline__ unsigned cvt_pk_bf16(float lo, float hi) { unsigned r; asm volatile("v_cvt_pk_bf16_f32 %0, %1, %2" : "=v"(r) : "v"(lo), "v"(hi)); return r; }

template <int STM> struct EpiPlainT {
    static constexpr bool PERM = true;
    bf16* O; int ldc; const float* ssq; int ssq_n; float ssq_inv; float eps;
    LAS unsigned char* xl;
    __device__ __forceinline__ void operator()(const f32x4 (&acc)[2][2][4][2], const Unit& u, int wr, int wc, int fr, int fq) const {
        const int lane = fq * 16 + fr; LAS unsigned char* t = xl + (wr * 4 + wc) * 2048;
        const int wsw = fr & 7, rrow = lane >> 3, rch = lane & 7;
#pragma unroll
        for (int ai = 0; ai < 2; ++ai)
#pragma unroll
            for (int m = 0; m < 4; ++m) { const int rowb = u.pm * BM + ai * HALF + wr * 64 + m * 16;
                float sc = 1.f;
                if (ssq) { const f32x4 p = *(const f32x4*)(ssq + (size_t)(rowb + fr) * ssq_n); sc = __builtin_amdgcn_rsqf((p[0] + p[1] + p[2] + p[3]) * ssq_inv + eps); }
#pragma unroll
                for (int bj = 0; bj < 2; ++bj) { const f32x4 v0 = acc[ai][bj][m][0] * sc, v1 = acc[ai][bj][m][1] * sc;
                    u32x4 w; w.x = cvt_pk_bf16(v0[0], v0[1]); w.y = cvt_pk_bf16(v0[2], v0[3]); w.z = cvt_pk_bf16(v1[0], v1[1]); w.w = cvt_pk_bf16(v1[2], v1[3]);
                    *(LAS u32x4*)(t + fr * 128 + 16 * ((4 * bj + fq) ^ wsw)) = w; }
#pragma unroll
                for (int i = 0; i < 2; ++i) { const int rr = 8 * i + rrow;
                    const u32x4 w = *(const LAS u32x4*)(t + rr * 128 + 16 * (rch ^ (rr & 7)));
                    stg16<STM>(O + (size_t)(rowb + rr) * ldc + u.pn * BM + wc * 64 + 8 * rch, w); }
            }
    }
};
template <int STM> struct EpiFp8T {
    static constexpr bool PERM = true;
    unsigned char* O; int ldc; float scale; LAS unsigned char* xl;
    __device__ __forceinline__ void operator()(const f32x4 (&acc)[2][2][4][2], const Unit& u, int wr, int wc, int fr, int fq) const {
        const int lane = fq * 16 + fr; LAS unsigned char* t = xl + (wr * 4 + wc) * 2048;
        const int rrow = lane >> 2, rch = lane & 3;
#pragma unroll
        for (int ai = 0; ai < 2; ++ai)
#pragma unroll
            for (int m = 0; m < 4; ++m) { const int rowb = u.pm * BM + ai * HALF + wr * 64 + m * 16;
#pragma unroll
                for (int bj = 0; bj < 2; ++bj) { f32x4 v0 = acc[ai][bj][m][0] * scale, v1 = acc[ai][bj][m][1] * scale;
#pragma unroll
                    for (int e = 0; e < 4; ++e) { v0[e] = __builtin_amdgcn_fmed3f(v0[e], -448.f, 448.f); v1[e] = __builtin_amdgcn_fmed3f(v1[e], -448.f, 448.f); }
                    int lo = __builtin_amdgcn_cvt_pk_fp8_f32(v0[0], v0[1], 0, false); lo = __builtin_amdgcn_cvt_pk_fp8_f32(v0[2], v0[3], lo, true);
                    int hi = __builtin_amdgcn_cvt_pk_fp8_f32(v1[0], v1[1], 0, false); hi = __builtin_amdgcn_cvt_pk_fp8_f32(v1[2], v1[3], hi, true);
                    *(LAS u32x2*)(t + fr * 64 + 32 * bj + 8 * fq) = (u32x2){(unsigned)lo, (unsigned)hi}; }
                const u32x4 w = *(const LAS u32x4*)(t + lane * 16);
                stg16<STM>(O + (size_t)(rowb + rrow) * ldc + u.pn * BM + wc * 64 + 16 * rch, w); }
    }
};
__device__ __forceinline__ f32x4 fp8x4_to_f32(unsigned w) { const f32x2 a = __builtin_amdgcn_cvt_pk_f32_fp8((int)w, false), b = __builtin_amdgcn_cvt_pk_f32_fp8((int)w, true); return (f32x4){a.x, a.y, b.x, b.y}; }
template <int STM> struct EpiGateUpT {
    static constexpr bool PERM = true;
    bf16* H; const float* sw;
    __device__ __forceinline__ void operator()(const f32x4 (&acc)[2][2][4][2], const Unit& u, int wr, int wc, int fr, int fq) const {
        const int row0 = u.pm * BM + wr * 64 + fr; const int col0 = u.pn * HALF + wc * 32 + 8 * fq;
#pragma unroll
        for (int ai = 0; ai < 2; ++ai)
#pragma unroll
            for (int m = 0; m < 4; ++m) { const int row = row0 + ai * HALF + m * 16; const float w = sw[row]; f32x4 hv[2];
#pragma unroll
                for (int n = 0; n < 2; ++n) { const f32x4 g = acc[ai][0][m][n], up = acc[ai][1][m][n];
#pragma unroll
                    for (int e = 0; e < 4; ++e) { const float sg = g[e] * __builtin_amdgcn_rcpf(1.0f + __builtin_amdgcn_exp2f(-g[e] * LOG2E)); hv[n][e] = sg * up[e] * w; } }
                u32x4 o; o.x = cvt_pk_bf16(hv[0][0], hv[0][1]); o.y = cvt_pk_bf16(hv[0][2], hv[0][3]); o.z = cvt_pk_bf16(hv[1][0], hv[1][1]); o.w = cvt_pk_bf16(hv[1][2], hv[1][3]);
                stg16<STM>(H + (size_t)row * FH + col0, o); }
    }
};

enum { GK_SKIP = 0, GK_PLAIN = 1, GK_ROPE32 = 2, GK_HEAD16 = 3, GK_IDX8 = 4, GK_WI = 5 };
struct GroupDesc { int kind; bf16* dst; int pitch; int col; float scale; int perm; float* ssq; int ssq_n; int ssq_i; };
struct RopeTabs { const int* pos; };
__device__ __forceinline__ int perm_row(int row, int perm) {
    if (perm == 0) return row; const int b = row >> 11, s = row & 2047;
    return perm == 4 ? (b << 11) + ((s & 3) << 9) + (s >> 2) : (b << 11) + ((s & 15) << 7) + (s >> 4);
}
__device__ __forceinline__ void st16(bf16* p, u32x2 a, u32x2 b) { u32x4 w; w.x = a.x; w.y = a.y; w.z = b.x; w.w = b.y; stg16<NT_EPI>(p, w); }
__device__ __forceinline__ u32x2 pk4(f32x4 v) { u32x2 w; w.x = cvt_pk_bf16(v[0], v[1]); w.y = cvt_pk_bf16(v[2], v[3]); return w; }
__device__ __forceinline__ void swap16(u32x2& X, u32x2& Y) {
    const auto a = __builtin_amdgcn_permlane16_swap(X.x, Y.x, false, false); const auto b = __builtin_amdgcn_permlane16_swap(X.y, Y.y, false, false);
    X.x = a[0]; Y.x = a[1]; X.y = b[0]; Y.y = b[1];
}
__device__ __forceinline__ float rope_k(int i, int rd) { return __builtin_amdgcn_exp2f(-18.931568569324174f * (float)(2 * i) / (float)rd) * 0.15915494309189535f; }
__device__ __forceinline__ void rope_cs(float posf, int i0, int rd, f32x4& c, f32x4& s) {
#pragma unroll
    for (int e = 0; e < 4; ++e) { const float f = __builtin_amdgcn_fractf(posf * rope_k(i0 + e, rd)); s[e] = __builtin_amdgcn_sinf(f); c[e] = __builtin_amdgcn_cosf(f); }
}
template <class DescFn> struct EpiGroups {
    static constexpr bool PERM = true;
    DescFn F; RopeTabs R; const float* rs_ssq; int rs_n; float rs_inv, rs_eps;
    __device__ __forceinline__ void operator()(const f32x4 (&acc)[2][2][4][2], const Unit& u, int wr, int wc, int fr, int fq) const {
        const int row0 = u.pm * BM + wr * 64 + fr;
#pragma unroll
        for (int bj = 0; bj < 2; ++bj) {
            const GroupDesc d = F(u.pn, bj, wc);
            if (d.kind == GK_SKIP) continue;
#if PROBE_P1 == 1
            if (u.fl) continue;
#endif
            const int ki0 = d.kind == GK_ROPE32 ? 4 * fq : (d.kind == GK_HEAD16 ? 4 * (fq & 1) : 0), krd = d.kind == GK_ROPE32 ? 32 : (d.kind == GK_HEAD16 ? 16 : 8);
#pragma unroll
            for (int ai = 0; ai < 2; ++ai)
#pragma unroll
                for (int m = 0; m < 4; ++m) {
                    const int row = row0 + ai * HALF + m * 16;
                    float sc = d.scale;
                    if (rs_ssq) { float s = 0.f; for (int i = 0; i < rs_n; ++i) s += rs_ssq[(size_t)row * rs_n + i]; sc *= __builtin_amdgcn_rsqf(s * rs_inv + rs_eps); }
                    f32x4 v0 = acc[ai][bj][m][0], v1 = acc[ai][bj][m][1];
                    if (d.ssq) {
                        float q = (v0[0] * v0[0] + v0[1] * v0[1]) + (v0[2] * v0[2] + v0[3] * v0[3]) + (v1[0] * v1[0] + v1[1] * v1[1]) + (v1[2] * v1[2] + v1[3] * v1[3]);
                        q += __shfl_xor(q, 16); q += __shfl_xor(q, 32);
                        if (fq == 0) d.ssq[(size_t)row * d.ssq_n + d.ssq_i] = q;
                    }
                    v0 = v0 * sc; v1 = v1 * sc;
                    if (d.kind == GK_WI) { if (fq == 0) { float* wp = (float*)d.dst + (size_t)row * 8; *(f32x4*)wp = v0; *(f32x4*)(wp + 4) = v1; } continue; }
                    bf16* rp = d.dst + (size_t)perm_row(row, d.perm) * d.pitch + d.col;
                    if (d.kind == GK_PLAIN) { st16(rp + 8 * fq, pk4(v0), pk4(v1)); }
                    else if (d.kind == GK_IDX8) {
                        f32x4 c, s; rope_cs((float)R.pos[row], ki0, krd, c, s);
                        const f32x4 o1 = fq == 0 ? v0 * c - v1 * s : v0, o2 = fq == 0 ? v1 * c + v0 * s : v1;
                        st16(rp + 8 * fq, pk4(o1), pk4(o2));
                    } else if (d.kind == GK_ROPE32) {
                        f32x4 c, s; rope_cs((float)R.pos[row], ki0, krd, c, s);
                        u32x2 X = pk4(v0 * c - v1 * s), Y = pk4(v1 * c + v0 * s);
                        swap16(X, Y);
                        st16(rp + ((fq & 1) ? 16 + 4 * (fq - 1) : 4 * fq), X, Y);
                    } else {
                        f32x4 c, s; rope_cs((float)R.pos[row], ki0, krd, c, s);
                        u32x2 X = pk4(fq < 2 ? v0 * c - v1 * s : v0), Y = pk4(fq < 2 ? v1 * c + v0 * s : v1);
                        swap16(X, Y);
                        st16(rp + 16 * (fq >> 1) + 8 * (fq & 1), X, Y);
                    }
                }
        }
    }
};

template <class Epi, class Sched, bool GATHER, int LDA = 0>
__device__ __forceinline__ void gemm_phase(LAS unsigned char* lds, const Gemm g, const Sched& S, const Epi& E, const int tid) {
    const int wid = __builtin_amdgcn_readfirstlane(tid >> 6), lane = tid & 63, wr = wid >> 2, wc = wid & 3, fr = lane & 15, fq = lane >> 4;
    const int K = g.K, nt = K / BK, lda = LDA ? LDA : K;
    unsigned voA[2][2], voB[2]; int RA[2], CA[2];
#pragma unroll
    for (int i = 0; i < 2; ++i) { int R, C; stage_rc(tid * 16 + i * 8192, R, C); const int Rb = Epi::PERM ? ((R & ~31) + perm32(R & 31)) : R;
        RA[i] = R; CA[i] = C; voA[0][i] = (unsigned)(R * lda + C) * 2u; voA[1][i] = (unsigned)((R + HALF) * lda + C) * 2u; voB[i] = (unsigned)(Rb * K + C) * 2u; }
    const size_t kstep = (size_t)(BK * 2);
    const size_t hstep = (size_t)HALF * K * 2;
    const size_t tstep = 2 * hstep;
    const size_t tstepA = (size_t)BM * lda * 2;
    const unsigned ldsw = (unsigned)wid * 1024u;
    const int aoff = lds_byte(wr * 64 + fr, fq * 8), boff = lds_byte(wc * 32 + fr, fq * 8);
#define PG8_SA(b, h) (((b) * 2 + (h)) * HTB)
#define PG8_SB(b, h) ((4 + (b) * 2 + (h)) * HTB)
#define PG8_STAGE(bufoff, gbase, voff) do { _Pragma("unroll") for (int _i = 0; _i < 2; ++_i) \
        __builtin_amdgcn_global_load_lds((const unsigned*)((const char*)(gbase) + (voff)[_i]), (LAS unsigned*)(lds + (bufoff) + ldsw + _i * 8192), 16, 0, 0); } while (0)
#define PG8_LDA(dst, b, h) do { _Pragma("unroll") for (int m = 0; m < 4; ++m) _Pragma("unroll") for (int k = 0; k < 2; ++k) dst[m][k] = *(const LAS bf16x8*)(lds + PG8_SA(b, h) + aoff + m * 2048 + k * 1024); } while (0)
#define PG8_LDB(dst, b, h) do { _Pragma("unroll") for (int n = 0; n < 2; ++n) _Pragma("unroll") for (int k = 0; k < 2; ++k) dst[n][k] = *(const LAS bf16x8*)(lds + PG8_SB(b, h) + boff + n * 2048 + k * 1024); } while (0)
#define PG8_MMA(ai, bj, At, Bt) do { __builtin_amdgcn_s_setprio(1); _Pragma("unroll") for (int m = 0; m < 4; ++m) _Pragma("unroll") for (int n = 0; n < 2; ++n) _Pragma("unroll") for (int k = 0; k < 2; ++k) \
        acc[ai][bj][m][n] = __builtin_amdgcn_mfma_f32_16x16x32_bf16(Bt[n][k], At[m][k], acc[ai][bj][m][n], 0, 0, 0); __builtin_amdgcn_s_setprio(0); } while (0)
#define PG8_WAIT_V(n) asm volatile("s_waitcnt vmcnt(" #n ")" ::: "memory")
#define PG8_WAIT_L(n) asm volatile("s_waitcnt lgkmcnt(" #n ")" ::: "memory")
#define PG8_BAR __builtin_amdgcn_s_barrier()
#define PG8_SCHED __builtin_amdgcn_sched_barrier(0)
    Unit cur, nxt; int ui = 0;
    if (!S.next(0, cur)) return;
    f32x4 acc[2][2][4][2];
#pragma unroll
    for (int a = 0; a < 2; ++a)
#pragma unroll
        for (int b = 0; b < 2; ++b)
#pragma unroll
            for (int m = 0; m < 4; ++m)
#pragma unroll
                for (int n = 0; n < 2; ++n) acc[a][b][m][n] = (f32x4){0.f, 0.f, 0.f, 0.f};
    bf16x8 At[4][2], B0[2][2], B1[2][2];
    unsigned nvA[2][2];
    const char* cA; const char* cB = (const char*)g.Bt + (size_t)cur.pb * tstep;
    if constexpr (GATHER) { cA = (const char*)g.A;
#pragma unroll
        for (int h = 0; h < 2; ++h)
#pragma unroll
            for (int i = 0; i < 2; ++i) voA[h][i] = (unsigned)g.gidx[cur.pm * BM + h * HALF + RA[i]] * (unsigned)(lda * 2) + (unsigned)CA[i] * 2u;
    } else cA = (const char*)g.A + (size_t)cur.pm * tstepA;
    PG8_STAGE(PG8_SB(0, 0), cB, voB); PG8_STAGE(PG8_SB(0, 1), cB + hstep, voB); PG8_STAGE(PG8_SA(0, 0), cA, voA[0]); PG8_STAGE(PG8_SA(0, 1), cA, voA[1]);
    if (wr == 1) PG8_BAR;
    PG8_WAIT_V(2); PG8_BAR;
    PG8_STAGE(PG8_SB(1, 0), cB + kstep, voB); PG8_STAGE(PG8_SA(1, 0), cA + kstep, voA[0]); PG8_STAGE(PG8_SB(1, 1), cB + hstep + kstep, voB);
    PG8_WAIT_V(6); PG8_BAR;
    for (;;) {
        const bool has_next = S.next(ui + 1, nxt);
        const char* nA; const char* nB = has_next ? (const char*)g.Bt + (size_t)nxt.pb * tstep : cB;
        if constexpr (GATHER) { nA = cA;
#pragma unroll
            for (int h = 0; h < 2; ++h)
#pragma unroll
                for (int i = 0; i < 2; ++i) nvA[h][i] = has_next ? (unsigned)g.gidx[nxt.pm * BM + h * HALF + RA[i]] * (unsigned)(lda * 2) + (unsigned)CA[i] * 2u : voA[h][i];
        } else nA = has_next ? (const char*)g.A + (size_t)nxt.pm * tstepA : cA;
#if PROBE_P1 == 2
        const int ntu = cur.fl ? 2 : nt;
#else
        const int ntu = nt;
#endif
#pragma nounroll
        for (int t = 0; t < ntu; t += 2) {
            const bool last = (t == ntu - 2);
            const char* a1 = cA + (size_t)(t + 1) * kstep;
            const char* a2 = last ? nA : cA + (size_t)(t + 2) * kstep; const char* b2 = last ? nB : cB + (size_t)(t + 2) * kstep;
            const char* a3 = a2 + kstep; const char* b3 = b2 + kstep;
            unsigned xA[2][2];
#pragma unroll
            for (int h = 0; h < 2; ++h)
#pragma unroll
                for (int i = 0; i < 2; ++i) xA[h][i] = (GATHER && last) ? nvA[h][i] : voA[h][i];
            PG8_LDB(B0, 0, 0); PG8_LDB(B1, 0, 1); PG8_SCHED; PG8_LDA(At, 0, 0); PG8_STAGE(PG8_SA(1, 1), a1, voA[1]);
            PG8_WAIT_V(8); PG8_WAIT_L(0); PG8_BAR; PG8_MMA(0, 0, At, B0); PG8_MMA(0, 1, At, B1); PG8_BAR; PG8_SCHED;
            PG8_LDA(At, 0, 1); PG8_STAGE(PG8_SB(0, 0), b2, voB); PG8_STAGE(PG8_SB(0, 1), b2 + hstep, voB); PG8_STAGE(PG8_SA(0, 0), a2, xA[0]);
            PG8_WAIT_V(8); PG8_WAIT_L(0); PG8_BAR; PG8_MMA(1, 0, At, B0); PG8_MMA(1, 1, At, B1); PG8_BAR; PG8_SCHED;
            PG8_LDB(B0, 1, 0); PG8_LDB(B1, 1, 1); PG8_SCHED; PG8_LDA(At, 1, 0); PG8_STAGE(PG8_SA(0, 1), a2, xA[1]);
            PG8_WAIT_V(8); PG8_WAIT_L(0); PG8_BAR; PG8_MMA(0, 0, At, B0); PG8_MMA(0, 1, At, B1); PG8_BAR; PG8_SCHED;
            PG8_LDA(At, 1, 1); PG8_STAGE(PG8_SB(1, 0), b3, voB); PG8_STAGE(PG8_SB(1, 1), b3 + hstep, voB); PG8_STAGE(PG8_SA(1, 0), a3, xA[0]);
            PG8_WAIT_V(8); PG8_WAIT_L(0); PG8_BAR; PG8_MMA(1, 0, At, B0); PG8_MMA(1, 1, At, B1); PG8_BAR; PG8_SCHED;
        }
        if (wr == 0) PG8_BAR;
        E(acc, cur, wr, wc, fr, fq);
        if (!has_next) break;
#pragma unroll
        for (int a = 0; a < 2; ++a)
#pragma unroll
            for (int b = 0; b < 2; ++b)
#pragma unroll
                for (int m = 0; m < 4; ++m)
#pragma unroll
                    for (int n = 0; n < 2; ++n) acc[a][b][m][n] = (f32x4){0.f, 0.f, 0.f, 0.f};
        cur = nxt; cA = nA; cB = nB; ++ui;
        if constexpr (GATHER) {
#pragma unroll
            for (int h = 0; h < 2; ++h)
#pragma unroll
                for (int i = 0; i < 2; ++i) voA[h][i] = nvA[h][i];
        }
        if (wr == 1) PG8_BAR;
    }
    PG8_WAIT_V(0);
    PG8_BAR;
#undef PG8_SA
#undef PG8_SB
#undef PG8_STAGE
#undef PG8_LDA
#undef PG8_LDB
#undef PG8_MMA
#undef PG8_WAIT_V
#undef PG8_WAIT_L
#undef PG8_BAR
#undef PG8_SCHED
}
}

#ifndef PROBE_LDS2
#define PROBE_LDS2 0
#endif
#ifndef PROBE_EXP2
#define PROBE_EXP2 0
#endif
#ifndef SOFTMAX_PK
#define SOFTMAX_PK 0
#endif
#ifndef SM_THR
#define SM_THR 8.0f
#endif
#ifndef REF_IN_ACC
#define REF_IN_ACC 1
#endif
#ifndef ATT_FUSE2
#define ATT_FUSE2 1
#endif
#ifndef FA_FUSE
#define FA_FUSE 0
#endif
namespace fa {
constexpr int VBYTES_T = 64 * 128;
typedef short v4i16_t __attribute__((ext_vector_type(4)));
__device__ __forceinline__ u32x2 vtr(const LAS unsigned char* p) { return __builtin_bit_cast(u32x2, __builtin_amdgcn_ds_read_tr16_b64_v4i16((LAS v4i16_t*)p)); }
__device__ __forceinline__ float max16(const f32x16& c) { float r;
    asm("v_max3_f32 %0, %1, %2, %3\n\tv_max3_f32 %0, %0, %4, %5\n\tv_max3_f32 %0, %0, %6, %7\n\tv_max3_f32 %0, %0, %8, %9\n\tv_max3_f32 %0, %0, %10, %11\n\tv_max3_f32 %0, %0, %12, %13\n\tv_max3_f32 %0, %0, %14, %15\n\tv_max_f32 %0, %0, %16"
        : "=&v"(r) : "v"(c[0]), "v"(c[1]), "v"(c[2]), "v"(c[3]), "v"(c[4]), "v"(c[5]), "v"(c[6]), "v"(c[7]), "v"(c[8]), "v"(c[9]), "v"(c[10]), "v"(c[11]), "v"(c[12]), "v"(c[13]), "v"(c[14]), "v"(c[15]));
    return r; }
__device__ __forceinline__ void mask_init(f32x16& S, unsigned nw) { float t0, t1, t2, t3, t4, t5, t6, t7, t8, t9, t10, t11, t12, t13, t14, t15;
    asm("v_bfe_i32 %0, %16, 0, 1\n\tv_lshlrev_b32 %0, 23, %0\n\tv_bfe_i32 %1, %16, 1, 1\n\tv_lshlrev_b32 %1, 23, %1\n\tv_bfe_i32 %2, %16, 2, 1\n\tv_lshlrev_b32 %2, 23, %2\n\tv_bfe_i32 %3, %16, 3, 1\n\tv_lshlrev_b32 %3, 23, %3\n\tv_bfe_i32 %4, %16, 8, 1\n\tv_lshlrev_b32 %4, 23, %4\n\tv_bfe_i32 %5, %16, 9, 1\n\tv_lshlrev_b32 %5, 23, %5\n\tv_bfe_i32 %6, %16, 10, 1\n\tv_lshlrev_b32 %6, 23, %6\n\tv_bfe_i32 %7, %16, 11, 1\n\tv_lshlrev_b32 %7, 23, %7\n\tv_bfe_i32 %8, %16, 16, 1\n\tv_lshlrev_b32 %8, 23, %8\n\tv_bfe_i32 %9, %16, 17, 1\n\tv_lshlrev_b32 %9, 23, %9\n\tv_bfe_i32 %10, %16, 18, 1\n\tv_lshlrev_b32 %10, 23, %10\n\tv_bfe_i32 %11, %16, 19, 1\n\tv_lshlrev_b32 %11, 23, %11\n\tv_bfe_i32 %12, %16, 24, 1\n\tv_lshlrev_b32 %12, 23, %12\n\tv_bfe_i32 %13, %16, 25, 1\n\tv_lshlrev_b32 %13, 23, %13\n\tv_bfe_i32 %14, %16, 26, 1\n\tv_lshlrev_b32 %14, 23, %14\n\tv_bfe_i32 %15, %16, 27, 1\n\tv_lshlrev_b32 %15, 23, %15"
        : "=&v"(t0), "=&v"(t1), "=&v"(t2), "=&v"(t3), "=&v"(t4), "=&v"(t5), "=&v"(t6), "=&v"(t7), "=&v"(t8), "=&v"(t9), "=&v"(t10), "=&v"(t11), "=&v"(t12), "=&v"(t13), "=&v"(t14), "=&v"(t15) : "v"(nw));
    S[0] = t0; S[1] = t1; S[2] = t2; S[3] = t3; S[4] = t4; S[5] = t5; S[6] = t6; S[7] = t7; S[8] = t8; S[9] = t9; S[10] = t10; S[11] = t11; S[12] = t12; S[13] = t13; S[14] = t14; S[15] = t15; }
template <int LO, int HI> __device__ __forceinline__ void sm_piece(f32x16& c0, f32x16& c1, const float ms, float& ls) {
#pragma unroll
    for (int e = LO; e < HI; ++e) { if (e < 16) { c0[e] = __builtin_amdgcn_exp2f(c0[e] - ms); ls += c0[e]; } else { c1[e - 16] = __builtin_amdgcn_exp2f(c1[e - 16] - ms); ls += c1[e - 16]; } }
}
__device__ __forceinline__ void mask_init_ref(f32x16& S, unsigned nw, float negref) { float t0, t1, t2, t3, t4, t5, t6, t7, t8, t9, t10, t11, t12, t13, t14, t15; const unsigned ninf = 0xff800000u;
    asm("v_bfe_i32 %0, %16, 0, 1\n\tv_bfi_b32 %0, %0, %17, %18\n\tv_bfe_i32 %1, %16, 1, 1\n\tv_bfi_b32 %1, %1, %17, %18\n\tv_bfe_i32 %2, %16, 2, 1\n\tv_bfi_b32 %2, %2, %17, %18\n\tv_bfe_i32 %3, %16, 3, 1\n\tv_bfi_b32 %3, %3, %17, %18\n\tv_bfe_i32 %4, %16, 8, 1\n\tv_bfi_b32 %4, %4, %17, %18\n\tv_bfe_i32 %5, %16, 9, 1\n\tv_bfi_b32 %5, %5, %17, %18\n\tv_bfe_i32 %6, %16, 10, 1\n\tv_bfi_b32 %6, %6, %17, %18\n\tv_bfe_i32 %7, %16, 11, 1\n\tv_bfi_b32 %7, %7, %17, %18\n\tv_bfe_i32 %8, %16, 16, 1\n\tv_bfi_b32 %8, %8, %17, %18\n\tv_bfe_i32 %9, %16, 17, 1\n\tv_bfi_b32 %9, %9, %17, %18\n\tv_bfe_i32 %10, %16, 18, 1\n\tv_bfi_b32 %10, %10, %17, %18\n\tv_bfe_i32 %11, %16, 19, 1\n\tv_bfi_b32 %11, %11, %17, %18\n\tv_bfe_i32 %12, %16, 24, 1\n\tv_bfi_b32 %12, %12, %17, %18\n\tv_bfe_i32 %13, %16, 25, 1\n\tv_bfi_b32 %13, %13, %17, %18\n\tv_bfe_i32 %14, %16, 26, 1\n\tv_bfi_b32 %14, %14, %17, %18\n\tv_bfe_i32 %15, %16, 27, 1\n\tv_bfi_b32 %15, %15, %17, %18"
        : "=&v"(t0), "=&v"(t1), "=&v"(t2), "=&v"(t3), "=&v"(t4), "=&v"(t5), "=&v"(t6), "=&v"(t7), "=&v"(t8), "=&v"(t9), "=&v"(t10), "=&v"(t11), "=&v"(t12), "=&v"(t13), "=&v"(t14), "=&v"(t15) : "v"(nw), "s"(ninf), "v"(negref));
    S[0] = t0; S[1] = t1; S[2] = t2; S[3] = t3; S[4] = t4; S[5] = t5; S[6] = t6; S[7] = t7; S[8] = t8; S[9] = t9; S[10] = t10; S[11] = t11; S[12] = t12; S[13] = t13; S[14] = t14; S[15] = t15; }
struct Params {
    const bf16* Q;  int q_pitch;
    const bf16* K1; int k1_pitch, k1_col;
    const bf16* K2; int k2_pitch, k2_col;
    const bf16* V;  int v_pitch, v_col;
    bf16* O; int o_pitch;
    float* LSE; int lse_pitch;
    const unsigned* BM;
    int CL, W;
};
struct UnitDesc { int seq0, qw, q_col, o_col, lse_col, k1_col, v_col, kt_lo, kt_hi; };
template <int DQK, int MODE, int NH, class DescFn>
__device__ __forceinline__ void attn_stream(const Params& P, LAS unsigned char* lds, const int tid, const int n_units, DescFn desc) {
    constexpr int NKS = DQK / 16, AHEAD = (NH == 2 ? 3 : 4), NST = AHEAD + 1, K1B = 8192 * NH, K2B = (DQK == 96 ? 4096 : 0), BMOFF = K1B + K2B + 8192 * NH, STB = BMOFF + (MODE == 1 ? 8192 : 0);
    constexpr int NDMA = 2 * NH + (DQK == 96 ? 1 : 0) + (MODE == 1 ? 1 : 0);
    static_assert(NH == 1 || (DQK == 64 && MODE != 1), "two-head stages: head dim 64 only");
    constexpr bool active = true;
    if (n_units <= 0) return;
    const int lane = tid & 63, r = lane & 31, h = lane >> 5, wave = __builtin_amdgcn_readfirstlane(tid >> 6);
    const int tq_ = (lane & 15) >> 2, tp_ = lane & 3, tg_ = lane >> 4;
    const int hsel = NH == 2 ? (wave >> 2) * 8192 : 0;
    const int vtoff = K1B + K2B + hsel + (4 * h + tq_) * 128, vxb = 2 * (16 * (tg_ & 1) + 4 * tp_), vsw = (tq_ >> 1) & 1;
    const int vx0 = vxb + ((0 ^ vsw) << 6), vx1 = vxb + ((1 ^ vsw) << 6);
    const int s1_ = (r >> 1) & 7, s2_ = (r >> 2) & 3;
    const int k1row = hsel + r * 128, k2row = K1B + r * 64;
    const int row1 = 8 * wave + (lane >> 3), row2 = 16 * (wave & 3) + (lane >> 2);
    const size_t tk1 = (size_t)64 * P.k1_pitch, tk2 = (size_t)64 * P.k2_pitch, tv = (size_t)64 * P.v_pitch;
    const int d_k1 = wave * 1024, d_k2 = K1B + (wave & 3) * 1024, d_v = K1B + K2B + wave * 1024;
    const bf16* src_k1; const bf16* src_v; const bf16* src_k2 = nullptr; const unsigned* bmp = nullptr;
    int ji = -1, kti = 1, kti_hi = 0;
    auto fa_issue = [&](const int st) __attribute__((always_inline)) {
        if (kti > kti_hi) {
            if (ji + 1 < n_units) { ++ji; const UnitDesc t = desc(ji); kti = t.kt_lo; kti_hi = t.kt_hi;
                src_k1 = P.K1 + (size_t)(t.seq0 + row1) * P.k1_pitch + t.k1_col + 8 * ((lane & 7) ^ ((row1 >> 1) & 7));
                src_v = P.V + (size_t)(t.seq0 + row1) * P.v_pitch + t.v_col + 8 * ((lane & 7) ^ (((row1 >> 1) & 1) << 2));
                if constexpr (DQK == 96) src_k2 = P.K2 + (size_t)(t.seq0 + row2) * P.k2_pitch + P.k2_col + 8 * ((lane & 3) ^ ((row2 >> 2) & 3));
                if constexpr (MODE == 1) bmp = P.BM + (size_t)(t.seq0 + t.qw + r) * 64;
            } else kti = kti_hi; }
        LAS unsigned char* sb_ = lds + st * STB;
        __builtin_amdgcn_global_load_lds((const unsigned*)(src_k1 + kti * tk1), (LAS unsigned*)(sb_ + d_k1), 16, 0, 0);
        __builtin_amdgcn_global_load_lds((const unsigned*)(src_v + kti * tv), (LAS unsigned*)(sb_ + d_v), 16, 0, 0);
        if constexpr (NH == 2) {
            __builtin_amdgcn_global_load_lds((const unsigned*)(src_k1 + 64 + kti * tk1), (LAS unsigned*)(sb_ + d_k1 + 8192), 16, 0, 0);
            __builtin_amdgcn_global_load_lds((const unsigned*)(src_v + 64 + kti * tv), (LAS unsigned*)(sb_ + d_v + 8192), 16, 0, 0); }
        if constexpr (DQK == 96) __builtin_amdgcn_global_load_lds((const unsigned*)(src_k2 + kti * tk2), (LAS unsigned*)(sb_ + d_k2), 16, 0, 0);
        if constexpr (MODE == 1) __builtin_amdgcn_global_load_lds(bmp + (kti & ~1) * 2, (LAS unsigned*)(sb_ + BMOFF + wave * 1024), 16, 0, 0);
        ++kti; };
#define FA_ISSUE(TILE, ST) fa_issue(ST)
    int st_is = 0, st_c = 0, st_n = 1;
    bf16x8 qf[NKS];
#define FA_LOADQ(D) do { const bf16* qp_ = P.Q + (size_t)((D).seq0 + (D).qw + r) * P.q_pitch + (D).q_col + 8 * h; \
        _Pragma("unroll") for (int ks = 0; ks < NKS; ++ks) asm volatile("global_load_dwordx4 %0, %1, off offset:%2" : "=&v"(qf[ks]) : "v"(qp_), "n"(32 * ks) : "memory"); } while (0)
#define FA_WAITQ(N) do { if constexpr (NKS == 6) asm volatile("s_waitcnt vmcnt(%6)" : "+v"(qf[0]), "+v"(qf[1]), "+v"(qf[2]), "+v"(qf[3]), "+v"(qf[4]), "+v"(qf[5]) : "n"(N) : "memory"); \
        else asm volatile("s_waitcnt vmcnt(%4)" : "+v"(qf[0]), "+v"(qf[1]), "+v"(qf[2]), "+v"(qf[3]) : "n"(N) : "memory"); } while (0)
    { const UnitDesc d0 = desc(0); FA_LOADQ(d0); FA_WAITQ(0); }
#pragma unroll 1
    for (int ju = 0; ju < n_units; ++ju) {
    const UnitDesc du = desc(ju);
    const int seq0 = du.seq0, qw = du.qw, q_col = du.q_col, o_col = du.o_col, lse_col = du.lse_col, kt_lo = du.kt_lo, kt_hi = du.kt_hi;
    const int q = qw + r;
    const int lo_q = MODE == 0 ? max(q & ~(P.CL - 1), q - P.W) : 0;
    const int qh = q - 4 * h, lqh = lo_q - 4 * h;
    const int lo_w0 = MODE == 0 ? max(qw & ~(P.CL - 1), qw - P.W) : 0;
    const int lo_w1 = MODE == 0 ? max((qw + 31) & ~(P.CL - 1), qw + 31 - P.W) : 0;
#define FA_WAITBAR(N) do { asm volatile("s_waitcnt vmcnt(%0)" :: "n"(N) : "memory"); __builtin_amdgcn_s_barrier(); asm volatile("" ::: "memory"); } while (0)
    f32x16 o0, o1, c0, c1, n0, n1;
#pragma unroll
    for (int i = 0; i < 16; ++i) { o0[i] = 0.f; o1[i] = 0.f; c0[i] = 0.f; c1[i] = 0.f; n0[i] = 0.f; n1[i] = 0.f; }
    float m = -INFINITY, l = 0.f;
    constexpr bool RIA = REF_IN_ACC && (MODE == 1);
    float msr = 0.f, rc_ = 0.f, rn_ = 0.f;
#define FA_PART(kt_) (active && (MODE == 0 ? ((kt_) * 64 <= qw + 31 && (kt_) * 64 + 63 >= lo_w0) : ((kt_) * 64 <= qw + 31)))
#define FA_KADDR(SB_, ROFF, ks) ((ks) < 4 ? (SB_) + (ROFF) * 128 + k1row + 16 * ((2 * (ks) + h) ^ s1_) : (SB_) + (ROFF) * 64 + k2row + 16 * ((2 * ((ks) - 4) + h) ^ s2_))
#define FA_QKH(S, SB_, ROFF, NW) do { bf16x8 fa_[NKS]; \
        _Pragma("unroll") for (int ks = 0; ks < NKS; ++ks) fa_[ks] = *(const LAS bf16x8*)FA_KADDR(SB_, ROFF, ks); \
        if (PROBE_LDS2) { _Pragma("unroll") for (int ks = 0; ks < NKS; ++ks) { const bf16x8 fb_ = *(const volatile LAS bf16x8*)FA_KADDR(SB_, (ROFF) ^ 32, ks); asm volatile("" :: "v"(fb_)); } } \
        if constexpr (MODE == 1) {        \
            mask_init(S, NW); \
        } else { _Pragma("unroll") for (int i = 0; i < 16; ++i) S[i] = 0.f; } \
        _Pragma("unroll") for (int ks = 0; ks < NKS; ++ks) S = __builtin_amdgcn_mfma_f32_32x32x16_bf16(fa_[ks], qf[ks], S, 0, 0, 0); \
        __builtin_amdgcn_sched_group_barrier(0x100, NKS, 0); __builtin_amdgcn_sched_group_barrier(0x008, NKS, 0); } while (0)
#define FA_QK(S0, S1, SB_, KT) do { unsigned nwa_ = 0u, nwb_ = 0u; \
        if constexpr (MODE == 1) { const u32x4 bw_ = *(const LAS u32x4*)((SB_) + BMOFF + wave * 1024 + lane * 16);        \
            nwa_ = ~((((KT) & 1) ? bw_.z : bw_.x) >> (4 * h)); nwb_ = ~((((KT) & 1) ? bw_.w : bw_.y) >> (4 * h)); } \
        FA_QKH(S0, SB_, 0, nwa_); FA_QKH(S1, SB_, 32, nwb_); } while (0)
#define FA_QKX(S, SB_, ROFF) do { bf16x8 fa_[NKS]; \
        _Pragma("unroll") for (int ks = 0; ks < NKS; ++ks) fa_[ks] = *(const LAS bf16x8*)FA_KADDR(SB_, ROFF, ks); \
        _Pragma("unroll") for (int i = 0; i < 16; ++i) S[i] = 0.f; \
        _Pragma("unroll") for (int ks = 0; ks < NKS; ++ks) S = __builtin_amdgcn_mfma_f32_32x32x16_bf16(fa_[ks], qf[ks], S, 0, 0, 0); } while (0)
    if (ju == 0) {
#pragma unroll 1
        for (int a = 0; a < AHEAD; ++a) { FA_ISSUE(kt_lo + a, st_is); st_is = st_is + 1; }
        FA_WAITBAR((AHEAD - 2) * NDMA);
    }
    if (FA_PART(kt_lo)) FA_QK(c0, c1, lds + st_c * STB, kt_lo);
    auto fa_step = [&](f32x16& c0, f32x16& c1, f32x16& n0, f32x16& n1, float& rc, float& rn, const int kt) __attribute__((always_inline)) {
        const bool more1 = kt < kt_hi;
        const bool qnext = !more1 && (ju + 1 < n_units);
        if (qnext) { const UnitDesc dq = desc(ju + 1); FA_LOADQ(dq); }
        const int k0 = kt * 64;
        const bool part_c = FA_PART(kt), part_n = more1 && FA_PART(kt + 1);
        const LAS unsigned char* Sn = lds + st_n * STB; const LAS unsigned char* Vb = lds + st_c * STB;
        const unsigned va0_ = (unsigned)(size_t)(Vb + vtoff + vx0), va1_ = (unsigned)(size_t)(Vb + vtoff + vx1);
#define FA_PVR(R, O0, O1, O2, O3) asm volatile("ds_read_b64_tr_b16 %0, %8 offset:%10\n\tds_read_b64_tr_b16 %1, %8 offset:%11\n\tds_read_b64_tr_b16 %2, %9 offset:%10\n\tds_read_b64_tr_b16 %3, %9 offset:%11\n\t" \
                             "ds_read_b64_tr_b16 %4, %8 offset:%12\n\tds_read_b64_tr_b16 %5, %8 offset:%13\n\tds_read_b64_tr_b16 %6, %9 offset:%12\n\tds_read_b64_tr_b16 %7, %9 offset:%13" \
                             : "=&v"(R[0]), "=&v"(R[1]), "=&v"(R[2]), "=&v"(R[3]), "=&v"(R[4]), "=&v"(R[5]), "=&v"(R[6]), "=&v"(R[7]) \
                             : "v"(va0_), "v"(va1_), "n"(O0), "n"(O1), "n"(O2), "n"(O3) : "memory")
        u32x2 vr0[8];
        if (part_c) FA_PVR(vr0, 0, 1024, 2048, 3072);
        const bool smask = MODE == 1 ? false : (MODE == 2 ? (k0 + 63 > qw) : true);
        const bool fused = ATT_FUSE2 && (MODE != 0) && part_c && part_n && !smask;
        float alpha = 1.0f;
        if (fused) {
            bf16x8 fa0[NKS], fa1[NKS];
#pragma unroll
            for (int ks = 0; ks < NKS; ++ks) { fa0[ks] = *(const LAS bf16x8*)FA_KADDR(Sn, 0, ks); fa1[ks] = *(const LAS bf16x8*)FA_KADDR(Sn, 32, ks); }
            if constexpr (MODE == 1) { const u32x4 bw_ = *(const LAS u32x4*)(Sn + BMOFF + wave * 1024 + lane * 16);
                if (RIA) { mask_init_ref(n0, ~((((kt + 1) & 1) ? bw_.z : bw_.x) >> (4 * h)), -msr); mask_init_ref(n1, ~((((kt + 1) & 1) ? bw_.w : bw_.y) >> (4 * h)), -msr); }
                else { mask_init(n0, ~((((kt + 1) & 1) ? bw_.z : bw_.x) >> (4 * h))); mask_init(n1, ~((((kt + 1) & 1) ? bw_.w : bw_.y) >> (4 * h))); }
            } else {
#pragma unroll
                for (int i = 0; i < 16; ++i) { n0[i] = 0.f; n1[i] = 0.f; } }
            rn = RIA ? msr : 0.f;
            float mxa, mxb, ms = 0.f, ls = 0.f;
#define FA_MF(S, F, KS) do { S = __builtin_amdgcn_mfma_f32_32x32x16_bf16(F[KS], qf[KS], S, 0, 0, 0); __builtin_amdgcn_sched_barrier(0); } while (0)
#define FA_PC(...) do { __VA_ARGS__; __builtin_amdgcn_sched_barrier(0); } while (0)
            __builtin_amdgcn_sched_barrier(0);
#define FA_MF0(S, F) FA_MF(S, F, 0)
            FA_MF0(n0, fa0); FA_PC(mxa = max16(c0));
            FA_MF0(n1, fa1); FA_PC(mxb = max16(c1));
            FA_MF(n0, fa0, 1); FA_PC({ const float mx = fmaxf(mxa, mxb) + rc;
                if (__any(mx > m + SM_THR)) { const float mn = fmaxf(m, xhalf_max(mx)); alpha = __builtin_amdgcn_exp2f(m - ((mn == -INFINITY) ? 0.f : mn)); m = mn; msr = (m == -INFINITY) ? 0.f : m; }
                if constexpr (RIA) { const float dsub = msr - rc;
                    if (__any(dsub != 0.f)) { _Pragma("unroll") for (int i = 0; i < 16; ++i) { c0[i] -= dsub; c1[i] -= dsub; } }
                    ms = 0.f; } else ms = msr; });
            if constexpr (NKS == 6) {
                FA_MF(n1, fa1, 1); FA_PC(sm_piece<0, 4>(c0, c1, ms, ls));
                FA_MF(n0, fa0, 2); FA_PC(sm_piece<4, 8>(c0, c1, ms, ls));
                FA_MF(n1, fa1, 2); FA_PC(sm_piece<8, 12>(c0, c1, ms, ls));
                FA_MF(n0, fa0, 3); FA_PC(sm_piece<12, 16>(c0, c1, ms, ls));
                FA_MF(n1, fa1, 3); FA_PC(sm_piece<16, 20>(c0, c1, ms, ls));
                FA_MF(n0, fa0, 4); FA_PC(sm_piece<20, 23>(c0, c1, ms, ls));
                FA_MF(n1, fa1, 4); FA_PC(sm_piece<23, 26>(c0, c1, ms, ls));
                FA_MF(n0, fa0, 5); FA_PC(sm_piece<26, 29>(c0, c1, ms, ls));
                FA_MF(n1, fa1, 5); FA_PC(sm_piece<29, 32>(c0, c1, ms, ls));
            } else {
                FA_MF(n1, fa1, 1); FA_PC(sm_piece<0, 7>(c0, c1, ms, ls));
                FA_MF(n0, fa0, 2); FA_PC(sm_piece<7, 14>(c0, c1, ms, ls));
                FA_MF(n1, fa1, 2); FA_PC(sm_piece<14, 20>(c0, c1, ms, ls));
                FA_MF(n0, fa0, 3); FA_PC(sm_piece<20, 26>(c0, c1, ms, ls));
                FA_MF(n1, fa1, 3); FA_PC(sm_piece<26, 32>(c0, c1, ms, ls));
            }
#undef FA_MF
#undef FA_MF0
#undef FA_PC
            l = l * alpha + ls;
        } else if (part_n) { FA_QK(n0, n1, Sn, kt + 1); rn = 0.f; }
        FA_ISSUE(kt + AHEAD, st_is); st_is = (st_is + 1 == NST) ? 0 : st_is + 1;
        if (part_c) {
            if (!fused && __any(rc != 0.f)) {
#pragma unroll
                for (int i = 0; i < 16; ++i) { c0[i] += rc; c1[i] += rc; } }
#define FA_SOFTMAX(MASKED) do { \
            if (MASKED) { if constexpr (MODE == 2) { const int qa = qh - k0, qa1 = qa - 32; \
                    _Pragma("unroll") for (int i = 0; i < 16; ++i) { const int ci = (i & 3) + 8 * (i >> 2); \
                        c0[i] = (ci > qa) ? -INFINITY : c0[i]; c1[i] = (ci > qa1) ? -INFINITY : c1[i]; } \
                } else if constexpr (MODE == 0) { const int lb = lqh - k0; const unsigned span = (unsigned)(q - lo_q), lb1 = (unsigned)(lb - 32);     \
                    _Pragma("unroll") for (int i = 0; i < 16; ++i) { const int ci = (i & 3) + 8 * (i >> 2); \
                        c0[i] = ((unsigned)(ci - lb) > span) ? -INFINITY : c0[i]; c1[i] = ((unsigned)ci - lb1 > span) ? -INFINITY : c1[i]; } \
                } } \
            float mx = fmaxf(max16(c0), max16(c1)); \
            if (__any(mx > m + SM_THR)) { const float mn = fmaxf(m, xhalf_max(mx)); alpha = __builtin_amdgcn_exp2f(m - ((mn == -INFINITY) ? 0.f : mn)); m = mn; msr = (m == -INFINITY) ? 0.f : m; }        \
            const float ms = msr; \
            float ls = 0.f; \
            if (PROBE_EXP2) { float dm_ = 0.f; _Pragma("unroll") for (int i = 0; i < 16; ++i) { dm_ += __builtin_amdgcn_exp2f(c0[i] - mx) + __builtin_amdgcn_exp2f(c1[i] - mx); } asm volatile("" :: "v"(dm_)); } \
            if (SOFTMAX_PK) { const f32x2 ms2 = {ms, ms}; f32x2 lsa = {0.f, 0.f}, lsb = {0.f, 0.f};            \
              _Pragma("unroll") for (int i = 0; i < 16; i += 2) { \
                  f32x2 ta = {c0[i], c0[i + 1]}, tb = {c1[i], c1[i + 1]}; ta = ta - ms2; tb = tb - ms2; \
                  ta.x = __builtin_amdgcn_exp2f(ta.x); ta.y = __builtin_amdgcn_exp2f(ta.y); tb.x = __builtin_amdgcn_exp2f(tb.x); tb.y = __builtin_amdgcn_exp2f(tb.y); \
                  c0[i] = ta.x; c0[i + 1] = ta.y; c1[i] = tb.x; c1[i + 1] = tb.y; lsa = lsa + ta; lsb = lsb + tb; } \
              lsa = lsa + lsb; ls = lsa.x + lsa.y; \
            } else {        \
              _Pragma("unroll") for (int i = 0; i < 16; ++i) { c0[i] = __builtin_amdgcn_exp2f(c0[i] - ms); c1[i] = __builtin_amdgcn_exp2f(c1[i] - ms); ls += c0[i] + c1[i]; } } \
            l = l * alpha + ls; } while (0)
            const bool need_mask = MODE == 1 ? false : (MODE == 2 ? (k0 + 63 > qw) : ((k0 + 63 > qw) || (k0 < lo_w1)));
            if (!fused) { if (need_mask) FA_SOFTMAX(true); else FA_SOFTMAX(false); }
#undef FA_SOFTMAX
            if (!__all(alpha == 1.0f)) {
#pragma unroll
                for (int i = 0; i < 16; ++i) { o0[i] *= alpha; o1[i] *= alpha; } }
#define FA_PVM(S_, R) do { bf16x8 pf[2]; \
                _Pragma("unroll") for (int sk = 0; sk < 2; ++sk) { u32x4 pw; pw.x = pk2(S_[8 * sk + 0], S_[8 * sk + 1]); pw.y = pk2(S_[8 * sk + 2], S_[8 * sk + 3]); pw.z = pk2(S_[8 * sk + 4], S_[8 * sk + 5]); pw.w = pk2(S_[8 * sk + 6], S_[8 * sk + 7]); pf[sk] = __builtin_bit_cast(bf16x8, pw); } \
                { const u32x4 v0w = {R[0].x, R[0].y, R[1].x, R[1].y}, v1w = {R[2].x, R[2].y, R[3].x, R[3].y}; \
                  o0 = __builtin_amdgcn_mfma_f32_32x32x16_bf16(__builtin_bit_cast(bf16x8, v0w), pf[0], o0, 0, 0, 0); \
                  o1 = __builtin_amdgcn_mfma_f32_32x32x16_bf16(__builtin_bit_cast(bf16x8, v1w), pf[0], o1, 0, 0, 0); } \
                { const u32x4 v0w = {R[4].x, R[4].y, R[5].x, R[5].y}, v1w = {R[6].x, R[6].y, R[7].x, R[7].y}; \
                  o0 = __builtin_amdgcn_mfma_f32_32x32x16_bf16(__builtin_bit_cast(bf16x8, v0w), pf[1], o0, 0, 0, 0); \
                  o1 = __builtin_amdgcn_mfma_f32_32x32x16_bf16(__builtin_bit_cast(bf16x8, v1w), pf[1], o1, 0, 0, 0); } } while (0)
            u32x2 vr1[8];
            FA_PVR(vr1, 4096, 5120, 6144, 7168);
            asm volatile("s_waitcnt lgkmcnt(8)" : "+v"(vr0[0]), "+v"(vr0[1]), "+v"(vr0[2]), "+v"(vr0[3]), "+v"(vr0[4]), "+v"(vr0[5]), "+v"(vr0[6]), "+v"(vr0[7]) :: "memory");
            __builtin_amdgcn_sched_barrier(0);
            FA_PVM(c0, vr0);
            asm volatile("s_waitcnt lgkmcnt(0)" : "+v"(vr1[0]), "+v"(vr1[1]), "+v"(vr1[2]), "+v"(vr1[3]), "+v"(vr1[4]), "+v"(vr1[5]), "+v"(vr1[6]), "+v"(vr1[7]) :: "memory");
            __builtin_amdgcn_sched_barrier(0);
            FA_PVM(c1, vr1);
#undef FA_PVM
#undef FA_PVR
        }
        if (qnext) FA_WAITBAR((AHEAD - 2) * NDMA + NKS); else FA_WAITBAR((AHEAD - 2) * NDMA);
        st_c = st_n; st_n = (st_n + 1 == NST) ? 0 : st_n + 1;
    };
    for (int kt = kt_lo;;) { fa_step(c0, c1, n0, n1, rc_, rn_, kt); if (++kt > kt_hi) break; fa_step(n0, n1, c0, c1, rn_, rc_, kt); if (++kt > kt_hi) break; }
#undef FA_PART
#undef FA_QK
#undef FA_QKH
#undef FA_QKX
#undef FA_KADDR
    const float lt = xhalf_sum(l);
    const float inv = 1.0f / lt;
    if (active) {
    bf16* op = P.O + (size_t)(seq0 + q) * P.o_pitch + o_col + 8 * h;
#pragma unroll
    for (int db = 0; db < 2; ++db) {
        const f32x16& o = db ? o1 : o0;
#pragma unroll
        for (int j = 0; j < 2; ++j) {
            u32x2 X, Y;
            X.x = pk2(o[8 * j] * inv, o[8 * j + 1] * inv); X.y = pk2(o[8 * j + 2] * inv, o[8 * j + 3] * inv);
            Y.x = pk2(o[8 * j + 4] * inv, o[8 * j + 5] * inv); Y.y = pk2(o[8 * j + 6] * inv, o[8 * j + 7] * inv);
            const auto a = __builtin_amdgcn_permlane32_swap(X.x, Y.x, false, false); const auto b = __builtin_amdgcn_permlane32_swap(X.y, Y.y, false, false);
            u32x4 w; w.x = a[0]; w.y = b[0]; w.z = a[1]; w.w = b[1];
            stg16<NT_ATT>(op + 32 * db + 16 * j, w);
        }
    }
    if (P.LSE && h == 0) P.LSE[(size_t)(seq0 + q) * P.lse_pitch + lse_col] = m + __builtin_amdgcn_logf(lt);
    }
    __builtin_amdgcn_sched_barrier(0);
    FA_WAITQ(4);
    }
    asm volatile("s_waitcnt vmcnt(0)" ::: "memory"); __builtin_amdgcn_s_barrier(); asm volatile("" ::: "memory");
#undef FA_ISSUE
#undef FA_LOADQ
#undef FA_WAITQ
#undef FA_WAITBAR
}
}

struct Args {
    const float* x; const int* pos; const float* w_in; const float* qn; const float* kvn; const float* w_uq; const float* w_ukv; const float* w_o;
    const float* ln1g; const float* ln1b; const float* rgw; const float* rgb; const float* rew; const float* reb;
    const float* wg; const float* wu; const float* wd; const float* ln2g; const float* ln2b;
    float* out; unsigned char* ws; int l_lo, l_hi, ph_lo, ph_hi, use_bar, pad;
};
typedef const __attribute__((address_space(4))) Args CArgs;
struct Ctx { LAS unsigned char* lds; int tid, lane, wave, G, c, vcu; unsigned char* ws; };

struct ColIdent { int off; __device__ __forceinline__ int operator()(int P) const { return off + P; } };
struct ColAdj { __device__ __forceinline__ int operator()(int P) const { const int p = P & 255; return (P & ~255) + 64 * ((p >> 5) & 3) + 32 * (p >> 7) + (p & 31); } };
__device__ __forceinline__ int map_rope32(int p) { return 16 * ((p >> 2) & 1) + 4 * (p >> 3) + (p & 3); }
__device__ __forceinline__ int map_head16(int p) { const int fq = p >> 3; return 16 * (fq >> 1) + 8 * ((p >> 2) & 1) + 4 * (fq & 1) + (p & 3); }
struct ColWin {
    __device__ __forceinline__ int operator()(int P) const {
        const int G = P >> 5, p = P & 31;
        if (G < 8) return 32 * G + p;
        if (G < 12) return 256 + 32 * (G - 8) + p;
        if (G == 12) return 384 + map_rope32(p);
        if (G == 13) return 1056 + p;
        if (G == 14) return 672 + map_head16(p);
        if (G == 15) return 704 + p;
        if (G < 24) { const int hh = (G - 16) >> 1; return 416 + 64 * hh + (((G - 16) & 1) ? 32 + p : map_head16(p)); }
        if (G < 26) return 736 + 32 * (G - 24) + p;
        if (G == 26) return p < 8 ? 1088 + p : -1;
        if (G < 32) return -1;
        if (G < 40) return 800 + 32 * (G - 32) + p;
        if (G < 64) { const int j = G - 40; return 1096 + 64 * (j >> 1) + ((j & 1) ? 32 + p : map_head16(p)); }
        if (G < 88) { const int j = G - 64; return 1096 + 768 + 64 * (j >> 1) + ((j & 1) ? 32 + p : map_head16(p)); }
        return 1096 + 1536 + 32 * (G - 88) + p;
    }
};
struct ColUq {
    __device__ __forceinline__ int operator()(int P) const { const int G = P >> 5, p = P & 31; return 32 * G + ((G % 3 == 2) ? map_rope32(p) : p); }
};
template <class ColFn>
__device__ __forceinline__ void transpose_item(const float* W, int ldw, int kvalid, bf16* WT, int ldt, int k0, int P0, const ColFn& cf, const float* rowscale, LAS float* scr, int lane) {
    const int c = lane & 31, col = cf(P0 + c);
#pragma unroll 8
    for (int i = 0; i < 32; ++i) { const int kk = 2 * i + (lane >> 5), k = k0 + kk; float v = 0.f;
        if (col >= 0 && k < kvalid) { v = ldg_s<float>(W + (size_t)k * ldw + col); if (rowscale) v *= rowscale[k]; }
        scr[kk * 33 + c] = v; }
    asm volatile("s_waitcnt lgkmcnt(0)" ::: "memory");
    const int cc = lane & 7;
#pragma unroll
    for (int j = 0; j < 4; ++j) { const int n = (lane >> 3) + 8 * j; const LAS float* s = scr + (8 * cc) * 33 + n;
        u32x4 o; o.x = pk2(s[0 * 33], s[1 * 33]); o.y = pk2(s[2 * 33], s[3 * 33]); o.z = pk2(s[4 * 33], s[5 * 33]); o.w = pk2(s[6 * 33], s[7 * 33]);
        *(u32x4*)(WT + (size_t)(P0 + n) * ldt + k0 + 8 * cc) = o; }
    asm volatile("s_waitcnt lgkmcnt(0)" ::: "memory");
}
__device__ __forceinline__ void prologue(const Ctx& X, const CArgs* ap) {
    struct { const float* x; const float *w_in, *qn, *kvn, *w_uq, *w_ukv, *w_o, *rgw, *rew; } a = {ap->x, ap->w_in, ap->qn, ap->kvn, ap->w_uq, ap->w_ukv, ap->w_o, ap->rgw, ap->rew};
    LAS float* scr = (LAS float*)(X.lds + X.wave * 16384);
    const int gw = X.vcu * 8 + X.wave, NGW = X.G * 8;
    constexpr int I_WIN = 16 * 112, I_UQ = 4 * 24, I_UKV = 2 * 32, I_WO = 16 * 32, I_L = I_WIN + I_UQ + I_UKV + I_WO;
    for (int it = gw; it < DEPTH * I_L; it += NGW) {
        const int l = it / I_L; int r = it % I_L;
        if (r < I_WIN) { transpose_item(a.w_in + (size_t)l * DM * IN_COLS, IN_COLS, DM, (bf16*)(X.ws + WS_WIN) + (size_t)l * NIN * DM, DM, 64 * (r / 112), 32 * (r % 112), ColWin{}, nullptr, scr, X.lane); continue; }
        r -= I_WIN;
        if (r < I_UQ) { transpose_item(a.w_uq + (size_t)l * 256 * 768, 768, 256, (bf16*)(X.ws + WS_WUQ) + (size_t)l * 768 * 256, 256, 64 * (r / 24), 32 * (r % 24), ColUq{}, a.qn + l * 256, scr, X.lane); continue; }
        r -= I_UQ;
        if (r < I_UKV) { transpose_item(a.w_ukv + (size_t)l * 128 * 1024, 1024, 128, (bf16*)(X.ws + WS_WUKV) + (size_t)l * 1024 * 128, 128, 64 * (r / 32), 32 * (r % 32), ColAdj{}, a.kvn + l * 128, scr, X.lane); continue; }
        r -= I_UKV;
        transpose_item(a.w_o + (size_t)l * DM * DM, DM, DM, (bf16*)(X.ws + WS_WO) + (size_t)l * DM * DM, DM, 64 * (r / 32), 32 * (r % 32), ColAdj{}, nullptr, scr, X.lane);
    }
    const size_t gt = (size_t)X.vcu * 512 + X.tid, NGT = (size_t)X.G * 512;
    { float* rgt = (float*)(X.ws + WS_RGT); float* ret = (float*)(X.ws + WS_RET);
      for (size_t i = gt; i < (size_t)DEPTH * 4 * DM; i += NGT) { const int l = (int)(i / (4 * DM)), g = (int)(i / DM) & 3, k = (int)(i % DM); rgt[i] = a.rgw[((size_t)l * DM + k) * 4 + g]; }
      for (size_t i = gt; i < (size_t)DEPTH * 32 * DM; i += NGT) { const int l = (int)(i / (32 * DM)), ge = (int)(i / DM) & 31, k = (int)(i % DM); ret[i] = a.rew[(((size_t)l * 4 + (ge >> 3)) * DM + k) * 8 + (ge & 7)]; } }
    { const f32x4* xs = (const f32x4*)a.x; u32x2* xb = (u32x2*)((unsigned char*)ap->out + XR_OFF);
      for (size_t i = gt; i < (size_t)NT * DM / 4; i += NGT) { const f32x4 v = ldg_s<f32x4>(xs + i); u32x2 w; w.x = pk2(v[0], v[1]); w.y = pk2(v[2], v[3]); xb[i] = w; } }
}
__device__ __forceinline__ void convert_experts(const Ctx& X, const CArgs* ap, int l) {
    struct { const float *wg, *wu, *wd; } a = {ap->wg, ap->wu, ap->wd};
    LAS float* scr = (LAS float*)(X.lds + X.wave * 16384);
    const int gw = X.vcu * 8 + X.wave, NGW = X.G * 8;
    constexpr int I_GU = 32 * 16 * 16, I_D = 32 * 4 * 32;
    for (int it = gw; it < I_GU + I_D; it += NGW) {
        if (it < I_GU) { const int e = it >> 8, r = it & 255, G32 = r >> 4, kb = r & 15; const int pn = G32 >> 3, r0 = (G32 & 7) * 32; const bool up = r0 >= 128;
            const float* W = (up ? a.wu : a.wg) + ((size_t)l * NEXP + e) * DM * FH;
            transpose_item(W, FH, DM, (bf16*)(X.ws + WS_WGU) + (size_t)e * 512 * DM, DM, 64 * kb, 32 * G32, ColIdent{128 * pn + (r0 & 127) - 32 * G32}, nullptr, scr, X.lane);
        } else { const int r = it - I_GU, e = r >> 7, q = r & 127, kb = q >> 5, pg = q & 31;
            transpose_item(a.wd + ((size_t)l * NEXP + e) * FH * DM, DM, FH, (bf16*)(X.ws + WS_WD) + (size_t)e * DM * FH, FH, 64 * kb, 32 * pg, ColAdj{}, nullptr, scr, X.lane); }
    }
}

struct InProjDesc {
    unsigned char* ws;
    __device__ __forceinline__ pg8::GroupDesc operator()(int pn, int bj, int wc) const {
        using namespace pg8; const int G = 8 * pn + 4 * bj + wc; GroupDesc d; d.kind = GK_PLAIN; d.dst = nullptr; d.pitch = 256; d.col = 0; d.scale = 1.f; d.perm = 0; d.ssq = nullptr; d.ssq_n = 0; d.ssq_i = 0;
        if (G < 8) { d.dst = (bf16*)(ws + WS_CQ); d.col = 32 * G; d.ssq = (float*)(ws + WS_SSQ); d.ssq_n = 8; d.ssq_i = G; }
        else if (G < 12) { d.dst = (bf16*)(ws + WS_T1); d.pitch = 128; d.col = 32 * (G - 8); d.ssq = (float*)(ws + WS_SSQ) + (size_t)NT * 8; d.ssq_n = 4; d.ssq_i = G - 8; }
        else if (G == 12) { d.kind = GK_ROPE32; d.dst = (bf16*)(ws + WS_KPE); d.pitch = 32; d.col = 0; }
        else if (G == 13) { d.kind = GK_IDX8; d.dst = (bf16*)(ws + WS_KI); d.pitch = 32; d.col = 0; }
        else if (G == 14) { d.kind = GK_HEAD16; d.dst = (bf16*)(ws + WS_BK); d.pitch = 64; d.col = 0; }
        else if (G == 15) { d.dst = (bf16*)(ws + WS_BK); d.pitch = 64; d.col = 32; }
        else if (G < 24) { d.kind = ((G - 16) & 1) ? GK_PLAIN : GK_HEAD16; d.dst = (bf16*)(ws + WS_BQ); d.col = 32 * (G - 16); d.scale = QSC64; }
        else if (G < 26) { d.dst = (bf16*)(ws + WS_BV); d.pitch = 64; d.col = 32 * (G - 24); }
        else if (G == 26) { d.kind = GK_WI; d.dst = (bf16*)(ws + WS_WI); }
        else if (G < 32) { d.kind = GK_SKIP; }
        else if (G < 40) { d.kind = GK_IDX8; d.dst = (bf16*)(ws + WS_BQI); d.col = 32 * (G - 32); }
        else if (G < 64) { const int j = G - 40, cfg = j >> 3; d.kind = (j & 1) ? GK_PLAIN : GK_HEAD16; d.dst = (bf16*)(ws + WS_DQ) + (size_t)cfg * NT * 256; d.col = 32 * (j & 7); d.scale = QSC64; d.perm = cfg == 0 ? 0 : (cfg == 1 ? 4 : 16); }
        else if (G < 88) { const int j = G - 64, cfg = j >> 3; d.kind = (j & 1) ? GK_PLAIN : GK_HEAD16; d.dst = (bf16*)(ws + WS_DK) + (size_t)cfg * NT * 256; d.col = 32 * (j & 7); d.perm = cfg == 0 ? 0 : (cfg == 1 ? 4 : 16); }
        else { const int j = G - 88, cfg = j >> 3; d.dst = (bf16*)(ws + WS_DV) + (size_t)cfg * NT * 256; d.col = 32 * (j & 7); d.perm = cfg == 0 ? 0 : (cfg == 1 ? 4 : 16); }
        return d;
    }
};
struct UqDesc {
    unsigned char* ws;
    __device__ __forceinline__ pg8::GroupDesc operator()(int pn, int bj, int wc) const {
        using namespace pg8; const int G = 8 * pn + 4 * bj + wc; GroupDesc d; d.kind = (G % 3 == 2) ? GK_ROPE32 : GK_PLAIN; d.dst = (bf16*)(ws + WS_QA); d.pitch = 768; d.col = 32 * G; d.scale = QSC96; d.perm = 0; d.ssq = nullptr; d.ssq_n = 0; d.ssq_i = 0;
        return d;
    }
};

__device__ __forceinline__ unsigned f16key(float v) { const _Float16 hf = (_Float16)v; const unsigned u = (unsigned)__builtin_bit_cast(unsigned short, hf); return (u ^ ((unsigned)__builtin_amdgcn_sbfe((int)u, 15, 1) | 0x8000u)) & 0xffffu; }
__device__ __forceinline__ unsigned pk_cnt(unsigned acc, unsigned kp2, unsigned mid2, unsigned one2) {
    unsigned t;
    asm("v_pk_sub_u16 %0, %2, %3 clamp\n\tv_pk_min_u16 %0, %0, %4\n\tv_pk_add_u16 %1, %1, %0" : "=&v"(t), "+v"(acc) : "v"(kp2), "s"(mid2), "s"(one2));
    return acc;
}
__device__ __forceinline__ int count_gt(const unsigned (&kp)[16], unsigned mid) {
    const unsigned m2 = __builtin_amdgcn_readfirstlane(mid | (mid << 16)), one2 = __builtin_amdgcn_readfirstlane(0x00010001u);
    unsigned a0 = 0u, a1 = 0u;
#pragma unroll
    for (int i = 0; i < 16; i += 2) { a0 = pk_cnt(a0, kp[i], m2, one2); a1 = pk_cnt(a1, kp[i + 1], m2, one2); }
    unsigned aw; asm("v_pk_add_u16 %0, %1, %2" : "=v"(aw) : "v"(a0), "v"(a1));
    const unsigned c = (aw & 0xffffu) + (aw >> 16);
    int tot = 0;
#pragma unroll
    for (int b = 0; b < 6; ++b) tot += __builtin_popcountll(__ballot((c >> b) & 1u)) << b;
    return tot;
}
__device__ __forceinline__ int wave_scan_incl(int v) {
    v += __builtin_amdgcn_update_dpp(0, v, 0x111, 0xf, 0xf, false); v += __builtin_amdgcn_update_dpp(0, v, 0x112, 0xf, 0xf, false);
    v += __builtin_amdgcn_update_dpp(0, v, 0x114, 0xf, 0xf, false); v += __builtin_amdgcn_update_dpp(0, v, 0x118, 0xf, 0xf, false);
    v += __builtin_amdgcn_update_dpp(0, v, 0x142, 0xa, 0xf, false); v += __builtin_amdgcn_update_dpp(0, v, 0x143, 0xc, 0xf, false);
    return v;
}
__device__ __forceinline__ void radix_pick(const LAS unsigned* hist, int lane, int target, int& B, int& above, int& inbin) {
    const u32x2 hw = *(const LAS u32x2*)(hist + 2 * lane);
    const int c0 = (int)(hw.x & 0xffffu), c1 = (int)(hw.x >> 16), c2 = (int)(hw.y & 0xffffu), c3 = (int)(hw.y >> 16);
    const int tl = (c0 + c1) + (c2 + c3);
    const int pre = wave_scan_incl(tl);
    const int suf = __builtin_amdgcn_readlane(pre, 63) - pre + tl;
    const unsigned long long reach = __ballot(suf >= target);
    const int ls = 63 - __builtin_clzll(reach | 1ull);
    int a = suf - tl, b = 4 * lane + 3, ib = c3;
    if (a + c3 < target) { a += c3; b = 4 * lane + 2; ib = c2; if (a + c2 < target) { a += c2; b = 4 * lane + 1; ib = c1; if (a + c1 < target) { a += c1; b = 4 * lane; ib = c0; } } }
    B = __builtin_amdgcn_readlane(b, ls); above = __builtin_amdgcn_readlane(a, ls); inbin = __builtin_amdgcn_readlane(ib, ls);
}
__device__ __forceinline__ float relu_i(float x) { const int i = __builtin_bit_cast(int, x); return __builtin_bit_cast(float, i > 0 ? i : 0); }
__device__ __forceinline__ void dsa_index_unit(const Ctx& X, int b, int q0) {
    const int lane = X.lane, r = lane & 31, h = lane >> 5; const size_t seq0 = (size_t)b * SEQ; const int t0 = q0 + 4 * X.wave;
    const bf16* BQI = (const bf16*)(X.ws + WS_BQI); const bf16* KI = (const bf16*)(X.ws + WS_KI); const float* WI = (const float*)(X.ws + WS_WI);
    LAS unsigned short* rows = (LAS unsigned short*)(X.lds + X.wave * 16384);
    LAS unsigned char* kbuf = X.lds + LDS_X_OFF;
    const bf16* ap = BQI + (seq0 + t0 + (r >> 3)) * 256 + 32 * (r & 7) + 16 * h;
    const bf16x8 a0 = *(const bf16x8*)ap, a1 = *(const bf16x8*)(ap + 8);
    f32x2 wq[4][2];
#pragma unroll
    for (int j = 0; j < 4; ++j) { const f32x4 w = *(const f32x4*)(WI + (seq0 + t0 + j) * 8 + 4 * h);
        wq[j][0] = (f32x2){w[0] * IDX_SCALE, w[1] * IDX_SCALE}; wq[j][1] = (f32x2){w[2] * IDX_SCALE, w[3] * IDX_SCALE}; }
    const int nch = ((q0 + 31) >> 7) + 1;
    const int skey = X.tid >> 2, spc = X.tid & 3;
    const bf16* sp = KI + (seq0 + skey) * 32 + 8 * spc;
    const int sdst = skey * 64 + ((spc ^ ((skey >> 2) & 3)) << 4);
    u32x4 stg0 = *(const u32x4*)sp, stg1 = stg0, stg2 = stg0, stg3 = stg0;
    if (1 < nch) stg1 = *(const u32x4*)(sp + (size_t)1 * 128 * 32);
    if (2 < nch) stg2 = *(const u32x4*)(sp + (size_t)2 * 128 * 32);
    if (3 < nch) stg3 = *(const u32x4*)(sp + (size_t)3 * 128 * 32);
    *(LAS u32x4*)(kbuf + sdst) = stg0;
    __syncthreads();
#define DSA_STEP(J, RCUR, RNEXT) { const int c = c0 + (J); \
        if (c + 4 < nch) RCUR = *(const u32x4*)(sp + (size_t)(c + 4) * 128 * 32); \
        const LAS unsigned char* kb = kbuf + (c & 1) * 8192; \
        f32x16 accq[4];        \
        _Pragma("unroll") for (int tq = 0; tq < 4; ++tq) { \
            const int key = 32 * tq + r, sw = (key >> 2) & 3; \
            const bf16x8 b0 = *(const LAS bf16x8*)(kb + key * 64 + (((2 * h) ^ sw) << 4)), b1 = *(const LAS bf16x8*)(kb + key * 64 + (((2 * h + 1) ^ sw) << 4)); \
            _Pragma("unroll") for (int i = 0; i < 16; ++i) accq[tq][i] = 0.f; \
            accq[tq] = __builtin_amdgcn_mfma_f32_32x32x16_bf16(a0, b0, accq[tq], 0, 0, 0); \
            accq[tq] = __builtin_amdgcn_mfma_f32_32x32x16_bf16(a1, b1, accq[tq], 0, 0, 0); } \
        __builtin_amdgcn_sched_barrier(0); \
        _Pragma("unroll") for (int tq = 0; tq < 4; ++tq) { const f32x16& acc = accq[tq]; \
            float p[4]; \
            _Pragma("unroll") for (int j = 0; j < 4; ++j) {            \
                const f32x2 ra = {relu_i(acc[4 * j]), relu_i(acc[4 * j + 1])}, rb = {relu_i(acc[4 * j + 2]), relu_i(acc[4 * j + 3])}; \
                const f32x2 pp = __builtin_elementwise_fma(rb, wq[j][1], ra * wq[j][0]); \
                p[j] = pp.x + pp.y; } \
            const auto s01 = __builtin_amdgcn_permlane32_swap(__float_as_uint(p[0]), __float_as_uint(p[1]), false, false); \
            const auto s23 = __builtin_amdgcn_permlane32_swap(__float_as_uint(p[2]), __float_as_uint(p[3]), false, false); \
            const float va = __uint_as_float(s01[0]) + __uint_as_float(s01[1]), vb = __uint_as_float(s23[0]) + __uint_as_float(s23[1]); \
            const int hw = 128 * c + 32 * tq + r;                                      \
            rows[h * 2048 + hw] = (unsigned short)f16key(va); \
            rows[(2 + h) * 2048 + hw] = (unsigned short)f16key(vb); \
        } \
        if (c + 1 < nch) *(LAS u32x4*)(kbuf + ((c + 1) & 1) * 8192 + sdst) = RNEXT; \
        __syncthreads(); }
#ifndef REP_SCORE
#define REP_SCORE 1
#endif
#ifndef REP_SEL
#define REP_SEL 1
#endif
    for (int rsc = 0; rsc < REP_SCORE; ++rsc) {
    if (rsc > 0) { stg0 = *(const u32x4*)sp; stg1 = stg0; stg2 = stg0; stg3 = stg0; if (1 < nch) stg1 = *(const u32x4*)(sp + (size_t)1 * 128 * 32); if (2 < nch) stg2 = *(const u32x4*)(sp + (size_t)2 * 128 * 32); if (3 < nch) stg3 = *(const u32x4*)(sp + (size_t)3 * 128 * 32); *(LAS u32x4*)(kbuf + sdst) = stg0; __syncthreads(); }
    for (int c0 = 0; c0 < nch; c0 += 4) {
        DSA_STEP(0, stg0, stg1)
        if (c0 + 1 >= nch) break;
        DSA_STEP(1, stg1, stg2)
        if (c0 + 2 >= nch) break;
        DSA_STEP(2, stg2, stg3)
        if (c0 + 3 >= nch) break;
        DSA_STEP(3, stg3, stg0)
    }
    }
#undef DSA_STEP
    unsigned* BMp = (unsigned*)(X.ws + WS_BM);
#ifndef REP_BIS
#define REP_BIS 1
#endif
#ifndef REP_EMIT
#define REP_EMIT 1
#endif
    for (int rsl = 0; rsl < REP_SEL; ++rsl)
    for (int j = 0; j < 4; ++j) {
        const int t = t0 + j;
        const LAS u32x4* rw = (const LAS u32x4*)(rows + j * 2048) + 4 * lane;
        unsigned kp[16];
#pragma unroll
        for (int v4 = 0; v4 < 4; ++v4) { const u32x4 d = rw[v4]; kp[4 * v4] = d.x; kp[4 * v4 + 1] = d.y; kp[4 * v4 + 2] = d.z; kp[4 * v4 + 3] = d.w; }
        const int nv = t + 1 - 32 * lane;
#pragma unroll
        for (int d = 0; d < 16; ++d) kp[d] &= ((2 * d < nv) ? 0xffffu : 0u) | ((2 * d + 1 < nv) ? 0xffff0000u : 0u);
        unsigned thr = 0u; int need = 0;
        for (int rb_ = 0; rb_ < REP_BIS; ++rb_)
        if (t + 1 > 256) {
            LAS unsigned* hist = (LAS unsigned*)(X.lds + LDS_HIST_OFF + X.wave * 512);
            *(LAS u32x2*)(hist + 2 * lane) = (u32x2){0u, 0u};
#pragma unroll
            for (int d = 0; d < 16; ++d) { const unsigned klo = kp[d] & 0xffffu, khi = kp[d] >> 16;
                if (klo) __hip_atomic_fetch_add(hist + (klo >> 9), (klo & 0x100u) ? 0x10000u : 1u, __ATOMIC_RELAXED, __HIP_MEMORY_SCOPE_WORKGROUP);
                if (khi) __hip_atomic_fetch_add(hist + (khi >> 9), (khi & 0x100u) ? 0x10000u : 1u, __ATOMIC_RELAXED, __HIP_MEMORY_SCOPE_WORKGROUP); }
            int B1, above1, in1; radix_pick(hist, lane, 256, B1, above1, in1);
            *(LAS u32x2*)(hist + 2 * lane) = (u32x2){0u, 0u};
#pragma unroll
            for (int d = 0; d < 16; ++d) { const unsigned klo = kp[d] & 0xffffu, khi = kp[d] >> 16;
                if ((int)(klo >> 8) == B1) __hip_atomic_fetch_add(hist + ((klo & 0xffu) >> 1), (klo & 1u) ? 0x10000u : 1u, __ATOMIC_RELAXED, __HIP_MEMORY_SCOPE_WORKGROUP);
                if ((int)(khi >> 8) == B1) __hip_atomic_fetch_add(hist + ((khi & 0xffu) >> 1), (khi & 1u) ? 0x10000u : 1u, __ATOMIC_RELAXED, __HIP_MEMORY_SCOPE_WORKGROUP); }
            int B2, above2, in2; radix_pick(hist, lane, 256 - above1, B2, above2, in2);
            const unsigned tk = ((unsigned)B1 << 8) | (unsigned)B2;
            const int rest = 256 - (above1 + above2);
            if (rest >= in2) { thr = tk - 1u; need = 0; } else { thr = tk; need = rest; }
        }
        unsigned word = 0u, eqw = 0u;
        const unsigned thr2 = __builtin_amdgcn_readfirstlane(thr | (thr << 16)), one2 = __builtin_amdgcn_readfirstlane(0x00010001u);
#pragma unroll
        for (int d = 0; d < 16; ++d) { unsigned g;
            asm("v_pk_sub_u16 %0, %1, %2 clamp\n\tv_pk_min_u16 %0, %0, %3" : "=&v"(g) : "v"(kp[d]), "s"(thr2), "s"(one2));
            word |= ((g | (g >> 15)) & 3u) << (2 * d); }
        if (need > 0) {
#pragma unroll
            for (int d = 0; d < 16; ++d) { unsigned g; const unsigned x = kp[d] ^ thr2;
                asm("v_pk_min_u16 %0, %1, %2" : "=v"(g) : "v"(x), "s"(one2));
                eqw |= ((~(g | (g >> 15))) & 3u) << (2 * d); }
            if (thr == 0u) eqw = 0u;
            const int ne = __builtin_popcount(eqw); const int inc = wave_scan_incl(ne);
            int take = need - (inc - ne); take = take < 0 ? 0 : (take > ne ? ne : take);
            while (__any(take > 0)) { if (take > 0) { const unsigned lowbit = eqw & (0u - eqw); word |= lowbit; eqw ^= lowbit; --take; } }
        }
        BMp[(seq0 + t) * 64 + lane] = word;
    }
}

__device__ __forceinline__ void dil_combine(const Ctx& X) {
    const bf16* OD = (const bf16*)(X.ws + WS_OD); const float* LS = (const float*)(X.ws + WS_LSE); bf16* O = (bf16*)(X.ws + WS_XB);
    const int gw = X.vcu * 8 + X.wave, NGW = X.G * 8, lane = X.lane, hh = lane >> 4;
    for (int t = gw; t < NT; t += NGW) {
        const int b = t >> 11, s = t & 2047;
        const int r0 = t, r1 = (b << 11) + ((s & 3) << 9) + (s >> 2), r2 = (b << 11) + ((s & 15) << 7) + (s >> 4);
        const float L0 = LS[(size_t)r0 * 4 + hh], L1 = LS[((size_t)NT + r1) * 4 + hh], L2 = LS[((size_t)2 * NT + r2) * 4 + hh];
        const float mx = fmaxf(L0, fmaxf(L1, L2));
        float w0 = __builtin_amdgcn_exp2f(L0 - mx), w1 = __builtin_amdgcn_exp2f(L1 - mx), w2 = __builtin_amdgcn_exp2f(L2 - mx);
        const float inv = 1.0f / (w0 + w1 + w2); w0 *= inv; w1 *= inv; w2 *= inv;
        const u32x2 a = *(const u32x2*)(OD + (size_t)r0 * 256 + 4 * lane), bq = *(const u32x2*)(OD + ((size_t)NT + r1) * 256 + 4 * lane), cq = *(const u32x2*)(OD + ((size_t)2 * NT + r2) * 256 + 4 * lane);
        u32x2 o;
        o.x = pk2(w0 * bflo(a.x) + w1 * bflo(bq.x) + w2 * bflo(cq.x), w0 * bfhi(a.x) + w1 * bfhi(bq.x) + w2 * bfhi(cq.x));
        o.y = pk2(w0 * bflo(a.y) + w1 * bflo(bq.y) + w2 * bflo(cq.y), w0 * bfhi(a.y) + w1 * bfhi(bq.y) + w2 * bfhi(cq.y));
        stg8<NT_ATT>(O + (size_t)t * DM + 768 + 4 * lane, o);
    }
}

__device__ __forceinline__ void ln1_router(const Ctx& X, const CArgs* ap, int l, bool first, bool dummy = false) {
    struct { const float *ln1g, *ln1b, *rgb, *reb; } a = {ap->ln1g, ap->ln1b, ap->rgb, ap->reb}; (void)first;
    const bf16* xin = (const bf16*)((const unsigned char*)ap->out + XR_OFF);
    const bool keep_copy = !LN2_X1B && (l == DEPTH - 1) && !dummy; bf16* XC = (bf16*)(X.ws + WS_KVA);
    const int lane = X.lane; const bf16* MIX = (const bf16*)(X.ws + WS_MIX); bf16* X1B = (bf16*)(X.ws + (dummy ? WS_Y : WS_XB));
    LAS float* reT = (LAS float*)X.lds;
    LAS float* rgT = (LAS float*)(X.lds + LDS_X_OFF);
    LAS int* hist = (LAS int*)(X.lds + LDSCTL_OFF + 256);
    { const u32x4* s1 = (const u32x4*)(X.ws + WS_RET + (size_t)l * 32 * DM * 4); for (int i = X.tid; i < 32 * DM / 4; i += 512) ((LAS u32x4*)reT)[i] = s1[i];
      const u32x4* s2 = (const u32x4*)(X.ws + WS_RGT + (size_t)l * 4 * DM * 4); for (int i = X.tid; i < 4 * DM / 4; i += 512) ((LAS u32x4*)rgT)[i] = s2[i]; }
    f32x4 g[4], bb[4];
#pragma unroll
    for (int j = 0; j < 4; ++j) { g[j] = *(const f32x4*)(a.ln1g + l * DM + 4 * lane + 256 * j); bb[j] = *(const f32x4*)(a.ln1b + l * DM + 4 * lane + 256 * j); }
    const float* rgb = a.rgb + l * 4; const float* reb = a.reb + l * 32;
    for (int rb = X.c; rb < NT / 256; rb += X.G) {
        if (X.tid < 32) hist[X.tid] = 0;
        __syncthreads();
        u32x2 xa[4], xb[4]; u32x2 ma[4], mb[4];
        { const int t = rb * 256 + X.wave * 32;
#pragma unroll
          for (int j = 0; j < 4; ++j) { xa[j] = *(const u32x2*)(xin + (size_t)t * DM + 4 * lane + 256 * j); ma[j] = *(const u32x2*)(MIX + (size_t)t * DM + 4 * lane + 256 * j); }
#pragma unroll
          for (int j = 0; j < 4; ++j) { xb[j] = *(const u32x2*)(xin + (size_t)(t + 1) * DM + 4 * lane + 256 * j); mb[j] = *(const u32x2*)(MIX + (size_t)(t + 1) * DM + 4 * lane + 256 * j); } }
        auto row = [&](u32x2 (&xn)[4], u32x2 (&mn)[4], const int i) __attribute__((always_inline)) {
            const int t = rb * 256 + X.wave * 32 + i;
            f32x4 v[4]; float s = 0.f;
#pragma unroll
            for (int j = 0; j < 4; ++j) { const u32x2 xw = xn[j]; const u32x2 mw = mn[j];
                if (keep_copy) *(u32x2*)(XC + (size_t)t * DM + 4 * lane + 256 * j) = xw;
                v[j][0] = ALPHA * bflo(xw.x) + bflo(mw.x); v[j][1] = ALPHA * bfhi(xw.x) + bfhi(mw.x); v[j][2] = ALPHA * bflo(xw.y) + bflo(mw.y); v[j][3] = ALPHA * bfhi(xw.y) + bfhi(mw.y);
                s += (v[j][0] + v[j][1]) + (v[j][2] + v[j][3]); }
            if (i + 2 < 32) {
#pragma unroll
                for (int j = 0; j < 4; ++j) { xn[j] = *(const u32x2*)(xin + (size_t)(t + 2) * DM + 4 * lane + 256 * j); mn[j] = *(const u32x2*)(MIX + (size_t)(t + 2) * DM + 4 * lane + 256 * j); } }
            const float mean = wave_sum(s) * (1.f / DM); float s2 = 0.f;
#pragma unroll
            for (int j = 0; j < 4; ++j) { v[j] = v[j] - mean; s2 += (v[j][0] * v[j][0] + v[j][1] * v[j][1]) + (v[j][2] * v[j][2] + v[j][3] * v[j][3]); }
            const float rstd = 1.0f / sqrtf(wave_sum(s2) * (1.f / DM) + 1e-5f);
#pragma unroll
            for (int j = 0; j < 4; ++j) { v[j] = v[j] * rstd * g[j] + bb[j];
                u32x2 w; w.x = pk2(v[j][0], v[j][1]); w.y = pk2(v[j][2], v[j][3]); stg8<NT_LN>(X1B + (size_t)t * DM + 4 * lane + 256 * j, w); }
            float lg[4];
            { f32x2 pa[4], pb[4];
#pragma unroll
              for (int gi = 0; gi < 4; ++gi) { pa[gi] = (f32x2){0.f, 0.f}; pb[gi] = (f32x2){0.f, 0.f}; }
#pragma unroll
              for (int j = 0; j < 4; ++j) { const f32x2 vxy = {v[j][0], v[j][1]}, vzw = {v[j][2], v[j][3]};
#pragma unroll
                  for (int gi = 0; gi < 4; ++gi) { const f32x4 w = *(const LAS f32x4*)(rgT + gi * DM + 4 * lane + 256 * j);
                      pa[gi] = __builtin_elementwise_fma(vxy, (f32x2){w[0], w[1]}, pa[gi]); pb[gi] = __builtin_elementwise_fma(vzw, (f32x2){w[2], w[3]}, pb[gi]); } }
#pragma unroll
              for (int gi = 0; gi < 4; ++gi) { const f32x2 q = pa[gi] + pb[gi]; lg[gi] = q.x + q.y; }
              wave_sum_n<4>(lg);
#pragma unroll
              for (int gi = 0; gi < 4; ++gi) lg[gi] += rgb[gi]; }
            int gs = 0; float gm = lg[0];
#pragma unroll
            for (int gi = 1; gi < 4; ++gi) if (lg[gi] > gm) { gm = lg[gi]; gs = gi; }
            float den = 0.f;
#pragma unroll
            for (int gi = 0; gi < 4; ++gi) den += __expf(lg[gi] - gm);
            const float ptop = __builtin_amdgcn_rcpf(den);
            gs = __builtin_amdgcn_readfirstlane(gs);
            float le[8];
            { f32x2 pa[8], pb[8]; const LAS float* reG = reT + gs * 8 * DM + 4 * lane;
#pragma unroll
              for (int e = 0; e < 8; ++e) { pa[e] = (f32x2){0.f, 0.f}; pb[e] = (f32x2){0.f, 0.f}; }
#pragma unroll
              for (int j = 0; j < 4; ++j) { const f32x2 vxy = {v[j][0], v[j][1]}, vzw = {v[j][2], v[j][3]};
#pragma unroll
                  for (int e = 0; e < 8; ++e) { const f32x4 w = *(const LAS f32x4*)(reG + e * DM + 256 * j);
                      pa[e] = __builtin_elementwise_fma(vxy, (f32x2){w[0], w[1]}, pa[e]); pb[e] = __builtin_elementwise_fma(vzw, (f32x2){w[2], w[3]}, pb[e]); } }
#pragma unroll
              for (int e = 0; e < 8; ++e) { const f32x2 q = pa[e] + pb[e]; le[e] = q.x + q.y; }
              wave_sum_n<8>(le);
#pragma unroll
              for (int e = 0; e < 8; ++e) le[e] += reb[gs * 8 + e]; }
            int e1 = 0; float v1 = le[0];
#pragma unroll
            for (int e = 1; e < 8; ++e) if (le[e] > v1) { v1 = le[e]; e1 = e; }
            int e2 = -1; float v2 = -INFINITY;
#pragma unroll
            for (int e = 0; e < 8; ++e) if (e != e1 && le[e] > v2) { v2 = le[e]; e2 = e; }
            const float wa = __builtin_amdgcn_rcpf(1.0f + __expf(v2 - v1)), wb = 1.0f - wa;
            if (lane == 0) { u32x4 ro; ro.x = (unsigned)(gs * 8 + e1); ro.y = (unsigned)(gs * 8 + e2); ro.z = __builtin_bit_cast(unsigned, ptop * wa); ro.w = __builtin_bit_cast(unsigned, ptop * wb);
                *(u32x4*)(X.ws + WS_ROUTE + (size_t)t * 16) = ro;
                __hip_atomic_fetch_add(hist + gs * 8 + e1, 1, __ATOMIC_RELAXED, __HIP_MEMORY_SCOPE_WORKGROUP); __hip_atomic_fetch_add(hist + gs * 8 + e2, 1, __ATOMIC_RELAXED, __HIP_MEMORY_SCOPE_WORKGROUP); }
        };
#pragma unroll 1
        for (int i = 0; i < 32; i += 2) { row(xa, ma, i); row(xb, mb, i + 1); }
        __syncthreads();
        if (X.tid < 32) ((int*)(X.ws + WS_HIST))[rb * 32 + X.tid] = hist[X.tid];
        __syncthreads();
    }
}

__device__ __forceinline__ void ln1_router_mfma(const Ctx& X, const CArgs* ap, int l, bool dummy = false) {
    struct { const float *ln1g, *ln1b, *rgb, *reb; } a = {ap->ln1g, ap->ln1b, ap->rgb, ap->reb};
    const bf16* xin = (const bf16*)((const unsigned char*)ap->out + XR_OFF);
    const int lane = X.lane, jr = lane & 31, hh = lane >> 5; const bf16* MIX = (const bf16*)(X.ws + WS_MIX); bf16* X1B = (bf16*)(X.ws + (dummy ? WS_Y : WS_XB));
    constexpr int WP = 1032;
    LAS bf16* wr = (LAS bf16*)X.lds;
    LAS float* rbias = (LAS float*)(X.lds + 40 * WP * 2);
    LAS int* hist = (LAS int*)(X.lds + LDSCTL_OFF + 256);
    { const float* ret = (const float*)(X.ws + WS_RET) + (size_t)l * 32 * DM; const float* rgt = (const float*)(X.ws + WS_RGT) + (size_t)l * 4 * DM;
      for (int i = X.tid; i < 40 * 256; i += 512) { const int row = i >> 8, c4 = i & 255; f32x4 w = {0.f, 0.f, 0.f, 0.f};
          if (row < 32) w = *(const f32x4*)(ret + (size_t)row * DM + 4 * c4); else if (row < 36) w = *(const f32x4*)(rgt + (size_t)(row - 32) * DM + 4 * c4);
          u32x2 p; p.x = pk2(w[0], w[1]); p.y = pk2(w[2], w[3]); *(LAS u32x2*)(wr + row * WP + 4 * c4) = p; }
      if (X.tid < 32) rbias[X.tid] = a.reb[l * 32 + X.tid]; else if (X.tid < 36) rbias[X.tid] = a.rgb[l * 4 + X.tid - 32]; }
    f32x4 g[4], bb[4];
#pragma unroll
    for (int j = 0; j < 4; ++j) { g[j] = *(const f32x4*)(a.ln1g + l * DM + 4 * lane + 256 * j); bb[j] = *(const f32x4*)(a.ln1b + l * DM + 4 * lane + 256 * j); }
    auto ldm = [&](int t, int j) __attribute__((always_inline)) -> u32x2 {
        if (MIX_FP8) { u32x2 r; r.x = *(const unsigned*)((const unsigned char*)MIX + (size_t)t * DM + 4 * lane + 256 * j); r.y = 0u; return r; }
        return ldg_s<u32x2>(MIX + (size_t)t * DM + 4 * lane + 256 * j); };
    for (int rb = X.c; rb < NT / 256; rb += X.G) {
        if (X.tid < 32) hist[X.tid] = 0;
        __syncthreads();
        const int tw = rb * 256 + X.wave * 32;
        u32x2 xa[4], xb[4]; u32x2 ma[4], mb[4];
#pragma unroll
        for (int j = 0; j < 4; ++j) { xa[j] = ldg_s<u32x2>(xin + (size_t)tw * DM + 4 * lane + 256 * j); ma[j] = ldm(tw, j); }
#pragma unroll
        for (int j = 0; j < 4; ++j) { xb[j] = ldg_s<u32x2>(xin + (size_t)(tw + 1) * DM + 4 * lane + 256 * j); mb[j] = ldm(tw + 1, j); }
        auto row = [&](u32x2 (&xn)[4], u32x2 (&mn)[4], const int i) __attribute__((always_inline)) {
            const int t = tw + i;
            f32x4 v[4]; float s = 0.f;
#pragma unroll
            for (int j = 0; j < 4; ++j) { const u32x2 xw = xn[j]; const u32x2 mw = mn[j];
                f32x4 mf;
                if (MIX_FP8) mf = pg8::fp8x4_to_f32(mw.x) * (1.0f / MIX_SCALE); else mf = (f32x4){bflo(mw.x), bfhi(mw.x), bflo(mw.y), bfhi(mw.y)};
                v[j][0] = ALPHA * bflo(xw.x) + mf[0]; v[j][1] = ALPHA * bfhi(xw.x) + mf[1]; v[j][2] = ALPHA * bflo(xw.y) + mf[2]; v[j][3] = ALPHA * bfhi(xw.y) + mf[3];
                s += (v[j][0] + v[j][1]) + (v[j][2] + v[j][3]); }
            if (i + 2 < 32) {
#pragma unroll
                for (int j = 0; j < 4; ++j) { xn[j] = ldg_s<u32x2>(xin + (size_t)(t + 2) * DM + 4 * lane + 256 * j); mn[j] = ldm(t + 2, j); } }
            const float mean = wave_sum(s) * (1.f / DM); float s2 = 0.f;
#pragma unroll
            for (int j = 0; j < 4; ++j) { v[j] = v[j] - mean; s2 += (v[j][0] * v[j][0] + v[j][1] * v[j][1]) + (v[j][2] * v[j][2] + v[j][3] * v[j][3]); }
            const float rstd = __builtin_amdgcn_rsqf(wave_sum(s2) * (1.f / DM) + 1e-5f);
#pragma unroll
            for (int j = 0; j < 4; ++j) { v[j] = v[j] * rstd * g[j] + bb[j];
                u32x2 w; w.x = pk2(v[j][0], v[j][1]); w.y = pk2(v[j][2], v[j][3]); stg8<NT_LN>(X1B + (size_t)t * DM + 4 * lane + 256 * j, w); }
        };
#pragma unroll 1
        for (int i = 0; i < 32; i += 2) { row(xa, ma, i); row(xb, mb, i + 1); }
        asm volatile("s_waitcnt vmcnt(0)" ::: "memory");
        f32x16 acc0, acc1;
#pragma unroll
        for (int i = 0; i < 16; ++i) { acc0[i] = 0.f; acc1[i] = 0.f; }
        const bf16* bp = X1B + (size_t)(tw + jr) * DM + 16 * hh;
        const LAS bf16* a0p = wr + jr * WP + 16 * hh; const LAS bf16* a1p = wr + (32 + (jr < 8 ? jr : 7)) * WP + 16 * hh;
#pragma unroll 4
        for (int t2 = 0; t2 < 32; ++t2) {
            const bf16x8 b0 = *(const bf16x8*)(bp + 32 * t2), b1 = *(const bf16x8*)(bp + 32 * t2 + 8);
            const bf16x8 a00 = *(const LAS bf16x8*)(a0p + 32 * t2), a01 = *(const LAS bf16x8*)(a0p + 32 * t2 + 8), a10 = *(const LAS bf16x8*)(a1p + 32 * t2), a11 = *(const LAS bf16x8*)(a1p + 32 * t2 + 8);
            acc0 = __builtin_amdgcn_mfma_f32_32x32x16_bf16(a00, b0, acc0, 0, 0, 0); acc1 = __builtin_amdgcn_mfma_f32_32x32x16_bf16(a10, b0, acc1, 0, 0, 0);
            acc0 = __builtin_amdgcn_mfma_f32_32x32x16_bf16(a01, b1, acc0, 0, 0, 0); acc1 = __builtin_amdgcn_mfma_f32_32x32x16_bf16(a11, b1, acc1, 0, 0, 0);
        }
        float gl[4];
#pragma unroll
        for (int i = 0; i < 4; ++i) { const auto tt = __builtin_amdgcn_permlane32_swap(__float_as_uint(acc1[i]), __float_as_uint(acc1[i]), false, false); gl[i] = __uint_as_float(tt[0]) + rbias[32 + i]; }
        int gs = 0; float gm = gl[0];
#pragma unroll
        for (int gi = 1; gi < 4; ++gi) if (gl[gi] > gm) { gm = gl[gi]; gs = gi; }
        float den = 0.f;
#pragma unroll
        for (int gi = 0; gi < 4; ++gi) den += __expf(gl[gi] - gm);
        const float ptop = __builtin_amdgcn_rcpf(den);
        float le[8];
#pragma unroll
        for (int k = 0; k < 4; ++k) { const float mine = gs == 0 ? acc0[k] : (gs == 1 ? acc0[4 + k] : (gs == 2 ? acc0[8 + k] : acc0[12 + k]));
            const auto tt = __builtin_amdgcn_permlane32_swap(__float_as_uint(mine), __float_as_uint(mine), false, false);
            le[k] = __uint_as_float(tt[0]); le[4 + k] = __uint_as_float(tt[1]); }
#pragma unroll
        for (int e = 0; e < 8; ++e) le[e] += rbias[gs * 8 + e];
        int e1 = 0; float v1 = le[0];
#pragma unroll
        for (int e = 1; e < 8; ++e) if (le[e] > v1) { v1 = le[e]; e1 = e; }
        int e2 = -1; float v2 = -INFINITY;
#pragma unroll
        for (int e = 0; e < 8; ++e) if (e != e1 && le[e] > v2) { v2 = le[e]; e2 = e; }
        const float wa = __builtin_amdgcn_rcpf(1.0f + __expf(v2 - v1)), wb = 1.0f - wa;
        if (hh == 0) { u32x4 ro; ro.x = (unsigned)(gs * 8 + e1); ro.y = (unsigned)(gs * 8 + e2); ro.z = __builtin_bit_cast(unsigned, ptop * wa); ro.w = __builtin_bit_cast(unsigned, ptop * wb);
            *(u32x4*)(X.ws + WS_ROUTE + (size_t)(tw + jr) * 16) = ro;
            __hip_atomic_fetch_add(hist + gs * 8 + e1, 1, __ATOMIC_RELAXED, __HIP_MEMORY_SCOPE_WORKGROUP); __hip_atomic_fetch_add(hist + gs * 8 + e2, 1, __ATOMIC_RELAXED, __HIP_MEMORY_SCOPE_WORKGROUP); }
        __syncthreads();
        if (X.tid < 32) ((int*)(X.ws + WS_HIST))[rb * 32 + X.tid] = hist[X.tid];
        __syncthreads();
    }
}

__device__ __forceinline__ void moe_dispatch(const Ctx& X) {
    LAS int* cnt = (LAS int*)(X.lds);
    LAS int* pre = cnt + 32;
    LAS int* ebase = cnt + 64;
    LAS int* wcnt = cnt + 128;
    const int* HIST = (const int*)(X.ws + WS_HIST); int* STOK = (int*)(X.ws + WS_STOK); float* SW = (float*)(X.ws + WS_SW); int* TSLOT = (int*)(X.ws + WS_TSLOT); int* TILEE = (int*)(X.ws + WS_TILEE);
    for (int rb = X.c; rb < NT / 256; rb += X.G) {
        if (X.tid < 64) cnt[X.tid] = 0;
        __syncthreads();
        { const int e = X.tid & 31, part = X.tid >> 5; int sa = 0, sp = 0;
          for (int q = 0; q < 16; ++q) { const int b2 = part * 16 + q; const int hv = HIST[b2 * 32 + e]; sa += hv; if (b2 < rb) sp += hv; }
          __hip_atomic_fetch_add(cnt + e, sa, __ATOMIC_RELAXED, __HIP_MEMORY_SCOPE_WORKGROUP); __hip_atomic_fetch_add(pre + e, sp, __ATOMIC_RELAXED, __HIP_MEMORY_SCOPE_WORKGROUP); }
        __syncthreads();
        if (X.tid < 64) { const int n = X.tid < 32 ? cnt[X.tid] : 0; const int pad = (n + 255) & ~255; int inc = pad;
#pragma unroll
            for (int o = 1; o < 32; o <<= 1) { const int u = __shfl_up(inc, o); if ((X.tid & 63) >= o) inc += u; }
            if (X.tid < 32) { ebase[X.tid] = inc - pad; if (X.tid == 31) ebase[32] = inc; } }
        __syncthreads();
        const int tl = X.tid >> 1, kk = X.tid & 1, t = rb * 256 + tl;
        const u32x4 ro = *(const u32x4*)(X.ws + WS_ROUTE + (size_t)t * 16);
        const int e = (int)(kk ? ro.y : ro.x); const float w = __builtin_bit_cast(float, kk ? ro.w : ro.z);
        int rank = 0;
        for (int ee = 0; ee < 32; ++ee) { const unsigned long long mm = __ballot(e == ee);
            if (e == ee) rank = __builtin_popcountll(mm & ((1ull << X.lane) - 1ull));
            if (X.lane == 0) wcnt[X.wave * 32 + ee] = __builtin_popcountll(mm); }
        __syncthreads();
        int off = 0;
        for (int w2 = 0; w2 < X.wave; ++w2) off += wcnt[w2 * 32 + e];
        const int slot = ebase[e] + pre[e] + off + rank;
        STOK[slot] = t; SW[slot] = w; TSLOT[2 * t + kk] = slot;
        if (rb < 32) { const int e2 = rb; for (int s = ebase[e2] + cnt[e2] + X.tid; s < ebase[e2 + 1]; s += 512) { STOK[s] = 0; SW[s] = 0.f; } }
        if (rb == 0) { const int ntl = ebase[32] >> 8;
            for (int tile = X.tid; tile < ntl; tile += 512) { int ee = 0; while (ee < 31 && ebase[ee + 1] <= tile * 256) ++ee; TILEE[tile] = ee; }
            if (X.tid == 0) TILEE[1024] = ntl; }
        __syncthreads();
    }
}

__device__ __forceinline__ void ln2_phase(const Ctx& X, const CArgs* ap, int l, bool first, bool dummy = false) {
    struct { const float *ln1g, *ln1b, *ln2g, *ln2b; } a = {ap->ln1g, ap->ln1b, ap->ln2g, ap->ln2b}; float* outw = dummy ? (float*)(X.ws + WS_Y + 272 * MiB) : ap->out; (void)first;
    const bool last = (l + 1 == DEPTH);
    const bf16* xin = LN2_X1B ? (const bf16*)(X.ws + WS_XB) : (last ? (const bf16*)(X.ws + WS_KVA) : (const bf16*)((const unsigned char*)ap->out + XR_OFF));
    const int lane = X.lane; const bf16* Y = (const bf16*)(X.ws + WS_Y); const bf16* MIX = (const bf16*)(X.ws + WS_MIX); const int* TSLOT = (const int*)(X.ws + WS_TSLOT); bf16* XBp = dummy ? (bf16*)(X.ws + WS_MIX) : (bf16*)((unsigned char*)ap->out + XR_OFF);
    auto ldy = [&](int slot, int j) __attribute__((always_inline)) -> u32x2 {
        if (Y_FP8) { u32x2 r; r.x = ldg_s<unsigned>((const unsigned char*)Y + (size_t)slot * DM + 4 * lane + 256 * j); r.y = 0u; return r; }
        return ldg_s<u32x2>(Y + (size_t)slot * DM + 4 * lane + 256 * j); };
    f32x4 g1[4], b1[4], g[4], bb[4];
#pragma unroll
    for (int j = 0; j < 4; ++j) { g1[j] = *(const f32x4*)(a.ln1g + l * DM + 4 * lane + 256 * j); b1[j] = *(const f32x4*)(a.ln1b + l * DM + 4 * lane + 256 * j);
        g[j] = *(const f32x4*)(a.ln2g + l * DM + 4 * lane + 256 * j); bb[j] = *(const f32x4*)(a.ln2b + l * DM + 4 * lane + 256 * j); }
    for (int rb = X.c; rb < NT / 256; rb += X.G) {
        const int tb = rb * 256 + X.wave * 32;
        const int myslots_a = TSLOT[2 * (tb + (lane & 31))], myslots_b = TSLOT[2 * (tb + (lane & 31)) + 1];
        u32x2 xn[4]; u32x2 mn[4], yan[4], ybn[4];
        { const int sa = __builtin_amdgcn_readlane(myslots_a, 0), sb = __builtin_amdgcn_readlane(myslots_b, 0);
#pragma unroll
          for (int j = 0; j < 4; ++j) { xn[j] = *(const u32x2*)(xin + (size_t)tb * DM + 4 * lane + 256 * j); mn[j] = LN2_X1B ? (u32x2){0u, 0u} : *(const u32x2*)(MIX + (size_t)tb * DM + 4 * lane + 256 * j);
              yan[j] = ldy(sa, j); ybn[j] = ldy(sb, j); } }
        for (int i = 0; i < 32; ++i) {
            const int t = tb + i;
            f32x4 v[4]; float s = 0.f;
#pragma unroll
            for (int j = 0; j < 4; ++j) { const u32x2 xw = xn[j]; const u32x2 mw = mn[j];
                if (LN2_X1B) { v[j][0] = bflo(xw.x); v[j][1] = bfhi(xw.x); v[j][2] = bflo(xw.y); v[j][3] = bfhi(xw.y); }
                else { v[j][0] = ALPHA * bflo(xw.x) + bflo(mw.x); v[j][1] = ALPHA * bfhi(xw.x) + bfhi(mw.x); v[j][2] = ALPHA * bflo(xw.y) + bflo(mw.y); v[j][3] = ALPHA * bfhi(xw.y) + bfhi(mw.y);
                    s += (v[j][0] + v[j][1]) + (v[j][2] + v[j][3]); } }
            u32x2 ya[4], yb[4];
#pragma unroll
            for (int j = 0; j < 4; ++j) { ya[j] = yan[j]; yb[j] = ybn[j]; }
            if (i + 1 < 32) { const int sa = __shfl(myslots_a, i + 1), sb = __shfl(myslots_b, i + 1);
#pragma unroll
                for (int j = 0; j < 4; ++j) { xn[j] = *(const u32x2*)(xin + (size_t)(t + 1) * DM + 4 * lane + 256 * j); if (!LN2_X1B) mn[j] = *(const u32x2*)(MIX + (size_t)(t + 1) * DM + 4 * lane + 256 * j);
                    yan[j] = ldy(sa, j); ybn[j] = ldy(sb, j); } }
            if (!LN2_X1B) { const float mean = wave_sum(s) * (1.f / DM); float s2 = 0.f;
#pragma unroll
              for (int j = 0; j < 4; ++j) { v[j] = v[j] - mean; s2 += (v[j][0] * v[j][0] + v[j][1] * v[j][1]) + (v[j][2] * v[j][2] + v[j][3] * v[j][3]); }
              const float rstd = 1.0f / sqrtf(wave_sum(s2) * (1.f / DM) + 1e-5f);
#pragma unroll
              for (int j = 0; j < 4; ++j) v[j] = v[j] * rstd * g1[j] + b1[j]; }
            s = 0.f;
#pragma unroll
            for (int j = 0; j < 4; ++j) { const f32x4 xv = v[j];
                if (Y_FP8) { const f32x4 fa = pg8::fp8x4_to_f32(ya[j].x), fb = pg8::fp8x4_to_f32(yb[j].x);
#pragma unroll
                    for (int e = 0; e < 4; ++e) v[j][e] = ALPHA * xv[e] + (fa[e] + fb[e]) * (1.0f / Y_SCALE);
                } else { v[j][0] = ALPHA * xv[0] + (bflo(ya[j].x) + bflo(yb[j].x)); v[j][1] = ALPHA * xv[1] + (bfhi(ya[j].x) + bfhi(yb[j].x)); v[j][2] = ALPHA * xv[2] + (bflo(ya[j].y) + bflo(yb[j].y)); v[j][3] = ALPHA * xv[3] + (bfhi(ya[j].y) + bfhi(yb[j].y)); }
                s += (v[j][0] + v[j][1]) + (v[j][2] + v[j][3]); }
            const float mean = wave_sum(s) * (1.f / DM); float s2 = 0.f;
#pragma unroll
            for (int j = 0; j < 4; ++j) { v[j] = v[j] - mean; s2 += (v[j][0] * v[j][0] + v[j][1] * v[j][1]) + (v[j][2] * v[j][2] + v[j][3] * v[j][3]); }
            const float rstd = 1.0f / sqrtf(wave_sum(s2) * (1.f / DM) + 1e-5f);
#pragma unroll
            for (int j = 0; j < 4; ++j) { v[j] = v[j] * rstd * g[j] + bb[j];
                if (last || dummy) stgf4<NT_LN>(outw + (size_t)t * DM + 4 * lane + 256 * j, v[j]);
                else { u32x2 w; w.x = pk2(v[j][0], v[j][1]); w.y = pk2(v[j][2], v[j][3]); stg8<NT_LN>(XBp + (size_t)t * DM + 4 * lane + 256 * j, w); } }
        }
    }
}

#ifndef REP_P0
#define REP_P0 1
#endif
#ifndef REP_P5
#define REP_P5 1
#endif
#ifndef REP_P9
#define REP_P9 1
#endif
#ifndef REP_BAR
#define REP_BAR 1
#endif
#ifndef REP_P1
#define REP_P1 1
#endif
#ifndef REP_P2A
#define REP_P2A 1
#endif
#ifndef REP_P2B
#define REP_P2B 1
#endif
#ifndef REP_P2C
#define REP_P2C 1
#endif
#ifndef REP_P2D
#define REP_P2D 1
#endif
#ifndef REP_P3A
#define REP_P3A 1
#endif
#ifndef REP_P3B
#define REP_P3B 1
#endif
#ifndef REP_P3C
#define REP_P3C 1
#endif
#ifndef REP_P4
#define REP_P4 1
#endif
#ifndef REP_P6
#define REP_P6 1
#endif
#ifndef REP_P7
#define REP_P7 1
#endif
#ifndef REP_P8
#define REP_P8 1
#endif
__global__ void __launch_bounds__(512, 2) mk_fwd(Args a) {
    extern __shared__ __attribute__((aligned(16))) unsigned char lds_raw[];
    LAS unsigned char* const lds0 = (LAS unsigned char*)lds_raw;
    for (int u = threadIdx.x; u < (LDS_BYTES - LDSCTL_OFF) / 4; u += 512) ((LAS unsigned*)(lds0 + LDSCTL_OFF))[u] = 0u;
    __syncthreads();
    unsigned* barw = (unsigned*)(a.ws + WS_CTL) + CW_BAR;
    XcdBarrier bar; bar.bar = barw; bar.x = 0; bar.st = nullptr;
    if (a.use_bar) bar = xcd_barrier_post(barw, (volatile LAS unsigned*)(lds0 + LDSCTL_OFF) + 8);
#define MKCTX() Ctx X; const CArgs* ap = (const CArgs*)__builtin_amdgcn_kernarg_segment_ptr(); asm volatile("" : "+s"(ap)); { int t_ = threadIdx.x; asm volatile("" : "+v"(t_)); X.lds = lds0; X.tid = t_; X.lane = t_ & 63; X.wave = __builtin_amdgcn_readfirstlane(t_ >> 6); \
        unsigned char* w_ = ap->ws; X.G = gridDim.x; X.c = blockIdx.x; X.vcu = (X.G % 8 == 0) ? (X.c % 8) * (X.G / 8) + X.c / 8 : X.c; X.ws = w_; }
#ifndef P2M
#define P2M 31
#endif
#ifndef PH_MASK0
#define PH_MASK0 1
#endif
#define GBAR() do { if (a.use_bar) for (int rb_ = 0; rb_ < REP_BAR; ++rb_) xcd_barrier(bar); } while (0)

    if ((PH_MASK0 & 1) && a.l_lo == 0 && a.ph_lo == 0) { MKCTX(); for (int rep = 0; rep < REP_P0; ++rep) { prologue(X, ap); __syncthreads(); } GBAR(); }

    for (int l = a.l_lo; l < a.l_hi; ++l) {
        const int lo = (l == a.l_lo) ? (a.ph_lo < 1 ? 1 : a.ph_lo) : 1, hi = (l == a.l_hi - 1) ? a.ph_hi : 10;
#ifndef PH_MASK
#define PH_MASK 0x3ff
#endif
#define IN(k) (((PH_MASK >> (k)) & 1) && lo <= (k) && (k) < hi)
        if (IN(1)) { MKCTX();
            pg8::Gemm g{(const bf16*)((const unsigned char*)ap->out + XR_OFF), (const bf16*)(X.ws + WS_WIN) + (size_t)l * NIN * DM, DM, nullptr};
            pg8::StaticOrder S; S.init(NT, NIN, X.G, X.c, REP_P1);
            pg8::RopeTabs R{ap->pos};
            pg8::EpiGroups<InProjDesc> E{InProjDesc{X.ws}, R, nullptr, 0, 0.f, 0.f};
            pg8::gemm_phase<pg8::EpiGroups<InProjDesc>, pg8::StaticOrder, false>(X.lds, g, S, E, X.tid);
            GBAR();
        }
        if (IN(2)) { MKCTX();
            {
                pg8::Gemm g{(const bf16*)(X.ws + WS_CQ), (const bf16*)(X.ws + WS_WUQ) + (size_t)l * 768 * 256, 256, nullptr};
                pg8::StaticOrder S; S.init(NT, 768, X.G, X.c, REP_P2A);
                pg8::RopeTabs R{ap->pos};
                pg8::EpiGroups<UqDesc> E{UqDesc{X.ws}, R, (const float*)(X.ws + WS_SSQ), 8, 1.0f / 256.0f, 1e-6f};
                pg8::gemm_phase<pg8::EpiGroups<UqDesc>, pg8::StaticOrder, false>(X.lds, g, S, E, X.tid);
            }
            {
                MKCTX();
                int kq = 128; asm volatile("" : "+s"(kq));
                pg8::Gemm g{(const bf16*)(X.ws + WS_T1), (const bf16*)(X.ws + WS_WUKV) + (size_t)l * 1024 * 128, kq, nullptr};
                pg8::StaticOrder S; S.init(NT, 1024, X.G, X.c, REP_P2A);
                pg8::EpiPlainT<NT_KVA> E{(bf16*)(X.ws + WS_KVA), 1024, (const float*)(X.ws + WS_SSQ) + (size_t)NT * 8, 4, 1.0f / 128.0f, 1e-6f, X.lds + LDS_X_OFF};
                pg8::gemm_phase<decltype(E), pg8::StaticOrder, false>(X.lds, g, S, E, X.tid);
            }
            __syncthreads();
            for (int rep = 0; rep < REP_P2B; ++rep) convert_experts(X, ap, l);
            __syncthreads();
            for (int rep = 0; rep < REP_P2C; ++rep) for (int U = X.vcu; U < NB * 32; U += X.G) { const int b = U >> 5, pr = U & 31;
                dsa_index_unit(X, b, 32 * pr); dsa_index_unit(X, b, 32 * (63 - pr)); }
            __syncthreads();
#pragma unroll 1
            for (int cfg = 0; cfg < 3 * REP_P2D; ++cfg) { const int cfgi = cfg % 3;
                fa::Params P; const size_t co = (size_t)cfgi * NT * 256;
                P.Q = (const bf16*)(X.ws + WS_DQ) + co; P.q_pitch = 256; P.K1 = (const bf16*)(X.ws + WS_DK) + co; P.k1_pitch = 256; P.K2 = nullptr; P.k2_pitch = 0; P.k2_col = 0;
                P.V = (const bf16*)(X.ws + WS_DV) + co; P.v_pitch = 256; P.O = (bf16*)(X.ws + WS_OD) + co; P.o_pitch = 256; P.LSE = (float*)(X.ws + WS_LSE) + (size_t)cfgi * NT * 4; P.lse_pitch = 4; P.BM = nullptr;
                P.CL = cfgi == 0 ? 2048 : (cfgi == 1 ? 512 : 128); P.W = 128;
                const int vcu = X.vcu, G = X.G, wv = X.wave, CLc = P.CL;
                fa::attn_stream<64, 0, 2>(P, X.lds, X.tid, (NB * 2 * 16 - vcu + G - 1) / G, [=](int j) { const int U = vcu + j * G, bh = U >> 4, qb = U & 15, b = bh >> 1, hp = bh & 1;
                    const int q0 = 128 * qb, hh = 2 * hp + (wv >> 2); int klo = q0 & ~(CLc - 1); if (q0 - 128 > klo) klo = q0 - 128;
                    return fa::UnitDesc{b * SEQ, q0 + 32 * (wv & 3), 64 * hh, 64 * hh, hh, 128 * hp, 128 * hp, klo >> 6, (q0 + 127) >> 6}; });
            }
            GBAR();
        }
        if (IN(3)) { MKCTX();
            {   fa::Params P; P.Q = (const bf16*)(X.ws + WS_QA); P.q_pitch = 768; P.K1 = (const bf16*)(X.ws + WS_KVA); P.k1_pitch = 1024; P.K2 = (const bf16*)(X.ws + WS_KPE); P.k2_pitch = 32; P.k2_col = 0;
                P.V = (const bf16*)(X.ws + WS_KVA); P.v_pitch = 1024; P.O = (bf16*)(X.ws + WS_XB); P.o_pitch = DM; P.LSE = nullptr; P.lse_pitch = 0; P.BM = nullptr; P.CL = 2048; P.W = 1 << 20;
                const int vcu = X.vcu, G = X.G, wv = X.wave;
                fa::attn_stream<96, 2, 1>(P, X.lds, X.tid, 2 * ((NB * 8 * 4 - vcu + G - 1) / G), [=](int j) { const int U = vcu + (j >> 1) * G, bh = U >> 2, pr = U & 3, b = bh >> 3, hd = bh & 7;
                    const int qb = (j & 1) ? 7 - pr : pr, q0 = 256 * qb;
                    return fa::UnitDesc{b * SEQ, q0 + 32 * wv, 96 * hd, 64 * hd, 0, 128 * hd, 128 * hd + 64, 0, (q0 + 255) >> 6}; });
            }
            {   fa::Params P; P.Q = (const bf16*)(X.ws + WS_BQ); P.q_pitch = 256; P.K1 = (const bf16*)(X.ws + WS_BK); P.k1_pitch = 64; P.k1_col = 0; P.K2 = nullptr; P.k2_pitch = 0; P.k2_col = 0;
                P.V = (const bf16*)(X.ws + WS_BV); P.v_pitch = 64; P.v_col = 0; P.O = (bf16*)(X.ws + WS_XB); P.o_pitch = DM; P.LSE = nullptr; P.lse_pitch = 0; P.BM = (const unsigned*)(X.ws + WS_BM); P.CL = 2048; P.W = 1 << 20;
                const int hd = X.wave & 3, sub = X.wave >> 2, vcu = X.vcu, G = X.G;
                fa::attn_stream<64, 1, 1>(P, X.lds, X.tid, 2 * ((NB * 16 - vcu + G - 1) / G), [=](int j) { const int U = vcu + (j >> 1) * G, b = U >> 4, pr = U & 15;
                    const int qb = (j & 1) ? 31 - pr : pr, q0 = 64 * qb;
                    return fa::UnitDesc{b * SEQ, q0 + 32 * sub, 64 * hd, 512 + 64 * hd, 0, 0, 0, 0, qb}; });
            }
            for (int rep = 0; rep < REP_P3C; ++rep) dil_combine(X);
            GBAR();
        }
        if (IN(4)) { MKCTX();
            pg8::Gemm g{(const bf16*)(X.ws + WS_XB), (const bf16*)(X.ws + WS_WO) + (size_t)l * DM * DM, DM, nullptr};
            pg8::StaticOrder S; S.init(NT, DM, X.G, X.c, REP_P4);
#if MIX_FP8 && ROUTER_MFMA && LN2_X1B
            pg8::EpiFp8T<NT_MIX> E{X.ws + WS_MIX, DM, MIX_SCALE, X.lds + LDS_X_OFF};
#else
            pg8::EpiPlainT<NT_MIX> E{(bf16*)(X.ws + WS_MIX), DM, nullptr, 0, 0.f, 0.f, X.lds + LDS_X_OFF};
#endif
            pg8::gemm_phase<decltype(E), pg8::StaticOrder, false>(X.lds, g, S, E, X.tid);
            GBAR();
        }
#if ROUTER_MFMA
        if (IN(5)) { MKCTX(); if (REP_P5 > 1) ln1_router_mfma(X, ap, l, true); ln1_router_mfma(X, ap, l); GBAR(); }
#else
        if (IN(5)) { MKCTX(); if (REP_P5 > 1) ln1_router(X, ap, l, l == 0, true); ln1_router(X, ap, l, l == 0); GBAR(); }
#endif
        if (IN(6)) { MKCTX(); for (int rep = 0; rep < REP_P6; ++rep) moe_dispatch(X); GBAR(); }
        if (IN(7)) { MKCTX();
            const int* TILEE = (const int*)(X.ws + WS_TILEE);
            pg8::Gemm g{(const bf16*)(X.ws + WS_XB), (const bf16*)(X.ws + WS_WGU), DM, (const int*)(X.ws + WS_STOK)};
            pg8::GroupedOrder S{TILEE, TILEE[1024], 2, X.G, X.c};
            pg8::EpiGateUpT<NT_H> E{(bf16*)(X.ws + WS_H), (const float*)(X.ws + WS_SW)};
            for (int rep = 0; rep < REP_P7; ++rep) pg8::gemm_phase<decltype(E), pg8::GroupedOrder, true>(X.lds, g, S, E, X.tid);
            GBAR();
        }
        if (IN(8)) { MKCTX();
            const int* TILEE = (const int*)(X.ws + WS_TILEE);
            pg8::Gemm g{(const bf16*)(X.ws + WS_H), (const bf16*)(X.ws + WS_WD), FH, nullptr};
            pg8::GroupedOrder S{TILEE, TILEE[1024], 4, X.G, X.c};
#if Y_FP8
            pg8::EpiFp8T<NT_Y> E{X.ws + WS_Y, DM, Y_SCALE, X.lds + LDS_X_OFF};
#else
            pg8::EpiPlainT<NT_Y> E{(bf16*)(X.ws + WS_Y), DM, nullptr, 0, 0.f, 0.f, X.lds + LDS_X_OFF};
#endif
            for (int rep = 0; rep < REP_P8; ++rep) pg8::gemm_phase<decltype(E), pg8::GroupedOrder, false>(X.lds, g, S, E, X.tid);
            GBAR();
        }
        if (IN(9)) { MKCTX(); if (REP_P9 > 1) ln2_phase(X, ap, l, l == 0, true); ln2_phase(X, ap, l, l == 0); if (!(l == a.l_hi - 1)) GBAR(); }
#undef IN
    }
#undef GBAR
}

extern "C" void kernel_launch(void* const* d_in, const int* in_sizes, int n_in, void* d_out, int out_size, void* d_ws, size_t ws_size, hipStream_t stream) {
    static int grid = 0;
    if (grid == 0) {
        if (n_in != 19 || in_sizes[0] != NT * DM || out_size != NT * DM || ws_size < WS_END) { fprintf(stderr, "kernel_launch: unexpected shapes (n_in %d, in0 %d, out %d, ws %zu < %zu); nothing launched\n", n_in, n_in > 0 ? in_sizes[0] : -1, out_size, ws_size, (size_t)WS_END); grid = -1; return; }
        int dev = 0, cus = 0, per_cu = 0;
        if (hipGetDevice(&dev) != hipSuccess || hipDeviceGetAttribute(&cus, hipDeviceAttributeMultiprocessorCount, dev) != hipSuccess) { grid = -1; return; }
        if (hipFuncSetAttribute((const void*)mk_fwd, hipFuncAttributeMaxDynamicSharedMemorySize, LDS_BYTES) != hipSuccess) { fprintf(stderr, "kernel_launch: hipFuncSetAttribute failed\n"); grid = -1; return; }
        if (hipOccupancyMaxActiveBlocksPerMultiprocessor(&per_cu, (const void*)mk_fwd, 512, LDS_BYTES) != hipSuccess || per_cu < 1) fprintf(stderr, "kernel_launch: occupancy query reports %d\n", per_cu);
        (void)hipGetLastError();
        grid = cus;
    }
    if (grid < 0) return;
    (void)hipMemsetAsync((char*)d_ws + WS_CTL, 0, 32768, stream);
    Args a{};
    a.x = (const float*)d_in[0]; a.pos = (const int*)d_in[1]; a.w_in = (const float*)d_in[2]; a.qn = (const float*)d_in[3]; a.kvn = (const float*)d_in[4];
    a.w_uq = (const float*)d_in[5]; a.w_ukv = (const float*)d_in[6]; a.w_o = (const float*)d_in[7]; a.ln1g = (const float*)d_in[8]; a.ln1b = (const float*)d_in[9];
    a.rgw = (const float*)d_in[10]; a.rgb = (const float*)d_in[11]; a.rew = (const float*)d_in[12]; a.reb = (const float*)d_in[13];
    a.wg = (const float*)d_in[14]; a.wu = (const float*)d_in[15]; a.wd = (const float*)d_in[16]; a.ln2g = (const float*)d_in[17]; a.ln2b = (const float*)d_in[18];
    a.out = (float*)d_out; a.ws = (unsigned char*)d_ws; a.pad = 0;
#if MK_MULTI
    a.use_bar = 0;
    a.l_lo = 0; a.l_hi = 0; a.ph_lo = 0; a.ph_hi = 0;
    hipLaunchKernelGGL(mk_fwd, dim3(grid), dim3(512), LDS_BYTES, stream, a);
    for (int l = 0; l < DEPTH; ++l)
        for (int ph = 1; ph < 10; ++ph) { a.l_lo = l; a.l_hi = l + 1; a.ph_lo = ph; a.ph_hi = ph + 1; hipLaunchKernelGGL(mk_fwd, dim3(grid), dim3(512), LDS_BYTES, stream, a); }
#else
    a.use_bar = 1; a.l_lo = 0; a.l_hi = DEPTH; a.ph_lo = 0; a.ph_hi = 10;
    hipLaunchKernelGGL(mk_fwd, dim3(grid), dim3(512), LDS_BYTES, stream, a);
#endif
    const hipError_t le = hipPeekAtLastError();
    if (le != hipSuccess) fprintf(stderr, "kernel_launch: launch failed: %s\n", hipGetErrorName(le));
}
```
